# Optimizing an MI355X kernel written in HIP

```python
import math
import jax
import jax.numpy as jnp
from jax import lax
import numpy as np

D_MODEL = 1024
BATCH = 2
SEQ = 8192
DEPTH = 2

GRID_W = 64
CTX_LEN = 256
N_BRANCH = 4
BRANCH_W = D_MODEL // 4
FNET_GROUPS = 4
FNET_GROUP_DIM = BRANCH_W // FNET_GROUPS
S5_GROUP_CH = 16
S5_GROUPS = BRANCH_W // S5_GROUP_CH
S5_STATE = 64
RET_HEADS = 4
RET_DIM = BRANCH_W // RET_HEADS
RET_CHUNK = 128
NA_HEADS = 4
NA_DIM = BRANCH_W // NA_HEADS
NA_WIN_ROWS = 8
NA_WIN_COLS = 16
ROPE_BASE = 10000.0
D_FF = -(-(8 * D_MODEL // 3) // 256) * 256
N_EXPERTS = 8
TOP_K = 2
D_FF_EXPERT = 7 * D_MODEL // 2
N_DENSE = (DEPTH + 1) // 2
N_MOE = DEPTH // 2
EPS = 1e-6
IN_WIDTHS = (BRANCH_W,) * 9 + (N_BRANCH * D_MODEL,)
IN_W = sum(IN_WIDTHS)
IN_SPLITS = tuple(sum(IN_WIDTHS[:i + 1]) for i in range(len(IN_WIDTHS) - 1))
F32 = jnp.float32

kernel_name = 'hybrid_gated_mixer_dit_block'


def rms_norm(x, g):
    xf = x.astype(F32)
    y = xf * lax.rsqrt(jnp.mean(xf * xf, axis=-1, keepdims=True) + EPS)
    return (y * g.astype(F32)).astype(x.dtype)


def split_heads(t, n_heads):
    return t.reshape(t.shape[0], t.shape[1], n_heads, t.shape[-1] // n_heads)


def flip_seq(t, rev):
    return jnp.flip(t, axis=1) if rev else t


def axial_rope(n_tokens, head_dim):
    t = jnp.arange(n_tokens)
    row = (t // GRID_W).astype(F32)
    col = (t % GRID_W).astype(F32)
    n_freq = head_dim // 4
    inv_freq = 1.0 / (ROPE_BASE ** (jnp.arange(n_freq, dtype=F32) / n_freq))
    ang = jnp.concatenate([row[:, None] * inv_freq, col[:, None] * inv_freq], axis=-1)
    return jnp.cos(ang), jnp.sin(ang)


def apply_rope(x, cos, sin):
    x1, x2 = jnp.split(x, 2, axis=-1)
    c, s = cos[:, None, :], sin[:, None, :]
    return jnp.concatenate([x1 * c - x2 * s, x1 * s + x2 * c], axis=-1)


def fourier_mix(u):
    b_, l_, _ = u.shape
    ug = u.astype(F32).reshape(b_, l_, FNET_GROUPS, FNET_GROUP_DIM)
    f = jnp.fft.fft2(ug, axes=(1, 3), norm='ortho').real
    return f.reshape(b_, l_, BRANCH_W).astype(u.dtype)


def linear_combine(left, right):
    a_l, b_l = left
    a_r, b_r = right
    return a_l * a_r, a_r * b_l + b_r


def s5_states(u, a_re, a_im, log_dt, b_re, b_im, h0):
    lam = lax.complex(a_re, a_im)
    a_bar = jnp.exp(lam * jnp.exp(log_dt)[:, None])
    b_bar = ((a_bar - 1.0) / lam)[..., None] * lax.complex(b_re, b_im)
    bu = jnp.einsum('blgh,gph->blgp', u.astype(jnp.complex64), b_bar)
    bu = bu.at[:, 0].add(a_bar * h0)
    a = jnp.broadcast_to(a_bar, bu.shape)
    _, h = lax.associative_scan(linear_combine, (a, bu), axis=1)
    return h


def s5_mixer(u_l, u_c, a_re, a_im, log_dt, b_re, b_im, c_re, c_im, d_skip, w_glu, b_glu, need_ctx_out):
    dtype = u_l.dtype
    b_ = u_l.shape[0]

    def groups(u):
        return u.astype(F32).reshape(u.shape[0], u.shape[1], S5_GROUPS, S5_GROUP_CH)

    ul, uc = groups(u_l), groups(u_c)
    d = d_skip.astype(F32).reshape(S5_GROUPS, S5_GROUP_CH)
    y_l = d * ul
    y_c = d * uc if need_ctx_out else None
    for dirn in range(2):
        rev = dirn == 1
        prm = [p[dirn].astype(F32) for p in (a_re, a_im, log_dt, b_re, b_im)]
        c_mat = lax.complex(c_re[dirn].astype(F32), c_im[dirn].astype(F32))
        h0 = jnp.zeros((b_, S5_GROUPS, S5_STATE), jnp.complex64)
        h_c = s5_states(flip_seq(uc, rev), *prm, h0)
        h_l = s5_states(flip_seq(ul, rev), *prm, h_c[:, -1])
        y_l = y_l + flip_seq(jnp.einsum('blgp,ghp->blgh', h_l, c_mat).real, rev)
        if need_ctx_out:
            y_c = y_c + flip_seq(jnp.einsum('blgp,ghp->blgh', h_c, c_mat).real, rev)

    def glu(y):
        z = jax.nn.gelu(y).reshape(y.shape[0], y.shape[1], BRANCH_W).astype(dtype)
        return z * jax.nn.sigmoid(z @ w_glu + b_glu)

    return glu(y_l), (glu(y_c) if need_ctx_out else None)


def retention_scan(q, k, v, log_gamma, s0, with_output):
    b_, l_, h_, dk = k.shape
    dv = v.shape[-1]
    n_ch = l_ // RET_CHUNK
    kc = k.reshape(b_, n_ch, RET_CHUNK, h_, dk)
    vc = v.reshape(b_, n_ch, RET_CHUNK, h_, dv)
    pos = jnp.arange(RET_CHUNK, dtype=F32)
    k_decay = jnp.exp((RET_CHUNK - 1.0 - pos)[:, None] * log_gamma[None, :])
    chunk_decay = jnp.exp(RET_CHUNK * log_gamma)[None, :, None, None]
    kv = jnp.einsum('bnjhd,bnjhe->nbhde', kc * k_decay[:, :, None], vc)

    def step(s, kv_n):
        return chunk_decay * s + kv_n, s

    s_final, s_prev = lax.scan(step, s0, kv)
    if not with_output:
        return None, s_final
    qc = q.reshape(b_, n_ch, RET_CHUNK, h_, dk)
    diff = pos[:, None] - pos[None, :]
    intra = jnp.where(diff >= 0, jnp.exp(jnp.maximum(diff, 0.0)[None] * log_gamma[:, None, None]), 0.0)
    q_decay = jnp.exp((pos + 1.0)[:, None] * log_gamma[None, :])
    scores = jnp.einsum('bnihd,bnjhd->bnhij', qc, kc) * intra
    inner = jnp.einsum('bnhij,bnjhe->bnihe', scores, vc)
    cross = jnp.einsum('bnihd,nbhde->bnihe', qc * q_decay[:, :, None], s_prev)
    return (inner + cross).reshape(b_, l_, h_, dv), s_final


def head_norm(o, g):
    mu = jnp.mean(o, axis=-1, keepdims=True)
    var = jnp.mean(jnp.square(o - mu), axis=-1, keepdims=True)
    y = (o - mu) * lax.rsqrt(var + EPS)
    return y.reshape(o.shape[0], o.shape[1], -1) * g.astype(F32)


def retention_mixer(q_l, k_l, v_l, g_l, q_c, k_c, v_c, g_c, ret_decay, ret_gn, need_ctx_out):
    dtype = g_l.dtype
    log_gamma = jax.nn.log_sigmoid(ret_decay.astype(F32))
    s0 = jnp.zeros((q_l.shape[0], RET_HEADS, RET_DIM, RET_DIM), F32)
    o_l = jnp.zeros_like(v_l)
    o_c = jnp.zeros_like(v_c) if need_ctx_out else None
    for dirn in range(2):
        rev = dirn == 1
        oc_d, s_c = retention_scan(flip_seq(q_c, rev), flip_seq(k_c, rev), flip_seq(v_c, rev),
                                   log_gamma[dirn], s0, need_ctx_out)
        ol_d, _ = retention_scan(flip_seq(q_l, rev), flip_seq(k_l, rev), flip_seq(v_l, rev),
                                 log_gamma[dirn], s_c, True)
        o_l = o_l + flip_seq(ol_d, rev)
        if need_ctx_out:
            o_c = o_c + flip_seq(oc_d, rev)
    out_l = (jax.nn.silu(g_l.astype(F32)) * head_norm(o_l, ret_gn)).astype(dtype)
    out_c = (jax.nn.silu(g_c.astype(F32)) * head_norm(o_c, ret_gn)).astype(dtype) if need_ctx_out else None
    return out_l, out_c


def neighborhood_attention(q_l, k_l, v_l, q_c, k_c, v_c, rpb, need_ctx_out):
    b_, n_, h_, dh = q_l.shape
    rows = n_ // GRID_W
    kr = min(NA_WIN_ROWS, rows)
    kw = NA_WIN_COLS
    scale = dh ** -0.5
    qg = q_l.reshape(b_, rows, GRID_W, h_, dh)
    kg = k_l.reshape(b_, rows, GRID_W, h_, dh)
    vg = v_l.reshape(b_, rows, GRID_W, h_, dh)
    r = jnp.arange(rows)
    row_idx = jnp.clip(r - kr // 2, 0, rows - kr)[:, None] + jnp.arange(kr)[None, :]
    k_band = kg[:, row_idx]
    v_band = vg[:, row_idx]
    col = jnp.arange(GRID_W)
    col_start = jnp.clip(col - kw // 2, 0, GRID_W - kw)
    in_win = (col[None, :] >= col_start[:, None]) & (col[None, :] < col_start[:, None] + kw)
    dr = row_idx - r[:, None] + (NA_WIN_ROWS - 1)
    dc = jnp.clip(col[None, :] - col[:, None], -(kw - 1), kw - 1) + (kw - 1)
    bias = rpb[:, dr[:, None, :, None], dc[None, :, None, :]].astype(F32)
    s_band = jnp.einsum('brqhd,brikhd->bhrqik', qg, k_band).astype(F32) * scale + bias[None]
    s_band = jnp.where(in_win[:, None, :], s_band, -jnp.inf)
    s_ctx = jnp.einsum('brqhd,bchd->bhrqc', qg, k_c).astype(F32) * scale
    n_band = kr * GRID_W
    s_all = jnp.concatenate([s_band.reshape(b_, h_, rows, GRID_W, n_band), s_ctx], axis=-1)
    p = jax.nn.softmax(s_all, axis=-1).astype(v_l.dtype)
    p_band = p[..., :n_band].reshape(b_, h_, rows, GRID_W, kr, GRID_W)
    o = (jnp.einsum('bhrqik,brikhd->brqhd', p_band, v_band)
         + jnp.einsum('bhrqc,bchd->brqhd', p[..., n_band:], v_c))
    out_l = o.reshape(b_, n_, h_ * dh)
    out_c = None
    if need_ctx_out:
        s_cc = jnp.einsum('bqhd,bkhd->bhqk', q_c, k_c).astype(F32) * scale
        p_cc = jax.nn.softmax(s_cc, axis=-1).astype(v_c.dtype)
        out_c = jnp.einsum('bhqk,bkhd->bqhd', p_cc, v_c).reshape(b_, q_c.shape[1], h_ * dh)
    return out_l, out_c


def merge_branches(outs, gate_logits, w_branch, w_out):
    gates = jax.nn.sigmoid(gate_logits.astype(F32)).astype(gate_logits.dtype)
    y = gates[..., :D_MODEL] * (outs[0] @ w_branch[0])
    for b in range(1, N_BRANCH):
        y = y + gates[..., b * D_MODEL:(b + 1) * D_MODEL] * (outs[b] @ w_branch[b])
    return y @ w_out


def token_mixers(h_l, h_c, w_in, s5_a_re, s5_a_im, s5_log_dt, s5_b_re, s5_b_im, s5_c_re, s5_c_im,
                 s5_d, s5_w_glu, s5_b_glu, ret_decay, ret_gn, na_rpb, w_branch, w_out,
                 rope_cos, rope_sin, need_ctx_out):
    f_l, s_l, rq_l, rk_l, rv_l, rg_l, nq_l, nk_l, nv_l, gt_l = jnp.split(h_l @ w_in, IN_SPLITS, axis=-1)
    f_c, s_c, rq_c, rk_c, rv_c, rg_c, nq_c, nk_c, nv_c, gt_c = jnp.split(h_c @ w_in, IN_SPLITS, axis=-1)
    a_l = fourier_mix(f_l)
    b_l, b_c = s5_mixer(s_l, s_c, s5_a_re, s5_a_im, s5_log_dt, s5_b_re, s5_b_im, s5_c_re, s5_c_im,
                        s5_d, s5_w_glu, s5_b_glu, need_ctx_out)
    k_scale = RET_DIM ** -0.5

    def rh(t):
        return split_heads(t.astype(F32), RET_HEADS)

    q_lr = apply_rope(rh(rq_l), rope_cos, rope_sin)
    k_lr = apply_rope(rh(rk_l), rope_cos, rope_sin) * k_scale
    r_l, r_c = retention_mixer(q_lr, k_lr, rh(rv_l), rg_l, rh(rq_c), rh(rk_c) * k_scale, rh(rv_c), rg_c,
                               ret_decay, ret_gn, need_ctx_out)
    n_l, n_c = neighborhood_attention(split_heads(nq_l, NA_HEADS), split_heads(nk_l, NA_HEADS),
                                      split_heads(nv_l, NA_HEADS), split_heads(nq_c, NA_HEADS),
                                      split_heads(nk_c, NA_HEADS), split_heads(nv_c, NA_HEADS),
                                      na_rpb, need_ctx_out)
    y_l = merge_branches((a_l, b_l, r_l, n_l), gt_l, w_branch, w_out)
    y_c = merge_branches((fourier_mix(f_c), b_c, r_c, n_c), gt_c, w_branch, w_out) if need_ctx_out else None
    return y_l, y_c


def swiglu(h, w_gate, w_up, w_down):
    return (jax.nn.silu(h @ w_gate) * (h @ w_up)) @ w_down


def moe_swiglu(h, w_router, b_router, w_gate, w_up, w_down):
    logits = (h @ w_router).astype(F32) + b_router.astype(F32)
    top_val, top_idx = lax.top_k(logits, TOP_K)
    top_w = jax.nn.softmax(top_val, axis=-1)
    combine = jnp.sum(jax.nn.one_hot(top_idx, N_EXPERTS, dtype=F32) * top_w[..., None], axis=-2).astype(h.dtype)
    out = jnp.zeros_like(h)
    for e in range(N_EXPERTS):
        out = out + combine[..., e:e + 1] * swiglu(h, w_gate[e], w_up[e], w_down[e])
    return out


def setup_inputs(seed: int = 0) -> dict:
    key = jax.random.key(seed)
    ks = iter(jax.random.split(key, 40))

    def nrm(shape, scale):
        return jax.random.normal(next(ks), shape, F32) * scale

    L = DEPTH
    s5_shape = (L, 2, S5_GROUPS, S5_STATE)
    ret_init = jnp.asarray(np.log(2.0 ** (5 + np.arange(RET_HEADS)) - 1.0), F32)
    return {
        'x': nrm((BATCH, SEQ, D_MODEL), 1.0),
        'c': nrm((BATCH, D_MODEL), 1.0),
        'ctx': nrm((BATCH, CTX_LEN, D_MODEL), 1.0),
        'c_ctx': nrm((D_MODEL,), 1.0),
        'w_mod': nrm((L, D_MODEL, 6 * D_MODEL), 0.5 * D_MODEL ** -0.5),
        'b_mod': nrm((L, 6 * D_MODEL), 0.01),
        'norm_g': 1.0 + nrm((L, 4, D_MODEL), 0.05),
        'w_in': nrm((L, D_MODEL, IN_W), D_MODEL ** -0.5),
        's5_a_re': -0.5 + nrm(s5_shape, 0.01),
        's5_a_im': math.pi * jnp.arange(S5_STATE, dtype=F32) + nrm(s5_shape, 0.01),
        's5_log_dt': jax.random.uniform(next(ks), (L, 2, S5_GROUPS), F32, math.log(1e-3), math.log(1e-1)),
        's5_b_re': nrm((L, 2, S5_GROUPS, S5_STATE, S5_GROUP_CH), (2 * S5_GROUP_CH) ** -0.5),
        's5_b_im': nrm((L, 2, S5_GROUPS, S5_STATE, S5_GROUP_CH), (2 * S5_GROUP_CH) ** -0.5),
        's5_c_re': nrm((L, 2, S5_GROUPS, S5_GROUP_CH, S5_STATE), S5_STATE ** -0.5),
        's5_c_im': nrm((L, 2, S5_GROUPS, S5_GROUP_CH, S5_STATE), S5_STATE ** -0.5),
        's5_d': nrm((L, BRANCH_W), 1.0),
        's5_w_glu': nrm((L, BRANCH_W, BRANCH_W), BRANCH_W ** -0.5),
        's5_b_glu': nrm((L, BRANCH_W), 0.01),
        'ret_decay': ret_init + nrm((L, 2, RET_HEADS), 0.05),
        'ret_gn': 1.0 + nrm((L, BRANCH_W), 0.05),
        'na_rpb': nrm((L, NA_HEADS, 2 * NA_WIN_ROWS - 1, 2 * NA_WIN_COLS - 1), 0.02),
        'w_branch': nrm((L, N_BRANCH, BRANCH_W, D_MODEL), BRANCH_W ** -0.5),
        'w_out': nrm((L, D_MODEL, D_MODEL), D_MODEL ** -0.5),
        'ffn_w_gate': nrm((N_DENSE, D_MODEL, D_FF), D_MODEL ** -0.5),
        'ffn_w_up': nrm((N_DENSE, D_MODEL, D_FF), D_MODEL ** -0.5),
        'ffn_w_down': nrm((N_DENSE, D_FF, D_MODEL), D_FF ** -0.5),
        'moe_w_router': nrm((N_MOE, D_MODEL, N_EXPERTS), D_MODEL ** -0.5),
        'moe_b_router': nrm((N_MOE, N_EXPERTS), 0.01),
        'moe_w_gate': nrm((N_MOE, N_EXPERTS, D_MODEL, D_FF_EXPERT), D_MODEL ** -0.5),
        'moe_w_up': nrm((N_MOE, N_EXPERTS, D_MODEL, D_FF_EXPERT), D_MODEL ** -0.5),
        'moe_w_down': nrm((N_MOE, N_EXPERTS, D_FF_EXPERT, D_MODEL), D_FF_EXPERT ** -0.5),
    }


def reference(x, c, ctx, c_ctx, w_mod, b_mod, norm_g, w_in, s5_a_re, s5_a_im, s5_log_dt, s5_b_re, s5_b_im,
              s5_c_re, s5_c_im, s5_d, s5_w_glu, s5_b_glu, ret_decay, ret_gn, na_rpb, w_branch, w_out,
              ffn_w_gate, ffn_w_up, ffn_w_down, moe_w_router, moe_b_router, moe_w_gate, moe_w_up, moe_w_down):
    rope_cos, rope_sin = axial_rope(x.shape[1], RET_DIM)
    cond = jnp.concatenate([c, c_ctx[None, :]], axis=0)
    for layer in range(DEPTH):
        last = layer == DEPTH - 1
        mod = jax.nn.silu(cond) @ w_mod[layer] + b_mod[layer]
        sh_a, sc_a, g_a, sh_f, sc_f, g_f = jnp.split(mod[:-1, None, :], 6, axis=-1)
        csh_a, csc_a, cg_a, csh_f, csc_f, cg_f = jnp.split(mod[-1:, None, :], 6, axis=-1)
        h_l = rms_norm(x, norm_g[layer, 0]) * (1 + sc_a) + sh_a
        h_c = rms_norm(ctx, norm_g[layer, 0]) * (1 + csc_a) + csh_a
        y_l, y_c = token_mixers(h_l, h_c, w_in[layer], s5_a_re[layer], s5_a_im[layer], s5_log_dt[layer],
                                s5_b_re[layer], s5_b_im[layer], s5_c_re[layer], s5_c_im[layer], s5_d[layer],
                                s5_w_glu[layer], s5_b_glu[layer], ret_decay[layer], ret_gn[layer],
                                na_rpb[layer], w_branch[layer], w_out[layer], rope_cos, rope_sin, not last)
        x = x + g_a * rms_norm(y_l, norm_g[layer, 1])
        if not last:
            ctx = ctx + cg_a * rms_norm(y_c, norm_g[layer, 1])
        i = layer // 2
        if layer % 2 == 0:
            def ffn(h):
                return swiglu(h, ffn_w_gate[i], ffn_w_up[i], ffn_w_down[i])
        else:
            def ffn(h):
                return moe_swiglu(h, moe_w_router[i], moe_b_router[i], moe_w_gate[i], moe_w_up[i], moe_w_down[i])
        h_l = rms_norm(x, norm_g[layer, 2]) * (1 + sc_f) + sh_f
        x = x + g_f * rms_norm(ffn(h_l), norm_g[layer, 3])
        if not last:
            h_c = rms_norm(ctx, norm_g[layer, 2]) * (1 + csc_f) + csh_f
            ctx = ctx + cg_f * rms_norm(ffn(h_c), norm_g[layer, 3])
    return x
```

```cpp
#define MK_MODE 0
#include <hip/hip_runtime.h>
#include <cstdio>
#include <cstdint>

#define GAS __attribute__((address_space(1)))
#define LAS __attribute__((address_space(3)))
typedef unsigned short bf16;
typedef short bf16x8 __attribute__((ext_vector_type(8)));
typedef short bf16x4 __attribute__((ext_vector_type(4)));
typedef float f32x2 __attribute__((ext_vector_type(2)));
typedef float f32x4 __attribute__((ext_vector_type(4)));
typedef float f32x16 __attribute__((ext_vector_type(16)));
typedef unsigned u32x2 __attribute__((ext_vector_type(2)));
typedef unsigned u32x4 __attribute__((ext_vector_type(4)));

constexpr int D = 1024, SEQ = 8192, LROWS = 16384, CTXL = 256, CROWS = 512, R = 16896;
constexpr int DFF = 2816, DFE = 3584, NEXP = 8, LCAP = 16640;
constexpr int NWAVES = 8, NTHREADS = 512;
constexpr int NCH16 = R / 16;
constexpr float EPSN = 1e-6f, LOG2E = 1.4426950408889634f;

constexpr size_t MiB = 1u << 20;
constexpr size_t WS_CTL = 0, CTL_ZERO_BYTES = 1 * MiB;
constexpr int CW_TMO = 0, CW_BAR = 4096, CW_MOECNT = 98304;
constexpr size_t CTL_MOD_OFF = 512 * 1024;
constexpr size_t WS_CTXBUF = 1 * MiB;
constexpr size_t WS_COST = 3 * MiB, WS_SINT = 4 * MiB, WS_COSN = 5 * MiB, WS_SINN = 6 * MiB;
constexpr size_t WS_LIST = 7 * MiB;
constexpr size_t WS_ROUTEW = WS_LIST + 8 * LCAP * 4;
constexpr size_t WS_S5K = 8 * MiB;
constexpr size_t WS_A16 = 9 * MiB;
constexpr size_t WS_W128T = WS_A16 + 64 * 1024;
constexpr size_t WS_TWC = WS_W128T + 64 * 1024, WS_TWS = WS_TWC + 32 * 1024;
constexpr size_t WS_FCT = WS_TWS + 32 * 1024;
constexpr size_t WS_W64T = WS_FCT + 32 * 1024;
constexpr size_t WS_W256T = WS_W64T + 32 * 1024;
constexpr size_t WS_MOE1 = 10 * MiB;
constexpr size_t WS_MOE2 = 122 * MiB;
constexpr size_t WS_OTHERW = 178 * MiB;
constexpr size_t WS_WIN = 178 * MiB;
constexpr size_t WS_WBR = 204 * MiB;
constexpr size_t WS_WOUT = 208 * MiB;
constexpr size_t WS_WGLU = 212 * MiB;
constexpr size_t WS_FFN1 = 213 * MiB;
constexpr size_t WS_FFN2 = 224 * MiB;
constexpr size_t WS_S5M1 = 230 * MiB;
constexpr size_t WS_S5TAB = 234 * MiB;
constexpr size_t WS_BIG = 242 * MiB;
constexpr size_t TOK256 = (size_t)R * 256 * 2;
constexpr size_t WS_INP = WS_BIG;
constexpr size_t WS_T = WS_INP + 7 * TOK256;
constexpr size_t WS_HLOC = WS_T + 3 * TOK256;
constexpr size_t WS_HIN = WS_HLOC + 2 * TOK256;
constexpr size_t WS_KV = WS_HIN + TOK256;
constexpr size_t WS_SPREV = WS_KV + 2 * TOK256;
constexpr size_t WS_FB = WS_SPREV + TOK256;
constexpr size_t WS_GATES = WS_BIG;
constexpr size_t WS_Y = WS_BIG + 132 * MiB;
constexpr size_t WS_YO = WS_Y + 33 * MiB;
constexpr size_t WS_Z = WS_YO + 33 * MiB;
constexpr size_t WS_FO = WS_Y;
constexpr size_t WS_HID = WS_BIG;
constexpr size_t WS_MHID = WS_OTHERW;
constexpr size_t WS_H = 449 * MiB;
constexpr size_t WS_MIX = 482 * MiB;
constexpr size_t WS_SLOT = WS_H;
constexpr size_t WS_END = 515 * MiB;
static_assert(WS_FB + 16 * MiB <= WS_Z && WS_Z + TOK256 <= WS_H && WS_MHID + (size_t)34816 * 3584 * 2 <= WS_H && WS_W256T + 256 * 1024 <= WS_MOE1, "ws map");
static_assert(WS_S5TAB + 8 * MiB <= WS_BIG && WS_FFN2 + (size_t)1024 * 2816 * 2 <= WS_S5M1 && WS_ROUTEW + 32768 * 4 <= WS_S5K, "ws map 2");

constexpr int RING_BYTES = 131072, LDSCTL_OFF = RING_BYTES, LDS_BYTES = 147456;
constexpr int LW_BAR = 8, LW_MOE = 16;

#define VM_WAIT() asm volatile("s_waitcnt vmcnt(0)" ::: "memory")
#define LDS_WAIT() asm volatile("s_waitcnt lgkmcnt(0)" ::: "memory")
typedef __bf16 bf16n2 __attribute__((ext_vector_type(2)));
__device__ __forceinline__ unsigned pk2(float lo, float hi) { bf16n2 v; v.x = (__bf16)lo; v.y = (__bf16)hi; return __builtin_bit_cast(unsigned, v); }
__device__ __forceinline__ float bf2f(unsigned short b) { return __builtin_bit_cast(float, ((unsigned)b) << 16); }
__device__ __forceinline__ float bflo(unsigned w) { return __builtin_bit_cast(float, w << 16); }
__device__ __forceinline__ float bfhi(unsigned w) { return __builtin_bit_cast(float, w & 0xffff0000u); }
__device__ __forceinline__ float ex2(float x) { return __builtin_amdgcn_exp2f(x); }
__device__ __forceinline__ float rcpf_(float x) { return __builtin_amdgcn_rcpf(x); }
__device__ __forceinline__ float sigm(float x) { return rcpf_(1.f + ex2(-LOG2E * x)); }
__device__ __forceinline__ float silu_(float x) { return x * sigm(x); }
__device__ __forceinline__ float gelu_tanh(float x) { const float u = 0.7978845608028654f * (x + 0.044715f * x * x * x); const float t = 1.f - 2.f * rcpf_(1.f + ex2(2.885390081777927f * u)); return 0.5f * x * (1.f + t); }
__device__ __forceinline__ float xor32_sum(float v) { const unsigned u = __builtin_bit_cast(unsigned, v); const auto r = __builtin_amdgcn_permlane32_swap(u, u, false, false); return __builtin_bit_cast(float, (unsigned)r[0]) + __builtin_bit_cast(float, (unsigned)r[1]); }
__device__ __forceinline__ float xor32_max(float v) { const unsigned u = __builtin_bit_cast(unsigned, v); const auto r = __builtin_amdgcn_permlane32_swap(u, u, false, false); return fmaxf(__builtin_bit_cast(float, (unsigned)r[0]), __builtin_bit_cast(float, (unsigned)r[1])); }
template <int X> __device__ __forceinline__ float swz_xor(float v) { return __builtin_bit_cast(float, __builtin_amdgcn_ds_swizzle(__builtin_bit_cast(int, v), (X << 10) | 0x1f)); }
__device__ __forceinline__ float wave_sum(float v) { v += swz_xor<1>(v); v += swz_xor<2>(v); v += swz_xor<4>(v); v += swz_xor<8>(v); v += swz_xor<16>(v); return xor32_sum(v); }
__device__ __forceinline__ f32x16 mma32(bf16x8 a, bf16x8 b, f32x16 c) { return __builtin_amdgcn_mfma_f32_32x32x16_bf16(a, b, c, 0, 0, 0); }
__device__ __forceinline__ bf16x8 ldg8(const bf16* p) { return *(const bf16x8*)p; }
__device__ __forceinline__ bf16x8 ldg8p(const bf16* p) { const bf16x4 lo = *(const bf16x4*)p, hi = *(const bf16x4*)(p + 8); return __builtin_shufflevector(lo, hi, 0, 1, 2, 3, 4, 5, 6, 7); }
template <int S> __device__ __forceinline__ bf16x8 accB(const f32x16& c) {
    u32x4 w; w.x = pk2(c[8 * S + 0], c[8 * S + 1]); w.y = pk2(c[8 * S + 2], c[8 * S + 3]); w.z = pk2(c[8 * S + 4], c[8 * S + 5]); w.w = pk2(c[8 * S + 6], c[8 * S + 7]);
    return __builtin_bit_cast(bf16x8, w);
}
__device__ __forceinline__ bf16x8 pack8(const float (&v)[8]) { u32x4 w; w.x = pk2(v[0], v[1]); w.y = pk2(v[2], v[3]); w.z = pk2(v[4], v[5]); w.w = pk2(v[6], v[7]); return __builtin_bit_cast(bf16x8, w); }
__device__ __forceinline__ void unpack8(const bf16x8 x, float (&v)[8]) { const u32x4 w = __builtin_bit_cast(u32x4, x); v[0] = bflo(w.x); v[1] = bfhi(w.x); v[2] = bflo(w.y); v[3] = bfhi(w.y); v[4] = bflo(w.z); v[5] = bfhi(w.z); v[6] = bflo(w.w); v[7] = bfhi(w.w); }
__device__ __forceinline__ f32x16 zero16() { f32x16 z;
#pragma unroll
    for (int i = 0; i < 16; ++i) z[i] = 0.f;
    return z; }

#define XB_TMO      128
#define XB_XCNT(j)  (256  + 64 * (j))
#define XB_XSUB(j)  (1280 + 64 * (j))
#define XB_XGEN(j)  (2304 + 64 * (j))
#define XB_TOP      3328
#define XB_TOPGEN   3392
#define XCD_BAR_WORDS 3456
#define XB_SPIN_CAP (1u << 18)
__device__ __forceinline__ unsigned xb_ld(unsigned* p)              { return __hip_atomic_load(p, __ATOMIC_RELAXED, __HIP_MEMORY_SCOPE_AGENT); }
__device__ __forceinline__ unsigned xb_add(unsigned* p, unsigned v) { return __hip_atomic_fetch_add(p, v, __ATOMIC_RELAXED, __HIP_MEMORY_SCOPE_AGENT); }
__device__ __forceinline__ unsigned xb_xcc_id() { return (unsigned)__builtin_amdgcn_s_getreg((3 << 11) | 20) & 0xFu; }
#define XB_SPIN(cond, bar) do { unsigned _sp = 0; while (cond) { __builtin_amdgcn_s_sleep(1); \
    if ((++_sp & 255u) == 0u) { if (xb_ld(&(bar)[XB_TMO])) break; if (_sp > XB_SPIN_CAP) { atomicAdd(&(bar)[XB_TMO], 1u); break; } } } } while (0)
struct XcdBarrier { unsigned* bar; unsigned x; volatile LAS unsigned* st; };
__device__ __forceinline__ XcdBarrier xcd_barrier_post(unsigned* bar, volatile LAS unsigned* st) {
    XcdBarrier b; b.bar = bar; b.x = xb_xcc_id(); b.st = st;
    if (threadIdx.x == 0) (void)xb_add(&bar[XB_XCNT(b.x)], 1u);
    return b;
}
__device__ __forceinline__ void xcd_barrier_complete(unsigned* bar, unsigned x, unsigned& nloc, unsigned& nx) {
    const unsigned G = gridDim.x * gridDim.y * gridDim.z;
    unsigned sum, cnt, mine, sp = 0u;
    for (;;) {
        sum = 0u; cnt = 0u; mine = 0u;
#pragma unroll
        for (unsigned j = 0; j < 16; ++j) { const unsigned c = xb_ld(&bar[XB_XCNT(j)]); sum += c; cnt += (c > 0u) ? 1u : 0u; mine = (j == x) ? c : mine; }
        if (sum == G) break;
        __builtin_amdgcn_s_sleep(1);
        if ((++sp & 255u) == 0u) { if (xb_ld(&bar[XB_TMO])) break; if (sp > XB_SPIN_CAP) { atomicAdd(&bar[XB_TMO], 1u); break; } }
    }
    nloc = mine > 0u ? mine : 1u; nx = cnt > 0u ? cnt : 1u;
}
__device__ __forceinline__ void xcd_barrier(const XcdBarrier& b) {
    asm volatile("s_waitcnt vmcnt(0)" ::: "memory");
    __syncthreads();
    if (threadIdx.x == 0) {
        unsigned* bar = b.bar;
        __builtin_amdgcn_s_waitcnt(0);
        unsigned nloc = b.st[0], nx = b.st[1];
        if (nloc == 0u) { xcd_barrier_complete(bar, b.x, nloc, nx); b.st[0] = nloc; b.st[1] = nx; }
        const unsigned old = xb_add(&bar[XB_XSUB(b.x)], 1u);
        const unsigned gen = old / nloc;
        if (old + 1u == (gen + 1u) * nloc) {
            __builtin_amdgcn_fence(__ATOMIC_RELEASE, "agent");
            asm volatile("s_waitcnt vmcnt(0)" ::: "memory");
            const unsigned og = xb_add(&bar[XB_TOP], 1u);
            const unsigned tg = og / nx;
            if (og + 1u == (tg + 1u) * nx) xb_add(&bar[XB_TOPGEN], 1u);
            else XB_SPIN(xb_ld(&bar[XB_TOPGEN]) == tg, bar);
            __builtin_amdgcn_fence(__ATOMIC_ACQUIRE, "agent");
            xb_add(&bar[XB_XGEN(b.x)], 1u);
            asm volatile("s_waitcnt vmcnt(0)" ::: "memory");
        } else {
            XB_SPIN(xb_ld(&bar[XB_XGEN(b.x)]) == gen, bar);
            __builtin_amdgcn_fence(__ATOMIC_ACQUIRE, "agent");
            asm volatile("s_waitcnt vmcnt(0)" ::: "memory");
        }
    }
    __syncthreads();
}
namespace gp {
constexpr int BM = 256, BK = 64, HALF = 128, HTB = HALF * BK * 2, STAGE_BYTES = 8 * HTB, NXCD = 8, WGM = 8;
__device__ __forceinline__ int lds_byte(int r, int c) { const int st = (r >> 4) * 2 + (c >> 5), rr = r & 15, cc = c & 31, ob = rr * 64 + cc * 2; return st * 1024 + (ob ^ (((ob >> 9) & 1) << 5)); }
__device__ __forceinline__ void stage_rc(int b, int& Rr, int& C) { const int st = b / 1024, sb = b % 1024, swz = sb ^ (((sb >> 9) & 1) << 5); Rr = (st >> 1) * 16 + swz / 64; C = (st & 1) * 32 + (swz % 64) / 2; }
__device__ __forceinline__ int perm32(int rho) { const int n = rho >> 4, i = rho & 15; return 8 * (i >> 2) + 4 * n + (i & 3); }

struct Unit { const char* a; const char* b; int e0, e1, e2, e3; };

__device__ __forceinline__ void tile_of(int L, int nM, int nN, int& pm, int& pn) {
    const int nwg = nM * nN; int wgid = L;
    { const int q = nwg / NXCD, r = nwg % NXCD, xcd = wgid % NXCD, off = wgid / NXCD; wgid = (xcd < r ? xcd * (q + 1) : r * (q + 1) + (xcd - r) * q) + off; }
    const int nig = WGM * nN, gid = wgid / nig, fm = gid * WGM, gsz = (nM - fm) < WGM ? (nM - fm) : WGM;
    pm = fm + ((wgid % nig) % gsz); pn = (wgid % nig) / gsz;
}

template <class Epi, class Sched>
__device__ __forceinline__ void gemm_phase(LAS unsigned char* lds, const int tid, const int K, const int lda, const int ldb, const Sched& S, const Epi& E) {
    constexpr bool GATHER = Sched::GATHER;
    const int wid = __builtin_amdgcn_readfirstlane(tid >> 6), lane = tid & 63, wr = wid >> 2, wc = wid & 3, fr = lane & 15, fq = lane >> 4;
    int nt = K / BK; asm volatile("" : "+s"(nt));
    unsigned voffA[2], voffB[2], cb2[2]; int rowA[2];
#pragma unroll
    for (int i = 0; i < 2; ++i) { int Rr, C; stage_rc(tid * 16 + i * 8192, Rr, C); const int Rb = (Rr & ~31) + perm32(Rr & 31);
        rowA[i] = Rr; cb2[i] = (unsigned)C * 2u; voffA[i] = (unsigned)(Rr * lda + C) * 2u; voffB[i] = (unsigned)(Rb * ldb + C) * 2u; }
    const size_t kstep = (size_t)(BK * 2);
    const unsigned hstepA = (unsigned)HALF * (unsigned)lda * 2u; const size_t hstepB = (size_t)HALF * ldb * 2;
    const unsigned ldsw = (unsigned)wid * 1024u;
    const int aoff = lds_byte(wr * 64 + fr, fq * 8), boff = lds_byte(wc * 32 + fr, fq * 8);
#define PG8_SA(b, h) (((b) * 2 + (h)) * HTB)
#define PG8_SB(b, h) ((4 + (b) * 2 + (h)) * HTB)
#define PG8_STB(bufoff, gbase, hh) do { _Pragma("unroll") for (int _i = 0; _i < 2; ++_i) \
        __builtin_amdgcn_global_load_lds((const unsigned*)((const char*)(gbase) + (size_t)(hh) * hstepB + voffB[_i]), (LAS unsigned*)(lds + (bufoff) + ldsw + _i * 8192), 16, 0, 0); } while (0)
#define PG8_STA(bufoff, gbase, hh, VG) do { _Pragma("unroll") for (int _i = 0; _i < 2; ++_i) { const unsigned _o = GATHER ? (VG)[hh][_i] : (voffA[_i] + (unsigned)(hh) * hstepA); \
        __builtin_amdgcn_global_load_lds((const unsigned*)((const char*)(gbase) + _o), (LAS unsigned*)(lds + (bufoff) + ldsw + _i * 8192), 16, 0, 0); } } while (0)
#define PG8_LDA(dst, b, h) do { _Pragma("unroll") for (int m = 0; m < 4; ++m) _Pragma("unroll") for (int k = 0; k < 2; ++k) dst[m][k] = *(const LAS bf16x8*)(lds + PG8_SA(b, h) + aoff + m * 2048 + k * 1024); } while (0)
#define PG8_LDB(dst, b, h) do { _Pragma("unroll") for (int n = 0; n < 2; ++n) _Pragma("unroll") for (int k = 0; k < 2; ++k) dst[n][k] = *(const LAS bf16x8*)(lds + PG8_SB(b, h) + boff + n * 2048 + k * 1024); } while (0)
#define PG8_MMA(ai, bj, At, Bt) do { __builtin_amdgcn_s_setprio(1); _Pragma("unroll") for (int m = 0; m < 4; ++m) _Pragma("unroll") for (int n = 0; n < 2; ++n) _Pragma("unroll") for (int k = 0; k < 2; ++k) \
        acc[ai][bj][m][n] = __builtin_amdgcn_mfma_f32_16x16x32_bf16(Bt[n][k], At[m][k], acc[ai][bj][m][n], 0, 0, 0); __builtin_amdgcn_s_setprio(0); } while (0)
#define PG8_WAIT_V(n) asm volatile("s_waitcnt vmcnt(" #n ")" ::: "memory")
#define PG8_WAIT_L(n) asm volatile("s_waitcnt lgkmcnt(" #n ")" ::: "memory")
#define PG8_BAR __builtin_amdgcn_s_barrier()
#define PG8_SCHED __builtin_amdgcn_sched_barrier(0)
    Unit cur, nxt; int ui = 0;
    if (!S.next(0, cur)) return;
    f32x4 acc[2][2][4][2];
#pragma unroll
    for (int a = 0; a < 2; ++a)
#pragma unroll
        for (int b = 0; b < 2; ++b)
#pragma unroll
            for (int m = 0; m < 4; ++m)
#pragma unroll
                for (int n = 0; n < 2; ++n) acc[a][b][m][n] = (f32x4){0.f, 0.f, 0.f, 0.f};
    bf16x8 At[4][2], B0[2][2], B1[2][2];
    unsigned vgc[2][2], vgn[2][2];
#pragma unroll
    for (int h = 0; h < 2; ++h)
#pragma unroll
        for (int i = 0; i < 2; ++i) { vgc[h][i] = GATHER ? S.rowoff(cur, rowA[i] + h * HALF) + cb2[i] : 0u; vgn[h][i] = vgc[h][i]; }
    const char* cA = cur.a; const char* cB = cur.b;
    PG8_STB(PG8_SB(0, 0), cB, 0); PG8_STB(PG8_SB(0, 1), cB, 1); PG8_STA(PG8_SA(0, 0), cA, 0, vgc); PG8_STA(PG8_SA(0, 1), cA, 1, vgc);
    if (wr == 1) PG8_BAR;
    PG8_WAIT_V(2); PG8_BAR;
    PG8_STB(PG8_SB(1, 0), cB + kstep, 0); PG8_STA(PG8_SA(1, 0), cA + kstep, 0, vgc); PG8_STB(PG8_SB(1, 1), cB + kstep, 1);
    PG8_WAIT_V(6); PG8_BAR;
    for (;;) {
        const bool has_next = S.next(ui + 1, nxt);
        const char* nA = has_next ? nxt.a : cA; const char* nB = has_next ? nxt.b : cB;
#pragma unroll 1
        for (int t = 0; t < nt; t += 2) {
            const bool last = (t == nt - 2);
            const char* a1 = cA + (size_t)(t + 1) * kstep;
            const char* a2 = last ? nA : cA + (size_t)(t + 2) * kstep; const char* b2 = last ? nB : cB + (size_t)(t + 2) * kstep;
            const char* a3 = a2 + kstep; const char* b3 = b2 + kstep;
            unsigned vg2[2][2];
            if constexpr (GATHER) {
                if (last && has_next) {
#pragma unroll
                    for (int h = 0; h < 2; ++h)
#pragma unroll
                        for (int i = 0; i < 2; ++i) vgn[h][i] = S.rowoff(nxt, rowA[i] + h * HALF) + cb2[i];
                }
            }
#pragma unroll
            for (int h = 0; h < 2; ++h)
#pragma unroll
                for (int i = 0; i < 2; ++i) vg2[h][i] = last ? vgn[h][i] : vgc[h][i];
            PG8_LDB(B0, 0, 0); PG8_LDB(B1, 0, 1); PG8_SCHED; PG8_LDA(At, 0, 0); PG8_STA(PG8_SA(1, 1), a1, 1, vgc);
            PG8_WAIT_V(8); PG8_WAIT_L(0); PG8_BAR; PG8_MMA(0, 0, At, B0); PG8_MMA(0, 1, At, B1); PG8_BAR; PG8_SCHED;
            PG8_LDA(At, 0, 1); PG8_STB(PG8_SB(0, 0), b2, 0); PG8_STB(PG8_SB(0, 1), b2, 1); PG8_STA(PG8_SA(0, 0), a2, 0, vg2);
            PG8_WAIT_V(8); PG8_WAIT_L(0); PG8_BAR; PG8_MMA(1, 0, At, B0); PG8_MMA(1, 1, At, B1); PG8_BAR; PG8_SCHED;
            PG8_LDB(B0, 1, 0); PG8_LDB(B1, 1, 1); PG8_SCHED; PG8_LDA(At, 1, 0); PG8_STA(PG8_SA(0, 1), a2, 1, vg2);
            PG8_WAIT_V(8); PG8_WAIT_L(0); PG8_BAR; PG8_MMA(0, 0, At, B0); PG8_MMA(0, 1, At, B1); PG8_BAR; PG8_SCHED;
            PG8_LDA(At, 1, 1); PG8_STB(PG8_SB(1, 0), b3, 0); PG8_STB(PG8_SB(1, 1), b3, 1); PG8_STA(PG8_SA(1, 0), a3, 0, vg2);
            PG8_WAIT_V(8); PG8_WAIT_L(0); PG8_BAR; PG8_MMA(1, 0, At, B0); PG8_MMA(1, 1, At, B1); PG8_BAR; PG8_SCHED;
        }
        if (wr == 0) PG8_BAR;
        E(acc, cur, wr, wc, fr, fq);
        if (!has_next) break;
#pragma unroll
        for (int a = 0; a < 2; ++a)
#pragma unroll
            for (int b = 0; b < 2; ++b)
#pragma unroll
                for (int m = 0; m < 4; ++m)
#pragma unroll
                    for (int n = 0; n < 2; ++n) acc[a][b][m][n] = (f32x4){0.f, 0.f, 0.f, 0.f};
        cur = nxt; cA = nA; cB = nB; ++ui;
#pragma unroll
        for (int h = 0; h < 2; ++h)
#pragma unroll
            for (int i = 0; i < 2; ++i) vgc[h][i] = vgn[h][i];
        if (wr == 1) PG8_BAR;
    }
    PG8_WAIT_V(0);
    PG8_BAR;
#undef PG8_SA
#undef PG8_SB
#undef PG8_STA
#undef PG8_STB
#undef PG8_LDA
#undef PG8_LDB
#undef PG8_MMA
#undef PG8_WAIT_V
#undef PG8_WAIT_L
#undef PG8_BAR
#undef PG8_SCHED
}

struct SchedPlain {
    static constexpr bool GATHER = false;
    const char* A; const char* B; size_t ta, tb; int nM, nN, G, c;
    __device__ __forceinline__ bool next(int i, Unit& u) const {
        const long L = (long)i * G + c; if (L >= (long)nM * nN) return false;
        int pm, pn; tile_of((int)L, nM, nN, pm, pn); u.a = A + (size_t)pm * ta; u.b = B + (size_t)pn * tb; u.e0 = pm; u.e1 = pn; u.e2 = 0; u.e3 = 0; return true; }
    __device__ __forceinline__ unsigned rowoff(const Unit&, int) const { return 0u; }
};
struct SchedInprojA {
    static constexpr bool GATHER = false;
    const char* Hh; const char* W; int nM, G, c;
    __device__ __forceinline__ bool next(int i, Unit& u) const {
        long L = (long)i * G + c; const int n1 = nM * 7, n2 = 3 * nM; if (L >= n1 + n2) return false;
        int pm, pn;
        if (L < n1) { tile_of((int)L, nM, 7, pm, pn); u.a = Hh + (size_t)pm * (256 * 2048); u.b = W + (size_t)pn * (256 * 2048); u.e2 = 0; }
        else { tile_of((int)(L - n1), 3, nM, pm, pn); u.a = W + (size_t)(23 + pm) * (256 * 2048); u.b = Hh + (size_t)pn * (256 * 2048); u.e2 = 1; }
        u.e0 = pm; u.e1 = pn; u.e3 = 0; return true; }
    __device__ __forceinline__ unsigned rowoff(const Unit&, int) const { return 0u; }
};
struct SchedMerge {
    static constexpr bool GATHER = false;
    const char* Mix; const char* Wb; int nM, G, c;
    __device__ __forceinline__ bool next(int i, Unit& u) const {
        const long L = (long)(i >> 2) * G + c; if (L >= (long)nM * 4) return false;
        int pm, pn; tile_of((int)L, nM, 4, pm, pn); const int b = i & 3;
        u.a = Mix + (size_t)pm * (256 * 2048) + b * 512; u.b = Wb + ((size_t)b * 1024 + pn * 256) * 512; u.e0 = pm; u.e1 = pn; u.e2 = b; u.e3 = 0; return true; }
    __device__ __forceinline__ unsigned rowoff(const Unit&, int) const { return 0u; }
};
struct SchedMoe1 {
    static constexpr bool GATHER = true;
    const char* Hh; const char* W; const int* list; const LAS unsigned* mt; int G, c;
    __device__ __forceinline__ bool next(int i, Unit& u) const {
        long L = (long)i * G + c; int e = 0;
        for (; e < 8; ++e) { const long ue = (long)mt[8 + e] * 28; if (L < ue) break; L -= ue; }
        if (e == 8) return false;
        const int m_e = (int)mt[8 + e], nti = (int)(L / m_e), mti = (int)(L % m_e);
        u.a = Hh; u.b = W + ((size_t)e * 7168 + (size_t)nti * 256) * 2048; u.e0 = e; u.e1 = mti; u.e2 = nti; u.e3 = ((int)mt[16 + e] + mti) * 256; return true; }
    __device__ __forceinline__ unsigned rowoff(const Unit& u, int r) const {
        const int li = u.e1 * 256 + r; const int ent = (li < (int)mt[u.e0]) ? list[u.e0 * LCAP + li] : 0; return (unsigned)(ent >> 1) * 2048u; }
};
struct SchedMoe2 {
    static constexpr bool GATHER = false;
    const char* Hid; const char* W; const LAS unsigned* mt; int G, c;
    __device__ __forceinline__ bool next(int i, Unit& u) const {
        long L = (long)i * G + c; int e = 0;
        for (; e < 8; ++e) { const long ue = (long)mt[8 + e] * 4; if (L < ue) break; L -= ue; }
        if (e == 8) return false;
        const int m_e = (int)mt[8 + e], nti = (int)(L / m_e), mti = (int)(L % m_e);
        u.a = Hid + (size_t)((int)mt[16 + e] + mti) * 256 * (size_t)(DFE * 2); u.b = W + ((size_t)e * 1024 + (size_t)nti * 256) * (size_t)(DFE * 2); u.e0 = e; u.e1 = mti; u.e2 = nti; u.e3 = 0; return true; }
    __device__ __forceinline__ unsigned rowoff(const Unit&, int) const { return 0u; }
};

#define EPI_ROWS(ai, m) (128 * (ai) + 64 * wr + 16 * (m) + fr)
#define EPI_COL(bj) (128 * (bj) + 32 * wc + 8 * fq)
__device__ __forceinline__ u32x4 pack_acc8(const f32x4 a, const f32x4 b) { u32x4 w; w.x = pk2(a[0], a[1]); w.y = pk2(a[2], a[3]); w.z = pk2(b[0], b[1]); w.w = pk2(b[2], b[3]); return w; }

struct EpiPlain {
    bf16* O; int ld;
    __device__ __forceinline__ void operator()(const f32x4 (&acc)[2][2][4][2], const Unit& u, int wr, int wc, int fr, int fq) const {
#pragma unroll
        for (int ai = 0; ai < 2; ++ai)
#pragma unroll
            for (int m = 0; m < 4; ++m) { bf16* rowp = O + (size_t)(u.e0 * 256 + EPI_ROWS(ai, m)) * ld + u.e1 * 256;
#pragma unroll
                for (int bj = 0; bj < 2; ++bj) *(u32x4*)(rowp + EPI_COL(bj)) = pack_acc8(acc[ai][bj][m][0], acc[ai][bj][m][1]); }
    }
};
struct EpiInprojA {
    bf16* INP; bf16* T;
    __device__ __forceinline__ void operator()(const f32x4 (&acc)[2][2][4][2], const Unit& u, int wr, int wc, int fr, int fq) const {
        if (u.e2 == 0) {
            bf16* base = INP + (size_t)u.e1 * ((size_t)R * 256);
            const bool regroup = (u.e1 == 1);
#pragma unroll
            for (int ai = 0; ai < 2; ++ai)
#pragma unroll
                for (int m = 0; m < 4; ++m) { const int row = u.e0 * 256 + EPI_ROWS(ai, m);
#pragma unroll
                    for (int bj = 0; bj < 2; ++bj) { const int col = EPI_COL(bj);
                        bf16* p = regroup ? base + ((size_t)(col >> 4) * R + row) * 16 + (col & 15) : base + (size_t)row * 256 + col;
                        *(u32x4*)p = pack_acc8(acc[ai][bj][m][0], acc[ai][bj][m][1]); } }
        } else {
#pragma unroll
            for (int ai = 0; ai < 2; ++ai)
#pragma unroll
                for (int m = 0; m < 4; ++m) { bf16* rowp = T + (size_t)(u.e0 * 256 + EPI_ROWS(ai, m)) * R + u.e1 * 256;
#pragma unroll
                    for (int bj = 0; bj < 2; ++bj) *(u32x4*)(rowp + EPI_COL(bj)) = pack_acc8(acc[ai][bj][m][0], acc[ai][bj][m][1]); }
        }
    }
};
struct EpiGates {
    bf16* Gt;
    __device__ __forceinline__ void operator()(const f32x4 (&acc)[2][2][4][2], const Unit& u, int wr, int wc, int fr, int fq) const {
#pragma unroll
        for (int ai = 0; ai < 2; ++ai)
#pragma unroll
            for (int m = 0; m < 4; ++m) { bf16* rowp = Gt + (size_t)(u.e0 * 256 + EPI_ROWS(ai, m)) * 4096 + u.e1 * 256;
#pragma unroll
                for (int bj = 0; bj < 2; ++bj) { f32x4 a = acc[ai][bj][m][0], b = acc[ai][bj][m][1];
#pragma unroll
                    for (int j = 0; j < 4; ++j) { a[j] = sigm(a[j]); b[j] = sigm(b[j]); }
                    *(u32x4*)(rowp + EPI_COL(bj)) = pack_acc8(a, b); } }
    }
};
struct EpiGlu {
    const bf16* Zz; bf16* Mix; const float* bglu;
    __device__ __forceinline__ void operator()(const f32x4 (&acc)[2][2][4][2], const Unit& u, int wr, int wc, int fr, int fq) const {
#pragma unroll
        for (int bj = 0; bj < 2; ++bj) { const int col = EPI_COL(bj);
            const f32x4 b0 = *(const f32x4*)(bglu + col), b1 = *(const f32x4*)(bglu + col + 4);
#pragma unroll
            for (int ai = 0; ai < 2; ++ai)
#pragma unroll
                for (int m = 0; m < 4; ++m) { const size_t row = (size_t)(u.e0 * 256 + EPI_ROWS(ai, m));
                    const u32x4 zz = *(const u32x4*)(Zz + row * 256 + col);
                    f32x4 a = acc[ai][bj][m][0] + b0, b = acc[ai][bj][m][1] + b1;
                    a[0] = bflo(zz.x) * sigm(a[0]); a[1] = bfhi(zz.x) * sigm(a[1]); a[2] = bflo(zz.y) * sigm(a[2]); a[3] = bfhi(zz.y) * sigm(a[3]);
                    b[0] = bflo(zz.z) * sigm(b[0]); b[1] = bfhi(zz.z) * sigm(b[1]); b[2] = bflo(zz.w) * sigm(b[2]); b[3] = bfhi(zz.w) * sigm(b[3]);
                    *(u32x4*)(Mix + row * 1024 + 256 + col) = pack_acc8(a, b); } }
    }
};
struct EpiMerge {
    const bf16* Gt; bf16* Y;
    __device__ __forceinline__ void operator()(const f32x4 (&acc)[2][2][4][2], const Unit& u, int wr, int wc, int fr, int fq) const {
#pragma unroll
        for (int ai = 0; ai < 2; ++ai)
#pragma unroll
            for (int m = 0; m < 4; ++m) { const size_t row = (size_t)(u.e0 * 256 + EPI_ROWS(ai, m));
#pragma unroll
                for (int bj = 0; bj < 2; ++bj) { const int col = u.e1 * 256 + EPI_COL(bj);
                    const u32x4 g = *(const u32x4*)(Gt + row * 4096 + u.e2 * 1024 + col);
                    bf16* yp = Y + row * 1024 + col;
                    f32x4 a = acc[ai][bj][m][0], b = acc[ai][bj][m][1];
                    a[0] *= bflo(g.x); a[1] *= bfhi(g.x); a[2] *= bflo(g.y); a[3] *= bfhi(g.y); b[0] *= bflo(g.z); b[1] *= bfhi(g.z); b[2] *= bflo(g.w); b[3] *= bfhi(g.w);
                    if (u.e2 != 0) { const u32x4 y = *(const u32x4*)yp;
                        a[0] += bflo(y.x); a[1] += bfhi(y.x); a[2] += bflo(y.y); a[3] += bfhi(y.y); b[0] += bflo(y.z); b[1] += bfhi(y.z); b[2] += bflo(y.w); b[3] += bfhi(y.w); }
                    *(u32x4*)yp = pack_acc8(a, b); } }
    }
};
struct EpiSwiglu {
    bf16* Hd; int ldh; bool moe;
    __device__ __forceinline__ void operator()(const f32x4 (&acc)[2][2][4][2], const Unit& u, int wr, int wc, int fr, int fq) const {
        const int rowbase = moe ? u.e3 : u.e0 * 256, pn = moe ? u.e2 : u.e1;
#pragma unroll
        for (int ai = 0; ai < 2; ++ai)
#pragma unroll
            for (int m = 0; m < 4; ++m) { bf16* p = Hd + (size_t)(rowbase + EPI_ROWS(ai, m)) * ldh + pn * 128 + 32 * wc + 8 * fq;
                f32x4 a = acc[ai][0][m][0], b = acc[ai][0][m][1]; const f32x4 ua = acc[ai][1][m][0], ub = acc[ai][1][m][1];
#pragma unroll
                for (int j = 0; j < 4; ++j) { a[j] = silu_(a[j]) * ua[j]; b[j] = silu_(b[j]) * ub[j]; }
                *(u32x4*)p = pack_acc8(a, b); }
    }
};
struct EpiMoeDown {
    bf16* Slot; const int* list; const float* routew; const LAS unsigned* mt;
    __device__ __forceinline__ void operator()(const f32x4 (&acc)[2][2][4][2], const Unit& u, int wr, int wc, int fr, int fq) const {
        const int cnt = (int)mt[u.e0];
#pragma unroll
        for (int ai = 0; ai < 2; ++ai)
#pragma unroll
            for (int m = 0; m < 4; ++m) { const int li = u.e1 * 256 + EPI_ROWS(ai, m);
                if (li < cnt) { const int ent = list[u.e0 * LCAP + li]; const float w = routew[ent];
                    bf16* rowp = Slot + ((size_t)(ent & 1) * LROWS + (size_t)(ent >> 1)) * 1024 + u.e2 * 256;
#pragma unroll
                    for (int bj = 0; bj < 2; ++bj) *(u32x4*)(rowp + EPI_COL(bj)) = pack_acc8(acc[ai][bj][m][0] * w, acc[ai][bj][m][1] * w); } }
    }
};
}
#define DROW(reg, h) (((reg) & 3) + 8 * ((reg) >> 2) + 4 * (h))

__device__ __forceinline__ void s5_state_item(const bf16* M1  , const bf16* SU, float* HLOC, int item, int lane) {
    const int cb = item % 33, gd = item / 33, g = gd >> 1, dir = gd & 1, li = lane & 31, h = lane >> 5;
    const bf16* A = M1 + (size_t)(g * 2 + dir) * 128 * 256;
    const bf16* B = SU + ((size_t)g * R + (size_t)(cb * 32 + li) * 16) * 16;
    f32x16 acc[4];
#pragma unroll
    for (int rt = 0; rt < 4; ++rt) acc[rt] = zero16();
#pragma unroll 4
    for (int ks = 0; ks < 16; ++ks) {
        const bf16x8 bf = ldg8(B + ks * 16 + 8 * h);
#pragma unroll
        for (int rt = 0; rt < 4; ++rt) acc[rt] = mma32(ldg8(A + (size_t)(rt * 32 + li) * 256 + ks * 16 + 8 * h), bf, acc[rt]);
    }
    float* o = HLOC + ((size_t)(g * 2 + dir) * NCH16 + cb * 32 + li) * 128;
#pragma unroll
    for (int rt = 0; rt < 4; ++rt)
#pragma unroll
        for (int q = 0; q < 4; ++q) *(f32x4*)(o + rt * 32 + 8 * q + 4 * h) = (f32x4){acc[rt][4 * q], acc[rt][4 * q + 1], acc[rt][4 * q + 2], acc[rt][4 * q + 3]};
}
__device__ __forceinline__ void s5_scan_item(const float* A16  , const float* HLOC, bf16* HIN, int item, int lane) {
    const int dir = item & 1, g = (item >> 1) & 15, b = item >> 5, p = lane;
    const f32x2 a = *(const f32x2*)(A16 + ((size_t)(dir * 16 + g) * 64 + p) * 2);
    const float* src = HLOC + (size_t)(g * 2 + dir) * NCH16 * 128 + 2 * p;
    bf16* dst = HIN + (size_t)g * NCH16 * 256 + dir * 128 + 2 * p;
    float hr = 0.f, hi = 0.f;
    for (int seg = 0; seg < 2; ++seg) {
        const int n = seg == 0 ? 16 : 512, c0 = seg == 0 ? 1024 + 16 * b : 512 * b;
        for (int s0 = 0; s0 < n; s0 += 16) {
            f32x2 v[16];
#pragma unroll
            for (int j = 0; j < 16; ++j) { const int s = s0 + j, c = c0 + (dir ? n - 1 - s : s); v[j] = *(const f32x2*)(src + (size_t)c * 128); }
#pragma unroll
            for (int j = 0; j < 16; ++j) { const int s = s0 + j, c = c0 + (dir ? n - 1 - s : s);
                *(unsigned*)(dst + (size_t)c * 256) = pk2(hr, hi);
                const float nr = a.x * hr - a.y * hi + v[j].x, ni = a.x * hi + a.y * hr + v[j].y; hr = nr; hi = ni; }
        }
    }
}
__device__ __forceinline__ void s5_out_item(const bf16* TAB  , const bf16* SU, const bf16* HIN, bf16* Z, int item, int lane) {
    const int mh = item & 1, it2 = item >> 1, cb = it2 % 33, g = it2 / 33, li = lane & 31, h = lane >> 5, c = cb * 32 + li;
    const bf16* A = TAB + ((size_t)g * 256 + mh * 128) * 512;
    const bf16* B0 = SU + ((size_t)g * R + (size_t)c * 16) * 16;
    const bf16* B1 = HIN + ((size_t)g * NCH16 + c) * 256;
    f32x16 acc[4];
#pragma unroll
    for (int rt = 0; rt < 4; ++rt) acc[rt] = zero16();
#pragma unroll 4
    for (int ks = 0; ks < 32; ++ks) {
        const bf16x8 bf = ks < 16 ? ldg8(B0 + ks * 16 + 8 * h) : ldg8(B1 + (ks - 16) * 16 + 8 * h);
#pragma unroll
        for (int rt = 0; rt < 4; ++rt) acc[rt] = mma32(ldg8(A + (size_t)(rt * 32 + li) * 512 + ks * 16 + 8 * h), bf, acc[rt]);
    }
#pragma unroll
    for (int rt = 0; rt < 4; ++rt)
#pragma unroll
        for (int q = 0; q < 4; ++q) {
            const int i = 8 * mh + 2 * rt + (q >> 1), ho0 = 8 * (q & 1) + 4 * h;
            u32x2 w; w.x = pk2(gelu_tanh(acc[rt][4 * q]), gelu_tanh(acc[rt][4 * q + 1])); w.y = pk2(gelu_tanh(acc[rt][4 * q + 2]), gelu_tanh(acc[rt][4 * q + 3]));
            *(u32x2*)(Z + ((size_t)c * 16 + i) * 256 + g * 16 + ho0) = w; }
}

__device__ __forceinline__ int ret_tok0(int b, int n) { return n < 64 ? b * SEQ + n * 128 : LROWS + b * CTXL + (n - 64) * 128; }
__device__ __forceinline__ void ret_kv_item(const bf16* RKT, const bf16* RVT, const float* COST, const float* SINT, const float* decay  , float* KV, int item, int lane) {
    const int n = item % 66, bh = item / 66, hd = bh & 3, b = bh >> 2, li = lane & 31, h = lane >> 5;
    const int tok0 = ret_tok0(b, n); const bool lat = n < 64;
    const float lgf = -log2f(1.f + __expf(-decay[hd])), lgr = -log2f(1.f + __expf(-decay[4 + hd]));
    f32x16 acc[2][2][2];
#pragma unroll
    for (int a = 0; a < 2; ++a)
#pragma unroll
        for (int c = 0; c < 2; ++c)
#pragma unroll
            for (int d = 0; d < 2; ++d) acc[a][c][d] = zero16();
    const bf16* k0p = RKT + (size_t)(hd * 64 + li) * R + tok0 + 8 * h;
    const bf16* v0p = RVT + (size_t)(hd * 64 + li) * R + tok0 + 8 * h;
#pragma unroll 2
    for (int ks = 0; ks < 8; ++ks) {
        float k1[8], k2[8];
        unpack8(ldg8(k0p + ks * 16), k1); unpack8(ldg8(k0p + (size_t)32 * R + ks * 16), k2);
        if (lat) {
            const float* cp = COST + (size_t)li * SEQ + n * 128 + ks * 16 + 8 * h; const float* sp = SINT + (size_t)li * SEQ + n * 128 + ks * 16 + 8 * h;
            const f32x4 c0 = *(const f32x4*)cp, c1 = *(const f32x4*)(cp + 4), s0 = *(const f32x4*)sp, s1 = *(const f32x4*)(sp + 4);
#pragma unroll
            for (int j = 0; j < 8; ++j) { const float cc = j < 4 ? c0[j & 3] : c1[j & 3], ss = j < 4 ? s0[j & 3] : s1[j & 3];
                const float x1 = k1[j], x2 = k2[j]; k1[j] = x1 * cc - x2 * ss; k2[j] = x1 * ss + x2 * cc; }
        }
        const bf16x8 vf0 = ldg8(v0p + ks * 16), vf1 = ldg8(v0p + (size_t)32 * R + ks * 16);
#pragma unroll
        for (int dir = 0; dir < 2; ++dir) {
            float a1[8], a2[8];
#pragma unroll
            for (int j = 0; j < 8; ++j) { const int i = ks * 16 + 8 * h + j; const float w = dir == 0 ? ex2(lgf * (float)(127 - i)) : ex2(lgr * (float)i); a1[j] = k1[j] * w; a2[j] = k2[j] * w; }
            const bf16x8 kd0 = pack8(a1), kd1 = pack8(a2);
            acc[dir][0][0] = mma32(kd0, vf0, acc[dir][0][0]); acc[dir][0][1] = mma32(kd0, vf1, acc[dir][0][1]);
            acc[dir][1][0] = mma32(kd1, vf0, acc[dir][1][0]); acc[dir][1][1] = mma32(kd1, vf1, acc[dir][1][1]);
        }
    }
#pragma unroll
    for (int dir = 0; dir < 2; ++dir) { float* o = KV + ((size_t)((b * 4 + hd) * 2 + dir) * 66 + n) * 4096;
#pragma unroll
        for (int dt = 0; dt < 2; ++dt)
#pragma unroll
            for (int et = 0; et < 2; ++et)
#pragma unroll
                for (int q = 0; q < 4; ++q) *(f32x4*)(o + (size_t)(et * 32 + li) * 64 + dt * 32 + 8 * q + 4 * h) = (f32x4){acc[dir][dt][et][4 * q], acc[dir][dt][et][4 * q + 1], acc[dir][dt][et][4 * q + 2], acc[dir][dt][et][4 * q + 3]}; }
}
__device__ __forceinline__ void ret_scan_item(const float* decay, const float* KV, bf16* SPREV, int item, int lane) {
    const int blk = item & 63, bhd = item >> 6, dir = bhd & 1, hd = (bhd >> 1) & 3, idx = blk * 64 + lane;
    const float lg = -log2f(1.f + __expf(-decay[dir * 4 + hd])), cd = ex2(128.f * lg);
    const float* src = KV + (size_t)bhd * 66 * 4096 + idx; bf16* dst = SPREV + (size_t)bhd * 66 * 4096 + idx;
    float s = 0.f;
    for (int s0 = 0; s0 < 66; s0 += 11) {
        float v[11];
#pragma unroll
        for (int j = 0; j < 11; ++j) { const int t = s0 + j; const int n = dir == 0 ? (t < 2 ? 64 + t : t - 2) : (t < 2 ? 65 - t : 65 - t); v[j] = src[(size_t)n * 4096]; }
#pragma unroll
        for (int j = 0; j < 11; ++j) { const int t = s0 + j; const int n = dir == 0 ? (t < 2 ? 64 + t : t - 2) : (t < 2 ? 65 - t : 65 - t); dst[(size_t)n * 4096] = (bf16)(pk2(s, 0.f) & 0xffffu); s = cd * s + v[j]; }
    }
}
__device__ __forceinline__ void ret_out_item(const bf16* RQ, const bf16* RK, const bf16* RG, const bf16* RVT, const bf16* SPREV, const float* COSN, const float* SINN,
                                             const float* decay, const float* gn  , bf16* MIX, int item, int lane) {
    const int qb = item & 3, it2 = item >> 2, n = it2 % 66, bh = it2 / 66, hd = bh & 3, b = bh >> 2, li = lane & 31, h = lane >> 5;
    const int tok0 = ret_tok0(b, n); const bool lat = n < 64;
    const float lgf = -log2f(1.f + __expf(-decay[hd])), lgr = -log2f(1.f + __expf(-decay[4 + hd]));
    const int iq = qb * 32 + li;
    bf16x8 qf[4];
    {
        const bf16* qp = RQ + (size_t)(tok0 + iq) * 256 + hd * 64 + 8 * h;
#pragma unroll
        for (int s = 0; s < 4; ++s) qf[s] = ldg8(qp + 16 * s);
        if (lat) { const int tl = n * 128 + iq;
#pragma unroll
            for (int s = 0; s < 2; ++s) { float x1[8], x2[8]; unpack8(qf[s], x1); unpack8(qf[s + 2], x2);
                const float* cp = COSN + (size_t)tl * 32 + 16 * s + 8 * h; const float* sp = SINN + (size_t)tl * 32 + 16 * s + 8 * h;
                const f32x4 c0 = *(const f32x4*)cp, c1 = *(const f32x4*)(cp + 4), s0 = *(const f32x4*)sp, s1 = *(const f32x4*)(sp + 4);
#pragma unroll
                for (int j = 0; j < 8; ++j) { const float cc = j < 4 ? c0[j & 3] : c1[j & 3], ss = j < 4 ? s0[j & 3] : s1[j & 3]; const float a = x1[j], bb = x2[j]; x1[j] = a * cc - bb * ss; x2[j] = a * ss + bb * cc; }
                qf[s] = pack8(x1); qf[s + 2] = pack8(x2); } }
    }
    f32x16 accO[2] = {zero16(), zero16()};
#pragma unroll 1
    for (int kt = 0; kt < 4; ++kt) {
        bf16x8 kf[4];
        const int jk = kt * 32 + li;
        const bf16* kp = RK + (size_t)(tok0 + jk) * 256 + hd * 64 + 8 * h;
#pragma unroll
        for (int s = 0; s < 4; ++s) kf[s] = ldg8(kp + 16 * s);
        if (lat) { const int tl = n * 128 + jk;
#pragma unroll
            for (int s = 0; s < 2; ++s) { float x1[8], x2[8]; unpack8(kf[s], x1); unpack8(kf[s + 2], x2);
                const float* cp = COSN + (size_t)tl * 32 + 16 * s + 8 * h; const float* sp = SINN + (size_t)tl * 32 + 16 * s + 8 * h;
                const f32x4 c0 = *(const f32x4*)cp, c1 = *(const f32x4*)(cp + 4), s0 = *(const f32x4*)sp, s1 = *(const f32x4*)(sp + 4);
#pragma unroll
                for (int j = 0; j < 8; ++j) { const float cc = j < 4 ? c0[j & 3] : c1[j & 3], ss = j < 4 ? s0[j & 3] : s1[j & 3]; const float a = x1[j], bb = x2[j]; x1[j] = a * cc - bb * ss; x2[j] = a * ss + bb * cc; }
                kf[s] = pack8(x1); kf[s + 2] = pack8(x2); } }
        f32x16 st = zero16();
#pragma unroll
        for (int s = 0; s < 4; ++s) st = mma32(kf[s], qf[s], st);
#pragma unroll
        for (int r = 0; r < 16; ++r) { const int j = kt * 32 + DROW(r, h), df = iq - j;
            const float w = df > 0 ? ex2(lgf * (float)df) : (df < 0 ? ex2(lgr * (float)(-df)) : 2.f); st[r] *= w; }
        const bf16x8 p0 = accB<0>(st), p1 = accB<1>(st);
#pragma unroll
        for (int et = 0; et < 2; ++et) { const bf16* vp = RVT + (size_t)(hd * 64 + et * 32 + li) * R + tok0 + kt * 32 + 4 * h;
            accO[et] = mma32(ldg8p(vp), p0, accO[et]); accO[et] = mma32(ldg8p(vp + 16), p1, accO[et]); }
    }
    const float cf = ex2(lgf * (float)(iq + 1)), cr = ex2(lgr * (float)(128 - iq));
#pragma unroll
    for (int dir = 0; dir < 2; ++dir) { const bf16* sp = SPREV + ((size_t)((b * 4 + hd) * 2 + dir) * 66 + n) * 4096;
#pragma unroll
        for (int et = 0; et < 2; ++et) { f32x16 a = zero16();
#pragma unroll
            for (int s = 0; s < 4; ++s) a = mma32(ldg8(sp + (size_t)(et * 32 + li) * 64 + 16 * s + 8 * h), qf[s], a);
            const float sc = dir == 0 ? cf : cr;
#pragma unroll
            for (int r = 0; r < 16; ++r) accO[et][r] += sc * a[r]; } }
    float s1 = 0.f;
#pragma unroll
    for (int et = 0; et < 2; ++et)
#pragma unroll
        for (int r = 0; r < 16; ++r) s1 += accO[et][r];
    s1 = xor32_sum(s1); const float mu = s1 * (1.f / 64.f);
    float s2 = 0.f;
#pragma unroll
    for (int et = 0; et < 2; ++et)
#pragma unroll
        for (int r = 0; r < 16; ++r) { const float dlt = accO[et][r] - mu; s2 += dlt * dlt; }
    s2 = xor32_sum(s2); const float rstd = __builtin_amdgcn_rsqf(s2 * (1.f / 64.f) + EPSN);
    const size_t tok = (size_t)(tok0 + iq);
#pragma unroll
    for (int et = 0; et < 2; ++et)
#pragma unroll
        for (int q = 0; q < 4; ++q) { const int e0 = hd * 64 + et * 32 + 8 * q + 4 * h;
            const f32x4 gv = *(const f32x4*)(gn + e0); const u32x2 gg = *(const u32x2*)(RG + tok * 256 + e0);
            const float g0 = bflo(gg.x), g1 = bfhi(gg.x), g2 = bflo(gg.y), g3 = bfhi(gg.y);
            u32x2 w; w.x = pk2(silu_(g0) * (accO[et][4 * q] - mu) * rstd * gv[0], silu_(g1) * (accO[et][4 * q + 1] - mu) * rstd * gv[1]);
            w.y = pk2(silu_(g2) * (accO[et][4 * q + 2] - mu) * rstd * gv[2], silu_(g3) * (accO[et][4 * q + 3] - mu) * rstd * gv[3]);
            *(u32x2*)(MIX + tok * 1024 + 512 + e0) = w; }
}

__device__ __forceinline__ void na_item(const bf16* NQ, const bf16* NK, const bf16* NVT, bf16* MIX, const LAS float* rpb, bool ctxq, int b, int r, int hd, int qs, int lane) {
    const int li = lane & 31, h = lane >> 5;
    const int tokq = ctxq ? LROWS + b * CTXL + qs * 32 + li : b * SEQ + r * 64 + qs * 32 + li;
    bf16x8 qf[4];
#pragma unroll
    for (int s = 0; s < 4; ++s) qf[s] = ldg8(NQ + (size_t)tokq * 256 + hd * 64 + 16 * s + 8 * h);
    float mrun = -1e30f, lrun = 0.f;
    f32x16 accO[2] = {zero16(), zero16()};
    const int rs = r - 4 < 0 ? 0 : (r - 4 > 120 ? 120 : r - 4);
    const int qc = qs * 32 + li, cs = qc - 8 < 0 ? 0 : (qc - 8 > 48 ? 48 : qc - 8);
    const int ntile = ctxq ? 8 : 24;
    const float c1 = 0.125f * LOG2E;
#pragma unroll 1
    for (int t = 0; t < ntile; ++t) {
        const bool band = t >= 8; const int tb = t - 8, rr = rs + (tb >> 1), ct = tb & 1;
        const int tokk0 = band ? b * SEQ + rr * 64 + ct * 32 : LROWS + b * CTXL + t * 32;
        f32x16 st = zero16();
        const bf16* kp = NK + (size_t)(tokk0 + li) * 256 + hd * 64 + 8 * h;
#pragma unroll
        for (int s = 0; s < 4; ++s) st = mma32(ldg8(kp + 16 * s), qf[s], st);
        float mt = -INFINITY;
        if (band) { const int dr = rr - r + 7;
#pragma unroll
            for (int g = 0; g < 16; ++g) { const int kc = ct * 32 + DROW(g, h); const bool inw = kc >= cs && kc < cs + 16; int dc = kc - qc + 15; dc = dc < 0 ? 0 : (dc > 30 ? 30 : dc);
                const float bias = rpb[(hd * 15 + dr) * 31 + dc]; const float v = inw ? st[g] * c1 + bias * LOG2E : -INFINITY; st[g] = v; mt = fmaxf(mt, v); }
        } else {
#pragma unroll
            for (int g = 0; g < 16; ++g) { const float v = st[g] * c1; st[g] = v; mt = fmaxf(mt, v); }
        }
        mt = xor32_max(mt);
        const float mnew = fmaxf(mrun, mt), alpha = ex2(mrun - mnew);
        float ps = 0.f;
#pragma unroll
        for (int g = 0; g < 16; ++g) { const float p = ex2(st[g] - mnew); st[g] = p; ps += p; }
        ps = xor32_sum(ps);
        lrun = lrun * alpha + ps; mrun = mnew;
#pragma unroll
        for (int et = 0; et < 2; ++et)
#pragma unroll
            for (int g = 0; g < 16; ++g) accO[et][g] *= alpha;
        const bf16x8 p0 = accB<0>(st), p1 = accB<1>(st);
#pragma unroll
        for (int et = 0; et < 2; ++et) { const bf16* vp = NVT + (size_t)(hd * 64 + et * 32 + li) * R + tokk0 + 4 * h;
            accO[et] = mma32(ldg8p(vp), p0, accO[et]); accO[et] = mma32(ldg8p(vp + 16), p1, accO[et]); }
    }
    const float inv = 1.f / lrun;
#pragma unroll
    for (int et = 0; et < 2; ++et)
#pragma unroll
        for (int q = 0; q < 4; ++q) { u32x2 w; w.x = pk2(accO[et][4 * q] * inv, accO[et][4 * q + 1] * inv); w.y = pk2(accO[et][4 * q + 2] * inv, accO[et][4 * q + 3] * inv);
            *(u32x2*)(MIX + (size_t)tokq * 1024 + 768 + hd * 64 + et * 32 + 8 * q + 4 * h) = w; }
}

__device__ __forceinline__ void fft1_item(const bf16* F, const bf16* W128T, const float* TWC, const float* TWS, bf16* FB, int item, int lane) {
    const int l2 = item & 63, g = (item >> 6) & 3, b = item >> 8, li = lane & 31, h = lane >> 5;
    bf16x8 idf[4];
#pragma unroll
    for (int s = 0; s < 4; ++s) { float v[8];
#pragma unroll
        for (int j = 0; j < 8; ++j) v[j] = (16 * (s & 1) + 8 * h + j == li) ? 1.f : 0.f;
        idf[s] = pack8(v); }
    bf16x8 xb[4][2][2];
#pragma unroll
    for (int lt = 0; lt < 4; ++lt) {
        const bf16* xp = F + (size_t)(b * SEQ + 64 * (lt * 32 + li) + l2) * 256 + g * 64 + 8 * h;
        const bf16x8 x0 = ldg8(xp), x1 = ldg8(xp + 16), x2 = ldg8(xp + 32), x3 = ldg8(xp + 48);
        f32x16 c0 = zero16(), c1 = zero16();
        c0 = mma32(x0, idf[0], c0); c0 = mma32(x1, idf[1], c0);
        c1 = mma32(x2, idf[0], c1); c1 = mma32(x3, idf[1], c1);
        xb[lt][0][0] = accB<0>(c0); xb[lt][0][1] = accB<1>(c0); xb[lt][1][0] = accB<0>(c1); xb[lt][1][1] = accB<1>(c1);
    }
#pragma unroll 1
    for (int kb = 0; kb < 4; ++kb) {
        f32x16 acc[2][2];
#pragma unroll
        for (int ri = 0; ri < 2; ++ri) { acc[ri][0] = zero16(); acc[ri][1] = zero16();
            const bf16* wp = W128T + ((size_t)ri * 128 + kb * 32 + li) * 128 + 4 * h;
#pragma unroll
            for (int lt = 0; lt < 4; ++lt)
#pragma unroll
                for (int s = 0; s < 2; ++s) { const bf16x8 wf = ldg8p(wp + lt * 32 + 16 * s);
                    acc[ri][0] = mma32(wf, xb[lt][0][s], acc[ri][0]); acc[ri][1] = mma32(wf, xb[lt][1][s], acc[ri][1]); } }
#pragma unroll
        for (int q = 0; q < 4; ++q) { const int k1 = kb * 32 + 8 * q + 4 * h;
            const f32x4 tc = *(const f32x4*)(TWC + l2 * 128 + k1), ts = *(const f32x4*)(TWS + l2 * 128 + k1);
#pragma unroll
            for (int j = 0; j < 4; ++j)
#pragma unroll
                for (int ct = 0; ct < 2; ++ct) { const float ar = acc[0][ct][4 * q + j], ai = acc[1][ct][4 * q + j];
                    const float br = ar * tc[j] + ai * ts[j], bi = ai * tc[j] - ar * ts[j];
                    bf16* o = FB + ((((size_t)(b * 4 + g) * 128 + k1 + j) * 2) * 64 + l2) * 64 + ct * 32 + li;
                    o[0] = (bf16)(pk2(br, 0.f) & 0xffffu); o[64 * 64] = (bf16)(pk2(bi, 0.f) & 0xffffu); } }
    }
}
__device__ __forceinline__ void fft2_item(const bf16* FB, const bf16* FCT, const bf16* W64T, bf16* MIX, int item, int lane) {
    const int mh = item & 1, k1 = (item >> 1) & 127, g = (item >> 8) & 3, b = item >> 10, li = lane & 31, h = lane >> 5;
    const bf16* br = FB + (((size_t)(b * 4 + g) * 128 + k1) * 2) * 64 * 64; const bf16* bi = br + 64 * 64;
    const bf16* fc = FCT + (size_t)(mh * 32 + li) * 64 + 8 * h; const bf16* fs = fc + 64 * 64; const bf16* fn = fc + 2 * 64 * 64;
    bf16x8 eb[2][2][2];
#pragma unroll
    for (int lt = 0; lt < 2; ++lt) { f32x16 er = zero16(), ei = zero16();
#pragma unroll
        for (int s = 0; s < 4; ++s) { const bf16x8 ar = ldg8(br + (size_t)(lt * 32 + li) * 64 + 16 * s + 8 * h), ai = ldg8(bi + (size_t)(lt * 32 + li) * 64 + 16 * s + 8 * h);
            const bf16x8 c = ldg8(fc + 16 * s), sn = ldg8(fs + 16 * s), ns = ldg8(fn + 16 * s);
            er = mma32(ar, c, er); er = mma32(ai, sn, er); ei = mma32(ai, c, ei); ei = mma32(ar, ns, ei); }
        eb[lt][0][0] = accB<0>(er); eb[lt][0][1] = accB<1>(er); eb[lt][1][0] = accB<0>(ei); eb[lt][1][1] = accB<1>(ei); }
#pragma unroll
    for (int kt = 0; kt < 2; ++kt) { f32x16 o = zero16();
        const bf16* wc = W64T + (size_t)(kt * 32 + li) * 64 + 4 * h; const bf16* wsn = wc + 64 * 64;
#pragma unroll
        for (int lt = 0; lt < 2; ++lt)
#pragma unroll
            for (int s = 0; s < 2; ++s) { o = mma32(ldg8p(wc + lt * 32 + 16 * s), eb[lt][0][s], o); o = mma32(ldg8p(wsn + lt * 32 + 16 * s), eb[lt][1][s], o); }
#pragma unroll
        for (int rg = 0; rg < 16; ++rg) { const int k2 = kt * 32 + DROW(rg, h);
            MIX[(size_t)(b * SEQ + k1 + 128 * k2) * 1024 + g * 64 + mh * 32 + li] = (bf16)(pk2(o[rg], 0.f) & 0xffffu); } }
}
__device__ __forceinline__ void fftc_item(const bf16* F, const bf16* FCT, const bf16* W256T, bf16* MIX, int item, int lane) {
    const int mh = item & 1, kb = (item >> 1) & 7, g = (item >> 4) & 3, b = item >> 6, li = lane & 31, h = lane >> 5;
    const bf16* fc = FCT + (size_t)(mh * 32 + li) * 64 + 8 * h; const bf16* fn = fc + 2 * 64 * 64;
    const bf16* wc = W256T + (size_t)(kb * 32 + li) * 256 + 4 * h; const bf16* wsn = wc + 256 * 256;
    f32x16 o = zero16();
#pragma unroll 1
    for (int lt = 0; lt < 8; ++lt) { f32x16 zr = zero16(), zi = zero16();
        const bf16* xp = F + (size_t)(LROWS + b * CTXL + lt * 32 + li) * 256 + g * 64 + 8 * h;
#pragma unroll
        for (int s = 0; s < 4; ++s) { const bf16x8 x = ldg8(xp + 16 * s); zr = mma32(x, ldg8(fc + 16 * s), zr); zi = mma32(x, ldg8(fn + 16 * s), zi); }
        o = mma32(ldg8p(wc + lt * 32), accB<0>(zr), o); o = mma32(ldg8p(wc + lt * 32 + 16), accB<1>(zr), o);
        o = mma32(ldg8p(wsn + lt * 32), accB<0>(zi), o); o = mma32(ldg8p(wsn + lt * 32 + 16), accB<1>(zi), o); }
#pragma unroll
    for (int rg = 0; rg < 16; ++rg) { const int k = kb * 32 + DROW(rg, h);
        MIX[(size_t)(LROWS + b * CTXL + k) * 1024 + g * 64 + mh * 32 + li] = (bf16)(pk2(o[rg], 0.f) & 0xffffu); }
}
__device__ __forceinline__ void row_ld_f32(const float* p, int lane, f32x4 (&v)[4]) {
#pragma unroll
    for (int j = 0; j < 4; ++j) v[j] = *(const f32x4*)(p + 256 * j + 4 * lane); }
__device__ __forceinline__ void row_ld_bf16(const bf16* p, int lane, f32x4 (&v)[4]) {
#pragma unroll
    for (int j = 0; j < 4; ++j) { const u32x2 w = *(const u32x2*)(p + 256 * j + 4 * lane); v[j] = (f32x4){bflo(w.x), bfhi(w.x), bflo(w.y), bfhi(w.y)}; } }
__device__ __forceinline__ void row_st_f32(float* p, int lane, const f32x4 (&v)[4]) {
#pragma unroll
    for (int j = 0; j < 4; ++j) *(f32x4*)(p + 256 * j + 4 * lane) = v[j]; }
__device__ __forceinline__ void row_st_bf16(bf16* p, int lane, const f32x4 (&v)[4]) {
#pragma unroll
    for (int j = 0; j < 4; ++j) { u32x2 w; w.x = pk2(v[j][0], v[j][1]); w.y = pk2(v[j][2], v[j][3]); *(u32x2*)(p + 256 * j + 4 * lane) = w; } }
__device__ __forceinline__ float row_rstd(const f32x4 (&v)[4]) { float s = 0.f;
#pragma unroll
    for (int j = 0; j < 4; ++j) s += (v[j][0] * v[j][0] + v[j][1] * v[j][1]) + (v[j][2] * v[j][2] + v[j][3] * v[j][3]);
    return __builtin_amdgcn_rsqf(wave_sum(s) * (1.f / 1024.f) + EPSN); }
__device__ __forceinline__ void row_modnorm(const f32x4 (&x)[4], const float* g, const float* sc, const float* sh, int lane, f32x4 (&hh)[4]) {
    const float rs = row_rstd(x); f32x4 gv[4], scv[4], shv[4]; row_ld_f32(g, lane, gv); row_ld_f32(sc, lane, scv); row_ld_f32(sh, lane, shv);
#pragma unroll
    for (int j = 0; j < 4; ++j) hh[j] = x[j] * rs * gv[j] * (scv[j] + 1.f) + shv[j]; }
__device__ __forceinline__ void row_resid(f32x4 (&x)[4], const f32x4 (&t)[4], const float* g, const float* gate, int lane) {
    const float rs = row_rstd(t); f32x4 gv[4], ga[4]; row_ld_f32(g, lane, gv); row_ld_f32(gate, lane, ga);
#pragma unroll
    for (int j = 0; j < 4; ++j) x[j] = x[j] + ga[j] * (t[j] * rs * gv[j]); }

__device__ __forceinline__ void transpose_item(const float* W, int ldw, int k0, int n0, bf16* dst, int ldd, float scale, LAS float* scr, int lane) {
#pragma unroll 8
    for (int i = 0; i < 32; ++i) { const int kk = 2 * i + (lane >> 5); scr[kk * 33 + (lane & 31)] = W[(size_t)(k0 + kk) * ldw + n0 + (lane & 31)]; }
    LDS_WAIT(); asm volatile("" ::: "memory");
    const int c = lane & 7;
#pragma unroll
    for (int j = 0; j < 4; ++j) { const int n = (lane >> 3) + 8 * j; const LAS float* s = scr + (8 * c) * 33 + n;
        u32x4 o; o.x = pk2(s[0 * 33] * scale, s[1 * 33] * scale); o.y = pk2(s[2 * 33] * scale, s[3 * 33] * scale); o.z = pk2(s[4 * 33] * scale, s[5 * 33] * scale); o.w = pk2(s[6 * 33] * scale, s[7 * 33] * scale);
        *(u32x4*)(dst + (size_t)n * ldd + k0 + 8 * c) = o; }
    LDS_WAIT(); asm volatile("" ::: "memory");
}
#ifndef MK_MODE
#define MK_MODE 1
#endif
#ifndef MK_LAST
#define MK_LAST 24
#endif
constexpr int NPHASE = 24;
struct Args { const float* in[31]; float* out; unsigned char* ws; int ph_lo, ph_hi, li, pad; };

__device__ __forceinline__ void cs2pi(int m, int N, float& c, float& s) { sincospif(2.0f * (float)(m % N) / (float)N, &s, &c); }

__global__ void __launch_bounds__(NTHREADS, 2) mk_fwd(Args args) {
    extern __shared__ __attribute__((aligned(16))) unsigned char lds_raw[];
    LAS unsigned char* lds = (LAS unsigned char*)lds_raw;
    const int tid0 = threadIdx.x, wave = __builtin_amdgcn_readfirstlane(tid0 >> 6);
    const int G = gridDim.x, bx = blockIdx.x, vcu = (G % 8 == 0) ? (bx % 8) * (G / 8) + bx / 8 : bx;
    const int wslot = wave * G + vcu, NW = G * NWAVES;
    volatile LAS unsigned* lctl = (volatile LAS unsigned*)(lds + LDSCTL_OFF);
    for (int u = tid0; u < (LDS_BYTES - LDSCTL_OFF) / 4; u += NTHREADS) lctl[u] = 0u;
    __syncthreads();
    const int lo = args.ph_lo, hi = args.ph_hi, bli = args.li;
    { XcdBarrier b0 = xcd_barrier_post((unsigned*)(args.ws + WS_CTL) + CW_BAR + bli * XCD_BAR_WORDS, lctl + LW_BAR); (void)b0; }
#define IN(k) (lo <= (k) && (k) < hi)
#define SEAM(k) do { if (IN(k) && IN((k) + 1)) { PH_BEGIN XcdBarrier b_; b_.bar = (unsigned*)(ws + WS_CTL) + CW_BAR + bli * XCD_BAR_WORDS; b_.x = xb_xcc_id(); b_.st = lctl + LW_BAR; xcd_barrier(b_); } } while (0)
#define PH_BEGIN int tid; { int l_; asm volatile("v_mbcnt_lo_u32_b32 %0, -1, 0\n\tv_mbcnt_hi_u32_b32 %0, -1, %0" : "=v"(l_)); tid = wave * 64 + (l_ & 63); } const CAS Args* ap_ = (const CAS Args*)__builtin_amdgcn_kernarg_segment_ptr(); asm volatile("" : "+s"(ap_)); unsigned char* ws = (unsigned char*)(GAS unsigned char*)ap_->ws; const int lane = tid & 63; (void)lane;
#define CAS __attribute__((address_space(4)))
#define AIN(k) ((const float*)(const GAS float*)ap_->in[k])
#define AOUT ((float*)(GAS float*)ap_->out)
#define MODp ((float*)(ws + CTL_MOD_OFF))
#define ctxbuf ((float*)(ws + WS_CTXBUF))
#define Hh ((bf16*)(ws + WS_H))
#define MIX ((bf16*)(ws + WS_MIX))
#define INP ((bf16*)(ws + WS_INP))
#define Tt ((bf16*)(ws + WS_T))

    if (IN(0)) { PH_BEGIN
        for (int it = bx; it < 64; it += G) {
            const int l = it >> 5, g = (it >> 1) & 15, dir = it & 1; const size_t pg = (size_t)(l * 2 + dir) * 16 + g;
            LAS f32x2* apow = (LAS f32x2*)lds; LAS f32x2* bbar = (LAS f32x2*)(lds + 17 * 64 * 8);
            if (tid < 64) { const int p = tid;
                const float are = AIN(8)[pg * 64 + p], aim = AIN(9)[pg * 64 + p], dt = expf(AIN(10)[pg]);
                for (int t = 0; t <= 16; ++t) { const float mag = expf(are * dt * (float)t); float sn, cs; sincosf(aim * dt * (float)t, &sn, &cs); apow[t * 64 + p] = (f32x2){mag * cs, mag * sn}; }
                const f32x2 a = apow[64 + p]; const float nr = a.x - 1.f, ni = a.y, den = 1.f / (are * are + aim * aim);
                const float cr = (nr * are + ni * aim) * den, ci = (ni * are - nr * aim) * den;
                for (int h = 0; h < 16; ++h) { const float br = AIN(11)[(pg * 64 + p) * 16 + h], bi = AIN(12)[(pg * 64 + p) * 16 + h]; bbar[p * 16 + h] = (f32x2){cr * br - ci * bi, cr * bi + ci * br}; }
                *(f32x2*)((float*)(ws + WS_A16) + (pg * 64 + p) * 2) = apow[16 * 64 + p];
            }
            __syncthreads();
            bf16* M1 = (bf16*)(ws + WS_S5M1) + ((size_t)(l * 16 + g) * 2 + dir) * 128 * 256;
            for (int v = tid; v < 4096; v += NTHREADS) { const int row = v >> 5, col0 = (v & 31) * 8, j = col0 >> 4, h0 = col0 & 15, p = row >> 1, ri = row & 1;
                const f32x2 pw = apow[(dir == 0 ? 15 - j : j) * 64 + p]; float vals[8];
#pragma unroll
                for (int hh = 0; hh < 8; ++hh) { const f32x2 bb = bbar[p * 16 + h0 + hh]; vals[hh] = ri ? pw.x * bb.y + pw.y * bb.x : pw.x * bb.x - pw.y * bb.y; }
                *(bf16x8*)(M1 + (size_t)row * 256 + col0) = pack8(vals); }
            bf16* TAB = (bf16*)(ws + WS_S5TAB) + (size_t)(l * 16 + g) * 256 * 512;
            for (int v = tid; v < 4096; v += NTHREADS) { const int row = v >> 4, cv = v & 15, i = row >> 4, ho = row & 15; float vals[8];
#pragma unroll
                for (int pp = 0; pp < 4; ++pp) { const int p = cv * 4 + pp; const float cre = AIN(13)[(pg * 16 + ho) * 64 + p], cim = AIN(14)[(pg * 16 + ho) * 64 + p];
                    const f32x2 pw = apow[(dir == 0 ? i + 1 : 16 - i) * 64 + p]; vals[2 * pp] = cre * pw.x - cim * pw.y; vals[2 * pp + 1] = -(cre * pw.y + cim * pw.x); }
                *(bf16x8*)(TAB + (size_t)row * 512 + 256 + dir * 128 + cv * 8) = pack8(vals); }
            float* Kt = (float*)(ws + WS_S5K) + ((size_t)(l * 16 + g) * 2 + dir) * 16 * 256;
            for (int e = tid; e < 4096; e += NTHREADS) { const int t = e >> 8, ho = (e >> 4) & 15, h = e & 15; float acc = 0.f;
                for (int p = 0; p < 64; ++p) { const float cre = AIN(13)[(pg * 16 + ho) * 64 + p], cim = AIN(14)[(pg * 16 + ho) * 64 + p]; const f32x2 pw = apow[t * 64 + p], bb = bbar[p * 16 + h];
                    const float xr = cre * pw.x - cim * pw.y, xi = cre * pw.y + cim * pw.x; acc += xr * bb.x - xi * bb.y; }
                Kt[e] = acc; }
            __syncthreads();
        }
        { LAS float* scr = (LAS float*)(lds + wave * 16384);
          for (int it = wslot; it < 56000; it += NW) {
            const float* src; int ldw, kb, n0, ldd; bf16* dst; float scale = 1.f;
            if (it < 43008) { const int e = it / 5376, r = it % 5376, w = r / 1792, li = r % 1792;
                if (w < 2) { src = AIN(28 + w) + (size_t)e * 1024 * DFE; ldw = DFE; kb = li / 112; n0 = (li % 112) * 32; ldd = 1024;
                    dst = (bf16*)(ws + WS_MOE1) + ((size_t)e * 7168 + 256 * (n0 / 128) + (n0 % 128) + 128 * w) * 1024; }
                else { src = AIN(30) + (size_t)e * DFE * 1024; ldw = 1024; kb = li / 32; n0 = (li % 32) * 32; ldd = DFE; dst = (bf16*)(ws + WS_MOE2) + ((size_t)e * 1024 + n0) * DFE; }
            } else if (it < 47232) { const int r = it - 43008, w = r / 1408, li = r % 1408;
                if (w < 2) { src = AIN(23 + w); ldw = DFF; kb = li / 88; n0 = (li % 88) * 32; ldd = 1024; dst = (bf16*)(ws + WS_FFN1) + (size_t)(256 * (n0 / 128) + (n0 % 128) + 128 * w) * 1024; }
                else { src = AIN(25); ldw = 1024; kb = li / 32; n0 = (li % 32) * 32; ldd = DFF; dst = (bf16*)(ws + WS_FFN2) + (size_t)n0 * DFF; }
            } else { const int r = it - 47232, l = r / 4384, q = r % 4384;
                if (q < 3328) { const int t = q / 128, li = q % 128; kb = li / 8; const int nb = li % 8;
                    const int srcc = t < 4 ? 256 * t : (t < 7 ? 256 * (t + 1) : (t < 23 ? 2304 + 256 * (t - 7) : (t == 23 ? 768 : (t == 24 ? 1024 : 2048))));
                    src = AIN(7) + (size_t)l * 1024 * 6400; ldw = 6400; n0 = srcc + 32 * nb; ldd = 1024; dst = (bf16*)(ws + WS_WIN) + ((size_t)(l * 26 + t) * 256 + 32 * nb) * 1024; scale = (t == 3 || t == 23) ? 0.125f : 1.f; }
                else if (q < 3360) { const int li = q - 3328; kb = li / 8; n0 = (li % 8) * 32; src = AIN(16) + (size_t)l * 65536; ldw = 256; ldd = 256; dst = (bf16*)(ws + WS_WGLU) + ((size_t)l * 256 + n0) * 256; }
                else if (q < 3872) { const int li = q - 3360, bb = li / 128, li2 = li % 128; kb = li2 / 32; n0 = (li2 % 32) * 32; src = AIN(21) + (size_t)(l * 4 + bb) * 256 * 1024; ldw = 1024; ldd = 256; dst = (bf16*)(ws + WS_WBR) + ((size_t)(l * 4 + bb) * 1024 + n0) * 256; }
                else { const int li = q - 3872; kb = li / 32; n0 = (li % 32) * 32; src = AIN(22) + (size_t)l * 1024 * 1024; ldw = 1024; ldd = 1024; dst = (bf16*)(ws + WS_WOUT) + ((size_t)l * 1024 + n0) * 1024; }
            }
            transpose_item(src, ldw, kb * 64, n0, dst, ldd, scale, scr, lane);
          } }
        __syncthreads();
        for (int it = bx; it < 192; it += G) { const int l = it / 96, cb = it % 96, col = cb * 64 + lane, ks = wave;
            const float* wm = AIN(4) + ((size_t)l * 1024 + ks * 128) * 6144 + col; float a0 = 0.f, a1 = 0.f, a2 = 0.f;
#pragma unroll 8
            for (int k = 0; k < 128; ++k) { const float w = wm[(size_t)k * 6144]; const int kk = ks * 128 + k;
                const float c0 = AIN(1)[kk], c1 = AIN(1)[1024 + kk], c2 = AIN(3)[kk];
                a0 += w * (c0 / (1.f + __expf(-c0))); a1 += w * (c1 / (1.f + __expf(-c1))); a2 += w * (c2 / (1.f + __expf(-c2))); }
            LAS float* part = (LAS float*)lds;
            part[(wave * 3 + 0) * 64 + lane] = a0; part[(wave * 3 + 1) * 64 + lane] = a1; part[(wave * 3 + 2) * 64 + lane] = a2;
            __syncthreads();
            if (tid < 192) { const int i = tid >> 6, c = tid & 63; float sacc = AIN(5)[l * 6144 + cb * 64 + c];
#pragma unroll
                for (int w = 0; w < 8; ++w) sacc += part[(w * 3 + i) * 64 + c];
                MODp[(size_t)(l * 3 + i) * 6144 + cb * 64 + c] = sacc; }
            __syncthreads();
        }
        for (int v = wslot * 64 + lane; v < 32 * SEQ; v += NW * 64) { const int p = v >> 13, t = v & 8191; const float pos = (float)(p < 16 ? (t >> 6) : (t & 63));
            const float inv = 1.0f / powf(10000.f, (float)(p & 15) / 16.f); float sn, cs; sincosf(pos * inv, &sn, &cs);
            ((float*)(ws + WS_COST))[v] = cs; ((float*)(ws + WS_SINT))[v] = sn; ((float*)(ws + WS_COSN))[t * 32 + p] = cs; ((float*)(ws + WS_SINN))[t * 32 + p] = sn; }
        for (int v = wslot * 64 + lane; v < 192512; v += NW * 64) { float c, s;
            if (v < 32768) { const int ri = v >> 14, k1 = (v >> 7) & 127, l1 = v & 127; cs2pi(k1 * l1, 128, c, s); const float sc = 0.08838834764831845f;
                ((bf16*)(ws + WS_W128T))[v] = (bf16)(pk2(ri ? -s * sc : c * sc, 0.f) & 0xffffu); }
            else if (v < 40960) { const int u = v - 32768, l2 = u >> 7, k1 = u & 127; cs2pi(k1 * l2, 8192, c, s); ((float*)(ws + WS_TWC))[u] = c; ((float*)(ws + WS_TWS))[u] = s; }
            else if (v < 53248) { const int u = v - 40960, w = u >> 12, m = (u >> 6) & 63, cc = u & 63; cs2pi(m * cc, 64, c, s);
                ((bf16*)(ws + WS_FCT))[u] = (bf16)(pk2((w == 0 ? c : (w == 1 ? s : -s)) * 0.125f, 0.f) & 0xffffu); }
            else if (v < 61440) { const int u = v - 53248, w = u >> 12, k2 = (u >> 6) & 63, l2 = u & 63; cs2pi(k2 * l2, 64, c, s); ((bf16*)(ws + WS_W64T))[u] = (bf16)(pk2((w == 0 ? c : s) * 0.125f, 0.f) & 0xffffu); }
            else { const int u = v - 61440, w = u >> 16, k = (u >> 8) & 255, l = u & 255; cs2pi(k * l, 256, c, s); ((bf16*)(ws + WS_W256T))[u] = (bf16)(pk2((w == 0 ? c : s) * 0.0625f, 0.f) & 0xffffu); }
        }
    }
    SEAM(0);

    if (IN(1)) { PH_BEGIN
        for (int v = wslot * 64 + lane; v < 262144; v += NW * 64) { const int l = v >> 17, g = (v >> 13) & 15, row = (v >> 5) & 255, col0 = (v & 31) * 8, i = row >> 4, ho = row & 15, j = col0 >> 4, h0 = col0 & 15;
            const float* Kf = (const float*)(ws + WS_S5K) + ((size_t)(l * 16 + g) * 2) * 16 * 256; const float* Kr = Kf + 16 * 256; float vals[8];
#pragma unroll
            for (int hh = 0; hh < 8; ++hh) { const int h = h0 + hh;
                vals[hh] = j < i ? Kf[(i - j) * 256 + ho * 16 + h] : (j > i ? Kr[(j - i) * 256 + ho * 16 + h] : Kf[ho * 16 + h] + Kr[ho * 16 + h] + (ho == h ? AIN(15)[l * 256 + g * 16 + h] : 0.f)); }
            *(bf16x8*)((bf16*)(ws + WS_S5TAB) + ((size_t)(l * 16 + g) * 256 + row) * 512 + col0) = pack8(vals); }
        for (int r = wslot; r < R; r += NW) { const int ci = r < SEQ ? 0 : (r < LROWS ? 1 : 2);
            f32x4 x[4], hh[4]; row_ld_f32(r < LROWS ? AIN(0) + (size_t)r * D : AIN(2) + (size_t)(r - LROWS) * D, lane, x);
            const float* md = MODp + (size_t)ci * 6144;
            row_modnorm(x, AIN(6), md + 1024, md, lane, hh); row_st_bf16(Hh + (size_t)r * D, lane, hh); }
    }
    SEAM(1);

    for (int layer = 0; layer < 2; ++layer) {
        const int pb = 1 + 11 * layer;
        const int nM = layer == 0 ? 66 : 64;
        const int nrows = layer == 0 ? R : LROWS;
#define normg (AIN(6) + (size_t)layer * 4 * D)
        if (IN(pb + 1)) { PH_BEGIN
            gp::SchedInprojA S{(const char*)Hh, (const char*)(ws + WS_WIN) + (size_t)layer * 26 * 256 * 2048, 66, G, bx};
            gp::EpiInprojA E{INP, Tt};
            gp::gemm_phase(lds, tid, 1024, 1024, 1024, S, E);
        }
        SEAM(pb + 1);
        if (IN(pb + 2)) { PH_BEGIN
            for (int it = wslot; it < 2096; it += NW) {
                if (it < 1056) s5_state_item((const bf16*)(ws + WS_S5M1) + (size_t)layer * 16 * 2 * 128 * 256, INP + (size_t)R * 256, (float*)(ws + WS_HLOC), it, lane);
                else if (it < 1584) ret_kv_item(Tt, Tt + (size_t)256 * R, (const float*)(ws + WS_COST), (const float*)(ws + WS_SINT), AIN(18) + layer * 8, (float*)(ws + WS_KV), it - 1056, lane);
                else fft1_item(INP, (const bf16*)(ws + WS_W128T), (const float*)(ws + WS_TWC), (const float*)(ws + WS_TWS), (bf16*)(ws + WS_FB), it - 1584, lane);
            }
        }
        SEAM(pb + 2);
        if (IN(pb + 3)) { PH_BEGIN
            LAS float* rpb = (LAS float*)lds;
            for (int i = tid; i < 1860; i += NTHREADS) rpb[i] = AIN(20)[layer * 1860 + i];
            __syncthreads();
            const int nit = 64 + 1024 + 2048 + (layer == 0 ? 64 : 0);
            for (int it = wslot; it < nit; it += NW) {
                if (it < 64) s5_scan_item((const float*)(ws + WS_A16) + (size_t)layer * 2 * 16 * 64 * 2, (const float*)(ws + WS_HLOC), (bf16*)(ws + WS_HIN), it, lane);
                else if (it < 1088) ret_scan_item(AIN(18) + layer * 8, (const float*)(ws + WS_KV), (bf16*)(ws + WS_SPREV), it - 64, lane);
                else if (it < 3136) { const int j = it - 1088; na_item(INP + (size_t)5 * R * 256, INP + (size_t)6 * R * 256, Tt + (size_t)512 * R, MIX, rpb, false, j >> 10, (j >> 3) & 127, (j >> 1) & 3, j & 1, lane); }
                else { const int j = it - 3136; na_item(INP + (size_t)5 * R * 256, INP + (size_t)6 * R * 256, Tt + (size_t)512 * R, MIX, rpb, true, j >> 5, 0, (j >> 3) & 3, j & 7, lane); }
            }
            __syncthreads();
        }
        SEAM(pb + 3);
        if (IN(pb + 4)) { PH_BEGIN
            const int nit = 1056 + 2112 + 2048 + (layer == 0 ? 128 : 0);
            for (int it = wslot; it < nit; it += NW) {
                if (it < 1056) s5_out_item((const bf16*)(ws + WS_S5TAB) + (size_t)layer * 16 * 256 * 512, INP + (size_t)R * 256, (const bf16*)(ws + WS_HIN), (bf16*)(ws + WS_Z), it, lane);
                else if (it < 3168) ret_out_item(INP + (size_t)2 * R * 256, INP + (size_t)3 * R * 256, INP + (size_t)4 * R * 256, Tt + (size_t)256 * R, (const bf16*)(ws + WS_SPREV),
                                                 (const float*)(ws + WS_COSN), (const float*)(ws + WS_SINN), AIN(18) + layer * 8, AIN(19) + layer * 256, MIX, it - 1056, lane);
                else if (it < 5216) fft2_item((const bf16*)(ws + WS_FB), (const bf16*)(ws + WS_FCT), (const bf16*)(ws + WS_W64T), MIX, it - 3168, lane);
                else fftc_item(INP, (const bf16*)(ws + WS_FCT), (const bf16*)(ws + WS_W256T), MIX, it - 5216, lane);
            }
        }
        SEAM(pb + 4);
        if (IN(pb + 5)) { PH_BEGIN
            { PH_BEGIN gp::SchedPlain S{(const char*)(ws + WS_Z), (const char*)(ws + WS_WGLU) + (size_t)layer * 256 * 512, (size_t)256 * 512, (size_t)256 * 512, nM, 1, G, bx};
              gp::EpiGlu E{(const bf16*)(ws + WS_Z), MIX, AIN(17) + layer * 256};
              gp::gemm_phase(lds, tid, 256, 256, 256, S, E); }
            { PH_BEGIN gp::SchedPlain S{(const char*)Hh, (const char*)(ws + WS_WIN) + ((size_t)layer * 26 + 7) * 256 * 2048, (size_t)256 * 2048, (size_t)256 * 2048, nM, 16, G, bx};
              gp::EpiGates E{(bf16*)(ws + WS_GATES)};
              gp::gemm_phase(lds, tid, 1024, 1024, 1024, S, E); }
        }
        SEAM(pb + 5);
        if (IN(pb + 6)) { PH_BEGIN
            gp::SchedMerge S{(const char*)MIX, (const char*)(ws + WS_WBR) + (size_t)layer * 4 * 1024 * 512, nM, G, bx};
            gp::EpiMerge E{(const bf16*)(ws + WS_GATES), (bf16*)(ws + WS_Y)};
            gp::gemm_phase(lds, tid, 256, 1024, 256, S, E);
        }
        SEAM(pb + 6);
        if (IN(pb + 7)) { PH_BEGIN
            gp::SchedPlain S{(const char*)(ws + WS_Y), (const char*)(ws + WS_WOUT) + (size_t)layer * 1024 * 2048, (size_t)256 * 2048, (size_t)256 * 2048, nM, 4, G, bx};
            gp::EpiPlain E{(bf16*)(ws + WS_YO), 1024};
            gp::gemm_phase(lds, tid, 1024, 1024, 1024, S, E);
        }
        SEAM(pb + 7);
        if (IN(pb + 8)) { PH_BEGIN
            if (layer == 0) {
                for (int r = wslot; r < R; r += NW) { const int ci = r < SEQ ? 0 : (r < LROWS ? 1 : 2); const float* md = MODp + (size_t)ci * 6144;
                    f32x4 x[4], t[4], hh[4]; row_ld_f32(r < LROWS ? AIN(0) + (size_t)r * D : AIN(2) + (size_t)(r - LROWS) * D, lane, x);
                    row_ld_bf16((const bf16*)(ws + WS_YO) + (size_t)r * D, lane, t);
                    row_resid(x, t, normg + D, md + 2048, lane);
                    row_st_f32(r < LROWS ? AOUT + (size_t)r * D : ctxbuf + (size_t)(r - LROWS) * D, lane, x);
                    row_modnorm(x, normg + 2 * D, md + 4096, md + 3072, lane, hh); row_st_bf16(Hh + (size_t)r * D, lane, hh); }
            } else {
                LAS float* wrs = (LAS float*)lds; LAS int* rowinfo = (LAS int*)(lds + 32768); LAS unsigned* cntL = (LAS unsigned*)(lds + 32768 + 1024); LAS unsigned* baseL = cntL + 8;
                for (int i = tid; i < 2048; i += NTHREADS) ((LAS f32x4*)wrs)[i] = ((const f32x4*)AIN(26))[i];
                int* list = (int*)(ws + WS_LIST); float* routew = (float*)(ws + WS_ROUTEW);
                for (int grp = vcu; grp < 256; grp += G) {
                    if (tid < 8) cntL[tid] = 0u;
                    __syncthreads();
                    for (int rr = 0; rr < 8; ++rr) { const int r = grp * 64 + wave * 8 + rr; const float* md = MODp + (size_t)(3 + (r < SEQ ? 0 : 1)) * 6144;
                        f32x4 x[4], t[4], hh[4]; row_ld_f32(AOUT + (size_t)r * D, lane, x); row_ld_bf16((const bf16*)(ws + WS_YO) + (size_t)r * D, lane, t);
                        row_resid(x, t, normg + D, md + 2048, lane); row_st_f32(AOUT + (size_t)r * D, lane, x);
                        row_modnorm(x, normg + 2 * D, md + 4096, md + 3072, lane, hh); row_st_bf16(Hh + (size_t)r * D, lane, hh);
                        float lg[8];
#pragma unroll
                        for (int e = 0; e < 8; ++e) lg[e] = 0.f;
#pragma unroll
                        for (int j = 0; j < 4; ++j)
#pragma unroll
                            for (int q = 0; q < 4; ++q) { const int k = 256 * j + 4 * lane + q; const f32x4 w0 = *(const LAS f32x4*)(wrs + k * 8), w1 = *(const LAS f32x4*)(wrs + k * 8 + 4); const float hv = hh[j][q];
                                lg[0] += hv * w0[0]; lg[1] += hv * w0[1]; lg[2] += hv * w0[2]; lg[3] += hv * w0[3]; lg[4] += hv * w1[0]; lg[5] += hv * w1[1]; lg[6] += hv * w1[2]; lg[7] += hv * w1[3]; }
#pragma unroll
                        for (int e = 0; e < 8; ++e) lg[e] = wave_sum(lg[e]) + AIN(27)[e];
                        int i0 = 0; float v0 = lg[0];
#pragma unroll
                        for (int e = 1; e < 8; ++e) if (lg[e] > v0) { v0 = lg[e]; i0 = e; }
                        int i1 = i0 == 0 ? 1 : 0; float v1 = i0 == 0 ? lg[1] : lg[0];
#pragma unroll
                        for (int e = 0; e < 8; ++e) if (e != i0 && lg[e] > v1) { v1 = lg[e]; i1 = e; }
                        const float w0 = 1.f / (1.f + __expf(v1 - v0)), w1 = 1.f - w0;
                        if (lane == 0) { const unsigned s0 = __hip_atomic_fetch_add(cntL + i0, 1u, __ATOMIC_RELAXED, __HIP_MEMORY_SCOPE_WORKGROUP), s1 = __hip_atomic_fetch_add(cntL + i1, 1u, __ATOMIC_RELAXED, __HIP_MEMORY_SCOPE_WORKGROUP);
                            LAS int* ri = rowinfo + (wave * 8 + rr) * 4; ri[0] = i0; ri[1] = (int)s0; ri[2] = i1; ri[3] = (int)s1; routew[(size_t)r * 2] = w0; routew[(size_t)r * 2 + 1] = w1; }
                    }
                    __syncthreads();
                    if (tid < 8) baseL[tid] = __hip_atomic_fetch_add((unsigned*)(ws + WS_CTL) + CW_MOECNT + 64 * tid, cntL[tid], __ATOMIC_RELAXED, __HIP_MEMORY_SCOPE_AGENT);
                    __syncthreads();
                    if (tid < 64) { const LAS int* ri = rowinfo + tid * 4; const int r = grp * 64 + tid;
                        list[ri[0] * LCAP + (int)baseL[ri[0]] + ri[1]] = r * 2; list[ri[2] * LCAP + (int)baseL[ri[2]] + ri[3]] = r * 2 + 1; }
                    __syncthreads();
                }
            }
        }
        SEAM(pb + 8);
        LAS unsigned* mt = (LAS unsigned*)(lds + LDSCTL_OFF) + LW_MOE;
        if (layer == 1 && (IN(pb + 9) || IN(pb + 10))) { PH_BEGIN
            if (tid == 0) { unsigned off = 0u;
                for (int e = 0; e < 8; ++e) { const unsigned c = __hip_atomic_load((unsigned*)(ws + WS_CTL) + CW_MOECNT + 64 * e, __ATOMIC_RELAXED, __HIP_MEMORY_SCOPE_AGENT); const unsigned m = (c + 255u) >> 8; mt[e] = c; mt[8 + e] = m; mt[16 + e] = off; off += m; }
                mt[24] = off; }
            __syncthreads();
        }
        if (IN(pb + 9)) { PH_BEGIN
            if (layer == 0) {
                gp::SchedPlain S{(const char*)Hh, (const char*)(ws + WS_FFN1), (size_t)256 * 2048, (size_t)256 * 2048, 66, 22, G, bx};
                gp::EpiSwiglu E{(bf16*)(ws + WS_HID), DFF, false};
                gp::gemm_phase(lds, tid, 1024, 1024, 1024, S, E);
            } else {
                gp::SchedMoe1 S{(const char*)Hh, (const char*)(ws + WS_MOE1), (const int*)(ws + WS_LIST), mt, G, bx};
                gp::EpiSwiglu E{(bf16*)(ws + WS_MHID), DFE, true};
                gp::gemm_phase(lds, tid, 1024, 1024, 1024, S, E);
            }
        }
        SEAM(pb + 9);
        if (IN(pb + 10)) { PH_BEGIN
            if (layer == 0) {
                gp::SchedPlain S{(const char*)(ws + WS_HID), (const char*)(ws + WS_FFN2), (size_t)256 * DFF * 2, (size_t)256 * DFF * 2, 66, 4, G, bx};
                gp::EpiPlain E{(bf16*)(ws + WS_FO), 1024};
                gp::gemm_phase(lds, tid, DFF, DFF, DFF, S, E);
            } else {
                gp::SchedMoe2 S{(const char*)(ws + WS_MHID), (const char*)(ws + WS_MOE2), mt, G, bx};
                gp::EpiMoeDown E{(bf16*)(ws + WS_SLOT), (const int*)(ws + WS_LIST), (const float*)(ws + WS_ROUTEW), mt};
                gp::gemm_phase(lds, tid, DFE, DFE, DFE, S, E);
            }
        }
        SEAM(pb + 10);
        if (IN(pb + 11)) { PH_BEGIN
            for (int r = wslot; r < nrows; r += NW) { const int ci = r < SEQ ? 0 : (r < LROWS ? 1 : 2); const float* md = MODp + (size_t)(layer * 3 + ci) * 6144;
                float* xp = r < LROWS ? AOUT + (size_t)r * D : ctxbuf + (size_t)(r - LROWS) * D;
                f32x4 x[4], t[4]; row_ld_f32(xp, lane, x);
                if (layer == 0) row_ld_bf16((const bf16*)(ws + WS_FO) + (size_t)r * D, lane, t);
                else { f32x4 t2[4]; row_ld_bf16((const bf16*)(ws + WS_SLOT) + (size_t)r * D, lane, t); row_ld_bf16((const bf16*)(ws + WS_SLOT) + ((size_t)LROWS + r) * D, lane, t2);
#pragma unroll
                    for (int j = 0; j < 4; ++j) t[j] = t[j] + t2[j]; }
                row_resid(x, t, normg + 3 * D, md + 5120, lane); row_st_f32(xp, lane, x);
                if (layer == 0) { f32x4 hh[4]; const float* md1 = MODp + (size_t)(3 + ci) * 6144; row_modnorm(x, AIN(6) + 4 * D, md1 + 1024, md1, lane, hh); row_st_bf16(Hh + (size_t)r * D, lane, hh); } }
        }
        SEAM(pb + 11);
    }
#undef IN
#undef SEAM
#undef PH_BEGIN
#undef normg
#undef AIN
#undef AOUT
#undef MODp
#undef ctxbuf
#undef Hh
#undef MIX
#undef INP
#undef Tt
}

__global__ void dumpk(const unsigned char* src, size_t nbytes, int isf32, float* out, size_t N, int accum) {
    const size_t i = (size_t)blockIdx.x * blockDim.x + threadIdx.x; if (i >= N) return;
    const size_t ne = isf32 ? nbytes / 4 : nbytes / 2; float s = 0.f;
    for (size_t k = i; k < ne; k += N) s += isf32 ? ((const float*)src)[k] : bf2f(((const bf16*)src)[k]);
    out[i] = accum ? out[i] + s : s;
}
extern "C" void kernel_launch(void* const* d_in, const int* in_sizes, int n_in, void* d_out, int out_size, void* d_ws, size_t ws_size, hipStream_t stream) {
    static int grid = 0;
    if (grid == 0) {
        if (n_in != 31 || out_size != LROWS * D || ws_size < WS_END) { fprintf(stderr, "kernel_launch: unexpected shapes (n_in %d, out %d, ws %zu < %zu)\n", n_in, out_size, ws_size, (size_t)WS_END); grid = -1; return; }
        int dev = 0, cus = 0, per_cu = 0;
        if (hipGetDevice(&dev) != hipSuccess || hipDeviceGetAttribute(&cus, hipDeviceAttributeMultiprocessorCount, dev) != hipSuccess) { grid = -1; return; }
        if (hipFuncSetAttribute((const void*)mk_fwd, hipFuncAttributeMaxDynamicSharedMemorySize, LDS_BYTES) != hipSuccess) { fprintf(stderr, "kernel_launch: hipFuncSetAttribute failed\n"); grid = -1; return; }
        if (hipOccupancyMaxActiveBlocksPerMultiprocessor(&per_cu, (const void*)mk_fwd, NTHREADS, LDS_BYTES) != hipSuccess || per_cu < 1) { fprintf(stderr, "kernel_launch: occupancy query says %d\n", per_cu); }
        (void)hipGetLastError();
        grid = cus;
    }
    if (grid < 0) return;
    (void)hipMemsetAsync((char*)d_ws + WS_CTL, 0, CTL_ZERO_BYTES, stream);
    Args a{};
    for (int i = 0; i < 31; ++i) a.in[i] = (const float*)d_in[i];
    a.out = (float*)d_out; a.ws = (unsigned char*)d_ws;
#if MK_MODE == 1
    a.ph_lo = 0; a.ph_hi = NPHASE; a.li = 0;
    hipLaunchKernelGGL(mk_fwd, dim3(grid), dim3(NTHREADS), LDS_BYTES, stream, a);
#else
    for (int p = 0; p < MK_LAST; ++p) { a.ph_lo = p; a.ph_hi = p + 1; a.li = p; hipLaunchKernelGGL(mk_fwd, dim3(grid), dim3(NTHREADS), LDS_BYTES, stream, a); }
#endif
#ifdef MK_DUMP_OFF
    dumpk<<<(LROWS * D + 255) / 256, 256, 0, stream>>>((const unsigned char*)d_ws + (size_t)(MK_DUMP_OFF), (size_t)(MK_DUMP_BYTES), MK_DUMP_F32, (float*)d_out, (size_t)LROWS * D, 0);
#endif
#ifdef MK_DUMP2_OFF
    dumpk<<<(LROWS * D + 255) / 256, 256, 0, stream>>>((const unsigned char*)d_ws + (size_t)(MK_DUMP2_OFF), (size_t)(MK_DUMP2_BYTES), MK_DUMP2_F32, (float*)d_out, (size_t)LROWS * D, 1);
#endif
#ifdef MK_DUMP3_OFF
    dumpk<<<(LROWS * D + 255) / 256, 256, 0, stream>>>((const unsigned char*)d_ws + (size_t)(MK_DUMP3_OFF), (size_t)(MK_DUMP3_BYTES), MK_DUMP3_F32, (float*)d_out, (size_t)LROWS * D, 1);
#endif
}
```

```cpp
#define MK_MODE 1
#include <hip/hip_runtime.h>
#include <cstdio>
#include <cstdint>

#define GAS __attribute__((address_space(1)))
#define LAS __attribute__((address_space(3)))
typedef unsigned short bf16;
typedef short bf16x8 __attribute__((ext_vector_type(8)));
typedef short bf16x4 __attribute__((ext_vector_type(4)));
typedef float f32x2 __attribute__((ext_vector_type(2)));
typedef float f32x4 __attribute__((ext_vector_type(4)));
typedef float f32x16 __attribute__((ext_vector_type(16)));
typedef unsigned u32x2 __attribute__((ext_vector_type(2)));
typedef unsigned u32x4 __attribute__((ext_vector_type(4)));

constexpr int D = 1024, SEQ = 8192, LROWS = 16384, CTXL = 256, CROWS = 512, R = 16896;
constexpr int DFF = 2816, DFE = 3584, NEXP = 8, LCAP = 16640;
constexpr int NWAVES = 8, NTHREADS = 512;
constexpr int NCH16 = R / 16;
constexpr float EPSN = 1e-6f, LOG2E = 1.4426950408889634f;

constexpr size_t MiB = 1u << 20;
constexpr size_t WS_CTL = 0, CTL_ZERO_BYTES = 1 * MiB;
constexpr int CW_TMO = 0, CW_BAR = 4096, CW_MOECNT = 98304;
constexpr size_t CTL_MOD_OFF = 512 * 1024;
constexpr size_t WS_CTXBUF = 1 * MiB;
constexpr size_t WS_COST = 3 * MiB, WS_SINT = 4 * MiB, WS_COSN = 5 * MiB, WS_SINN = 6 * MiB;
constexpr size_t WS_LIST = 7 * MiB;
constexpr size_t WS_ROUTEW = WS_LIST + 8 * LCAP * 4;
constexpr size_t WS_S5K = 8 * MiB;
constexpr size_t WS_A16 = 9 * MiB;
constexpr size_t WS_W128T = WS_A16 + 64 * 1024;
constexpr size_t WS_TWC = WS_W128T + 64 * 1024, WS_TWS = WS_TWC + 32 * 1024;
constexpr size_t WS_FCT = WS_TWS + 32 * 1024;
constexpr size_t WS_W64T = WS_FCT + 32 * 1024;
constexpr size_t WS_W256T = WS_W64T + 32 * 1024;
constexpr size_t WS_MOE1 = 10 * MiB;
constexpr size_t WS_MOE2 = 122 * MiB;
constexpr size_t WS_OTHERW = 178 * MiB;
constexpr size_t WS_WIN = 178 * MiB;
constexpr size_t WS_WBR = 204 * MiB;
constexpr size_t WS_WOUT = 208 * MiB;
constexpr size_t WS_WGLU = 212 * MiB;
constexpr size_t WS_FFN1 = 213 * MiB;
constexpr size_t WS_FFN2 = 224 * MiB;
constexpr size_t WS_S5M1 = 230 * MiB;
constexpr size_t WS_S5TAB = 234 * MiB;
constexpr size_t WS_BIG = 242 * MiB;
constexpr size_t TOK256 = (size_t)R * 256 * 2;
constexpr size_t WS_INP = WS_BIG;
constexpr size_t WS_T = WS_INP + 7 * TOK256;
constexpr size_t WS_HLOC = WS_T + 3 * TOK256;
constexpr size_t WS_HIN = WS_HLOC + 2 * TOK256;
constexpr size_t WS_KV = WS_HIN + TOK256;
constexpr size_t WS_SPREV = WS_KV + 2 * TOK256;
constexpr size_t WS_FB = WS_SPREV + TOK256;
constexpr size_t WS_GATES = WS_BIG;
constexpr size_t WS_Y = WS_BIG + 132 * MiB;
constexpr size_t WS_YO = WS_Y + 33 * MiB;
constexpr size_t WS_Z = WS_YO + 33 * MiB;
constexpr size_t WS_FO = WS_Y;
constexpr size_t WS_HID = WS_BIG;
constexpr size_t WS_MHID = WS_OTHERW;
constexpr size_t WS_H = 449 * MiB;
constexpr size_t WS_MIX = 482 * MiB;
constexpr size_t WS_SLOT = WS_H;
constexpr size_t WS_END = 515 * MiB;
static_assert(WS_FB + 16 * MiB <= WS_Z && WS_Z + TOK256 <= WS_H && WS_MHID + (size_t)34816 * 3584 * 2 <= WS_H && WS_W256T + 256 * 1024 <= WS_MOE1, "ws map");
static_assert(WS_S5TAB + 8 * MiB <= WS_BIG && WS_FFN2 + (size_t)1024 * 2816 * 2 <= WS_S5M1 && WS_ROUTEW + 32768 * 4 <= WS_S5K, "ws map 2");

constexpr int RING_BYTES = 131072, LDSCTL_OFF = RING_BYTES, LDS_BYTES = 147456;
constexpr int LW_BAR = 8, LW_MOE = 16;

#define VM_WAIT() asm volatile("s_waitcnt vmcnt(0)" ::: "memory")
#define LDS_WAIT() asm volatile("s_waitcnt lgkmcnt(0)" ::: "memory")
typedef __bf16 bf16n2 __attribute__((ext_vector_type(2)));
__device__ __forceinline__ unsigned pk2(float lo, float hi) { bf16n2 v; v.x = (__bf16)lo; v.y = (__bf16)hi; return __builtin_bit_cast(unsigned, v); }
__device__ __forceinline__ float bf2f(unsigned short b) { return __builtin_bit_cast(float, ((unsigned)b) << 16); }
__device__ __forceinline__ float bflo(unsigned w) { return __builtin_bit_cast(float, w << 16); }
__device__ __forceinline__ float bfhi(unsigned w) { return __builtin_bit_cast(float, w & 0xffff0000u); }
__device__ __forceinline__ float ex2(float x) { return __builtin_amdgcn_exp2f(x); }
__device__ __forceinline__ float rcpf_(float x) { return __builtin_amdgcn_rcpf(x); }
__device__ __forceinline__ float sigm(float x) { return rcpf_(1.f + ex2(-LOG2E * x)); }
__device__ __forceinline__ float silu_(float x) { return x * sigm(x); }
__device__ __forceinline__ float gelu_tanh(float x) { const float u = 0.7978845608028654f * (x + 0.044715f * x * x * x); const float t = 1.f - 2.f * rcpf_(1.f + ex2(2.885390081777927f * u)); return 0.5f * x * (1.f + t); }
__device__ __forceinline__ float xor32_sum(float v) { const unsigned u = __builtin_bit_cast(unsigned, v); const auto r = __builtin_amdgcn_permlane32_swap(u, u, false, false); return __builtin_bit_cast(float, (unsigned)r[0]) + __builtin_bit_cast(float, (unsigned)r[1]); }
__device__ __forceinline__ float xor32_max(float v) { const unsigned u = __builtin_bit_cast(unsigned, v); const auto r = __builtin_amdgcn_permlane32_swap(u, u, false, false); return fmaxf(__builtin_bit_cast(float, (unsigned)r[0]), __builtin_bit_cast(float, (unsigned)r[1])); }
template <int X> __device__ __forceinline__ float swz_xor(float v) { return __builtin_bit_cast(float, __builtin_amdgcn_ds_swizzle(__builtin_bit_cast(int, v), (X << 10) | 0x1f)); }
__device__ __forceinline__ float wave_sum(float v) { v += swz_xor<1>(v); v += swz_xor<2>(v); v += swz_xor<4>(v); v += swz_xor<8>(v); v += swz_xor<16>(v); return xor32_sum(v); }
__device__ __forceinline__ f32x16 mma32(bf16x8 a, bf16x8 b, f32x16 c) { return __builtin_amdgcn_mfma_f32_32x32x16_bf16(a, b, c, 0, 0, 0); }
__device__ __forceinline__ bf16x8 ldg8(const bf16* p) { return *(const bf16x8*)p; }
__device__ __forceinline__ bf16x8 ldg8p(const bf16* p) { const bf16x4 lo = *(const bf16x4*)p, hi = *(const bf16x4*)(p + 8); return __builtin_shufflevector(lo, hi, 0, 1, 2, 3, 4, 5, 6, 7); }
template <int S> __device__ __forceinline__ bf16x8 accB(const f32x16& c) {
    u32x4 w; w.x = pk2(c[8 * S + 0], c[8 * S + 1]); w.y = pk2(c[8 * S + 2], c[8 * S + 3]); w.z = pk2(c[8 * S + 4], c[8 * S + 5]); w.w = pk2(c[8 * S + 6], c[8 * S + 7]);
    return __builtin_bit_cast(bf16x8, w);
}
__device__ __forceinline__ bf16x8 pack8(const float (&v)[8]) { u32x4 w; w.x = pk2(v[0], v[1]); w.y = pk2(v[2], v[3]); w.z = pk2(v[4], v[5]); w.w = pk2(v[6], v[7]); return __builtin_bit_cast(bf16x8, w); }
__device__ __forceinline__ void unpack8(const bf16x8 x, float (&v)[8]) { const u32x4 w = __builtin_bit_cast(u32x4, x); v[0] = bflo(w.x); v[1] = bfhi(w.x); v[2] = bflo(w.y); v[3] = bfhi(w.y); v[4] = bflo(w.z); v[5] = bfhi(w.z); v[6] = bflo(w.w); v[7] = bfhi(w.w); }
__device__ __forceinline__ f32x16 zero16() { f32x16 z;
#pragma unroll
    for (int i = 0; i < 16; ++i) z[i] = 0.f;
    return z; }

#define XB_TMO      128
#define XB_XCNT(j)  (256  + 64 * (j))
#define XB_XSUB(j)  (1280 + 64 * (j))
#define XB_XGEN(j)  (2304 + 64 * (j))
#define XB_TOP      3328
#define XB_TOPGEN   3392
#define XCD_BAR_WORDS 3456
#define XB_SPIN_CAP (1u << 18)
__device__ __forceinline__ unsigned xb_ld(unsigned* p)              { return __hip_atomic_load(p, __ATOMIC_RELAXED, __HIP_MEMORY_SCOPE_AGENT); }
__device__ __forceinline__ unsigned xb_add(unsigned* p, unsigned v) { return __hip_atomic_fetch_add(p, v, __ATOMIC_RELAXED, __HIP_MEMORY_SCOPE_AGENT); }
__device__ __forceinline__ unsigned xb_xcc_id() { return (unsigned)__builtin_amdgcn_s_getreg((3 << 11) | 20) & 0xFu; }
#define XB_SPIN(cond, bar) do { unsigned _sp = 0; while (cond) { __builtin_amdgcn_s_sleep(1); \
    if ((++_sp & 255u) == 0u) { if (xb_ld(&(bar)[XB_TMO])) break; if (_sp > XB_SPIN_CAP) { atomicAdd(&(bar)[XB_TMO], 1u); break; } } } } while (0)
struct XcdBarrier { unsigned* bar; unsigned x; volatile LAS unsigned* st; };
__device__ __forceinline__ XcdBarrier xcd_barrier_post(unsigned* bar, volatile LAS unsigned* st) {
    XcdBarrier b; b.bar = bar; b.x = xb_xcc_id(); b.st = st;
    if (threadIdx.x == 0) (void)xb_add(&bar[XB_XCNT(b.x)], 1u);
    return b;
}
__device__ __forceinline__ void xcd_barrier_complete(unsigned* bar, unsigned x, unsigned& nloc, unsigned& nx) {
    const unsigned G = gridDim.x * gridDim.y * gridDim.z;
    unsigned sum, cnt, mine, sp = 0u;
    for (;;) {
        sum = 0u; cnt = 0u; mine = 0u;
#pragma unroll
        for (unsigned j = 0; j < 16; ++j) { const unsigned c = xb_ld(&bar[XB_XCNT(j)]); sum += c; cnt += (c > 0u) ? 1u : 0u; mine = (j == x) ? c : mine; }
        if (sum == G) break;
        __builtin_amdgcn_s_sleep(1);
        if ((++sp & 255u) == 0u) { if (xb_ld(&bar[XB_TMO])) break; if (sp > XB_SPIN_CAP) { atomicAdd(&bar[XB_TMO], 1u); break; } }
    }
    nloc = mine > 0u ? mine : 1u; nx = cnt > 0u ? cnt : 1u;
}
__device__ __forceinline__ void xcd_barrier(const XcdBarrier& b) {
    asm volatile("s_waitcnt vmcnt(0)" ::: "memory");
    __syncthreads();
    if (threadIdx.x == 0) {
        unsigned* bar = b.bar;
        __builtin_amdgcn_s_waitcnt(0);
        unsigned nloc = b.st[0], nx = b.st[1];
        if (nloc == 0u) { xcd_barrier_complete(bar, b.x, nloc, nx); b.st[0] = nloc; b.st[1] = nx; }
        const unsigned old = xb_add(&bar[XB_XSUB(b.x)], 1u);
        const unsigned gen = old / nloc;
        if (old + 1u == (gen + 1u) * nloc) {
            __builtin_amdgcn_fence(__ATOMIC_RELEASE, "agent");
            asm volatile("s_waitcnt vmcnt(0)" ::: "memory");
            const unsigned og = xb_add(&bar[XB_TOP], 1u);
            const unsigned tg = og / nx;
            if (og + 1u == (tg + 1u) * nx) xb_add(&bar[XB_TOPGEN], 1u);
            else XB_SPIN(xb_ld(&bar[XB_TOPGEN]) == tg, bar);
            __builtin_amdgcn_fence(__ATOMIC_ACQUIRE, "agent");
            xb_add(&bar[XB_XGEN(b.x)], 1u);
            asm volatile("s_waitcnt vmcnt(0)" ::: "memory");
        } else {
            XB_SPIN(xb_ld(&bar[XB_XGEN(b.x)]) == gen, bar);
            __builtin_amdgcn_fence(__ATOMIC_ACQUIRE, "agent");
            asm volatile("s_waitcnt vmcnt(0)" ::: "memory");
        }
    }
    __syncthreads();
}
namespace gp {
constexpr int BM = 256, BK = 64, HALF = 128, HTB = HALF * BK * 2, STAGE_BYTES = 8 * HTB, NXCD = 8, WGM = 8;
__device__ __forceinline__ int lds_byte(int r, int c) { const int st = (r >> 4) * 2 + (c >> 5), rr = r & 15, cc = c & 31, ob = rr * 64 + cc * 2; return st * 1024 + (ob ^ (((ob >> 9) & 1) << 5)); }
__device__ __forceinline__ void stage_rc(int b, int& Rr, int& C) { const int st = b / 1024, sb = b % 1024, swz = sb ^ (((sb >> 9) & 1) << 5); Rr = (st >> 1) * 16 + swz / 64; C = (st & 1) * 32 + (swz % 64) / 2; }
__device__ __forceinline__ int perm32(int rho) { const int n = rho >> 4, i = rho & 15; return 8 * (i >> 2) + 4 * n + (i & 3); }

struct Unit { const char* a; const char* b; int e0, e1, e2, e3; };

__device__ __forceinline__ void tile_of(int L, int nM, int nN, int& pm, int& pn) {
    const int nwg = nM * nN; int wgid = L;
    { const int q = nwg / NXCD, r = nwg % NXCD, xcd = wgid % NXCD, off = wgid / NXCD; wgid = (xcd < r ? xcd * (q + 1) : r * (q + 1) + (xcd - r) * q) + off; }
    const int nig = WGM * nN, gid = wgid / nig, fm = gid * WGM, gsz = (nM - fm) < WGM ? (nM - fm) : WGM;
    pm = fm + ((wgid % nig) % gsz); pn = (wgid % nig) / gsz;
}

template <class Epi, class Sched>
__device__ __forceinline__ void gemm_phase(LAS unsigned char* lds, const int tid, const int K, const int lda, const int ldb, const Sched& S, const Epi& E) {
    constexpr bool GATHER = Sched::GATHER;
    const int wid = __builtin_amdgcn_readfirstlane(tid >> 6), lane = tid & 63, wr = wid >> 2, wc = wid & 3, fr = lane & 15, fq = lane >> 4;
    int nt = K / BK; asm volatile("" : "+s"(nt));
    unsigned voffA[2], voffB[2], cb2[2]; int rowA[2];
#pragma unroll
    for (int i = 0; i < 2; ++i) { int Rr, C; stage_rc(tid * 16 + i * 8192, Rr, C); const int Rb = (Rr & ~31) + perm32(Rr & 31);
        rowA[i] = Rr; cb2[i] = (unsigned)C * 2u; voffA[i] = (unsigned)(Rr * lda + C) * 2u; voffB[i] = (unsigned)(Rb * ldb + C) * 2u; }
    const size_t kstep = (size_t)(BK * 2);
    const unsigned hstepA = (unsigned)HALF * (unsigned)lda * 2u; const size_t hstepB = (size_t)HALF * ldb * 2;
    const unsigned ldsw = (unsigned)wid * 1024u;
    const int aoff = lds_byte(wr * 64 + fr, fq * 8), boff = lds_byte(wc * 32 + fr, fq * 8);
#define PG8_SA(b, h) (((b) * 2 + (h)) * HTB)
#define PG8_SB(b, h) ((4 + (b) * 2 + (h)) * HTB)
#define PG8_STB(bufoff, gbase, hh) do { _Pragma("unroll") for (int _i = 0; _i < 2; ++_i) \
        __builtin_amdgcn_global_load_lds((const unsigned*)((const char*)(gbase) + (size_t)(hh) * hstepB + voffB[_i]), (LAS unsigned*)(lds + (bufoff) + ldsw + _i * 8192), 16, 0, 0); } while (0)
#define PG8_STA(bufoff, gbase, hh, VG) do { _Pragma("unroll") for (int _i = 0; _i < 2; ++_i) { const unsigned _o = GATHER ? (VG)[hh][_i] : (voffA[_i] + (unsigned)(hh) * hstepA); \
        __builtin_amdgcn_global_load_lds((const unsigned*)((const char*)(gbase) + _o), (LAS unsigned*)(lds + (bufoff) + ldsw + _i * 8192), 16, 0, 0); } } while (0)
#define PG8_LDA(dst, b, h) do { _Pragma("unroll") for (int m = 0; m < 4; ++m) _Pragma("unroll") for (int k = 0; k < 2; ++k) dst[m][k] = *(const LAS bf16x8*)(lds + PG8_SA(b, h) + aoff + m * 2048 + k * 1024); } while (0)
#define PG8_LDB(dst, b, h) do { _Pragma("unroll") for (int n = 0; n < 2; ++n) _Pragma("unroll") for (int k = 0; k < 2; ++k) dst[n][k] = *(const LAS bf16x8*)(lds + PG8_SB(b, h) + boff + n * 2048 + k * 1024); } while (0)
#define PG8_MMA(ai, bj, At, Bt) do { __builtin_amdgcn_s_setprio(1); _Pragma("unroll") for (int m = 0; m < 4; ++m) _Pragma("unroll") for (int n = 0; n < 2; ++n) _Pragma("unroll") for (int k = 0; k < 2; ++k) \
        acc[ai][bj][m][n] = __builtin_amdgcn_mfma_f32_16x16x32_bf16(Bt[n][k], At[m][k], acc[ai][bj][m][n], 0, 0, 0); __builtin_amdgcn_s_setprio(0); } while (0)
#define PG8_WAIT_V(n) asm volatile("s_waitcnt vmcnt(" #n ")" ::: "memory")
#define PG8_WAIT_L(n) asm volatile("s_waitcnt lgkmcnt(" #n ")" ::: "memory")
#define PG8_BAR __builtin_amdgcn_s_barrier()
#define PG8_SCHED __builtin_amdgcn_sched_barrier(0)
    Unit cur, nxt; int ui = 0;
    if (!S.next(0, cur)) return;
    f32x4 acc[2][2][4][2];
#pragma unroll
    for (int a = 0; a < 2; ++a)
#pragma unroll
        for (int b = 0; b < 2; ++b)
#pragma unroll
            for (int m = 0; m < 4; ++m)
#pragma unroll
                for (int n = 0; n < 2; ++n) acc[a][b][m][n] = (f32x4){0.f, 0.f, 0.f, 0.f};
    bf16x8 At[4][2], B0[2][2], B1[2][2];
    unsigned vgc[2][2], vgn[2][2];
#pragma unroll
    for (int h = 0; h < 2; ++h)
#pragma unroll
        for (int i = 0; i < 2; ++i) { vgc[h][i] = GATHER ? S.rowoff(cur, rowA[i] + h * HALF) + cb2[i] : 0u; vgn[h][i] = vgc[h][i]; }
    const char* cA = cur.a; const char* cB = cur.b;
    PG8_STB(PG8_SB(0, 0), cB, 0); PG8_STB(PG8_SB(0, 1), cB, 1); PG8_STA(PG8_SA(0, 0), cA, 0, vgc); PG8_STA(PG8_SA(0, 1), cA, 1, vgc);
    if (wr == 1) PG8_BAR;
    PG8_WAIT_V(2); PG8_BAR;
    PG8_STB(PG8_SB(1, 0), cB + kstep, 0); PG8_STA(PG8_SA(1, 0), cA + kstep, 0, vgc); PG8_STB(PG8_SB(1, 1), cB + kstep, 1);
    PG8_WAIT_V(6); PG8_BAR;
    for (;;) {
        const bool has_next = S.next(ui + 1, nxt);
        const char* nA = has_next ? nxt.a : cA; const char* nB = has_next ? nxt.b : cB;
#pragma unroll 1
        for (int t = 0; t < nt; t += 2) {
            const bool last = (t == nt - 2);
            const char* a1 = cA + (size_t)(t + 1) * kstep;
            const char* a2 = last ? nA : cA + (size_t)(t + 2) * kstep; const char* b2 = last ? nB : cB + (size_t)(t + 2) * kstep;
            const char* a3 = a2 + kstep; const char* b3 = b2 + kstep;
            unsigned vg2[2][2];
            if constexpr (GATHER) {
                if (last && has_next) {
#pragma unroll
                    for (int h = 0; h < 2; ++h)
#pragma unroll
                        for (int i = 0; i < 2; ++i) vgn[h][i] = S.rowoff(nxt, rowA[i] + h * HALF) + cb2[i];
                }
            }
#pragma unroll
            for (int h = 0; h < 2; ++h)
#pragma unroll
                for (int i = 0; i < 2; ++i) vg2[h][i] = last ? vgn[h][i] : vgc[h][i];
            PG8_LDB(B0, 0, 0); PG8_LDB(B1, 0, 1); PG8_SCHED; PG8_LDA(At, 0, 0); PG8_STA(PG8_SA(1, 1), a1, 1, vgc);
            PG8_WAIT_V(8); PG8_WAIT_L(0); PG8_BAR; PG8_MMA(0, 0, At, B0); PG8_MMA(0, 1, At, B1); PG8_BAR; PG8_SCHED;
            PG8_LDA(At, 0, 1); PG8_STB(PG8_SB(0, 0), b2, 0); PG8_STB(PG8_SB(0, 1), b2, 1); PG8_STA(PG8_SA(0, 0), a2, 0, vg2);
            PG8_WAIT_V(8); PG8_WAIT_L(0); PG8_BAR; PG8_MMA(1, 0, At, B0); PG8_MMA(1, 1, At, B1); PG8_BAR; PG8_SCHED;
            PG8_LDB(B0, 1, 0); PG8_LDB(B1, 1, 1); PG8_SCHED; PG8_LDA(At, 1, 0); PG8_STA(PG8_SA(0, 1), a2, 1, vg2);
            PG8_WAIT_V(8); PG8_WAIT_L(0); PG8_BAR; PG8_MMA(0, 0, At, B0); PG8_MMA(0, 1, At, B1); PG8_BAR; PG8_SCHED;
            PG8_LDA(At, 1, 1); PG8_STB(PG8_SB(1, 0), b3, 0); PG8_STB(PG8_SB(1, 1), b3, 1); PG8_STA(PG8_SA(1, 0), a3, 0, vg2);
            PG8_WAIT_V(8); PG8_WAIT_L(0); PG8_BAR; PG8_MMA(1, 0, At, B0); PG8_MMA(1, 1, At, B1); PG8_BAR; PG8_SCHED;
        }
        if (wr == 0) PG8_BAR;
        E(acc, cur, wr, wc, fr, fq);
        if (!has_next) break;
#pragma unroll
        for (int a = 0; a < 2; ++a)
#pragma unroll
            for (int b = 0; b < 2; ++b)
#pragma unroll
                for (int m = 0; m < 4; ++m)
#pragma unroll
                    for (int n = 0; n < 2; ++n) acc[a][b][m][n] = (f32x4){0.f, 0.f, 0.f, 0.f};
        cur = nxt; cA = nA; cB = nB; ++ui;
#pragma unroll
        for (int h = 0; h < 2; ++h)
#pragma unroll
            for (int i = 0; i < 2; ++i) vgc[h][i] = vgn[h][i];
        if (wr == 1) PG8_BAR;
    }
    PG8_WAIT_V(0);
    PG8_BAR;
#undef PG8_SA
#undef PG8_SB
#undef PG8_STA
#undef PG8_STB
#undef PG8_LDA
#undef PG8_LDB
#undef PG8_MMA
#undef PG8_WAIT_V
#undef PG8_WAIT_L
#undef PG8_BAR
#undef PG8_SCHED
}

struct SchedPlain {
    static constexpr bool GATHER = false;
    const char* A; const char* B; size_t ta, tb; int nM, nN, G, c;
    __device__ __forceinline__ bool next(int i, Unit& u) const {
        const long L = (long)i * G + c; if (L >= (long)nM * nN) return false;
        int pm, pn; tile_of((int)L, nM, nN, pm, pn); u.a = A + (size_t)pm * ta; u.b = B + (size_t)pn * tb; u.e0 = pm; u.e1 = pn; u.e2 = 0; u.e3 = 0; return true; }
    __device__ __forceinline__ unsigned rowoff(const Unit&, int) const { return 0u; }
};
struct SchedInprojA {
    static constexpr bool GATHER = false;
    const char* Hh; const char* W; int nM, G, c;
    __device__ __forceinline__ bool next(int i, Unit& u) const {
        long L = (long)i * G + c; const int n1 = nM * 7, n2 = 3 * nM; if (L >= n1 + n2) return false;
        int pm, pn;
        if (L < n1) { tile_of((int)L, nM, 7, pm, pn); u.a = Hh + (size_t)pm * (256 * 2048); u.b = W + (size_t)pn * (256 * 2048); u.e2 = 0; }
        else { tile_of((int)(L - n1), 3, nM, pm, pn); u.a = W + (size_t)(23 + pm) * (256 * 2048); u.b = Hh + (size_t)pn * (256 * 2048); u.e2 = 1; }
        u.e0 = pm; u.e1 = pn; u.e3 = 0; return true; }
    __device__ __forceinline__ unsigned rowoff(const Unit&, int) const { return 0u; }
};
struct SchedMerge {
    static constexpr bool GATHER = false;
    const char* Mix; const char* Wb; int nM, G, c;
    __device__ __forceinline__ bool next(int i, Unit& u) const {
        const long L = (long)(i >> 2) * G + c; if (L >= (long)nM * 4) return false;
        int pm, pn; tile_of((int)L, nM, 4, pm, pn); const int b = i & 3;
        u.a = Mix + (size_t)pm * (256 * 2048) + b * 512; u.b = Wb + ((size_t)b * 1024 + pn * 256) * 512; u.e0 = pm; u.e1 = pn; u.e2 = b; u.e3 = 0; return true; }
    __device__ __forceinline__ unsigned rowoff(const Unit&, int) const { return 0u; }
};
struct SchedMoe1 {
    static constexpr bool GATHER = true;
    const char* Hh; const char* W; const int* list; const LAS unsigned* mt; int G, c;
    __device__ __forceinline__ bool next(int i, Unit& u) const {
        long L = (long)i * G + c; int e = 0;
        for (; e < 8; ++e) { const long ue = (long)mt[8 + e] * 28; if (L < ue) break; L -= ue; }
        if (e == 8) return false;
        const int m_e = (int)mt[8 + e], nti = (int)(L / m_e), mti = (int)(L % m_e);
        u.a = Hh; u.b = W + ((size_t)e * 7168 + (size_t)nti * 256) * 2048; u.e0 = e; u.e1 = mti; u.e2 = nti; u.e3 = ((int)mt[16 + e] + mti) * 256; return true; }
    __device__ __forceinline__ unsigned rowoff(const Unit& u, int r) const {
        const int li = u.e1 * 256 + r; const int ent = (li < (int)mt[u.e0]) ? list[u.e0 * LCAP + li] : 0; return (unsigned)(ent >> 1) * 2048u; }
};
struct SchedMoe2 {
    static constexpr bool GATHER = false;
    const char* Hid; const char* W; const LAS unsigned* mt; int G, c;
    __device__ __forceinline__ bool next(int i, Unit& u) const {
        long L = (long)i * G + c; int e = 0;
        for (; e < 8; ++e) { const long ue = (long)mt[8 + e] * 4; if (L < ue) break; L -= ue; }
        if (e == 8) return false;
        const int m_e = (int)mt[8 + e], nti = (int)(L / m_e), mti = (int)(L % m_e);
        u.a = Hid + (size_t)((int)mt[16 + e] + mti) * 256 * (size_t)(DFE * 2); u.b = W + ((size_t)e * 1024 + (size_t)nti * 256) * (size_t)(DFE * 2); u.e0 = e; u.e1 = mti; u.e2 = nti; u.e3 = 0; return true; }
    __device__ __forceinline__ unsigned rowoff(const Unit&, int) const { return 0u; }
};

#define EPI_ROWS(ai, m) (128 * (ai) + 64 * wr + 16 * (m) + fr)
#define EPI_COL(bj) (128 * (bj) + 32 * wc + 8 * fq)
__device__ __forceinline__ u32x4 pack_acc8(const f32x4 a, const f32x4 b) { u32x4 w; w.x = pk2(a[0], a[1]); w.y = pk2(a[2], a[3]); w.z = pk2(b[0], b[1]); w.w = pk2(b[2], b[3]); return w; }

struct EpiPlain {
    bf16* O; int ld;
    __device__ __forceinline__ void operator()(const f32x4 (&acc)[2][2][4][2], const Unit& u, int wr, int wc, int fr, int fq) const {
#pragma unroll
        for (int ai = 0; ai < 2; ++ai)
#pragma unroll
            for (int m = 0; m < 4; ++m) { bf16* rowp = O + (size_t)(u.e0 * 256 + EPI_ROWS(ai, m)) * ld + u.e1 * 256;
#pragma unroll
                for (int bj = 0; bj < 2; ++bj) *(u32x4*)(rowp + EPI_COL(bj)) = pack_acc8(acc[ai][bj][m][0], acc[ai][bj][m][1]); }
    }
};
struct EpiInprojA {
    bf16* INP; bf16* T;
    __device__ __forceinline__ void operator()(const f32x4 (&acc)[2][2][4][2], const Unit& u, int wr, int wc, int fr, int fq) const {
        if (u.e2 == 0) {
            bf16* base = INP + (size_t)u.e1 * ((size_t)R * 256);
            const bool regroup = (u.e1 == 1);
#pragma unroll
            for (int ai = 0; ai < 2; ++ai)
#pragma unroll
                for (int m = 0; m < 4; ++m) { const int row = u.e0 * 256 + EPI_ROWS(ai, m);
#pragma unroll
                    for (int bj = 0; bj < 2; ++bj) { const int col = EPI_COL(bj);
                        bf16* p = regroup ? base + ((size_t)(col >> 4) * R + row) * 16 + (col & 15) : base + (size_t)row * 256 + col;
                        *(u32x4*)p = pack_acc8(acc[ai][bj][m][0], acc[ai][bj][m][1]); } }
        } else {
#pragma unroll
            for (int ai = 0; ai < 2; ++ai)
#pragma unroll
                for (int m = 0; m < 4; ++m) { bf16* rowp = T + (size_t)(u.e0 * 256 + EPI_ROWS(ai, m)) * R + u.e1 * 256;
#pragma unroll
                    for (int bj = 0; bj < 2; ++bj) *(u32x4*)(rowp + EPI_COL(bj)) = pack_acc8(acc[ai][bj][m][0], acc[ai][bj][m][1]); }
        }
    }
};
struct EpiGates {
    bf16* Gt;
    __device__ __forceinline__ void operator()(const f32x4 (&acc)[2][2][4][2], const Unit& u, int wr, int wc, int fr, int fq) const {
#pragma unroll
        for (int ai = 0; ai < 2; ++ai)
#pragma unroll
            for (int m = 0; m < 4; ++m) { bf16* rowp = Gt + (size_t)(u.e0 * 256 + EPI_ROWS(ai, m)) * 4096 + u.e1 * 256;
#pragma unroll
                for (int bj = 0; bj < 2; ++bj) { f32x4 a = acc[ai][bj][m][0], b = acc[ai][bj][m][1];
#pragma unroll
                    for (int j = 0; j < 4; ++j) { a[j] = sigm(a[j]); b[j] = sigm(b[j]); }
                    *(u32x4*)(rowp + EPI_COL(bj)) = pack_acc8(a, b); } }
    }
};
struct EpiGlu {
    const bf16* Zz; bf16* Mix; const float* bglu;
    __device__ __forceinline__ void operator()(const f32x4 (&acc)[2][2][4][2], const Unit& u, int wr, int wc, int fr, int fq) const {
#pragma unroll
        for (int bj = 0; bj < 2; ++bj) { const int col = EPI_COL(bj);
            const f32x4 b0 = *(const f32x4*)(bglu + col), b1 = *(const f32x4*)(bglu + col + 4);
#pragma unroll
            for (int ai = 0; ai < 2; ++ai)
#pragma unroll
                for (int m = 0; m < 4; ++m) { const size_t row = (size_t)(u.e0 * 256 + EPI_ROWS(ai, m));
                    const u32x4 zz = *(const u32x4*)(Zz + row * 256 + col);
                    f32x4 a = acc[ai][bj][m][0] + b0, b = acc[ai][bj][m][1] + b1;
                    a[0] = bflo(zz.x) * sigm(a[0]); a[1] = bfhi(zz.x) * sigm(a[1]); a[2] = bflo(zz.y) * sigm(a[2]); a[3] = bfhi(zz.y) * sigm(a[3]);
                    b[0] = bflo(zz.z) * sigm(b[0]); b[1] = bfhi(zz.z) * sigm(b[1]); b[2] = bflo(zz.w) * sigm(b[2]); b[3] = bfhi(zz.w) * sigm(b[3]);
                    *(u32x4*)(Mix + row * 1024 + 256 + col) = pack_acc8(a, b); } }
    }
};
struct EpiMerge {
    const bf16* Gt; bf16* Y;
    __device__ __forceinline__ void operator()(const f32x4 (&acc)[2][2][4][2], const Unit& u, int wr, int wc, int fr, int fq) const {
#pragma unroll
        for (int ai = 0; ai < 2; ++ai)
#pragma unroll
            for (int m = 0; m < 4; ++m) { const size_t row = (size_t)(u.e0 * 256 + EPI_ROWS(ai, m));
#pragma unroll
                for (int bj = 0; bj < 2; ++bj) { const int col = u.e1 * 256 + EPI_COL(bj);
                    const u32x4 g = *(const u32x4*)(Gt + row * 4096 + u.e2 * 1024 + col);
                    bf16* yp = Y + row * 1024 + col;
                    f32x4 a = acc[ai][bj][m][0], b = acc[ai][bj][m][1];
                    a[0] *= bflo(g.x); a[1] *= bfhi(g.x); a[2] *= bflo(g.y); a[3] *= bfhi(g.y); b[0] *= bflo(g.z); b[1] *= bfhi(g.z); b[2] *= bflo(g.w); b[3] *= bfhi(g.w);
                    if (u.e2 != 0) { const u32x4 y = *(const u32x4*)yp;
                        a[0] += bflo(y.x); a[1] += bfhi(y.x); a[2] += bflo(y.y); a[3] += bfhi(y.y); b[0] += bflo(y.z); b[1] += bfhi(y.z); b[2] += bflo(y.w); b[3] += bfhi(y.w); }
                    *(u32x4*)yp = pack_acc8(a, b); } }
    }
};
struct EpiSwiglu {
    bf16* Hd; int ldh; bool moe;
    __device__ __forceinline__ void operator()(const f32x4 (&acc)[2][2][4][2], const Unit& u, int wr, int wc, int fr, int fq) const {
        const int rowbase = moe ? u.e3 : u.e0 * 256, pn = moe ? u.e2 : u.e1;
#pragma unroll
        for (int ai = 0; ai < 2; ++ai)
#pragma unroll
            for (int m = 0; m < 4; ++m) { bf16* p = Hd + (size_t)(rowbase + EPI_ROWS(ai, m)) * ldh + pn * 128 + 32 * wc + 8 * fq;
                f32x4 a = acc[ai][0][m][0], b = acc[ai][0][m][1]; const f32x4 ua = acc[ai][1][m][0], ub = acc[ai][1][m][1];
#pragma unroll
                for (int j = 0; j < 4; ++j) { a[j] = silu_(a[j]) * ua[j]; b[j] = silu_(b[j]) * ub[j]; }
                *(u32x4*)p = pack_acc8(a, b); }
    }
};
struct EpiMoeDown {
    bf16* Slot; const int* list; const float* routew; const LAS unsigned* mt;
    __device__ __forceinline__ void operator()(const f32x4 (&acc)[2][2][4][2], const Unit& u, int wr, int wc, int fr, int fq) const {
        const int cnt = (int)mt[u.e0];
#pragma unroll
        for (int ai = 0; ai < 2; ++ai)
#pragma unroll
            for (int m = 0; m < 4; ++m) { const int li = u.e1 * 256 + EPI_ROWS(ai, m);
                if (li < cnt) { const int ent = list[u.e0 * LCAP + li]; const float w = routew[ent];
                    bf16* rowp = Slot + ((size_t)(ent & 1) * LROWS + (size_t)(ent >> 1)) * 1024 + u.e2 * 256;
#pragma unroll
                    for (int bj = 0; bj < 2; ++bj) *(u32x4*)(rowp + EPI_COL(bj)) = pack_acc8(acc[ai][bj][m][0] * w, acc[ai][bj][m][1] * w); } }
    }
};
}
#define DROW(reg, h) (((reg) & 3) + 8 * ((reg) >> 2) + 4 * (h))

__device__ __forceinline__ void s5_state_item(const bf16* M1  , const bf16* SU, float* HLOC, int item, int lane) {
    const int cb = item % 33, gd = item / 33, g = gd >> 1, dir = gd & 1, li = lane & 31, h = lane >> 5;
    const bf16* A = M1 + (size_t)(g * 2 + dir) * 128 * 256;
    const bf16* B = SU + ((size_t)g * R + (size_t)(cb * 32 + li) * 16) * 16;
    f32x16 acc[4];
#pragma unroll
    for (int rt = 0; rt < 4; ++rt) acc[rt] = zero16();
#pragma unroll 4
    for (int ks = 0; ks < 16; ++ks) {
        const bf16x8 bf = ldg8(B + ks * 16 + 8 * h);
#pragma unroll
        for (int rt = 0; rt < 4; ++rt) acc[rt] = mma32(ldg8(A + (size_t)(rt * 32 + li) * 256 + ks * 16 + 8 * h), bf, acc[rt]);
    }
    float* o = HLOC + ((size_t)(g * 2 + dir) * NCH16 + cb * 32 + li) * 128;
#pragma unroll
    for (int rt = 0; rt < 4; ++rt)
#pragma unroll
        for (int q = 0; q < 4; ++q) *(f32x4*)(o + rt * 32 + 8 * q + 4 * h) = (f32x4){acc[rt][4 * q], acc[rt][4 * q + 1], acc[rt][4 * q + 2], acc[rt][4 * q + 3]};
}
__device__ __forceinline__ void s5_scan_item(const float* A16  , const float* HLOC, bf16* HIN, int item, int lane) {
    const int dir = item & 1, g = (item >> 1) & 15, b = item >> 5, p = lane;
    const f32x2 a = *(const f32x2*)(A16 + ((size_t)(dir * 16 + g) * 64 + p) * 2);
    const float* src = HLOC + (size_t)(g * 2 + dir) * NCH16 * 128 + 2 * p;
    bf16* dst = HIN + (size_t)g * NCH16 * 256 + dir * 128 + 2 * p;
    float hr = 0.f, hi = 0.f;
    for (int seg = 0; seg < 2; ++seg) {
        const int n = seg == 0 ? 16 : 512, c0 = seg == 0 ? 1024 + 16 * b : 512 * b;
        for (int s0 = 0; s0 < n; s0 += 16) {
            f32x2 v[16];
#pragma unroll
            for (int j = 0; j < 16; ++j) { const int s = s0 + j, c = c0 + (dir ? n - 1 - s : s); v[j] = *(const f32x2*)(src + (size_t)c * 128); }
#pragma unroll
            for (int j = 0; j < 16; ++j) { const int s = s0 + j, c = c0 + (dir ? n - 1 - s : s);
                *(unsigned*)(dst + (size_t)c * 256) = pk2(hr, hi);
                const float nr = a.x * hr - a.y * hi + v[j].x, ni = a.x * hi + a.y * hr + v[j].y; hr = nr; hi = ni; }
        }
    }
}
__device__ __forceinline__ void s5_out_item(const bf16* TAB  , const bf16* SU, const bf16* HIN, bf16* Z, int item, int lane) {
    const int mh = item & 1, it2 = item >> 1, cb = it2 % 33, g = it2 / 33, li = lane & 31, h = lane >> 5, c = cb * 32 + li;
    const bf16* A = TAB + ((size_t)g * 256 + mh * 128) * 512;
    const bf16* B0 = SU + ((size_t)g * R + (size_t)c * 16) * 16;
    const bf16* B1 = HIN + ((size_t)g * NCH16 + c) * 256;
    f32x16 acc[4];
#pragma unroll
    for (int rt = 0; rt < 4; ++rt) acc[rt] = zero16();
#pragma unroll 4
    for (int ks = 0; ks < 32; ++ks) {
        const bf16x8 bf = ks < 16 ? ldg8(B0 + ks * 16 + 8 * h) : ldg8(B1 + (ks - 16) * 16 + 8 * h);
#pragma unroll
        for (int rt = 0; rt < 4; ++rt) acc[rt] = mma32(ldg8(A + (size_t)(rt * 32 + li) * 512 + ks * 16 + 8 * h), bf, acc[rt]);
    }
#pragma unroll
    for (int rt = 0; rt < 4; ++rt)
#pragma unroll
        for (int q = 0; q < 4; ++q) {
            const int i = 8 * mh + 2 * rt + (q >> 1), ho0 = 8 * (q & 1) + 4 * h;
            u32x2 w; w.x = pk2(gelu_tanh(acc[rt][4 * q]), gelu_tanh(acc[rt][4 * q + 1])); w.y = pk2(gelu_tanh(acc[rt][4 * q + 2]), gelu_tanh(acc[rt][4 * q + 3]));
            *(u32x2*)(Z + ((size_t)c * 16 + i) * 256 + g * 16 + ho0) = w; }
}

__device__ __forceinline__ int ret_tok0(int b, int n) { return n < 64 ? b * SEQ + n * 128 : LROWS + b * CTXL + (n - 64) * 128; }
__device__ __forceinline__ void ret_kv_item(const bf16* RKT, const bf16* RVT, const float* COST, const float* SINT, const float* decay  , float* KV, int item, int lane) {
    const int n = item % 66, bh = item / 66, hd = bh & 3, b = bh >> 2, li = lane & 31, h = lane >> 5;
    const int tok0 = ret_tok0(b, n); const bool lat = n < 64;
    const float lgf = -log2f(1.f + __expf(-decay[hd])), lgr = -log2f(1.f + __expf(-decay[4 + hd]));
    f32x16 acc[2][2][2];
#pragma unroll
    for (int a = 0; a < 2; ++a)
#pragma unroll
        for (int c = 0; c < 2; ++c)
#pragma unroll
            for (int d = 0; d < 2; ++d) acc[a][c][d] = zero16();
    const bf16* k0p = RKT + (size_t)(hd * 64 + li) * R + tok0 + 8 * h;
    const bf16* v0p = RVT + (size_t)(hd * 64 + li) * R + tok0 + 8 * h;
#pragma unroll 2
    for (int ks = 0; ks < 8; ++ks) {
        float k1[8], k2[8];
        unpack8(ldg8(k0p + ks * 16), k1); unpack8(ldg8(k0p + (size_t)32 * R + ks * 16), k2);
        if (lat) {
            const float* cp = COST + (size_t)li * SEQ + n * 128 + ks * 16 + 8 * h; const float* sp = SINT + (size_t)li * SEQ + n * 128 + ks * 16 + 8 * h;
            const f32x4 c0 = *(const f32x4*)cp, c1 = *(const f32x4*)(cp + 4), s0 = *(const f32x4*)sp, s1 = *(const f32x4*)(sp + 4);
#pragma unroll
            for (int j = 0; j < 8; ++j) { const float cc = j < 4 ? c0[j & 3] : c1[j & 3], ss = j < 4 ? s0[j & 3] : s1[j & 3];
                const float x1 = k1[j], x2 = k2[j]; k1[j] = x1 * cc - x2 * ss; k2[j] = x1 * ss + x2 * cc; }
        }
        const bf16x8 vf0 = ldg8(v0p + ks * 16), vf1 = ldg8(v0p + (size_t)32 * R + ks * 16);
#pragma unroll
        for (int dir = 0; dir < 2; ++dir) {
            float a1[8], a2[8];
#pragma unroll
            for (int j = 0; j < 8; ++j) { const int i = ks * 16 + 8 * h + j; const float w = dir == 0 ? ex2(lgf * (float)(127 - i)) : ex2(lgr * (float)i); a1[j] = k1[j] * w; a2[j] = k2[j] * w; }
            const bf16x8 kd0 = pack8(a1), kd1 = pack8(a2);
            acc[dir][0][0] = mma32(kd0, vf0, acc[dir][0][0]); acc[dir][0][1] = mma32(kd0, vf1, acc[dir][0][1]);
            acc[dir][1][0] = mma32(kd1, vf0, acc[dir][1][0]); acc[dir][1][1] = mma32(kd1, vf1, acc[dir][1][1]);
        }
    }
#pragma unroll
    for (int dir = 0; dir < 2; ++dir) { float* o = KV + ((size_t)((b * 4 + hd) * 2 + dir) * 66 + n) * 4096;
#pragma unroll
        for (int dt = 0; dt < 2; ++dt)
#pragma unroll
            for (int et = 0; et < 2; ++et)
#pragma unroll
                for (int q = 0; q < 4; ++q) *(f32x4*)(o + (size_t)(et * 32 + li) * 64 + dt * 32 + 8 * q + 4 * h) = (f32x4){acc[dir][dt][et][4 * q], acc[dir][dt][et][4 * q + 1], acc[dir][dt][et][4 * q + 2], acc[dir][dt][et][4 * q + 3]}; }
}
__device__ __forceinline__ void ret_scan_item(const float* decay, const float* KV, bf16* SPREV, int item, int lane) {
    const int blk = item & 63, bhd = item >> 6, dir = bhd & 1, hd = (bhd >> 1) & 3, idx = blk * 64 + lane;
    const float lg = -log2f(1.f + __expf(-decay[dir * 4 + hd])), cd = ex2(128.f * lg);
    const float* src = KV + (size_t)bhd * 66 * 4096 + idx; bf16* dst = SPREV + (size_t)bhd * 66 * 4096 + idx;
    float s = 0.f;
    for (int s0 = 0; s0 < 66; s0 += 11) {
        float v[11];
#pragma unroll
        for (int j = 0; j < 11; ++j) { const int t = s0 + j; const int n = dir == 0 ? (t < 2 ? 64 + t : t - 2) : (t < 2 ? 65 - t : 65 - t); v[j] = src[(size_t)n * 4096]; }
#pragma unroll
        for (int j = 0; j < 11; ++j) { const int t = s0 + j; const int n = dir == 0 ? (t < 2 ? 64 + t : t - 2) : (t < 2 ? 65 - t : 65 - t); dst[(size_t)n * 4096] = (bf16)(pk2(s, 0.f) & 0xffffu); s = cd * s + v[j]; }
    }
}
__device__ __forceinline__ void ret_out_item(const bf16* RQ, const bf16* RK, const bf16* RG, const bf16* RVT, const bf16* SPREV, const float* COSN, const float* SINN,
                                             const float* decay, const float* gn  , bf16* MIX, int item, int lane) {
    const int qb = item & 3, it2 = item >> 2, n = it2 % 66, bh = it2 / 66, hd = bh & 3, b = bh >> 2, li = lane & 31, h = lane >> 5;
    const int tok0 = ret_tok0(b, n); const bool lat = n < 64;
    const float lgf = -log2f(1.f + __expf(-decay[hd])), lgr = -log2f(1.f + __expf(-decay[4 + hd]));
    const int iq = qb * 32 + li;
    bf16x8 qf[4];
    {
        const bf16* qp = RQ + (size_t)(tok0 + iq) * 256 + hd * 64 + 8 * h;
#pragma unroll
        for (int s = 0; s < 4; ++s) qf[s] = ldg8(qp + 16 * s);
        if (lat) { const int tl = n * 128 + iq;
#pragma unroll
            for (int s = 0; s < 2; ++s) { float x1[8], x2[8]; unpack8(qf[s], x1); unpack8(qf[s + 2], x2);
                const float* cp = COSN + (size_t)tl * 32 + 16 * s + 8 * h; const float* sp = SINN + (size_t)tl * 32 + 16 * s + 8 * h;
                const f32x4 c0 = *(const f32x4*)cp, c1 = *(const f32x4*)(cp + 4), s0 = *(const f32x4*)sp, s1 = *(const f32x4*)(sp + 4);
#pragma unroll
                for (int j = 0; j < 8; ++j) { const float cc = j < 4 ? c0[j & 3] : c1[j & 3], ss = j < 4 ? s0[j & 3] : s1[j & 3]; const float a = x1[j], bb = x2[j]; x1[j] = a * cc - bb * ss; x2[j] = a * ss + bb * cc; }
                qf[s] = pack8(x1); qf[s + 2] = pack8(x2); } }
    }
    f32x16 accO[2] = {zero16(), zero16()};
#pragma unroll 1
    for (int kt = 0; kt < 4; ++kt) {
        bf16x8 kf[4];
        const int jk = kt * 32 + li;
        const bf16* kp = RK + (size_t)(tok0 + jk) * 256 + hd * 64 + 8 * h;
#pragma unroll
        for (int s = 0; s < 4; ++s) kf[s] = ldg8(kp + 16 * s);
        if (lat) { const int tl = n * 128 + jk;
#pragma unroll
            for (int s = 0; s < 2; ++s) { float x1[8], x2[8]; unpack8(kf[s], x1); unpack8(kf[s + 2], x2);
                const float* cp = COSN + (size_t)tl * 32 + 16 * s + 8 * h; const float* sp = SINN + (size_t)tl * 32 + 16 * s + 8 * h;
                const f32x4 c0 = *(const f32x4*)cp, c1 = *(const f32x4*)(cp + 4), s0 = *(const f32x4*)sp, s1 = *(const f32x4*)(sp + 4);
#pragma unroll
                for (int j = 0; j < 8; ++j) { const float cc = j < 4 ? c0[j & 3] : c1[j & 3], ss = j < 4 ? s0[j & 3] : s1[j & 3]; const float a = x1[j], bb = x2[j]; x1[j] = a * cc - bb * ss; x2[j] = a * ss + bb * cc; }
                kf[s] = pack8(x1); kf[s + 2] = pack8(x2); } }
        f32x16 st = zero16();
#pragma unroll
        for (int s = 0; s < 4; ++s) st = mma32(kf[s], qf[s], st);
#pragma unroll
        for (int r = 0; r < 16; ++r) { const int j = kt * 32 + DROW(r, h), df = iq - j;
            const float w = df > 0 ? ex2(lgf * (float)df) : (df < 0 ? ex2(lgr * (float)(-df)) : 2.f); st[r] *= w; }
        const bf16x8 p0 = accB<0>(st), p1 = accB<1>(st);
#pragma unroll
        for (int et = 0; et < 2; ++et) { const bf16* vp = RVT + (size_t)(hd * 64 + et * 32 + li) * R + tok0 + kt * 32 + 4 * h;
            accO[et] = mma32(ldg8p(vp), p0, accO[et]); accO[et] = mma32(ldg8p(vp + 16), p1, accO[et]); }
    }
    const float cf = ex2(lgf * (float)(iq + 1)), cr = ex2(lgr * (float)(128 - iq));
#pragma unroll
    for (int dir = 0; dir < 2; ++dir) { const bf16* sp = SPREV + ((size_t)((b * 4 + hd) * 2 + dir) * 66 + n) * 4096;
#pragma unroll
        for (int et = 0; et < 2; ++et) { f32x16 a = zero16();
#pragma unroll
            for (int s = 0; s < 4; ++s) a = mma32(ldg8(sp + (size_t)(et * 32 + li) * 64 + 16 * s + 8 * h), qf[s], a);
            const float sc = dir == 0 ? cf : cr;
#pragma unroll
            for (int r = 0; r < 16; ++r) accO[et][r] += sc * a[r]; } }
    float s1 = 0.f;
#pragma unroll
    for (int et = 0; et < 2; ++et)
#pragma unroll
        for (int r = 0; r < 16; ++r) s1 += accO[et][r];
    s1 = xor32_sum(s1); const float mu = s1 * (1.f / 64.f);
    float s2 = 0.f;
#pragma unroll
    for (int et = 0; et < 2; ++et)
#pragma unroll
        for (int r = 0; r < 16; ++r) { const float dlt = accO[et][r] - mu; s2 += dlt * dlt; }
    s2 = xor32_sum(s2); const float rstd = __builtin_amdgcn_rsqf(s2 * (1.f / 64.f) + EPSN);
    const size_t tok = (size_t)(tok0 + iq);
#pragma unroll
    for (int et = 0; et < 2; ++et)
#pragma unroll
        for (int q = 0; q < 4; ++q) { const int e0 = hd * 64 + et * 32 + 8 * q + 4 * h;
            const f32x4 gv = *(const f32x4*)(gn + e0); const u32x2 gg = *(const u32x2*)(RG + tok * 256 + e0);
            const float g0 = bflo(gg.x), g1 = bfhi(gg.x), g2 = bflo(gg.y), g3 = bfhi(gg.y);
            u32x2 w; w.x = pk2(silu_(g0) * (accO[et][4 * q] - mu) * rstd * gv[0], silu_(g1) * (accO[et][4 * q + 1] - mu) * rstd * gv[1]);
            w.y = pk2(silu_(g2) * (accO[et][4 * q + 2] - mu) * rstd * gv[2], silu_(g3) * (accO[et][4 * q + 3] - mu) * rstd * gv[3]);
            *(u32x2*)(MIX + tok * 1024 + 512 + e0) = w; }
}

__device__ __forceinline__ void na_item(const bf16* NQ, const bf16* NK, const bf16* NVT, bf16* MIX, const LAS float* rpb, bool ctxq, int b, int r, int hd, int qs, int lane) {
    const int li = lane & 31, h = lane >> 5;
    const int tokq = ctxq ? LROWS + b * CTXL + qs * 32 + li : b * SEQ + r * 64 + qs * 32 + li;
    bf16x8 qf[4];
#pragma unroll
    for (int s = 0; s < 4; ++s) qf[s] = ldg8(NQ + (size_t)tokq * 256 + hd * 64 + 16 * s + 8 * h);
    float mrun = -1e30f, lrun = 0.f;
    f32x16 accO[2] = {zero16(), zero16()};
    const int rs = r - 4 < 0 ? 0 : (r - 4 > 120 ? 120 : r - 4);
    const int qc = qs * 32 + li, cs = qc - 8 < 0 ? 0 : (qc - 8 > 48 ? 48 : qc - 8);
    const int ntile = ctxq ? 8 : 24;
    const float c1 = 0.125f * LOG2E;
#pragma unroll 1
    for (int t = 0; t < ntile; ++t) {
        const bool band = t >= 8; const int tb = t - 8, rr = rs + (tb >> 1), ct = tb & 1;
        const int tokk0 = band ? b * SEQ + rr * 64 + ct * 32 : LROWS + b * CTXL + t * 32;
        f32x16 st = zero16();
        const bf16* kp = NK + (size_t)(tokk0 + li) * 256 + hd * 64 + 8 * h;
#pragma unroll
        for (int s = 0; s < 4; ++s) st = mma32(ldg8(kp + 16 * s), qf[s], st);
        float mt = -INFINITY;
        if (band) { const int dr = rr - r + 7;
#pragma unroll
            for (int g = 0; g < 16; ++g) { const int kc = ct * 32 + DROW(g, h); const bool inw = kc >= cs && kc < cs + 16; int dc = kc - qc + 15; dc = dc < 0 ? 0 : (dc > 30 ? 30 : dc);
                const float bias = rpb[(hd * 15 + dr) * 31 + dc]; const float v = inw ? st[g] * c1 + bias * LOG2E : -INFINITY; st[g] = v; mt = fmaxf(mt, v); }
        } else {
#pragma unroll
            for (int g = 0; g < 16; ++g) { const float v = st[g] * c1; st[g] = v; mt = fmaxf(mt, v); }
        }
        mt = xor32_max(mt);
        const float mnew = fmaxf(mrun, mt), alpha = ex2(mrun - mnew);
        float ps = 0.f;
#pragma unroll
        for (int g = 0; g < 16; ++g) { const float p = ex2(st[g] - mnew); st[g] = p; ps += p; }
        ps = xor32_sum(ps);
        lrun = lrun * alpha + ps; mrun = mnew;
#pragma unroll
        for (int et = 0; et < 2; ++et)
#pragma unroll
            for (int g = 0; g < 16; ++g) accO[et][g] *= alpha;
        const bf16x8 p0 = accB<0>(st), p1 = accB<1>(st);
#pragma unroll
        for (int et = 0; et < 2; ++et) { const bf16* vp = NVT + (size_t)(hd * 64 + et * 32 + li) * R + tokk0 + 4 * h;
            accO[et] = mma32(ldg8p(vp), p0, accO[et]); accO[et] = mma32(ldg8p(vp + 16), p1, accO[et]); }
    }
    const float inv = 1.f / lrun;
#pragma unroll
    for (int et = 0; et < 2; ++et)
#pragma unroll
        for (int q = 0; q < 4; ++q) { u32x2 w; w.x = pk2(accO[et][4 * q] * inv, accO[et][4 * q + 1] * inv); w.y = pk2(accO[et][4 * q + 2] * inv, accO[et][4 * q + 3] * inv);
            *(u32x2*)(MIX + (size_t)tokq * 1024 + 768 + hd * 64 + et * 32 + 8 * q + 4 * h) = w; }
}

__device__ __forceinline__ void fft1_item(const bf16* F, const bf16* W128T, const float* TWC, const float* TWS, bf16* FB, int item, int lane) {
    const int l2 = item & 63, g = (item >> 6) & 3, b = item >> 8, li = lane & 31, h = lane >> 5;
    bf16x8 idf[4];
#pragma unroll
    for (int s = 0; s < 4; ++s) { float v[8];
#pragma unroll
        for (int j = 0; j < 8; ++j) v[j] = (16 * (s & 1) + 8 * h + j == li) ? 1.f : 0.f;
        idf[s] = pack8(v); }
    bf16x8 xb[4][2][2];
#pragma unroll
    for (int lt = 0; lt < 4; ++lt) {
        const bf16* xp = F + (size_t)(b * SEQ + 64 * (lt * 32 + li) + l2) * 256 + g * 64 + 8 * h;
        const bf16x8 x0 = ldg8(xp), x1 = ldg8(xp + 16), x2 = ldg8(xp + 32), x3 = ldg8(xp + 48);
        f32x16 c0 = zero16(), c1 = zero16();
        c0 = mma32(x0, idf[0], c0); c0 = mma32(x1, idf[1], c0);
        c1 = mma32(x2, idf[0], c1); c1 = mma32(x3, idf[1], c1);
        xb[lt][0][0] = accB<0>(c0); xb[lt][0][1] = accB<1>(c0); xb[lt][1][0] = accB<0>(c1); xb[lt][1][1] = accB<1>(c1);
    }
#pragma unroll 1
    for (int kb = 0; kb < 4; ++kb) {
        f32x16 acc[2][2];
#pragma unroll
        for (int ri = 0; ri < 2; ++ri) { acc[ri][0] = zero16(); acc[ri][1] = zero16();
            const bf16* wp = W128T + ((size_t)ri * 128 + kb * 32 + li) * 128 + 4 * h;
#pragma unroll
            for (int lt = 0; lt < 4; ++lt)
#pragma unroll
                for (int s = 0; s < 2; ++s) { const bf16x8 wf = ldg8p(wp + lt * 32 + 16 * s);
                    acc[ri][0] = mma32(wf, xb[lt][0][s], acc[ri][0]); acc[ri][1] = mma32(wf, xb[lt][1][s], acc[ri][1]); } }
#pragma unroll
        for (int q = 0; q < 4; ++q) { const int k1 = kb * 32 + 8 * q + 4 * h;
            const f32x4 tc = *(const f32x4*)(TWC + l2 * 128 + k1), ts = *(const f32x4*)(TWS + l2 * 128 + k1);
#pragma unroll
            for (int j = 0; j < 4; ++j)
#pragma unroll
                for (int ct = 0; ct < 2; ++ct) { const float ar = acc[0][ct][4 * q + j], ai = acc[1][ct][4 * q + j];
                    const float br = ar * tc[j] + ai * ts[j], bi = ai * tc[j] - ar * ts[j];
                    bf16* o = FB + ((((size_t)(b * 4 + g) * 128 + k1 + j) * 2) * 64 + l2) * 64 + ct * 32 + li;
                    o[0] = (bf16)(pk2(br, 0.f) & 0xffffu); o[64 * 64] = (bf16)(pk2(bi, 0.f) & 0xffffu); } }
    }
}
__device__ __forceinline__ void fft2_item(const bf16* FB, const bf16* FCT, const bf16* W64T, bf16* MIX, int item, int lane) {
    const int mh = item & 1, k1 = (item >> 1) & 127, g = (item >> 8) & 3, b = item >> 10, li = lane & 31, h = lane >> 5;
    const bf16* br = FB + (((size_t)(b * 4 + g) * 128 + k1) * 2) * 64 * 64; const bf16* bi = br + 64 * 64;
    const bf16* fc = FCT + (size_t)(mh * 32 + li) * 64 + 8 * h; const bf16* fs = fc + 64 * 64; const bf16* fn = fc + 2 * 64 * 64;
    bf16x8 eb[2][2][2];
#pragma unroll
    for (int lt = 0; lt < 2; ++lt) { f32x16 er = zero16(), ei = zero16();
#pragma unroll
        for (int s = 0; s < 4; ++s) { const bf16x8 ar = ldg8(br + (size_t)(lt * 32 + li) * 64 + 16 * s + 8 * h), ai = ldg8(bi + (size_t)(lt * 32 + li) * 64 + 16 * s + 8 * h);
            const bf16x8 c = ldg8(fc + 16 * s), sn = ldg8(fs + 16 * s), ns = ldg8(fn + 16 * s);
            er = mma32(ar, c, er); er = mma32(ai, sn, er); ei = mma32(ai, c, ei); ei = mma32(ar, ns, ei); }
        eb[lt][0][0] = accB<0>(er); eb[lt][0][1] = accB<1>(er); eb[lt][1][0] = accB<0>(ei); eb[lt][1][1] = accB<1>(ei); }
#pragma unroll
    for (int kt = 0; kt < 2; ++kt) { f32x16 o = zero16();
        const bf16* wc = W64T + (size_t)(kt * 32 + li) * 64 + 4 * h; const bf16* wsn = wc + 64 * 64;
#pragma unroll
        for (int lt = 0; lt < 2; ++lt)
#pragma unroll
            for (int s = 0; s < 2; ++s) { o = mma32(ldg8p(wc + lt * 32 + 16 * s), eb[lt][0][s], o); o = mma32(ldg8p(wsn + lt * 32 + 16 * s), eb[lt][1][s], o); }
#pragma unroll
        for (int rg = 0; rg < 16; ++rg) { const int k2 = kt * 32 + DROW(rg, h);
            MIX[(size_t)(b * SEQ + k1 + 128 * k2) * 1024 + g * 64 + mh * 32 + li] = (bf16)(pk2(o[rg], 0.f) & 0xffffu); } }
}
__device__ __forceinline__ void fftc_item(const bf16* F, const bf16* FCT, const bf16* W256T, bf16* MIX, int item, int lane) {
    const int mh = item & 1, kb = (item >> 1) & 7, g = (item >> 4) & 3, b = item >> 6, li = lane & 31, h = lane >> 5;
    const bf16* fc = FCT + (size_t)(mh * 32 + li) * 64 + 8 * h; const bf16* fn = fc + 2 * 64 * 64;
    const bf16* wc = W256T + (size_t)(kb * 32 + li) * 256 + 4 * h; const bf16* wsn = wc + 256 * 256;
    f32x16 o = zero16();
#pragma unroll 1
    for (int lt = 0; lt < 8; ++lt) { f32x16 zr = zero16(), zi = zero16();
        const bf16* xp = F + (size_t)(LROWS + b * CTXL + lt * 32 + li) * 256 + g * 64 + 8 * h;
#pragma unroll
        for (int s = 0; s < 4; ++s) { const bf16x8 x = ldg8(xp + 16 * s); zr = mma32(x, ldg8(fc + 16 * s), zr); zi = mma32(x, ldg8(fn + 16 * s), zi); }
        o = mma32(ldg8p(wc + lt * 32), accB<0>(zr), o); o = mma32(ldg8p(wc + lt * 32 + 16), accB<1>(zr), o);
        o = mma32(ldg8p(wsn + lt * 32), accB<0>(zi), o); o = mma32(ldg8p(wsn + lt * 32 + 16), accB<1>(zi), o); }
#pragma unroll
    for (int rg = 0; rg < 16; ++rg) { const int k = kb * 32 + DROW(rg, h);
        MIX[(size_t)(LROWS + b * CTXL + k) * 1024 + g * 64 + mh * 32 + li] = (bf16)(pk2(o[rg], 0.f) & 0xffffu); }
}
__device__ __forceinline__ void row_ld_f32(const float* p, int lane, f32x4 (&v)[4]) {
#pragma unroll
    for (int j = 0; j < 4; ++j) v[j] = *(const f32x4*)(p + 256 * j + 4 * lane); }
__device__ __forceinline__ void row_ld_bf16(const bf16* p, int lane, f32x4 (&v)[4]) {
#pragma unroll
    for (int j = 0; j < 4; ++j) { const u32x2 w = *(const u32x2*)(p + 256 * j + 4 * lane); v[j] = (f32x4){bflo(w.x), bfhi(w.x), bflo(w.y), bfhi(w.y)}; } }
__device__ __forceinline__ void row_st_f32(float* p, int lane, const f32x4 (&v)[4]) {
#pragma unroll
    for (int j = 0; j < 4; ++j) *(f32x4*)(p + 256 * j + 4 * lane) = v[j]; }
__device__ __forceinline__ void row_st_bf16(bf16* p, int lane, const f32x4 (&v)[4]) {
#pragma unroll
    for (int j = 0; j < 4; ++j) { u32x2 w; w.x = pk2(v[j][0], v[j][1]); w.y = pk2(v[j][2], v[j][3]); *(u32x2*)(p + 256 * j + 4 * lane) = w; } }
__device__ __forceinline__ float row_rstd(const f32x4 (&v)[4]) { float s = 0.f;
#pragma unroll
    for (int j = 0; j < 4; ++j) s += (v[j][0] * v[j][0] + v[j][1] * v[j][1]) + (v[j][2] * v[j][2] + v[j][3] * v[j][3]);
    return __builtin_amdgcn_rsqf(wave_sum(s) * (1.f / 1024.f) + EPSN); }
__device__ __forceinline__ void row_modnorm(const f32x4 (&x)[4], const float* g, const float* sc, const float* sh, int lane, f32x4 (&hh)[4]) {
    const float rs = row_rstd(x); f32x4 gv[4], scv[4], shv[4]; row_ld_f32(g, lane, gv); row_ld_f32(sc, lane, scv); row_ld_f32(sh, lane, shv);
#pragma unroll
    for (int j = 0; j < 4; ++j) hh[j] = x[j] * rs * gv[j] * (scv[j] + 1.f) + shv[j]; }
__device__ __forceinline__ void row_resid(f32x4 (&x)[4], const f32x4 (&t)[4], const float* g, const float* gate, int lane) {
    const float rs = row_rstd(t); f32x4 gv[4], ga[4]; row_ld_f32(g, lane, gv); row_ld_f32(gate, lane, ga);
#pragma unroll
    for (int j = 0; j < 4; ++j) x[j] = x[j] + ga[j] * (t[j] * rs * gv[j]); }

__device__ __forceinline__ void transpose_item(const float* W, int ldw, int k0, int n0, bf16* dst, int ldd, float scale, LAS float* scr, int lane) {
#pragma unroll 8
    for (int i = 0; i < 32; ++i) { const int kk = 2 * i + (lane >> 5); scr[kk * 33 + (lane & 31)] = W[(size_t)(k0 + kk) * ldw + n0 + (lane & 31)]; }
    LDS_WAIT(); asm volatile("" ::: "memory");
    const int c = lane & 7;
#pragma unroll
    for (int j = 0; j < 4; ++j) { const int n = (lane >> 3) + 8 * j; const LAS float* s = scr + (8 * c) * 33 + n;
        u32x4 o; o.x = pk2(s[0 * 33] * scale, s[1 * 33] * scale); o.y = pk2(s[2 * 33] * scale, s[3 * 33] * scale); o.z = pk2(s[4 * 33] * scale, s[5 * 33] * scale); o.w = pk2(s[6 * 33] * scale, s[7 * 33] * scale);
        *(u32x4*)(dst + (size_t)n * ldd + k0 + 8 * c) = o; }
    LDS_WAIT(); asm volatile("" ::: "memory");
}
#ifndef MK_MODE
#define MK_MODE 1
#endif
#ifndef MK_LAST
#define MK_LAST 24
#endif
constexpr int NPHASE = 24;
struct Args { const float* in[31]; float* out; unsigned char* ws; int ph_lo, ph_hi, li, pad; };

__device__ __forceinline__ void cs2pi(int m, int N, float& c, float& s) { sincospif(2.0f * (float)(m % N) / (float)N, &s, &c); }

__global__ void __launch_bounds__(NTHREADS, 2) mk_fwd(Args args) {
    extern __shared__ __attribute__((aligned(16))) unsigned char lds_raw[];
    LAS unsigned char* lds = (LAS unsigned char*)lds_raw;
    const int tid0 = threadIdx.x, wave = __builtin_amdgcn_readfirstlane(tid0 >> 6);
    const int G = gridDim.x, bx = blockIdx.x, vcu = (G % 8 == 0) ? (bx % 8) * (G / 8) + bx / 8 : bx;
    const int wslot = wave * G + vcu, NW = G * NWAVES;
    volatile LAS unsigned* lctl = (volatile LAS unsigned*)(lds + LDSCTL_OFF);
    for (int u = tid0; u < (LDS_BYTES - LDSCTL_OFF) / 4; u += NTHREADS) lctl[u] = 0u;
    __syncthreads();
    const int lo = args.ph_lo, hi = args.ph_hi, bli = args.li;
    { XcdBarrier b0 = xcd_barrier_post((unsigned*)(args.ws + WS_CTL) + CW_BAR + bli * XCD_BAR_WORDS, lctl + LW_BAR); (void)b0; }
#define IN(k) (lo <= (k) && (k) < hi)
#define SEAM(k) do { if (IN(k) && IN((k) + 1)) { PH_BEGIN XcdBarrier b_; b_.bar = (unsigned*)(ws + WS_CTL) + CW_BAR + bli * XCD_BAR_WORDS; b_.x = xb_xcc_id(); b_.st = lctl + LW_BAR; xcd_barrier(b_); } } while (0)
#define PH_BEGIN int tid; { int l_; asm volatile("v_mbcnt_lo_u32_b32 %0, -1, 0\n\tv_mbcnt_hi_u32_b32 %0, -1, %0" : "=v"(l_)); tid = wave * 64 + (l_ & 63); } const CAS Args* ap_ = (const CAS Args*)__builtin_amdgcn_kernarg_segment_ptr(); asm volatile("" : "+s"(ap_)); unsigned char* ws = (unsigned char*)(GAS unsigned char*)ap_->ws; const int lane = tid & 63; (void)lane;
#define CAS __attribute__((address_space(4)))
#define AIN(k) ((const float*)(const GAS float*)ap_->in[k])
#define AOUT ((float*)(GAS float*)ap_->out)
#define MODp ((float*)(ws + CTL_MOD_OFF))
#define ctxbuf ((float*)(ws + WS_CTXBUF))
#define Hh ((bf16*)(ws + WS_H))
#define MIX ((bf16*)(ws + WS_MIX))
#define INP ((bf16*)(ws + WS_INP))
#define Tt ((bf16*)(ws + WS_T))

    if (IN(0)) { PH_BEGIN
        for (int it = bx; it < 64; it += G) {
            const int l = it >> 5, g = (it >> 1) & 15, dir = it & 1; const size_t pg = (size_t)(l * 2 + dir) * 16 + g;
            LAS f32x2* apow = (LAS f32x2*)lds; LAS f32x2* bbar = (LAS f32x2*)(lds + 17 * 64 * 8);
            if (tid < 64) { const int p = tid;
                const float are = AIN(8)[pg * 64 + p], aim = AIN(9)[pg * 64 + p], dt = expf(AIN(10)[pg]);
                for (int t = 0; t <= 16; ++t) { const float mag = expf(are * dt * (float)t); float sn, cs; sincosf(aim * dt * (float)t, &sn, &cs); apow[t * 64 + p] = (f32x2){mag * cs, mag * sn}; }
                const f32x2 a = apow[64 + p]; const float nr = a.x - 1.f, ni = a.y, den = 1.f / (are * are + aim * aim);
                const float cr = (nr * are + ni * aim) * den, ci = (ni * are - nr * aim) * den;
                for (int h = 0; h < 16; ++h) { const float br = AIN(11)[(pg * 64 + p) * 16 + h], bi = AIN(12)[(pg * 64 + p) * 16 + h]; bbar[p * 16 + h] = (f32x2){cr * br - ci * bi, cr * bi + ci * br}; }
                *(f32x2*)((float*)(ws + WS_A16) + (pg * 64 + p) * 2) = apow[16 * 64 + p];
            }
            __syncthreads();
            bf16* M1 = (bf16*)(ws + WS_S5M1) + ((size_t)(l * 16 + g) * 2 + dir) * 128 * 256;
            for (int v = tid; v < 4096; v += NTHREADS) { const int row = v >> 5, col0 = (v & 31) * 8, j = col0 >> 4, h0 = col0 & 15, p = row >> 1, ri = row & 1;
                const f32x2 pw = apow[(dir == 0 ? 15 - j : j) * 64 + p]; float vals[8];
#pragma unroll
                for (int hh = 0; hh < 8; ++hh) { const f32x2 bb = bbar[p * 16 + h0 + hh]; vals[hh] = ri ? pw.x * bb.y + pw.y * bb.x : pw.x * bb.x - pw.y * bb.y; }
                *(bf16x8*)(M1 + (size_t)row * 256 + col0) = pack8(vals); }
            bf16* TAB = (bf16*)(ws + WS_S5TAB) + (size_t)(l * 16 + g) * 256 * 512;
            for (int v = tid; v < 4096; v += NTHREADS) { const int row = v >> 4, cv = v & 15, i = row >> 4, ho = row & 15; float vals[8];
#pragma unroll
                for (int pp = 0; pp < 4; ++pp) { const int p = cv * 4 + pp; const float cre = AIN(13)[(pg * 16 + ho) * 64 + p], cim = AIN(14)[(pg * 16 + ho) * 64 + p];
                    const f32x2 pw = apow[(dir == 0 ? i + 1 : 16 - i) * 64 + p]; vals[2 * pp] = cre * pw.x - cim * pw.y; vals[2 * pp + 1] = -(cre * pw.y + cim * pw.x); }
                *(bf16x8*)(TAB + (size_t)row * 512 + 256 + dir * 128 + cv * 8) = pack8(vals); }
            float* Kt = (float*)(ws + WS_S5K) + ((size_t)(l * 16 + g) * 2 + dir) * 16 * 256;
            for (int e = tid; e < 4096; e += NTHREADS) { const int t = e >> 8, ho = (e >> 4) & 15, h = e & 15; float acc = 0.f;
                for (int p = 0; p < 64; ++p) { const float cre = AIN(13)[(pg * 16 + ho) * 64 + p], cim = AIN(14)[(pg * 16 + ho) * 64 + p]; const f32x2 pw = apow[t * 64 + p], bb = bbar[p * 16 + h];
                    const float xr = cre * pw.x - cim * pw.y, xi = cre * pw.y + cim * pw.x; acc += xr * bb.x - xi * bb.y; }
                Kt[e] = acc; }
            __syncthreads();
        }
        { LAS float* scr = (LAS float*)(lds + wave * 16384);
          for (int it = wslot; it < 56000; it += NW) {
            const float* src; int ldw, kb, n0, ldd; bf16* dst; float scale = 1.f;
            if (it < 43008) { const int e = it / 5376, r = it % 5376, w = r / 1792, li = r % 1792;
                if (w < 2) { src = AIN(28 + w) + (size_t)e * 1024 * DFE; ldw = DFE; kb = li / 112; n0 = (li % 112) * 32; ldd = 1024;
                    dst = (bf16*)(ws + WS_MOE1) + ((size_t)e * 7168 + 256 * (n0 / 128) + (n0 % 128) + 128 * w) * 1024; }
                else { src = AIN(30) + (size_t)e * DFE * 1024; ldw = 1024; kb = li / 32; n0 = (li % 32) * 32; ldd = DFE; dst = (bf16*)(ws + WS_MOE2) + ((size_t)e * 1024 + n0) * DFE; }
            } else if (it < 47232) { const int r = it - 43008, w = r / 1408, li = r % 1408;
                if (w < 2) { src = AIN(23 + w); ldw = DFF; kb = li / 88; n0 = (li % 88) * 32; ldd = 1024; dst = (bf16*)(ws + WS_FFN1) + (size_t)(256 * (n0 / 128) + (n0 % 128) + 128 * w) * 1024; }
                else { src = AIN(25); ldw = 1024; kb = li / 32; n0 = (li % 32) * 32; ldd = DFF; dst = (bf16*)(ws + WS_FFN2) + (size_t)n0 * DFF; }
            } else { const int r = it - 47232, l = r / 4384, q = r % 4384;
                if (q < 3328) { const int t = q / 128, li = q % 128; kb = li / 8; const int nb = li % 8;
                    const int srcc = t < 4 ? 256 * t : (t < 7 ? 256 * (t + 1) : (t < 23 ? 2304 + 256 * (t - 7) : (t == 23 ? 768 : (t == 24 ? 1024 : 2048))));
                    src = AIN(7) + (size_t)l * 1024 * 6400; ldw = 6400; n0 = srcc + 32 * nb; ldd = 1024; dst = (bf16*)(ws + WS_WIN) + ((size_t)(l * 26 + t) * 256 + 32 * nb) * 1024; scale = (t == 3 || t == 23) ? 0.125f : 1.f; }
                else if (q < 3360) { const int li = q - 3328; kb = li / 8; n0 = (li % 8) * 32; src = AIN(16) + (size_t)l * 65536; ldw = 256; ldd = 256; dst = (bf16*)(ws + WS_WGLU) + ((size_t)l * 256 + n0) * 256; }
                else if (q < 3872) { const int li = q - 3360, bb = li / 128, li2 = li % 128; kb = li2 / 32; n0 = (li2 % 32) * 32; src = AIN(21) + (size_t)(l * 4 + bb) * 256 * 1024; ldw = 1024; ldd = 256; dst = (bf16*)(ws + WS_WBR) + ((size_t)(l * 4 + bb) * 1024 + n0) * 256; }
                else { const int li = q - 3872; kb = li / 32; n0 = (li % 32) * 32; src = AIN(22) + (size_t)l * 1024 * 1024; ldw = 1024; ldd = 1024; dst = (bf16*)(ws + WS_WOUT) + ((size_t)l * 1024 + n0) * 1024; }
            }
            transpose_item(src, ldw, kb * 64, n0, dst, ldd, scale, scr, lane);
          } }
        __syncthreads();
        for (int it = bx; it < 192; it += G) { const int l = it / 96, cb = it % 96, col = cb * 64 + lane, ks = wave;
            const float* wm = AIN(4) + ((size_t)l * 1024 + ks * 128) * 6144 + col; float a0 = 0.f, a1 = 0.f, a2 = 0.f;
#pragma unroll 8
            for (int k = 0; k < 128; ++k) { const float w = wm[(size_t)k * 6144]; const int kk = ks * 128 + k;
                const float c0 = AIN(1)[kk], c1 = AIN(1)[1024 + kk], c2 = AIN(3)[kk];
                a0 += w * (c0 / (1.f + __expf(-c0))); a1 += w * (c1 / (1.f + __expf(-c1))); a2 += w * (c2 / (1.f + __expf(-c2))); }
            LAS float* part = (LAS float*)lds;
            part[(wave * 3 + 0) * 64 + lane] = a0; part[(wave * 3 + 1) * 64 + lane] = a1; part[(wave * 3 + 2) * 64 + lane] = a2;
            __syncthreads();
            if (tid < 192) { const int i = tid >> 6, c = tid & 63; float sacc = AIN(5)[l * 6144 + cb * 64 + c];
#pragma unroll
                for (int w = 0; w < 8; ++w) sacc += part[(w * 3 + i) * 64 + c];
                MODp[(size_t)(l * 3 + i) * 6144 + cb * 64 + c] = sacc; }
            __syncthreads();
        }
        for (int v = wslot * 64 + lane; v < 32 * SEQ; v += NW * 64) { const int p = v >> 13, t = v & 8191; const float pos = (float)(p < 16 ? (t >> 6) : (t & 63));
            const float inv = 1.0f / powf(10000.f, (float)(p & 15) / 16.f); float sn, cs; sincosf(pos * inv, &sn, &cs);
            ((float*)(ws + WS_COST))[v] = cs; ((float*)(ws + WS_SINT))[v] = sn; ((float*)(ws + WS_COSN))[t * 32 + p] = cs; ((float*)(ws + WS_SINN))[t * 32 + p] = sn; }
        for (int v = wslot * 64 + lane; v < 192512; v += NW * 64) { float c, s;
            if (v < 32768) { const int ri = v >> 14, k1 = (v >> 7) & 127, l1 = v & 127; cs2pi(k1 * l1, 128, c, s); const float sc = 0.08838834764831845f;
                ((bf16*)(ws + WS_W128T))[v] = (bf16)(pk2(ri ? -s * sc : c * sc, 0.f) & 0xffffu); }
            else if (v < 40960) { const int u = v - 32768, l2 = u >> 7, k1 = u & 127; cs2pi(k1 * l2, 8192, c, s); ((float*)(ws + WS_TWC))[u] = c; ((float*)(ws + WS_TWS))[u] = s; }
            else if (v < 53248) { const int u = v - 40960, w = u >> 12, m = (u >> 6) & 63, cc = u & 63; cs2pi(m * cc, 64, c, s);
                ((bf16*)(ws + WS_FCT))[u] = (bf16)(pk2((w == 0 ? c : (w == 1 ? s : -s)) * 0.125f, 0.f) & 0xffffu); }
            else if (v < 61440) { const int u = v - 53248, w = u >> 12, k2 = (u >> 6) & 63, l2 = u & 63; cs2pi(k2 * l2, 64, c, s); ((bf16*)(ws + WS_W64T))[u] = (bf16)(pk2((w == 0 ? c : s) * 0.125f, 0.f) & 0xffffu); }
            else { const int u = v - 61440, w = u >> 16, k = (u >> 8) & 255, l = u & 255; cs2pi(k * l, 256, c, s); ((bf16*)(ws + WS_W256T))[u] = (bf16)(pk2((w == 0 ? c : s) * 0.0625f, 0.f) & 0xffffu); }
        }
    }
    SEAM(0);

    if (IN(1)) { PH_BEGIN
        for (int v = wslot * 64 + lane; v < 262144; v += NW * 64) { const int l = v >> 17, g = (v >> 13) & 15, row = (v >> 5) & 255, col0 = (v & 31) * 8, i = row >> 4, ho = row & 15, j = col0 >> 4, h0 = col0 & 15;
            const float* Kf = (const float*)(ws + WS_S5K) + ((size_t)(l * 16 + g) * 2) * 16 * 256; const float* Kr = Kf + 16 * 256; float vals[8];
#pragma unroll
            for (int hh = 0; hh < 8; ++hh) { const int h = h0 + hh;
                vals[hh] = j < i ? Kf[(i - j) * 256 + ho * 16 + h] : (j > i ? Kr[(j - i) * 256 + ho * 16 + h] : Kf[ho * 16 + h] + Kr[ho * 16 + h] + (ho == h ? AIN(15)[l * 256 + g * 16 + h] : 0.f)); }
            *(bf16x8*)((bf16*)(ws + WS_S5TAB) + ((size_t)(l * 16 + g) * 256 + row) * 512 + col0) = pack8(vals); }
        for (int r = wslot; r < R; r += NW) { const int ci = r < SEQ ? 0 : (r < LROWS ? 1 : 2);
            f32x4 x[4], hh[4]; row_ld_f32(r < LROWS ? AIN(0) + (size_t)r * D : AIN(2) + (size_t)(r - LROWS) * D, lane, x);
            const float* md = MODp + (size_t)ci * 6144;
            row_modnorm(x, AIN(6), md + 1024, md, lane, hh); row_st_bf16(Hh + (size_t)r * D, lane, hh); }
    }
    SEAM(1);

    for (int layer = 0; layer < 2; ++layer) {
        const int pb = 1 + 11 * layer;
        const int nM = layer == 0 ? 66 : 64;
        const int nrows = layer == 0 ? R : LROWS;
#define normg (AIN(6) + (size_t)layer * 4 * D)
        if (IN(pb + 1)) { PH_BEGIN
            gp::SchedInprojA S{(const char*)Hh, (const char*)(ws + WS_WIN) + (size_t)layer * 26 * 256 * 2048, 66, G, bx};
            gp::EpiInprojA E{INP, Tt};
            gp::gemm_phase(lds, tid, 1024, 1024, 1024, S, E);
        }
        SEAM(pb + 1);
        if (IN(pb + 2)) { PH_BEGIN
            for (int it = wslot; it < 2096; it += NW) {
                if (it < 1056) s5_state_item((const bf16*)(ws + WS_S5M1) + (size_t)layer * 16 * 2 * 128 * 256, INP + (size_t)R * 256, (float*)(ws + WS_HLOC), it, lane);
                else if (it < 1584) ret_kv_item(Tt, Tt + (size_t)256 * R, (const float*)(ws + WS_COST), (const float*)(ws + WS_SINT), AIN(18) + layer * 8, (float*)(ws + WS_KV), it - 1056, lane);
                else fft1_item(INP, (const bf16*)(ws + WS_W128T), (const float*)(ws + WS_TWC), (const float*)(ws + WS_TWS), (bf16*)(ws + WS_FB), it - 1584, lane);
            }
        }
        SEAM(pb + 2);
        if (IN(pb + 3)) { PH_BEGIN
            LAS float* rpb = (LAS float*)lds;
            for (int i = tid; i < 1860; i += NTHREADS) rpb[i] = AIN(20)[layer * 1860 + i];
            __syncthreads();
            const int nit = 64 + 1024 + 2048 + (layer == 0 ? 64 : 0);
            for (int it = wslot; it < nit; it += NW) {
                if (it < 64) s5_scan_item((const float*)(ws + WS_A16) + (size_t)layer * 2 * 16 * 64 * 2, (const float*)(ws + WS_HLOC), (bf16*)(ws + WS_HIN), it, lane);
                else if (it < 1088) ret_scan_item(AIN(18) + layer * 8, (const float*)(ws + WS_KV), (bf16*)(ws + WS_SPREV), it - 64, lane);
                else if (it < 3136) { const int j = it - 1088; na_item(INP + (size_t)5 * R * 256, INP + (size_t)6 * R * 256, Tt + (size_t)512 * R, MIX, rpb, false, j >> 10, (j >> 3) & 127, (j >> 1) & 3, j & 1, lane); }
                else { const int j = it - 3136; na_item(INP + (size_t)5 * R * 256, INP + (size_t)6 * R * 256, Tt + (size_t)512 * R, MIX, rpb, true, j >> 5, 0, (j >> 3) & 3, j & 7, lane); }
            }
            __syncthreads();
        }
        SEAM(pb + 3);
        if (IN(pb + 4)) { PH_BEGIN
            const int nit = 1056 + 2112 + 2048 + (layer == 0 ? 128 : 0);
            for (int it = wslot; it < nit; it += NW) {
                if (it < 1056) s5_out_item((const bf16*)(ws + WS_S5TAB) + (size_t)layer * 16 * 256 * 512, INP + (size_t)R * 256, (const bf16*)(ws + WS_HIN), (bf16*)(ws + WS_Z), it, lane);
                else if (it < 3168) ret_out_item(INP + (size_t)2 * R * 256, INP + (size_t)3 * R * 256, INP + (size_t)4 * R * 256, Tt + (size_t)256 * R, (const bf16*)(ws + WS_SPREV),
                                                 (const float*)(ws + WS_COSN), (const float*)(ws + WS_SINN), AIN(18) + layer * 8, AIN(19) + layer * 256, MIX, it - 1056, lane);
                else if (it < 5216) fft2_item((const bf16*)(ws + WS_FB), (const bf16*)(ws + WS_FCT), (const bf16*)(ws + WS_W64T), MIX, it - 3168, lane);
                else fftc_item(INP, (const bf16*)(ws + WS_FCT), (const bf16*)(ws + WS_W256T), MIX, it - 5216, lane);
            }
        }
        SEAM(pb + 4);
        if (IN(pb + 5)) { PH_BEGIN
            { PH_BEGIN gp::SchedPlain S{(const char*)(ws + WS_Z), (const char*)(ws + WS_WGLU) + (size_t)layer * 256 * 512, (size_t)256 * 512, (size_t)256 * 512, nM, 1, G, bx};
              gp::EpiGlu E{(const bf16*)(ws + WS_Z), MIX, AIN(17) + layer * 256};
              gp::gemm_phase(lds, tid, 256, 256, 256, S, E); }
            { PH_BEGIN gp::SchedPlain S{(const char*)Hh, (const char*)(ws + WS_WIN) + ((size_t)layer * 26 + 7) * 256 * 2048, (size_t)256 * 2048, (size_t)256 * 2048, nM, 16, G, bx};
              gp::EpiGates E{(bf16*)(ws + WS_GATES)};
              gp::gemm_phase(lds, tid, 1024, 1024, 1024, S, E); }
        }
        SEAM(pb + 5);
        if (IN(pb + 6)) { PH_BEGIN
            gp::SchedMerge S{(const char*)MIX, (const char*)(ws + WS_WBR) + (size_t)layer * 4 * 1024 * 512, nM, G, bx};
            gp::EpiMerge E{(const bf16*)(ws + WS_GATES), (bf16*)(ws + WS_Y)};
            gp::gemm_phase(lds, tid, 256, 1024, 256, S, E);
        }
        SEAM(pb + 6);
        if (IN(pb + 7)) { PH_BEGIN
            gp::SchedPlain S{(const char*)(ws + WS_Y), (const char*)(ws + WS_WOUT) + (size_t)layer * 1024 * 2048, (size_t)256 * 2048, (size_t)256 * 2048, nM, 4, G, bx};
            gp::EpiPlain E{(bf16*)(ws + WS_YO), 1024};
            gp::gemm_phase(lds, tid, 1024, 1024, 1024, S, E);
        }
        SEAM(pb + 7);
        if (IN(pb + 8)) { PH_BEGIN
            if (layer == 0) {
                for (int r = wslot; r < R; r += NW) { const int ci = r < SEQ ? 0 : (r < LROWS ? 1 : 2); const float* md = MODp + (size_t)ci * 6144;
                    f32x4 x[4], t[4], hh[4]; row_ld_f32(r < LROWS ? AIN(0) + (size_t)r * D : AIN(2) + (size_t)(r - LROWS) * D, lane, x);
                    row_ld_bf16((const bf16*)(ws + WS_YO) + (size_t)r * D, lane, t);
                    row_resid(x, t, normg + D, md + 2048, lane);
                    row_st_f32(r < LROWS ? AOUT + (size_t)r * D : ctxbuf + (size_t)(r - LROWS) * D, lane, x);
                    row_modnorm(x, normg + 2 * D, md + 4096, md + 3072, lane, hh); row_st_bf16(Hh + (size_t)r * D, lane, hh); }
            } else {
                LAS float* wrs = (LAS float*)lds; LAS int* rowinfo = (LAS int*)(lds + 32768); LAS unsigned* cntL = (LAS unsigned*)(lds + 32768 + 1024); LAS unsigned* baseL = cntL + 8;
                for (int i = tid; i < 2048; i += NTHREADS) ((LAS f32x4*)wrs)[i] = ((const f32x4*)AIN(26))[i];
                int* list = (int*)(ws + WS_LIST); float* routew = (float*)(ws + WS_ROUTEW);
                for (int grp = vcu; grp < 256; grp += G) {
                    if (tid < 8) cntL[tid] = 0u;
                    __syncthreads();
                    for (int rr = 0; rr < 8; ++rr) { const int r = grp * 64 + wave * 8 + rr; const float* md = MODp + (size_t)(3 + (r < SEQ ? 0 : 1)) * 6144;
                        f32x4 x[4], t[4], hh[4]; row_ld_f32(AOUT + (size_t)r * D, lane, x); row_ld_bf16((const bf16*)(ws + WS_YO) + (size_t)r * D, lane, t);
                        row_resid(x, t, normg + D, md + 2048, lane); row_st_f32(AOUT + (size_t)r * D, lane, x);
                        row_modnorm(x, normg + 2 * D, md + 4096, md + 3072, lane, hh); row_st_bf16(Hh + (size_t)r * D, lane, hh);
                        float lg[8];
#pragma unroll
                        for (int e = 0; e < 8; ++e) lg[e] = 0.f;
#pragma unroll
                        for (int j = 0; j < 4; ++j)
#pragma unroll
                            for (int q = 0; q < 4; ++q) { const int k = 256 * j + 4 * lane + q; const f32x4 w0 = *(const LAS f32x4*)(wrs + k * 8), w1 = *(const LAS f32x4*)(wrs + k * 8 + 4); const float hv = hh[j][q];
                                lg[0] += hv * w0[0]; lg[1] += hv * w0[1]; lg[2] += hv * w0[2]; lg[3] += hv * w0[3]; lg[4] += hv * w1[0]; lg[5] += hv * w1[1]; lg[6] += hv * w1[2]; lg[7] += hv * w1[3]; }
#pragma unroll
                        for (int e = 0; e < 8; ++e) lg[e] = wave_sum(lg[e]) + AIN(27)[e];
                        int i0 = 0; float v0 = lg[0];
#pragma unroll
                        for (int e = 1; e < 8; ++e) if (lg[e] > v0) { v0 = lg[e]; i0 = e; }
                        int i1 = i0 == 0 ? 1 : 0; float v1 = i0 == 0 ? lg[1] : lg[0];
#pragma unroll
                        for (int e = 0; e < 8; ++e) if (e != i0 && lg[e] > v1) { v1 = lg[e]; i1 = e; }
                        const float w0 = 1.f / (1.f + __expf(v1 - v0)), w1 = 1.f - w0;
                        if (lane == 0) { const unsigned s0 = __hip_atomic_fetch_add(cntL + i0, 1u, __ATOMIC_RELAXED, __HIP_MEMORY_SCOPE_WORKGROUP), s1 = __hip_atomic_fetch_add(cntL + i1, 1u, __ATOMIC_RELAXED, __HIP_MEMORY_SCOPE_WORKGROUP);
                            LAS int* ri = rowinfo + (wave * 8 + rr) * 4; ri[0] = i0; ri[1] = (int)s0; ri[2] = i1; ri[3] = (int)s1; routew[(size_t)r * 2] = w0; routew[(size_t)r * 2 + 1] = w1; }
                    }
                    __syncthreads();
                    if (tid < 8) baseL[tid] = __hip_atomic_fetch_add((unsigned*)(ws + WS_CTL) + CW_MOECNT + 64 * tid, cntL[tid], __ATOMIC_RELAXED, __HIP_MEMORY_SCOPE_AGENT);
                    __syncthreads();
                    if (tid < 64) { const LAS int* ri = rowinfo + tid * 4; const int r = grp * 64 + tid;
                        list[ri[0] * LCAP + (int)baseL[ri[0]] + ri[1]] = r * 2; list[ri[2] * LCAP + (int)baseL[ri[2]] + ri[3]] = r * 2 + 1; }
                    __syncthreads();
                }
            }
        }
        SEAM(pb + 8);
        LAS unsigned* mt = (LAS unsigned*)(lds + LDSCTL_OFF) + LW_MOE;
        if (layer == 1 && (IN(pb + 9) || IN(pb + 10))) { PH_BEGIN
            if (tid == 0) { unsigned off = 0u;
                for (int e = 0; e < 8; ++e) { const unsigned c = __hip_atomic_load((unsigned*)(ws + WS_CTL) + CW_MOECNT + 64 * e, __ATOMIC_RELAXED, __HIP_MEMORY_SCOPE_AGENT); const unsigned m = (c + 255u) >> 8; mt[e] = c; mt[8 + e] = m; mt[16 + e] = off; off += m; }
                mt[24] = off; }
            __syncthreads();
        }
        if (IN(pb + 9)) { PH_BEGIN
            if (layer == 0) {
                gp::SchedPlain S{(const char*)Hh, (const char*)(ws + WS_FFN1), (size_t)256 * 2048, (size_t)256 * 2048, 66, 22, G, bx};
                gp::EpiSwiglu E{(bf16*)(ws + WS_HID), DFF, false};
                gp::gemm_phase(lds, tid, 1024, 1024, 1024, S, E);
            } else {
                gp::SchedMoe1 S{(const char*)Hh, (const char*)(ws + WS_MOE1), (const int*)(ws + WS_LIST), mt, G, bx};
                gp::EpiSwiglu E{(bf16*)(ws + WS_MHID), DFE, true};
                gp::gemm_phase(lds, tid, 1024, 1024, 1024, S, E);
            }
        }
        SEAM(pb + 9);
        if (IN(pb + 10)) { PH_BEGIN
            if (layer == 0) {
                gp::SchedPlain S{(const char*)(ws + WS_HID), (const char*)(ws + WS_FFN2), (size_t)256 * DFF * 2, (size_t)256 * DFF * 2, 66, 4, G, bx};
                gp::EpiPlain E{(bf16*)(ws + WS_FO), 1024};
                gp::gemm_phase(lds, tid, DFF, DFF, DFF, S, E);
            } else {
                gp::SchedMoe2 S{(const char*)(ws + WS_MHID), (const char*)(ws + WS_MOE2), mt, G, bx};
                gp::EpiMoeDown E{(bf16*)(ws + WS_SLOT), (const int*)(ws + WS_LIST), (const float*)(ws + WS_ROUTEW), mt};
                gp::gemm_phase(lds, tid, DFE, DFE, DFE, S, E);
            }
        }
        SEAM(pb + 10);
        if (IN(pb + 11)) { PH_BEGIN
            for (int r = wslot; r < nrows; r += NW) { const int ci = r < SEQ ? 0 : (r < LROWS ? 1 : 2); const float* md = MODp + (size_t)(layer * 3 + ci) * 6144;
                float* xp = r < LROWS ? AOUT + (size_t)r * D : ctxbuf + (size_t)(r - LROWS) * D;
                f32x4 x[4], t[4]; row_ld_f32(xp, lane, x);
                if (layer == 0) row_ld_bf16((const bf16*)(ws + WS_FO) + (size_t)r * D, lane, t);
                else { f32x4 t2[4]; row_ld_bf16((const bf16*)(ws + WS_SLOT) + (size_t)r * D, lane, t); row_ld_bf16((const bf16*)(ws + WS_SLOT) + ((size_t)LROWS + r) * D, lane, t2);
#pragma unroll
                    for (int j = 0; j < 4; ++j) t[j] = t[j] + t2[j]; }
                row_resid(x, t, normg + 3 * D, md + 5120, lane); row_st_f32(xp, lane, x);
                if (layer == 0) { f32x4 hh[4]; const float* md1 = MODp + (size_t)(3 + ci) * 6144; row_modnorm(x, AIN(6) + 4 * D, md1 + 1024, md1, lane, hh); row_st_bf16(Hh + (size_t)r * D, lane, hh); } }
        }
        SEAM(pb + 11);
    }
#undef IN
#undef SEAM
#undef PH_BEGIN
#undef normg
#undef AIN
#undef AOUT
#undef MODp
#undef ctxbuf
#undef Hh
#undef MIX
#undef INP
#undef Tt
}

__global__ void dumpk(const unsigned char* src, size_t nbytes, int isf32, float* out, size_t N, int accum) {
    const size_t i = (size_t)blockIdx.x * blockDim.x + threadIdx.x; if (i >= N) return;
    const size_t ne = isf32 ? nbytes / 4 : nbytes / 2; float s = 0.f;
    for (size_t k = i; k < ne; k += N) s += isf32 ? ((const float*)src)[k] : bf2f(((const bf16*)src)[k]);
    out[i] = accum ? out[i] + s : s;
}
extern "C" void kernel_launch(void* const* d_in, const int* in_sizes, int n_in, void* d_out, int out_size, void* d_ws, size_t ws_size, hipStream_t stream) {
    static int grid = 0;
    if (grid == 0) {
        if (n_in != 31 || out_size != LROWS * D || ws_size < WS_END) { fprintf(stderr, "kernel_launch: unexpected shapes (n_in %d, out %d, ws %zu < %zu)\n", n_in, out_size, ws_size, (size_t)WS_END); grid = -1; return; }
        int dev = 0, cus = 0, per_cu = 0;
        if (hipGetDevice(&dev) != hipSuccess || hipDeviceGetAttribute(&cus, hipDeviceAttributeMultiprocessorCount, dev) != hipSuccess) { grid = -1; return; }
        if (hipFuncSetAttribute((const void*)mk_fwd, hipFuncAttributeMaxDynamicSharedMemorySize, LDS_BYTES) != hipSuccess) { fprintf(stderr, "kernel_launch: hipFuncSetAttribute failed\n"); grid = -1; return; }
        if (hipOccupancyMaxActiveBlocksPerMultiprocessor(&per_cu, (const void*)mk_fwd, NTHREADS, LDS_BYTES) != hipSuccess || per_cu < 1) { fprintf(stderr, "kernel_launch: occupancy query says %d\n", per_cu); }
        (void)hipGetLastError();
        grid = cus;
    }
    if (grid < 0) return;
    (void)hipMemsetAsync((char*)d_ws + WS_CTL, 0, CTL_ZERO_BYTES, stream);
    Args a{};
    for (int i = 0; i < 31; ++i) a.in[i] = (const float*)d_in[i];
    a.out = (float*)d_out; a.ws = (unsigned char*)d_ws;
#if MK_MODE == 1
    a.ph_lo = 0; a.ph_hi = NPHASE; a.li = 0;
    hipLaunchKernelGGL(mk_fwd, dim3(grid), dim3(NTHREADS), LDS_BYTES, stream, a);
#else
    for (int p = 0; p < MK_LAST; ++p) { a.ph_lo = p; a.ph_hi = p + 1; a.li = p; hipLaunchKernelGGL(mk_fwd, dim3(grid), dim3(NTHREADS), LDS_BYTES, stream, a); }
#endif
#ifdef MK_DUMP_OFF
    dumpk<<<(LROWS * D + 255) / 256, 256, 0, stream>>>((const unsigned char*)d_ws + (size_t)(MK_DUMP_OFF), (size_t)(MK_DUMP_BYTES), MK_DUMP_F32, (float*)d_out, (size_t)LROWS * D, 0);
#endif
#ifdef MK_DUMP2_OFF
    dumpk<<<(LROWS * D + 255) / 256, 256, 0, stream>>>((const unsigned char*)d_ws + (size_t)(MK_DUMP2_OFF), (size_t)(MK_DUMP2_BYTES), MK_DUMP2_F32, (float*)d_out, (size_t)LROWS * D, 1);
#endif
#ifdef MK_DUMP3_OFF
    dumpk<<<(LROWS * D + 255) / 256, 256, 0, stream>>>((const unsigned char*)d_ws + (size_t)(MK_DUMP3_OFF), (size_t)(MK_DUMP3_BYTES), MK_DUMP3_F32, (float*)d_out, (size_t)LROWS * D, 1);
#endif
}
```

```cpp
#define MK_MODE 1
#include <hip/hip_runtime.h>
#include <cstdio>
#include <cstdint>

#define GAS __attribute__((address_space(1)))
#define LAS __attribute__((address_space(3)))
typedef unsigned short bf16;
typedef short bf16x8 __attribute__((ext_vector_type(8)));
typedef short bf16x4 __attribute__((ext_vector_type(4)));
typedef float f32x2 __attribute__((ext_vector_type(2)));
typedef float f32x4 __attribute__((ext_vector_type(4)));
typedef float f32x16 __attribute__((ext_vector_type(16)));
typedef unsigned u32x2 __attribute__((ext_vector_type(2)));
typedef unsigned u32x4 __attribute__((ext_vector_type(4)));

constexpr int D = 1024, SEQ = 8192, LROWS = 16384, CTXL = 256, CROWS = 512, R = 16896;
constexpr int DFF = 2816, DFE = 3584, NEXP = 8, LCAP = 16640;
constexpr int NWAVES = 8, NTHREADS = 512;
constexpr int NCH16 = R / 16;
constexpr float EPSN = 1e-6f, LOG2E = 1.4426950408889634f;

constexpr size_t MiB = 1u << 20;
constexpr size_t WS_CTL = 0, CTL_ZERO_BYTES = 1 * MiB;
constexpr int CW_TMO = 0, CW_BAR = 4096, CW_MOECNT = 98304, CW_QHEAD = 100352;
constexpr size_t CTL_MOD_OFF = 512 * 1024;
constexpr size_t WS_CTXBUF = 1 * MiB;
constexpr size_t WS_COST = 3 * MiB, WS_SINT = 4 * MiB, WS_COSN = 5 * MiB, WS_SINN = 6 * MiB;
constexpr size_t WS_LIST = 7 * MiB;
constexpr size_t WS_ROUTEW = WS_LIST + 8 * LCAP * 4;
constexpr size_t WS_S5K = 8 * MiB;
constexpr size_t WS_A16 = 9 * MiB;
constexpr size_t WS_W128T = WS_A16 + 64 * 1024;
constexpr size_t WS_TWC = WS_W128T + 64 * 1024, WS_TWS = WS_TWC + 32 * 1024;
constexpr size_t WS_FCT = WS_TWS + 32 * 1024;
constexpr size_t WS_W64T = WS_FCT + 32 * 1024;
constexpr size_t WS_W256T = WS_W64T + 32 * 1024;
constexpr size_t WS_MOE1 = 10 * MiB;
constexpr size_t WS_MOE2 = 122 * MiB;
constexpr size_t WS_OTHERW = 178 * MiB;
constexpr size_t WS_WIN = 178 * MiB;
constexpr size_t WS_WBR = 204 * MiB;
constexpr size_t WS_WOUT = 208 * MiB;
constexpr size_t WS_WGLU = 212 * MiB;
constexpr size_t WS_FFN1 = 213 * MiB;
constexpr size_t WS_FFN2 = 224 * MiB;
constexpr size_t WS_S5M1 = 230 * MiB;
constexpr size_t WS_S5TAB = 234 * MiB;
constexpr size_t WS_BIG = 242 * MiB;
constexpr size_t TOK256 = (size_t)R * 256 * 2;
constexpr size_t WS_INP = WS_BIG;
constexpr size_t WS_T = WS_INP + 7 * TOK256;
constexpr size_t WS_HLOC = WS_T + 3 * TOK256;
constexpr size_t WS_HIN = WS_HLOC + 2 * TOK256;
constexpr size_t WS_KV = WS_HIN + TOK256;
constexpr size_t WS_SPREV = WS_KV + 2 * TOK256;
constexpr size_t WS_FB = WS_SPREV + TOK256;
constexpr size_t WS_GATES = WS_BIG;
constexpr size_t WS_Y = WS_BIG + 132 * MiB;
constexpr size_t WS_YO = WS_Y + 33 * MiB;
constexpr size_t WS_Z = WS_YO + 33 * MiB;
constexpr size_t WS_FO = WS_Y;
constexpr size_t WS_HID = WS_BIG;
constexpr size_t WS_MHID = WS_OTHERW;
constexpr size_t WS_H = 449 * MiB;
constexpr size_t WS_MIX = 482 * MiB;
constexpr size_t WS_SLOT = WS_H;
constexpr size_t WS_GCTX = 515 * MiB;
constexpr size_t WS_END = 519 * MiB;
static_assert(WS_FB + 16 * MiB <= WS_Z && WS_Z + TOK256 <= WS_H && WS_MHID + (size_t)34816 * 3584 * 2 <= WS_H && WS_W256T + 256 * 1024 <= WS_MOE1, "ws map");
static_assert(WS_S5TAB + 8 * MiB <= WS_BIG && WS_FFN2 + (size_t)1024 * 2816 * 2 <= WS_S5M1 && WS_ROUTEW + 32768 * 4 <= WS_S5K, "ws map 2");

constexpr int RING_BYTES = 131072, LDSCTL_OFF = RING_BYTES, LDS_BYTES = 147456;
constexpr int LW_BAR = 8, LW_MOE = 16;

#define VM_WAIT() asm volatile("s_waitcnt vmcnt(0)" ::: "memory")
#define LDS_WAIT() asm volatile("s_waitcnt lgkmcnt(0)" ::: "memory")
typedef __bf16 bf16n2 __attribute__((ext_vector_type(2)));
__device__ __forceinline__ unsigned pk2(float lo, float hi) { bf16n2 v; v.x = (__bf16)lo; v.y = (__bf16)hi; return __builtin_bit_cast(unsigned, v); }
__device__ __forceinline__ float bf2f(unsigned short b) { return __builtin_bit_cast(float, ((unsigned)b) << 16); }
__device__ __forceinline__ float bflo(unsigned w) { return __builtin_bit_cast(float, w << 16); }
__device__ __forceinline__ float bfhi(unsigned w) { return __builtin_bit_cast(float, w & 0xffff0000u); }
__device__ __forceinline__ float ex2(float x) { return __builtin_amdgcn_exp2f(x); }
__device__ __forceinline__ float rcpf_(float x) { return __builtin_amdgcn_rcpf(x); }
__device__ __forceinline__ float sigm(float x) { return rcpf_(1.f + ex2(-LOG2E * x)); }
__device__ __forceinline__ float silu_(float x) { return x * sigm(x); }
__device__ __forceinline__ float gelu_tanh(float x) { const float u = 0.7978845608028654f * (x + 0.044715f * x * x * x); const float t = 1.f - 2.f * rcpf_(1.f + ex2(2.885390081777927f * u)); return 0.5f * x * (1.f + t); }
__device__ __forceinline__ float xor32_sum(float v) { const unsigned u = __builtin_bit_cast(unsigned, v); const auto r = __builtin_amdgcn_permlane32_swap(u, u, false, false); return __builtin_bit_cast(float, (unsigned)r[0]) + __builtin_bit_cast(float, (unsigned)r[1]); }
__device__ __forceinline__ float xor32_max(float v) { const unsigned u = __builtin_bit_cast(unsigned, v); const auto r = __builtin_amdgcn_permlane32_swap(u, u, false, false); return fmaxf(__builtin_bit_cast(float, (unsigned)r[0]), __builtin_bit_cast(float, (unsigned)r[1])); }
template <int X> __device__ __forceinline__ float swz_xor(float v) { return __builtin_bit_cast(float, __builtin_amdgcn_ds_swizzle(__builtin_bit_cast(int, v), (X << 10) | 0x1f)); }
__device__ __forceinline__ float wave_sum(float v) { v += swz_xor<1>(v); v += swz_xor<2>(v); v += swz_xor<4>(v); v += swz_xor<8>(v); v += swz_xor<16>(v); return xor32_sum(v); }
__device__ __forceinline__ f32x16 mma32(bf16x8 a, bf16x8 b, f32x16 c) { return __builtin_amdgcn_mfma_f32_32x32x16_bf16(a, b, c, 0, 0, 0); }
__device__ __forceinline__ bf16x8 ldg8(const bf16* p) { return *(const bf16x8*)p; }
__device__ __forceinline__ bf16x8 ldg8p(const bf16* p) { const bf16x4 lo = *(const bf16x4*)p, hi = *(const bf16x4*)(p + 8); return __builtin_shufflevector(lo, hi, 0, 1, 2, 3, 4, 5, 6, 7); }
template <int S> __device__ __forceinline__ bf16x8 accB(const f32x16& c) {
    u32x4 w; w.x = pk2(c[8 * S + 0], c[8 * S + 1]); w.y = pk2(c[8 * S + 2], c[8 * S + 3]); w.z = pk2(c[8 * S + 4], c[8 * S + 5]); w.w = pk2(c[8 * S + 6], c[8 * S + 7]);
    return __builtin_bit_cast(bf16x8, w);
}
__device__ __forceinline__ bf16x8 pack8(const float (&v)[8]) { u32x4 w; w.x = pk2(v[0], v[1]); w.y = pk2(v[2], v[3]); w.z = pk2(v[4], v[5]); w.w = pk2(v[6], v[7]); return __builtin_bit_cast(bf16x8, w); }
__device__ __forceinline__ void unpack8(const bf16x8 x, float (&v)[8]) { const u32x4 w = __builtin_bit_cast(u32x4, x); v[0] = bflo(w.x); v[1] = bfhi(w.x); v[2] = bflo(w.y); v[3] = bfhi(w.y); v[4] = bflo(w.z); v[5] = bfhi(w.z); v[6] = bflo(w.w); v[7] = bfhi(w.w); }
__device__ __forceinline__ f32x16 zero16() { f32x16 z;
#pragma unroll
    for (int i = 0; i < 16; ++i) z[i] = 0.f;
    return z; }

#define XB_TMO      128
#define XB_XCNT(j)  (256  + 64 * (j))
#define XB_XSUB(j)  (1280 + 64 * (j))
#define XB_XGEN(j)  (2304 + 64 * (j))
#define XB_TOP      3328
#define XB_TOPGEN   3392
#define XCD_BAR_WORDS 3456
#define XB_SPIN_CAP (1u << 18)
__device__ __forceinline__ unsigned xb_ld(unsigned* p)              { return __hip_atomic_load(p, __ATOMIC_RELAXED, __HIP_MEMORY_SCOPE_AGENT); }
__device__ __forceinline__ unsigned xb_add(unsigned* p, unsigned v) { return __hip_atomic_fetch_add(p, v, __ATOMIC_RELAXED, __HIP_MEMORY_SCOPE_AGENT); }
__device__ __forceinline__ unsigned xb_xcc_id() { return (unsigned)__builtin_amdgcn_s_getreg((3 << 11) | 20) & 0xFu; }
#define XB_SPIN(cond, bar) do { unsigned _sp = 0; while (cond) { __builtin_amdgcn_s_sleep(1); \
    if ((++_sp & 255u) == 0u) { if (xb_ld(&(bar)[XB_TMO])) break; if (_sp > XB_SPIN_CAP) { atomicAdd(&(bar)[XB_TMO], 1u); break; } } } } while (0)
struct XcdBarrier { unsigned* bar; unsigned x; volatile LAS unsigned* st; };
__device__ __forceinline__ XcdBarrier xcd_barrier_post(unsigned* bar, volatile LAS unsigned* st) {
    XcdBarrier b; b.bar = bar; b.x = xb_xcc_id(); b.st = st;
    if (threadIdx.x == 0) (void)xb_add(&bar[XB_XCNT(b.x)], 1u);
    return b;
}
__device__ __forceinline__ void xcd_barrier_complete(unsigned* bar, unsigned x, unsigned& nloc, unsigned& nx) {
    const unsigned G = gridDim.x * gridDim.y * gridDim.z;
    unsigned sum, cnt, mine, sp = 0u;
    for (;;) {
        sum = 0u; cnt = 0u; mine = 0u;
#pragma unroll
        for (unsigned j = 0; j < 16; ++j) { const unsigned c = xb_ld(&bar[XB_XCNT(j)]); sum += c; cnt += (c > 0u) ? 1u : 0u; mine = (j == x) ? c : mine; }
        if (sum == G) break;
        __builtin_amdgcn_s_sleep(1);
        if ((++sp & 255u) == 0u) { if (xb_ld(&bar[XB_TMO])) break; if (sp > XB_SPIN_CAP) { atomicAdd(&bar[XB_TMO], 1u); break; } }
    }
    nloc = mine > 0u ? mine : 1u; nx = cnt > 0u ? cnt : 1u;
}
__device__ __forceinline__ void xcd_barrier(const XcdBarrier& b) {
    asm volatile("s_waitcnt vmcnt(0)" ::: "memory");
    __syncthreads();
    if (threadIdx.x == 0) {
        unsigned* bar = b.bar;
        __builtin_amdgcn_s_waitcnt(0);
        unsigned nloc = b.st[0], nx = b.st[1];
        if (nloc == 0u) { xcd_barrier_complete(bar, b.x, nloc, nx); b.st[0] = nloc; b.st[1] = nx; }
        const unsigned old = xb_add(&bar[XB_XSUB(b.x)], 1u);
        const unsigned gen = old / nloc;
        if (old + 1u == (gen + 1u) * nloc) {
            __builtin_amdgcn_fence(__ATOMIC_RELEASE, "agent");
            asm volatile("s_waitcnt vmcnt(0)" ::: "memory");
            const unsigned og = xb_add(&bar[XB_TOP], 1u);
            const unsigned tg = og / nx;
            if (og + 1u == (tg + 1u) * nx) xb_add(&bar[XB_TOPGEN], 1u);
            else XB_SPIN(xb_ld(&bar[XB_TOPGEN]) == tg, bar);
            __builtin_amdgcn_fence(__ATOMIC_ACQUIRE, "agent");
            xb_add(&bar[XB_XGEN(b.x)], 1u);
            asm volatile("s_waitcnt vmcnt(0)" ::: "memory");
        } else {
            XB_SPIN(xb_ld(&bar[XB_XGEN(b.x)]) == gen, bar);
            __builtin_amdgcn_fence(__ATOMIC_ACQUIRE, "agent");
            asm volatile("s_waitcnt vmcnt(0)" ::: "memory");
        }
    }
    __syncthreads();
}
namespace gp {
constexpr int BM = 256, BK = 64, HALF = 128, HTB = HALF * BK * 2, STAGE_BYTES = 8 * HTB, NXCD = 8, WGM = 8;
__device__ __forceinline__ int lds_byte(int r, int c) { const int st = (r >> 4) * 2 + (c >> 5), rr = r & 15, cc = c & 31, ob = rr * 64 + cc * 2; return st * 1024 + (ob ^ (((ob >> 9) & 1) << 5)); }
__device__ __forceinline__ void stage_rc(int b, int& Rr, int& C) { const int st = b / 1024, sb = b % 1024, swz = sb ^ (((sb >> 9) & 1) << 5); Rr = (st >> 1) * 16 + swz / 64; C = (st & 1) * 32 + (swz % 64) / 2; }
__device__ __forceinline__ int perm32(int rho) { const int n = rho >> 4, i = rho & 15; return 8 * (i >> 2) + 4 * n + (i & 3); }

struct Unit { const char* a; const char* b; int e0, e1, e2, e3; };

__device__ __forceinline__ void tile_of(int L, int nM, int nN, int& pm, int& pn) {
    const int nwg = nM * nN; int wgid = L;
    { const int q = nwg / NXCD, r = nwg % NXCD, xcd = wgid % NXCD, off = wgid / NXCD; wgid = (xcd < r ? xcd * (q + 1) : r * (q + 1) + (xcd - r) * q) + off; }
    const int nig = WGM * nN, gid = wgid / nig, fm = gid * WGM, gsz = (nM - fm) < WGM ? (nM - fm) : WGM;
    pm = fm + ((wgid % nig) % gsz); pn = (wgid % nig) / gsz;
}

template <class Epi, class Sched>
__device__ __forceinline__ void gemm_phase(LAS unsigned char* lds, const int tid, const int K, const int lda, const int ldb, const Sched& S, const Epi& E) {
    constexpr bool GATHER = Sched::GATHER;
    const int wid = __builtin_amdgcn_readfirstlane(tid >> 6), lane = tid & 63, wr = wid >> 2, wc = wid & 3, fr = lane & 15, fq = lane >> 4;
    int nt = K / BK; asm volatile("" : "+s"(nt));
    unsigned voffA[2], voffB[2], cb2[2]; int rowA[2];
#pragma unroll
    for (int i = 0; i < 2; ++i) { int Rr, C; stage_rc(tid * 16 + i * 8192, Rr, C); const int Rb = (Rr & ~31) + perm32(Rr & 31);
        rowA[i] = Rr; cb2[i] = (unsigned)C * 2u; voffA[i] = (unsigned)(Rr * lda + C) * 2u; voffB[i] = (unsigned)(Rb * ldb + C) * 2u; }
    const size_t kstep = (size_t)(BK * 2);
    const unsigned hstepA = (unsigned)HALF * (unsigned)lda * 2u; const size_t hstepB = (size_t)HALF * ldb * 2;
    const unsigned ldsw = (unsigned)wid * 1024u;
    const int aoff = lds_byte(wr * 64 + fr, fq * 8), boff = lds_byte(wc * 32 + fr, fq * 8);
#define PG8_SA(b, h) (((b) * 2 + (h)) * HTB)
#define PG8_SB(b, h) ((4 + (b) * 2 + (h)) * HTB)
#define PG8_STB(bufoff, gbase, hh) do { _Pragma("unroll") for (int _i = 0; _i < 2; ++_i) \
        __builtin_amdgcn_global_load_lds((const unsigned*)((const char*)(gbase) + (size_t)(hh) * hstepB + voffB[_i]), (LAS unsigned*)(lds + (bufoff) + ldsw + _i * 8192), 16, 0, 0); } while (0)
#define PG8_STA(bufoff, gbase, hh, VG) do { _Pragma("unroll") for (int _i = 0; _i < 2; ++_i) { const unsigned _o = GATHER ? (VG)[hh][_i] : (voffA[_i] + (unsigned)(hh) * hstepA); \
        __builtin_amdgcn_global_load_lds((const unsigned*)((const char*)(gbase) + _o), (LAS unsigned*)(lds + (bufoff) + ldsw + _i * 8192), 16, 0, 0); } } while (0)
#define PG8_LDA(dst, b, h) do { _Pragma("unroll") for (int m = 0; m < 4; ++m) _Pragma("unroll") for (int k = 0; k < 2; ++k) dst[m][k] = *(const LAS bf16x8*)(lds + PG8_SA(b, h) + aoff + m * 2048 + k * 1024); } while (0)
#define PG8_LDB(dst, b, h) do { _Pragma("unroll") for (int n = 0; n < 2; ++n) _Pragma("unroll") for (int k = 0; k < 2; ++k) dst[n][k] = *(const LAS bf16x8*)(lds + PG8_SB(b, h) + boff + n * 2048 + k * 1024); } while (0)
#define PG8_MMA(ai, bj, At, Bt) do { __builtin_amdgcn_s_setprio(1); _Pragma("unroll") for (int m = 0; m < 4; ++m) _Pragma("unroll") for (int n = 0; n < 2; ++n) _Pragma("unroll") for (int k = 0; k < 2; ++k) \
        acc[ai][bj][m][n] = __builtin_amdgcn_mfma_f32_16x16x32_bf16(Bt[n][k], At[m][k], acc[ai][bj][m][n], 0, 0, 0); __builtin_amdgcn_s_setprio(0); } while (0)
#define PG8_WAIT_V(n) asm volatile("s_waitcnt vmcnt(" #n ")" ::: "memory")
#define PG8_WAIT_L(n) asm volatile("s_waitcnt lgkmcnt(" #n ")" ::: "memory")
#define PG8_BAR __builtin_amdgcn_s_barrier()
#define PG8_SCHED __builtin_amdgcn_sched_barrier(0)
    Unit cur, nxt; int ui = 0;
    if (!S.next(0, cur)) return;
    f32x4 acc[2][2][4][2];
#pragma unroll
    for (int a = 0; a < 2; ++a)
#pragma unroll
        for (int b = 0; b < 2; ++b)
#pragma unroll
            for (int m = 0; m < 4; ++m)
#pragma unroll
                for (int n = 0; n < 2; ++n) acc[a][b][m][n] = (f32x4){0.f, 0.f, 0.f, 0.f};
    bf16x8 At[4][2], B0[2][2], B1[2][2];
    unsigned vgc[2][2], vgn[2][2];
#pragma unroll
    for (int h = 0; h < 2; ++h)
#pragma unroll
        for (int i = 0; i < 2; ++i) { vgc[h][i] = GATHER ? S.rowoff(cur, rowA[i] + h * HALF) + cb2[i] : 0u; vgn[h][i] = vgc[h][i]; }
    const char* cA = cur.a; const char* cB = cur.b;
    PG8_STB(PG8_SB(0, 0), cB, 0); PG8_STB(PG8_SB(0, 1), cB, 1); PG8_STA(PG8_SA(0, 0), cA, 0, vgc); PG8_STA(PG8_SA(0, 1), cA, 1, vgc);
    if (wr == 1) PG8_BAR;
    PG8_WAIT_V(2); PG8_BAR;
    PG8_STB(PG8_SB(1, 0), cB + kstep, 0); PG8_STA(PG8_SA(1, 0), cA + kstep, 0, vgc); PG8_STB(PG8_SB(1, 1), cB + kstep, 1);
    PG8_WAIT_V(6); PG8_BAR;
    for (;;) {
        const bool has_next = S.next(ui + 1, nxt);
        const char* nA = has_next ? nxt.a : cA; const char* nB = has_next ? nxt.b : cB;
#pragma unroll 1
        for (int t = 0; t < nt; t += 2) {
            const bool last = (t == nt - 2);
            const char* a1 = cA + (size_t)(t + 1) * kstep;
            const char* a2 = last ? nA : cA + (size_t)(t + 2) * kstep; const char* b2 = last ? nB : cB + (size_t)(t + 2) * kstep;
            const char* a3 = a2 + kstep; const char* b3 = b2 + kstep;
            unsigned vg2[2][2];
            if constexpr (GATHER) {
                if (last && has_next) {
#pragma unroll
                    for (int h = 0; h < 2; ++h)
#pragma unroll
                        for (int i = 0; i < 2; ++i) vgn[h][i] = S.rowoff(nxt, rowA[i] + h * HALF) + cb2[i];
                }
            }
#pragma unroll
            for (int h = 0; h < 2; ++h)
#pragma unroll
                for (int i = 0; i < 2; ++i) vg2[h][i] = last ? vgn[h][i] : vgc[h][i];
            PG8_LDB(B0, 0, 0); PG8_LDB(B1, 0, 1); PG8_SCHED; PG8_LDA(At, 0, 0); PG8_STA(PG8_SA(1, 1), a1, 1, vgc);
            PG8_WAIT_V(8); PG8_WAIT_L(0); PG8_BAR; PG8_MMA(0, 0, At, B0); PG8_MMA(0, 1, At, B1); PG8_BAR; PG8_SCHED;
            PG8_LDA(At, 0, 1); PG8_STB(PG8_SB(0, 0), b2, 0); PG8_STB(PG8_SB(0, 1), b2, 1); PG8_STA(PG8_SA(0, 0), a2, 0, vg2);
            PG8_WAIT_V(8); PG8_WAIT_L(0); PG8_BAR; PG8_MMA(1, 0, At, B0); PG8_MMA(1, 1, At, B1); PG8_BAR; PG8_SCHED;
            PG8_LDB(B0, 1, 0); PG8_LDB(B1, 1, 1); PG8_SCHED; PG8_LDA(At, 1, 0); PG8_STA(PG8_SA(0, 1), a2, 1, vg2);
            PG8_WAIT_V(8); PG8_WAIT_L(0); PG8_BAR; PG8_MMA(0, 0, At, B0); PG8_MMA(0, 1, At, B1); PG8_BAR; PG8_SCHED;
            PG8_LDA(At, 1, 1); PG8_STB(PG8_SB(1, 0), b3, 0); PG8_STB(PG8_SB(1, 1), b3, 1); PG8_STA(PG8_SA(1, 0), a3, 0, vg2);
            PG8_WAIT_V(8); PG8_WAIT_L(0); PG8_BAR; PG8_MMA(1, 0, At, B0); PG8_MMA(1, 1, At, B1); PG8_BAR; PG8_SCHED;
        }
        if (wr == 0) PG8_BAR;
        if constexpr (Epi::CARRY) { E.carry(acc, cur, wr, wc, fr, fq); if (!has_next) break; }
        else {
        E(acc, cur, wr, wc, fr, fq);
        if (!has_next) break;
#pragma unroll
        for (int a = 0; a < 2; ++a)
#pragma unroll
            for (int b = 0; b < 2; ++b)
#pragma unroll
                for (int m = 0; m < 4; ++m)
#pragma unroll
                    for (int n = 0; n < 2; ++n) acc[a][b][m][n] = (f32x4){0.f, 0.f, 0.f, 0.f};
        }
        cur = nxt; cA = nA; cB = nB; ++ui;
#pragma unroll
        for (int h = 0; h < 2; ++h)
#pragma unroll
            for (int i = 0; i < 2; ++i) vgc[h][i] = vgn[h][i];
        if (wr == 1) PG8_BAR;
    }
    PG8_WAIT_V(0);
    PG8_BAR;
#undef PG8_SA
#undef PG8_SB
#undef PG8_STA
#undef PG8_STB
#undef PG8_LDA
#undef PG8_LDB
#undef PG8_MMA
#undef PG8_WAIT_V
#undef PG8_WAIT_L
#undef PG8_BAR
#undef PG8_SCHED
}

struct SchedPlain {
    static constexpr bool GATHER = false;
    const char* A; const char* B; size_t ta, tb; int nM, nN, G, c;
    __device__ __forceinline__ bool next(int i, Unit& u) const {
        const long L = (long)i * G + c; if (L >= (long)nM * nN) return false;
        int pm, pn; tile_of((int)L, nM, nN, pm, pn); u.a = A + (size_t)pm * ta; u.b = B + (size_t)pn * tb; u.e0 = pm; u.e1 = pn; u.e2 = 0; u.e3 = 0; return true; }
    __device__ __forceinline__ unsigned rowoff(const Unit&, int) const { return 0u; }
};
struct SchedInprojA {
    static constexpr bool GATHER = false;
    const char* Hh; const char* W; int nM, G, c, ng;
    __device__ __forceinline__ bool next(int i, Unit& u) const {
        long L = (long)i * G + c; const int n1 = nM * 7, n2 = 3 * nM; if (L >= n1 + n2 + ng) return false;
        int pm, pn;
        if (L < n1) { tile_of((int)L, nM, 7, pm, pn); u.a = Hh + (size_t)pm * (256 * 2048); u.b = W + (size_t)pn * (256 * 2048); u.e2 = 0; }
        else if (L < n1 + n2) { tile_of((int)(L - n1), 3, nM, pm, pn); u.a = W + (size_t)(23 + pm) * (256 * 2048); u.b = Hh + (size_t)pn * (256 * 2048); u.e2 = 1; }
        else { const int q = (int)(L - n1 - n2); pm = q >> 4; pn = q & 15; u.a = Hh + (size_t)(64 + pm) * (256 * 2048); u.b = W + (size_t)(7 + pn) * (256 * 2048); u.e2 = 2; }
        u.e0 = pm; u.e1 = pn; u.e3 = 0; return true; }
    __device__ __forceinline__ unsigned rowoff(const Unit&, int) const { return 0u; }
};
struct SchedMerge {
    static constexpr bool GATHER = false;
    const char* Mix; const char* Wb; int nM, G, c;
    __device__ __forceinline__ bool next(int i, Unit& u) const {
        const long L = (long)(i >> 2) * G + c; if (L >= (long)nM * 4) return false;
        int pm, pn; tile_of((int)L, nM, 4, pm, pn); const int b = i & 3;
        u.a = Mix + (size_t)pm * (256 * 2048) + b * 512; u.b = Wb + ((size_t)b * 1024 + pn * 256) * 512; u.e0 = pm; u.e1 = pn; u.e2 = b; u.e3 = 0; return true; }
    __device__ __forceinline__ unsigned rowoff(const Unit&, int) const { return 0u; }
};
struct SchedMoe1 {
    static constexpr bool GATHER = true;
    const char* Hh; const char* W; const int* list; const LAS unsigned* mt; int G, c;
    __device__ __forceinline__ bool next(int i, Unit& u) const {
        long L = (long)i * G + c; int e = 0;
        for (; e < 8; ++e) { const long ue = (long)mt[8 + e] * 28; if (L < ue) break; L -= ue; }
        if (e == 8) return false;
        const int m_e = (int)mt[8 + e], nti = (int)(L / m_e), mti = (int)(L % m_e);
        u.a = Hh; u.b = W + ((size_t)e * 7168 + (size_t)nti * 256) * 2048; u.e0 = e; u.e1 = mti; u.e2 = nti; u.e3 = ((int)mt[16 + e] + mti) * 256; return true; }
    __device__ __forceinline__ unsigned rowoff(const Unit& u, int r) const {
        const int li = u.e1 * 256 + r; const int ent = (li < (int)mt[u.e0]) ? list[u.e0 * LCAP + li] : 0; return (unsigned)(ent >> 1) * 2048u; }
};
struct SchedMoe2 {
    static constexpr bool GATHER = false;
    const char* Hid; const char* W; const LAS unsigned* mt; int G, c;
    __device__ __forceinline__ bool next(int i, Unit& u) const {
        long L = (long)i * G + c; int e = 0;
        for (; e < 8; ++e) { const long ue = (long)mt[8 + e] * 4; if (L < ue) break; L -= ue; }
        if (e == 8) return false;
        const int m_e = (int)mt[8 + e], nti = (int)(L / m_e), mti = (int)(L % m_e);
        u.a = Hid + (size_t)((int)mt[16 + e] + mti) * 256 * (size_t)(DFE * 2); u.b = W + ((size_t)e * 1024 + (size_t)nti * 256) * (size_t)(DFE * 2); u.e0 = e; u.e1 = mti; u.e2 = nti; u.e3 = 0; return true; }
    __device__ __forceinline__ unsigned rowoff(const Unit&, int) const { return 0u; }
};

#define EPI_ROWS(ai, m) (128 * (ai) + 64 * wr + 16 * (m) + fr)
#define EPI_COL(bj) (128 * (bj) + 32 * wc + 8 * fq)
__device__ __forceinline__ u32x4 pack_acc8(const f32x4 a, const f32x4 b) { u32x4 w; w.x = pk2(a[0], a[1]); w.y = pk2(a[2], a[3]); w.z = pk2(b[0], b[1]); w.w = pk2(b[2], b[3]); return w; }

__device__ __forceinline__ unsigned gq8(float g) { const unsigned q = (unsigned)(g * 255.f + 0.5f); return q < 1u ? 1u : q; }
__device__ __forceinline__ u32x2 pack_gate8(const f32x4 a, const f32x4 b) {
    u32x2 w; w.x = gq8(a[0]) | (gq8(a[1]) << 8) | (gq8(a[2]) << 16) | (gq8(a[3]) << 24); w.y = gq8(b[0]) | (gq8(b[1]) << 8) | (gq8(b[2]) << 16) | (gq8(b[3]) << 24); return w; }
__device__ __forceinline__ float gate8(unsigned w, int k) { return (float)((w >> (8 * k)) & 255u) * (1.f / 255.f); }
struct EpiPlain { static constexpr bool CARRY = false;
    bf16* O; int ld;
    __device__ __forceinline__ void operator()(const f32x4 (&acc)[2][2][4][2], const Unit& u, int wr, int wc, int fr, int fq) const {
#pragma unroll
        for (int ai = 0; ai < 2; ++ai)
#pragma unroll
            for (int m = 0; m < 4; ++m) { bf16* rowp = O + (size_t)(u.e0 * 256 + EPI_ROWS(ai, m)) * ld + u.e1 * 256;
#pragma unroll
                for (int bj = 0; bj < 2; ++bj) *(u32x4*)(rowp + EPI_COL(bj)) = pack_acc8(acc[ai][bj][m][0], acc[ai][bj][m][1]); }
    }
};
struct EpiInprojA { static constexpr bool CARRY = false;
    bf16* INP; bf16* T; unsigned char* Gc;
    __device__ __forceinline__ void operator()(const f32x4 (&acc)[2][2][4][2], const Unit& u, int wr, int wc, int fr, int fq) const {
        if (u.e2 == 2) {
#pragma unroll
            for (int ai = 0; ai < 2; ++ai)
#pragma unroll
                for (int m = 0; m < 4; ++m) { unsigned char* rowp = Gc + (size_t)(u.e0 * 256 + EPI_ROWS(ai, m)) * 4096 + u.e1 * 256;
#pragma unroll
                    for (int bj = 0; bj < 2; ++bj) { f32x4 a = acc[ai][bj][m][0], b = acc[ai][bj][m][1];
#pragma unroll
                        for (int j = 0; j < 4; ++j) { a[j] = sigm(a[j]); b[j] = sigm(b[j]); }
                        *(u32x2*)(rowp + EPI_COL(bj)) = pack_gate8(a, b); } }
        } else if (u.e2 == 0) {
            bf16* base = INP + (size_t)u.e1 * ((size_t)R * 256);
            const bool regroup = (u.e1 == 1);
#pragma unroll
            for (int ai = 0; ai < 2; ++ai)
#pragma unroll
                for (int m = 0; m < 4; ++m) { const int row = u.e0 * 256 + EPI_ROWS(ai, m);
#pragma unroll
                    for (int bj = 0; bj < 2; ++bj) { const int col = EPI_COL(bj);
                        bf16* p = regroup ? base + ((((size_t)(col >> 4) * 33 + (row >> 9)) * 16 + (row & 15)) * 64 + ((col & 8) << 2) + ((row >> 4) & 31)) * 8 : base + (size_t)row * 256 + col;
                        *(u32x4*)p = pack_acc8(acc[ai][bj][m][0], acc[ai][bj][m][1]); } }
        } else {
#pragma unroll
            for (int ai = 0; ai < 2; ++ai)
#pragma unroll
                for (int m = 0; m < 4; ++m) { bf16* rowp = T + (size_t)(u.e0 * 256 + EPI_ROWS(ai, m)) * R + u.e1 * 256;
#pragma unroll
                    for (int bj = 0; bj < 2; ++bj) *(u32x4*)(rowp + EPI_COL(bj)) = pack_acc8(acc[ai][bj][m][0], acc[ai][bj][m][1]); }
        }
    }
};
struct EpiGates { static constexpr bool CARRY = false;
    unsigned char* Gt;
    __device__ __forceinline__ void operator()(const f32x4 (&acc)[2][2][4][2], const Unit& u, int wr, int wc, int fr, int fq) const {
#pragma unroll
        for (int ai = 0; ai < 2; ++ai)
#pragma unroll
            for (int m = 0; m < 4; ++m) { unsigned char* rowp = Gt + (size_t)(u.e0 * 256 + EPI_ROWS(ai, m)) * 4096 + u.e1 * 256;
#pragma unroll
                for (int bj = 0; bj < 2; ++bj) { f32x4 a = acc[ai][bj][m][0], b = acc[ai][bj][m][1];
#pragma unroll
                    for (int j = 0; j < 4; ++j) { a[j] = sigm(a[j]); b[j] = sigm(b[j]); }
                    *(u32x2*)(rowp + EPI_COL(bj)) = pack_gate8(a, b); } }
    }
};
struct EpiGlu { static constexpr bool CARRY = false;
    const bf16* Zz; bf16* Mix; const float* bglu;
    __device__ __forceinline__ void operator()(const f32x4 (&acc)[2][2][4][2], const Unit& u, int wr, int wc, int fr, int fq) const {
#pragma unroll
        for (int bj = 0; bj < 2; ++bj) { const int col = EPI_COL(bj);
            const f32x4 b0 = *(const f32x4*)(bglu + col), b1 = *(const f32x4*)(bglu + col + 4);
#pragma unroll
            for (int ai = 0; ai < 2; ++ai)
#pragma unroll
                for (int m = 0; m < 4; ++m) { const size_t row = (size_t)(u.e0 * 256 + EPI_ROWS(ai, m));
                    const u32x4 zz = *(const u32x4*)(Zz + row * 256 + col);
                    f32x4 a = acc[ai][bj][m][0] + b0, b = acc[ai][bj][m][1] + b1;
                    a[0] = bflo(zz.x) * sigm(a[0]); a[1] = bfhi(zz.x) * sigm(a[1]); a[2] = bflo(zz.y) * sigm(a[2]); a[3] = bfhi(zz.y) * sigm(a[3]);
                    b[0] = bflo(zz.z) * sigm(b[0]); b[1] = bfhi(zz.z) * sigm(b[1]); b[2] = bflo(zz.w) * sigm(b[2]); b[3] = bfhi(zz.w) * sigm(b[3]);
                    *(u32x4*)(Mix + row * 1024 + 256 + col) = pack_acc8(a, b); } }
    }
};
struct EpiMerge {
    static constexpr bool CARRY = true;
    const unsigned char* Gt; const unsigned char* Gc; bf16* Y;
    __device__ __forceinline__ void carry(f32x4 (&acc)[2][2][4][2], const Unit& u, int wr, int wc, int fr, int fq) const {
        const int b = u.e2, bn = b < 3 ? b + 1 : 3;
        u32x2 g[2][4][2], gn[2][4][2];
#pragma unroll
        for (int ai = 0; ai < 2; ++ai)
#pragma unroll
            for (int m = 0; m < 4; ++m) { const size_t row = (size_t)(u.e0 * 256 + EPI_ROWS(ai, m));
                const unsigned char* grow = (u.e0 < 64 ? Gt + row * 4096 : Gc + (row - LROWS) * 4096) + u.e1 * 256;
#pragma unroll
                for (int bj = 0; bj < 2; ++bj) { g[ai][m][bj] = *(const u32x2*)(grow + b * 1024 + EPI_COL(bj)); gn[ai][m][bj] = *(const u32x2*)(grow + bn * 1024 + EPI_COL(bj)); } }
#pragma unroll
        for (int ai = 0; ai < 2; ++ai)
#pragma unroll
            for (int m = 0; m < 4; ++m) { const size_t row = (size_t)(u.e0 * 256 + EPI_ROWS(ai, m));
#pragma unroll
                for (int bj = 0; bj < 2; ++bj) { const int col = u.e1 * 256 + EPI_COL(bj);
                    f32x4 a0 = acc[ai][bj][m][0], a1 = acc[ai][bj][m][1];
#pragma unroll
                    for (int j = 0; j < 4; ++j) { a0[j] *= gate8(g[ai][m][bj].x, j); a1[j] *= gate8(g[ai][m][bj].y, j); }
                    if (b != 3) {
#pragma unroll
                        for (int j = 0; j < 4; ++j) { a0[j] *= rcpf_(gate8(gn[ai][m][bj].x, j)); a1[j] *= rcpf_(gate8(gn[ai][m][bj].y, j)); }
                        acc[ai][bj][m][0] = a0; acc[ai][bj][m][1] = a1; }
                    else { *(u32x4*)(Y + row * 1024 + col) = pack_acc8(a0, a1); acc[ai][bj][m][0] = (f32x4){0.f, 0.f, 0.f, 0.f}; acc[ai][bj][m][1] = (f32x4){0.f, 0.f, 0.f, 0.f}; } } }
    }
};
struct EpiSwiglu { static constexpr bool CARRY = false;
    bf16* Hd; int ldh; bool moe;
    __device__ __forceinline__ void operator()(const f32x4 (&acc)[2][2][4][2], const Unit& u, int wr, int wc, int fr, int fq) const {
        const int rowbase = moe ? u.e3 : u.e0 * 256, pn = moe ? u.e2 : u.e1;
#pragma unroll
        for (int ai = 0; ai < 2; ++ai)
#pragma unroll
            for (int m = 0; m < 4; ++m) { bf16* p = Hd + (size_t)(rowbase + EPI_ROWS(ai, m)) * ldh + pn * 128 + 32 * wc + 8 * fq;
                f32x4 a = acc[ai][0][m][0], b = acc[ai][0][m][1]; const f32x4 ua = acc[ai][1][m][0], ub = acc[ai][1][m][1];
#pragma unroll
                for (int j = 0; j < 4; ++j) { a[j] = silu_(a[j]) * ua[j]; b[j] = silu_(b[j]) * ub[j]; }
                *(u32x4*)p = pack_acc8(a, b); }
    }
};
struct EpiMoeDown { static constexpr bool CARRY = false;
    bf16* Slot; const int* list; const float* routew; const LAS unsigned* mt;
    __device__ __forceinline__ void operator()(const f32x4 (&acc)[2][2][4][2], const Unit& u, int wr, int wc, int fr, int fq) const {
        const int cnt = (int)mt[u.e0];
#pragma unroll
        for (int ai = 0; ai < 2; ++ai)
#pragma unroll
            for (int m = 0; m < 4; ++m) { const int li = u.e1 * 256 + EPI_ROWS(ai, m);
                if (li < cnt) { const int ent = list[u.e0 * LCAP + li]; const float w = routew[ent];
                    bf16* rowp = Slot + ((size_t)(ent & 1) * LROWS + (size_t)(ent >> 1)) * 1024 + u.e2 * 256;
#pragma unroll
                    for (int bj = 0; bj < 2; ++bj) *(u32x4*)(rowp + EPI_COL(bj)) = pack_acc8(acc[ai][bj][m][0] * w, acc[ai][bj][m][1] * w); } }
    }
};
}
#define DROW(reg, h) (((reg) & 3) + 8 * ((reg) >> 2) + 4 * (h))

__device__ __forceinline__ void s5_state_item(const bf16* M1F  , const bf16* SUF, float* HLOC, int item, int lane) {
    const int cb = item % 33, gd = item / 33, g = gd >> 1, dir = gd & 1, li = lane & 31, h = lane >> 5;
    const bf16* A = M1F + (size_t)(g * 2 + dir) * 128 * 256 + lane * 8;
    const bf16* B = SUF + (size_t)(g * 33 + cb) * 16 * 512 + lane * 8;
    f32x16 acc[4];
#pragma unroll
    for (int rt = 0; rt < 4; ++rt) acc[rt] = zero16();
#pragma unroll 4
    for (int ks = 0; ks < 16; ++ks) {
        const bf16x8 bf = ldg8(B + ks * 512);
#pragma unroll
        for (int rt = 0; rt < 4; ++rt) acc[rt] = mma32(ldg8(A + (ks * 4 + rt) * 512), bf, acc[rt]);
    }
    float* o = HLOC + ((size_t)(g * 2 + dir) * NCH16 + cb * 32 + li) * 128;
#pragma unroll
    for (int rt = 0; rt < 4; ++rt)
#pragma unroll
        for (int q = 0; q < 4; ++q) *(f32x4*)(o + rt * 32 + 8 * q + 4 * h) = (f32x4){acc[rt][4 * q], acc[rt][4 * q + 1], acc[rt][4 * q + 2], acc[rt][4 * q + 3]};
}
__device__ __forceinline__ void s5_scan_item(const float* A16  , const float* HLOC, bf16* HIN, int item, int lane) {
    const int dir = item & 1, g = (item >> 1) & 15, b = item >> 5, p = lane;
    const f32x2 a = *(const f32x2*)(A16 + ((size_t)(dir * 16 + g) * 64 + p) * 2);
    const float* src = HLOC + (size_t)(g * 2 + dir) * NCH16 * 128 + 2 * p;
    const int k2 = dir * 128 + 2 * p; bf16* dst = HIN + ((size_t)g * 33 * 16 + (k2 >> 4)) * 512 + ((k2 >> 3) & 1) * 256 + (k2 & 7);
    float hr = 0.f, hi = 0.f;
#define S5_CH(s) ((s) < 16 ? 1024 + 16 * b + (dir ? 15 - (s) : (s)) : 512 * b + (dir ? 511 - ((s) - 16) : (s) - 16))
    f32x2 v[32], w[32];
#pragma unroll
    for (int j = 0; j < 32; ++j) v[j] = *(const f32x2*)(src + (size_t)S5_CH(j) * 128);
    for (int s0 = 0; s0 < 528; s0 += 32) {
        const int nb = 528 - s0 < 32 ? 528 - s0 : 32;
        if (s0 + 32 < 528) {
#pragma unroll
            for (int j = 0; j < 32; ++j) { const int s = s0 + 32 + j; w[j] = *(const f32x2*)(src + (size_t)S5_CH(s < 528 ? s : 527) * 128); } }
#pragma unroll
        for (int j = 0; j < 32; ++j) if (j < nb) { const int c = S5_CH(s0 + j);
            *(unsigned*)(dst + (size_t)(c >> 5) * 8192 + (c & 31) * 8) = pk2(hr, hi);
            const float nr = a.x * hr - a.y * hi + v[j].x, ni = a.x * hi + a.y * hr + v[j].y; hr = nr; hi = ni; }
#pragma unroll
        for (int j = 0; j < 32; ++j) v[j] = w[j];
    }
#undef S5_CH
}
__device__ __forceinline__ void s5_out_item(const bf16* TABF  , const bf16* SUF, const bf16* HINF, bf16* Z, int item, int lane) {
    const int mh = item & 1, it2 = item >> 1, cb = it2 % 33, g = it2 / 33, li = lane & 31, h = lane >> 5, c = cb * 32 + li;
    const bf16* A = TABF + ((size_t)g * 256 + mh * 128) * 512 + lane * 8;
    const bf16* B0 = SUF + (size_t)(g * 33 + cb) * 16 * 512 + lane * 8;
    const bf16* B1 = HINF + (size_t)(g * 33 + cb) * 16 * 512 + lane * 8;
    f32x16 acc[4];
#pragma unroll
    for (int rt = 0; rt < 4; ++rt) acc[rt] = zero16();
#pragma unroll 4
    for (int ks = 0; ks < 16; ++ks) {
        const bf16x8 bf = ldg8(B0 + ks * 512);
#pragma unroll
        for (int rt = 0; rt < 4; ++rt) acc[rt] = mma32(ldg8(A + (ks * 4 + rt) * 512), bf, acc[rt]);
    }
#pragma unroll 4
    for (int ks = 0; ks < 16; ++ks) {
        const bf16x8 bf = ldg8(B1 + ks * 512);
#pragma unroll
        for (int rt = 0; rt < 4; ++rt) acc[rt] = mma32(ldg8(A + ((16 + ks) * 4 + rt) * 512), bf, acc[rt]);
    }
#pragma unroll
    for (int rt = 0; rt < 4; ++rt)
#pragma unroll
        for (int q = 0; q < 4; ++q) {
            const int i = 8 * mh + 2 * rt + (q >> 1), ho0 = 8 * (q & 1) + 4 * h;
            u32x2 w; w.x = pk2(gelu_tanh(acc[rt][4 * q]), gelu_tanh(acc[rt][4 * q + 1])); w.y = pk2(gelu_tanh(acc[rt][4 * q + 2]), gelu_tanh(acc[rt][4 * q + 3]));
            *(u32x2*)(Z + ((size_t)c * 16 + i) * 256 + g * 16 + ho0) = w; }
}

__device__ __forceinline__ int ret_tok0(int b, int n) { return n < 64 ? b * SEQ + n * 128 : LROWS + b * CTXL + (n - 64) * 128; }
__device__ __forceinline__ void ret_kv_item(const bf16* RKT, const bf16* RVT, const float* COST, const float* SINT, const float* decay  , float* KV, int item, int lane) {
    const int n = item % 66, bh = item / 66, hd = bh & 3, b = bh >> 2, li = lane & 31, h = lane >> 5;
    const int tok0 = ret_tok0(b, n); const bool lat = n < 64;
    const float lgf = -log2f(1.f + __expf(-decay[hd])), lgr = -log2f(1.f + __expf(-decay[4 + hd]));
    f32x16 acc[2][2][2];
#pragma unroll
    for (int a = 0; a < 2; ++a)
#pragma unroll
        for (int c = 0; c < 2; ++c)
#pragma unroll
            for (int d = 0; d < 2; ++d) acc[a][c][d] = zero16();
    const bf16* k0p = RKT + (size_t)(hd * 64 + li) * R + tok0 + 8 * h;
    const bf16* v0p = RVT + (size_t)(hd * 64 + li) * R + tok0 + 8 * h;
#pragma unroll 2
    for (int ks = 0; ks < 8; ++ks) {
        float k1[8], k2[8];
        unpack8(ldg8(k0p + ks * 16), k1); unpack8(ldg8(k0p + (size_t)32 * R + ks * 16), k2);
        if (lat) {
            const float* cp = COST + (size_t)li * SEQ + n * 128 + ks * 16 + 8 * h; const float* sp = SINT + (size_t)li * SEQ + n * 128 + ks * 16 + 8 * h;
            const f32x4 c0 = *(const f32x4*)cp, c1 = *(const f32x4*)(cp + 4), s0 = *(const f32x4*)sp, s1 = *(const f32x4*)(sp + 4);
#pragma unroll
            for (int j = 0; j < 8; ++j) { const float cc = j < 4 ? c0[j & 3] : c1[j & 3], ss = j < 4 ? s0[j & 3] : s1[j & 3];
                const float x1 = k1[j], x2 = k2[j]; k1[j] = x1 * cc - x2 * ss; k2[j] = x1 * ss + x2 * cc; }
        }
        const bf16x8 vf0 = ldg8(v0p + ks * 16), vf1 = ldg8(v0p + (size_t)32 * R + ks * 16);
#pragma unroll
        for (int dir = 0; dir < 2; ++dir) {
            float a1[8], a2[8];
#pragma unroll
            for (int j = 0; j < 8; ++j) { const int i = ks * 16 + 8 * h + j; const float w = dir == 0 ? ex2(lgf * (float)(127 - i)) : ex2(lgr * (float)i); a1[j] = k1[j] * w; a2[j] = k2[j] * w; }
            const bf16x8 kd0 = pack8(a1), kd1 = pack8(a2);
            acc[dir][0][0] = mma32(kd0, vf0, acc[dir][0][0]); acc[dir][0][1] = mma32(kd0, vf1, acc[dir][0][1]);
            acc[dir][1][0] = mma32(kd1, vf0, acc[dir][1][0]); acc[dir][1][1] = mma32(kd1, vf1, acc[dir][1][1]);
        }
    }
#pragma unroll
    for (int dir = 0; dir < 2; ++dir) { float* o = KV + ((size_t)((b * 4 + hd) * 2 + dir) * 66 + n) * 4096;
#pragma unroll
        for (int dt = 0; dt < 2; ++dt)
#pragma unroll
            for (int et = 0; et < 2; ++et)
#pragma unroll
                for (int q = 0; q < 4; ++q) *(f32x4*)(o + (size_t)(et * 32 + li) * 64 + dt * 32 + 8 * q + 4 * h) = (f32x4){acc[dir][dt][et][4 * q], acc[dir][dt][et][4 * q + 1], acc[dir][dt][et][4 * q + 2], acc[dir][dt][et][4 * q + 3]}; }
}
__device__ __forceinline__ void ret_scan_item(const float* decay, const float* KV, bf16* SPREV, int item, int lane) {
    const int blk = item & 63, bhd = item >> 6, dir = bhd & 1, hd = (bhd >> 1) & 3, idx = blk * 64 + lane;
    const float lg = -log2f(1.f + __expf(-decay[dir * 4 + hd])), cd = ex2(128.f * lg);
    const float* src = KV + (size_t)bhd * 66 * 4096 + idx; bf16* dst = SPREV + (size_t)bhd * 66 * 4096 + idx;
    float s = 0.f;
    for (int s0 = 0; s0 < 66; s0 += 11) {
        float v[11];
#pragma unroll
        for (int j = 0; j < 11; ++j) { const int t = s0 + j; const int n = dir == 0 ? (t < 2 ? 64 + t : t - 2) : (t < 2 ? 65 - t : 65 - t); v[j] = src[(size_t)n * 4096]; }
#pragma unroll
        for (int j = 0; j < 11; ++j) { const int t = s0 + j; const int n = dir == 0 ? (t < 2 ? 64 + t : t - 2) : (t < 2 ? 65 - t : 65 - t); dst[(size_t)n * 4096] = (bf16)(pk2(s, 0.f) & 0xffffu); s = cd * s + v[j]; }
    }
}
struct KVTile { u32x4 k[4], v[4]; };
__device__ __forceinline__ void kv_tile_load(KVTile& T, const bf16* Kh  , const bf16* VTh  , int tok0, int lane) {
#pragma unroll
    for (int i = 0; i < 4; ++i) T.k[i] = *(const u32x4*)(Kh + (size_t)(tok0 + 8 * i + (lane >> 3)) * 256 + (lane & 7) * 8);
#pragma unroll
    for (int i = 0; i < 4; ++i) T.v[i] = *(const u32x4*)(VTh + (size_t)(16 * i + (lane >> 2)) * R + tok0 + (lane & 3) * 8);
}
__device__ __forceinline__ void kv_tile_store(const KVTile& T, LAS unsigned char* wl, int lane) {
#pragma unroll
    for (int i = 0; i < 4; ++i) *(LAS u32x4*)(wl + (8 * i + (lane >> 3)) * 144 + (lane & 7) * 16) = T.k[i];
#pragma unroll
    for (int i = 0; i < 4; ++i) *(LAS u32x4*)(wl + 4608 + (16 * i + (lane >> 2)) * 80 + (lane & 3) * 16) = T.v[i];
}
__device__ __forceinline__ void kv_tile_frags(const LAS unsigned char* wl, int lane, bf16x8 (&kf)[4], bf16x8 (&vf)[2][2]) {
    const int li = lane & 31, h = lane >> 5;
#pragma unroll
    for (int s = 0; s < 4; ++s) kf[s] = *(const LAS bf16x8*)(wl + li * 144 + (2 * s + h) * 16);
#pragma unroll
    for (int et = 0; et < 2; ++et)
#pragma unroll
        for (int s2 = 0; s2 < 2; ++s2) { const LAS unsigned char* p = wl + 4608 + (et * 32 + li) * 80 + s2 * 32 + 8 * h;
            const bf16x4 lo = *(const LAS bf16x4*)p, hi = *(const LAS bf16x4*)(p + 16); vf[et][s2] = __builtin_shufflevector(lo, hi, 0, 1, 2, 3, 4, 5, 6, 7); }
}

__device__ __forceinline__ void rope_item(bf16* RQ, bf16* RK, const float* COSN, const float* SINN, int item, int lane) {
    const int u = lane & 15, off = (u >> 2) * 64 + (u & 3) * 8, c8 = (u & 3) * 8;
#pragma unroll 4
    for (int st = 0; st < 32; ++st) { const int row = item * 128 + 4 * st + (lane >> 4), tl = row & (SEQ - 1);
        const f32x4 c0 = *(const f32x4*)(COSN + (size_t)tl * 32 + c8), c1 = *(const f32x4*)(COSN + (size_t)tl * 32 + c8 + 4), s0 = *(const f32x4*)(SINN + (size_t)tl * 32 + c8), s1 = *(const f32x4*)(SINN + (size_t)tl * 32 + c8 + 4);
#pragma unroll
        for (int w = 0; w < 2; ++w) { bf16* p = (w ? RK : RQ) + (size_t)row * 256 + off; float x1[8], x2[8]; unpack8(*(const bf16x8*)p, x1); unpack8(*(const bf16x8*)(p + 32), x2);
#pragma unroll
            for (int j = 0; j < 8; ++j) { const float cc = j < 4 ? c0[j & 3] : c1[j & 3], ss = j < 4 ? s0[j & 3] : s1[j & 3]; const float a = x1[j], bb = x2[j]; x1[j] = a * cc - bb * ss; x2[j] = a * ss + bb * cc; }
            *(bf16x8*)p = pack8(x1); *(bf16x8*)(p + 32) = pack8(x2); } }
}
__device__ __forceinline__ void ret_out_item(const bf16* RQ, const bf16* RK, const bf16* RG, const bf16* RVT, const bf16* SPREV, const float* decay, const float* gn  , bf16* MIX,
                                             LAS unsigned char* wl, int item, int lane) {
    const int qb = item & 3, it2 = item >> 2, n = it2 % 66, bh = it2 / 66, hd = bh & 3, b = bh >> 2, li = lane & 31, h = lane >> 5;
    const int tok0 = ret_tok0(b, n);
    const float lgf = -log2f(1.f + __expf(-decay[hd])), lgr = -log2f(1.f + __expf(-decay[4 + hd]));
    const int iq = qb * 32 + li;
    const bf16* Kh = RK + hd * 64; const bf16* VTh = RVT + (size_t)hd * 64 * R;
    KVTile T; kv_tile_load(T, Kh, VTh, tok0, lane);
    bf16x8 qf[4];
    { const bf16* qp = RQ + (size_t)(tok0 + iq) * 256 + hd * 64 + 8 * h;
#pragma unroll
      for (int s = 0; s < 4; ++s) qf[s] = ldg8(qp + 16 * s); }
    kv_tile_store(T, wl, lane);
    f32x16 accO[2] = {zero16(), zero16()};
#pragma unroll 1
    for (int kt = 0; kt < 4; ++kt) {
        kv_tile_load(T, Kh, VTh, tok0 + (kt < 3 ? kt + 1 : kt) * 32, lane);
        bf16x8 kf[4], vf[2][2]; kv_tile_frags(wl, lane, kf, vf);
        f32x16 st = zero16();
#pragma unroll
        for (int s = 0; s < 4; ++s) st = mma32(kf[s], qf[s], st);
#pragma unroll
        for (int r = 0; r < 16; ++r) { const int j = kt * 32 + DROW(r, h), df = iq - j;
            const float w = df > 0 ? ex2(lgf * (float)df) : (df < 0 ? ex2(lgr * (float)(-df)) : 2.f); st[r] *= w; }
        const bf16x8 p0 = accB<0>(st), p1 = accB<1>(st);
        accO[0] = mma32(vf[0][0], p0, accO[0]); accO[0] = mma32(vf[0][1], p1, accO[0]); accO[1] = mma32(vf[1][0], p0, accO[1]); accO[1] = mma32(vf[1][1], p1, accO[1]);
        kv_tile_store(T, wl, lane);
    }
    const float cf = ex2(lgf * (float)(iq + 1)), cr = ex2(lgr * (float)(128 - iq));
#pragma unroll
    for (int dir = 0; dir < 2; ++dir) { const bf16* sp = SPREV + ((size_t)((b * 4 + hd) * 2 + dir) * 66 + n) * 4096;
#pragma unroll
        for (int et = 0; et < 2; ++et) { f32x16 a = zero16();
#pragma unroll
            for (int s = 0; s < 4; ++s) a = mma32(ldg8(sp + (size_t)(et * 32 + li) * 64 + 16 * s + 8 * h), qf[s], a);
            const float sc = dir == 0 ? cf : cr;
#pragma unroll
            for (int r = 0; r < 16; ++r) accO[et][r] += sc * a[r]; } }
    float s1 = 0.f;
#pragma unroll
    for (int et = 0; et < 2; ++et)
#pragma unroll
        for (int r = 0; r < 16; ++r) s1 += accO[et][r];
    s1 = xor32_sum(s1); const float mu = s1 * (1.f / 64.f);
    float s2 = 0.f;
#pragma unroll
    for (int et = 0; et < 2; ++et)
#pragma unroll
        for (int r = 0; r < 16; ++r) { const float dlt = accO[et][r] - mu; s2 += dlt * dlt; }
    s2 = xor32_sum(s2); const float rstd = __builtin_amdgcn_rsqf(s2 * (1.f / 64.f) + EPSN);
    const size_t tok = (size_t)(tok0 + iq);
#pragma unroll
    for (int et = 0; et < 2; ++et)
#pragma unroll
        for (int q = 0; q < 4; ++q) { const int e0 = hd * 64 + et * 32 + 8 * q + 4 * h;
            const f32x4 gv = *(const f32x4*)(gn + e0); const u32x2 gg = *(const u32x2*)(RG + tok * 256 + e0);
            const float g0 = bflo(gg.x), g1 = bfhi(gg.x), g2 = bflo(gg.y), g3 = bfhi(gg.y);
            u32x2 w; w.x = pk2(silu_(g0) * (accO[et][4 * q] - mu) * rstd * gv[0], silu_(g1) * (accO[et][4 * q + 1] - mu) * rstd * gv[1]);
            w.y = pk2(silu_(g2) * (accO[et][4 * q + 2] - mu) * rstd * gv[2], silu_(g3) * (accO[et][4 * q + 3] - mu) * rstd * gv[3]);
            *(u32x2*)(MIX + tok * 1024 + 512 + e0) = w; }
}

__device__ __forceinline__ int na_tile_tok(int t, int b, int rs) { const int tb = t - 8; return t >= 8 ? b * SEQ + (rs + (tb >> 1)) * 64 + (tb & 1) * 32 : LROWS + b * CTXL + t * 32; }
__device__ __forceinline__ void na_item(const bf16* NQ, const bf16* NK, const bf16* NVT, bf16* MIX, const LAS float* rpb2, LAS unsigned char* wl, bool ctxq, int b, int r, int hd, int qs, int lane) {
    const int li = lane & 31, h = lane >> 5;
    const int tokq = ctxq ? LROWS + b * CTXL + qs * 32 + li : b * SEQ + r * 64 + qs * 32 + li;
    bf16x8 qf[4];
#pragma unroll
    for (int s = 0; s < 4; ++s) qf[s] = ldg8(NQ + (size_t)tokq * 256 + hd * 64 + 16 * s + 8 * h);
    float mrun = -1e30f, lrun = 0.f;
    f32x16 accO[2] = {zero16(), zero16()};
    const int rs = r - 4 < 0 ? 0 : (r - 4 > 120 ? 120 : r - 4);
    const int qc = qs * 32 + li, cs = qc - 8 < 0 ? 0 : (qc - 8 > 48 ? 48 : qc - 8);
    const int ntile = ctxq ? 8 : 24;
    const float c1 = 0.125f * LOG2E;
    const bf16* Kh = NK + hd * 64; const bf16* VTh = NVT + (size_t)hd * 64 * R;
    KVTile T; kv_tile_load(T, Kh, VTh, na_tile_tok(0, b, rs), lane); kv_tile_store(T, wl, lane);
#pragma unroll 1
    for (int t = 0; t < ntile; ++t) {
        const bool band = t >= 8; const int tb = t - 8, rr = rs + (tb >> 1), ct = tb & 1;
        kv_tile_load(T, Kh, VTh, na_tile_tok(t + 1 < ntile ? t + 1 : t, b, rs), lane);
        bf16x8 kf[4], vf[2][2]; kv_tile_frags(wl, lane, kf, vf);
        f32x16 st = zero16();
#pragma unroll
        for (int s = 0; s < 4; ++s) st = mma32(kf[s], qf[s], st);
        float mt = -INFINITY;
        if (band) { const int dr = rr - r + 7; const LAS float* bp = rpb2 + ((hd * 15 + dr) * 31 + 32 * ct - qc + 15 + 4 * h); const int d0 = 32 * ct + 4 * h - cs;
#pragma unroll
            for (int g = 0; g < 16; ++g) { const int o = 8 * (g >> 2) + (g & 3); const bool inw = (unsigned)(d0 + o) < 16u;
                const float v = inw ? st[g] * c1 + bp[o] : -INFINITY; st[g] = v; mt = fmaxf(mt, v); }
        } else {
#pragma unroll
            for (int g = 0; g < 16; ++g) { const float v = st[g] * c1; st[g] = v; mt = fmaxf(mt, v); }
        }
        mt = xor32_max(mt);
        const float mnew = fmaxf(mrun, mt);
        if (__builtin_amdgcn_ballot_w64(mnew > mrun)) { const float alpha = ex2(mrun - mnew); lrun *= alpha;
#pragma unroll
            for (int et = 0; et < 2; ++et)
#pragma unroll
                for (int g = 0; g < 16; ++g) accO[et][g] *= alpha; }
        mrun = mnew;
        float ps = 0.f;
#pragma unroll
        for (int g = 0; g < 16; ++g) { const float p = ex2(st[g] - mnew); st[g] = p; ps += p; }
        lrun += xor32_sum(ps);
        const bf16x8 p0 = accB<0>(st), p1 = accB<1>(st);
        accO[0] = mma32(vf[0][0], p0, accO[0]); accO[0] = mma32(vf[0][1], p1, accO[0]); accO[1] = mma32(vf[1][0], p0, accO[1]); accO[1] = mma32(vf[1][1], p1, accO[1]);
        kv_tile_store(T, wl, lane);
    }
    const float inv = 1.f / lrun;
#pragma unroll
    for (int et = 0; et < 2; ++et)
#pragma unroll
        for (int q = 0; q < 4; ++q) { u32x2 w; w.x = pk2(accO[et][4 * q] * inv, accO[et][4 * q + 1] * inv); w.y = pk2(accO[et][4 * q + 2] * inv, accO[et][4 * q + 3] * inv);
            *(u32x2*)(MIX + (size_t)tokq * 1024 + 768 + hd * 64 + et * 32 + 8 * q + 4 * h) = w; }
}

__device__ __forceinline__ void fft1_item(const bf16* F, const bf16* W128T, const float* TWC, const float* TWS, bf16* FB, int item, int lane) {
    const int l2 = item & 63, g = (item >> 6) & 3, b = item >> 8, li = lane & 31, h = lane >> 5;
    bf16x8 idf[4];
#pragma unroll
    for (int s = 0; s < 4; ++s) { float v[8];
#pragma unroll
        for (int j = 0; j < 8; ++j) v[j] = (16 * (s & 1) + 8 * h + j == li) ? 1.f : 0.f;
        idf[s] = pack8(v); }
    bf16x8 xb[4][2][2];
#pragma unroll
    for (int lt = 0; lt < 4; ++lt) {
        const bf16* xp = F + (size_t)(b * SEQ + 64 * (lt * 32 + li) + l2) * 256 + g * 64 + 8 * h;
        const bf16x8 x0 = ldg8(xp), x1 = ldg8(xp + 16), x2 = ldg8(xp + 32), x3 = ldg8(xp + 48);
        f32x16 c0 = zero16(), c1 = zero16();
        c0 = mma32(x0, idf[0], c0); c0 = mma32(x1, idf[1], c0);
        c1 = mma32(x2, idf[0], c1); c1 = mma32(x3, idf[1], c1);
        xb[lt][0][0] = accB<0>(c0); xb[lt][0][1] = accB<1>(c0); xb[lt][1][0] = accB<0>(c1); xb[lt][1][1] = accB<1>(c1);
    }
#pragma unroll 1
    for (int kb = 0; kb < 4; ++kb) {
        f32x16 acc[2][2];
#pragma unroll
        for (int ri = 0; ri < 2; ++ri) { acc[ri][0] = zero16(); acc[ri][1] = zero16();
            const bf16* wp = W128T + ((size_t)ri * 128 + kb * 32 + li) * 128 + 4 * h;
#pragma unroll
            for (int lt = 0; lt < 4; ++lt)
#pragma unroll
                for (int s = 0; s < 2; ++s) { const bf16x8 wf = ldg8p(wp + lt * 32 + 16 * s);
                    acc[ri][0] = mma32(wf, xb[lt][0][s], acc[ri][0]); acc[ri][1] = mma32(wf, xb[lt][1][s], acc[ri][1]); } }
#pragma unroll
        for (int q = 0; q < 4; ++q) { const int k1 = kb * 32 + 8 * q + 4 * h;
            const f32x4 tc = *(const f32x4*)(TWC + l2 * 128 + k1), ts = *(const f32x4*)(TWS + l2 * 128 + k1);
#pragma unroll
            for (int j = 0; j < 4; ++j)
#pragma unroll
                for (int ct = 0; ct < 2; ++ct) { const float ar = acc[0][ct][4 * q + j], ai = acc[1][ct][4 * q + j];
                    const float br = ar * tc[j] + ai * ts[j], bi = ai * tc[j] - ar * ts[j];
                    bf16* o = FB + ((((size_t)(b * 4 + g) * 128 + k1 + j) * 2) * 64 + l2) * 64 + ct * 32 + li;
                    o[0] = (bf16)(pk2(br, 0.f) & 0xffffu); o[64 * 64] = (bf16)(pk2(bi, 0.f) & 0xffffu); } }
    }
}
__device__ __forceinline__ void fft2_item(const bf16* FB, const bf16* FCT, const bf16* W64T, bf16* MIX, int item, int lane) {
    const int mh = item & 1, k1 = (item >> 1) & 127, g = (item >> 8) & 3, b = item >> 10, li = lane & 31, h = lane >> 5;
    const bf16* br = FB + (((size_t)(b * 4 + g) * 128 + k1) * 2) * 64 * 64; const bf16* bi = br + 64 * 64;
    const bf16* fc = FCT + (size_t)(mh * 32 + li) * 64 + 8 * h; const bf16* fs = fc + 64 * 64; const bf16* fn = fc + 2 * 64 * 64;
    bf16x8 eb[2][2][2];
#pragma unroll
    for (int lt = 0; lt < 2; ++lt) { f32x16 er = zero16(), ei = zero16();
#pragma unroll
        for (int s = 0; s < 4; ++s) { const bf16x8 ar = ldg8(br + (size_t)(lt * 32 + li) * 64 + 16 * s + 8 * h), ai = ldg8(bi + (size_t)(lt * 32 + li) * 64 + 16 * s + 8 * h);
            const bf16x8 c = ldg8(fc + 16 * s), sn = ldg8(fs + 16 * s), ns = ldg8(fn + 16 * s);
            er = mma32(ar, c, er); er = mma32(ai, sn, er); ei = mma32(ai, c, ei); ei = mma32(ar, ns, ei); }
        eb[lt][0][0] = accB<0>(er); eb[lt][0][1] = accB<1>(er); eb[lt][1][0] = accB<0>(ei); eb[lt][1][1] = accB<1>(ei); }
#pragma unroll
    for (int kt = 0; kt < 2; ++kt) { f32x16 o = zero16();
        const bf16* wc = W64T + (size_t)(kt * 32 + li) * 64 + 4 * h; const bf16* wsn = wc + 64 * 64;
#pragma unroll
        for (int lt = 0; lt < 2; ++lt)
#pragma unroll
            for (int s = 0; s < 2; ++s) { o = mma32(ldg8p(wc + lt * 32 + 16 * s), eb[lt][0][s], o); o = mma32(ldg8p(wsn + lt * 32 + 16 * s), eb[lt][1][s], o); }
#pragma unroll
        for (int rg = 0; rg < 16; ++rg) { const int k2 = kt * 32 + DROW(rg, h);
            MIX[(size_t)(b * SEQ + k1 + 128 * k2) * 1024 + g * 64 + mh * 32 + li] = (bf16)(pk2(o[rg], 0.f) & 0xffffu); } }
}
__device__ __forceinline__ void fftc_item(const bf16* F, const bf16* FCT, const bf16* W256T, bf16* MIX, int item, int lane) {
    const int mh = item & 1, kb = (item >> 1) & 7, g = (item >> 4) & 3, b = item >> 6, li = lane & 31, h = lane >> 5;
    const bf16* fc = FCT + (size_t)(mh * 32 + li) * 64 + 8 * h; const bf16* fn = fc + 2 * 64 * 64;
    const bf16* wc = W256T + (size_t)(kb * 32 + li) * 256 + 4 * h; const bf16* wsn = wc + 256 * 256;
    f32x16 o = zero16();
#pragma unroll 1
    for (int lt = 0; lt < 8; ++lt) { f32x16 zr = zero16(), zi = zero16();
        const bf16* xp = F + (size_t)(LROWS + b * CTXL + lt * 32 + li) * 256 + g * 64 + 8 * h;
#pragma unroll
        for (int s = 0; s < 4; ++s) { const bf16x8 x = ldg8(xp + 16 * s); zr = mma32(x, ldg8(fc + 16 * s), zr); zi = mma32(x, ldg8(fn + 16 * s), zi); }
        o = mma32(ldg8p(wc + lt * 32), accB<0>(zr), o); o = mma32(ldg8p(wc + lt * 32 + 16), accB<1>(zr), o);
        o = mma32(ldg8p(wsn + lt * 32), accB<0>(zi), o); o = mma32(ldg8p(wsn + lt * 32 + 16), accB<1>(zi), o); }
#pragma unroll
    for (int rg = 0; rg < 16; ++rg) { const int k = kb * 32 + DROW(rg, h);
        MIX[(size_t)(LROWS + b * CTXL + k) * 1024 + g * 64 + mh * 32 + li] = (bf16)(pk2(o[rg], 0.f) & 0xffffu); }
}
__device__ __forceinline__ void row_ld_f32(const float* p, int lane, f32x4 (&v)[4]) {
#pragma unroll
    for (int j = 0; j < 4; ++j) v[j] = *(const f32x4*)(p + 256 * j + 4 * lane); }
__device__ __forceinline__ void row_ld_bf16(const bf16* p, int lane, f32x4 (&v)[4]) {
#pragma unroll
    for (int j = 0; j < 4; ++j) { const u32x2 w = *(const u32x2*)(p + 256 * j + 4 * lane); v[j] = (f32x4){bflo(w.x), bfhi(w.x), bflo(w.y), bfhi(w.y)}; } }
__device__ __forceinline__ void row_st_f32(float* p, int lane, const f32x4 (&v)[4]) {
#pragma unroll
    for (int j = 0; j < 4; ++j) *(f32x4*)(p + 256 * j + 4 * lane) = v[j]; }
__device__ __forceinline__ void row_st_bf16(bf16* p, int lane, const f32x4 (&v)[4]) {
#pragma unroll
    for (int j = 0; j < 4; ++j) { u32x2 w; w.x = pk2(v[j][0], v[j][1]); w.y = pk2(v[j][2], v[j][3]); *(u32x2*)(p + 256 * j + 4 * lane) = w; } }
__device__ __forceinline__ float row_rstd(const f32x4 (&v)[4]) { float s = 0.f;
#pragma unroll
    for (int j = 0; j < 4; ++j) s += (v[j][0] * v[j][0] + v[j][1] * v[j][1]) + (v[j][2] * v[j][2] + v[j][3] * v[j][3]);
    return __builtin_amdgcn_rsqf(wave_sum(s) * (1.f / 1024.f) + EPSN); }
__device__ __forceinline__ void row_modnorm(const f32x4 (&x)[4], const float* g, const float* sc, const float* sh, int lane, f32x4 (&hh)[4]) {
    const float rs = row_rstd(x); f32x4 gv[4], scv[4], shv[4]; row_ld_f32(g, lane, gv); row_ld_f32(sc, lane, scv); row_ld_f32(sh, lane, shv);
#pragma unroll
    for (int j = 0; j < 4; ++j) hh[j] = x[j] * rs * gv[j] * (scv[j] + 1.f) + shv[j]; }
__device__ __forceinline__ void row_resid(f32x4 (&x)[4], const f32x4 (&t)[4], const float* g, const float* gate, int lane) {
    const float rs = row_rstd(t); f32x4 gv[4], ga[4]; row_ld_f32(g, lane, gv); row_ld_f32(gate, lane, ga);
#pragma unroll
    for (int j = 0; j < 4; ++j) x[j] = x[j] + ga[j] * (t[j] * rs * gv[j]); }

__device__ __forceinline__ void transpose_item(const float* W, int ldw, int k0, int n0, bf16* dst, int ldd, float scale, LAS float* scr, int lane) {
#pragma unroll 8
    for (int i = 0; i < 32; ++i) { const int kk = 2 * i + (lane >> 5); scr[kk * 33 + (lane & 31)] = W[(size_t)(k0 + kk) * ldw + n0 + (lane & 31)]; }
    LDS_WAIT(); asm volatile("" ::: "memory");
    const int c = lane & 7;
#pragma unroll
    for (int j = 0; j < 4; ++j) { const int n = (lane >> 3) + 8 * j; const LAS float* s = scr + (8 * c) * 33 + n;
        u32x4 o; o.x = pk2(s[0 * 33] * scale, s[1 * 33] * scale); o.y = pk2(s[2 * 33] * scale, s[3 * 33] * scale); o.z = pk2(s[4 * 33] * scale, s[5 * 33] * scale); o.w = pk2(s[6 * 33] * scale, s[7 * 33] * scale);
        *(u32x4*)(dst + (size_t)n * ldd + k0 + 8 * c) = o; }
    LDS_WAIT(); asm volatile("" ::: "memory");
}
#ifndef MK_MODE
#define MK_MODE 1
#endif
#ifndef MK_LAST
#define MK_LAST 24
#endif
constexpr int NPHASE = 24;
struct Args { const float* in[31]; float* out; unsigned char* ws; int ph_lo, ph_hi, li, pad; };


struct TrJob { const float* src; bf16* dst; int ldw, k0, n0, ldd; float scale; };
#define CAS __attribute__((address_space(4)))
__device__ __forceinline__ void tr_decode(int it, const CAS Args* ap_, unsigned char* ws, TrJob& J) {
#define TIN(k) ((const float*)(const GAS float*)ap_->in[k])
    int kb; J.scale = 1.f;
    if (it < 43008) { const int e = it / 5376, r = it % 5376, w = r / 1792, li = r % 1792;
        if (w < 2) { J.src = TIN(28 + w) + (size_t)e * 1024 * DFE; J.ldw = DFE; kb = li / 112; J.n0 = (li % 112) * 32; J.ldd = 1024;
            J.dst = (bf16*)(ws + WS_MOE1) + ((size_t)e * 7168 + 256 * (J.n0 / 128) + (J.n0 % 128) + 128 * w) * 1024; }
        else { J.src = TIN(30) + (size_t)e * DFE * 1024; J.ldw = 1024; kb = li / 32; J.n0 = (li % 32) * 32; J.ldd = DFE; J.dst = (bf16*)(ws + WS_MOE2) + ((size_t)e * 1024 + J.n0) * DFE; }
    } else if (it < 47232) { const int r = it - 43008, w = r / 1408, li = r % 1408;
        if (w < 2) { J.src = TIN(23 + w); J.ldw = DFF; kb = li / 88; J.n0 = (li % 88) * 32; J.ldd = 1024; J.dst = (bf16*)(ws + WS_FFN1) + (size_t)(256 * (J.n0 / 128) + (J.n0 % 128) + 128 * w) * 1024; }
        else { J.src = TIN(25); J.ldw = 1024; kb = li / 32; J.n0 = (li % 32) * 32; J.ldd = DFF; J.dst = (bf16*)(ws + WS_FFN2) + (size_t)J.n0 * DFF; }
    } else { const int r = it - 47232, l = r / 4384, q = r % 4384;
        if (q < 3328) { const int t = q / 128, li = q % 128; kb = li / 8; const int nb = li % 8;
            const int srcc = t < 4 ? 256 * t : (t < 7 ? 256 * (t + 1) : (t < 23 ? 2304 + 256 * (t - 7) : (t == 23 ? 768 : (t == 24 ? 1024 : 2048))));
            J.src = TIN(7) + (size_t)l * 1024 * 6400; J.ldw = 6400; J.n0 = srcc + 32 * nb; J.ldd = 1024; J.dst = (bf16*)(ws + WS_WIN) + ((size_t)(l * 26 + t) * 256 + 32 * nb) * 1024; J.scale = (t == 3 || t == 23) ? 0.125f : 1.f; }
        else if (q < 3360) { const int li = q - 3328; kb = li / 8; J.n0 = (li % 8) * 32; J.src = TIN(16) + (size_t)l * 65536; J.ldw = 256; J.ldd = 256; J.dst = (bf16*)(ws + WS_WGLU) + ((size_t)l * 256 + J.n0) * 256; }
        else if (q < 3872) { const int li = q - 3360, bb = li / 128, li2 = li % 128; kb = li2 / 32; J.n0 = (li2 % 32) * 32; J.src = TIN(21) + (size_t)(l * 4 + bb) * 256 * 1024; J.ldw = 1024; J.ldd = 256; J.dst = (bf16*)(ws + WS_WBR) + ((size_t)(l * 4 + bb) * 1024 + J.n0) * 256; }
        else { const int li = q - 3872; kb = li / 32; J.n0 = (li % 32) * 32; J.src = TIN(22) + (size_t)l * 1024 * 1024; J.ldw = 1024; J.ldd = 1024; J.dst = (bf16*)(ws + WS_WOUT) + ((size_t)l * 1024 + J.n0) * 1024; }
    }
    J.k0 = kb * 64;
#undef TIN
}
__device__ __forceinline__ void tr_load(const TrJob& J, int lane, float (&v)[32]) {
#pragma unroll
    for (int i = 0; i < 32; ++i) { const int kk = 2 * i + (lane >> 5); v[i] = J.src[(size_t)(J.k0 + kk) * J.ldw + J.n0 + (lane & 31)]; } }
__device__ __forceinline__ void tr_store(const TrJob& J, int lane, const float (&v)[32], LAS float* scr) {
#pragma unroll
    for (int i = 0; i < 32; ++i) { const int kk = 2 * i + (lane >> 5); scr[kk * 33 + (lane & 31)] = v[i]; }
    LDS_WAIT(); asm volatile("" ::: "memory");
    const int c = lane & 7;
#pragma unroll
    for (int j = 0; j < 4; ++j) { const int n = (lane >> 3) + 8 * j; const LAS float* s = scr + (8 * c) * 33 + n; const float sc = J.scale;
        u32x4 o; o.x = pk2(s[0 * 33] * sc, s[1 * 33] * sc); o.y = pk2(s[2 * 33] * sc, s[3 * 33] * sc); o.z = pk2(s[4 * 33] * sc, s[5 * 33] * sc); o.w = pk2(s[6 * 33] * sc, s[7 * 33] * sc);
        *(u32x4*)(J.dst + (size_t)n * J.ldd + J.k0 + 8 * c) = o; }
    LDS_WAIT(); asm volatile("" ::: "memory");
}

__device__ __forceinline__ void cs2pi(int m, int N, float& c, float& s) { sincospif(2.0f * (float)(m % N) / (float)N, &s, &c); }

__global__ void __launch_bounds__(NTHREADS, 2) mk_fwd(Args args) {
    extern __shared__ __attribute__((aligned(16))) unsigned char lds_raw[];
    LAS unsigned char* lds = (LAS unsigned char*)lds_raw;
    const int tid0 = threadIdx.x, wave = __builtin_amdgcn_readfirstlane(tid0 >> 6);
    const int G = gridDim.x, bx = blockIdx.x, vcu = (G % 8 == 0) ? (bx % 8) * (G / 8) + bx / 8 : bx;
    const int wslot = wave * G + vcu, NW = G * NWAVES;
    volatile LAS unsigned* lctl = (volatile LAS unsigned*)(lds + LDSCTL_OFF);
    for (int u = tid0; u < (LDS_BYTES - LDSCTL_OFF) / 4; u += NTHREADS) lctl[u] = 0u;
    __syncthreads();
    const int lo = args.ph_lo, hi = args.ph_hi, bli = args.li;
#ifdef MK_STAMP_PHASE
    if (wave == 0) *(volatile LAS unsigned long long*)(lctl + 64) = __builtin_amdgcn_s_memrealtime();
#endif
    { XcdBarrier b0 = xcd_barrier_post((unsigned*)(args.ws + WS_CTL) + CW_BAR + bli * XCD_BAR_WORDS, lctl + LW_BAR); (void)b0; }
#define IN(k) (lo <= (k) && (k) < hi)
#ifndef MK_REP_MASK
#define MK_REP_MASK 0u
#endif
#define NREP(k) (((MK_REP_MASK >> (k)) & 1u) ? 2 : 1)
#define FORCE_BAR do { PH_BEGIN XcdBarrier b_; b_.bar = (unsigned*)(ws + WS_CTL) + CW_BAR + bli * XCD_BAR_WORDS; b_.x = xb_xcc_id(); b_.st = lctl + LW_BAR; xcd_barrier(b_); } while (0)
#ifdef MK_STAMP_PHASE
#define STAMP_AT(k) do { if (wave == 0) { if ((k) == MK_STAMP_PHASE - 1) *(volatile LAS unsigned long long*)(lctl + 64) = __builtin_amdgcn_s_memrealtime(); if ((k) == MK_STAMP_PHASE) *(volatile LAS unsigned long long*)(lctl + 66) = __builtin_amdgcn_s_memrealtime(); } } while (0)
#else
#define STAMP_AT(k) do { } while (0)
#endif
#define SEAM(k) do { if (IN(k) && IN((k) + 1)) { PH_BEGIN XcdBarrier b_; b_.bar = (unsigned*)(ws + WS_CTL) + CW_BAR + bli * XCD_BAR_WORDS; b_.x = xb_xcc_id(); b_.st = lctl + LW_BAR; xcd_barrier(b_); } STAMP_AT(k); } while (0)
#define PH_BEGIN int tid; { int l_; asm volatile("v_mbcnt_lo_u32_b32 %0, -1, 0\n\tv_mbcnt_hi_u32_b32 %0, -1, %0" : "=v"(l_)); tid = wave * 64 + (l_ & 63); } const CAS Args* ap_ = (const CAS Args*)__builtin_amdgcn_kernarg_segment_ptr(); asm volatile("" : "+s"(ap_)); unsigned char* ws = (unsigned char*)(GAS unsigned char*)ap_->ws; const int lane = tid & 63; (void)lane;
#define AIN(k) ((const float*)(const GAS float*)ap_->in[k])
#define AOUT ((float*)(GAS float*)ap_->out)
#define MODp ((float*)(ws + CTL_MOD_OFF))
#define ctxbuf ((float*)(ws + WS_CTXBUF))
#define Hh ((bf16*)(ws + WS_H))
#define MIX ((bf16*)(ws + WS_MIX))
#define INP ((bf16*)(ws + WS_INP))
#define Tt ((bf16*)(ws + WS_T))

    for (int rep_ = 0; rep_ < NREP(0); ++rep_) if (IN(0)) { if (rep_) { FORCE_BAR; } PH_BEGIN
        for (int it = bx; it < 32; it += G) {
            const int l = it >> 4, g = it & 15;
            LAS f32x2* apow = (LAS f32x2*)lds; LAS f32x2* bbar = (LAS f32x2*)(lds + 8704); LAS f32x2* Cc = (LAS f32x2*)(lds + 16896); LAS float* Kt = (LAS float*)(lds + 25088);
            for (int dir = 0; dir < 2; ++dir) { const size_t pg = (size_t)(l * 2 + dir) * 16 + g;
                if (tid < 64) { const int p = tid;
                    const float are = AIN(8)[pg * 64 + p], aim = AIN(9)[pg * 64 + p], dt = expf(AIN(10)[pg]);
                    for (int t = 0; t <= 16; ++t) { const float mag = expf(are * dt * (float)t); float sn, cs; sincosf(aim * dt * (float)t, &sn, &cs); apow[t * 64 + p] = (f32x2){mag * cs, mag * sn}; }
                    const f32x2 a = apow[64 + p]; const float nr = a.x - 1.f, ni = a.y, den = 1.f / (are * are + aim * aim);
                    const float cr = (nr * are + ni * aim) * den, ci = (ni * are - nr * aim) * den;
                    for (int h = 0; h < 16; ++h) { const float br = AIN(11)[(pg * 64 + p) * 16 + h], bi = AIN(12)[(pg * 64 + p) * 16 + h]; bbar[p * 16 + h] = (f32x2){cr * br - ci * bi, cr * bi + ci * br}; }
                    *(f32x2*)((float*)(ws + WS_A16) + (pg * 64 + p) * 2) = apow[16 * 64 + p];
                }
                for (int i = tid; i < 1024; i += NTHREADS) Cc[i] = (f32x2){AIN(13)[pg * 1024 + i], AIN(14)[pg * 1024 + i]};
                __syncthreads();
                bf16* M1 = (bf16*)(ws + WS_S5M1) + ((size_t)(l * 16 + g) * 2 + dir) * 128 * 256;
                for (int v = tid; v < 4096; v += NTHREADS) { const int row = v >> 5, col0 = (v & 31) * 8, j = col0 >> 4, h0 = col0 & 15, p = row >> 1, ri = row & 1;
                    const f32x2 pw = apow[(dir == 0 ? 15 - j : j) * 64 + p]; float vals[8];
#pragma unroll
                    for (int hh = 0; hh < 8; ++hh) { const f32x2 bb = bbar[p * 16 + h0 + hh]; vals[hh] = ri ? pw.x * bb.y + pw.y * bb.x : pw.x * bb.x - pw.y * bb.y; }
                    *(bf16x8*)(M1 + ((((col0 >> 4) * 4 + (row >> 5)) * 64 + ((col0 >> 3) & 1) * 32 + (row & 31)) * 8)) = pack8(vals); }
                bf16* TAB = (bf16*)(ws + WS_S5TAB) + (size_t)(l * 16 + g) * 256 * 512;
                for (int v = tid; v < 4096; v += NTHREADS) { const int row = v >> 4, cv = v & 15, i = row >> 4, ho = row & 15; float vals[8];
#pragma unroll
                    for (int pp = 0; pp < 4; ++pp) { const int p = cv * 4 + pp; const f32x2 cc = Cc[ho * 64 + p];
                        const f32x2 pw = apow[(dir == 0 ? i + 1 : 16 - i) * 64 + p]; vals[2 * pp] = cc.x * pw.x - cc.y * pw.y; vals[2 * pp + 1] = -(cc.x * pw.y + cc.y * pw.x); }
                    { const int colt = 256 + dir * 128 + cv * 8; *(bf16x8*)(TAB + (((((row >> 7) * 32 + (colt >> 4)) * 4 + ((row >> 5) & 3)) * 64 + ((colt >> 3) & 1) * 32 + (row & 31)) * 8)) = pack8(vals); } }
                for (int e = tid; e < 4096; e += NTHREADS) { const int t = e >> 8, ho = (e >> 4) & 15, h = e & 15; float acc = 0.f;
#pragma unroll 8
                    for (int p = 0; p < 64; ++p) { const f32x2 cc = Cc[ho * 64 + p], pw = apow[t * 64 + p], bb = bbar[p * 16 + h];
                        const float xr = cc.x * pw.x - cc.y * pw.y, xi = cc.x * pw.y + cc.y * pw.x; acc += xr * bb.x - xi * bb.y; }
                    Kt[dir * 4096 + e] = acc; }
                __syncthreads();
            }
            for (int v = tid; v < 8192; v += NTHREADS) { const int row = v >> 5, col0 = (v & 31) * 8, i = row >> 4, ho = row & 15, j = col0 >> 4, h0 = col0 & 15; float vals[8];
#pragma unroll
                for (int hh = 0; hh < 8; ++hh) { const int h = h0 + hh;
                    vals[hh] = j < i ? Kt[(i - j) * 256 + ho * 16 + h] : (j > i ? Kt[4096 + (j - i) * 256 + ho * 16 + h] : Kt[ho * 16 + h] + Kt[4096 + ho * 16 + h] + (ho == h ? AIN(15)[l * 256 + g * 16 + h] : 0.f)); }
                *(bf16x8*)((bf16*)(ws + WS_S5TAB) + (size_t)(l * 16 + g) * 256 * 512 + (((((row >> 7) * 32 + (col0 >> 4)) * 4 + ((row >> 5) & 3)) * 64 + ((col0 >> 3) & 1) * 32 + (row & 31)) * 8)) = pack8(vals); }
            __syncthreads();
        }
        __syncthreads();
        for (int it = (bx >= 32 ? bx - 32 : bx + G - 32); it < 192; it += G) { const int l = it / 96, cb = it % 96, col = cb * 64 + lane, ks = wave;
            const float* wm = AIN(4) + ((size_t)l * 1024 + ks * 128) * 6144 + col; float a0 = 0.f, a1 = 0.f, a2 = 0.f;
#pragma unroll 8
            for (int k = 0; k < 128; ++k) { const float w = wm[(size_t)k * 6144]; const int kk = ks * 128 + k;
                const float c0 = AIN(1)[kk], c1 = AIN(1)[1024 + kk], c2 = AIN(3)[kk];
                a0 += w * (c0 / (1.f + __expf(-c0))); a1 += w * (c1 / (1.f + __expf(-c1))); a2 += w * (c2 / (1.f + __expf(-c2))); }
            LAS float* part = (LAS float*)lds;
            part[(wave * 3 + 0) * 64 + lane] = a0; part[(wave * 3 + 1) * 64 + lane] = a1; part[(wave * 3 + 2) * 64 + lane] = a2;
            __syncthreads();
            if (tid < 192) { const int i = tid >> 6, c = tid & 63; float sacc = AIN(5)[l * 6144 + cb * 64 + c];
#pragma unroll
                for (int w = 0; w < 8; ++w) sacc += part[(w * 3 + i) * 64 + c];
                MODp[(size_t)(l * 3 + i) * 6144 + cb * 64 + c] = sacc; }
            __syncthreads();
        }
        { LAS float* scr = (LAS float*)(lds + wave * 16384);
          unsigned* qh = (unsigned*)(ws + WS_CTL) + CW_QHEAD;
          int q = bx & 7;
          for (int tries = 0; tries < 8; ) {
            unsigned base = 0u; if (lane == 0) base = __hip_atomic_fetch_add(qh + 64 * q, 2u, __ATOMIC_RELAXED, __HIP_MEMORY_SCOPE_AGENT);
            base = (unsigned)__builtin_amdgcn_readfirstlane((int)base);
            if (base >= 7000u) { q = (q + 1) & 7; ++tries; continue; }
            float va[32], vb[32]; TrJob ja, jb; const bool two = base + 1u < 7000u;
            tr_decode(q * 7000 + (int)base, ap_, ws, ja); tr_load(ja, lane, va);
            tr_decode(q * 7000 + (int)base + (two ? 1 : 0), ap_, ws, jb); tr_load(jb, lane, vb);
            tr_store(ja, lane, va, scr); if (two) tr_store(jb, lane, vb, scr);
          } }
        for (int v = wslot * 64 + lane; v < 32 * SEQ; v += NW * 64) { const int p = v >> 13, t = v & 8191; const float pos = (float)(p < 16 ? (t >> 6) : (t & 63));
            const float inv = 1.0f / powf(10000.f, (float)(p & 15) / 16.f); float sn, cs; sincosf(pos * inv, &sn, &cs);
            ((float*)(ws + WS_COST))[v] = cs; ((float*)(ws + WS_SINT))[v] = sn; ((float*)(ws + WS_COSN))[t * 32 + p] = cs; ((float*)(ws + WS_SINN))[t * 32 + p] = sn; }
        for (int v = wslot * 64 + lane; v < 192512; v += NW * 64) { float c, s;
            if (v < 32768) { const int ri = v >> 14, k1 = (v >> 7) & 127, l1 = v & 127; cs2pi(k1 * l1, 128, c, s); const float sc = 0.08838834764831845f;
                ((bf16*)(ws + WS_W128T))[v] = (bf16)(pk2(ri ? -s * sc : c * sc, 0.f) & 0xffffu); }
            else if (v < 40960) { const int u = v - 32768, l2 = u >> 7, k1 = u & 127; cs2pi(k1 * l2, 8192, c, s); ((float*)(ws + WS_TWC))[u] = c; ((float*)(ws + WS_TWS))[u] = s; }
            else if (v < 53248) { const int u = v - 40960, w = u >> 12, m = (u >> 6) & 63, cc = u & 63; cs2pi(m * cc, 64, c, s);
                ((bf16*)(ws + WS_FCT))[u] = (bf16)(pk2((w == 0 ? c : (w == 1 ? s : -s)) * 0.125f, 0.f) & 0xffffu); }
            else if (v < 61440) { const int u = v - 53248, w = u >> 12, k2 = (u >> 6) & 63, l2 = u & 63; cs2pi(k2 * l2, 64, c, s); ((bf16*)(ws + WS_W64T))[u] = (bf16)(pk2((w == 0 ? c : s) * 0.125f, 0.f) & 0xffffu); }
            else { const int u = v - 61440, w = u >> 16, k = (u >> 8) & 255, l = u & 255; cs2pi(k * l, 256, c, s); ((bf16*)(ws + WS_W256T))[u] = (bf16)(pk2((w == 0 ? c : s) * 0.0625f, 0.f) & 0xffffu); }
        }
    }
    SEAM(0);

    for (int rep_ = 0; rep_ < NREP(1); ++rep_) if (IN(1)) { if (rep_) { FORCE_BAR; } PH_BEGIN
        for (int r = wslot; r < R; r += NW) { const int ci = r < SEQ ? 0 : (r < LROWS ? 1 : 2);
            f32x4 x[4], hh[4]; row_ld_f32(r < LROWS ? AIN(0) + (size_t)r * D : AIN(2) + (size_t)(r - LROWS) * D, lane, x);
            const float* md = MODp + (size_t)ci * 6144;
            row_modnorm(x, AIN(6), md + 1024, md, lane, hh); row_st_bf16(Hh + (size_t)r * D, lane, hh); }
    }
    SEAM(1);

    for (int layer = 0; layer < 2; ++layer) {
        const int pb = 1 + 11 * layer;
        const int nM = layer == 0 ? 66 : 64;
        const int nrows = layer == 0 ? R : LROWS;
#define normg (AIN(6) + (size_t)layer * 4 * D)
        for (int rep_ = 0; rep_ < NREP(pb + 1); ++rep_) if (IN(pb + 1)) { if (rep_) { FORCE_BAR; } PH_BEGIN
            gp::SchedInprojA S{(const char*)Hh, (const char*)(ws + WS_WIN) + (size_t)layer * 26 * 256 * 2048, 66, G, bx, layer == 0 ? 32 : 0};
            gp::EpiInprojA E{INP, Tt, (unsigned char*)(ws + WS_GCTX)};
            gp::gemm_phase(lds, tid, 1024, 1024, 1024, S, E);
        }
        SEAM(pb + 1);
        for (int rep_ = 0; rep_ < NREP(pb + 2); ++rep_) if (IN(pb + 2)) { if (rep_) { FORCE_BAR; } PH_BEGIN
            LAS float* rpb = (LAS float*)(lds + 98304 + 4096);
            LAS unsigned char* wl = lds + wave * 12288;
            for (int i = tid; i < 1860; i += NTHREADS) rpb[i] = AIN(20)[layer * 1860 + i] * LOG2E;
            __syncthreads();
            const int nitA = 2224 + 64 + (layer == 0 ? 64 : 0);
            for (int it = wslot; it < nitA; it += NW) {
                if (it < 1056) s5_state_item((const bf16*)(ws + WS_S5M1) + (size_t)layer * 16 * 2 * 128 * 256, INP + (size_t)R * 256, (float*)(ws + WS_HLOC), it, lane);
                else if (it < 1584) ret_kv_item(Tt, Tt + (size_t)256 * R, (const float*)(ws + WS_COST), (const float*)(ws + WS_SINT), AIN(18) + layer * 8, (float*)(ws + WS_KV), it - 1056, lane);
                else if (it < 2096) fft1_item(INP, (const bf16*)(ws + WS_W128T), (const float*)(ws + WS_TWC), (const float*)(ws + WS_TWS), (bf16*)(ws + WS_FB), it - 1584, lane);
                else if (it < 2224) rope_item(INP + (size_t)2 * R * 256, INP + (size_t)3 * R * 256, (const float*)(ws + WS_COSN), (const float*)(ws + WS_SINN), it - 2096, lane);
                else if (it < 2288) { const int j = 1984 + (it - 2224); na_item(INP + (size_t)5 * R * 256, INP + (size_t)6 * R * 256, Tt + (size_t)512 * R, MIX, rpb, wl, false, j >> 10, (j >> 3) & 127, (j >> 1) & 3, j & 1, lane); }
                else { const int j = it - 2288; na_item(INP + (size_t)5 * R * 256, INP + (size_t)6 * R * 256, Tt + (size_t)512 * R, MIX, rpb, wl, true, j >> 5, 0, (j >> 3) & 3, j & 7, lane); }
            }
            __syncthreads();
        }
        SEAM(pb + 2);
        for (int rep_ = 0; rep_ < NREP(pb + 3); ++rep_) if (IN(pb + 3)) { if (rep_) { FORCE_BAR; } PH_BEGIN
            LAS float* rpb = (LAS float*)(lds + 98304 + 4096); LAS unsigned char* wl = lds + wave * 12288;
            for (int i = tid; i < 1860; i += NTHREADS) rpb[i] = AIN(20)[layer * 1860 + i] * LOG2E;
            __syncthreads();
            for (int vs = wslot; vs < 2048; vs += NW) {
                if (vs < 64) s5_scan_item((const float*)(ws + WS_A16) + (size_t)layer * 2 * 16 * 64 * 2, (const float*)(ws + WS_HLOC), (bf16*)(ws + WS_HIN), vs, lane);
                else { const int j = vs - 64; na_item(INP + (size_t)5 * R * 256, INP + (size_t)6 * R * 256, Tt + (size_t)512 * R, MIX, rpb, wl, false, j >> 10, (j >> 3) & 127, (j >> 1) & 3, j & 1, lane);
                    if (vs >= 1024) ret_scan_item(AIN(18) + layer * 8, (const float*)(ws + WS_KV), (bf16*)(ws + WS_SPREV), vs - 1024, lane); }
            }
            __syncthreads();
        }
        SEAM(pb + 3);
        for (int rep_ = 0; rep_ < NREP(pb + 4); ++rep_) if (IN(pb + 4)) { if (rep_) { FORCE_BAR; } PH_BEGIN
            const int nit = 1056 + 2112 + 2048 + (layer == 0 ? 128 : 0);
            for (int it = wslot; it < nit; it += NW) {
                if (it < 1056) s5_out_item((const bf16*)(ws + WS_S5TAB) + (size_t)layer * 16 * 256 * 512, INP + (size_t)R * 256, (const bf16*)(ws + WS_HIN), (bf16*)(ws + WS_Z), it, lane);
                else if (it < 3168) ret_out_item(INP + (size_t)2 * R * 256, INP + (size_t)3 * R * 256, INP + (size_t)4 * R * 256, Tt + (size_t)256 * R, (const bf16*)(ws + WS_SPREV),
                                                 AIN(18) + layer * 8, AIN(19) + layer * 256, MIX, lds + wave * 12288, it - 1056, lane);
                else if (it < 5216) fft2_item((const bf16*)(ws + WS_FB), (const bf16*)(ws + WS_FCT), (const bf16*)(ws + WS_W64T), MIX, it - 3168, lane);
                else fftc_item(INP, (const bf16*)(ws + WS_FCT), (const bf16*)(ws + WS_W256T), MIX, it - 5216, lane);
            }
        }
        SEAM(pb + 4);
        for (int rep_ = 0; rep_ < NREP(pb + 5); ++rep_) if (IN(pb + 5)) { if (rep_) { FORCE_BAR; } PH_BEGIN
            { PH_BEGIN gp::SchedPlain S{(const char*)(ws + WS_Z), (const char*)(ws + WS_WGLU) + (size_t)layer * 256 * 512, (size_t)256 * 512, (size_t)256 * 512, nM, 1, G, bx};
              gp::EpiGlu E{(const bf16*)(ws + WS_Z), MIX, AIN(17) + layer * 256};
              gp::gemm_phase(lds, tid, 256, 256, 256, S, E); }
            { PH_BEGIN gp::SchedPlain S{(const char*)Hh, (const char*)(ws + WS_WIN) + ((size_t)layer * 26 + 7) * 256 * 2048, (size_t)256 * 2048, (size_t)256 * 2048, 64, 16, G, bx};
              gp::EpiGates E{(unsigned char*)(ws + WS_GATES)};
              gp::gemm_phase(lds, tid, 1024, 1024, 1024, S, E); }
        }
        SEAM(pb + 5);
        for (int rep_ = 0; rep_ < NREP(pb + 6); ++rep_) if (IN(pb + 6)) { if (rep_) { FORCE_BAR; } PH_BEGIN
            gp::SchedMerge S{(const char*)MIX, (const char*)(ws + WS_WBR) + (size_t)layer * 4 * 1024 * 512, nM, G, bx};
            gp::EpiMerge E{(const unsigned char*)(ws + WS_GATES), (const unsigned char*)(ws + WS_GCTX), (bf16*)(ws + WS_Y)};
            gp::gemm_phase(lds, tid, 256, 1024, 256, S, E);
        }
        SEAM(pb + 6);
        for (int rep_ = 0; rep_ < NREP(pb + 7); ++rep_) if (IN(pb + 7)) { if (rep_) { FORCE_BAR; } PH_BEGIN
            gp::SchedPlain S{(const char*)(ws + WS_Y), (const char*)(ws + WS_WOUT) + (size_t)layer * 1024 * 2048, (size_t)256 * 2048, (size_t)256 * 2048, nM, 4, G, bx};
            gp::EpiPlain E{(bf16*)(ws + WS_YO), 1024};
            gp::gemm_phase(lds, tid, 1024, 1024, 1024, S, E);
        }
        SEAM(pb + 7);
        for (int rep_ = 0; rep_ < NREP(pb + 8); ++rep_) if (IN(pb + 8)) { if (rep_) { FORCE_BAR; } PH_BEGIN
            if (layer == 0) {
                for (int r = wslot; r < R; r += NW) { const int ci = r < SEQ ? 0 : (r < LROWS ? 1 : 2); const float* md = MODp + (size_t)ci * 6144;
                    f32x4 x[4], t[4], hh[4]; row_ld_f32(r < LROWS ? AIN(0) + (size_t)r * D : AIN(2) + (size_t)(r - LROWS) * D, lane, x);
                    row_ld_bf16((const bf16*)(ws + WS_YO) + (size_t)r * D, lane, t);
                    row_resid(x, t, normg + D, md + 2048, lane);
                    row_st_f32(r < LROWS ? AOUT + (size_t)r * D : ctxbuf + (size_t)(r - LROWS) * D, lane, x);
                    row_modnorm(x, normg + 2 * D, md + 4096, md + 3072, lane, hh); row_st_bf16(Hh + (size_t)r * D, lane, hh); }
            } else {
                LAS float* wrs = (LAS float*)lds; LAS int* rowinfo = (LAS int*)(lds + 32768); LAS unsigned* cntL = (LAS unsigned*)(lds + 32768 + 1024); LAS unsigned* baseL = cntL + 8;
                for (int i = tid; i < 2048; i += NTHREADS) ((LAS f32x4*)wrs)[i] = ((const f32x4*)AIN(26))[i];
                int* list = (int*)(ws + WS_LIST); float* routew = (float*)(ws + WS_ROUTEW);
                for (int grp = vcu; grp < 256; grp += G) {
                    if (tid < 8) cntL[tid] = 0u;
                    __syncthreads();
                    for (int rr = 0; rr < 8; ++rr) { const int r = grp * 64 + wave * 8 + rr; const float* md = MODp + (size_t)(3 + (r < SEQ ? 0 : 1)) * 6144;
                        f32x4 x[4], t[4], hh[4]; row_ld_f32(AOUT + (size_t)r * D, lane, x); row_ld_bf16((const bf16*)(ws + WS_YO) + (size_t)r * D, lane, t);
                        row_resid(x, t, normg + D, md + 2048, lane); row_st_f32(AOUT + (size_t)r * D, lane, x);
                        row_modnorm(x, normg + 2 * D, md + 4096, md + 3072, lane, hh); row_st_bf16(Hh + (size_t)r * D, lane, hh);
                        float lg[8];
#pragma unroll
                        for (int e = 0; e < 8; ++e) lg[e] = 0.f;
#pragma unroll
                        for (int j = 0; j < 4; ++j)
#pragma unroll
                            for (int q = 0; q < 4; ++q) { const int k = 256 * j + 4 * lane + q; const f32x4 w0 = *(const LAS f32x4*)(wrs + k * 8), w1 = *(const LAS f32x4*)(wrs + k * 8 + 4); const float hv = hh[j][q];
                                lg[0] += hv * w0[0]; lg[1] += hv * w0[1]; lg[2] += hv * w0[2]; lg[3] += hv * w0[3]; lg[4] += hv * w1[0]; lg[5] += hv * w1[1]; lg[6] += hv * w1[2]; lg[7] += hv * w1[3]; }
#pragma unroll
                        for (int e = 0; e < 8; ++e) lg[e] = wave_sum(lg[e]) + AIN(27)[e];
                        int i0 = 0; float v0 = lg[0];
#pragma unroll
                        for (int e = 1; e < 8; ++e) if (lg[e] > v0) { v0 = lg[e]; i0 = e; }
                        int i1 = i0 == 0 ? 1 : 0; float v1 = i0 == 0 ? lg[1] : lg[0];
#pragma unroll
                        for (int e = 0; e < 8; ++e) if (e != i0 && lg[e] > v1) { v1 = lg[e]; i1 = e; }
                        const float w0 = 1.f / (1.f + __expf(v1 - v0)), w1 = 1.f - w0;
                        if (lane == 0) { const unsigned s0 = __hip_atomic_fetch_add(cntL + i0, 1u, __ATOMIC_RELAXED, __HIP_MEMORY_SCOPE_WORKGROUP), s1 = __hip_atomic_fetch_add(cntL + i1, 1u, __ATOMIC_RELAXED, __HIP_MEMORY_SCOPE_WORKGROUP);
                            LAS int* ri = rowinfo + (wave * 8 + rr) * 4; ri[0] = i0; ri[1] = (int)s0; ri[2] = i1; ri[3] = (int)s1; routew[(size_t)r * 2] = w0; routew[(size_t)r * 2 + 1] = w1; }
                    }
                    __syncthreads();
                    if (tid < 8) baseL[tid] = __hip_atomic_fetch_add((unsigned*)(ws + WS_CTL) + CW_MOECNT + 64 * tid, cntL[tid], __ATOMIC_RELAXED, __HIP_MEMORY_SCOPE_AGENT);
                    __syncthreads();
                    if (tid < 64) { const LAS int* ri = rowinfo + tid * 4; const int r = grp * 64 + tid;
                        list[ri[0] * LCAP + (int)baseL[ri[0]] + ri[1]] = r * 2; list[ri[2] * LCAP + (int)baseL[ri[2]] + ri[3]] = r * 2 + 1; }
                    __syncthreads();
                }
            }
        }
        SEAM(pb + 8);
        LAS unsigned* mt = (LAS unsigned*)(lds + LDSCTL_OFF) + LW_MOE;
        if (layer == 1 && (IN(pb + 9) || IN(pb + 10))) { PH_BEGIN
            if (tid == 0) { unsigned off = 0u;
                for (int e = 0; e < 8; ++e) { const unsigned c = __hip_atomic_load((unsigned*)(ws + WS_CTL) + CW_MOECNT + 64 * e, __ATOMIC_RELAXED, __HIP_MEMORY_SCOPE_AGENT); const unsigned m = (c + 255u) >> 8; mt[e] = c; mt[8 + e] = m; mt[16 + e] = off; off += m; }
                mt[24] = off; }
            __syncthreads();
        }
        for (int rep_ = 0; rep_ < NREP(pb + 9); ++rep_) if (IN(pb + 9)) { if (rep_) { FORCE_BAR; } PH_BEGIN
            if (layer == 0) {
                gp::SchedPlain S{(const char*)Hh, (const char*)(ws + WS_FFN1), (size_t)256 * 2048, (size_t)256 * 2048, 66, 22, G, bx};
                gp::EpiSwiglu E{(bf16*)(ws + WS_HID), DFF, false};
                gp::gemm_phase(lds, tid, 1024, 1024, 1024, S, E);
            } else {
                gp::SchedMoe1 S{(const char*)Hh, (const char*)(ws + WS_MOE1), (const int*)(ws + WS_LIST), mt, G, bx};
                gp::EpiSwiglu E{(bf16*)(ws + WS_MHID), DFE, true};
                gp::gemm_phase(lds, tid, 1024, 1024, 1024, S, E);
            }
        }
        SEAM(pb + 9);
        for (int rep_ = 0; rep_ < NREP(pb + 10); ++rep_) if (IN(pb + 10)) { if (rep_) { FORCE_BAR; } PH_BEGIN
            if (layer == 0) {
                gp::SchedPlain S{(const char*)(ws + WS_HID), (const char*)(ws + WS_FFN2), (size_t)256 * DFF * 2, (size_t)256 * DFF * 2, 66, 4, G, bx};
                gp::EpiPlain E{(bf16*)(ws + WS_FO), 1024};
                gp::gemm_phase(lds, tid, DFF, DFF, DFF, S, E);
            } else {
                gp::SchedMoe2 S{(const char*)(ws + WS_MHID), (const char*)(ws + WS_MOE2), mt, G, bx};
                gp::EpiMoeDown E{(bf16*)(ws + WS_SLOT), (const int*)(ws + WS_LIST), (const float*)(ws + WS_ROUTEW), mt};
                gp::gemm_phase(lds, tid, DFE, DFE, DFE, S, E);
            }
        }
        SEAM(pb + 10);
        for (int rep_ = 0; rep_ < NREP(pb + 11); ++rep_) if (IN(pb + 11)) { if (rep_) { FORCE_BAR; } PH_BEGIN
            for (int r = wslot; r < nrows; r += NW) { const int ci = r < SEQ ? 0 : (r < LROWS ? 1 : 2); const float* md = MODp + (size_t)(layer * 3 + ci) * 6144;
                float* xp = r < LROWS ? AOUT + (size_t)r * D : ctxbuf + (size_t)(r - LROWS) * D;
                f32x4 x[4], t[4]; row_ld_f32(xp, lane, x);
                if (layer == 0) row_ld_bf16((const bf16*)(ws + WS_FO) + (size_t)r * D, lane, t);
                else { f32x4 t2[4]; row_ld_bf16((const bf16*)(ws + WS_SLOT) + (size_t)r * D, lane, t); row_ld_bf16((const bf16*)(ws + WS_SLOT) + ((size_t)LROWS + r) * D, lane, t2);
#pragma unroll
                    for (int j = 0; j < 4; ++j) t[j] = t[j] + t2[j]; }
                row_resid(x, t, normg + 3 * D, md + 5120, lane); row_st_f32(xp, lane, x);
                if (layer == 0) { f32x4 hh[4]; const float* md1 = MODp + (size_t)(3 + ci) * 6144; row_modnorm(x, AIN(6) + 4 * D, md1 + 1024, md1, lane, hh); row_st_bf16(Hh + (size_t)r * D, lane, hh); } }
        }
        SEAM(pb + 11);
    }
#ifdef MK_STAMP_PHASE
    if (MK_STAMP_PHASE == NPHASE - 1 && wave == 0) *(volatile LAS unsigned long long*)(lctl + 66) = __builtin_amdgcn_s_memrealtime();
    if (blockIdx.x == 0 && wave == 0) { const unsigned long long st0_ = *(volatile LAS unsigned long long*)(lctl + 64), st1_ = *(volatile LAS unsigned long long*)(lctl + 66); const unsigned long long target = __builtin_amdgcn_s_memrealtime() + (unsigned long long)MK_STAMP_AMP * (st1_ - st0_); while (__builtin_amdgcn_s_memrealtime() < target) __builtin_amdgcn_s_sleep(20); }
#endif
#ifdef MK_EXTRA_BARS
    for (int xb_ = 0; xb_ < MK_EXTRA_BARS; ++xb_) { FORCE_BAR; }
#endif
#undef IN
#undef SEAM
#undef PH_BEGIN
#undef normg
#undef AIN
#undef AOUT
#undef MODp
#undef ctxbuf
#undef Hh
#undef MIX
#undef INP
#undef Tt
}

__global__ void dumpk(const unsigned char* src, size_t nbytes, int isf32, float* out, size_t N, int accum) {
    const size_t i = (size_t)blockIdx.x * blockDim.x + threadIdx.x; if (i >= N) return;
    const size_t ne = isf32 ? nbytes / 4 : nbytes / 2; float s = 0.f;
    for (size_t k = i; k < ne; k += N) s += isf32 ? ((const float*)src)[k] : bf2f(((const bf16*)src)[k]);
    out[i] = accum ? out[i] + s : s;
}
extern "C" void kernel_launch(void* const* d_in, const int* in_sizes, int n_in, void* d_out, int out_size, void* d_ws, size_t ws_size, hipStream_t stream) {
    static int grid = 0;
    if (grid == 0) {
        if (n_in != 31 || out_size != LROWS * D || ws_size < WS_END) { fprintf(stderr, "kernel_launch: unexpected shapes (n_in %d, out %d, ws %zu < %zu)\n", n_in, out_size, ws_size, (size_t)WS_END); grid = -1; return; }
        int dev = 0, cus = 0, per_cu = 0;
        if (hipGetDevice(&dev) != hipSuccess || hipDeviceGetAttribute(&cus, hipDeviceAttributeMultiprocessorCount, dev) != hipSuccess) { grid = -1; return; }
        if (hipFuncSetAttribute((const void*)mk_fwd, hipFuncAttributeMaxDynamicSharedMemorySize, LDS_BYTES) != hipSuccess) { fprintf(stderr, "kernel_launch: hipFuncSetAttribute failed\n"); grid = -1; return; }
        if (hipOccupancyMaxActiveBlocksPerMultiprocessor(&per_cu, (const void*)mk_fwd, NTHREADS, LDS_BYTES) != hipSuccess || per_cu < 1) { fprintf(stderr, "kernel_launch: occupancy query says %d\n", per_cu); }
        (void)hipGetLastError();
        grid = cus;
    }
    if (grid < 0) return;
    (void)hipMemsetAsync((char*)d_ws + WS_CTL, 0, CTL_ZERO_BYTES, stream);
    Args a{};
    for (int i = 0; i < 31; ++i) a.in[i] = (const float*)d_in[i];
    a.out = (float*)d_out; a.ws = (unsigned char*)d_ws;
#if MK_MODE == 1
    a.ph_lo = 0; a.ph_hi = NPHASE; a.li = 0;
    hipLaunchKernelGGL(mk_fwd, dim3(grid), dim3(NTHREADS), LDS_BYTES, stream, a);
#else
    for (int p = 0; p < MK_LAST; ++p) { a.ph_lo = p; a.ph_hi = p + 1; a.li = p; hipLaunchKernelGGL(mk_fwd, dim3(grid), dim3(NTHREADS), LDS_BYTES, stream, a); }
#endif
#ifdef MK_DUMP_OFF
    dumpk<<<(LROWS * D + 255) / 256, 256, 0, stream>>>((const unsigned char*)d_ws + (size_t)(MK_DUMP_OFF), (size_t)(MK_DUMP_BYTES), MK_DUMP_F32, (float*)d_out, (size_t)LROWS * D, 0);
#endif
#ifdef MK_DUMP2_OFF
    dumpk<<<(LROWS * D + 255) / 256, 256, 0, stream>>>((const unsigned char*)d_ws + (size_t)(MK_DUMP2_OFF), (size_t)(MK_DUMP2_BYTES), MK_DUMP2_F32, (float*)d_out, (size_t)LROWS * D, 1);
#endif
#ifdef MK_DUMP3_OFF
    dumpk<<<(LROWS * D + 255) / 256, 256, 0, stream>>>((const unsigned char*)d_ws + (size_t)(MK_DUMP3_OFF), (size_t)(MK_DUMP3_BYTES), MK_DUMP3_F32, (float*)d_out, (size_t)LROWS * D, 1);
#endif
}
```

```cpp
#define MK_MODE 1
#include <hip/hip_runtime.h>
#include <cstdio>
#include <cstdint>

#define GAS __attribute__((address_space(1)))
#define LAS __attribute__((address_space(3)))
typedef unsigned short bf16;
typedef short bf16x8 __attribute__((ext_vector_type(8)));
typedef short bf16x4 __attribute__((ext_vector_type(4)));
typedef float f32x2 __attribute__((ext_vector_type(2)));
typedef float f32x4 __attribute__((ext_vector_type(4)));
typedef float f32x16 __attribute__((ext_vector_type(16)));
typedef unsigned u32x2 __attribute__((ext_vector_type(2)));
typedef unsigned u32x4 __attribute__((ext_vector_type(4)));

constexpr int D = 1024, SEQ = 8192, LROWS = 16384, CTXL = 256, CROWS = 512, R = 16896;
constexpr int DFF = 2816, DFE = 3584, NEXP = 8, LCAP = 16640;
constexpr int NWAVES = 8, NTHREADS = 512;
constexpr int NCH16 = R / 16;
constexpr float EPSN = 1e-6f, LOG2E = 1.4426950408889634f;

constexpr size_t MiB = 1u << 20;
constexpr size_t WS_CTL = 0, CTL_ZERO_BYTES = 1 * MiB;
constexpr int CW_TMO = 0, CW_BAR = 4096, CW_MOECNT = 98304, CW_QHEAD = 100352;
constexpr size_t CTL_MOD_OFF = 512 * 1024;
constexpr size_t WS_CTXBUF = 1 * MiB;
constexpr size_t WS_COST = 3 * MiB, WS_SINT = 4 * MiB, WS_COSN = 5 * MiB, WS_SINN = 6 * MiB;
constexpr size_t WS_LIST = 7 * MiB;
constexpr size_t WS_ROUTEW = WS_LIST + 8 * LCAP * 4;
constexpr size_t WS_S5K = 8 * MiB;
constexpr size_t WS_A16 = 9 * MiB;
constexpr size_t WS_W128T = WS_A16 + 64 * 1024;
constexpr size_t WS_TWC = WS_W128T + 64 * 1024, WS_TWS = WS_TWC + 32 * 1024;
constexpr size_t WS_FCT = WS_TWS + 32 * 1024;
constexpr size_t WS_W64T = WS_FCT + 32 * 1024;
constexpr size_t WS_W256T = WS_W64T + 32 * 1024;
constexpr size_t WS_MOE1 = 10 * MiB;
constexpr size_t WS_MOE2 = 122 * MiB;
constexpr size_t WS_OTHERW = 178 * MiB;
constexpr size_t WS_WIN = 178 * MiB;
constexpr size_t WS_WBR = 204 * MiB;
constexpr size_t WS_WOUT = 208 * MiB;
constexpr size_t WS_WGLU = 212 * MiB;
constexpr size_t WS_FFN1 = 213 * MiB;
constexpr size_t WS_FFN2 = 224 * MiB;
constexpr size_t WS_S5M1 = 230 * MiB;
constexpr size_t WS_S5TAB = 234 * MiB;
constexpr size_t WS_BIG = 242 * MiB;
constexpr size_t TOK256 = (size_t)R * 256 * 2;
constexpr size_t WS_INP = WS_BIG;
constexpr size_t WS_T = WS_INP + 7 * TOK256;
constexpr size_t WS_HLOC = WS_T + 3 * TOK256;
constexpr size_t WS_HIN = WS_HLOC + 2 * TOK256;
constexpr size_t WS_KV = WS_HIN + TOK256;
constexpr size_t WS_SPREV = WS_KV + 2 * TOK256;
constexpr size_t WS_FB = WS_SPREV + TOK256;
constexpr size_t WS_GATES = WS_BIG;
constexpr size_t WS_Y = WS_BIG + 132 * MiB;
constexpr size_t WS_YO = WS_Y + 33 * MiB;
constexpr size_t WS_Z = WS_YO + 33 * MiB;
constexpr size_t WS_FO = WS_Y;
constexpr size_t WS_HID = WS_BIG;
constexpr size_t WS_MHID = WS_OTHERW;
constexpr size_t WS_H = 449 * MiB;
constexpr size_t WS_MIX = 482 * MiB;
constexpr size_t WS_SLOT = WS_H;
constexpr size_t WS_GCTX = 515 * MiB;
constexpr size_t WS_END = 519 * MiB;
static_assert(WS_FB + 16 * MiB <= WS_Z && WS_Z + TOK256 <= WS_H && WS_MHID + (size_t)34816 * 3584 * 2 <= WS_H && WS_W256T + 256 * 1024 <= WS_MOE1, "ws map");
static_assert(WS_S5TAB + 8 * MiB <= WS_BIG && WS_FFN2 + (size_t)1024 * 2816 * 2 <= WS_S5M1 && WS_ROUTEW + 32768 * 4 <= WS_S5K, "ws map 2");

constexpr int RING_BYTES = 131072, LDSCTL_OFF = RING_BYTES, LDS_BYTES = 147456;
constexpr int LW_BAR = 8, LW_MOE = 16;

#define VM_WAIT() asm volatile("s_waitcnt vmcnt(0)" ::: "memory")
#define LDS_WAIT() asm volatile("s_waitcnt lgkmcnt(0)" ::: "memory")
typedef __bf16 bf16n2 __attribute__((ext_vector_type(2)));
__device__ __forceinline__ unsigned pk2(float lo, float hi) { bf16n2 v; v.x = (__bf16)lo; v.y = (__bf16)hi; return __builtin_bit_cast(unsigned, v); }
__device__ __forceinline__ float bf2f(unsigned short b) { return __builtin_bit_cast(float, ((unsigned)b) << 16); }
__device__ __forceinline__ float bflo(unsigned w) { return __builtin_bit_cast(float, w << 16); }
__device__ __forceinline__ float bfhi(unsigned w) { return __builtin_bit_cast(float, w & 0xffff0000u); }
__device__ __forceinline__ float ex2(float x) { return __builtin_amdgcn_exp2f(x); }
__device__ __forceinline__ float rcpf_(float x) { return __builtin_amdgcn_rcpf(x); }
__device__ __forceinline__ float sigm(float x) { return rcpf_(1.f + ex2(-LOG2E * x)); }
__device__ __forceinline__ float silu_(float x) { return x * sigm(x); }
__device__ __forceinline__ float gelu_tanh(float x) { const float u = 0.7978845608028654f * (x + 0.044715f * x * x * x); const float t = 1.f - 2.f * rcpf_(1.f + ex2(2.885390081777927f * u)); return 0.5f * x * (1.f + t); }
__device__ __forceinline__ float xor32_sum(float v) { const unsigned u = __builtin_bit_cast(unsigned, v); const auto r = __builtin_amdgcn_permlane32_swap(u, u, false, false); return __builtin_bit_cast(float, (unsigned)r[0]) + __builtin_bit_cast(float, (unsigned)r[1]); }
__device__ __forceinline__ float xor32_max(float v) { const unsigned u = __builtin_bit_cast(unsigned, v); const auto r = __builtin_amdgcn_permlane32_swap(u, u, false, false); return fmaxf(__builtin_bit_cast(float, (unsigned)r[0]), __builtin_bit_cast(float, (unsigned)r[1])); }
template <int X> __device__ __forceinline__ float swz_xor(float v) { return __builtin_bit_cast(float, __builtin_amdgcn_ds_swizzle(__builtin_bit_cast(int, v), (X << 10) | 0x1f)); }
__device__ __forceinline__ float wave_sum(float v) { v += swz_xor<1>(v); v += swz_xor<2>(v); v += swz_xor<4>(v); v += swz_xor<8>(v); v += swz_xor<16>(v); return xor32_sum(v); }
__device__ __forceinline__ f32x16 mma32(bf16x8 a, bf16x8 b, f32x16 c) { return __builtin_amdgcn_mfma_f32_32x32x16_bf16(a, b, c, 0, 0, 0); }
__device__ __forceinline__ bf16x8 ldg8(const bf16* p) { return *(const bf16x8*)p; }
__device__ __forceinline__ bf16x8 ldg8p(const bf16* p) { const bf16x4 lo = *(const bf16x4*)p, hi = *(const bf16x4*)(p + 8); return __builtin_shufflevector(lo, hi, 0, 1, 2, 3, 4, 5, 6, 7); }
template <int S> __device__ __forceinline__ bf16x8 accB(const f32x16& c) {
    u32x4 w; w.x = pk2(c[8 * S + 0], c[8 * S + 1]); w.y = pk2(c[8 * S + 2], c[8 * S + 3]); w.z = pk2(c[8 * S + 4], c[8 * S + 5]); w.w = pk2(c[8 * S + 6], c[8 * S + 7]);
    return __builtin_bit_cast(bf16x8, w);
}
__device__ __forceinline__ bf16x8 pack8(const float (&v)[8]) { u32x4 w; w.x = pk2(v[0], v[1]); w.y = pk2(v[2], v[3]); w.z = pk2(v[4], v[5]); w.w = pk2(v[6], v[7]); return __builtin_bit_cast(bf16x8, w); }
__device__ __forceinline__ void unpack8(const bf16x8 x, float (&v)[8]) { const u32x4 w = __builtin_bit_cast(u32x4, x); v[0] = bflo(w.x); v[1] = bfhi(w.x); v[2] = bflo(w.y); v[3] = bfhi(w.y); v[4] = bflo(w.z); v[5] = bfhi(w.z); v[6] = bflo(w.w); v[7] = bfhi(w.w); }
__device__ __forceinline__ f32x16 zero16() { f32x16 z;
#pragma unroll
    for (int i = 0; i < 16; ++i) z[i] = 0.f;
    return z; }

#define XB_TMO      128
#define XB_XCNT(j)  (256  + 64 * (j))
#define XB_XSUB(j)  (1280 + 64 * (j))
#define XB_XGEN(j)  (2304 + 64 * (j))
#define XB_TOP      3328
#define XB_TOPGEN   3392
#define XCD_BAR_WORDS 3456
#define XB_SPIN_CAP (1u << 18)
__device__ __forceinline__ unsigned xb_ld(unsigned* p)              { return __hip_atomic_load(p, __ATOMIC_RELAXED, __HIP_MEMORY_SCOPE_AGENT); }
__device__ __forceinline__ unsigned xb_add(unsigned* p, unsigned v) { return __hip_atomic_fetch_add(p, v, __ATOMIC_RELAXED, __HIP_MEMORY_SCOPE_AGENT); }
__device__ __forceinline__ unsigned xb_xcc_id() { return (unsigned)__builtin_amdgcn_s_getreg((3 << 11) | 20) & 0xFu; }
#define XB_SPIN(cond, bar) do { unsigned _sp = 0; while (cond) { __builtin_amdgcn_s_sleep(1); \
    if ((++_sp & 255u) == 0u) { if (xb_ld(&(bar)[XB_TMO])) break; if (_sp > XB_SPIN_CAP) { atomicAdd(&(bar)[XB_TMO], 1u); break; } } } } while (0)
struct XcdBarrier { unsigned* bar; unsigned x; volatile LAS unsigned* st; };
__device__ __forceinline__ XcdBarrier xcd_barrier_post(unsigned* bar, volatile LAS unsigned* st) {
    XcdBarrier b; b.bar = bar; b.x = xb_xcc_id(); b.st = st;
    if (threadIdx.x == 0) (void)xb_add(&bar[XB_XCNT(b.x)], 1u);
    return b;
}
__device__ __forceinline__ void xcd_barrier_complete(unsigned* bar, unsigned x, unsigned& nloc, unsigned& nx) {
    const unsigned G = gridDim.x * gridDim.y * gridDim.z;
    unsigned sum, cnt, mine, sp = 0u;
    for (;;) {
        sum = 0u; cnt = 0u; mine = 0u;
#pragma unroll
        for (unsigned j = 0; j < 16; ++j) { const unsigned c = xb_ld(&bar[XB_XCNT(j)]); sum += c; cnt += (c > 0u) ? 1u : 0u; mine = (j == x) ? c : mine; }
        if (sum == G) break;
        __builtin_amdgcn_s_sleep(1);
        if ((++sp & 255u) == 0u) { if (xb_ld(&bar[XB_TMO])) break; if (sp > XB_SPIN_CAP) { atomicAdd(&bar[XB_TMO], 1u); break; } }
    }
    nloc = mine > 0u ? mine : 1u; nx = cnt > 0u ? cnt : 1u;
}
__device__ __forceinline__ void xcd_barrier(const XcdBarrier& b) {
    asm volatile("s_waitcnt vmcnt(0)" ::: "memory");
    __syncthreads();
    if (threadIdx.x == 0) {
        unsigned* bar = b.bar;
        __builtin_amdgcn_s_waitcnt(0);
        unsigned nloc = b.st[0], nx = b.st[1];
        if (nloc == 0u) { xcd_barrier_complete(bar, b.x, nloc, nx); b.st[0] = nloc; b.st[1] = nx; }
        const unsigned old = xb_add(&bar[XB_XSUB(b.x)], 1u);
        const unsigned gen = old / nloc;
        if (old + 1u == (gen + 1u) * nloc) {
            __builtin_amdgcn_fence(__ATOMIC_RELEASE, "agent");
            asm volatile("s_waitcnt vmcnt(0)" ::: "memory");
            const unsigned og = xb_add(&bar[XB_TOP], 1u);
            const unsigned tg = og / nx;
            if (og + 1u == (tg + 1u) * nx) xb_add(&bar[XB_TOPGEN], 1u);
            else XB_SPIN(xb_ld(&bar[XB_TOPGEN]) == tg, bar);
            __builtin_amdgcn_fence(__ATOMIC_ACQUIRE, "agent");
            xb_add(&bar[XB_XGEN(b.x)], 1u);
            asm volatile("s_waitcnt vmcnt(0)" ::: "memory");
        } else {
            XB_SPIN(xb_ld(&bar[XB_XGEN(b.x)]) == gen, bar);
            __builtin_amdgcn_fence(__ATOMIC_ACQUIRE, "agent");
            asm volatile("s_waitcnt vmcnt(0)" ::: "memory");
        }
    }
    __syncthreads();
}
namespace gp {
constexpr int BM = 256, BK = 64, HALF = 128, HTB = HALF * BK * 2, STAGE_BYTES = 8 * HTB, NXCD = 8, WGM = 8;
__device__ __forceinline__ int lds_byte(int r, int c) { const int st = (r >> 4) * 2 + (c >> 5), rr = r & 15, cc = c & 31, ob = rr * 64 + cc * 2; return st * 1024 + (ob ^ (((ob >> 9) & 1) << 5)); }
__device__ __forceinline__ void stage_rc(int b, int& Rr, int& C) { const int st = b / 1024, sb = b % 1024, swz = sb ^ (((sb >> 9) & 1) << 5); Rr = (st >> 1) * 16 + swz / 64; C = (st & 1) * 32 + (swz % 64) / 2; }
__device__ __forceinline__ int perm32(int rho) { const int n = rho >> 4, i = rho & 15; return 8 * (i >> 2) + 4 * n + (i & 3); }

struct Unit { const char* a; const char* b; int e0, e1, e2, e3; };

__device__ __forceinline__ void tile_of(int L, int nM, int nN, int& pm, int& pn) {
    const int nwg = nM * nN; int wgid = L;
    { const int q = nwg / NXCD, r = nwg % NXCD, xcd = wgid % NXCD, off = wgid / NXCD; wgid = (xcd < r ? xcd * (q + 1) : r * (q + 1) + (xcd - r) * q) + off; }
    const int nig = WGM * nN, gid = wgid / nig, fm = gid * WGM, gsz = (nM - fm) < WGM ? (nM - fm) : WGM;
    pm = fm + ((wgid % nig) % gsz); pn = (wgid % nig) / gsz;
}

template <class Epi, class Sched>
__device__ __forceinline__ void gemm_phase(LAS unsigned char* lds, const int tid, const int K, const int lda, const int ldb, const Sched& S, const Epi& E) {
    constexpr bool GATHER = Sched::GATHER;
    const int wid = __builtin_amdgcn_readfirstlane(tid >> 6), lane = tid & 63, wr = wid >> 2, wc = wid & 3, fr = lane & 15, fq = lane >> 4;
    int nt = K / BK; asm volatile("" : "+s"(nt));
    unsigned voffA[2], voffB[2], cb2[2]; int rowA[2];
#pragma unroll
    for (int i = 0; i < 2; ++i) { int Rr, C; stage_rc(tid * 16 + i * 8192, Rr, C); const int Rb = (Rr & ~31) + perm32(Rr & 31);
        rowA[i] = Rr; cb2[i] = (unsigned)C * 2u; voffA[i] = (unsigned)(Rr * lda + C) * 2u; voffB[i] = (unsigned)(Rb * ldb + C) * 2u; }
    const size_t kstep = (size_t)(BK * 2);
    const unsigned hstepA = (unsigned)HALF * (unsigned)lda * 2u; const size_t hstepB = (size_t)HALF * ldb * 2;
    const unsigned ldsw = (unsigned)wid * 1024u;
    const int aoff = lds_byte(wr * 64 + fr, fq * 8), boff = lds_byte(wc * 32 + fr, fq * 8);
#define PG8_SA(b, h) (((b) * 2 + (h)) * HTB)
#define PG8_SB(b, h) ((4 + (b) * 2 + (h)) * HTB)
#define PG8_STB(bufoff, gbase, hh) do { _Pragma("unroll") for (int _i = 0; _i < 2; ++_i) \
        __builtin_amdgcn_global_load_lds((const unsigned*)((const char*)(gbase) + (size_t)(hh) * hstepB + voffB[_i]), (LAS unsigned*)(lds + (bufoff) + ldsw + _i * 8192), 16, 0, 0); } while (0)
#define PG8_STA(bufoff, gbase, hh, VG) do { _Pragma("unroll") for (int _i = 0; _i < 2; ++_i) { const unsigned _o = GATHER ? (VG)[hh][_i] : (voffA[_i] + (unsigned)(hh) * hstepA); \
        __builtin_amdgcn_global_load_lds((const unsigned*)((const char*)(gbase) + _o), (LAS unsigned*)(lds + (bufoff) + ldsw + _i * 8192), 16, 0, 0); } } while (0)
#define PG8_LDA(dst, b, h) do { _Pragma("unroll") for (int m = 0; m < 4; ++m) _Pragma("unroll") for (int k = 0; k < 2; ++k) dst[m][k] = *(const LAS bf16x8*)(lds + PG8_SA(b, h) + aoff + m * 2048 + k * 1024); } while (0)
#define PG8_LDB(dst, b, h) do { _Pragma("unroll") for (int n = 0; n < 2; ++n) _Pragma("unroll") for (int k = 0; k < 2; ++k) dst[n][k] = *(const LAS bf16x8*)(lds + PG8_SB(b, h) + boff + n * 2048 + k * 1024); } while (0)
#define PG8_MMA(ai, bj, At, Bt) do { __builtin_amdgcn_s_setprio(1); _Pragma("unroll") for (int m = 0; m < 4; ++m) _Pragma("unroll") for (int n = 0; n < 2; ++n) _Pragma("unroll") for (int k = 0; k < 2; ++k) \
        acc[ai][bj][m][n] = __builtin_amdgcn_mfma_f32_16x16x32_bf16(Bt[n][k], At[m][k], acc[ai][bj][m][n], 0, 0, 0); __builtin_amdgcn_s_setprio(0); } while (0)
#define PG8_WAIT_V(n) asm volatile("s_waitcnt vmcnt(" #n ")" ::: "memory")
#define PG8_WAIT_L(n) asm volatile("s_waitcnt lgkmcnt(" #n ")" ::: "memory")
#define PG8_BAR __builtin_amdgcn_s_barrier()
#define PG8_SCHED __builtin_amdgcn_sched_barrier(0)
    Unit cur, nxt; int ui = 0;
    if (!S.next(0, cur)) return;
    f32x4 acc[2][2][4][2];
#pragma unroll
    for (int a = 0; a < 2; ++a)
#pragma unroll
        for (int b = 0; b < 2; ++b)
#pragma unroll
            for (int m = 0; m < 4; ++m)
#pragma unroll
                for (int n = 0; n < 2; ++n) acc[a][b][m][n] = (f32x4){0.f, 0.f, 0.f, 0.f};
    bf16x8 At[4][2], B0[2][2], B1[2][2];
    unsigned vgc[2][2], vgn[2][2];
#pragma unroll
    for (int h = 0; h < 2; ++h)
#pragma unroll
        for (int i = 0; i < 2; ++i) { vgc[h][i] = GATHER ? S.rowoff(cur, rowA[i] + h * HALF) + cb2[i] : 0u; vgn[h][i] = vgc[h][i]; }
    const char* cA = cur.a; const char* cB = cur.b;
    PG8_STB(PG8_SB(0, 0), cB, 0); PG8_STB(PG8_SB(0, 1), cB, 1); PG8_STA(PG8_SA(0, 0), cA, 0, vgc); PG8_STA(PG8_SA(0, 1), cA, 1, vgc);
    if (wr == 1) PG8_BAR;
    PG8_WAIT_V(2); PG8_BAR;
    PG8_STB(PG8_SB(1, 0), cB + kstep, 0); PG8_STA(PG8_SA(1, 0), cA + kstep, 0, vgc); PG8_STB(PG8_SB(1, 1), cB + kstep, 1);
    PG8_WAIT_V(6); PG8_BAR;
    for (;;) {
        const bool has_next = S.next(ui + 1, nxt);
        const char* nA = has_next ? nxt.a : cA; const char* nB = has_next ? nxt.b : cB;
#pragma unroll 1
        for (int t = 0; t < nt; t += 2) {
            const bool last = (t == nt - 2);
            const char* a1 = cA + (size_t)(t + 1) * kstep;
            const char* a2 = last ? nA : cA + (size_t)(t + 2) * kstep; const char* b2 = last ? nB : cB + (size_t)(t + 2) * kstep;
            const char* a3 = a2 + kstep; const char* b3 = b2 + kstep;
            unsigned vg2[2][2];
            if constexpr (GATHER) {
                if (last && has_next) {
#pragma unroll
                    for (int h = 0; h < 2; ++h)
#pragma unroll
                        for (int i = 0; i < 2; ++i) vgn[h][i] = S.rowoff(nxt, rowA[i] + h * HALF) + cb2[i];
                }
            }
#pragma unroll
            for (int h = 0; h < 2; ++h)
#pragma unroll
                for (int i = 0; i < 2; ++i) vg2[h][i] = last ? vgn[h][i] : vgc[h][i];
            PG8_LDB(B0, 0, 0); PG8_LDB(B1, 0, 1); PG8_SCHED; PG8_LDA(At, 0, 0); PG8_STA(PG8_SA(1, 1), a1, 1, vgc);
            PG8_WAIT_V(8); PG8_WAIT_L(0); PG8_BAR; PG8_MMA(0, 0, At, B0); PG8_MMA(0, 1, At, B1); PG8_BAR; PG8_SCHED;
            PG8_LDA(At, 0, 1); PG8_STB(PG8_SB(0, 0), b2, 0); PG8_STB(PG8_SB(0, 1), b2, 1); PG8_STA(PG8_SA(0, 0), a2, 0, vg2);
            PG8_WAIT_V(8); PG8_WAIT_L(0); PG8_BAR; PG8_MMA(1, 0, At, B0); PG8_MMA(1, 1, At, B1); PG8_BAR; PG8_SCHED;
            PG8_LDB(B0, 1, 0); PG8_LDB(B1, 1, 1); PG8_SCHED; PG8_LDA(At, 1, 0); PG8_STA(PG8_SA(0, 1), a2, 1, vg2);
            PG8_WAIT_V(8); PG8_WAIT_L(0); PG8_BAR; PG8_MMA(0, 0, At, B0); PG8_MMA(0, 1, At, B1); PG8_BAR; PG8_SCHED;
            PG8_LDA(At, 1, 1); PG8_STB(PG8_SB(1, 0), b3, 0); PG8_STB(PG8_SB(1, 1), b3, 1); PG8_STA(PG8_SA(1, 0), a3, 0, vg2);
            PG8_WAIT_V(8); PG8_WAIT_L(0); PG8_BAR; PG8_MMA(1, 0, At, B0); PG8_MMA(1, 1, At, B1); PG8_BAR; PG8_SCHED;
        }
        if (wr == 0) PG8_BAR;
        if constexpr (Epi::CARRY) { E.carry(acc, cur, wr, wc, fr, fq); if (!has_next) break; }
        else {
        E(acc, cur, wr, wc, fr, fq);
        if (!has_next) break;
#pragma unroll
        for (int a = 0; a < 2; ++a)
#pragma unroll
            for (int b = 0; b < 2; ++b)
#pragma unroll
                for (int m = 0; m < 4; ++m)
#pragma unroll
                    for (int n = 0; n < 2; ++n) acc[a][b][m][n] = (f32x4){0.f, 0.f, 0.f, 0.f};
        }
        cur = nxt; cA = nA; cB = nB; ++ui;
#pragma unroll
        for (int h = 0; h < 2; ++h)
#pragma unroll
            for (int i = 0; i < 2; ++i) vgc[h][i] = vgn[h][i];
        if (wr == 1) PG8_BAR;
    }
    PG8_WAIT_V(0);
    PG8_BAR;
#undef PG8_SA
#undef PG8_SB
#undef PG8_STA
#undef PG8_STB
#undef PG8_LDA
#undef PG8_LDB
#undef PG8_MMA
#undef PG8_WAIT_V
#undef PG8_WAIT_L
#undef PG8_BAR
#undef PG8_SCHED
}

struct SchedPlain {
    static constexpr bool GATHER = false;
    const char* A; const char* B; size_t ta, tb; int nM, nN, G, c;
    __device__ __forceinline__ bool next(int i, Unit& u) const {
        const long L = (long)i * G + c; if (L >= (long)nM * nN) return false;
        int pm, pn; tile_of((int)L, nM, nN, pm, pn); u.a = A + (size_t)pm * ta; u.b = B + (size_t)pn * tb; u.e0 = pm; u.e1 = pn; u.e2 = 0; u.e3 = 0; return true; }
    __device__ __forceinline__ unsigned rowoff(const Unit&, int) const { return 0u; }
};
struct SchedInprojA {
    static constexpr bool GATHER = false;
    const char* Hh; const char* W; int nM, G, c, ng;
    __device__ __forceinline__ bool next(int i, Unit& u) const {
        long L = (long)i * G + c; const int n1 = nM * 7, n2 = 3 * nM; if (L >= n1 + n2 + ng) return false;
        int pm, pn;
        if (L < n1) { tile_of((int)L, nM, 7, pm, pn); u.a = Hh + (size_t)pm * (256 * 2048); u.b = W + (size_t)pn * (256 * 2048); u.e2 = 0; }
        else if (L < n1 + n2) { tile_of((int)(L - n1), 3, nM, pm, pn); u.a = W + (size_t)(23 + pm) * (256 * 2048); u.b = Hh + (size_t)pn * (256 * 2048); u.e2 = 1; }
        else { const int q = (int)(L - n1 - n2); pm = q >> 4; pn = q & 15; u.a = Hh + (size_t)(64 + pm) * (256 * 2048); u.b = W + (size_t)(7 + pn) * (256 * 2048); u.e2 = 2; }
        u.e0 = pm; u.e1 = pn; u.e3 = 0; return true; }
    __device__ __forceinline__ unsigned rowoff(const Unit&, int) const { return 0u; }
};
struct SchedMerge {
    static constexpr bool GATHER = false;
    const char* Mix; const char* Wb; int nM, G, c;
    __device__ __forceinline__ bool next(int i, Unit& u) const {
        const long L = (long)(i >> 2) * G + c; if (L >= (long)nM * 4) return false;
        int pm, pn; tile_of((int)L, nM, 4, pm, pn); const int b = i & 3;
        u.a = Mix + (size_t)pm * (256 * 2048) + b * 512; u.b = Wb + ((size_t)b * 1024 + pn * 256) * 512; u.e0 = pm; u.e1 = pn; u.e2 = b; u.e3 = 0; return true; }
    __device__ __forceinline__ unsigned rowoff(const Unit&, int) const { return 0u; }
};
struct SchedMoe1 {
    static constexpr bool GATHER = true;
    const char* Hh; const char* W; const int* list; const LAS unsigned* mt; int G, c;
    __device__ __forceinline__ bool next(int i, Unit& u) const {
        long L = (long)i * G + c; int e = 0;
        for (; e < 8; ++e) { const long ue = (long)mt[8 + e] * 28; if (L < ue) break; L -= ue; }
        if (e == 8) return false;
        const int m_e = (int)mt[8 + e], nti = (int)(L / m_e), mti = (int)(L % m_e);
        u.a = Hh; u.b = W + ((size_t)e * 7168 + (size_t)nti * 256) * 2048; u.e0 = e; u.e1 = mti; u.e2 = nti; u.e3 = ((int)mt[16 + e] + mti) * 256; return true; }
    __device__ __forceinline__ unsigned rowoff(const Unit& u, int r) const {
        const int li = u.e1 * 256 + r; const int ent = (li < (int)mt[u.e0]) ? list[u.e0 * LCAP + li] : 0; return (unsigned)(ent >> 1) * 2048u; }
};
struct SchedMoe2 {
    static constexpr bool GATHER = false;
    const char* Hid; const char* W; const LAS unsigned* mt; int G, c;
    __device__ __forceinline__ bool next(int i, Unit& u) const {
        long L = (long)i * G + c; int e = 0;
        for (; e < 8; ++e) { const long ue = (long)mt[8 + e] * 4; if (L < ue) break; L -= ue; }
        if (e == 8) return false;
        const int m_e = (int)mt[8 + e], nti = (int)(L / m_e), mti = (int)(L % m_e);
        u.a = Hid + (size_t)((int)mt[16 + e] + mti) * 256 * (size_t)(DFE * 2); u.b = W + ((size_t)e * 1024 + (size_t)nti * 256) * (size_t)(DFE * 2); u.e0 = e; u.e1 = mti; u.e2 = nti; u.e3 = 0; return true; }
    __device__ __forceinline__ unsigned rowoff(const Unit&, int) const { return 0u; }
};

#define EPI_ROWS(ai, m) (128 * (ai) + 64 * wr + 16 * (m) + fr)
#define EPI_COL(bj) (128 * (bj) + 32 * wc + 8 * fq)
__device__ __forceinline__ u32x4 pack_acc8(const f32x4 a, const f32x4 b) { u32x4 w; w.x = pk2(a[0], a[1]); w.y = pk2(a[2], a[3]); w.z = pk2(b[0], b[1]); w.w = pk2(b[2], b[3]); return w; }

__device__ __forceinline__ unsigned gq8(float g) { const unsigned q = (unsigned)(g * 255.f + 0.5f); return q < 1u ? 1u : q; }
__device__ __forceinline__ u32x2 pack_gate8(const f32x4 a, const f32x4 b) {
    u32x2 w; w.x = gq8(a[0]) | (gq8(a[1]) << 8) | (gq8(a[2]) << 16) | (gq8(a[3]) << 24); w.y = gq8(b[0]) | (gq8(b[1]) << 8) | (gq8(b[2]) << 16) | (gq8(b[3]) << 24); return w; }
__device__ __forceinline__ float gate8(unsigned w, int k) { return (float)((w >> (8 * k)) & 255u) * (1.f / 255.f); }
struct EpiPlain { static constexpr bool CARRY = false;
    bf16* O; int ld;
    __device__ __forceinline__ void operator()(const f32x4 (&acc)[2][2][4][2], const Unit& u, int wr, int wc, int fr, int fq) const {
#pragma unroll
        for (int ai = 0; ai < 2; ++ai)
#pragma unroll
            for (int m = 0; m < 4; ++m) { bf16* rowp = O + (size_t)(u.e0 * 256 + EPI_ROWS(ai, m)) * ld + u.e1 * 256;
#pragma unroll
                for (int bj = 0; bj < 2; ++bj) *(u32x4*)(rowp + EPI_COL(bj)) = pack_acc8(acc[ai][bj][m][0], acc[ai][bj][m][1]); }
    }
};
struct EpiInprojA { static constexpr bool CARRY = false;
    bf16* INP; bf16* T; unsigned char* Gc;
    __device__ __forceinline__ void operator()(const f32x4 (&acc)[2][2][4][2], const Unit& u, int wr, int wc, int fr, int fq) const {
        if (u.e2 == 2) {
#pragma unroll
            for (int ai = 0; ai < 2; ++ai)
#pragma unroll
                for (int m = 0; m < 4; ++m) { unsigned char* rowp = Gc + (size_t)(u.e0 * 256 + EPI_ROWS(ai, m)) * 4096 + u.e1 * 256;
#pragma unroll
                    for (int bj = 0; bj < 2; ++bj) { f32x4 a = acc[ai][bj][m][0], b = acc[ai][bj][m][1];
#pragma unroll
                        for (int j = 0; j < 4; ++j) { a[j] = sigm(a[j]); b[j] = sigm(b[j]); }
                        *(u32x2*)(rowp + EPI_COL(bj)) = pack_gate8(a, b); } }
        } else if (u.e2 == 0) {
            bf16* base = INP + (size_t)u.e1 * ((size_t)R * 256);
            const bool regroup = (u.e1 == 1);
#pragma unroll
            for (int ai = 0; ai < 2; ++ai)
#pragma unroll
                for (int m = 0; m < 4; ++m) { const int row = u.e0 * 256 + EPI_ROWS(ai, m);
#pragma unroll
                    for (int bj = 0; bj < 2; ++bj) { const int col = EPI_COL(bj);
                        bf16* p = regroup ? base + ((((size_t)(col >> 4) * 33 + (row >> 9)) * 16 + (row & 15)) * 64 + ((col & 8) << 2) + ((row >> 4) & 31)) * 8 : base + (size_t)row * 256 + col;
                        *(u32x4*)p = pack_acc8(acc[ai][bj][m][0], acc[ai][bj][m][1]); } }
        } else {
#pragma unroll
            for (int ai = 0; ai < 2; ++ai)
#pragma unroll
                for (int m = 0; m < 4; ++m) { bf16* rowp = T + (size_t)(u.e0 * 256 + EPI_ROWS(ai, m)) * R + u.e1 * 256;
#pragma unroll
                    for (int bj = 0; bj < 2; ++bj) *(u32x4*)(rowp + EPI_COL(bj)) = pack_acc8(acc[ai][bj][m][0], acc[ai][bj][m][1]); }
        }
    }
};
struct EpiGates { static constexpr bool CARRY = false;
    unsigned char* Gt;
    __device__ __forceinline__ void operator()(const f32x4 (&acc)[2][2][4][2], const Unit& u, int wr, int wc, int fr, int fq) const {
#pragma unroll
        for (int ai = 0; ai < 2; ++ai)
#pragma unroll
            for (int m = 0; m < 4; ++m) { unsigned char* rowp = Gt + (size_t)(u.e0 * 256 + EPI_ROWS(ai, m)) * 4096 + u.e1 * 256;
#pragma unroll
                for (int bj = 0; bj < 2; ++bj) { f32x4 a = acc[ai][bj][m][0], b = acc[ai][bj][m][1];
#pragma unroll
                    for (int j = 0; j < 4; ++j) { a[j] = sigm(a[j]); b[j] = sigm(b[j]); }
                    *(u32x2*)(rowp + EPI_COL(bj)) = pack_gate8(a, b); } }
    }
};
struct EpiGlu { static constexpr bool CARRY = false;
    const bf16* Zz; bf16* Mix; const float* bglu;
    __device__ __forceinline__ void operator()(const f32x4 (&acc)[2][2][4][2], const Unit& u, int wr, int wc, int fr, int fq) const {
#pragma unroll
        for (int bj = 0; bj < 2; ++bj) { const int col = EPI_COL(bj);
            const f32x4 b0 = *(const f32x4*)(bglu + col), b1 = *(const f32x4*)(bglu + col + 4);
#pragma unroll
            for (int ai = 0; ai < 2; ++ai)
#pragma unroll
                for (int m = 0; m < 4; ++m) { const size_t row = (size_t)(u.e0 * 256 + EPI_ROWS(ai, m));
                    const u32x4 zz = *(const u32x4*)(Zz + row * 256 + col);
                    f32x4 a = acc[ai][bj][m][0] + b0, b = acc[ai][bj][m][1] + b1;
                    a[0] = bflo(zz.x) * sigm(a[0]); a[1] = bfhi(zz.x) * sigm(a[1]); a[2] = bflo(zz.y) * sigm(a[2]); a[3] = bfhi(zz.y) * sigm(a[3]);
                    b[0] = bflo(zz.z) * sigm(b[0]); b[1] = bfhi(zz.z) * sigm(b[1]); b[2] = bflo(zz.w) * sigm(b[2]); b[3] = bfhi(zz.w) * sigm(b[3]);
                    *(u32x4*)(Mix + row * 1024 + 256 + col) = pack_acc8(a, b); } }
    }
};
struct EpiMerge {
    static constexpr bool CARRY = true;
    const unsigned char* Gt; const unsigned char* Gc; bf16* Y;
    __device__ __forceinline__ void carry(f32x4 (&acc)[2][2][4][2], const Unit& u, int wr, int wc, int fr, int fq) const {
        const int b = u.e2, bn = b < 3 ? b + 1 : 3;
        u32x2 g[2][4][2], gn[2][4][2];
#pragma unroll
        for (int ai = 0; ai < 2; ++ai)
#pragma unroll
            for (int m = 0; m < 4; ++m) { const size_t row = (size_t)(u.e0 * 256 + EPI_ROWS(ai, m));
                const unsigned char* grow = (u.e0 < 64 ? Gt + row * 4096 : Gc + (row - LROWS) * 4096) + u.e1 * 256;
#pragma unroll
                for (int bj = 0; bj < 2; ++bj) { g[ai][m][bj] = *(const u32x2*)(grow + b * 1024 + EPI_COL(bj)); gn[ai][m][bj] = *(const u32x2*)(grow + bn * 1024 + EPI_COL(bj)); } }
#pragma unroll
        for (int ai = 0; ai < 2; ++ai)
#pragma unroll
            for (int m = 0; m < 4; ++m) { const size_t row = (size_t)(u.e0 * 256 + EPI_ROWS(ai, m));
#pragma unroll
                for (int bj = 0; bj < 2; ++bj) { const int col = u.e1 * 256 + EPI_COL(bj);
                    f32x4 a0 = acc[ai][bj][m][0], a1 = acc[ai][bj][m][1];
#pragma unroll
                    for (int j = 0; j < 4; ++j) { a0[j] *= gate8(g[ai][m][bj].x, j); a1[j] *= gate8(g[ai][m][bj].y, j); }
                    if (b != 3) {
#pragma unroll
                        for (int j = 0; j < 4; ++j) { a0[j] *= rcpf_(gate8(gn[ai][m][bj].x, j)); a1[j] *= rcpf_(gate8(gn[ai][m][bj].y, j)); }
                        acc[ai][bj][m][0] = a0; acc[ai][bj][m][1] = a1; }
                    else { *(u32x4*)(Y + row * 1024 + col) = pack_acc8(a0, a1); acc[ai][bj][m][0] = (f32x4){0.f, 0.f, 0.f, 0.f}; acc[ai][bj][m][1] = (f32x4){0.f, 0.f, 0.f, 0.f}; } } }
    }
};
struct EpiSwiglu { static constexpr bool CARRY = false;
    bf16* Hd; int ldh; bool moe;
    __device__ __forceinline__ void operator()(const f32x4 (&acc)[2][2][4][2], const Unit& u, int wr, int wc, int fr, int fq) const {
        const int rowbase = moe ? u.e3 : u.e0 * 256, pn = moe ? u.e2 : u.e1;
#pragma unroll
        for (int ai = 0; ai < 2; ++ai)
#pragma unroll
            for (int m = 0; m < 4; ++m) { bf16* p = Hd + (size_t)(rowbase + EPI_ROWS(ai, m)) * ldh + pn * 128 + 32 * wc + 8 * fq;
                f32x4 a = acc[ai][0][m][0], b = acc[ai][0][m][1]; const f32x4 ua = acc[ai][1][m][0], ub = acc[ai][1][m][1];
#pragma unroll
                for (int j = 0; j < 4; ++j) { a[j] = silu_(a[j]) * ua[j]; b[j] = silu_(b[j]) * ub[j]; }
                *(u32x4*)p = pack_acc8(a, b); }
    }
};
struct EpiMoeDown { static constexpr bool CARRY = false;
    bf16* Slot; const int* list; const float* routew; const LAS unsigned* mt;
    __device__ __forceinline__ void operator()(const f32x4 (&acc)[2][2][4][2], const Unit& u, int wr, int wc, int fr, int fq) const {
        const int cnt = (int)mt[u.e0];
#pragma unroll
        for (int ai = 0; ai < 2; ++ai)
#pragma unroll
            for (int m = 0; m < 4; ++m) { const int li = u.e1 * 256 + EPI_ROWS(ai, m);
                if (li < cnt) { const int ent = list[u.e0 * LCAP + li]; const float w = routew[ent];
                    bf16* rowp = Slot + ((size_t)(ent & 1) * LROWS + (size_t)(ent >> 1)) * 1024 + u.e2 * 256;
#pragma unroll
                    for (int bj = 0; bj < 2; ++bj) *(u32x4*)(rowp + EPI_COL(bj)) = pack_acc8(acc[ai][bj][m][0] * w, acc[ai][bj][m][1] * w); } }
    }
};
}
#define DROW(reg, h) (((reg) & 3) + 8 * ((reg) >> 2) + 4 * (h))

__device__ __forceinline__ void s5_state_item(const bf16* M1F  , const bf16* SUF, float* HLOC, int item, int lane) {
    const int cb = item % 33, gd = item / 33, g = gd >> 1, dir = gd & 1, li = lane & 31, h = lane >> 5;
    const bf16* A = M1F + (size_t)(g * 2 + dir) * 128 * 256 + lane * 8;
    const bf16* B = SUF + (size_t)(g * 33 + cb) * 16 * 512 + lane * 8;
    f32x16 acc[4];
#pragma unroll
    for (int rt = 0; rt < 4; ++rt) acc[rt] = zero16();
    bf16x8 a0[2][4], b0[2], a1[2][4], b1[2];
#define S5S_LOAD(AA, BB, grp) do { _Pragma("unroll") for (int s = 0; s < 2; ++s) { const int ks = (grp) * 2 + s; BB[s] = ldg8(B + ks * 512); \
        _Pragma("unroll") for (int rt = 0; rt < 4; ++rt) AA[s][rt] = ldg8(A + (ks * 4 + rt) * 512); } } while (0)
#define S5S_MMA(AA, BB) do { _Pragma("unroll") for (int s = 0; s < 2; ++s) _Pragma("unroll") for (int rt = 0; rt < 4; ++rt) acc[rt] = mma32(AA[s][rt], BB[s], acc[rt]); } while (0)
    S5S_LOAD(a0, b0, 0);
#pragma unroll 1
    for (int gp = 0; gp < 8; gp += 2) {
        S5S_LOAD(a1, b1, gp + 1);
        S5S_MMA(a0, b0);
        if (gp + 2 < 8) S5S_LOAD(a0, b0, gp + 2);
        S5S_MMA(a1, b1);
    }
#undef S5S_LOAD
#undef S5S_MMA
    float* o = HLOC + ((size_t)(g * 2 + dir) * NCH16 + cb * 32 + li) * 128;
#pragma unroll
    for (int rt = 0; rt < 4; ++rt)
#pragma unroll
        for (int q = 0; q < 4; ++q) *(f32x4*)(o + rt * 32 + 8 * q + 4 * h) = (f32x4){acc[rt][4 * q], acc[rt][4 * q + 1], acc[rt][4 * q + 2], acc[rt][4 * q + 3]};
}
__device__ __forceinline__ void s5_scan_item(const float* A16  , const float* HLOC, bf16* HIN, int item, int lane) {
    const int dir = item & 1, g = (item >> 1) & 15, b = item >> 5, p = lane;
    const f32x2 a = *(const f32x2*)(A16 + ((size_t)(dir * 16 + g) * 64 + p) * 2);
    const float* src = HLOC + (size_t)(g * 2 + dir) * NCH16 * 128 + 2 * p;
    const int k2 = dir * 128 + 2 * p; bf16* dst = HIN + ((size_t)g * 33 * 16 + (k2 >> 4)) * 512 + ((k2 >> 3) & 1) * 256 + (k2 & 7);
    float hr = 0.f, hi = 0.f;
#define S5_CH(s) ((s) < 16 ? 1024 + 16 * b + (dir ? 15 - (s) : (s)) : 512 * b + (dir ? 511 - ((s) - 16) : (s) - 16))
    f32x2 v[32], w[32];
#pragma unroll
    for (int j = 0; j < 32; ++j) v[j] = *(const f32x2*)(src + (size_t)S5_CH(j) * 128);
    for (int s0 = 0; s0 < 528; s0 += 32) {
        const int nb = 528 - s0 < 32 ? 528 - s0 : 32;
        if (s0 + 32 < 528) {
#pragma unroll
            for (int j = 0; j < 32; ++j) { const int s = s0 + 32 + j; w[j] = *(const f32x2*)(src + (size_t)S5_CH(s < 528 ? s : 527) * 128); } }
#pragma unroll
        for (int j = 0; j < 32; ++j) if (j < nb) { const int c = S5_CH(s0 + j);
            *(unsigned*)(dst + (size_t)(c >> 5) * 8192 + (c & 31) * 8) = pk2(hr, hi);
            const float nr = a.x * hr - a.y * hi + v[j].x, ni = a.x * hi + a.y * hr + v[j].y; hr = nr; hi = ni; }
#pragma unroll
        for (int j = 0; j < 32; ++j) v[j] = w[j];
    }
#undef S5_CH
}
__device__ __forceinline__ void s5_out_item(const bf16* TABF  , const bf16* SUF, const bf16* HINF, bf16* Z, int item, int lane) {
    const int mh = item & 1, it2 = item >> 1, cb = it2 % 33, g = it2 / 33, li = lane & 31, h = lane >> 5, c = cb * 32 + li;
    const bf16* A = TABF + ((size_t)g * 256 + mh * 128) * 512 + lane * 8;
    const bf16* B0 = SUF + (size_t)(g * 33 + cb) * 16 * 512 + lane * 8;
    const bf16* B1 = HINF + (size_t)(g * 33 + cb) * 16 * 512 + lane * 8;
    f32x16 acc[4];
#pragma unroll
    for (int rt = 0; rt < 4; ++rt) acc[rt] = zero16();
    bf16x8 a0[2][4], b0[2], a1[2][4], b1[2];
#define S5O_LOAD(AA, BB, grp) do { _Pragma("unroll") for (int s = 0; s < 2; ++s) { const int ks = (grp) * 2 + s; BB[s] = ldg8((ks < 16 ? B0 + ks * 512 : B1 + (ks - 16) * 512)); \
        _Pragma("unroll") for (int rt = 0; rt < 4; ++rt) AA[s][rt] = ldg8(A + (ks * 4 + rt) * 512); } } while (0)
#define S5O_MMA(AA, BB) do { _Pragma("unroll") for (int s = 0; s < 2; ++s) _Pragma("unroll") for (int rt = 0; rt < 4; ++rt) acc[rt] = mma32(AA[s][rt], BB[s], acc[rt]); } while (0)
    S5O_LOAD(a0, b0, 0);
#pragma unroll 1
    for (int gp = 0; gp < 16; gp += 2) {
        S5O_LOAD(a1, b1, gp + 1);
        S5O_MMA(a0, b0);
        if (gp + 2 < 16) S5O_LOAD(a0, b0, gp + 2);
        S5O_MMA(a1, b1);
    }
#undef S5O_LOAD
#undef S5O_MMA
#pragma unroll
    for (int rt = 0; rt < 4; ++rt)
#pragma unroll
        for (int q = 0; q < 4; ++q) {
            const int i = 8 * mh + 2 * rt + (q >> 1), ho0 = 8 * (q & 1) + 4 * h;
            u32x2 w; w.x = pk2(gelu_tanh(acc[rt][4 * q]), gelu_tanh(acc[rt][4 * q + 1])); w.y = pk2(gelu_tanh(acc[rt][4 * q + 2]), gelu_tanh(acc[rt][4 * q + 3]));
            *(u32x2*)(Z + ((size_t)c * 16 + i) * 256 + g * 16 + ho0) = w; }
}

__device__ __forceinline__ int ret_tok0(int b, int n) { return n < 64 ? b * SEQ + n * 128 : LROWS + b * CTXL + (n - 64) * 128; }
__device__ __forceinline__ void ret_kv_item(const bf16* RKT, const bf16* RVT, const float* COST, const float* SINT, const float* decay  , float* KV, int item, int lane) {
    const int n = item % 66, bh = item / 66, hd = bh & 3, b = bh >> 2, li = lane & 31, h = lane >> 5;
    const int tok0 = ret_tok0(b, n); const bool lat = n < 64;
    const float lgf = -log2f(1.f + __expf(-decay[hd])), lgr = -log2f(1.f + __expf(-decay[4 + hd]));
    f32x16 acc[2][2][2];
#pragma unroll
    for (int a = 0; a < 2; ++a)
#pragma unroll
        for (int c = 0; c < 2; ++c)
#pragma unroll
            for (int d = 0; d < 2; ++d) acc[a][c][d] = zero16();
    const bf16* k0p = RKT + (size_t)(hd * 64 + li) * R + tok0 + 8 * h;
    const bf16* v0p = RVT + (size_t)(hd * 64 + li) * R + tok0 + 8 * h;
#pragma unroll 2
    for (int ks = 0; ks < 8; ++ks) {
        float k1[8], k2[8];
        unpack8(ldg8(k0p + ks * 16), k1); unpack8(ldg8(k0p + (size_t)32 * R + ks * 16), k2);
        if (lat) {
            const float* cp = COST + (size_t)li * SEQ + n * 128 + ks * 16 + 8 * h; const float* sp = SINT + (size_t)li * SEQ + n * 128 + ks * 16 + 8 * h;
            const f32x4 c0 = *(const f32x4*)cp, c1 = *(const f32x4*)(cp + 4), s0 = *(const f32x4*)sp, s1 = *(const f32x4*)(sp + 4);
#pragma unroll
            for (int j = 0; j < 8; ++j) { const float cc = j < 4 ? c0[j & 3] : c1[j & 3], ss = j < 4 ? s0[j & 3] : s1[j & 3];
                const float x1 = k1[j], x2 = k2[j]; k1[j] = x1 * cc - x2 * ss; k2[j] = x1 * ss + x2 * cc; }
        }
        const bf16x8 vf0 = ldg8(v0p + ks * 16), vf1 = ldg8(v0p + (size_t)32 * R + ks * 16);
#pragma unroll
        for (int dir = 0; dir < 2; ++dir) {
            float a1[8], a2[8];
#pragma unroll
            for (int j = 0; j < 8; ++j) { const int i = ks * 16 + 8 * h + j; const float w = dir == 0 ? ex2(lgf * (float)(127 - i)) : ex2(lgr * (float)i); a1[j] = k1[j] * w; a2[j] = k2[j] * w; }
            const bf16x8 kd0 = pack8(a1), kd1 = pack8(a2);
            acc[dir][0][0] = mma32(kd0, vf0, acc[dir][0][0]); acc[dir][0][1] = mma32(kd0, vf1, acc[dir][0][1]);
            acc[dir][1][0] = mma32(kd1, vf0, acc[dir][1][0]); acc[dir][1][1] = mma32(kd1, vf1, acc[dir][1][1]);
        }
    }
#pragma unroll
    for (int dir = 0; dir < 2; ++dir) { float* o = KV + ((size_t)((b * 4 + hd) * 2 + dir) * 66 + n) * 4096;
#pragma unroll
        for (int dt = 0; dt < 2; ++dt)
#pragma unroll
            for (int et = 0; et < 2; ++et)
#pragma unroll
                for (int q = 0; q < 4; ++q) *(f32x4*)(o + (size_t)(et * 32 + li) * 64 + dt * 32 + 8 * q + 4 * h) = (f32x4){acc[dir][dt][et][4 * q], acc[dir][dt][et][4 * q + 1], acc[dir][dt][et][4 * q + 2], acc[dir][dt][et][4 * q + 3]}; }
}
__device__ __forceinline__ void ret_scan_item(const float* decay, const float* KV, bf16* SPREV, int item, int lane) {
    const int blk = item & 63, bhd = item >> 6, dir = bhd & 1, hd = (bhd >> 1) & 3, idx = blk * 64 + lane;
    const float lg = -log2f(1.f + __expf(-decay[dir * 4 + hd])), cd = ex2(128.f * lg);
    const float* src = KV + (size_t)bhd * 66 * 4096 + idx; bf16* dst = SPREV + (size_t)bhd * 66 * 4096 + idx;
    float s = 0.f;
    for (int s0 = 0; s0 < 66; s0 += 11) {
        float v[11];
#pragma unroll
        for (int j = 0; j < 11; ++j) { const int t = s0 + j; const int n = dir == 0 ? (t < 2 ? 64 + t : t - 2) : (t < 2 ? 65 - t : 65 - t); v[j] = src[(size_t)n * 4096]; }
#pragma unroll
        for (int j = 0; j < 11; ++j) { const int t = s0 + j; const int n = dir == 0 ? (t < 2 ? 64 + t : t - 2) : (t < 2 ? 65 - t : 65 - t); dst[(size_t)n * 4096] = (bf16)(pk2(s, 0.f) & 0xffffu); s = cd * s + v[j]; }
    }
}
struct KVTile { u32x4 k[4], v[4]; };
__device__ __forceinline__ void kv_tile_load(KVTile& T, const bf16* Kh  , const bf16* VTh  , int tok0, int lane) {
#pragma unroll
    for (int i = 0; i < 4; ++i) T.k[i] = *(const u32x4*)(Kh + (size_t)(tok0 + 8 * i + (lane >> 3)) * 256 + (lane & 7) * 8);
#pragma unroll
    for (int i = 0; i < 4; ++i) T.v[i] = *(const u32x4*)(VTh + (size_t)(16 * i + (lane >> 2)) * R + tok0 + (lane & 3) * 8);
}
__device__ __forceinline__ void kv_tile_store(const KVTile& T, LAS unsigned char* wl, int lane) {
#pragma unroll
    for (int i = 0; i < 4; ++i) *(LAS u32x4*)(wl + (8 * i + (lane >> 3)) * 144 + (lane & 7) * 16) = T.k[i];
#pragma unroll
    for (int i = 0; i < 4; ++i) *(LAS u32x4*)(wl + 4608 + (16 * i + (lane >> 2)) * 80 + (lane & 3) * 16) = T.v[i];
}
__device__ __forceinline__ void kv_tile_frags(const LAS unsigned char* wl, int lane, bf16x8 (&kf)[4], bf16x8 (&vf)[2][2]) {
    const int li = lane & 31, h = lane >> 5;
#pragma unroll
    for (int s = 0; s < 4; ++s) kf[s] = *(const LAS bf16x8*)(wl + li * 144 + (2 * s + h) * 16);
#pragma unroll
    for (int et = 0; et < 2; ++et)
#pragma unroll
        for (int s2 = 0; s2 < 2; ++s2) { const LAS unsigned char* p = wl + 4608 + (et * 32 + li) * 80 + s2 * 32 + 8 * h;
            const bf16x4 lo = *(const LAS bf16x4*)p, hi = *(const LAS bf16x4*)(p + 16); vf[et][s2] = __builtin_shufflevector(lo, hi, 0, 1, 2, 3, 4, 5, 6, 7); }
}

__device__ __forceinline__ void rope_item(bf16* RQ, bf16* RK, const float* COSN, const float* SINN, int item, int lane) {
    const int u = lane & 15, off = (u >> 2) * 64 + (u & 3) * 8, c8 = (u & 3) * 8;
#pragma unroll 4
    for (int st = 0; st < 32; ++st) { const int row = item * 128 + 4 * st + (lane >> 4), tl = row & (SEQ - 1);
        const f32x4 c0 = *(const f32x4*)(COSN + (size_t)tl * 32 + c8), c1 = *(const f32x4*)(COSN + (size_t)tl * 32 + c8 + 4), s0 = *(const f32x4*)(SINN + (size_t)tl * 32 + c8), s1 = *(const f32x4*)(SINN + (size_t)tl * 32 + c8 + 4);
#pragma unroll
        for (int w = 0; w < 2; ++w) { bf16* p = (w ? RK : RQ) + (size_t)row * 256 + off; float x1[8], x2[8]; unpack8(*(const bf16x8*)p, x1); unpack8(*(const bf16x8*)(p + 32), x2);
#pragma unroll
            for (int j = 0; j < 8; ++j) { const float cc = j < 4 ? c0[j & 3] : c1[j & 3], ss = j < 4 ? s0[j & 3] : s1[j & 3]; const float a = x1[j], bb = x2[j]; x1[j] = a * cc - bb * ss; x2[j] = a * ss + bb * cc; }
            *(bf16x8*)p = pack8(x1); *(bf16x8*)(p + 32) = pack8(x2); } }
}
__device__ __forceinline__ void ret_out_item(const bf16* RQ, const bf16* RK, const bf16* RG, const bf16* RVT, const bf16* SPREV, const float* decay, const float* gn  , bf16* MIX,
                                             LAS unsigned char* wl, int item, int lane) {
    const int qb = item & 3, it2 = item >> 2, n = it2 % 66, bh = it2 / 66, hd = bh & 3, b = bh >> 2, li = lane & 31, h = lane >> 5;
    const int tok0 = ret_tok0(b, n);
    const float lgf = -log2f(1.f + __expf(-decay[hd])), lgr = -log2f(1.f + __expf(-decay[4 + hd]));
    const int iq = qb * 32 + li;
    const bf16* Kh = RK + hd * 64; const bf16* VTh = RVT + (size_t)hd * 64 * R;
    KVTile T; kv_tile_load(T, Kh, VTh, tok0, lane);
    bf16x8 qf[4];
    { const bf16* qp = RQ + (size_t)(tok0 + iq) * 256 + hd * 64 + 8 * h;
#pragma unroll
      for (int s = 0; s < 4; ++s) qf[s] = ldg8(qp + 16 * s); }
    kv_tile_store(T, wl, lane);
    f32x16 accO[2] = {zero16(), zero16()};
#pragma unroll 1
    for (int kt = 0; kt < 4; ++kt) {
        kv_tile_load(T, Kh, VTh, tok0 + (kt < 3 ? kt + 1 : kt) * 32, lane);
        bf16x8 kf[4], vf[2][2]; kv_tile_frags(wl, lane, kf, vf);
        f32x16 st = zero16();
#pragma unroll
        for (int s = 0; s < 4; ++s) st = mma32(kf[s], qf[s], st);
#pragma unroll
        for (int r = 0; r < 16; ++r) { const int j = kt * 32 + DROW(r, h), df = iq - j;
            const float w = df > 0 ? ex2(lgf * (float)df) : (df < 0 ? ex2(lgr * (float)(-df)) : 2.f); st[r] *= w; }
        const bf16x8 p0 = accB<0>(st), p1 = accB<1>(st);
        accO[0] = mma32(vf[0][0], p0, accO[0]); accO[0] = mma32(vf[0][1], p1, accO[0]); accO[1] = mma32(vf[1][0], p0, accO[1]); accO[1] = mma32(vf[1][1], p1, accO[1]);
        kv_tile_store(T, wl, lane);
    }
    const float cf = ex2(lgf * (float)(iq + 1)), cr = ex2(lgr * (float)(128 - iq));
#pragma unroll
    for (int dir = 0; dir < 2; ++dir) { const bf16* sp = SPREV + ((size_t)((b * 4 + hd) * 2 + dir) * 66 + n) * 4096;
#pragma unroll
        for (int et = 0; et < 2; ++et) { f32x16 a = zero16();
#pragma unroll
            for (int s = 0; s < 4; ++s) a = mma32(ldg8(sp + (size_t)(et * 32 + li) * 64 + 16 * s + 8 * h), qf[s], a);
            const float sc = dir == 0 ? cf : cr;
#pragma unroll
            for (int r = 0; r < 16; ++r) accO[et][r] += sc * a[r]; } }
    float s1 = 0.f;
#pragma unroll
    for (int et = 0; et < 2; ++et)
#pragma unroll
        for (int r = 0; r < 16; ++r) s1 += accO[et][r];
    s1 = xor32_sum(s1); const float mu = s1 * (1.f / 64.f);
    float s2 = 0.f;
#pragma unroll
    for (int et = 0; et < 2; ++et)
#pragma unroll
        for (int r = 0; r < 16; ++r) { const float dlt = accO[et][r] - mu; s2 += dlt * dlt; }
    s2 = xor32_sum(s2); const float rstd = __builtin_amdgcn_rsqf(s2 * (1.f / 64.f) + EPSN);
    const size_t tok = (size_t)(tok0 + iq);
#pragma unroll
    for (int et = 0; et < 2; ++et)
#pragma unroll
        for (int q = 0; q < 4; ++q) { const int e0 = hd * 64 + et * 32 + 8 * q + 4 * h;
            const f32x4 gv = *(const f32x4*)(gn + e0); const u32x2 gg = *(const u32x2*)(RG + tok * 256 + e0);
            const float g0 = bflo(gg.x), g1 = bfhi(gg.x), g2 = bflo(gg.y), g3 = bfhi(gg.y);
            u32x2 w; w.x = pk2(silu_(g0) * (accO[et][4 * q] - mu) * rstd * gv[0], silu_(g1) * (accO[et][4 * q + 1] - mu) * rstd * gv[1]);
            w.y = pk2(silu_(g2) * (accO[et][4 * q + 2] - mu) * rstd * gv[2], silu_(g3) * (accO[et][4 * q + 3] - mu) * rstd * gv[3]);
            *(u32x2*)(MIX + tok * 1024 + 512 + e0) = w; }
}

__device__ __forceinline__ int na_tile_tok(int t, int b, int rs) { const int tb = t - 8; return t >= 8 ? b * SEQ + (rs + (tb >> 1)) * 64 + (tb & 1) * 32 : LROWS + b * CTXL + t * 32; }
__device__ __forceinline__ void na_item(const bf16* NQ, const bf16* NK, const bf16* NVT, bf16* MIX, const LAS float* rpb2, LAS unsigned char* wl, bool ctxq, int b, int r, int hd, int qs, int lane) {
    const int li = lane & 31, h = lane >> 5;
    const int tokq = ctxq ? LROWS + b * CTXL + qs * 32 + li : b * SEQ + r * 64 + qs * 32 + li;
    bf16x8 qf[4];
#pragma unroll
    for (int s = 0; s < 4; ++s) qf[s] = ldg8(NQ + (size_t)tokq * 256 + hd * 64 + 16 * s + 8 * h);
    float mrun = -1e30f, lrun = 0.f;
    f32x16 accO[2] = {zero16(), zero16()};
    const int rs = r - 4 < 0 ? 0 : (r - 4 > 120 ? 120 : r - 4);
    const int qc = qs * 32 + li, cs = qc - 8 < 0 ? 0 : (qc - 8 > 48 ? 48 : qc - 8);
    const int ntile = ctxq ? 8 : 24;
    const float c1 = 0.125f * LOG2E;
    const bf16* Kh = NK + hd * 64; const bf16* VTh = NVT + (size_t)hd * 64 * R;
    KVTile T; kv_tile_load(T, Kh, VTh, na_tile_tok(0, b, rs), lane); kv_tile_store(T, wl, lane);
#pragma unroll 1
    for (int t = 0; t < ntile; ++t) {
        const bool band = t >= 8; const int tb = t - 8, rr = rs + (tb >> 1), ct = tb & 1;
        kv_tile_load(T, Kh, VTh, na_tile_tok(t + 1 < ntile ? t + 1 : t, b, rs), lane);
        bf16x8 kf[4], vf[2][2]; kv_tile_frags(wl, lane, kf, vf);
        f32x16 st = zero16();
#pragma unroll
        for (int s = 0; s < 4; ++s) st = mma32(kf[s], qf[s], st);
        float mt = -INFINITY;
        if (band) { const int dr = rr - r + 7; const LAS float* bp = rpb2 + ((hd * 15 + dr) * 31 + 32 * ct - qc + 15 + 4 * h); const int d0 = 32 * ct + 4 * h - cs;
#pragma unroll
            for (int g = 0; g < 16; ++g) { const int o = 8 * (g >> 2) + (g & 3); const bool inw = (unsigned)(d0 + o) < 16u;
                const float v = inw ? st[g] * c1 + bp[o] : -INFINITY; st[g] = v; mt = fmaxf(mt, v); }
        } else {
#pragma unroll
            for (int g = 0; g < 16; ++g) { const float v = st[g] * c1; st[g] = v; mt = fmaxf(mt, v); }
        }
        mt = xor32_max(mt);
        const float mnew = fmaxf(mrun, mt);
        if (__builtin_amdgcn_ballot_w64(mnew > mrun)) { const float alpha = ex2(mrun - mnew); lrun *= alpha;
#pragma unroll
            for (int et = 0; et < 2; ++et)
#pragma unroll
                for (int g = 0; g < 16; ++g) accO[et][g] *= alpha; }
        mrun = mnew;
        float ps = 0.f;
#pragma unroll
        for (int g = 0; g < 16; ++g) { const float p = ex2(st[g] - mnew); st[g] = p; ps += p; }
        lrun += xor32_sum(ps);
        const bf16x8 p0 = accB<0>(st), p1 = accB<1>(st);
        accO[0] = mma32(vf[0][0], p0, accO[0]); accO[0] = mma32(vf[0][1], p1, accO[0]); accO[1] = mma32(vf[1][0], p0, accO[1]); accO[1] = mma32(vf[1][1], p1, accO[1]);
        kv_tile_store(T, wl, lane);
    }
    const float inv = 1.f / lrun;
#pragma unroll
    for (int et = 0; et < 2; ++et)
#pragma unroll
        for (int q = 0; q < 4; ++q) { u32x2 w; w.x = pk2(accO[et][4 * q] * inv, accO[et][4 * q + 1] * inv); w.y = pk2(accO[et][4 * q + 2] * inv, accO[et][4 * q + 3] * inv);
            *(u32x2*)(MIX + (size_t)tokq * 1024 + 768 + hd * 64 + et * 32 + 8 * q + 4 * h) = w; }
}

__device__ __forceinline__ void fft1_item(const bf16* F, const bf16* W128T, const float* TWC, const float* TWS, bf16* FB, int item, int lane) {
    const int l2 = item & 63, g = (item >> 6) & 3, b = item >> 8, li = lane & 31, h = lane >> 5;
    bf16x8 idf[4];
#pragma unroll
    for (int s = 0; s < 4; ++s) { float v[8];
#pragma unroll
        for (int j = 0; j < 8; ++j) v[j] = (16 * (s & 1) + 8 * h + j == li) ? 1.f : 0.f;
        idf[s] = pack8(v); }
    bf16x8 xb[4][2][2];
#pragma unroll
    for (int lt = 0; lt < 4; ++lt) {
        const bf16* xp = F + (size_t)(b * SEQ + 64 * (lt * 32 + li) + l2) * 256 + g * 64 + 8 * h;
        const bf16x8 x0 = ldg8(xp), x1 = ldg8(xp + 16), x2 = ldg8(xp + 32), x3 = ldg8(xp + 48);
        f32x16 c0 = zero16(), c1 = zero16();
        c0 = mma32(x0, idf[0], c0); c0 = mma32(x1, idf[1], c0);
        c1 = mma32(x2, idf[0], c1); c1 = mma32(x3, idf[1], c1);
        xb[lt][0][0] = accB<0>(c0); xb[lt][0][1] = accB<1>(c0); xb[lt][1][0] = accB<0>(c1); xb[lt][1][1] = accB<1>(c1);
    }
#pragma unroll 1
    for (int kb = 0; kb < 4; ++kb) {
        f32x16 acc[2][2];
#pragma unroll
        for (int ri = 0; ri < 2; ++ri) { acc[ri][0] = zero16(); acc[ri][1] = zero16();
            const bf16* wp = W128T + ((size_t)ri * 128 + kb * 32 + li) * 128 + 4 * h;
#pragma unroll
            for (int lt = 0; lt < 4; ++lt)
#pragma unroll
                for (int s = 0; s < 2; ++s) { const bf16x8 wf = ldg8p(wp + lt * 32 + 16 * s);
                    acc[ri][0] = mma32(wf, xb[lt][0][s], acc[ri][0]); acc[ri][1] = mma32(wf, xb[lt][1][s], acc[ri][1]); } }
#pragma unroll
        for (int q = 0; q < 4; ++q) { const int k1 = kb * 32 + 8 * q + 4 * h;
            const f32x4 tc = *(const f32x4*)(TWC + l2 * 128 + k1), ts = *(const f32x4*)(TWS + l2 * 128 + k1);
#pragma unroll
            for (int j = 0; j < 4; ++j)
#pragma unroll
                for (int ct = 0; ct < 2; ++ct) { const float ar = acc[0][ct][4 * q + j], ai = acc[1][ct][4 * q + j];
                    const float br = ar * tc[j] + ai * ts[j], bi = ai * tc[j] - ar * ts[j];
                    bf16* o = FB + ((((size_t)(b * 4 + g) * 128 + k1 + j) * 2) * 64 + l2) * 64 + ct * 32 + li;
                    o[0] = (bf16)(pk2(br, 0.f) & 0xffffu); o[64 * 64] = (bf16)(pk2(bi, 0.f) & 0xffffu); } }
    }
}
__device__ __forceinline__ void fft2_item(const bf16* FB, const bf16* FCT, const bf16* W64T, bf16* MIX, int item, int lane) {
    const int mh = item & 1, k1 = (item >> 1) & 127, g = (item >> 8) & 3, b = item >> 10, li = lane & 31, h = lane >> 5;
    const bf16* br = FB + (((size_t)(b * 4 + g) * 128 + k1) * 2) * 64 * 64; const bf16* bi = br + 64 * 64;
    const bf16* fc = FCT + (size_t)(mh * 32 + li) * 64 + 8 * h; const bf16* fs = fc + 64 * 64; const bf16* fn = fc + 2 * 64 * 64;
    bf16x8 eb[2][2][2];
#pragma unroll
    for (int lt = 0; lt < 2; ++lt) { f32x16 er = zero16(), ei = zero16();
#pragma unroll
        for (int s = 0; s < 4; ++s) { const bf16x8 ar = ldg8(br + (size_t)(lt * 32 + li) * 64 + 16 * s + 8 * h), ai = ldg8(bi + (size_t)(lt * 32 + li) * 64 + 16 * s + 8 * h);
            const bf16x8 c = ldg8(fc + 16 * s), sn = ldg8(fs + 16 * s), ns = ldg8(fn + 16 * s);
            er = mma32(ar, c, er); er = mma32(ai, sn, er); ei = mma32(ai, c, ei); ei = mma32(ar, ns, ei); }
        eb[lt][0][0] = accB<0>(er); eb[lt][0][1] = accB<1>(er); eb[lt][1][0] = accB<0>(ei); eb[lt][1][1] = accB<1>(ei); }
#pragma unroll
    for (int kt = 0; kt < 2; ++kt) { f32x16 o = zero16();
        const bf16* wc = W64T + (size_t)(kt * 32 + li) * 64 + 4 * h; const bf16* wsn = wc + 64 * 64;
#pragma unroll
        for (int lt = 0; lt < 2; ++lt)
#pragma unroll
            for (int s = 0; s < 2; ++s) { o = mma32(ldg8p(wc + lt * 32 + 16 * s), eb[lt][0][s], o); o = mma32(ldg8p(wsn + lt * 32 + 16 * s), eb[lt][1][s], o); }
#pragma unroll
        for (int rg = 0; rg < 16; ++rg) { const int k2 = kt * 32 + DROW(rg, h);
            MIX[(size_t)(b * SEQ + k1 + 128 * k2) * 1024 + g * 64 + mh * 32 + li] = (bf16)(pk2(o[rg], 0.f) & 0xffffu); } }
}
__device__ __forceinline__ void fftc_item(const bf16* F, const bf16* FCT, const bf16* W256T, bf16* MIX, int item, int lane) {
    const int mh = item & 1, kb = (item >> 1) & 7, g = (item >> 4) & 3, b = item >> 6, li = lane & 31, h = lane >> 5;
    const bf16* fc = FCT + (size_t)(mh * 32 + li) * 64 + 8 * h; const bf16* fn = fc + 2 * 64 * 64;
    const bf16* wc = W256T + (size_t)(kb * 32 + li) * 256 + 4 * h; const bf16* wsn = wc + 256 * 256;
    f32x16 o = zero16();
#pragma unroll 1
    for (int lt = 0; lt < 8; ++lt) { f32x16 zr = zero16(), zi = zero16();
        const bf16* xp = F + (size_t)(LROWS + b * CTXL + lt * 32 + li) * 256 + g * 64 + 8 * h;
#pragma unroll
        for (int s = 0; s < 4; ++s) { const bf16x8 x = ldg8(xp + 16 * s); zr = mma32(x, ldg8(fc + 16 * s), zr); zi = mma32(x, ldg8(fn + 16 * s), zi); }
        o = mma32(ldg8p(wc + lt * 32), accB<0>(zr), o); o = mma32(ldg8p(wc + lt * 32 + 16), accB<1>(zr), o);
        o = mma32(ldg8p(wsn + lt * 32), accB<0>(zi), o); o = mma32(ldg8p(wsn + lt * 32 + 16), accB<1>(zi), o); }
#pragma unroll
    for (int rg = 0; rg < 16; ++rg) { const int k = kb * 32 + DROW(rg, h);
        MIX[(size_t)(LROWS + b * CTXL + k) * 1024 + g * 64 + mh * 32 + li] = (bf16)(pk2(o[rg], 0.f) & 0xffffu); }
}
__device__ __forceinline__ void row_ld_f32(const float* p, int lane, f32x4 (&v)[4]) {
#pragma unroll
    for (int j = 0; j < 4; ++j) v[j] = *(const f32x4*)(p + 256 * j + 4 * lane); }
__device__ __forceinline__ void row_ld_bf16(const bf16* p, int lane, f32x4 (&v)[4]) {
#pragma unroll
    for (int j = 0; j < 4; ++j) { const u32x2 w = *(const u32x2*)(p + 256 * j + 4 * lane); v[j] = (f32x4){bflo(w.x), bfhi(w.x), bflo(w.y), bfhi(w.y)}; } }
__device__ __forceinline__ void row_st_f32(float* p, int lane, const f32x4 (&v)[4]) {
#pragma unroll
    for (int j = 0; j < 4; ++j) *(f32x4*)(p + 256 * j + 4 * lane) = v[j]; }
__device__ __forceinline__ void row_st_bf16(bf16* p, int lane, const f32x4 (&v)[4]) {
#pragma unroll
    for (int j = 0; j < 4; ++j) { u32x2 w; w.x = pk2(v[j][0], v[j][1]); w.y = pk2(v[j][2], v[j][3]); *(u32x2*)(p + 256 * j + 4 * lane) = w; } }
__device__ __forceinline__ float row_rstd(const f32x4 (&v)[4]) { float s = 0.f;
#pragma unroll
    for (int j = 0; j < 4; ++j) s += (v[j][0] * v[j][0] + v[j][1] * v[j][1]) + (v[j][2] * v[j][2] + v[j][3] * v[j][3]);
    return __builtin_amdgcn_rsqf(wave_sum(s) * (1.f / 1024.f) + EPSN); }
__device__ __forceinline__ void row_modnorm(const f32x4 (&x)[4], const float* g, const float* sc, const float* sh, int lane, f32x4 (&hh)[4]) {
    const float rs = row_rstd(x); f32x4 gv[4], scv[4], shv[4]; row_ld_f32(g, lane, gv); row_ld_f32(sc, lane, scv); row_ld_f32(sh, lane, shv);
#pragma unroll
    for (int j = 0; j < 4; ++j) hh[j] = x[j] * rs * gv[j] * (scv[j] + 1.f) + shv[j]; }
__device__ __forceinline__ void row_resid(f32x4 (&x)[4], const f32x4 (&t)[4], const float* g, const float* gate, int lane) {
    const float rs = row_rstd(t); f32x4 gv[4], ga[4]; row_ld_f32(g, lane, gv); row_ld_f32(gate, lane, ga);
#pragma unroll
    for (int j = 0; j < 4; ++j) x[j] = x[j] + ga[j] * (t[j] * rs * gv[j]); }

__device__ __forceinline__ void transpose_item(const float* W, int ldw, int k0, int n0, bf16* dst, int ldd, float scale, LAS float* scr, int lane) {
#pragma unroll 8
    for (int i = 0; i < 32; ++i) { const int kk = 2 * i + (lane >> 5); scr[kk * 33 + (lane & 31)] = W[(size_t)(k0 + kk) * ldw + n0 + (lane & 31)]; }
    LDS_WAIT(); asm volatile("" ::: "memory");
    const int c = lane & 7;
#pragma unroll
    for (int j = 0; j < 4; ++j) { const int n = (lane >> 3) + 8 * j; const LAS float* s = scr + (8 * c) * 33 + n;
        u32x4 o; o.x = pk2(s[0 * 33] * scale, s[1 * 33] * scale); o.y = pk2(s[2 * 33] * scale, s[3 * 33] * scale); o.z = pk2(s[4 * 33] * scale, s[5 * 33] * scale); o.w = pk2(s[6 * 33] * scale, s[7 * 33] * scale);
        *(u32x4*)(dst + (size_t)n * ldd + k0 + 8 * c) = o; }
    LDS_WAIT(); asm volatile("" ::: "memory");
}
#ifndef MK_MODE
#define MK_MODE 1
#endif
#ifndef MK_LAST
#define MK_LAST 24
#endif
constexpr int NPHASE = 24;
struct Args { const float* in[31]; float* out; unsigned char* ws; int ph_lo, ph_hi, li, pad; };


struct TrJob { const float* src; bf16* dst; int ldw, k0, n0, ldd; float scale; };
#define CAS __attribute__((address_space(4)))
__device__ __forceinline__ void tr_decode(int it, const CAS Args* ap_, unsigned char* ws, TrJob& J) {
#define TIN(k) ((const float*)(const GAS float*)ap_->in[k])
    int kb; J.scale = 1.f;
    if (it < 43008) { const int e = it / 5376, r = it % 5376, w = r / 1792, li = r % 1792;
        if (w < 2) { J.src = TIN(28 + w) + (size_t)e * 1024 * DFE; J.ldw = DFE; kb = li / 112; J.n0 = (li % 112) * 32; J.ldd = 1024;
            J.dst = (bf16*)(ws + WS_MOE1) + ((size_t)e * 7168 + 256 * (J.n0 / 128) + (J.n0 % 128) + 128 * w) * 1024; }
        else { J.src = TIN(30) + (size_t)e * DFE * 1024; J.ldw = 1024; kb = li / 32; J.n0 = (li % 32) * 32; J.ldd = DFE; J.dst = (bf16*)(ws + WS_MOE2) + ((size_t)e * 1024 + J.n0) * DFE; }
    } else if (it < 47232) { const int r = it - 43008, w = r / 1408, li = r % 1408;
        if (w < 2) { J.src = TIN(23 + w); J.ldw = DFF; kb = li / 88; J.n0 = (li % 88) * 32; J.ldd = 1024; J.dst = (bf16*)(ws + WS_FFN1) + (size_t)(256 * (J.n0 / 128) + (J.n0 % 128) + 128 * w) * 1024; }
        else { J.src = TIN(25); J.ldw = 1024; kb = li / 32; J.n0 = (li % 32) * 32; J.ldd = DFF; J.dst = (bf16*)(ws + WS_FFN2) + (size_t)J.n0 * DFF; }
    } else { const int r = it - 47232, l = r / 4384, q = r % 4384;
        if (q < 3328) { const int t = q / 128, li = q % 128; kb = li / 8; const int nb = li % 8;
            const int srcc = t < 4 ? 256 * t : (t < 7 ? 256 * (t + 1) : (t < 23 ? 2304 + 256 * (t - 7) : (t == 23 ? 768 : (t == 24 ? 1024 : 2048))));
            J.src = TIN(7) + (size_t)l * 1024 * 6400; J.ldw = 6400; J.n0 = srcc + 32 * nb; J.ldd = 1024; J.dst = (bf16*)(ws + WS_WIN) + ((size_t)(l * 26 + t) * 256 + 32 * nb) * 1024; J.scale = (t == 3 || t == 23) ? 0.125f : 1.f; }
        else if (q < 3360) { const int li = q - 3328; kb = li / 8; J.n0 = (li % 8) * 32; J.src = TIN(16) + (size_t)l * 65536; J.ldw = 256; J.ldd = 256; J.dst = (bf16*)(ws + WS_WGLU) + ((size_t)l * 256 + J.n0) * 256; }
        else if (q < 3872) { const int li = q - 3360, bb = li / 128, li2 = li % 128; kb = li2 / 32; J.n0 = (li2 % 32) * 32; J.src = TIN(21) + (size_t)(l * 4 + bb) * 256 * 1024; J.ldw = 1024; J.ldd = 256; J.dst = (bf16*)(ws + WS_WBR) + ((size_t)(l * 4 + bb) * 1024 + J.n0) * 256; }
        else { const int li = q - 3872; kb = li / 32; J.n0 = (li % 32) * 32; J.src = TIN(22) + (size_t)l * 1024 * 1024; J.ldw = 1024; J.ldd = 1024; J.dst = (bf16*)(ws + WS_WOUT) + ((size_t)l * 1024 + J.n0) * 1024; }
    }
    J.k0 = kb * 64;
#undef TIN
}
__device__ __forceinline__ void tr_load(const TrJob& J, int lane, float (&v)[32]) {
#pragma unroll
    for (int i = 0; i < 32; ++i) { const int kk = 2 * i + (lane >> 5); v[i] = J.src[(size_t)(J.k0 + kk) * J.ldw + J.n0 + (lane & 31)]; } }
__device__ __forceinline__ void tr_store(const TrJob& J, int lane, const float (&v)[32], LAS float* scr) {
#pragma unroll
    for (int i = 0; i < 32; ++i) { const int kk = 2 * i + (lane >> 5); scr[kk * 33 + (lane & 31)] = v[i]; }
    LDS_WAIT(); asm volatile("" ::: "memory");
    const int c = lane & 7;
#pragma unroll
    for (int j = 0; j < 4; ++j) { const int n = (lane >> 3) + 8 * j; const LAS float* s = scr + (8 * c) * 33 + n; const float sc = J.scale;
        u32x4 o; o.x = pk2(s[0 * 33] * sc, s[1 * 33] * sc); o.y = pk2(s[2 * 33] * sc, s[3 * 33] * sc); o.z = pk2(s[4 * 33] * sc, s[5 * 33] * sc); o.w = pk2(s[6 * 33] * sc, s[7 * 33] * sc);
        *(u32x4*)(J.dst + (size_t)n * J.ldd + J.k0 + 8 * c) = o; }
    LDS_WAIT(); asm volatile("" ::: "memory");
}

__device__ __forceinline__ void cs2pi(int m, int N, float& c, float& s) { sincospif(2.0f * (float)(m % N) / (float)N, &s, &c); }

__global__ void __launch_bounds__(NTHREADS, 2) mk_fwd(Args args) {
    extern __shared__ __attribute__((aligned(16))) unsigned char lds_raw[];
    LAS unsigned char* lds = (LAS unsigned char*)lds_raw;
    const int tid0 = threadIdx.x, wave = __builtin_amdgcn_readfirstlane(tid0 >> 6);
    const int G = gridDim.x, bx = blockIdx.x, vcu = (G % 8 == 0) ? (bx % 8) * (G / 8) + bx / 8 : bx;
    const int wslot = wave * G + vcu, NW = G * NWAVES;
    volatile LAS unsigned* lctl = (volatile LAS unsigned*)(lds + LDSCTL_OFF);
    for (int u = tid0; u < (LDS_BYTES - LDSCTL_OFF) / 4; u += NTHREADS) lctl[u] = 0u;
    __syncthreads();
    const int lo = args.ph_lo, hi = args.ph_hi, bli = args.li;
#ifdef MK_STAMP_PHASE
    if (wave == 0) *(volatile LAS unsigned long long*)(lctl + 64) = __builtin_amdgcn_s_memrealtime();
#endif
    { XcdBarrier b0 = xcd_barrier_post((unsigned*)(args.ws + WS_CTL) + CW_BAR + bli * XCD_BAR_WORDS, lctl + LW_BAR); (void)b0; }
#define IN(k) (lo <= (k) && (k) < hi)
#ifndef MK_REP_MASK
#define MK_REP_MASK 0u
#endif
#define NREP(k) (((MK_REP_MASK >> (k)) & 1u) ? 2 : 1)
#define FORCE_BAR do { PH_BEGIN XcdBarrier b_; b_.bar = (unsigned*)(ws + WS_CTL) + CW_BAR + bli * XCD_BAR_WORDS; b_.x = xb_xcc_id(); b_.st = lctl + LW_BAR; xcd_barrier(b_); } while (0)
#ifdef MK_STAMP_PHASE
#define STAMP_AT(k) do { if (wave == 0) { if ((k) == MK_STAMP_PHASE - 1) *(volatile LAS unsigned long long*)(lctl + 64) = __builtin_amdgcn_s_memrealtime(); if ((k) == MK_STAMP_PHASE) *(volatile LAS unsigned long long*)(lctl + 66) = __builtin_amdgcn_s_memrealtime(); } } while (0)
#else
#define STAMP_AT(k) do { } while (0)
#endif
#define SEAM(k) do { if (IN(k) && IN((k) + 1)) { PH_BEGIN XcdBarrier b_; b_.bar = (unsigned*)(ws + WS_CTL) + CW_BAR + bli * XCD_BAR_WORDS; b_.x = xb_xcc_id(); b_.st = lctl + LW_BAR; xcd_barrier(b_); } STAMP_AT(k); } while (0)
#define PH_BEGIN int tid; { int l_; asm volatile("v_mbcnt_lo_u32_b32 %0, -1, 0\n\tv_mbcnt_hi_u32_b32 %0, -1, %0" : "=v"(l_)); tid = wave * 64 + (l_ & 63); } const CAS Args* ap_ = (const CAS Args*)__builtin_amdgcn_kernarg_segment_ptr(); asm volatile("" : "+s"(ap_)); unsigned char* ws = (unsigned char*)(GAS unsigned char*)ap_->ws; const int lane = tid & 63; (void)lane;
#define AIN(k) ((const float*)(const GAS float*)ap_->in[k])
#define AOUT ((float*)(GAS float*)ap_->out)
#define MODp ((float*)(ws + CTL_MOD_OFF))
#define ctxbuf ((float*)(ws + WS_CTXBUF))
#define Hh ((bf16*)(ws + WS_H))
#define MIX ((bf16*)(ws + WS_MIX))
#define INP ((bf16*)(ws + WS_INP))
#define Tt ((bf16*)(ws + WS_T))

    for (int rep_ = 0; rep_ < NREP(0); ++rep_) if (IN(0)) { if (rep_) { FORCE_BAR; } PH_BEGIN
        for (int it = bx; it < 32; it += G) {
            const int l = it >> 4, g = it & 15;
            LAS f32x2* apow = (LAS f32x2*)lds; LAS f32x2* bbar = (LAS f32x2*)(lds + 8704); LAS f32x2* Cc = (LAS f32x2*)(lds + 16896); LAS float* Kt = (LAS float*)(lds + 25088);
            for (int dir = 0; dir < 2; ++dir) { const size_t pg = (size_t)(l * 2 + dir) * 16 + g;
                if (tid < 64) { const int p = tid;
                    const float are = AIN(8)[pg * 64 + p], aim = AIN(9)[pg * 64 + p], dt = expf(AIN(10)[pg]);
                    for (int t = 0; t <= 16; ++t) { const float mag = expf(are * dt * (float)t); float sn, cs; sincosf(aim * dt * (float)t, &sn, &cs); apow[t * 64 + p] = (f32x2){mag * cs, mag * sn}; }
                    const f32x2 a = apow[64 + p]; const float nr = a.x - 1.f, ni = a.y, den = 1.f / (are * are + aim * aim);
                    const float cr = (nr * are + ni * aim) * den, ci = (ni * are - nr * aim) * den;
                    for (int h = 0; h < 16; ++h) { const float br = AIN(11)[(pg * 64 + p) * 16 + h], bi = AIN(12)[(pg * 64 + p) * 16 + h]; bbar[p * 16 + h] = (f32x2){cr * br - ci * bi, cr * bi + ci * br}; }
                    *(f32x2*)((float*)(ws + WS_A16) + (pg * 64 + p) * 2) = apow[16 * 64 + p];
                }
                for (int i = tid; i < 1024; i += NTHREADS) Cc[i] = (f32x2){AIN(13)[pg * 1024 + i], AIN(14)[pg * 1024 + i]};
                __syncthreads();
                bf16* M1 = (bf16*)(ws + WS_S5M1) + ((size_t)(l * 16 + g) * 2 + dir) * 128 * 256;
                for (int v = tid; v < 4096; v += NTHREADS) { const int row = v >> 5, col0 = (v & 31) * 8, j = col0 >> 4, h0 = col0 & 15, p = row >> 1, ri = row & 1;
                    const f32x2 pw = apow[(dir == 0 ? 15 - j : j) * 64 + p]; float vals[8];
#pragma unroll
                    for (int hh = 0; hh < 8; ++hh) { const f32x2 bb = bbar[p * 16 + h0 + hh]; vals[hh] = ri ? pw.x * bb.y + pw.y * bb.x : pw.x * bb.x - pw.y * bb.y; }
                    *(bf16x8*)(M1 + ((((col0 >> 4) * 4 + (row >> 5)) * 64 + ((col0 >> 3) & 1) * 32 + (row & 31)) * 8)) = pack8(vals); }
                bf16* TAB = (bf16*)(ws + WS_S5TAB) + (size_t)(l * 16 + g) * 256 * 512;
                for (int v = tid; v < 4096; v += NTHREADS) { const int row = v >> 4, cv = v & 15, i = row >> 4, ho = row & 15; float vals[8];
#pragma unroll
                    for (int pp = 0; pp < 4; ++pp) { const int p = cv * 4 + pp; const f32x2 cc = Cc[ho * 64 + p];
                        const f32x2 pw = apow[(dir == 0 ? i + 1 : 16 - i) * 64 + p]; vals[2 * pp] = cc.x * pw.x - cc.y * pw.y; vals[2 * pp + 1] = -(cc.x * pw.y + cc.y * pw.x); }
                    { const int colt = 256 + dir * 128 + cv * 8; *(bf16x8*)(TAB + (((((row >> 7) * 32 + (colt >> 4)) * 4 + ((row >> 5) & 3)) * 64 + ((colt >> 3) & 1) * 32 + (row & 31)) * 8)) = pack8(vals); } }
                for (int e = tid; e < 4096; e += NTHREADS) { const int t = e >> 8, ho = (e >> 4) & 15, h = e & 15; float acc = 0.f;
#pragma unroll 8
                    for (int p = 0; p < 64; ++p) { const f32x2 cc = Cc[ho * 64 + p], pw = apow[t * 64 + p], bb = bbar[p * 16 + h];
                        const float xr = cc.x * pw.x - cc.y * pw.y, xi = cc.x * pw.y + cc.y * pw.x; acc += xr * bb.x - xi * bb.y; }
                    Kt[dir * 4096 + e] = acc; }
                __syncthreads();
            }
            for (int v = tid; v < 8192; v += NTHREADS) { const int row = v >> 5, col0 = (v & 31) * 8, i = row >> 4, ho = row & 15, j = col0 >> 4, h0 = col0 & 15; float vals[8];
#pragma unroll
                for (int hh = 0; hh < 8; ++hh) { const int h = h0 + hh;
                    vals[hh] = j < i ? Kt[(i - j) * 256 + ho * 16 + h] : (j > i ? Kt[4096 + (j - i) * 256 + ho * 16 + h] : Kt[ho * 16 + h] + Kt[4096 + ho * 16 + h] + (ho == h ? AIN(15)[l * 256 + g * 16 + h] : 0.f)); }
                *(bf16x8*)((bf16*)(ws + WS_S5TAB) + (size_t)(l * 16 + g) * 256 * 512 + (((((row >> 7) * 32 + (col0 >> 4)) * 4 + ((row >> 5) & 3)) * 64 + ((col0 >> 3) & 1) * 32 + (row & 31)) * 8)) = pack8(vals); }
            __syncthreads();
        }
        __syncthreads();
        for (int it = (bx >= 32 ? bx - 32 : bx + G - 32); it < 192; it += G) { const int l = it / 96, cb = it % 96, col = cb * 64 + lane, ks = wave;
            const float* wm = AIN(4) + ((size_t)l * 1024 + ks * 128) * 6144 + col; float a0 = 0.f, a1 = 0.f, a2 = 0.f;
#pragma unroll 8
            for (int k = 0; k < 128; ++k) { const float w = wm[(size_t)k * 6144]; const int kk = ks * 128 + k;
                const float c0 = AIN(1)[kk], c1 = AIN(1)[1024 + kk], c2 = AIN(3)[kk];
                a0 += w * (c0 / (1.f + __expf(-c0))); a1 += w * (c1 / (1.f + __expf(-c1))); a2 += w * (c2 / (1.f + __expf(-c2))); }
            LAS float* part = (LAS float*)lds;
            part[(wave * 3 + 0) * 64 + lane] = a0; part[(wave * 3 + 1) * 64 + lane] = a1; part[(wave * 3 + 2) * 64 + lane] = a2;
            __syncthreads();
            if (tid < 192) { const int i = tid >> 6, c = tid & 63; float sacc = AIN(5)[l * 6144 + cb * 64 + c];
#pragma unroll
                for (int w = 0; w < 8; ++w) sacc += part[(w * 3 + i) * 64 + c];
                MODp[(size_t)(l * 3 + i) * 6144 + cb * 64 + c] = sacc; }
            __syncthreads();
        }
        { LAS float* scr = (LAS float*)(lds + wave * 16384);
          unsigned* qh = (unsigned*)(ws + WS_CTL) + CW_QHEAD;
          int q = bx & 7;
          for (int tries = 0; tries < 8; ) {
            unsigned base = 0u; if (lane == 0) base = __hip_atomic_fetch_add(qh + 64 * q, 2u, __ATOMIC_RELAXED, __HIP_MEMORY_SCOPE_AGENT);
            base = (unsigned)__builtin_amdgcn_readfirstlane((int)base);
            if (base >= 7000u) { q = (q + 1) & 7; ++tries; continue; }
            float va[32], vb[32]; TrJob ja, jb; const bool two = base + 1u < 7000u;
            tr_decode(q * 7000 + (int)base, ap_, ws, ja); tr_load(ja, lane, va);
            tr_decode(q * 7000 + (int)base + (two ? 1 : 0), ap_, ws, jb); tr_load(jb, lane, vb);
            tr_store(ja, lane, va, scr); if (two) tr_store(jb, lane, vb, scr);
          } }
        for (int v = wslot * 64 + lane; v < 32 * SEQ; v += NW * 64) { const int p = v >> 13, t = v & 8191; const float pos = (float)(p < 16 ? (t >> 6) : (t & 63));
            const float inv = 1.0f / powf(10000.f, (float)(p & 15) / 16.f); float sn, cs; sincosf(pos * inv, &sn, &cs);
            ((float*)(ws + WS_COST))[v] = cs; ((float*)(ws + WS_SINT))[v] = sn; ((float*)(ws + WS_COSN))[t * 32 + p] = cs; ((float*)(ws + WS_SINN))[t * 32 + p] = sn; }
        for (int v = wslot * 64 + lane; v < 192512; v += NW * 64) { float c, s;
            if (v < 32768) { const int ri = v >> 14, k1 = (v >> 7) & 127, l1 = v & 127; cs2pi(k1 * l1, 128, c, s); const float sc = 0.08838834764831845f;
                ((bf16*)(ws + WS_W128T))[v] = (bf16)(pk2(ri ? -s * sc : c * sc, 0.f) & 0xffffu); }
            else if (v < 40960) { const int u = v - 32768, l2 = u >> 7, k1 = u & 127; cs2pi(k1 * l2, 8192, c, s); ((float*)(ws + WS_TWC))[u] = c; ((float*)(ws + WS_TWS))[u] = s; }
            else if (v < 53248) { const int u = v - 40960, w = u >> 12, m = (u >> 6) & 63, cc = u & 63; cs2pi(m * cc, 64, c, s);
                ((bf16*)(ws + WS_FCT))[u] = (bf16)(pk2((w == 0 ? c : (w == 1 ? s : -s)) * 0.125f, 0.f) & 0xffffu); }
            else if (v < 61440) { const int u = v - 53248, w = u >> 12, k2 = (u >> 6) & 63, l2 = u & 63; cs2pi(k2 * l2, 64, c, s); ((bf16*)(ws + WS_W64T))[u] = (bf16)(pk2((w == 0 ? c : s) * 0.125f, 0.f) & 0xffffu); }
            else { const int u = v - 61440, w = u >> 16, k = (u >> 8) & 255, l = u & 255; cs2pi(k * l, 256, c, s); ((bf16*)(ws + WS_W256T))[u] = (bf16)(pk2((w == 0 ? c : s) * 0.0625f, 0.f) & 0xffffu); }
        }
    }
    SEAM(0);

    for (int rep_ = 0; rep_ < NREP(1); ++rep_) if (IN(1)) { if (rep_) { FORCE_BAR; } PH_BEGIN
        for (int r = wslot; r < R; r += NW) { const int ci = r < SEQ ? 0 : (r < LROWS ? 1 : 2);
            f32x4 x[4], hh[4]; row_ld_f32(r < LROWS ? AIN(0) + (size_t)r * D : AIN(2) + (size_t)(r - LROWS) * D, lane, x);
            const float* md = MODp + (size_t)ci * 6144;
            row_modnorm(x, AIN(6), md + 1024, md, lane, hh); row_st_bf16(Hh + (size_t)r * D, lane, hh); }
    }
    SEAM(1);

    for (int layer = 0; layer < 2; ++layer) {
        const int pb = 1 + 11 * layer;
        const int nM = layer == 0 ? 66 : 64;
        const int nrows = layer == 0 ? R : LROWS;
#define normg (AIN(6) + (size_t)layer * 4 * D)
        for (int rep_ = 0; rep_ < NREP(pb + 1); ++rep_) if (IN(pb + 1)) { if (rep_) { FORCE_BAR; } PH_BEGIN
            gp::SchedInprojA S{(const char*)Hh, (const char*)(ws + WS_WIN) + (size_t)layer * 26 * 256 * 2048, 66, G, bx, layer == 0 ? 32 : 0};
            gp::EpiInprojA E{INP, Tt, (unsigned char*)(ws + WS_GCTX)};
            gp::gemm_phase(lds, tid, 1024, 1024, 1024, S, E);
        }
        SEAM(pb + 1);
        for (int rep_ = 0; rep_ < NREP(pb + 2); ++rep_) if (IN(pb + 2)) { if (rep_) { FORCE_BAR; } PH_BEGIN
            LAS float* rpb = (LAS float*)(lds + 98304 + 4096);
            LAS unsigned char* wl = lds + wave * 12288;
            for (int i = tid; i < 1860; i += NTHREADS) rpb[i] = AIN(20)[layer * 1860 + i] * LOG2E;
            __syncthreads();
            const int nitA = 2224 + 64 + (layer == 0 ? 64 : 0);
            for (int it = wslot; it < nitA; it += NW) {
                if (it < 1056) s5_state_item((const bf16*)(ws + WS_S5M1) + (size_t)layer * 16 * 2 * 128 * 256, INP + (size_t)R * 256, (float*)(ws + WS_HLOC), it, lane);
                else if (it < 1584) ret_kv_item(Tt, Tt + (size_t)256 * R, (const float*)(ws + WS_COST), (const float*)(ws + WS_SINT), AIN(18) + layer * 8, (float*)(ws + WS_KV), it - 1056, lane);
                else if (it < 2096) fft1_item(INP, (const bf16*)(ws + WS_W128T), (const float*)(ws + WS_TWC), (const float*)(ws + WS_TWS), (bf16*)(ws + WS_FB), it - 1584, lane);
                else if (it < 2224) rope_item(INP + (size_t)2 * R * 256, INP + (size_t)3 * R * 256, (const float*)(ws + WS_COSN), (const float*)(ws + WS_SINN), it - 2096, lane);
                else if (it < 2288) { const int j = 1984 + (it - 2224); na_item(INP + (size_t)5 * R * 256, INP + (size_t)6 * R * 256, Tt + (size_t)512 * R, MIX, rpb, wl, false, j >> 10, (j >> 3) & 127, (j >> 1) & 3, j & 1, lane); }
                else { const int j = it - 2288; na_item(INP + (size_t)5 * R * 256, INP + (size_t)6 * R * 256, Tt + (size_t)512 * R, MIX, rpb, wl, true, j >> 5, 0, (j >> 3) & 3, j & 7, lane); }
            }
            __syncthreads();
        }
        SEAM(pb + 2);
        for (int rep_ = 0; rep_ < NREP(pb + 3); ++rep_) if (IN(pb + 3)) { if (rep_) { FORCE_BAR; } PH_BEGIN
            LAS float* rpb = (LAS float*)(lds + 98304 + 4096); LAS unsigned char* wl = lds + wave * 12288;
            for (int i = tid; i < 1860; i += NTHREADS) rpb[i] = AIN(20)[layer * 1860 + i] * LOG2E;
            __syncthreads();
            for (int vs = wslot; vs < 2048; vs += NW) {
                if (vs < 64) s5_scan_item((const float*)(ws + WS_A16) + (size_t)layer * 2 * 16 * 64 * 2, (const float*)(ws + WS_HLOC), (bf16*)(ws + WS_HIN), vs, lane);
                else { const int j = vs - 64; na_item(INP + (size_t)5 * R * 256, INP + (size_t)6 * R * 256, Tt + (size_t)512 * R, MIX, rpb, wl, false, j >> 10, (j >> 3) & 127, (j >> 1) & 3, j & 1, lane);
                    if (vs >= 1024) ret_scan_item(AIN(18) + layer * 8, (const float*)(ws + WS_KV), (bf16*)(ws + WS_SPREV), vs - 1024, lane); }
            }
            __syncthreads();
        }
        SEAM(pb + 3);
        for (int rep_ = 0; rep_ < NREP(pb + 4); ++rep_) if (IN(pb + 4)) { if (rep_) { FORCE_BAR; } PH_BEGIN
            const int nit = 1056 + 2112 + 2048 + (layer == 0 ? 128 : 0);
            for (int it = wslot; it < nit; it += NW) {
                if (it < 1056) s5_out_item((const bf16*)(ws + WS_S5TAB) + (size_t)layer * 16 * 256 * 512, INP + (size_t)R * 256, (const bf16*)(ws + WS_HIN), (bf16*)(ws + WS_Z), it, lane);
                else if (it < 3168) ret_out_item(INP + (size_t)2 * R * 256, INP + (size_t)3 * R * 256, INP + (size_t)4 * R * 256, Tt + (size_t)256 * R, (const bf16*)(ws + WS_SPREV),
                                                 AIN(18) + layer * 8, AIN(19) + layer * 256, MIX, lds + wave * 12288, it - 1056, lane);
                else if (it < 5216) fft2_item((const bf16*)(ws + WS_FB), (const bf16*)(ws + WS_FCT), (const bf16*)(ws + WS_W64T), MIX, it - 3168, lane);
                else fftc_item(INP, (const bf16*)(ws + WS_FCT), (const bf16*)(ws + WS_W256T), MIX, it - 5216, lane);
            }
        }
        SEAM(pb + 4);
        for (int rep_ = 0; rep_ < NREP(pb + 5); ++rep_) if (IN(pb + 5)) { if (rep_) { FORCE_BAR; } PH_BEGIN
            { PH_BEGIN gp::SchedPlain S{(const char*)(ws + WS_Z), (const char*)(ws + WS_WGLU) + (size_t)layer * 256 * 512, (size_t)256 * 512, (size_t)256 * 512, nM, 1, G, bx};
              gp::EpiGlu E{(const bf16*)(ws + WS_Z), MIX, AIN(17) + layer * 256};
              gp::gemm_phase(lds, tid, 256, 256, 256, S, E); }
            { PH_BEGIN gp::SchedPlain S{(const char*)Hh, (const char*)(ws + WS_WIN) + ((size_t)layer * 26 + 7) * 256 * 2048, (size_t)256 * 2048, (size_t)256 * 2048, 64, 16, G, bx};
              gp::EpiGates E{(unsigned char*)(ws + WS_GATES)};
              gp::gemm_phase(lds, tid, 1024, 1024, 1024, S, E); }
        }
        SEAM(pb + 5);
        for (int rep_ = 0; rep_ < NREP(pb + 6); ++rep_) if (IN(pb + 6)) { if (rep_) { FORCE_BAR; } PH_BEGIN
            gp::SchedMerge S{(const char*)MIX, (const char*)(ws + WS_WBR) + (size_t)layer * 4 * 1024 * 512, nM, G, bx};
            gp::EpiMerge E{(const unsigned char*)(ws + WS_GATES), (const unsigned char*)(ws + WS_GCTX), (bf16*)(ws + WS_Y)};
            gp::gemm_phase(lds, tid, 256, 1024, 256, S, E);
        }
        SEAM(pb + 6);
        for (int rep_ = 0; rep_ < NREP(pb + 7); ++rep_) if (IN(pb + 7)) { if (rep_) { FORCE_BAR; } PH_BEGIN
            gp::SchedPlain S{(const char*)(ws + WS_Y), (const char*)(ws + WS_WOUT) + (size_t)layer * 1024 * 2048, (size_t)256 * 2048, (size_t)256 * 2048, nM, 4, G, bx};
            gp::EpiPlain E{(bf16*)(ws + WS_YO), 1024};
            gp::gemm_phase(lds, tid, 1024, 1024, 1024, S, E);
        }
        SEAM(pb + 7);
        for (int rep_ = 0; rep_ < NREP(pb + 8); ++rep_) if (IN(pb + 8)) { if (rep_) { FORCE_BAR; } PH_BEGIN
            if (layer == 0) {
                for (int r = wslot; r < R; r += NW) { const int ci = r < SEQ ? 0 : (r < LROWS ? 1 : 2); const float* md = MODp + (size_t)ci * 6144;
                    f32x4 x[4], t[4], hh[4]; row_ld_f32(r < LROWS ? AIN(0) + (size_t)r * D : AIN(2) + (size_t)(r - LROWS) * D, lane, x);
                    row_ld_bf16((const bf16*)(ws + WS_YO) + (size_t)r * D, lane, t);
                    row_resid(x, t, normg + D, md + 2048, lane);
                    row_st_f32(r < LROWS ? AOUT + (size_t)r * D : ctxbuf + (size_t)(r - LROWS) * D, lane, x);
                    row_modnorm(x, normg + 2 * D, md + 4096, md + 3072, lane, hh); row_st_bf16(Hh + (size_t)r * D, lane, hh); }
            } else {
                LAS float* wrs = (LAS float*)lds; LAS int* rowinfo = (LAS int*)(lds + 32768); LAS unsigned* cntL = (LAS unsigned*)(lds + 32768 + 1024); LAS unsigned* baseL = cntL + 8;
                for (int i = tid; i < 2048; i += NTHREADS) ((LAS f32x4*)wrs)[i] = ((const f32x4*)AIN(26))[i];
                int* list = (int*)(ws + WS_LIST); float* routew = (float*)(ws + WS_ROUTEW);
                for (int grp = vcu; grp < 256; grp += G) {
                    if (tid < 8) cntL[tid] = 0u;
                    __syncthreads();
                    for (int rr = 0; rr < 8; ++rr) { const int r = grp * 64 + wave * 8 + rr; const float* md = MODp + (size_t)(3 + (r < SEQ ? 0 : 1)) * 6144;
                        f32x4 x[4], t[4], hh[4]; row_ld_f32(AOUT + (size_t)r * D, lane, x); row_ld_bf16((const bf16*)(ws + WS_YO) + (size_t)r * D, lane, t);
                        row_resid(x, t, normg + D, md + 2048, lane); row_st_f32(AOUT + (size_t)r * D, lane, x);
                        row_modnorm(x, normg + 2 * D, md + 4096, md + 3072, lane, hh); row_st_bf16(Hh + (size_t)r * D, lane, hh);
                        float lg[8];
#pragma unroll
                        for (int e = 0; e < 8; ++e) lg[e] = 0.f;
#pragma unroll
                        for (int j = 0; j < 4; ++j)
#pragma unroll
                            for (int q = 0; q < 4; ++q) { const int k = 256 * j + 4 * lane + q; const f32x4 w0 = *(const LAS f32x4*)(wrs + k * 8), w1 = *(const LAS f32x4*)(wrs + k * 8 + 4); const float hv = hh[j][q];
                                lg[0] += hv * w0[0]; lg[1] += hv * w0[1]; lg[2] += hv * w0[2]; lg[3] += hv * w0[3]; lg[4] += hv * w1[0]; lg[5] += hv * w1[1]; lg[6] += hv * w1[2]; lg[7] += hv * w1[3]; }
#pragma unroll
                        for (int e = 0; e < 8; ++e) lg[e] = wave_sum(lg[e]) + AIN(27)[e];
                        int i0 = 0; float v0 = lg[0];
#pragma unroll
                        for (int e = 1; e < 8; ++e) if (lg[e] > v0) { v0 = lg[e]; i0 = e; }
                        int i1 = i0 == 0 ? 1 : 0; float v1 = i0 == 0 ? lg[1] : lg[0];
#pragma unroll
                        for (int e = 0; e < 8; ++e) if (e != i0 && lg[e] > v1) { v1 = lg[e]; i1 = e; }
                        const float w0 = 1.f / (1.f + __expf(v1 - v0)), w1 = 1.f - w0;
                        if (lane == 0) { const unsigned s0 = __hip_atomic_fetch_add(cntL + i0, 1u, __ATOMIC_RELAXED, __HIP_MEMORY_SCOPE_WORKGROUP), s1 = __hip_atomic_fetch_add(cntL + i1, 1u, __ATOMIC_RELAXED, __HIP_MEMORY_SCOPE_WORKGROUP);
                            LAS int* ri = rowinfo + (wave * 8 + rr) * 4; ri[0] = i0; ri[1] = (int)s0; ri[2] = i1; ri[3] = (int)s1; routew[(size_t)r * 2] = w0; routew[(size_t)r * 2 + 1] = w1; }
                    }
                    __syncthreads();
                    if (tid < 8) baseL[tid] = __hip_atomic_fetch_add((unsigned*)(ws + WS_CTL) + CW_MOECNT + 64 * tid, cntL[tid], __ATOMIC_RELAXED, __HIP_MEMORY_SCOPE_AGENT);
                    __syncthreads();
                    if (tid < 64) { const LAS int* ri = rowinfo + tid * 4; const int r = grp * 64 + tid;
                        list[ri[0] * LCAP + (int)baseL[ri[0]] + ri[1]] = r * 2; list[ri[2] * LCAP + (int)baseL[ri[2]] + ri[3]] = r * 2 + 1; }
                    __syncthreads();
                }
            }
        }
        SEAM(pb + 8);
        LAS unsigned* mt = (LAS unsigned*)(lds + LDSCTL_OFF) + LW_MOE;
        if (layer == 1 && (IN(pb + 9) || IN(pb + 10))) { PH_BEGIN
            if (tid == 0) { unsigned off = 0u;
                for (int e = 0; e < 8; ++e) { const unsigned c = __hip_atomic_load((unsigned*)(ws + WS_CTL) + CW_MOECNT + 64 * e, __ATOMIC_RELAXED, __HIP_MEMORY_SCOPE_AGENT); const unsigned m = (c + 255u) >> 8; mt[e] = c; mt[8 + e] = m; mt[16 + e] = off; off += m; }
                mt[24] = off; }
            __syncthreads();
        }
        for (int rep_ = 0; rep_ < NREP(pb + 9); ++rep_) if (IN(pb + 9)) { if (rep_) { FORCE_BAR; } PH_BEGIN
            if (layer == 0) {
                gp::SchedPlain S{(const char*)Hh, (const char*)(ws + WS_FFN1), (size_t)256 * 2048, (size_t)256 * 2048, 66, 22, G, bx};
                gp::EpiSwiglu E{(bf16*)(ws + WS_HID), DFF, false};
                gp::gemm_phase(lds, tid, 1024, 1024, 1024, S, E);
            } else {
                gp::SchedMoe1 S{(const char*)Hh, (const char*)(ws + WS_MOE1), (const int*)(ws + WS_LIST), mt, G, bx};
                gp::EpiSwiglu E{(bf16*)(ws + WS_MHID), DFE, true};
                gp::gemm_phase(lds, tid, 1024, 1024, 1024, S, E);
            }
        }
        SEAM(pb + 9);
        for (int rep_ = 0; rep_ < NREP(pb + 10); ++rep_) if (IN(pb + 10)) { if (rep_) { FORCE_BAR; } PH_BEGIN
            if (layer == 0) {
                gp::SchedPlain S{(const char*)(ws + WS_HID), (const char*)(ws + WS_FFN2), (size_t)256 * DFF * 2, (size_t)256 * DFF * 2, 66, 4, G, bx};
                gp::EpiPlain E{(bf16*)(ws + WS_FO), 1024};
                gp::gemm_phase(lds, tid, DFF, DFF, DFF, S, E);
            } else {
                gp::SchedMoe2 S{(const char*)(ws + WS_MHID), (const char*)(ws + WS_MOE2), mt, G, bx};
                gp::EpiMoeDown E{(bf16*)(ws + WS_SLOT), (const int*)(ws + WS_LIST), (const float*)(ws + WS_ROUTEW), mt};
                gp::gemm_phase(lds, tid, DFE, DFE, DFE, S, E);
            }
        }
        SEAM(pb + 10);
        for (int rep_ = 0; rep_ < NREP(pb + 11); ++rep_) if (IN(pb + 11)) { if (rep_) { FORCE_BAR; } PH_BEGIN
            for (int r = wslot; r < nrows; r += NW) { const int ci = r < SEQ ? 0 : (r < LROWS ? 1 : 2); const float* md = MODp + (size_t)(layer * 3 + ci) * 6144;
                float* xp = r < LROWS ? AOUT + (size_t)r * D : ctxbuf + (size_t)(r - LROWS) * D;
                f32x4 x[4], t[4]; row_ld_f32(xp, lane, x);
                if (layer == 0) row_ld_bf16((const bf16*)(ws + WS_FO) + (size_t)r * D, lane, t);
                else { f32x4 t2[4]; row_ld_bf16((const bf16*)(ws + WS_SLOT) + (size_t)r * D, lane, t); row_ld_bf16((const bf16*)(ws + WS_SLOT) + ((size_t)LROWS + r) * D, lane, t2);
#pragma unroll
                    for (int j = 0; j < 4; ++j) t[j] = t[j] + t2[j]; }
                row_resid(x, t, normg + 3 * D, md + 5120, lane); row_st_f32(xp, lane, x);
                if (layer == 0) { f32x4 hh[4]; const float* md1 = MODp + (size_t)(3 + ci) * 6144; row_modnorm(x, AIN(6) + 4 * D, md1 + 1024, md1, lane, hh); row_st_bf16(Hh + (size_t)r * D, lane, hh); } }
        }
        SEAM(pb + 11);
    }
#ifdef MK_STAMP_PHASE
    if (MK_STAMP_PHASE == NPHASE - 1 && wave == 0) *(volatile LAS unsigned long long*)(lctl + 66) = __builtin_amdgcn_s_memrealtime();
    if (blockIdx.x == 0 && wave == 0) { const unsigned long long st0_ = *(volatile LAS unsigned long long*)(lctl + 64), st1_ = *(volatile LAS unsigned long long*)(lctl + 66); const unsigned long long target = __builtin_amdgcn_s_memrealtime() + (unsigned long long)MK_STAMP_AMP * (st1_ - st0_); while (__builtin_amdgcn_s_memrealtime() < target) __builtin_amdgcn_s_sleep(20); }
#endif
#ifdef MK_EXTRA_BARS
    for (int xb_ = 0; xb_ < MK_EXTRA_BARS; ++xb_) { FORCE_BAR; }
#endif
#undef IN
#undef SEAM
#undef PH_BEGIN
#undef normg
#undef AIN
#undef AOUT
#undef MODp
#undef ctxbuf
#undef Hh
#undef MIX
#undef INP
#undef Tt
}

__global__ void dumpk(const unsigned char* src, size_t nbytes, int isf32, float* out, size_t N, int accum) {
    const size_t i = (size_t)blockIdx.x * blockDim.x + threadIdx.x; if (i >= N) return;
    const size_t ne = isf32 ? nbytes / 4 : nbytes / 2; float s = 0.f;
    for (size_t k = i; k < ne; k += N) s += isf32 ? ((const float*)src)[k] : bf2f(((const bf16*)src)[k]);
    out[i] = accum ? out[i] + s : s;
}
extern "C" void kernel_launch(void* const* d_in, const int* in_sizes, int n_in, void* d_out, int out_size, void* d_ws, size_t ws_size, hipStream_t stream) {
    static int grid = 0;
    if (grid == 0) {
        if (n_in != 31 || out_size != LROWS * D || ws_size < WS_END) { fprintf(stderr, "kernel_launch: unexpected shapes (n_in %d, out %d, ws %zu < %zu)\n", n_in, out_size, ws_size, (size_t)WS_END); grid = -1; return; }
        int dev = 0, cus = 0, per_cu = 0;
        if (hipGetDevice(&dev) != hipSuccess || hipDeviceGetAttribute(&cus, hipDeviceAttributeMultiprocessorCount, dev) != hipSuccess) { grid = -1; return; }
        if (hipFuncSetAttribute((const void*)mk_fwd, hipFuncAttributeMaxDynamicSharedMemorySize, LDS_BYTES) != hipSuccess) { fprintf(stderr, "kernel_launch: hipFuncSetAttribute failed\n"); grid = -1; return; }
        if (hipOccupancyMaxActiveBlocksPerMultiprocessor(&per_cu, (const void*)mk_fwd, NTHREADS, LDS_BYTES) != hipSuccess || per_cu < 1) { fprintf(stderr, "kernel_launch: occupancy query says %d\n", per_cu); }
        (void)hipGetLastError();
        grid = cus;
    }
    if (grid < 0) return;
    (void)hipMemsetAsync((char*)d_ws + WS_CTL, 0, CTL_ZERO_BYTES, stream);
    Args a{};
    for (int i = 0; i < 31; ++i) a.in[i] = (const float*)d_in[i];
    a.out = (float*)d_out; a.ws = (unsigned char*)d_ws;
#if MK_MODE == 1
    a.ph_lo = 0; a.ph_hi = NPHASE; a.li = 0;
    hipLaunchKernelGGL(mk_fwd, dim3(grid), dim3(NTHREADS), LDS_BYTES, stream, a);
#else
    for (int p = 0; p < MK_LAST; ++p) { a.ph_lo = p; a.ph_hi = p + 1; a.li = p; hipLaunchKernelGGL(mk_fwd, dim3(grid), dim3(NTHREADS), LDS_BYTES, stream, a); }
#endif
#ifdef MK_DUMP_OFF
    dumpk<<<(LROWS * D + 255) / 256, 256, 0, stream>>>((const unsigned char*)d_ws + (size_t)(MK_DUMP_OFF), (size_t)(MK_DUMP_BYTES), MK_DUMP_F32, (float*)d_out, (size_t)LROWS * D, 0);
#endif
#ifdef MK_DUMP2_OFF
    dumpk<<<(LROWS * D + 255) / 256, 256, 0, stream>>>((const unsigned char*)d_ws + (size_t)(MK_DUMP2_OFF), (size_t)(MK_DUMP2_BYTES), MK_DUMP2_F32, (float*)d_out, (size_t)LROWS * D, 1);
#endif
#ifdef MK_DUMP3_OFF
    dumpk<<<(LROWS * D + 255) / 256, 256, 0, stream>>>((const unsigned char*)d_ws + (size_t)(MK_DUMP3_OFF), (size_t)(MK_DUMP3_BYTES), MK_DUMP3_F32, (float*)d_out, (size_t)LROWS * D, 1);
#endif
}
```

```cpp
#define MK_MODE 1
#include <hip/hip_runtime.h>
#include <cstdio>
#include <cstdint>

#define GAS __attribute__((address_space(1)))
#define LAS __attribute__((address_space(3)))
typedef unsigned short bf16;
typedef short bf16x8 __attribute__((ext_vector_type(8)));
typedef short bf16x4 __attribute__((ext_vector_type(4)));
typedef float f32x2 __attribute__((ext_vector_type(2)));
typedef float f32x4 __attribute__((ext_vector_type(4)));
typedef float f32x16 __attribute__((ext_vector_type(16)));
typedef unsigned u32x2 __attribute__((ext_vector_type(2)));
typedef unsigned u32x4 __attribute__((ext_vector_type(4)));

constexpr int D = 1024, SEQ = 8192, LROWS = 16384, CTXL = 256, CROWS = 512, R = 16896;
constexpr int DFF = 2816, DFE = 3584, NEXP = 8, LCAP = 16640;
constexpr int NWAVES = 8, NTHREADS = 512;
constexpr int NCH16 = R / 16;
constexpr float EPSN = 1e-6f, LOG2E = 1.4426950408889634f;

constexpr size_t MiB = 1u << 20;
constexpr size_t WS_CTL = 0, CTL_ZERO_BYTES = 1 * MiB;
constexpr int CW_TMO = 0, CW_BAR = 4096, CW_MOECNT = 98304, CW_QHEAD = 100352;
constexpr size_t CTL_MOD_OFF = 512 * 1024;
constexpr size_t WS_CTXBUF = 1 * MiB;
constexpr size_t WS_COST = 3 * MiB, WS_SINT = 4 * MiB, WS_COSN = 5 * MiB, WS_SINN = 6 * MiB;
constexpr size_t WS_LIST = 7 * MiB;
constexpr size_t WS_ROUTEW = WS_LIST + 8 * LCAP * 4;
constexpr size_t WS_S5K = 8 * MiB;
constexpr size_t WS_A16 = 9 * MiB;
constexpr size_t WS_W128T = WS_A16 + 64 * 1024;
constexpr size_t WS_TWC = WS_W128T + 64 * 1024, WS_TWS = WS_TWC + 32 * 1024;
constexpr size_t WS_FCT = WS_TWS + 32 * 1024;
constexpr size_t WS_W64T = WS_FCT + 32 * 1024;
constexpr size_t WS_W256T = WS_W64T + 32 * 1024;
constexpr size_t WS_MOE1 = 10 * MiB;
constexpr size_t WS_MOE2 = 122 * MiB;
constexpr size_t WS_OTHERW = 178 * MiB;
constexpr size_t WS_WIN = 178 * MiB;
constexpr size_t WS_WBR = 204 * MiB;
constexpr size_t WS_WOUT = 208 * MiB;
constexpr size_t WS_WGLU = 212 * MiB;
constexpr size_t WS_FFN1 = 213 * MiB;
constexpr size_t WS_FFN2 = 224 * MiB;
constexpr size_t WS_S5M1 = 230 * MiB;
constexpr size_t WS_S5TAB = 234 * MiB;
constexpr size_t WS_BIG = 242 * MiB;
constexpr size_t TOK256 = (size_t)R * 256 * 2;
constexpr size_t WS_INP = WS_BIG;
constexpr size_t WS_T = WS_INP + 7 * TOK256;
constexpr size_t WS_HLOC = WS_T + 3 * TOK256;
constexpr size_t WS_HIN = WS_HLOC + 2 * TOK256;
constexpr size_t WS_KV = WS_HIN + TOK256;
constexpr size_t WS_SPREV = WS_KV + 2 * TOK256;
constexpr size_t WS_FB = WS_SPREV + TOK256;
constexpr size_t WS_GATES = WS_BIG;
constexpr size_t WS_Y = WS_BIG + 132 * MiB;
constexpr size_t WS_YO = WS_Y + 33 * MiB;
constexpr size_t WS_Z = WS_YO + 33 * MiB;
constexpr size_t WS_YP = WS_Z;
constexpr size_t WS_PARTW = WS_BIG;
constexpr size_t WS_PARTF = 340 * MiB;
constexpr size_t WS_FO = WS_Y;
constexpr size_t WS_HID = WS_BIG;
constexpr size_t WS_MHID = WS_OTHERW;
constexpr size_t WS_H = 449 * MiB;
constexpr size_t WS_MIX = 482 * MiB;
constexpr size_t WS_SLOT = WS_H;
constexpr size_t WS_GCTX = 515 * MiB;
constexpr size_t WS_END = 519 * MiB;
static_assert(WS_FB + 16 * MiB <= WS_Z && WS_Z + TOK256 <= WS_H && WS_MHID + (size_t)34816 * 3584 * 2 <= WS_H && WS_W256T + 256 * 1024 <= WS_MOE1, "ws map");
static_assert(WS_S5TAB + 8 * MiB <= WS_BIG && WS_FFN2 + (size_t)1024 * 2816 * 2 <= WS_S5M1 && WS_ROUTEW + 32768 * 4 <= WS_S5K, "ws map 2");

constexpr int RING_BYTES = 131072, LDSCTL_OFF = RING_BYTES, LDS_BYTES = 147456;
constexpr int LW_BAR = 8, LW_MOE = 16;

#define VM_WAIT() asm volatile("s_waitcnt vmcnt(0)" ::: "memory")
#define LDS_WAIT() asm volatile("s_waitcnt lgkmcnt(0)" ::: "memory")
typedef __bf16 bf16n2 __attribute__((ext_vector_type(2)));
__device__ __forceinline__ unsigned pk2(float lo, float hi) { bf16n2 v; v.x = (__bf16)lo; v.y = (__bf16)hi; return __builtin_bit_cast(unsigned, v); }
__device__ __forceinline__ float bf2f(unsigned short b) { return __builtin_bit_cast(float, ((unsigned)b) << 16); }
__device__ __forceinline__ float bflo(unsigned w) { return __builtin_bit_cast(float, w << 16); }
__device__ __forceinline__ float bfhi(unsigned w) { return __builtin_bit_cast(float, w & 0xffff0000u); }
__device__ __forceinline__ float ex2(float x) { return __builtin_amdgcn_exp2f(x); }
__device__ __forceinline__ float rcpf_(float x) { return __builtin_amdgcn_rcpf(x); }
__device__ __forceinline__ float sigm(float x) { return rcpf_(1.f + ex2(-LOG2E * x)); }
__device__ __forceinline__ float silu_(float x) { return x * sigm(x); }
__device__ __forceinline__ float gelu_tanh(float x) { const float u = 0.7978845608028654f * (x + 0.044715f * x * x * x); const float t = 1.f - 2.f * rcpf_(1.f + ex2(2.885390081777927f * u)); return 0.5f * x * (1.f + t); }
__device__ __forceinline__ float xor32_sum(float v) { const unsigned u = __builtin_bit_cast(unsigned, v); const auto r = __builtin_amdgcn_permlane32_swap(u, u, false, false); return __builtin_bit_cast(float, (unsigned)r[0]) + __builtin_bit_cast(float, (unsigned)r[1]); }
__device__ __forceinline__ float xor32_max(float v) { const unsigned u = __builtin_bit_cast(unsigned, v); const auto r = __builtin_amdgcn_permlane32_swap(u, u, false, false); return fmaxf(__builtin_bit_cast(float, (unsigned)r[0]), __builtin_bit_cast(float, (unsigned)r[1])); }
template <int X> __device__ __forceinline__ float swz_xor(float v) { return __builtin_bit_cast(float, __builtin_amdgcn_ds_swizzle(__builtin_bit_cast(int, v), (X << 10) | 0x1f)); }
__device__ __forceinline__ float wave_sum(float v) { v += swz_xor<1>(v); v += swz_xor<2>(v); v += swz_xor<4>(v); v += swz_xor<8>(v); v += swz_xor<16>(v); return xor32_sum(v); }
__device__ __forceinline__ f32x16 mma32(bf16x8 a, bf16x8 b, f32x16 c) { return __builtin_amdgcn_mfma_f32_32x32x16_bf16(a, b, c, 0, 0, 0); }
__device__ __forceinline__ bf16x8 ldg8(const bf16* p) { return *(const bf16x8*)p; }
__device__ __forceinline__ bf16x8 ldg8p(const bf16* p) { const bf16x4 lo = *(const bf16x4*)p, hi = *(const bf16x4*)(p + 8); return __builtin_shufflevector(lo, hi, 0, 1, 2, 3, 4, 5, 6, 7); }
template <int S> __device__ __forceinline__ bf16x8 accB(const f32x16& c) {
    u32x4 w; w.x = pk2(c[8 * S + 0], c[8 * S + 1]); w.y = pk2(c[8 * S + 2], c[8 * S + 3]); w.z = pk2(c[8 * S + 4], c[8 * S + 5]); w.w = pk2(c[8 * S + 6], c[8 * S + 7]);
    return __builtin_bit_cast(bf16x8, w);
}
__device__ __forceinline__ bf16x8 pack8(const float (&v)[8]) { u32x4 w; w.x = pk2(v[0], v[1]); w.y = pk2(v[2], v[3]); w.z = pk2(v[4], v[5]); w.w = pk2(v[6], v[7]); return __builtin_bit_cast(bf16x8, w); }
__device__ __forceinline__ void unpack8(const bf16x8 x, float (&v)[8]) { const u32x4 w = __builtin_bit_cast(u32x4, x); v[0] = bflo(w.x); v[1] = bfhi(w.x); v[2] = bflo(w.y); v[3] = bfhi(w.y); v[4] = bflo(w.z); v[5] = bfhi(w.z); v[6] = bflo(w.w); v[7] = bfhi(w.w); }
__device__ __forceinline__ f32x16 zero16() { f32x16 z;
#pragma unroll
    for (int i = 0; i < 16; ++i) z[i] = 0.f;
    return z; }

#define XB_TMO      128
#define XB_XCNT(j)  (256  + 64 * (j))
#define XB_XSUB(j)  (1280 + 64 * (j))
#define XB_XGEN(j)  (2304 + 64 * (j))
#define XB_TOP      3328
#define XB_TOPGEN   3392
#define XCD_BAR_WORDS 3456
#define XB_SPIN_CAP (1u << 18)
__device__ __forceinline__ unsigned xb_ld(unsigned* p)              { return __hip_atomic_load(p, __ATOMIC_RELAXED, __HIP_MEMORY_SCOPE_AGENT); }
__device__ __forceinline__ unsigned xb_add(unsigned* p, unsigned v) { return __hip_atomic_fetch_add(p, v, __ATOMIC_RELAXED, __HIP_MEMORY_SCOPE_AGENT); }
__device__ __forceinline__ unsigned xb_xcc_id() { return (unsigned)__builtin_amdgcn_s_getreg((3 << 11) | 20) & 0xFu; }
#define XB_SPIN(cond, bar) do { unsigned _sp = 0; while (cond) { __builtin_amdgcn_s_sleep(1); \
    if ((++_sp & 255u) == 0u) { if (xb_ld(&(bar)[XB_TMO])) break; if (_sp > XB_SPIN_CAP) { atomicAdd(&(bar)[XB_TMO], 1u); break; } } } } while (0)
struct XcdBarrier { unsigned* bar; unsigned x; volatile LAS unsigned* st; };
__device__ __forceinline__ XcdBarrier xcd_barrier_post(unsigned* bar, volatile LAS unsigned* st) {
    XcdBarrier b; b.bar = bar; b.x = xb_xcc_id(); b.st = st;
    if (threadIdx.x == 0) (void)xb_add(&bar[XB_XCNT(b.x)], 1u);
    return b;
}
__device__ __forceinline__ void xcd_barrier_complete(unsigned* bar, unsigned x, unsigned& nloc, unsigned& nx) {
    const unsigned G = gridDim.x * gridDim.y * gridDim.z;
    unsigned sum, cnt, mine, sp = 0u;
    for (;;) {
        sum = 0u; cnt = 0u; mine = 0u;
#pragma unroll
        for (unsigned j = 0; j < 16; ++j) { const unsigned c = xb_ld(&bar[XB_XCNT(j)]); sum += c; cnt += (c > 0u) ? 1u : 0u; mine = (j == x) ? c : mine; }
        if (sum == G) break;
        __builtin_amdgcn_s_sleep(1);
        if ((++sp & 255u) == 0u) { if (xb_ld(&bar[XB_TMO])) break; if (sp > XB_SPIN_CAP) { atomicAdd(&bar[XB_TMO], 1u); break; } }
    }
    nloc = mine > 0u ? mine : 1u; nx = cnt > 0u ? cnt : 1u;
}
__device__ __forceinline__ void xcd_barrier(const XcdBarrier& b) {
    asm volatile("s_waitcnt vmcnt(0)" ::: "memory");
    __syncthreads();
    if (threadIdx.x == 0) {
        unsigned* bar = b.bar;
        __builtin_amdgcn_s_waitcnt(0);
        unsigned nloc = b.st[0], nx = b.st[1];
        if (nloc == 0u) { xcd_barrier_complete(bar, b.x, nloc, nx); b.st[0] = nloc; b.st[1] = nx; }
        const unsigned old = xb_add(&bar[XB_XSUB(b.x)], 1u);
        const unsigned gen = old / nloc;
        if (old + 1u == (gen + 1u) * nloc) {
            __builtin_amdgcn_fence(__ATOMIC_RELEASE, "agent");
            asm volatile("s_waitcnt vmcnt(0)" ::: "memory");
            const unsigned og = xb_add(&bar[XB_TOP], 1u);
            const unsigned tg = og / nx;
            if (og + 1u == (tg + 1u) * nx) xb_add(&bar[XB_TOPGEN], 1u);
            else XB_SPIN(xb_ld(&bar[XB_TOPGEN]) == tg, bar);
            __builtin_amdgcn_fence(__ATOMIC_ACQUIRE, "agent");
            xb_add(&bar[XB_XGEN(b.x)], 1u);
            asm volatile("s_waitcnt vmcnt(0)" ::: "memory");
        } else {
            XB_SPIN(xb_ld(&bar[XB_XGEN(b.x)]) == gen, bar);
            __builtin_amdgcn_fence(__ATOMIC_ACQUIRE, "agent");
            asm volatile("s_waitcnt vmcnt(0)" ::: "memory");
        }
    }
    __syncthreads();
}
namespace gp {
constexpr int BM = 256, BK = 64, HALF = 128, HTB = HALF * BK * 2, STAGE_BYTES = 8 * HTB, NXCD = 8, WGM = 8;
__device__ __forceinline__ int lds_byte(int r, int c) { const int st = (r >> 4) * 2 + (c >> 5), rr = r & 15, cc = c & 31, ob = rr * 64 + cc * 2; return st * 1024 + (ob ^ (((ob >> 9) & 1) << 5)); }
__device__ __forceinline__ void stage_rc(int b, int& Rr, int& C) { const int st = b / 1024, sb = b % 1024, swz = sb ^ (((sb >> 9) & 1) << 5); Rr = (st >> 1) * 16 + swz / 64; C = (st & 1) * 32 + (swz % 64) / 2; }
__device__ __forceinline__ int perm32(int rho) { const int n = rho >> 4, i = rho & 15; return 8 * (i >> 2) + 4 * n + (i & 3); }

struct Unit { const char* a; const char* b; int e0, e1, e2, e3, nt; };

__device__ __forceinline__ void tile_of(int L, int nM, int nN, int& pm, int& pn) {
    const int nwg = nM * nN; int wgid = L;
    { const int q = nwg / NXCD, r = nwg % NXCD, xcd = wgid % NXCD, off = wgid / NXCD; wgid = (xcd < r ? xcd * (q + 1) : r * (q + 1) + (xcd - r) * q) + off; }
    const int nig = WGM * nN, gid = wgid / nig, fm = gid * WGM, gsz = (nM - fm) < WGM ? (nM - fm) : WGM;
    pm = fm + ((wgid % nig) % gsz); pn = (wgid % nig) / gsz;
}

template <class Epi, class Sched>
__device__ __forceinline__ void gemm_phase(LAS unsigned char* lds, const int tid, const int K, const int lda, const int ldb, const Sched& S, const Epi& E) {
    constexpr bool GATHER = Sched::GATHER;
    const int wid = __builtin_amdgcn_readfirstlane(tid >> 6), lane = tid & 63, wr = wid >> 2, wc = wid & 3, fr = lane & 15, fq = lane >> 4;
    unsigned voffA[2], voffB[2], cb2[2]; int rowA[2];
#pragma unroll
    for (int i = 0; i < 2; ++i) { int Rr, C; stage_rc(tid * 16 + i * 8192, Rr, C); const int Rb = (Rr & ~31) + perm32(Rr & 31);
        rowA[i] = Rr; cb2[i] = (unsigned)C * 2u; voffA[i] = (unsigned)(Rr * lda + C) * 2u; voffB[i] = (unsigned)(Rb * ldb + C) * 2u; }
    const size_t kstep = (size_t)(BK * 2);
    const unsigned hstepA = (unsigned)HALF * (unsigned)lda * 2u; const size_t hstepB = (size_t)HALF * ldb * 2;
    const unsigned ldsw = (unsigned)wid * 1024u;
    const int aoff = lds_byte(wr * 64 + fr, fq * 8), boff = lds_byte(wc * 32 + fr, fq * 8);
#define PG8_SA(b, h) (((b) * 2 + (h)) * HTB)
#define PG8_SB(b, h) ((4 + (b) * 2 + (h)) * HTB)
#define PG8_STB(bufoff, gbase, hh) do { _Pragma("unroll") for (int _i = 0; _i < 2; ++_i) \
        __builtin_amdgcn_global_load_lds((const unsigned*)((const char*)(gbase) + (size_t)(hh) * hstepB + voffB[_i]), (LAS unsigned*)(lds + (bufoff) + ldsw + _i * 8192), 16, 0, 0); } while (0)
#define PG8_STA(bufoff, gbase, hh, VG) do { _Pragma("unroll") for (int _i = 0; _i < 2; ++_i) { const unsigned _o = GATHER ? (VG)[hh][_i] : (voffA[_i] + (unsigned)(hh) * hstepA); \
        __builtin_amdgcn_global_load_lds((const unsigned*)((const char*)(gbase) + _o), (LAS unsigned*)(lds + (bufoff) + ldsw + _i * 8192), 16, 0, 0); } } while (0)
#define PG8_LDA(dst, b, h) do { _Pragma("unroll") for (int m = 0; m < 4; ++m) _Pragma("unroll") for (int k = 0; k < 2; ++k) dst[m][k] = *(const LAS bf16x8*)(lds + PG8_SA(b, h) + aoff + m * 2048 + k * 1024); } while (0)
#define PG8_LDB(dst, b, h) do { _Pragma("unroll") for (int n = 0; n < 2; ++n) _Pragma("unroll") for (int k = 0; k < 2; ++k) dst[n][k] = *(const LAS bf16x8*)(lds + PG8_SB(b, h) + boff + n * 2048 + k * 1024); } while (0)
#define PG8_MMA(ai, bj, At, Bt) do { __builtin_amdgcn_s_setprio(1); _Pragma("unroll") for (int m = 0; m < 4; ++m) _Pragma("unroll") for (int n = 0; n < 2; ++n) _Pragma("unroll") for (int k = 0; k < 2; ++k) \
        acc[ai][bj][m][n] = __builtin_amdgcn_mfma_f32_16x16x32_bf16(Bt[n][k], At[m][k], acc[ai][bj][m][n], 0, 0, 0); __builtin_amdgcn_s_setprio(0); } while (0)
#define PG8_WAIT_V(n) asm volatile("s_waitcnt vmcnt(" #n ")" ::: "memory")
#define PG8_WAIT_L(n) asm volatile("s_waitcnt lgkmcnt(" #n ")" ::: "memory")
#define PG8_BAR __builtin_amdgcn_s_barrier()
#define PG8_SCHED __builtin_amdgcn_sched_barrier(0)
    Unit cur, nxt; int ui = 0;
    if (!S.next(0, cur)) return;
    f32x4 acc[2][2][4][2];
#pragma unroll
    for (int a = 0; a < 2; ++a)
#pragma unroll
        for (int b = 0; b < 2; ++b)
#pragma unroll
            for (int m = 0; m < 4; ++m)
#pragma unroll
                for (int n = 0; n < 2; ++n) acc[a][b][m][n] = (f32x4){0.f, 0.f, 0.f, 0.f};
    bf16x8 At[4][2], B0[2][2], B1[2][2];
    unsigned vgc[2][2], vgn[2][2];
#pragma unroll
    for (int h = 0; h < 2; ++h)
#pragma unroll
        for (int i = 0; i < 2; ++i) { vgc[h][i] = GATHER ? S.rowoff(cur, rowA[i] + h * HALF) + cb2[i] : 0u; vgn[h][i] = vgc[h][i]; }
    const char* cA = cur.a; const char* cB = cur.b;
    PG8_STB(PG8_SB(0, 0), cB, 0); PG8_STB(PG8_SB(0, 1), cB, 1); PG8_STA(PG8_SA(0, 0), cA, 0, vgc); PG8_STA(PG8_SA(0, 1), cA, 1, vgc);
    if (wr == 1) PG8_BAR;
    PG8_WAIT_V(2); PG8_BAR;
    PG8_STB(PG8_SB(1, 0), cB + kstep, 0); PG8_STA(PG8_SA(1, 0), cA + kstep, 0, vgc); PG8_STB(PG8_SB(1, 1), cB + kstep, 1);
    PG8_WAIT_V(6); PG8_BAR;
    for (;;) {
        const bool has_next = S.next(ui + 1, nxt);
        const char* nA = has_next ? nxt.a : cA; const char* nB = has_next ? nxt.b : cB;
        int nt = cur.nt; asm volatile("" : "+s"(nt));
#pragma unroll 1
        for (int t = 0; t < nt; t += 2) {
            const bool last = (t == nt - 2);
            const char* a1 = cA + (size_t)(t + 1) * kstep;
            const char* a2 = last ? nA : cA + (size_t)(t + 2) * kstep; const char* b2 = last ? nB : cB + (size_t)(t + 2) * kstep;
            const char* a3 = a2 + kstep; const char* b3 = b2 + kstep;
            unsigned vg2[2][2];
            if constexpr (GATHER) {
                if (last && has_next) {
#pragma unroll
                    for (int h = 0; h < 2; ++h)
#pragma unroll
                        for (int i = 0; i < 2; ++i) vgn[h][i] = S.rowoff(nxt, rowA[i] + h * HALF) + cb2[i];
                }
            }
#pragma unroll
            for (int h = 0; h < 2; ++h)
#pragma unroll
                for (int i = 0; i < 2; ++i) vg2[h][i] = last ? vgn[h][i] : vgc[h][i];
            PG8_LDB(B0, 0, 0); PG8_LDB(B1, 0, 1); PG8_SCHED; PG8_LDA(At, 0, 0); PG8_STA(PG8_SA(1, 1), a1, 1, vgc);
            PG8_WAIT_V(8); PG8_WAIT_L(0); PG8_BAR; PG8_MMA(0, 0, At, B0); PG8_MMA(0, 1, At, B1); PG8_BAR; PG8_SCHED;
            PG8_LDA(At, 0, 1); PG8_STB(PG8_SB(0, 0), b2, 0); PG8_STB(PG8_SB(0, 1), b2, 1); PG8_STA(PG8_SA(0, 0), a2, 0, vg2);
            PG8_WAIT_V(8); PG8_WAIT_L(0); PG8_BAR; PG8_MMA(1, 0, At, B0); PG8_MMA(1, 1, At, B1); PG8_BAR; PG8_SCHED;
            PG8_LDB(B0, 1, 0); PG8_LDB(B1, 1, 1); PG8_SCHED; PG8_LDA(At, 1, 0); PG8_STA(PG8_SA(0, 1), a2, 1, vg2);
            PG8_WAIT_V(8); PG8_WAIT_L(0); PG8_BAR; PG8_MMA(0, 0, At, B0); PG8_MMA(0, 1, At, B1); PG8_BAR; PG8_SCHED;
            PG8_LDA(At, 1, 1); PG8_STB(PG8_SB(1, 0), b3, 0); PG8_STB(PG8_SB(1, 1), b3, 1); PG8_STA(PG8_SA(1, 0), a3, 0, vg2);
            PG8_WAIT_V(8); PG8_WAIT_L(0); PG8_BAR; PG8_MMA(1, 0, At, B0); PG8_MMA(1, 1, At, B1); PG8_BAR; PG8_SCHED;
        }
        if (wr == 0) PG8_BAR;
        if constexpr (Epi::CARRY) { E.carry(acc, cur, wr, wc, fr, fq); if (!has_next) break; }
        else {
        E(acc, cur, wr, wc, fr, fq);
        if (!has_next) break;
#pragma unroll
        for (int a = 0; a < 2; ++a)
#pragma unroll
            for (int b = 0; b < 2; ++b)
#pragma unroll
                for (int m = 0; m < 4; ++m)
#pragma unroll
                    for (int n = 0; n < 2; ++n) acc[a][b][m][n] = (f32x4){0.f, 0.f, 0.f, 0.f};
        }
        cur = nxt; cA = nA; cB = nB; ++ui;
#pragma unroll
        for (int h = 0; h < 2; ++h)
#pragma unroll
            for (int i = 0; i < 2; ++i) vgc[h][i] = vgn[h][i];
        if (wr == 1) PG8_BAR;
    }
    PG8_WAIT_V(0);
    PG8_BAR;
#undef PG8_SA
#undef PG8_SB
#undef PG8_STA
#undef PG8_STB
#undef PG8_LDA
#undef PG8_LDB
#undef PG8_MMA
#undef PG8_WAIT_V
#undef PG8_WAIT_L
#undef PG8_BAR
#undef PG8_SCHED
}

struct SchedPlain {
    static constexpr bool GATHER = false;
    const char* A; const char* B; size_t ta, tb; int nM, nN, G, c, nt;
    __device__ __forceinline__ bool next(int i, Unit& u) const {
        const long L = (long)i * G + c; if (L >= (long)nM * nN) return false;
        int pm, pn; tile_of((int)L, nM, nN, pm, pn); u.a = A + (size_t)pm * ta; u.b = B + (size_t)pn * tb; u.e0 = pm; u.e1 = pn; u.e2 = 0; u.e3 = 0; u.nt = nt; return true; }
    __device__ __forceinline__ unsigned rowoff(const Unit&, int) const { return 0u; }
};
struct SchedInprojA {
    static constexpr bool GATHER = false;
    const char* Hh; const char* W; int nM, G, c, ng;
    __device__ __forceinline__ bool next(int i, Unit& u) const {
        long L = (long)i * G + c; const int n1 = nM * 7, n2 = 3 * nM; if (L >= n1 + n2 + ng) return false;
        int pm, pn;
        if (L < n1) { tile_of((int)L, nM, 7, pm, pn); u.a = Hh + (size_t)pm * (256 * 2048); u.b = W + (size_t)pn * (256 * 2048); u.e2 = 0; }
        else if (L < n1 + n2) { tile_of((int)(L - n1), 3, nM, pm, pn); u.a = W + (size_t)(23 + pm) * (256 * 2048); u.b = Hh + (size_t)pn * (256 * 2048); u.e2 = 1; }
        else { const int q = (int)(L - n1 - n2); pm = q >> 4; pn = q & 15; u.a = Hh + (size_t)(64 + pm) * (256 * 2048); u.b = W + (size_t)(7 + pn) * (256 * 2048); u.e2 = 2; }
        u.e0 = pm; u.e1 = pn; u.e3 = 0; u.nt = 16; return true; }
    __device__ __forceinline__ unsigned rowoff(const Unit&, int) const { return 0u; }
};
struct SchedSplit {
    static constexpr bool GATHER = false;
    const char* A; const char* B; size_t ta, tb; int nslice, ntf, G, c; const char* Ac; size_t tac, sac; int ks;
    __device__ __forceinline__ bool next(int i, Unit& u) const {
        const long L = (long)i * G + c; int pm, pn;
        if (L < 256) { tile_of((int)L, 64, 4, pm, pn); u.a = A + (size_t)pm * ta; u.b = B + (size_t)pn * tb; u.e2 = 0; u.e3 = 0; u.nt = ntf; }
        else { const int q = (int)(L - 256); if (q >= 8 * nslice) return false; const int tile = q / nslice, s = q % nslice; pm = 64 + (tile >> 2); pn = tile & 3;
            u.a = Ac + (size_t)(tile >> 2) * tac + (size_t)(s / ks) * sac + (s % ks) * 512; u.b = B + (size_t)pn * tb + (s % ks) * 512; u.e2 = s + 1; u.e3 = tile; u.nt = 4; }
        u.e0 = pm; u.e1 = pn; return true; }
    __device__ __forceinline__ unsigned rowoff(const Unit&, int) const { return 0u; }
};
struct SchedMerge {
    static constexpr bool GATHER = false;
    const char* Mix; const char* Wb; int nctx, G, c;
    __device__ __forceinline__ bool next(int i, Unit& u) const {
        const int rounds = (256 + G - 1) / G; int pm, pn, b;
        if (i < 4 * rounds && (long)(i >> 2) * G + c < 256) { tile_of((int)((i >> 2) * G + c), 64, 4, pm, pn); b = i & 3; u.e3 = 0; }
        else { const long q = (long)(i - 4 * rounds) * G + c; if (i < 4 * rounds || q >= nctx) return false; const int tile = (int)q >> 2; b = (int)q & 3; pm = 64 + (tile >> 2); pn = tile & 3; u.e3 = 1; }
        u.a = Mix + (size_t)pm * (256 * 2048) + b * 512; u.b = Wb + ((size_t)b * 1024 + pn * 256) * 512; u.e0 = pm; u.e1 = pn; u.e2 = b; u.nt = 4; return true; }
    __device__ __forceinline__ unsigned rowoff(const Unit&, int) const { return 0u; }
};
struct SchedMoe1 {
    static constexpr bool GATHER = true;
    const char* Hh; const char* W; const int* list; const LAS unsigned* mt; int G, c;
    __device__ __forceinline__ bool next(int i, Unit& u) const {
        long L = (long)i * G + c; int e = 0;
        for (; e < 8; ++e) { const long ue = (long)mt[8 + e] * 28; if (L < ue) break; L -= ue; }
        if (e == 8) return false;
        const int m_e = (int)mt[8 + e], nti = (int)(L / m_e), mti = (int)(L % m_e);
        u.a = Hh; u.b = W + ((size_t)e * 7168 + (size_t)nti * 256) * 2048; u.e0 = e; u.e1 = mti; u.e2 = nti; u.e3 = ((int)mt[16 + e] + mti) * 256; u.nt = 16; return true; }
    __device__ __forceinline__ unsigned rowoff(const Unit& u, int r) const {
        const int li = u.e1 * 256 + r; const int ent = (li < (int)mt[u.e0]) ? list[u.e0 * LCAP + li] : 0; return (unsigned)(ent >> 1) * 2048u; }
};
struct SchedMoe2 {
    static constexpr bool GATHER = false;
    const char* Hid; const char* W; const LAS unsigned* mt; int G, c;
    __device__ __forceinline__ bool next(int i, Unit& u) const {
        long L = (long)i * G + c; int e = 0;
        for (; e < 8; ++e) { const long ue = (long)mt[8 + e] * 4; if (L < ue) break; L -= ue; }
        if (e == 8) return false;
        const int m_e = (int)mt[8 + e], nti = (int)(L / m_e), mti = (int)(L % m_e);
        u.a = Hid + (size_t)((int)mt[16 + e] + mti) * 256 * (size_t)(DFE * 2); u.b = W + ((size_t)e * 1024 + (size_t)nti * 256) * (size_t)(DFE * 2); u.e0 = e; u.e1 = mti; u.e2 = nti; u.e3 = 0; u.nt = DFE / 64; return true; }
    __device__ __forceinline__ unsigned rowoff(const Unit&, int) const { return 0u; }
};

#define EPI_ROWS(ai, m) (128 * (ai) + 64 * wr + 16 * (m) + fr)
#define EPI_COL(bj) (128 * (bj) + 32 * wc + 8 * fq)
__device__ __forceinline__ u32x4 pack_acc8(const f32x4 a, const f32x4 b) { u32x4 w; w.x = pk2(a[0], a[1]); w.y = pk2(a[2], a[3]); w.z = pk2(b[0], b[1]); w.w = pk2(b[2], b[3]); return w; }

__device__ __forceinline__ unsigned gq8(float g) { const unsigned q = (unsigned)(g * 255.f + 0.5f); return q < 1u ? 1u : q; }
__device__ __forceinline__ u32x2 pack_gate8(const f32x4 a, const f32x4 b) {
    u32x2 w; w.x = gq8(a[0]) | (gq8(a[1]) << 8) | (gq8(a[2]) << 16) | (gq8(a[3]) << 24); w.y = gq8(b[0]) | (gq8(b[1]) << 8) | (gq8(b[2]) << 16) | (gq8(b[3]) << 24); return w; }
__device__ __forceinline__ float gate8(unsigned w, int k) { return (float)((w >> (8 * k)) & 255u) * (1.f / 255.f); }
struct EpiPlain { static constexpr bool CARRY = false;
    bf16* O; int ld;
    __device__ __forceinline__ void operator()(const f32x4 (&acc)[2][2][4][2], const Unit& u, int wr, int wc, int fr, int fq) const {
#pragma unroll
        for (int ai = 0; ai < 2; ++ai)
#pragma unroll
            for (int m = 0; m < 4; ++m) { bf16* rowp = O + (size_t)(u.e0 * 256 + EPI_ROWS(ai, m)) * ld + u.e1 * 256;
#pragma unroll
                for (int bj = 0; bj < 2; ++bj) *(u32x4*)(rowp + EPI_COL(bj)) = pack_acc8(acc[ai][bj][m][0], acc[ai][bj][m][1]); }
    }
};
struct EpiPlainSplit { static constexpr bool CARRY = false;
    bf16* O; int ld; float* P; int nslice;
    __device__ __forceinline__ void operator()(const f32x4 (&acc)[2][2][4][2], const Unit& u, int wr, int wc, int fr, int fq) const {
        if (u.e2 == 0) {
#pragma unroll
            for (int ai = 0; ai < 2; ++ai)
#pragma unroll
                for (int m = 0; m < 4; ++m) { bf16* rowp = O + (size_t)(u.e0 * 256 + EPI_ROWS(ai, m)) * ld + u.e1 * 256;
#pragma unroll
                    for (int bj = 0; bj < 2; ++bj) *(u32x4*)(rowp + EPI_COL(bj)) = pack_acc8(acc[ai][bj][m][0], acc[ai][bj][m][1]); }
        } else { float* pt = P + (size_t)(u.e3 * nslice + (u.e2 - 1)) * 65536;
#pragma unroll
            for (int ai = 0; ai < 2; ++ai)
#pragma unroll
                for (int m = 0; m < 4; ++m)
#pragma unroll
                    for (int bj = 0; bj < 2; ++bj) { float* p = pt + EPI_ROWS(ai, m) * 256 + EPI_COL(bj); *(f32x4*)p = acc[ai][bj][m][0]; *(f32x4*)(p + 4) = acc[ai][bj][m][1]; }
        }
    }
};
struct EpiInprojA { static constexpr bool CARRY = false;
    bf16* INP; bf16* T; unsigned char* Gc;
    __device__ __forceinline__ void operator()(const f32x4 (&acc)[2][2][4][2], const Unit& u, int wr, int wc, int fr, int fq) const {
        if (u.e2 == 2) {
#pragma unroll
            for (int ai = 0; ai < 2; ++ai)
#pragma unroll
                for (int m = 0; m < 4; ++m) { unsigned char* rowp = Gc + (size_t)(u.e0 * 256 + EPI_ROWS(ai, m)) * 4096 + u.e1 * 256;
#pragma unroll
                    for (int bj = 0; bj < 2; ++bj) { f32x4 a = acc[ai][bj][m][0], b = acc[ai][bj][m][1];
#pragma unroll
                        for (int j = 0; j < 4; ++j) { a[j] = sigm(a[j]); b[j] = sigm(b[j]); }
                        *(u32x2*)(rowp + EPI_COL(bj)) = pack_gate8(a, b); } }
        } else if (u.e2 == 0) {
            bf16* base = INP + (size_t)u.e1 * ((size_t)R * 256);
            const bool regroup = (u.e1 == 1);
#pragma unroll
            for (int ai = 0; ai < 2; ++ai)
#pragma unroll
                for (int m = 0; m < 4; ++m) { const int row = u.e0 * 256 + EPI_ROWS(ai, m);
#pragma unroll
                    for (int bj = 0; bj < 2; ++bj) { const int col = EPI_COL(bj);
                        bf16* p = regroup ? base + ((((size_t)(col >> 4) * 33 + (row >> 9)) * 16 + (row & 15)) * 64 + ((col & 8) << 2) + ((row >> 4) & 31)) * 8 : base + (size_t)row * 256 + col;
                        *(u32x4*)p = pack_acc8(acc[ai][bj][m][0], acc[ai][bj][m][1]); } }
        } else {
#pragma unroll
            for (int ai = 0; ai < 2; ++ai)
#pragma unroll
                for (int m = 0; m < 4; ++m) { bf16* rowp = T + (size_t)(u.e0 * 256 + EPI_ROWS(ai, m)) * R + u.e1 * 256;
#pragma unroll
                    for (int bj = 0; bj < 2; ++bj) *(u32x4*)(rowp + EPI_COL(bj)) = pack_acc8(acc[ai][bj][m][0], acc[ai][bj][m][1]); }
        }
    }
};
struct EpiGates { static constexpr bool CARRY = false;
    unsigned char* Gt;
    __device__ __forceinline__ void operator()(const f32x4 (&acc)[2][2][4][2], const Unit& u, int wr, int wc, int fr, int fq) const {
#pragma unroll
        for (int ai = 0; ai < 2; ++ai)
#pragma unroll
            for (int m = 0; m < 4; ++m) { unsigned char* rowp = Gt + (size_t)(u.e0 * 256 + EPI_ROWS(ai, m)) * 4096 + u.e1 * 256;
#pragma unroll
                for (int bj = 0; bj < 2; ++bj) { f32x4 a = acc[ai][bj][m][0], b = acc[ai][bj][m][1];
#pragma unroll
                    for (int j = 0; j < 4; ++j) { a[j] = sigm(a[j]); b[j] = sigm(b[j]); }
                    *(u32x2*)(rowp + EPI_COL(bj)) = pack_gate8(a, b); } }
    }
};
struct EpiGlu { static constexpr bool CARRY = false;
    const bf16* Zz; bf16* Mix; const float* bglu;
    __device__ __forceinline__ void operator()(const f32x4 (&acc)[2][2][4][2], const Unit& u, int wr, int wc, int fr, int fq) const {
#pragma unroll
        for (int bj = 0; bj < 2; ++bj) { const int col = EPI_COL(bj);
            const f32x4 b0 = *(const f32x4*)(bglu + col), b1 = *(const f32x4*)(bglu + col + 4);
#pragma unroll
            for (int ai = 0; ai < 2; ++ai)
#pragma unroll
                for (int m = 0; m < 4; ++m) { const size_t row = (size_t)(u.e0 * 256 + EPI_ROWS(ai, m));
                    const u32x4 zz = *(const u32x4*)(Zz + row * 256 + col);
                    f32x4 a = acc[ai][bj][m][0] + b0, b = acc[ai][bj][m][1] + b1;
                    a[0] = bflo(zz.x) * sigm(a[0]); a[1] = bfhi(zz.x) * sigm(a[1]); a[2] = bflo(zz.y) * sigm(a[2]); a[3] = bfhi(zz.y) * sigm(a[3]);
                    b[0] = bflo(zz.z) * sigm(b[0]); b[1] = bfhi(zz.z) * sigm(b[1]); b[2] = bflo(zz.w) * sigm(b[2]); b[3] = bfhi(zz.w) * sigm(b[3]);
                    *(u32x4*)(Mix + row * 1024 + 256 + col) = pack_acc8(a, b); } }
    }
};
struct EpiMerge {
    static constexpr bool CARRY = true;
    const unsigned char* Gt; const unsigned char* Gc; bf16* Y; bf16* YP;
    __device__ __forceinline__ void carry(f32x4 (&acc)[2][2][4][2], const Unit& u, int wr, int wc, int fr, int fq) const {
        if (u.e3) {
            const int b = u.e2;
#pragma unroll
            for (int ai = 0; ai < 2; ++ai)
#pragma unroll
                for (int m = 0; m < 4; ++m) { const size_t rc = (size_t)((u.e0 - 64) * 256 + EPI_ROWS(ai, m));
#pragma unroll
                    for (int bj = 0; bj < 2; ++bj) { const int col = u.e1 * 256 + EPI_COL(bj); const u32x2 g = *(const u32x2*)(Gc + rc * 4096 + b * 1024 + col);
                        f32x4 a0 = acc[ai][bj][m][0], a1 = acc[ai][bj][m][1];
#pragma unroll
                        for (int j = 0; j < 4; ++j) { a0[j] *= gate8(g.x, j); a1[j] *= gate8(g.y, j); }
                        *(u32x4*)(YP + ((size_t)b * CROWS + rc) * 1024 + col) = pack_acc8(a0, a1); acc[ai][bj][m][0] = (f32x4){0.f, 0.f, 0.f, 0.f}; acc[ai][bj][m][1] = (f32x4){0.f, 0.f, 0.f, 0.f}; } }
            return; }
        const int b = u.e2, bn = b < 3 ? b + 1 : 3;
        u32x2 g[2][4][2], gn[2][4][2];
#pragma unroll
        for (int ai = 0; ai < 2; ++ai)
#pragma unroll
            for (int m = 0; m < 4; ++m) { const size_t row = (size_t)(u.e0 * 256 + EPI_ROWS(ai, m));
                const unsigned char* grow = (u.e0 < 64 ? Gt + row * 4096 : Gc + (row - LROWS) * 4096) + u.e1 * 256;
#pragma unroll
                for (int bj = 0; bj < 2; ++bj) { g[ai][m][bj] = *(const u32x2*)(grow + b * 1024 + EPI_COL(bj)); gn[ai][m][bj] = *(const u32x2*)(grow + bn * 1024 + EPI_COL(bj)); } }
#pragma unroll
        for (int ai = 0; ai < 2; ++ai)
#pragma unroll
            for (int m = 0; m < 4; ++m) { const size_t row = (size_t)(u.e0 * 256 + EPI_ROWS(ai, m));
#pragma unroll
                for (int bj = 0; bj < 2; ++bj) { const int col = u.e1 * 256 + EPI_COL(bj);
                    f32x4 a0 = acc[ai][bj][m][0], a1 = acc[ai][bj][m][1];
#pragma unroll
                    for (int j = 0; j < 4; ++j) { a0[j] *= gate8(g[ai][m][bj].x, j); a1[j] *= gate8(g[ai][m][bj].y, j); }
                    if (b != 3) {
#pragma unroll
                        for (int j = 0; j < 4; ++j) { a0[j] *= rcpf_(gate8(gn[ai][m][bj].x, j)); a1[j] *= rcpf_(gate8(gn[ai][m][bj].y, j)); }
                        acc[ai][bj][m][0] = a0; acc[ai][bj][m][1] = a1; }
                    else { *(u32x4*)(Y + row * 1024 + col) = pack_acc8(a0, a1); acc[ai][bj][m][0] = (f32x4){0.f, 0.f, 0.f, 0.f}; acc[ai][bj][m][1] = (f32x4){0.f, 0.f, 0.f, 0.f}; } } }
    }
};
struct EpiSwiglu { static constexpr bool CARRY = false;
    bf16* Hd; int ldh; bool moe;
    __device__ __forceinline__ void operator()(const f32x4 (&acc)[2][2][4][2], const Unit& u, int wr, int wc, int fr, int fq) const {
        const int rowbase = moe ? u.e3 : u.e0 * 256, pn = moe ? u.e2 : u.e1;
#pragma unroll
        for (int ai = 0; ai < 2; ++ai)
#pragma unroll
            for (int m = 0; m < 4; ++m) { bf16* p = Hd + (size_t)(rowbase + EPI_ROWS(ai, m)) * ldh + pn * 128 + 32 * wc + 8 * fq;
                f32x4 a = acc[ai][0][m][0], b = acc[ai][0][m][1]; const f32x4 ua = acc[ai][1][m][0], ub = acc[ai][1][m][1];
#pragma unroll
                for (int j = 0; j < 4; ++j) { a[j] = silu_(a[j]) * ua[j]; b[j] = silu_(b[j]) * ub[j]; }
                *(u32x4*)p = pack_acc8(a, b); }
    }
};
struct EpiMoeDown { static constexpr bool CARRY = false;
    bf16* Slot; const int* list; const float* routew; const LAS unsigned* mt;
    __device__ __forceinline__ void operator()(const f32x4 (&acc)[2][2][4][2], const Unit& u, int wr, int wc, int fr, int fq) const {
        const int cnt = (int)mt[u.e0];
#pragma unroll
        for (int ai = 0; ai < 2; ++ai)
#pragma unroll
            for (int m = 0; m < 4; ++m) { const int li = u.e1 * 256 + EPI_ROWS(ai, m);
                if (li < cnt) { const int ent = list[u.e0 * LCAP + li]; const float w = routew[ent];
                    bf16* rowp = Slot + ((size_t)(ent & 1) * LROWS + (size_t)(ent >> 1)) * 1024 + u.e2 * 256;
#pragma unroll
                    for (int bj = 0; bj < 2; ++bj) *(u32x4*)(rowp + EPI_COL(bj)) = pack_acc8(acc[ai][bj][m][0] * w, acc[ai][bj][m][1] * w); } }
    }
};
}
#define DROW(reg, h) (((reg) & 3) + 8 * ((reg) >> 2) + 4 * (h))

__device__ __forceinline__ void s5_state_item(const bf16* M1F  , const bf16* SUF, float* HLOC, int item, int lane) {
    const int cb = item % 33, gd = item / 33, g = gd >> 1, dir = gd & 1, li = lane & 31, h = lane >> 5;
    const bf16* A = M1F + (size_t)(g * 2 + dir) * 128 * 256 + lane * 8;
    const bf16* B = SUF + (size_t)(g * 33 + cb) * 16 * 512 + lane * 8;
    f32x16 acc[4];
#pragma unroll
    for (int rt = 0; rt < 4; ++rt) acc[rt] = zero16();
    bf16x8 a0[2][4], b0[2], a1[2][4], b1[2];
#define S5S_LOAD(AA, BB, grp) do { _Pragma("unroll") for (int s = 0; s < 2; ++s) { const int ks = (grp) * 2 + s; BB[s] = ldg8(B + ks * 512); \
        _Pragma("unroll") for (int rt = 0; rt < 4; ++rt) AA[s][rt] = ldg8(A + (ks * 4 + rt) * 512); } } while (0)
#define S5S_MMA(AA, BB) do { _Pragma("unroll") for (int s = 0; s < 2; ++s) _Pragma("unroll") for (int rt = 0; rt < 4; ++rt) acc[rt] = mma32(AA[s][rt], BB[s], acc[rt]); } while (0)
    S5S_LOAD(a0, b0, 0);
#pragma unroll 1
    for (int gp = 0; gp < 8; gp += 2) {
        S5S_LOAD(a1, b1, gp + 1);
        S5S_MMA(a0, b0);
        if (gp + 2 < 8) S5S_LOAD(a0, b0, gp + 2);
        S5S_MMA(a1, b1);
    }
#undef S5S_LOAD
#undef S5S_MMA
    float* o = HLOC + ((size_t)(g * 2 + dir) * NCH16 + cb * 32 + li) * 128;
#pragma unroll
    for (int rt = 0; rt < 4; ++rt)
#pragma unroll
        for (int q = 0; q < 4; ++q) *(f32x4*)(o + rt * 32 + 8 * q + 4 * h) = (f32x4){acc[rt][4 * q], acc[rt][4 * q + 1], acc[rt][4 * q + 2], acc[rt][4 * q + 3]};
}
__device__ __forceinline__ void s5_scan_item(const float* A16  , const float* HLOC, bf16* HIN, int item, int lane) {
    const int dir = item & 1, g = (item >> 1) & 15, b = item >> 5, p = lane;
    const f32x2 a = *(const f32x2*)(A16 + ((size_t)(dir * 16 + g) * 64 + p) * 2);
    const float* src = HLOC + (size_t)(g * 2 + dir) * NCH16 * 128 + 2 * p;
    const int k2 = dir * 128 + 2 * p; bf16* dst = HIN + ((size_t)g * 33 * 16 + (k2 >> 4)) * 512 + ((k2 >> 3) & 1) * 256 + (k2 & 7);
    float hr = 0.f, hi = 0.f;
#define S5_CH(s) ((s) < 16 ? 1024 + 16 * b + (dir ? 15 - (s) : (s)) : 512 * b + (dir ? 511 - ((s) - 16) : (s) - 16))
    f32x2 v[32], w[32];
#pragma unroll
    for (int j = 0; j < 32; ++j) v[j] = *(const f32x2*)(src + (size_t)S5_CH(j) * 128);
    for (int s0 = 0; s0 < 528; s0 += 32) {
        const int nb = 528 - s0 < 32 ? 528 - s0 : 32;
        if (s0 + 32 < 528) {
#pragma unroll
            for (int j = 0; j < 32; ++j) { const int s = s0 + 32 + j; w[j] = *(const f32x2*)(src + (size_t)S5_CH(s < 528 ? s : 527) * 128); } }
#pragma unroll
        for (int j = 0; j < 32; ++j) if (j < nb) { const int c = S5_CH(s0 + j);
            *(unsigned*)(dst + (size_t)(c >> 5) * 8192 + (c & 31) * 8) = pk2(hr, hi);
            const float nr = a.x * hr - a.y * hi + v[j].x, ni = a.x * hi + a.y * hr + v[j].y; hr = nr; hi = ni; }
#pragma unroll
        for (int j = 0; j < 32; ++j) v[j] = w[j];
    }
#undef S5_CH
}
__device__ __forceinline__ void s5_out_item(const bf16* TABF  , const bf16* SUF, const bf16* HINF, bf16* Z, int item, int lane) {
    const int mh = item & 1, it2 = item >> 1, cb = it2 % 33, g = it2 / 33, li = lane & 31, h = lane >> 5, c = cb * 32 + li;
    const bf16* A = TABF + ((size_t)g * 256 + mh * 128) * 512 + lane * 8;
    const bf16* B0 = SUF + (size_t)(g * 33 + cb) * 16 * 512 + lane * 8;
    const bf16* B1 = HINF + (size_t)(g * 33 + cb) * 16 * 512 + lane * 8;
    f32x16 acc[4];
#pragma unroll
    for (int rt = 0; rt < 4; ++rt) acc[rt] = zero16();
    bf16x8 a0[2][4], b0[2], a1[2][4], b1[2];
#define S5O_LOAD(AA, BB, grp) do { _Pragma("unroll") for (int s = 0; s < 2; ++s) { const int ks = (grp) * 2 + s; BB[s] = ldg8((ks < 16 ? B0 + ks * 512 : B1 + (ks - 16) * 512)); \
        _Pragma("unroll") for (int rt = 0; rt < 4; ++rt) AA[s][rt] = ldg8(A + (ks * 4 + rt) * 512); } } while (0)
#define S5O_MMA(AA, BB) do { _Pragma("unroll") for (int s = 0; s < 2; ++s) _Pragma("unroll") for (int rt = 0; rt < 4; ++rt) acc[rt] = mma32(AA[s][rt], BB[s], acc[rt]); } while (0)
    S5O_LOAD(a0, b0, 0);
#pragma unroll 1
    for (int gp = 0; gp < 16; gp += 2) {
        S5O_LOAD(a1, b1, gp + 1);
        S5O_MMA(a0, b0);
        if (gp + 2 < 16) S5O_LOAD(a0, b0, gp + 2);
        S5O_MMA(a1, b1);
    }
#undef S5O_LOAD
#undef S5O_MMA
#pragma unroll
    for (int rt = 0; rt < 4; ++rt)
#pragma unroll
        for (int q = 0; q < 4; ++q) {
            const int i = 8 * mh + 2 * rt + (q >> 1), ho0 = 8 * (q & 1) + 4 * h;
            u32x2 w; w.x = pk2(gelu_tanh(acc[rt][4 * q]), gelu_tanh(acc[rt][4 * q + 1])); w.y = pk2(gelu_tanh(acc[rt][4 * q + 2]), gelu_tanh(acc[rt][4 * q + 3]));
            *(u32x2*)(Z + ((size_t)c * 16 + i) * 256 + g * 16 + ho0) = w; }
}

__device__ __forceinline__ int ret_tok0(int b, int n) { return n < 64 ? b * SEQ + n * 128 : LROWS + b * CTXL + (n - 64) * 128; }
__device__ __forceinline__ void ret_kv_item(const bf16* RKT, const bf16* RVT, const float* COST, const float* SINT, const float* decay  , float* KV, int item, int lane) {
    const int n = item % 66, bh = item / 66, hd = bh & 3, b = bh >> 2, li = lane & 31, h = lane >> 5;
    const int tok0 = ret_tok0(b, n); const bool lat = n < 64;
    const float lgf = -log2f(1.f + __expf(-decay[hd])), lgr = -log2f(1.f + __expf(-decay[4 + hd]));
    f32x16 acc[2][2][2];
#pragma unroll
    for (int a = 0; a < 2; ++a)
#pragma unroll
        for (int c = 0; c < 2; ++c)
#pragma unroll
            for (int d = 0; d < 2; ++d) acc[a][c][d] = zero16();
    const bf16* k0p = RKT + (size_t)(hd * 64 + li) * R + tok0 + 8 * h;
    const bf16* v0p = RVT + (size_t)(hd * 64 + li) * R + tok0 + 8 * h;
#pragma unroll 2
    for (int ks = 0; ks < 8; ++ks) {
        float k1[8], k2[8];
        unpack8(ldg8(k0p + ks * 16), k1); unpack8(ldg8(k0p + (size_t)32 * R + ks * 16), k2);
        if (lat) {
            const float* cp = COST + (size_t)li * SEQ + n * 128 + ks * 16 + 8 * h; const float* sp = SINT + (size_t)li * SEQ + n * 128 + ks * 16 + 8 * h;
            const f32x4 c0 = *(const f32x4*)cp, c1 = *(const f32x4*)(cp + 4), s0 = *(const f32x4*)sp, s1 = *(const f32x4*)(sp + 4);
#pragma unroll
            for (int j = 0; j < 8; ++j) { const float cc = j < 4 ? c0[j & 3] : c1[j & 3], ss = j < 4 ? s0[j & 3] : s1[j & 3];
                const float x1 = k1[j], x2 = k2[j]; k1[j] = x1 * cc - x2 * ss; k2[j] = x1 * ss + x2 * cc; }
        }
        const bf16x8 vf0 = ldg8(v0p + ks * 16), vf1 = ldg8(v0p + (size_t)32 * R + ks * 16);
#pragma unroll
        for (int dir = 0; dir < 2; ++dir) {
            float a1[8], a2[8];
#pragma unroll
            for (int j = 0; j < 8; ++j) { const int i = ks * 16 + 8 * h + j; const float w = dir == 0 ? ex2(lgf * (float)(127 - i)) : ex2(lgr * (float)i); a1[j] = k1[j] * w; a2[j] = k2[j] * w; }
            const bf16x8 kd0 = pack8(a1), kd1 = pack8(a2);
            acc[dir][0][0] = mma32(kd0, vf0, acc[dir][0][0]); acc[dir][0][1] = mma32(kd0, vf1, acc[dir][0][1]);
            acc[dir][1][0] = mma32(kd1, vf0, acc[dir][1][0]); acc[dir][1][1] = mma32(kd1, vf1, acc[dir][1][1]);
        }
    }
#pragma unroll
    for (int dir = 0; dir < 2; ++dir) { float* o = KV + ((size_t)((b * 4 + hd) * 2 + dir) * 66 + n) * 4096;
#pragma unroll
        for (int dt = 0; dt < 2; ++dt)
#pragma unroll
            for (int et = 0; et < 2; ++et)
#pragma unroll
                for (int q = 0; q < 4; ++q) *(f32x4*)(o + (size_t)(et * 32 + li) * 64 + dt * 32 + 8 * q + 4 * h) = (f32x4){acc[dir][dt][et][4 * q], acc[dir][dt][et][4 * q + 1], acc[dir][dt][et][4 * q + 2], acc[dir][dt][et][4 * q + 3]}; }
}
__device__ __forceinline__ void ret_scan_item(const float* decay, const float* KV, bf16* SPREV, int item, int lane) {
    const int blk = item & 63, bhd = item >> 6, dir = bhd & 1, hd = (bhd >> 1) & 3, idx = blk * 64 + lane;
    const float lg = -log2f(1.f + __expf(-decay[dir * 4 + hd])), cd = ex2(128.f * lg);
    const float* src = KV + (size_t)bhd * 66 * 4096 + idx; bf16* dst = SPREV + (size_t)bhd * 66 * 4096 + idx;
    float s = 0.f;
    for (int s0 = 0; s0 < 66; s0 += 11) {
        float v[11];
#pragma unroll
        for (int j = 0; j < 11; ++j) { const int t = s0 + j; const int n = dir == 0 ? (t < 2 ? 64 + t : t - 2) : (t < 2 ? 65 - t : 65 - t); v[j] = src[(size_t)n * 4096]; }
#pragma unroll
        for (int j = 0; j < 11; ++j) { const int t = s0 + j; const int n = dir == 0 ? (t < 2 ? 64 + t : t - 2) : (t < 2 ? 65 - t : 65 - t); dst[(size_t)n * 4096] = (bf16)(pk2(s, 0.f) & 0xffffu); s = cd * s + v[j]; }
    }
}
struct KVTile { u32x4 k[4], v[4]; };
__device__ __forceinline__ void kv_tile_load(KVTile& T, const bf16* Kh  , const bf16* VTh  , int tok0, int lane) {
#pragma unroll
    for (int i = 0; i < 4; ++i) T.k[i] = *(const u32x4*)(Kh + (size_t)(tok0 + 8 * i + (lane >> 3)) * 256 + (lane & 7) * 8);
#pragma unroll
    for (int i = 0; i < 4; ++i) T.v[i] = *(const u32x4*)(VTh + (size_t)(16 * i + (lane >> 2)) * R + tok0 + (lane & 3) * 8);
}
__device__ __forceinline__ void kv_tile_store(const KVTile& T, LAS unsigned char* wl, int lane) {
#pragma unroll
    for (int i = 0; i < 4; ++i) *(LAS u32x4*)(wl + (8 * i + (lane >> 3)) * 144 + (lane & 7) * 16) = T.k[i];
#pragma unroll
    for (int i = 0; i < 4; ++i) *(LAS u32x4*)(wl + 4608 + (16 * i + (lane >> 2)) * 80 + (lane & 3) * 16) = T.v[i];
}
__device__ __forceinline__ void kv_tile_frags(const LAS unsigned char* wl, int lane, bf16x8 (&kf)[4], bf16x8 (&vf)[2][2]) {
    const int li = lane & 31, h = lane >> 5;
#pragma unroll
    for (int s = 0; s < 4; ++s) kf[s] = *(const LAS bf16x8*)(wl + li * 144 + (2 * s + h) * 16);
#pragma unroll
    for (int et = 0; et < 2; ++et)
#pragma unroll
        for (int s2 = 0; s2 < 2; ++s2) { const LAS unsigned char* p = wl + 4608 + (et * 32 + li) * 80 + s2 * 32 + 8 * h;
            const bf16x4 lo = *(const LAS bf16x4*)p, hi = *(const LAS bf16x4*)(p + 16); vf[et][s2] = __builtin_shufflevector(lo, hi, 0, 1, 2, 3, 4, 5, 6, 7); }
}

__device__ __forceinline__ void rope_item(bf16* RQ, bf16* RK, const float* COSN, const float* SINN, int item, int lane) {
    const int u = lane & 15, off = (u >> 2) * 64 + (u & 3) * 8, c8 = (u & 3) * 8;
#pragma unroll 4
    for (int st = 0; st < 32; ++st) { const int row = item * 128 + 4 * st + (lane >> 4), tl = row & (SEQ - 1);
        const f32x4 c0 = *(const f32x4*)(COSN + (size_t)tl * 32 + c8), c1 = *(const f32x4*)(COSN + (size_t)tl * 32 + c8 + 4), s0 = *(const f32x4*)(SINN + (size_t)tl * 32 + c8), s1 = *(const f32x4*)(SINN + (size_t)tl * 32 + c8 + 4);
#pragma unroll
        for (int w = 0; w < 2; ++w) { bf16* p = (w ? RK : RQ) + (size_t)row * 256 + off; float x1[8], x2[8]; unpack8(*(const bf16x8*)p, x1); unpack8(*(const bf16x8*)(p + 32), x2);
#pragma unroll
            for (int j = 0; j < 8; ++j) { const float cc = j < 4 ? c0[j & 3] : c1[j & 3], ss = j < 4 ? s0[j & 3] : s1[j & 3]; const float a = x1[j], bb = x2[j]; x1[j] = a * cc - bb * ss; x2[j] = a * ss + bb * cc; }
            *(bf16x8*)p = pack8(x1); *(bf16x8*)(p + 32) = pack8(x2); } }
}
__device__ __forceinline__ void ret_out_item(const bf16* RQ, const bf16* RK, const bf16* RG, const bf16* RVT, const bf16* SPREV, const float* decay, const float* gn  , bf16* MIX,
                                             LAS unsigned char* wl, int item, int lane) {
    const int qb = item & 3, it2 = item >> 2, n = it2 % 66, bh = it2 / 66, hd = bh & 3, b = bh >> 2, li = lane & 31, h = lane >> 5;
    const int tok0 = ret_tok0(b, n);
    const float lgf = -log2f(1.f + __expf(-decay[hd])), lgr = -log2f(1.f + __expf(-decay[4 + hd]));
    const int iq = qb * 32 + li;
    const bf16* Kh = RK + hd * 64; const bf16* VTh = RVT + (size_t)hd * 64 * R;
    KVTile T; kv_tile_load(T, Kh, VTh, tok0, lane);
    bf16x8 qf[4];
    { const bf16* qp = RQ + (size_t)(tok0 + iq) * 256 + hd * 64 + 8 * h;
#pragma unroll
      for (int s = 0; s < 4; ++s) qf[s] = ldg8(qp + 16 * s); }
    kv_tile_store(T, wl, lane);
    f32x16 accO[2] = {zero16(), zero16()};
#pragma unroll 1
    for (int kt = 0; kt < 4; ++kt) {
        kv_tile_load(T, Kh, VTh, tok0 + (kt < 3 ? kt + 1 : kt) * 32, lane);
        bf16x8 kf[4], vf[2][2]; kv_tile_frags(wl, lane, kf, vf);
        f32x16 st = zero16();
#pragma unroll
        for (int s = 0; s < 4; ++s) st = mma32(kf[s], qf[s], st);
#pragma unroll
        for (int r = 0; r < 16; ++r) { const int j = kt * 32 + DROW(r, h), df = iq - j;
            const float w = df > 0 ? ex2(lgf * (float)df) : (df < 0 ? ex2(lgr * (float)(-df)) : 2.f); st[r] *= w; }
        const bf16x8 p0 = accB<0>(st), p1 = accB<1>(st);
        accO[0] = mma32(vf[0][0], p0, accO[0]); accO[0] = mma32(vf[0][1], p1, accO[0]); accO[1] = mma32(vf[1][0], p0, accO[1]); accO[1] = mma32(vf[1][1], p1, accO[1]);
        kv_tile_store(T, wl, lane);
    }
    const float cf = ex2(lgf * (float)(iq + 1)), cr = ex2(lgr * (float)(128 - iq));
#pragma unroll
    for (int dir = 0; dir < 2; ++dir) { const bf16* sp = SPREV + ((size_t)((b * 4 + hd) * 2 + dir) * 66 + n) * 4096;
#pragma unroll
        for (int et = 0; et < 2; ++et) { f32x16 a = zero16();
#pragma unroll
            for (int s = 0; s < 4; ++s) a = mma32(ldg8(sp + (size_t)(et * 32 + li) * 64 + 16 * s + 8 * h), qf[s], a);
            const float sc = dir == 0 ? cf : cr;
#pragma unroll
            for (int r = 0; r < 16; ++r) accO[et][r] += sc * a[r]; } }
    float s1 = 0.f;
#pragma unroll
    for (int et = 0; et < 2; ++et)
#pragma unroll
        for (int r = 0; r < 16; ++r) s1 += accO[et][r];
    s1 = xor32_sum(s1); const float mu = s1 * (1.f / 64.f);
    float s2 = 0.f;
#pragma unroll
    for (int et = 0; et < 2; ++et)
#pragma unroll
        for (int r = 0; r < 16; ++r) { const float dlt = accO[et][r] - mu; s2 += dlt * dlt; }
    s2 = xor32_sum(s2); const float rstd = __builtin_amdgcn_rsqf(s2 * (1.f / 64.f) + EPSN);
    const size_t tok = (size_t)(tok0 + iq);
#pragma unroll
    for (int et = 0; et < 2; ++et)
#pragma unroll
        for (int q = 0; q < 4; ++q) { const int e0 = hd * 64 + et * 32 + 8 * q + 4 * h;
            const f32x4 gv = *(const f32x4*)(gn + e0); const u32x2 gg = *(const u32x2*)(RG + tok * 256 + e0);
            const float g0 = bflo(gg.x), g1 = bfhi(gg.x), g2 = bflo(gg.y), g3 = bfhi(gg.y);
            u32x2 w; w.x = pk2(silu_(g0) * (accO[et][4 * q] - mu) * rstd * gv[0], silu_(g1) * (accO[et][4 * q + 1] - mu) * rstd * gv[1]);
            w.y = pk2(silu_(g2) * (accO[et][4 * q + 2] - mu) * rstd * gv[2], silu_(g3) * (accO[et][4 * q + 3] - mu) * rstd * gv[3]);
            *(u32x2*)(MIX + tok * 1024 + 512 + e0) = w; }
}

__device__ __forceinline__ int na_tile_tok(int t, int b, int rs) { const int tb = t - 8; return t >= 8 ? b * SEQ + (rs + (tb >> 1)) * 64 + (tb & 1) * 32 : LROWS + b * CTXL + t * 32; }
__device__ __forceinline__ void na_item(const bf16* NQ, const bf16* NK, const bf16* NVT, bf16* MIX, const LAS float* rpb2, LAS unsigned char* wl, bool ctxq, int b, int r, int hd, int qs, int lane) {
    const int li = lane & 31, h = lane >> 5;
    const int tokq = ctxq ? LROWS + b * CTXL + qs * 32 + li : b * SEQ + r * 64 + qs * 32 + li;
    bf16x8 qf[4];
#pragma unroll
    for (int s = 0; s < 4; ++s) qf[s] = ldg8(NQ + (size_t)tokq * 256 + hd * 64 + 16 * s + 8 * h);
    float mrun = -1e30f, lrun = 0.f;
    f32x16 accO[2] = {zero16(), zero16()};
    const int rs = r - 4 < 0 ? 0 : (r - 4 > 120 ? 120 : r - 4);
    const int qc = qs * 32 + li, cs = qc - 8 < 0 ? 0 : (qc - 8 > 48 ? 48 : qc - 8);
    const int ntile = ctxq ? 8 : 24;
    const float c1 = 0.125f * LOG2E;
    const bf16* Kh = NK + hd * 64; const bf16* VTh = NVT + (size_t)hd * 64 * R;
    KVTile T; kv_tile_load(T, Kh, VTh, na_tile_tok(0, b, rs), lane); kv_tile_store(T, wl, lane);
#pragma unroll 1
    for (int t = 0; t < ntile; ++t) {
        const bool band = t >= 8; const int tb = t - 8, rr = rs + (tb >> 1), ct = tb & 1;
        kv_tile_load(T, Kh, VTh, na_tile_tok(t + 1 < ntile ? t + 1 : t, b, rs), lane);
        bf16x8 kf[4], vf[2][2]; kv_tile_frags(wl, lane, kf, vf);
        f32x16 st = zero16();
#pragma unroll
        for (int s = 0; s < 4; ++s) st = mma32(kf[s], qf[s], st);
        float mt = -INFINITY;
        if (band) { const int dr = rr - r + 7; const LAS float* bp = rpb2 + ((hd * 15 + dr) * 31 + 32 * ct - qc + 15 + 4 * h); const int d0 = 32 * ct + 4 * h - cs;
#pragma unroll
            for (int g = 0; g < 16; ++g) { const int o = 8 * (g >> 2) + (g & 3); const bool inw = (unsigned)(d0 + o) < 16u;
                const float v = inw ? st[g] * c1 + bp[o] : -INFINITY; st[g] = v; mt = fmaxf(mt, v); }
        } else {
#pragma unroll
            for (int g = 0; g < 16; ++g) { const float v = st[g] * c1; st[g] = v; mt = fmaxf(mt, v); }
        }
        mt = xor32_max(mt);
        const float mnew = fmaxf(mrun, mt);
        if (__builtin_amdgcn_ballot_w64(mnew > mrun)) { const float alpha = ex2(mrun - mnew); lrun *= alpha;
#pragma unroll
            for (int et = 0; et < 2; ++et)
#pragma unroll
                for (int g = 0; g < 16; ++g) accO[et][g] *= alpha; }
        mrun = mnew;
        float ps = 0.f;
#pragma unroll
        for (int g = 0; g < 16; ++g) { const float p = ex2(st[g] - mnew); st[g] = p; ps += p; }
        lrun += xor32_sum(ps);
        const bf16x8 p0 = accB<0>(st), p1 = accB<1>(st);
        accO[0] = mma32(vf[0][0], p0, accO[0]); accO[0] = mma32(vf[0][1], p1, accO[0]); accO[1] = mma32(vf[1][0], p0, accO[1]); accO[1] = mma32(vf[1][1], p1, accO[1]);
        kv_tile_store(T, wl, lane);
    }
    const float inv = 1.f / lrun;
#pragma unroll
    for (int et = 0; et < 2; ++et)
#pragma unroll
        for (int q = 0; q < 4; ++q) { u32x2 w; w.x = pk2(accO[et][4 * q] * inv, accO[et][4 * q + 1] * inv); w.y = pk2(accO[et][4 * q + 2] * inv, accO[et][4 * q + 3] * inv);
            *(u32x2*)(MIX + (size_t)tokq * 1024 + 768 + hd * 64 + et * 32 + 8 * q + 4 * h) = w; }
}

__device__ __forceinline__ void fft1_item(const bf16* F, const bf16* W128T, const float* TWC, const float* TWS, bf16* FB, int item, int lane) {
    const int l2 = item & 63, g = (item >> 6) & 3, b = item >> 8, li = lane & 31, h = lane >> 5;
    bf16x8 idf[4];
#pragma unroll
    for (int s = 0; s < 4; ++s) { float v[8];
#pragma unroll
        for (int j = 0; j < 8; ++j) v[j] = (16 * (s & 1) + 8 * h + j == li) ? 1.f : 0.f;
        idf[s] = pack8(v); }
    bf16x8 xb[4][2][2];
#pragma unroll
    for (int lt = 0; lt < 4; ++lt) {
        const bf16* xp = F + (size_t)(b * SEQ + 64 * (lt * 32 + li) + l2) * 256 + g * 64 + 8 * h;
        const bf16x8 x0 = ldg8(xp), x1 = ldg8(xp + 16), x2 = ldg8(xp + 32), x3 = ldg8(xp + 48);
        f32x16 c0 = zero16(), c1 = zero16();
        c0 = mma32(x0, idf[0], c0); c0 = mma32(x1, idf[1], c0);
        c1 = mma32(x2, idf[0], c1); c1 = mma32(x3, idf[1], c1);
        xb[lt][0][0] = accB<0>(c0); xb[lt][0][1] = accB<1>(c0); xb[lt][1][0] = accB<0>(c1); xb[lt][1][1] = accB<1>(c1);
    }
#pragma unroll 1
    for (int kb = 0; kb < 4; ++kb) {
        f32x16 acc[2][2];
#pragma unroll
        for (int ri = 0; ri < 2; ++ri) { acc[ri][0] = zero16(); acc[ri][1] = zero16();
            const bf16* wp = W128T + ((size_t)ri * 128 + kb * 32 + li) * 128 + 4 * h;
#pragma unroll
            for (int lt = 0; lt < 4; ++lt)
#pragma unroll
                for (int s = 0; s < 2; ++s) { const bf16x8 wf = ldg8p(wp + lt * 32 + 16 * s);
                    acc[ri][0] = mma32(wf, xb[lt][0][s], acc[ri][0]); acc[ri][1] = mma32(wf, xb[lt][1][s], acc[ri][1]); } }
#pragma unroll
        for (int q = 0; q < 4; ++q) { const int k1 = kb * 32 + 8 * q + 4 * h;
            const f32x4 tc = *(const f32x4*)(TWC + l2 * 128 + k1), ts = *(const f32x4*)(TWS + l2 * 128 + k1);
#pragma unroll
            for (int j = 0; j < 4; ++j)
#pragma unroll
                for (int ct = 0; ct < 2; ++ct) { const float ar = acc[0][ct][4 * q + j], ai = acc[1][ct][4 * q + j];
                    const float br = ar * tc[j] + ai * ts[j], bi = ai * tc[j] - ar * ts[j];
                    bf16* o = FB + ((((size_t)(b * 4 + g) * 128 + k1 + j) * 2) * 64 + l2) * 64 + ct * 32 + li;
                    o[0] = (bf16)(pk2(br, 0.f) & 0xffffu); o[64 * 64] = (bf16)(pk2(bi, 0.f) & 0xffffu); } }
    }
}
__device__ __forceinline__ void fft2_item(const bf16* FB, const bf16* FCT, const bf16* W64T, bf16* MIX, int item, int lane) {
    const int mh = item & 1, k1 = (item >> 1) & 127, g = (item >> 8) & 3, b = item >> 10, li = lane & 31, h = lane >> 5;
    const bf16* br = FB + (((size_t)(b * 4 + g) * 128 + k1) * 2) * 64 * 64; const bf16* bi = br + 64 * 64;
    const bf16* fc = FCT + (size_t)(mh * 32 + li) * 64 + 8 * h; const bf16* fs = fc + 64 * 64; const bf16* fn = fc + 2 * 64 * 64;
    bf16x8 eb[2][2][2];
#pragma unroll
    for (int lt = 0; lt < 2; ++lt) { f32x16 er = zero16(), ei = zero16();
#pragma unroll
        for (int s = 0; s < 4; ++s) { const bf16x8 ar = ldg8(br + (size_t)(lt * 32 + li) * 64 + 16 * s + 8 * h), ai = ldg8(bi + (size_t)(lt * 32 + li) * 64 + 16 * s + 8 * h);
            const bf16x8 c = ldg8(fc + 16 * s), sn = ldg8(fs + 16 * s), ns = ldg8(fn + 16 * s);
            er = mma32(ar, c, er); er = mma32(ai, sn, er); ei = mma32(ai, c, ei); ei = mma32(ar, ns, ei); }
        eb[lt][0][0] = accB<0>(er); eb[lt][0][1] = accB<1>(er); eb[lt][1][0] = accB<0>(ei); eb[lt][1][1] = accB<1>(ei); }
#pragma unroll
    for (int kt = 0; kt < 2; ++kt) { f32x16 o = zero16();
        const bf16* wc = W64T + (size_t)(kt * 32 + li) * 64 + 4 * h; const bf16* wsn = wc + 64 * 64;
#pragma unroll
        for (int lt = 0; lt < 2; ++lt)
#pragma unroll
            for (int s = 0; s < 2; ++s) { o = mma32(ldg8p(wc + lt * 32 + 16 * s), eb[lt][0][s], o); o = mma32(ldg8p(wsn + lt * 32 + 16 * s), eb[lt][1][s], o); }
#pragma unroll
        for (int rg = 0; rg < 16; ++rg) { const int k2 = kt * 32 + DROW(rg, h);
            MIX[(size_t)(b * SEQ + k1 + 128 * k2) * 1024 + g * 64 + mh * 32 + li] = (bf16)(pk2(o[rg], 0.f) & 0xffffu); } }
}
__device__ __forceinline__ void fftc_item(const bf16* F, const bf16* FCT, const bf16* W256T, bf16* MIX, int item, int lane) {
    const int mh = item & 1, kb = (item >> 1) & 7, g = (item >> 4) & 3, b = item >> 6, li = lane & 31, h = lane >> 5;
    const bf16* fc = FCT + (size_t)(mh * 32 + li) * 64 + 8 * h; const bf16* fn = fc + 2 * 64 * 64;
    const bf16* wc = W256T + (size_t)(kb * 32 + li) * 256 + 4 * h; const bf16* wsn = wc + 256 * 256;
    f32x16 o = zero16();
#pragma unroll 1
    for (int lt = 0; lt < 8; ++lt) { f32x16 zr = zero16(), zi = zero16();
        const bf16* xp = F + (size_t)(LROWS + b * CTXL + lt * 32 + li) * 256 + g * 64 + 8 * h;
#pragma unroll
        for (int s = 0; s < 4; ++s) { const bf16x8 x = ldg8(xp + 16 * s); zr = mma32(x, ldg8(fc + 16 * s), zr); zi = mma32(x, ldg8(fn + 16 * s), zi); }
        o = mma32(ldg8p(wc + lt * 32), accB<0>(zr), o); o = mma32(ldg8p(wc + lt * 32 + 16), accB<1>(zr), o);
        o = mma32(ldg8p(wsn + lt * 32), accB<0>(zi), o); o = mma32(ldg8p(wsn + lt * 32 + 16), accB<1>(zi), o); }
#pragma unroll
    for (int rg = 0; rg < 16; ++rg) { const int k = kb * 32 + DROW(rg, h);
        MIX[(size_t)(LROWS + b * CTXL + k) * 1024 + g * 64 + mh * 32 + li] = (bf16)(pk2(o[rg], 0.f) & 0xffffu); }
}
__device__ __forceinline__ void row_ld_f32(const float* p, int lane, f32x4 (&v)[4]) {
#pragma unroll
    for (int j = 0; j < 4; ++j) v[j] = *(const f32x4*)(p + 256 * j + 4 * lane); }
__device__ __forceinline__ void row_ld_bf16(const bf16* p, int lane, f32x4 (&v)[4]) {
#pragma unroll
    for (int j = 0; j < 4; ++j) { const u32x2 w = *(const u32x2*)(p + 256 * j + 4 * lane); v[j] = (f32x4){bflo(w.x), bfhi(w.x), bflo(w.y), bfhi(w.y)}; } }
__device__ __forceinline__ void row_ld_part(const float* P, int nslice, int r, int lane, f32x4 (&v)[4]) {
#pragma unroll
    for (int j = 0; j < 4; ++j) { const float* p = P + ((size_t)((((r - LROWS) >> 8) * 4 + j) * nslice) * 256 + (r & 255)) * 256 + 4 * lane; f32x4 s = *(const f32x4*)p;
        for (int k = 1; k < nslice; ++k) s = s + *(const f32x4*)(p + (size_t)k * 65536);
        v[j] = s; } }
__device__ __forceinline__ void row_st_f32(float* p, int lane, const f32x4 (&v)[4]) {
#pragma unroll
    for (int j = 0; j < 4; ++j) *(f32x4*)(p + 256 * j + 4 * lane) = v[j]; }
__device__ __forceinline__ void row_st_bf16(bf16* p, int lane, const f32x4 (&v)[4]) {
#pragma unroll
    for (int j = 0; j < 4; ++j) { u32x2 w; w.x = pk2(v[j][0], v[j][1]); w.y = pk2(v[j][2], v[j][3]); *(u32x2*)(p + 256 * j + 4 * lane) = w; } }
__device__ __forceinline__ float row_rstd(const f32x4 (&v)[4]) { float s = 0.f;
#pragma unroll
    for (int j = 0; j < 4; ++j) s += (v[j][0] * v[j][0] + v[j][1] * v[j][1]) + (v[j][2] * v[j][2] + v[j][3] * v[j][3]);
    return __builtin_amdgcn_rsqf(wave_sum(s) * (1.f / 1024.f) + EPSN); }
__device__ __forceinline__ void row_modnorm(const f32x4 (&x)[4], const float* g, const float* sc, const float* sh, int lane, f32x4 (&hh)[4]) {
    const float rs = row_rstd(x); f32x4 gv[4], scv[4], shv[4]; row_ld_f32(g, lane, gv); row_ld_f32(sc, lane, scv); row_ld_f32(sh, lane, shv);
#pragma unroll
    for (int j = 0; j < 4; ++j) hh[j] = x[j] * rs * gv[j] * (scv[j] + 1.f) + shv[j]; }
__device__ __forceinline__ void row_resid(f32x4 (&x)[4], const f32x4 (&t)[4], const float* g, const float* gate, int lane) {
    const float rs = row_rstd(t); f32x4 gv[4], ga[4]; row_ld_f32(g, lane, gv); row_ld_f32(gate, lane, ga);
#pragma unroll
    for (int j = 0; j < 4; ++j) x[j] = x[j] + ga[j] * (t[j] * rs * gv[j]); }

__device__ __forceinline__ void transpose_item(const float* W, int ldw, int k0, int n0, bf16* dst, int ldd, float scale, LAS float* scr, int lane) {
#pragma unroll 8
    for (int i = 0; i < 32; ++i) { const int kk = 2 * i + (lane >> 5); scr[kk * 33 + (lane & 31)] = W[(size_t)(k0 + kk) * ldw + n0 + (lane & 31)]; }
    LDS_WAIT(); asm volatile("" ::: "memory");
    const int c = lane & 7;
#pragma unroll
    for (int j = 0; j < 4; ++j) { const int n = (lane >> 3) + 8 * j; const LAS float* s = scr + (8 * c) * 33 + n;
        u32x4 o; o.x = pk2(s[0 * 33] * scale, s[1 * 33] * scale); o.y = pk2(s[2 * 33] * scale, s[3 * 33] * scale); o.z = pk2(s[4 * 33] * scale, s[5 * 33] * scale); o.w = pk2(s[6 * 33] * scale, s[7 * 33] * scale);
        *(u32x4*)(dst + (size_t)n * ldd + k0 + 8 * c) = o; }
    LDS_WAIT(); asm volatile("" ::: "memory");
}
#ifndef MK_MODE
#define MK_MODE 1
#endif
#ifndef MK_LAST
#define MK_LAST 24
#endif
constexpr int NPHASE = 24;
struct Args { const float* in[31]; float* out; unsigned char* ws; int ph_lo, ph_hi, li, pad; };


struct TrJob { const float* src; bf16* dst; int ldw, k0, n0, ldd; float scale; };
#define CAS __attribute__((address_space(4)))
__device__ __forceinline__ void tr_decode(int it, const CAS Args* ap_, unsigned char* ws, TrJob& J) {
#define TIN(k) ((const float*)(const GAS float*)ap_->in[k])
    int kb; J.scale = 1.f;
    if (it < 43008) { const int e = it / 5376, r = it % 5376, w = r / 1792, li = r % 1792;
        if (w < 2) { J.src = TIN(28 + w) + (size_t)e * 1024 * DFE; J.ldw = DFE; kb = li / 112; J.n0 = (li % 112) * 32; J.ldd = 1024;
            J.dst = (bf16*)(ws + WS_MOE1) + ((size_t)e * 7168 + 256 * (J.n0 / 128) + (J.n0 % 128) + 128 * w) * 1024; }
        else { J.src = TIN(30) + (size_t)e * DFE * 1024; J.ldw = 1024; kb = li / 32; J.n0 = (li % 32) * 32; J.ldd = DFE; J.dst = (bf16*)(ws + WS_MOE2) + ((size_t)e * 1024 + J.n0) * DFE; }
    } else if (it < 47232) { const int r = it - 43008, w = r / 1408, li = r % 1408;
        if (w < 2) { J.src = TIN(23 + w); J.ldw = DFF; kb = li / 88; J.n0 = (li % 88) * 32; J.ldd = 1024; J.dst = (bf16*)(ws + WS_FFN1) + (size_t)(256 * (J.n0 / 128) + (J.n0 % 128) + 128 * w) * 1024; }
        else { J.src = TIN(25); J.ldw = 1024; kb = li / 32; J.n0 = (li % 32) * 32; J.ldd = DFF; J.dst = (bf16*)(ws + WS_FFN2) + (size_t)J.n0 * DFF; }
    } else { const int r = it - 47232, l = r / 4384, q = r % 4384;
        if (q < 3328) { const int t = q / 128, li = q % 128; kb = li / 8; const int nb = li % 8;
            const int srcc = t < 4 ? 256 * t : (t < 7 ? 256 * (t + 1) : (t < 23 ? 2304 + 256 * (t - 7) : (t == 23 ? 768 : (t == 24 ? 1024 : 2048))));
            J.src = TIN(7) + (size_t)l * 1024 * 6400; J.ldw = 6400; J.n0 = srcc + 32 * nb; J.ldd = 1024; J.dst = (bf16*)(ws + WS_WIN) + ((size_t)(l * 26 + t) * 256 + 32 * nb) * 1024; J.scale = (t == 3 || t == 23) ? 0.125f : 1.f; }
        else if (q < 3360) { const int li = q - 3328; kb = li / 8; J.n0 = (li % 8) * 32; J.src = TIN(16) + (size_t)l * 65536; J.ldw = 256; J.ldd = 256; J.dst = (bf16*)(ws + WS_WGLU) + ((size_t)l * 256 + J.n0) * 256; }
        else if (q < 3872) { const int li = q - 3360, bb = li / 128, li2 = li % 128; kb = li2 / 32; J.n0 = (li2 % 32) * 32; J.src = TIN(21) + (size_t)(l * 4 + bb) * 256 * 1024; J.ldw = 1024; J.ldd = 256; J.dst = (bf16*)(ws + WS_WBR) + ((size_t)(l * 4 + bb) * 1024 + J.n0) * 256; }
        else { const int li = q - 3872; kb = li / 32; J.n0 = (li % 32) * 32; J.src = TIN(22) + (size_t)l * 1024 * 1024; J.ldw = 1024; J.ldd = 1024; J.dst = (bf16*)(ws + WS_WOUT) + ((size_t)l * 1024 + J.n0) * 1024; }
    }
    J.k0 = kb * 64;
#undef TIN
}
__device__ __forceinline__ void tr_load(const TrJob& J, int lane, float (&v)[32]) {
#pragma unroll
    for (int i = 0; i < 32; ++i) { const int kk = 2 * i + (lane >> 5); v[i] = J.src[(size_t)(J.k0 + kk) * J.ldw + J.n0 + (lane & 31)]; } }
__device__ __forceinline__ void tr_store(const TrJob& J, int lane, const float (&v)[32], LAS float* scr) {
#pragma unroll
    for (int i = 0; i < 32; ++i) { const int kk = 2 * i + (lane >> 5); scr[kk * 33 + (lane & 31)] = v[i]; }
    LDS_WAIT(); asm volatile("" ::: "memory");
    const int c = lane & 7;
#pragma unroll
    for (int j = 0; j < 4; ++j) { const int n = (lane >> 3) + 8 * j; const LAS float* s = scr + (8 * c) * 33 + n; const float sc = J.scale;
        u32x4 o; o.x = pk2(s[0 * 33] * sc, s[1 * 33] * sc); o.y = pk2(s[2 * 33] * sc, s[3 * 33] * sc); o.z = pk2(s[4 * 33] * sc, s[5 * 33] * sc); o.w = pk2(s[6 * 33] * sc, s[7 * 33] * sc);
        *(u32x4*)(J.dst + (size_t)n * J.ldd + J.k0 + 8 * c) = o; }
    LDS_WAIT(); asm volatile("" ::: "memory");
}

__device__ __forceinline__ void cs2pi(int m, int N, float& c, float& s) { sincospif(2.0f * (float)(m % N) / (float)N, &s, &c); }

__global__ void __launch_bounds__(NTHREADS, 2) mk_fwd(Args args) {
    extern __shared__ __attribute__((aligned(16))) unsigned char lds_raw[];
    LAS unsigned char* lds = (LAS unsigned char*)lds_raw;
    const int tid0 = threadIdx.x, wave = __builtin_amdgcn_readfirstlane(tid0 >> 6);
    const int G = gridDim.x, bx = blockIdx.x, vcu = (G % 8 == 0) ? (bx % 8) * (G / 8) + bx / 8 : bx;
    const int wslot = wave * G + vcu, NW = G * NWAVES;
    volatile LAS unsigned* lctl = (volatile LAS unsigned*)(lds + LDSCTL_OFF);
    for (int u = tid0; u < (LDS_BYTES - LDSCTL_OFF) / 4; u += NTHREADS) lctl[u] = 0u;
    __syncthreads();
    const int lo = args.ph_lo, hi = args.ph_hi, bli = args.li;
#ifdef MK_STAMP_PHASE
    if (wave == 0) *(volatile LAS unsigned long long*)(lctl + 64) = __builtin_amdgcn_s_memrealtime();
#endif
    { XcdBarrier b0 = xcd_barrier_post((unsigned*)(args.ws + WS_CTL) + CW_BAR + bli * XCD_BAR_WORDS, lctl + LW_BAR); (void)b0; }
#define IN(k) (lo <= (k) && (k) < hi)
#ifndef MK_REP_MASK
#define MK_REP_MASK 0u
#endif
#define NREP(k) (((MK_REP_MASK >> (k)) & 1u) ? 2 : 1)
#define FORCE_BAR do { PH_BEGIN XcdBarrier b_; b_.bar = (unsigned*)(ws + WS_CTL) + CW_BAR + bli * XCD_BAR_WORDS; b_.x = xb_xcc_id(); b_.st = lctl + LW_BAR; xcd_barrier(b_); } while (0)
#ifdef MK_STAMP_PHASE
#define STAMP_AT(k) do { if (wave == 0) { if ((k) == MK_STAMP_PHASE - 1) *(volatile LAS unsigned long long*)(lctl + 64) = __builtin_amdgcn_s_memrealtime(); if ((k) == MK_STAMP_PHASE) *(volatile LAS unsigned long long*)(lctl + 66) = __builtin_amdgcn_s_memrealtime(); } } while (0)
#else
#define STAMP_AT(k) do { } while (0)
#endif
#define SEAM(k) do { if (IN(k) && IN((k) + 1)) { PH_BEGIN XcdBarrier b_; b_.bar = (unsigned*)(ws + WS_CTL) + CW_BAR + bli * XCD_BAR_WORDS; b_.x = xb_xcc_id(); b_.st = lctl + LW_BAR; xcd_barrier(b_); } STAMP_AT(k); } while (0)
#define PH_BEGIN int tid; { int l_; asm volatile("v_mbcnt_lo_u32_b32 %0, -1, 0\n\tv_mbcnt_hi_u32_b32 %0, -1, %0" : "=v"(l_)); tid = wave * 64 + (l_ & 63); } const CAS Args* ap_ = (const CAS Args*)__builtin_amdgcn_kernarg_segment_ptr(); asm volatile("" : "+s"(ap_)); unsigned char* ws = (unsigned char*)(GAS unsigned char*)ap_->ws; const int lane = tid & 63; (void)lane;
#define AIN(k) ((const float*)(const GAS float*)ap_->in[k])
#define AOUT ((float*)(GAS float*)ap_->out)
#define MODp ((float*)(ws + CTL_MOD_OFF))
#define ctxbuf ((float*)(ws + WS_CTXBUF))
#define Hh ((bf16*)(ws + WS_H))
#define MIX ((bf16*)(ws + WS_MIX))
#define INP ((bf16*)(ws + WS_INP))
#define Tt ((bf16*)(ws + WS_T))

    for (int rep_ = 0; rep_ < NREP(0); ++rep_) if (IN(0)) { if (rep_) { FORCE_BAR; } PH_BEGIN
        for (int it = bx; it < 32; it += G) {
            const int l = it >> 4, g = it & 15;
            LAS f32x2* apow = (LAS f32x2*)lds; LAS f32x2* bbar = (LAS f32x2*)(lds + 8704); LAS f32x2* Cc = (LAS f32x2*)(lds + 16896); LAS float* Kt = (LAS float*)(lds + 25088);
            for (int dir = 0; dir < 2; ++dir) { const size_t pg = (size_t)(l * 2 + dir) * 16 + g;
                if (tid < 64) { const int p = tid;
                    const float are = AIN(8)[pg * 64 + p], aim = AIN(9)[pg * 64 + p], dt = expf(AIN(10)[pg]);
                    for (int t = 0; t <= 16; ++t) { const float mag = expf(are * dt * (float)t); float sn, cs; sincosf(aim * dt * (float)t, &sn, &cs); apow[t * 64 + p] = (f32x2){mag * cs, mag * sn}; }
                    const f32x2 a = apow[64 + p]; const float nr = a.x - 1.f, ni = a.y, den = 1.f / (are * are + aim * aim);
                    const float cr = (nr * are + ni * aim) * den, ci = (ni * are - nr * aim) * den;
                    for (int h = 0; h < 16; ++h) { const float br = AIN(11)[(pg * 64 + p) * 16 + h], bi = AIN(12)[(pg * 64 + p) * 16 + h]; bbar[p * 16 + h] = (f32x2){cr * br - ci * bi, cr * bi + ci * br}; }
                    *(f32x2*)((float*)(ws + WS_A16) + (pg * 64 + p) * 2) = apow[16 * 64 + p];
                }
                for (int i = tid; i < 1024; i += NTHREADS) Cc[i] = (f32x2){AIN(13)[pg * 1024 + i], AIN(14)[pg * 1024 + i]};
                __syncthreads();
                bf16* M1 = (bf16*)(ws + WS_S5M1) + ((size_t)(l * 16 + g) * 2 + dir) * 128 * 256;
                for (int v = tid; v < 4096; v += NTHREADS) { const int row = v >> 5, col0 = (v & 31) * 8, j = col0 >> 4, h0 = col0 & 15, p = row >> 1, ri = row & 1;
                    const f32x2 pw = apow[(dir == 0 ? 15 - j : j) * 64 + p]; float vals[8];
#pragma unroll
                    for (int hh = 0; hh < 8; ++hh) { const f32x2 bb = bbar[p * 16 + h0 + hh]; vals[hh] = ri ? pw.x * bb.y + pw.y * bb.x : pw.x * bb.x - pw.y * bb.y; }
                    *(bf16x8*)(M1 + ((((col0 >> 4) * 4 + (row >> 5)) * 64 + ((col0 >> 3) & 1) * 32 + (row & 31)) * 8)) = pack8(vals); }
                bf16* TAB = (bf16*)(ws + WS_S5TAB) + (size_t)(l * 16 + g) * 256 * 512;
                for (int v = tid; v < 4096; v += NTHREADS) { const int row = v >> 4, cv = v & 15, i = row >> 4, ho = row & 15; float vals[8];
#pragma unroll
                    for (int pp = 0; pp < 4; ++pp) { const int p = cv * 4 + pp; const f32x2 cc = Cc[ho * 64 + p];
                        const f32x2 pw = apow[(dir == 0 ? i + 1 : 16 - i) * 64 + p]; vals[2 * pp] = cc.x * pw.x - cc.y * pw.y; vals[2 * pp + 1] = -(cc.x * pw.y + cc.y * pw.x); }
                    { const int colt = 256 + dir * 128 + cv * 8; *(bf16x8*)(TAB + (((((row >> 7) * 32 + (colt >> 4)) * 4 + ((row >> 5) & 3)) * 64 + ((colt >> 3) & 1) * 32 + (row & 31)) * 8)) = pack8(vals); } }
                for (int e = tid; e < 4096; e += NTHREADS) { const int t = e >> 8, ho = (e >> 4) & 15, h = e & 15; float acc = 0.f;
#pragma unroll 8
                    for (int p = 0; p < 64; ++p) { const f32x2 cc = Cc[ho * 64 + p], pw = apow[t * 64 + p], bb = bbar[p * 16 + h];
                        const float xr = cc.x * pw.x - cc.y * pw.y, xi = cc.x * pw.y + cc.y * pw.x; acc += xr * bb.x - xi * bb.y; }
                    Kt[dir * 4096 + e] = acc; }
                __syncthreads();
            }
            for (int v = tid; v < 8192; v += NTHREADS) { const int row = v >> 5, col0 = (v & 31) * 8, i = row >> 4, ho = row & 15, j = col0 >> 4, h0 = col0 & 15; float vals[8];
#pragma unroll
                for (int hh = 0; hh < 8; ++hh) { const int h = h0 + hh;
                    vals[hh] = j < i ? Kt[(i - j) * 256 + ho * 16 + h] : (j > i ? Kt[4096 + (j - i) * 256 + ho * 16 + h] : Kt[ho * 16 + h] + Kt[4096 + ho * 16 + h] + (ho == h ? AIN(15)[l * 256 + g * 16 + h] : 0.f)); }
                *(bf16x8*)((bf16*)(ws + WS_S5TAB) + (size_t)(l * 16 + g) * 256 * 512 + (((((row >> 7) * 32 + (col0 >> 4)) * 4 + ((row >> 5) & 3)) * 64 + ((col0 >> 3) & 1) * 32 + (row & 31)) * 8)) = pack8(vals); }
            __syncthreads();
        }
        __syncthreads();
        for (int it = (bx >= 32 ? bx - 32 : bx + G - 32); it < 192; it += G) { const int l = it / 96, cb = it % 96, col = cb * 64 + lane, ks = wave;
            const float* wm = AIN(4) + ((size_t)l * 1024 + ks * 128) * 6144 + col; float a0 = 0.f, a1 = 0.f, a2 = 0.f;
#pragma unroll 8
            for (int k = 0; k < 128; ++k) { const float w = wm[(size_t)k * 6144]; const int kk = ks * 128 + k;
                const float c0 = AIN(1)[kk], c1 = AIN(1)[1024 + kk], c2 = AIN(3)[kk];
                a0 += w * (c0 / (1.f + __expf(-c0))); a1 += w * (c1 / (1.f + __expf(-c1))); a2 += w * (c2 / (1.f + __expf(-c2))); }
            LAS float* part = (LAS float*)lds;
            part[(wave * 3 + 0) * 64 + lane] = a0; part[(wave * 3 + 1) * 64 + lane] = a1; part[(wave * 3 + 2) * 64 + lane] = a2;
            __syncthreads();
            if (tid < 192) { const int i = tid >> 6, c = tid & 63; float sacc = AIN(5)[l * 6144 + cb * 64 + c];
#pragma unroll
                for (int w = 0; w < 8; ++w) sacc += part[(w * 3 + i) * 64 + c];
                MODp[(size_t)(l * 3 + i) * 6144 + cb * 64 + c] = sacc; }
            __syncthreads();
        }
        { LAS float* scr = (LAS float*)(lds + wave * 16384);
          unsigned* qh = (unsigned*)(ws + WS_CTL) + CW_QHEAD;
          int q = bx & 7;
          for (int tries = 0; tries < 8; ) {
            unsigned base = 0u; if (lane == 0) base = __hip_atomic_fetch_add(qh + 64 * q, 2u, __ATOMIC_RELAXED, __HIP_MEMORY_SCOPE_AGENT);
            base = (unsigned)__builtin_amdgcn_readfirstlane((int)base);
            if (base >= 7000u) { q = (q + 1) & 7; ++tries; continue; }
            float va[32], vb[32]; TrJob ja, jb; const bool two = base + 1u < 7000u;
            tr_decode(q * 7000 + (int)base, ap_, ws, ja); tr_load(ja, lane, va);
            tr_decode(q * 7000 + (int)base + (two ? 1 : 0), ap_, ws, jb); tr_load(jb, lane, vb);
            tr_store(ja, lane, va, scr); if (two) tr_store(jb, lane, vb, scr);
          } }
        for (int v = wslot * 64 + lane; v < 32 * SEQ; v += NW * 64) { const int p = v >> 13, t = v & 8191; const float pos = (float)(p < 16 ? (t >> 6) : (t & 63));
            const float inv = 1.0f / powf(10000.f, (float)(p & 15) / 16.f); float sn, cs; sincosf(pos * inv, &sn, &cs);
            ((float*)(ws + WS_COST))[v] = cs; ((float*)(ws + WS_SINT))[v] = sn; ((float*)(ws + WS_COSN))[t * 32 + p] = cs; ((float*)(ws + WS_SINN))[t * 32 + p] = sn; }
        for (int v = wslot * 64 + lane; v < 192512; v += NW * 64) { float c, s;
            if (v < 32768) { const int ri = v >> 14, k1 = (v >> 7) & 127, l1 = v & 127; cs2pi(k1 * l1, 128, c, s); const float sc = 0.08838834764831845f;
                ((bf16*)(ws + WS_W128T))[v] = (bf16)(pk2(ri ? -s * sc : c * sc, 0.f) & 0xffffu); }
            else if (v < 40960) { const int u = v - 32768, l2 = u >> 7, k1 = u & 127; cs2pi(k1 * l2, 8192, c, s); ((float*)(ws + WS_TWC))[u] = c; ((float*)(ws + WS_TWS))[u] = s; }
            else if (v < 53248) { const int u = v - 40960, w = u >> 12, m = (u >> 6) & 63, cc = u & 63; cs2pi(m * cc, 64, c, s);
                ((bf16*)(ws + WS_FCT))[u] = (bf16)(pk2((w == 0 ? c : (w == 1 ? s : -s)) * 0.125f, 0.f) & 0xffffu); }
            else if (v < 61440) { const int u = v - 53248, w = u >> 12, k2 = (u >> 6) & 63, l2 = u & 63; cs2pi(k2 * l2, 64, c, s); ((bf16*)(ws + WS_W64T))[u] = (bf16)(pk2((w == 0 ? c : s) * 0.125f, 0.f) & 0xffffu); }
            else { const int u = v - 61440, w = u >> 16, k = (u >> 8) & 255, l = u & 255; cs2pi(k * l, 256, c, s); ((bf16*)(ws + WS_W256T))[u] = (bf16)(pk2((w == 0 ? c : s) * 0.0625f, 0.f) & 0xffffu); }
        }
    }
    SEAM(0);

    for (int rep_ = 0; rep_ < NREP(1); ++rep_) if (IN(1)) { if (rep_) { FORCE_BAR; } PH_BEGIN
        for (int r = wslot; r < R; r += NW) { const int ci = r < SEQ ? 0 : (r < LROWS ? 1 : 2);
            f32x4 x[4], hh[4]; row_ld_f32(r < LROWS ? AIN(0) + (size_t)r * D : AIN(2) + (size_t)(r - LROWS) * D, lane, x);
            const float* md = MODp + (size_t)ci * 6144;
            row_modnorm(x, AIN(6), md + 1024, md, lane, hh); row_st_bf16(Hh + (size_t)r * D, lane, hh); }
    }
    SEAM(1);

    for (int layer = 0; layer < 2; ++layer) {
        const int pb = 1 + 11 * layer;
        const int nM = layer == 0 ? 66 : 64;
        const int nrows = layer == 0 ? R : LROWS;
#define normg (AIN(6) + (size_t)layer * 4 * D)
        for (int rep_ = 0; rep_ < NREP(pb + 1); ++rep_) if (IN(pb + 1)) { if (rep_) { FORCE_BAR; } PH_BEGIN
            gp::SchedInprojA S{(const char*)Hh, (const char*)(ws + WS_WIN) + (size_t)layer * 26 * 256 * 2048, 66, G, bx, layer == 0 ? 32 : 0};
            gp::EpiInprojA E{INP, Tt, (unsigned char*)(ws + WS_GCTX)};
            gp::gemm_phase(lds, tid, 1024, 1024, 1024, S, E);
        }
        SEAM(pb + 1);
        for (int rep_ = 0; rep_ < NREP(pb + 2); ++rep_) if (IN(pb + 2)) { if (rep_) { FORCE_BAR; } PH_BEGIN
            LAS float* rpb = (LAS float*)(lds + 98304 + 4096);
            LAS unsigned char* wl = lds + wave * 12288;
            for (int i = tid; i < 1860; i += NTHREADS) rpb[i] = AIN(20)[layer * 1860 + i] * LOG2E;
            __syncthreads();
            const int nitA = 2224 + 64 + (layer == 0 ? 64 : 0);
            for (int it = wslot; it < nitA; it += NW) {
                if (it < 1056) s5_state_item((const bf16*)(ws + WS_S5M1) + (size_t)layer * 16 * 2 * 128 * 256, INP + (size_t)R * 256, (float*)(ws + WS_HLOC), it, lane);
                else if (it < 1584) ret_kv_item(Tt, Tt + (size_t)256 * R, (const float*)(ws + WS_COST), (const float*)(ws + WS_SINT), AIN(18) + layer * 8, (float*)(ws + WS_KV), it - 1056, lane);
                else if (it < 2096) fft1_item(INP, (const bf16*)(ws + WS_W128T), (const float*)(ws + WS_TWC), (const float*)(ws + WS_TWS), (bf16*)(ws + WS_FB), it - 1584, lane);
                else if (it < 2224) rope_item(INP + (size_t)2 * R * 256, INP + (size_t)3 * R * 256, (const float*)(ws + WS_COSN), (const float*)(ws + WS_SINN), it - 2096, lane);
                else if (it < 2288) { const int j = 1984 + (it - 2224); na_item(INP + (size_t)5 * R * 256, INP + (size_t)6 * R * 256, Tt + (size_t)512 * R, MIX, rpb, wl, false, j >> 10, (j >> 3) & 127, (j >> 1) & 3, j & 1, lane); }
                else { const int j = it - 2288; na_item(INP + (size_t)5 * R * 256, INP + (size_t)6 * R * 256, Tt + (size_t)512 * R, MIX, rpb, wl, true, j >> 5, 0, (j >> 3) & 3, j & 7, lane); }
            }
            __syncthreads();
        }
        SEAM(pb + 2);
        for (int rep_ = 0; rep_ < NREP(pb + 3); ++rep_) if (IN(pb + 3)) { if (rep_) { FORCE_BAR; } PH_BEGIN
            LAS float* rpb = (LAS float*)(lds + 98304 + 4096); LAS unsigned char* wl = lds + wave * 12288;
            for (int i = tid; i < 1860; i += NTHREADS) rpb[i] = AIN(20)[layer * 1860 + i] * LOG2E;
            __syncthreads();
            for (int vs = wslot; vs < 2048; vs += NW) {
                if (vs < 64) s5_scan_item((const float*)(ws + WS_A16) + (size_t)layer * 2 * 16 * 64 * 2, (const float*)(ws + WS_HLOC), (bf16*)(ws + WS_HIN), vs, lane);
                else { const int j = vs - 64; na_item(INP + (size_t)5 * R * 256, INP + (size_t)6 * R * 256, Tt + (size_t)512 * R, MIX, rpb, wl, false, j >> 10, (j >> 3) & 127, (j >> 1) & 3, j & 1, lane);
                    if (vs >= 1024) ret_scan_item(AIN(18) + layer * 8, (const float*)(ws + WS_KV), (bf16*)(ws + WS_SPREV), vs - 1024, lane); }
            }
            __syncthreads();
        }
        SEAM(pb + 3);
        for (int rep_ = 0; rep_ < NREP(pb + 4); ++rep_) if (IN(pb + 4)) { if (rep_) { FORCE_BAR; } PH_BEGIN
            const int nit = 1056 + 2112 + 2048 + (layer == 0 ? 128 : 0);
            for (int it = wslot; it < nit; it += NW) {
                if (it < 1056) s5_out_item((const bf16*)(ws + WS_S5TAB) + (size_t)layer * 16 * 256 * 512, INP + (size_t)R * 256, (const bf16*)(ws + WS_HIN), (bf16*)(ws + WS_Z), it, lane);
                else if (it < 3168) ret_out_item(INP + (size_t)2 * R * 256, INP + (size_t)3 * R * 256, INP + (size_t)4 * R * 256, Tt + (size_t)256 * R, (const bf16*)(ws + WS_SPREV),
                                                 AIN(18) + layer * 8, AIN(19) + layer * 256, MIX, lds + wave * 12288, it - 1056, lane);
                else if (it < 5216) fft2_item((const bf16*)(ws + WS_FB), (const bf16*)(ws + WS_FCT), (const bf16*)(ws + WS_W64T), MIX, it - 3168, lane);
                else fftc_item(INP, (const bf16*)(ws + WS_FCT), (const bf16*)(ws + WS_W256T), MIX, it - 5216, lane);
            }
        }
        SEAM(pb + 4);
        for (int rep_ = 0; rep_ < NREP(pb + 5); ++rep_) if (IN(pb + 5)) { if (rep_) { FORCE_BAR; } PH_BEGIN
            { PH_BEGIN gp::SchedPlain S{(const char*)(ws + WS_Z), (const char*)(ws + WS_WGLU) + (size_t)layer * 256 * 512, (size_t)256 * 512, (size_t)256 * 512, nM, 1, G, bx, 4};
              gp::EpiGlu E{(const bf16*)(ws + WS_Z), MIX, AIN(17) + layer * 256};
              gp::gemm_phase(lds, tid, 256, 256, 256, S, E); }
            { PH_BEGIN gp::SchedPlain S{(const char*)Hh, (const char*)(ws + WS_WIN) + ((size_t)layer * 26 + 7) * 256 * 2048, (size_t)256 * 2048, (size_t)256 * 2048, 64, 16, G, bx, 16};
              gp::EpiGates E{(unsigned char*)(ws + WS_GATES)};
              gp::gemm_phase(lds, tid, 1024, 1024, 1024, S, E); }
        }
        SEAM(pb + 5);
        for (int rep_ = 0; rep_ < NREP(pb + 6); ++rep_) if (IN(pb + 6)) { if (rep_) { FORCE_BAR; } PH_BEGIN
            gp::SchedMerge S{(const char*)MIX, (const char*)(ws + WS_WBR) + (size_t)layer * 4 * 1024 * 512, layer == 0 ? 32 : 0, G, bx};
            gp::EpiMerge E{(const unsigned char*)(ws + WS_GATES), (const unsigned char*)(ws + WS_GCTX), (bf16*)(ws + WS_Y), (bf16*)(ws + WS_YP)};
            gp::gemm_phase(lds, tid, 256, 1024, 256, S, E);
        }
        SEAM(pb + 6);
        for (int rep_ = 0; rep_ < NREP(pb + 7); ++rep_) if (IN(pb + 7)) { if (rep_) { FORCE_BAR; } PH_BEGIN
            gp::SchedSplit S{(const char*)(ws + WS_Y), (const char*)(ws + WS_WOUT) + (size_t)layer * 1024 * 2048, (size_t)256 * 2048, (size_t)256 * 2048, layer == 0 ? 16 : 0, 16, G, bx,
                             (const char*)(ws + WS_YP), (size_t)256 * 2048, (size_t)CROWS * 2048, 4};
            gp::EpiPlainSplit E{(bf16*)(ws + WS_YO), 1024, (float*)(ws + WS_PARTW), 16};
            gp::gemm_phase(lds, tid, 1024, 1024, 1024, S, E);
        }
        SEAM(pb + 7);
        for (int rep_ = 0; rep_ < NREP(pb + 8); ++rep_) if (IN(pb + 8)) { if (rep_) { FORCE_BAR; } PH_BEGIN
            if (layer == 0) {
                for (int r = wslot; r < R; r += NW) { const int ci = r < SEQ ? 0 : (r < LROWS ? 1 : 2); const float* md = MODp + (size_t)ci * 6144;
                    f32x4 x[4], t[4], hh[4]; row_ld_f32(r < LROWS ? AIN(0) + (size_t)r * D : AIN(2) + (size_t)(r - LROWS) * D, lane, x);
                    if (r < LROWS) row_ld_bf16((const bf16*)(ws + WS_YO) + (size_t)r * D, lane, t); else row_ld_part((const float*)(ws + WS_PARTW), 16, r, lane, t);
                    row_resid(x, t, normg + D, md + 2048, lane);
                    row_st_f32(r < LROWS ? AOUT + (size_t)r * D : ctxbuf + (size_t)(r - LROWS) * D, lane, x);
                    row_modnorm(x, normg + 2 * D, md + 4096, md + 3072, lane, hh); row_st_bf16(Hh + (size_t)r * D, lane, hh); }
            } else {
                LAS float* wrs = (LAS float*)lds; LAS int* rowinfo = (LAS int*)(lds + 32768); LAS unsigned* cntL = (LAS unsigned*)(lds + 32768 + 1024); LAS unsigned* baseL = cntL + 8;
                for (int i = tid; i < 2048; i += NTHREADS) ((LAS f32x4*)wrs)[i] = ((const f32x4*)AIN(26))[i];
                int* list = (int*)(ws + WS_LIST); float* routew = (float*)(ws + WS_ROUTEW);
                for (int grp = vcu; grp < 256; grp += G) {
                    if (tid < 8) cntL[tid] = 0u;
                    __syncthreads();
                    for (int rr = 0; rr < 8; ++rr) { const int r = grp * 64 + wave * 8 + rr; const float* md = MODp + (size_t)(3 + (r < SEQ ? 0 : 1)) * 6144;
                        f32x4 x[4], t[4], hh[4]; row_ld_f32(AOUT + (size_t)r * D, lane, x); row_ld_bf16((const bf16*)(ws + WS_YO) + (size_t)r * D, lane, t);
                        row_resid(x, t, normg + D, md + 2048, lane); row_st_f32(AOUT + (size_t)r * D, lane, x);
                        row_modnorm(x, normg + 2 * D, md + 4096, md + 3072, lane, hh); row_st_bf16(Hh + (size_t)r * D, lane, hh);
                        float lg[8];
#pragma unroll
                        for (int e = 0; e < 8; ++e) lg[e] = 0.f;
#pragma unroll
                        for (int j = 0; j < 4; ++j)
#pragma unroll
                            for (int q = 0; q < 4; ++q) { const int k = 256 * j + 4 * lane + q; const f32x4 w0 = *(const LAS f32x4*)(wrs + k * 8), w1 = *(const LAS f32x4*)(wrs + k * 8 + 4); const float hv = hh[j][q];
                                lg[0] += hv * w0[0]; lg[1] += hv * w0[1]; lg[2] += hv * w0[2]; lg[3] += hv * w0[3]; lg[4] += hv * w1[0]; lg[5] += hv * w1[1]; lg[6] += hv * w1[2]; lg[7] += hv * w1[3]; }
#pragma unroll
                        for (int e = 0; e < 8; ++e) lg[e] = wave_sum(lg[e]) + AIN(27)[e];
                        int i0 = 0; float v0 = lg[0];
#pragma unroll
                        for (int e = 1; e < 8; ++e) if (lg[e] > v0) { v0 = lg[e]; i0 = e; }
                        int i1 = i0 == 0 ? 1 : 0; float v1 = i0 == 0 ? lg[1] : lg[0];
#pragma unroll
                        for (int e = 0; e < 8; ++e) if (e != i0 && lg[e] > v1) { v1 = lg[e]; i1 = e; }
                        const float w0 = 1.f / (1.f + __expf(v1 - v0)), w1 = 1.f - w0;
                        if (lane == 0) { const unsigned s0 = __hip_atomic_fetch_add(cntL + i0, 1u, __ATOMIC_RELAXED, __HIP_MEMORY_SCOPE_WORKGROUP), s1 = __hip_atomic_fetch_add(cntL + i1, 1u, __ATOMIC_RELAXED, __HIP_MEMORY_SCOPE_WORKGROUP);
                            LAS int* ri = rowinfo + (wave * 8 + rr) * 4; ri[0] = i0; ri[1] = (int)s0; ri[2] = i1; ri[3] = (int)s1; routew[(size_t)r * 2] = w0; routew[(size_t)r * 2 + 1] = w1; }
                    }
                    __syncthreads();
                    if (tid < 8) baseL[tid] = __hip_atomic_fetch_add((unsigned*)(ws + WS_CTL) + CW_MOECNT + 64 * tid, cntL[tid], __ATOMIC_RELAXED, __HIP_MEMORY_SCOPE_AGENT);
                    __syncthreads();
                    if (tid < 64) { const LAS int* ri = rowinfo + tid * 4; const int r = grp * 64 + tid;
                        list[ri[0] * LCAP + (int)baseL[ri[0]] + ri[1]] = r * 2; list[ri[2] * LCAP + (int)baseL[ri[2]] + ri[3]] = r * 2 + 1; }
                    __syncthreads();
                }
            }
        }
        SEAM(pb + 8);
        LAS unsigned* mt = (LAS unsigned*)(lds + LDSCTL_OFF) + LW_MOE;
        if (layer == 1 && (IN(pb + 9) || IN(pb + 10))) { PH_BEGIN
            if (tid == 0) { unsigned off = 0u;
                for (int e = 0; e < 8; ++e) { const unsigned c = __hip_atomic_load((unsigned*)(ws + WS_CTL) + CW_MOECNT + 64 * e, __ATOMIC_RELAXED, __HIP_MEMORY_SCOPE_AGENT); const unsigned m = (c + 255u) >> 8; mt[e] = c; mt[8 + e] = m; mt[16 + e] = off; off += m; }
                mt[24] = off; }
            __syncthreads();
        }
        for (int rep_ = 0; rep_ < NREP(pb + 9); ++rep_) if (IN(pb + 9)) { if (rep_) { FORCE_BAR; } PH_BEGIN
            if (layer == 0) {
                gp::SchedPlain S{(const char*)Hh, (const char*)(ws + WS_FFN1), (size_t)256 * 2048, (size_t)256 * 2048, 66, 22, G, bx, 16};
                gp::EpiSwiglu E{(bf16*)(ws + WS_HID), DFF, false};
                gp::gemm_phase(lds, tid, 1024, 1024, 1024, S, E);
            } else {
                gp::SchedMoe1 S{(const char*)Hh, (const char*)(ws + WS_MOE1), (const int*)(ws + WS_LIST), mt, G, bx};
                gp::EpiSwiglu E{(bf16*)(ws + WS_MHID), DFE, true};
                gp::gemm_phase(lds, tid, 1024, 1024, 1024, S, E);
            }
        }
        SEAM(pb + 9);
        for (int rep_ = 0; rep_ < NREP(pb + 10); ++rep_) if (IN(pb + 10)) { if (rep_) { FORCE_BAR; } PH_BEGIN
            if (layer == 0) {
                gp::SchedSplit S{(const char*)(ws + WS_HID), (const char*)(ws + WS_FFN2), (size_t)256 * DFF * 2, (size_t)256 * DFF * 2, 11, DFF / 64, G, bx,
                                 (const char*)(ws + WS_HID) + (size_t)64 * 256 * DFF * 2, (size_t)256 * DFF * 2, 0, 11};
                gp::EpiPlainSplit E{(bf16*)(ws + WS_FO), 1024, (float*)(ws + WS_PARTF), 11};
                gp::gemm_phase(lds, tid, DFF, DFF, DFF, S, E);
            } else {
                gp::SchedMoe2 S{(const char*)(ws + WS_MHID), (const char*)(ws + WS_MOE2), mt, G, bx};
                gp::EpiMoeDown E{(bf16*)(ws + WS_SLOT), (const int*)(ws + WS_LIST), (const float*)(ws + WS_ROUTEW), mt};
                gp::gemm_phase(lds, tid, DFE, DFE, DFE, S, E);
            }
        }
        SEAM(pb + 10);
        for (int rep_ = 0; rep_ < NREP(pb + 11); ++rep_) if (IN(pb + 11)) { if (rep_) { FORCE_BAR; } PH_BEGIN
            for (int r = wslot; r < nrows; r += NW) { const int ci = r < SEQ ? 0 : (r < LROWS ? 1 : 2); const float* md = MODp + (size_t)(layer * 3 + ci) * 6144;
                float* xp = r < LROWS ? AOUT + (size_t)r * D : ctxbuf + (size_t)(r - LROWS) * D;
                f32x4 x[4], t[4]; row_ld_f32(xp, lane, x);
                if (layer == 0) { if (r < LROWS) row_ld_bf16((const bf16*)(ws + WS_FO) + (size_t)r * D, lane, t); else row_ld_part((const float*)(ws + WS_PARTF), 11, r, lane, t); }
                else { f32x4 t2[4]; row_ld_bf16((const bf16*)(ws + WS_SLOT) + (size_t)r * D, lane, t); row_ld_bf16((const bf16*)(ws + WS_SLOT) + ((size_t)LROWS + r) * D, lane, t2);
#pragma unroll
                    for (int j = 0; j < 4; ++j) t[j] = t[j] + t2[j]; }
                row_resid(x, t, normg + 3 * D, md + 5120, lane); row_st_f32(xp, lane, x);
                if (layer == 0) { f32x4 hh[4]; const float* md1 = MODp + (size_t)(3 + ci) * 6144; row_modnorm(x, AIN(6) + 4 * D, md1 + 1024, md1, lane, hh); row_st_bf16(Hh + (size_t)r * D, lane, hh); } }
        }
        SEAM(pb + 11);
    }
#ifdef MK_STAMP_PHASE
    if (MK_STAMP_PHASE == NPHASE - 1 && wave == 0) *(volatile LAS unsigned long long*)(lctl + 66) = __builtin_amdgcn_s_memrealtime();
    if (blockIdx.x == 0 && wave == 0) { const unsigned long long st0_ = *(volatile LAS unsigned long long*)(lctl + 64), st1_ = *(volatile LAS unsigned long long*)(lctl + 66); const unsigned long long target = __builtin_amdgcn_s_memrealtime() + (unsigned long long)MK_STAMP_AMP * (st1_ - st0_); while (__builtin_amdgcn_s_memrealtime() < target) __builtin_amdgcn_s_sleep(20); }
#endif
#ifdef MK_EXTRA_BARS
    for (int xb_ = 0; xb_ < MK_EXTRA_BARS; ++xb_) { FORCE_BAR; }
#endif
#undef IN
#undef SEAM
#undef PH_BEGIN
#undef normg
#undef AIN
#undef AOUT
#undef MODp
#undef ctxbuf
#undef Hh
#undef MIX
#undef INP
#undef Tt
}

__global__ void dumpk(const unsigned char* src, size_t nbytes, int isf32, float* out, size_t N, int accum) {
    const size_t i = (size_t)blockIdx.x * blockDim.x + threadIdx.x; if (i >= N) return;
    const size_t ne = isf32 ? nbytes / 4 : nbytes / 2; float s = 0.f;
    for (size_t k = i; k < ne; k += N) s += isf32 ? ((const float*)src)[k] : bf2f(((const bf16*)src)[k]);
    out[i] = accum ? out[i] + s : s;
}
extern "C" void kernel_launch(void* const* d_in, const int* in_sizes, int n_in, void* d_out, int out_size, void* d_ws, size_t ws_size, hipStream_t stream) {
    static int grid = 0;
    if (grid == 0) {
        if (n_in != 31 || out_size != LROWS * D || ws_size < WS_END) { fprintf(stderr, "kernel_launch: unexpected shapes (n_in %d, out %d, ws %zu < %zu)\n", n_in, out_size, ws_size, (size_t)WS_END); grid = -1; return; }
        int dev = 0, cus = 0, per_cu = 0;
        if (hipGetDevice(&dev) != hipSuccess || hipDeviceGetAttribute(&cus, hipDeviceAttributeMultiprocessorCount, dev) != hipSuccess) { grid = -1; return; }
        if (hipFuncSetAttribute((const void*)mk_fwd, hipFuncAttributeMaxDynamicSharedMemorySize, LDS_BYTES) != hipSuccess) { fprintf(stderr, "kernel_launch: hipFuncSetAttribute failed\n"); grid = -1; return; }
        if (hipOccupancyMaxActiveBlocksPerMultiprocessor(&per_cu, (const void*)mk_fwd, NTHREADS, LDS_BYTES) != hipSuccess || per_cu < 1) { fprintf(stderr, "kernel_launch: occupancy query says %d\n", per_cu); }
        (void)hipGetLastError();
        grid = cus;
    }
    if (grid < 0) return;
    (void)hipMemsetAsync((char*)d_ws + WS_CTL, 0, CTL_ZERO_BYTES, stream);
    Args a{};
    for (int i = 0; i < 31; ++i) a.in[i] = (const float*)d_in[i];
    a.out = (float*)d_out; a.ws = (unsigned char*)d_ws;
#if MK_MODE == 1
    a.ph_lo = 0; a.ph_hi = NPHASE; a.li = 0;
    hipLaunchKernelGGL(mk_fwd, dim3(grid), dim3(NTHREADS), LDS_BYTES, stream, a);
#else
    for (int p = 0; p < MK_LAST; ++p) { a.ph_lo = p; a.ph_hi = p + 1; a.li = p; hipLaunchKernelGGL(mk_fwd, dim3(grid), dim3(NTHREADS), LDS_BYTES, stream, a); }
#endif
#ifdef MK_DUMP_OFF
    dumpk<<<(LROWS * D + 255) / 256, 256, 0, stream>>>((const unsigned char*)d_ws + (size_t)(MK_DUMP_OFF), (size_t)(MK_DUMP_BYTES), MK_DUMP_F32, (float*)d_out, (size_t)LROWS * D, 0);
#endif
#ifdef MK_DUMP2_OFF
    dumpk<<<(LROWS * D + 255) / 256, 256, 0, stream>>>((const unsigned char*)d_ws + (size_t)(MK_DUMP2_OFF), (size_t)(MK_DUMP2_BYTES), MK_DUMP2_F32, (float*)d_out, (size_t)LROWS * D, 1);
#endif
#ifdef MK_DUMP3_OFF
    dumpk<<<(LROWS * D + 255) / 256, 256, 0, stream>>>((const unsigned char*)d_ws + (size_t)(MK_DUMP3_OFF), (size_t)(MK_DUMP3_BYTES), MK_DUMP3_F32, (float*)d_out, (size_t)LROWS * D, 1);
#endif
}
```

```cpp
#define MK_MODE 1
#include <hip/hip_runtime.h>
#include <cstdio>
#include <cstdint>

#define GAS __attribute__((address_space(1)))
#define LAS __attribute__((address_space(3)))
typedef unsigned short bf16;
typedef short bf16x8 __attribute__((ext_vector_type(8)));
typedef short bf16x4 __attribute__((ext_vector_type(4)));
typedef float f32x2 __attribute__((ext_vector_type(2)));
typedef float f32x4 __attribute__((ext_vector_type(4)));
typedef float f32x16 __attribute__((ext_vector_type(16)));
typedef unsigned u32x2 __attribute__((ext_vector_type(2)));
typedef unsigned u32x4 __attribute__((ext_vector_type(4)));

constexpr int D = 1024, SEQ = 8192, LROWS = 16384, CTXL = 256, CROWS = 512, R = 16896;
constexpr int DFF = 2816, DFE = 3584, NEXP = 8, LCAP = 16640;
constexpr int NWAVES = 8, NTHREADS = 512;
constexpr int NCH16 = R / 16;
constexpr float EPSN = 1e-6f, LOG2E = 1.4426950408889634f;

constexpr size_t MiB = 1u << 20;
constexpr size_t WS_CTL = 0, CTL_ZERO_BYTES = 1 * MiB;
constexpr int CW_TMO = 0, CW_BAR = 4096, CW_MOECNT = 98304, CW_QHEAD = 100352;
constexpr size_t CTL_MOD_OFF = 512 * 1024;
constexpr size_t WS_CTXBUF = 1 * MiB;
constexpr size_t WS_COST = 3 * MiB, WS_SINT = 4 * MiB, WS_COSN = 5 * MiB, WS_SINN = 6 * MiB;
constexpr size_t WS_LIST = 7 * MiB;
constexpr size_t WS_ROUTEW = WS_LIST + 8 * LCAP * 4;
constexpr size_t WS_S5K = 8 * MiB;
constexpr size_t WS_A16 = 9 * MiB;
constexpr size_t WS_W128T = WS_A16 + 64 * 1024;
constexpr size_t WS_TWC = WS_W128T + 64 * 1024, WS_TWS = WS_TWC + 32 * 1024;
constexpr size_t WS_FCT = WS_TWS + 32 * 1024;
constexpr size_t WS_W64T = WS_FCT + 32 * 1024;
constexpr size_t WS_W256T = WS_W64T + 32 * 1024;
constexpr size_t WS_MOE1 = 10 * MiB;
constexpr size_t WS_MOE2 = 122 * MiB;
constexpr size_t WS_OTHERW = 178 * MiB;
constexpr size_t WS_WIN = 178 * MiB;
constexpr size_t WS_WBR = 204 * MiB;
constexpr size_t WS_WOUT = 208 * MiB;
constexpr size_t WS_WGLU = 212 * MiB;
constexpr size_t WS_FFN1 = 213 * MiB;
constexpr size_t WS_FFN2 = 224 * MiB;
constexpr size_t WS_S5M1 = 230 * MiB;
constexpr size_t WS_S5TAB = 234 * MiB;
constexpr size_t WS_BIG = 242 * MiB;
constexpr size_t TOK256 = (size_t)R * 256 * 2;
constexpr size_t WS_INP = WS_BIG;
constexpr size_t WS_T = WS_INP + 7 * TOK256;
constexpr size_t WS_HLOC = WS_T + 3 * TOK256;
constexpr size_t WS_HIN = WS_HLOC + 2 * TOK256;
constexpr size_t WS_KV = WS_HIN + TOK256;
constexpr size_t WS_SPREV = WS_KV + 2 * TOK256;
constexpr size_t WS_FB = WS_SPREV + TOK256;
constexpr size_t WS_GATES = WS_BIG;
constexpr size_t WS_Y = WS_BIG + 132 * MiB;
constexpr size_t WS_YO = WS_Y + 33 * MiB;
constexpr size_t WS_Z = WS_YO + 33 * MiB;
constexpr size_t WS_YP = WS_Z;
constexpr size_t WS_PARTW = WS_BIG;
constexpr size_t WS_PARTF = 340 * MiB;
constexpr size_t WS_PARTM = 416 * MiB;
constexpr size_t WS_SMAP = WS_S5K;
constexpr size_t WS_FO = WS_Y;
constexpr size_t WS_HID = WS_BIG;
constexpr size_t WS_MHID = WS_OTHERW;
constexpr size_t WS_H = 449 * MiB;
constexpr size_t WS_MIX = 482 * MiB;
constexpr size_t WS_SLOT = WS_H;
constexpr size_t WS_GCTX = 515 * MiB;
constexpr size_t WS_END = 519 * MiB;
static_assert(WS_FB + 16 * MiB <= WS_Z && WS_Z + TOK256 <= WS_H && WS_MHID + (size_t)34816 * 3584 * 2 <= WS_H && WS_W256T + 256 * 1024 <= WS_MOE1, "ws map");
static_assert(WS_PARTM + (size_t)32 * 7 * 65536 * 2 <= WS_H && WS_MHID + (size_t)34816 * 3584 * 2 <= WS_PARTM, "ws map 3");
static_assert(WS_S5TAB + 8 * MiB <= WS_BIG && WS_FFN2 + (size_t)1024 * 2816 * 2 <= WS_S5M1 && WS_ROUTEW + 32768 * 4 <= WS_S5K, "ws map 2");

constexpr int RING_BYTES = 131072, LDSCTL_OFF = RING_BYTES, LDS_BYTES = 147456;
constexpr int LW_BAR = 8, LW_MOE = 16;

#define VM_WAIT() asm volatile("s_waitcnt vmcnt(0)" ::: "memory")
#define LDS_WAIT() asm volatile("s_waitcnt lgkmcnt(0)" ::: "memory")
typedef __bf16 bf16n2 __attribute__((ext_vector_type(2)));
__device__ __forceinline__ unsigned pk2(float lo, float hi) { bf16n2 v; v.x = (__bf16)lo; v.y = (__bf16)hi; return __builtin_bit_cast(unsigned, v); }
__device__ __forceinline__ float bf2f(unsigned short b) { return __builtin_bit_cast(float, ((unsigned)b) << 16); }
__device__ __forceinline__ float bflo(unsigned w) { return __builtin_bit_cast(float, w << 16); }
__device__ __forceinline__ float bfhi(unsigned w) { return __builtin_bit_cast(float, w & 0xffff0000u); }
__device__ __forceinline__ float ex2(float x) { return __builtin_amdgcn_exp2f(x); }
__device__ __forceinline__ float rcpf_(float x) { return __builtin_amdgcn_rcpf(x); }
__device__ __forceinline__ float sigm(float x) { return rcpf_(1.f + ex2(-LOG2E * x)); }
__device__ __forceinline__ float silu_(float x) { return x * sigm(x); }
__device__ __forceinline__ float gelu_tanh(float x) { const float u = 0.7978845608028654f * (x + 0.044715f * x * x * x); const float t = 1.f - 2.f * rcpf_(1.f + ex2(2.885390081777927f * u)); return 0.5f * x * (1.f + t); }
__device__ __forceinline__ float xor32_sum(float v) { const unsigned u = __builtin_bit_cast(unsigned, v); const auto r = __builtin_amdgcn_permlane32_swap(u, u, false, false); return __builtin_bit_cast(float, (unsigned)r[0]) + __builtin_bit_cast(float, (unsigned)r[1]); }
__device__ __forceinline__ float xor32_max(float v) { const unsigned u = __builtin_bit_cast(unsigned, v); const auto r = __builtin_amdgcn_permlane32_swap(u, u, false, false); return fmaxf(__builtin_bit_cast(float, (unsigned)r[0]), __builtin_bit_cast(float, (unsigned)r[1])); }
template <int X> __device__ __forceinline__ float swz_xor(float v) { return __builtin_bit_cast(float, __builtin_amdgcn_ds_swizzle(__builtin_bit_cast(int, v), (X << 10) | 0x1f)); }
__device__ __forceinline__ float wave_sum(float v) { v += swz_xor<1>(v); v += swz_xor<2>(v); v += swz_xor<4>(v); v += swz_xor<8>(v); v += swz_xor<16>(v); return xor32_sum(v); }
__device__ __forceinline__ f32x16 mma32(bf16x8 a, bf16x8 b, f32x16 c) { return __builtin_amdgcn_mfma_f32_32x32x16_bf16(a, b, c, 0, 0, 0); }
__device__ __forceinline__ bf16x8 ldg8(const bf16* p) { return *(const bf16x8*)p; }
__device__ __forceinline__ bf16x8 ldg8p(const bf16* p) { const bf16x4 lo = *(const bf16x4*)p, hi = *(const bf16x4*)(p + 8); return __builtin_shufflevector(lo, hi, 0, 1, 2, 3, 4, 5, 6, 7); }
template <int S> __device__ __forceinline__ bf16x8 accB(const f32x16& c) {
    u32x4 w; w.x = pk2(c[8 * S + 0], c[8 * S + 1]); w.y = pk2(c[8 * S + 2], c[8 * S + 3]); w.z = pk2(c[8 * S + 4], c[8 * S + 5]); w.w = pk2(c[8 * S + 6], c[8 * S + 7]);
    return __builtin_bit_cast(bf16x8, w);
}
__device__ __forceinline__ bf16x8 pack8(const float (&v)[8]) { u32x4 w; w.x = pk2(v[0], v[1]); w.y = pk2(v[2], v[3]); w.z = pk2(v[4], v[5]); w.w = pk2(v[6], v[7]); return __builtin_bit_cast(bf16x8, w); }
__device__ __forceinline__ void unpack8(const bf16x8 x, float (&v)[8]) { const u32x4 w = __builtin_bit_cast(u32x4, x); v[0] = bflo(w.x); v[1] = bfhi(w.x); v[2] = bflo(w.y); v[3] = bfhi(w.y); v[4] = bflo(w.z); v[5] = bfhi(w.z); v[6] = bflo(w.w); v[7] = bfhi(w.w); }
__device__ __forceinline__ f32x16 zero16() { f32x16 z;
#pragma unroll
    for (int i = 0; i < 16; ++i) z[i] = 0.f;
    return z; }

#define XB_TMO      128
#define XB_XCNT(j)  (256  + 64 * (j))
#define XB_XSUB(j)  (1280 + 64 * (j))
#define XB_XGEN(j)  (2304 + 64 * (j))
#define XB_TOP      3328
#define XB_TOPGEN   3392
#define XCD_BAR_WORDS 3456
#define XB_SPIN_CAP (1u << 18)
__device__ __forceinline__ unsigned xb_ld(unsigned* p)              { return __hip_atomic_load(p, __ATOMIC_RELAXED, __HIP_MEMORY_SCOPE_AGENT); }
__device__ __forceinline__ unsigned xb_add(unsigned* p, unsigned v) { return __hip_atomic_fetch_add(p, v, __ATOMIC_RELAXED, __HIP_MEMORY_SCOPE_AGENT); }
__device__ __forceinline__ unsigned xb_xcc_id() { return (unsigned)__builtin_amdgcn_s_getreg((3 << 11) | 20) & 0xFu; }
#define XB_SPIN(cond, bar) do { unsigned _sp = 0; while (cond) { __builtin_amdgcn_s_sleep(1); \
    if ((++_sp & 255u) == 0u) { if (xb_ld(&(bar)[XB_TMO])) break; if (_sp > XB_SPIN_CAP) { atomicAdd(&(bar)[XB_TMO], 1u); break; } } } } while (0)
struct XcdBarrier { unsigned* bar; unsigned x; volatile LAS unsigned* st; };
__device__ __forceinline__ XcdBarrier xcd_barrier_post(unsigned* bar, volatile LAS unsigned* st) {
    XcdBarrier b; b.bar = bar; b.x = xb_xcc_id(); b.st = st;
    if (threadIdx.x == 0) (void)xb_add(&bar[XB_XCNT(b.x)], 1u);
    return b;
}
__device__ __forceinline__ void xcd_barrier_complete(unsigned* bar, unsigned x, unsigned& nloc, unsigned& nx) {
    const unsigned G = gridDim.x * gridDim.y * gridDim.z;
    unsigned sum, cnt, mine, sp = 0u;
    for (;;) {
        sum = 0u; cnt = 0u; mine = 0u;
#pragma unroll
        for (unsigned j = 0; j < 16; ++j) { const unsigned c = xb_ld(&bar[XB_XCNT(j)]); sum += c; cnt += (c > 0u) ? 1u : 0u; mine = (j == x) ? c : mine; }
        if (sum == G) break;
        __builtin_amdgcn_s_sleep(1);
        if ((++sp & 255u) == 0u) { if (xb_ld(&bar[XB_TMO])) break; if (sp > XB_SPIN_CAP) { atomicAdd(&bar[XB_TMO], 1u); break; } }
    }
    nloc = mine > 0u ? mine : 1u; nx = cnt > 0u ? cnt : 1u;
}
__device__ __forceinline__ void xcd_barrier(const XcdBarrier& b) {
    asm volatile("s_waitcnt vmcnt(0)" ::: "memory");
    __syncthreads();
    if (threadIdx.x == 0) {
        unsigned* bar = b.bar;
        __builtin_amdgcn_s_waitcnt(0);
        unsigned nloc = b.st[0], nx = b.st[1];
        if (nloc == 0u) { xcd_barrier_complete(bar, b.x, nloc, nx); b.st[0] = nloc; b.st[1] = nx; }
        const unsigned old = xb_add(&bar[XB_XSUB(b.x)], 1u);
        const unsigned gen = old / nloc;
        if (old + 1u == (gen + 1u) * nloc) {
            __builtin_amdgcn_fence(__ATOMIC_RELEASE, "agent");
            asm volatile("s_waitcnt vmcnt(0)" ::: "memory");
            const unsigned og = xb_add(&bar[XB_TOP], 1u);
            const unsigned tg = og / nx;
            if (og + 1u == (tg + 1u) * nx) xb_add(&bar[XB_TOPGEN], 1u);
            else XB_SPIN(xb_ld(&bar[XB_TOPGEN]) == tg, bar);
            __builtin_amdgcn_fence(__ATOMIC_ACQUIRE, "agent");
            xb_add(&bar[XB_XGEN(b.x)], 1u);
            asm volatile("s_waitcnt vmcnt(0)" ::: "memory");
        } else {
            XB_SPIN(xb_ld(&bar[XB_XGEN(b.x)]) == gen, bar);
            __builtin_amdgcn_fence(__ATOMIC_ACQUIRE, "agent");
            asm volatile("s_waitcnt vmcnt(0)" ::: "memory");
        }
    }
    __syncthreads();
}
namespace gp {
constexpr int BM = 256, BK = 64, HALF = 128, HTB = HALF * BK * 2, STAGE_BYTES = 8 * HTB, NXCD = 8, WGM = 8;
__device__ __forceinline__ int lds_byte(int r, int c) { const int st = (r >> 4) * 2 + (c >> 5), rr = r & 15, cc = c & 31, ob = rr * 64 + cc * 2; return st * 1024 + (ob ^ (((ob >> 9) & 1) << 5)); }
__device__ __forceinline__ void stage_rc(int b, int& Rr, int& C) { const int st = b / 1024, sb = b % 1024, swz = sb ^ (((sb >> 9) & 1) << 5); Rr = (st >> 1) * 16 + swz / 64; C = (st & 1) * 32 + (swz % 64) / 2; }
__device__ __forceinline__ int perm32(int rho) { const int n = rho >> 4, i = rho & 15; return 8 * (i >> 2) + 4 * n + (i & 3); }

struct Unit { const char* a; const char* b; int e0, e1, e2, e3, nt; };

__device__ __forceinline__ void tile_of(int L, int nM, int nN, int& pm, int& pn) {
    const int nwg = nM * nN; int wgid = L;
    { const int q = nwg / NXCD, r = nwg % NXCD, xcd = wgid % NXCD, off = wgid / NXCD; wgid = (xcd < r ? xcd * (q + 1) : r * (q + 1) + (xcd - r) * q) + off; }
    const int nig = WGM * nN, gid = wgid / nig, fm = gid * WGM, gsz = (nM - fm) < WGM ? (nM - fm) : WGM;
    pm = fm + ((wgid % nig) % gsz); pn = (wgid % nig) / gsz;
}

template <class Epi, class Sched>
__device__ __forceinline__ void gemm_phase(LAS unsigned char* lds, const int tid, const int K, const int lda, const int ldb, const Sched& S, const Epi& E) {
    constexpr bool GATHER = Sched::GATHER;
    const int wid = __builtin_amdgcn_readfirstlane(tid >> 6), lane = tid & 63, wr = wid >> 2, wc = wid & 3, fr = lane & 15, fq = lane >> 4;
    unsigned voffA[2], voffB[2];
#pragma unroll
    for (int i = 0; i < 2; ++i) { int Rr, C; stage_rc(tid * 16 + i * 8192, Rr, C); const int Rb = (Rr & ~31) + perm32(Rr & 31);
        voffA[i] = (unsigned)(Rr * lda + C) * 2u; voffB[i] = (unsigned)(Rb * ldb + C) * 2u; }
#define PG8_GOFF(dst, unit) do { _Pragma("unroll") for (int _h = 0; _h < 2; ++_h) _Pragma("unroll") for (int _i = 0; _i < 2; ++_i) { int _R, _C; stage_rc(tid * 16 + _i * 8192, _R, _C); dst[_h][_i] = S.rowoff(unit, _R + _h * HALF) + (unsigned)_C * 2u; } } while (0)
    const size_t kstep = (size_t)(BK * 2);
    const unsigned hstepA = (unsigned)HALF * (unsigned)lda * 2u; const size_t hstepB = (size_t)HALF * ldb * 2;
    const unsigned ldsw = (unsigned)wid * 1024u;
    const int aoff = lds_byte(wr * 64 + fr, fq * 8), boff = lds_byte(wc * 32 + fr, fq * 8);
#define PG8_SA(b, h) (((b) * 2 + (h)) * HTB)
#define PG8_SB(b, h) ((4 + (b) * 2 + (h)) * HTB)
#define PG8_STB(bufoff, gbase, hh) do { _Pragma("unroll") for (int _i = 0; _i < 2; ++_i) \
        __builtin_amdgcn_global_load_lds((const unsigned*)((const char*)(gbase) + (size_t)(hh) * hstepB + voffB[_i]), (LAS unsigned*)(lds + (bufoff) + ldsw + _i * 8192), 16, 0, 0); } while (0)
#define PG8_STA(bufoff, gbase, hh, VG) do { _Pragma("unroll") for (int _i = 0; _i < 2; ++_i) { const unsigned _o = GATHER ? (VG) : (voffA[_i] + (unsigned)(hh) * hstepA); \
        __builtin_amdgcn_global_load_lds((const unsigned*)((const char*)(gbase) + _o), (LAS unsigned*)(lds + (bufoff) + ldsw + _i * 8192), 16, 0, 0); } } while (0)
#define PG8_LDA(dst, b, h) do { _Pragma("unroll") for (int m = 0; m < 4; ++m) _Pragma("unroll") for (int k = 0; k < 2; ++k) dst[m][k] = *(const LAS bf16x8*)(lds + PG8_SA(b, h) + aoff + m * 2048 + k * 1024); } while (0)
#define PG8_LDB(dst, b, h) do { _Pragma("unroll") for (int n = 0; n < 2; ++n) _Pragma("unroll") for (int k = 0; k < 2; ++k) dst[n][k] = *(const LAS bf16x8*)(lds + PG8_SB(b, h) + boff + n * 2048 + k * 1024); } while (0)
#define PG8_MMA(ai, bj, At, Bt) do { __builtin_amdgcn_s_setprio(1); _Pragma("unroll") for (int m = 0; m < 4; ++m) _Pragma("unroll") for (int n = 0; n < 2; ++n) _Pragma("unroll") for (int k = 0; k < 2; ++k) \
        acc[ai][bj][m][n] = __builtin_amdgcn_mfma_f32_16x16x32_bf16(Bt[n][k], At[m][k], acc[ai][bj][m][n], 0, 0, 0); __builtin_amdgcn_s_setprio(0); } while (0)
#define PG8_WAIT_V(n) asm volatile("s_waitcnt vmcnt(" #n ")" ::: "memory")
#define PG8_WAIT_L(n) asm volatile("s_waitcnt lgkmcnt(" #n ")" ::: "memory")
#define PG8_BAR __builtin_amdgcn_s_barrier()
#define PG8_SCHED __builtin_amdgcn_sched_barrier(0)
    Unit cur, nxt; int ui = 0;
    if (!S.next(0, cur)) return;
    f32x4 acc[2][2][4][2];
#pragma unroll
    for (int a = 0; a < 2; ++a)
#pragma unroll
        for (int b = 0; b < 2; ++b)
#pragma unroll
            for (int m = 0; m < 4; ++m)
#pragma unroll
                for (int n = 0; n < 2; ++n) acc[a][b][m][n] = (f32x4){0.f, 0.f, 0.f, 0.f};
    bf16x8 At[4][2], B0[2][2], B1[2][2];
    unsigned vgc[2][2], vgn[2][2];
    if constexpr (GATHER) { PG8_GOFF(vgc, cur); }
#pragma unroll
    for (int h = 0; h < 2; ++h)
#pragma unroll
        for (int i = 0; i < 2; ++i) { if (!GATHER) vgc[h][i] = 0u; vgn[h][i] = vgc[h][i]; }
    const char* cA = cur.a; const char* cB = cur.b;
    PG8_STB(PG8_SB(0, 0), cB, 0); PG8_STB(PG8_SB(0, 1), cB, 1); PG8_STA(PG8_SA(0, 0), cA, 0, vgc[0][_i]); PG8_STA(PG8_SA(0, 1), cA, 1, vgc[1][_i]);
    if (wr == 1) PG8_BAR;
    PG8_WAIT_V(2); PG8_BAR;
    PG8_STB(PG8_SB(1, 0), cB + kstep, 0); PG8_STA(PG8_SA(1, 0), cA + kstep, 0, vgc[0][_i]); PG8_STB(PG8_SB(1, 1), cB + kstep, 1);
    PG8_WAIT_V(6); PG8_BAR;
    for (;;) {
        const bool has_next = S.next(ui + 1, nxt);
        const char* nA = has_next ? nxt.a : cA; const char* nB = has_next ? nxt.b : cB;
        int nt = cur.nt; asm volatile("" : "+s"(nt));
#pragma unroll 1
        for (int t = 0; t < nt; t += 2) {
            const bool last = (t == nt - 2);
            const char* a1 = cA + (size_t)(t + 1) * kstep;
            const char* a2 = last ? nA : cA + (size_t)(t + 2) * kstep; const char* b2 = last ? nB : cB + (size_t)(t + 2) * kstep;
            const char* a3 = a2 + kstep; const char* b3 = b2 + kstep;
            if constexpr (GATHER) { if (last && has_next) { PG8_GOFF(vgn, nxt); } }
            PG8_LDB(B0, 0, 0); PG8_LDB(B1, 0, 1); PG8_SCHED; PG8_LDA(At, 0, 0); PG8_STA(PG8_SA(1, 1), a1, 1, vgc[1][_i]);
            PG8_WAIT_V(8); PG8_WAIT_L(0); PG8_BAR; PG8_MMA(0, 0, At, B0); PG8_MMA(0, 1, At, B1); PG8_BAR; PG8_SCHED;
            PG8_LDA(At, 0, 1); PG8_STB(PG8_SB(0, 0), b2, 0); PG8_STB(PG8_SB(0, 1), b2, 1); PG8_STA(PG8_SA(0, 0), a2, 0, (last ? vgn[0][_i] : vgc[0][_i]));
            PG8_WAIT_V(8); PG8_WAIT_L(0); PG8_BAR; PG8_MMA(1, 0, At, B0); PG8_MMA(1, 1, At, B1); PG8_BAR; PG8_SCHED;
            PG8_LDB(B0, 1, 0); PG8_LDB(B1, 1, 1); PG8_SCHED; PG8_LDA(At, 1, 0); PG8_STA(PG8_SA(0, 1), a2, 1, (last ? vgn[1][_i] : vgc[1][_i]));
            PG8_WAIT_V(8); PG8_WAIT_L(0); PG8_BAR; PG8_MMA(0, 0, At, B0); PG8_MMA(0, 1, At, B1); PG8_BAR; PG8_SCHED;
            PG8_LDA(At, 1, 1); PG8_STB(PG8_SB(1, 0), b3, 0); PG8_STB(PG8_SB(1, 1), b3, 1); PG8_STA(PG8_SA(1, 0), a3, 0, (last ? vgn[0][_i] : vgc[0][_i]));
            PG8_WAIT_V(8); PG8_WAIT_L(0); PG8_BAR; PG8_MMA(1, 0, At, B0); PG8_MMA(1, 1, At, B1); PG8_BAR; PG8_SCHED;
        }
        if (wr == 0) PG8_BAR;
        Unit ue = cur; int le = lane;
        if constexpr (Epi::LAUNDER) { int t0 = cur.e0, t1 = cur.e1, t2 = cur.e2, t3 = cur.e3; asm volatile("" : "+v"(t0), "+v"(t1), "+v"(t2), "+v"(t3), "+v"(le));
          ue.e0 = __builtin_amdgcn_readfirstlane(t0); ue.e1 = __builtin_amdgcn_readfirstlane(t1); ue.e2 = __builtin_amdgcn_readfirstlane(t2); ue.e3 = __builtin_amdgcn_readfirstlane(t3); le &= 63; }
        const int fre = le & 15, fqe = le >> 4;
        if constexpr (Epi::CARRY) { E.carry(acc, ue, wr, wc, fre, fqe); if (!has_next) break; }
        else {
        E(acc, ue, wr, wc, fre, fqe);
        if (!has_next) break;
#pragma unroll
        for (int a = 0; a < 2; ++a)
#pragma unroll
            for (int b = 0; b < 2; ++b)
#pragma unroll
                for (int m = 0; m < 4; ++m)
#pragma unroll
                    for (int n = 0; n < 2; ++n) acc[a][b][m][n] = (f32x4){0.f, 0.f, 0.f, 0.f};
        }
        cur = nxt; cA = nA; cB = nB; ++ui;
#pragma unroll
        for (int h = 0; h < 2; ++h)
#pragma unroll
            for (int i = 0; i < 2; ++i) vgc[h][i] = vgn[h][i];
        if (wr == 1) PG8_BAR;
    }
    PG8_WAIT_V(0);
    PG8_BAR;
#undef PG8_SA
#undef PG8_SB
#undef PG8_STA
#undef PG8_GOFF
#undef PG8_STB
#undef PG8_LDA
#undef PG8_LDB
#undef PG8_MMA
#undef PG8_WAIT_V
#undef PG8_WAIT_L
#undef PG8_BAR
#undef PG8_SCHED
}

struct SchedPlain {
    static constexpr bool GATHER = false;
    const char* A; const char* B; size_t ta, tb; int nM, nN, G, c, nt;
    __device__ __forceinline__ bool next(int i, Unit& u) const {
        const long L = (long)i * G + c; if (L >= (long)nM * nN) return false;
        int pm, pn; tile_of((int)L, nM, nN, pm, pn); u.a = A + (size_t)pm * ta; u.b = B + (size_t)pn * tb; u.e0 = pm; u.e1 = pn; u.e2 = 0; u.e3 = 0; u.nt = nt; return true; }
    __device__ __forceinline__ unsigned rowoff(const Unit&, int) const { return 0u; }
};
struct SchedInprojA {
    static constexpr bool GATHER = false;
    const char* Hh; const char* W; int nM, G, c, ng;
    __device__ __forceinline__ bool next(int i, Unit& u) const {
        long L = (long)i * G + c; const int n1 = nM * 7, n2 = 3 * nM; if (L >= n1 + n2 + ng) return false;
        int pm, pn;
        if (L < n1) { tile_of((int)L, nM, 7, pm, pn); u.a = Hh + (size_t)pm * (256 * 2048); u.b = W + (size_t)pn * (256 * 2048); u.e2 = 0; }
        else if (L < n1 + n2) { tile_of((int)(L - n1), 3, nM, pm, pn); u.a = W + (size_t)(23 + pm) * (256 * 2048); u.b = Hh + (size_t)pn * (256 * 2048); u.e2 = 1; }
        else { const int q = (int)(L - n1 - n2); pm = q >> 4; pn = q & 15; u.a = Hh + (size_t)(64 + pm) * (256 * 2048); u.b = W + (size_t)(7 + pn) * (256 * 2048); u.e2 = 2; }
        u.e0 = pm; u.e1 = pn; u.e3 = 0; u.nt = 16; return true; }
    __device__ __forceinline__ unsigned rowoff(const Unit&, int) const { return 0u; }
};
struct SchedSplit {
    static constexpr bool GATHER = false;
    const char* A; const char* B; size_t ta, tb; int nslice, ntf, G, c; const char* Ac; size_t tac, sac; int ks;
    __device__ __forceinline__ bool next(int i, Unit& u) const {
        const long L = (long)i * G + c; int pm, pn;
        if (L < 256) { tile_of((int)L, 64, 4, pm, pn); u.a = A + (size_t)pm * ta; u.b = B + (size_t)pn * tb; u.e2 = 0; u.e3 = 0; u.nt = ntf; }
        else { const int q = (int)(L - 256); if (q >= 8 * nslice) return false; const int tile = q / nslice, s = q % nslice; pm = 64 + (tile >> 2); pn = tile & 3;
            u.a = Ac + (size_t)(tile >> 2) * tac + (size_t)(s / ks) * sac + (s % ks) * 512; u.b = B + (size_t)pn * tb + (s % ks) * 512; u.e2 = s + 1; u.e3 = tile; u.nt = 4; }
        u.e0 = pm; u.e1 = pn; return true; }
    __device__ __forceinline__ unsigned rowoff(const Unit&, int) const { return 0u; }
};
struct SchedMerge {
    static constexpr bool GATHER = false;
    const char* Mix; const char* Wb; int nctx, G, c;
    __device__ __forceinline__ bool next(int i, Unit& u) const {
        const int rounds = (256 + G - 1) / G; int pm, pn, b;
        if (i < 4 * rounds && (long)(i >> 2) * G + c < 256) { tile_of((int)((i >> 2) * G + c), 64, 4, pm, pn); b = i & 3; u.e3 = 0; }
        else { const long q = (long)(i - 4 * rounds) * G + c; if (i < 4 * rounds || q >= nctx) return false; const int tile = (int)q >> 2; b = (int)q & 3; pm = 64 + (tile >> 2); pn = tile & 3; u.e3 = 1; }
        u.a = Mix + (size_t)pm * (256 * 2048) + b * 512; u.b = Wb + ((size_t)b * 1024 + pn * 256) * 512; u.e0 = pm; u.e1 = pn; u.e2 = b; u.nt = 4; return true; }
    __device__ __forceinline__ unsigned rowoff(const Unit&, int) const { return 0u; }
};
struct SchedMoe1 {
    static constexpr bool GATHER = true;
    const char* Hh; const char* W; const int* list; const LAS unsigned* mt; int G, c;
    __device__ __forceinline__ bool next(int i, Unit& u) const {
        long L = (long)i * G + c; int e = 0;
        for (; e < 8; ++e) { const long ue = (long)mt[8 + e] * 28; if (L < ue) break; L -= ue; }
        if (e == 8) return false;
        const int m_e = (int)mt[8 + e], nti = (int)(L / m_e), mti = (int)(L % m_e);
        u.a = Hh; u.b = W + ((size_t)e * 7168 + (size_t)nti * 256) * 2048; u.e0 = e; u.e1 = mti; u.e2 = nti; u.e3 = ((int)mt[16 + e] + mti) * 256; u.nt = 16; return true; }
    __device__ __forceinline__ unsigned rowoff(const Unit& u, int r) const {
        const int li = u.e1 * 256 + r; const int ent = (li < (int)mt[u.e0]) ? list[u.e0 * LCAP + li] : 0; return (unsigned)(ent >> 1) * 2048u; }
};
__device__ __forceinline__ bool moe2_unit(long L, const LAS unsigned* mt, const char* Hid, const char* W, Unit& u) {
    int e = 0;
    for (; e < 8; ++e) { const long ue = (long)mt[8 + e] * 4; if (L < ue) break; L -= ue; }
    if (e == 8) return false;
    const int m_e = (int)mt[8 + e], nti = (int)(L / m_e), mti = (int)(L % m_e);
    u.a = Hid + (size_t)((int)mt[16 + e] + mti) * 256 * (size_t)(DFE * 2); u.b = W + ((size_t)e * 1024 + (size_t)nti * 256) * (size_t)(DFE * 2); u.e0 = e; u.e1 = mti; u.e2 = nti; u.e3 = 0; u.nt = DFE / 64; return true;
}
struct SchedMoe2 {
    static constexpr bool GATHER = false;
    const char* Hid; const char* W; const LAS unsigned* mt; int G, c;
    __device__ __forceinline__ bool next(int i, Unit& u) const { const long L = (long)i * G + c; if (L >= (long)mt[25]) return false; return moe2_unit(L, mt, Hid, W, u); }
    __device__ __forceinline__ unsigned rowoff(const Unit&, int) const { return 0u; }
};
struct SchedMoe2S {
    static constexpr bool GATHER = false;
    const char* Hid; const char* W; const LAS unsigned* mt; int G, c;
    __device__ __forceinline__ bool next(int i, Unit& u) const { const long q = (long)i * G + c; if (q >= (long)mt[26] * 7) return false;
        if (!moe2_unit((long)mt[25] + q / 7, mt, Hid, W, u)) return false; const int s = (int)(q % 7); u.a += s * 1024; u.b += s * 1024; u.e3 = (int)q; u.nt = 8; return true; }
    __device__ __forceinline__ unsigned rowoff(const Unit&, int) const { return 0u; }
};

#define EPI_ROWS(ai, m) (128 * (ai) + 64 * wr + 16 * (m) + fr)
#define EPI_COL(bj) (128 * (bj) + 32 * wc + 8 * fq)
__device__ __forceinline__ u32x4 pack_acc8(const f32x4 a, const f32x4 b) { u32x4 w; w.x = pk2(a[0], a[1]); w.y = pk2(a[2], a[3]); w.z = pk2(b[0], b[1]); w.w = pk2(b[2], b[3]); return w; }

__device__ __forceinline__ unsigned gq8(float g) { const unsigned q = (unsigned)(g * 255.f + 0.5f); return q < 1u ? 1u : q; }
__device__ __forceinline__ u32x2 pack_gate8(const f32x4 a, const f32x4 b) {
    u32x2 w; w.x = gq8(a[0]) | (gq8(a[1]) << 8) | (gq8(a[2]) << 16) | (gq8(a[3]) << 24); w.y = gq8(b[0]) | (gq8(b[1]) << 8) | (gq8(b[2]) << 16) | (gq8(b[3]) << 24); return w; }
__device__ __forceinline__ float gate8(unsigned w, int k) { return (float)((w >> (8 * k)) & 255u) * (1.f / 255.f); }
struct EpiPlain { static constexpr bool CARRY = false, LAUNDER = false;
    bf16* O; int ld;
    __device__ __forceinline__ void operator()(const f32x4 (&acc)[2][2][4][2], const Unit& u, int wr, int wc, int fr, int fq) const {
#pragma unroll
        for (int ai = 0; ai < 2; ++ai)
#pragma unroll
            for (int m = 0; m < 4; ++m) { bf16* rowp = O + (size_t)(u.e0 * 256 + EPI_ROWS(ai, m)) * ld + u.e1 * 256;
#pragma unroll
                for (int bj = 0; bj < 2; ++bj) *(u32x4*)(rowp + EPI_COL(bj)) = pack_acc8(acc[ai][bj][m][0], acc[ai][bj][m][1]); }
    }
};
struct EpiPlainSplit { static constexpr bool CARRY = false, LAUNDER = false;
    bf16* O; int ld; float* P; int nslice;
    __device__ __forceinline__ void operator()(const f32x4 (&acc)[2][2][4][2], const Unit& u, int wr, int wc, int fr, int fq) const {
        if (u.e2 == 0) {
#pragma unroll
            for (int ai = 0; ai < 2; ++ai)
#pragma unroll
                for (int m = 0; m < 4; ++m) { bf16* rowp = O + (size_t)(u.e0 * 256 + EPI_ROWS(ai, m)) * ld + u.e1 * 256;
#pragma unroll
                    for (int bj = 0; bj < 2; ++bj) *(u32x4*)(rowp + EPI_COL(bj)) = pack_acc8(acc[ai][bj][m][0], acc[ai][bj][m][1]); }
        } else { float* pt = P + (size_t)(u.e3 * nslice + (u.e2 - 1)) * 65536;
#pragma unroll
            for (int ai = 0; ai < 2; ++ai)
#pragma unroll
                for (int m = 0; m < 4; ++m)
#pragma unroll
                    for (int bj = 0; bj < 2; ++bj) { float* p = pt + EPI_ROWS(ai, m) * 256 + EPI_COL(bj); *(f32x4*)p = acc[ai][bj][m][0]; *(f32x4*)(p + 4) = acc[ai][bj][m][1]; }
        }
    }
};
struct EpiInprojA { static constexpr bool CARRY = false, LAUNDER = false;
    bf16* INP; bf16* T; unsigned char* Gc;
    __device__ __forceinline__ void operator()(const f32x4 (&acc)[2][2][4][2], const Unit& u, int wr, int wc, int fr, int fq) const {
        if (u.e2 == 2) {
#pragma unroll
            for (int ai = 0; ai < 2; ++ai)
#pragma unroll
                for (int m = 0; m < 4; ++m) { unsigned char* rowp = Gc + (size_t)(u.e0 * 256 + EPI_ROWS(ai, m)) * 4096 + u.e1 * 256;
#pragma unroll
                    for (int bj = 0; bj < 2; ++bj) { f32x4 a = acc[ai][bj][m][0], b = acc[ai][bj][m][1];
#pragma unroll
                        for (int j = 0; j < 4; ++j) { a[j] = sigm(a[j]); b[j] = sigm(b[j]); }
                        *(u32x2*)(rowp + EPI_COL(bj)) = pack_gate8(a, b); } }
        } else if (u.e2 == 0) {
            bf16* base = INP + (size_t)u.e1 * ((size_t)R * 256);
            const bool regroup = (u.e1 == 1);
#pragma unroll
            for (int ai = 0; ai < 2; ++ai)
#pragma unroll
                for (int m = 0; m < 4; ++m) { const int row = u.e0 * 256 + EPI_ROWS(ai, m);
#pragma unroll
                    for (int bj = 0; bj < 2; ++bj) { const int col = EPI_COL(bj);
                        bf16* p = regroup ? base + ((((size_t)(col >> 4) * 33 + (row >> 9)) * 16 + (row & 15)) * 64 + ((col & 8) << 2) + ((row >> 4) & 31)) * 8 : base + (size_t)row * 256 + col;
                        *(u32x4*)p = pack_acc8(acc[ai][bj][m][0], acc[ai][bj][m][1]); } }
        } else {
#pragma unroll
            for (int ai = 0; ai < 2; ++ai)
#pragma unroll
                for (int m = 0; m < 4; ++m) { bf16* rowp = T + (size_t)(u.e0 * 256 + EPI_ROWS(ai, m)) * R + u.e1 * 256;
#pragma unroll
                    for (int bj = 0; bj < 2; ++bj) *(u32x4*)(rowp + EPI_COL(bj)) = pack_acc8(acc[ai][bj][m][0], acc[ai][bj][m][1]); }
        }
    }
};
struct EpiGates { static constexpr bool CARRY = false, LAUNDER = false;
    unsigned char* Gt;
    __device__ __forceinline__ void operator()(const f32x4 (&acc)[2][2][4][2], const Unit& u, int wr, int wc, int fr, int fq) const {
#pragma unroll
        for (int ai = 0; ai < 2; ++ai)
#pragma unroll
            for (int m = 0; m < 4; ++m) { unsigned char* rowp = Gt + (size_t)(u.e0 * 256 + EPI_ROWS(ai, m)) * 4096 + u.e1 * 256;
#pragma unroll
                for (int bj = 0; bj < 2; ++bj) { f32x4 a = acc[ai][bj][m][0], b = acc[ai][bj][m][1];
#pragma unroll
                    for (int j = 0; j < 4; ++j) { a[j] = sigm(a[j]); b[j] = sigm(b[j]); }
                    *(u32x2*)(rowp + EPI_COL(bj)) = pack_gate8(a, b); } }
    }
};
struct EpiGlu { static constexpr bool CARRY = false, LAUNDER = false;
    const bf16* Zz; bf16* Mix; const float* bglu;
    __device__ __forceinline__ void operator()(const f32x4 (&acc)[2][2][4][2], const Unit& u, int wr, int wc, int fr, int fq) const {
#pragma unroll
        for (int bj = 0; bj < 2; ++bj) { const int col = EPI_COL(bj);
            const f32x4 b0 = *(const f32x4*)(bglu + col), b1 = *(const f32x4*)(bglu + col + 4);
#pragma unroll
            for (int ai = 0; ai < 2; ++ai)
#pragma unroll
                for (int m = 0; m < 4; ++m) { const size_t row = (size_t)(u.e0 * 256 + EPI_ROWS(ai, m));
                    const u32x4 zz = *(const u32x4*)(Zz + row * 256 + col);
                    f32x4 a = acc[ai][bj][m][0] + b0, b = acc[ai][bj][m][1] + b1;
                    a[0] = bflo(zz.x) * sigm(a[0]); a[1] = bfhi(zz.x) * sigm(a[1]); a[2] = bflo(zz.y) * sigm(a[2]); a[3] = bfhi(zz.y) * sigm(a[3]);
                    b[0] = bflo(zz.z) * sigm(b[0]); b[1] = bfhi(zz.z) * sigm(b[1]); b[2] = bflo(zz.w) * sigm(b[2]); b[3] = bfhi(zz.w) * sigm(b[3]);
                    *(u32x4*)(Mix + row * 1024 + 256 + col) = pack_acc8(a, b); } }
    }
};
struct EpiMerge {
    static constexpr bool CARRY = true, LAUNDER = false;
    const unsigned char* Gt; const unsigned char* Gc; bf16* Y; bf16* YP;
    __device__ __forceinline__ void carry(f32x4 (&acc)[2][2][4][2], const Unit& u, int wr, int wc, int fr, int fq) const {
        if (u.e3) {
            const int b = u.e2;
#pragma unroll
            for (int ai = 0; ai < 2; ++ai)
#pragma unroll
                for (int m = 0; m < 4; ++m) { const size_t rc = (size_t)((u.e0 - 64) * 256 + EPI_ROWS(ai, m));
#pragma unroll
                    for (int bj = 0; bj < 2; ++bj) { const int col = u.e1 * 256 + EPI_COL(bj); const u32x2 g = *(const u32x2*)(Gc + rc * 4096 + b * 1024 + col);
                        f32x4 a0 = acc[ai][bj][m][0], a1 = acc[ai][bj][m][1];
#pragma unroll
                        for (int j = 0; j < 4; ++j) { a0[j] *= gate8(g.x, j); a1[j] *= gate8(g.y, j); }
                        *(u32x4*)(YP + ((size_t)b * CROWS + rc) * 1024 + col) = pack_acc8(a0, a1); acc[ai][bj][m][0] = (f32x4){0.f, 0.f, 0.f, 0.f}; acc[ai][bj][m][1] = (f32x4){0.f, 0.f, 0.f, 0.f}; } }
            return; }
        const int b = u.e2, bn = b < 3 ? b + 1 : 3;
        u32x2 g[2][4][2], gn[2][4][2];
#pragma unroll
        for (int ai = 0; ai < 2; ++ai)
#pragma unroll
            for (int m = 0; m < 4; ++m) { const size_t row = (size_t)(u.e0 * 256 + EPI_ROWS(ai, m));
                const unsigned char* grow = (u.e0 < 64 ? Gt + row * 4096 : Gc + (row - LROWS) * 4096) + u.e1 * 256;
#pragma unroll
                for (int bj = 0; bj < 2; ++bj) { g[ai][m][bj] = *(const u32x2*)(grow + b * 1024 + EPI_COL(bj)); gn[ai][m][bj] = *(const u32x2*)(grow + bn * 1024 + EPI_COL(bj)); } }
#pragma unroll
        for (int ai = 0; ai < 2; ++ai)
#pragma unroll
            for (int m = 0; m < 4; ++m) { const size_t row = (size_t)(u.e0 * 256 + EPI_ROWS(ai, m));
#pragma unroll
                for (int bj = 0; bj < 2; ++bj) { const int col = u.e1 * 256 + EPI_COL(bj);
                    f32x4 a0 = acc[ai][bj][m][0], a1 = acc[ai][bj][m][1];
#pragma unroll
                    for (int j = 0; j < 4; ++j) { a0[j] *= gate8(g[ai][m][bj].x, j); a1[j] *= gate8(g[ai][m][bj].y, j); }
                    if (b != 3) {
#pragma unroll
                        for (int j = 0; j < 4; ++j) { a0[j] *= rcpf_(gate8(gn[ai][m][bj].x, j)); a1[j] *= rcpf_(gate8(gn[ai][m][bj].y, j)); }
                        acc[ai][bj][m][0] = a0; acc[ai][bj][m][1] = a1; }
                    else { *(u32x4*)(Y + row * 1024 + col) = pack_acc8(a0, a1); acc[ai][bj][m][0] = (f32x4){0.f, 0.f, 0.f, 0.f}; acc[ai][bj][m][1] = (f32x4){0.f, 0.f, 0.f, 0.f}; } } }
    }
};
struct EpiSwiglu { static constexpr bool CARRY = false, LAUNDER = false;
    bf16* Hd; int ldh; bool moe;
    __device__ __forceinline__ void operator()(const f32x4 (&acc)[2][2][4][2], const Unit& u, int wr, int wc, int fr, int fq) const {
        const int rowbase = moe ? u.e3 : u.e0 * 256, pn = moe ? u.e2 : u.e1;
#pragma unroll
        for (int ai = 0; ai < 2; ++ai)
#pragma unroll
            for (int m = 0; m < 4; ++m) { bf16* p = Hd + (size_t)(rowbase + EPI_ROWS(ai, m)) * ldh + pn * 128 + 32 * wc + 8 * fq;
                f32x4 a = acc[ai][0][m][0], b = acc[ai][0][m][1]; const f32x4 ua = acc[ai][1][m][0], ub = acc[ai][1][m][1];
#pragma unroll
                for (int j = 0; j < 4; ++j) { a[j] = silu_(a[j]) * ua[j]; b[j] = silu_(b[j]) * ub[j]; }
                *(u32x4*)p = pack_acc8(a, b); }
    }
};
struct EpiMoeDown { static constexpr bool CARRY = false, LAUNDER = false;
    bf16* Slot; const int* list; const float* routew; const LAS unsigned* mt;
    __device__ __forceinline__ void operator()(const f32x4 (&acc)[2][2][4][2], const Unit& u, int wr, int wc, int fr, int fq) const {
        const int cnt = (int)mt[u.e0];
#pragma unroll
        for (int ai = 0; ai < 2; ++ai)
#pragma unroll
            for (int m = 0; m < 4; ++m) { const int li = u.e1 * 256 + EPI_ROWS(ai, m);
                if (li < cnt) { const int ent = list[u.e0 * LCAP + li]; const float w = routew[ent];
                    bf16* rowp = Slot + ((size_t)(ent & 1) * LROWS + (size_t)(ent >> 1)) * 1024 + u.e2 * 256;
#pragma unroll
                    for (int bj = 0; bj < 2; ++bj) *(u32x4*)(rowp + EPI_COL(bj)) = pack_acc8(acc[ai][bj][m][0] * w, acc[ai][bj][m][1] * w); } }
    }
};
struct EpiMoePart { static constexpr bool CARRY = false, LAUNDER = true;
    bf16* Pm; const int* list; const LAS unsigned* mt; int* smap;
    __device__ __forceinline__ void operator()(const f32x4 (&acc)[2][2][4][2], const Unit& u, int wr, int wc, int fr, int fq) const {
        const int cnt = (int)mt[u.e0], q = u.e3; bf16* pt = Pm + (size_t)q * 65536; const bool mapper = (q % 7 == 0) && wc == 0 && fq == 0;
#pragma unroll
        for (int ai = 0; ai < 2; ++ai)
#pragma unroll
            for (int m = 0; m < 4; ++m) { const int rl = EPI_ROWS(ai, m), li = u.e1 * 256 + rl;
#pragma unroll
                for (int bj = 0; bj < 2; ++bj) *(u32x4*)(pt + rl * 256 + EPI_COL(bj)) = pack_acc8(acc[ai][bj][m][0], acc[ai][bj][m][1]);
                if (mapper && li < cnt) smap[list[u.e0 * LCAP + li] * 4 + u.e2] = ((q / 7) << 8) | rl; }
    }
};
}
#define DROW(reg, h) (((reg) & 3) + 8 * ((reg) >> 2) + 4 * (h))

__device__ __forceinline__ void s5_state_item(const bf16* M1F  , const bf16* SUF, float* HLOC, int item, int lane) {
    const int cb = item % 33, gd = item / 33, g = gd >> 1, dir = gd & 1, li = lane & 31, h = lane >> 5;
    const bf16* A = M1F + (size_t)(g * 2 + dir) * 128 * 256 + lane * 8;
    const bf16* B = SUF + (size_t)(g * 33 + cb) * 16 * 512 + lane * 8;
    f32x16 acc[4];
#pragma unroll
    for (int rt = 0; rt < 4; ++rt) acc[rt] = zero16();
    bf16x8 a0[2][4], b0[2], a1[2][4], b1[2];
#define S5S_LOAD(AA, BB, grp) do { _Pragma("unroll") for (int s = 0; s < 2; ++s) { const int ks = (grp) * 2 + s; BB[s] = ldg8(B + ks * 512); \
        _Pragma("unroll") for (int rt = 0; rt < 4; ++rt) AA[s][rt] = ldg8(A + (ks * 4 + rt) * 512); } } while (0)
#define S5S_MMA(AA, BB) do { _Pragma("unroll") for (int s = 0; s < 2; ++s) _Pragma("unroll") for (int rt = 0; rt < 4; ++rt) acc[rt] = mma32(AA[s][rt], BB[s], acc[rt]); } while (0)
    S5S_LOAD(a0, b0, 0);
#pragma unroll 1
    for (int gp = 0; gp < 8; gp += 2) {
        S5S_LOAD(a1, b1, gp + 1);
        S5S_MMA(a0, b0);
        if (gp + 2 < 8) S5S_LOAD(a0, b0, gp + 2);
        S5S_MMA(a1, b1);
    }
#undef S5S_LOAD
#undef S5S_MMA
    float* o = HLOC + ((size_t)(g * 2 + dir) * NCH16 + cb * 32 + li) * 128;
#pragma unroll
    for (int rt = 0; rt < 4; ++rt)
#pragma unroll
        for (int q = 0; q < 4; ++q) *(f32x4*)(o + rt * 32 + 8 * q + 4 * h) = (f32x4){acc[rt][4 * q], acc[rt][4 * q + 1], acc[rt][4 * q + 2], acc[rt][4 * q + 3]};
}
__device__ __forceinline__ void s5_scan_item(const float* A16  , const float* HLOC, bf16* HIN, int item, int lane) {
    const int dir = item & 1, g = (item >> 1) & 15, b = item >> 5, p = lane;
    const f32x2 a = *(const f32x2*)(A16 + ((size_t)(dir * 16 + g) * 64 + p) * 2);
    const float* src = HLOC + (size_t)(g * 2 + dir) * NCH16 * 128 + 2 * p;
    const int k2 = dir * 128 + 2 * p; bf16* dst = HIN + ((size_t)g * 33 * 16 + (k2 >> 4)) * 512 + ((k2 >> 3) & 1) * 256 + (k2 & 7);
    float hr = 0.f, hi = 0.f;
#define S5_CH(s) ((s) < 16 ? 1024 + 16 * b + (dir ? 15 - (s) : (s)) : 512 * b + (dir ? 511 - ((s) - 16) : (s) - 16))
    f32x2 v[32], w[32];
#pragma unroll
    for (int j = 0; j < 32; ++j) v[j] = *(const f32x2*)(src + (size_t)S5_CH(j) * 128);
    for (int s0 = 0; s0 < 528; s0 += 32) {
        const int nb = 528 - s0 < 32 ? 528 - s0 : 32;
        if (s0 + 32 < 528) {
#pragma unroll
            for (int j = 0; j < 32; ++j) { const int s = s0 + 32 + j; w[j] = *(const f32x2*)(src + (size_t)S5_CH(s < 528 ? s : 527) * 128); } }
#pragma unroll
        for (int j = 0; j < 32; ++j) if (j < nb) { const int c = S5_CH(s0 + j);
            *(unsigned*)(dst + (size_t)(c >> 5) * 8192 + (c & 31) * 8) = pk2(hr, hi);
            const float nr = a.x * hr - a.y * hi + v[j].x, ni = a.x * hi + a.y * hr + v[j].y; hr = nr; hi = ni; }
#pragma unroll
        for (int j = 0; j < 32; ++j) v[j] = w[j];
    }
#undef S5_CH
}
__device__ __forceinline__ void s5_out_item(const bf16* TABF  , const bf16* SUF, const bf16* HINF, bf16* Z, int item, int lane) {
    const int mh = item & 1, it2 = item >> 1, cb = it2 % 33, g = it2 / 33, li = lane & 31, h = lane >> 5, c = cb * 32 + li;
    const bf16* A = TABF + ((size_t)g * 256 + mh * 128) * 512 + lane * 8;
    const bf16* B0 = SUF + (size_t)(g * 33 + cb) * 16 * 512 + lane * 8;
    const bf16* B1 = HINF + (size_t)(g * 33 + cb) * 16 * 512 + lane * 8;
    f32x16 acc[4];
#pragma unroll
    for (int rt = 0; rt < 4; ++rt) acc[rt] = zero16();
    bf16x8 a0[2][4], b0[2], a1[2][4], b1[2];
#define S5O_LOAD(AA, BB, grp) do { _Pragma("unroll") for (int s = 0; s < 2; ++s) { const int ks = (grp) * 2 + s; BB[s] = ldg8((ks < 16 ? B0 + ks * 512 : B1 + (ks - 16) * 512)); \
        _Pragma("unroll") for (int rt = 0; rt < 4; ++rt) AA[s][rt] = ldg8(A + (ks * 4 + rt) * 512); } } while (0)
#define S5O_MMA(AA, BB) do { _Pragma("unroll") for (int s = 0; s < 2; ++s) _Pragma("unroll") for (int rt = 0; rt < 4; ++rt) acc[rt] = mma32(AA[s][rt], BB[s], acc[rt]); } while (0)
    S5O_LOAD(a0, b0, 0);
#pragma unroll 1
    for (int gp = 0; gp < 16; gp += 2) {
        S5O_LOAD(a1, b1, gp + 1);
        S5O_MMA(a0, b0);
        if (gp + 2 < 16) S5O_LOAD(a0, b0, gp + 2);
        S5O_MMA(a1, b1);
    }
#undef S5O_LOAD
#undef S5O_MMA
#pragma unroll
    for (int rt = 0; rt < 4; ++rt)
#pragma unroll
        for (int q = 0; q < 4; ++q) {
            const int i = 8 * mh + 2 * rt + (q >> 1), ho0 = 8 * (q & 1) + 4 * h;
            u32x2 w; w.x = pk2(gelu_tanh(acc[rt][4 * q]), gelu_tanh(acc[rt][4 * q + 1])); w.y = pk2(gelu_tanh(acc[rt][4 * q + 2]), gelu_tanh(acc[rt][4 * q + 3]));
            *(u32x2*)(Z + ((size_t)c * 16 + i) * 256 + g * 16 + ho0) = w; }
}

__device__ __forceinline__ int ret_tok0(int b, int n) { return n < 64 ? b * SEQ + n * 128 : LROWS + b * CTXL + (n - 64) * 128; }
__device__ __forceinline__ void ret_kv_item(const bf16* RKT, const bf16* RVT, const float* COST, const float* SINT, const float* decay  , float* KV, int item, int lane) {
    const int n = item % 66, bh = item / 66, hd = bh & 3, b = bh >> 2, li = lane & 31, h = lane >> 5;
    const int tok0 = ret_tok0(b, n); const bool lat = n < 64;
    const float lgf = -log2f(1.f + __expf(-decay[hd])), lgr = -log2f(1.f + __expf(-decay[4 + hd]));
    f32x16 acc[2][2][2];
#pragma unroll
    for (int a = 0; a < 2; ++a)
#pragma unroll
        for (int c = 0; c < 2; ++c)
#pragma unroll
            for (int d = 0; d < 2; ++d) acc[a][c][d] = zero16();
    const bf16* k0p = RKT + (size_t)(hd * 64 + li) * R + tok0 + 8 * h;
    const bf16* v0p = RVT + (size_t)(hd * 64 + li) * R + tok0 + 8 * h;
#pragma unroll 2
    for (int ks = 0; ks < 8; ++ks) {
        float k1[8], k2[8];
        unpack8(ldg8(k0p + ks * 16), k1); unpack8(ldg8(k0p + (size_t)32 * R + ks * 16), k2);
        if (lat) {
            const float* cp = COST + (size_t)li * SEQ + n * 128 + ks * 16 + 8 * h; const float* sp = SINT + (size_t)li * SEQ + n * 128 + ks * 16 + 8 * h;
            const f32x4 c0 = *(const f32x4*)cp, c1 = *(const f32x4*)(cp + 4), s0 = *(const f32x4*)sp, s1 = *(const f32x4*)(sp + 4);
#pragma unroll
            for (int j = 0; j < 8; ++j) { const float cc = j < 4 ? c0[j & 3] : c1[j & 3], ss = j < 4 ? s0[j & 3] : s1[j & 3];
                const float x1 = k1[j], x2 = k2[j]; k1[j] = x1 * cc - x2 * ss; k2[j] = x1 * ss + x2 * cc; }
        }
        const bf16x8 vf0 = ldg8(v0p + ks * 16), vf1 = ldg8(v0p + (size_t)32 * R + ks * 16);
#pragma unroll
        for (int dir = 0; dir < 2; ++dir) {
            float a1[8], a2[8];
#pragma unroll
            for (int j = 0; j < 8; ++j) { const int i = ks * 16 + 8 * h + j; const float w = dir == 0 ? ex2(lgf * (float)(127 - i)) : ex2(lgr * (float)i); a1[j] = k1[j] * w; a2[j] = k2[j] * w; }
            const bf16x8 kd0 = pack8(a1), kd1 = pack8(a2);
            acc[dir][0][0] = mma32(kd0, vf0, acc[dir][0][0]); acc[dir][0][1] = mma32(kd0, vf1, acc[dir][0][1]);
            acc[dir][1][0] = mma32(kd1, vf0, acc[dir][1][0]); acc[dir][1][1] = mma32(kd1, vf1, acc[dir][1][1]);
        }
    }
#pragma unroll
    for (int dir = 0; dir < 2; ++dir) { float* o = KV + ((size_t)((b * 4 + hd) * 2 + dir) * 66 + n) * 4096;
#pragma unroll
        for (int dt = 0; dt < 2; ++dt)
#pragma unroll
            for (int et = 0; et < 2; ++et)
#pragma unroll
                for (int q = 0; q < 4; ++q) *(f32x4*)(o + (size_t)(et * 32 + li) * 64 + dt * 32 + 8 * q + 4 * h) = (f32x4){acc[dir][dt][et][4 * q], acc[dir][dt][et][4 * q + 1], acc[dir][dt][et][4 * q + 2], acc[dir][dt][et][4 * q + 3]}; }
}
__device__ __forceinline__ void ret_scan_item(const float* decay, const float* KV, bf16* SPREV, int item, int lane) {
    const int blk = item & 63, bhd = item >> 6, dir = bhd & 1, hd = (bhd >> 1) & 3, idx = blk * 64 + lane;
    const float lg = -log2f(1.f + __expf(-decay[dir * 4 + hd])), cd = ex2(128.f * lg);
    const float* src = KV + (size_t)bhd * 66 * 4096 + idx; bf16* dst = SPREV + (size_t)bhd * 66 * 4096 + idx;
    float s = 0.f;
    for (int s0 = 0; s0 < 66; s0 += 11) {
        float v[11];
#pragma unroll
        for (int j = 0; j < 11; ++j) { const int t = s0 + j; const int n = dir == 0 ? (t < 2 ? 64 + t : t - 2) : (t < 2 ? 65 - t : 65 - t); v[j] = src[(size_t)n * 4096]; }
#pragma unroll
        for (int j = 0; j < 11; ++j) { const int t = s0 + j; const int n = dir == 0 ? (t < 2 ? 64 + t : t - 2) : (t < 2 ? 65 - t : 65 - t); dst[(size_t)n * 4096] = (bf16)(pk2(s, 0.f) & 0xffffu); s = cd * s + v[j]; }
    }
}
struct KVTile { u32x4 k[4], v[4]; };
__device__ __forceinline__ void kv_tile_load(KVTile& T, const bf16* Kh  , const bf16* VTh  , int tok0, int lane) {
#pragma unroll
    for (int i = 0; i < 4; ++i) T.k[i] = *(const u32x4*)(Kh + (size_t)(tok0 + 8 * i + (lane >> 3)) * 256 + (lane & 7) * 8);
#pragma unroll
    for (int i = 0; i < 4; ++i) T.v[i] = *(const u32x4*)(VTh + (size_t)(16 * i + (lane >> 2)) * R + tok0 + (lane & 3) * 8);
}
__device__ __forceinline__ void kv_tile_store(const KVTile& T, LAS unsigned char* wl, int lane) {
#pragma unroll
    for (int i = 0; i < 4; ++i) *(LAS u32x4*)(wl + (8 * i + (lane >> 3)) * 144 + (lane & 7) * 16) = T.k[i];
#pragma unroll
    for (int i = 0; i < 4; ++i) *(LAS u32x4*)(wl + 4608 + (16 * i + (lane >> 2)) * 80 + (lane & 3) * 16) = T.v[i];
}
__device__ __forceinline__ void kv_tile_frags(const LAS unsigned char* wl, int lane, bf16x8 (&kf)[4], bf16x8 (&vf)[2][2]) {
    const int li = lane & 31, h = lane >> 5;
#pragma unroll
    for (int s = 0; s < 4; ++s) kf[s] = *(const LAS bf16x8*)(wl + li * 144 + (2 * s + h) * 16);
#pragma unroll
    for (int et = 0; et < 2; ++et)
#pragma unroll
        for (int s2 = 0; s2 < 2; ++s2) { const LAS unsigned char* p = wl + 4608 + (et * 32 + li) * 80 + s2 * 32 + 8 * h;
            const bf16x4 lo = *(const LAS bf16x4*)p, hi = *(const LAS bf16x4*)(p + 16); vf[et][s2] = __builtin_shufflevector(lo, hi, 0, 1, 2, 3, 4, 5, 6, 7); }
}

__device__ __forceinline__ void rope_item(bf16* RQ, bf16* RK, const float* COSN, const float* SINN, int item, int lane) {
    const int u = lane & 15, off = (u >> 2) * 64 + (u & 3) * 8, c8 = (u & 3) * 8;
#pragma unroll 4
    for (int st = 0; st < 32; ++st) { const int row = item * 128 + 4 * st + (lane >> 4), tl = row & (SEQ - 1);
        const f32x4 c0 = *(const f32x4*)(COSN + (size_t)tl * 32 + c8), c1 = *(const f32x4*)(COSN + (size_t)tl * 32 + c8 + 4), s0 = *(const f32x4*)(SINN + (size_t)tl * 32 + c8), s1 = *(const f32x4*)(SINN + (size_t)tl * 32 + c8 + 4);
#pragma unroll
        for (int w = 0; w < 2; ++w) { bf16* p = (w ? RK : RQ) + (size_t)row * 256 + off; float x1[8], x2[8]; unpack8(*(const bf16x8*)p, x1); unpack8(*(const bf16x8*)(p + 32), x2);
#pragma unroll
            for (int j = 0; j < 8; ++j) { const float cc = j < 4 ? c0[j & 3] : c1[j & 3], ss = j < 4 ? s0[j & 3] : s1[j & 3]; const float a = x1[j], bb = x2[j]; x1[j] = a * cc - bb * ss; x2[j] = a * ss + bb * cc; }
            *(bf16x8*)p = pack8(x1); *(bf16x8*)(p + 32) = pack8(x2); } }
}
__device__ __forceinline__ void ret_out_item(const bf16* RQ, const bf16* RK, const bf16* RG, const bf16* RVT, const bf16* SPREV, const float* decay, const float* gn  , bf16* MIX,
                                             LAS unsigned char* wl, int item, int lane) {
    const int qb = item & 3, it2 = item >> 2, n = it2 % 66, bh = it2 / 66, hd = bh & 3, b = bh >> 2, li = lane & 31, h = lane >> 5;
    const int tok0 = ret_tok0(b, n);
    const float lgf = -log2f(1.f + __expf(-decay[hd])), lgr = -log2f(1.f + __expf(-decay[4 + hd]));
    const int iq = qb * 32 + li;
    const bf16* Kh = RK + hd * 64; const bf16* VTh = RVT + (size_t)hd * 64 * R;
    KVTile T; kv_tile_load(T, Kh, VTh, tok0, lane);
    bf16x8 qf[4];
    { const bf16* qp = RQ + (size_t)(tok0 + iq) * 256 + hd * 64 + 8 * h;
#pragma unroll
      for (int s = 0; s < 4; ++s) qf[s] = ldg8(qp + 16 * s); }
    kv_tile_store(T, wl, lane);
    f32x16 accO[2] = {zero16(), zero16()};
#pragma unroll 1
    for (int kt = 0; kt < 4; ++kt) {
        kv_tile_load(T, Kh, VTh, tok0 + (kt < 3 ? kt + 1 : kt) * 32, lane);
        bf16x8 kf[4], vf[2][2]; kv_tile_frags(wl, lane, kf, vf);
        f32x16 st = zero16();
#pragma unroll
        for (int s = 0; s < 4; ++s) st = mma32(kf[s], qf[s], st);
#pragma unroll
        for (int r = 0; r < 16; ++r) { const int j = kt * 32 + DROW(r, h), df = iq - j;
            const float w = df > 0 ? ex2(lgf * (float)df) : (df < 0 ? ex2(lgr * (float)(-df)) : 2.f); st[r] *= w; }
        const bf16x8 p0 = accB<0>(st), p1 = accB<1>(st);
        accO[0] = mma32(vf[0][0], p0, accO[0]); accO[0] = mma32(vf[0][1], p1, accO[0]); accO[1] = mma32(vf[1][0], p0, accO[1]); accO[1] = mma32(vf[1][1], p1, accO[1]);
        kv_tile_store(T, wl, lane);
    }
    const float cf = ex2(lgf * (float)(iq + 1)), cr = ex2(lgr * (float)(128 - iq));
#pragma unroll
    for (int dir = 0; dir < 2; ++dir) { const bf16* sp = SPREV + ((size_t)((b * 4 + hd) * 2 + dir) * 66 + n) * 4096;
#pragma unroll
        for (int et = 0; et < 2; ++et) { f32x16 a = zero16();
#pragma unroll
            for (int s = 0; s < 4; ++s) a = mma32(ldg8(sp + (size_t)(et * 32 + li) * 64 + 16 * s + 8 * h), qf[s], a);
            const float sc = dir == 0 ? cf : cr;
#pragma unroll
            for (int r = 0; r < 16; ++r) accO[et][r] += sc * a[r]; } }
    float s1 = 0.f;
#pragma unroll
    for (int et = 0; et < 2; ++et)
#pragma unroll
        for (int r = 0; r < 16; ++r) s1 += accO[et][r];
    s1 = xor32_sum(s1); const float mu = s1 * (1.f / 64.f);
    float s2 = 0.f;
#pragma unroll
    for (int et = 0; et < 2; ++et)
#pragma unroll
        for (int r = 0; r < 16; ++r) { const float dlt = accO[et][r] - mu; s2 += dlt * dlt; }
    s2 = xor32_sum(s2); const float rstd = __builtin_amdgcn_rsqf(s2 * (1.f / 64.f) + EPSN);
    const size_t tok = (size_t)(tok0 + iq);
#pragma unroll
    for (int et = 0; et < 2; ++et)
#pragma unroll
        for (int q = 0; q < 4; ++q) { const int e0 = hd * 64 + et * 32 + 8 * q + 4 * h;
            const f32x4 gv = *(const f32x4*)(gn + e0); const u32x2 gg = *(const u32x2*)(RG + tok * 256 + e0);
            const float g0 = bflo(gg.x), g1 = bfhi(gg.x), g2 = bflo(gg.y), g3 = bfhi(gg.y);
            u32x2 w; w.x = pk2(silu_(g0) * (accO[et][4 * q] - mu) * rstd * gv[0], silu_(g1) * (accO[et][4 * q + 1] - mu) * rstd * gv[1]);
            w.y = pk2(silu_(g2) * (accO[et][4 * q + 2] - mu) * rstd * gv[2], silu_(g3) * (accO[et][4 * q + 3] - mu) * rstd * gv[3]);
            *(u32x2*)(MIX + tok * 1024 + 512 + e0) = w; }
}

__device__ __forceinline__ int na_tile_tok(int t, int b, int rs) { const int tb = t - 8; return t >= 8 ? b * SEQ + (rs + (tb >> 1)) * 64 + (tb & 1) * 32 : LROWS + b * CTXL + t * 32; }
__device__ __forceinline__ void na_item(const bf16* NQ, const bf16* NK, const bf16* NVT, bf16* MIX, const LAS float* rpb2, LAS unsigned char* wl, bool ctxq, int b, int r, int hd, int qs, int lane) {
    const int li = lane & 31, h = lane >> 5;
    const int tokq = ctxq ? LROWS + b * CTXL + qs * 32 + li : b * SEQ + r * 64 + qs * 32 + li;
    bf16x8 qf[4];
#pragma unroll
    for (int s = 0; s < 4; ++s) qf[s] = ldg8(NQ + (size_t)tokq * 256 + hd * 64 + 16 * s + 8 * h);
    float mrun = -1e30f, lrun = 0.f;
    f32x16 accO[2] = {zero16(), zero16()};
    const int rs = r - 4 < 0 ? 0 : (r - 4 > 120 ? 120 : r - 4);
    const int qc = qs * 32 + li, cs = qc - 8 < 0 ? 0 : (qc - 8 > 48 ? 48 : qc - 8);
    const int ntile = ctxq ? 8 : 24;
    const float c1 = 0.125f * LOG2E;
    const bf16* Kh = NK + hd * 64; const bf16* VTh = NVT + (size_t)hd * 64 * R;
    KVTile T; kv_tile_load(T, Kh, VTh, na_tile_tok(0, b, rs), lane); kv_tile_store(T, wl, lane);
#pragma unroll 1
    for (int t = 0; t < ntile; ++t) {
        const bool band = t >= 8; const int tb = t - 8, rr = rs + (tb >> 1), ct = tb & 1;
        kv_tile_load(T, Kh, VTh, na_tile_tok(t + 1 < ntile ? t + 1 : t, b, rs), lane);
        bf16x8 kf[4], vf[2][2]; kv_tile_frags(wl, lane, kf, vf);
        f32x16 st = zero16();
#pragma unroll
        for (int s = 0; s < 4; ++s) st = mma32(kf[s], qf[s], st);
        float mt = -INFINITY;
        if (band) { const int dr = rr - r + 7; const LAS float* bp = rpb2 + ((hd * 15 + dr) * 31 + 32 * ct - qc + 15 + 4 * h); const int d0 = 32 * ct + 4 * h - cs;
#pragma unroll
            for (int g = 0; g < 16; ++g) { const int o = 8 * (g >> 2) + (g & 3); const bool inw = (unsigned)(d0 + o) < 16u;
                const float v = inw ? st[g] * c1 + bp[o] : -INFINITY; st[g] = v; mt = fmaxf(mt, v); }
        } else {
#pragma unroll
            for (int g = 0; g < 16; ++g) { const float v = st[g] * c1; st[g] = v; mt = fmaxf(mt, v); }
        }
        mt = xor32_max(mt);
        const float mnew = fmaxf(mrun, mt);
        if (__builtin_amdgcn_ballot_w64(mnew > mrun)) { const float alpha = ex2(mrun - mnew); lrun *= alpha;
#pragma unroll
            for (int et = 0; et < 2; ++et)
#pragma unroll
                for (int g = 0; g < 16; ++g) accO[et][g] *= alpha; }
        mrun = mnew;
        float ps = 0.f;
#pragma unroll
        for (int g = 0; g < 16; ++g) { const float p = ex2(st[g] - mnew); st[g] = p; ps += p; }
        lrun += xor32_sum(ps);
        const bf16x8 p0 = accB<0>(st), p1 = accB<1>(st);
        accO[0] = mma32(vf[0][0], p0, accO[0]); accO[0] = mma32(vf[0][1], p1, accO[0]); accO[1] = mma32(vf[1][0], p0, accO[1]); accO[1] = mma32(vf[1][1], p1, accO[1]);
        kv_tile_store(T, wl, lane);
    }
    const float inv = 1.f / lrun;
#pragma unroll
    for (int et = 0; et < 2; ++et)
#pragma unroll
        for (int q = 0; q < 4; ++q) { u32x2 w; w.x = pk2(accO[et][4 * q] * inv, accO[et][4 * q + 1] * inv); w.y = pk2(accO[et][4 * q + 2] * inv, accO[et][4 * q + 3] * inv);
            *(u32x2*)(MIX + (size_t)tokq * 1024 + 768 + hd * 64 + et * 32 + 8 * q + 4 * h) = w; }
}

__device__ __forceinline__ void fft1_item(const bf16* F, const bf16* W128T, const float* TWC, const float* TWS, bf16* FB, int item, int lane) {
    const int l2 = item & 63, g = (item >> 6) & 3, b = item >> 8, li = lane & 31, h = lane >> 5;
    bf16x8 idf[4];
#pragma unroll
    for (int s = 0; s < 4; ++s) { float v[8];
#pragma unroll
        for (int j = 0; j < 8; ++j) v[j] = (16 * (s & 1) + 8 * h + j == li) ? 1.f : 0.f;
        idf[s] = pack8(v); }
    bf16x8 xb[4][2][2];
#pragma unroll
    for (int lt = 0; lt < 4; ++lt) {
        const bf16* xp = F + (size_t)(b * SEQ + 64 * (lt * 32 + li) + l2) * 256 + g * 64 + 8 * h;
        const bf16x8 x0 = ldg8(xp), x1 = ldg8(xp + 16), x2 = ldg8(xp + 32), x3 = ldg8(xp + 48);
        f32x16 c0 = zero16(), c1 = zero16();
        c0 = mma32(x0, idf[0], c0); c0 = mma32(x1, idf[1], c0);
        c1 = mma32(x2, idf[0], c1); c1 = mma32(x3, idf[1], c1);
        xb[lt][0][0] = accB<0>(c0); xb[lt][0][1] = accB<1>(c0); xb[lt][1][0] = accB<0>(c1); xb[lt][1][1] = accB<1>(c1);
    }
#pragma unroll 1
    for (int kb = 0; kb < 4; ++kb) {
        f32x16 acc[2][2];
#pragma unroll
        for (int ri = 0; ri < 2; ++ri) { acc[ri][0] = zero16(); acc[ri][1] = zero16();
            const bf16* wp = W128T + ((size_t)ri * 128 + kb * 32 + li) * 128 + 4 * h;
#pragma unroll
            for (int lt = 0; lt < 4; ++lt)
#pragma unroll
                for (int s = 0; s < 2; ++s) { const bf16x8 wf = ldg8p(wp + lt * 32 + 16 * s);
                    acc[ri][0] = mma32(wf, xb[lt][0][s], acc[ri][0]); acc[ri][1] = mma32(wf, xb[lt][1][s], acc[ri][1]); } }
#pragma unroll
        for (int q = 0; q < 4; ++q) { const int k1 = kb * 32 + 8 * q + 4 * h;
            const f32x4 tc = *(const f32x4*)(TWC + l2 * 128 + k1), ts = *(const f32x4*)(TWS + l2 * 128 + k1);
#pragma unroll
            for (int j = 0; j < 4; ++j)
#pragma unroll
                for (int ct = 0; ct < 2; ++ct) { const float ar = acc[0][ct][4 * q + j], ai = acc[1][ct][4 * q + j];
                    const float br = ar * tc[j] + ai * ts[j], bi = ai * tc[j] - ar * ts[j];
                    bf16* o = FB + ((((size_t)(b * 4 + g) * 128 + k1 + j) * 2) * 64 + l2) * 64 + ct * 32 + li;
                    o[0] = (bf16)(pk2(br, 0.f) & 0xffffu); o[64 * 64] = (bf16)(pk2(bi, 0.f) & 0xffffu); } }
    }
}
__device__ __forceinline__ void fft2_item(const bf16* FB, const bf16* FCT, const bf16* W64T, bf16* MIX, int item, int lane) {
    const int mh = item & 1, k1 = (item >> 1) & 127, g = (item >> 8) & 3, b = item >> 10, li = lane & 31, h = lane >> 5;
    const bf16* br = FB + (((size_t)(b * 4 + g) * 128 + k1) * 2) * 64 * 64; const bf16* bi = br + 64 * 64;
    const bf16* fc = FCT + (size_t)(mh * 32 + li) * 64 + 8 * h; const bf16* fs = fc + 64 * 64; const bf16* fn = fc + 2 * 64 * 64;
    bf16x8 eb[2][2][2];
#pragma unroll
    for (int lt = 0; lt < 2; ++lt) { f32x16 er = zero16(), ei = zero16();
#pragma unroll
        for (int s = 0; s < 4; ++s) { const bf16x8 ar = ldg8(br + (size_t)(lt * 32 + li) * 64 + 16 * s + 8 * h), ai = ldg8(bi + (size_t)(lt * 32 + li) * 64 + 16 * s + 8 * h);
            const bf16x8 c = ldg8(fc + 16 * s), sn = ldg8(fs + 16 * s), ns = ldg8(fn + 16 * s);
            er = mma32(ar, c, er); er = mma32(ai, sn, er); ei = mma32(ai, c, ei); ei = mma32(ar, ns, ei); }
        eb[lt][0][0] = accB<0>(er); eb[lt][0][1] = accB<1>(er); eb[lt][1][0] = accB<0>(ei); eb[lt][1][1] = accB<1>(ei); }
#pragma unroll
    for (int kt = 0; kt < 2; ++kt) { f32x16 o = zero16();
        const bf16* wc = W64T + (size_t)(kt * 32 + li) * 64 + 4 * h; const bf16* wsn = wc + 64 * 64;
#pragma unroll
        for (int lt = 0; lt < 2; ++lt)
#pragma unroll
            for (int s = 0; s < 2; ++s) { o = mma32(ldg8p(wc + lt * 32 + 16 * s), eb[lt][0][s], o); o = mma32(ldg8p(wsn + lt * 32 + 16 * s), eb[lt][1][s], o); }
#pragma unroll
        for (int rg = 0; rg < 16; ++rg) { const int k2 = kt * 32 + DROW(rg, h);
            MIX[(size_t)(b * SEQ + k1 + 128 * k2) * 1024 + g * 64 + mh * 32 + li] = (bf16)(pk2(o[rg], 0.f) & 0xffffu); } }
}
__device__ __forceinline__ void fftc_item(const bf16* F, const bf16* FCT, const bf16* W256T, bf16* MIX, int item, int lane) {
    const int mh = item & 1, kb = (item >> 1) & 7, g = (item >> 4) & 3, b = item >> 6, li = lane & 31, h = lane >> 5;
    const bf16* fc = FCT + (size_t)(mh * 32 + li) * 64 + 8 * h; const bf16* fn = fc + 2 * 64 * 64;
    const bf16* wc = W256T + (size_t)(kb * 32 + li) * 256 + 4 * h; const bf16* wsn = wc + 256 * 256;
    f32x16 o = zero16();
#pragma unroll 1
    for (int lt = 0; lt < 8; ++lt) { f32x16 zr = zero16(), zi = zero16();
        const bf16* xp = F + (size_t)(LROWS + b * CTXL + lt * 32 + li) * 256 + g * 64 + 8 * h;
#pragma unroll
        for (int s = 0; s < 4; ++s) { const bf16x8 x = ldg8(xp + 16 * s); zr = mma32(x, ldg8(fc + 16 * s), zr); zi = mma32(x, ldg8(fn + 16 * s), zi); }
        o = mma32(ldg8p(wc + lt * 32), accB<0>(zr), o); o = mma32(ldg8p(wc + lt * 32 + 16), accB<1>(zr), o);
        o = mma32(ldg8p(wsn + lt * 32), accB<0>(zi), o); o = mma32(ldg8p(wsn + lt * 32 + 16), accB<1>(zi), o); }
#pragma unroll
    for (int rg = 0; rg < 16; ++rg) { const int k = kb * 32 + DROW(rg, h);
        MIX[(size_t)(LROWS + b * CTXL + k) * 1024 + g * 64 + mh * 32 + li] = (bf16)(pk2(o[rg], 0.f) & 0xffffu); }
}
__device__ __forceinline__ void row_ld_f32(const float* p, int lane, f32x4 (&v)[4]) {
#pragma unroll
    for (int j = 0; j < 4; ++j) v[j] = *(const f32x4*)(p + 256 * j + 4 * lane); }
__device__ __forceinline__ void row_ld_bf16(const bf16* p, int lane, f32x4 (&v)[4]) {
#pragma unroll
    for (int j = 0; j < 4; ++j) { const u32x2 w = *(const u32x2*)(p + 256 * j + 4 * lane); v[j] = (f32x4){bflo(w.x), bfhi(w.x), bflo(w.y), bfhi(w.y)}; } }
__device__ __forceinline__ void row_ld_part(const float* P, int nslice, int r, int lane, f32x4 (&v)[4]) {
#pragma unroll
    for (int j = 0; j < 4; ++j) { const float* p = P + ((size_t)((((r - LROWS) >> 8) * 4 + j) * nslice) * 256 + (r & 255)) * 256 + 4 * lane; f32x4 s = *(const f32x4*)p;
        for (int k = 1; k < nslice; ++k) s = s + *(const f32x4*)(p + (size_t)k * 65536);
        v[j] = s; } }
__device__ __forceinline__ void row_st_f32(float* p, int lane, const f32x4 (&v)[4]) {
#pragma unroll
    for (int j = 0; j < 4; ++j) *(f32x4*)(p + 256 * j + 4 * lane) = v[j]; }
__device__ __forceinline__ void row_st_bf16(bf16* p, int lane, const f32x4 (&v)[4]) {
#pragma unroll
    for (int j = 0; j < 4; ++j) { u32x2 w; w.x = pk2(v[j][0], v[j][1]); w.y = pk2(v[j][2], v[j][3]); *(u32x2*)(p + 256 * j + 4 * lane) = w; } }
__device__ __forceinline__ float row_rstd(const f32x4 (&v)[4]) { float s = 0.f;
#pragma unroll
    for (int j = 0; j < 4; ++j) s += (v[j][0] * v[j][0] + v[j][1] * v[j][1]) + (v[j][2] * v[j][2] + v[j][3] * v[j][3]);
    return __builtin_amdgcn_rsqf(wave_sum(s) * (1.f / 1024.f) + EPSN); }
__device__ __forceinline__ void row_modnorm(const f32x4 (&x)[4], const float* g, const float* sc, const float* sh, int lane, f32x4 (&hh)[4]) {
    const float rs = row_rstd(x); f32x4 gv[4], scv[4], shv[4]; row_ld_f32(g, lane, gv); row_ld_f32(sc, lane, scv); row_ld_f32(sh, lane, shv);
#pragma unroll
    for (int j = 0; j < 4; ++j) hh[j] = x[j] * rs * gv[j] * (scv[j] + 1.f) + shv[j]; }
__device__ __forceinline__ void row_resid(f32x4 (&x)[4], const f32x4 (&t)[4], const float* g, const float* gate, int lane) {
    const float rs = row_rstd(t); f32x4 gv[4], ga[4]; row_ld_f32(g, lane, gv); row_ld_f32(gate, lane, ga);
#pragma unroll
    for (int j = 0; j < 4; ++j) x[j] = x[j] + ga[j] * (t[j] * rs * gv[j]); }

__device__ __forceinline__ void transpose_item(const float* W, int ldw, int k0, int n0, bf16* dst, int ldd, float scale, LAS float* scr, int lane) {
#pragma unroll 8
    for (int i = 0; i < 32; ++i) { const int kk = 2 * i + (lane >> 5); scr[kk * 33 + (lane & 31)] = W[(size_t)(k0 + kk) * ldw + n0 + (lane & 31)]; }
    LDS_WAIT(); asm volatile("" ::: "memory");
    const int c = lane & 7;
#pragma unroll
    for (int j = 0; j < 4; ++j) { const int n = (lane >> 3) + 8 * j; const LAS float* s = scr + (8 * c) * 33 + n;
        u32x4 o; o.x = pk2(s[0 * 33] * scale, s[1 * 33] * scale); o.y = pk2(s[2 * 33] * scale, s[3 * 33] * scale); o.z = pk2(s[4 * 33] * scale, s[5 * 33] * scale); o.w = pk2(s[6 * 33] * scale, s[7 * 33] * scale);
        *(u32x4*)(dst + (size_t)n * ldd + k0 + 8 * c) = o; }
    LDS_WAIT(); asm volatile("" ::: "memory");
}
#ifndef MK_MODE
#define MK_MODE 1
#endif
#ifndef MK_LAST
#define MK_LAST 24
#endif
constexpr int NPHASE = 24;
struct Args { const float* in[31]; float* out; unsigned char* ws; int ph_lo, ph_hi, li, pad; };


struct TrJob { const float* src; bf16* dst; int ldw, k0, n0, ldd; float scale; };
#define CAS __attribute__((address_space(4)))
__device__ __forceinline__ void tr_decode(int it, const CAS Args* ap_, unsigned char* ws, TrJob& J) {
#define TIN(k) ((const float*)(const GAS float*)ap_->in[k])
    int kb; J.scale = 1.f;
    if (it < 43008) { const int e = it / 5376, r = it % 5376, w = r / 1792, li = r % 1792;
        if (w < 2) { J.src = TIN(28 + w) + (size_t)e * 1024 * DFE; J.ldw = DFE; kb = li / 112; J.n0 = (li % 112) * 32; J.ldd = 1024;
            J.dst = (bf16*)(ws + WS_MOE1) + ((size_t)e * 7168 + 256 * (J.n0 / 128) + (J.n0 % 128) + 128 * w) * 1024; }
        else { J.src = TIN(30) + (size_t)e * DFE * 1024; J.ldw = 1024; kb = li / 32; J.n0 = (li % 32) * 32; J.ldd = DFE; J.dst = (bf16*)(ws + WS_MOE2) + ((size_t)e * 1024 + J.n0) * DFE; }
    } else if (it < 47232) { const int r = it - 43008, w = r / 1408, li = r % 1408;
        if (w < 2) { J.src = TIN(23 + w); J.ldw = DFF; kb = li / 88; J.n0 = (li % 88) * 32; J.ldd = 1024; J.dst = (bf16*)(ws + WS_FFN1) + (size_t)(256 * (J.n0 / 128) + (J.n0 % 128) + 128 * w) * 1024; }
        else { J.src = TIN(25); J.ldw = 1024; kb = li / 32; J.n0 = (li % 32) * 32; J.ldd = DFF; J.dst = (bf16*)(ws + WS_FFN2) + (size_t)J.n0 * DFF; }
    } else { const int r = it - 47232, l = r / 4384, q = r % 4384;
        if (q < 3328) { const int t = q / 128, li = q % 128; kb = li / 8; const int nb = li % 8;
            const int srcc = t < 4 ? 256 * t : (t < 7 ? 256 * (t + 1) : (t < 23 ? 2304 + 256 * (t - 7) : (t == 23 ? 768 : (t == 24 ? 1024 : 2048))));
            J.src = TIN(7) + (size_t)l * 1024 * 6400; J.ldw = 6400; J.n0 = srcc + 32 * nb; J.ldd = 1024; J.dst = (bf16*)(ws + WS_WIN) + ((size_t)(l * 26 + t) * 256 + 32 * nb) * 1024; J.scale = (t == 3 || t == 23) ? 0.125f : 1.f; }
        else if (q < 3360) { const int li = q - 3328; kb = li / 8; J.n0 = (li % 8) * 32; J.src = TIN(16) + (size_t)l * 65536; J.ldw = 256; J.ldd = 256; J.dst = (bf16*)(ws + WS_WGLU) + ((size_t)l * 256 + J.n0) * 256; }
        else if (q < 3872) { const int li = q - 3360, bb = li / 128, li2 = li % 128; kb = li2 / 32; J.n0 = (li2 % 32) * 32; J.src = TIN(21) + (size_t)(l * 4 + bb) * 256 * 1024; J.ldw = 1024; J.ldd = 256; J.dst = (bf16*)(ws + WS_WBR) + ((size_t)(l * 4 + bb) * 1024 + J.n0) * 256; }
        else { const int li = q - 3872; kb = li / 32; J.n0 = (li % 32) * 32; J.src = TIN(22) + (size_t)l * 1024 * 1024; J.ldw = 1024; J.ldd = 1024; J.dst = (bf16*)(ws + WS_WOUT) + ((size_t)l * 1024 + J.n0) * 1024; }
    }
    J.k0 = kb * 64;
#undef TIN
}
__device__ __forceinline__ void tr_load(const TrJob& J, int lane, float (&v)[32]) {
#pragma unroll
    for (int i = 0; i < 32; ++i) { const int kk = 2 * i + (lane >> 5); v[i] = J.src[(size_t)(J.k0 + kk) * J.ldw + J.n0 + (lane & 31)]; } }
__device__ __forceinline__ void tr_store(const TrJob& J, int lane, const float (&v)[32], LAS float* scr) {
#pragma unroll
    for (int i = 0; i < 32; ++i) { const int kk = 2 * i + (lane >> 5); scr[kk * 33 + (lane & 31)] = v[i]; }
    LDS_WAIT(); asm volatile("" ::: "memory");
    const int c = lane & 7;
#pragma unroll
    for (int j = 0; j < 4; ++j) { const int n = (lane >> 3) + 8 * j; const LAS float* s = scr + (8 * c) * 33 + n; const float sc = J.scale;
        u32x4 o; o.x = pk2(s[0 * 33] * sc, s[1 * 33] * sc); o.y = pk2(s[2 * 33] * sc, s[3 * 33] * sc); o.z = pk2(s[4 * 33] * sc, s[5 * 33] * sc); o.w = pk2(s[6 * 33] * sc, s[7 * 33] * sc);
        *(u32x4*)(J.dst + (size_t)n * J.ldd + J.k0 + 8 * c) = o; }
    LDS_WAIT(); asm volatile("" ::: "memory");
}

__device__ __forceinline__ void cs2pi(int m, int N, float& c, float& s) { sincospif(2.0f * (float)(m % N) / (float)N, &s, &c); }

__global__ void __launch_bounds__(NTHREADS, 2) mk_fwd(Args args) {
    extern __shared__ __attribute__((aligned(16))) unsigned char lds_raw[];
    LAS unsigned char* lds = (LAS unsigned char*)lds_raw;
    const int tid0 = threadIdx.x, wave = __builtin_amdgcn_readfirstlane(tid0 >> 6);
    const int G = gridDim.x, bx = blockIdx.x, vcu = (G % 8 == 0) ? (bx % 8) * (G / 8) + bx / 8 : bx;
    const int wslot = wave * G + vcu, NW = G * NWAVES;
    volatile LAS unsigned* lctl = (volatile LAS unsigned*)(lds + LDSCTL_OFF);
    for (int u = tid0; u < (LDS_BYTES - LDSCTL_OFF) / 4; u += NTHREADS) lctl[u] = 0u;
    __syncthreads();
    const int lo = args.ph_lo, hi = args.ph_hi, bli = args.li;
#ifdef MK_STAMP_PHASE
    if (wave == 0) *(volatile LAS unsigned long long*)(lctl + 64) = __builtin_amdgcn_s_memrealtime();
#endif
    { XcdBarrier b0 = xcd_barrier_post((unsigned*)(args.ws + WS_CTL) + CW_BAR + bli * XCD_BAR_WORDS, lctl + LW_BAR); (void)b0; }
#define IN(k) (lo <= (k) && (k) < hi)
#ifndef MK_REP_MASK
#define MK_REP_MASK 0u
#endif
#define NREP(k) (((MK_REP_MASK >> (k)) & 1u) ? 2 : 1)
#define FORCE_BAR do { PH_BEGIN XcdBarrier b_; b_.bar = (unsigned*)(ws + WS_CTL) + CW_BAR + bli * XCD_BAR_WORDS; b_.x = xb_xcc_id(); b_.st = lctl + LW_BAR; xcd_barrier(b_); } while (0)
#ifdef MK_STAMP_PHASE
#define STAMP_AT(k) do { if (wave == 0) { if ((k) == MK_STAMP_PHASE - 1) *(volatile LAS unsigned long long*)(lctl + 64) = __builtin_amdgcn_s_memrealtime(); if ((k) == MK_STAMP_PHASE) *(volatile LAS unsigned long long*)(lctl + 66) = __builtin_amdgcn_s_memrealtime(); } } while (0)
#else
#define STAMP_AT(k) do { } while (0)
#endif
#define SEAM(k) do { if (IN(k) && IN((k) + 1)) { PH_BEGIN XcdBarrier b_; b_.bar = (unsigned*)(ws + WS_CTL) + CW_BAR + bli * XCD_BAR_WORDS; b_.x = xb_xcc_id(); b_.st = lctl + LW_BAR; xcd_barrier(b_); } STAMP_AT(k); } while (0)
#define PH_BEGIN int tid; { int l_; asm volatile("v_mbcnt_lo_u32_b32 %0, -1, 0\n\tv_mbcnt_hi_u32_b32 %0, -1, %0" : "=v"(l_)); tid = wave * 64 + (l_ & 63); } const CAS Args* ap_ = (const CAS Args*)__builtin_amdgcn_kernarg_segment_ptr(); asm volatile("" : "+s"(ap_)); unsigned char* ws = (unsigned char*)(GAS unsigned char*)ap_->ws; const int lane = tid & 63; (void)lane;
#define AIN(k) ((const float*)(const GAS float*)ap_->in[k])
#define AOUT ((float*)(GAS float*)ap_->out)
#define MODp ((float*)(ws + CTL_MOD_OFF))
#define ctxbuf ((float*)(ws + WS_CTXBUF))
#define Hh ((bf16*)(ws + WS_H))
#define MIX ((bf16*)(ws + WS_MIX))
#define INP ((bf16*)(ws + WS_INP))
#define Tt ((bf16*)(ws + WS_T))

    for (int rep_ = 0; rep_ < NREP(0); ++rep_) if (IN(0)) { if (rep_) { FORCE_BAR; } PH_BEGIN
        for (int it = bx; it < 32; it += G) {
            const int l = it >> 4, g = it & 15;
            LAS f32x2* apow = (LAS f32x2*)lds; LAS f32x2* bbar = (LAS f32x2*)(lds + 8704); LAS f32x2* Cc = (LAS f32x2*)(lds + 16896); LAS float* Kt = (LAS float*)(lds + 25088);
            for (int dir = 0; dir < 2; ++dir) { const size_t pg = (size_t)(l * 2 + dir) * 16 + g;
                if (tid < 64) { const int p = tid;
                    const float are = AIN(8)[pg * 64 + p], aim = AIN(9)[pg * 64 + p], dt = expf(AIN(10)[pg]);
                    for (int t = 0; t <= 16; ++t) { const float mag = expf(are * dt * (float)t); float sn, cs; sincosf(aim * dt * (float)t, &sn, &cs); apow[t * 64 + p] = (f32x2){mag * cs, mag * sn}; }
                    const f32x2 a = apow[64 + p]; const float nr = a.x - 1.f, ni = a.y, den = 1.f / (are * are + aim * aim);
                    const float cr = (nr * are + ni * aim) * den, ci = (ni * are - nr * aim) * den;
                    for (int h = 0; h < 16; ++h) { const float br = AIN(11)[(pg * 64 + p) * 16 + h], bi = AIN(12)[(pg * 64 + p) * 16 + h]; bbar[p * 16 + h] = (f32x2){cr * br - ci * bi, cr * bi + ci * br}; }
                    *(f32x2*)((float*)(ws + WS_A16) + (pg * 64 + p) * 2) = apow[16 * 64 + p];
                }
                for (int i = tid; i < 1024; i += NTHREADS) Cc[i] = (f32x2){AIN(13)[pg * 1024 + i], AIN(14)[pg * 1024 + i]};
                __syncthreads();
                bf16* M1 = (bf16*)(ws + WS_S5M1) + ((size_t)(l * 16 + g) * 2 + dir) * 128 * 256;
                for (int v = tid; v < 4096; v += NTHREADS) { const int row = v >> 5, col0 = (v & 31) * 8, j = col0 >> 4, h0 = col0 & 15, p = row >> 1, ri = row & 1;
                    const f32x2 pw = apow[(dir == 0 ? 15 - j : j) * 64 + p]; float vals[8];
#pragma unroll
                    for (int hh = 0; hh < 8; ++hh) { const f32x2 bb = bbar[p * 16 + h0 + hh]; vals[hh] = ri ? pw.x * bb.y + pw.y * bb.x : pw.x * bb.x - pw.y * bb.y; }
                    *(bf16x8*)(M1 + ((((col0 >> 4) * 4 + (row >> 5)) * 64 + ((col0 >> 3) & 1) * 32 + (row & 31)) * 8)) = pack8(vals); }
                bf16* TAB = (bf16*)(ws + WS_S5TAB) + (size_t)(l * 16 + g) * 256 * 512;
                for (int v = tid; v < 4096; v += NTHREADS) { const int row = v >> 4, cv = v & 15, i = row >> 4, ho = row & 15; float vals[8];
#pragma unroll
                    for (int pp = 0; pp < 4; ++pp) { const int p = cv * 4 + pp; const f32x2 cc = Cc[ho * 64 + p];
                        const f32x2 pw = apow[(dir == 0 ? i + 1 : 16 - i) * 64 + p]; vals[2 * pp] = cc.x * pw.x - cc.y * pw.y; vals[2 * pp + 1] = -(cc.x * pw.y + cc.y * pw.x); }
                    { const int colt = 256 + dir * 128 + cv * 8; *(bf16x8*)(TAB + (((((row >> 7) * 32 + (colt >> 4)) * 4 + ((row >> 5) & 3)) * 64 + ((colt >> 3) & 1) * 32 + (row & 31)) * 8)) = pack8(vals); } }
                for (int e = tid; e < 4096; e += NTHREADS) { const int t = e >> 8, ho = (e >> 4) & 15, h = e & 15; float acc = 0.f;
#pragma unroll 8
                    for (int p = 0; p < 64; ++p) { const f32x2 cc = Cc[ho * 64 + p], pw = apow[t * 64 + p], bb = bbar[p * 16 + h];
                        const float xr = cc.x * pw.x - cc.y * pw.y, xi = cc.x * pw.y + cc.y * pw.x; acc += xr * bb.x - xi * bb.y; }
                    Kt[dir * 4096 + e] = acc; }
                __syncthreads();
            }
            for (int v = tid; v < 8192; v += NTHREADS) { const int row = v >> 5, col0 = (v & 31) * 8, i = row >> 4, ho = row & 15, j = col0 >> 4, h0 = col0 & 15; float vals[8];
#pragma unroll
                for (int hh = 0; hh < 8; ++hh) { const int h = h0 + hh;
                    vals[hh] = j < i ? Kt[(i - j) * 256 + ho * 16 + h] : (j > i ? Kt[4096 + (j - i) * 256 + ho * 16 + h] : Kt[ho * 16 + h] + Kt[4096 + ho * 16 + h] + (ho == h ? AIN(15)[l * 256 + g * 16 + h] : 0.f)); }
                *(bf16x8*)((bf16*)(ws + WS_S5TAB) + (size_t)(l * 16 + g) * 256 * 512 + (((((row >> 7) * 32 + (col0 >> 4)) * 4 + ((row >> 5) & 3)) * 64 + ((col0 >> 3) & 1) * 32 + (row & 31)) * 8)) = pack8(vals); }
            __syncthreads();
        }
        __syncthreads();
        for (int it = (bx >= 32 ? bx - 32 : bx + G - 32); it < 192; it += G) { const int l = it / 96, cb = it % 96, col = cb * 64 + lane, ks = wave;
            const float* wm = AIN(4) + ((size_t)l * 1024 + ks * 128) * 6144 + col; float a0 = 0.f, a1 = 0.f, a2 = 0.f;
#pragma unroll 8
            for (int k = 0; k < 128; ++k) { const float w = wm[(size_t)k * 6144]; const int kk = ks * 128 + k;
                const float c0 = AIN(1)[kk], c1 = AIN(1)[1024 + kk], c2 = AIN(3)[kk];
                a0 += w * (c0 / (1.f + __expf(-c0))); a1 += w * (c1 / (1.f + __expf(-c1))); a2 += w * (c2 / (1.f + __expf(-c2))); }
            LAS float* part = (LAS float*)lds;
            part[(wave * 3 + 0) * 64 + lane] = a0; part[(wave * 3 + 1) * 64 + lane] = a1; part[(wave * 3 + 2) * 64 + lane] = a2;
            __syncthreads();
            if (tid < 192) { const int i = tid >> 6, c = tid & 63; float sacc = AIN(5)[l * 6144 + cb * 64 + c];
#pragma unroll
                for (int w = 0; w < 8; ++w) sacc += part[(w * 3 + i) * 64 + c];
                MODp[(size_t)(l * 3 + i) * 6144 + cb * 64 + c] = sacc; }
            __syncthreads();
        }
        { LAS float* scr = (LAS float*)(lds + wave * 16384);
          unsigned* qh = (unsigned*)(ws + WS_CTL) + CW_QHEAD;
          int q = bx & 7;
          for (int tries = 0; tries < 8; ) {
            unsigned base = 0u; if (lane == 0) base = __hip_atomic_fetch_add(qh + 64 * q, 2u, __ATOMIC_RELAXED, __HIP_MEMORY_SCOPE_AGENT);
            base = (unsigned)__builtin_amdgcn_readfirstlane((int)base);
            if (base >= 7000u) { q = (q + 1) & 7; ++tries; continue; }
            float va[32], vb[32]; TrJob ja, jb; const bool two = base + 1u < 7000u;
            tr_decode(q * 7000 + (int)base, ap_, ws, ja); tr_load(ja, lane, va);
            tr_decode(q * 7000 + (int)base + (two ? 1 : 0), ap_, ws, jb); tr_load(jb, lane, vb);
            tr_store(ja, lane, va, scr); if (two) tr_store(jb, lane, vb, scr);
          } }
        for (int v = wslot * 64 + lane; v < 32 * SEQ; v += NW * 64) { const int p = v >> 13, t = v & 8191; const float pos = (float)(p < 16 ? (t >> 6) : (t & 63));
            const float inv = 1.0f / powf(10000.f, (float)(p & 15) / 16.f); float sn, cs; sincosf(pos * inv, &sn, &cs);
            ((float*)(ws + WS_COST))[v] = cs; ((float*)(ws + WS_SINT))[v] = sn; ((float*)(ws + WS_COSN))[t * 32 + p] = cs; ((float*)(ws + WS_SINN))[t * 32 + p] = sn; }
        for (int v = wslot * 64 + lane; v < 192512; v += NW * 64) { float c, s;
            if (v < 32768) { const int ri = v >> 14, k1 = (v >> 7) & 127, l1 = v & 127; cs2pi(k1 * l1, 128, c, s); const float sc = 0.08838834764831845f;
                ((bf16*)(ws + WS_W128T))[v] = (bf16)(pk2(ri ? -s * sc : c * sc, 0.f) & 0xffffu); }
            else if (v < 40960) { const int u = v - 32768, l2 = u >> 7, k1 = u & 127; cs2pi(k1 * l2, 8192, c, s); ((float*)(ws + WS_TWC))[u] = c; ((float*)(ws + WS_TWS))[u] = s; }
            else if (v < 53248) { const int u = v - 40960, w = u >> 12, m = (u >> 6) & 63, cc = u & 63; cs2pi(m * cc, 64, c, s);
                ((bf16*)(ws + WS_FCT))[u] = (bf16)(pk2((w == 0 ? c : (w == 1 ? s : -s)) * 0.125f, 0.f) & 0xffffu); }
            else if (v < 61440) { const int u = v - 53248, w = u >> 12, k2 = (u >> 6) & 63, l2 = u & 63; cs2pi(k2 * l2, 64, c, s); ((bf16*)(ws + WS_W64T))[u] = (bf16)(pk2((w == 0 ? c : s) * 0.125f, 0.f) & 0xffffu); }
            else { const int u = v - 61440, w = u >> 16, k = (u >> 8) & 255, l = u & 255; cs2pi(k * l, 256, c, s); ((bf16*)(ws + WS_W256T))[u] = (bf16)(pk2((w == 0 ? c : s) * 0.0625f, 0.f) & 0xffffu); }
        }
    }
    SEAM(0);

    for (int rep_ = 0; rep_ < NREP(1); ++rep_) if (IN(1)) { if (rep_) { FORCE_BAR; } PH_BEGIN
        for (int r = wslot; r < R; r += NW) { const int ci = r < SEQ ? 0 : (r < LROWS ? 1 : 2);
            f32x4 x[4], hh[4]; row_ld_f32(r < LROWS ? AIN(0) + (size_t)r * D : AIN(2) + (size_t)(r - LROWS) * D, lane, x);
            const float* md = MODp + (size_t)ci * 6144;
            row_modnorm(x, AIN(6), md + 1024, md, lane, hh); row_st_bf16(Hh + (size_t)r * D, lane, hh); }
    }
    SEAM(1);

    for (int layer = 0; layer < 2; ++layer) {
        const int pb = 1 + 11 * layer;
        const int nM = layer == 0 ? 66 : 64;
        const int nrows = layer == 0 ? R : LROWS;
#define normg (AIN(6) + (size_t)layer * 4 * D)
        for (int rep_ = 0; rep_ < NREP(pb + 1); ++rep_) if (IN(pb + 1)) { if (rep_) { FORCE_BAR; } PH_BEGIN
            gp::SchedInprojA S{(const char*)Hh, (const char*)(ws + WS_WIN) + (size_t)layer * 26 * 256 * 2048, 66, G, bx, layer == 0 ? 32 : 0};
            gp::EpiInprojA E{INP, Tt, (unsigned char*)(ws + WS_GCTX)};
            gp::gemm_phase(lds, tid, 1024, 1024, 1024, S, E);
        }
        SEAM(pb + 1);
        for (int rep_ = 0; rep_ < NREP(pb + 2); ++rep_) if (IN(pb + 2)) { if (rep_) { FORCE_BAR; } PH_BEGIN
            LAS float* rpb = (LAS float*)(lds + 98304 + 4096);
            LAS unsigned char* wl = lds + wave * 12288;
            for (int i = tid; i < 1860; i += NTHREADS) rpb[i] = AIN(20)[layer * 1860 + i] * LOG2E;
            __syncthreads();
            const int nitA = 2224 + 64 + (layer == 0 ? 64 : 0);
            for (int it = wslot; it < nitA; it += NW) {
                if (it < 1056) s5_state_item((const bf16*)(ws + WS_S5M1) + (size_t)layer * 16 * 2 * 128 * 256, INP + (size_t)R * 256, (float*)(ws + WS_HLOC), it, lane);
                else if (it < 1584) ret_kv_item(Tt, Tt + (size_t)256 * R, (const float*)(ws + WS_COST), (const float*)(ws + WS_SINT), AIN(18) + layer * 8, (float*)(ws + WS_KV), it - 1056, lane);
                else if (it < 2096) fft1_item(INP, (const bf16*)(ws + WS_W128T), (const float*)(ws + WS_TWC), (const float*)(ws + WS_TWS), (bf16*)(ws + WS_FB), it - 1584, lane);
                else if (it < 2224) rope_item(INP + (size_t)2 * R * 256, INP + (size_t)3 * R * 256, (const float*)(ws + WS_COSN), (const float*)(ws + WS_SINN), it - 2096, lane);
                else if (it < 2288) { const int j = 1984 + (it - 2224); na_item(INP + (size_t)5 * R * 256, INP + (size_t)6 * R * 256, Tt + (size_t)512 * R, MIX, rpb, wl, false, j >> 10, (j >> 3) & 127, (j >> 1) & 3, j & 1, lane); }
                else { const int j = it - 2288; na_item(INP + (size_t)5 * R * 256, INP + (size_t)6 * R * 256, Tt + (size_t)512 * R, MIX, rpb, wl, true, j >> 5, 0, (j >> 3) & 3, j & 7, lane); }
            }
            __syncthreads();
        }
        SEAM(pb + 2);
        for (int rep_ = 0; rep_ < NREP(pb + 3); ++rep_) if (IN(pb + 3)) { if (rep_) { FORCE_BAR; } PH_BEGIN
            LAS float* rpb = (LAS float*)(lds + 98304 + 4096); LAS unsigned char* wl = lds + wave * 12288;
            for (int i = tid; i < 1860; i += NTHREADS) rpb[i] = AIN(20)[layer * 1860 + i] * LOG2E;
            __syncthreads();
            for (int vs = wslot; vs < 2048; vs += NW) {
                if (vs < 64) s5_scan_item((const float*)(ws + WS_A16) + (size_t)layer * 2 * 16 * 64 * 2, (const float*)(ws + WS_HLOC), (bf16*)(ws + WS_HIN), vs, lane);
                else { const int j = vs - 64; na_item(INP + (size_t)5 * R * 256, INP + (size_t)6 * R * 256, Tt + (size_t)512 * R, MIX, rpb, wl, false, j >> 10, (j >> 3) & 127, (j >> 1) & 3, j & 1, lane);
                    if (vs >= 1024) ret_scan_item(AIN(18) + layer * 8, (const float*)(ws + WS_KV), (bf16*)(ws + WS_SPREV), vs - 1024, lane); }
            }
            __syncthreads();
        }
        SEAM(pb + 3);
        for (int rep_ = 0; rep_ < NREP(pb + 4); ++rep_) if (IN(pb + 4)) { if (rep_) { FORCE_BAR; } PH_BEGIN
            const int nit = 1056 + 2112 + 2048 + (layer == 0 ? 128 : 0);
            for (int it = wslot; it < nit; it += NW) {
                if (it < 1056) s5_out_item((const bf16*)(ws + WS_S5TAB) + (size_t)layer * 16 * 256 * 512, INP + (size_t)R * 256, (const bf16*)(ws + WS_HIN), (bf16*)(ws + WS_Z), it, lane);
                else if (it < 3168) ret_out_item(INP + (size_t)2 * R * 256, INP + (size_t)3 * R * 256, INP + (size_t)4 * R * 256, Tt + (size_t)256 * R, (const bf16*)(ws + WS_SPREV),
                                                 AIN(18) + layer * 8, AIN(19) + layer * 256, MIX, lds + wave * 12288, it - 1056, lane);
                else if (it < 5216) fft2_item((const bf16*)(ws + WS_FB), (const bf16*)(ws + WS_FCT), (const bf16*)(ws + WS_W64T), MIX, it - 3168, lane);
                else fftc_item(INP, (const bf16*)(ws + WS_FCT), (const bf16*)(ws + WS_W256T), MIX, it - 5216, lane);
            }
        }
        SEAM(pb + 4);
        for (int rep_ = 0; rep_ < NREP(pb + 5); ++rep_) if (IN(pb + 5)) { if (rep_) { FORCE_BAR; } PH_BEGIN
            { PH_BEGIN gp::SchedPlain S{(const char*)(ws + WS_Z), (const char*)(ws + WS_WGLU) + (size_t)layer * 256 * 512, (size_t)256 * 512, (size_t)256 * 512, nM, 1, G, bx, 4};
              gp::EpiGlu E{(const bf16*)(ws + WS_Z), MIX, AIN(17) + layer * 256};
              gp::gemm_phase(lds, tid, 256, 256, 256, S, E); }
            { PH_BEGIN gp::SchedPlain S{(const char*)Hh, (const char*)(ws + WS_WIN) + ((size_t)layer * 26 + 7) * 256 * 2048, (size_t)256 * 2048, (size_t)256 * 2048, 64, 16, G, bx, 16};
              gp::EpiGates E{(unsigned char*)(ws + WS_GATES)};
              gp::gemm_phase(lds, tid, 1024, 1024, 1024, S, E); }
        }
        SEAM(pb + 5);
        for (int rep_ = 0; rep_ < NREP(pb + 6); ++rep_) if (IN(pb + 6)) { if (rep_) { FORCE_BAR; } PH_BEGIN
            gp::SchedMerge S{(const char*)MIX, (const char*)(ws + WS_WBR) + (size_t)layer * 4 * 1024 * 512, layer == 0 ? 32 : 0, G, bx};
            gp::EpiMerge E{(const unsigned char*)(ws + WS_GATES), (const unsigned char*)(ws + WS_GCTX), (bf16*)(ws + WS_Y), (bf16*)(ws + WS_YP)};
            gp::gemm_phase(lds, tid, 256, 1024, 256, S, E);
        }
        SEAM(pb + 6);
        for (int rep_ = 0; rep_ < NREP(pb + 7); ++rep_) if (IN(pb + 7)) { if (rep_) { FORCE_BAR; } PH_BEGIN
            gp::SchedSplit S{(const char*)(ws + WS_Y), (const char*)(ws + WS_WOUT) + (size_t)layer * 1024 * 2048, (size_t)256 * 2048, (size_t)256 * 2048, layer == 0 ? 16 : 0, 16, G, bx,
                             (const char*)(ws + WS_YP), (size_t)256 * 2048, (size_t)CROWS * 2048, 4};
            gp::EpiPlainSplit E{(bf16*)(ws + WS_YO), 1024, (float*)(ws + WS_PARTW), 16};
            gp::gemm_phase(lds, tid, 1024, 1024, 1024, S, E);
        }
        SEAM(pb + 7);
        for (int rep_ = 0; rep_ < NREP(pb + 8); ++rep_) if (IN(pb + 8)) { if (rep_) { FORCE_BAR; } PH_BEGIN
            if (layer == 0) {
                for (int r = wslot; r < R; r += NW) { const int ci = r < SEQ ? 0 : (r < LROWS ? 1 : 2); const float* md = MODp + (size_t)ci * 6144;
                    f32x4 x[4], t[4], hh[4]; row_ld_f32(r < LROWS ? AIN(0) + (size_t)r * D : AIN(2) + (size_t)(r - LROWS) * D, lane, x);
                    if (r < LROWS) row_ld_bf16((const bf16*)(ws + WS_YO) + (size_t)r * D, lane, t); else row_ld_part((const float*)(ws + WS_PARTW), 16, r, lane, t);
                    row_resid(x, t, normg + D, md + 2048, lane);
                    row_st_f32(r < LROWS ? AOUT + (size_t)r * D : ctxbuf + (size_t)(r - LROWS) * D, lane, x);
                    row_modnorm(x, normg + 2 * D, md + 4096, md + 3072, lane, hh); row_st_bf16(Hh + (size_t)r * D, lane, hh); }
            } else {
                LAS float* wrs = (LAS float*)lds; LAS int* rowinfo = (LAS int*)(lds + 32768); LAS unsigned* cntL = (LAS unsigned*)(lds + 32768 + 1024); LAS unsigned* baseL = cntL + 8;
                for (int i = tid; i < 2048; i += NTHREADS) ((LAS f32x4*)wrs)[i] = ((const f32x4*)AIN(26))[i];
                int* list = (int*)(ws + WS_LIST); float* routew = (float*)(ws + WS_ROUTEW);
                for (int grp = vcu; grp < 256; grp += G) {
                    if (tid < 8) cntL[tid] = 0u;
                    __syncthreads();
                    for (int rr = 0; rr < 8; ++rr) { const int r = grp * 64 + wave * 8 + rr; const float* md = MODp + (size_t)(3 + (r < SEQ ? 0 : 1)) * 6144;
                        f32x4 x[4], t[4], hh[4]; row_ld_f32(AOUT + (size_t)r * D, lane, x); row_ld_bf16((const bf16*)(ws + WS_YO) + (size_t)r * D, lane, t);
                        row_resid(x, t, normg + D, md + 2048, lane); row_st_f32(AOUT + (size_t)r * D, lane, x);
                        row_modnorm(x, normg + 2 * D, md + 4096, md + 3072, lane, hh); row_st_bf16(Hh + (size_t)r * D, lane, hh);
                        float lg[8];
#pragma unroll
                        for (int e = 0; e < 8; ++e) lg[e] = 0.f;
#pragma unroll
                        for (int j = 0; j < 4; ++j)
#pragma unroll
                            for (int q = 0; q < 4; ++q) { const int k = 256 * j + 4 * lane + q; const f32x4 w0 = *(const LAS f32x4*)(wrs + k * 8), w1 = *(const LAS f32x4*)(wrs + k * 8 + 4); const float hv = hh[j][q];
                                lg[0] += hv * w0[0]; lg[1] += hv * w0[1]; lg[2] += hv * w0[2]; lg[3] += hv * w0[3]; lg[4] += hv * w1[0]; lg[5] += hv * w1[1]; lg[6] += hv * w1[2]; lg[7] += hv * w1[3]; }
#pragma unroll
                        for (int e = 0; e < 8; ++e) lg[e] = wave_sum(lg[e]) + AIN(27)[e];
                        int i0 = 0; float v0 = lg[0];
#pragma unroll
                        for (int e = 1; e < 8; ++e) if (lg[e] > v0) { v0 = lg[e]; i0 = e; }
                        int i1 = i0 == 0 ? 1 : 0; float v1 = i0 == 0 ? lg[1] : lg[0];
#pragma unroll
                        for (int e = 0; e < 8; ++e) if (e != i0 && lg[e] > v1) { v1 = lg[e]; i1 = e; }
                        const float w0 = 1.f / (1.f + __expf(v1 - v0)), w1 = 1.f - w0;
                        if (lane == 0) { const unsigned s0 = __hip_atomic_fetch_add(cntL + i0, 1u, __ATOMIC_RELAXED, __HIP_MEMORY_SCOPE_WORKGROUP), s1 = __hip_atomic_fetch_add(cntL + i1, 1u, __ATOMIC_RELAXED, __HIP_MEMORY_SCOPE_WORKGROUP);
                            LAS int* ri = rowinfo + (wave * 8 + rr) * 4; ri[0] = i0; ri[1] = (int)s0; ri[2] = i1; ri[3] = (int)s1; routew[(size_t)r * 2] = w0; routew[(size_t)r * 2 + 1] = w1; }
                        if (lane < 8) ((int*)(ws + WS_SMAP))[(size_t)r * 8 + lane] = -1;
                    }
                    __syncthreads();
                    if (tid < 8) baseL[tid] = __hip_atomic_fetch_add((unsigned*)(ws + WS_CTL) + CW_MOECNT + 64 * tid, cntL[tid], __ATOMIC_RELAXED, __HIP_MEMORY_SCOPE_AGENT);
                    __syncthreads();
                    if (tid < 64) { const LAS int* ri = rowinfo + tid * 4; const int r = grp * 64 + tid;
                        list[ri[0] * LCAP + (int)baseL[ri[0]] + ri[1]] = r * 2; list[ri[2] * LCAP + (int)baseL[ri[2]] + ri[3]] = r * 2 + 1; }
                    __syncthreads();
                }
            }
        }
        SEAM(pb + 8);
        LAS unsigned* mt = (LAS unsigned*)(lds + LDSCTL_OFF) + LW_MOE;
        if (layer == 1 && (IN(pb + 9) || IN(pb + 10))) { PH_BEGIN
            if (tid == 0) { unsigned off = 0u;
                for (int e = 0; e < 8; ++e) { const unsigned c = __hip_atomic_load((unsigned*)(ws + WS_CTL) + CW_MOECNT + 64 * e, __ATOMIC_RELAXED, __HIP_MEMORY_SCOPE_AGENT); const unsigned m = (c + 255u) >> 8; mt[e] = c; mt[8 + e] = m; mt[16 + e] = off; off += m; }
                mt[24] = off; const unsigned U = off * 4u, full = (U / (unsigned)G) * (unsigned)G, rem = U - full;
                if (rem != 0u && rem <= 32u && full != 0u) { mt[25] = full; mt[26] = rem; } else { mt[25] = U; mt[26] = 0u; } }
            __syncthreads();
        }
        for (int rep_ = 0; rep_ < NREP(pb + 9); ++rep_) if (IN(pb + 9)) { if (rep_) { FORCE_BAR; } PH_BEGIN
            if (layer == 0) {
                gp::SchedPlain S{(const char*)Hh, (const char*)(ws + WS_FFN1), (size_t)256 * 2048, (size_t)256 * 2048, 66, 22, G, bx, 16};
                gp::EpiSwiglu E{(bf16*)(ws + WS_HID), DFF, false};
                gp::gemm_phase(lds, tid, 1024, 1024, 1024, S, E);
            } else {
                gp::SchedMoe1 S{(const char*)Hh, (const char*)(ws + WS_MOE1), (const int*)(ws + WS_LIST), mt, G, bx};
                gp::EpiSwiglu E{(bf16*)(ws + WS_MHID), DFE, true};
                gp::gemm_phase(lds, tid, 1024, 1024, 1024, S, E);
            }
        }
        SEAM(pb + 9);
        for (int rep_ = 0; rep_ < NREP(pb + 10); ++rep_) if (IN(pb + 10)) { if (rep_) { FORCE_BAR; } PH_BEGIN
            if (layer == 0) {
                gp::SchedSplit S{(const char*)(ws + WS_HID), (const char*)(ws + WS_FFN2), (size_t)256 * DFF * 2, (size_t)256 * DFF * 2, 11, DFF / 64, G, bx,
                                 (const char*)(ws + WS_HID) + (size_t)64 * 256 * DFF * 2, (size_t)256 * DFF * 2, 0, 11};
                gp::EpiPlainSplit E{(bf16*)(ws + WS_FO), 1024, (float*)(ws + WS_PARTF), 11};
                gp::gemm_phase(lds, tid, DFF, DFF, DFF, S, E);
            } else {
                { gp::SchedMoe2 S{(const char*)(ws + WS_MHID), (const char*)(ws + WS_MOE2), mt, G, bx};
                  gp::EpiMoeDown E{(bf16*)(ws + WS_SLOT), (const int*)(ws + WS_LIST), (const float*)(ws + WS_ROUTEW), mt};
                  gp::gemm_phase(lds, tid, DFE, DFE, DFE, S, E); }
                { PH_BEGIN gp::SchedMoe2S S{(const char*)(ws + WS_MHID), (const char*)(ws + WS_MOE2), mt, G, bx};
                  gp::EpiMoePart E{(bf16*)(ws + WS_PARTM), (const int*)(ws + WS_LIST), mt, (int*)(ws + WS_SMAP)};
                  gp::gemm_phase(lds, tid, DFE, DFE, DFE, S, E); }
            }
        }
        SEAM(pb + 10);
        for (int rep_ = 0; rep_ < NREP(pb + 11); ++rep_) if (IN(pb + 11)) { if (rep_) { FORCE_BAR; } PH_BEGIN
            for (int r = wslot; r < nrows; r += NW) { const int ci = r < SEQ ? 0 : (r < LROWS ? 1 : 2); const float* md = MODp + (size_t)(layer * 3 + ci) * 6144;
                float* xp = r < LROWS ? AOUT + (size_t)r * D : ctxbuf + (size_t)(r - LROWS) * D;
                f32x4 x[4], t[4]; row_ld_f32(xp, lane, x);
                if (layer == 0) { if (r < LROWS) row_ld_bf16((const bf16*)(ws + WS_FO) + (size_t)r * D, lane, t); else row_ld_part((const float*)(ws + WS_PARTF), 11, r, lane, t); }
                else { typedef int i32x4 __attribute__((ext_vector_type(4)));
                    const i32x4 m0 = *(const i32x4*)((const int*)(ws + WS_SMAP) + (size_t)r * 8), m1 = *(const i32x4*)((const int*)(ws + WS_SMAP) + (size_t)r * 8 + 4);
                    if ((m0.x & m0.y & m0.z & m0.w & m1.x & m1.y & m1.z & m1.w) == -1) {
                        f32x4 t2[4]; row_ld_bf16((const bf16*)(ws + WS_SLOT) + (size_t)r * D, lane, t); row_ld_bf16((const bf16*)(ws + WS_SLOT) + ((size_t)LROWS + r) * D, lane, t2);
#pragma unroll
                        for (int j = 0; j < 4; ++j) t[j] = t[j] + t2[j];
                    } else {
#pragma unroll
                        for (int j = 0; j < 4; ++j) t[j] = (f32x4){0.f, 0.f, 0.f, 0.f};
#pragma unroll
                        for (int k = 0; k < 2; ++k) { const int ent = 2 * r + k; const i32x4 mk = k ? m1 : m0;
#pragma unroll
                            for (int j = 0; j < 4; ++j) { const int mm = j == 0 ? mk.x : (j == 1 ? mk.y : (j == 2 ? mk.z : mk.w));
                                if (mm < 0) { const u32x2 w = *(const u32x2*)((const bf16*)(ws + WS_SLOT) + ((size_t)k * LROWS + r) * D + 256 * j + 4 * lane); t[j] = t[j] + (f32x4){bflo(w.x), bfhi(w.x), bflo(w.y), bfhi(w.y)}; }
                                else { const bf16* pp = (const bf16*)(ws + WS_PARTM) + ((size_t)(mm >> 8) * 7 * 256 + (mm & 255)) * 256 + 4 * lane; f32x4 sacc = (f32x4){0.f, 0.f, 0.f, 0.f};
                                    for (int sl = 0; sl < 7; ++sl) { const u32x2 w = *(const u32x2*)(pp + (size_t)sl * 65536); sacc = sacc + (f32x4){bflo(w.x), bfhi(w.x), bflo(w.y), bfhi(w.y)}; }
                                    t[j] = t[j] + sacc * ((const float*)(ws + WS_ROUTEW))[ent]; } } } } }
                row_resid(x, t, normg + 3 * D, md + 5120, lane); row_st_f32(xp, lane, x);
                if (layer == 0) { f32x4 hh[4]; const float* md1 = MODp + (size_t)(3 + ci) * 6144; row_modnorm(x, AIN(6) + 4 * D, md1 + 1024, md1, lane, hh); row_st_bf16(Hh + (size_t)r * D, lane, hh); } }
        }
        SEAM(pb + 11);
    }
#ifdef MK_STAMP_PHASE
    if (MK_STAMP_PHASE == NPHASE - 1 && wave == 0) *(volatile LAS unsigned long long*)(lctl + 66) = __builtin_amdgcn_s_memrealtime();
    if (blockIdx.x == 0 && wave == 0) { const unsigned long long st0_ = *(volatile LAS unsigned long long*)(lctl + 64), st1_ = *(volatile LAS unsigned long long*)(lctl + 66); const unsigned long long target = __builtin_amdgcn_s_memrealtime() + (unsigned long long)MK_STAMP_AMP * (st1_ - st0_); while (__builtin_amdgcn_s_memrealtime() < target) __builtin_amdgcn_s_sleep(20); }
#endif
#ifdef MK_EXTRA_BARS
    for (int xb_ = 0; xb_ < MK_EXTRA_BARS; ++xb_) { FORCE_BAR; }
#endif
#undef IN
#undef SEAM
#undef PH_BEGIN
#undef normg
#undef AIN
#undef AOUT
#undef MODp
#undef ctxbuf
#undef Hh
#undef MIX
#undef INP
#undef Tt
}

__global__ void dumpk(const unsigned char* src, size_t nbytes, int isf32, float* out, size_t N, int accum) {
    const size_t i = (size_t)blockIdx.x * blockDim.x + threadIdx.x; if (i >= N) return;
    const size_t ne = isf32 ? nbytes / 4 : nbytes / 2; float s = 0.f;
    for (size_t k = i; k < ne; k += N) s += isf32 ? ((const float*)src)[k] : bf2f(((const bf16*)src)[k]);
    out[i] = accum ? out[i] + s : s;
}
extern "C" void kernel_launch(void* const* d_in, const int* in_sizes, int n_in, void* d_out, int out_size, void* d_ws, size_t ws_size, hipStream_t stream) {
    static int grid = 0;
    if (grid == 0) {
        if (n_in != 31 || out_size != LROWS * D || ws_size < WS_END) { fprintf(stderr, "kernel_launch: unexpected shapes (n_in %d, out %d, ws %zu < %zu)\n", n_in, out_size, ws_size, (size_t)WS_END); grid = -1; return; }
        int dev = 0, cus = 0, per_cu = 0;
        if (hipGetDevice(&dev) != hipSuccess || hipDeviceGetAttribute(&cus, hipDeviceAttributeMultiprocessorCount, dev) != hipSuccess) { grid = -1; return; }
        if (hipFuncSetAttribute((const void*)mk_fwd, hipFuncAttributeMaxDynamicSharedMemorySize, LDS_BYTES) != hipSuccess) { fprintf(stderr, "kernel_launch: hipFuncSetAttribute failed\n"); grid = -1; return; }
        if (hipOccupancyMaxActiveBlocksPerMultiprocessor(&per_cu, (const void*)mk_fwd, NTHREADS, LDS_BYTES) != hipSuccess || per_cu < 1) { fprintf(stderr, "kernel_launch: occupancy query says %d\n", per_cu); }
        (void)hipGetLastError();
        grid = cus;
    }
    if (grid < 0) return;
    (void)hipMemsetAsync((char*)d_ws + WS_CTL, 0, CTL_ZERO_BYTES, stream);
    Args a{};
    for (int i = 0; i < 31; ++i) a.in[i] = (const float*)d_in[i];
    a.out = (float*)d_out; a.ws = (unsigned char*)d_ws;
#if MK_MODE == 1
    a.ph_lo = 0; a.ph_hi = NPHASE; a.li = 0;
    hipLaunchKernelGGL(mk_fwd, dim3(grid), dim3(NTHREADS), LDS_BYTES, stream, a);
#else
    for (int p = 0; p < MK_LAST; ++p) { a.ph_lo = p; a.ph_hi = p + 1; a.li = p; hipLaunchKernelGGL(mk_fwd, dim3(grid), dim3(NTHREADS), LDS_BYTES, stream, a); }
#endif
#ifdef MK_DUMP_OFF
    dumpk<<<(LROWS * D + 255) / 256, 256, 0, stream>>>((const unsigned char*)d_ws + (size_t)(MK_DUMP_OFF), (size_t)(MK_DUMP_BYTES), MK_DUMP_F32, (float*)d_out, (size_t)LROWS * D, 0);
#endif
#ifdef MK_DUMP2_OFF
    dumpk<<<(LROWS * D + 255) / 256, 256, 0, stream>>>((const unsigned char*)d_ws + (size_t)(MK_DUMP2_OFF), (size_t)(MK_DUMP2_BYTES), MK_DUMP2_F32, (float*)d_out, (size_t)LROWS * D, 1);
#endif
#ifdef MK_DUMP3_OFF
    dumpk<<<(LROWS * D + 255) / 256, 256, 0, stream>>>((const unsigned char*)d_ws + (size_t)(MK_DUMP3_OFF), (size_t)(MK_DUMP3_BYTES), MK_DUMP3_F32, (float*)d_out, (size_t)LROWS * D, 1);
#endif
}
```

```cpp
#define MK_MODE 1
#include <hip/hip_runtime.h>
#include <cstdio>
#include <cstdint>

#define GAS __attribute__((address_space(1)))
#define LAS __attribute__((address_space(3)))
typedef unsigned short bf16;
typedef short bf16x8 __attribute__((ext_vector_type(8)));
typedef short bf16x4 __attribute__((ext_vector_type(4)));
typedef float f32x2 __attribute__((ext_vector_type(2)));
typedef float f32x4 __attribute__((ext_vector_type(4)));
typedef float f32x16 __attribute__((ext_vector_type(16)));
typedef unsigned u32x2 __attribute__((ext_vector_type(2)));
typedef unsigned u32x4 __attribute__((ext_vector_type(4)));

constexpr int D = 1024, SEQ = 8192, LROWS = 16384, CTXL = 256, CROWS = 512, R = 16896;
constexpr int DFF = 2816, DFE = 3584, NEXP = 8, LCAP = 16640;
constexpr int NWAVES = 8, NTHREADS = 512;
constexpr int NCH16 = R / 16;
constexpr float EPSN = 1e-6f, LOG2E = 1.4426950408889634f;

constexpr size_t MiB = 1u << 20;
constexpr size_t WS_CTL = 0, CTL_ZERO_BYTES = 1 * MiB;
constexpr int CW_TMO = 0, CW_BAR = 4096, CW_MOECNT = 98304, CW_QHEAD = 100352;
constexpr size_t CTL_MOD_OFF = 512 * 1024;
constexpr size_t WS_CTXBUF = 1 * MiB;
constexpr size_t WS_COST = 3 * MiB, WS_SINT = 4 * MiB, WS_COSN = 5 * MiB, WS_SINN = 6 * MiB;
constexpr size_t WS_LIST = 7 * MiB;
constexpr size_t WS_ROUTEW = WS_LIST + 8 * LCAP * 4;
constexpr size_t WS_S5K = 8 * MiB;
constexpr size_t WS_A16 = 9 * MiB;
constexpr size_t WS_W128T = WS_A16 + 64 * 1024;
constexpr size_t WS_TWC = WS_W128T + 64 * 1024, WS_TWS = WS_TWC + 32 * 1024;
constexpr size_t WS_FCT = WS_TWS + 32 * 1024;
constexpr size_t WS_W64T = WS_FCT + 32 * 1024;
constexpr size_t WS_W256T = WS_W64T + 32 * 1024;
constexpr size_t WS_MOE1 = 10 * MiB;
constexpr size_t WS_MOE2 = 122 * MiB;
constexpr size_t WS_OTHERW = 178 * MiB;
constexpr size_t WS_WIN = 178 * MiB;
constexpr size_t WS_WBR = 204 * MiB;
constexpr size_t WS_WOUT = 208 * MiB;
constexpr size_t WS_WGLU = 212 * MiB;
constexpr size_t WS_FFN1 = 213 * MiB;
constexpr size_t WS_FFN2 = 224 * MiB;
constexpr size_t WS_S5M1 = 230 * MiB;
constexpr size_t WS_S5TAB = 234 * MiB;
constexpr size_t WS_BIG = 242 * MiB;
constexpr size_t TOK256 = (size_t)R * 256 * 2;
constexpr size_t WS_INP = WS_BIG;
constexpr size_t WS_T = WS_INP + 7 * TOK256;
constexpr size_t WS_HLOC = WS_T + 3 * TOK256;
constexpr size_t WS_HIN = WS_HLOC + 2 * TOK256;
constexpr size_t WS_KV = WS_HIN + TOK256;
constexpr size_t WS_SPREV = WS_KV + 2 * TOK256;
constexpr size_t WS_FB = WS_SPREV + TOK256;
constexpr size_t WS_GATES = WS_BIG;
constexpr size_t WS_Y = WS_BIG + 132 * MiB;
constexpr size_t WS_YO = WS_Y + 33 * MiB;
constexpr size_t WS_Z = WS_YO + 33 * MiB;
constexpr size_t WS_YP = WS_Z;
constexpr size_t WS_PARTW = WS_BIG;
constexpr size_t WS_PARTF = 340 * MiB;
constexpr size_t WS_PARTM = 416 * MiB;
constexpr size_t WS_SMAP = WS_S5K;
constexpr size_t WS_FO = WS_Y;
constexpr size_t WS_HID = WS_BIG;
constexpr size_t WS_MHID = WS_OTHERW;
constexpr size_t WS_H = 449 * MiB;
constexpr size_t WS_MIX = 482 * MiB;
constexpr size_t WS_SLOT = WS_H;
constexpr size_t WS_GCTX = 515 * MiB;
constexpr size_t WS_END = 519 * MiB;
static_assert(WS_FB + 16 * MiB <= WS_Z && WS_Z + TOK256 <= WS_H && WS_MHID + (size_t)34816 * 3584 * 2 <= WS_H && WS_W256T + 256 * 1024 <= WS_MOE1, "ws map");
static_assert(WS_PARTM + (size_t)32 * 7 * 65536 * 2 <= WS_H && WS_MHID + (size_t)34816 * 3584 * 2 <= WS_PARTM, "ws map 3");
static_assert(WS_S5TAB + 8 * MiB <= WS_BIG && WS_FFN2 + (size_t)1024 * 2816 * 2 <= WS_S5M1 && WS_ROUTEW + 32768 * 4 <= WS_S5K, "ws map 2");

constexpr int RING_BYTES = 131072, LDSCTL_OFF = RING_BYTES, LDS_BYTES = 147456;
constexpr int LW_BAR = 8, LW_MOE = 16;

#define VM_WAIT() asm volatile("s_waitcnt vmcnt(0)" ::: "memory")
#define LDS_WAIT() asm volatile("s_waitcnt lgkmcnt(0)" ::: "memory")
typedef __bf16 bf16n2 __attribute__((ext_vector_type(2)));
__device__ __forceinline__ unsigned pk2(float lo, float hi) { bf16n2 v; v.x = (__bf16)lo; v.y = (__bf16)hi; return __builtin_bit_cast(unsigned, v); }
__device__ __forceinline__ float bf2f(unsigned short b) { return __builtin_bit_cast(float, ((unsigned)b) << 16); }
__device__ __forceinline__ float bflo(unsigned w) { return __builtin_bit_cast(float, w << 16); }
__device__ __forceinline__ float bfhi(unsigned w) { return __builtin_bit_cast(float, w & 0xffff0000u); }
__device__ __forceinline__ float ex2(float x) { return __builtin_amdgcn_exp2f(x); }
__device__ __forceinline__ float rcpf_(float x) { return __builtin_amdgcn_rcpf(x); }
__device__ __forceinline__ float sigm(float x) { return rcpf_(1.f + ex2(-LOG2E * x)); }
__device__ __forceinline__ float silu_(float x) { return x * sigm(x); }
__device__ __forceinline__ float gelu_tanh(float x) { const float u = 0.7978845608028654f * (x + 0.044715f * x * x * x); const float t = 1.f - 2.f * rcpf_(1.f + ex2(2.885390081777927f * u)); return 0.5f * x * (1.f + t); }
__device__ __forceinline__ float xor32_sum(float v) { const unsigned u = __builtin_bit_cast(unsigned, v); const auto r = __builtin_amdgcn_permlane32_swap(u, u, false, false); return __builtin_bit_cast(float, (unsigned)r[0]) + __builtin_bit_cast(float, (unsigned)r[1]); }
__device__ __forceinline__ float xor32_max(float v) { const unsigned u = __builtin_bit_cast(unsigned, v); const auto r = __builtin_amdgcn_permlane32_swap(u, u, false, false); return fmaxf(__builtin_bit_cast(float, (unsigned)r[0]), __builtin_bit_cast(float, (unsigned)r[1])); }
template <int X> __device__ __forceinline__ float swz_xor(float v) { return __builtin_bit_cast(float, __builtin_amdgcn_ds_swizzle(__builtin_bit_cast(int, v), (X << 10) | 0x1f)); }
__device__ __forceinline__ float wave_sum(float v) { v += swz_xor<1>(v); v += swz_xor<2>(v); v += swz_xor<4>(v); v += swz_xor<8>(v); v += swz_xor<16>(v); return xor32_sum(v); }
__device__ __forceinline__ f32x16 mma32(bf16x8 a, bf16x8 b, f32x16 c) { return __builtin_amdgcn_mfma_f32_32x32x16_bf16(a, b, c, 0, 0, 0); }
__device__ __forceinline__ bf16x8 ldg8(const bf16* p) { return *(const bf16x8*)p; }
__device__ __forceinline__ bf16x8 ldg8p(const bf16* p) { const bf16x4 lo = *(const bf16x4*)p, hi = *(const bf16x4*)(p + 8); return __builtin_shufflevector(lo, hi, 0, 1, 2, 3, 4, 5, 6, 7); }
template <int S> __device__ __forceinline__ bf16x8 accB(const f32x16& c) {
    u32x4 w; w.x = pk2(c[8 * S + 0], c[8 * S + 1]); w.y = pk2(c[8 * S + 2], c[8 * S + 3]); w.z = pk2(c[8 * S + 4], c[8 * S + 5]); w.w = pk2(c[8 * S + 6], c[8 * S + 7]);
    return __builtin_bit_cast(bf16x8, w);
}
__device__ __forceinline__ bf16x8 pack8(const float (&v)[8]) { u32x4 w; w.x = pk2(v[0], v[1]); w.y = pk2(v[2], v[3]); w.z = pk2(v[4], v[5]); w.w = pk2(v[6], v[7]); return __builtin_bit_cast(bf16x8, w); }
__device__ __forceinline__ void unpack8(const bf16x8 x, float (&v)[8]) { const u32x4 w = __builtin_bit_cast(u32x4, x); v[0] = bflo(w.x); v[1] = bfhi(w.x); v[2] = bflo(w.y); v[3] = bfhi(w.y); v[4] = bflo(w.z); v[5] = bfhi(w.z); v[6] = bflo(w.w); v[7] = bfhi(w.w); }
__device__ __forceinline__ f32x16 zero16() { f32x16 z;
#pragma unroll
    for (int i = 0; i < 16; ++i) z[i] = 0.f;
    return z; }

#define XB_TMO      128
#define XB_XCNT(j)  (256  + 64 * (j))
#define XB_XSUB(j)  (1280 + 64 * (j))
#define XB_XGEN(j)  (2304 + 64 * (j))
#define XB_TOP      3328
#define XB_TOPGEN   3392
#define XCD_BAR_WORDS 3456
#define XB_SPIN_CAP (1u << 18)
__device__ __forceinline__ unsigned xb_ld(unsigned* p)              { return __hip_atomic_load(p, __ATOMIC_RELAXED, __HIP_MEMORY_SCOPE_AGENT); }
__device__ __forceinline__ unsigned xb_add(unsigned* p, unsigned v) { return __hip_atomic_fetch_add(p, v, __ATOMIC_RELAXED, __HIP_MEMORY_SCOPE_AGENT); }
__device__ __forceinline__ unsigned xb_xcc_id() { return (unsigned)__builtin_amdgcn_s_getreg((3 << 11) | 20) & 0xFu; }
#define XB_SPIN(cond, bar) do { unsigned _sp = 0; while (cond) { __builtin_amdgcn_s_sleep(1); \
    if ((++_sp & 255u) == 0u) { if (xb_ld(&(bar)[XB_TMO])) break; if (_sp > XB_SPIN_CAP) { atomicAdd(&(bar)[XB_TMO], 1u); break; } } } } while (0)
struct XcdBarrier { unsigned* bar; unsigned x; volatile LAS unsigned* st; };
__device__ __forceinline__ XcdBarrier xcd_barrier_post(unsigned* bar, volatile LAS unsigned* st) {
    XcdBarrier b; b.bar = bar; b.x = xb_xcc_id(); b.st = st;
    if (threadIdx.x == 0) (void)xb_add(&bar[XB_XCNT(b.x)], 1u);
    return b;
}
__device__ __forceinline__ void xcd_barrier_complete(unsigned* bar, unsigned x, unsigned& nloc, unsigned& nx) {
    const unsigned G = gridDim.x * gridDim.y * gridDim.z;
    unsigned sum, cnt, mine, sp = 0u;
    for (;;) {
        sum = 0u; cnt = 0u; mine = 0u;
#pragma unroll
        for (unsigned j = 0; j < 16; ++j) { const unsigned c = xb_ld(&bar[XB_XCNT(j)]); sum += c; cnt += (c > 0u) ? 1u : 0u; mine = (j == x) ? c : mine; }
        if (sum == G) break;
        __builtin_amdgcn_s_sleep(1);
        if ((++sp & 255u) == 0u) { if (xb_ld(&bar[XB_TMO])) break; if (sp > XB_SPIN_CAP) { atomicAdd(&bar[XB_TMO], 1u); break; } }
    }
    nloc = mine > 0u ? mine : 1u; nx = cnt > 0u ? cnt : 1u;
}
__device__ __forceinline__ void xcd_barrier(const XcdBarrier& b) {
    asm volatile("s_waitcnt vmcnt(0)" ::: "memory");
    __syncthreads();
    if (threadIdx.x == 0) {
        unsigned* bar = b.bar;
        __builtin_amdgcn_s_waitcnt(0);
        unsigned nloc = b.st[0], nx = b.st[1];
        if (nloc == 0u) { xcd_barrier_complete(bar, b.x, nloc, nx); b.st[0] = nloc; b.st[1] = nx; }
        const unsigned old = xb_add(&bar[XB_XSUB(b.x)], 1u);
        const unsigned gen = old / nloc;
        if (old + 1u == (gen + 1u) * nloc) {
            __builtin_amdgcn_fence(__ATOMIC_RELEASE, "agent");
            asm volatile("s_waitcnt vmcnt(0)" ::: "memory");
            const unsigned og = xb_add(&bar[XB_TOP], 1u);
            const unsigned tg = og / nx;
            if (og + 1u == (tg + 1u) * nx) xb_add(&bar[XB_TOPGEN], 1u);
            else XB_SPIN(xb_ld(&bar[XB_TOPGEN]) == tg, bar);
            __builtin_amdgcn_fence(__ATOMIC_ACQUIRE, "agent");
            xb_add(&bar[XB_XGEN(b.x)], 1u);
            asm volatile("s_waitcnt vmcnt(0)" ::: "memory");
        } else {
            XB_SPIN(xb_ld(&bar[XB_XGEN(b.x)]) == gen, bar);
            __builtin_amdgcn_fence(__ATOMIC_ACQUIRE, "agent");
            asm volatile("s_waitcnt vmcnt(0)" ::: "memory");
        }
    }
    __syncthreads();
}
namespace gp {
constexpr int BM = 256, BK = 64, HALF = 128, HTB = HALF * BK * 2, STAGE_BYTES = 8 * HTB, NXCD = 8, WGM = 8;
__device__ __forceinline__ int lds_byte(int r, int c) { const int st = (r >> 4) * 2 + (c >> 5), rr = r & 15, cc = c & 31, ob = rr * 64 + cc * 2; return st * 1024 + (ob ^ (((ob >> 9) & 1) << 5)); }
__device__ __forceinline__ void stage_rc(int b, int& Rr, int& C) { const int st = b / 1024, sb = b % 1024, swz = sb ^ (((sb >> 9) & 1) << 5); Rr = (st >> 1) * 16 + swz / 64; C = (st & 1) * 32 + (swz % 64) / 2; }
__device__ __forceinline__ int perm32(int rho) { const int n = rho >> 4, i = rho & 15; return 8 * (i >> 2) + 4 * n + (i & 3); }

struct Unit { const char* a; const char* b; int e0, e1, e2, e3, nt; };

__device__ __forceinline__ void tile_of(int L, int nM, int nN, int& pm, int& pn) {
    const int nwg = nM * nN; int wgid = L;
    { const int q = nwg / NXCD, r = nwg % NXCD, xcd = wgid % NXCD, off = wgid / NXCD; wgid = (xcd < r ? xcd * (q + 1) : r * (q + 1) + (xcd - r) * q) + off; }
    const int nig = WGM * nN, gid = wgid / nig, fm = gid * WGM, gsz = (nM - fm) < WGM ? (nM - fm) : WGM;
    pm = fm + ((wgid % nig) % gsz); pn = (wgid % nig) / gsz;
}

template <class Epi, class Sched>
__device__ __forceinline__ void gemm_phase(LAS unsigned char* lds, const int tid, const int K, const int lda, const int ldb, const Sched& S, const Epi& E) {
    constexpr bool GATHER = Sched::GATHER;
    const int wid = __builtin_amdgcn_readfirstlane(tid >> 6), lane = tid & 63, wr = wid >> 2, wc = wid & 3, fr = lane & 15, fq = lane >> 4;
    unsigned voffA[2], voffB[2];
#pragma unroll
    for (int i = 0; i < 2; ++i) { int Rr, C; stage_rc(tid * 16 + i * 8192, Rr, C); const int Rb = (Rr & ~31) + perm32(Rr & 31);
        voffA[i] = (unsigned)(Rr * lda + C) * 2u; voffB[i] = (unsigned)(Rb * ldb + C) * 2u; }
#define PG8_GOFF(dst, unit) do { _Pragma("unroll") for (int _h = 0; _h < 2; ++_h) _Pragma("unroll") for (int _i = 0; _i < 2; ++_i) { int _R, _C; stage_rc(tid * 16 + _i * 8192, _R, _C); dst[_h][_i] = S.rowoff(unit, _R + _h * HALF) + (unsigned)_C * 2u; } } while (0)
    const size_t kstep = (size_t)(BK * 2);
    const unsigned hstepA = (unsigned)HALF * (unsigned)lda * 2u; const size_t hstepB = (size_t)HALF * ldb * 2;
    const unsigned ldsw = (unsigned)wid * 1024u;
    const int aoff = lds_byte(wr * 64 + fr, fq * 8), boff = lds_byte(wc * 32 + fr, fq * 8);
#define PG8_SA(b, h) (((b) * 2 + (h)) * HTB)
#define PG8_SB(b, h) ((4 + (b) * 2 + (h)) * HTB)
#define PG8_STB(bufoff, gbase, hh) do { _Pragma("unroll") for (int _i = 0; _i < 2; ++_i) \
        __builtin_amdgcn_global_load_lds((const unsigned*)((const char*)(gbase) + (size_t)(hh) * hstepB + voffB[_i]), (LAS unsigned*)(lds + (bufoff) + ldsw + _i * 8192), 16, 0, 0); } while (0)
#define PG8_STA(bufoff, gbase, hh, VG) do { _Pragma("unroll") for (int _i = 0; _i < 2; ++_i) { const unsigned _o = GATHER ? (VG) : (voffA[_i] + (unsigned)(hh) * hstepA); \
        __builtin_amdgcn_global_load_lds((const unsigned*)((const char*)(gbase) + _o), (LAS unsigned*)(lds + (bufoff) + ldsw + _i * 8192), 16, 0, 0); } } while (0)
#define PG8_LDA(dst, b, h) do { _Pragma("unroll") for (int m = 0; m < 4; ++m) _Pragma("unroll") for (int k = 0; k < 2; ++k) dst[m][k] = *(const LAS bf16x8*)(lds + PG8_SA(b, h) + aoff + m * 2048 + k * 1024); } while (0)
#define PG8_LDB(dst, b, h) do { _Pragma("unroll") for (int n = 0; n < 2; ++n) _Pragma("unroll") for (int k = 0; k < 2; ++k) dst[n][k] = *(const LAS bf16x8*)(lds + PG8_SB(b, h) + boff + n * 2048 + k * 1024); } while (0)
#define PG8_MMA(ai, bj, At, Bt) do { __builtin_amdgcn_s_setprio(1); _Pragma("unroll") for (int m = 0; m < 4; ++m) _Pragma("unroll") for (int n = 0; n < 2; ++n) _Pragma("unroll") for (int k = 0; k < 2; ++k) \
        acc[ai][bj][m][n] = __builtin_amdgcn_mfma_f32_16x16x32_bf16(Bt[n][k], At[m][k], acc[ai][bj][m][n], 0, 0, 0); __builtin_amdgcn_s_setprio(0); } while (0)
#define PG8_WAIT_V(n) asm volatile("s_waitcnt vmcnt(" #n ")" ::: "memory")
#define PG8_WAIT_L(n) asm volatile("s_waitcnt lgkmcnt(" #n ")" ::: "memory")
#define PG8_BAR __builtin_amdgcn_s_barrier()
#define PG8_SCHED __builtin_amdgcn_sched_barrier(0)
    Unit cur, nxt; int ui = 0;
    if (!S.next(0, cur)) return;
    f32x4 acc[2][2][4][2];
#pragma unroll
    for (int a = 0; a < 2; ++a)
#pragma unroll
        for (int b = 0; b < 2; ++b)
#pragma unroll
            for (int m = 0; m < 4; ++m)
#pragma unroll
                for (int n = 0; n < 2; ++n) acc[a][b][m][n] = (f32x4){0.f, 0.f, 0.f, 0.f};
    bf16x8 At[4][2], B0[2][2], B1[2][2];
    unsigned vgc[2][2], vgn[2][2];
    if constexpr (GATHER) { PG8_GOFF(vgc, cur); }
#pragma unroll
    for (int h = 0; h < 2; ++h)
#pragma unroll
        for (int i = 0; i < 2; ++i) { if (!GATHER) vgc[h][i] = 0u; vgn[h][i] = vgc[h][i]; }
    const char* cA = cur.a; const char* cB = cur.b;
    PG8_STB(PG8_SB(0, 0), cB, 0); PG8_STB(PG8_SB(0, 1), cB, 1); PG8_STA(PG8_SA(0, 0), cA, 0, vgc[0][_i]); PG8_STA(PG8_SA(0, 1), cA, 1, vgc[1][_i]);
    if (wr == 1) PG8_BAR;
    PG8_WAIT_V(2); PG8_BAR;
    PG8_STB(PG8_SB(1, 0), cB + kstep, 0); PG8_STA(PG8_SA(1, 0), cA + kstep, 0, vgc[0][_i]); PG8_STB(PG8_SB(1, 1), cB + kstep, 1);
    PG8_WAIT_V(6); PG8_BAR;
    for (;;) {
        const bool has_next = S.next(ui + 1, nxt);
        const char* nA = has_next ? nxt.a : cA; const char* nB = has_next ? nxt.b : cB;
        int nt = cur.nt; asm volatile("" : "+s"(nt));
#pragma unroll 1
        for (int t = 0; t < nt; t += 2) {
            const bool last = (t == nt - 2);
            const char* a1 = cA + (size_t)(t + 1) * kstep;
            const char* a2 = last ? nA : cA + (size_t)(t + 2) * kstep; const char* b2 = last ? nB : cB + (size_t)(t + 2) * kstep;
            const char* a3 = a2 + kstep; const char* b3 = b2 + kstep;
            if constexpr (GATHER) { if (last && has_next) { PG8_GOFF(vgn, nxt); } }
            PG8_LDB(B0, 0, 0); PG8_LDB(B1, 0, 1); PG8_SCHED; PG8_LDA(At, 0, 0); PG8_STA(PG8_SA(1, 1), a1, 1, vgc[1][_i]);
            PG8_WAIT_V(8); PG8_WAIT_L(0); PG8_BAR; PG8_MMA(0, 0, At, B0); PG8_MMA(0, 1, At, B1); PG8_BAR; PG8_SCHED;
            PG8_LDA(At, 0, 1); PG8_STB(PG8_SB(0, 0), b2, 0); PG8_STB(PG8_SB(0, 1), b2, 1); PG8_STA(PG8_SA(0, 0), a2, 0, (last ? vgn[0][_i] : vgc[0][_i]));
            PG8_WAIT_V(8); PG8_WAIT_L(0); PG8_BAR; PG8_MMA(1, 0, At, B0); PG8_MMA(1, 1, At, B1); PG8_BAR; PG8_SCHED;
            PG8_LDB(B0, 1, 0); PG8_LDB(B1, 1, 1); PG8_SCHED; PG8_LDA(At, 1, 0); PG8_STA(PG8_SA(0, 1), a2, 1, (last ? vgn[1][_i] : vgc[1][_i]));
            PG8_WAIT_V(8); PG8_WAIT_L(0); PG8_BAR; PG8_MMA(0, 0, At, B0); PG8_MMA(0, 1, At, B1); PG8_BAR; PG8_SCHED;
            PG8_LDA(At, 1, 1); PG8_STB(PG8_SB(1, 0), b3, 0); PG8_STB(PG8_SB(1, 1), b3, 1); PG8_STA(PG8_SA(1, 0), a3, 0, (last ? vgn[0][_i] : vgc[0][_i]));
            PG8_WAIT_V(8); PG8_WAIT_L(0); PG8_BAR; PG8_MMA(1, 0, At, B0); PG8_MMA(1, 1, At, B1); PG8_BAR; PG8_SCHED;
        }
        if (wr == 0) PG8_BAR;
        Unit ue = cur; int le = lane;
        if constexpr (Epi::LAUNDER) { int t0 = cur.e0, t1 = cur.e1, t2 = cur.e2, t3 = cur.e3; asm volatile("" : "+v"(t0), "+v"(t1), "+v"(t2), "+v"(t3), "+v"(le));
          ue.e0 = __builtin_amdgcn_readfirstlane(t0); ue.e1 = __builtin_amdgcn_readfirstlane(t1); ue.e2 = __builtin_amdgcn_readfirstlane(t2); ue.e3 = __builtin_amdgcn_readfirstlane(t3); le &= 63; }
        const int fre = le & 15, fqe = le >> 4;
        if constexpr (Epi::CARRY) { E.carry(acc, ue, wr, wc, fre, fqe); if (!has_next) break; }
        else {
        E(acc, ue, wr, wc, fre, fqe);
        if (!has_next) break;
#pragma unroll
        for (int a = 0; a < 2; ++a)
#pragma unroll
            for (int b = 0; b < 2; ++b)
#pragma unroll
                for (int m = 0; m < 4; ++m)
#pragma unroll
                    for (int n = 0; n < 2; ++n) acc[a][b][m][n] = (f32x4){0.f, 0.f, 0.f, 0.f};
        }
        cur = nxt; cA = nA; cB = nB; ++ui;
#pragma unroll
        for (int h = 0; h < 2; ++h)
#pragma unroll
            for (int i = 0; i < 2; ++i) vgc[h][i] = vgn[h][i];
        if (wr == 1) PG8_BAR;
    }
    PG8_WAIT_V(0);
    PG8_BAR;
#undef PG8_SA
#undef PG8_SB
#undef PG8_STA
#undef PG8_GOFF
#undef PG8_STB
#undef PG8_LDA
#undef PG8_LDB
#undef PG8_MMA
#undef PG8_WAIT_V
#undef PG8_WAIT_L
#undef PG8_BAR
#undef PG8_SCHED
}

struct SchedPlain {
    static constexpr bool GATHER = false;
    const char* A; const char* B; size_t ta, tb; int nM, nN, G, c, nt;
    __device__ __forceinline__ bool next(int i, Unit& u) const {
        const long L = (long)i * G + c; if (L >= (long)nM * nN) return false;
        int pm, pn; tile_of((int)L, nM, nN, pm, pn); u.a = A + (size_t)pm * ta; u.b = B + (size_t)pn * tb; u.e0 = pm; u.e1 = pn; u.e2 = 0; u.e3 = 0; u.nt = nt; return true; }
    __device__ __forceinline__ unsigned rowoff(const Unit&, int) const { return 0u; }
};
struct SchedInprojA {
    static constexpr bool GATHER = false;
    const char* Hh; const char* W; int nM, G, c, ng;
    __device__ __forceinline__ bool next(int i, Unit& u) const {
        long L = (long)i * G + c; const int n1 = nM * 7, n2 = 3 * nM; if (L >= n1 + n2 + ng) return false;
        int pm, pn;
        if (L < n1) { tile_of((int)L, nM, 7, pm, pn); u.a = Hh + (size_t)pm * (256 * 2048); u.b = W + (size_t)pn * (256 * 2048); u.e2 = 0; }
        else if (L < n1 + n2) { tile_of((int)(L - n1), 3, nM, pm, pn); u.a = W + (size_t)(23 + pm) * (256 * 2048); u.b = Hh + (size_t)pn * (256 * 2048); u.e2 = 1; }
        else { const int q = (int)(L - n1 - n2); pm = q >> 4; pn = q & 15; u.a = Hh + (size_t)(64 + pm) * (256 * 2048); u.b = W + (size_t)(7 + pn) * (256 * 2048); u.e2 = 2; }
        u.e0 = pm; u.e1 = pn; u.e3 = 0; u.nt = 16; return true; }
    __device__ __forceinline__ unsigned rowoff(const Unit&, int) const { return 0u; }
};
struct SchedSplit {
    static constexpr bool GATHER = false;
    const char* A; const char* B; size_t ta, tb; int nslice, ntf, G, c; const char* Ac; size_t tac, sac; int ks;
    __device__ __forceinline__ bool next(int i, Unit& u) const {
        const long L = (long)i * G + c; int pm, pn;
        if (L < 256) { tile_of((int)L, 64, 4, pm, pn); u.a = A + (size_t)pm * ta; u.b = B + (size_t)pn * tb; u.e2 = 0; u.e3 = 0; u.nt = ntf; }
        else { const int q = (int)(L - 256); if (q >= 8 * nslice) return false; const int tile = q / nslice, s = q % nslice; pm = 64 + (tile >> 2); pn = tile & 3;
            u.a = Ac + (size_t)(tile >> 2) * tac + (size_t)(s / ks) * sac + (s % ks) * 512; u.b = B + (size_t)pn * tb + (s % ks) * 512; u.e2 = s + 1; u.e3 = tile; u.nt = 4; }
        u.e0 = pm; u.e1 = pn; return true; }
    __device__ __forceinline__ unsigned rowoff(const Unit&, int) const { return 0u; }
};
struct SchedMerge {
    static constexpr bool GATHER = false;
    const char* Mix; const char* Wb; int nctx, G, c;
    __device__ __forceinline__ bool next(int i, Unit& u) const {
        const int rounds = (256 + G - 1) / G; int pm, pn, b;
        if (i < 4 * rounds && (long)(i >> 2) * G + c < 256) { tile_of((int)((i >> 2) * G + c), 64, 4, pm, pn); b = i & 3; u.e3 = 0; }
        else { const long q = (long)(i - 4 * rounds) * G + c; if (i < 4 * rounds || q >= nctx) return false; const int tile = (int)q >> 2; b = (int)q & 3; pm = 64 + (tile >> 2); pn = tile & 3; u.e3 = 1; }
        u.a = Mix + (size_t)pm * (256 * 2048) + b * 512; u.b = Wb + ((size_t)b * 1024 + pn * 256) * 512; u.e0 = pm; u.e1 = pn; u.e2 = b; u.nt = 4; return true; }
    __device__ __forceinline__ unsigned rowoff(const Unit&, int) const { return 0u; }
};
struct SchedMoe1 {
    static constexpr bool GATHER = true;
    const char* Hh; const char* W; const int* list; const LAS unsigned* mt; int G, c;
    __device__ __forceinline__ bool next(int i, Unit& u) const {
        long L = (long)i * G + c; int e = 0;
        for (; e < 8; ++e) { const long ue = (long)mt[8 + e] * 28; if (L < ue) break; L -= ue; }
        if (e == 8) return false;
        const int m_e = (int)mt[8 + e], nti = (int)(L / m_e), mti = (int)(L % m_e);
        u.a = Hh; u.b = W + ((size_t)e * 7168 + (size_t)nti * 256) * 2048; u.e0 = e; u.e1 = mti; u.e2 = nti; u.e3 = ((int)mt[16 + e] + mti) * 256; u.nt = 16; return true; }
    __device__ __forceinline__ unsigned rowoff(const Unit& u, int r) const {
        const int li = u.e1 * 256 + r; const int ent = (li < (int)mt[u.e0]) ? list[u.e0 * LCAP + li] : 0; return (unsigned)(ent >> 1) * 2048u; }
};
__device__ __forceinline__ bool moe2_unit(long L, const LAS unsigned* mt, const char* Hid, const char* W, Unit& u) {
    int e = 0;
    for (; e < 8; ++e) { const long ue = (long)mt[8 + e] * 4; if (L < ue) break; L -= ue; }
    if (e == 8) return false;
    const int m_e = (int)mt[8 + e], nti = (int)(L / m_e), mti = (int)(L % m_e);
    u.a = Hid + (size_t)((int)mt[16 + e] + mti) * 256 * (size_t)(DFE * 2); u.b = W + ((size_t)e * 1024 + (size_t)nti * 256) * (size_t)(DFE * 2); u.e0 = e; u.e1 = mti; u.e2 = nti; u.e3 = 0; u.nt = DFE / 64; return true;
}
struct SchedMoe2 {
    static constexpr bool GATHER = false;
    const char* Hid; const char* W; const LAS unsigned* mt; int G, c;
    __device__ __forceinline__ bool next(int i, Unit& u) const { const long L = (long)i * G + c; if (L >= (long)mt[25]) return false; return moe2_unit(L, mt, Hid, W, u); }
    __device__ __forceinline__ unsigned rowoff(const Unit&, int) const { return 0u; }
};
struct SchedMoe2S {
    static constexpr bool GATHER = false;
    const char* Hid; const char* W; const LAS unsigned* mt; int G, c;
    __device__ __forceinline__ bool next(int i, Unit& u) const { const long q = (long)i * G + c; if (q >= (long)mt[26] * 7) return false;
        if (!moe2_unit((long)mt[25] + q / 7, mt, Hid, W, u)) return false; const int s = (int)(q % 7); u.a += s * 1024; u.b += s * 1024; u.e3 = (int)q; u.nt = 8; return true; }
    __device__ __forceinline__ unsigned rowoff(const Unit&, int) const { return 0u; }
};

#define EPI_ROWS(ai, m) (128 * (ai) + 64 * wr + 16 * (m) + fr)
#define EPI_COL(bj) (128 * (bj) + 32 * wc + 8 * fq)
__device__ __forceinline__ u32x4 pack_acc8(const f32x4 a, const f32x4 b) { u32x4 w; w.x = pk2(a[0], a[1]); w.y = pk2(a[2], a[3]); w.z = pk2(b[0], b[1]); w.w = pk2(b[2], b[3]); return w; }

__device__ __forceinline__ unsigned gq8(float g) { const unsigned q = (unsigned)(g * 255.f + 0.5f); return q < 1u ? 1u : q; }
__device__ __forceinline__ u32x2 pack_gate8(const f32x4 a, const f32x4 b) {
    u32x2 w; w.x = gq8(a[0]) | (gq8(a[1]) << 8) | (gq8(a[2]) << 16) | (gq8(a[3]) << 24); w.y = gq8(b[0]) | (gq8(b[1]) << 8) | (gq8(b[2]) << 16) | (gq8(b[3]) << 24); return w; }
__device__ __forceinline__ float gate8(unsigned w, int k) { return (float)((w >> (8 * k)) & 255u) * (1.f / 255.f); }
struct EpiPlain { static constexpr bool CARRY = false, LAUNDER = false;
    bf16* O; int ld;
    __device__ __forceinline__ void operator()(const f32x4 (&acc)[2][2][4][2], const Unit& u, int wr, int wc, int fr, int fq) const {
#pragma unroll
        for (int ai = 0; ai < 2; ++ai)
#pragma unroll
            for (int m = 0; m < 4; ++m) { bf16* rowp = O + (size_t)(u.e0 * 256 + EPI_ROWS(ai, m)) * ld + u.e1 * 256;
#pragma unroll
                for (int bj = 0; bj < 2; ++bj) *(u32x4*)(rowp + EPI_COL(bj)) = pack_acc8(acc[ai][bj][m][0], acc[ai][bj][m][1]); }
    }
};
struct EpiPlainSplit { static constexpr bool CARRY = false, LAUNDER = false;
    bf16* O; int ld; float* P; int nslice;
    __device__ __forceinline__ void operator()(const f32x4 (&acc)[2][2][4][2], const Unit& u, int wr, int wc, int fr, int fq) const {
        if (u.e2 == 0) {
#pragma unroll
            for (int ai = 0; ai < 2; ++ai)
#pragma unroll
                for (int m = 0; m < 4; ++m) { bf16* rowp = O + (size_t)(u.e0 * 256 + EPI_ROWS(ai, m)) * ld + u.e1 * 256;
#pragma unroll
                    for (int bj = 0; bj < 2; ++bj) *(u32x4*)(rowp + EPI_COL(bj)) = pack_acc8(acc[ai][bj][m][0], acc[ai][bj][m][1]); }
        } else { float* pt = P + (size_t)(u.e3 * nslice + (u.e2 - 1)) * 65536;
#pragma unroll
            for (int ai = 0; ai < 2; ++ai)
#pragma unroll
                for (int m = 0; m < 4; ++m)
#pragma unroll
                    for (int bj = 0; bj < 2; ++bj) { float* p = pt + EPI_ROWS(ai, m) * 256 + EPI_COL(bj); *(f32x4*)p = acc[ai][bj][m][0]; *(f32x4*)(p + 4) = acc[ai][bj][m][1]; }
        }
    }
};
struct EpiInprojA { static constexpr bool CARRY = false, LAUNDER = false;
    bf16* INP; bf16* T; unsigned char* Gc;
    __device__ __forceinline__ void operator()(const f32x4 (&acc)[2][2][4][2], const Unit& u, int wr, int wc, int fr, int fq) const {
        if (u.e2 == 2) {
#pragma unroll
            for (int ai = 0; ai < 2; ++ai)
#pragma unroll
                for (int m = 0; m < 4; ++m) { unsigned char* rowp = Gc + (size_t)(u.e0 * 256 + EPI_ROWS(ai, m)) * 4096 + u.e1 * 256;
#pragma unroll
                    for (int bj = 0; bj < 2; ++bj) { f32x4 a = acc[ai][bj][m][0], b = acc[ai][bj][m][1];
#pragma unroll
                        for (int j = 0; j < 4; ++j) { a[j] = sigm(a[j]); b[j] = sigm(b[j]); }
                        *(u32x2*)(rowp + EPI_COL(bj)) = pack_gate8(a, b); } }
        } else if (u.e2 == 0) {
            bf16* base = INP + (size_t)u.e1 * ((size_t)R * 256);
            const bool regroup = (u.e1 == 1);
#pragma unroll
            for (int ai = 0; ai < 2; ++ai)
#pragma unroll
                for (int m = 0; m < 4; ++m) { const int row = u.e0 * 256 + EPI_ROWS(ai, m);
#pragma unroll
                    for (int bj = 0; bj < 2; ++bj) { const int col = EPI_COL(bj);
                        bf16* p = regroup ? base + ((((size_t)(col >> 4) * 33 + (row >> 9)) * 16 + (row & 15)) * 64 + ((col & 8) << 2) + ((row >> 4) & 31)) * 8 : base + (size_t)row * 256 + col;
                        *(u32x4*)p = pack_acc8(acc[ai][bj][m][0], acc[ai][bj][m][1]); } }
        } else {
#pragma unroll
            for (int ai = 0; ai < 2; ++ai)
#pragma unroll
                for (int m = 0; m < 4; ++m) { bf16* rowp = T + (size_t)(u.e0 * 256 + EPI_ROWS(ai, m)) * R + u.e1 * 256;
#pragma unroll
                    for (int bj = 0; bj < 2; ++bj) *(u32x4*)(rowp + EPI_COL(bj)) = pack_acc8(acc[ai][bj][m][0], acc[ai][bj][m][1]); }
        }
    }
};
struct EpiGates { static constexpr bool CARRY = false, LAUNDER = false;
    unsigned char* Gt;
    __device__ __forceinline__ void operator()(const f32x4 (&acc)[2][2][4][2], const Unit& u, int wr, int wc, int fr, int fq) const {
#pragma unroll
        for (int ai = 0; ai < 2; ++ai)
#pragma unroll
            for (int m = 0; m < 4; ++m) { unsigned char* rowp = Gt + (size_t)(u.e0 * 256 + EPI_ROWS(ai, m)) * 4096 + u.e1 * 256;
#pragma unroll
                for (int bj = 0; bj < 2; ++bj) { f32x4 a = acc[ai][bj][m][0], b = acc[ai][bj][m][1];
#pragma unroll
                    for (int j = 0; j < 4; ++j) { a[j] = sigm(a[j]); b[j] = sigm(b[j]); }
                    *(u32x2*)(rowp + EPI_COL(bj)) = pack_gate8(a, b); } }
    }
};
struct EpiGlu { static constexpr bool CARRY = false, LAUNDER = false;
    const bf16* Zz; bf16* Mix; const float* bglu;
    __device__ __forceinline__ void operator()(const f32x4 (&acc)[2][2][4][2], const Unit& u, int wr, int wc, int fr, int fq) const {
#pragma unroll
        for (int bj = 0; bj < 2; ++bj) { const int col = EPI_COL(bj);
            const f32x4 b0 = *(const f32x4*)(bglu + col), b1 = *(const f32x4*)(bglu + col + 4);
#pragma unroll
            for (int ai = 0; ai < 2; ++ai)
#pragma unroll
                for (int m = 0; m < 4; ++m) { const size_t row = (size_t)(u.e0 * 256 + EPI_ROWS(ai, m));
                    const u32x4 zz = *(const u32x4*)(Zz + row * 256 + col);
                    f32x4 a = acc[ai][bj][m][0] + b0, b = acc[ai][bj][m][1] + b1;
                    a[0] = bflo(zz.x) * sigm(a[0]); a[1] = bfhi(zz.x) * sigm(a[1]); a[2] = bflo(zz.y) * sigm(a[2]); a[3] = bfhi(zz.y) * sigm(a[3]);
                    b[0] = bflo(zz.z) * sigm(b[0]); b[1] = bfhi(zz.z) * sigm(b[1]); b[2] = bflo(zz.w) * sigm(b[2]); b[3] = bfhi(zz.w) * sigm(b[3]);
                    *(u32x4*)(Mix + row * 1024 + 256 + col) = pack_acc8(a, b); } }
    }
};
struct EpiMerge {
    static constexpr bool CARRY = true, LAUNDER = false;
    const unsigned char* Gt; const unsigned char* Gc; bf16* Y; bf16* YP;
    __device__ __forceinline__ void carry(f32x4 (&acc)[2][2][4][2], const Unit& u, int wr, int wc, int fr, int fq) const {
        if (u.e3) {
            const int b = u.e2;
#pragma unroll
            for (int ai = 0; ai < 2; ++ai)
#pragma unroll
                for (int m = 0; m < 4; ++m) { const size_t rc = (size_t)((u.e0 - 64) * 256 + EPI_ROWS(ai, m));
#pragma unroll
                    for (int bj = 0; bj < 2; ++bj) { const int col = u.e1 * 256 + EPI_COL(bj); const u32x2 g = *(const u32x2*)(Gc + rc * 4096 + b * 1024 + col);
                        f32x4 a0 = acc[ai][bj][m][0], a1 = acc[ai][bj][m][1];
#pragma unroll
                        for (int j = 0; j < 4; ++j) { a0[j] *= gate8(g.x, j); a1[j] *= gate8(g.y, j); }
                        *(u32x4*)(YP + ((size_t)b * CROWS + rc) * 1024 + col) = pack_acc8(a0, a1); acc[ai][bj][m][0] = (f32x4){0.f, 0.f, 0.f, 0.f}; acc[ai][bj][m][1] = (f32x4){0.f, 0.f, 0.f, 0.f}; } }
            return; }
        const int b = u.e2, bn = b < 3 ? b + 1 : 3;
        u32x2 g[2][4][2], gn[2][4][2];
#pragma unroll
        for (int ai = 0; ai < 2; ++ai)
#pragma unroll
            for (int m = 0; m < 4; ++m) { const size_t row = (size_t)(u.e0 * 256 + EPI_ROWS(ai, m));
                const unsigned char* grow = (u.e0 < 64 ? Gt + row * 4096 : Gc + (row - LROWS) * 4096) + u.e1 * 256;
#pragma unroll
                for (int bj = 0; bj < 2; ++bj) { g[ai][m][bj] = *(const u32x2*)(grow + b * 1024 + EPI_COL(bj)); gn[ai][m][bj] = *(const u32x2*)(grow + bn * 1024 + EPI_COL(bj)); } }
#pragma unroll
        for (int ai = 0; ai < 2; ++ai)
#pragma unroll
            for (int m = 0; m < 4; ++m) { const size_t row = (size_t)(u.e0 * 256 + EPI_ROWS(ai, m));
#pragma unroll
                for (int bj = 0; bj < 2; ++bj) { const int col = u.e1 * 256 + EPI_COL(bj);
                    f32x4 a0 = acc[ai][bj][m][0], a1 = acc[ai][bj][m][1];
#pragma unroll
                    for (int j = 0; j < 4; ++j) { a0[j] *= gate8(g[ai][m][bj].x, j); a1[j] *= gate8(g[ai][m][bj].y, j); }
                    if (b != 3) {
#pragma unroll
                        for (int j = 0; j < 4; ++j) { a0[j] *= rcpf_(gate8(gn[ai][m][bj].x, j)); a1[j] *= rcpf_(gate8(gn[ai][m][bj].y, j)); }
                        acc[ai][bj][m][0] = a0; acc[ai][bj][m][1] = a1; }
                    else { *(u32x4*)(Y + row * 1024 + col) = pack_acc8(a0, a1); acc[ai][bj][m][0] = (f32x4){0.f, 0.f, 0.f, 0.f}; acc[ai][bj][m][1] = (f32x4){0.f, 0.f, 0.f, 0.f}; } } }
    }
};
struct EpiSwiglu { static constexpr bool CARRY = false, LAUNDER = false;
    bf16* Hd; int ldh; bool moe;
    __device__ __forceinline__ void operator()(const f32x4 (&acc)[2][2][4][2], const Unit& u, int wr, int wc, int fr, int fq) const {
        const int rowbase = moe ? u.e3 : u.e0 * 256, pn = moe ? u.e2 : u.e1;
#pragma unroll
        for (int ai = 0; ai < 2; ++ai)
#pragma unroll
            for (int m = 0; m < 4; ++m) { bf16* p = Hd + (size_t)(rowbase + EPI_ROWS(ai, m)) * ldh + pn * 128 + 32 * wc + 8 * fq;
                f32x4 a = acc[ai][0][m][0], b = acc[ai][0][m][1]; const f32x4 ua = acc[ai][1][m][0], ub = acc[ai][1][m][1];
#pragma unroll
                for (int j = 0; j < 4; ++j) { a[j] = silu_(a[j]) * ua[j]; b[j] = silu_(b[j]) * ub[j]; }
                *(u32x4*)p = pack_acc8(a, b); }
    }
};
struct EpiMoeDown { static constexpr bool CARRY = false, LAUNDER = false;
    bf16* Slot; const int* list; const float* routew; const LAS unsigned* mt;
    __device__ __forceinline__ void operator()(const f32x4 (&acc)[2][2][4][2], const Unit& u, int wr, int wc, int fr, int fq) const {
        const int cnt = (int)mt[u.e0];
#pragma unroll
        for (int ai = 0; ai < 2; ++ai)
#pragma unroll
            for (int m = 0; m < 4; ++m) { const int li = u.e1 * 256 + EPI_ROWS(ai, m);
                if (li < cnt) { const int ent = list[u.e0 * LCAP + li]; const float w = routew[ent];
                    bf16* rowp = Slot + ((size_t)(ent & 1) * LROWS + (size_t)(ent >> 1)) * 1024 + u.e2 * 256;
#pragma unroll
                    for (int bj = 0; bj < 2; ++bj) *(u32x4*)(rowp + EPI_COL(bj)) = pack_acc8(acc[ai][bj][m][0] * w, acc[ai][bj][m][1] * w); } }
    }
};
struct EpiMoePart { static constexpr bool CARRY = false, LAUNDER = true;
    bf16* Pm; const int* list; const LAS unsigned* mt; int* smap;
    __device__ __forceinline__ void operator()(const f32x4 (&acc)[2][2][4][2], const Unit& u, int wr, int wc, int fr, int fq) const {
        const int cnt = (int)mt[u.e0], q = u.e3; bf16* pt = Pm + (size_t)q * 65536; const bool mapper = (q % 7 == 0) && wc == 0 && fq == 0;
#pragma unroll
        for (int ai = 0; ai < 2; ++ai)
#pragma unroll
            for (int m = 0; m < 4; ++m) { const int rl = EPI_ROWS(ai, m), li = u.e1 * 256 + rl;
#pragma unroll
                for (int bj = 0; bj < 2; ++bj) *(u32x4*)(pt + rl * 256 + EPI_COL(bj)) = pack_acc8(acc[ai][bj][m][0], acc[ai][bj][m][1]);
                if (mapper && li < cnt) smap[list[u.e0 * LCAP + li] * 4 + u.e2] = ((q / 7) << 8) | rl; }
    }
};
}
#define DROW(reg, h) (((reg) & 3) + 8 * ((reg) >> 2) + 4 * (h))

__device__ __forceinline__ void s5_state_item(const bf16* M1F  , const bf16* SUF, float* HLOC, int item, int lane) {
    const int cb = item % 33, gd = item / 33, g = gd >> 1, dir = gd & 1, li = lane & 31, h = lane >> 5;
    const bf16* A = M1F + (size_t)(g * 2 + dir) * 128 * 256 + lane * 8;
    const bf16* B = SUF + (size_t)(g * 33 + cb) * 16 * 512 + lane * 8;
    f32x16 acc[4];
#pragma unroll
    for (int rt = 0; rt < 4; ++rt) acc[rt] = zero16();
    bf16x8 a0[2][4], b0[2], a1[2][4], b1[2];
#define S5S_LOAD(AA, BB, grp) do { _Pragma("unroll") for (int s = 0; s < 2; ++s) { const int ks = (grp) * 2 + s; BB[s] = ldg8(B + ks * 512); \
        _Pragma("unroll") for (int rt = 0; rt < 4; ++rt) AA[s][rt] = ldg8(A + (ks * 4 + rt) * 512); } } while (0)
#define S5S_MMA(AA, BB) do { _Pragma("unroll") for (int s = 0; s < 2; ++s) _Pragma("unroll") for (int rt = 0; rt < 4; ++rt) acc[rt] = mma32(AA[s][rt], BB[s], acc[rt]); } while (0)
    S5S_LOAD(a0, b0, 0);
#pragma unroll 1
    for (int gp = 0; gp < 8; gp += 2) {
        S5S_LOAD(a1, b1, gp + 1);
        S5S_MMA(a0, b0);
        if (gp + 2 < 8) S5S_LOAD(a0, b0, gp + 2);
        S5S_MMA(a1, b1);
    }
#undef S5S_LOAD
#undef S5S_MMA
    float* o = HLOC + ((size_t)(g * 2 + dir) * NCH16 + cb * 32 + li) * 128;
#pragma unroll
    for (int rt = 0; rt < 4; ++rt)
#pragma unroll
        for (int q = 0; q < 4; ++q) *(f32x4*)(o + rt * 32 + 8 * q + 4 * h) = (f32x4){acc[rt][4 * q], acc[rt][4 * q + 1], acc[rt][4 * q + 2], acc[rt][4 * q + 3]};
}
__device__ __forceinline__ void s5_scan_item(const float* A16  , const float* HLOC, bf16* HIN, int item, int lane) {
    const int dir = item & 1, g = (item >> 1) & 15, b = item >> 5, p = lane;
    const f32x2 a = *(const f32x2*)(A16 + ((size_t)(dir * 16 + g) * 64 + p) * 2);
    const float* src = HLOC + (size_t)(g * 2 + dir) * NCH16 * 128 + 2 * p;
    const int k2 = dir * 128 + 2 * p; bf16* dst = HIN + ((size_t)g * 33 * 16 + (k2 >> 4)) * 512 + ((k2 >> 3) & 1) * 256 + (k2 & 7);
    float hr = 0.f, hi = 0.f;
#define S5_CH(s) ((s) < 16 ? 1024 + 16 * b + (dir ? 15 - (s) : (s)) : 512 * b + (dir ? 511 - ((s) - 16) : (s) - 16))
    f32x2 v[32], w[32];
#pragma unroll
    for (int j = 0; j < 32; ++j) v[j] = *(const f32x2*)(src + (size_t)S5_CH(j) * 128);
    for (int s0 = 0; s0 < 528; s0 += 32) {
        const int nb = 528 - s0 < 32 ? 528 - s0 : 32;
        if (s0 + 32 < 528) {
#pragma unroll
            for (int j = 0; j < 32; ++j) { const int s = s0 + 32 + j; w[j] = *(const f32x2*)(src + (size_t)S5_CH(s < 528 ? s : 527) * 128); } }
#pragma unroll
        for (int j = 0; j < 32; ++j) if (j < nb) { const int c = S5_CH(s0 + j);
            *(unsigned*)(dst + (size_t)(c >> 5) * 8192 + (c & 31) * 8) = pk2(hr, hi);
            const float nr = a.x * hr - a.y * hi + v[j].x, ni = a.x * hi + a.y * hr + v[j].y; hr = nr; hi = ni; }
#pragma unroll
        for (int j = 0; j < 32; ++j) v[j] = w[j];
    }
#undef S5_CH
}
__device__ __forceinline__ void s5_out_item(const bf16* TABF  , const bf16* SUF, const bf16* HINF, bf16* Z, int item, int lane) {
    const int mh = item & 1, it2 = item >> 1, cb = it2 % 33, g = it2 / 33, li = lane & 31, h = lane >> 5, c = cb * 32 + li;
    const bf16* A = TABF + ((size_t)g * 256 + mh * 128) * 512 + lane * 8;
    const bf16* B0 = SUF + (size_t)(g * 33 + cb) * 16 * 512 + lane * 8;
    const bf16* B1 = HINF + (size_t)(g * 33 + cb) * 16 * 512 + lane * 8;
    f32x16 acc[4];
#pragma unroll
    for (int rt = 0; rt < 4; ++rt) acc[rt] = zero16();
    bf16x8 a0[2][4], b0[2], a1[2][4], b1[2];
#define S5O_LOAD(AA, BB, grp) do { _Pragma("unroll") for (int s = 0; s < 2; ++s) { const int ks = (grp) * 2 + s; BB[s] = ldg8((ks < 16 ? B0 + ks * 512 : B1 + (ks - 16) * 512)); \
        _Pragma("unroll") for (int rt = 0; rt < 4; ++rt) AA[s][rt] = ldg8(A + (ks * 4 + rt) * 512); } } while (0)
#define S5O_MMA(AA, BB) do { _Pragma("unroll") for (int s = 0; s < 2; ++s) _Pragma("unroll") for (int rt = 0; rt < 4; ++rt) acc[rt] = mma32(AA[s][rt], BB[s], acc[rt]); } while (0)
    S5O_LOAD(a0, b0, 0);
#pragma unroll 1
    for (int gp = 0; gp < 16; gp += 2) {
        S5O_LOAD(a1, b1, gp + 1);
        S5O_MMA(a0, b0);
        if (gp + 2 < 16) S5O_LOAD(a0, b0, gp + 2);
        S5O_MMA(a1, b1);
    }
#undef S5O_LOAD
#undef S5O_MMA
#pragma unroll
    for (int rt = 0; rt < 4; ++rt)
#pragma unroll
        for (int q = 0; q < 4; ++q) {
            const int i = 8 * mh + 2 * rt + (q >> 1), ho0 = 8 * (q & 1) + 4 * h;
            u32x2 w; w.x = pk2(gelu_tanh(acc[rt][4 * q]), gelu_tanh(acc[rt][4 * q + 1])); w.y = pk2(gelu_tanh(acc[rt][4 * q + 2]), gelu_tanh(acc[rt][4 * q + 3]));
            *(u32x2*)(Z + ((size_t)c * 16 + i) * 256 + g * 16 + ho0) = w; }
}

__device__ __forceinline__ int ret_tok0(int b, int n) { return n < 64 ? b * SEQ + n * 128 : LROWS + b * CTXL + (n - 64) * 128; }
__device__ __forceinline__ void ret_kv_item(const bf16* RKT, const bf16* RVT, const float* COST, const float* SINT, const float* decay  , float* KV, int item, int lane) {
    const int n = item % 66, bh = item / 66, hd = bh & 3, b = bh >> 2, li = lane & 31, h = lane >> 5;
    const int tok0 = ret_tok0(b, n); const bool lat = n < 64;
    const float lgf = -log2f(1.f + __expf(-decay[hd])), lgr = -log2f(1.f + __expf(-decay[4 + hd]));
    f32x16 acc[2][2][2];
#pragma unroll
    for (int a = 0; a < 2; ++a)
#pragma unroll
        for (int c = 0; c < 2; ++c)
#pragma unroll
            for (int d = 0; d < 2; ++d) acc[a][c][d] = zero16();
    const bf16* k0p = RKT + (size_t)(hd * 64 + li) * R + tok0 + 8 * h;
    const bf16* v0p = RVT + (size_t)(hd * 64 + li) * R + tok0 + 8 * h;
#pragma unroll 2
    for (int ks = 0; ks < 8; ++ks) {
        float k1[8], k2[8];
        unpack8(ldg8(k0p + ks * 16), k1); unpack8(ldg8(k0p + (size_t)32 * R + ks * 16), k2);
        if (lat) {
            const float* cp = COST + (size_t)li * SEQ + n * 128 + ks * 16 + 8 * h; const float* sp = SINT + (size_t)li * SEQ + n * 128 + ks * 16 + 8 * h;
            const f32x4 c0 = *(const f32x4*)cp, c1 = *(const f32x4*)(cp + 4), s0 = *(const f32x4*)sp, s1 = *(const f32x4*)(sp + 4);
#pragma unroll
            for (int j = 0; j < 8; ++j) { const float cc = j < 4 ? c0[j & 3] : c1[j & 3], ss = j < 4 ? s0[j & 3] : s1[j & 3];
                const float x1 = k1[j], x2 = k2[j]; k1[j] = x1 * cc - x2 * ss; k2[j] = x1 * ss + x2 * cc; }
        }
        const bf16x8 vf0 = ldg8(v0p + ks * 16), vf1 = ldg8(v0p + (size_t)32 * R + ks * 16);
#pragma unroll
        for (int dir = 0; dir < 2; ++dir) {
            float a1[8], a2[8];
#pragma unroll
            for (int j = 0; j < 8; ++j) { const int i = ks * 16 + 8 * h + j; const float w = dir == 0 ? ex2(lgf * (float)(127 - i)) : ex2(lgr * (float)i); a1[j] = k1[j] * w; a2[j] = k2[j] * w; }
            const bf16x8 kd0 = pack8(a1), kd1 = pack8(a2);
            acc[dir][0][0] = mma32(kd0, vf0, acc[dir][0][0]); acc[dir][0][1] = mma32(kd0, vf1, acc[dir][0][1]);
            acc[dir][1][0] = mma32(kd1, vf0, acc[dir][1][0]); acc[dir][1][1] = mma32(kd1, vf1, acc[dir][1][1]);
        }
    }
#pragma unroll
    for (int dir = 0; dir < 2; ++dir) { float* o = KV + ((size_t)((b * 4 + hd) * 2 + dir) * 66 + n) * 4096;
#pragma unroll
        for (int dt = 0; dt < 2; ++dt)
#pragma unroll
            for (int et = 0; et < 2; ++et)
#pragma unroll
                for (int q = 0; q < 4; ++q) *(f32x4*)(o + (size_t)(et * 32 + li) * 64 + dt * 32 + 8 * q + 4 * h) = (f32x4){acc[dir][dt][et][4 * q], acc[dir][dt][et][4 * q + 1], acc[dir][dt][et][4 * q + 2], acc[dir][dt][et][4 * q + 3]}; }
}
__device__ __forceinline__ void ret_scan_item(const float* decay, const float* KV, bf16* SPREV, int item, int lane) {
    const int blk = item & 63, bhd = item >> 6, dir = bhd & 1, hd = (bhd >> 1) & 3, idx = blk * 64 + lane;
    const float lg = -log2f(1.f + __expf(-decay[dir * 4 + hd])), cd = ex2(128.f * lg);
    const float* src = KV + (size_t)bhd * 66 * 4096 + idx; bf16* dst = SPREV + (size_t)bhd * 66 * 4096 + idx;
    float s = 0.f;
    for (int s0 = 0; s0 < 66; s0 += 11) {
        float v[11];
#pragma unroll
        for (int j = 0; j < 11; ++j) { const int t = s0 + j; const int n = dir == 0 ? (t < 2 ? 64 + t : t - 2) : (t < 2 ? 65 - t : 65 - t); v[j] = src[(size_t)n * 4096]; }
#pragma unroll
        for (int j = 0; j < 11; ++j) { const int t = s0 + j; const int n = dir == 0 ? (t < 2 ? 64 + t : t - 2) : (t < 2 ? 65 - t : 65 - t); dst[(size_t)n * 4096] = (bf16)(pk2(s, 0.f) & 0xffffu); s = cd * s + v[j]; }
    }
}
struct KVTile { u32x4 k[4], v[4]; };
__device__ __forceinline__ void kv_tile_load(KVTile& T, const bf16* Kh  , const bf16* VTh  , int tok0, int lane) {
#pragma unroll
    for (int i = 0; i < 4; ++i) T.k[i] = *(const u32x4*)(Kh + (size_t)(tok0 + 8 * i + (lane >> 3)) * 256 + (lane & 7) * 8);
#pragma unroll
    for (int i = 0; i < 4; ++i) T.v[i] = *(const u32x4*)(VTh + (size_t)(16 * i + (lane >> 2)) * R + tok0 + (lane & 3) * 8);
}
__device__ __forceinline__ void kv_tile_store(const KVTile& T, LAS unsigned char* wl, int lane) {
#pragma unroll
    for (int i = 0; i < 4; ++i) *(LAS u32x4*)(wl + (8 * i + (lane >> 3)) * 144 + (lane & 7) * 16) = T.k[i];
#pragma unroll
    for (int i = 0; i < 4; ++i) *(LAS u32x4*)(wl + 4608 + (16 * i + (lane >> 2)) * 80 + (lane & 3) * 16) = T.v[i];
}
__device__ __forceinline__ void kv_tile_frags(const LAS unsigned char* wl, int lane, bf16x8 (&kf)[4], bf16x8 (&vf)[2][2]) {
    const int li = lane & 31, h = lane >> 5;
#pragma unroll
    for (int s = 0; s < 4; ++s) kf[s] = *(const LAS bf16x8*)(wl + li * 144 + (2 * s + h) * 16);
#pragma unroll
    for (int et = 0; et < 2; ++et)
#pragma unroll
        for (int s2 = 0; s2 < 2; ++s2) { const LAS unsigned char* p = wl + 4608 + (et * 32 + li) * 80 + s2 * 32 + 8 * h;
            const bf16x4 lo = *(const LAS bf16x4*)p, hi = *(const LAS bf16x4*)(p + 16); vf[et][s2] = __builtin_shufflevector(lo, hi, 0, 1, 2, 3, 4, 5, 6, 7); }
}

__device__ __forceinline__ void rope_item(bf16* RQ, bf16* RK, const float* COSN, const float* SINN, int item, int lane) {
    const int u = lane & 15, off = (u >> 2) * 64 + (u & 3) * 8, c8 = (u & 3) * 8;
#pragma unroll 4
    for (int st = 0; st < 32; ++st) { const int row = item * 128 + 4 * st + (lane >> 4), tl = row & (SEQ - 1);
        const f32x4 c0 = *(const f32x4*)(COSN + (size_t)tl * 32 + c8), c1 = *(const f32x4*)(COSN + (size_t)tl * 32 + c8 + 4), s0 = *(const f32x4*)(SINN + (size_t)tl * 32 + c8), s1 = *(const f32x4*)(SINN + (size_t)tl * 32 + c8 + 4);
#pragma unroll
        for (int w = 0; w < 2; ++w) { bf16* p = (w ? RK : RQ) + (size_t)row * 256 + off; float x1[8], x2[8]; unpack8(*(const bf16x8*)p, x1); unpack8(*(const bf16x8*)(p + 32), x2);
#pragma unroll
            for (int j = 0; j < 8; ++j) { const float cc = j < 4 ? c0[j & 3] : c1[j & 3], ss = j < 4 ? s0[j & 3] : s1[j & 3]; const float a = x1[j], bb = x2[j]; x1[j] = a * cc - bb * ss; x2[j] = a * ss + bb * cc; }
            *(bf16x8*)p = pack8(x1); *(bf16x8*)(p + 32) = pack8(x2); } }
}
__device__ __forceinline__ void ret_out_item(const bf16* RQ, const bf16* RK, const bf16* RG, const bf16* RVT, const bf16* SPREV, const float* decay, const float* gn  , bf16* MIX,
                                             LAS unsigned char* wl, int item, int lane) {
    const int qb = item & 3, it2 = item >> 2, n = it2 % 66, bh = it2 / 66, hd = bh & 3, b = bh >> 2, li = lane & 31, h = lane >> 5;
    const int tok0 = ret_tok0(b, n);
    const float lgf = -log2f(1.f + __expf(-decay[hd])), lgr = -log2f(1.f + __expf(-decay[4 + hd]));
    const int iq = qb * 32 + li;
    const bf16* Kh = RK + hd * 64; const bf16* VTh = RVT + (size_t)hd * 64 * R;
    KVTile T; kv_tile_load(T, Kh, VTh, tok0, lane);
    bf16x8 qf[4];
    { const bf16* qp = RQ + (size_t)(tok0 + iq) * 256 + hd * 64 + 8 * h;
#pragma unroll
      for (int s = 0; s < 4; ++s) qf[s] = ldg8(qp + 16 * s); }
    kv_tile_store(T, wl, lane);
    f32x16 accO[2] = {zero16(), zero16()};
#pragma unroll 1
    for (int kt = 0; kt < 4; ++kt) {
        kv_tile_load(T, Kh, VTh, tok0 + (kt < 3 ? kt + 1 : kt) * 32, lane);
        bf16x8 kf[4], vf[2][2]; kv_tile_frags(wl, lane, kf, vf);
        f32x16 st = zero16();
#pragma unroll
        for (int s = 0; s < 4; ++s) st = mma32(kf[s], qf[s], st);
#pragma unroll
        for (int r = 0; r < 16; ++r) { const int j = kt * 32 + DROW(r, h), df = iq - j;
            const float w = df > 0 ? ex2(lgf * (float)df) : (df < 0 ? ex2(lgr * (float)(-df)) : 2.f); st[r] *= w; }
        const bf16x8 p0 = accB<0>(st), p1 = accB<1>(st);
        accO[0] = mma32(vf[0][0], p0, accO[0]); accO[0] = mma32(vf[0][1], p1, accO[0]); accO[1] = mma32(vf[1][0], p0, accO[1]); accO[1] = mma32(vf[1][1], p1, accO[1]);
        kv_tile_store(T, wl, lane);
    }
    const float cf = ex2(lgf * (float)(iq + 1)), cr = ex2(lgr * (float)(128 - iq));
#pragma unroll
    for (int dir = 0; dir < 2; ++dir) { const bf16* sp = SPREV + ((size_t)((b * 4 + hd) * 2 + dir) * 66 + n) * 4096;
#pragma unroll
        for (int et = 0; et < 2; ++et) { f32x16 a = zero16();
#pragma unroll
            for (int s = 0; s < 4; ++s) a = mma32(ldg8(sp + (size_t)(et * 32 + li) * 64 + 16 * s + 8 * h), qf[s], a);
            const float sc = dir == 0 ? cf : cr;
#pragma unroll
            for (int r = 0; r < 16; ++r) accO[et][r] += sc * a[r]; } }
    float s1 = 0.f;
#pragma unroll
    for (int et = 0; et < 2; ++et)
#pragma unroll
        for (int r = 0; r < 16; ++r) s1 += accO[et][r];
    s1 = xor32_sum(s1); const float mu = s1 * (1.f / 64.f);
    float s2 = 0.f;
#pragma unroll
    for (int et = 0; et < 2; ++et)
#pragma unroll
        for (int r = 0; r < 16; ++r) { const float dlt = accO[et][r] - mu; s2 += dlt * dlt; }
    s2 = xor32_sum(s2); const float rstd = __builtin_amdgcn_rsqf(s2 * (1.f / 64.f) + EPSN);
    const size_t tok = (size_t)(tok0 + iq);
#pragma unroll
    for (int et = 0; et < 2; ++et)
#pragma unroll
        for (int q = 0; q < 4; ++q) { const int e0 = hd * 64 + et * 32 + 8 * q + 4 * h;
            const f32x4 gv = *(const f32x4*)(gn + e0); const u32x2 gg = *(const u32x2*)(RG + tok * 256 + e0);
            const float g0 = bflo(gg.x), g1 = bfhi(gg.x), g2 = bflo(gg.y), g3 = bfhi(gg.y);
            u32x2 w; w.x = pk2(silu_(g0) * (accO[et][4 * q] - mu) * rstd * gv[0], silu_(g1) * (accO[et][4 * q + 1] - mu) * rstd * gv[1]);
            w.y = pk2(silu_(g2) * (accO[et][4 * q + 2] - mu) * rstd * gv[2], silu_(g3) * (accO[et][4 * q + 3] - mu) * rstd * gv[3]);
            *(u32x2*)(MIX + tok * 1024 + 512 + e0) = w; }
}

__device__ __forceinline__ int na_tile_tok(int t, int b, int rs) { const int tb = t - 8; return t >= 8 ? b * SEQ + (rs + (tb >> 1)) * 64 + (tb & 1) * 32 : LROWS + b * CTXL + t * 32; }
__device__ __forceinline__ void na_item(const bf16* NQ, const bf16* NK, const bf16* NVT, bf16* MIX, const LAS float* rpb2, LAS unsigned char* wl, bool ctxq, int b, int r, int hd, int qs, int lane) {
    const int li = lane & 31, h = lane >> 5;
    const int tokq = ctxq ? LROWS + b * CTXL + qs * 32 + li : b * SEQ + r * 64 + qs * 32 + li;
    bf16x8 qf[4];
#pragma unroll
    for (int s = 0; s < 4; ++s) qf[s] = ldg8(NQ + (size_t)tokq * 256 + hd * 64 + 16 * s + 8 * h);
    float mrun = -1e30f, lrun = 0.f;
    f32x16 accO[2] = {zero16(), zero16()};
    const int rs = r - 4 < 0 ? 0 : (r - 4 > 120 ? 120 : r - 4);
    const int qc = qs * 32 + li, cs = qc - 8 < 0 ? 0 : (qc - 8 > 48 ? 48 : qc - 8);
    const int ntile = ctxq ? 8 : 24;
    const float c1 = 0.125f * LOG2E;
    const bf16* Kh = NK + hd * 64; const bf16* VTh = NVT + (size_t)hd * 64 * R;
    KVTile T; kv_tile_load(T, Kh, VTh, na_tile_tok(0, b, rs), lane); kv_tile_store(T, wl, lane);
#pragma unroll 1
    for (int t = 0; t < ntile; ++t) {
        const bool band = t >= 8; const int tb = t - 8, rr = rs + (tb >> 1), ct = tb & 1;
        kv_tile_load(T, Kh, VTh, na_tile_tok(t + 1 < ntile ? t + 1 : t, b, rs), lane);
        bf16x8 kf[4], vf[2][2]; kv_tile_frags(wl, lane, kf, vf);
        f32x16 st = zero16();
#pragma unroll
        for (int s = 0; s < 4; ++s) st = mma32(kf[s], qf[s], st);
        float mt = -INFINITY;
        if (band) { const int dr = rr - r + 7; const LAS float* bp = rpb2 + ((hd * 15 + dr) * 31 + 32 * ct - qc + 15 + 4 * h); const int d0 = 32 * ct + 4 * h - cs;
#pragma unroll
            for (int g = 0; g < 16; ++g) { const int o = 8 * (g >> 2) + (g & 3); const bool inw = (unsigned)(d0 + o) < 16u;
                const float v = inw ? st[g] * c1 + bp[o] : -INFINITY; st[g] = v; mt = fmaxf(mt, v); }
        } else {
#pragma unroll
            for (int g = 0; g < 16; ++g) { const float v = st[g] * c1; st[g] = v; mt = fmaxf(mt, v); }
        }
        mt = xor32_max(mt);
        const float mnew = fmaxf(mrun, mt);
        if (__builtin_amdgcn_ballot_w64(mnew > mrun)) { const float alpha = ex2(mrun - mnew); lrun *= alpha;
#pragma unroll
            for (int et = 0; et < 2; ++et)
#pragma unroll
                for (int g = 0; g < 16; ++g) accO[et][g] *= alpha; }
        mrun = mnew;
        float ps = 0.f;
#pragma unroll
        for (int g = 0; g < 16; ++g) { const float p = ex2(st[g] - mnew); st[g] = p; ps += p; }
        lrun += xor32_sum(ps);
        const bf16x8 p0 = accB<0>(st), p1 = accB<1>(st);
        accO[0] = mma32(vf[0][0], p0, accO[0]); accO[0] = mma32(vf[0][1], p1, accO[0]); accO[1] = mma32(vf[1][0], p0, accO[1]); accO[1] = mma32(vf[1][1], p1, accO[1]);
        kv_tile_store(T, wl, lane);
    }
    const float inv = 1.f / lrun;
#pragma unroll
    for (int et = 0; et < 2; ++et)
#pragma unroll
        for (int q = 0; q < 4; ++q) { u32x2 w; w.x = pk2(accO[et][4 * q] * inv, accO[et][4 * q + 1] * inv); w.y = pk2(accO[et][4 * q + 2] * inv, accO[et][4 * q + 3] * inv);
            *(u32x2*)(MIX + (size_t)tokq * 1024 + 768 + hd * 64 + et * 32 + 8 * q + 4 * h) = w; }
}

__device__ __forceinline__ void fft1_item(const bf16* F, const bf16* W128T, const float* TWC, const float* TWS, bf16* FB, int item, int lane) {
    const int l2 = item & 63, g = (item >> 6) & 3, b = item >> 8, li = lane & 31, h = lane >> 5;
    bf16x8 idf[4];
#pragma unroll
    for (int s = 0; s < 4; ++s) { float v[8];
#pragma unroll
        for (int j = 0; j < 8; ++j) v[j] = (16 * (s & 1) + 8 * h + j == li) ? 1.f : 0.f;
        idf[s] = pack8(v); }
    bf16x8 xb[4][2][2];
#pragma unroll
    for (int lt = 0; lt < 4; ++lt) {
        const bf16* xp = F + (size_t)(b * SEQ + 64 * (lt * 32 + li) + l2) * 256 + g * 64 + 8 * h;
        const bf16x8 x0 = ldg8(xp), x1 = ldg8(xp + 16), x2 = ldg8(xp + 32), x3 = ldg8(xp + 48);
        f32x16 c0 = zero16(), c1 = zero16();
        c0 = mma32(x0, idf[0], c0); c0 = mma32(x1, idf[1], c0);
        c1 = mma32(x2, idf[0], c1); c1 = mma32(x3, idf[1], c1);
        xb[lt][0][0] = accB<0>(c0); xb[lt][0][1] = accB<1>(c0); xb[lt][1][0] = accB<0>(c1); xb[lt][1][1] = accB<1>(c1);
    }
#pragma unroll 1
    for (int kb = 0; kb < 4; ++kb) {
        f32x16 acc[2][2];
#pragma unroll
        for (int ri = 0; ri < 2; ++ri) { acc[ri][0] = zero16(); acc[ri][1] = zero16();
            const bf16* wp = W128T + ((size_t)ri * 128 + kb * 32 + li) * 128 + 4 * h;
#pragma unroll
            for (int lt = 0; lt < 4; ++lt)
#pragma unroll
                for (int s = 0; s < 2; ++s) { const bf16x8 wf = ldg8p(wp + lt * 32 + 16 * s);
                    acc[ri][0] = mma32(wf, xb[lt][0][s], acc[ri][0]); acc[ri][1] = mma32(wf, xb[lt][1][s], acc[ri][1]); } }
#pragma unroll
        for (int q = 0; q < 4; ++q) { const int k1 = kb * 32 + 8 * q + 4 * h;
            const f32x4 tc = *(const f32x4*)(TWC + l2 * 128 + k1), ts = *(const f32x4*)(TWS + l2 * 128 + k1);
#pragma unroll
            for (int j = 0; j < 4; ++j)
#pragma unroll
                for (int ct = 0; ct < 2; ++ct) { const float ar = acc[0][ct][4 * q + j], ai = acc[1][ct][4 * q + j];
                    const float br = ar * tc[j] + ai * ts[j], bi = ai * tc[j] - ar * ts[j];
                    bf16* o = FB + ((((size_t)(b * 4 + g) * 128 + k1 + j) * 2) * 64 + l2) * 64 + ct * 32 + li;
                    o[0] = (bf16)(pk2(br, 0.f) & 0xffffu); o[64 * 64] = (bf16)(pk2(bi, 0.f) & 0xffffu); } }
    }
}
__device__ __forceinline__ void fft2_item(const bf16* FB, const bf16* FCT, const bf16* W64T, bf16* MIX, int item, int lane) {
    const int mh = item & 1, k1 = (item >> 1) & 127, g = (item >> 8) & 3, b = item >> 10, li = lane & 31, h = lane >> 5;
    const bf16* br = FB + (((size_t)(b * 4 + g) * 128 + k1) * 2) * 64 * 64; const bf16* bi = br + 64 * 64;
    const bf16* fc = FCT + (size_t)(mh * 32 + li) * 64 + 8 * h; const bf16* fs = fc + 64 * 64; const bf16* fn = fc + 2 * 64 * 64;
    bf16x8 eb[2][2][2];
#pragma unroll
    for (int lt = 0; lt < 2; ++lt) { f32x16 er = zero16(), ei = zero16();
#pragma unroll
        for (int s = 0; s < 4; ++s) { const bf16x8 ar = ldg8(br + (size_t)(lt * 32 + li) * 64 + 16 * s + 8 * h), ai = ldg8(bi + (size_t)(lt * 32 + li) * 64 + 16 * s + 8 * h);
            const bf16x8 c = ldg8(fc + 16 * s), sn = ldg8(fs + 16 * s), ns = ldg8(fn + 16 * s);
            er = mma32(ar, c, er); er = mma32(ai, sn, er); ei = mma32(ai, c, ei); ei = mma32(ar, ns, ei); }
        eb[lt][0][0] = accB<0>(er); eb[lt][0][1] = accB<1>(er); eb[lt][1][0] = accB<0>(ei); eb[lt][1][1] = accB<1>(ei); }
#pragma unroll
    for (int kt = 0; kt < 2; ++kt) { f32x16 o = zero16();
        const bf16* wc = W64T + (size_t)(kt * 32 + li) * 64 + 4 * h; const bf16* wsn = wc + 64 * 64;
#pragma unroll
        for (int lt = 0; lt < 2; ++lt)
#pragma unroll
            for (int s = 0; s < 2; ++s) { o = mma32(ldg8p(wc + lt * 32 + 16 * s), eb[lt][0][s], o); o = mma32(ldg8p(wsn + lt * 32 + 16 * s), eb[lt][1][s], o); }
#pragma unroll
        for (int rg = 0; rg < 16; ++rg) { const int k2 = kt * 32 + DROW(rg, h);
            MIX[(size_t)(b * SEQ + k1 + 128 * k2) * 1024 + g * 64 + mh * 32 + li] = (bf16)(pk2(o[rg], 0.f) & 0xffffu); } }
}
__device__ __forceinline__ void fftc_item(const bf16* F, const bf16* FCT, const bf16* W256T, bf16* MIX, int item, int lane) {
    const int mh = item & 1, kb = (item >> 1) & 7, g = (item >> 4) & 3, b = item >> 6, li = lane & 31, h = lane >> 5;
    const bf16* fc = FCT + (size_t)(mh * 32 + li) * 64 + 8 * h; const bf16* fn = fc + 2 * 64 * 64;
    const bf16* wc = W256T + (size_t)(kb * 32 + li) * 256 + 4 * h; const bf16* wsn = wc + 256 * 256;
    f32x16 o = zero16();
#pragma unroll 1
    for (int lt = 0; lt < 8; ++lt) { f32x16 zr = zero16(), zi = zero16();
        const bf16* xp = F + (size_t)(LROWS + b * CTXL + lt * 32 + li) * 256 + g * 64 + 8 * h;
#pragma unroll
        for (int s = 0; s < 4; ++s) { const bf16x8 x = ldg8(xp + 16 * s); zr = mma32(x, ldg8(fc + 16 * s), zr); zi = mma32(x, ldg8(fn + 16 * s), zi); }
        o = mma32(ldg8p(wc + lt * 32), accB<0>(zr), o); o = mma32(ldg8p(wc + lt * 32 + 16), accB<1>(zr), o);
        o = mma32(ldg8p(wsn + lt * 32), accB<0>(zi), o); o = mma32(ldg8p(wsn + lt * 32 + 16), accB<1>(zi), o); }
#pragma unroll
    for (int rg = 0; rg < 16; ++rg) { const int k = kb * 32 + DROW(rg, h);
        MIX[(size_t)(LROWS + b * CTXL + k) * 1024 + g * 64 + mh * 32 + li] = (bf16)(pk2(o[rg], 0.f) & 0xffffu); }
}
__device__ __forceinline__ void row_ld_f32(const float* p, int lane, f32x4 (&v)[4]) {
#pragma unroll
    for (int j = 0; j < 4; ++j) v[j] = *(const f32x4*)(p + 256 * j + 4 * lane); }
__device__ __forceinline__ void row_ld_bf16(const bf16* p, int lane, f32x4 (&v)[4]) {
#pragma unroll
    for (int j = 0; j < 4; ++j) { const u32x2 w = *(const u32x2*)(p + 256 * j + 4 * lane); v[j] = (f32x4){bflo(w.x), bfhi(w.x), bflo(w.y), bfhi(w.y)}; } }
__device__ __forceinline__ void row_ld_part(const float* P, int nslice, int r, int lane, f32x4 (&v)[4]) {
#pragma unroll
    for (int j = 0; j < 4; ++j) { const float* p = P + ((size_t)((((r - LROWS) >> 8) * 4 + j) * nslice) * 256 + (r & 255)) * 256 + 4 * lane; f32x4 s = *(const f32x4*)p;
        for (int k = 1; k < nslice; ++k) s = s + *(const f32x4*)(p + (size_t)k * 65536);
        v[j] = s; } }
__device__ __forceinline__ void row_st_f32(float* p, int lane, const f32x4 (&v)[4]) {
#pragma unroll
    for (int j = 0; j < 4; ++j) *(f32x4*)(p + 256 * j + 4 * lane) = v[j]; }
__device__ __forceinline__ void row_st_bf16(bf16* p, int lane, const f32x4 (&v)[4]) {
#pragma unroll
    for (int j = 0; j < 4; ++j) { u32x2 w; w.x = pk2(v[j][0], v[j][1]); w.y = pk2(v[j][2], v[j][3]); *(u32x2*)(p + 256 * j + 4 * lane) = w; } }
__device__ __forceinline__ float row_rstd(const f32x4 (&v)[4]) { float s = 0.f;
#pragma unroll
    for (int j = 0; j < 4; ++j) s += (v[j][0] * v[j][0] + v[j][1] * v[j][1]) + (v[j][2] * v[j][2] + v[j][3] * v[j][3]);
    return __builtin_amdgcn_rsqf(wave_sum(s) * (1.f / 1024.f) + EPSN); }
__device__ __forceinline__ void row_modnorm(const f32x4 (&x)[4], const float* g, const float* sc, const float* sh, int lane, f32x4 (&hh)[4]) {
    const float rs = row_rstd(x); f32x4 gv[4], scv[4], shv[4]; row_ld_f32(g, lane, gv); row_ld_f32(sc, lane, scv); row_ld_f32(sh, lane, shv);
#pragma unroll
    for (int j = 0; j < 4; ++j) hh[j] = x[j] * rs * gv[j] * (scv[j] + 1.f) + shv[j]; }
__device__ __forceinline__ void row_resid(f32x4 (&x)[4], const f32x4 (&t)[4], const float* g, const float* gate, int lane) {
    const float rs = row_rstd(t); f32x4 gv[4], ga[4]; row_ld_f32(g, lane, gv); row_ld_f32(gate, lane, ga);
#pragma unroll
    for (int j = 0; j < 4; ++j) x[j] = x[j] + ga[j] * (t[j] * rs * gv[j]); }

struct NormCfg {
    const float* xin_lat; const float* xin_ctx;
    float* xout_lat; float* xout_ctx;
    const bf16* trow;
    const float* tpart; int npart;
    const float* gA; const float* modA; int gate_off;
    const float* gB; const float* modB; int sc_off, sh_off; bf16* hout;
    int nrows;
};
__device__ __forceinline__ void norm_rows(const NormCfg& C, int wslot, int NW, int lane) {
    const int nlat = C.nrows < LROWS ? C.nrows : LROWS;
    int r = wslot;
    if (r < nlat) {
        int cur = -1; f32x4 gav[4], scv[4], shv[4];
        f32x4 xn[4]; u32x2 tn[4];
#pragma unroll
        for (int j = 0; j < 4; ++j) { tn[j] = (u32x2){0u, 0u}; gav[j] = scv[j] = shv[j] = (f32x4){0.f, 0.f, 0.f, 0.f}; }
        row_ld_f32(C.xin_lat + (size_t)r * D, lane, xn);
        if (C.trow) {
#pragma unroll
            for (int j = 0; j < 4; ++j) tn[j] = *(const u32x2*)(C.trow + (size_t)r * D + 256 * j + 4 * lane); }
        for (; r < nlat; r += NW) {
            f32x4 x[4]; u32x2 tr[4];
#pragma unroll
            for (int j = 0; j < 4; ++j) { x[j] = xn[j]; tr[j] = tn[j]; }
            const int r2 = r + NW;
            if (r2 < nlat) { row_ld_f32(C.xin_lat + (size_t)r2 * D, lane, xn);
                if (C.trow) {
#pragma unroll
                    for (int j = 0; j < 4; ++j) tn[j] = *(const u32x2*)(C.trow + (size_t)r2 * D + 256 * j + 4 * lane); } }
            const int ci = r < SEQ ? 0 : 1;
            if (ci != cur) { cur = ci;
                if (C.trow) row_ld_f32(C.modA + (size_t)ci * 6144 + C.gate_off, lane, gav);
                if (C.gB) { row_ld_f32(C.modB + (size_t)ci * 6144 + C.sc_off, lane, scv); row_ld_f32(C.modB + (size_t)ci * 6144 + C.sh_off, lane, shv); } }
            if (C.trow) { f32x4 t[4], gAv[4]; row_ld_f32(C.gA, lane, gAv);
#pragma unroll
                for (int j = 0; j < 4; ++j) t[j] = (f32x4){bflo(tr[j].x), bfhi(tr[j].x), bflo(tr[j].y), bfhi(tr[j].y)};
                const float rs = row_rstd(t);
#pragma unroll
                for (int j = 0; j < 4; ++j) x[j] = x[j] + gav[j] * (t[j] * rs * gAv[j]);
                row_st_f32(C.xout_lat + (size_t)r * D, lane, x); }
            if (C.gB) { f32x4 gBv[4]; row_ld_f32(C.gB, lane, gBv); const float rs = row_rstd(x); f32x4 hh[4];
#pragma unroll
                for (int j = 0; j < 4; ++j) hh[j] = x[j] * rs * gBv[j] * (scv[j] + 1.f) + shv[j];
                row_st_bf16(C.hout + (size_t)r * D, lane, hh); }
        }
    }
    for (r = LROWS + wslot; r < C.nrows; r += NW) {
        f32x4 x[4]; row_ld_f32(C.xin_ctx + (size_t)(r - LROWS) * D, lane, x);
        if (C.trow) { f32x4 t[4]; if (C.tpart) row_ld_part(C.tpart, C.npart, r, lane, t); else row_ld_bf16(C.trow + (size_t)r * D, lane, t);
            row_resid(x, t, C.gA, C.modA + (size_t)2 * 6144 + C.gate_off, lane); row_st_f32(C.xout_ctx + (size_t)(r - LROWS) * D, lane, x); }
        if (C.gB) { f32x4 hh[4]; row_modnorm(x, C.gB, C.modB + (size_t)2 * 6144 + C.sc_off, C.modB + (size_t)2 * 6144 + C.sh_off, lane, hh); row_st_bf16(C.hout + (size_t)r * D, lane, hh); }
    }
}

__device__ __forceinline__ void transpose_item(const float* W, int ldw, int k0, int n0, bf16* dst, int ldd, float scale, LAS float* scr, int lane) {
#pragma unroll 8
    for (int i = 0; i < 32; ++i) { const int kk = 2 * i + (lane >> 5); scr[kk * 33 + (lane & 31)] = W[(size_t)(k0 + kk) * ldw + n0 + (lane & 31)]; }
    LDS_WAIT(); asm volatile("" ::: "memory");
    const int c = lane & 7;
#pragma unroll
    for (int j = 0; j < 4; ++j) { const int n = (lane >> 3) + 8 * j; const LAS float* s = scr + (8 * c) * 33 + n;
        u32x4 o; o.x = pk2(s[0 * 33] * scale, s[1 * 33] * scale); o.y = pk2(s[2 * 33] * scale, s[3 * 33] * scale); o.z = pk2(s[4 * 33] * scale, s[5 * 33] * scale); o.w = pk2(s[6 * 33] * scale, s[7 * 33] * scale);
        *(u32x4*)(dst + (size_t)n * ldd + k0 + 8 * c) = o; }
    LDS_WAIT(); asm volatile("" ::: "memory");
}
#ifndef MK_MODE
#define MK_MODE 1
#endif
#ifndef MK_LAST
#define MK_LAST 24
#endif
constexpr int NPHASE = 24;
struct Args { const float* in[31]; float* out; unsigned char* ws; int ph_lo, ph_hi, li, pad; };


struct TrJob { const float* src; bf16* dst; int ldw, k0, n0, ldd; float scale; };
#define CAS __attribute__((address_space(4)))
__device__ __forceinline__ void tr_decode(int it, const CAS Args* ap_, unsigned char* ws, TrJob& J) {
#define TIN(k) ((const float*)(const GAS float*)ap_->in[k])
    int kb; J.scale = 1.f;
    if (it < 43008) { const int e = it / 5376, r = it % 5376, w = r / 1792, li = r % 1792;
        if (w < 2) { J.src = TIN(28 + w) + (size_t)e * 1024 * DFE; J.ldw = DFE; kb = li / 112; J.n0 = (li % 112) * 32; J.ldd = 1024;
            J.dst = (bf16*)(ws + WS_MOE1) + ((size_t)e * 7168 + 256 * (J.n0 / 128) + (J.n0 % 128) + 128 * w) * 1024; }
        else { J.src = TIN(30) + (size_t)e * DFE * 1024; J.ldw = 1024; kb = li / 32; J.n0 = (li % 32) * 32; J.ldd = DFE; J.dst = (bf16*)(ws + WS_MOE2) + ((size_t)e * 1024 + J.n0) * DFE; }
    } else if (it < 47232) { const int r = it - 43008, w = r / 1408, li = r % 1408;
        if (w < 2) { J.src = TIN(23 + w); J.ldw = DFF; kb = li / 88; J.n0 = (li % 88) * 32; J.ldd = 1024; J.dst = (bf16*)(ws + WS_FFN1) + (size_t)(256 * (J.n0 / 128) + (J.n0 % 128) + 128 * w) * 1024; }
        else { J.src = TIN(25); J.ldw = 1024; kb = li / 32; J.n0 = (li % 32) * 32; J.ldd = DFF; J.dst = (bf16*)(ws + WS_FFN2) + (size_t)J.n0 * DFF; }
    } else { const int r = it - 47232, l = r / 4384, q = r % 4384;
        if (q < 3328) { const int t = q / 128, li = q % 128; kb = li / 8; const int nb = li % 8;
            const int srcc = t < 4 ? 256 * t : (t < 7 ? 256 * (t + 1) : (t < 23 ? 2304 + 256 * (t - 7) : (t == 23 ? 768 : (t == 24 ? 1024 : 2048))));
            J.src = TIN(7) + (size_t)l * 1024 * 6400; J.ldw = 6400; J.n0 = srcc + 32 * nb; J.ldd = 1024; J.dst = (bf16*)(ws + WS_WIN) + ((size_t)(l * 26 + t) * 256 + 32 * nb) * 1024; J.scale = (t == 3 || t == 23) ? 0.125f : 1.f; }
        else if (q < 3360) { const int li = q - 3328; kb = li / 8; J.n0 = (li % 8) * 32; J.src = TIN(16) + (size_t)l * 65536; J.ldw = 256; J.ldd = 256; J.dst = (bf16*)(ws + WS_WGLU) + ((size_t)l * 256 + J.n0) * 256; }
        else if (q < 3872) { const int li = q - 3360, bb = li / 128, li2 = li % 128; kb = li2 / 32; J.n0 = (li2 % 32) * 32; J.src = TIN(21) + (size_t)(l * 4 + bb) * 256 * 1024; J.ldw = 1024; J.ldd = 256; J.dst = (bf16*)(ws + WS_WBR) + ((size_t)(l * 4 + bb) * 1024 + J.n0) * 256; }
        else { const int li = q - 3872; kb = li / 32; J.n0 = (li % 32) * 32; J.src = TIN(22) + (size_t)l * 1024 * 1024; J.ldw = 1024; J.ldd = 1024; J.dst = (bf16*)(ws + WS_WOUT) + ((size_t)l * 1024 + J.n0) * 1024; }
    }
    J.k0 = kb * 64;
#undef TIN
}
__device__ __forceinline__ void tr_load(const TrJob& J, int lane, float (&v)[32]) {
#pragma unroll
    for (int i = 0; i < 32; ++i) { const int kk = 2 * i + (lane >> 5); v[i] = J.src[(size_t)(J.k0 + kk) * J.ldw + J.n0 + (lane & 31)]; } }
__device__ __forceinline__ void tr_store(const TrJob& J, int lane, const float (&v)[32], LAS float* scr) {
#pragma unroll
    for (int i = 0; i < 32; ++i) { const int kk = 2 * i + (lane >> 5); scr[kk * 33 + (lane & 31)] = v[i]; }
    LDS_WAIT(); asm volatile("" ::: "memory");
    const int c = lane & 7;
#pragma unroll
    for (int j = 0; j < 4; ++j) { const int n = (lane >> 3) + 8 * j; const LAS float* s = scr + (8 * c) * 33 + n; const float sc = J.scale;
        u32x4 o; o.x = pk2(s[0 * 33] * sc, s[1 * 33] * sc); o.y = pk2(s[2 * 33] * sc, s[3 * 33] * sc); o.z = pk2(s[4 * 33] * sc, s[5 * 33] * sc); o.w = pk2(s[6 * 33] * sc, s[7 * 33] * sc);
        *(u32x4*)(J.dst + (size_t)n * J.ldd + J.k0 + 8 * c) = o; }
    LDS_WAIT(); asm volatile("" ::: "memory");
}

__device__ __forceinline__ void cs2pi(int m, int N, float& c, float& s) { sincospif(2.0f * (float)(m % N) / (float)N, &s, &c); }

__global__ void __launch_bounds__(NTHREADS, 2) mk_fwd(Args args) {
    extern __shared__ __attribute__((aligned(16))) unsigned char lds_raw[];
    LAS unsigned char* lds = (LAS unsigned char*)lds_raw;
    const int tid0 = threadIdx.x, wave = __builtin_amdgcn_readfirstlane(tid0 >> 6);
    const int G = gridDim.x, bx = blockIdx.x, vcu = (G % 8 == 0) ? (bx % 8) * (G / 8) + bx / 8 : bx;
    const int wslot = wave * G + vcu, NW = G * NWAVES;
    volatile LAS unsigned* lctl = (volatile LAS unsigned*)(lds + LDSCTL_OFF);
    for (int u = tid0; u < (LDS_BYTES - LDSCTL_OFF) / 4; u += NTHREADS) lctl[u] = 0u;
    __syncthreads();
    const int lo = args.ph_lo, hi = args.ph_hi, bli = args.li;
#ifdef MK_STAMP_PHASE
    if (wave == 0) *(volatile LAS unsigned long long*)(lctl + 64) = __builtin_amdgcn_s_memrealtime();
#endif
    { XcdBarrier b0 = xcd_barrier_post((unsigned*)(args.ws + WS_CTL) + CW_BAR + bli * XCD_BAR_WORDS, lctl + LW_BAR); (void)b0; }
#define IN(k) (lo <= (k) && (k) < hi)
#ifndef MK_REP_MASK
#define MK_REP_MASK 0u
#endif
#define NREP(k) (((MK_REP_MASK >> (k)) & 1u) ? 2 : 1)
#define FORCE_BAR do { PH_BEGIN XcdBarrier b_; b_.bar = (unsigned*)(ws + WS_CTL) + CW_BAR + bli * XCD_BAR_WORDS; b_.x = xb_xcc_id(); b_.st = lctl + LW_BAR; xcd_barrier(b_); } while (0)
#ifdef MK_STAMP_PHASE
#define STAMP_AT(k) do { if (wave == 0) { if ((k) == MK_STAMP_PHASE - 1) *(volatile LAS unsigned long long*)(lctl + 64) = __builtin_amdgcn_s_memrealtime(); if ((k) == MK_STAMP_PHASE) *(volatile LAS unsigned long long*)(lctl + 66) = __builtin_amdgcn_s_memrealtime(); } } while (0)
#else
#define STAMP_AT(k) do { } while (0)
#endif
#define SEAM(k) do { if (IN(k) && IN((k) + 1)) { PH_BEGIN XcdBarrier b_; b_.bar = (unsigned*)(ws + WS_CTL) + CW_BAR + bli * XCD_BAR_WORDS; b_.x = xb_xcc_id(); b_.st = lctl + LW_BAR; xcd_barrier(b_); } STAMP_AT(k); } while (0)
#define PH_BEGIN int tid; { int l_; asm volatile("v_mbcnt_lo_u32_b32 %0, -1, 0\n\tv_mbcnt_hi_u32_b32 %0, -1, %0" : "=v"(l_)); tid = wave * 64 + (l_ & 63); } const CAS Args* ap_ = (const CAS Args*)__builtin_amdgcn_kernarg_segment_ptr(); asm volatile("" : "+s"(ap_)); unsigned char* ws = (unsigned char*)(GAS unsigned char*)ap_->ws; const int lane = tid & 63; (void)lane;
#define AIN(k) ((const float*)(const GAS float*)ap_->in[k])
#define AOUT ((float*)(GAS float*)ap_->out)
#define MODp ((float*)(ws + CTL_MOD_OFF))
#define ctxbuf ((float*)(ws + WS_CTXBUF))
#define Hh ((bf16*)(ws + WS_H))
#define MIX ((bf16*)(ws + WS_MIX))
#define INP ((bf16*)(ws + WS_INP))
#define Tt ((bf16*)(ws + WS_T))

    for (int rep_ = 0; rep_ < NREP(0); ++rep_) if (IN(0)) { if (rep_) { FORCE_BAR; } PH_BEGIN
        for (int it = bx; it < 32; it += G) {
            const int l = it >> 4, g = it & 15;
            LAS f32x2* apow = (LAS f32x2*)lds; LAS f32x2* bbar = (LAS f32x2*)(lds + 8704); LAS f32x2* Cc = (LAS f32x2*)(lds + 16896); LAS float* Kt = (LAS float*)(lds + 25088);
            for (int dir = 0; dir < 2; ++dir) { const size_t pg = (size_t)(l * 2 + dir) * 16 + g;
                if (tid < 64) { const int p = tid;
                    const float are = AIN(8)[pg * 64 + p], aim = AIN(9)[pg * 64 + p], dt = expf(AIN(10)[pg]);
                    for (int t = 0; t <= 16; ++t) { const float mag = expf(are * dt * (float)t); float sn, cs; sincosf(aim * dt * (float)t, &sn, &cs); apow[t * 64 + p] = (f32x2){mag * cs, mag * sn}; }
                    const f32x2 a = apow[64 + p]; const float nr = a.x - 1.f, ni = a.y, den = 1.f / (are * are + aim * aim);
                    const float cr = (nr * are + ni * aim) * den, ci = (ni * are - nr * aim) * den;
                    for (int h = 0; h < 16; ++h) { const float br = AIN(11)[(pg * 64 + p) * 16 + h], bi = AIN(12)[(pg * 64 + p) * 16 + h]; bbar[p * 16 + h] = (f32x2){cr * br - ci * bi, cr * bi + ci * br}; }
                    *(f32x2*)((float*)(ws + WS_A16) + (pg * 64 + p) * 2) = apow[16 * 64 + p];
                }
                for (int i = tid; i < 1024; i += NTHREADS) Cc[i] = (f32x2){AIN(13)[pg * 1024 + i], AIN(14)[pg * 1024 + i]};
                __syncthreads();
                bf16* M1 = (bf16*)(ws + WS_S5M1) + ((size_t)(l * 16 + g) * 2 + dir) * 128 * 256;
                for (int v = tid; v < 4096; v += NTHREADS) { const int row = v >> 5, col0 = (v & 31) * 8, j = col0 >> 4, h0 = col0 & 15, p = row >> 1, ri = row & 1;
                    const f32x2 pw = apow[(dir == 0 ? 15 - j : j) * 64 + p]; float vals[8];
#pragma unroll
                    for (int hh = 0; hh < 8; ++hh) { const f32x2 bb = bbar[p * 16 + h0 + hh]; vals[hh] = ri ? pw.x * bb.y + pw.y * bb.x : pw.x * bb.x - pw.y * bb.y; }
                    *(bf16x8*)(M1 + ((((col0 >> 4) * 4 + (row >> 5)) * 64 + ((col0 >> 3) & 1) * 32 + (row & 31)) * 8)) = pack8(vals); }
                bf16* TAB = (bf16*)(ws + WS_S5TAB) + (size_t)(l * 16 + g) * 256 * 512;
                for (int v = tid; v < 4096; v += NTHREADS) { const int row = v >> 4, cv = v & 15, i = row >> 4, ho = row & 15; float vals[8];
#pragma unroll
                    for (int pp = 0; pp < 4; ++pp) { const int p = cv * 4 + pp; const f32x2 cc = Cc[ho * 64 + p];
                        const f32x2 pw = apow[(dir == 0 ? i + 1 : 16 - i) * 64 + p]; vals[2 * pp] = cc.x * pw.x - cc.y * pw.y; vals[2 * pp + 1] = -(cc.x * pw.y + cc.y * pw.x); }
                    { const int colt = 256 + dir * 128 + cv * 8; *(bf16x8*)(TAB + (((((row >> 7) * 32 + (colt >> 4)) * 4 + ((row >> 5) & 3)) * 64 + ((colt >> 3) & 1) * 32 + (row & 31)) * 8)) = pack8(vals); } }
                for (int e = tid; e < 4096; e += NTHREADS) { const int t = e >> 8, ho = (e >> 4) & 15, h = e & 15; float acc = 0.f;
#pragma unroll 8
                    for (int p = 0; p < 64; ++p) { const f32x2 cc = Cc[ho * 64 + p], pw = apow[t * 64 + p], bb = bbar[p * 16 + h];
                        const float xr = cc.x * pw.x - cc.y * pw.y, xi = cc.x * pw.y + cc.y * pw.x; acc += xr * bb.x - xi * bb.y; }
                    Kt[dir * 4096 + e] = acc; }
                __syncthreads();
            }
            for (int v = tid; v < 8192; v += NTHREADS) { const int row = v >> 5, col0 = (v & 31) * 8, i = row >> 4, ho = row & 15, j = col0 >> 4, h0 = col0 & 15; float vals[8];
#pragma unroll
                for (int hh = 0; hh < 8; ++hh) { const int h = h0 + hh;
                    vals[hh] = j < i ? Kt[(i - j) * 256 + ho * 16 + h] : (j > i ? Kt[4096 + (j - i) * 256 + ho * 16 + h] : Kt[ho * 16 + h] + Kt[4096 + ho * 16 + h] + (ho == h ? AIN(15)[l * 256 + g * 16 + h] : 0.f)); }
                *(bf16x8*)((bf16*)(ws + WS_S5TAB) + (size_t)(l * 16 + g) * 256 * 512 + (((((row >> 7) * 32 + (col0 >> 4)) * 4 + ((row >> 5) & 3)) * 64 + ((col0 >> 3) & 1) * 32 + (row & 31)) * 8)) = pack8(vals); }
            __syncthreads();
        }
        __syncthreads();
        for (int it = (bx >= 32 ? bx - 32 : bx + G - 32); it < 192; it += G) { const int l = it / 96, cb = it % 96, col = cb * 64 + lane, ks = wave;
            const float* wm = AIN(4) + ((size_t)l * 1024 + ks * 128) * 6144 + col; float a0 = 0.f, a1 = 0.f, a2 = 0.f;
#pragma unroll 8
            for (int k = 0; k < 128; ++k) { const float w = wm[(size_t)k * 6144]; const int kk = ks * 128 + k;
                const float c0 = AIN(1)[kk], c1 = AIN(1)[1024 + kk], c2 = AIN(3)[kk];
                a0 += w * (c0 / (1.f + __expf(-c0))); a1 += w * (c1 / (1.f + __expf(-c1))); a2 += w * (c2 / (1.f + __expf(-c2))); }
            LAS float* part = (LAS float*)lds;
            part[(wave * 3 + 0) * 64 + lane] = a0; part[(wave * 3 + 1) * 64 + lane] = a1; part[(wave * 3 + 2) * 64 + lane] = a2;
            __syncthreads();
            if (tid < 192) { const int i = tid >> 6, c = tid & 63; float sacc = AIN(5)[l * 6144 + cb * 64 + c];
#pragma unroll
                for (int w = 0; w < 8; ++w) sacc += part[(w * 3 + i) * 64 + c];
                MODp[(size_t)(l * 3 + i) * 6144 + cb * 64 + c] = sacc; }
            __syncthreads();
        }
        { LAS float* scr = (LAS float*)(lds + wave * 16384);
          unsigned* qh = (unsigned*)(ws + WS_CTL) + CW_QHEAD;
          int q = bx & 7;
          for (int tries = 0; tries < 8; ) {
            unsigned base = 0u; if (lane == 0) base = __hip_atomic_fetch_add(qh + 64 * q, 2u, __ATOMIC_RELAXED, __HIP_MEMORY_SCOPE_AGENT);
            base = (unsigned)__builtin_amdgcn_readfirstlane((int)base);
            if (base >= 7000u) { q = (q + 1) & 7; ++tries; continue; }
            float va[32], vb[32]; TrJob ja, jb; const bool two = base + 1u < 7000u;
            tr_decode(q * 7000 + (int)base, ap_, ws, ja); tr_load(ja, lane, va);
            tr_decode(q * 7000 + (int)base + (two ? 1 : 0), ap_, ws, jb); tr_load(jb, lane, vb);
            tr_store(ja, lane, va, scr); if (two) tr_store(jb, lane, vb, scr);
          } }
        for (int v = wslot * 64 + lane; v < 32 * SEQ; v += NW * 64) { const int p = v >> 13, t = v & 8191; const float pos = (float)(p < 16 ? (t >> 6) : (t & 63));
            const float inv = 1.0f / powf(10000.f, (float)(p & 15) / 16.f); float sn, cs; sincosf(pos * inv, &sn, &cs);
            ((float*)(ws + WS_COST))[v] = cs; ((float*)(ws + WS_SINT))[v] = sn; ((float*)(ws + WS_COSN))[t * 32 + p] = cs; ((float*)(ws + WS_SINN))[t * 32 + p] = sn; }
        for (int v = wslot * 64 + lane; v < 192512; v += NW * 64) { float c, s;
            if (v < 32768) { const int ri = v >> 14, k1 = (v >> 7) & 127, l1 = v & 127; cs2pi(k1 * l1, 128, c, s); const float sc = 0.08838834764831845f;
                ((bf16*)(ws + WS_W128T))[v] = (bf16)(pk2(ri ? -s * sc : c * sc, 0.f) & 0xffffu); }
            else if (v < 40960) { const int u = v - 32768, l2 = u >> 7, k1 = u & 127; cs2pi(k1 * l2, 8192, c, s); ((float*)(ws + WS_TWC))[u] = c; ((float*)(ws + WS_TWS))[u] = s; }
            else if (v < 53248) { const int u = v - 40960, w = u >> 12, m = (u >> 6) & 63, cc = u & 63; cs2pi(m * cc, 64, c, s);
                ((bf16*)(ws + WS_FCT))[u] = (bf16)(pk2((w == 0 ? c : (w == 1 ? s : -s)) * 0.125f, 0.f) & 0xffffu); }
            else if (v < 61440) { const int u = v - 53248, w = u >> 12, k2 = (u >> 6) & 63, l2 = u & 63; cs2pi(k2 * l2, 64, c, s); ((bf16*)(ws + WS_W64T))[u] = (bf16)(pk2((w == 0 ? c : s) * 0.125f, 0.f) & 0xffffu); }
            else { const int u = v - 61440, w = u >> 16, k = (u >> 8) & 255, l = u & 255; cs2pi(k * l, 256, c, s); ((bf16*)(ws + WS_W256T))[u] = (bf16)(pk2((w == 0 ? c : s) * 0.0625f, 0.f) & 0xffffu); }
        }
    }
    SEAM(0);

    for (int rep_ = 0; rep_ < NREP(1); ++rep_) if (IN(1)) { if (rep_) { FORCE_BAR; } PH_BEGIN
        { NormCfg C{AIN(0), AIN(2), nullptr, nullptr, nullptr, nullptr, 0, nullptr, nullptr, 0, AIN(6), MODp, 1024, 0, Hh, R}; norm_rows(C, wslot, NW, lane); }
    }
    SEAM(1);

    for (int layer = 0; layer < 2; ++layer) {
        const int pb = 1 + 11 * layer;
        const int nM = layer == 0 ? 66 : 64;
        const int nrows = layer == 0 ? R : LROWS;
#define normg (AIN(6) + (size_t)layer * 4 * D)
        for (int rep_ = 0; rep_ < NREP(pb + 1); ++rep_) if (IN(pb + 1)) { if (rep_) { FORCE_BAR; } PH_BEGIN
            gp::SchedInprojA S{(const char*)Hh, (const char*)(ws + WS_WIN) + (size_t)layer * 26 * 256 * 2048, 66, G, bx, layer == 0 ? 32 : 0};
            gp::EpiInprojA E{INP, Tt, (unsigned char*)(ws + WS_GCTX)};
            gp::gemm_phase(lds, tid, 1024, 1024, 1024, S, E);
        }
        SEAM(pb + 1);
        for (int rep_ = 0; rep_ < NREP(pb + 2); ++rep_) if (IN(pb + 2)) { if (rep_) { FORCE_BAR; } PH_BEGIN
            LAS float* rpb = (LAS float*)(lds + 98304 + 4096);
            LAS unsigned char* wl = lds + wave * 12288;
            for (int i = tid; i < 1860; i += NTHREADS) rpb[i] = AIN(20)[layer * 1860 + i] * LOG2E;
            __syncthreads();
            const int nitA = 2224 + 64 + (layer == 0 ? 64 : 0);
            for (int it = wslot; it < nitA; it += NW) {
                if (it < 1056) s5_state_item((const bf16*)(ws + WS_S5M1) + (size_t)layer * 16 * 2 * 128 * 256, INP + (size_t)R * 256, (float*)(ws + WS_HLOC), it, lane);
                else if (it < 1584) ret_kv_item(Tt, Tt + (size_t)256 * R, (const float*)(ws + WS_COST), (const float*)(ws + WS_SINT), AIN(18) + layer * 8, (float*)(ws + WS_KV), it - 1056, lane);
                else if (it < 2096) fft1_item(INP, (const bf16*)(ws + WS_W128T), (const float*)(ws + WS_TWC), (const float*)(ws + WS_TWS), (bf16*)(ws + WS_FB), it - 1584, lane);
                else if (it < 2224) rope_item(INP + (size_t)2 * R * 256, INP + (size_t)3 * R * 256, (const float*)(ws + WS_COSN), (const float*)(ws + WS_SINN), it - 2096, lane);
                else if (it < 2288) { const int j = 1984 + (it - 2224); na_item(INP + (size_t)5 * R * 256, INP + (size_t)6 * R * 256, Tt + (size_t)512 * R, MIX, rpb, wl, false, j >> 10, (j >> 3) & 127, (j >> 1) & 3, j & 1, lane); }
                else { const int j = it - 2288; na_item(INP + (size_t)5 * R * 256, INP + (size_t)6 * R * 256, Tt + (size_t)512 * R, MIX, rpb, wl, true, j >> 5, 0, (j >> 3) & 3, j & 7, lane); }
            }
            __syncthreads();
        }
        SEAM(pb + 2);
        for (int rep_ = 0; rep_ < NREP(pb + 3); ++rep_) if (IN(pb + 3)) { if (rep_) { FORCE_BAR; } PH_BEGIN
            LAS float* rpb = (LAS float*)(lds + 98304 + 4096); LAS unsigned char* wl = lds + wave * 12288;
            for (int i = tid; i < 1860; i += NTHREADS) rpb[i] = AIN(20)[layer * 1860 + i] * LOG2E;
            __syncthreads();
            for (int vs = wslot; vs < 2048; vs += NW) {
                if (vs < 64) s5_scan_item((const float*)(ws + WS_A16) + (size_t)layer * 2 * 16 * 64 * 2, (const float*)(ws + WS_HLOC), (bf16*)(ws + WS_HIN), vs, lane);
                else { const int j = vs - 64; na_item(INP + (size_t)5 * R * 256, INP + (size_t)6 * R * 256, Tt + (size_t)512 * R, MIX, rpb, wl, false, j >> 10, (j >> 3) & 127, (j >> 1) & 3, j & 1, lane);
                    if (vs >= 1024) ret_scan_item(AIN(18) + layer * 8, (const float*)(ws + WS_KV), (bf16*)(ws + WS_SPREV), vs - 1024, lane); }
            }
            __syncthreads();
        }
        SEAM(pb + 3);
        for (int rep_ = 0; rep_ < NREP(pb + 4); ++rep_) if (IN(pb + 4)) { if (rep_) { FORCE_BAR; } PH_BEGIN
            const int nit = 1056 + 2112 + 2048 + (layer == 0 ? 128 : 0);
            for (int it = wslot; it < nit; it += NW) {
                if (it < 1056) s5_out_item((const bf16*)(ws + WS_S5TAB) + (size_t)layer * 16 * 256 * 512, INP + (size_t)R * 256, (const bf16*)(ws + WS_HIN), (bf16*)(ws + WS_Z), it, lane);
                else if (it < 3168) ret_out_item(INP + (size_t)2 * R * 256, INP + (size_t)3 * R * 256, INP + (size_t)4 * R * 256, Tt + (size_t)256 * R, (const bf16*)(ws + WS_SPREV),
                                                 AIN(18) + layer * 8, AIN(19) + layer * 256, MIX, lds + wave * 12288, it - 1056, lane);
                else if (it < 5216) fft2_item((const bf16*)(ws + WS_FB), (const bf16*)(ws + WS_FCT), (const bf16*)(ws + WS_W64T), MIX, it - 3168, lane);
                else fftc_item(INP, (const bf16*)(ws + WS_FCT), (const bf16*)(ws + WS_W256T), MIX, it - 5216, lane);
            }
        }
        SEAM(pb + 4);
        for (int rep_ = 0; rep_ < NREP(pb + 5); ++rep_) if (IN(pb + 5)) { if (rep_) { FORCE_BAR; } PH_BEGIN
            { PH_BEGIN gp::SchedPlain S{(const char*)(ws + WS_Z), (const char*)(ws + WS_WGLU) + (size_t)layer * 256 * 512, (size_t)256 * 512, (size_t)256 * 512, nM, 1, G, bx, 4};
              gp::EpiGlu E{(const bf16*)(ws + WS_Z), MIX, AIN(17) + layer * 256};
              gp::gemm_phase(lds, tid, 256, 256, 256, S, E); }
            { PH_BEGIN gp::SchedPlain S{(const char*)Hh, (const char*)(ws + WS_WIN) + ((size_t)layer * 26 + 7) * 256 * 2048, (size_t)256 * 2048, (size_t)256 * 2048, 64, 16, G, bx, 16};
              gp::EpiGates E{(unsigned char*)(ws + WS_GATES)};
              gp::gemm_phase(lds, tid, 1024, 1024, 1024, S, E); }
        }
        SEAM(pb + 5);
        for (int rep_ = 0; rep_ < NREP(pb + 6); ++rep_) if (IN(pb + 6)) { if (rep_) { FORCE_BAR; } PH_BEGIN
            gp::SchedMerge S{(const char*)MIX, (const char*)(ws + WS_WBR) + (size_t)layer * 4 * 1024 * 512, layer == 0 ? 32 : 0, G, bx};
            gp::EpiMerge E{(const unsigned char*)(ws + WS_GATES), (const unsigned char*)(ws + WS_GCTX), (bf16*)(ws + WS_Y), (bf16*)(ws + WS_YP)};
            gp::gemm_phase(lds, tid, 256, 1024, 256, S, E);
        }
        SEAM(pb + 6);
        for (int rep_ = 0; rep_ < NREP(pb + 7); ++rep_) if (IN(pb + 7)) { if (rep_) { FORCE_BAR; } PH_BEGIN
            gp::SchedSplit S{(const char*)(ws + WS_Y), (const char*)(ws + WS_WOUT) + (size_t)layer * 1024 * 2048, (size_t)256 * 2048, (size_t)256 * 2048, layer == 0 ? 16 : 0, 16, G, bx,
                             (const char*)(ws + WS_YP), (size_t)256 * 2048, (size_t)CROWS * 2048, 4};
            gp::EpiPlainSplit E{(bf16*)(ws + WS_YO), 1024, (float*)(ws + WS_PARTW), 16};
            gp::gemm_phase(lds, tid, 1024, 1024, 1024, S, E);
        }
        SEAM(pb + 7);
        for (int rep_ = 0; rep_ < NREP(pb + 8); ++rep_) if (IN(pb + 8)) { if (rep_) { FORCE_BAR; } PH_BEGIN
            if (layer == 0) {
                NormCfg C{AIN(0), AIN(2), AOUT, ctxbuf, (const bf16*)(ws + WS_YO), (const float*)(ws + WS_PARTW), 16, normg + D, MODp, 2048, normg + 2 * D, MODp, 4096, 3072, Hh, R};
                norm_rows(C, wslot, NW, lane);
            } else {
                LAS float* wrs = (LAS float*)lds; LAS int* rowinfo = (LAS int*)(lds + 32768); LAS unsigned* cntL = (LAS unsigned*)(lds + 32768 + 1024); LAS unsigned* baseL = cntL + 8;
                for (int i = tid; i < 2048; i += NTHREADS) ((LAS f32x4*)wrs)[i] = ((const f32x4*)AIN(26))[i];
                int* list = (int*)(ws + WS_LIST); float* routew = (float*)(ws + WS_ROUTEW);
                for (int grp = vcu; grp < 256; grp += G) {
                    if (tid < 8) cntL[tid] = 0u;
                    __syncthreads();
                    const int r0 = grp * 64 + wave * 8; const float* md = MODp + (size_t)(3 + (r0 < SEQ ? 0 : 1)) * 6144;
                    f32x4 gav[4], scv[4], shv[4]; row_ld_f32(md + 2048, lane, gav); row_ld_f32(md + 4096, lane, scv); row_ld_f32(md + 3072, lane, shv);
                    f32x4 xn[4]; u32x2 tn[4]; row_ld_f32(AOUT + (size_t)r0 * D, lane, xn);
#pragma unroll
                    for (int j = 0; j < 4; ++j) tn[j] = *(const u32x2*)((const bf16*)(ws + WS_YO) + (size_t)r0 * D + 256 * j + 4 * lane);
                    for (int rr = 0; rr < 8; ++rr) { const int r = r0 + rr;
                        f32x4 x[4], t[4], hh[4];
#pragma unroll
                        for (int j = 0; j < 4; ++j) { x[j] = xn[j]; t[j] = (f32x4){bflo(tn[j].x), bfhi(tn[j].x), bflo(tn[j].y), bfhi(tn[j].y)}; }
                        if (rr < 7) { row_ld_f32(AOUT + (size_t)(r + 1) * D, lane, xn);
#pragma unroll
                            for (int j = 0; j < 4; ++j) tn[j] = *(const u32x2*)((const bf16*)(ws + WS_YO) + (size_t)(r + 1) * D + 256 * j + 4 * lane); }
                        { f32x4 gAv[4]; row_ld_f32(normg + D, lane, gAv); const float rs = row_rstd(t);
#pragma unroll
                          for (int j = 0; j < 4; ++j) x[j] = x[j] + gav[j] * (t[j] * rs * gAv[j]); }
                        row_st_f32(AOUT + (size_t)r * D, lane, x);
                        { f32x4 gBv[4]; row_ld_f32(normg + 2 * D, lane, gBv); const float rs = row_rstd(x);
#pragma unroll
                          for (int j = 0; j < 4; ++j) hh[j] = x[j] * rs * gBv[j] * (scv[j] + 1.f) + shv[j]; }
                        row_st_bf16(Hh + (size_t)r * D, lane, hh);
                        float lg[8];
#pragma unroll
                        for (int e = 0; e < 8; ++e) lg[e] = 0.f;
#pragma unroll
                        for (int j = 0; j < 4; ++j)
#pragma unroll
                            for (int q = 0; q < 4; ++q) { const int k = 256 * j + 4 * lane + q; const f32x4 w0 = *(const LAS f32x4*)(wrs + k * 8), w1 = *(const LAS f32x4*)(wrs + k * 8 + 4); const float hv = hh[j][q];
                                lg[0] += hv * w0[0]; lg[1] += hv * w0[1]; lg[2] += hv * w0[2]; lg[3] += hv * w0[3]; lg[4] += hv * w1[0]; lg[5] += hv * w1[1]; lg[6] += hv * w1[2]; lg[7] += hv * w1[3]; }
#pragma unroll
                        for (int e = 0; e < 8; ++e) lg[e] = wave_sum(lg[e]) + AIN(27)[e];
                        int i0 = 0; float v0 = lg[0];
#pragma unroll
                        for (int e = 1; e < 8; ++e) if (lg[e] > v0) { v0 = lg[e]; i0 = e; }
                        int i1 = i0 == 0 ? 1 : 0; float v1 = i0 == 0 ? lg[1] : lg[0];
#pragma unroll
                        for (int e = 0; e < 8; ++e) if (e != i0 && lg[e] > v1) { v1 = lg[e]; i1 = e; }
                        const float w0 = 1.f / (1.f + __expf(v1 - v0)), w1 = 1.f - w0;
                        if (lane == 0) { const unsigned s0 = __hip_atomic_fetch_add(cntL + i0, 1u, __ATOMIC_RELAXED, __HIP_MEMORY_SCOPE_WORKGROUP), s1 = __hip_atomic_fetch_add(cntL + i1, 1u, __ATOMIC_RELAXED, __HIP_MEMORY_SCOPE_WORKGROUP);
                            LAS int* ri = rowinfo + (wave * 8 + rr) * 4; ri[0] = i0; ri[1] = (int)s0; ri[2] = i1; ri[3] = (int)s1; routew[(size_t)r * 2] = w0; routew[(size_t)r * 2 + 1] = w1; }
                        if (lane < 8) ((int*)(ws + WS_SMAP))[(size_t)r * 8 + lane] = -1;
                    }
                    __syncthreads();
                    if (tid < 8) baseL[tid] = __hip_atomic_fetch_add((unsigned*)(ws + WS_CTL) + CW_MOECNT + 64 * tid, cntL[tid], __ATOMIC_RELAXED, __HIP_MEMORY_SCOPE_AGENT);
                    __syncthreads();
                    if (tid < 64) { const LAS int* ri = rowinfo + tid * 4; const int r = grp * 64 + tid;
                        list[ri[0] * LCAP + (int)baseL[ri[0]] + ri[1]] = r * 2; list[ri[2] * LCAP + (int)baseL[ri[2]] + ri[3]] = r * 2 + 1; }
                    __syncthreads();
                }
            }
        }
        SEAM(pb + 8);
        LAS unsigned* mt = (LAS unsigned*)(lds + LDSCTL_OFF) + LW_MOE;
        if (layer == 1 && (IN(pb + 9) || IN(pb + 10))) { PH_BEGIN
            if (tid == 0) { unsigned off = 0u;
                for (int e = 0; e < 8; ++e) { const unsigned c = __hip_atomic_load((unsigned*)(ws + WS_CTL) + CW_MOECNT + 64 * e, __ATOMIC_RELAXED, __HIP_MEMORY_SCOPE_AGENT); const unsigned m = (c + 255u) >> 8; mt[e] = c; mt[8 + e] = m; mt[16 + e] = off; off += m; }
                mt[24] = off; const unsigned U = off * 4u, full = (U / (unsigned)G) * (unsigned)G, rem = U - full;
                if (rem != 0u && rem <= 32u && full != 0u) { mt[25] = full; mt[26] = rem; } else { mt[25] = U; mt[26] = 0u; } }
            __syncthreads();
        }
        for (int rep_ = 0; rep_ < NREP(pb + 9); ++rep_) if (IN(pb + 9)) { if (rep_) { FORCE_BAR; } PH_BEGIN
            if (layer == 0) {
                gp::SchedPlain S{(const char*)Hh, (const char*)(ws + WS_FFN1), (size_t)256 * 2048, (size_t)256 * 2048, 66, 22, G, bx, 16};
                gp::EpiSwiglu E{(bf16*)(ws + WS_HID), DFF, false};
                gp::gemm_phase(lds, tid, 1024, 1024, 1024, S, E);
            } else {
                gp::SchedMoe1 S{(const char*)Hh, (const char*)(ws + WS_MOE1), (const int*)(ws + WS_LIST), mt, G, bx};
                gp::EpiSwiglu E{(bf16*)(ws + WS_MHID), DFE, true};
                gp::gemm_phase(lds, tid, 1024, 1024, 1024, S, E);
            }
        }
        SEAM(pb + 9);
        for (int rep_ = 0; rep_ < NREP(pb + 10); ++rep_) if (IN(pb + 10)) { if (rep_) { FORCE_BAR; } PH_BEGIN
            if (layer == 0) {
                gp::SchedSplit S{(const char*)(ws + WS_HID), (const char*)(ws + WS_FFN2), (size_t)256 * DFF * 2, (size_t)256 * DFF * 2, 11, DFF / 64, G, bx,
                                 (const char*)(ws + WS_HID) + (size_t)64 * 256 * DFF * 2, (size_t)256 * DFF * 2, 0, 11};
                gp::EpiPlainSplit E{(bf16*)(ws + WS_FO), 1024, (float*)(ws + WS_PARTF), 11};
                gp::gemm_phase(lds, tid, DFF, DFF, DFF, S, E);
            } else {
                { gp::SchedMoe2 S{(const char*)(ws + WS_MHID), (const char*)(ws + WS_MOE2), mt, G, bx};
                  gp::EpiMoeDown E{(bf16*)(ws + WS_SLOT), (const int*)(ws + WS_LIST), (const float*)(ws + WS_ROUTEW), mt};
                  gp::gemm_phase(lds, tid, DFE, DFE, DFE, S, E); }
                { PH_BEGIN gp::SchedMoe2S S{(const char*)(ws + WS_MHID), (const char*)(ws + WS_MOE2), mt, G, bx};
                  gp::EpiMoePart E{(bf16*)(ws + WS_PARTM), (const int*)(ws + WS_LIST), mt, (int*)(ws + WS_SMAP)};
                  gp::gemm_phase(lds, tid, DFE, DFE, DFE, S, E); }
            }
        }
        SEAM(pb + 10);
        for (int rep_ = 0; rep_ < NREP(pb + 11); ++rep_) if (IN(pb + 11)) { if (rep_) { FORCE_BAR; } PH_BEGIN
            if (layer == 0) { PH_BEGIN NormCfg C{AOUT, ctxbuf, AOUT, ctxbuf, (const bf16*)(ws + WS_FO), (const float*)(ws + WS_PARTF), 11, normg + 3 * D, MODp, 5120, AIN(6) + 4 * D, MODp + 3 * 6144, 1024, 0, Hh, R};
                norm_rows(C, wslot, NW, lane); }
            else { PH_BEGIN for (int r = wslot; r < nrows; r += NW) { const int ci = r < SEQ ? 0 : (r < LROWS ? 1 : 2); const float* md = MODp + (size_t)(layer * 3 + ci) * 6144;
                float* xp = r < LROWS ? AOUT + (size_t)r * D : ctxbuf + (size_t)(r - LROWS) * D;
                f32x4 x[4], t[4]; row_ld_f32(xp, lane, x);
                if (layer == 0) { if (r < LROWS) row_ld_bf16((const bf16*)(ws + WS_FO) + (size_t)r * D, lane, t); else row_ld_part((const float*)(ws + WS_PARTF), 11, r, lane, t); }
                else { typedef int i32x4 __attribute__((ext_vector_type(4)));
                    const i32x4 m0 = *(const i32x4*)((const int*)(ws + WS_SMAP) + (size_t)r * 8), m1 = *(const i32x4*)((const int*)(ws + WS_SMAP) + (size_t)r * 8 + 4);
                    if ((m0.x & m0.y & m0.z & m0.w & m1.x & m1.y & m1.z & m1.w) == -1) {
                        f32x4 t2[4]; row_ld_bf16((const bf16*)(ws + WS_SLOT) + (size_t)r * D, lane, t); row_ld_bf16((const bf16*)(ws + WS_SLOT) + ((size_t)LROWS + r) * D, lane, t2);
#pragma unroll
                        for (int j = 0; j < 4; ++j) t[j] = t[j] + t2[j];
                    } else {
#pragma unroll
                        for (int j = 0; j < 4; ++j) t[j] = (f32x4){0.f, 0.f, 0.f, 0.f};
#pragma unroll
                        for (int k = 0; k < 2; ++k) { const int ent = 2 * r + k; const i32x4 mk = k ? m1 : m0;
#pragma unroll
                            for (int j = 0; j < 4; ++j) { const int mm = j == 0 ? mk.x : (j == 1 ? mk.y : (j == 2 ? mk.z : mk.w));
                                if (mm < 0) { const u32x2 w = *(const u32x2*)((const bf16*)(ws + WS_SLOT) + ((size_t)k * LROWS + r) * D + 256 * j + 4 * lane); t[j] = t[j] + (f32x4){bflo(w.x), bfhi(w.x), bflo(w.y), bfhi(w.y)}; }
                                else { const bf16* pp = (const bf16*)(ws + WS_PARTM) + ((size_t)(mm >> 8) * 7 * 256 + (mm & 255)) * 256 + 4 * lane; f32x4 sacc = (f32x4){0.f, 0.f, 0.f, 0.f};
                                    for (int sl = 0; sl < 7; ++sl) { const u32x2 w = *(const u32x2*)(pp + (size_t)sl * 65536); sacc = sacc + (f32x4){bflo(w.x), bfhi(w.x), bflo(w.y), bfhi(w.y)}; }
                                    t[j] = t[j] + sacc * ((const float*)(ws + WS_ROUTEW))[ent]; } } } } }
                row_resid(x, t, normg + 3 * D, md + 5120, lane); row_st_f32(xp, lane, x);
                } }
        }
        SEAM(pb + 11);
    }
#ifdef MK_STAMP_PHASE
    if (MK_STAMP_PHASE == NPHASE - 1 && wave == 0) *(volatile LAS unsigned long long*)(lctl + 66) = __builtin_amdgcn_s_memrealtime();
    if (blockIdx.x == 0 && wave == 0) { const unsigned long long st0_ = *(volatile LAS unsigned long long*)(lctl + 64), st1_ = *(volatile LAS unsigned long long*)(lctl + 66); const unsigned long long target = __builtin_amdgcn_s_memrealtime() + (unsigned long long)MK_STAMP_AMP * (st1_ - st0_); while (__builtin_amdgcn_s_memrealtime() < target) __builtin_amdgcn_s_sleep(20); }
#endif
#ifdef MK_EXTRA_BARS
    for (int xb_ = 0; xb_ < MK_EXTRA_BARS; ++xb_) { FORCE_BAR; }
#endif
#undef IN
#undef SEAM
#undef PH_BEGIN
#undef normg
#undef AIN
#undef AOUT
#undef MODp
#undef ctxbuf
#undef Hh
#undef MIX
#undef INP
#undef Tt
}

__global__ void dumpk(const unsigned char* src, size_t nbytes, int isf32, float* out, size_t N, int accum) {
    const size_t i = (size_t)blockIdx.x * blockDim.x + threadIdx.x; if (i >= N) return;
    const size_t ne = isf32 ? nbytes / 4 : nbytes / 2; float s = 0.f;
    for (size_t k = i; k < ne; k += N) s += isf32 ? ((const float*)src)[k] : bf2f(((const bf16*)src)[k]);
    out[i] = accum ? out[i] + s : s;
}
extern "C" void kernel_launch(void* const* d_in, const int* in_sizes, int n_in, void* d_out, int out_size, void* d_ws, size_t ws_size, hipStream_t stream) {
    static int grid = 0;
    if (grid == 0) {
        if (n_in != 31 || out_size != LROWS * D || ws_size < WS_END) { fprintf(stderr, "kernel_launch: unexpected shapes (n_in %d, out %d, ws %zu < %zu)\n", n_in, out_size, ws_size, (size_t)WS_END); grid = -1; return; }
        int dev = 0, cus = 0, per_cu = 0;
        if (hipGetDevice(&dev) != hipSuccess || hipDeviceGetAttribute(&cus, hipDeviceAttributeMultiprocessorCount, dev) != hipSuccess) { grid = -1; return; }
        if (hipFuncSetAttribute((const void*)mk_fwd, hipFuncAttributeMaxDynamicSharedMemorySize, LDS_BYTES) != hipSuccess) { fprintf(stderr, "kernel_launch: hipFuncSetAttribute failed\n"); grid = -1; return; }
        if (hipOccupancyMaxActiveBlocksPerMultiprocessor(&per_cu, (const void*)mk_fwd, NTHREADS, LDS_BYTES) != hipSuccess || per_cu < 1) { fprintf(stderr, "kernel_launch: occupancy query says %d\n", per_cu); }
        (void)hipGetLastError();
        grid = cus;
    }
    if (grid < 0) return;
    (void)hipMemsetAsync((char*)d_ws + WS_CTL, 0, CTL_ZERO_BYTES, stream);
    Args a{};
    for (int i = 0; i < 31; ++i) a.in[i] = (const float*)d_in[i];
    a.out = (float*)d_out; a.ws = (unsigned char*)d_ws;
#if MK_MODE == 1
    a.ph_lo = 0; a.ph_hi = NPHASE; a.li = 0;
    hipLaunchKernelGGL(mk_fwd, dim3(grid), dim3(NTHREADS), LDS_BYTES, stream, a);
#else
    for (int p = 0; p < MK_LAST; ++p) { a.ph_lo = p; a.ph_hi = p + 1; a.li = p; hipLaunchKernelGGL(mk_fwd, dim3(grid), dim3(NTHREADS), LDS_BYTES, stream, a); }
#endif
#ifdef MK_DUMP_OFF
    dumpk<<<(LROWS * D + 255) / 256, 256, 0, stream>>>((const unsigned char*)d_ws + (size_t)(MK_DUMP_OFF), (size_t)(MK_DUMP_BYTES), MK_DUMP_F32, (float*)d_out, (size_t)LROWS * D, 0);
#endif
#ifdef MK_DUMP2_OFF
    dumpk<<<(LROWS * D + 255) / 256, 256, 0, stream>>>((const unsigned char*)d_ws + (size_t)(MK_DUMP2_OFF), (size_t)(MK_DUMP2_BYTES), MK_DUMP2_F32, (float*)d_out, (size_t)LROWS * D, 1);
#endif
#ifdef MK_DUMP3_OFF
    dumpk<<<(LROWS * D + 255) / 256, 256, 0, stream>>>((const unsigned char*)d_ws + (size_t)(MK_DUMP3_OFF), (size_t)(MK_DUMP3_BYTES), MK_DUMP3_F32, (float*)d_out, (size_t)LROWS * D, 1);
#endif
}
```

```cpp
#define MK_MODE 1
#include <hip/hip_runtime.h>
#include <cstdio>
#include <cstdint>

#define GAS __attribute__((address_space(1)))
#define LAS __attribute__((address_space(3)))
typedef unsigned short bf16;
typedef short bf16x8 __attribute__((ext_vector_type(8)));
typedef short bf16x4 __attribute__((ext_vector_type(4)));
typedef float f32x2 __attribute__((ext_vector_type(2)));
typedef float f32x4 __attribute__((ext_vector_type(4)));
typedef float f32x16 __attribute__((ext_vector_type(16)));
typedef unsigned u32x2 __attribute__((ext_vector_type(2)));
typedef unsigned u32x4 __attribute__((ext_vector_type(4)));

constexpr int D = 1024, SEQ = 8192, LROWS = 16384, CTXL = 256, CROWS = 512, R = 16896;
constexpr int DFF = 2816, DFE = 3584, NEXP = 8, LCAP = 16640;
constexpr int NWAVES = 8, NTHREADS = 512;
constexpr int NCH16 = R / 16;
constexpr float EPSN = 1e-6f, LOG2E = 1.4426950408889634f;

constexpr size_t MiB = 1u << 20;
constexpr size_t WS_CTL = 0, CTL_ZERO_BYTES = 1 * MiB;
constexpr int CW_TMO = 0, CW_BAR = 4096, CW_MOECNT = 98304, CW_QHEAD = 100352, CW_MQ = 102400;
constexpr size_t CTL_MOD_OFF = 512 * 1024;
constexpr size_t WS_CTXBUF = 1 * MiB;
constexpr size_t WS_COST = 3 * MiB, WS_SINT = 4 * MiB, WS_COSN = 5 * MiB, WS_SINN = 6 * MiB;
constexpr size_t WS_LIST = 7 * MiB;
constexpr size_t WS_ROUTEW = WS_LIST + 8 * LCAP * 4;
constexpr size_t WS_S5K = 8 * MiB;
constexpr size_t WS_A16 = 9 * MiB;
constexpr size_t WS_W128T = WS_A16 + 64 * 1024;
constexpr size_t WS_TWC = WS_W128T + 64 * 1024, WS_TWS = WS_TWC + 32 * 1024;
constexpr size_t WS_FCT = WS_TWS + 32 * 1024;
constexpr size_t WS_W64T = WS_FCT + 32 * 1024;
constexpr size_t WS_W256T = WS_W64T + 32 * 1024;
constexpr size_t WS_MOE1 = 10 * MiB;
constexpr size_t WS_MOE2 = 122 * MiB;
constexpr size_t WS_OTHERW = 178 * MiB;
constexpr size_t WS_WIN = 178 * MiB;
constexpr size_t WS_WBR = 204 * MiB;
constexpr size_t WS_WOUT = 208 * MiB;
constexpr size_t WS_WGLU = 212 * MiB;
constexpr size_t WS_FFN1 = 213 * MiB;
constexpr size_t WS_FFN2 = 224 * MiB;
constexpr size_t WS_S5M1 = 230 * MiB;
constexpr size_t WS_S5TAB = 234 * MiB;
constexpr size_t WS_BIG = 242 * MiB;
constexpr size_t TOK256 = (size_t)R * 256 * 2;
constexpr size_t WS_INP = WS_BIG;
constexpr size_t WS_T = WS_INP + 7 * TOK256;
constexpr size_t WS_HLOC = WS_T + 3 * TOK256;
constexpr size_t WS_HIN = WS_HLOC + 2 * TOK256;
constexpr size_t WS_KV = WS_HIN + TOK256;
constexpr size_t WS_SPREV = WS_KV + 2 * TOK256;
constexpr size_t WS_FB = WS_SPREV + TOK256;
constexpr size_t WS_GATES = WS_BIG;
constexpr size_t WS_Y = WS_BIG + 132 * MiB;
constexpr size_t WS_YO = WS_Y + 33 * MiB;
constexpr size_t WS_Z = WS_YO + 33 * MiB;
constexpr size_t WS_YP = WS_Z;
constexpr size_t WS_PARTW = WS_BIG;
constexpr size_t WS_PARTF = 340 * MiB;
constexpr size_t WS_PARTM = 416 * MiB;
constexpr size_t WS_SMAP = WS_S5K;
constexpr size_t WS_FO = WS_Y;
constexpr size_t WS_HID = WS_BIG;
constexpr size_t WS_MHID = WS_OTHERW;
constexpr size_t WS_H = 449 * MiB;
constexpr size_t WS_MIX = 482 * MiB;
constexpr size_t WS_SLOT = WS_H;
constexpr size_t WS_GCTX = 515 * MiB;
constexpr size_t WS_END = 519 * MiB;
static_assert(WS_FB + 16 * MiB <= WS_Z && WS_Z + TOK256 <= WS_H && WS_MHID + (size_t)34816 * 3584 * 2 <= WS_H && WS_W256T + 256 * 1024 <= WS_MOE1, "ws map");
static_assert(WS_PARTM + (size_t)32 * 7 * 65536 * 2 <= WS_H && WS_MHID + (size_t)34816 * 3584 * 2 <= WS_PARTM, "ws map 3");
static_assert(WS_S5TAB + 8 * MiB <= WS_BIG && WS_FFN2 + (size_t)1024 * 2816 * 2 <= WS_S5M1 && WS_ROUTEW + 32768 * 4 <= WS_S5K, "ws map 2");

constexpr int RING_BYTES = 131072, LDSCTL_OFF = RING_BYTES, LDS_BYTES = 147456;
constexpr int LW_BAR = 8, LW_MOE = 16;

#define VM_WAIT() asm volatile("s_waitcnt vmcnt(0)" ::: "memory")
#define LDS_WAIT() asm volatile("s_waitcnt lgkmcnt(0)" ::: "memory")
typedef __bf16 bf16n2 __attribute__((ext_vector_type(2)));
__device__ __forceinline__ unsigned pk2(float lo, float hi) { bf16n2 v; v.x = (__bf16)lo; v.y = (__bf16)hi; return __builtin_bit_cast(unsigned, v); }
__device__ __forceinline__ float bf2f(unsigned short b) { return __builtin_bit_cast(float, ((unsigned)b) << 16); }
__device__ __forceinline__ float bflo(unsigned w) { return __builtin_bit_cast(float, w << 16); }
__device__ __forceinline__ float bfhi(unsigned w) { return __builtin_bit_cast(float, w & 0xffff0000u); }
__device__ __forceinline__ float ex2(float x) { return __builtin_amdgcn_exp2f(x); }
__device__ __forceinline__ float rcpf_(float x) { return __builtin_amdgcn_rcpf(x); }
__device__ __forceinline__ float sigm(float x) { return rcpf_(1.f + ex2(-LOG2E * x)); }
__device__ __forceinline__ float silu_(float x) { return x * sigm(x); }
__device__ __forceinline__ float gelu_tanh(float x) { const float u = 0.7978845608028654f * (x + 0.044715f * x * x * x); const float t = 1.f - 2.f * rcpf_(1.f + ex2(2.885390081777927f * u)); return 0.5f * x * (1.f + t); }
__device__ __forceinline__ float xor32_sum(float v) { const unsigned u = __builtin_bit_cast(unsigned, v); const auto r = __builtin_amdgcn_permlane32_swap(u, u, false, false); return __builtin_bit_cast(float, (unsigned)r[0]) + __builtin_bit_cast(float, (unsigned)r[1]); }
__device__ __forceinline__ float xor32_max(float v) { const unsigned u = __builtin_bit_cast(unsigned, v); const auto r = __builtin_amdgcn_permlane32_swap(u, u, false, false); return fmaxf(__builtin_bit_cast(float, (unsigned)r[0]), __builtin_bit_cast(float, (unsigned)r[1])); }
template <int X> __device__ __forceinline__ float swz_xor(float v) { return __builtin_bit_cast(float, __builtin_amdgcn_ds_swizzle(__builtin_bit_cast(int, v), (X << 10) | 0x1f)); }
__device__ __forceinline__ float wave_sum(float v) { v += swz_xor<1>(v); v += swz_xor<2>(v); v += swz_xor<4>(v); v += swz_xor<8>(v); v += swz_xor<16>(v); return xor32_sum(v); }
__device__ __forceinline__ f32x16 mma32(bf16x8 a, bf16x8 b, f32x16 c) { return __builtin_amdgcn_mfma_f32_32x32x16_bf16(a, b, c, 0, 0, 0); }
__device__ __forceinline__ bf16x8 ldg8(const bf16* p) { return *(const bf16x8*)p; }
__device__ __forceinline__ bf16x8 ldg8p(const bf16* p) { const bf16x4 lo = *(const bf16x4*)p, hi = *(const bf16x4*)(p + 8); return __builtin_shufflevector(lo, hi, 0, 1, 2, 3, 4, 5, 6, 7); }
template <int S> __device__ __forceinline__ bf16x8 accB(const f32x16& c) {
    u32x4 w; w.x = pk2(c[8 * S + 0], c[8 * S + 1]); w.y = pk2(c[8 * S + 2], c[8 * S + 3]); w.z = pk2(c[8 * S + 4], c[8 * S + 5]); w.w = pk2(c[8 * S + 6], c[8 * S + 7]);
    return __builtin_bit_cast(bf16x8, w);
}
__device__ __forceinline__ bf16x8 pack8(const float (&v)[8]) { u32x4 w; w.x = pk2(v[0], v[1]); w.y = pk2(v[2], v[3]); w.z = pk2(v[4], v[5]); w.w = pk2(v[6], v[7]); return __builtin_bit_cast(bf16x8, w); }
__device__ __forceinline__ void unpack8(const bf16x8 x, float (&v)[8]) { const u32x4 w = __builtin_bit_cast(u32x4, x); v[0] = bflo(w.x); v[1] = bfhi(w.x); v[2] = bflo(w.y); v[3] = bfhi(w.y); v[4] = bflo(w.z); v[5] = bfhi(w.z); v[6] = bflo(w.w); v[7] = bfhi(w.w); }
__device__ __forceinline__ f32x16 zero16() { f32x16 z;
#pragma unroll
    for (int i = 0; i < 16; ++i) z[i] = 0.f;
    return z; }

#define XB_TMO      128
#define XB_XCNT(j)  (256  + 64 * (j))
#define XB_XSUB(j)  (1280 + 64 * (j))
#define XB_XGEN(j)  (2304 + 64 * (j))
#define XB_TOP      3328
#define XB_TOPGEN   3392
#define XCD_BAR_WORDS 3456
#define XB_SPIN_CAP (1u << 18)
__device__ __forceinline__ unsigned xb_ld(unsigned* p)              { return __hip_atomic_load(p, __ATOMIC_RELAXED, __HIP_MEMORY_SCOPE_AGENT); }
__device__ __forceinline__ unsigned xb_add(unsigned* p, unsigned v) { return __hip_atomic_fetch_add(p, v, __ATOMIC_RELAXED, __HIP_MEMORY_SCOPE_AGENT); }
__device__ __forceinline__ unsigned xb_xcc_id() { return (unsigned)__builtin_amdgcn_s_getreg((3 << 11) | 20) & 0xFu; }
#define XB_SPIN(cond, bar) do { unsigned _sp = 0; while (cond) { __builtin_amdgcn_s_sleep(1); \
    if ((++_sp & 255u) == 0u) { if (xb_ld(&(bar)[XB_TMO])) break; if (_sp > XB_SPIN_CAP) { atomicAdd(&(bar)[XB_TMO], 1u); break; } } } } while (0)
struct XcdBarrier { unsigned* bar; unsigned x; volatile LAS unsigned* st; };
__device__ __forceinline__ XcdBarrier xcd_barrier_post(unsigned* bar, volatile LAS unsigned* st) {
    XcdBarrier b; b.bar = bar; b.x = xb_xcc_id(); b.st = st;
    if (threadIdx.x == 0) (void)xb_add(&bar[XB_XCNT(b.x)], 1u);
    return b;
}
__device__ __forceinline__ void xcd_barrier_complete(unsigned* bar, unsigned x, unsigned& nloc, unsigned& nx) {
    const unsigned G = gridDim.x * gridDim.y * gridDim.z;
    unsigned sum, cnt, mine, sp = 0u;
    for (;;) {
        sum = 0u; cnt = 0u; mine = 0u;
#pragma unroll
        for (unsigned j = 0; j < 16; ++j) { const unsigned c = xb_ld(&bar[XB_XCNT(j)]); sum += c; cnt += (c > 0u) ? 1u : 0u; mine = (j == x) ? c : mine; }
        if (sum == G) break;
        __builtin_amdgcn_s_sleep(1);
        if ((++sp & 255u) == 0u) { if (xb_ld(&bar[XB_TMO])) break; if (sp > XB_SPIN_CAP) { atomicAdd(&bar[XB_TMO], 1u); break; } }
    }
    nloc = mine > 0u ? mine : 1u; nx = cnt > 0u ? cnt : 1u;
}
__device__ __forceinline__ void xcd_barrier(const XcdBarrier& b) {
    asm volatile("s_waitcnt vmcnt(0)" ::: "memory");
    __syncthreads();
    if (threadIdx.x == 0) {
        unsigned* bar = b.bar;
        __builtin_amdgcn_s_waitcnt(0);
        unsigned nloc = b.st[0], nx = b.st[1];
        if (nloc == 0u) { xcd_barrier_complete(bar, b.x, nloc, nx); b.st[0] = nloc; b.st[1] = nx; }
        const unsigned old = xb_add(&bar[XB_XSUB(b.x)], 1u);
        const unsigned gen = old / nloc;
        if (old + 1u == (gen + 1u) * nloc) {
            __builtin_amdgcn_fence(__ATOMIC_RELEASE, "agent");
            asm volatile("s_waitcnt vmcnt(0)" ::: "memory");
            const unsigned og = xb_add(&bar[XB_TOP], 1u);
            const unsigned tg = og / nx;
            if (og + 1u == (tg + 1u) * nx) xb_add(&bar[XB_TOPGEN], 1u);
            else XB_SPIN(xb_ld(&bar[XB_TOPGEN]) == tg, bar);
            __builtin_amdgcn_fence(__ATOMIC_ACQUIRE, "agent");
            xb_add(&bar[XB_XGEN(b.x)], 1u);
            asm volatile("s_waitcnt vmcnt(0)" ::: "memory");
        } else {
            XB_SPIN(xb_ld(&bar[XB_XGEN(b.x)]) == gen, bar);
            __builtin_amdgcn_fence(__ATOMIC_ACQUIRE, "agent");
            asm volatile("s_waitcnt vmcnt(0)" ::: "memory");
        }
    }
    __syncthreads();
}
namespace gp {
constexpr int BM = 256, BK = 64, HALF = 128, HTB = HALF * BK * 2, STAGE_BYTES = 8 * HTB, NXCD = 8, WGM = 8;
__device__ __forceinline__ int lds_byte(int r, int c) { const int st = (r >> 4) * 2 + (c >> 5), rr = r & 15, cc = c & 31, ob = rr * 64 + cc * 2; return st * 1024 + (ob ^ (((ob >> 9) & 1) << 5)); }
__device__ __forceinline__ void stage_rc(int b, int& Rr, int& C) { const int st = b / 1024, sb = b % 1024, swz = sb ^ (((sb >> 9) & 1) << 5); Rr = (st >> 1) * 16 + swz / 64; C = (st & 1) * 32 + (swz % 64) / 2; }
__device__ __forceinline__ int perm32(int rho) { const int n = rho >> 4, i = rho & 15; return 8 * (i >> 2) + 4 * n + (i & 3); }

struct Unit { const char* a; const char* b; int e0, e1, e2, e3, nt; };

__device__ __forceinline__ void tile_of(int L, int nM, int nN, int& pm, int& pn) {
    const int nwg = nM * nN; int wgid = L;
    { const int q = nwg / NXCD, r = nwg % NXCD, xcd = wgid % NXCD, off = wgid / NXCD; wgid = (xcd < r ? xcd * (q + 1) : r * (q + 1) + (xcd - r) * q) + off; }
    const int nig = WGM * nN, gid = wgid / nig, fm = gid * WGM, gsz = (nM - fm) < WGM ? (nM - fm) : WGM;
    pm = fm + ((wgid % nig) % gsz); pn = (wgid % nig) / gsz;
}

template <class Epi, class Sched>
__device__ __forceinline__ void gemm_phase(LAS unsigned char* lds, const int tid, const int K, const int lda, const int ldb, const Sched& S, const Epi& E) {
    constexpr bool GATHER = Sched::GATHER;
    const int wid = __builtin_amdgcn_readfirstlane(tid >> 6), lane = tid & 63, wr = wid >> 2, wc = wid & 3, fr = lane & 15, fq = lane >> 4;
    unsigned voffA[2], voffB[2];
#pragma unroll
    for (int i = 0; i < 2; ++i) { int Rr, C; stage_rc(tid * 16 + i * 8192, Rr, C); const int Rb = (Rr & ~31) + perm32(Rr & 31);
        voffA[i] = (unsigned)(Rr * lda + C) * 2u; voffB[i] = (unsigned)(Rb * ldb + C) * 2u; }
#define PG8_GOFF(dst, unit) do { _Pragma("unroll") for (int _h = 0; _h < 2; ++_h) _Pragma("unroll") for (int _i = 0; _i < 2; ++_i) { int _R, _C; stage_rc(tid * 16 + _i * 8192, _R, _C); dst[_h][_i] = S.rowoff(unit, _R + _h * HALF) + (unsigned)_C * 2u; } } while (0)
    const size_t kstep = (size_t)(BK * 2);
    const unsigned hstepA = (unsigned)HALF * (unsigned)lda * 2u; const size_t hstepB = (size_t)HALF * ldb * 2;
    const unsigned ldsw = (unsigned)wid * 1024u;
    const int aoff = lds_byte(wr * 64 + fr, fq * 8), boff = lds_byte(wc * 32 + fr, fq * 8);
#define PG8_SA(b, h) (((b) * 2 + (h)) * HTB)
#define PG8_SB(b, h) ((4 + (b) * 2 + (h)) * HTB)
#define PG8_STB(bufoff, gbase, hh) do { _Pragma("unroll") for (int _i = 0; _i < 2; ++_i) \
        __builtin_amdgcn_global_load_lds((const unsigned*)((const char*)(gbase) + (size_t)(hh) * hstepB + voffB[_i]), (LAS unsigned*)(lds + (bufoff) + ldsw + _i * 8192), 16, 0, 0); } while (0)
#define PG8_STA(bufoff, gbase, hh, VG) do { _Pragma("unroll") for (int _i = 0; _i < 2; ++_i) { const unsigned _o = GATHER ? (VG) : (voffA[_i] + (unsigned)(hh) * hstepA); \
        __builtin_amdgcn_global_load_lds((const unsigned*)((const char*)(gbase) + _o), (LAS unsigned*)(lds + (bufoff) + ldsw + _i * 8192), 16, 0, 0); } } while (0)
#define PG8_LDA(dst, b, h) do { _Pragma("unroll") for (int m = 0; m < 4; ++m) _Pragma("unroll") for (int k = 0; k < 2; ++k) dst[m][k] = *(const LAS bf16x8*)(lds + PG8_SA(b, h) + aoff + m * 2048 + k * 1024); } while (0)
#define PG8_LDB(dst, b, h) do { _Pragma("unroll") for (int n = 0; n < 2; ++n) _Pragma("unroll") for (int k = 0; k < 2; ++k) dst[n][k] = *(const LAS bf16x8*)(lds + PG8_SB(b, h) + boff + n * 2048 + k * 1024); } while (0)
#define PG8_MMA(ai, bj, At, Bt) do { __builtin_amdgcn_s_setprio(1); _Pragma("unroll") for (int m = 0; m < 4; ++m) _Pragma("unroll") for (int n = 0; n < 2; ++n) _Pragma("unroll") for (int k = 0; k < 2; ++k) \
        acc[ai][bj][m][n] = __builtin_amdgcn_mfma_f32_16x16x32_bf16(Bt[n][k], At[m][k], acc[ai][bj][m][n], 0, 0, 0); __builtin_amdgcn_s_setprio(0); } while (0)
#define PG8_WAIT_V(n) asm volatile("s_waitcnt vmcnt(" #n ")" ::: "memory")
#define PG8_WAIT_L(n) asm volatile("s_waitcnt lgkmcnt(" #n ")" ::: "memory")
#define PG8_BAR __builtin_amdgcn_s_barrier()
#define PG8_SCHED __builtin_amdgcn_sched_barrier(0)
    Unit cur, nxt; int ui = 0;
    if (!S.next(0, cur)) return;
    f32x4 acc[2][2][4][2];
#pragma unroll
    for (int a = 0; a < 2; ++a)
#pragma unroll
        for (int b = 0; b < 2; ++b)
#pragma unroll
            for (int m = 0; m < 4; ++m)
#pragma unroll
                for (int n = 0; n < 2; ++n) acc[a][b][m][n] = (f32x4){0.f, 0.f, 0.f, 0.f};
    bf16x8 At[4][2], B0[2][2], B1[2][2];
    unsigned vgc[2][2], vgn[2][2];
    if constexpr (GATHER) { PG8_GOFF(vgc, cur); }
#pragma unroll
    for (int h = 0; h < 2; ++h)
#pragma unroll
        for (int i = 0; i < 2; ++i) { if (!GATHER) vgc[h][i] = 0u; vgn[h][i] = vgc[h][i]; }
    const char* cA = cur.a; const char* cB = cur.b;
    PG8_STB(PG8_SB(0, 0), cB, 0); PG8_STB(PG8_SB(0, 1), cB, 1); PG8_STA(PG8_SA(0, 0), cA, 0, vgc[0][_i]); PG8_STA(PG8_SA(0, 1), cA, 1, vgc[1][_i]);
    if (wr == 1) PG8_BAR;
    PG8_WAIT_V(2); PG8_BAR;
    PG8_STB(PG8_SB(1, 0), cB + kstep, 0); PG8_STA(PG8_SA(1, 0), cA + kstep, 0, vgc[0][_i]); PG8_STB(PG8_SB(1, 1), cB + kstep, 1);
    PG8_WAIT_V(6); PG8_BAR;
    for (;;) {
        const bool has_next = S.next(ui + 1, nxt);
        const char* nA = has_next ? nxt.a : cA; const char* nB = has_next ? nxt.b : cB;
        int nt = cur.nt; asm volatile("" : "+s"(nt));
#pragma unroll 1
        for (int t = 0; t < nt; t += 2) {
            const bool last = (t == nt - 2);
            const char* a1 = cA + (size_t)(t + 1) * kstep;
            const char* a2 = last ? nA : cA + (size_t)(t + 2) * kstep; const char* b2 = last ? nB : cB + (size_t)(t + 2) * kstep;
            const char* a3 = a2 + kstep; const char* b3 = b2 + kstep;
            if constexpr (Epi::MID) { if (t != 0 && (t & 3) == 0 && cur.nt == 16) E.mid(acc, cur, (t >> 2) - 1, wr, wc, fr, fq); }
            if constexpr (GATHER) { if (last && has_next) { PG8_GOFF(vgn, nxt); } }
            PG8_LDB(B0, 0, 0); PG8_LDB(B1, 0, 1); PG8_SCHED; PG8_LDA(At, 0, 0); PG8_STA(PG8_SA(1, 1), a1, 1, vgc[1][_i]);
            PG8_WAIT_V(8); PG8_WAIT_L(0); PG8_BAR; PG8_MMA(0, 0, At, B0); PG8_MMA(0, 1, At, B1); PG8_BAR; PG8_SCHED;
            PG8_LDA(At, 0, 1); PG8_STB(PG8_SB(0, 0), b2, 0); PG8_STB(PG8_SB(0, 1), b2, 1); PG8_STA(PG8_SA(0, 0), a2, 0, (last ? vgn[0][_i] : vgc[0][_i]));
            PG8_WAIT_V(8); PG8_WAIT_L(0); PG8_BAR; PG8_MMA(1, 0, At, B0); PG8_MMA(1, 1, At, B1); PG8_BAR; PG8_SCHED;
            PG8_LDB(B0, 1, 0); PG8_LDB(B1, 1, 1); PG8_SCHED; PG8_LDA(At, 1, 0); PG8_STA(PG8_SA(0, 1), a2, 1, (last ? vgn[1][_i] : vgc[1][_i]));
            PG8_WAIT_V(8); PG8_WAIT_L(0); PG8_BAR; PG8_MMA(0, 0, At, B0); PG8_MMA(0, 1, At, B1); PG8_BAR; PG8_SCHED;
            PG8_LDA(At, 1, 1); PG8_STB(PG8_SB(1, 0), b3, 0); PG8_STB(PG8_SB(1, 1), b3, 1); PG8_STA(PG8_SA(1, 0), a3, 0, (last ? vgn[0][_i] : vgc[0][_i]));
            PG8_WAIT_V(8); PG8_WAIT_L(0); PG8_BAR; PG8_MMA(1, 0, At, B0); PG8_MMA(1, 1, At, B1); PG8_BAR; PG8_SCHED;
        }
        if (wr == 0) PG8_BAR;
        Unit ue = cur; int le = lane;
        if constexpr (Epi::LAUNDER) { int t0 = cur.e0, t1 = cur.e1, t2 = cur.e2, t3 = cur.e3; asm volatile("" : "+v"(t0), "+v"(t1), "+v"(t2), "+v"(t3), "+v"(le));
          ue.e0 = __builtin_amdgcn_readfirstlane(t0); ue.e1 = __builtin_amdgcn_readfirstlane(t1); ue.e2 = __builtin_amdgcn_readfirstlane(t2); ue.e3 = __builtin_amdgcn_readfirstlane(t3); le &= 63; }
        const int fre = le & 15, fqe = le >> 4;
        if constexpr (Epi::CARRY) { E.carry(acc, ue, wr, wc, fre, fqe); if (!has_next) break; }
        else {
        E(acc, ue, wr, wc, fre, fqe);
        if (!has_next) break;
#pragma unroll
        for (int a = 0; a < 2; ++a)
#pragma unroll
            for (int b = 0; b < 2; ++b)
#pragma unroll
                for (int m = 0; m < 4; ++m)
#pragma unroll
                    for (int n = 0; n < 2; ++n) acc[a][b][m][n] = (f32x4){0.f, 0.f, 0.f, 0.f};
        }
        cur = nxt; cA = nA; cB = nB; ++ui;
#pragma unroll
        for (int h = 0; h < 2; ++h)
#pragma unroll
            for (int i = 0; i < 2; ++i) vgc[h][i] = vgn[h][i];
        if (wr == 1) PG8_BAR;
    }
    PG8_WAIT_V(0);
    PG8_BAR;
#undef PG8_SA
#undef PG8_SB
#undef PG8_STA
#undef PG8_GOFF
#undef PG8_STB
#undef PG8_LDA
#undef PG8_LDB
#undef PG8_MMA
#undef PG8_WAIT_V
#undef PG8_WAIT_L
#undef PG8_BAR
#undef PG8_SCHED
}

struct SchedPlain {
    static constexpr bool GATHER = false;
    const char* A; const char* B; size_t ta, tb; int nM, nN, G, c, nt;
    __device__ __forceinline__ bool next(int i, Unit& u) const {
        const long L = (long)i * G + c; if (L >= (long)nM * nN) return false;
        int pm, pn; tile_of((int)L, nM, nN, pm, pn); u.a = A + (size_t)pm * ta; u.b = B + (size_t)pn * tb; u.e0 = pm; u.e1 = pn; u.e2 = 0; u.e3 = 0; u.nt = nt; return true; }
    __device__ __forceinline__ unsigned rowoff(const Unit&, int) const { return 0u; }
};
struct SchedInprojA {
    static constexpr bool GATHER = false;
    const char* Hh; const char* W; int nM, G, c, ng;
    __device__ __forceinline__ bool next(int i, Unit& u) const {
        long L = (long)i * G + c; const int n1 = nM * 7, n2 = 3 * nM; if (L >= n1 + n2 + ng) return false;
        int pm, pn;
        if (L < n1) { tile_of((int)L, nM, 7, pm, pn); u.a = Hh + (size_t)pm * (256 * 2048); u.b = W + (size_t)pn * (256 * 2048); u.e2 = 0; }
        else if (L < n1 + n2) { tile_of((int)(L - n1), 3, nM, pm, pn); u.a = W + (size_t)(23 + pm) * (256 * 2048); u.b = Hh + (size_t)pn * (256 * 2048); u.e2 = 1; }
        else { const int q = (int)(L - n1 - n2); pm = q >> 4; pn = q & 15; u.a = Hh + (size_t)(64 + pm) * (256 * 2048); u.b = W + (size_t)(7 + pn) * (256 * 2048); u.e2 = 2; }
        u.e0 = pm; u.e1 = pn; u.e3 = 0; u.nt = 16; return true; }
    __device__ __forceinline__ unsigned rowoff(const Unit&, int) const { return 0u; }
};
struct SchedSplit {
    static constexpr bool GATHER = false;
    const char* A; const char* B; size_t ta, tb; int nslice, ntf, G, c; const char* Ac; size_t tac, sac; int ks;
    __device__ __forceinline__ bool next(int i, Unit& u) const {
        const long L = (long)i * G + c; int pm, pn;
        if (L < 256) { tile_of((int)L, 64, 4, pm, pn); u.a = A + (size_t)pm * ta; u.b = B + (size_t)pn * tb; u.e2 = 0; u.e3 = 0; u.nt = ntf; }
        else { const int q = (int)(L - 256); if (q >= 8 * nslice) return false; const int tile = q / nslice, s = q % nslice; pm = 64 + (tile >> 2); pn = tile & 3;
            u.a = Ac + (size_t)(tile >> 2) * tac + (size_t)(s / ks) * sac + (s % ks) * 512; u.b = B + (size_t)pn * tb + (s % ks) * 512; u.e2 = s + 1; u.e3 = tile; u.nt = 4; }
        u.e0 = pm; u.e1 = pn; return true; }
    __device__ __forceinline__ unsigned rowoff(const Unit&, int) const { return 0u; }
};
struct SchedMerge {
    static constexpr bool GATHER = false;
    const char* Mix; const char* Wb; int nctx, G, c;
    __device__ __forceinline__ bool next(int i, Unit& u) const {
        const long L = (long)i * G + c; int pm, pn;
        if (L < 256) { tile_of((int)L, 64, 4, pm, pn); u.a = Mix + (size_t)pm * (256 * 2048); u.b = Wb + (size_t)pn * (256 * 2048); u.e2 = 0; u.e3 = 0; u.nt = 16; }
        else { const long q = L - 256; if (q >= nctx) return false; const int tile = (int)q >> 2, b = (int)q & 3; pm = 64 + (tile >> 2); pn = tile & 3;
            u.a = Mix + (size_t)pm * (256 * 2048) + b * 512; u.b = Wb + (size_t)pn * (256 * 2048) + b * 512; u.e2 = b; u.e3 = 1; u.nt = 4; }
        u.e0 = pm; u.e1 = pn; return true; }
    __device__ __forceinline__ unsigned rowoff(const Unit&, int) const { return 0u; }
};
struct SchedMoe1 {
    static constexpr bool GATHER = true;
    const char* Hh; const char* W; const int* list; const LAS unsigned* mt; int G, c;
    __device__ __forceinline__ bool next(int i, Unit& u) const {
        long L = (long)i * G + c; int e = 0;
        for (; e < 8; ++e) { const long ue = (long)mt[8 + e] * 28; if (L < ue) break; L -= ue; }
        if (e == 8) return false;
        const int m_e = (int)mt[8 + e], nti = (int)(L / m_e), mti = (int)(L % m_e);
        u.a = Hh; u.b = W + ((size_t)e * 7168 + (size_t)nti * 256) * 2048; u.e0 = e; u.e1 = mti; u.e2 = nti; u.e3 = ((int)mt[16 + e] + mti) * 256; u.nt = 16; return true; }
    __device__ __forceinline__ unsigned rowoff(const Unit& u, int r) const {
        const int li = u.e1 * 256 + r; const int ent = (li < (int)mt[u.e0]) ? list[u.e0 * LCAP + li] : 0; return (unsigned)(ent >> 1) * 2048u; }
};
__device__ __forceinline__ bool moe2_unit(long L, const LAS unsigned* mt, const char* Hid, const char* W, Unit& u) {
    int e = 0;
    for (; e < 8; ++e) { const long ue = (long)mt[8 + e] * 4; if (L < ue) break; L -= ue; }
    if (e == 8) return false;
    const int m_e = (int)mt[8 + e], nti = (int)(L / m_e), mti = (int)(L % m_e);
    u.a = Hid + (size_t)((int)mt[16 + e] + mti) * 256 * (size_t)(DFE * 2); u.b = W + ((size_t)e * 1024 + (size_t)nti * 256) * (size_t)(DFE * 2); u.e0 = e; u.e1 = mti; u.e2 = nti; u.e3 = 0; u.nt = DFE / 64; return true;
}
struct SchedMoe2 {
    static constexpr bool GATHER = false;
    const char* Hid; const char* W; const LAS unsigned* mt; int G, c;
    __device__ __forceinline__ bool next(int i, Unit& u) const { const long L = (long)i * G + c; if (L >= (long)mt[25]) return false; return moe2_unit(L, mt, Hid, W, u); }
    __device__ __forceinline__ unsigned rowoff(const Unit&, int) const { return 0u; }
};
struct SchedMoe2S {
    static constexpr bool GATHER = false;
    const char* Hid; const char* W; const LAS unsigned* mt; int G, c;
    __device__ __forceinline__ bool next(int i, Unit& u) const { const long q = (long)i * G + c; if (q >= (long)mt[26] * 7) return false;
        if (!moe2_unit((long)mt[25] + q / 7, mt, Hid, W, u)) return false; const int s = (int)(q % 7); u.a += s * 1024; u.b += s * 1024; u.e3 = (int)q; u.nt = 8; return true; }
    __device__ __forceinline__ unsigned rowoff(const Unit&, int) const { return 0u; }
};

#define EPI_ROWS(ai, m) (128 * (ai) + 64 * wr + 16 * (m) + fr)
#define EPI_COL(bj) (128 * (bj) + 32 * wc + 8 * fq)
__device__ __forceinline__ u32x4 pack_acc8(const f32x4 a, const f32x4 b) { u32x4 w; w.x = pk2(a[0], a[1]); w.y = pk2(a[2], a[3]); w.z = pk2(b[0], b[1]); w.w = pk2(b[2], b[3]); return w; }

__device__ __forceinline__ unsigned gq8(float g) { const unsigned q = (unsigned)(g * 255.f + 0.5f); return q < 1u ? 1u : q; }
__device__ __forceinline__ u32x2 pack_gate8(const f32x4 a, const f32x4 b) {
    u32x2 w; w.x = gq8(a[0]) | (gq8(a[1]) << 8) | (gq8(a[2]) << 16) | (gq8(a[3]) << 24); w.y = gq8(b[0]) | (gq8(b[1]) << 8) | (gq8(b[2]) << 16) | (gq8(b[3]) << 24); return w; }
__device__ __forceinline__ size_t gate_off(int pm, int j, int b, int wr, int wc, int ai, int m, int bj, int fr, int fq) { return ((((size_t)((pm * 4 + j) * 4 + b) * 8 + wr * 4 + wc) * 16 + (ai * 4 + m) * 2 + bj) * 64 + fq * 16 + fr) * 8; }
__device__ __forceinline__ float gate8(unsigned w, int k) { return (float)((w >> (8 * k)) & 255u) * (1.f / 255.f); }
struct EpiPlain { static constexpr bool CARRY = false, LAUNDER = false, MID = false;
    bf16* O; int ld;
    __device__ __forceinline__ void operator()(const f32x4 (&acc)[2][2][4][2], const Unit& u, int wr, int wc, int fr, int fq) const {
#pragma unroll
        for (int ai = 0; ai < 2; ++ai)
#pragma unroll
            for (int m = 0; m < 4; ++m) { bf16* rowp = O + (size_t)(u.e0 * 256 + EPI_ROWS(ai, m)) * ld + u.e1 * 256;
#pragma unroll
                for (int bj = 0; bj < 2; ++bj) *(u32x4*)(rowp + EPI_COL(bj)) = pack_acc8(acc[ai][bj][m][0], acc[ai][bj][m][1]); }
    }
};
struct EpiPlainSplit { static constexpr bool CARRY = false, LAUNDER = false, MID = false;
    bf16* O; int ld; float* P; int nslice;
    __device__ __forceinline__ void operator()(const f32x4 (&acc)[2][2][4][2], const Unit& u, int wr, int wc, int fr, int fq) const {
        if (u.e2 == 0) {
#pragma unroll
            for (int ai = 0; ai < 2; ++ai)
#pragma unroll
                for (int m = 0; m < 4; ++m) { bf16* rowp = O + (size_t)(u.e0 * 256 + EPI_ROWS(ai, m)) * ld + u.e1 * 256;
#pragma unroll
                    for (int bj = 0; bj < 2; ++bj) *(u32x4*)(rowp + EPI_COL(bj)) = pack_acc8(acc[ai][bj][m][0], acc[ai][bj][m][1]); }
        } else { float* pt = P + (size_t)(u.e3 * nslice + (u.e2 - 1)) * 65536;
#pragma unroll
            for (int ai = 0; ai < 2; ++ai)
#pragma unroll
                for (int m = 0; m < 4; ++m)
#pragma unroll
                    for (int bj = 0; bj < 2; ++bj) { float* p = pt + EPI_ROWS(ai, m) * 256 + EPI_COL(bj); *(f32x4*)p = acc[ai][bj][m][0]; *(f32x4*)(p + 4) = acc[ai][bj][m][1]; }
        }
    }
};
struct EpiInprojA { static constexpr bool CARRY = false, LAUNDER = false, MID = false;
    bf16* INP; bf16* T; unsigned char* Gc;
    __device__ __forceinline__ void operator()(const f32x4 (&acc)[2][2][4][2], const Unit& u, int wr, int wc, int fr, int fq) const {
        if (u.e2 == 2) {
#pragma unroll
            for (int ai = 0; ai < 2; ++ai)
#pragma unroll
                for (int m = 0; m < 4; ++m)
#pragma unroll
                    for (int bj = 0; bj < 2; ++bj) { f32x4 a = acc[ai][bj][m][0], b = acc[ai][bj][m][1];
#pragma unroll
                        for (int j = 0; j < 4; ++j) { a[j] = sigm(a[j]); b[j] = sigm(b[j]); }
                        *(u32x2*)(Gc + gate_off(u.e0, u.e1 & 3, u.e1 >> 2, wr, wc, ai, m, bj, fr, fq)) = pack_gate8(a, b); }
        } else if (u.e2 == 0) {
            bf16* base = INP + (size_t)u.e1 * ((size_t)R * 256);
            const bool regroup = (u.e1 == 1);
#pragma unroll
            for (int ai = 0; ai < 2; ++ai)
#pragma unroll
                for (int m = 0; m < 4; ++m) { const int row = u.e0 * 256 + EPI_ROWS(ai, m);
#pragma unroll
                    for (int bj = 0; bj < 2; ++bj) { const int col = EPI_COL(bj);
                        bf16* p = regroup ? base + ((((size_t)(col >> 4) * 33 + (row >> 9)) * 16 + (row & 15)) * 64 + ((col & 8) << 2) + ((row >> 4) & 31)) * 8 : base + (size_t)row * 256 + col;
                        *(u32x4*)p = pack_acc8(acc[ai][bj][m][0], acc[ai][bj][m][1]); } }
        } else {
#pragma unroll
            for (int ai = 0; ai < 2; ++ai)
#pragma unroll
                for (int m = 0; m < 4; ++m) { bf16* rowp = T + (size_t)(u.e0 * 256 + EPI_ROWS(ai, m)) * R + u.e1 * 256;
#pragma unroll
                    for (int bj = 0; bj < 2; ++bj) *(u32x4*)(rowp + EPI_COL(bj)) = pack_acc8(acc[ai][bj][m][0], acc[ai][bj][m][1]); }
        }
    }
};
struct EpiGates { static constexpr bool CARRY = false, LAUNDER = false, MID = false;
    unsigned char* Gt;
    __device__ __forceinline__ void operator()(const f32x4 (&acc)[2][2][4][2], const Unit& u, int wr, int wc, int fr, int fq) const {
#pragma unroll
        for (int ai = 0; ai < 2; ++ai)
#pragma unroll
            for (int m = 0; m < 4; ++m)
#pragma unroll
                for (int bj = 0; bj < 2; ++bj) { f32x4 a = acc[ai][bj][m][0], b = acc[ai][bj][m][1];
#pragma unroll
                    for (int j = 0; j < 4; ++j) { a[j] = sigm(a[j]); b[j] = sigm(b[j]); }
                    *(u32x2*)(Gt + gate_off(u.e0, u.e1 & 3, u.e1 >> 2, wr, wc, ai, m, bj, fr, fq)) = pack_gate8(a, b); }
    }
};
struct EpiGlu { static constexpr bool CARRY = false, LAUNDER = false, MID = false;
    const bf16* Zz; bf16* Mix; const float* bglu;
    __device__ __forceinline__ void operator()(const f32x4 (&acc)[2][2][4][2], const Unit& u, int wr, int wc, int fr, int fq) const {
#pragma unroll
        for (int bj = 0; bj < 2; ++bj) { const int col = EPI_COL(bj);
            const f32x4 b0 = *(const f32x4*)(bglu + col), b1 = *(const f32x4*)(bglu + col + 4);
#pragma unroll
            for (int ai = 0; ai < 2; ++ai)
#pragma unroll
                for (int m = 0; m < 4; ++m) { const size_t row = (size_t)(u.e0 * 256 + EPI_ROWS(ai, m));
                    const u32x4 zz = *(const u32x4*)(Zz + row * 256 + col);
                    f32x4 a = acc[ai][bj][m][0] + b0, b = acc[ai][bj][m][1] + b1;
                    a[0] = bflo(zz.x) * sigm(a[0]); a[1] = bfhi(zz.x) * sigm(a[1]); a[2] = bflo(zz.y) * sigm(a[2]); a[3] = bfhi(zz.y) * sigm(a[3]);
                    b[0] = bflo(zz.z) * sigm(b[0]); b[1] = bfhi(zz.z) * sigm(b[1]); b[2] = bflo(zz.w) * sigm(b[2]); b[3] = bfhi(zz.w) * sigm(b[3]);
                    *(u32x4*)(Mix + row * 1024 + 256 + col) = pack_acc8(a, b); } }
    }
};
struct EpiMerge {
    static constexpr bool CARRY = false, LAUNDER = false, MID = true;
    const unsigned char* Gt; const unsigned char* Gc; bf16* Y; bf16* YP;
    __device__ __forceinline__ void mid(f32x4 (&acc)[2][2][4][2], const Unit& u, int b, int wr, int wc, int fr, int fq) const {
#pragma unroll
        for (int ai = 0; ai < 2; ++ai) {
            u32x2 g[4][2], gn[4][2];
#pragma unroll
            for (int m = 0; m < 4; ++m)
#pragma unroll
                for (int bj = 0; bj < 2; ++bj) { const unsigned char* gp = Gt + gate_off(u.e0, u.e1, b, wr, wc, ai, m, bj, fr, fq); g[m][bj] = *(const u32x2*)gp; gn[m][bj] = *(const u32x2*)(gp + 65536); }
#pragma unroll
            for (int m = 0; m < 4; ++m)
#pragma unroll
                for (int bj = 0; bj < 2; ++bj) { f32x4 a0 = acc[ai][bj][m][0], a1 = acc[ai][bj][m][1];
#pragma unroll
                    for (int j = 0; j < 4; ++j) { a0[j] *= gate8(g[m][bj].x, j) * rcpf_(gate8(gn[m][bj].x, j)); a1[j] *= gate8(g[m][bj].y, j) * rcpf_(gate8(gn[m][bj].y, j)); }
                    acc[ai][bj][m][0] = a0; acc[ai][bj][m][1] = a1; } }
    }
    __device__ __forceinline__ void operator()(const f32x4 (&acc)[2][2][4][2], const Unit& u, int wr, int wc, int fr, int fq) const {
        const int b = u.e3 ? u.e2 : 3;
#pragma unroll
        for (int ai = 0; ai < 2; ++ai)
#pragma unroll
            for (int m = 0; m < 4; ++m) { const size_t row = (size_t)(u.e0 * 256 + EPI_ROWS(ai, m));
                bf16* orow = (u.e3 ? YP + ((size_t)b * CROWS + (row - LROWS)) * 1024 : Y + row * 1024) + u.e1 * 256;
#pragma unroll
                for (int bj = 0; bj < 2; ++bj) { const u32x2 g = *(const u32x2*)((u.e3 ? Gc : Gt) + gate_off(u.e3 ? u.e0 - 64 : u.e0, u.e1, b, wr, wc, ai, m, bj, fr, fq)); f32x4 a0 = acc[ai][bj][m][0], a1 = acc[ai][bj][m][1];
#pragma unroll
                    for (int j = 0; j < 4; ++j) { a0[j] *= gate8(g.x, j); a1[j] *= gate8(g.y, j); }
                    *(u32x4*)(orow + EPI_COL(bj)) = pack_acc8(a0, a1); } }
    }
};
struct EpiSwiglu { static constexpr bool CARRY = false, LAUNDER = false, MID = false;
    bf16* Hd; int ldh; bool moe;
    __device__ __forceinline__ void operator()(const f32x4 (&acc)[2][2][4][2], const Unit& u, int wr, int wc, int fr, int fq) const {
        const int rowbase = moe ? u.e3 : u.e0 * 256, pn = moe ? u.e2 : u.e1;
#pragma unroll
        for (int ai = 0; ai < 2; ++ai)
#pragma unroll
            for (int m = 0; m < 4; ++m) { bf16* p = Hd + (size_t)(rowbase + EPI_ROWS(ai, m)) * ldh + pn * 128 + 32 * wc + 8 * fq;
                f32x4 a = acc[ai][0][m][0], b = acc[ai][0][m][1]; const f32x4 ua = acc[ai][1][m][0], ub = acc[ai][1][m][1];
#pragma unroll
                for (int j = 0; j < 4; ++j) { a[j] = silu_(a[j]) * ua[j]; b[j] = silu_(b[j]) * ub[j]; }
                *(u32x4*)p = pack_acc8(a, b); }
    }
};
struct EpiMoeDown { static constexpr bool CARRY = false, LAUNDER = false, MID = false;
    bf16* Slot; const int* list; const float* routew; const LAS unsigned* mt;
    __device__ __forceinline__ void operator()(const f32x4 (&acc)[2][2][4][2], const Unit& u, int wr, int wc, int fr, int fq) const {
        const int cnt = (int)mt[u.e0];
#pragma unroll
        for (int ai = 0; ai < 2; ++ai)
#pragma unroll
            for (int m = 0; m < 4; ++m) { const int li = u.e1 * 256 + EPI_ROWS(ai, m);
                if (li < cnt) { const int ent = list[u.e0 * LCAP + li]; const float w = routew[ent];
                    bf16* rowp = Slot + ((size_t)(ent & 1) * LROWS + (size_t)(ent >> 1)) * 1024 + u.e2 * 256;
#pragma unroll
                    for (int bj = 0; bj < 2; ++bj) *(u32x4*)(rowp + EPI_COL(bj)) = pack_acc8(acc[ai][bj][m][0] * w, acc[ai][bj][m][1] * w); } }
    }
};
struct EpiMoePart { static constexpr bool CARRY = false, LAUNDER = true, MID = false;
    bf16* Pm; const int* list; const LAS unsigned* mt; int* smap;
    __device__ __forceinline__ void operator()(const f32x4 (&acc)[2][2][4][2], const Unit& u, int wr, int wc, int fr, int fq) const {
        const int cnt = (int)mt[u.e0], q = u.e3; bf16* pt = Pm + (size_t)q * 65536; const bool mapper = (q % 7 == 0) && wc == 0 && fq == 0;
#pragma unroll
        for (int ai = 0; ai < 2; ++ai)
#pragma unroll
            for (int m = 0; m < 4; ++m) { const int rl = EPI_ROWS(ai, m), li = u.e1 * 256 + rl;
#pragma unroll
                for (int bj = 0; bj < 2; ++bj) *(u32x4*)(pt + rl * 256 + EPI_COL(bj)) = pack_acc8(acc[ai][bj][m][0], acc[ai][bj][m][1]);
                if (mapper && li < cnt) smap[list[u.e0 * LCAP + li] * 4 + u.e2] = ((q / 7) << 8) | rl; }
    }
};
}
#define DROW(reg, h) (((reg) & 3) + 8 * ((reg) >> 2) + 4 * (h))

__device__ __forceinline__ void s5_state_item(const bf16* M1F  , const bf16* SUF, float* HLOC, int item, int lane) {
    const int cb = item % 33, gd = item / 33, g = gd >> 1, dir = gd & 1, li = lane & 31, h = lane >> 5;
    const bf16* A = M1F + (size_t)(g * 2 + dir) * 128 * 256 + lane * 8;
    const bf16* B = SUF + (size_t)(g * 33 + cb) * 16 * 512 + lane * 8;
    f32x16 acc[4];
#pragma unroll
    for (int rt = 0; rt < 4; ++rt) acc[rt] = zero16();
    bf16x8 a0[2][4], b0[2], a1[2][4], b1[2];
#define S5S_LOAD(AA, BB, grp) do { _Pragma("unroll") for (int s = 0; s < 2; ++s) { const int ks = (grp) * 2 + s; BB[s] = ldg8(B + ks * 512); \
        _Pragma("unroll") for (int rt = 0; rt < 4; ++rt) AA[s][rt] = ldg8(A + (ks * 4 + rt) * 512); } } while (0)
#define S5S_MMA(AA, BB) do { _Pragma("unroll") for (int s = 0; s < 2; ++s) _Pragma("unroll") for (int rt = 0; rt < 4; ++rt) acc[rt] = mma32(AA[s][rt], BB[s], acc[rt]); } while (0)
    S5S_LOAD(a0, b0, 0);
#pragma unroll 1
    for (int gp = 0; gp < 8; gp += 2) {
        S5S_LOAD(a1, b1, gp + 1);
        S5S_MMA(a0, b0);
        if (gp + 2 < 8) S5S_LOAD(a0, b0, gp + 2);
        S5S_MMA(a1, b1);
    }
#undef S5S_LOAD
#undef S5S_MMA
    const int c = cb * 32 + li; float* o = HLOC + (((size_t)(g * 2 + dir) * (NCH16 / 2) + (c >> 1)) * 64) * 4 + (c & 1) * 2;
#pragma unroll
    for (int rt = 0; rt < 4; ++rt)
#pragma unroll
        for (int q = 0; q < 4; ++q) { const int p0 = 16 * rt + 4 * q + 2 * h;
            *(f32x2*)(o + (size_t)p0 * 4) = (f32x2){acc[rt][4 * q], acc[rt][4 * q + 1]}; *(f32x2*)(o + (size_t)(p0 + 1) * 4) = (f32x2){acc[rt][4 * q + 2], acc[rt][4 * q + 3]}; }
}
__device__ __forceinline__ void s5_scan_item(const float* A16  , const float* HLOC, bf16* HINF, LAS unsigned char* wl, int item, int lane) {
    const int dir = item & 1, g = (item >> 1) & 15, b = item >> 5, p = lane;
    const f32x2 a = *(const f32x2*)(A16 + ((size_t)(dir * 16 + g) * 64 + p) * 2);
    const float* src = HLOC + ((size_t)(g * 2 + dir) * (NCH16 / 2) * 64 + p) * 4;
    const int k2 = dir * 128 + 2 * p;
    bf16* dctx = HINF + ((size_t)(g * 33 + 32) * 16 + (k2 >> 4)) * 512 + ((k2 >> 3) & 1) * 256 + (k2 & 7);
    float hr = 0.f, hi = 0.f;
#define S5_STEP(xr, xi) do { const float nr_ = a.x * hr - a.y * hi + (xr), ni_ = a.x * hi + a.y * hr + (xi); hr = nr_; hi = ni_; } while (0)
    {
        f32x4 v[8];
#pragma unroll
        for (int j = 0; j < 8; ++j) v[j] = *(const f32x4*)(src + (size_t)(512 + 8 * b + (dir ? 7 - j : j)) * 256);
#pragma unroll
        for (int j = 0; j < 8; ++j) { const int cl0 = 16 * b + 2 * (dir ? 7 - j : j);
            if (!dir) { *(unsigned*)(dctx + (cl0) * 8) = pk2(hr, hi); S5_STEP(v[j][0], v[j][1]); *(unsigned*)(dctx + (cl0 + 1) * 8) = pk2(hr, hi); S5_STEP(v[j][2], v[j][3]); }
            else      { *(unsigned*)(dctx + (cl0 + 1) * 8) = pk2(hr, hi); S5_STEP(v[j][2], v[j][3]); *(unsigned*)(dctx + (cl0) * 8) = pk2(hr, hi); S5_STEP(v[j][0], v[j][1]); } }
    }
    const int pg = p >> 2; LAS unsigned char* wbase = wl + ((p >> 3) * 64 + (pg & 1) * 32) * 16 + 4 * (p & 3);
    f32x4 vn[16];
#pragma unroll
    for (int j = 0; j < 16; ++j) vn[j] = *(const f32x4*)(src + (size_t)(256 * b + (dir ? 255 - j : j)) * 256);
#pragma unroll 1
    for (int blk = 0; blk < 16; ++blk) {
        f32x4 v[16];
#pragma unroll
        for (int j = 0; j < 16; ++j) v[j] = vn[j];
        if (blk < 15) {
#pragma unroll
            for (int j = 0; j < 16; ++j) { const int pj = 16 * (blk + 1) + j; vn[j] = *(const f32x4*)(src + (size_t)(256 * b + (dir ? 255 - pj : pj)) * 256); } }
#pragma unroll
        for (int j = 0; j < 16; ++j) { const int pl = dir ? 15 - j : j;
            if (!dir) { *(LAS unsigned*)(wbase + ((2 * pl + pg) & 31) * 16) = pk2(hr, hi); S5_STEP(v[j][0], v[j][1]); *(LAS unsigned*)(wbase + ((2 * pl + 1 + pg) & 31) * 16) = pk2(hr, hi); S5_STEP(v[j][2], v[j][3]); }
            else      { *(LAS unsigned*)(wbase + ((2 * pl + 1 + pg) & 31) * 16) = pk2(hr, hi); S5_STEP(v[j][2], v[j][3]); *(LAS unsigned*)(wbase + ((2 * pl + pg) & 31) * 16) = pk2(hr, hi); S5_STEP(v[j][0], v[j][1]); } }
        const int cb = 16 * b + (dir ? 15 - blk : blk), hs = lane >> 5, cl = lane & 31;
        bf16* dout = HINF + ((size_t)(g * 33 + cb) * 16 + dir * 8) * 512 + lane * 8;
#pragma unroll
        for (int j = 0; j < 8; ++j) *(u32x4*)(dout + j * 512) = *(const LAS u32x4*)(wl + (j * 64 + hs * 32 + ((cl + 2 * j + hs) & 31)) * 16);
    }
#undef S5_STEP
}
__device__ __forceinline__ void s5_out_item(const bf16* TABF  , const bf16* SUF, const bf16* HINF, bf16* Z, int item, int lane) {
    const int mh = item & 1, it2 = item >> 1, cb = it2 % 33, g = it2 / 33, li = lane & 31, h = lane >> 5, c = cb * 32 + li;
    const bf16* A = TABF + ((size_t)g * 256 + mh * 128) * 512 + lane * 8;
    const bf16* B0 = SUF + (size_t)(g * 33 + cb) * 16 * 512 + lane * 8;
    const bf16* B1 = HINF + (size_t)(g * 33 + cb) * 16 * 512 + lane * 8;
    f32x16 acc[4];
#pragma unroll
    for (int rt = 0; rt < 4; ++rt) acc[rt] = zero16();
    bf16x8 a0[2][4], b0[2], a1[2][4], b1[2];
#define S5O_LOAD(AA, BB, grp) do { _Pragma("unroll") for (int s = 0; s < 2; ++s) { const int ks = (grp) * 2 + s; BB[s] = ldg8((ks < 16 ? B0 + ks * 512 : B1 + (ks - 16) * 512)); \
        _Pragma("unroll") for (int rt = 0; rt < 4; ++rt) AA[s][rt] = ldg8(A + (ks * 4 + rt) * 512); } } while (0)
#define S5O_MMA(AA, BB) do { _Pragma("unroll") for (int s = 0; s < 2; ++s) _Pragma("unroll") for (int rt = 0; rt < 4; ++rt) acc[rt] = mma32(AA[s][rt], BB[s], acc[rt]); } while (0)
    S5O_LOAD(a0, b0, 0);
#pragma unroll 1
    for (int gp = 0; gp < 16; gp += 2) {
        S5O_LOAD(a1, b1, gp + 1);
        S5O_MMA(a0, b0);
        if (gp + 2 < 16) S5O_LOAD(a0, b0, gp + 2);
        S5O_MMA(a1, b1);
    }
#undef S5O_LOAD
#undef S5O_MMA
#pragma unroll
    for (int rt = 0; rt < 4; ++rt)
#pragma unroll
        for (int q = 0; q < 4; ++q) {
            const int i = 8 * mh + 2 * rt + (q >> 1), ho0 = 8 * (q & 1) + 4 * h;
            u32x2 w; w.x = pk2(gelu_tanh(acc[rt][4 * q]), gelu_tanh(acc[rt][4 * q + 1])); w.y = pk2(gelu_tanh(acc[rt][4 * q + 2]), gelu_tanh(acc[rt][4 * q + 3]));
            *(u32x2*)(Z + ((size_t)c * 16 + i) * 256 + g * 16 + ho0) = w; }
}

__device__ __forceinline__ int ret_tok0(int b, int n) { return n < 64 ? b * SEQ + n * 128 : LROWS + b * CTXL + (n - 64) * 128; }
__device__ __forceinline__ void ret_kv_item(const bf16* RKT, const bf16* RVT, const float* COST, const float* SINT, const float* decay  , float* KV, int item, int lane) {
    const int n = item % 66, bh = item / 66, hd = bh & 3, b = bh >> 2, li = lane & 31, h = lane >> 5;
    const int tok0 = ret_tok0(b, n); const bool lat = n < 64;
    const float lgf = -log2f(1.f + __expf(-decay[hd])), lgr = -log2f(1.f + __expf(-decay[4 + hd]));
    f32x16 acc[2][2][2];
#pragma unroll
    for (int a = 0; a < 2; ++a)
#pragma unroll
        for (int c = 0; c < 2; ++c)
#pragma unroll
            for (int d = 0; d < 2; ++d) acc[a][c][d] = zero16();
    const bf16* k0p = RKT + (size_t)(hd * 64 + li) * R + tok0 + 8 * h;
    const bf16* v0p = RVT + (size_t)(hd * 64 + li) * R + tok0 + 8 * h;
#pragma unroll 2
    for (int ks = 0; ks < 8; ++ks) {
        float k1[8], k2[8];
        unpack8(ldg8(k0p + ks * 16), k1); unpack8(ldg8(k0p + (size_t)32 * R + ks * 16), k2);
        if (lat) {
            const float* cp = COST + (size_t)li * SEQ + n * 128 + ks * 16 + 8 * h; const float* sp = SINT + (size_t)li * SEQ + n * 128 + ks * 16 + 8 * h;
            const f32x4 c0 = *(const f32x4*)cp, c1 = *(const f32x4*)(cp + 4), s0 = *(const f32x4*)sp, s1 = *(const f32x4*)(sp + 4);
#pragma unroll
            for (int j = 0; j < 8; ++j) { const float cc = j < 4 ? c0[j & 3] : c1[j & 3], ss = j < 4 ? s0[j & 3] : s1[j & 3];
                const float x1 = k1[j], x2 = k2[j]; k1[j] = x1 * cc - x2 * ss; k2[j] = x1 * ss + x2 * cc; }
        }
        const bf16x8 vf0 = ldg8(v0p + ks * 16), vf1 = ldg8(v0p + (size_t)32 * R + ks * 16);
#pragma unroll
        for (int dir = 0; dir < 2; ++dir) {
            float a1[8], a2[8];
#pragma unroll
            for (int j = 0; j < 8; ++j) { const int i = ks * 16 + 8 * h + j; const float w = dir == 0 ? ex2(lgf * (float)(127 - i)) : ex2(lgr * (float)i); a1[j] = k1[j] * w; a2[j] = k2[j] * w; }
            const bf16x8 kd0 = pack8(a1), kd1 = pack8(a2);
            acc[dir][0][0] = mma32(kd0, vf0, acc[dir][0][0]); acc[dir][0][1] = mma32(kd0, vf1, acc[dir][0][1]);
            acc[dir][1][0] = mma32(kd1, vf0, acc[dir][1][0]); acc[dir][1][1] = mma32(kd1, vf1, acc[dir][1][1]);
        }
    }
#pragma unroll
    for (int dir = 0; dir < 2; ++dir) { float* o = KV + ((size_t)((b * 4 + hd) * 2 + dir) * 66 + n) * 4096;
#pragma unroll
        for (int dt = 0; dt < 2; ++dt)
#pragma unroll
            for (int et = 0; et < 2; ++et)
#pragma unroll
                for (int q = 0; q < 4; ++q) *(f32x4*)(o + (size_t)(et * 32 + li) * 64 + dt * 32 + 8 * q + 4 * h) = (f32x4){acc[dir][dt][et][4 * q], acc[dir][dt][et][4 * q + 1], acc[dir][dt][et][4 * q + 2], acc[dir][dt][et][4 * q + 3]}; }
}
__device__ __forceinline__ void ret_scan_item(const float* decay, const float* KV, bf16* SPREV, int item, int lane) {
    const int blk = item & 63, bhd = item >> 6, dir = bhd & 1, hd = (bhd >> 1) & 3, idx = blk * 64 + lane;
    const float lg = -log2f(1.f + __expf(-decay[dir * 4 + hd])), cd = ex2(128.f * lg);
    const float* src = KV + (size_t)bhd * 66 * 4096 + idx; bf16* dst = SPREV + (size_t)bhd * 66 * 4096 + idx;
    float s = 0.f;
    for (int s0 = 0; s0 < 66; s0 += 11) {
        float v[11];
#pragma unroll
        for (int j = 0; j < 11; ++j) { const int t = s0 + j; const int n = dir == 0 ? (t < 2 ? 64 + t : t - 2) : (t < 2 ? 65 - t : 65 - t); v[j] = src[(size_t)n * 4096]; }
#pragma unroll
        for (int j = 0; j < 11; ++j) { const int t = s0 + j; const int n = dir == 0 ? (t < 2 ? 64 + t : t - 2) : (t < 2 ? 65 - t : 65 - t); dst[(size_t)n * 4096] = (bf16)(pk2(s, 0.f) & 0xffffu); s = cd * s + v[j]; }
    }
}
struct KVTile { u32x4 k[4], v[4]; };
__device__ __forceinline__ void kv_tile_load(KVTile& T, const bf16* Kh  , const bf16* VTh  , int tok0, int lane) {
#pragma unroll
    for (int i = 0; i < 4; ++i) T.k[i] = *(const u32x4*)(Kh + (size_t)(tok0 + 8 * i + (lane >> 3)) * 256 + (lane & 7) * 8);
#pragma unroll
    for (int i = 0; i < 4; ++i) T.v[i] = *(const u32x4*)(VTh + (size_t)(16 * i + (lane >> 2)) * R + tok0 + (lane & 3) * 8);
}
__device__ __forceinline__ void kv_tile_store(const KVTile& T, LAS unsigned char* wl, int lane) {
#pragma unroll
    for (int i = 0; i < 4; ++i) *(LAS u32x4*)(wl + (8 * i + (lane >> 3)) * 144 + (lane & 7) * 16) = T.k[i];
#pragma unroll
    for (int i = 0; i < 4; ++i) *(LAS u32x4*)(wl + 4608 + (16 * i + (lane >> 2)) * 80 + (lane & 3) * 16) = T.v[i];
}
__device__ __forceinline__ void kv_tile_frags(const LAS unsigned char* wl, int lane, bf16x8 (&kf)[4], bf16x8 (&vf)[2][2]) {
    const int li = lane & 31, h = lane >> 5;
#pragma unroll
    for (int s = 0; s < 4; ++s) kf[s] = *(const LAS bf16x8*)(wl + li * 144 + (2 * s + h) * 16);
#pragma unroll
    for (int et = 0; et < 2; ++et)
#pragma unroll
        for (int s2 = 0; s2 < 2; ++s2) { const LAS unsigned char* p = wl + 4608 + (et * 32 + li) * 80 + s2 * 32 + 8 * h;
            const bf16x4 lo = *(const LAS bf16x4*)p, hi = *(const LAS bf16x4*)(p + 16); vf[et][s2] = __builtin_shufflevector(lo, hi, 0, 1, 2, 3, 4, 5, 6, 7); }
}

__device__ __forceinline__ void rope_item(bf16* RQ, bf16* RK, const float* COSN, const float* SINN, int item, int lane) {
    const int u = lane & 15, off = (u >> 2) * 64 + (u & 3) * 8, c8 = (u & 3) * 8;
#pragma unroll 4
    for (int st = 0; st < 32; ++st) { const int row = item * 128 + 4 * st + (lane >> 4), tl = row & (SEQ - 1);
        const f32x4 c0 = *(const f32x4*)(COSN + (size_t)tl * 32 + c8), c1 = *(const f32x4*)(COSN + (size_t)tl * 32 + c8 + 4), s0 = *(const f32x4*)(SINN + (size_t)tl * 32 + c8), s1 = *(const f32x4*)(SINN + (size_t)tl * 32 + c8 + 4);
#pragma unroll
        for (int w = 0; w < 2; ++w) { bf16* p = (w ? RK : RQ) + (size_t)row * 256 + off; float x1[8], x2[8]; unpack8(*(const bf16x8*)p, x1); unpack8(*(const bf16x8*)(p + 32), x2);
#pragma unroll
            for (int j = 0; j < 8; ++j) { const float cc = j < 4 ? c0[j & 3] : c1[j & 3], ss = j < 4 ? s0[j & 3] : s1[j & 3]; const float a = x1[j], bb = x2[j]; x1[j] = a * cc - bb * ss; x2[j] = a * ss + bb * cc; }
            *(bf16x8*)p = pack8(x1); *(bf16x8*)(p + 32) = pack8(x2); } }
}
__device__ __forceinline__ void ret_out_item(const bf16* RQ, const bf16* RK, const bf16* RG, const bf16* RVT, const bf16* SPREV, const float* decay, const float* gn  , bf16* MIX,
                                             LAS unsigned char* wl, int item, int lane) {
    const int qb = item & 3, it2 = item >> 2, n = it2 % 66, bh = it2 / 66, hd = bh & 3, b = bh >> 2, li = lane & 31, h = lane >> 5;
    const int tok0 = ret_tok0(b, n);
    const float lgf = -log2f(1.f + __expf(-decay[hd])), lgr = -log2f(1.f + __expf(-decay[4 + hd]));
    const int iq = qb * 32 + li;
    const bf16* Kh = RK + hd * 64; const bf16* VTh = RVT + (size_t)hd * 64 * R;
    KVTile T; kv_tile_load(T, Kh, VTh, tok0, lane);
    bf16x8 qf[4];
    { const bf16* qp = RQ + (size_t)(tok0 + iq) * 256 + hd * 64 + 8 * h;
#pragma unroll
      for (int s = 0; s < 4; ++s) qf[s] = ldg8(qp + 16 * s); }
    kv_tile_store(T, wl, lane);
    f32x16 accO[2] = {zero16(), zero16()};
#pragma unroll 1
    for (int kt = 0; kt < 4; ++kt) {
        kv_tile_load(T, Kh, VTh, tok0 + (kt < 3 ? kt + 1 : kt) * 32, lane);
        bf16x8 kf[4], vf[2][2]; kv_tile_frags(wl, lane, kf, vf);
        f32x16 st = zero16();
#pragma unroll
        for (int s = 0; s < 4; ++s) st = mma32(kf[s], qf[s], st);
#pragma unroll
        for (int r = 0; r < 16; ++r) { const int j = kt * 32 + DROW(r, h), df = iq - j;
            const float w = df > 0 ? ex2(lgf * (float)df) : (df < 0 ? ex2(lgr * (float)(-df)) : 2.f); st[r] *= w; }
        const bf16x8 p0 = accB<0>(st), p1 = accB<1>(st);
        accO[0] = mma32(vf[0][0], p0, accO[0]); accO[0] = mma32(vf[0][1], p1, accO[0]); accO[1] = mma32(vf[1][0], p0, accO[1]); accO[1] = mma32(vf[1][1], p1, accO[1]);
        kv_tile_store(T, wl, lane);
    }
    const float cf = ex2(lgf * (float)(iq + 1)), cr = ex2(lgr * (float)(128 - iq));
#pragma unroll
    for (int dir = 0; dir < 2; ++dir) { const bf16* sp = SPREV + ((size_t)((b * 4 + hd) * 2 + dir) * 66 + n) * 4096;
#pragma unroll
        for (int et = 0; et < 2; ++et) { f32x16 a = zero16();
#pragma unroll
            for (int s = 0; s < 4; ++s) a = mma32(ldg8(sp + (size_t)(et * 32 + li) * 64 + 16 * s + 8 * h), qf[s], a);
            const float sc = dir == 0 ? cf : cr;
#pragma unroll
            for (int r = 0; r < 16; ++r) accO[et][r] += sc * a[r]; } }
    float s1 = 0.f;
#pragma unroll
    for (int et = 0; et < 2; ++et)
#pragma unroll
        for (int r = 0; r < 16; ++r) s1 += accO[et][r];
    s1 = xor32_sum(s1); const float mu = s1 * (1.f / 64.f);
    float s2 = 0.f;
#pragma unroll
    for (int et = 0; et < 2; ++et)
#pragma unroll
        for (int r = 0; r < 16; ++r) { const float dlt = accO[et][r] - mu; s2 += dlt * dlt; }
    s2 = xor32_sum(s2); const float rstd = __builtin_amdgcn_rsqf(s2 * (1.f / 64.f) + EPSN);
    const size_t tok = (size_t)(tok0 + iq);
#pragma unroll
    for (int et = 0; et < 2; ++et)
#pragma unroll
        for (int q = 0; q < 4; ++q) { const int e0 = hd * 64 + et * 32 + 8 * q + 4 * h;
            const f32x4 gv = *(const f32x4*)(gn + e0); const u32x2 gg = *(const u32x2*)(RG + tok * 256 + e0);
            const float g0 = bflo(gg.x), g1 = bfhi(gg.x), g2 = bflo(gg.y), g3 = bfhi(gg.y);
            u32x2 w; w.x = pk2(silu_(g0) * (accO[et][4 * q] - mu) * rstd * gv[0], silu_(g1) * (accO[et][4 * q + 1] - mu) * rstd * gv[1]);
            w.y = pk2(silu_(g2) * (accO[et][4 * q + 2] - mu) * rstd * gv[2], silu_(g3) * (accO[et][4 * q + 3] - mu) * rstd * gv[3]);
            *(u32x2*)(MIX + tok * 1024 + 512 + e0) = w; }
}

__device__ __forceinline__ int na_tile_tok(int t, int b, int rs) { const int tb = t - 8; return t >= 8 ? b * SEQ + (rs + (tb >> 1)) * 64 + (tb & 1) * 32 : LROWS + b * CTXL + t * 32; }
__device__ __forceinline__ void na_item(const bf16* NQ, const bf16* NK, const bf16* NVT, bf16* MIX, const LAS float* rpb2, LAS unsigned char* wl, bool ctxq, int b, int r, int hd, int qs, int lane) {
    const int li = lane & 31, h = lane >> 5;
    const int tokq = ctxq ? LROWS + b * CTXL + qs * 32 + li : b * SEQ + r * 64 + qs * 32 + li;
    bf16x8 qf[4];
#pragma unroll
    for (int s = 0; s < 4; ++s) qf[s] = ldg8(NQ + (size_t)tokq * 256 + hd * 64 + 16 * s + 8 * h);
    float mrun = -1e30f, lrun = 0.f;
    f32x16 accO[2] = {zero16(), zero16()};
    const int rs = r - 4 < 0 ? 0 : (r - 4 > 120 ? 120 : r - 4);
    const int qc = qs * 32 + li, cs = qc - 8 < 0 ? 0 : (qc - 8 > 48 ? 48 : qc - 8);
    const int ntile = ctxq ? 8 : 24;
    const float c1 = 0.125f * LOG2E;
    const bf16* Kh = NK + hd * 64; const bf16* VTh = NVT + (size_t)hd * 64 * R;
    KVTile T; kv_tile_load(T, Kh, VTh, na_tile_tok(0, b, rs), lane); kv_tile_store(T, wl, lane);
#pragma unroll 1
    for (int t = 0; t < ntile; ++t) {
        const bool band = t >= 8; const int tb = t - 8, rr = rs + (tb >> 1), ct = tb & 1;
        kv_tile_load(T, Kh, VTh, na_tile_tok(t + 1 < ntile ? t + 1 : t, b, rs), lane);
        bf16x8 kf[4], vf[2][2]; kv_tile_frags(wl, lane, kf, vf);
        f32x16 st = zero16();
#pragma unroll
        for (int s = 0; s < 4; ++s) st = mma32(kf[s], qf[s], st);
        float mt = -INFINITY;
        if (band) { const int dr = rr - r + 7; const LAS float* bp = rpb2 + ((hd * 15 + dr) * 31 + 32 * ct - qc + 15 + 4 * h); const int d0 = 32 * ct + 4 * h - cs;
#pragma unroll
            for (int g = 0; g < 16; ++g) { const int o = 8 * (g >> 2) + (g & 3); const bool inw = (unsigned)(d0 + o) < 16u;
                const float v = inw ? st[g] * c1 + bp[o] : -INFINITY; st[g] = v; mt = fmaxf(mt, v); }
        } else {
#pragma unroll
            for (int g = 0; g < 16; ++g) { const float v = st[g] * c1; st[g] = v; mt = fmaxf(mt, v); }
        }
        mt = xor32_max(mt);
        const float mnew = fmaxf(mrun, mt);
        if (__builtin_amdgcn_ballot_w64(mnew > mrun)) { const float alpha = ex2(mrun - mnew); lrun *= alpha;
#pragma unroll
            for (int et = 0; et < 2; ++et)
#pragma unroll
                for (int g = 0; g < 16; ++g) accO[et][g] *= alpha; }
        mrun = mnew;
        float ps = 0.f;
#pragma unroll
        for (int g = 0; g < 16; ++g) { const float p = ex2(st[g] - mnew); st[g] = p; ps += p; }
        lrun += xor32_sum(ps);
        const bf16x8 p0 = accB<0>(st), p1 = accB<1>(st);
        accO[0] = mma32(vf[0][0], p0, accO[0]); accO[0] = mma32(vf[0][1], p1, accO[0]); accO[1] = mma32(vf[1][0], p0, accO[1]); accO[1] = mma32(vf[1][1], p1, accO[1]);
        kv_tile_store(T, wl, lane);
    }
    const float inv = 1.f / lrun;
#pragma unroll
    for (int et = 0; et < 2; ++et)
#pragma unroll
        for (int q = 0; q < 4; ++q) { u32x2 w; w.x = pk2(accO[et][4 * q] * inv, accO[et][4 * q + 1] * inv); w.y = pk2(accO[et][4 * q + 2] * inv, accO[et][4 * q + 3] * inv);
            *(u32x2*)(MIX + (size_t)tokq * 1024 + 768 + hd * 64 + et * 32 + 8 * q + 4 * h) = w; }
}

__device__ __forceinline__ void fft1_item(const bf16* F, const bf16* W128T, const float* TWC, const float* TWS, bf16* FB, int item, int lane) {
    const int l2 = item & 63, g = (item >> 6) & 3, b = item >> 8, li = lane & 31, h = lane >> 5;
    bf16x8 idf[4];
#pragma unroll
    for (int s = 0; s < 4; ++s) { float v[8];
#pragma unroll
        for (int j = 0; j < 8; ++j) v[j] = (16 * (s & 1) + 8 * h + j == li) ? 1.f : 0.f;
        idf[s] = pack8(v); }
    bf16x8 xb[4][2][2];
#pragma unroll
    for (int lt = 0; lt < 4; ++lt) {
        const bf16* xp = F + (size_t)(b * SEQ + 64 * (lt * 32 + li) + l2) * 256 + g * 64 + 8 * h;
        const bf16x8 x0 = ldg8(xp), x1 = ldg8(xp + 16), x2 = ldg8(xp + 32), x3 = ldg8(xp + 48);
        f32x16 c0 = zero16(), c1 = zero16();
        c0 = mma32(x0, idf[0], c0); c0 = mma32(x1, idf[1], c0);
        c1 = mma32(x2, idf[0], c1); c1 = mma32(x3, idf[1], c1);
        xb[lt][0][0] = accB<0>(c0); xb[lt][0][1] = accB<1>(c0); xb[lt][1][0] = accB<0>(c1); xb[lt][1][1] = accB<1>(c1);
    }
#pragma unroll 1
    for (int kb = 0; kb < 4; ++kb) {
        f32x16 acc[2][2];
#pragma unroll
        for (int ri = 0; ri < 2; ++ri) { acc[ri][0] = zero16(); acc[ri][1] = zero16();
            const bf16* wp = W128T + ((size_t)ri * 128 + kb * 32 + li) * 128 + 4 * h;
#pragma unroll
            for (int lt = 0; lt < 4; ++lt)
#pragma unroll
                for (int s = 0; s < 2; ++s) { const bf16x8 wf = ldg8p(wp + lt * 32 + 16 * s);
                    acc[ri][0] = mma32(wf, xb[lt][0][s], acc[ri][0]); acc[ri][1] = mma32(wf, xb[lt][1][s], acc[ri][1]); } }
#pragma unroll
        for (int q = 0; q < 4; ++q) { const int k1 = kb * 32 + 8 * q + 4 * h;
            const f32x4 tc = *(const f32x4*)(TWC + l2 * 128 + k1), ts = *(const f32x4*)(TWS + l2 * 128 + k1);
#pragma unroll
            for (int j = 0; j < 4; ++j)
#pragma unroll
                for (int ct = 0; ct < 2; ++ct) { const float ar = acc[0][ct][4 * q + j], ai = acc[1][ct][4 * q + j];
                    const float br = ar * tc[j] + ai * ts[j], bi = ai * tc[j] - ar * ts[j];
                    bf16* o = FB + ((((size_t)(b * 4 + g) * 128 + k1 + j) * 2) * 64 + l2) * 64 + ct * 32 + li;
                    o[0] = (bf16)(pk2(br, 0.f) & 0xffffu); o[64 * 64] = (bf16)(pk2(bi, 0.f) & 0xffffu); } }
    }
}
__device__ __forceinline__ void fft2_item(const bf16* FB, const bf16* FCT, const bf16* W64T, bf16* MIX, int item, int lane) {
    const int mh = item & 1, k1 = (item >> 1) & 127, g = (item >> 8) & 3, b = item >> 10, li = lane & 31, h = lane >> 5;
    const bf16* br = FB + (((size_t)(b * 4 + g) * 128 + k1) * 2) * 64 * 64; const bf16* bi = br + 64 * 64;
    const bf16* fc = FCT + (size_t)(mh * 32 + li) * 64 + 8 * h; const bf16* fs = fc + 64 * 64; const bf16* fn = fc + 2 * 64 * 64;
    bf16x8 eb[2][2][2];
#pragma unroll
    for (int lt = 0; lt < 2; ++lt) { f32x16 er = zero16(), ei = zero16();
#pragma unroll
        for (int s = 0; s < 4; ++s) { const bf16x8 ar = ldg8(br + (size_t)(lt * 32 + li) * 64 + 16 * s + 8 * h), ai = ldg8(bi + (size_t)(lt * 32 + li) * 64 + 16 * s + 8 * h);
            const bf16x8 c = ldg8(fc + 16 * s), sn = ldg8(fs + 16 * s), ns = ldg8(fn + 16 * s);
            er = mma32(ar, c, er); er = mma32(ai, sn, er); ei = mma32(ai, c, ei); ei = mma32(ar, ns, ei); }
        eb[lt][0][0] = accB<0>(er); eb[lt][0][1] = accB<1>(er); eb[lt][1][0] = accB<0>(ei); eb[lt][1][1] = accB<1>(ei); }
#pragma unroll
    for (int kt = 0; kt < 2; ++kt) { f32x16 o = zero16();
        const bf16* wc = W64T + (size_t)(kt * 32 + li) * 64 + 4 * h; const bf16* wsn = wc + 64 * 64;
#pragma unroll
        for (int lt = 0; lt < 2; ++lt)
#pragma unroll
            for (int s = 0; s < 2; ++s) { o = mma32(ldg8p(wc + lt * 32 + 16 * s), eb[lt][0][s], o); o = mma32(ldg8p(wsn + lt * 32 + 16 * s), eb[lt][1][s], o); }
#pragma unroll
        for (int rg = 0; rg < 16; ++rg) { const int k2 = kt * 32 + DROW(rg, h);
            MIX[(size_t)(b * SEQ + k1 + 128 * k2) * 1024 + g * 64 + mh * 32 + li] = (bf16)(pk2(o[rg], 0.f) & 0xffffu); } }
}
__device__ __forceinline__ void fftc_item(const bf16* F, const bf16* FCT, const bf16* W256T, bf16* MIX, int item, int lane) {
    const int mh = item & 1, kb = (item >> 1) & 7, g = (item >> 4) & 3, b = item >> 6, li = lane & 31, h = lane >> 5;
    const bf16* fc = FCT + (size_t)(mh * 32 + li) * 64 + 8 * h; const bf16* fn = fc + 2 * 64 * 64;
    const bf16* wc = W256T + (size_t)(kb * 32 + li) * 256 + 4 * h; const bf16* wsn = wc + 256 * 256;
    f32x16 o = zero16();
#pragma unroll 1
    for (int lt = 0; lt < 8; ++lt) { f32x16 zr = zero16(), zi = zero16();
        const bf16* xp = F + (size_t)(LROWS + b * CTXL + lt * 32 + li) * 256 + g * 64 + 8 * h;
#pragma unroll
        for (int s = 0; s < 4; ++s) { const bf16x8 x = ldg8(xp + 16 * s); zr = mma32(x, ldg8(fc + 16 * s), zr); zi = mma32(x, ldg8(fn + 16 * s), zi); }
        o = mma32(ldg8p(wc + lt * 32), accB<0>(zr), o); o = mma32(ldg8p(wc + lt * 32 + 16), accB<1>(zr), o);
        o = mma32(ldg8p(wsn + lt * 32), accB<0>(zi), o); o = mma32(ldg8p(wsn + lt * 32 + 16), accB<1>(zi), o); }
#pragma unroll
    for (int rg = 0; rg < 16; ++rg) { const int k = kb * 32 + DROW(rg, h);
        MIX[(size_t)(LROWS + b * CTXL + k) * 1024 + g * 64 + mh * 32 + li] = (bf16)(pk2(o[rg], 0.f) & 0xffffu); }
}
__device__ __forceinline__ void row_ld_f32(const float* p, int lane, f32x4 (&v)[4]) {
#pragma unroll
    for (int j = 0; j < 4; ++j) v[j] = *(const f32x4*)(p + 256 * j + 4 * lane); }
__device__ __forceinline__ void row_ld_bf16(const bf16* p, int lane, f32x4 (&v)[4]) {
#pragma unroll
    for (int j = 0; j < 4; ++j) { const u32x2 w = *(const u32x2*)(p + 256 * j + 4 * lane); v[j] = (f32x4){bflo(w.x), bfhi(w.x), bflo(w.y), bfhi(w.y)}; } }
__device__ __forceinline__ void row_ld_part(const float* P, int nslice, int r, int lane, f32x4 (&v)[4]) {
#pragma unroll
    for (int j = 0; j < 4; ++j) { const float* p = P + ((size_t)((((r - LROWS) >> 8) * 4 + j) * nslice) * 256 + (r & 255)) * 256 + 4 * lane; f32x4 s = *(const f32x4*)p;
        for (int k = 1; k < nslice; ++k) s = s + *(const f32x4*)(p + (size_t)k * 65536);
        v[j] = s; } }
__device__ __forceinline__ void row_st_f32(float* p, int lane, const f32x4 (&v)[4]) {
#pragma unroll
    for (int j = 0; j < 4; ++j) *(f32x4*)(p + 256 * j + 4 * lane) = v[j]; }
__device__ __forceinline__ void row_st_bf16(bf16* p, int lane, const f32x4 (&v)[4]) {
#pragma unroll
    for (int j = 0; j < 4; ++j) { u32x2 w; w.x = pk2(v[j][0], v[j][1]); w.y = pk2(v[j][2], v[j][3]); *(u32x2*)(p + 256 * j + 4 * lane) = w; } }
__device__ __forceinline__ float row_rstd(const f32x4 (&v)[4]) { float s = 0.f;
#pragma unroll
    for (int j = 0; j < 4; ++j) s += (v[j][0] * v[j][0] + v[j][1] * v[j][1]) + (v[j][2] * v[j][2] + v[j][3] * v[j][3]);
    return __builtin_amdgcn_rsqf(wave_sum(s) * (1.f / 1024.f) + EPSN); }
__device__ __forceinline__ void row_modnorm(const f32x4 (&x)[4], const float* g, const float* sc, const float* sh, int lane, f32x4 (&hh)[4]) {
    const float rs = row_rstd(x); f32x4 gv[4], scv[4], shv[4]; row_ld_f32(g, lane, gv); row_ld_f32(sc, lane, scv); row_ld_f32(sh, lane, shv);
#pragma unroll
    for (int j = 0; j < 4; ++j) hh[j] = x[j] * rs * gv[j] * (scv[j] + 1.f) + shv[j]; }
__device__ __forceinline__ void row_resid(f32x4 (&x)[4], const f32x4 (&t)[4], const float* g, const float* gate, int lane) {
    const float rs = row_rstd(t); f32x4 gv[4], ga[4]; row_ld_f32(g, lane, gv); row_ld_f32(gate, lane, ga);
#pragma unroll
    for (int j = 0; j < 4; ++j) x[j] = x[j] + ga[j] * (t[j] * rs * gv[j]); }

struct NormCfg {
    const float* xin_lat; const float* xin_ctx;
    float* xout_lat; float* xout_ctx;
    const bf16* trow;
    const float* tpart; int npart;
    const float* gA; const float* modA; int gate_off;
    const float* gB; const float* modB; int sc_off, sh_off; bf16* hout;
    int nrows;
};
__device__ __forceinline__ void norm_rows(const NormCfg& C, int wslot, int NW, int lane) {
    const int nlat = C.nrows < LROWS ? C.nrows : LROWS;
    int r = wslot;
    if (r < nlat) {
        int cur = -1; f32x4 gav[4], scv[4], shv[4];
        f32x4 xn[4]; u32x2 tn[4];
#pragma unroll
        for (int j = 0; j < 4; ++j) { tn[j] = (u32x2){0u, 0u}; gav[j] = scv[j] = shv[j] = (f32x4){0.f, 0.f, 0.f, 0.f}; }
        row_ld_f32(C.xin_lat + (size_t)r * D, lane, xn);
        if (C.trow) {
#pragma unroll
            for (int j = 0; j < 4; ++j) tn[j] = *(const u32x2*)(C.trow + (size_t)r * D + 256 * j + 4 * lane); }
        for (; r < nlat; r += NW) {
            f32x4 x[4]; u32x2 tr[4];
#pragma unroll
            for (int j = 0; j < 4; ++j) { x[j] = xn[j]; tr[j] = tn[j]; }
            const int r2 = r + NW;
            if (r2 < nlat) { row_ld_f32(C.xin_lat + (size_t)r2 * D, lane, xn);
                if (C.trow) {
#pragma unroll
                    for (int j = 0; j < 4; ++j) tn[j] = *(const u32x2*)(C.trow + (size_t)r2 * D + 256 * j + 4 * lane); } }
            const int ci = r < SEQ ? 0 : 1;
            if (ci != cur) { cur = ci;
                if (C.trow) row_ld_f32(C.modA + (size_t)ci * 6144 + C.gate_off, lane, gav);
                if (C.gB) { row_ld_f32(C.modB + (size_t)ci * 6144 + C.sc_off, lane, scv); row_ld_f32(C.modB + (size_t)ci * 6144 + C.sh_off, lane, shv); } }
            if (C.trow) { f32x4 t[4], gAv[4]; row_ld_f32(C.gA, lane, gAv);
#pragma unroll
                for (int j = 0; j < 4; ++j) t[j] = (f32x4){bflo(tr[j].x), bfhi(tr[j].x), bflo(tr[j].y), bfhi(tr[j].y)};
                const float rs = row_rstd(t);
#pragma unroll
                for (int j = 0; j < 4; ++j) x[j] = x[j] + gav[j] * (t[j] * rs * gAv[j]);
                row_st_f32(C.xout_lat + (size_t)r * D, lane, x); }
            if (C.gB) { f32x4 gBv[4]; row_ld_f32(C.gB, lane, gBv); const float rs = row_rstd(x); f32x4 hh[4];
#pragma unroll
                for (int j = 0; j < 4; ++j) hh[j] = x[j] * rs * gBv[j] * (scv[j] + 1.f) + shv[j];
                row_st_bf16(C.hout + (size_t)r * D, lane, hh); }
        }
    }
    for (r = LROWS + wslot; r < C.nrows; r += NW) {
        f32x4 x[4]; row_ld_f32(C.xin_ctx + (size_t)(r - LROWS) * D, lane, x);
        if (C.trow) { f32x4 t[4]; if (C.tpart) row_ld_part(C.tpart, C.npart, r, lane, t); else row_ld_bf16(C.trow + (size_t)r * D, lane, t);
            row_resid(x, t, C.gA, C.modA + (size_t)2 * 6144 + C.gate_off, lane); row_st_f32(C.xout_ctx + (size_t)(r - LROWS) * D, lane, x); }
        if (C.gB) { f32x4 hh[4]; row_modnorm(x, C.gB, C.modB + (size_t)2 * 6144 + C.sc_off, C.modB + (size_t)2 * 6144 + C.sh_off, lane, hh); row_st_bf16(C.hout + (size_t)r * D, lane, hh); }
    }
}

__device__ __forceinline__ void transpose_item(const float* W, int ldw, int k0, int n0, bf16* dst, int ldd, float scale, LAS float* scr, int lane) {
#pragma unroll 8
    for (int i = 0; i < 32; ++i) { const int kk = 2 * i + (lane >> 5); scr[kk * 33 + (lane & 31)] = W[(size_t)(k0 + kk) * ldw + n0 + (lane & 31)]; }
    LDS_WAIT(); asm volatile("" ::: "memory");
    const int c = lane & 7;
#pragma unroll
    for (int j = 0; j < 4; ++j) { const int n = (lane >> 3) + 8 * j; const LAS float* s = scr + (8 * c) * 33 + n;
        u32x4 o; o.x = pk2(s[0 * 33] * scale, s[1 * 33] * scale); o.y = pk2(s[2 * 33] * scale, s[3 * 33] * scale); o.z = pk2(s[4 * 33] * scale, s[5 * 33] * scale); o.w = pk2(s[6 * 33] * scale, s[7 * 33] * scale);
        *(u32x4*)(dst + (size_t)n * ldd + k0 + 8 * c) = o; }
    LDS_WAIT(); asm volatile("" ::: "memory");
}
#ifndef MK_MODE
#define MK_MODE 1
#endif
#ifndef MK_LAST
#define MK_LAST 24
#endif
constexpr int NPHASE = 24;
struct Args { const float* in[31]; float* out; unsigned char* ws; int ph_lo, ph_hi, li, pad; };


struct TrJob { const float* src; bf16* dst; int ldw, k0, n0, ldd; float scale; };
#define CAS __attribute__((address_space(4)))
__device__ __forceinline__ void tr_decode(int it, const CAS Args* ap_, unsigned char* ws, TrJob& J) {
#define TIN(k) ((const float*)(const GAS float*)ap_->in[k])
    int kb; J.scale = 1.f;
    if (it < 43008) { const int e = it / 5376, r = it % 5376, w = r / 1792, li = r % 1792;
        if (w < 2) { J.src = TIN(28 + w) + (size_t)e * 1024 * DFE; J.ldw = DFE; kb = li / 112; J.n0 = (li % 112) * 32; J.ldd = 1024;
            J.dst = (bf16*)(ws + WS_MOE1) + ((size_t)e * 7168 + 256 * (J.n0 / 128) + (J.n0 % 128) + 128 * w) * 1024; }
        else { J.src = TIN(30) + (size_t)e * DFE * 1024; J.ldw = 1024; kb = li / 32; J.n0 = (li % 32) * 32; J.ldd = DFE; J.dst = (bf16*)(ws + WS_MOE2) + ((size_t)e * 1024 + J.n0) * DFE; }
    } else if (it < 47232) { const int r = it - 43008, w = r / 1408, li = r % 1408;
        if (w < 2) { J.src = TIN(23 + w); J.ldw = DFF; kb = li / 88; J.n0 = (li % 88) * 32; J.ldd = 1024; J.dst = (bf16*)(ws + WS_FFN1) + (size_t)(256 * (J.n0 / 128) + (J.n0 % 128) + 128 * w) * 1024; }
        else { J.src = TIN(25); J.ldw = 1024; kb = li / 32; J.n0 = (li % 32) * 32; J.ldd = DFF; J.dst = (bf16*)(ws + WS_FFN2) + (size_t)J.n0 * DFF; }
    } else { const int r = it - 47232, l = r / 4384, q = r % 4384;
        if (q < 3328) { const int t = q / 128, li = q % 128; kb = li / 8; const int nb = li % 8;
            const int srcc = t < 4 ? 256 * t : (t < 7 ? 256 * (t + 1) : (t < 23 ? 2304 + 256 * (t - 7) : (t == 23 ? 768 : (t == 24 ? 1024 : 2048))));
            J.src = TIN(7) + (size_t)l * 1024 * 6400; J.ldw = 6400; J.n0 = srcc + 32 * nb; J.ldd = 1024; J.dst = (bf16*)(ws + WS_WIN) + ((size_t)(l * 26 + t) * 256 + 32 * nb) * 1024; J.scale = (t == 3 || t == 23) ? 0.125f : 1.f; }
        else if (q < 3360) { const int li = q - 3328; kb = li / 8; J.n0 = (li % 8) * 32; J.src = TIN(16) + (size_t)l * 65536; J.ldw = 256; J.ldd = 256; J.dst = (bf16*)(ws + WS_WGLU) + ((size_t)l * 256 + J.n0) * 256; }
        else if (q < 3872) { const int li = q - 3360, bb = li / 128, li2 = li % 128; kb = li2 / 32; J.n0 = (li2 % 32) * 32; J.src = TIN(21) + (size_t)(l * 4 + bb) * 256 * 1024; J.ldw = 1024; J.ldd = 1024; J.dst = (bf16*)(ws + WS_WBR) + ((size_t)l * 1024 + J.n0) * 1024 + bb * 256; }
        else { const int li = q - 3872; kb = li / 32; J.n0 = (li % 32) * 32; J.src = TIN(22) + (size_t)l * 1024 * 1024; J.ldw = 1024; J.ldd = 1024; J.dst = (bf16*)(ws + WS_WOUT) + ((size_t)l * 1024 + J.n0) * 1024; }
    }
    J.k0 = kb * 64;
#undef TIN
}
__device__ __forceinline__ void tr_load(const TrJob& J, int lane, float (&v)[32]) {
#pragma unroll
    for (int i = 0; i < 32; ++i) { const int kk = 2 * i + (lane >> 5); v[i] = J.src[(size_t)(J.k0 + kk) * J.ldw + J.n0 + (lane & 31)]; } }
__device__ __forceinline__ void tr_store(const TrJob& J, int lane, const float (&v)[32], LAS float* scr) {
#pragma unroll
    for (int i = 0; i < 32; ++i) { const int kk = 2 * i + (lane >> 5); scr[kk * 33 + (lane & 31)] = v[i]; }
    LDS_WAIT(); asm volatile("" ::: "memory");
    const int c = lane & 7;
#pragma unroll
    for (int j = 0; j < 4; ++j) { const int n = (lane >> 3) + 8 * j; const LAS float* s = scr + (8 * c) * 33 + n; const float sc = J.scale;
        u32x4 o; o.x = pk2(s[0 * 33] * sc, s[1 * 33] * sc); o.y = pk2(s[2 * 33] * sc, s[3 * 33] * sc); o.z = pk2(s[4 * 33] * sc, s[5 * 33] * sc); o.w = pk2(s[6 * 33] * sc, s[7 * 33] * sc);
        *(u32x4*)(J.dst + (size_t)n * J.ldd + J.k0 + 8 * c) = o; }
    LDS_WAIT(); asm volatile("" ::: "memory");
}

__device__ __forceinline__ void cs2pi(int m, int N, float& c, float& s) { sincospif(2.0f * (float)(m % N) / (float)N, &s, &c); }

__global__ void __launch_bounds__(NTHREADS, 2) mk_fwd(Args args) {
    extern __shared__ __attribute__((aligned(16))) unsigned char lds_raw[];
    LAS unsigned char* lds = (LAS unsigned char*)lds_raw;
    const int tid0 = threadIdx.x, wave = __builtin_amdgcn_readfirstlane(tid0 >> 6);
    const int G = gridDim.x, bx = blockIdx.x, vcu = (G % 8 == 0) ? (bx % 8) * (G / 8) + bx / 8 : bx;
    const int wslot = wave * G + vcu, NW = G * NWAVES;
    volatile LAS unsigned* lctl = (volatile LAS unsigned*)(lds + LDSCTL_OFF);
    for (int u = tid0; u < (LDS_BYTES - LDSCTL_OFF) / 4; u += NTHREADS) lctl[u] = 0u;
    __syncthreads();
    const int lo = args.ph_lo, hi = args.ph_hi, bli = args.li;
#ifdef MK_STAMP_PHASE
    if (wave == 0) *(volatile LAS unsigned long long*)(lctl + 64) = __builtin_amdgcn_s_memrealtime();
#endif
    { XcdBarrier b0 = xcd_barrier_post((unsigned*)(args.ws + WS_CTL) + CW_BAR + bli * XCD_BAR_WORDS, lctl + LW_BAR); (void)b0; }
#define IN(k) (lo <= (k) && (k) < hi)
#ifndef MK_DBL
#define MK_DBL 0
#endif
#define MK_NR(k) (MK_DBL == (k) ? 2 : 1)
#ifndef MK_REP_MASK
#define MK_REP_MASK 0u
#endif
#define NREP(k) (((MK_REP_MASK >> (k)) & 1u) ? 2 : 1)
#define FORCE_BAR do { PH_BEGIN XcdBarrier b_; b_.bar = (unsigned*)(ws + WS_CTL) + CW_BAR + bli * XCD_BAR_WORDS; b_.x = xb_xcc_id(); b_.st = lctl + LW_BAR; xcd_barrier(b_); } while (0)
#ifdef MK_STAMP_PHASE
#define STAMP_AT(k) do { if (wave == 0) { if ((k) == MK_STAMP_PHASE - 1) *(volatile LAS unsigned long long*)(lctl + 64) = __builtin_amdgcn_s_memrealtime(); if ((k) == MK_STAMP_PHASE) *(volatile LAS unsigned long long*)(lctl + 66) = __builtin_amdgcn_s_memrealtime(); } } while (0)
#else
#define STAMP_AT(k) do { } while (0)
#endif
#define SEAM(k) do { if (IN(k) && IN((k) + 1)) { PH_BEGIN XcdBarrier b_; b_.bar = (unsigned*)(ws + WS_CTL) + CW_BAR + bli * XCD_BAR_WORDS; b_.x = xb_xcc_id(); b_.st = lctl + LW_BAR; xcd_barrier(b_); } STAMP_AT(k); } while (0)
#define PH_BEGIN int tid; { int l_; asm volatile("v_mbcnt_lo_u32_b32 %0, -1, 0\n\tv_mbcnt_hi_u32_b32 %0, -1, %0" : "=v"(l_)); tid = wave * 64 + (l_ & 63); } const CAS Args* ap_ = (const CAS Args*)__builtin_amdgcn_kernarg_segment_ptr(); asm volatile("" : "+s"(ap_)); unsigned char* ws = (unsigned char*)(GAS unsigned char*)ap_->ws; const int lane = tid & 63; (void)lane;
#define AIN(k) ((const float*)(const GAS float*)ap_->in[k])
#define AOUT ((float*)(GAS float*)ap_->out)
#define MODp ((float*)(ws + CTL_MOD_OFF))
#define ctxbuf ((float*)(ws + WS_CTXBUF))
#define Hh ((bf16*)(ws + WS_H))
#define MIX ((bf16*)(ws + WS_MIX))
#define INP ((bf16*)(ws + WS_INP))
#define Tt ((bf16*)(ws + WS_T))

    for (int rep_ = 0; rep_ < NREP(0); ++rep_) if (IN(0)) { if (rep_) { FORCE_BAR; } PH_BEGIN
        for (int dd_ = 0; dd_ < MK_NR(20); ++dd_) for (int it = bx; it < 32; it += G) {
            const int l = it >> 4, g = it & 15;
            LAS f32x2* apow = (LAS f32x2*)lds; LAS f32x2* bbar = (LAS f32x2*)(lds + 8704); LAS f32x2* Cc = (LAS f32x2*)(lds + 16896); LAS float* Kt = (LAS float*)(lds + 25088);
            for (int dir = 0; dir < 2; ++dir) { const size_t pg = (size_t)(l * 2 + dir) * 16 + g;
                if (tid < 64) { const int p = tid;
                    const float are = AIN(8)[pg * 64 + p], aim = AIN(9)[pg * 64 + p], dt = expf(AIN(10)[pg]);
                    for (int t = 0; t <= 16; ++t) { const float mag = expf(are * dt * (float)t); float sn, cs; sincosf(aim * dt * (float)t, &sn, &cs); apow[t * 64 + p] = (f32x2){mag * cs, mag * sn}; }
                    const f32x2 a = apow[64 + p]; const float nr = a.x - 1.f, ni = a.y, den = 1.f / (are * are + aim * aim);
                    const float cr = (nr * are + ni * aim) * den, ci = (ni * are - nr * aim) * den;
                    for (int h = 0; h < 16; ++h) { const float br = AIN(11)[(pg * 64 + p) * 16 + h], bi = AIN(12)[(pg * 64 + p) * 16 + h]; bbar[p * 16 + h] = (f32x2){cr * br - ci * bi, cr * bi + ci * br}; }
                    *(f32x2*)((float*)(ws + WS_A16) + (pg * 64 + p) * 2) = apow[16 * 64 + p];
                }
                for (int i = tid; i < 1024; i += NTHREADS) Cc[i] = (f32x2){AIN(13)[pg * 1024 + i], AIN(14)[pg * 1024 + i]};
                __syncthreads();
                bf16* M1 = (bf16*)(ws + WS_S5M1) + ((size_t)(l * 16 + g) * 2 + dir) * 128 * 256;
                for (int v = tid; v < 4096; v += NTHREADS) { const int row = v >> 5, col0 = (v & 31) * 8, j = col0 >> 4, h0 = col0 & 15, p = row >> 1, ri = row & 1;
                    const f32x2 pw = apow[(dir == 0 ? 15 - j : j) * 64 + p]; float vals[8];
#pragma unroll
                    for (int hh = 0; hh < 8; ++hh) { const f32x2 bb = bbar[p * 16 + h0 + hh]; vals[hh] = ri ? pw.x * bb.y + pw.y * bb.x : pw.x * bb.x - pw.y * bb.y; }
                    *(bf16x8*)(M1 + ((((col0 >> 4) * 4 + (row >> 5)) * 64 + ((col0 >> 3) & 1) * 32 + (row & 31)) * 8)) = pack8(vals); }
                bf16* TAB = (bf16*)(ws + WS_S5TAB) + (size_t)(l * 16 + g) * 256 * 512;
                for (int v = tid; v < 4096; v += NTHREADS) { const int row = v >> 4, cv = v & 15, i = row >> 4, ho = row & 15; float vals[8];
#pragma unroll
                    for (int pp = 0; pp < 4; ++pp) { const int p = cv * 4 + pp; const f32x2 cc = Cc[ho * 64 + p];
                        const f32x2 pw = apow[(dir == 0 ? i + 1 : 16 - i) * 64 + p]; vals[2 * pp] = cc.x * pw.x - cc.y * pw.y; vals[2 * pp + 1] = -(cc.x * pw.y + cc.y * pw.x); }
                    { const int colt = 256 + dir * 128 + cv * 8; *(bf16x8*)(TAB + (((((row >> 7) * 32 + (colt >> 4)) * 4 + ((row >> 5) & 3)) * 64 + ((colt >> 3) & 1) * 32 + (row & 31)) * 8)) = pack8(vals); } }
                for (int e = tid; e < 4096; e += NTHREADS) { const int t = e >> 8, ho = (e >> 4) & 15, h = e & 15; float acc = 0.f;
#pragma unroll 8
                    for (int p = 0; p < 64; ++p) { const f32x2 cc = Cc[ho * 64 + p], pw = apow[t * 64 + p], bb = bbar[p * 16 + h];
                        const float xr = cc.x * pw.x - cc.y * pw.y, xi = cc.x * pw.y + cc.y * pw.x; acc += xr * bb.x - xi * bb.y; }
                    Kt[dir * 4096 + e] = acc; }
                __syncthreads();
            }
            for (int v = tid; v < 8192; v += NTHREADS) { const int row = v >> 5, col0 = (v & 31) * 8, i = row >> 4, ho = row & 15, j = col0 >> 4, h0 = col0 & 15; float vals[8];
#pragma unroll
                for (int hh = 0; hh < 8; ++hh) { const int h = h0 + hh;
                    vals[hh] = j < i ? Kt[(i - j) * 256 + ho * 16 + h] : (j > i ? Kt[4096 + (j - i) * 256 + ho * 16 + h] : Kt[ho * 16 + h] + Kt[4096 + ho * 16 + h] + (ho == h ? AIN(15)[l * 256 + g * 16 + h] : 0.f)); }
                *(bf16x8*)((bf16*)(ws + WS_S5TAB) + (size_t)(l * 16 + g) * 256 * 512 + (((((row >> 7) * 32 + (col0 >> 4)) * 4 + ((row >> 5) & 3)) * 64 + ((col0 >> 3) & 1) * 32 + (row & 31)) * 8)) = pack8(vals); }
            __syncthreads();
        }
        __syncthreads();
        for (int it = (bx >= 32 ? bx - 32 : bx + G - 32); it < 192; it += G) { const int l = it / 96, cb = it % 96, col = cb * 64 + lane, ks = wave;
            const float* wm = AIN(4) + ((size_t)l * 1024 + ks * 128) * 6144 + col; float a0 = 0.f, a1 = 0.f, a2 = 0.f;
#pragma unroll 8
            for (int k = 0; k < 128; ++k) { const float w = wm[(size_t)k * 6144]; const int kk = ks * 128 + k;
                const float c0 = AIN(1)[kk], c1 = AIN(1)[1024 + kk], c2 = AIN(3)[kk];
                a0 += w * (c0 / (1.f + __expf(-c0))); a1 += w * (c1 / (1.f + __expf(-c1))); a2 += w * (c2 / (1.f + __expf(-c2))); }
            LAS float* part = (LAS float*)lds;
            part[(wave * 3 + 0) * 64 + lane] = a0; part[(wave * 3 + 1) * 64 + lane] = a1; part[(wave * 3 + 2) * 64 + lane] = a2;
            __syncthreads();
            if (tid < 192) { const int i = tid >> 6, c = tid & 63; float sacc = AIN(5)[l * 6144 + cb * 64 + c];
#pragma unroll
                for (int w = 0; w < 8; ++w) sacc += part[(w * 3 + i) * 64 + c];
                MODp[(size_t)(l * 3 + i) * 6144 + cb * 64 + c] = sacc; }
            __syncthreads();
        }
        { LAS float* scr = (LAS float*)(lds + wave * 16384);
          unsigned* qh = (unsigned*)(ws + WS_CTL) + CW_QHEAD;
          int q = bx & 7, tries = 0;
#define TR_POP(dst) do { dst = -1; while (tries < 8) { unsigned b_ = 0u; if (lane == 0) b_ = __hip_atomic_fetch_add(qh + 64 * q, 2u, __ATOMIC_RELAXED, __HIP_MEMORY_SCOPE_AGENT); \
              b_ = (unsigned)__builtin_amdgcn_readfirstlane((int)b_); if (b_ < 7000u) { dst = q * 7000 + (int)b_; break; } q = (q + 1) & 7; ++tries; } } while (0)
#define TR_LOAD2(VA, VB, g_) do { TrJob j_; tr_decode(g_, ap_, ws, j_); tr_load(j_, lane, VA); tr_decode((g_) + (((g_) % 7000) + 1 < 7000 ? 1 : 0), ap_, ws, j_); tr_load(j_, lane, VB); } while (0)
#define TR_STORE2(VA, VB, g_) do { TrJob j_; tr_decode(g_, ap_, ws, j_); tr_store(j_, lane, VA, scr); if (((g_) % 7000) + 1 < 7000) { tr_decode((g_) + 1, ap_, ws, j_); tr_store(j_, lane, VB, scr); } } while (0)
          float a0[32], a1[32], b0[32], b1[32]; int s0, s1;
          TR_POP(s0); if (s0 >= 0) TR_LOAD2(a0, a1, s0);
          TR_POP(s1);
          while (s0 >= 0) {
              int s2, s3 = -1;
              if (s1 >= 0) TR_LOAD2(b0, b1, s1);
              TR_POP(s2);
              TR_STORE2(a0, a1, s0);
              if (s1 < 0) break;
              if (s2 >= 0) TR_LOAD2(a0, a1, s2);
              TR_POP(s3);
              TR_STORE2(b0, b1, s1);
              s0 = s2; s1 = s3;
          }
#undef TR_POP
#undef TR_LOAD2
#undef TR_STORE2
        }
        for (int v = wslot * 64 + lane; v < 32 * SEQ; v += NW * 64) { const int p = v >> 13, t = v & 8191; const float pos = (float)(p < 16 ? (t >> 6) : (t & 63));
            const float inv = 1.0f / powf(10000.f, (float)(p & 15) / 16.f); float sn, cs; sincosf(pos * inv, &sn, &cs);
            ((float*)(ws + WS_COST))[v] = cs; ((float*)(ws + WS_SINT))[v] = sn; ((float*)(ws + WS_COSN))[t * 32 + p] = cs; ((float*)(ws + WS_SINN))[t * 32 + p] = sn; }
        for (int v = wslot * 64 + lane; v < 192512; v += NW * 64) { float c, s;
            if (v < 32768) { const int ri = v >> 14, k1 = (v >> 7) & 127, l1 = v & 127; cs2pi(k1 * l1, 128, c, s); const float sc = 0.08838834764831845f;
                ((bf16*)(ws + WS_W128T))[v] = (bf16)(pk2(ri ? -s * sc : c * sc, 0.f) & 0xffffu); }
            else if (v < 40960) { const int u = v - 32768, l2 = u >> 7, k1 = u & 127; cs2pi(k1 * l2, 8192, c, s); ((float*)(ws + WS_TWC))[u] = c; ((float*)(ws + WS_TWS))[u] = s; }
            else if (v < 53248) { const int u = v - 40960, w = u >> 12, m = (u >> 6) & 63, cc = u & 63; cs2pi(m * cc, 64, c, s);
                ((bf16*)(ws + WS_FCT))[u] = (bf16)(pk2((w == 0 ? c : (w == 1 ? s : -s)) * 0.125f, 0.f) & 0xffffu); }
            else if (v < 61440) { const int u = v - 53248, w = u >> 12, k2 = (u >> 6) & 63, l2 = u & 63; cs2pi(k2 * l2, 64, c, s); ((bf16*)(ws + WS_W64T))[u] = (bf16)(pk2((w == 0 ? c : s) * 0.125f, 0.f) & 0xffffu); }
            else { const int u = v - 61440, w = u >> 16, k = (u >> 8) & 255, l = u & 255; cs2pi(k * l, 256, c, s); ((bf16*)(ws + WS_W256T))[u] = (bf16)(pk2((w == 0 ? c : s) * 0.0625f, 0.f) & 0xffffu); }
        }
    }
    SEAM(0);

    for (int rep_ = 0; rep_ < NREP(1); ++rep_) if (IN(1)) { if (rep_) { FORCE_BAR; } PH_BEGIN
        { NormCfg C{AIN(0), AIN(2), nullptr, nullptr, nullptr, nullptr, 0, nullptr, nullptr, 0, AIN(6), MODp, 1024, 0, Hh, R}; norm_rows(C, wslot, NW, lane); }
    }
    SEAM(1);

    for (int layer = 0; layer < 2; ++layer) {
        const int pb = 1 + 11 * layer;
        const int nM = layer == 0 ? 66 : 64;
        const int nrows = layer == 0 ? R : LROWS;
#define normg (AIN(6) + (size_t)layer * 4 * D)
        for (int rep_ = 0; rep_ < NREP(pb + 1); ++rep_) if (IN(pb + 1)) { if (rep_) { FORCE_BAR; } PH_BEGIN
            gp::SchedInprojA S{(const char*)Hh, (const char*)(ws + WS_WIN) + (size_t)layer * 26 * 256 * 2048, 66, G, bx, layer == 0 ? 32 : 0};
            gp::EpiInprojA E{INP, Tt, (unsigned char*)(ws + WS_GCTX)};
            gp::gemm_phase(lds, tid, 1024, 1024, 1024, S, E);
        }
        SEAM(pb + 1);
        for (int rep_ = 0; rep_ < NREP(pb + 2); ++rep_) if (IN(pb + 2)) { if (rep_) { FORCE_BAR; } PH_BEGIN
            LAS float* rpb = (LAS float*)(lds + 98304 + 4096);
            LAS unsigned char* wl = lds + wave * 12288;
            for (int i = tid; i < 1860; i += NTHREADS) rpb[i] = AIN(20)[layer * 1860 + i] * LOG2E;
            __syncthreads();
            const int nitA = 2224 + 64 + (layer == 0 ? 64 : 0);
            for (int it = wslot; it < nitA; it += NW) {
                if (it < 1056) s5_state_item((const bf16*)(ws + WS_S5M1) + (size_t)layer * 16 * 2 * 128 * 256, INP + (size_t)R * 256, (float*)(ws + WS_HLOC), it, lane);
                else if (it < 1584) ret_kv_item(Tt, Tt + (size_t)256 * R, (const float*)(ws + WS_COST), (const float*)(ws + WS_SINT), AIN(18) + layer * 8, (float*)(ws + WS_KV), it - 1056, lane);
                else if (it < 2096) fft1_item(INP, (const bf16*)(ws + WS_W128T), (const float*)(ws + WS_TWC), (const float*)(ws + WS_TWS), (bf16*)(ws + WS_FB), it - 1584, lane);
                else if (it < 2224) rope_item(INP + (size_t)2 * R * 256, INP + (size_t)3 * R * 256, (const float*)(ws + WS_COSN), (const float*)(ws + WS_SINN), it - 2096, lane);
                else if (it < 2288) { const int j = 1984 + (it - 2224); na_item(INP + (size_t)5 * R * 256, INP + (size_t)6 * R * 256, Tt + (size_t)512 * R, MIX, rpb, wl, false, j >> 10, (j >> 3) & 127, (j >> 1) & 3, j & 1, lane); }
                else { const int j = it - 2288; na_item(INP + (size_t)5 * R * 256, INP + (size_t)6 * R * 256, Tt + (size_t)512 * R, MIX, rpb, wl, true, j >> 5, 0, (j >> 3) & 3, j & 7, lane); }
            }
            __syncthreads();
        }
        SEAM(pb + 2);
        for (int rep_ = 0; rep_ < NREP(pb + 3); ++rep_) if (IN(pb + 3)) { if (rep_) { FORCE_BAR; } PH_BEGIN
            LAS float* rpb = (LAS float*)(lds + 98304 + 4096); LAS unsigned char* wl = lds + wave * 12288;
            for (int i = tid; i < 1860; i += NTHREADS) rpb[i] = AIN(20)[layer * 1860 + i] * LOG2E;
            __syncthreads();
            for (int vs = wslot; vs < 2048; vs += NW) {
                if (vs < 64) s5_scan_item((const float*)(ws + WS_A16) + (size_t)layer * 2 * 16 * 64 * 2, (const float*)(ws + WS_HLOC), (bf16*)(ws + WS_HIN), wl, vs, lane);
                else { const int j = vs - 64; na_item(INP + (size_t)5 * R * 256, INP + (size_t)6 * R * 256, Tt + (size_t)512 * R, MIX, rpb, wl, false, j >> 10, (j >> 3) & 127, (j >> 1) & 3, j & 1, lane);
                    if (vs >= 1024) ret_scan_item(AIN(18) + layer * 8, (const float*)(ws + WS_KV), (bf16*)(ws + WS_SPREV), vs - 1024, lane); }
            }
            __syncthreads();
        }
        SEAM(pb + 3);
        for (int rep_ = 0; rep_ < NREP(pb + 4); ++rep_) if (IN(pb + 4)) { if (rep_) { FORCE_BAR; } PH_BEGIN
            const int nit = 1056 + 2112 + 2048 + (layer == 0 ? 128 : 0);
            for (int it = wslot; it < nit; it += NW) {
                if (it < 1056) s5_out_item((const bf16*)(ws + WS_S5TAB) + (size_t)layer * 16 * 256 * 512, INP + (size_t)R * 256, (const bf16*)(ws + WS_HIN), (bf16*)(ws + WS_Z), it, lane);
                else if (it < 3168) ret_out_item(INP + (size_t)2 * R * 256, INP + (size_t)3 * R * 256, INP + (size_t)4 * R * 256, Tt + (size_t)256 * R, (const bf16*)(ws + WS_SPREV),
                                                 AIN(18) + layer * 8, AIN(19) + layer * 256, MIX, lds + wave * 12288, it - 1056, lane);
                else if (it < 5216) fft2_item((const bf16*)(ws + WS_FB), (const bf16*)(ws + WS_FCT), (const bf16*)(ws + WS_W64T), MIX, it - 3168, lane);
                else fftc_item(INP, (const bf16*)(ws + WS_FCT), (const bf16*)(ws + WS_W256T), MIX, it - 5216, lane);
            }
        }
        SEAM(pb + 4);
        for (int rep_ = 0; rep_ < NREP(pb + 5); ++rep_) if (IN(pb + 5)) { if (rep_) { FORCE_BAR; } PH_BEGIN
            { PH_BEGIN gp::SchedPlain S{(const char*)(ws + WS_Z), (const char*)(ws + WS_WGLU) + (size_t)layer * 256 * 512, (size_t)256 * 512, (size_t)256 * 512, nM, 1, G, bx, 4};
              gp::EpiGlu E{(const bf16*)(ws + WS_Z), MIX, AIN(17) + layer * 256};
              gp::gemm_phase(lds, tid, 256, 256, 256, S, E); }
            { PH_BEGIN gp::SchedPlain S{(const char*)Hh, (const char*)(ws + WS_WIN) + ((size_t)layer * 26 + 7) * 256 * 2048, (size_t)256 * 2048, (size_t)256 * 2048, 64, 16, G, bx, 16};
              gp::EpiGates E{(unsigned char*)(ws + WS_GATES)};
              gp::gemm_phase(lds, tid, 1024, 1024, 1024, S, E); }
        }
        SEAM(pb + 5);
        for (int rep_ = 0; rep_ < NREP(pb + 6); ++rep_) if (IN(pb + 6)) { if (rep_) { FORCE_BAR; } PH_BEGIN
            gp::SchedMerge S{(const char*)MIX, (const char*)(ws + WS_WBR) + (size_t)layer * 1024 * 2048, layer == 0 ? 32 : 0, G, bx};
            gp::EpiMerge E{(const unsigned char*)(ws + WS_GATES), (const unsigned char*)(ws + WS_GCTX), (bf16*)(ws + WS_Y), (bf16*)(ws + WS_YP)};
            gp::gemm_phase(lds, tid, 1024, 1024, 1024, S, E);
        }
        SEAM(pb + 6);
        for (int rep_ = 0; rep_ < NREP(pb + 7); ++rep_) if (IN(pb + 7)) { if (rep_) { FORCE_BAR; } PH_BEGIN
            gp::SchedSplit S{(const char*)(ws + WS_Y), (const char*)(ws + WS_WOUT) + (size_t)layer * 1024 * 2048, (size_t)256 * 2048, (size_t)256 * 2048, layer == 0 ? 16 : 0, 16, G, bx,
                             (const char*)(ws + WS_YP), (size_t)256 * 2048, (size_t)CROWS * 2048, 4};
            gp::EpiPlainSplit E{(bf16*)(ws + WS_YO), 1024, (float*)(ws + WS_PARTW), 16};
            gp::gemm_phase(lds, tid, 1024, 1024, 1024, S, E);
        }
        SEAM(pb + 7);
        for (int rep_ = 0; rep_ < NREP(pb + 8); ++rep_) if (IN(pb + 8)) { if (rep_) { FORCE_BAR; } PH_BEGIN
            if (layer == 0) {
                NormCfg C{AIN(0), AIN(2), AOUT, ctxbuf, (const bf16*)(ws + WS_YO), (const float*)(ws + WS_PARTW), 16, normg + D, MODp, 2048, normg + 2 * D, MODp, 4096, 3072, Hh, R};
                norm_rows(C, wslot, NW, lane);
            } else {
                LAS float* wrs = (LAS float*)lds; LAS int* rowinfo = (LAS int*)(lds + 32768); LAS unsigned* cntL = (LAS unsigned*)(lds + 32768 + 1024); LAS unsigned* baseL = cntL + 8;
                for (int i = tid; i < 2048; i += NTHREADS) ((LAS f32x4*)wrs)[i] = ((const f32x4*)AIN(26))[i];
                int* list = (int*)(ws + WS_LIST); float* routew = (float*)(ws + WS_ROUTEW);
                for (int grp = vcu; grp < 256; grp += G) {
                    if (tid < 8) cntL[tid] = 0u;
                    __syncthreads();
                    const int r0 = grp * 64 + wave * 8; const float* md = MODp + (size_t)(3 + (r0 < SEQ ? 0 : 1)) * 6144;
                    f32x4 gav[4], scv[4], shv[4]; row_ld_f32(md + 2048, lane, gav); row_ld_f32(md + 4096, lane, scv); row_ld_f32(md + 3072, lane, shv);
                    f32x4 xn[4]; u32x2 tn[4]; row_ld_f32(AOUT + (size_t)r0 * D, lane, xn);
#pragma unroll
                    for (int j = 0; j < 4; ++j) tn[j] = *(const u32x2*)((const bf16*)(ws + WS_YO) + (size_t)r0 * D + 256 * j + 4 * lane);
                    for (int rr = 0; rr < 8; ++rr) { const int r = r0 + rr;
                        f32x4 x[4], t[4], hh[4];
#pragma unroll
                        for (int j = 0; j < 4; ++j) { x[j] = xn[j]; t[j] = (f32x4){bflo(tn[j].x), bfhi(tn[j].x), bflo(tn[j].y), bfhi(tn[j].y)}; }
                        if (rr < 7) { row_ld_f32(AOUT + (size_t)(r + 1) * D, lane, xn);
#pragma unroll
                            for (int j = 0; j < 4; ++j) tn[j] = *(const u32x2*)((const bf16*)(ws + WS_YO) + (size_t)(r + 1) * D + 256 * j + 4 * lane); }
                        { f32x4 gAv[4]; row_ld_f32(normg + D, lane, gAv); const float rs = row_rstd(t);
#pragma unroll
                          for (int j = 0; j < 4; ++j) x[j] = x[j] + gav[j] * (t[j] * rs * gAv[j]); }
                        row_st_f32(AOUT + (size_t)r * D, lane, x);
                        { f32x4 gBv[4]; row_ld_f32(normg + 2 * D, lane, gBv); const float rs = row_rstd(x);
#pragma unroll
                          for (int j = 0; j < 4; ++j) hh[j] = x[j] * rs * gBv[j] * (scv[j] + 1.f) + shv[j]; }
                        row_st_bf16(Hh + (size_t)r * D, lane, hh);
                        float lg[8];
#pragma unroll
                        for (int e = 0; e < 8; ++e) lg[e] = 0.f;
#pragma unroll
                        for (int j = 0; j < 4; ++j)
#pragma unroll
                            for (int q = 0; q < 4; ++q) { const int k = 256 * j + 4 * lane + q; const f32x4 w0 = *(const LAS f32x4*)(wrs + k * 8), w1 = *(const LAS f32x4*)(wrs + k * 8 + 4); const float hv = hh[j][q];
                                lg[0] += hv * w0[0]; lg[1] += hv * w0[1]; lg[2] += hv * w0[2]; lg[3] += hv * w0[3]; lg[4] += hv * w1[0]; lg[5] += hv * w1[1]; lg[6] += hv * w1[2]; lg[7] += hv * w1[3]; }
#pragma unroll
                        for (int e = 0; e < 8; ++e) lg[e] = wave_sum(lg[e]) + AIN(27)[e];
                        int i0 = 0; float v0 = lg[0];
#pragma unroll
                        for (int e = 1; e < 8; ++e) if (lg[e] > v0) { v0 = lg[e]; i0 = e; }
                        int i1 = i0 == 0 ? 1 : 0; float v1 = i0 == 0 ? lg[1] : lg[0];
#pragma unroll
                        for (int e = 0; e < 8; ++e) if (e != i0 && lg[e] > v1) { v1 = lg[e]; i1 = e; }
                        const float w0 = 1.f / (1.f + __expf(v1 - v0)), w1 = 1.f - w0;
                        if (lane == 0) { const unsigned s0 = __hip_atomic_fetch_add(cntL + i0, 1u, __ATOMIC_RELAXED, __HIP_MEMORY_SCOPE_WORKGROUP), s1 = __hip_atomic_fetch_add(cntL + i1, 1u, __ATOMIC_RELAXED, __HIP_MEMORY_SCOPE_WORKGROUP);
                            LAS int* ri = rowinfo + (wave * 8 + rr) * 4; ri[0] = i0; ri[1] = (int)s0; ri[2] = i1; ri[3] = (int)s1; routew[(size_t)r * 2] = w0; routew[(size_t)r * 2 + 1] = w1; }
                        if (lane < 8) ((int*)(ws + WS_SMAP))[(size_t)r * 8 + lane] = -1;
                    }
                    __syncthreads();
                    if (tid < 8) baseL[tid] = __hip_atomic_fetch_add((unsigned*)(ws + WS_CTL) + CW_MOECNT + 64 * tid, cntL[tid], __ATOMIC_RELAXED, __HIP_MEMORY_SCOPE_AGENT);
                    __syncthreads();
                    if (tid < 64) { const LAS int* ri = rowinfo + tid * 4; const int r = grp * 64 + tid;
                        list[ri[0] * LCAP + (int)baseL[ri[0]] + ri[1]] = r * 2; list[ri[2] * LCAP + (int)baseL[ri[2]] + ri[3]] = r * 2 + 1; }
                    __syncthreads();
                }
            }
        }
        SEAM(pb + 8);
        LAS unsigned* mt = (LAS unsigned*)(lds + LDSCTL_OFF) + LW_MOE;
        if (layer == 1 && (IN(pb + 9) || IN(pb + 10))) { PH_BEGIN
            if (tid == 0) { unsigned off = 0u;
                for (int e = 0; e < 8; ++e) { const unsigned c = __hip_atomic_load((unsigned*)(ws + WS_CTL) + CW_MOECNT + 64 * e, __ATOMIC_RELAXED, __HIP_MEMORY_SCOPE_AGENT); const unsigned m = (c + 255u) >> 8; mt[e] = c; mt[8 + e] = m; mt[16 + e] = off; off += m; }
                mt[24] = off; const unsigned U = off * 4u, full = (U / (unsigned)G) * (unsigned)G, rem = U - full;
                if (rem != 0u && rem <= 32u && full != 0u) { mt[25] = full; mt[26] = rem; } else { mt[25] = U; mt[26] = 0u; } }
            __syncthreads();
        }
        for (int rep_ = 0; rep_ < NREP(pb + 9); ++rep_) if (IN(pb + 9)) { if (rep_) { FORCE_BAR; } PH_BEGIN
            if (layer == 0) {
                gp::SchedPlain S{(const char*)Hh, (const char*)(ws + WS_FFN1), (size_t)256 * 2048, (size_t)256 * 2048, 66, 22, G, bx, 16};
                gp::EpiSwiglu E{(bf16*)(ws + WS_HID), DFF, false};
                gp::gemm_phase(lds, tid, 1024, 1024, 1024, S, E);
            } else {
                gp::SchedMoe1 S{(const char*)Hh, (const char*)(ws + WS_MOE1), (const int*)(ws + WS_LIST), mt, G, bx};
                gp::EpiSwiglu E{(bf16*)(ws + WS_MHID), DFE, true};
                gp::gemm_phase(lds, tid, 1024, 1024, 1024, S, E);
            }
        }
        SEAM(pb + 9);
        for (int rep_ = 0; rep_ < NREP(pb + 10); ++rep_) if (IN(pb + 10)) { if (rep_) { FORCE_BAR; } PH_BEGIN
            if (layer == 0) {
                gp::SchedSplit S{(const char*)(ws + WS_HID), (const char*)(ws + WS_FFN2), (size_t)256 * DFF * 2, (size_t)256 * DFF * 2, 11, DFF / 64, G, bx,
                                 (const char*)(ws + WS_HID) + (size_t)64 * 256 * DFF * 2, (size_t)256 * DFF * 2, 0, 11};
                gp::EpiPlainSplit E{(bf16*)(ws + WS_FO), 1024, (float*)(ws + WS_PARTF), 11};
                gp::gemm_phase(lds, tid, DFF, DFF, DFF, S, E);
            } else {
                { gp::SchedMoe2 S{(const char*)(ws + WS_MHID), (const char*)(ws + WS_MOE2), mt, G, bx};
                  gp::EpiMoeDown E{(bf16*)(ws + WS_SLOT), (const int*)(ws + WS_LIST), (const float*)(ws + WS_ROUTEW), mt};
                  gp::gemm_phase(lds, tid, DFE, DFE, DFE, S, E); }
                { PH_BEGIN gp::SchedMoe2S S{(const char*)(ws + WS_MHID), (const char*)(ws + WS_MOE2), mt, G, bx};
                  gp::EpiMoePart E{(bf16*)(ws + WS_PARTM), (const int*)(ws + WS_LIST), mt, (int*)(ws + WS_SMAP)};
                  gp::gemm_phase(lds, tid, DFE, DFE, DFE, S, E); }
            }
        }
        SEAM(pb + 10);
        for (int rep_ = 0; rep_ < NREP(pb + 11); ++rep_) if (IN(pb + 11)) { if (rep_) { FORCE_BAR; } PH_BEGIN
            if (layer == 0) { PH_BEGIN NormCfg C{AOUT, ctxbuf, AOUT, ctxbuf, (const bf16*)(ws + WS_FO), (const float*)(ws + WS_PARTF), 11, normg + 3 * D, MODp, 5120, AIN(6) + 4 * D, MODp + 3 * 6144, 1024, 0, Hh, R};
                norm_rows(C, wslot, NW, lane); }
            else { PH_BEGIN for (int r = wslot; r < nrows; r += NW) { const int ci = r < SEQ ? 0 : (r < LROWS ? 1 : 2); const float* md = MODp + (size_t)(layer * 3 + ci) * 6144;
                float* xp = r < LROWS ? AOUT + (size_t)r * D : ctxbuf + (size_t)(r - LROWS) * D;
                f32x4 x[4], t[4]; row_ld_f32(xp, lane, x);
                if (layer == 0) { if (r < LROWS) row_ld_bf16((const bf16*)(ws + WS_FO) + (size_t)r * D, lane, t); else row_ld_part((const float*)(ws + WS_PARTF), 11, r, lane, t); }
                else { typedef int i32x4 __attribute__((ext_vector_type(4)));
                    const i32x4 m0 = *(const i32x4*)((const int*)(ws + WS_SMAP) + (size_t)r * 8), m1 = *(const i32x4*)((const int*)(ws + WS_SMAP) + (size_t)r * 8 + 4);
                    if ((m0.x & m0.y & m0.z & m0.w & m1.x & m1.y & m1.z & m1.w) == -1) {
                        f32x4 t2[4]; row_ld_bf16((const bf16*)(ws + WS_SLOT) + (size_t)r * D, lane, t); row_ld_bf16((const bf16*)(ws + WS_SLOT) + ((size_t)LROWS + r) * D, lane, t2);
#pragma unroll
                        for (int j = 0; j < 4; ++j) t[j] = t[j] + t2[j];
                    } else {
#pragma unroll
                        for (int j = 0; j < 4; ++j) t[j] = (f32x4){0.f, 0.f, 0.f, 0.f};
#pragma unroll
                        for (int k = 0; k < 2; ++k) { const int ent = 2 * r + k; const i32x4 mk = k ? m1 : m0;
#pragma unroll
                            for (int j = 0; j < 4; ++j) { const int mm = j == 0 ? mk.x : (j == 1 ? mk.y : (j == 2 ? mk.z : mk.w));
                                if (mm < 0) { const u32x2 w = *(const u32x2*)((const bf16*)(ws + WS_SLOT) + ((size_t)k * LROWS + r) * D + 256 * j + 4 * lane); t[j] = t[j] + (f32x4){bflo(w.x), bfhi(w.x), bflo(w.y), bfhi(w.y)}; }
                                else { const bf16* pp = (const bf16*)(ws + WS_PARTM) + ((size_t)(mm >> 8) * 7 * 256 + (mm & 255)) * 256 + 4 * lane; f32x4 sacc = (f32x4){0.f, 0.f, 0.f, 0.f};
                                    for (int sl = 0; sl < 7; ++sl) { const u32x2 w = *(const u32x2*)(pp + (size_t)sl * 65536); sacc = sacc + (f32x4){bflo(w.x), bfhi(w.x), bflo(w.y), bfhi(w.y)}; }
                                    t[j] = t[j] + sacc * ((const float*)(ws + WS_ROUTEW))[ent]; } } } } }
                row_resid(x, t, normg + 3 * D, md + 5120, lane); row_st_f32(xp, lane, x);
                } }
        }
        SEAM(pb + 11);
    }
#ifdef MK_STAMP_PHASE
    if (MK_STAMP_PHASE == NPHASE - 1 && wave == 0) *(volatile LAS unsigned long long*)(lctl + 66) = __builtin_amdgcn_s_memrealtime();
    if (blockIdx.x == 0 && wave == 0) { const unsigned long long st0_ = *(volatile LAS unsigned long long*)(lctl + 64), st1_ = *(volatile LAS unsigned long long*)(lctl + 66); const unsigned long long target = __builtin_amdgcn_s_memrealtime() + (unsigned long long)MK_STAMP_AMP * (st1_ - st0_); while (__builtin_amdgcn_s_memrealtime() < target) __builtin_amdgcn_s_sleep(20); }
#endif
#ifdef MK_EXTRA_BARS
    for (int xb_ = 0; xb_ < MK_EXTRA_BARS; ++xb_) { FORCE_BAR; }
#endif
#undef IN
#undef SEAM
#undef PH_BEGIN
#undef normg
#undef AIN
#undef AOUT
#undef MODp
#undef ctxbuf
#undef Hh
#undef MIX
#undef INP
#undef Tt
}

__global__ void dumpk(const unsigned char* src, size_t nbytes, int isf32, float* out, size_t N, int accum) {
    const size_t i = (size_t)blockIdx.x * blockDim.x + threadIdx.x; if (i >= N) return;
    const size_t ne = isf32 ? nbytes / 4 : nbytes / 2; float s = 0.f;
    for (size_t k = i; k < ne; k += N) s += isf32 ? ((const float*)src)[k] : bf2f(((const bf16*)src)[k]);
    out[i] = accum ? out[i] + s : s;
}
extern "C" void kernel_launch(void* const* d_in, const int* in_sizes, int n_in, void* d_out, int out_size, void* d_ws, size_t ws_size, hipStream_t stream) {
    static int grid = 0;
    if (grid == 0) {
        if (n_in != 31 || out_size != LROWS * D || ws_size < WS_END) { fprintf(stderr, "kernel_launch: unexpected shapes (n_in %d, out %d, ws %zu < %zu)\n", n_in, out_size, ws_size, (size_t)WS_END); grid = -1; return; }
        int dev = 0, cus = 0, per_cu = 0;
        if (hipGetDevice(&dev) != hipSuccess || hipDeviceGetAttribute(&cus, hipDeviceAttributeMultiprocessorCount, dev) != hipSuccess) { grid = -1; return; }
        if (hipFuncSetAttribute((const void*)mk_fwd, hipFuncAttributeMaxDynamicSharedMemorySize, LDS_BYTES) != hipSuccess) { fprintf(stderr, "kernel_launch: hipFuncSetAttribute failed\n"); grid = -1; return; }
        if (hipOccupancyMaxActiveBlocksPerMultiprocessor(&per_cu, (const void*)mk_fwd, NTHREADS, LDS_BYTES) != hipSuccess || per_cu < 1) { fprintf(stderr, "kernel_launch: occupancy query says %d\n", per_cu); }
        (void)hipGetLastError();
        grid = cus;
    }
    if (grid < 0) return;
    (void)hipMemsetAsync((char*)d_ws + WS_CTL, 0, CTL_ZERO_BYTES, stream);
    Args a{};
    for (int i = 0; i < 31; ++i) a.in[i] = (const float*)d_in[i];
    a.out = (float*)d_out; a.ws = (unsigned char*)d_ws;
#if MK_MODE == 1
    a.ph_lo = 0; a.ph_hi = NPHASE; a.li = 0;
    hipLaunchKernelGGL(mk_fwd, dim3(grid), dim3(NTHREADS), LDS_BYTES, stream, a);
#else
    for (int p = 0; p < MK_LAST; ++p) { a.ph_lo = p; a.ph_hi = p + 1; a.li = p; hipLaunchKernelGGL(mk_fwd, dim3(grid), dim3(NTHREADS), LDS_BYTES, stream, a); }
#endif
#ifdef MK_DUMP_OFF
    dumpk<<<(LROWS * D + 255) / 256, 256, 0, stream>>>((const unsigned char*)d_ws + (size_t)(MK_DUMP_OFF), (size_t)(MK_DUMP_BYTES), MK_DUMP_F32, (float*)d_out, (size_t)LROWS * D, 0);
#endif
#ifdef MK_DUMP2_OFF
    dumpk<<<(LROWS * D + 255) / 256, 256, 0, stream>>>((const unsigned char*)d_ws + (size_t)(MK_DUMP2_OFF), (size_t)(MK_DUMP2_BYTES), MK_DUMP2_F32, (float*)d_out, (size_t)LROWS * D, 1);
#endif
#ifdef MK_DUMP3_OFF
    dumpk<<<(LROWS * D + 255) / 256, 256, 0, stream>>>((const unsigned char*)d_ws + (size_t)(MK_DUMP3_OFF), (size_t)(MK_DUMP3_BYTES), MK_DUMP3_F32, (float*)d_out, (size_t)LROWS * D, 1);
#endif
}
```

```cpp
#define MK_MODE 1
#include <hip/hip_runtime.h>
#include <cstdio>
#include <cstdint>

#define GAS __attribute__((address_space(1)))
#define LAS __attribute__((address_space(3)))
typedef unsigned short bf16;
typedef short bf16x8 __attribute__((ext_vector_type(8)));
typedef short bf16x4 __attribute__((ext_vector_type(4)));
typedef float f32x2 __attribute__((ext_vector_type(2)));
typedef float f32x4 __attribute__((ext_vector_type(4)));
typedef float f32x16 __attribute__((ext_vector_type(16)));
typedef unsigned u32x2 __attribute__((ext_vector_type(2)));
typedef unsigned u32x4 __attribute__((ext_vector_type(4)));

constexpr int D = 1024, SEQ = 8192, LROWS = 16384, CTXL = 256, CROWS = 512, R = 16896;
constexpr int DFF = 2816, DFE = 3584, NEXP = 8, LCAP = 16640;
constexpr int NWAVES = 8, NTHREADS = 512;
constexpr int NCH16 = R / 16;
constexpr float EPSN = 1e-6f, LOG2E = 1.4426950408889634f;

constexpr size_t MiB = 1u << 20;
constexpr size_t WS_CTL = 0, CTL_ZERO_BYTES = 1 * MiB;
constexpr int CW_TMO = 0, CW_BAR = 4096, CW_MOECNT = 98304, CW_QHEAD = 100352, CW_MQ = 102400;
constexpr size_t CTL_MOD_OFF = 512 * 1024;
constexpr size_t WS_CTXBUF = 1 * MiB;
constexpr size_t WS_COST = 3 * MiB, WS_SINT = 4 * MiB, WS_COSN = 5 * MiB, WS_SINN = 6 * MiB;
constexpr size_t WS_LIST = 7 * MiB;
constexpr size_t WS_ROUTEW = WS_LIST + 8 * LCAP * 4;
constexpr size_t WS_S5K = 8 * MiB;
constexpr size_t WS_A16 = 9 * MiB;
constexpr size_t WS_W128T = WS_A16 + 64 * 1024;
constexpr size_t WS_TWC = WS_W128T + 64 * 1024, WS_TWS = WS_TWC + 32 * 1024;
constexpr size_t WS_FCT = WS_TWS + 32 * 1024;
constexpr size_t WS_W64T = WS_FCT + 32 * 1024;
constexpr size_t WS_W256T = WS_W64T + 32 * 1024;
constexpr size_t WS_MOE1 = 10 * MiB;
constexpr size_t WS_MOE2 = 122 * MiB;
constexpr size_t WS_OTHERW = 178 * MiB;
constexpr size_t WS_WIN = 178 * MiB;
constexpr size_t WS_WBR = 204 * MiB;
constexpr size_t WS_WOUT = 208 * MiB;
constexpr size_t WS_WGLU = 212 * MiB;
constexpr size_t WS_FFN1 = 213 * MiB;
constexpr size_t WS_FFN2 = 224 * MiB;
constexpr size_t WS_S5M1 = 230 * MiB;
constexpr size_t WS_S5TAB = 234 * MiB;
constexpr size_t WS_BIG = 242 * MiB;
constexpr size_t TOK256 = (size_t)R * 256 * 2;
constexpr size_t WS_INP = WS_BIG;
constexpr size_t WS_T = WS_INP + 7 * TOK256;
constexpr size_t WS_HLOC = WS_T + 3 * TOK256;
constexpr size_t WS_HIN = WS_HLOC + 2 * TOK256;
constexpr size_t WS_KV = WS_HIN + TOK256;
constexpr size_t WS_SPREV = WS_KV + 2 * TOK256;
constexpr size_t WS_FB = WS_SPREV + TOK256;
constexpr size_t WS_GATES = WS_BIG;
constexpr size_t WS_Y = WS_BIG + 132 * MiB;
constexpr size_t WS_YO = WS_Y + 33 * MiB;
constexpr size_t WS_Z = WS_YO + 33 * MiB;
constexpr size_t WS_YP = WS_Z;
constexpr size_t WS_PARTW = WS_BIG;
constexpr size_t WS_PARTF = 340 * MiB;
constexpr size_t WS_PARTM = 416 * MiB;
constexpr size_t WS_SMAP = WS_S5K;
constexpr size_t WS_FO = WS_Y;
constexpr size_t WS_HID = WS_BIG;
constexpr size_t WS_MHID = WS_OTHERW;
constexpr size_t WS_H = 449 * MiB;
constexpr size_t WS_MIX = 482 * MiB;
constexpr size_t WS_SLOT = WS_H;
constexpr size_t WS_GCTX = 515 * MiB;
constexpr size_t WS_END = 519 * MiB;
static_assert(WS_FB + 16 * MiB <= WS_Z && WS_Z + TOK256 <= WS_H && WS_MHID + (size_t)34816 * 3584 * 2 <= WS_H && WS_W256T + 256 * 1024 <= WS_MOE1, "ws map");
static_assert(WS_PARTM + (size_t)32 * 7 * 65536 * 2 <= WS_H && WS_MHID + (size_t)34816 * 3584 * 2 <= WS_PARTM, "ws map 3");
static_assert(WS_S5TAB + 8 * MiB <= WS_BIG && WS_FFN2 + (size_t)1024 * 2816 * 2 <= WS_S5M1 && WS_ROUTEW + 32768 * 4 <= WS_S5K, "ws map 2");

constexpr int RING_BYTES = 131072, LDSCTL_OFF = RING_BYTES, LDS_BYTES = 147456;
constexpr int LW_BAR = 8, LW_MOE = 16;

#define VM_WAIT() asm volatile("s_waitcnt vmcnt(0)" ::: "memory")
#define LDS_WAIT() asm volatile("s_waitcnt lgkmcnt(0)" ::: "memory")
typedef __bf16 bf16n2 __attribute__((ext_vector_type(2)));
__device__ __forceinline__ unsigned pk2(float lo, float hi) { bf16n2 v; v.x = (__bf16)lo; v.y = (__bf16)hi; return __builtin_bit_cast(unsigned, v); }
__device__ __forceinline__ unsigned pk4_f8(float a, float b, float c, float d) { int w = 0; w = __builtin_amdgcn_cvt_pk_fp8_f32(a, b, w, false); w = __builtin_amdgcn_cvt_pk_fp8_f32(c, d, w, true); return (unsigned)w; }
__device__ __forceinline__ float bf2f(unsigned short b) { return __builtin_bit_cast(float, ((unsigned)b) << 16); }
__device__ __forceinline__ float bflo(unsigned w) { return __builtin_bit_cast(float, w << 16); }
__device__ __forceinline__ float bfhi(unsigned w) { return __builtin_bit_cast(float, w & 0xffff0000u); }
__device__ __forceinline__ float ex2(float x) { return __builtin_amdgcn_exp2f(x); }
__device__ __forceinline__ float rcpf_(float x) { return __builtin_amdgcn_rcpf(x); }
__device__ __forceinline__ float sigm(float x) { return rcpf_(1.f + ex2(-LOG2E * x)); }
__device__ __forceinline__ float silu_(float x) { return x * sigm(x); }
__device__ __forceinline__ float gelu_tanh(float x) { const float u = 0.7978845608028654f * (x + 0.044715f * x * x * x); const float t = 1.f - 2.f * rcpf_(1.f + ex2(2.885390081777927f * u)); return 0.5f * x * (1.f + t); }
__device__ __forceinline__ float xor32_sum(float v) { const unsigned u = __builtin_bit_cast(unsigned, v); const auto r = __builtin_amdgcn_permlane32_swap(u, u, false, false); return __builtin_bit_cast(float, (unsigned)r[0]) + __builtin_bit_cast(float, (unsigned)r[1]); }
__device__ __forceinline__ float xor32_max(float v) { const unsigned u = __builtin_bit_cast(unsigned, v); const auto r = __builtin_amdgcn_permlane32_swap(u, u, false, false); return fmaxf(__builtin_bit_cast(float, (unsigned)r[0]), __builtin_bit_cast(float, (unsigned)r[1])); }
template <int X> __device__ __forceinline__ float swz_xor(float v) { return __builtin_bit_cast(float, __builtin_amdgcn_ds_swizzle(__builtin_bit_cast(int, v), (X << 10) | 0x1f)); }
__device__ __forceinline__ float wave_sum(float v) { v += swz_xor<1>(v); v += swz_xor<2>(v); v += swz_xor<4>(v); v += swz_xor<8>(v); v += swz_xor<16>(v); return xor32_sum(v); }
__device__ __forceinline__ f32x16 mma32(bf16x8 a, bf16x8 b, f32x16 c) { return __builtin_amdgcn_mfma_f32_32x32x16_bf16(a, b, c, 0, 0, 0); }
__device__ __forceinline__ bf16x8 ldg8(const bf16* p) { return *(const bf16x8*)p; }
__device__ __forceinline__ bf16x8 ldg8p(const bf16* p) { const bf16x4 lo = *(const bf16x4*)p, hi = *(const bf16x4*)(p + 8); return __builtin_shufflevector(lo, hi, 0, 1, 2, 3, 4, 5, 6, 7); }
template <int S> __device__ __forceinline__ bf16x8 accB(const f32x16& c) {
    u32x4 w; w.x = pk2(c[8 * S + 0], c[8 * S + 1]); w.y = pk2(c[8 * S + 2], c[8 * S + 3]); w.z = pk2(c[8 * S + 4], c[8 * S + 5]); w.w = pk2(c[8 * S + 6], c[8 * S + 7]);
    return __builtin_bit_cast(bf16x8, w);
}
__device__ __forceinline__ bf16x8 pack8(const float (&v)[8]) { u32x4 w; w.x = pk2(v[0], v[1]); w.y = pk2(v[2], v[3]); w.z = pk2(v[4], v[5]); w.w = pk2(v[6], v[7]); return __builtin_bit_cast(bf16x8, w); }
__device__ __forceinline__ void unpack8(const bf16x8 x, float (&v)[8]) { const u32x4 w = __builtin_bit_cast(u32x4, x); v[0] = bflo(w.x); v[1] = bfhi(w.x); v[2] = bflo(w.y); v[3] = bfhi(w.y); v[4] = bflo(w.z); v[5] = bfhi(w.z); v[6] = bflo(w.w); v[7] = bfhi(w.w); }
__device__ __forceinline__ f32x16 zero16() { f32x16 z;
#pragma unroll
    for (int i = 0; i < 16; ++i) z[i] = 0.f;
    return z; }

#define XB_TMO      128
#define XB_XCNT(j)  (256  + 64 * (j))
#define XB_XSUB(j)  (1280 + 64 * (j))
#define XB_XGEN(j)  (2304 + 64 * (j))
#define XB_TOP      3328
#define XB_TOPGEN   3392
#define XCD_BAR_WORDS 3456
#define XB_SPIN_CAP (1u << 18)
__device__ __forceinline__ unsigned xb_ld(unsigned* p)              { return __hip_atomic_load(p, __ATOMIC_RELAXED, __HIP_MEMORY_SCOPE_AGENT); }
__device__ __forceinline__ unsigned xb_add(unsigned* p, unsigned v) { return __hip_atomic_fetch_add(p, v, __ATOMIC_RELAXED, __HIP_MEMORY_SCOPE_AGENT); }
__device__ __forceinline__ unsigned xb_xcc_id() { return (unsigned)__builtin_amdgcn_s_getreg((3 << 11) | 20) & 0xFu; }
#define XB_SPIN(cond, bar) do { unsigned _sp = 0; while (cond) { __builtin_amdgcn_s_sleep(1); \
    if ((++_sp & 255u) == 0u) { if (xb_ld(&(bar)[XB_TMO])) break; if (_sp > XB_SPIN_CAP) { atomicAdd(&(bar)[XB_TMO], 1u); break; } } } } while (0)
struct XcdBarrier { unsigned* bar; unsigned x; volatile LAS unsigned* st; };
__device__ __forceinline__ XcdBarrier xcd_barrier_post(unsigned* bar, volatile LAS unsigned* st) {
    XcdBarrier b; b.bar = bar; b.x = xb_xcc_id(); b.st = st;
    if (threadIdx.x == 0) (void)xb_add(&bar[XB_XCNT(b.x)], 1u);
    return b;
}
__device__ __forceinline__ void xcd_barrier_complete(unsigned* bar, unsigned x, unsigned& nloc, unsigned& nx) {
    const unsigned G = gridDim.x * gridDim.y * gridDim.z;
    unsigned sum, cnt, mine, sp = 0u;
    for (;;) {
        sum = 0u; cnt = 0u; mine = 0u;
#pragma unroll
        for (unsigned j = 0; j < 16; ++j) { const unsigned c = xb_ld(&bar[XB_XCNT(j)]); sum += c; cnt += (c > 0u) ? 1u : 0u; mine = (j == x) ? c : mine; }
        if (sum == G) break;
        __builtin_amdgcn_s_sleep(1);
        if ((++sp & 255u) == 0u) { if (xb_ld(&bar[XB_TMO])) break; if (sp > XB_SPIN_CAP) { atomicAdd(&bar[XB_TMO], 1u); break; } }
    }
    nloc = mine > 0u ? mine : 1u; nx = cnt > 0u ? cnt : 1u;
}
__device__ __forceinline__ void xcd_barrier(const XcdBarrier& b) {
    asm volatile("s_waitcnt vmcnt(0)" ::: "memory");
    __syncthreads();
    if (threadIdx.x == 0) {
        unsigned* bar = b.bar;
        __builtin_amdgcn_s_waitcnt(0);
        unsigned nloc = b.st[0], nx = b.st[1];
        if (nloc == 0u) { xcd_barrier_complete(bar, b.x, nloc, nx); b.st[0] = nloc; b.st[1] = nx; }
        const unsigned old = xb_add(&bar[XB_XSUB(b.x)], 1u);
        const unsigned gen = old / nloc;
        if (old + 1u == (gen + 1u) * nloc) {
            __builtin_amdgcn_fence(__ATOMIC_RELEASE, "agent");
            asm volatile("s_waitcnt vmcnt(0)" ::: "memory");
            const unsigned og = xb_add(&bar[XB_TOP], 1u);
            const unsigned tg = og / nx;
            if (og + 1u == (tg + 1u) * nx) xb_add(&bar[XB_TOPGEN], 1u);
            else XB_SPIN(xb_ld(&bar[XB_TOPGEN]) == tg, bar);
            __builtin_amdgcn_fence(__ATOMIC_ACQUIRE, "agent");
            xb_add(&bar[XB_XGEN(b.x)], 1u);
            asm volatile("s_waitcnt vmcnt(0)" ::: "memory");
        } else {
            XB_SPIN(xb_ld(&bar[XB_XGEN(b.x)]) == gen, bar);
            __builtin_amdgcn_fence(__ATOMIC_ACQUIRE, "agent");
            asm volatile("s_waitcnt vmcnt(0)" ::: "memory");
        }
    }
    __syncthreads();
}
namespace gp {
constexpr int BM = 256, BK = 64, HALF = 128, HTB = HALF * BK * 2, STAGE_BYTES = 8 * HTB, NXCD = 8, WGM = 8;
__device__ __forceinline__ int lds_byte(int r, int c) { const int st = (r >> 4) * 2 + (c >> 5), rr = r & 15, cc = c & 31, ob = rr * 64 + cc * 2; return st * 1024 + (ob ^ (((ob >> 9) & 1) << 5)); }
__device__ __forceinline__ void stage_rc(int b, int& Rr, int& C) { const int st = b / 1024, sb = b % 1024, swz = sb ^ (((sb >> 9) & 1) << 5); Rr = (st >> 1) * 16 + swz / 64; C = (st & 1) * 32 + (swz % 64) / 2; }
__device__ __forceinline__ int perm32(int rho) { const int n = rho >> 4, i = rho & 15; return 8 * (i >> 2) + 4 * n + (i & 3); }

struct Unit { const char* a; const char* b; int e0, e1, e2, e3, nt; };

__device__ __forceinline__ void tile_of(int L, int nM, int nN, int& pm, int& pn) {
    const int nwg = nM * nN; int wgid = L;
    { const int q = nwg / NXCD, r = nwg % NXCD, xcd = wgid % NXCD, off = wgid / NXCD; wgid = (xcd < r ? xcd * (q + 1) : r * (q + 1) + (xcd - r) * q) + off; }
    const int nig = WGM * nN, gid = wgid / nig, fm = gid * WGM, gsz = (nM - fm) < WGM ? (nM - fm) : WGM;
    pm = fm + ((wgid % nig) % gsz); pn = (wgid % nig) / gsz;
}

typedef int i32x8 __attribute__((ext_vector_type(8)));
typedef int i32x4v __attribute__((ext_vector_type(4)));
__device__ __forceinline__ i32x8 cat8(const bf16x8 a, const bf16x8 b) { const i32x4v x = __builtin_bit_cast(i32x4v, a), y = __builtin_bit_cast(i32x4v, b); return __builtin_shufflevector(x, y, 0, 1, 2, 3, 4, 5, 6, 7); }
__device__ __forceinline__ void mfma_f8(f32x4& acc, const i32x8 a, const i32x8 b) { asm volatile("s_nop 1\n\tv_mfma_f32_16x16x128_f8f6f4 %0, %1, %2, %0" : "+v"(acc) : "v"(a), "v"(b)); }
template <class Epi, class Sched, bool F8 = false>
__device__ __forceinline__ void gemm_phase(LAS unsigned char* lds, const int tid, const int K, const int lda, const int ldb, const Sched& S, const Epi& E) {
    constexpr bool GATHER = Sched::GATHER;
    const int wid = __builtin_amdgcn_readfirstlane(tid >> 6), lane = tid & 63, wr = wid >> 2, wc = wid & 3, fr = lane & 15, fq = lane >> 4;
    unsigned voffA[2], voffB[2];
#pragma unroll
    for (int i = 0; i < 2; ++i) { int Rr, C; stage_rc(tid * 16 + i * 8192, Rr, C); const int Rb = (Rr & ~31) + perm32(Rr & 31);
        voffA[i] = (unsigned)(Rr * lda + C) * 2u; voffB[i] = (unsigned)(Rb * ldb + C) * 2u; }
#define PG8_GOFF(dst, unit) do { _Pragma("unroll") for (int _h = 0; _h < 2; ++_h) _Pragma("unroll") for (int _i = 0; _i < 2; ++_i) { int _R, _C; stage_rc(tid * 16 + _i * 8192, _R, _C); dst[_h][_i] = S.rowoff(unit, _R + _h * HALF) + (unsigned)_C * 2u; } } while (0)
    const size_t kstep = (size_t)(BK * 2);
    const unsigned hstepA = (unsigned)HALF * (unsigned)lda * 2u; const size_t hstepB = (size_t)HALF * ldb * 2;
    const unsigned ldsw = (unsigned)wid * 1024u;
    const int aoff = lds_byte(wr * 64 + fr, fq * 8), boff = lds_byte(wc * 32 + fr, fq * 8);
#define PG8_SA(b, h) (((b) * 2 + (h)) * HTB)
#define PG8_SB(b, h) ((4 + (b) * 2 + (h)) * HTB)
#define PG8_STB(bufoff, gbase, hh) do { const char* _gb = (const char*)(gbase) + (size_t)(hh) * hstepB; _Pragma("unroll") for (int _i = 0; _i < 2; ++_i) \
        __builtin_amdgcn_global_load_lds((const unsigned*)(_gb + voffB[_i]), (LAS unsigned*)(lds + (bufoff) + ldsw + _i * 8192), 16, 0, 0); } while (0)
#define PG8_STA(bufoff, gbase, hh, VG) do { const char* _ga = (const char*)(gbase) + (GATHER ? (size_t)0 : (size_t)(hh) * hstepA); _Pragma("unroll") for (int _i = 0; _i < 2; ++_i) { const unsigned _o = GATHER ? (VG) : voffA[_i]; \
        __builtin_amdgcn_global_load_lds((const unsigned*)(_ga + _o), (LAS unsigned*)(lds + (bufoff) + ldsw + _i * 8192), 16, 0, 0); } } while (0)
#define PG8_LDA(dst, b, h) do { _Pragma("unroll") for (int m = 0; m < 4; ++m) _Pragma("unroll") for (int k = 0; k < 2; ++k) dst[m][k] = *(const LAS bf16x8*)(lds + PG8_SA(b, h) + aoff + m * 2048 + k * 1024); } while (0)
#define PG8_LDB(dst, b, h) do { _Pragma("unroll") for (int n = 0; n < 2; ++n) _Pragma("unroll") for (int k = 0; k < 2; ++k) dst[n][k] = *(const LAS bf16x8*)(lds + PG8_SB(b, h) + boff + n * 2048 + k * 1024); } while (0)
#define PG8_MMA(ai, bj, At, Bt) do { __builtin_amdgcn_s_setprio(1); _Pragma("unroll") for (int m = 0; m < 4; ++m) _Pragma("unroll") for (int n = 0; n < 2; ++n) { \
        if constexpr (F8) mfma_f8(acc[ai][bj][m][n], cat8(Bt[n][0], Bt[n][1]), cat8(At[m][0], At[m][1])); \
        else { _Pragma("unroll") for (int k = 0; k < 2; ++k) acc[ai][bj][m][n] = __builtin_amdgcn_mfma_f32_16x16x32_bf16(Bt[n][k], At[m][k], acc[ai][bj][m][n], 0, 0, 0); } } __builtin_amdgcn_s_setprio(0); } while (0)
#define PG8_WAIT_V(n) asm volatile("s_waitcnt vmcnt(" #n ")" ::: "memory")
#define PG8_WAIT_L(n) asm volatile("s_waitcnt lgkmcnt(" #n ")" ::: "memory")
#define PG8_BAR __builtin_amdgcn_s_barrier()
#define PG8_SCHED __builtin_amdgcn_sched_barrier(0)
    Unit cur, nxt; int ui = 0;
    if (!S.next(0, cur)) return;
    f32x4 acc[2][2][4][2];
#pragma unroll
    for (int a = 0; a < 2; ++a)
#pragma unroll
        for (int b = 0; b < 2; ++b)
#pragma unroll
            for (int m = 0; m < 4; ++m)
#pragma unroll
                for (int n = 0; n < 2; ++n) acc[a][b][m][n] = (f32x4){0.f, 0.f, 0.f, 0.f};
    bf16x8 At[4][2], B0[2][2], B1[2][2];
    unsigned vgc[2][2], vgn[2][2];
    if constexpr (GATHER) { PG8_GOFF(vgc, cur); }
#pragma unroll
    for (int h = 0; h < 2; ++h)
#pragma unroll
        for (int i = 0; i < 2; ++i) { if (!GATHER) vgc[h][i] = 0u; vgn[h][i] = vgc[h][i]; }
    const char* cA = cur.a; const char* cB = cur.b;
    PG8_STB(PG8_SB(0, 0), cB, 0); PG8_STB(PG8_SB(0, 1), cB, 1); PG8_STA(PG8_SA(0, 0), cA, 0, vgc[0][_i]); PG8_STA(PG8_SA(0, 1), cA, 1, vgc[1][_i]);
    if (wr == 1) PG8_BAR;
    PG8_WAIT_V(2); PG8_BAR;
    PG8_STB(PG8_SB(1, 0), cB + kstep, 0); PG8_STA(PG8_SA(1, 0), cA + kstep, 0, vgc[0][_i]); PG8_STB(PG8_SB(1, 1), cB + kstep, 1);
    PG8_WAIT_V(6); PG8_BAR;
    for (;;) {
        const bool has_next = S.next(ui + 1, nxt);
        const char* nA = has_next ? nxt.a : cA; const char* nB = has_next ? nxt.b : cB;
        int nt = cur.nt; asm volatile("" : "+s"(nt));
#pragma unroll 1
        for (int t = 0; t < nt; t += 2) {
            const bool last = (t == nt - 2);
            const char* a1 = cA + (size_t)(t + 1) * kstep;
            const char* a2 = last ? nA : cA + (size_t)(t + 2) * kstep; const char* b2 = last ? nB : cB + (size_t)(t + 2) * kstep;
            const char* a3 = a2 + kstep; const char* b3 = b2 + kstep;
            if constexpr (Epi::MID) { if (t != 0 && (t & 3) == 0 && cur.nt == 16) E.mid(acc, cur, (t >> 2) - 1, wr, wc, fr, fq); }
            if constexpr (GATHER) { if (last && has_next) { PG8_GOFF(vgn, nxt); } }
            PG8_LDB(B0, 0, 0); PG8_LDB(B1, 0, 1); PG8_SCHED; PG8_LDA(At, 0, 0); PG8_STA(PG8_SA(1, 1), a1, 1, vgc[1][_i]);
            PG8_WAIT_V(8); PG8_WAIT_L(0); PG8_BAR; PG8_MMA(0, 0, At, B0); PG8_MMA(0, 1, At, B1); PG8_BAR; PG8_SCHED;
            PG8_LDA(At, 0, 1); PG8_STB(PG8_SB(0, 0), b2, 0); PG8_STB(PG8_SB(0, 1), b2, 1); PG8_STA(PG8_SA(0, 0), a2, 0, (last ? vgn[0][_i] : vgc[0][_i]));
            PG8_WAIT_V(8); PG8_WAIT_L(0); PG8_BAR; PG8_MMA(1, 0, At, B0); PG8_MMA(1, 1, At, B1); PG8_BAR; PG8_SCHED;
            PG8_LDB(B0, 1, 0); PG8_LDB(B1, 1, 1); PG8_SCHED; PG8_LDA(At, 1, 0); PG8_STA(PG8_SA(0, 1), a2, 1, (last ? vgn[1][_i] : vgc[1][_i]));
            PG8_WAIT_V(8); PG8_WAIT_L(0); PG8_BAR; PG8_MMA(0, 0, At, B0); PG8_MMA(0, 1, At, B1); PG8_BAR; PG8_SCHED;
            PG8_LDA(At, 1, 1); PG8_STB(PG8_SB(1, 0), b3, 0); PG8_STB(PG8_SB(1, 1), b3, 1); PG8_STA(PG8_SA(1, 0), a3, 0, (last ? vgn[0][_i] : vgc[0][_i]));
            PG8_WAIT_V(8); PG8_WAIT_L(0); PG8_BAR; PG8_MMA(1, 0, At, B0); PG8_MMA(1, 1, At, B1); PG8_BAR; PG8_SCHED;
        }
        if constexpr (F8) { asm volatile("s_nop 15\n\ts_nop 15" ::: "memory"); }
        if (wr == 0) PG8_BAR;
        Unit ue = cur; int le = lane;
        if constexpr (Epi::LAUNDER) { int t0 = cur.e0, t1 = cur.e1, t2 = cur.e2, t3 = cur.e3; asm volatile("" : "+v"(t0), "+v"(t1), "+v"(t2), "+v"(t3), "+v"(le));
          ue.e0 = __builtin_amdgcn_readfirstlane(t0); ue.e1 = __builtin_amdgcn_readfirstlane(t1); ue.e2 = __builtin_amdgcn_readfirstlane(t2); ue.e3 = __builtin_amdgcn_readfirstlane(t3); le &= 63; }
        const int fre = le & 15, fqe = le >> 4;
        if constexpr (Epi::CARRY) { E.carry(acc, ue, wr, wc, fre, fqe); if (!has_next) break; }
        else {
        E(acc, ue, wr, wc, fre, fqe);
        if (!has_next) break;
#pragma unroll
        for (int a = 0; a < 2; ++a)
#pragma unroll
            for (int b = 0; b < 2; ++b)
#pragma unroll
                for (int m = 0; m < 4; ++m)
#pragma unroll
                    for (int n = 0; n < 2; ++n) acc[a][b][m][n] = (f32x4){0.f, 0.f, 0.f, 0.f};
        }
        cur = nxt; cA = nA; cB = nB; ++ui;
#pragma unroll
        for (int h = 0; h < 2; ++h)
#pragma unroll
            for (int i = 0; i < 2; ++i) vgc[h][i] = vgn[h][i];
        if (wr == 1) PG8_BAR;
    }
    PG8_WAIT_V(0);
    PG8_BAR;
#undef PG8_SA
#undef PG8_SB
#undef PG8_STA
#undef PG8_GOFF
#undef PG8_STB
#undef PG8_LDA
#undef PG8_LDB
#undef PG8_MMA
#undef PG8_WAIT_V
#undef PG8_WAIT_L
#undef PG8_BAR
#undef PG8_SCHED
}

struct SchedPlain {
    static constexpr bool GATHER = false;
    const char* A; const char* B; size_t ta, tb; int nM, nN, G, c, nt;
    __device__ __forceinline__ bool next(int i, Unit& u) const {
        const long L = (long)i * G + c; if (L >= (long)nM * nN) return false;
        int pm, pn; tile_of((int)L, nM, nN, pm, pn); u.a = A + (size_t)pm * ta; u.b = B + (size_t)pn * tb; u.e0 = pm; u.e1 = pn; u.e2 = 0; u.e3 = 0; u.nt = nt; return true; }
    __device__ __forceinline__ unsigned rowoff(const Unit&, int) const { return 0u; }
};
struct SchedInprojA {
    static constexpr bool GATHER = false;
    const char* Hh; const char* W; int nM, G, c, ng;
    __device__ __forceinline__ bool next(int i, Unit& u) const {
        long L = (long)i * G + c; const int n1 = nM * 7, n2 = 3 * nM; if (L >= n1 + n2 + ng) return false;
        int pm, pn;
        if (L < n1) { tile_of((int)L, nM, 7, pm, pn); u.a = Hh + (size_t)pm * (256 * 2048); u.b = W + (size_t)pn * (256 * 2048); u.e2 = 0; }
        else if (L < n1 + n2) { tile_of((int)(L - n1), 3, nM, pm, pn); u.a = W + (size_t)(23 + pm) * (256 * 2048); u.b = Hh + (size_t)pn * (256 * 2048); u.e2 = 1; }
        else { const int q = (int)(L - n1 - n2); pm = q >> 4; pn = q & 15; u.a = Hh + (size_t)(64 + pm) * (256 * 2048); u.b = W + (size_t)(7 + pn) * (256 * 2048); u.e2 = 2; }
        u.e0 = pm; u.e1 = pn; u.e3 = 0; u.nt = 16; return true; }
    __device__ __forceinline__ unsigned rowoff(const Unit&, int) const { return 0u; }
};
struct SchedSplit {
    static constexpr bool GATHER = false;
    const char* A; const char* B; size_t ta, tb; int nslice, ntf, G, c; const char* Ac; size_t tac, sac; int ks;
    __device__ __forceinline__ bool next(int i, Unit& u) const {
        const long L = (long)i * G + c; int pm, pn;
        if (L < 256) { tile_of((int)L, 64, 4, pm, pn); u.a = A + (size_t)pm * ta; u.b = B + (size_t)pn * tb; u.e2 = 0; u.e3 = 0; u.nt = ntf; }
        else { const int q = (int)(L - 256); if (q >= 8 * nslice) return false; const int tile = q / nslice, s = q % nslice; pm = 64 + (tile >> 2); pn = tile & 3;
            u.a = Ac + (size_t)(tile >> 2) * tac + (size_t)(s / ks) * sac + (s % ks) * 512; u.b = B + (size_t)pn * tb + (s % ks) * 512; u.e2 = s + 1; u.e3 = tile; u.nt = 4; }
        u.e0 = pm; u.e1 = pn; return true; }
    __device__ __forceinline__ unsigned rowoff(const Unit&, int) const { return 0u; }
};
struct SchedMerge {
    static constexpr bool GATHER = false;
    const char* Mix; const char* Wb; int nctx, G, c;
    __device__ __forceinline__ bool next(int i, Unit& u) const {
        const long L = (long)i * G + c; int pm, pn;
        if (L < 256) { tile_of((int)L, 64, 4, pm, pn); u.a = Mix + (size_t)pm * (256 * 2048); u.b = Wb + (size_t)pn * (256 * 2048); u.e2 = 0; u.e3 = 0; u.nt = 16; }
        else { const long q = L - 256; if (q >= nctx) return false; const int tile = (int)q >> 2, b = (int)q & 3; pm = 64 + (tile >> 2); pn = tile & 3;
            u.a = Mix + (size_t)pm * (256 * 2048) + b * 512; u.b = Wb + (size_t)pn * (256 * 2048) + b * 512; u.e2 = b; u.e3 = 1; u.nt = 4; }
        u.e0 = pm; u.e1 = pn; return true; }
    __device__ __forceinline__ unsigned rowoff(const Unit&, int) const { return 0u; }
};
__device__ __forceinline__ int mtu(const LAS unsigned* mt, int i) { return __builtin_amdgcn_readfirstlane((int)mt[i]); }
struct SchedMoe1 {
    static constexpr bool GATHER = true;
    const char* Hh; const char* W; const int* list; const LAS unsigned* mt; int G, c; unsigned rb;
    __device__ __forceinline__ bool next(int i, Unit& u) const {
        long L = (long)i * G + c; int e = 0;
        for (; e < 8; ++e) { const long ue = (long)mtu(mt, 8 + e) * 28; if (L < ue) break; L -= ue; }
        if (e == 8) return false;
        const int m_e = mtu(mt, 8 + e), nti = (int)(L / m_e), mti = (int)(L % m_e);
        u.a = Hh; u.b = W + ((size_t)e * 7168 + (size_t)nti * 256) * rb; u.e0 = e; u.e1 = mti; u.e2 = nti; u.e3 = (mtu(mt, 16 + e) + mti) * 256; u.nt = (int)(rb >> 7); return true; }
    __device__ __forceinline__ unsigned rowoff(const Unit& u, int r) const {
        const int li = u.e1 * 256 + r; const int ent = (li < (int)mt[u.e0]) ? list[u.e0 * LCAP + li] : 0; return (unsigned)(ent >> 1) * rb; }
};
__device__ __forceinline__ bool moe2_unit(long L, const LAS unsigned* mt, const char* Hid, const char* W, Unit& u, const size_t rb) {
    int e = 0;
    for (; e < 8; ++e) { const long ue = (long)mtu(mt, 8 + e) * 4; if (L < ue) break; L -= ue; }
    if (e == 8) return false;
    const int m_e = mtu(mt, 8 + e), nti = (int)(L / m_e), mti = (int)(L % m_e);
    u.a = Hid + (size_t)(mtu(mt, 16 + e) + mti) * 256 * rb; u.b = W + ((size_t)e * 1024 + (size_t)nti * 256) * rb; u.e0 = e; u.e1 = mti; u.e2 = nti; u.e3 = 0; u.nt = (int)(rb >> 7); return true;
}
struct SchedMoe2 {
    static constexpr bool GATHER = false;
    const char* Hid; const char* W; const LAS unsigned* mt; int G, c; unsigned rb;
    __device__ __forceinline__ bool next(int i, Unit& u) const { const long L = (long)i * G + c; if (L >= (long)mtu(mt, 25)) return false; return moe2_unit(L, mt, Hid, W, u, rb); }
    __device__ __forceinline__ unsigned rowoff(const Unit&, int) const { return 0u; }
};
struct SchedMoe2S {
    static constexpr bool GATHER = false;
    const char* Hid; const char* W; const LAS unsigned* mt; int G, c; unsigned rb;
    __device__ __forceinline__ bool next(int i, Unit& u) const { const long q = (long)i * G + c; if (q >= (long)mtu(mt, 26) * 7) return false;
        if (!moe2_unit((long)mtu(mt, 25) + q / 7, mt, Hid, W, u, rb)) return false; const int s = (int)(q % 7); const unsigned sb = rb / 7u; u.a += s * sb; u.b += s * sb; u.e3 = (int)q; u.nt = (int)(sb >> 7); return true; }
    __device__ __forceinline__ unsigned rowoff(const Unit&, int) const { return 0u; }
};

#define EPI_ROWS(ai, m) (128 * (ai) + 64 * wr + 16 * (m) + fr)
#define EPI_COL(bj) (128 * (bj) + 32 * wc + 8 * fq)
__device__ __forceinline__ u32x4 pack_acc8(const f32x4 a, const f32x4 b) { u32x4 w; w.x = pk2(a[0], a[1]); w.y = pk2(a[2], a[3]); w.z = pk2(b[0], b[1]); w.w = pk2(b[2], b[3]); return w; }

__device__ __forceinline__ unsigned gq8(float g) { const unsigned q = (unsigned)(g * 255.f + 0.5f); return q < 1u ? 1u : q; }
__device__ __forceinline__ u32x2 pack_gate8(const f32x4 a, const f32x4 b) {
    u32x2 w; w.x = gq8(a[0]) | (gq8(a[1]) << 8) | (gq8(a[2]) << 16) | (gq8(a[3]) << 24); w.y = gq8(b[0]) | (gq8(b[1]) << 8) | (gq8(b[2]) << 16) | (gq8(b[3]) << 24); return w; }
__device__ __forceinline__ size_t gate_off(int pm, int j, int b, int wr, int wc, int ai, int m, int bj, int fr, int fq) { return ((((size_t)((pm * 4 + j) * 4 + b) * 8 + wr * 4 + wc) * 16 + (ai * 4 + m) * 2 + bj) * 64 + fq * 16 + fr) * 8; }
__device__ __forceinline__ float gate8(unsigned w, int k) { return (float)((w >> (8 * k)) & 255u) * (1.f / 255.f); }
struct EpiPlain { static constexpr bool CARRY = false, LAUNDER = false, MID = false;
    bf16* O; int ld;
    __device__ __forceinline__ void operator()(const f32x4 (&acc)[2][2][4][2], const Unit& u, int wr, int wc, int fr, int fq) const {
#pragma unroll
        for (int ai = 0; ai < 2; ++ai)
#pragma unroll
            for (int m = 0; m < 4; ++m) { bf16* rowp = O + (size_t)(u.e0 * 256 + EPI_ROWS(ai, m)) * ld + u.e1 * 256;
#pragma unroll
                for (int bj = 0; bj < 2; ++bj) *(u32x4*)(rowp + EPI_COL(bj)) = pack_acc8(acc[ai][bj][m][0], acc[ai][bj][m][1]); }
    }
};
struct EpiPlainSplit { static constexpr bool CARRY = false, LAUNDER = false, MID = false;
    bf16* O; int ld; float* P; int nslice;
    __device__ __forceinline__ void operator()(const f32x4 (&acc)[2][2][4][2], const Unit& u, int wr, int wc, int fr, int fq) const {
        if (u.e2 == 0) {
#pragma unroll
            for (int ai = 0; ai < 2; ++ai)
#pragma unroll
                for (int m = 0; m < 4; ++m) { bf16* rowp = O + (size_t)(u.e0 * 256 + EPI_ROWS(ai, m)) * ld + u.e1 * 256;
#pragma unroll
                    for (int bj = 0; bj < 2; ++bj) *(u32x4*)(rowp + EPI_COL(bj)) = pack_acc8(acc[ai][bj][m][0], acc[ai][bj][m][1]); }
        } else { float* pt = P + (size_t)(u.e3 * nslice + (u.e2 - 1)) * 65536;
#pragma unroll
            for (int ai = 0; ai < 2; ++ai)
#pragma unroll
                for (int m = 0; m < 4; ++m)
#pragma unroll
                    for (int bj = 0; bj < 2; ++bj) { float* p = pt + EPI_ROWS(ai, m) * 256 + EPI_COL(bj); *(f32x4*)p = acc[ai][bj][m][0]; *(f32x4*)(p + 4) = acc[ai][bj][m][1]; }
        }
    }
};
struct EpiInprojA { static constexpr bool CARRY = false, LAUNDER = false, MID = false;
    bf16* INP; bf16* T; unsigned char* Gc;
    __device__ __forceinline__ void operator()(const f32x4 (&acc)[2][2][4][2], const Unit& u, int wr, int wc, int fr, int fq) const {
        if (u.e2 == 2) {
#pragma unroll
            for (int ai = 0; ai < 2; ++ai)
#pragma unroll
                for (int m = 0; m < 4; ++m)
#pragma unroll
                    for (int bj = 0; bj < 2; ++bj) { f32x4 a = acc[ai][bj][m][0], b = acc[ai][bj][m][1];
#pragma unroll
                        for (int j = 0; j < 4; ++j) { a[j] = sigm(a[j]); b[j] = sigm(b[j]); }
                        *(u32x2*)(Gc + gate_off(u.e0, u.e1 & 3, u.e1 >> 2, wr, wc, ai, m, bj, fr, fq)) = pack_gate8(a, b); }
        } else if (u.e2 == 0) {
            bf16* base = INP + (size_t)u.e1 * ((size_t)R * 256);
            const bool regroup = (u.e1 == 1);
#pragma unroll
            for (int ai = 0; ai < 2; ++ai)
#pragma unroll
                for (int m = 0; m < 4; ++m) { const int row = u.e0 * 256 + EPI_ROWS(ai, m);
#pragma unroll
                    for (int bj = 0; bj < 2; ++bj) { const int col = EPI_COL(bj);
                        bf16* p = regroup ? base + ((((size_t)(col >> 4) * 33 + (row >> 9)) * 16 + (row & 15)) * 64 + ((col & 8) << 2) + ((row >> 4) & 31)) * 8 : base + (size_t)row * 256 + col;
                        *(u32x4*)p = pack_acc8(acc[ai][bj][m][0], acc[ai][bj][m][1]); } }
        } else {
#pragma unroll
            for (int ai = 0; ai < 2; ++ai)
#pragma unroll
                for (int m = 0; m < 4; ++m) { bf16* rowp = T + (size_t)(u.e0 * 256 + EPI_ROWS(ai, m)) * R + u.e1 * 256;
#pragma unroll
                    for (int bj = 0; bj < 2; ++bj) *(u32x4*)(rowp + EPI_COL(bj)) = pack_acc8(acc[ai][bj][m][0], acc[ai][bj][m][1]); }
        }
    }
};
struct EpiGates { static constexpr bool CARRY = false, LAUNDER = false, MID = false;
    unsigned char* Gt;
    __device__ __forceinline__ void operator()(const f32x4 (&acc)[2][2][4][2], const Unit& u, int wr, int wc, int fr, int fq) const {
#pragma unroll
        for (int ai = 0; ai < 2; ++ai)
#pragma unroll
            for (int m = 0; m < 4; ++m)
#pragma unroll
                for (int bj = 0; bj < 2; ++bj) { f32x4 a = acc[ai][bj][m][0], b = acc[ai][bj][m][1];
#pragma unroll
                    for (int j = 0; j < 4; ++j) { a[j] = sigm(a[j]); b[j] = sigm(b[j]); }
                    *(u32x2*)(Gt + gate_off(u.e0, u.e1 & 3, u.e1 >> 2, wr, wc, ai, m, bj, fr, fq)) = pack_gate8(a, b); }
    }
};
struct EpiGlu { static constexpr bool CARRY = false, LAUNDER = false, MID = false;
    const bf16* Zz; bf16* Mix; const float* bglu;
    __device__ __forceinline__ void operator()(const f32x4 (&acc)[2][2][4][2], const Unit& u, int wr, int wc, int fr, int fq) const {
#pragma unroll
        for (int bj = 0; bj < 2; ++bj) { const int col = EPI_COL(bj);
            const f32x4 b0 = *(const f32x4*)(bglu + col), b1 = *(const f32x4*)(bglu + col + 4);
#pragma unroll
            for (int ai = 0; ai < 2; ++ai)
#pragma unroll
                for (int m = 0; m < 4; ++m) { const size_t row = (size_t)(u.e0 * 256 + EPI_ROWS(ai, m));
                    const u32x4 zz = *(const u32x4*)(Zz + row * 256 + col);
                    f32x4 a = acc[ai][bj][m][0] + b0, b = acc[ai][bj][m][1] + b1;
                    a[0] = bflo(zz.x) * sigm(a[0]); a[1] = bfhi(zz.x) * sigm(a[1]); a[2] = bflo(zz.y) * sigm(a[2]); a[3] = bfhi(zz.y) * sigm(a[3]);
                    b[0] = bflo(zz.z) * sigm(b[0]); b[1] = bfhi(zz.z) * sigm(b[1]); b[2] = bflo(zz.w) * sigm(b[2]); b[3] = bfhi(zz.w) * sigm(b[3]);
                    *(u32x4*)(Mix + row * 1024 + 256 + col) = pack_acc8(a, b); } }
    }
};
struct EpiMerge {
    static constexpr bool CARRY = false, LAUNDER = false, MID = true;
    const unsigned char* Gt; const unsigned char* Gc; bf16* Y; bf16* YP;
    __device__ __forceinline__ void mid(f32x4 (&acc)[2][2][4][2], const Unit& u, int b, int wr, int wc, int fr, int fq) const {
#pragma unroll
        for (int ai = 0; ai < 2; ++ai) {
            u32x2 g[4][2], gn[4][2];
#pragma unroll
            for (int m = 0; m < 4; ++m)
#pragma unroll
                for (int bj = 0; bj < 2; ++bj) { const unsigned char* gp = Gt + gate_off(u.e0, u.e1, b, wr, wc, ai, m, bj, fr, fq); g[m][bj] = *(const u32x2*)gp; gn[m][bj] = *(const u32x2*)(gp + 65536); }
#pragma unroll
            for (int m = 0; m < 4; ++m)
#pragma unroll
                for (int bj = 0; bj < 2; ++bj) { f32x4 a0 = acc[ai][bj][m][0], a1 = acc[ai][bj][m][1];
#pragma unroll
                    for (int j = 0; j < 4; ++j) { a0[j] *= gate8(g[m][bj].x, j) * rcpf_(gate8(gn[m][bj].x, j)); a1[j] *= gate8(g[m][bj].y, j) * rcpf_(gate8(gn[m][bj].y, j)); }
                    acc[ai][bj][m][0] = a0; acc[ai][bj][m][1] = a1; } }
    }
    __device__ __forceinline__ void operator()(const f32x4 (&acc)[2][2][4][2], const Unit& u, int wr, int wc, int fr, int fq) const {
        const int b = u.e3 ? u.e2 : 3;
#pragma unroll
        for (int ai = 0; ai < 2; ++ai)
#pragma unroll
            for (int m = 0; m < 4; ++m) { const size_t row = (size_t)(u.e0 * 256 + EPI_ROWS(ai, m));
                bf16* orow = (u.e3 ? YP + ((size_t)b * CROWS + (row - LROWS)) * 1024 : Y + row * 1024) + u.e1 * 256;
#pragma unroll
                for (int bj = 0; bj < 2; ++bj) { const u32x2 g = *(const u32x2*)((u.e3 ? Gc : Gt) + gate_off(u.e3 ? u.e0 - 64 : u.e0, u.e1, b, wr, wc, ai, m, bj, fr, fq)); f32x4 a0 = acc[ai][bj][m][0], a1 = acc[ai][bj][m][1];
#pragma unroll
                    for (int j = 0; j < 4; ++j) { a0[j] *= gate8(g.x, j); a1[j] *= gate8(g.y, j); }
                    *(u32x4*)(orow + EPI_COL(bj)) = pack_acc8(a0, a1); } }
    }
};
struct EpiSwiglu { static constexpr bool CARRY = false, LAUNDER = false, MID = false;
    bf16* Hd; int ldh; bool moe;
    __device__ __forceinline__ void operator()(const f32x4 (&acc)[2][2][4][2], const Unit& u, int wr, int wc, int fr, int fq) const {
        const int rowbase = moe ? u.e3 : u.e0 * 256, pn = moe ? u.e2 : u.e1;
#pragma unroll
        for (int ai = 0; ai < 2; ++ai)
#pragma unroll
            for (int m = 0; m < 4; ++m) { bf16* p = Hd + (size_t)(rowbase + EPI_ROWS(ai, m)) * ldh + pn * 128 + 32 * wc + 8 * fq;
                f32x4 a = acc[ai][0][m][0], b = acc[ai][0][m][1]; const f32x4 ua = acc[ai][1][m][0], ub = acc[ai][1][m][1];
#pragma unroll
                for (int j = 0; j < 4; ++j) { a[j] = silu_(a[j]) * ua[j]; b[j] = silu_(b[j]) * ub[j]; }
                *(u32x4*)p = pack_acc8(a, b); }
    }
};
struct EpiSwigluF8 { static constexpr bool CARRY = false, LAUNDER = true, MID = false;
    unsigned char* Hd; int ldh; bool moe; float ws, hs;
    __device__ __forceinline__ void operator()(const f32x4 (&acc)[2][2][4][2], const Unit& u, int wr, int wc, int fr, int fq) const {
        const int rowbase = moe ? u.e3 : u.e0 * 256, pn = moe ? u.e2 : u.e1; const float hs2 = hs * ws;
#pragma unroll
        for (int ai = 0; ai < 2; ++ai)
#pragma unroll
            for (int m = 0; m < 4; ++m) { unsigned char* p = Hd + (size_t)(rowbase + EPI_ROWS(ai, m)) * ldh + pn * 128 + 32 * wc + 8 * fq;
                f32x4 a = acc[ai][0][m][0], b = acc[ai][0][m][1]; const f32x4 ua = acc[ai][1][m][0], ub = acc[ai][1][m][1];
#pragma unroll
                for (int j = 0; j < 4; ++j) { a[j] = __builtin_amdgcn_fmed3f(silu_(a[j] * ws) * (ua[j] * hs2), -448.f, 448.f); b[j] = __builtin_amdgcn_fmed3f(silu_(b[j] * ws) * (ub[j] * hs2), -448.f, 448.f); }
                u32x2 w; w.x = pk4_f8(a[0], a[1], a[2], a[3]); w.y = pk4_f8(b[0], b[1], b[2], b[3]); *(u32x2*)p = w; }
    }
};
struct EpiMoeDown { static constexpr bool CARRY = false, LAUNDER = true, MID = false;
    bf16* Slot; const int* list; const float* routew; const LAS unsigned* mt; float osc;
    __device__ __forceinline__ void operator()(const f32x4 (&acc)[2][2][4][2], const Unit& u, int wr, int wc, int fr, int fq) const {
        const int cnt = (int)mt[u.e0];
#pragma unroll
        for (int ai = 0; ai < 2; ++ai)
#pragma unroll
            for (int m = 0; m < 4; ++m) { const int li = u.e1 * 256 + EPI_ROWS(ai, m);
                if (li < cnt) { const int ent = list[u.e0 * LCAP + li]; const float w = routew[ent] * osc;
                    bf16* rowp = Slot + ((size_t)(ent & 1) * LROWS + (size_t)(ent >> 1)) * 1024 + u.e2 * 256;
#pragma unroll
                    for (int bj = 0; bj < 2; ++bj) *(u32x4*)(rowp + EPI_COL(bj)) = pack_acc8(acc[ai][bj][m][0] * w, acc[ai][bj][m][1] * w); } }
    }
};
struct EpiMoePart { static constexpr bool CARRY = false, LAUNDER = true, MID = false;
    bf16* Pm; const int* list; const LAS unsigned* mt; int* smap; float osc;
    __device__ __forceinline__ void operator()(const f32x4 (&acc)[2][2][4][2], const Unit& u, int wr, int wc, int fr, int fq) const {
        const int cnt = (int)mt[u.e0], q = u.e3; bf16* pt = Pm + (size_t)q * 65536; const bool mapper = (q % 7 == 0) && wc == 0 && fq == 0;
#pragma unroll
        for (int ai = 0; ai < 2; ++ai)
#pragma unroll
            for (int m = 0; m < 4; ++m) { const int rl = EPI_ROWS(ai, m), li = u.e1 * 256 + rl;
#pragma unroll
                for (int bj = 0; bj < 2; ++bj) *(u32x4*)(pt + rl * 256 + EPI_COL(bj)) = pack_acc8(acc[ai][bj][m][0] * osc, acc[ai][bj][m][1] * osc);
                if (mapper && li < cnt) smap[list[u.e0 * LCAP + li] * 4 + u.e2] = ((q / 7) << 8) | rl; }
    }
};
}
#define DROW(reg, h) (((reg) & 3) + 8 * ((reg) >> 2) + 4 * (h))

__device__ __forceinline__ void s5_state_item(const bf16* M1F  , const bf16* SUF, float* HLOC, int item, int lane) {
    const int cb = item % 33, gd = item / 33, g = gd >> 1, dir = gd & 1, li = lane & 31, h = lane >> 5;
    const bf16* A = M1F + (size_t)(g * 2 + dir) * 128 * 256 + lane * 8;
    const bf16* B = SUF + (size_t)(g * 33 + cb) * 16 * 512 + lane * 8;
    f32x16 acc[4];
#pragma unroll
    for (int rt = 0; rt < 4; ++rt) acc[rt] = zero16();
    bf16x8 a0[2][4], b0[2], a1[2][4], b1[2];
#define S5S_LOAD(AA, BB, grp) do { _Pragma("unroll") for (int s = 0; s < 2; ++s) { const int ks = (grp) * 2 + s; BB[s] = ldg8(B + ks * 512); \
        _Pragma("unroll") for (int rt = 0; rt < 4; ++rt) AA[s][rt] = ldg8(A + (ks * 4 + rt) * 512); } } while (0)
#define S5S_MMA(AA, BB) do { _Pragma("unroll") for (int s = 0; s < 2; ++s) _Pragma("unroll") for (int rt = 0; rt < 4; ++rt) acc[rt] = mma32(AA[s][rt], BB[s], acc[rt]); } while (0)
    S5S_LOAD(a0, b0, 0);
#pragma unroll 1
    for (int gp = 0; gp < 8; gp += 2) {
        S5S_LOAD(a1, b1, gp + 1);
        S5S_MMA(a0, b0);
        if (gp + 2 < 8) S5S_LOAD(a0, b0, gp + 2);
        S5S_MMA(a1, b1);
    }
#undef S5S_LOAD
#undef S5S_MMA
    const int c = cb * 32 + li; float* o = HLOC + (((size_t)(g * 2 + dir) * (NCH16 / 2) + (c >> 1)) * 64) * 4 + (c & 1) * 2;
#pragma unroll
    for (int rt = 0; rt < 4; ++rt)
#pragma unroll
        for (int q = 0; q < 4; ++q) { const int p0 = 16 * rt + 4 * q + 2 * h;
            *(f32x2*)(o + (size_t)p0 * 4) = (f32x2){acc[rt][4 * q], acc[rt][4 * q + 1]}; *(f32x2*)(o + (size_t)(p0 + 1) * 4) = (f32x2){acc[rt][4 * q + 2], acc[rt][4 * q + 3]}; }
}
__device__ __forceinline__ void s5_scan_item(const float* A16  , const float* HLOC, bf16* HINF, LAS unsigned char* wl, int item, int lane) {
    const int dir = item & 1, g = (item >> 1) & 15, b = item >> 5, p = lane;
    const f32x2 a = *(const f32x2*)(A16 + ((size_t)(dir * 16 + g) * 64 + p) * 2);
    const float* src = HLOC + ((size_t)(g * 2 + dir) * (NCH16 / 2) * 64 + p) * 4;
    const int k2 = dir * 128 + 2 * p;
    bf16* dctx = HINF + ((size_t)(g * 33 + 32) * 16 + (k2 >> 4)) * 512 + ((k2 >> 3) & 1) * 256 + (k2 & 7);
    float hr = 0.f, hi = 0.f;
#define S5_STEP(xr, xi) do { const float nr_ = a.x * hr - a.y * hi + (xr), ni_ = a.x * hi + a.y * hr + (xi); hr = nr_; hi = ni_; } while (0)
    {
        f32x4 v[8];
#pragma unroll
        for (int j = 0; j < 8; ++j) v[j] = *(const f32x4*)(src + (size_t)(512 + 8 * b + (dir ? 7 - j : j)) * 256);
#pragma unroll
        for (int j = 0; j < 8; ++j) { const int cl0 = 16 * b + 2 * (dir ? 7 - j : j);
            if (!dir) { *(unsigned*)(dctx + (cl0) * 8) = pk2(hr, hi); S5_STEP(v[j][0], v[j][1]); *(unsigned*)(dctx + (cl0 + 1) * 8) = pk2(hr, hi); S5_STEP(v[j][2], v[j][3]); }
            else      { *(unsigned*)(dctx + (cl0 + 1) * 8) = pk2(hr, hi); S5_STEP(v[j][2], v[j][3]); *(unsigned*)(dctx + (cl0) * 8) = pk2(hr, hi); S5_STEP(v[j][0], v[j][1]); } }
    }
    const int pg = p >> 2; LAS unsigned char* wbase = wl + ((p >> 3) * 64 + (pg & 1) * 32) * 16 + 4 * (p & 3);
    f32x4 vn[16];
#pragma unroll
    for (int j = 0; j < 16; ++j) vn[j] = *(const f32x4*)(src + (size_t)(256 * b + (dir ? 255 - j : j)) * 256);
#pragma unroll 1
    for (int blk = 0; blk < 16; ++blk) {
        f32x4 v[16];
#pragma unroll
        for (int j = 0; j < 16; ++j) v[j] = vn[j];
        if (blk < 15) {
#pragma unroll
            for (int j = 0; j < 16; ++j) { const int pj = 16 * (blk + 1) + j; vn[j] = *(const f32x4*)(src + (size_t)(256 * b + (dir ? 255 - pj : pj)) * 256); } }
#pragma unroll
        for (int j = 0; j < 16; ++j) { const int pl = dir ? 15 - j : j;
            if (!dir) { *(LAS unsigned*)(wbase + ((2 * pl + pg) & 31) * 16) = pk2(hr, hi); S5_STEP(v[j][0], v[j][1]); *(LAS unsigned*)(wbase + ((2 * pl + 1 + pg) & 31) * 16) = pk2(hr, hi); S5_STEP(v[j][2], v[j][3]); }
            else      { *(LAS unsigned*)(wbase + ((2 * pl + 1 + pg) & 31) * 16) = pk2(hr, hi); S5_STEP(v[j][2], v[j][3]); *(LAS unsigned*)(wbase + ((2 * pl + pg) & 31) * 16) = pk2(hr, hi); S5_STEP(v[j][0], v[j][1]); } }
        const int cb = 16 * b + (dir ? 15 - blk : blk), hs = lane >> 5, cl = lane & 31;
        bf16* dout = HINF + ((size_t)(g * 33 + cb) * 16 + dir * 8) * 512 + lane * 8;
#pragma unroll
        for (int j = 0; j < 8; ++j) *(u32x4*)(dout + j * 512) = *(const LAS u32x4*)(wl + (j * 64 + hs * 32 + ((cl + 2 * j + hs) & 31)) * 16);
    }
#undef S5_STEP
}
__device__ __forceinline__ void s5_out_item(const bf16* TABF  , const bf16* SUF, const bf16* HINF, bf16* Z, int item, int lane) {
    const int mh = item & 1, it2 = item >> 1, cb = it2 % 33, g = it2 / 33, li = lane & 31, h = lane >> 5, c = cb * 32 + li;
    const bf16* A = TABF + ((size_t)g * 256 + mh * 128) * 512 + lane * 8;
    const bf16* B0 = SUF + (size_t)(g * 33 + cb) * 16 * 512 + lane * 8;
    const bf16* B1 = HINF + (size_t)(g * 33 + cb) * 16 * 512 + lane * 8;
    f32x16 acc[4];
#pragma unroll
    for (int rt = 0; rt < 4; ++rt) acc[rt] = zero16();
    bf16x8 a0[2][4], b0[2], a1[2][4], b1[2];
#define S5O_LOAD(AA, BB, grp) do { _Pragma("unroll") for (int s = 0; s < 2; ++s) { const int ks = (grp) * 2 + s; BB[s] = ldg8((ks < 16 ? B0 + ks * 512 : B1 + (ks - 16) * 512)); \
        _Pragma("unroll") for (int rt = 0; rt < 4; ++rt) AA[s][rt] = ldg8(A + (ks * 4 + rt) * 512); } } while (0)
#define S5O_MMA(AA, BB) do { _Pragma("unroll") for (int s = 0; s < 2; ++s) _Pragma("unroll") for (int rt = 0; rt < 4; ++rt) acc[rt] = mma32(AA[s][rt], BB[s], acc[rt]); } while (0)
    S5O_LOAD(a0, b0, 0);
#pragma unroll 1
    for (int gp = 0; gp < 16; gp += 2) {
        S5O_LOAD(a1, b1, gp + 1);
        S5O_MMA(a0, b0);
        if (gp + 2 < 16) S5O_LOAD(a0, b0, gp + 2);
        S5O_MMA(a1, b1);
    }
#undef S5O_LOAD
#undef S5O_MMA
#pragma unroll
    for (int rt = 0; rt < 4; ++rt)
#pragma unroll
        for (int q = 0; q < 4; ++q) {
            const int i = 8 * mh + 2 * rt + (q >> 1), ho0 = 8 * (q & 1) + 4 * h;
            u32x2 w; w.x = pk2(gelu_tanh(acc[rt][4 * q]), gelu_tanh(acc[rt][4 * q + 1])); w.y = pk2(gelu_tanh(acc[rt][4 * q + 2]), gelu_tanh(acc[rt][4 * q + 3]));
            *(u32x2*)(Z + ((size_t)c * 16 + i) * 256 + g * 16 + ho0) = w; }
}

__device__ __forceinline__ int ret_tok0(int b, int n) { return n < 64 ? b * SEQ + n * 128 : LROWS + b * CTXL + (n - 64) * 128; }
__device__ __forceinline__ void ret_kv_item(const bf16* RKT, const bf16* RVT, const float* COST, const float* SINT, const float* decay  , float* KV, int item, int lane) {
    const int n = item % 66, bh = item / 66, hd = bh & 3, b = bh >> 2, li = lane & 31, h = lane >> 5;
    const int tok0 = ret_tok0(b, n); const bool lat = n < 64;
    const float lgf = -log2f(1.f + __expf(-decay[hd])), lgr = -log2f(1.f + __expf(-decay[4 + hd]));
    f32x16 acc[2][2][2];
#pragma unroll
    for (int a = 0; a < 2; ++a)
#pragma unroll
        for (int c = 0; c < 2; ++c)
#pragma unroll
            for (int d = 0; d < 2; ++d) acc[a][c][d] = zero16();
    const bf16* k0p = RKT + (size_t)(hd * 64 + li) * R + tok0 + 8 * h;
    const bf16* v0p = RVT + (size_t)(hd * 64 + li) * R + tok0 + 8 * h;
#pragma unroll 2
    for (int ks = 0; ks < 8; ++ks) {
        float k1[8], k2[8];
        unpack8(ldg8(k0p + ks * 16), k1); unpack8(ldg8(k0p + (size_t)32 * R + ks * 16), k2);
        if (lat) {
            const float* cp = COST + (size_t)li * SEQ + n * 128 + ks * 16 + 8 * h; const float* sp = SINT + (size_t)li * SEQ + n * 128 + ks * 16 + 8 * h;
            const f32x4 c0 = *(const f32x4*)cp, c1 = *(const f32x4*)(cp + 4), s0 = *(const f32x4*)sp, s1 = *(const f32x4*)(sp + 4);
#pragma unroll
            for (int j = 0; j < 8; ++j) { const float cc = j < 4 ? c0[j & 3] : c1[j & 3], ss = j < 4 ? s0[j & 3] : s1[j & 3];
                const float x1 = k1[j], x2 = k2[j]; k1[j] = x1 * cc - x2 * ss; k2[j] = x1 * ss + x2 * cc; }
        }
        const bf16x8 vf0 = ldg8(v0p + ks * 16), vf1 = ldg8(v0p + (size_t)32 * R + ks * 16);
#pragma unroll
        for (int dir = 0; dir < 2; ++dir) {
            float a1[8], a2[8];
#pragma unroll
            for (int j = 0; j < 8; ++j) { const int i = ks * 16 + 8 * h + j; const float w = dir == 0 ? ex2(lgf * (float)(127 - i)) : ex2(lgr * (float)i); a1[j] = k1[j] * w; a2[j] = k2[j] * w; }
            const bf16x8 kd0 = pack8(a1), kd1 = pack8(a2);
            acc[dir][0][0] = mma32(kd0, vf0, acc[dir][0][0]); acc[dir][0][1] = mma32(kd0, vf1, acc[dir][0][1]);
            acc[dir][1][0] = mma32(kd1, vf0, acc[dir][1][0]); acc[dir][1][1] = mma32(kd1, vf1, acc[dir][1][1]);
        }
    }
#pragma unroll
    for (int dir = 0; dir < 2; ++dir) { float* o = KV + ((size_t)((b * 4 + hd) * 2 + dir) * 66 + n) * 4096;
#pragma unroll
        for (int dt = 0; dt < 2; ++dt)
#pragma unroll
            for (int et = 0; et < 2; ++et)
#pragma unroll
                for (int q = 0; q < 4; ++q) *(f32x4*)(o + (size_t)(et * 32 + li) * 64 + dt * 32 + 8 * q + 4 * h) = (f32x4){acc[dir][dt][et][4 * q], acc[dir][dt][et][4 * q + 1], acc[dir][dt][et][4 * q + 2], acc[dir][dt][et][4 * q + 3]}; }
}
__device__ __forceinline__ void ret_scan_item(const float* decay, const float* KV, bf16* SPREV, int item, int lane) {
    const int blk = item & 63, bhd = item >> 6, dir = bhd & 1, hd = (bhd >> 1) & 3, idx = blk * 64 + lane;
    const float lg = -log2f(1.f + __expf(-decay[dir * 4 + hd])), cd = ex2(128.f * lg);
    const float* src = KV + (size_t)bhd * 66 * 4096 + idx; bf16* dst = SPREV + (size_t)bhd * 66 * 4096 + idx;
    float s = 0.f;
    for (int s0 = 0; s0 < 66; s0 += 11) {
        float v[11];
#pragma unroll
        for (int j = 0; j < 11; ++j) { const int t = s0 + j; const int n = dir == 0 ? (t < 2 ? 64 + t : t - 2) : (t < 2 ? 65 - t : 65 - t); v[j] = src[(size_t)n * 4096]; }
#pragma unroll
        for (int j = 0; j < 11; ++j) { const int t = s0 + j; const int n = dir == 0 ? (t < 2 ? 64 + t : t - 2) : (t < 2 ? 65 - t : 65 - t); dst[(size_t)n * 4096] = (bf16)(pk2(s, 0.f) & 0xffffu); s = cd * s + v[j]; }
    }
}
struct KVTile { u32x4 k[4], v[4]; };
__device__ __forceinline__ void kv_tile_load(KVTile& T, const bf16* Kh  , const bf16* VTh  , int tok0, int lane) {
#pragma unroll
    for (int i = 0; i < 4; ++i) T.k[i] = *(const u32x4*)(Kh + (size_t)(tok0 + 8 * i + (lane >> 3)) * 256 + (lane & 7) * 8);
#pragma unroll
    for (int i = 0; i < 4; ++i) T.v[i] = *(const u32x4*)(VTh + (size_t)(16 * i + (lane >> 2)) * R + tok0 + (lane & 3) * 8);
}
__device__ __forceinline__ void kv_tile_store(const KVTile& T, LAS unsigned char* wl, int lane) {
#pragma unroll
    for (int i = 0; i < 4; ++i) *(LAS u32x4*)(wl + (8 * i + (lane >> 3)) * 144 + (lane & 7) * 16) = T.k[i];
#pragma unroll
    for (int i = 0; i < 4; ++i) *(LAS u32x4*)(wl + 4608 + (16 * i + (lane >> 2)) * 80 + (lane & 3) * 16) = T.v[i];
}
__device__ __forceinline__ void kv_tile_frags(const LAS unsigned char* wl, int lane, bf16x8 (&kf)[4], bf16x8 (&vf)[2][2]) {
    const int li = lane & 31, h = lane >> 5;
#pragma unroll
    for (int s = 0; s < 4; ++s) kf[s] = *(const LAS bf16x8*)(wl + li * 144 + (2 * s + h) * 16);
#pragma unroll
    for (int et = 0; et < 2; ++et)
#pragma unroll
        for (int s2 = 0; s2 < 2; ++s2) { const LAS unsigned char* p = wl + 4608 + (et * 32 + li) * 80 + s2 * 32 + 8 * h;
            const bf16x4 lo = *(const LAS bf16x4*)p, hi = *(const LAS bf16x4*)(p + 16); vf[et][s2] = __builtin_shufflevector(lo, hi, 0, 1, 2, 3, 4, 5, 6, 7); }
}

__device__ __forceinline__ void rope_item(bf16* RQ, bf16* RK, const float* COSN, const float* SINN, int item, int lane) {
    const int u = lane & 15, off = (u >> 2) * 64 + (u & 3) * 8, c8 = (u & 3) * 8;
#pragma unroll 4
    for (int st = 0; st < 32; ++st) { const int row = item * 128 + 4 * st + (lane >> 4), tl = row & (SEQ - 1);
        const f32x4 c0 = *(const f32x4*)(COSN + (size_t)tl * 32 + c8), c1 = *(const f32x4*)(COSN + (size_t)tl * 32 + c8 + 4), s0 = *(const f32x4*)(SINN + (size_t)tl * 32 + c8), s1 = *(const f32x4*)(SINN + (size_t)tl * 32 + c8 + 4);
#pragma unroll
        for (int w = 0; w < 2; ++w) { bf16* p = (w ? RK : RQ) + (size_t)row * 256 + off; float x1[8], x2[8]; unpack8(*(const bf16x8*)p, x1); unpack8(*(const bf16x8*)(p + 32), x2);
#pragma unroll
            for (int j = 0; j < 8; ++j) { const float cc = j < 4 ? c0[j & 3] : c1[j & 3], ss = j < 4 ? s0[j & 3] : s1[j & 3]; const float a = x1[j], bb = x2[j]; x1[j] = a * cc - bb * ss; x2[j] = a * ss + bb * cc; }
            *(bf16x8*)p = pack8(x1); *(bf16x8*)(p + 32) = pack8(x2); } }
}
__device__ __forceinline__ void ret_out_item(const bf16* RQ, const bf16* RK, const bf16* RG, const bf16* RVT, const bf16* SPREV, const float* decay, const float* gn  , bf16* MIX,
                                             LAS unsigned char* wl, int item, int lane) {
    const int qb = item & 3, it2 = item >> 2, n = it2 % 66, bh = it2 / 66, hd = bh & 3, b = bh >> 2, li = lane & 31, h = lane >> 5;
    const int tok0 = ret_tok0(b, n);
    const float lgf = -log2f(1.f + __expf(-decay[hd])), lgr = -log2f(1.f + __expf(-decay[4 + hd]));
    const int iq = qb * 32 + li;
    const bf16* Kh = RK + hd * 64; const bf16* VTh = RVT + (size_t)hd * 64 * R;
    KVTile T; kv_tile_load(T, Kh, VTh, tok0, lane);
    bf16x8 qf[4];
    { const bf16* qp = RQ + (size_t)(tok0 + iq) * 256 + hd * 64 + 8 * h;
#pragma unroll
      for (int s = 0; s < 4; ++s) qf[s] = ldg8(qp + 16 * s); }
    kv_tile_store(T, wl, lane);
    f32x16 accO[2] = {zero16(), zero16()};
#pragma unroll 1
    for (int kt = 0; kt < 4; ++kt) {
        kv_tile_load(T, Kh, VTh, tok0 + (kt < 3 ? kt + 1 : kt) * 32, lane);
        bf16x8 kf[4], vf[2][2]; kv_tile_frags(wl, lane, kf, vf);
        f32x16 st = zero16();
#pragma unroll
        for (int s = 0; s < 4; ++s) st = mma32(kf[s], qf[s], st);
#pragma unroll
        for (int r = 0; r < 16; ++r) { const int j = kt * 32 + DROW(r, h), df = iq - j;
            const float w = df > 0 ? ex2(lgf * (float)df) : (df < 0 ? ex2(lgr * (float)(-df)) : 2.f); st[r] *= w; }
        const bf16x8 p0 = accB<0>(st), p1 = accB<1>(st);
        accO[0] = mma32(vf[0][0], p0, accO[0]); accO[0] = mma32(vf[0][1], p1, accO[0]); accO[1] = mma32(vf[1][0], p0, accO[1]); accO[1] = mma32(vf[1][1], p1, accO[1]);
        kv_tile_store(T, wl, lane);
    }
    const float cf = ex2(lgf * (float)(iq + 1)), cr = ex2(lgr * (float)(128 - iq));
#pragma unroll
    for (int dir = 0; dir < 2; ++dir) { const bf16* sp = SPREV + ((size_t)((b * 4 + hd) * 2 + dir) * 66 + n) * 4096;
#pragma unroll
        for (int et = 0; et < 2; ++et) { f32x16 a = zero16();
#pragma unroll
            for (int s = 0; s < 4; ++s) a = mma32(ldg8(sp + (size_t)(et * 32 + li) * 64 + 16 * s + 8 * h), qf[s], a);
            const float sc = dir == 0 ? cf : cr;
#pragma unroll
            for (int r = 0; r < 16; ++r) accO[et][r] += sc * a[r]; } }
    float s1 = 0.f;
#pragma unroll
    for (int et = 0; et < 2; ++et)
#pragma unroll
        for (int r = 0; r < 16; ++r) s1 += accO[et][r];
    s1 = xor32_sum(s1); const float mu = s1 * (1.f / 64.f);
    float s2 = 0.f;
#pragma unroll
    for (int et = 0; et < 2; ++et)
#pragma unroll
        for (int r = 0; r < 16; ++r) { const float dlt = accO[et][r] - mu; s2 += dlt * dlt; }
    s2 = xor32_sum(s2); const float rstd = __builtin_amdgcn_rsqf(s2 * (1.f / 64.f) + EPSN);
    const size_t tok = (size_t)(tok0 + iq);
#pragma unroll
    for (int et = 0; et < 2; ++et)
#pragma unroll
        for (int q = 0; q < 4; ++q) { const int e0 = hd * 64 + et * 32 + 8 * q + 4 * h;
            const f32x4 gv = *(const f32x4*)(gn + e0); const u32x2 gg = *(const u32x2*)(RG + tok * 256 + e0);
            const float g0 = bflo(gg.x), g1 = bfhi(gg.x), g2 = bflo(gg.y), g3 = bfhi(gg.y);
            u32x2 w; w.x = pk2(silu_(g0) * (accO[et][4 * q] - mu) * rstd * gv[0], silu_(g1) * (accO[et][4 * q + 1] - mu) * rstd * gv[1]);
            w.y = pk2(silu_(g2) * (accO[et][4 * q + 2] - mu) * rstd * gv[2], silu_(g3) * (accO[et][4 * q + 3] - mu) * rstd * gv[3]);
            *(u32x2*)(MIX + tok * 1024 + 512 + e0) = w; }
}

__device__ __forceinline__ int na_tile_tok(int t, int b, int rs) { const int tb = t - 8; return t >= 8 ? b * SEQ + (rs + (tb >> 1)) * 64 + (tb & 1) * 32 : LROWS + b * CTXL + t * 32; }
__device__ __forceinline__ void na_item(const bf16* NQ, const bf16* NK, const bf16* NVT, bf16* MIX, const LAS float* rpb2, LAS unsigned char* wl, bool ctxq, int b, int r, int hd, int qs, int lane) {
    const int li = lane & 31, h = lane >> 5;
    const int tokq = ctxq ? LROWS + b * CTXL + qs * 32 + li : b * SEQ + r * 64 + qs * 32 + li;
    bf16x8 qf[4];
#pragma unroll
    for (int s = 0; s < 4; ++s) qf[s] = ldg8(NQ + (size_t)tokq * 256 + hd * 64 + 16 * s + 8 * h);
    float mrun = -1e30f, lrun = 0.f;
    f32x16 accO[2] = {zero16(), zero16()};
    const int rs = r - 4 < 0 ? 0 : (r - 4 > 120 ? 120 : r - 4);
    const int qc = qs * 32 + li, cs = qc - 8 < 0 ? 0 : (qc - 8 > 48 ? 48 : qc - 8);
    const int ntile = ctxq ? 8 : 24;
    const float c1 = 0.125f * LOG2E;
    const bf16* Kh = NK + hd * 64; const bf16* VTh = NVT + (size_t)hd * 64 * R;
    KVTile T; kv_tile_load(T, Kh, VTh, na_tile_tok(0, b, rs), lane); kv_tile_store(T, wl, lane);
#pragma unroll 1
    for (int t = 0; t < ntile; ++t) {
        const bool band = t >= 8; const int tb = t - 8, rr = rs + (tb >> 1), ct = tb & 1;
        kv_tile_load(T, Kh, VTh, na_tile_tok(t + 1 < ntile ? t + 1 : t, b, rs), lane);
        bf16x8 kf[4], vf[2][2]; kv_tile_frags(wl, lane, kf, vf);
        f32x16 st = zero16();
#pragma unroll
        for (int s = 0; s < 4; ++s) st = mma32(kf[s], qf[s], st);
        float mt = -INFINITY;
        if (band) { const int dr = rr - r + 7; const LAS float* bp = rpb2 + ((hd * 15 + dr) * 31 + 32 * ct - qc + 15 + 4 * h); const int d0 = 32 * ct + 4 * h - cs;
#pragma unroll
            for (int g = 0; g < 16; ++g) { const int o = 8 * (g >> 2) + (g & 3); const bool inw = (unsigned)(d0 + o) < 16u;
                const float v = inw ? st[g] * c1 + bp[o] : -INFINITY; st[g] = v; mt = fmaxf(mt, v); }
        } else {
#pragma unroll
            for (int g = 0; g < 16; ++g) { const float v = st[g] * c1; st[g] = v; mt = fmaxf(mt, v); }
        }
        mt = xor32_max(mt);
        const float mnew = fmaxf(mrun, mt);
        if (__builtin_amdgcn_ballot_w64(mnew > mrun)) { const float alpha = ex2(mrun - mnew); lrun *= alpha;
#pragma unroll
            for (int et = 0; et < 2; ++et)
#pragma unroll
                for (int g = 0; g < 16; ++g) accO[et][g] *= alpha; }
        mrun = mnew;
        float ps = 0.f;
#pragma unroll
        for (int g = 0; g < 16; ++g) { const float p = ex2(st[g] - mnew); st[g] = p; ps += p; }
        lrun += xor32_sum(ps);
        const bf16x8 p0 = accB<0>(st), p1 = accB<1>(st);
        accO[0] = mma32(vf[0][0], p0, accO[0]); accO[0] = mma32(vf[0][1], p1, accO[0]); accO[1] = mma32(vf[1][0], p0, accO[1]); accO[1] = mma32(vf[1][1], p1, accO[1]);
        kv_tile_store(T, wl, lane);
    }
    const float inv = 1.f / lrun;
#pragma unroll
    for (int et = 0; et < 2; ++et)
#pragma unroll
        for (int q = 0; q < 4; ++q) { u32x2 w; w.x = pk2(accO[et][4 * q] * inv, accO[et][4 * q + 1] * inv); w.y = pk2(accO[et][4 * q + 2] * inv, accO[et][4 * q + 3] * inv);
            *(u32x2*)(MIX + (size_t)tokq * 1024 + 768 + hd * 64 + et * 32 + 8 * q + 4 * h) = w; }
}

__device__ __forceinline__ void fft1_item(const bf16* F, const bf16* W128T, const float* TWC, const float* TWS, bf16* FB, int item, int lane) {
    const int l2 = item & 63, g = (item >> 6) & 3, b = item >> 8, li = lane & 31, h = lane >> 5;
    bf16x8 idf[4];
#pragma unroll
    for (int s = 0; s < 4; ++s) { float v[8];
#pragma unroll
        for (int j = 0; j < 8; ++j) v[j] = (16 * (s & 1) + 8 * h + j == li) ? 1.f : 0.f;
        idf[s] = pack8(v); }
    bf16x8 xb[4][2][2];
#pragma unroll
    for (int lt = 0; lt < 4; ++lt) {
        const bf16* xp = F + (size_t)(b * SEQ + 64 * (lt * 32 + li) + l2) * 256 + g * 64 + 8 * h;
        const bf16x8 x0 = ldg8(xp), x1 = ldg8(xp + 16), x2 = ldg8(xp + 32), x3 = ldg8(xp + 48);
        f32x16 c0 = zero16(), c1 = zero16();
        c0 = mma32(x0, idf[0], c0); c0 = mma32(x1, idf[1], c0);
        c1 = mma32(x2, idf[0], c1); c1 = mma32(x3, idf[1], c1);
        xb[lt][0][0] = accB<0>(c0); xb[lt][0][1] = accB<1>(c0); xb[lt][1][0] = accB<0>(c1); xb[lt][1][1] = accB<1>(c1);
    }
#pragma unroll 1
    for (int kb = 0; kb < 4; ++kb) {
        f32x16 acc[2][2];
#pragma unroll
        for (int ri = 0; ri < 2; ++ri) { acc[ri][0] = zero16(); acc[ri][1] = zero16();
            const bf16* wp = W128T + ((size_t)ri * 128 + kb * 32 + li) * 128 + 4 * h;
#pragma unroll
            for (int lt = 0; lt < 4; ++lt)
#pragma unroll
                for (int s = 0; s < 2; ++s) { const bf16x8 wf = ldg8p(wp + lt * 32 + 16 * s);
                    acc[ri][0] = mma32(wf, xb[lt][0][s], acc[ri][0]); acc[ri][1] = mma32(wf, xb[lt][1][s], acc[ri][1]); } }
#pragma unroll
        for (int q = 0; q < 4; ++q) { const int k1 = kb * 32 + 8 * q + 4 * h;
            const f32x4 tc = *(const f32x4*)(TWC + l2 * 128 + k1), ts = *(const f32x4*)(TWS + l2 * 128 + k1);
#pragma unroll
            for (int j = 0; j < 4; ++j)
#pragma unroll
                for (int ct = 0; ct < 2; ++ct) { const float ar = acc[0][ct][4 * q + j], ai = acc[1][ct][4 * q + j];
                    const float br = ar * tc[j] + ai * ts[j], bi = ai * tc[j] - ar * ts[j];
                    bf16* o = FB + ((((size_t)(b * 4 + g) * 128 + k1 + j) * 2) * 64 + l2) * 64 + ct * 32 + li;
                    o[0] = (bf16)(pk2(br, 0.f) & 0xffffu); o[64 * 64] = (bf16)(pk2(bi, 0.f) & 0xffffu); } }
    }
}
__device__ __forceinline__ void fft2_item(const bf16* FB, const bf16* FCT, const bf16* W64T, bf16* MIX, int item, int lane) {
    const int mh = item & 1, k1 = (item >> 1) & 127, g = (item >> 8) & 3, b = item >> 10, li = lane & 31, h = lane >> 5;
    const bf16* br = FB + (((size_t)(b * 4 + g) * 128 + k1) * 2) * 64 * 64; const bf16* bi = br + 64 * 64;
    const bf16* fc = FCT + (size_t)(mh * 32 + li) * 64 + 8 * h; const bf16* fs = fc + 64 * 64; const bf16* fn = fc + 2 * 64 * 64;
    bf16x8 eb[2][2][2];
#pragma unroll
    for (int lt = 0; lt < 2; ++lt) { f32x16 er = zero16(), ei = zero16();
#pragma unroll
        for (int s = 0; s < 4; ++s) { const bf16x8 ar = ldg8(br + (size_t)(lt * 32 + li) * 64 + 16 * s + 8 * h), ai = ldg8(bi + (size_t)(lt * 32 + li) * 64 + 16 * s + 8 * h);
            const bf16x8 c = ldg8(fc + 16 * s), sn = ldg8(fs + 16 * s), ns = ldg8(fn + 16 * s);
            er = mma32(ar, c, er); er = mma32(ai, sn, er); ei = mma32(ai, c, ei); ei = mma32(ar, ns, ei); }
        eb[lt][0][0] = accB<0>(er); eb[lt][0][1] = accB<1>(er); eb[lt][1][0] = accB<0>(ei); eb[lt][1][1] = accB<1>(ei); }
#pragma unroll
    for (int kt = 0; kt < 2; ++kt) { f32x16 o = zero16();
        const bf16* wc = W64T + (size_t)(kt * 32 + li) * 64 + 4 * h; const bf16* wsn = wc + 64 * 64;
#pragma unroll
        for (int lt = 0; lt < 2; ++lt)
#pragma unroll
            for (int s = 0; s < 2; ++s) { o = mma32(ldg8p(wc + lt * 32 + 16 * s), eb[lt][0][s], o); o = mma32(ldg8p(wsn + lt * 32 + 16 * s), eb[lt][1][s], o); }
#pragma unroll
        for (int rg = 0; rg < 16; ++rg) { const int k2 = kt * 32 + DROW(rg, h);
            MIX[(size_t)(b * SEQ + k1 + 128 * k2) * 1024 + g * 64 + mh * 32 + li] = (bf16)(pk2(o[rg], 0.f) & 0xffffu); } }
}
__device__ __forceinline__ void fftc_item(const bf16* F, const bf16* FCT, const bf16* W256T, bf16* MIX, int item, int lane) {
    const int mh = item & 1, kb = (item >> 1) & 7, g = (item >> 4) & 3, b = item >> 6, li = lane & 31, h = lane >> 5;
    const bf16* fc = FCT + (size_t)(mh * 32 + li) * 64 + 8 * h; const bf16* fn = fc + 2 * 64 * 64;
    const bf16* wc = W256T + (size_t)(kb * 32 + li) * 256 + 4 * h; const bf16* wsn = wc + 256 * 256;
    f32x16 o = zero16();
#pragma unroll 1
    for (int lt = 0; lt < 8; ++lt) { f32x16 zr = zero16(), zi = zero16();
        const bf16* xp = F + (size_t)(LROWS + b * CTXL + lt * 32 + li) * 256 + g * 64 + 8 * h;
#pragma unroll
        for (int s = 0; s < 4; ++s) { const bf16x8 x = ldg8(xp + 16 * s); zr = mma32(x, ldg8(fc + 16 * s), zr); zi = mma32(x, ldg8(fn + 16 * s), zi); }
        o = mma32(ldg8p(wc + lt * 32), accB<0>(zr), o); o = mma32(ldg8p(wc + lt * 32 + 16), accB<1>(zr), o);
        o = mma32(ldg8p(wsn + lt * 32), accB<0>(zi), o); o = mma32(ldg8p(wsn + lt * 32 + 16), accB<1>(zi), o); }
#pragma unroll
    for (int rg = 0; rg < 16; ++rg) { const int k = kb * 32 + DROW(rg, h);
        MIX[(size_t)(LROWS + b * CTXL + k) * 1024 + g * 64 + mh * 32 + li] = (bf16)(pk2(o[rg], 0.f) & 0xffffu); }
}
__device__ __forceinline__ void row_ld_f32(const float* p, int lane, f32x4 (&v)[4]) {
#pragma unroll
    for (int j = 0; j < 4; ++j) v[j] = *(const f32x4*)(p + 256 * j + 4 * lane); }
__device__ __forceinline__ void row_ld_bf16(const bf16* p, int lane, f32x4 (&v)[4]) {
#pragma unroll
    for (int j = 0; j < 4; ++j) { const u32x2 w = *(const u32x2*)(p + 256 * j + 4 * lane); v[j] = (f32x4){bflo(w.x), bfhi(w.x), bflo(w.y), bfhi(w.y)}; } }
__device__ __forceinline__ void row_ld_part(const float* P, int nslice, int r, int lane, f32x4 (&v)[4]) {
#pragma unroll
    for (int j = 0; j < 4; ++j) { const float* p = P + ((size_t)((((r - LROWS) >> 8) * 4 + j) * nslice) * 256 + (r & 255)) * 256 + 4 * lane; f32x4 s = *(const f32x4*)p;
        for (int k = 1; k < nslice; ++k) s = s + *(const f32x4*)(p + (size_t)k * 65536);
        v[j] = s; } }
__device__ __forceinline__ void row_st_f32(float* p, int lane, const f32x4 (&v)[4]) {
#pragma unroll
    for (int j = 0; j < 4; ++j) *(f32x4*)(p + 256 * j + 4 * lane) = v[j]; }
__device__ __forceinline__ void row_st_bf16(bf16* p, int lane, const f32x4 (&v)[4]) {
#pragma unroll
    for (int j = 0; j < 4; ++j) { u32x2 w; w.x = pk2(v[j][0], v[j][1]); w.y = pk2(v[j][2], v[j][3]); *(u32x2*)(p + 256 * j + 4 * lane) = w; } }
__device__ __forceinline__ float row_rstd(const f32x4 (&v)[4]) { float s = 0.f;
#pragma unroll
    for (int j = 0; j < 4; ++j) s += (v[j][0] * v[j][0] + v[j][1] * v[j][1]) + (v[j][2] * v[j][2] + v[j][3] * v[j][3]);
    return __builtin_amdgcn_rsqf(wave_sum(s) * (1.f / 1024.f) + EPSN); }
__device__ __forceinline__ void row_modnorm(const f32x4 (&x)[4], const float* g, const float* sc, const float* sh, int lane, f32x4 (&hh)[4]) {
    const float rs = row_rstd(x); f32x4 gv[4], scv[4], shv[4]; row_ld_f32(g, lane, gv); row_ld_f32(sc, lane, scv); row_ld_f32(sh, lane, shv);
#pragma unroll
    for (int j = 0; j < 4; ++j) hh[j] = x[j] * rs * gv[j] * (scv[j] + 1.f) + shv[j]; }
__device__ __forceinline__ void row_resid(f32x4 (&x)[4], const f32x4 (&t)[4], const float* g, const float* gate, int lane) {
    const float rs = row_rstd(t); f32x4 gv[4], ga[4]; row_ld_f32(g, lane, gv); row_ld_f32(gate, lane, ga);
#pragma unroll
    for (int j = 0; j < 4; ++j) x[j] = x[j] + ga[j] * (t[j] * rs * gv[j]); }

struct NormCfg {
    const float* xin_lat; const float* xin_ctx;
    float* xout_lat; float* xout_ctx;
    const bf16* trow;
    const float* tpart; int npart;
    const float* gA; const float* modA; int gate_off;
    const float* gB; const float* modB; int sc_off, sh_off; bf16* hout;
    int nrows;
};
__device__ __forceinline__ void norm_rows(const NormCfg& C, int wslot, int NW, int lane) {
    const int nlat = C.nrows < LROWS ? C.nrows : LROWS;
    int r = wslot;
    if (r < nlat) {
        int cur = -1; f32x4 gav[4], scv[4], shv[4];
        f32x4 xn[4]; u32x2 tn[4];
#pragma unroll
        for (int j = 0; j < 4; ++j) { tn[j] = (u32x2){0u, 0u}; gav[j] = scv[j] = shv[j] = (f32x4){0.f, 0.f, 0.f, 0.f}; }
        row_ld_f32(C.xin_lat + (size_t)r * D, lane, xn);
        if (C.trow) {
#pragma unroll
            for (int j = 0; j < 4; ++j) tn[j] = *(const u32x2*)(C.trow + (size_t)r * D + 256 * j + 4 * lane); }
        for (; r < nlat; r += NW) {
            f32x4 x[4]; u32x2 tr[4];
#pragma unroll
            for (int j = 0; j < 4; ++j) { x[j] = xn[j]; tr[j] = tn[j]; }
            const int r2 = r + NW;
            if (r2 < nlat) { row_ld_f32(C.xin_lat + (size_t)r2 * D, lane, xn);
                if (C.trow) {
#pragma unroll
                    for (int j = 0; j < 4; ++j) tn[j] = *(const u32x2*)(C.trow + (size_t)r2 * D + 256 * j + 4 * lane); } }
            const int ci = r < SEQ ? 0 : 1;
            if (ci != cur) { cur = ci;
                if (C.trow) row_ld_f32(C.modA + (size_t)ci * 6144 + C.gate_off, lane, gav);
                if (C.gB) { row_ld_f32(C.modB + (size_t)ci * 6144 + C.sc_off, lane, scv); row_ld_f32(C.modB + (size_t)ci * 6144 + C.sh_off, lane, shv); } }
            if (C.trow) { f32x4 t[4], gAv[4]; row_ld_f32(C.gA, lane, gAv);
#pragma unroll
                for (int j = 0; j < 4; ++j) t[j] = (f32x4){bflo(tr[j].x), bfhi(tr[j].x), bflo(tr[j].y), bfhi(tr[j].y)};
                const float rs = row_rstd(t);
#pragma unroll
                for (int j = 0; j < 4; ++j) x[j] = x[j] + gav[j] * (t[j] * rs * gAv[j]);
                row_st_f32(C.xout_lat + (size_t)r * D, lane, x); }
            if (C.gB) { f32x4 gBv[4]; row_ld_f32(C.gB, lane, gBv); const float rs = row_rstd(x); f32x4 hh[4];
#pragma unroll
                for (int j = 0; j < 4; ++j) hh[j] = x[j] * rs * gBv[j] * (scv[j] + 1.f) + shv[j];
                row_st_bf16(C.hout + (size_t)r * D, lane, hh); }
        }
    }
    for (r = LROWS + wslot; r < C.nrows; r += NW) {
        f32x4 x[4]; row_ld_f32(C.xin_ctx + (size_t)(r - LROWS) * D, lane, x);
        if (C.trow) { f32x4 t[4]; if (C.tpart) row_ld_part(C.tpart, C.npart, r, lane, t); else row_ld_bf16(C.trow + (size_t)r * D, lane, t);
            row_resid(x, t, C.gA, C.modA + (size_t)2 * 6144 + C.gate_off, lane); row_st_f32(C.xout_ctx + (size_t)(r - LROWS) * D, lane, x); }
        if (C.gB) { f32x4 hh[4]; row_modnorm(x, C.gB, C.modB + (size_t)2 * 6144 + C.sc_off, C.modB + (size_t)2 * 6144 + C.sh_off, lane, hh); row_st_bf16(C.hout + (size_t)r * D, lane, hh); }
    }
}

__device__ __forceinline__ void transpose_item(const float* W, int ldw, int k0, int n0, bf16* dst, int ldd, float scale, LAS float* scr, int lane) {
#pragma unroll 8
    for (int i = 0; i < 32; ++i) { const int kk = 2 * i + (lane >> 5); scr[kk * 33 + (lane & 31)] = W[(size_t)(k0 + kk) * ldw + n0 + (lane & 31)]; }
    LDS_WAIT(); asm volatile("" ::: "memory");
    const int c = lane & 7;
#pragma unroll
    for (int j = 0; j < 4; ++j) { const int n = (lane >> 3) + 8 * j; const LAS float* s = scr + (8 * c) * 33 + n;
        u32x4 o; o.x = pk2(s[0 * 33] * scale, s[1 * 33] * scale); o.y = pk2(s[2 * 33] * scale, s[3 * 33] * scale); o.z = pk2(s[4 * 33] * scale, s[5 * 33] * scale); o.w = pk2(s[6 * 33] * scale, s[7 * 33] * scale);
        *(u32x4*)(dst + (size_t)n * ldd + k0 + 8 * c) = o; }
    LDS_WAIT(); asm volatile("" ::: "memory");
}
#ifndef MK_MODE
#define MK_MODE 1
#endif
#ifndef MK_LAST
#define MK_LAST 24
#endif
constexpr int NPHASE = 24;
struct Args { const float* in[31]; float* out; unsigned char* ws; int ph_lo, ph_hi, li, pad; };


struct TrJob { const float* src; unsigned char* dst; int ldw, k0, n0, ldd, esz; float scale; };
#define CAS __attribute__((address_space(4)))
constexpr float MOE_W1S = 32.f, MOE_W2S = 64.f, MOE_HS = 2.f;
__device__ __forceinline__ void tr_decode(int it, const CAS Args* ap_, unsigned char* ws, TrJob& J) {
#define TIN(k) ((const float*)(const GAS float*)ap_->in[k])
    int kb; J.scale = 1.f; J.esz = 2;
    if (it < 43008) { const int e = it / 5376, r = it % 5376, w = r / 1792, li = r % 1792; J.esz = 1;
        if (w < 2) { J.src = TIN(28 + w) + (size_t)e * 1024 * DFE; J.ldw = DFE; kb = li / 112; J.n0 = (li % 112) * 32; J.ldd = 1024; J.scale = MOE_W1S;
            J.dst = ws + WS_MOE1 + ((size_t)e * 7168 + 256 * (J.n0 / 128) + (J.n0 % 128) + 128 * w) * 1024; }
        else { J.src = TIN(30) + (size_t)e * DFE * 1024; J.ldw = 1024; kb = li / 32; J.n0 = (li % 32) * 32; J.ldd = DFE; J.scale = MOE_W2S; J.dst = ws + WS_MOE2 + ((size_t)e * 1024 + J.n0) * DFE; }
    } else if (it < 47232) { const int r = it - 43008, w = r / 1408, li = r % 1408;
        if (w < 2) { J.src = TIN(23 + w); J.ldw = DFF; kb = li / 88; J.n0 = (li % 88) * 32; J.ldd = 1024; J.dst = ws + WS_FFN1 + (size_t)(256 * (J.n0 / 128) + (J.n0 % 128) + 128 * w) * 1024 * 2; }
        else { J.src = TIN(25); J.ldw = 1024; kb = li / 32; J.n0 = (li % 32) * 32; J.ldd = DFF; J.dst = ws + WS_FFN2 + (size_t)J.n0 * DFF * 2; }
    } else { const int r = it - 47232, l = r / 4384, q = r % 4384;
        if (q < 3328) { const int t = q / 128, li = q % 128; kb = li / 8; const int nb = li % 8;
            const int srcc = t < 4 ? 256 * t : (t < 7 ? 256 * (t + 1) : (t < 23 ? 2304 + 256 * (t - 7) : (t == 23 ? 768 : (t == 24 ? 1024 : 2048))));
            J.src = TIN(7) + (size_t)l * 1024 * 6400; J.ldw = 6400; J.n0 = srcc + 32 * nb; J.ldd = 1024; J.dst = ws + WS_WIN + ((size_t)(l * 26 + t) * 256 + 32 * nb) * 1024 * 2; J.scale = (t == 3 || t == 23) ? 0.125f : 1.f; }
        else if (q < 3360) { const int li = q - 3328; kb = li / 8; J.n0 = (li % 8) * 32; J.src = TIN(16) + (size_t)l * 65536; J.ldw = 256; J.ldd = 256; J.dst = ws + WS_WGLU + ((size_t)l * 256 + J.n0) * 256 * 2; }
        else if (q < 3872) { const int li = q - 3360, bb = li / 128, li2 = li % 128; kb = li2 / 32; J.n0 = (li2 % 32) * 32; J.src = TIN(21) + (size_t)(l * 4 + bb) * 256 * 1024; J.ldw = 1024; J.ldd = 1024; J.dst = ws + WS_WBR + (((size_t)l * 1024 + J.n0) * 1024 + bb * 256) * 2; }
        else { const int li = q - 3872; kb = li / 32; J.n0 = (li % 32) * 32; J.src = TIN(22) + (size_t)l * 1024 * 1024; J.ldw = 1024; J.ldd = 1024; J.dst = ws + WS_WOUT + ((size_t)l * 1024 + J.n0) * 1024 * 2; }
    }
    J.k0 = kb * 64;
#undef TIN
}
__device__ __forceinline__ void tr_load(const TrJob& J, int lane, float (&v)[32]) {
#pragma unroll
    for (int i = 0; i < 32; ++i) { const int kk = 2 * i + (lane >> 5); v[i] = J.src[(size_t)(J.k0 + kk) * J.ldw + J.n0 + (lane & 31)]; } }
__device__ __forceinline__ void tr_store(const TrJob& J, int lane, const float (&v)[32], LAS float* scr) {
#pragma unroll
    for (int i = 0; i < 32; ++i) { const int kk = 2 * i + (lane >> 5); scr[kk * 33 + (lane & 31)] = v[i]; }
    LDS_WAIT(); asm volatile("" ::: "memory");
    const int c = lane & 7;
#pragma unroll
    for (int j = 0; j < 4; ++j) { const int n = (lane >> 3) + 8 * j; const LAS float* s = scr + (8 * c) * 33 + n; const float sc = J.scale;
        if (J.esz == 2) { u32x4 o; o.x = pk2(s[0 * 33] * sc, s[1 * 33] * sc); o.y = pk2(s[2 * 33] * sc, s[3 * 33] * sc); o.z = pk2(s[4 * 33] * sc, s[5 * 33] * sc); o.w = pk2(s[6 * 33] * sc, s[7 * 33] * sc);
            *(u32x4*)(J.dst + ((size_t)n * J.ldd + J.k0 + 8 * c) * 2) = o; }
        else { u32x2 o; o.x = pk4_f8(s[0 * 33] * sc, s[1 * 33] * sc, s[2 * 33] * sc, s[3 * 33] * sc); o.y = pk4_f8(s[4 * 33] * sc, s[5 * 33] * sc, s[6 * 33] * sc, s[7 * 33] * sc);
            *(u32x2*)(J.dst + (size_t)n * J.ldd + J.k0 + 8 * c) = o; } }
    LDS_WAIT(); asm volatile("" ::: "memory");
}

__device__ __forceinline__ void cs2pi(int m, int N, float& c, float& s) { sincospif(2.0f * (float)(m % N) / (float)N, &s, &c); }

__global__ void __launch_bounds__(NTHREADS, 2) mk_fwd(Args args) {
    extern __shared__ __attribute__((aligned(16))) unsigned char lds_raw[];
    LAS unsigned char* lds = (LAS unsigned char*)lds_raw;
    const int tid0 = threadIdx.x, wave = __builtin_amdgcn_readfirstlane(tid0 >> 6);
    const int G = gridDim.x, bx = blockIdx.x, vcu = (G % 8 == 0) ? (bx % 8) * (G / 8) + bx / 8 : bx;
    const int wslot = wave * G + vcu, NW = G * NWAVES;
    volatile LAS unsigned* lctl = (volatile LAS unsigned*)(lds + LDSCTL_OFF);
    for (int u = tid0; u < (LDS_BYTES - LDSCTL_OFF) / 4; u += NTHREADS) lctl[u] = 0u;
    __syncthreads();
    const int lo = args.ph_lo, hi = args.ph_hi, bli = args.li;
#ifdef MK_STAMP_PHASE
    if (wave == 0) *(volatile LAS unsigned long long*)(lctl + 64) = __builtin_amdgcn_s_memrealtime();
#endif
    { XcdBarrier b0 = xcd_barrier_post((unsigned*)(args.ws + WS_CTL) + CW_BAR + bli * XCD_BAR_WORDS, lctl + LW_BAR); (void)b0; }
#define IN(k) (lo <= (k) && (k) < hi)
#ifndef MK_DBL
#define MK_DBL 0
#endif
#define MK_NR(k) (MK_DBL == (k) ? 2 : 1)
#ifndef MK_REP_MASK
#define MK_REP_MASK 0u
#endif
#define NREP(k) (((MK_REP_MASK >> (k)) & 1u) ? 2 : 1)
#define FORCE_BAR do { PH_BEGIN XcdBarrier b_; b_.bar = (unsigned*)(ws + WS_CTL) + CW_BAR + bli * XCD_BAR_WORDS; b_.x = xb_xcc_id(); b_.st = lctl + LW_BAR; xcd_barrier(b_); } while (0)
#ifdef MK_STAMP_PHASE
#define STAMP_AT(k) do { if (wave == 0) { if ((k) == MK_STAMP_PHASE - 1) *(volatile LAS unsigned long long*)(lctl + 64) = __builtin_amdgcn_s_memrealtime(); if ((k) == MK_STAMP_PHASE) *(volatile LAS unsigned long long*)(lctl + 66) = __builtin_amdgcn_s_memrealtime(); } } while (0)
#else
#define STAMP_AT(k) do { } while (0)
#endif
#define SEAM(k) do { if (IN(k) && IN((k) + 1)) { PH_BEGIN XcdBarrier b_; b_.bar = (unsigned*)(ws + WS_CTL) + CW_BAR + bli * XCD_BAR_WORDS; b_.x = xb_xcc_id(); b_.st = lctl + LW_BAR; xcd_barrier(b_); } STAMP_AT(k); } while (0)
#define PH_BEGIN int tid; { int l_; asm volatile("v_mbcnt_lo_u32_b32 %0, -1, 0\n\tv_mbcnt_hi_u32_b32 %0, -1, %0" : "=v"(l_)); tid = wave * 64 + (l_ & 63); } const CAS Args* ap_ = (const CAS Args*)__builtin_amdgcn_kernarg_segment_ptr(); asm volatile("" : "+s"(ap_)); unsigned char* ws = (unsigned char*)(GAS unsigned char*)ap_->ws; const int lane = tid & 63; (void)lane;
#define AIN(k) ((const float*)(const GAS float*)ap_->in[k])
#define AOUT ((float*)(GAS float*)ap_->out)
#define MODp ((float*)(ws + CTL_MOD_OFF))
#define ctxbuf ((float*)(ws + WS_CTXBUF))
#define Hh ((bf16*)(ws + WS_H))
#define MIX ((bf16*)(ws + WS_MIX))
#define INP ((bf16*)(ws + WS_INP))
#define Tt ((bf16*)(ws + WS_T))

    for (int rep_ = 0; rep_ < NREP(0); ++rep_) if (IN(0)) { if (rep_) { FORCE_BAR; } PH_BEGIN
        for (int dd_ = 0; dd_ < MK_NR(20); ++dd_) for (int it = bx; it < 32; it += G) {
            const int l = it >> 4, g = it & 15;
            LAS f32x2* apow = (LAS f32x2*)lds; LAS f32x2* bbar = (LAS f32x2*)(lds + 8704); LAS f32x2* Cc = (LAS f32x2*)(lds + 16896); LAS float* Kt = (LAS float*)(lds + 25088);
            for (int dir = 0; dir < 2; ++dir) { const size_t pg = (size_t)(l * 2 + dir) * 16 + g;
                if (tid < 64) { const int p = tid;
                    const float are = AIN(8)[pg * 64 + p], aim = AIN(9)[pg * 64 + p], dt = expf(AIN(10)[pg]);
                    for (int t = 0; t <= 16; ++t) { const float mag = expf(are * dt * (float)t); float sn, cs; sincosf(aim * dt * (float)t, &sn, &cs); apow[t * 64 + p] = (f32x2){mag * cs, mag * sn}; }
                    const f32x2 a = apow[64 + p]; const float nr = a.x - 1.f, ni = a.y, den = 1.f / (are * are + aim * aim);
                    const float cr = (nr * are + ni * aim) * den, ci = (ni * are - nr * aim) * den;
                    for (int h = 0; h < 16; ++h) { const float br = AIN(11)[(pg * 64 + p) * 16 + h], bi = AIN(12)[(pg * 64 + p) * 16 + h]; bbar[p * 16 + h] = (f32x2){cr * br - ci * bi, cr * bi + ci * br}; }
                    *(f32x2*)((float*)(ws + WS_A16) + (pg * 64 + p) * 2) = apow[16 * 64 + p];
                }
                for (int i = tid; i < 1024; i += NTHREADS) Cc[i] = (f32x2){AIN(13)[pg * 1024 + i], AIN(14)[pg * 1024 + i]};
                __syncthreads();
                bf16* M1 = (bf16*)(ws + WS_S5M1) + ((size_t)(l * 16 + g) * 2 + dir) * 128 * 256;
                for (int v = tid; v < 4096; v += NTHREADS) { const int row = v >> 5, col0 = (v & 31) * 8, j = col0 >> 4, h0 = col0 & 15, p = row >> 1, ri = row & 1;
                    const f32x2 pw = apow[(dir == 0 ? 15 - j : j) * 64 + p]; float vals[8];
#pragma unroll
                    for (int hh = 0; hh < 8; ++hh) { const f32x2 bb = bbar[p * 16 + h0 + hh]; vals[hh] = ri ? pw.x * bb.y + pw.y * bb.x : pw.x * bb.x - pw.y * bb.y; }
                    *(bf16x8*)(M1 + ((((col0 >> 4) * 4 + (row >> 5)) * 64 + ((col0 >> 3) & 1) * 32 + (row & 31)) * 8)) = pack8(vals); }
                bf16* TAB = (bf16*)(ws + WS_S5TAB) + (size_t)(l * 16 + g) * 256 * 512;
                for (int v = tid; v < 4096; v += NTHREADS) { const int row = v >> 4, cv = v & 15, i = row >> 4, ho = row & 15; float vals[8];
#pragma unroll
                    for (int pp = 0; pp < 4; ++pp) { const int p = cv * 4 + pp; const f32x2 cc = Cc[ho * 64 + p];
                        const f32x2 pw = apow[(dir == 0 ? i + 1 : 16 - i) * 64 + p]; vals[2 * pp] = cc.x * pw.x - cc.y * pw.y; vals[2 * pp + 1] = -(cc.x * pw.y + cc.y * pw.x); }
                    { const int colt = 256 + dir * 128 + cv * 8; *(bf16x8*)(TAB + (((((row >> 7) * 32 + (colt >> 4)) * 4 + ((row >> 5) & 3)) * 64 + ((colt >> 3) & 1) * 32 + (row & 31)) * 8)) = pack8(vals); } }
                for (int e = tid; e < 4096; e += NTHREADS) { const int t = e >> 8, ho = (e >> 4) & 15, h = e & 15; float acc = 0.f;
#pragma unroll 8
                    for (int p = 0; p < 64; ++p) { const f32x2 cc = Cc[ho * 64 + p], pw = apow[t * 64 + p], bb = bbar[p * 16 + h];
                        const float xr = cc.x * pw.x - cc.y * pw.y, xi = cc.x * pw.y + cc.y * pw.x; acc += xr * bb.x - xi * bb.y; }
                    Kt[dir * 4096 + e] = acc; }
                __syncthreads();
            }
            for (int v = tid; v < 8192; v += NTHREADS) { const int row = v >> 5, col0 = (v & 31) * 8, i = row >> 4, ho = row & 15, j = col0 >> 4, h0 = col0 & 15; float vals[8];
#pragma unroll
                for (int hh = 0; hh < 8; ++hh) { const int h = h0 + hh;
                    vals[hh] = j < i ? Kt[(i - j) * 256 + ho * 16 + h] : (j > i ? Kt[4096 + (j - i) * 256 + ho * 16 + h] : Kt[ho * 16 + h] + Kt[4096 + ho * 16 + h] + (ho == h ? AIN(15)[l * 256 + g * 16 + h] : 0.f)); }
                *(bf16x8*)((bf16*)(ws + WS_S5TAB) + (size_t)(l * 16 + g) * 256 * 512 + (((((row >> 7) * 32 + (col0 >> 4)) * 4 + ((row >> 5) & 3)) * 64 + ((col0 >> 3) & 1) * 32 + (row & 31)) * 8)) = pack8(vals); }
            __syncthreads();
        }
        __syncthreads();
        for (int it = (bx >= 32 ? bx - 32 : bx + G - 32); it < 192; it += G) { const int l = it / 96, cb = it % 96, col = cb * 64 + lane, ks = wave;
            const float* wm = AIN(4) + ((size_t)l * 1024 + ks * 128) * 6144 + col; float a0 = 0.f, a1 = 0.f, a2 = 0.f;
#pragma unroll 8
            for (int k = 0; k < 128; ++k) { const float w = wm[(size_t)k * 6144]; const int kk = ks * 128 + k;
                const float c0 = AIN(1)[kk], c1 = AIN(1)[1024 + kk], c2 = AIN(3)[kk];
                a0 += w * (c0 / (1.f + __expf(-c0))); a1 += w * (c1 / (1.f + __expf(-c1))); a2 += w * (c2 / (1.f + __expf(-c2))); }
            LAS float* part = (LAS float*)lds;
            part[(wave * 3 + 0) * 64 + lane] = a0; part[(wave * 3 + 1) * 64 + lane] = a1; part[(wave * 3 + 2) * 64 + lane] = a2;
            __syncthreads();
            if (tid < 192) { const int i = tid >> 6, c = tid & 63; float sacc = AIN(5)[l * 6144 + cb * 64 + c];
#pragma unroll
                for (int w = 0; w < 8; ++w) sacc += part[(w * 3 + i) * 64 + c];
                MODp[(size_t)(l * 3 + i) * 6144 + cb * 64 + c] = sacc; }
            __syncthreads();
        }
        { LAS float* scr = (LAS float*)(lds + wave * 16384);
          unsigned* qh = (unsigned*)(ws + WS_CTL) + CW_QHEAD;
          int q = bx & 7, tries = 0;
#define TR_POP(dst) do { dst = -1; while (tries < 8) { unsigned b_ = 0u; if (lane == 0) b_ = __hip_atomic_fetch_add(qh + 64 * q, 2u, __ATOMIC_RELAXED, __HIP_MEMORY_SCOPE_AGENT); \
              b_ = (unsigned)__builtin_amdgcn_readfirstlane((int)b_); if (b_ < 7000u) { dst = q * 7000 + (int)b_; break; } q = (q + 1) & 7; ++tries; } } while (0)
#define TR_LOAD2(VA, VB, g_) do { TrJob j_; tr_decode(g_, ap_, ws, j_); tr_load(j_, lane, VA); tr_decode((g_) + (((g_) % 7000) + 1 < 7000 ? 1 : 0), ap_, ws, j_); tr_load(j_, lane, VB); } while (0)
#define TR_STORE2(VA, VB, g_) do { TrJob j_; tr_decode(g_, ap_, ws, j_); tr_store(j_, lane, VA, scr); if (((g_) % 7000) + 1 < 7000) { tr_decode((g_) + 1, ap_, ws, j_); tr_store(j_, lane, VB, scr); } } while (0)
          float a0[32], a1[32], b0[32], b1[32]; int s0, s1;
          TR_POP(s0); if (s0 >= 0) TR_LOAD2(a0, a1, s0);
          TR_POP(s1);
          while (s0 >= 0) {
              int s2, s3 = -1;
              if (s1 >= 0) TR_LOAD2(b0, b1, s1);
              TR_POP(s2);
              TR_STORE2(a0, a1, s0);
              if (s1 < 0) break;
              if (s2 >= 0) TR_LOAD2(a0, a1, s2);
              TR_POP(s3);
              TR_STORE2(b0, b1, s1);
              s0 = s2; s1 = s3;
          }
#undef TR_POP
#undef TR_LOAD2
#undef TR_STORE2
        }
        for (int v = wslot * 64 + lane; v < 32 * SEQ; v += NW * 64) { const int p = v >> 13, t = v & 8191; const float pos = (float)(p < 16 ? (t >> 6) : (t & 63));
            const float inv = 1.0f / powf(10000.f, (float)(p & 15) / 16.f); float sn, cs; sincosf(pos * inv, &sn, &cs);
            ((float*)(ws + WS_COST))[v] = cs; ((float*)(ws + WS_SINT))[v] = sn; ((float*)(ws + WS_COSN))[t * 32 + p] = cs; ((float*)(ws + WS_SINN))[t * 32 + p] = sn; }
        for (int v = wslot * 64 + lane; v < 192512; v += NW * 64) { float c, s;
            if (v < 32768) { const int ri = v >> 14, k1 = (v >> 7) & 127, l1 = v & 127; cs2pi(k1 * l1, 128, c, s); const float sc = 0.08838834764831845f;
                ((bf16*)(ws + WS_W128T))[v] = (bf16)(pk2(ri ? -s * sc : c * sc, 0.f) & 0xffffu); }
            else if (v < 40960) { const int u = v - 32768, l2 = u >> 7, k1 = u & 127; cs2pi(k1 * l2, 8192, c, s); ((float*)(ws + WS_TWC))[u] = c; ((float*)(ws + WS_TWS))[u] = s; }
            else if (v < 53248) { const int u = v - 40960, w = u >> 12, m = (u >> 6) & 63, cc = u & 63; cs2pi(m * cc, 64, c, s);
                ((bf16*)(ws + WS_FCT))[u] = (bf16)(pk2((w == 0 ? c : (w == 1 ? s : -s)) * 0.125f, 0.f) & 0xffffu); }
            else if (v < 61440) { const int u = v - 53248, w = u >> 12, k2 = (u >> 6) & 63, l2 = u & 63; cs2pi(k2 * l2, 64, c, s); ((bf16*)(ws + WS_W64T))[u] = (bf16)(pk2((w == 0 ? c : s) * 0.125f, 0.f) & 0xffffu); }
            else { const int u = v - 61440, w = u >> 16, k = (u >> 8) & 255, l = u & 255; cs2pi(k * l, 256, c, s); ((bf16*)(ws + WS_W256T))[u] = (bf16)(pk2((w == 0 ? c : s) * 0.0625f, 0.f) & 0xffffu); }
        }
    }
    SEAM(0);

    for (int rep_ = 0; rep_ < NREP(1); ++rep_) if (IN(1)) { if (rep_) { FORCE_BAR; } PH_BEGIN
        { NormCfg C{AIN(0), AIN(2), nullptr, nullptr, nullptr, nullptr, 0, nullptr, nullptr, 0, AIN(6), MODp, 1024, 0, Hh, R}; norm_rows(C, wslot, NW, lane); }
    }
    SEAM(1);

    for (int layer = 0; layer < 2; ++layer) {
        const int pb = 1 + 11 * layer;
        const int nM = layer == 0 ? 66 : 64;
        const int nrows = layer == 0 ? R : LROWS;
#define normg (AIN(6) + (size_t)layer * 4 * D)
        for (int rep_ = 0; rep_ < NREP(pb + 1); ++rep_) if (IN(pb + 1)) { if (rep_) { FORCE_BAR; } PH_BEGIN
            gp::SchedInprojA S{(const char*)Hh, (const char*)(ws + WS_WIN) + (size_t)layer * 26 * 256 * 2048, 66, G, bx, layer == 0 ? 32 : 0};
            gp::EpiInprojA E{INP, Tt, (unsigned char*)(ws + WS_GCTX)};
            gp::gemm_phase(lds, tid, 1024, 1024, 1024, S, E);
        }
        SEAM(pb + 1);
        for (int rep_ = 0; rep_ < NREP(pb + 2); ++rep_) if (IN(pb + 2)) { if (rep_) { FORCE_BAR; } PH_BEGIN
            LAS float* rpb = (LAS float*)(lds + 98304 + 4096);
            LAS unsigned char* wl = lds + wave * 12288;
            for (int i = tid; i < 1860; i += NTHREADS) rpb[i] = AIN(20)[layer * 1860 + i] * LOG2E;
            __syncthreads();
            const int nitA = 2224 + 64 + (layer == 0 ? 64 : 0);
            for (int it = wslot; it < nitA; it += NW) {
                if (it < 1056) s5_state_item((const bf16*)(ws + WS_S5M1) + (size_t)layer * 16 * 2 * 128 * 256, INP + (size_t)R * 256, (float*)(ws + WS_HLOC), it, lane);
                else if (it < 1584) ret_kv_item(Tt, Tt + (size_t)256 * R, (const float*)(ws + WS_COST), (const float*)(ws + WS_SINT), AIN(18) + layer * 8, (float*)(ws + WS_KV), it - 1056, lane);
                else if (it < 2096) fft1_item(INP, (const bf16*)(ws + WS_W128T), (const float*)(ws + WS_TWC), (const float*)(ws + WS_TWS), (bf16*)(ws + WS_FB), it - 1584, lane);
                else if (it < 2224) rope_item(INP + (size_t)2 * R * 256, INP + (size_t)3 * R * 256, (const float*)(ws + WS_COSN), (const float*)(ws + WS_SINN), it - 2096, lane);
                else if (it < 2288) { const int j = 1984 + (it - 2224); na_item(INP + (size_t)5 * R * 256, INP + (size_t)6 * R * 256, Tt + (size_t)512 * R, MIX, rpb, wl, false, j >> 10, (j >> 3) & 127, (j >> 1) & 3, j & 1, lane); }
                else { const int j = it - 2288; na_item(INP + (size_t)5 * R * 256, INP + (size_t)6 * R * 256, Tt + (size_t)512 * R, MIX, rpb, wl, true, j >> 5, 0, (j >> 3) & 3, j & 7, lane); }
            }
            __syncthreads();
        }
        SEAM(pb + 2);
        for (int rep_ = 0; rep_ < NREP(pb + 3); ++rep_) if (IN(pb + 3)) { if (rep_) { FORCE_BAR; } PH_BEGIN
            LAS float* rpb = (LAS float*)(lds + 98304 + 4096); LAS unsigned char* wl = lds + wave * 12288;
            for (int i = tid; i < 1860; i += NTHREADS) rpb[i] = AIN(20)[layer * 1860 + i] * LOG2E;
            __syncthreads();
            for (int vs = wslot; vs < 2048; vs += NW) {
                if (vs < 64) s5_scan_item((const float*)(ws + WS_A16) + (size_t)layer * 2 * 16 * 64 * 2, (const float*)(ws + WS_HLOC), (bf16*)(ws + WS_HIN), wl, vs, lane);
                else { const int j = vs - 64; na_item(INP + (size_t)5 * R * 256, INP + (size_t)6 * R * 256, Tt + (size_t)512 * R, MIX, rpb, wl, false, j >> 10, (j >> 3) & 127, (j >> 1) & 3, j & 1, lane);
                    if (vs >= 1024) ret_scan_item(AIN(18) + layer * 8, (const float*)(ws + WS_KV), (bf16*)(ws + WS_SPREV), vs - 1024, lane); }
            }
            __syncthreads();
        }
        SEAM(pb + 3);
        for (int rep_ = 0; rep_ < NREP(pb + 4); ++rep_) if (IN(pb + 4)) { if (rep_) { FORCE_BAR; } PH_BEGIN
            const int nit = 1056 + 2112 + 2048 + (layer == 0 ? 128 : 0);
            for (int it = wslot; it < nit; it += NW) {
                if (it < 1056) s5_out_item((const bf16*)(ws + WS_S5TAB) + (size_t)layer * 16 * 256 * 512, INP + (size_t)R * 256, (const bf16*)(ws + WS_HIN), (bf16*)(ws + WS_Z), it, lane);
                else if (it < 3168) ret_out_item(INP + (size_t)2 * R * 256, INP + (size_t)3 * R * 256, INP + (size_t)4 * R * 256, Tt + (size_t)256 * R, (const bf16*)(ws + WS_SPREV),
                                                 AIN(18) + layer * 8, AIN(19) + layer * 256, MIX, lds + wave * 12288, it - 1056, lane);
                else if (it < 5216) fft2_item((const bf16*)(ws + WS_FB), (const bf16*)(ws + WS_FCT), (const bf16*)(ws + WS_W64T), MIX, it - 3168, lane);
                else fftc_item(INP, (const bf16*)(ws + WS_FCT), (const bf16*)(ws + WS_W256T), MIX, it - 5216, lane);
            }
        }
        SEAM(pb + 4);
        for (int rep_ = 0; rep_ < NREP(pb + 5); ++rep_) if (IN(pb + 5)) { if (rep_) { FORCE_BAR; } PH_BEGIN
            { PH_BEGIN gp::SchedPlain S{(const char*)(ws + WS_Z), (const char*)(ws + WS_WGLU) + (size_t)layer * 256 * 512, (size_t)256 * 512, (size_t)256 * 512, nM, 1, G, bx, 4};
              gp::EpiGlu E{(const bf16*)(ws + WS_Z), MIX, AIN(17) + layer * 256};
              gp::gemm_phase(lds, tid, 256, 256, 256, S, E); }
            { PH_BEGIN gp::SchedPlain S{(const char*)Hh, (const char*)(ws + WS_WIN) + ((size_t)layer * 26 + 7) * 256 * 2048, (size_t)256 * 2048, (size_t)256 * 2048, 64, 16, G, bx, 16};
              gp::EpiGates E{(unsigned char*)(ws + WS_GATES)};
              gp::gemm_phase(lds, tid, 1024, 1024, 1024, S, E); }
        }
        SEAM(pb + 5);
        for (int rep_ = 0; rep_ < NREP(pb + 6); ++rep_) if (IN(pb + 6)) { if (rep_) { FORCE_BAR; } PH_BEGIN
            gp::SchedMerge S{(const char*)MIX, (const char*)(ws + WS_WBR) + (size_t)layer * 1024 * 2048, layer == 0 ? 32 : 0, G, bx};
            gp::EpiMerge E{(const unsigned char*)(ws + WS_GATES), (const unsigned char*)(ws + WS_GCTX), (bf16*)(ws + WS_Y), (bf16*)(ws + WS_YP)};
            gp::gemm_phase(lds, tid, 1024, 1024, 1024, S, E);
        }
        SEAM(pb + 6);
        for (int rep_ = 0; rep_ < NREP(pb + 7); ++rep_) if (IN(pb + 7)) { if (rep_) { FORCE_BAR; } PH_BEGIN
            gp::SchedSplit S{(const char*)(ws + WS_Y), (const char*)(ws + WS_WOUT) + (size_t)layer * 1024 * 2048, (size_t)256 * 2048, (size_t)256 * 2048, layer == 0 ? 16 : 0, 16, G, bx,
                             (const char*)(ws + WS_YP), (size_t)256 * 2048, (size_t)CROWS * 2048, 4};
            gp::EpiPlainSplit E{(bf16*)(ws + WS_YO), 1024, (float*)(ws + WS_PARTW), 16};
            gp::gemm_phase(lds, tid, 1024, 1024, 1024, S, E);
        }
        SEAM(pb + 7);
        for (int rep_ = 0; rep_ < NREP(pb + 8); ++rep_) if (IN(pb + 8)) { if (rep_) { FORCE_BAR; } PH_BEGIN
            if (layer == 0) {
                NormCfg C{AIN(0), AIN(2), AOUT, ctxbuf, (const bf16*)(ws + WS_YO), (const float*)(ws + WS_PARTW), 16, normg + D, MODp, 2048, normg + 2 * D, MODp, 4096, 3072, Hh, R};
                norm_rows(C, wslot, NW, lane);
            } else {
                LAS float* wrs = (LAS float*)lds; LAS int* rowinfo = (LAS int*)(lds + 32768); LAS unsigned* cntL = (LAS unsigned*)(lds + 32768 + 1024); LAS unsigned* baseL = cntL + 8;
                for (int i = tid; i < 2048; i += NTHREADS) ((LAS f32x4*)wrs)[i] = ((const f32x4*)AIN(26))[i];
                int* list = (int*)(ws + WS_LIST); float* routew = (float*)(ws + WS_ROUTEW);
                for (int grp = vcu; grp < 256; grp += G) {
                    if (tid < 8) cntL[tid] = 0u;
                    __syncthreads();
                    const int r0 = grp * 64 + wave * 8; const float* md = MODp + (size_t)(3 + (r0 < SEQ ? 0 : 1)) * 6144;
                    f32x4 gav[4], scv[4], shv[4]; row_ld_f32(md + 2048, lane, gav); row_ld_f32(md + 4096, lane, scv); row_ld_f32(md + 3072, lane, shv);
                    f32x4 xn[4]; u32x2 tn[4]; row_ld_f32(AOUT + (size_t)r0 * D, lane, xn);
#pragma unroll
                    for (int j = 0; j < 4; ++j) tn[j] = *(const u32x2*)((const bf16*)(ws + WS_YO) + (size_t)r0 * D + 256 * j + 4 * lane);
                    for (int rr = 0; rr < 8; ++rr) { const int r = r0 + rr;
                        f32x4 x[4], t[4], hh[4];
#pragma unroll
                        for (int j = 0; j < 4; ++j) { x[j] = xn[j]; t[j] = (f32x4){bflo(tn[j].x), bfhi(tn[j].x), bflo(tn[j].y), bfhi(tn[j].y)}; }
                        if (rr < 7) { row_ld_f32(AOUT + (size_t)(r + 1) * D, lane, xn);
#pragma unroll
                            for (int j = 0; j < 4; ++j) tn[j] = *(const u32x2*)((const bf16*)(ws + WS_YO) + (size_t)(r + 1) * D + 256 * j + 4 * lane); }
                        { f32x4 gAv[4]; row_ld_f32(normg + D, lane, gAv); const float rs = row_rstd(t);
#pragma unroll
                          for (int j = 0; j < 4; ++j) x[j] = x[j] + gav[j] * (t[j] * rs * gAv[j]); }
                        row_st_f32(AOUT + (size_t)r * D, lane, x);
                        { f32x4 gBv[4]; row_ld_f32(normg + 2 * D, lane, gBv); const float rs = row_rstd(x);
#pragma unroll
                          for (int j = 0; j < 4; ++j) hh[j] = x[j] * rs * gBv[j] * (scv[j] + 1.f) + shv[j]; }
#pragma unroll
                        for (int j = 0; j < 4; ++j) *(unsigned*)(ws + WS_H + (size_t)r * D + 256 * j + 4 * lane) = pk4_f8(hh[j][0], hh[j][1], hh[j][2], hh[j][3]);
                        float lg[8];
#pragma unroll
                        for (int e = 0; e < 8; ++e) lg[e] = 0.f;
#pragma unroll
                        for (int j = 0; j < 4; ++j)
#pragma unroll
                            for (int q = 0; q < 4; ++q) { const int k = 256 * j + 4 * lane + q; const f32x4 w0 = *(const LAS f32x4*)(wrs + k * 8), w1 = *(const LAS f32x4*)(wrs + k * 8 + 4); const float hv = hh[j][q];
                                lg[0] += hv * w0[0]; lg[1] += hv * w0[1]; lg[2] += hv * w0[2]; lg[3] += hv * w0[3]; lg[4] += hv * w1[0]; lg[5] += hv * w1[1]; lg[6] += hv * w1[2]; lg[7] += hv * w1[3]; }
#pragma unroll
                        for (int e = 0; e < 8; ++e) lg[e] = wave_sum(lg[e]) + AIN(27)[e];
                        int i0 = 0; float v0 = lg[0];
#pragma unroll
                        for (int e = 1; e < 8; ++e) if (lg[e] > v0) { v0 = lg[e]; i0 = e; }
                        int i1 = i0 == 0 ? 1 : 0; float v1 = i0 == 0 ? lg[1] : lg[0];
#pragma unroll
                        for (int e = 0; e < 8; ++e) if (e != i0 && lg[e] > v1) { v1 = lg[e]; i1 = e; }
                        const float w0 = 1.f / (1.f + __expf(v1 - v0)), w1 = 1.f - w0;
                        if (lane == 0) { const unsigned s0 = __hip_atomic_fetch_add(cntL + i0, 1u, __ATOMIC_RELAXED, __HIP_MEMORY_SCOPE_WORKGROUP), s1 = __hip_atomic_fetch_add(cntL + i1, 1u, __ATOMIC_RELAXED, __HIP_MEMORY_SCOPE_WORKGROUP);
                            LAS int* ri = rowinfo + (wave * 8 + rr) * 4; ri[0] = i0; ri[1] = (int)s0; ri[2] = i1; ri[3] = (int)s1; routew[(size_t)r * 2] = w0; routew[(size_t)r * 2 + 1] = w1; }
                        if (lane < 8) ((int*)(ws + WS_SMAP))[(size_t)r * 8 + lane] = -1;
                    }
                    __syncthreads();
                    if (tid < 8) baseL[tid] = __hip_atomic_fetch_add((unsigned*)(ws + WS_CTL) + CW_MOECNT + 64 * tid, cntL[tid], __ATOMIC_RELAXED, __HIP_MEMORY_SCOPE_AGENT);
                    __syncthreads();
                    if (tid < 64) { const LAS int* ri = rowinfo + tid * 4; const int r = grp * 64 + tid;
                        list[ri[0] * LCAP + (int)baseL[ri[0]] + ri[1]] = r * 2; list[ri[2] * LCAP + (int)baseL[ri[2]] + ri[3]] = r * 2 + 1; }
                    __syncthreads();
                }
            }
        }
        SEAM(pb + 8);
        LAS unsigned* mt = (LAS unsigned*)(lds + LDSCTL_OFF) + LW_MOE;
        if (layer == 1 && (IN(pb + 9) || IN(pb + 10))) { PH_BEGIN
            if (tid == 0) { unsigned off = 0u;
                for (int e = 0; e < 8; ++e) { const unsigned c = __hip_atomic_load((unsigned*)(ws + WS_CTL) + CW_MOECNT + 64 * e, __ATOMIC_RELAXED, __HIP_MEMORY_SCOPE_AGENT); const unsigned m = (c + 255u) >> 8; mt[e] = c; mt[8 + e] = m; mt[16 + e] = off; off += m; }
                mt[24] = off; const unsigned U = off * 4u, full = (U / (unsigned)G) * (unsigned)G, rem = U - full;
                if (rem != 0u && rem <= 32u && full != 0u) { mt[25] = full; mt[26] = rem; } else { mt[25] = U; mt[26] = 0u; } }
            __syncthreads();
        }
        for (int rep_ = 0; rep_ < NREP(pb + 9); ++rep_) if (IN(pb + 9)) { if (rep_) { FORCE_BAR; } PH_BEGIN
            if (layer == 0) {
                gp::SchedPlain S{(const char*)Hh, (const char*)(ws + WS_FFN1), (size_t)256 * 2048, (size_t)256 * 2048, 66, 22, G, bx, 16};
                gp::EpiSwiglu E{(bf16*)(ws + WS_HID), DFF, false};
                gp::gemm_phase(lds, tid, 1024, 1024, 1024, S, E);
            } else {
                gp::SchedMoe1 S{(const char*)(ws + WS_H), (const char*)(ws + WS_MOE1), (const int*)(ws + WS_LIST), mt, G, bx, 1024u};
                gp::EpiSwigluF8 E{ws + WS_MHID, DFE, true, 1.f / MOE_W1S, MOE_HS};
                gp::gemm_phase<gp::EpiSwigluF8, gp::SchedMoe1, true>(lds, tid, 1024, 512, 512, S, E);
            }
        }
        SEAM(pb + 9);
        for (int rep_ = 0; rep_ < NREP(pb + 10); ++rep_) if (IN(pb + 10)) { if (rep_) { FORCE_BAR; } PH_BEGIN
            if (layer == 0) {
                gp::SchedSplit S{(const char*)(ws + WS_HID), (const char*)(ws + WS_FFN2), (size_t)256 * DFF * 2, (size_t)256 * DFF * 2, 11, DFF / 64, G, bx,
                                 (const char*)(ws + WS_HID) + (size_t)64 * 256 * DFF * 2, (size_t)256 * DFF * 2, 0, 11};
                gp::EpiPlainSplit E{(bf16*)(ws + WS_FO), 1024, (float*)(ws + WS_PARTF), 11};
                gp::gemm_phase(lds, tid, DFF, DFF, DFF, S, E);
            } else {
                { gp::SchedMoe2 S{(const char*)(ws + WS_MHID), (const char*)(ws + WS_MOE2), mt, G, bx, (unsigned)DFE};
                  gp::EpiMoeDown E{(bf16*)(ws + WS_SLOT), (const int*)(ws + WS_LIST), (const float*)(ws + WS_ROUTEW), mt, 1.f / (MOE_HS * MOE_W2S)};
                  gp::gemm_phase<gp::EpiMoeDown, gp::SchedMoe2, true>(lds, tid, DFE, DFE / 2, DFE / 2, S, E); }
                { PH_BEGIN gp::SchedMoe2S S{(const char*)(ws + WS_MHID), (const char*)(ws + WS_MOE2), mt, G, bx, (unsigned)DFE};
                  gp::EpiMoePart E{(bf16*)(ws + WS_PARTM), (const int*)(ws + WS_LIST), mt, (int*)(ws + WS_SMAP), 1.f / (MOE_HS * MOE_W2S)};
                  gp::gemm_phase<gp::EpiMoePart, gp::SchedMoe2S, true>(lds, tid, DFE, DFE / 2, DFE / 2, S, E); }
            }
        }
        SEAM(pb + 10);
        for (int rep_ = 0; rep_ < NREP(pb + 11); ++rep_) if (IN(pb + 11)) { if (rep_) { FORCE_BAR; } PH_BEGIN
            if (layer == 0) { PH_BEGIN NormCfg C{AOUT, ctxbuf, AOUT, ctxbuf, (const bf16*)(ws + WS_FO), (const float*)(ws + WS_PARTF), 11, normg + 3 * D, MODp, 5120, AIN(6) + 4 * D, MODp + 3 * 6144, 1024, 0, Hh, R};
                norm_rows(C, wslot, NW, lane); }
            else { PH_BEGIN for (int r = wslot; r < nrows; r += NW) { const int ci = r < SEQ ? 0 : (r < LROWS ? 1 : 2); const float* md = MODp + (size_t)(layer * 3 + ci) * 6144;
                float* xp = r < LROWS ? AOUT + (size_t)r * D : ctxbuf + (size_t)(r - LROWS) * D;
                f32x4 x[4], t[4]; row_ld_f32(xp, lane, x);
                if (layer == 0) { if (r < LROWS) row_ld_bf16((const bf16*)(ws + WS_FO) + (size_t)r * D, lane, t); else row_ld_part((const float*)(ws + WS_PARTF), 11, r, lane, t); }
                else { typedef int i32x4 __attribute__((ext_vector_type(4)));
                    const i32x4 m0 = *(const i32x4*)((const int*)(ws + WS_SMAP) + (size_t)r * 8), m1 = *(const i32x4*)((const int*)(ws + WS_SMAP) + (size_t)r * 8 + 4);
                    if ((m0.x & m0.y & m0.z & m0.w & m1.x & m1.y & m1.z & m1.w) == -1) {
                        f32x4 t2[4]; row_ld_bf16((const bf16*)(ws + WS_SLOT) + (size_t)r * D, lane, t); row_ld_bf16((const bf16*)(ws + WS_SLOT) + ((size_t)LROWS + r) * D, lane, t2);
#pragma unroll
                        for (int j = 0; j < 4; ++j) t[j] = t[j] + t2[j];
                    } else {
#pragma unroll
                        for (int j = 0; j < 4; ++j) t[j] = (f32x4){0.f, 0.f, 0.f, 0.f};
#pragma unroll
                        for (int k = 0; k < 2; ++k) { const int ent = 2 * r + k; const i32x4 mk = k ? m1 : m0;
#pragma unroll
                            for (int j = 0; j < 4; ++j) { const int mm = j == 0 ? mk.x : (j == 1 ? mk.y : (j == 2 ? mk.z : mk.w));
                                if (mm < 0) { const u32x2 w = *(const u32x2*)((const bf16*)(ws + WS_SLOT) + ((size_t)k * LROWS + r) * D + 256 * j + 4 * lane); t[j] = t[j] + (f32x4){bflo(w.x), bfhi(w.x), bflo(w.y), bfhi(w.y)}; }
                                else { const bf16* pp = (const bf16*)(ws + WS_PARTM) + ((size_t)(mm >> 8) * 7 * 256 + (mm & 255)) * 256 + 4 * lane; f32x4 sacc = (f32x4){0.f, 0.f, 0.f, 0.f};
                                    for (int sl = 0; sl < 7; ++sl) { const u32x2 w = *(const u32x2*)(pp + (size_t)sl * 65536); sacc = sacc + (f32x4){bflo(w.x), bfhi(w.x), bflo(w.y), bfhi(w.y)}; }
                                    t[j] = t[j] + sacc * ((const float*)(ws + WS_ROUTEW))[ent]; } } } } }
                row_resid(x, t, normg + 3 * D, md + 5120, lane); row_st_f32(xp, lane, x);
                } }
        }
        SEAM(pb + 11);
    }
#ifdef MK_STAMP_PHASE
    if (MK_STAMP_PHASE == NPHASE - 1 && wave == 0) *(volatile LAS unsigned long long*)(lctl + 66) = __builtin_amdgcn_s_memrealtime();
    if (blockIdx.x == 0 && wave == 0) { const unsigned long long st0_ = *(volatile LAS unsigned long long*)(lctl + 64), st1_ = *(volatile LAS unsigned long long*)(lctl + 66); const unsigned long long target = __builtin_amdgcn_s_memrealtime() + (unsigned long long)MK_STAMP_AMP * (st1_ - st0_); while (__builtin_amdgcn_s_memrealtime() < target) __builtin_amdgcn_s_sleep(20); }
#endif
#ifdef MK_EXTRA_BARS
    for (int xb_ = 0; xb_ < MK_EXTRA_BARS; ++xb_) { FORCE_BAR; }
#endif
#undef IN
#undef SEAM
#undef PH_BEGIN
#undef normg
#undef AIN
#undef AOUT
#undef MODp
#undef ctxbuf
#undef Hh
#undef MIX
#undef INP
#undef Tt
}

__global__ void dumpk(const unsigned char* src, size_t nbytes, int isf32, float* out, size_t N, int accum) {
    const size_t i = (size_t)blockIdx.x * blockDim.x + threadIdx.x; if (i >= N) return;
    const size_t ne = isf32 ? nbytes / 4 : nbytes / 2; float s = 0.f;
    for (size_t k = i; k < ne; k += N) s += isf32 ? ((const float*)src)[k] : bf2f(((const bf16*)src)[k]);
    out[i] = accum ? out[i] + s : s;
}
extern "C" void kernel_launch(void* const* d_in, const int* in_sizes, int n_in, void* d_out, int out_size, void* d_ws, size_t ws_size, hipStream_t stream) {
    static int grid = 0;
    if (grid == 0) {
        if (n_in != 31 || out_size != LROWS * D || ws_size < WS_END) { fprintf(stderr, "kernel_launch: unexpected shapes (n_in %d, out %d, ws %zu < %zu)\n", n_in, out_size, ws_size, (size_t)WS_END); grid = -1; return; }
        int dev = 0, cus = 0, per_cu = 0;
        if (hipGetDevice(&dev) != hipSuccess || hipDeviceGetAttribute(&cus, hipDeviceAttributeMultiprocessorCount, dev) != hipSuccess) { grid = -1; return; }
        if (hipFuncSetAttribute((const void*)mk_fwd, hipFuncAttributeMaxDynamicSharedMemorySize, LDS_BYTES) != hipSuccess) { fprintf(stderr, "kernel_launch: hipFuncSetAttribute failed\n"); grid = -1; return; }
        if (hipOccupancyMaxActiveBlocksPerMultiprocessor(&per_cu, (const void*)mk_fwd, NTHREADS, LDS_BYTES) != hipSuccess || per_cu < 1) { fprintf(stderr, "kernel_launch: occupancy query says %d\n", per_cu); }
        (void)hipGetLastError();
        grid = cus;
    }
    if (grid < 0) return;
    (void)hipMemsetAsync((char*)d_ws + WS_CTL, 0, CTL_ZERO_BYTES, stream);
    Args a{};
    for (int i = 0; i < 31; ++i) a.in[i] = (const float*)d_in[i];
    a.out = (float*)d_out; a.ws = (unsigned char*)d_ws;
#if MK_MODE == 1
    a.ph_lo = 0; a.ph_hi = NPHASE; a.li = 0;
    hipLaunchKernelGGL(mk_fwd, dim3(grid), dim3(NTHREADS), LDS_BYTES, stream, a);
#else
    for (int p = 0; p < MK_LAST; ++p) { a.ph_lo = p; a.ph_hi = p + 1; a.li = p; hipLaunchKernelGGL(mk_fwd, dim3(grid), dim3(NTHREADS), LDS_BYTES, stream, a); }
#endif
#ifdef MK_DUMP_OFF
    dumpk<<<(LROWS * D + 255) / 256, 256, 0, stream>>>((const unsigned char*)d_ws + (size_t)(MK_DUMP_OFF), (size_t)(MK_DUMP_BYTES), MK_DUMP_F32, (float*)d_out, (size_t)LROWS * D, 0);
#endif
#ifdef MK_DUMP2_OFF
    dumpk<<<(LROWS * D + 255) / 256, 256, 0, stream>>>((const unsigned char*)d_ws + (size_t)(MK_DUMP2_OFF), (size_t)(MK_DUMP2_BYTES), MK_DUMP2_F32, (float*)d_out, (size_t)LROWS * D, 1);
#endif
#ifdef MK_DUMP3_OFF
    dumpk<<<(LROWS * D + 255) / 256, 256, 0, stream>>>((const unsigned char*)d_ws + (size_t)(MK_DUMP3_OFF), (size_t)(MK_DUMP3_BYTES), MK_DUMP3_F32, (float*)d_out, (size_t)LROWS * D, 1);
#endif
}
```

```cpp
#define MK_MODE 1
#include <hip/hip_runtime.h>
#include <cstdio>
#include <cstdint>

#define GAS __attribute__((address_space(1)))
#define LAS __attribute__((address_space(3)))
typedef unsigned short bf16;
typedef short bf16x8 __attribute__((ext_vector_type(8)));
typedef short bf16x4 __attribute__((ext_vector_type(4)));
typedef float f32x2 __attribute__((ext_vector_type(2)));
typedef float f32x4 __attribute__((ext_vector_type(4)));
typedef float f32x16 __attribute__((ext_vector_type(16)));
typedef unsigned u32x2 __attribute__((ext_vector_type(2)));
typedef unsigned u32x4 __attribute__((ext_vector_type(4)));

constexpr int D = 1024, SEQ = 8192, LROWS = 16384, CTXL = 256, CROWS = 512, R = 16896;
constexpr int DFF = 2816, DFE = 3584, NEXP = 8, LCAP = 16640;
constexpr int NWAVES = 8, NTHREADS = 512;
constexpr int NCH16 = R / 16;
constexpr float EPSN = 1e-6f, LOG2E = 1.4426950408889634f;

constexpr size_t MiB = 1u << 20;
constexpr size_t WS_CTL = 0, CTL_ZERO_BYTES = 1 * MiB;
constexpr int CW_TMO = 0, CW_BAR = 4096, CW_MOECNT = 98304, CW_QHEAD = 100352, CW_MQ = 102400;
constexpr size_t CTL_MOD_OFF = 512 * 1024;
constexpr size_t WS_CTXBUF = 1 * MiB;
constexpr size_t WS_COST = 3 * MiB, WS_SINT = 4 * MiB, WS_COSN = 5 * MiB, WS_SINN = 6 * MiB;
constexpr size_t WS_LIST = 7 * MiB;
constexpr size_t WS_ROUTEW = WS_LIST + 8 * LCAP * 4;
constexpr size_t WS_S5K = 8 * MiB;
constexpr size_t WS_A16 = 9 * MiB;
constexpr size_t WS_W128T = WS_A16 + 64 * 1024;
constexpr size_t WS_TWC = WS_W128T + 64 * 1024, WS_TWS = WS_TWC + 32 * 1024;
constexpr size_t WS_FCT = WS_TWS + 32 * 1024;
constexpr size_t WS_W64T = WS_FCT + 32 * 1024;
constexpr size_t WS_W256T = WS_W64T + 32 * 1024;
constexpr size_t WS_MOE1 = 10 * MiB;
constexpr size_t WS_WG8 = 66 * MiB;
constexpr size_t WS_H8 = 74 * MiB;
constexpr size_t WS_MOE2 = 122 * MiB;
constexpr size_t WS_OTHERW = 178 * MiB;
constexpr size_t WS_WIN = 178 * MiB;
constexpr size_t WS_WBR = 204 * MiB;
constexpr size_t WS_WOUT = 208 * MiB;
constexpr size_t WS_WGLU = 212 * MiB;
constexpr size_t WS_FFN1 = 213 * MiB;
constexpr size_t WS_FFN2 = 224 * MiB;
constexpr size_t WS_S5M1 = 230 * MiB;
constexpr size_t WS_S5TAB = 234 * MiB;
constexpr size_t WS_BIG = 242 * MiB;
constexpr size_t TOK256 = (size_t)R * 256 * 2;
constexpr size_t WS_INP = WS_BIG;
constexpr size_t WS_T = WS_INP + 7 * TOK256;
constexpr size_t WS_HLOC = WS_T + 3 * TOK256;
constexpr size_t WS_HIN = WS_HLOC + 2 * TOK256;
constexpr size_t WS_KV = WS_HIN + TOK256;
constexpr size_t WS_SPREV = WS_KV + 2 * TOK256;
constexpr size_t WS_FB = WS_SPREV + TOK256;
constexpr size_t WS_GATES = WS_BIG;
constexpr size_t WS_Y = WS_BIG + 132 * MiB;
constexpr size_t WS_YO = WS_Y + 33 * MiB;
constexpr size_t WS_Z = WS_YO + 33 * MiB;
constexpr size_t WS_YP = WS_Z;
constexpr size_t WS_PARTW = WS_BIG;
constexpr size_t WS_PARTF = 340 * MiB;
constexpr size_t WS_PARTM = 416 * MiB;
constexpr size_t WS_SMAP = WS_S5K;
constexpr size_t WS_FO = WS_Y;
constexpr size_t WS_HID = WS_BIG;
constexpr size_t WS_MHID = WS_OTHERW;
constexpr size_t WS_H = 449 * MiB;
constexpr size_t WS_MIX = 482 * MiB;
constexpr size_t WS_SLOT = WS_H;
constexpr size_t WS_GCTX = 515 * MiB;
constexpr size_t WS_END = 519 * MiB;
static_assert(WS_FB + 16 * MiB <= WS_Z && WS_Z + TOK256 <= WS_H && WS_MHID + (size_t)34816 * 3584 * 2 <= WS_H && WS_W256T + 256 * 1024 <= WS_MOE1, "ws map");
static_assert(WS_PARTM + (size_t)32 * 7 * 65536 * 2 <= WS_H && WS_MHID + (size_t)34816 * 3584 * 2 <= WS_PARTM, "ws map 3");
static_assert(WS_S5TAB + 8 * MiB <= WS_BIG && WS_FFN2 + (size_t)1024 * 2816 * 2 <= WS_S5M1 && WS_ROUTEW + 32768 * 4 <= WS_S5K, "ws map 2");

constexpr int RING_BYTES = 131072, LDSCTL_OFF = RING_BYTES, LDS_BYTES = 147456;
constexpr int LW_BAR = 8, LW_MOE = 16;

#define VM_WAIT() asm volatile("s_waitcnt vmcnt(0)" ::: "memory")
#define LDS_WAIT() asm volatile("s_waitcnt lgkmcnt(0)" ::: "memory")
typedef __bf16 bf16n2 __attribute__((ext_vector_type(2)));
__device__ __forceinline__ unsigned pk2(float lo, float hi) { bf16n2 v; v.x = (__bf16)lo; v.y = (__bf16)hi; return __builtin_bit_cast(unsigned, v); }
__device__ __forceinline__ unsigned pk4_f8(float a, float b, float c, float d) { int w = 0; w = __builtin_amdgcn_cvt_pk_fp8_f32(a, b, w, false); w = __builtin_amdgcn_cvt_pk_fp8_f32(c, d, w, true); return (unsigned)w; }
__device__ __forceinline__ float bf2f(unsigned short b) { return __builtin_bit_cast(float, ((unsigned)b) << 16); }
__device__ __forceinline__ float bflo(unsigned w) { return __builtin_bit_cast(float, w << 16); }
__device__ __forceinline__ float bfhi(unsigned w) { return __builtin_bit_cast(float, w & 0xffff0000u); }
__device__ __forceinline__ float ex2(float x) { return __builtin_amdgcn_exp2f(x); }
__device__ __forceinline__ float rcpf_(float x) { return __builtin_amdgcn_rcpf(x); }
__device__ __forceinline__ float sigm(float x) { return rcpf_(1.f + ex2(-LOG2E * x)); }
__device__ __forceinline__ float silu_(float x) { return x * sigm(x); }
__device__ __forceinline__ float gelu_tanh(float x) { const float u = 0.7978845608028654f * (x + 0.044715f * x * x * x); const float t = 1.f - 2.f * rcpf_(1.f + ex2(2.885390081777927f * u)); return 0.5f * x * (1.f + t); }
__device__ __forceinline__ float xor32_sum(float v) { const unsigned u = __builtin_bit_cast(unsigned, v); const auto r = __builtin_amdgcn_permlane32_swap(u, u, false, false); return __builtin_bit_cast(float, (unsigned)r[0]) + __builtin_bit_cast(float, (unsigned)r[1]); }
__device__ __forceinline__ float xor32_max(float v) { const unsigned u = __builtin_bit_cast(unsigned, v); const auto r = __builtin_amdgcn_permlane32_swap(u, u, false, false); return fmaxf(__builtin_bit_cast(float, (unsigned)r[0]), __builtin_bit_cast(float, (unsigned)r[1])); }
template <int X> __device__ __forceinline__ float swz_xor(float v) { return __builtin_bit_cast(float, __builtin_amdgcn_ds_swizzle(__builtin_bit_cast(int, v), (X << 10) | 0x1f)); }
__device__ __forceinline__ float wave_sum(float v) { v += swz_xor<1>(v); v += swz_xor<2>(v); v += swz_xor<4>(v); v += swz_xor<8>(v); v += swz_xor<16>(v); return xor32_sum(v); }
__device__ __forceinline__ f32x16 mma32(bf16x8 a, bf16x8 b, f32x16 c) { return __builtin_amdgcn_mfma_f32_32x32x16_bf16(a, b, c, 0, 0, 0); }
__device__ __forceinline__ bf16x8 ldg8(const bf16* p) { return *(const bf16x8*)p; }
__device__ __forceinline__ bf16x8 ldg8p(const bf16* p) { const bf16x4 lo = *(const bf16x4*)p, hi = *(const bf16x4*)(p + 8); return __builtin_shufflevector(lo, hi, 0, 1, 2, 3, 4, 5, 6, 7); }
template <int S> __device__ __forceinline__ bf16x8 accB(const f32x16& c) {
    u32x4 w; w.x = pk2(c[8 * S + 0], c[8 * S + 1]); w.y = pk2(c[8 * S + 2], c[8 * S + 3]); w.z = pk2(c[8 * S + 4], c[8 * S + 5]); w.w = pk2(c[8 * S + 6], c[8 * S + 7]);
    return __builtin_bit_cast(bf16x8, w);
}
__device__ __forceinline__ bf16x8 pack8(const float (&v)[8]) { u32x4 w; w.x = pk2(v[0], v[1]); w.y = pk2(v[2], v[3]); w.z = pk2(v[4], v[5]); w.w = pk2(v[6], v[7]); return __builtin_bit_cast(bf16x8, w); }
__device__ __forceinline__ void unpack8(const bf16x8 x, float (&v)[8]) { const u32x4 w = __builtin_bit_cast(u32x4, x); v[0] = bflo(w.x); v[1] = bfhi(w.x); v[2] = bflo(w.y); v[3] = bfhi(w.y); v[4] = bflo(w.z); v[5] = bfhi(w.z); v[6] = bflo(w.w); v[7] = bfhi(w.w); }
__device__ __forceinline__ f32x16 zero16() { f32x16 z;
#pragma unroll
    for (int i = 0; i < 16; ++i) z[i] = 0.f;
    return z; }

#define XB_TMO      128
#define XB_XCNT(j)  (256  + 64 * (j))
#define XB_XSUB(j)  (1280 + 64 * (j))
#define XB_XGEN(j)  (2304 + 64 * (j))
#define XB_TOP      3328
#define XB_TOPGEN   3392
#define XCD_BAR_WORDS 3456
#define XB_SPIN_CAP (1u << 18)
__device__ __forceinline__ unsigned xb_ld(unsigned* p)              { return __hip_atomic_load(p, __ATOMIC_RELAXED, __HIP_MEMORY_SCOPE_AGENT); }
__device__ __forceinline__ unsigned xb_add(unsigned* p, unsigned v) { return __hip_atomic_fetch_add(p, v, __ATOMIC_RELAXED, __HIP_MEMORY_SCOPE_AGENT); }
__device__ __forceinline__ unsigned xb_xcc_id() { return (unsigned)__builtin_amdgcn_s_getreg((3 << 11) | 20) & 0xFu; }
#define XB_SPIN(cond, bar) do { unsigned _sp = 0; while (cond) { __builtin_amdgcn_s_sleep(1); \
    if ((++_sp & 255u) == 0u) { if (xb_ld(&(bar)[XB_TMO])) break; if (_sp > XB_SPIN_CAP) { atomicAdd(&(bar)[XB_TMO], 1u); break; } } } } while (0)
struct XcdBarrier { unsigned* bar; unsigned x; volatile LAS unsigned* st; };
__device__ __forceinline__ XcdBarrier xcd_barrier_post(unsigned* bar, volatile LAS unsigned* st) {
    XcdBarrier b; b.bar = bar; b.x = xb_xcc_id(); b.st = st;
    if (threadIdx.x == 0) (void)xb_add(&bar[XB_XCNT(b.x)], 1u);
    return b;
}
__device__ __forceinline__ void xcd_barrier_complete(unsigned* bar, unsigned x, unsigned& nloc, unsigned& nx) {
    const unsigned G = gridDim.x * gridDim.y * gridDim.z;
    unsigned sum, cnt, mine, sp = 0u;
    for (;;) {
        sum = 0u; cnt = 0u; mine = 0u;
#pragma unroll
        for (unsigned j = 0; j < 16; ++j) { const unsigned c = xb_ld(&bar[XB_XCNT(j)]); sum += c; cnt += (c > 0u) ? 1u : 0u; mine = (j == x) ? c : mine; }
        if (sum == G) break;
        __builtin_amdgcn_s_sleep(1);
        if ((++sp & 255u) == 0u) { if (xb_ld(&bar[XB_TMO])) break; if (sp > XB_SPIN_CAP) { atomicAdd(&bar[XB_TMO], 1u); break; } }
    }
    nloc = mine > 0u ? mine : 1u; nx = cnt > 0u ? cnt : 1u;
}
__device__ __forceinline__ void xcd_barrier(const XcdBarrier& b) {
    asm volatile("s_waitcnt vmcnt(0)" ::: "memory");
    __syncthreads();
    if (threadIdx.x == 0) {
        unsigned* bar = b.bar;
        __builtin_amdgcn_s_waitcnt(0);
        unsigned nloc = b.st[0], nx = b.st[1];
        if (nloc == 0u) { xcd_barrier_complete(bar, b.x, nloc, nx); b.st[0] = nloc; b.st[1] = nx; }
        const unsigned old = xb_add(&bar[XB_XSUB(b.x)], 1u);
        const unsigned gen = old / nloc;
        if (old + 1u == (gen + 1u) * nloc) {
            __builtin_amdgcn_fence(__ATOMIC_RELEASE, "agent");
            asm volatile("s_waitcnt vmcnt(0)" ::: "memory");
            const unsigned og = xb_add(&bar[XB_TOP], 1u);
            const unsigned tg = og / nx;
            if (og + 1u == (tg + 1u) * nx) xb_add(&bar[XB_TOPGEN], 1u);
            else XB_SPIN(xb_ld(&bar[XB_TOPGEN]) == tg, bar);
            __builtin_amdgcn_fence(__ATOMIC_ACQUIRE, "agent");
            xb_add(&bar[XB_XGEN(b.x)], 1u);
            asm volatile("s_waitcnt vmcnt(0)" ::: "memory");
        } else {
            XB_SPIN(xb_ld(&bar[XB_XGEN(b.x)]) == gen, bar);
            __builtin_amdgcn_fence(__ATOMIC_ACQUIRE, "agent");
            asm volatile("s_waitcnt vmcnt(0)" ::: "memory");
        }
    }
    __syncthreads();
}
namespace gp {
constexpr int BM = 256, BK = 64, HALF = 128, HTB = HALF * BK * 2, STAGE_BYTES = 8 * HTB, NXCD = 8, WGM = 8;
__device__ __forceinline__ int lds_byte(int r, int c) { const int st = (r >> 4) * 2 + (c >> 5), rr = r & 15, cc = c & 31, ob = rr * 64 + cc * 2; return st * 1024 + (ob ^ (((ob >> 9) & 1) << 5)); }
__device__ __forceinline__ void stage_rc(int b, int& Rr, int& C) { const int st = b / 1024, sb = b % 1024, swz = sb ^ (((sb >> 9) & 1) << 5); Rr = (st >> 1) * 16 + swz / 64; C = (st & 1) * 32 + (swz % 64) / 2; }
__device__ __forceinline__ int perm32(int rho) { const int n = rho >> 4, i = rho & 15; return 8 * (i >> 2) + 4 * n + (i & 3); }

struct Unit { const char* a; const char* b; int e0, e1, e2, e3, nt; };

__device__ __forceinline__ void tile_of(int L, int nM, int nN, int& pm, int& pn) {
    const int nwg = nM * nN; int wgid = L;
    { const int q = nwg / NXCD, r = nwg % NXCD, xcd = wgid % NXCD, off = wgid / NXCD; wgid = (xcd < r ? xcd * (q + 1) : r * (q + 1) + (xcd - r) * q) + off; }
    const int nig = WGM * nN, gid = wgid / nig, fm = gid * WGM, gsz = (nM - fm) < WGM ? (nM - fm) : WGM;
    pm = fm + ((wgid % nig) % gsz); pn = (wgid % nig) / gsz;
}

typedef int i32x8 __attribute__((ext_vector_type(8)));
typedef int i32x4v __attribute__((ext_vector_type(4)));
__device__ __forceinline__ i32x8 cat8(const bf16x8 a, const bf16x8 b) { const i32x4v x = __builtin_bit_cast(i32x4v, a), y = __builtin_bit_cast(i32x4v, b); return __builtin_shufflevector(x, y, 0, 1, 2, 3, 4, 5, 6, 7); }
__device__ __forceinline__ void mfma_f8(f32x4& acc, const i32x8 a, const i32x8 b) { asm volatile("s_nop 1\n\tv_mfma_f32_16x16x128_f8f6f4 %0, %1, %2, %0" : "+v"(acc) : "v"(a), "v"(b)); }
template <class Epi, class Sched, bool F8 = false>
__device__ __forceinline__ void gemm_phase(LAS unsigned char* lds, const int tid, const int K, const int lda, const int ldb, const Sched& S, const Epi& E) {
    constexpr bool GATHER = Sched::GATHER;
    const int wid = __builtin_amdgcn_readfirstlane(tid >> 6), lane = tid & 63, wr = wid >> 2, wc = wid & 3, fr = lane & 15, fq = lane >> 4;
    unsigned voffA[2], voffB[2];
#pragma unroll
    for (int i = 0; i < 2; ++i) { int Rr, C; stage_rc(tid * 16 + i * 8192, Rr, C); const int Rb = (Rr & ~31) + perm32(Rr & 31);
        voffA[i] = (unsigned)(Rr * lda + C) * 2u; voffB[i] = (unsigned)(Rb * ldb + C) * 2u; }
#define PG8_GOFF(dst, unit) do { _Pragma("unroll") for (int _h = 0; _h < 2; ++_h) _Pragma("unroll") for (int _i = 0; _i < 2; ++_i) { int _R, _C; stage_rc(tid * 16 + _i * 8192, _R, _C); dst[_h][_i] = S.rowoff(unit, _R + _h * HALF) + (unsigned)_C * 2u; } } while (0)
    const size_t kstep = (size_t)(BK * 2);
    const unsigned hstepA = (unsigned)HALF * (unsigned)lda * 2u; const size_t hstepB = (size_t)HALF * ldb * 2;
    const unsigned ldsw = (unsigned)wid * 1024u;
    const int aoff = lds_byte(wr * 64 + fr, fq * 8), boff = lds_byte(wc * 32 + fr, fq * 8);
#define PG8_SA(b, h) (((b) * 2 + (h)) * HTB)
#define PG8_SB(b, h) ((4 + (b) * 2 + (h)) * HTB)
#define PG8_STB(bufoff, gbase, hh) do { const char* _gb = (const char*)(gbase) + (size_t)(hh) * hstepB; _Pragma("unroll") for (int _i = 0; _i < 2; ++_i) \
        __builtin_amdgcn_global_load_lds((const unsigned*)(_gb + voffB[_i]), (LAS unsigned*)(lds + (bufoff) + ldsw + _i * 8192), 16, 0, 0); } while (0)
#define PG8_STA(bufoff, gbase, hh, VG) do { const char* _ga = (const char*)(gbase) + (GATHER ? (size_t)0 : (size_t)(hh) * hstepA); _Pragma("unroll") for (int _i = 0; _i < 2; ++_i) { const unsigned _o = GATHER ? (VG) : voffA[_i]; \
        __builtin_amdgcn_global_load_lds((const unsigned*)(_ga + _o), (LAS unsigned*)(lds + (bufoff) + ldsw + _i * 8192), 16, 0, 0); } } while (0)
#define PG8_LDA(dst, b, h) do { _Pragma("unroll") for (int m = 0; m < 4; ++m) _Pragma("unroll") for (int k = 0; k < 2; ++k) dst[m][k] = *(const LAS bf16x8*)(lds + PG8_SA(b, h) + aoff + m * 2048 + k * 1024); } while (0)
#define PG8_LDB(dst, b, h) do { _Pragma("unroll") for (int n = 0; n < 2; ++n) _Pragma("unroll") for (int k = 0; k < 2; ++k) dst[n][k] = *(const LAS bf16x8*)(lds + PG8_SB(b, h) + boff + n * 2048 + k * 1024); } while (0)
#define PG8_MMA(ai, bj, At, Bt) do { __builtin_amdgcn_s_setprio(1); _Pragma("unroll") for (int m = 0; m < 4; ++m) _Pragma("unroll") for (int n = 0; n < 2; ++n) { \
        if constexpr (F8) mfma_f8(acc[ai][bj][m][n], cat8(Bt[n][0], Bt[n][1]), cat8(At[m][0], At[m][1])); \
        else { _Pragma("unroll") for (int k = 0; k < 2; ++k) acc[ai][bj][m][n] = __builtin_amdgcn_mfma_f32_16x16x32_bf16(Bt[n][k], At[m][k], acc[ai][bj][m][n], 0, 0, 0); } } __builtin_amdgcn_s_setprio(0); } while (0)
#define PG8_WAIT_V(n) asm volatile("s_waitcnt vmcnt(" #n ")" ::: "memory")
#define PG8_WAIT_L(n) asm volatile("s_waitcnt lgkmcnt(" #n ")" ::: "memory")
#define PG8_BAR __builtin_amdgcn_s_barrier()
#define PG8_SCHED __builtin_amdgcn_sched_barrier(0)
    Unit cur, nxt; int ui = 0;
    if (!S.next(0, cur)) return;
    f32x4 acc[2][2][4][2];
#pragma unroll
    for (int a = 0; a < 2; ++a)
#pragma unroll
        for (int b = 0; b < 2; ++b)
#pragma unroll
            for (int m = 0; m < 4; ++m)
#pragma unroll
                for (int n = 0; n < 2; ++n) acc[a][b][m][n] = (f32x4){0.f, 0.f, 0.f, 0.f};
    bf16x8 At[4][2], B0[2][2], B1[2][2];
    unsigned vgc[2][2], vgn[2][2];
    if constexpr (GATHER) { PG8_GOFF(vgc, cur); }
#pragma unroll
    for (int h = 0; h < 2; ++h)
#pragma unroll
        for (int i = 0; i < 2; ++i) { if (!GATHER) vgc[h][i] = 0u; vgn[h][i] = vgc[h][i]; }
    const char* cA = cur.a; const char* cB = cur.b;
    PG8_STB(PG8_SB(0, 0), cB, 0); PG8_STB(PG8_SB(0, 1), cB, 1); PG8_STA(PG8_SA(0, 0), cA, 0, vgc[0][_i]); PG8_STA(PG8_SA(0, 1), cA, 1, vgc[1][_i]);
    if (wr == 1) PG8_BAR;
    PG8_WAIT_V(2); PG8_BAR;
    PG8_STB(PG8_SB(1, 0), cB + kstep, 0); PG8_STA(PG8_SA(1, 0), cA + kstep, 0, vgc[0][_i]); PG8_STB(PG8_SB(1, 1), cB + kstep, 1);
    PG8_WAIT_V(6); PG8_BAR;
    for (;;) {
        const bool has_next = S.next(ui + 1, nxt);
        const char* nA = has_next ? nxt.a : cA; const char* nB = has_next ? nxt.b : cB;
        int nt = cur.nt; asm volatile("" : "+s"(nt));
#pragma unroll 1
        for (int t = 0; t < nt; t += 2) {
            const bool last = (t == nt - 2);
            const char* a1 = cA + (size_t)(t + 1) * kstep;
            const char* a2 = last ? nA : cA + (size_t)(t + 2) * kstep; const char* b2 = last ? nB : cB + (size_t)(t + 2) * kstep;
            const char* a3 = a2 + kstep; const char* b3 = b2 + kstep;
            if constexpr (Epi::MID) { if (t != 0 && (t & 3) == 0 && cur.nt == 16) E.mid(acc, cur, (t >> 2) - 1, wr, wc, fr, fq); }
            if constexpr (GATHER) { if (last && has_next) { PG8_GOFF(vgn, nxt); } }
            PG8_LDB(B0, 0, 0); PG8_LDB(B1, 0, 1); PG8_SCHED; PG8_LDA(At, 0, 0); PG8_STA(PG8_SA(1, 1), a1, 1, vgc[1][_i]);
            PG8_WAIT_V(8); PG8_WAIT_L(0); PG8_BAR; PG8_MMA(0, 0, At, B0); PG8_MMA(0, 1, At, B1); PG8_BAR; PG8_SCHED;
            PG8_LDA(At, 0, 1); PG8_STB(PG8_SB(0, 0), b2, 0); PG8_STB(PG8_SB(0, 1), b2, 1); PG8_STA(PG8_SA(0, 0), a2, 0, (last ? vgn[0][_i] : vgc[0][_i]));
            PG8_WAIT_V(8); PG8_WAIT_L(0); PG8_BAR; PG8_MMA(1, 0, At, B0); PG8_MMA(1, 1, At, B1); PG8_BAR; PG8_SCHED;
            PG8_LDB(B0, 1, 0); PG8_LDB(B1, 1, 1); PG8_SCHED; PG8_LDA(At, 1, 0); PG8_STA(PG8_SA(0, 1), a2, 1, (last ? vgn[1][_i] : vgc[1][_i]));
            PG8_WAIT_V(8); PG8_WAIT_L(0); PG8_BAR; PG8_MMA(0, 0, At, B0); PG8_MMA(0, 1, At, B1); PG8_BAR; PG8_SCHED;
            PG8_LDA(At, 1, 1); PG8_STB(PG8_SB(1, 0), b3, 0); PG8_STB(PG8_SB(1, 1), b3, 1); PG8_STA(PG8_SA(1, 0), a3, 0, (last ? vgn[0][_i] : vgc[0][_i]));
            PG8_WAIT_V(8); PG8_WAIT_L(0); PG8_BAR; PG8_MMA(1, 0, At, B0); PG8_MMA(1, 1, At, B1); PG8_BAR; PG8_SCHED;
        }
        if constexpr (F8) { asm volatile("s_nop 15\n\ts_nop 15" ::: "memory"); }
        if (wr == 0) PG8_BAR;
        Unit ue = cur; int le = lane;
        if constexpr (Epi::LAUNDER) { int t0 = cur.e0, t1 = cur.e1, t2 = cur.e2, t3 = cur.e3; asm volatile("" : "+v"(t0), "+v"(t1), "+v"(t2), "+v"(t3), "+v"(le));
          ue.e0 = __builtin_amdgcn_readfirstlane(t0); ue.e1 = __builtin_amdgcn_readfirstlane(t1); ue.e2 = __builtin_amdgcn_readfirstlane(t2); ue.e3 = __builtin_amdgcn_readfirstlane(t3); le &= 63; }
        const int fre = le & 15, fqe = le >> 4;
        if constexpr (Epi::CARRY) { E.carry(acc, ue, wr, wc, fre, fqe); if (!has_next) break; }
        else {
        E(acc, ue, wr, wc, fre, fqe);
        if (!has_next) break;
#pragma unroll
        for (int a = 0; a < 2; ++a)
#pragma unroll
            for (int b = 0; b < 2; ++b)
#pragma unroll
                for (int m = 0; m < 4; ++m)
#pragma unroll
                    for (int n = 0; n < 2; ++n) acc[a][b][m][n] = (f32x4){0.f, 0.f, 0.f, 0.f};
        }
        cur = nxt; cA = nA; cB = nB; ++ui;
#pragma unroll
        for (int h = 0; h < 2; ++h)
#pragma unroll
            for (int i = 0; i < 2; ++i) vgc[h][i] = vgn[h][i];
        if (wr == 1) PG8_BAR;
    }
    PG8_WAIT_V(0);
    PG8_BAR;
#undef PG8_SA
#undef PG8_SB
#undef PG8_STA
#undef PG8_GOFF
#undef PG8_STB
#undef PG8_LDA
#undef PG8_LDB
#undef PG8_MMA
#undef PG8_WAIT_V
#undef PG8_WAIT_L
#undef PG8_BAR
#undef PG8_SCHED
}

struct SchedPlain {
    static constexpr bool GATHER = false;
    const char* A; const char* B; size_t ta, tb; int nM, nN, G, c, nt;
    __device__ __forceinline__ bool next(int i, Unit& u) const {
        const long L = (long)i * G + c; if (L >= (long)nM * nN) return false;
        int pm, pn; tile_of((int)L, nM, nN, pm, pn); u.a = A + (size_t)pm * ta; u.b = B + (size_t)pn * tb; u.e0 = pm; u.e1 = pn; u.e2 = 0; u.e3 = 0; u.nt = nt; return true; }
    __device__ __forceinline__ unsigned rowoff(const Unit&, int) const { return 0u; }
};
struct SchedInprojA {
    static constexpr bool GATHER = false;
    const char* Hh; const char* W; int nM, G, c, ng;
    __device__ __forceinline__ bool next(int i, Unit& u) const {
        long L = (long)i * G + c; const int n1 = nM * 7, n2 = 3 * nM; if (L >= n1 + n2 + ng) return false;
        int pm, pn;
        if (L < n1) { tile_of((int)L, nM, 7, pm, pn); u.a = Hh + (size_t)pm * (256 * 2048); u.b = W + (size_t)pn * (256 * 2048); u.e2 = 0; }
        else if (L < n1 + n2) { tile_of((int)(L - n1), 3, nM, pm, pn); u.a = W + (size_t)(23 + pm) * (256 * 2048); u.b = Hh + (size_t)pn * (256 * 2048); u.e2 = 1; }
        else { const int q = (int)(L - n1 - n2); pm = q >> 4; pn = q & 15; u.a = Hh + (size_t)(64 + pm) * (256 * 2048); u.b = W + (size_t)(7 + pn) * (256 * 2048); u.e2 = 2; }
        u.e0 = pm; u.e1 = pn; u.e3 = 0; u.nt = 16; return true; }
    __device__ __forceinline__ unsigned rowoff(const Unit&, int) const { return 0u; }
};
struct SchedSplit {
    static constexpr bool GATHER = false;
    const char* A; const char* B; size_t ta, tb; int nslice, ntf, G, c; const char* Ac; size_t tac, sac; int ks;
    __device__ __forceinline__ bool next(int i, Unit& u) const {
        const long L = (long)i * G + c; int pm, pn;
        if (L < 256) { tile_of((int)L, 64, 4, pm, pn); u.a = A + (size_t)pm * ta; u.b = B + (size_t)pn * tb; u.e2 = 0; u.e3 = 0; u.nt = ntf; }
        else { const int q = (int)(L - 256); if (q >= 8 * nslice) return false; const int tile = q / nslice, s = q % nslice; pm = 64 + (tile >> 2); pn = tile & 3;
            u.a = Ac + (size_t)(tile >> 2) * tac + (size_t)(s / ks) * sac + (s % ks) * 512; u.b = B + (size_t)pn * tb + (s % ks) * 512; u.e2 = s + 1; u.e3 = tile; u.nt = 4; }
        u.e0 = pm; u.e1 = pn; return true; }
    __device__ __forceinline__ unsigned rowoff(const Unit&, int) const { return 0u; }
};
struct SchedMerge {
    static constexpr bool GATHER = false;
    const char* Mix; const char* Wb; int nctx, G, c;
    __device__ __forceinline__ bool next(int i, Unit& u) const {
        const long L = (long)i * G + c; int pm, pn;
        if (L < 256) { tile_of((int)L, 64, 4, pm, pn); u.a = Mix + (size_t)pm * (256 * 2048); u.b = Wb + (size_t)pn * (256 * 2048); u.e2 = 0; u.e3 = 0; u.nt = 16; }
        else { const long q = L - 256; if (q >= nctx) return false; const int tile = (int)q >> 2, b = (int)q & 3; pm = 64 + (tile >> 2); pn = tile & 3;
            u.a = Mix + (size_t)pm * (256 * 2048) + b * 512; u.b = Wb + (size_t)pn * (256 * 2048) + b * 512; u.e2 = b; u.e3 = 1; u.nt = 4; }
        u.e0 = pm; u.e1 = pn; return true; }
    __device__ __forceinline__ unsigned rowoff(const Unit&, int) const { return 0u; }
};
__device__ __forceinline__ int mtu(const LAS unsigned* mt, int i) { return __builtin_amdgcn_readfirstlane((int)mt[i]); }
struct SchedMoe1 {
    static constexpr bool GATHER = true;
    const char* Hh; const char* W; const int* list; const LAS unsigned* mt; int G, c; unsigned rb;
    __device__ __forceinline__ bool next(int i, Unit& u) const {
        long L = (long)i * G + c; int e = 0;
        for (; e < 8; ++e) { const long ue = (long)mtu(mt, 8 + e) * 28; if (L < ue) break; L -= ue; }
        if (e == 8) return false;
        const int m_e = mtu(mt, 8 + e), nti = (int)(L / m_e), mti = (int)(L % m_e);
        u.a = Hh; u.b = W + ((size_t)e * 7168 + (size_t)nti * 256) * rb; u.e0 = e; u.e1 = mti; u.e2 = nti; u.e3 = (mtu(mt, 16 + e) + mti) * 256; u.nt = (int)(rb >> 7); return true; }
    __device__ __forceinline__ unsigned rowoff(const Unit& u, int r) const {
        const int li = u.e1 * 256 + r; const int ent = (li < (int)mt[u.e0]) ? list[u.e0 * LCAP + li] : 0; return (unsigned)(ent >> 1) * rb; }
};
__device__ __forceinline__ bool moe2_unit(long L, const LAS unsigned* mt, const char* Hid, const char* W, Unit& u, const size_t rb) {
    int e = 0;
    for (; e < 8; ++e) { const long ue = (long)mtu(mt, 8 + e) * 4; if (L < ue) break; L -= ue; }
    if (e == 8) return false;
    const int m_e = mtu(mt, 8 + e), nti = (int)(L / m_e), mti = (int)(L % m_e);
    u.a = Hid + (size_t)(mtu(mt, 16 + e) + mti) * 256 * rb; u.b = W + ((size_t)e * 1024 + (size_t)nti * 256) * rb; u.e0 = e; u.e1 = mti; u.e2 = nti; u.e3 = 0; u.nt = (int)(rb >> 7); return true;
}
struct SchedMoe2 {
    static constexpr bool GATHER = false;
    const char* Hid; const char* W; const LAS unsigned* mt; int G, c; unsigned rb;
    __device__ __forceinline__ bool next(int i, Unit& u) const { const long L = (long)i * G + c; if (L >= (long)mtu(mt, 25)) return false; return moe2_unit(L, mt, Hid, W, u, rb); }
    __device__ __forceinline__ unsigned rowoff(const Unit&, int) const { return 0u; }
};
struct SchedMoe2S {
    static constexpr bool GATHER = false;
    const char* Hid; const char* W; const LAS unsigned* mt; int G, c; unsigned rb;
    __device__ __forceinline__ bool next(int i, Unit& u) const { const long q = (long)i * G + c; if (q >= (long)mtu(mt, 26) * 7) return false;
        if (!moe2_unit((long)mtu(mt, 25) + q / 7, mt, Hid, W, u, rb)) return false; const int s = (int)(q % 7); const unsigned sb = rb / 7u; u.a += s * sb; u.b += s * sb; u.e3 = (int)q; u.nt = (int)(sb >> 7); return true; }
    __device__ __forceinline__ unsigned rowoff(const Unit&, int) const { return 0u; }
};

#define EPI_ROWS(ai, m) (128 * (ai) + 64 * wr + 16 * (m) + fr)
#define EPI_COL(bj) (128 * (bj) + 32 * wc + 8 * fq)
__device__ __forceinline__ u32x4 pack_acc8(const f32x4 a, const f32x4 b) { u32x4 w; w.x = pk2(a[0], a[1]); w.y = pk2(a[2], a[3]); w.z = pk2(b[0], b[1]); w.w = pk2(b[2], b[3]); return w; }

__device__ __forceinline__ unsigned gq8(float g) { const unsigned q = (unsigned)(g * 255.f + 0.5f); return q < 1u ? 1u : q; }
__device__ __forceinline__ u32x2 pack_gate8(const f32x4 a, const f32x4 b) {
    u32x2 w; w.x = gq8(a[0]) | (gq8(a[1]) << 8) | (gq8(a[2]) << 16) | (gq8(a[3]) << 24); w.y = gq8(b[0]) | (gq8(b[1]) << 8) | (gq8(b[2]) << 16) | (gq8(b[3]) << 24); return w; }
__device__ __forceinline__ size_t gate_off(int pm, int j, int b, int wr, int wc, int ai, int m, int bj, int fr, int fq) { return ((((size_t)((pm * 4 + j) * 4 + b) * 8 + wr * 4 + wc) * 16 + (ai * 4 + m) * 2 + bj) * 64 + fq * 16 + fr) * 8; }
__device__ __forceinline__ float gate8(unsigned w, int k) { return (float)((w >> (8 * k)) & 255u) * (1.f / 255.f); }
struct EpiPlain { static constexpr bool CARRY = false, LAUNDER = false, MID = false;
    bf16* O; int ld;
    __device__ __forceinline__ void operator()(const f32x4 (&acc)[2][2][4][2], const Unit& u, int wr, int wc, int fr, int fq) const {
#pragma unroll
        for (int ai = 0; ai < 2; ++ai)
#pragma unroll
            for (int m = 0; m < 4; ++m) { bf16* rowp = O + (size_t)(u.e0 * 256 + EPI_ROWS(ai, m)) * ld + u.e1 * 256;
#pragma unroll
                for (int bj = 0; bj < 2; ++bj) *(u32x4*)(rowp + EPI_COL(bj)) = pack_acc8(acc[ai][bj][m][0], acc[ai][bj][m][1]); }
    }
};
struct EpiPlainSplit { static constexpr bool CARRY = false, LAUNDER = false, MID = false;
    bf16* O; int ld; float* P; int nslice;
    __device__ __forceinline__ void operator()(const f32x4 (&acc)[2][2][4][2], const Unit& u, int wr, int wc, int fr, int fq) const {
        if (u.e2 == 0) {
#pragma unroll
            for (int ai = 0; ai < 2; ++ai)
#pragma unroll
                for (int m = 0; m < 4; ++m) { bf16* rowp = O + (size_t)(u.e0 * 256 + EPI_ROWS(ai, m)) * ld + u.e1 * 256;
#pragma unroll
                    for (int bj = 0; bj < 2; ++bj) *(u32x4*)(rowp + EPI_COL(bj)) = pack_acc8(acc[ai][bj][m][0], acc[ai][bj][m][1]); }
        } else { float* pt = P + (size_t)(u.e3 * nslice + (u.e2 - 1)) * 65536;
#pragma unroll
            for (int ai = 0; ai < 2; ++ai)
#pragma unroll
                for (int m = 0; m < 4; ++m)
#pragma unroll
                    for (int bj = 0; bj < 2; ++bj) { float* p = pt + EPI_ROWS(ai, m) * 256 + EPI_COL(bj); *(f32x4*)p = acc[ai][bj][m][0]; *(f32x4*)(p + 4) = acc[ai][bj][m][1]; }
        }
    }
};
struct EpiInprojA { static constexpr bool CARRY = false, LAUNDER = false, MID = false;
    bf16* INP; bf16* T; unsigned char* Gc;
    __device__ __forceinline__ void operator()(const f32x4 (&acc)[2][2][4][2], const Unit& u, int wr, int wc, int fr, int fq) const {
        if (u.e2 == 2) {
#pragma unroll
            for (int ai = 0; ai < 2; ++ai)
#pragma unroll
                for (int m = 0; m < 4; ++m)
#pragma unroll
                    for (int bj = 0; bj < 2; ++bj) { f32x4 a = acc[ai][bj][m][0], b = acc[ai][bj][m][1];
#pragma unroll
                        for (int j = 0; j < 4; ++j) { a[j] = sigm(a[j]); b[j] = sigm(b[j]); }
                        *(u32x2*)(Gc + gate_off(u.e0, u.e1 & 3, u.e1 >> 2, wr, wc, ai, m, bj, fr, fq)) = pack_gate8(a, b); }
        } else if (u.e2 == 0) {
            bf16* base = INP + (size_t)u.e1 * ((size_t)R * 256);
            const bool regroup = (u.e1 == 1);
#pragma unroll
            for (int ai = 0; ai < 2; ++ai)
#pragma unroll
                for (int m = 0; m < 4; ++m) { const int row = u.e0 * 256 + EPI_ROWS(ai, m);
#pragma unroll
                    for (int bj = 0; bj < 2; ++bj) { const int col = EPI_COL(bj);
                        bf16* p = regroup ? base + ((((size_t)(col >> 4) * 33 + (row >> 9)) * 16 + (row & 15)) * 64 + ((col & 8) << 2) + ((row >> 4) & 31)) * 8 : base + (size_t)row * 256 + col;
                        *(u32x4*)p = pack_acc8(acc[ai][bj][m][0], acc[ai][bj][m][1]); } }
        } else {
#pragma unroll
            for (int ai = 0; ai < 2; ++ai)
#pragma unroll
                for (int m = 0; m < 4; ++m) { bf16* rowp = T + (size_t)(u.e0 * 256 + EPI_ROWS(ai, m)) * R + u.e1 * 256;
#pragma unroll
                    for (int bj = 0; bj < 2; ++bj) *(u32x4*)(rowp + EPI_COL(bj)) = pack_acc8(acc[ai][bj][m][0], acc[ai][bj][m][1]); }
        }
    }
};
struct EpiGates { static constexpr bool CARRY = false, LAUNDER = false, MID = false;
    unsigned char* Gt; float isc;
    __device__ __forceinline__ void operator()(const f32x4 (&acc)[2][2][4][2], const Unit& u, int wr, int wc, int fr, int fq) const {
#pragma unroll
        for (int ai = 0; ai < 2; ++ai)
#pragma unroll
            for (int m = 0; m < 4; ++m)
#pragma unroll
                for (int bj = 0; bj < 2; ++bj) { f32x4 a = acc[ai][bj][m][0], b = acc[ai][bj][m][1];
#pragma unroll
                    for (int j = 0; j < 4; ++j) { a[j] = sigm(a[j] * isc); b[j] = sigm(b[j] * isc); }
                    *(u32x2*)(Gt + gate_off(u.e0, u.e1 & 3, u.e1 >> 2, wr, wc, ai, m, bj, fr, fq)) = pack_gate8(a, b); }
    }
};
struct EpiGlu { static constexpr bool CARRY = false, LAUNDER = false, MID = false;
    const bf16* Zz; bf16* Mix; const float* bglu;
    __device__ __forceinline__ void operator()(const f32x4 (&acc)[2][2][4][2], const Unit& u, int wr, int wc, int fr, int fq) const {
#pragma unroll
        for (int bj = 0; bj < 2; ++bj) { const int col = EPI_COL(bj);
            const f32x4 b0 = *(const f32x4*)(bglu + col), b1 = *(const f32x4*)(bglu + col + 4);
#pragma unroll
            for (int ai = 0; ai < 2; ++ai)
#pragma unroll
                for (int m = 0; m < 4; ++m) { const size_t row = (size_t)(u.e0 * 256 + EPI_ROWS(ai, m));
                    const u32x4 zz = *(const u32x4*)(Zz + row * 256 + col);
                    f32x4 a = acc[ai][bj][m][0] + b0, b = acc[ai][bj][m][1] + b1;
                    a[0] = bflo(zz.x) * sigm(a[0]); a[1] = bfhi(zz.x) * sigm(a[1]); a[2] = bflo(zz.y) * sigm(a[2]); a[3] = bfhi(zz.y) * sigm(a[3]);
                    b[0] = bflo(zz.z) * sigm(b[0]); b[1] = bfhi(zz.z) * sigm(b[1]); b[2] = bflo(zz.w) * sigm(b[2]); b[3] = bfhi(zz.w) * sigm(b[3]);
                    *(u32x4*)(Mix + row * 1024 + 256 + col) = pack_acc8(a, b); } }
    }
};
struct EpiMerge {
    static constexpr bool CARRY = false, LAUNDER = false, MID = true;
    const unsigned char* Gt; const unsigned char* Gc; bf16* Y; bf16* YP;
    __device__ __forceinline__ void mid(f32x4 (&acc)[2][2][4][2], const Unit& u, int b, int wr, int wc, int fr, int fq) const {
#pragma unroll
        for (int ai = 0; ai < 2; ++ai) {
            u32x2 g[4][2], gn[4][2];
#pragma unroll
            for (int m = 0; m < 4; ++m)
#pragma unroll
                for (int bj = 0; bj < 2; ++bj) { const unsigned char* gp = Gt + gate_off(u.e0, u.e1, b, wr, wc, ai, m, bj, fr, fq); g[m][bj] = *(const u32x2*)gp; gn[m][bj] = *(const u32x2*)(gp + 65536); }
#pragma unroll
            for (int m = 0; m < 4; ++m)
#pragma unroll
                for (int bj = 0; bj < 2; ++bj) { f32x4 a0 = acc[ai][bj][m][0], a1 = acc[ai][bj][m][1];
#pragma unroll
                    for (int j = 0; j < 4; ++j) { a0[j] *= gate8(g[m][bj].x, j) * rcpf_(gate8(gn[m][bj].x, j)); a1[j] *= gate8(g[m][bj].y, j) * rcpf_(gate8(gn[m][bj].y, j)); }
                    acc[ai][bj][m][0] = a0; acc[ai][bj][m][1] = a1; } }
    }
    __device__ __forceinline__ void operator()(const f32x4 (&acc)[2][2][4][2], const Unit& u, int wr, int wc, int fr, int fq) const {
        const int b = u.e3 ? u.e2 : 3;
#pragma unroll
        for (int ai = 0; ai < 2; ++ai)
#pragma unroll
            for (int m = 0; m < 4; ++m) { const size_t row = (size_t)(u.e0 * 256 + EPI_ROWS(ai, m));
                bf16* orow = (u.e3 ? YP + ((size_t)b * CROWS + (row - LROWS)) * 1024 : Y + row * 1024) + u.e1 * 256;
#pragma unroll
                for (int bj = 0; bj < 2; ++bj) { const u32x2 g = *(const u32x2*)((u.e3 ? Gc : Gt) + gate_off(u.e3 ? u.e0 - 64 : u.e0, u.e1, b, wr, wc, ai, m, bj, fr, fq)); f32x4 a0 = acc[ai][bj][m][0], a1 = acc[ai][bj][m][1];
#pragma unroll
                    for (int j = 0; j < 4; ++j) { a0[j] *= gate8(g.x, j); a1[j] *= gate8(g.y, j); }
                    *(u32x4*)(orow + EPI_COL(bj)) = pack_acc8(a0, a1); } }
    }
};
struct EpiSwiglu { static constexpr bool CARRY = false, LAUNDER = false, MID = false;
    bf16* Hd; int ldh; bool moe;
    __device__ __forceinline__ void operator()(const f32x4 (&acc)[2][2][4][2], const Unit& u, int wr, int wc, int fr, int fq) const {
        const int rowbase = moe ? u.e3 : u.e0 * 256, pn = moe ? u.e2 : u.e1;
#pragma unroll
        for (int ai = 0; ai < 2; ++ai)
#pragma unroll
            for (int m = 0; m < 4; ++m) { bf16* p = Hd + (size_t)(rowbase + EPI_ROWS(ai, m)) * ldh + pn * 128 + 32 * wc + 8 * fq;
                f32x4 a = acc[ai][0][m][0], b = acc[ai][0][m][1]; const f32x4 ua = acc[ai][1][m][0], ub = acc[ai][1][m][1];
#pragma unroll
                for (int j = 0; j < 4; ++j) { a[j] = silu_(a[j]) * ua[j]; b[j] = silu_(b[j]) * ub[j]; }
                *(u32x4*)p = pack_acc8(a, b); }
    }
};
struct EpiSwigluF8 { static constexpr bool CARRY = false, LAUNDER = true, MID = false;
    unsigned char* Hd; int ldh; bool moe; float ws, hs;
    __device__ __forceinline__ void operator()(const f32x4 (&acc)[2][2][4][2], const Unit& u, int wr, int wc, int fr, int fq) const {
        const int rowbase = moe ? u.e3 : u.e0 * 256, pn = moe ? u.e2 : u.e1; const float hs2 = hs * ws;
#pragma unroll
        for (int ai = 0; ai < 2; ++ai)
#pragma unroll
            for (int m = 0; m < 4; ++m) { unsigned char* p = Hd + (size_t)(rowbase + EPI_ROWS(ai, m)) * ldh + pn * 128 + 32 * wc + 8 * fq;
                f32x4 a = acc[ai][0][m][0], b = acc[ai][0][m][1]; const f32x4 ua = acc[ai][1][m][0], ub = acc[ai][1][m][1];
#pragma unroll
                for (int j = 0; j < 4; ++j) { a[j] = __builtin_amdgcn_fmed3f(silu_(a[j] * ws) * (ua[j] * hs2), -448.f, 448.f); b[j] = __builtin_amdgcn_fmed3f(silu_(b[j] * ws) * (ub[j] * hs2), -448.f, 448.f); }
                u32x2 w; w.x = pk4_f8(a[0], a[1], a[2], a[3]); w.y = pk4_f8(b[0], b[1], b[2], b[3]); *(u32x2*)p = w; }
    }
};
struct EpiMoeDown { static constexpr bool CARRY = false, LAUNDER = true, MID = false;
    bf16* Slot; const int* list; const float* routew; const LAS unsigned* mt; float osc;
    __device__ __forceinline__ void operator()(const f32x4 (&acc)[2][2][4][2], const Unit& u, int wr, int wc, int fr, int fq) const {
        const int cnt = (int)mt[u.e0];
#pragma unroll
        for (int ai = 0; ai < 2; ++ai)
#pragma unroll
            for (int m = 0; m < 4; ++m) { const int li = u.e1 * 256 + EPI_ROWS(ai, m);
                if (li < cnt) { const int ent = list[u.e0 * LCAP + li]; const float w = routew[ent] * osc;
                    bf16* rowp = Slot + ((size_t)(ent & 1) * LROWS + (size_t)(ent >> 1)) * 1024 + u.e2 * 256;
#pragma unroll
                    for (int bj = 0; bj < 2; ++bj) *(u32x4*)(rowp + EPI_COL(bj)) = pack_acc8(acc[ai][bj][m][0] * w, acc[ai][bj][m][1] * w); } }
    }
};
struct EpiMoePart { static constexpr bool CARRY = false, LAUNDER = true, MID = false;
    bf16* Pm; const int* list; const LAS unsigned* mt; int* smap; float osc;
    __device__ __forceinline__ void operator()(const f32x4 (&acc)[2][2][4][2], const Unit& u, int wr, int wc, int fr, int fq) const {
        const int cnt = (int)mt[u.e0], q = u.e3; bf16* pt = Pm + (size_t)q * 65536; const bool mapper = (q % 7 == 0) && wc == 0 && fq == 0;
#pragma unroll
        for (int ai = 0; ai < 2; ++ai)
#pragma unroll
            for (int m = 0; m < 4; ++m) { const int rl = EPI_ROWS(ai, m), li = u.e1 * 256 + rl;
#pragma unroll
                for (int bj = 0; bj < 2; ++bj) *(u32x4*)(pt + rl * 256 + EPI_COL(bj)) = pack_acc8(acc[ai][bj][m][0] * osc, acc[ai][bj][m][1] * osc);
                if (mapper && li < cnt) smap[list[u.e0 * LCAP + li] * 4 + u.e2] = ((q / 7) << 8) | rl; }
    }
};
}
#define DROW(reg, h) (((reg) & 3) + 8 * ((reg) >> 2) + 4 * (h))

__device__ __forceinline__ void s5_state_item(const bf16* M1F  , const bf16* SUF, float* HLOC, int item, int lane) {
    const int cb = item % 33, gd = item / 33, g = gd >> 1, dir = gd & 1, li = lane & 31, h = lane >> 5;
    const bf16* A = M1F + (size_t)(g * 2 + dir) * 128 * 256 + lane * 8;
    const bf16* B = SUF + (size_t)(g * 33 + cb) * 16 * 512 + lane * 8;
    f32x16 acc[4];
#pragma unroll
    for (int rt = 0; rt < 4; ++rt) acc[rt] = zero16();
    bf16x8 a0[2][4], b0[2], a1[2][4], b1[2];
#define S5S_LOAD(AA, BB, grp) do { _Pragma("unroll") for (int s = 0; s < 2; ++s) { const int ks = (grp) * 2 + s; BB[s] = ldg8(B + ks * 512); \
        _Pragma("unroll") for (int rt = 0; rt < 4; ++rt) AA[s][rt] = ldg8(A + (ks * 4 + rt) * 512); } } while (0)
#define S5S_MMA(AA, BB) do { _Pragma("unroll") for (int s = 0; s < 2; ++s) _Pragma("unroll") for (int rt = 0; rt < 4; ++rt) acc[rt] = mma32(AA[s][rt], BB[s], acc[rt]); } while (0)
    S5S_LOAD(a0, b0, 0);
#pragma unroll 1
    for (int gp = 0; gp < 8; gp += 2) {
        S5S_LOAD(a1, b1, gp + 1);
        S5S_MMA(a0, b0);
        if (gp + 2 < 8) S5S_LOAD(a0, b0, gp + 2);
        S5S_MMA(a1, b1);
    }
#undef S5S_LOAD
#undef S5S_MMA
    const int c = cb * 32 + li; float* o = HLOC + (((size_t)(g * 2 + dir) * (NCH16 / 2) + (c >> 1)) * 64) * 4 + (c & 1) * 2;
#pragma unroll
    for (int rt = 0; rt < 4; ++rt)
#pragma unroll
        for (int q = 0; q < 4; ++q) { const int p0 = 16 * rt + 4 * q + 2 * h;
            *(f32x2*)(o + (size_t)p0 * 4) = (f32x2){acc[rt][4 * q], acc[rt][4 * q + 1]}; *(f32x2*)(o + (size_t)(p0 + 1) * 4) = (f32x2){acc[rt][4 * q + 2], acc[rt][4 * q + 3]}; }
}
__device__ __forceinline__ void s5_scan_item(const float* A16  , const float* HLOC, bf16* HINF, LAS unsigned char* wl, int item, int lane) {
    const int dir = item & 1, g = (item >> 1) & 15, b = item >> 5, p = lane;
    const f32x2 a = *(const f32x2*)(A16 + ((size_t)(dir * 16 + g) * 64 + p) * 2);
    const float* src = HLOC + ((size_t)(g * 2 + dir) * (NCH16 / 2) * 64 + p) * 4;
    const int k2 = dir * 128 + 2 * p;
    bf16* dctx = HINF + ((size_t)(g * 33 + 32) * 16 + (k2 >> 4)) * 512 + ((k2 >> 3) & 1) * 256 + (k2 & 7);
    float hr = 0.f, hi = 0.f;
#define S5_STEP(xr, xi) do { const float nr_ = a.x * hr - a.y * hi + (xr), ni_ = a.x * hi + a.y * hr + (xi); hr = nr_; hi = ni_; } while (0)
    {
        f32x4 v[8];
#pragma unroll
        for (int j = 0; j < 8; ++j) v[j] = *(const f32x4*)(src + (size_t)(512 + 8 * b + (dir ? 7 - j : j)) * 256);
#pragma unroll
        for (int j = 0; j < 8; ++j) { const int cl0 = 16 * b + 2 * (dir ? 7 - j : j);
            if (!dir) { *(unsigned*)(dctx + (cl0) * 8) = pk2(hr, hi); S5_STEP(v[j][0], v[j][1]); *(unsigned*)(dctx + (cl0 + 1) * 8) = pk2(hr, hi); S5_STEP(v[j][2], v[j][3]); }
            else      { *(unsigned*)(dctx + (cl0 + 1) * 8) = pk2(hr, hi); S5_STEP(v[j][2], v[j][3]); *(unsigned*)(dctx + (cl0) * 8) = pk2(hr, hi); S5_STEP(v[j][0], v[j][1]); } }
    }
    const int pg = p >> 2; LAS unsigned char* wbase = wl + ((p >> 3) * 64 + (pg & 1) * 32) * 16 + 4 * (p & 3);
    f32x4 vn[16];
#pragma unroll
    for (int j = 0; j < 16; ++j) vn[j] = *(const f32x4*)(src + (size_t)(256 * b + (dir ? 255 - j : j)) * 256);
#pragma unroll 1
    for (int blk = 0; blk < 16; ++blk) {
        f32x4 v[16];
#pragma unroll
        for (int j = 0; j < 16; ++j) v[j] = vn[j];
        if (blk < 15) {
#pragma unroll
            for (int j = 0; j < 16; ++j) { const int pj = 16 * (blk + 1) + j; vn[j] = *(const f32x4*)(src + (size_t)(256 * b + (dir ? 255 - pj : pj)) * 256); } }
#pragma unroll
        for (int j = 0; j < 16; ++j) { const int pl = dir ? 15 - j : j;
            if (!dir) { *(LAS unsigned*)(wbase + ((2 * pl + pg) & 31) * 16) = pk2(hr, hi); S5_STEP(v[j][0], v[j][1]); *(LAS unsigned*)(wbase + ((2 * pl + 1 + pg) & 31) * 16) = pk2(hr, hi); S5_STEP(v[j][2], v[j][3]); }
            else      { *(LAS unsigned*)(wbase + ((2 * pl + 1 + pg) & 31) * 16) = pk2(hr, hi); S5_STEP(v[j][2], v[j][3]); *(LAS unsigned*)(wbase + ((2 * pl + pg) & 31) * 16) = pk2(hr, hi); S5_STEP(v[j][0], v[j][1]); } }
        const int cb = 16 * b + (dir ? 15 - blk : blk), hs = lane >> 5, cl = lane & 31;
        bf16* dout = HINF + ((size_t)(g * 33 + cb) * 16 + dir * 8) * 512 + lane * 8;
#pragma unroll
        for (int j = 0; j < 8; ++j) *(u32x4*)(dout + j * 512) = *(const LAS u32x4*)(wl + (j * 64 + hs * 32 + ((cl + 2 * j + hs) & 31)) * 16);
    }
#undef S5_STEP
}
__device__ __forceinline__ void s5_out_item(const bf16* TABF  , const bf16* SUF, const bf16* HINF, bf16* Z, int item, int lane) {
    const int mh = item & 1, it2 = item >> 1, cb = it2 % 33, g = it2 / 33, li = lane & 31, h = lane >> 5, c = cb * 32 + li;
    const bf16* A = TABF + ((size_t)g * 256 + mh * 128) * 512 + lane * 8;
    const bf16* B0 = SUF + (size_t)(g * 33 + cb) * 16 * 512 + lane * 8;
    const bf16* B1 = HINF + (size_t)(g * 33 + cb) * 16 * 512 + lane * 8;
    f32x16 acc[4];
#pragma unroll
    for (int rt = 0; rt < 4; ++rt) acc[rt] = zero16();
    bf16x8 a0[2][4], b0[2], a1[2][4], b1[2];
#define S5O_LOAD(AA, BB, grp) do { _Pragma("unroll") for (int s = 0; s < 2; ++s) { const int ks = (grp) * 2 + s; BB[s] = ldg8((ks < 16 ? B0 + ks * 512 : B1 + (ks - 16) * 512)); \
        _Pragma("unroll") for (int rt = 0; rt < 4; ++rt) AA[s][rt] = ldg8(A + (ks * 4 + rt) * 512); } } while (0)
#define S5O_MMA(AA, BB) do { _Pragma("unroll") for (int s = 0; s < 2; ++s) _Pragma("unroll") for (int rt = 0; rt < 4; ++rt) acc[rt] = mma32(AA[s][rt], BB[s], acc[rt]); } while (0)
    S5O_LOAD(a0, b0, 0);
#pragma unroll 1
    for (int gp = 0; gp < 16; gp += 2) {
        S5O_LOAD(a1, b1, gp + 1);
        S5O_MMA(a0, b0);
        if (gp + 2 < 16) S5O_LOAD(a0, b0, gp + 2);
        S5O_MMA(a1, b1);
    }
#undef S5O_LOAD
#undef S5O_MMA
#pragma unroll
    for (int rt = 0; rt < 4; ++rt)
#pragma unroll
        for (int q = 0; q < 4; ++q) {
            const int i = 8 * mh + 2 * rt + (q >> 1), ho0 = 8 * (q & 1) + 4 * h;
            u32x2 w; w.x = pk2(gelu_tanh(acc[rt][4 * q]), gelu_tanh(acc[rt][4 * q + 1])); w.y = pk2(gelu_tanh(acc[rt][4 * q + 2]), gelu_tanh(acc[rt][4 * q + 3]));
            *(u32x2*)(Z + ((size_t)c * 16 + i) * 256 + g * 16 + ho0) = w; }
}

__device__ __forceinline__ int ret_tok0(int b, int n) { return n < 64 ? b * SEQ + n * 128 : LROWS + b * CTXL + (n - 64) * 128; }
__device__ __forceinline__ void ret_kv_item(const bf16* RKT, const bf16* RVT, const float* COST, const float* SINT, const float* decay  , float* KV, int item, int lane) {
    const int n = item % 66, bh = item / 66, hd = bh & 3, b = bh >> 2, li = lane & 31, h = lane >> 5;
    const int tok0 = ret_tok0(b, n); const bool lat = n < 64;
    const float lgf = -log2f(1.f + __expf(-decay[hd])), lgr = -log2f(1.f + __expf(-decay[4 + hd]));
    f32x16 acc[2][2][2];
#pragma unroll
    for (int a = 0; a < 2; ++a)
#pragma unroll
        for (int c = 0; c < 2; ++c)
#pragma unroll
            for (int d = 0; d < 2; ++d) acc[a][c][d] = zero16();
    const bf16* k0p = RKT + (size_t)(hd * 64 + li) * R + tok0 + 8 * h;
    const bf16* v0p = RVT + (size_t)(hd * 64 + li) * R + tok0 + 8 * h;
#pragma unroll 2
    for (int ks = 0; ks < 8; ++ks) {
        float k1[8], k2[8];
        unpack8(ldg8(k0p + ks * 16), k1); unpack8(ldg8(k0p + (size_t)32 * R + ks * 16), k2);
        if (lat) {
            const float* cp = COST + (size_t)li * SEQ + n * 128 + ks * 16 + 8 * h; const float* sp = SINT + (size_t)li * SEQ + n * 128 + ks * 16 + 8 * h;
            const f32x4 c0 = *(const f32x4*)cp, c1 = *(const f32x4*)(cp + 4), s0 = *(const f32x4*)sp, s1 = *(const f32x4*)(sp + 4);
#pragma unroll
            for (int j = 0; j < 8; ++j) { const float cc = j < 4 ? c0[j & 3] : c1[j & 3], ss = j < 4 ? s0[j & 3] : s1[j & 3];
                const float x1 = k1[j], x2 = k2[j]; k1[j] = x1 * cc - x2 * ss; k2[j] = x1 * ss + x2 * cc; }
        }
        const bf16x8 vf0 = ldg8(v0p + ks * 16), vf1 = ldg8(v0p + (size_t)32 * R + ks * 16);
#pragma unroll
        for (int dir = 0; dir < 2; ++dir) {
            float a1[8], a2[8];
#pragma unroll
            for (int j = 0; j < 8; ++j) { const int i = ks * 16 + 8 * h + j; const float w = dir == 0 ? ex2(lgf * (float)(127 - i)) : ex2(lgr * (float)i); a1[j] = k1[j] * w; a2[j] = k2[j] * w; }
            const bf16x8 kd0 = pack8(a1), kd1 = pack8(a2);
            acc[dir][0][0] = mma32(kd0, vf0, acc[dir][0][0]); acc[dir][0][1] = mma32(kd0, vf1, acc[dir][0][1]);
            acc[dir][1][0] = mma32(kd1, vf0, acc[dir][1][0]); acc[dir][1][1] = mma32(kd1, vf1, acc[dir][1][1]);
        }
    }
#pragma unroll
    for (int dir = 0; dir < 2; ++dir) { float* o = KV + ((size_t)((b * 4 + hd) * 2 + dir) * 66 + n) * 4096;
#pragma unroll
        for (int dt = 0; dt < 2; ++dt)
#pragma unroll
            for (int et = 0; et < 2; ++et)
#pragma unroll
                for (int q = 0; q < 4; ++q) *(f32x4*)(o + (size_t)(et * 32 + li) * 64 + dt * 32 + 8 * q + 4 * h) = (f32x4){acc[dir][dt][et][4 * q], acc[dir][dt][et][4 * q + 1], acc[dir][dt][et][4 * q + 2], acc[dir][dt][et][4 * q + 3]}; }
}
__device__ __forceinline__ void ret_scan_item(const float* decay, const float* KV, bf16* SPREV, int item, int lane) {
    const int blk = item & 63, bhd = item >> 6, dir = bhd & 1, hd = (bhd >> 1) & 3, idx = blk * 64 + lane;
    const float lg = -log2f(1.f + __expf(-decay[dir * 4 + hd])), cd = ex2(128.f * lg);
    const float* src = KV + (size_t)bhd * 66 * 4096 + idx; bf16* dst = SPREV + (size_t)bhd * 66 * 4096 + idx;
    float s = 0.f;
    for (int s0 = 0; s0 < 66; s0 += 11) {
        float v[11];
#pragma unroll
        for (int j = 0; j < 11; ++j) { const int t = s0 + j; const int n = dir == 0 ? (t < 2 ? 64 + t : t - 2) : (t < 2 ? 65 - t : 65 - t); v[j] = src[(size_t)n * 4096]; }
#pragma unroll
        for (int j = 0; j < 11; ++j) { const int t = s0 + j; const int n = dir == 0 ? (t < 2 ? 64 + t : t - 2) : (t < 2 ? 65 - t : 65 - t); dst[(size_t)n * 4096] = (bf16)(pk2(s, 0.f) & 0xffffu); s = cd * s + v[j]; }
    }
}
struct KVTile { u32x4 k[4], v[4]; };
__device__ __forceinline__ void kv_tile_load(KVTile& T, const bf16* Kh  , const bf16* VTh  , int tok0, int lane) {
#pragma unroll
    for (int i = 0; i < 4; ++i) T.k[i] = *(const u32x4*)(Kh + (size_t)(tok0 + 8 * i + (lane >> 3)) * 256 + (lane & 7) * 8);
#pragma unroll
    for (int i = 0; i < 4; ++i) T.v[i] = *(const u32x4*)(VTh + (size_t)(16 * i + (lane >> 2)) * R + tok0 + (lane & 3) * 8);
}
__device__ __forceinline__ void kv_tile_store(const KVTile& T, LAS unsigned char* wl, int lane) {
#pragma unroll
    for (int i = 0; i < 4; ++i) *(LAS u32x4*)(wl + (8 * i + (lane >> 3)) * 144 + (lane & 7) * 16) = T.k[i];
#pragma unroll
    for (int i = 0; i < 4; ++i) *(LAS u32x4*)(wl + 4608 + (16 * i + (lane >> 2)) * 80 + (lane & 3) * 16) = T.v[i];
}
__device__ __forceinline__ void kv_tile_frags(const LAS unsigned char* wl, int lane, bf16x8 (&kf)[4], bf16x8 (&vf)[2][2]) {
    const int li = lane & 31, h = lane >> 5;
#pragma unroll
    for (int s = 0; s < 4; ++s) kf[s] = *(const LAS bf16x8*)(wl + li * 144 + (2 * s + h) * 16);
#pragma unroll
    for (int et = 0; et < 2; ++et)
#pragma unroll
        for (int s2 = 0; s2 < 2; ++s2) { const LAS unsigned char* p = wl + 4608 + (et * 32 + li) * 80 + s2 * 32 + 8 * h;
            const bf16x4 lo = *(const LAS bf16x4*)p, hi = *(const LAS bf16x4*)(p + 16); vf[et][s2] = __builtin_shufflevector(lo, hi, 0, 1, 2, 3, 4, 5, 6, 7); }
}

__device__ __forceinline__ void rope_item(bf16* RQ, bf16* RK, const float* COSN, const float* SINN, int item, int lane) {
    const int u = lane & 15, off = (u >> 2) * 64 + (u & 3) * 8, c8 = (u & 3) * 8;
#pragma unroll 4
    for (int st = 0; st < 32; ++st) { const int row = item * 128 + 4 * st + (lane >> 4), tl = row & (SEQ - 1);
        const f32x4 c0 = *(const f32x4*)(COSN + (size_t)tl * 32 + c8), c1 = *(const f32x4*)(COSN + (size_t)tl * 32 + c8 + 4), s0 = *(const f32x4*)(SINN + (size_t)tl * 32 + c8), s1 = *(const f32x4*)(SINN + (size_t)tl * 32 + c8 + 4);
#pragma unroll
        for (int w = 0; w < 2; ++w) { bf16* p = (w ? RK : RQ) + (size_t)row * 256 + off; float x1[8], x2[8]; unpack8(*(const bf16x8*)p, x1); unpack8(*(const bf16x8*)(p + 32), x2);
#pragma unroll
            for (int j = 0; j < 8; ++j) { const float cc = j < 4 ? c0[j & 3] : c1[j & 3], ss = j < 4 ? s0[j & 3] : s1[j & 3]; const float a = x1[j], bb = x2[j]; x1[j] = a * cc - bb * ss; x2[j] = a * ss + bb * cc; }
            *(bf16x8*)p = pack8(x1); *(bf16x8*)(p + 32) = pack8(x2); } }
}
__device__ __forceinline__ void ret_out_item(const bf16* RQ, const bf16* RK, const bf16* RG, const bf16* RVT, const bf16* SPREV, const float* decay, const float* gn  , bf16* MIX,
                                             LAS unsigned char* wl, int item, int lane) {
    const int qb = item & 3, it2 = item >> 2, n = it2 % 66, bh = it2 / 66, hd = bh & 3, b = bh >> 2, li = lane & 31, h = lane >> 5;
    const int tok0 = ret_tok0(b, n);
    const float lgf = -log2f(1.f + __expf(-decay[hd])), lgr = -log2f(1.f + __expf(-decay[4 + hd]));
    const int iq = qb * 32 + li;
    const bf16* Kh = RK + hd * 64; const bf16* VTh = RVT + (size_t)hd * 64 * R;
    KVTile T; kv_tile_load(T, Kh, VTh, tok0, lane);
    bf16x8 qf[4];
    { const bf16* qp = RQ + (size_t)(tok0 + iq) * 256 + hd * 64 + 8 * h;
#pragma unroll
      for (int s = 0; s < 4; ++s) qf[s] = ldg8(qp + 16 * s); }
    kv_tile_store(T, wl, lane);
    f32x16 accO[2] = {zero16(), zero16()};
#pragma unroll 1
    for (int kt = 0; kt < 4; ++kt) {
        kv_tile_load(T, Kh, VTh, tok0 + (kt < 3 ? kt + 1 : kt) * 32, lane);
        bf16x8 kf[4], vf[2][2]; kv_tile_frags(wl, lane, kf, vf);
        f32x16 st = zero16();
#pragma unroll
        for (int s = 0; s < 4; ++s) st = mma32(kf[s], qf[s], st);
#pragma unroll
        for (int r = 0; r < 16; ++r) { const int j = kt * 32 + DROW(r, h), df = iq - j;
            const float w = df > 0 ? ex2(lgf * (float)df) : (df < 0 ? ex2(lgr * (float)(-df)) : 2.f); st[r] *= w; }
        const bf16x8 p0 = accB<0>(st), p1 = accB<1>(st);
        accO[0] = mma32(vf[0][0], p0, accO[0]); accO[0] = mma32(vf[0][1], p1, accO[0]); accO[1] = mma32(vf[1][0], p0, accO[1]); accO[1] = mma32(vf[1][1], p1, accO[1]);
        kv_tile_store(T, wl, lane);
    }
    const float cf = ex2(lgf * (float)(iq + 1)), cr = ex2(lgr * (float)(128 - iq));
#pragma unroll
    for (int dir = 0; dir < 2; ++dir) { const bf16* sp = SPREV + ((size_t)((b * 4 + hd) * 2 + dir) * 66 + n) * 4096;
#pragma unroll
        for (int et = 0; et < 2; ++et) { f32x16 a = zero16();
#pragma unroll
            for (int s = 0; s < 4; ++s) a = mma32(ldg8(sp + (size_t)(et * 32 + li) * 64 + 16 * s + 8 * h), qf[s], a);
            const float sc = dir == 0 ? cf : cr;
#pragma unroll
            for (int r = 0; r < 16; ++r) accO[et][r] += sc * a[r]; } }
    float s1 = 0.f;
#pragma unroll
    for (int et = 0; et < 2; ++et)
#pragma unroll
        for (int r = 0; r < 16; ++r) s1 += accO[et][r];
    s1 = xor32_sum(s1); const float mu = s1 * (1.f / 64.f);
    float s2 = 0.f;
#pragma unroll
    for (int et = 0; et < 2; ++et)
#pragma unroll
        for (int r = 0; r < 16; ++r) { const float dlt = accO[et][r] - mu; s2 += dlt * dlt; }
    s2 = xor32_sum(s2); const float rstd = __builtin_amdgcn_rsqf(s2 * (1.f / 64.f) + EPSN);
    const size_t tok = (size_t)(tok0 + iq);
#pragma unroll
    for (int et = 0; et < 2; ++et)
#pragma unroll
        for (int q = 0; q < 4; ++q) { const int e0 = hd * 64 + et * 32 + 8 * q + 4 * h;
            const f32x4 gv = *(const f32x4*)(gn + e0); const u32x2 gg = *(const u32x2*)(RG + tok * 256 + e0);
            const float g0 = bflo(gg.x), g1 = bfhi(gg.x), g2 = bflo(gg.y), g3 = bfhi(gg.y);
            u32x2 w; w.x = pk2(silu_(g0) * (accO[et][4 * q] - mu) * rstd * gv[0], silu_(g1) * (accO[et][4 * q + 1] - mu) * rstd * gv[1]);
            w.y = pk2(silu_(g2) * (accO[et][4 * q + 2] - mu) * rstd * gv[2], silu_(g3) * (accO[et][4 * q + 3] - mu) * rstd * gv[3]);
            *(u32x2*)(MIX + tok * 1024 + 512 + e0) = w; }
}

__device__ __forceinline__ int na_tile_tok(int t, int b, int rs) { const int tb = t - 8; return t >= 8 ? b * SEQ + (rs + (tb >> 1)) * 64 + (tb & 1) * 32 : LROWS + b * CTXL + t * 32; }
__device__ __forceinline__ void na_item(const bf16* NQ, const bf16* NK, const bf16* NVT, bf16* MIX, const LAS float* rpb2, LAS unsigned char* wl, bool ctxq, int b, int r, int hd, int qs, int lane) {
    const int li = lane & 31, h = lane >> 5;
    const int tokq = ctxq ? LROWS + b * CTXL + qs * 32 + li : b * SEQ + r * 64 + qs * 32 + li;
    bf16x8 qf[4];
#pragma unroll
    for (int s = 0; s < 4; ++s) qf[s] = ldg8(NQ + (size_t)tokq * 256 + hd * 64 + 16 * s + 8 * h);
    float mrun = -1e30f, lrun = 0.f;
    f32x16 accO[2] = {zero16(), zero16()};
    const int rs = r - 4 < 0 ? 0 : (r - 4 > 120 ? 120 : r - 4);
    const int qc = qs * 32 + li, cs = qc - 8 < 0 ? 0 : (qc - 8 > 48 ? 48 : qc - 8);
    const int ntile = ctxq ? 8 : 24;
    const float c1 = 0.125f * LOG2E;
    const bf16* Kh = NK + hd * 64; const bf16* VTh = NVT + (size_t)hd * 64 * R;
    KVTile T; kv_tile_load(T, Kh, VTh, na_tile_tok(0, b, rs), lane); kv_tile_store(T, wl, lane);
#pragma unroll 1
    for (int t = 0; t < ntile; ++t) {
        const bool band = t >= 8; const int tb = t - 8, rr = rs + (tb >> 1), ct = tb & 1;
        kv_tile_load(T, Kh, VTh, na_tile_tok(t + 1 < ntile ? t + 1 : t, b, rs), lane);
        bf16x8 kf[4], vf[2][2]; kv_tile_frags(wl, lane, kf, vf);
        f32x16 st = zero16();
#pragma unroll
        for (int s = 0; s < 4; ++s) st = mma32(kf[s], qf[s], st);
        float mt = -INFINITY;
        if (band) { const int dr = rr - r + 7; const LAS float* bp = rpb2 + ((hd * 15 + dr) * 31 + 32 * ct - qc + 15 + 4 * h); const int d0 = 32 * ct + 4 * h - cs;
#pragma unroll
            for (int g = 0; g < 16; ++g) { const int o = 8 * (g >> 2) + (g & 3); const bool inw = (unsigned)(d0 + o) < 16u;
                const float v = inw ? st[g] * c1 + bp[o] : -INFINITY; st[g] = v; mt = fmaxf(mt, v); }
        } else {
#pragma unroll
            for (int g = 0; g < 16; ++g) { const float v = st[g] * c1; st[g] = v; mt = fmaxf(mt, v); }
        }
        mt = xor32_max(mt);
        const float mnew = fmaxf(mrun, mt);
        if (__builtin_amdgcn_ballot_w64(mnew > mrun)) { const float alpha = ex2(mrun - mnew); lrun *= alpha;
#pragma unroll
            for (int et = 0; et < 2; ++et)
#pragma unroll
                for (int g = 0; g < 16; ++g) accO[et][g] *= alpha; }
        mrun = mnew;
        float ps = 0.f;
#pragma unroll
        for (int g = 0; g < 16; ++g) { const float p = ex2(st[g] - mnew); st[g] = p; ps += p; }
        lrun += xor32_sum(ps);
        const bf16x8 p0 = accB<0>(st), p1 = accB<1>(st);
        accO[0] = mma32(vf[0][0], p0, accO[0]); accO[0] = mma32(vf[0][1], p1, accO[0]); accO[1] = mma32(vf[1][0], p0, accO[1]); accO[1] = mma32(vf[1][1], p1, accO[1]);
        kv_tile_store(T, wl, lane);
    }
    const float inv = 1.f / lrun;
#pragma unroll
    for (int et = 0; et < 2; ++et)
#pragma unroll
        for (int q = 0; q < 4; ++q) { u32x2 w; w.x = pk2(accO[et][4 * q] * inv, accO[et][4 * q + 1] * inv); w.y = pk2(accO[et][4 * q + 2] * inv, accO[et][4 * q + 3] * inv);
            *(u32x2*)(MIX + (size_t)tokq * 1024 + 768 + hd * 64 + et * 32 + 8 * q + 4 * h) = w; }
}

__device__ __forceinline__ void fft1_item(const bf16* F, const bf16* W128T, const float* TWC, const float* TWS, bf16* FB, int item, int lane) {
    const int l2 = item & 63, g = (item >> 6) & 3, b = item >> 8, li = lane & 31, h = lane >> 5;
    bf16x8 idf[4];
#pragma unroll
    for (int s = 0; s < 4; ++s) { float v[8];
#pragma unroll
        for (int j = 0; j < 8; ++j) v[j] = (16 * (s & 1) + 8 * h + j == li) ? 1.f : 0.f;
        idf[s] = pack8(v); }
    bf16x8 xb[4][2][2];
#pragma unroll
    for (int lt = 0; lt < 4; ++lt) {
        const bf16* xp = F + (size_t)(b * SEQ + 64 * (lt * 32 + li) + l2) * 256 + g * 64 + 8 * h;
        const bf16x8 x0 = ldg8(xp), x1 = ldg8(xp + 16), x2 = ldg8(xp + 32), x3 = ldg8(xp + 48);
        f32x16 c0 = zero16(), c1 = zero16();
        c0 = mma32(x0, idf[0], c0); c0 = mma32(x1, idf[1], c0);
        c1 = mma32(x2, idf[0], c1); c1 = mma32(x3, idf[1], c1);
        xb[lt][0][0] = accB<0>(c0); xb[lt][0][1] = accB<1>(c0); xb[lt][1][0] = accB<0>(c1); xb[lt][1][1] = accB<1>(c1);
    }
#pragma unroll 1
    for (int kb = 0; kb < 4; ++kb) {
        f32x16 acc[2][2];
#pragma unroll
        for (int ri = 0; ri < 2; ++ri) { acc[ri][0] = zero16(); acc[ri][1] = zero16();
            const bf16* wp = W128T + ((size_t)ri * 128 + kb * 32 + li) * 128 + 4 * h;
#pragma unroll
            for (int lt = 0; lt < 4; ++lt)
#pragma unroll
                for (int s = 0; s < 2; ++s) { const bf16x8 wf = ldg8p(wp + lt * 32 + 16 * s);
                    acc[ri][0] = mma32(wf, xb[lt][0][s], acc[ri][0]); acc[ri][1] = mma32(wf, xb[lt][1][s], acc[ri][1]); } }
#pragma unroll
        for (int q = 0; q < 4; ++q) { const int k1 = kb * 32 + 8 * q + 4 * h;
            const f32x4 tc = *(const f32x4*)(TWC + l2 * 128 + k1), ts = *(const f32x4*)(TWS + l2 * 128 + k1);
#pragma unroll
            for (int j = 0; j < 4; ++j)
#pragma unroll
                for (int ct = 0; ct < 2; ++ct) { const float ar = acc[0][ct][4 * q + j], ai = acc[1][ct][4 * q + j];
                    const float br = ar * tc[j] + ai * ts[j], bi = ai * tc[j] - ar * ts[j];
                    bf16* o = FB + ((((size_t)(b * 4 + g) * 128 + k1 + j) * 2) * 64 + l2) * 64 + ct * 32 + li;
                    o[0] = (bf16)(pk2(br, 0.f) & 0xffffu); o[64 * 64] = (bf16)(pk2(bi, 0.f) & 0xffffu); } }
    }
}
__device__ __forceinline__ void fft2_item(const bf16* FB, const bf16* FCT, const bf16* W64T, bf16* MIX, int item, int lane) {
    const int mh = item & 1, k1 = (item >> 1) & 127, g = (item >> 8) & 3, b = item >> 10, li = lane & 31, h = lane >> 5;
    const bf16* br = FB + (((size_t)(b * 4 + g) * 128 + k1) * 2) * 64 * 64; const bf16* bi = br + 64 * 64;
    const bf16* fc = FCT + (size_t)(mh * 32 + li) * 64 + 8 * h; const bf16* fs = fc + 64 * 64; const bf16* fn = fc + 2 * 64 * 64;
    bf16x8 eb[2][2][2];
#pragma unroll
    for (int lt = 0; lt < 2; ++lt) { f32x16 er = zero16(), ei = zero16();
#pragma unroll
        for (int s = 0; s < 4; ++s) { const bf16x8 ar = ldg8(br + (size_t)(lt * 32 + li) * 64 + 16 * s + 8 * h), ai = ldg8(bi + (size_t)(lt * 32 + li) * 64 + 16 * s + 8 * h);
            const bf16x8 c = ldg8(fc + 16 * s), sn = ldg8(fs + 16 * s), ns = ldg8(fn + 16 * s);
            er = mma32(ar, c, er); er = mma32(ai, sn, er); ei = mma32(ai, c, ei); ei = mma32(ar, ns, ei); }
        eb[lt][0][0] = accB<0>(er); eb[lt][0][1] = accB<1>(er); eb[lt][1][0] = accB<0>(ei); eb[lt][1][1] = accB<1>(ei); }
#pragma unroll
    for (int kt = 0; kt < 2; ++kt) { f32x16 o = zero16();
        const bf16* wc = W64T + (size_t)(kt * 32 + li) * 64 + 4 * h; const bf16* wsn = wc + 64 * 64;
#pragma unroll
        for (int lt = 0; lt < 2; ++lt)
#pragma unroll
            for (int s = 0; s < 2; ++s) { o = mma32(ldg8p(wc + lt * 32 + 16 * s), eb[lt][0][s], o); o = mma32(ldg8p(wsn + lt * 32 + 16 * s), eb[lt][1][s], o); }
#pragma unroll
        for (int rg = 0; rg < 16; ++rg) { const int k2 = kt * 32 + DROW(rg, h);
            MIX[(size_t)(b * SEQ + k1 + 128 * k2) * 1024 + g * 64 + mh * 32 + li] = (bf16)(pk2(o[rg], 0.f) & 0xffffu); } }
}
__device__ __forceinline__ void fftc_item(const bf16* F, const bf16* FCT, const bf16* W256T, bf16* MIX, int item, int lane) {
    const int mh = item & 1, kb = (item >> 1) & 7, g = (item >> 4) & 3, b = item >> 6, li = lane & 31, h = lane >> 5;
    const bf16* fc = FCT + (size_t)(mh * 32 + li) * 64 + 8 * h; const bf16* fn = fc + 2 * 64 * 64;
    const bf16* wc = W256T + (size_t)(kb * 32 + li) * 256 + 4 * h; const bf16* wsn = wc + 256 * 256;
    f32x16 o = zero16();
#pragma unroll 1
    for (int lt = 0; lt < 8; ++lt) { f32x16 zr = zero16(), zi = zero16();
        const bf16* xp = F + (size_t)(LROWS + b * CTXL + lt * 32 + li) * 256 + g * 64 + 8 * h;
#pragma unroll
        for (int s = 0; s < 4; ++s) { const bf16x8 x = ldg8(xp + 16 * s); zr = mma32(x, ldg8(fc + 16 * s), zr); zi = mma32(x, ldg8(fn + 16 * s), zi); }
        o = mma32(ldg8p(wc + lt * 32), accB<0>(zr), o); o = mma32(ldg8p(wc + lt * 32 + 16), accB<1>(zr), o);
        o = mma32(ldg8p(wsn + lt * 32), accB<0>(zi), o); o = mma32(ldg8p(wsn + lt * 32 + 16), accB<1>(zi), o); }
#pragma unroll
    for (int rg = 0; rg < 16; ++rg) { const int k = kb * 32 + DROW(rg, h);
        MIX[(size_t)(LROWS + b * CTXL + k) * 1024 + g * 64 + mh * 32 + li] = (bf16)(pk2(o[rg], 0.f) & 0xffffu); }
}
__device__ __forceinline__ void row_ld_f32(const float* p, int lane, f32x4 (&v)[4]) {
#pragma unroll
    for (int j = 0; j < 4; ++j) v[j] = *(const f32x4*)(p + 256 * j + 4 * lane); }
__device__ __forceinline__ void row_ld_bf16(const bf16* p, int lane, f32x4 (&v)[4]) {
#pragma unroll
    for (int j = 0; j < 4; ++j) { const u32x2 w = *(const u32x2*)(p + 256 * j + 4 * lane); v[j] = (f32x4){bflo(w.x), bfhi(w.x), bflo(w.y), bfhi(w.y)}; } }
__device__ __forceinline__ void row_ld_part(const float* P, int nslice, int r, int lane, f32x4 (&v)[4]) {
#pragma unroll
    for (int j = 0; j < 4; ++j) { const float* p = P + ((size_t)((((r - LROWS) >> 8) * 4 + j) * nslice) * 256 + (r & 255)) * 256 + 4 * lane; f32x4 s = *(const f32x4*)p;
        for (int k = 1; k < nslice; ++k) s = s + *(const f32x4*)(p + (size_t)k * 65536);
        v[j] = s; } }
__device__ __forceinline__ void row_st_f32(float* p, int lane, const f32x4 (&v)[4]) {
#pragma unroll
    for (int j = 0; j < 4; ++j) *(f32x4*)(p + 256 * j + 4 * lane) = v[j]; }
__device__ __forceinline__ void row_st_bf16(bf16* p, int lane, const f32x4 (&v)[4]) {
#pragma unroll
    for (int j = 0; j < 4; ++j) { u32x2 w; w.x = pk2(v[j][0], v[j][1]); w.y = pk2(v[j][2], v[j][3]); *(u32x2*)(p + 256 * j + 4 * lane) = w; } }
__device__ __forceinline__ void row_st_f8(unsigned char* p, int lane, const f32x4 (&v)[4]) {
#pragma unroll
    for (int j = 0; j < 4; ++j) *(unsigned*)(p + 256 * j + 4 * lane) = pk4_f8(v[j][0], v[j][1], v[j][2], v[j][3]); }
__device__ __forceinline__ float row_rstd(const f32x4 (&v)[4]) { float s = 0.f;
#pragma unroll
    for (int j = 0; j < 4; ++j) s += (v[j][0] * v[j][0] + v[j][1] * v[j][1]) + (v[j][2] * v[j][2] + v[j][3] * v[j][3]);
    return __builtin_amdgcn_rsqf(wave_sum(s) * (1.f / 1024.f) + EPSN); }
__device__ __forceinline__ void row_modnorm(const f32x4 (&x)[4], const float* g, const float* sc, const float* sh, int lane, f32x4 (&hh)[4]) {
    const float rs = row_rstd(x); f32x4 gv[4], scv[4], shv[4]; row_ld_f32(g, lane, gv); row_ld_f32(sc, lane, scv); row_ld_f32(sh, lane, shv);
#pragma unroll
    for (int j = 0; j < 4; ++j) hh[j] = x[j] * rs * gv[j] * (scv[j] + 1.f) + shv[j]; }
__device__ __forceinline__ void row_resid(f32x4 (&x)[4], const f32x4 (&t)[4], const float* g, const float* gate, int lane) {
    const float rs = row_rstd(t); f32x4 gv[4], ga[4]; row_ld_f32(g, lane, gv); row_ld_f32(gate, lane, ga);
#pragma unroll
    for (int j = 0; j < 4; ++j) x[j] = x[j] + ga[j] * (t[j] * rs * gv[j]); }

struct NormCfg {
    const float* xin_lat; const float* xin_ctx;
    float* xout_lat; float* xout_ctx;
    const bf16* trow;
    const float* tpart; int npart;
    const float* gA; const float* modA; int gate_off;
    const float* gB; const float* modB; int sc_off, sh_off; bf16* hout;
    int nrows;
    unsigned char* hout8;
};
__device__ __forceinline__ void norm_rows(const NormCfg& C, int wslot, int NW, int lane) {
    const int nlat = C.nrows < LROWS ? C.nrows : LROWS;
    int r = wslot;
    if (r < nlat) {
        int cur = -1; f32x4 gav[4], scv[4], shv[4];
        f32x4 xn[4]; u32x2 tn[4];
#pragma unroll
        for (int j = 0; j < 4; ++j) { tn[j] = (u32x2){0u, 0u}; gav[j] = scv[j] = shv[j] = (f32x4){0.f, 0.f, 0.f, 0.f}; }
        row_ld_f32(C.xin_lat + (size_t)r * D, lane, xn);
        if (C.trow) {
#pragma unroll
            for (int j = 0; j < 4; ++j) tn[j] = *(const u32x2*)(C.trow + (size_t)r * D + 256 * j + 4 * lane); }
        for (; r < nlat; r += NW) {
            f32x4 x[4]; u32x2 tr[4];
#pragma unroll
            for (int j = 0; j < 4; ++j) { x[j] = xn[j]; tr[j] = tn[j]; }
            const int r2 = r + NW;
            if (r2 < nlat) { row_ld_f32(C.xin_lat + (size_t)r2 * D, lane, xn);
                if (C.trow) {
#pragma unroll
                    for (int j = 0; j < 4; ++j) tn[j] = *(const u32x2*)(C.trow + (size_t)r2 * D + 256 * j + 4 * lane); } }
            const int ci = r < SEQ ? 0 : 1;
            if (ci != cur) { cur = ci;
                if (C.trow) row_ld_f32(C.modA + (size_t)ci * 6144 + C.gate_off, lane, gav);
                if (C.gB) { row_ld_f32(C.modB + (size_t)ci * 6144 + C.sc_off, lane, scv); row_ld_f32(C.modB + (size_t)ci * 6144 + C.sh_off, lane, shv); } }
            if (C.trow) { f32x4 t[4], gAv[4]; row_ld_f32(C.gA, lane, gAv);
#pragma unroll
                for (int j = 0; j < 4; ++j) t[j] = (f32x4){bflo(tr[j].x), bfhi(tr[j].x), bflo(tr[j].y), bfhi(tr[j].y)};
                const float rs = row_rstd(t);
#pragma unroll
                for (int j = 0; j < 4; ++j) x[j] = x[j] + gav[j] * (t[j] * rs * gAv[j]);
                row_st_f32(C.xout_lat + (size_t)r * D, lane, x); }
            if (C.gB) { f32x4 gBv[4]; row_ld_f32(C.gB, lane, gBv); const float rs = row_rstd(x); f32x4 hh[4];
#pragma unroll
                for (int j = 0; j < 4; ++j) hh[j] = x[j] * rs * gBv[j] * (scv[j] + 1.f) + shv[j];
                row_st_bf16(C.hout + (size_t)r * D, lane, hh); if (C.hout8) row_st_f8(C.hout8 + (size_t)r * D, lane, hh); }
        }
    }
    for (r = LROWS + wslot; r < C.nrows; r += NW) {
        f32x4 x[4]; row_ld_f32(C.xin_ctx + (size_t)(r - LROWS) * D, lane, x);
        if (C.trow) { f32x4 t[4]; if (C.tpart) row_ld_part(C.tpart, C.npart, r, lane, t); else row_ld_bf16(C.trow + (size_t)r * D, lane, t);
            row_resid(x, t, C.gA, C.modA + (size_t)2 * 6144 + C.gate_off, lane); row_st_f32(C.xout_ctx + (size_t)(r - LROWS) * D, lane, x); }
        if (C.gB) { f32x4 hh[4]; row_modnorm(x, C.gB, C.modB + (size_t)2 * 6144 + C.sc_off, C.modB + (size_t)2 * 6144 + C.sh_off, lane, hh); row_st_bf16(C.hout + (size_t)r * D, lane, hh); if (C.hout8) row_st_f8(C.hout8 + (size_t)r * D, lane, hh); }
    }
}

__device__ __forceinline__ void transpose_item(const float* W, int ldw, int k0, int n0, bf16* dst, int ldd, float scale, LAS float* scr, int lane) {
#pragma unroll 8
    for (int i = 0; i < 32; ++i) { const int kk = 2 * i + (lane >> 5); scr[kk * 33 + (lane & 31)] = W[(size_t)(k0 + kk) * ldw + n0 + (lane & 31)]; }
    LDS_WAIT(); asm volatile("" ::: "memory");
    const int c = lane & 7;
#pragma unroll
    for (int j = 0; j < 4; ++j) { const int n = (lane >> 3) + 8 * j; const LAS float* s = scr + (8 * c) * 33 + n;
        u32x4 o; o.x = pk2(s[0 * 33] * scale, s[1 * 33] * scale); o.y = pk2(s[2 * 33] * scale, s[3 * 33] * scale); o.z = pk2(s[4 * 33] * scale, s[5 * 33] * scale); o.w = pk2(s[6 * 33] * scale, s[7 * 33] * scale);
        *(u32x4*)(dst + (size_t)n * ldd + k0 + 8 * c) = o; }
    LDS_WAIT(); asm volatile("" ::: "memory");
}
#ifndef MK_MODE
#define MK_MODE 1
#endif
#ifndef MK_LAST
#define MK_LAST 24
#endif
constexpr int NPHASE = 24;
struct Args { const float* in[31]; float* out; unsigned char* ws; int ph_lo, ph_hi, li, pad; };


struct TrJob { const float* src; unsigned char* dst; int ldw, k0, n0, ldd, esz; float scale; };
#define CAS __attribute__((address_space(4)))
constexpr float MOE_W1S = 32.f, MOE_W2S = 64.f, MOE_HS = 2.f, WIN_S = 32.f;
constexpr int NTR = 60096, NTRQ = NTR / 8;
__device__ __forceinline__ void tr_decode(int it, const CAS Args* ap_, unsigned char* ws, TrJob& J) {
#define TIN(k) ((const float*)(const GAS float*)ap_->in[k])
    int kb; J.scale = 1.f; J.esz = 2;
    if (it < 43008) { const int e = it / 5376, r = it % 5376, w = r / 1792, li = r % 1792; J.esz = 1;
        if (w < 2) { J.src = TIN(28 + w) + (size_t)e * 1024 * DFE; J.ldw = DFE; kb = li / 112; J.n0 = (li % 112) * 32; J.ldd = 1024; J.scale = MOE_W1S;
            J.dst = ws + WS_MOE1 + ((size_t)e * 7168 + 256 * (J.n0 / 128) + (J.n0 % 128) + 128 * w) * 1024; }
        else { J.src = TIN(30) + (size_t)e * DFE * 1024; J.ldw = 1024; kb = li / 32; J.n0 = (li % 32) * 32; J.ldd = DFE; J.scale = MOE_W2S; J.dst = ws + WS_MOE2 + ((size_t)e * 1024 + J.n0) * DFE; }
    } else if (it < 47232) { const int r = it - 43008, w = r / 1408, li = r % 1408;
        if (w < 2) { J.src = TIN(23 + w); J.ldw = DFF; kb = li / 88; J.n0 = (li % 88) * 32; J.ldd = 1024; J.dst = ws + WS_FFN1 + (size_t)(256 * (J.n0 / 128) + (J.n0 % 128) + 128 * w) * 1024 * 2; }
        else { J.src = TIN(25); J.ldw = 1024; kb = li / 32; J.n0 = (li % 32) * 32; J.ldd = DFF; J.dst = ws + WS_FFN2 + (size_t)J.n0 * DFF * 2; }
    } else if (it >= 56000) { const int r = it - 56000, l = r / 2048, q = r % 2048; kb = q / 128; const int nb = q % 128; J.esz = 1; J.scale = WIN_S;
        J.src = TIN(7) + (size_t)l * 1024 * 6400; J.ldw = 6400; J.n0 = 2304 + 32 * nb; J.ldd = 1024; J.dst = ws + WS_WG8 + ((size_t)l * 4096 + 32 * nb) * 1024;
    } else { const int r = it - 47232, l = r / 4384, q = r % 4384;
        if (q < 3328) { const int t = q / 128, li = q % 128; kb = li / 8; const int nb = li % 8; if (l == 1 && t >= 7 && t < 23) J.esz = 0;
            const int srcc = t < 4 ? 256 * t : (t < 7 ? 256 * (t + 1) : (t < 23 ? 2304 + 256 * (t - 7) : (t == 23 ? 768 : (t == 24 ? 1024 : 2048))));
            J.src = TIN(7) + (size_t)l * 1024 * 6400; J.ldw = 6400; J.n0 = srcc + 32 * nb; J.ldd = 1024; J.dst = ws + WS_WIN + ((size_t)(l * 26 + t) * 256 + 32 * nb) * 1024 * 2; J.scale = (t == 3 || t == 23) ? 0.125f : 1.f; }
        else if (q < 3360) { const int li = q - 3328; kb = li / 8; J.n0 = (li % 8) * 32; J.src = TIN(16) + (size_t)l * 65536; J.ldw = 256; J.ldd = 256; J.dst = ws + WS_WGLU + ((size_t)l * 256 + J.n0) * 256 * 2; }
        else if (q < 3872) { const int li = q - 3360, bb = li / 128, li2 = li % 128; kb = li2 / 32; J.n0 = (li2 % 32) * 32; J.src = TIN(21) + (size_t)(l * 4 + bb) * 256 * 1024; J.ldw = 1024; J.ldd = 1024; J.dst = ws + WS_WBR + (((size_t)l * 1024 + J.n0) * 1024 + bb * 256) * 2; }
        else { const int li = q - 3872; kb = li / 32; J.n0 = (li % 32) * 32; J.src = TIN(22) + (size_t)l * 1024 * 1024; J.ldw = 1024; J.ldd = 1024; J.dst = ws + WS_WOUT + ((size_t)l * 1024 + J.n0) * 1024 * 2; }
    }
    J.k0 = kb * 64;
#undef TIN
}
__device__ __forceinline__ void tr_load(const TrJob& J, int lane, float (&v)[32]) {
    if (J.esz == 0) return;
#pragma unroll
    for (int i = 0; i < 32; ++i) { const int kk = 2 * i + (lane >> 5); v[i] = J.src[(size_t)(J.k0 + kk) * J.ldw + J.n0 + (lane & 31)]; } }
__device__ __forceinline__ void tr_store(const TrJob& J, int lane, const float (&v)[32], LAS float* scr) {
    if (J.esz == 0) return;
#pragma unroll
    for (int i = 0; i < 32; ++i) { const int kk = 2 * i + (lane >> 5); scr[kk * 33 + (lane & 31)] = v[i]; }
    LDS_WAIT(); asm volatile("" ::: "memory");
    const int c = lane & 7;
#pragma unroll
    for (int j = 0; j < 4; ++j) { const int n = (lane >> 3) + 8 * j; const LAS float* s = scr + (8 * c) * 33 + n; const float sc = J.scale;
        if (J.esz == 2) { u32x4 o; o.x = pk2(s[0 * 33] * sc, s[1 * 33] * sc); o.y = pk2(s[2 * 33] * sc, s[3 * 33] * sc); o.z = pk2(s[4 * 33] * sc, s[5 * 33] * sc); o.w = pk2(s[6 * 33] * sc, s[7 * 33] * sc);
            *(u32x4*)(J.dst + ((size_t)n * J.ldd + J.k0 + 8 * c) * 2) = o; }
        else { u32x2 o; o.x = pk4_f8(s[0 * 33] * sc, s[1 * 33] * sc, s[2 * 33] * sc, s[3 * 33] * sc); o.y = pk4_f8(s[4 * 33] * sc, s[5 * 33] * sc, s[6 * 33] * sc, s[7 * 33] * sc);
            *(u32x2*)(J.dst + (size_t)n * J.ldd + J.k0 + 8 * c) = o; } }
    LDS_WAIT(); asm volatile("" ::: "memory");
}

__device__ __forceinline__ void cs2pi(int m, int N, float& c, float& s) { sincospif(2.0f * (float)(m % N) / (float)N, &s, &c); }

__global__ void __launch_bounds__(NTHREADS, 2) mk_fwd(Args args) {
    extern __shared__ __attribute__((aligned(16))) unsigned char lds_raw[];
    LAS unsigned char* lds = (LAS unsigned char*)lds_raw;
    const int tid0 = threadIdx.x, wave = __builtin_amdgcn_readfirstlane(tid0 >> 6);
    const int G = gridDim.x, bx = blockIdx.x, vcu = (G % 8 == 0) ? (bx % 8) * (G / 8) + bx / 8 : bx;
    const int wslot = wave * G + vcu, NW = G * NWAVES;
    volatile LAS unsigned* lctl = (volatile LAS unsigned*)(lds + LDSCTL_OFF);
    for (int u = tid0; u < (LDS_BYTES - LDSCTL_OFF) / 4; u += NTHREADS) lctl[u] = 0u;
    __syncthreads();
    const int lo = args.ph_lo, hi = args.ph_hi, bli = args.li;
#ifdef MK_STAMP_PHASE
    if (wave == 0) *(volatile LAS unsigned long long*)(lctl + 64) = __builtin_amdgcn_s_memrealtime();
#endif
    { XcdBarrier b0 = xcd_barrier_post((unsigned*)(args.ws + WS_CTL) + CW_BAR + bli * XCD_BAR_WORDS, lctl + LW_BAR); (void)b0; }
#define IN(k) (lo <= (k) && (k) < hi)
#ifndef MK_DBL
#define MK_DBL 0
#endif
#define MK_NR(k) (MK_DBL == (k) ? 2 : 1)
#ifndef MK_REP_MASK
#define MK_REP_MASK 0u
#endif
#define NREP(k) (((MK_REP_MASK >> (k)) & 1u) ? 2 : 1)
#define FORCE_BAR do { PH_BEGIN XcdBarrier b_; b_.bar = (unsigned*)(ws + WS_CTL) + CW_BAR + bli * XCD_BAR_WORDS; b_.x = xb_xcc_id(); b_.st = lctl + LW_BAR; xcd_barrier(b_); } while (0)
#ifdef MK_STAMP_PHASE
#define STAMP_AT(k) do { if (wave == 0) { if ((k) == MK_STAMP_PHASE - 1) *(volatile LAS unsigned long long*)(lctl + 64) = __builtin_amdgcn_s_memrealtime(); if ((k) == MK_STAMP_PHASE) *(volatile LAS unsigned long long*)(lctl + 66) = __builtin_amdgcn_s_memrealtime(); } } while (0)
#else
#define STAMP_AT(k) do { } while (0)
#endif
#define SEAM(k) do { if (IN(k) && IN((k) + 1)) { PH_BEGIN XcdBarrier b_; b_.bar = (unsigned*)(ws + WS_CTL) + CW_BAR + bli * XCD_BAR_WORDS; b_.x = xb_xcc_id(); b_.st = lctl + LW_BAR; xcd_barrier(b_); } STAMP_AT(k); } while (0)
#define PH_BEGIN int tid; { int l_; asm volatile("v_mbcnt_lo_u32_b32 %0, -1, 0\n\tv_mbcnt_hi_u32_b32 %0, -1, %0" : "=v"(l_)); tid = wave * 64 + (l_ & 63); } const CAS Args* ap_ = (const CAS Args*)__builtin_amdgcn_kernarg_segment_ptr(); asm volatile("" : "+s"(ap_)); unsigned char* ws = (unsigned char*)(GAS unsigned char*)ap_->ws; const int lane = tid & 63; (void)lane;
#define AIN(k) ((const float*)(const GAS float*)ap_->in[k])
#define AOUT ((float*)(GAS float*)ap_->out)
#define MODp ((float*)(ws + CTL_MOD_OFF))
#define ctxbuf ((float*)(ws + WS_CTXBUF))
#define Hh ((bf16*)(ws + WS_H))
#define MIX ((bf16*)(ws + WS_MIX))
#define INP ((bf16*)(ws + WS_INP))
#define Tt ((bf16*)(ws + WS_T))

    for (int rep_ = 0; rep_ < NREP(0); ++rep_) if (IN(0)) { if (rep_) { FORCE_BAR; } PH_BEGIN
        for (int dd_ = 0; dd_ < MK_NR(20); ++dd_) for (int it = bx; it < 32; it += G) {
            const int l = it >> 4, g = it & 15;
            LAS f32x2* apow = (LAS f32x2*)lds; LAS f32x2* bbar = (LAS f32x2*)(lds + 8704); LAS f32x2* Cc = (LAS f32x2*)(lds + 16896); LAS float* Kt = (LAS float*)(lds + 25088);
            for (int dir = 0; dir < 2; ++dir) { const size_t pg = (size_t)(l * 2 + dir) * 16 + g;
                if (tid < 64) { const int p = tid;
                    const float are = AIN(8)[pg * 64 + p], aim = AIN(9)[pg * 64 + p], dt = expf(AIN(10)[pg]);
                    for (int t = 0; t <= 16; ++t) { const float mag = expf(are * dt * (float)t); float sn, cs; sincosf(aim * dt * (float)t, &sn, &cs); apow[t * 64 + p] = (f32x2){mag * cs, mag * sn}; }
                    const f32x2 a = apow[64 + p]; const float nr = a.x - 1.f, ni = a.y, den = 1.f / (are * are + aim * aim);
                    const float cr = (nr * are + ni * aim) * den, ci = (ni * are - nr * aim) * den;
                    for (int h = 0; h < 16; ++h) { const float br = AIN(11)[(pg * 64 + p) * 16 + h], bi = AIN(12)[(pg * 64 + p) * 16 + h]; bbar[p * 16 + h] = (f32x2){cr * br - ci * bi, cr * bi + ci * br}; }
                    *(f32x2*)((float*)(ws + WS_A16) + (pg * 64 + p) * 2) = apow[16 * 64 + p];
                }
                for (int i = tid; i < 1024; i += NTHREADS) Cc[i] = (f32x2){AIN(13)[pg * 1024 + i], AIN(14)[pg * 1024 + i]};
                __syncthreads();
                bf16* M1 = (bf16*)(ws + WS_S5M1) + ((size_t)(l * 16 + g) * 2 + dir) * 128 * 256;
                for (int v = tid; v < 4096; v += NTHREADS) { const int row = v >> 5, col0 = (v & 31) * 8, j = col0 >> 4, h0 = col0 & 15, p = row >> 1, ri = row & 1;
                    const f32x2 pw = apow[(dir == 0 ? 15 - j : j) * 64 + p]; float vals[8];
#pragma unroll
                    for (int hh = 0; hh < 8; ++hh) { const f32x2 bb = bbar[p * 16 + h0 + hh]; vals[hh] = ri ? pw.x * bb.y + pw.y * bb.x : pw.x * bb.x - pw.y * bb.y; }
                    *(bf16x8*)(M1 + ((((col0 >> 4) * 4 + (row >> 5)) * 64 + ((col0 >> 3) & 1) * 32 + (row & 31)) * 8)) = pack8(vals); }
                bf16* TAB = (bf16*)(ws + WS_S5TAB) + (size_t)(l * 16 + g) * 256 * 512;
                for (int v = tid; v < 4096; v += NTHREADS) { const int row = v >> 4, cv = v & 15, i = row >> 4, ho = row & 15; float vals[8];
#pragma unroll
                    for (int pp = 0; pp < 4; ++pp) { const int p = cv * 4 + pp; const f32x2 cc = Cc[ho * 64 + p];
                        const f32x2 pw = apow[(dir == 0 ? i + 1 : 16 - i) * 64 + p]; vals[2 * pp] = cc.x * pw.x - cc.y * pw.y; vals[2 * pp + 1] = -(cc.x * pw.y + cc.y * pw.x); }
                    { const int colt = 256 + dir * 128 + cv * 8; *(bf16x8*)(TAB + (((((row >> 7) * 32 + (colt >> 4)) * 4 + ((row >> 5) & 3)) * 64 + ((colt >> 3) & 1) * 32 + (row & 31)) * 8)) = pack8(vals); } }
                for (int e = tid; e < 4096; e += NTHREADS) { const int t = e >> 8, ho = (e >> 4) & 15, h = e & 15; float acc = 0.f;
#pragma unroll 8
                    for (int p = 0; p < 64; ++p) { const f32x2 cc = Cc[ho * 64 + p], pw = apow[t * 64 + p], bb = bbar[p * 16 + h];
                        const float xr = cc.x * pw.x - cc.y * pw.y, xi = cc.x * pw.y + cc.y * pw.x; acc += xr * bb.x - xi * bb.y; }
                    Kt[dir * 4096 + e] = acc; }
                __syncthreads();
            }
            for (int v = tid; v < 8192; v += NTHREADS) { const int row = v >> 5, col0 = (v & 31) * 8, i = row >> 4, ho = row & 15, j = col0 >> 4, h0 = col0 & 15; float vals[8];
#pragma unroll
                for (int hh = 0; hh < 8; ++hh) { const int h = h0 + hh;
                    vals[hh] = j < i ? Kt[(i - j) * 256 + ho * 16 + h] : (j > i ? Kt[4096 + (j - i) * 256 + ho * 16 + h] : Kt[ho * 16 + h] + Kt[4096 + ho * 16 + h] + (ho == h ? AIN(15)[l * 256 + g * 16 + h] : 0.f)); }
                *(bf16x8*)((bf16*)(ws + WS_S5TAB) + (size_t)(l * 16 + g) * 256 * 512 + (((((row >> 7) * 32 + (col0 >> 4)) * 4 + ((row >> 5) & 3)) * 64 + ((col0 >> 3) & 1) * 32 + (row & 31)) * 8)) = pack8(vals); }
            __syncthreads();
        }
        __syncthreads();
        for (int it = (bx >= 32 ? bx - 32 : bx + G - 32); it < 192; it += G) { const int l = it / 96, cb = it % 96, col = cb * 64 + lane, ks = wave;
            const float* wm = AIN(4) + ((size_t)l * 1024 + ks * 128) * 6144 + col; float a0 = 0.f, a1 = 0.f, a2 = 0.f;
#pragma unroll 8
            for (int k = 0; k < 128; ++k) { const float w = wm[(size_t)k * 6144]; const int kk = ks * 128 + k;
                const float c0 = AIN(1)[kk], c1 = AIN(1)[1024 + kk], c2 = AIN(3)[kk];
                a0 += w * (c0 / (1.f + __expf(-c0))); a1 += w * (c1 / (1.f + __expf(-c1))); a2 += w * (c2 / (1.f + __expf(-c2))); }
            LAS float* part = (LAS float*)lds;
            part[(wave * 3 + 0) * 64 + lane] = a0; part[(wave * 3 + 1) * 64 + lane] = a1; part[(wave * 3 + 2) * 64 + lane] = a2;
            __syncthreads();
            if (tid < 192) { const int i = tid >> 6, c = tid & 63; float sacc = AIN(5)[l * 6144 + cb * 64 + c];
#pragma unroll
                for (int w = 0; w < 8; ++w) sacc += part[(w * 3 + i) * 64 + c];
                MODp[(size_t)(l * 3 + i) * 6144 + cb * 64 + c] = sacc; }
            __syncthreads();
        }
        { LAS float* scr = (LAS float*)(lds + wave * 16384);
          unsigned* qh = (unsigned*)(ws + WS_CTL) + CW_QHEAD;
          int q = bx & 7, tries = 0;
#define TR_POP(dst) do { dst = -1; while (tries < 8) { unsigned b_ = 0u; if (lane == 0) b_ = __hip_atomic_fetch_add(qh + 64 * q, 2u, __ATOMIC_RELAXED, __HIP_MEMORY_SCOPE_AGENT); \
              b_ = (unsigned)__builtin_amdgcn_readfirstlane((int)b_); if (b_ < (unsigned)NTRQ) { dst = q * NTRQ + (int)b_; break; } q = (q + 1) & 7; ++tries; } } while (0)
#define TR_LOAD2(VA, VB, g_) do { TrJob j_; tr_decode(g_, ap_, ws, j_); tr_load(j_, lane, VA); tr_decode((g_) + (((g_) % NTRQ) + 1 < NTRQ ? 1 : 0), ap_, ws, j_); tr_load(j_, lane, VB); } while (0)
#define TR_STORE2(VA, VB, g_) do { TrJob j_; tr_decode(g_, ap_, ws, j_); tr_store(j_, lane, VA, scr); if (((g_) % NTRQ) + 1 < NTRQ) { tr_decode((g_) + 1, ap_, ws, j_); tr_store(j_, lane, VB, scr); } } while (0)
          float a0[32], a1[32], b0[32], b1[32]; int s0, s1;
          TR_POP(s0); if (s0 >= 0) TR_LOAD2(a0, a1, s0);
          TR_POP(s1);
          while (s0 >= 0) {
              int s2, s3 = -1;
              if (s1 >= 0) TR_LOAD2(b0, b1, s1);
              TR_POP(s2);
              TR_STORE2(a0, a1, s0);
              if (s1 < 0) break;
              if (s2 >= 0) TR_LOAD2(a0, a1, s2);
              TR_POP(s3);
              TR_STORE2(b0, b1, s1);
              s0 = s2; s1 = s3;
          }
#undef TR_POP
#undef TR_LOAD2
#undef TR_STORE2
        }
        for (int v = wslot * 64 + lane; v < 32 * SEQ; v += NW * 64) { const int p = v >> 13, t = v & 8191; const float pos = (float)(p < 16 ? (t >> 6) : (t & 63));
            const float inv = 1.0f / powf(10000.f, (float)(p & 15) / 16.f); float sn, cs; sincosf(pos * inv, &sn, &cs);
            ((float*)(ws + WS_COST))[v] = cs; ((float*)(ws + WS_SINT))[v] = sn; ((float*)(ws + WS_COSN))[t * 32 + p] = cs; ((float*)(ws + WS_SINN))[t * 32 + p] = sn; }
        for (int v = wslot * 64 + lane; v < 192512; v += NW * 64) { float c, s;
            if (v < 32768) { const int ri = v >> 14, k1 = (v >> 7) & 127, l1 = v & 127; cs2pi(k1 * l1, 128, c, s); const float sc = 0.08838834764831845f;
                ((bf16*)(ws + WS_W128T))[v] = (bf16)(pk2(ri ? -s * sc : c * sc, 0.f) & 0xffffu); }
            else if (v < 40960) { const int u = v - 32768, l2 = u >> 7, k1 = u & 127; cs2pi(k1 * l2, 8192, c, s); ((float*)(ws + WS_TWC))[u] = c; ((float*)(ws + WS_TWS))[u] = s; }
            else if (v < 53248) { const int u = v - 40960, w = u >> 12, m = (u >> 6) & 63, cc = u & 63; cs2pi(m * cc, 64, c, s);
                ((bf16*)(ws + WS_FCT))[u] = (bf16)(pk2((w == 0 ? c : (w == 1 ? s : -s)) * 0.125f, 0.f) & 0xffffu); }
            else if (v < 61440) { const int u = v - 53248, w = u >> 12, k2 = (u >> 6) & 63, l2 = u & 63; cs2pi(k2 * l2, 64, c, s); ((bf16*)(ws + WS_W64T))[u] = (bf16)(pk2((w == 0 ? c : s) * 0.125f, 0.f) & 0xffffu); }
            else { const int u = v - 61440, w = u >> 16, k = (u >> 8) & 255, l = u & 255; cs2pi(k * l, 256, c, s); ((bf16*)(ws + WS_W256T))[u] = (bf16)(pk2((w == 0 ? c : s) * 0.0625f, 0.f) & 0xffffu); }
        }
    }
    SEAM(0);

    for (int rep_ = 0; rep_ < NREP(1); ++rep_) if (IN(1)) { if (rep_) { FORCE_BAR; } PH_BEGIN
        { NormCfg C{AIN(0), AIN(2), nullptr, nullptr, nullptr, nullptr, 0, nullptr, nullptr, 0, AIN(6), MODp, 1024, 0, Hh, R, ws + WS_H8}; norm_rows(C, wslot, NW, lane); }
    }
    SEAM(1);

    for (int layer = 0; layer < 2; ++layer) {
        const int pb = 1 + 11 * layer;
        const int nM = layer == 0 ? 66 : 64;
        const int nrows = layer == 0 ? R : LROWS;
#define normg (AIN(6) + (size_t)layer * 4 * D)
        for (int rep_ = 0; rep_ < NREP(pb + 1); ++rep_) if (IN(pb + 1)) { if (rep_) { FORCE_BAR; } PH_BEGIN
            gp::SchedInprojA S{(const char*)Hh, (const char*)(ws + WS_WIN) + (size_t)layer * 26 * 256 * 2048, 66, G, bx, layer == 0 ? 32 : 0};
            gp::EpiInprojA E{INP, Tt, (unsigned char*)(ws + WS_GCTX)};
            gp::gemm_phase(lds, tid, 1024, 1024, 1024, S, E);
        }
        SEAM(pb + 1);
        for (int rep_ = 0; rep_ < NREP(pb + 2); ++rep_) if (IN(pb + 2)) { if (rep_) { FORCE_BAR; } PH_BEGIN
            LAS float* rpb = (LAS float*)(lds + 98304 + 4096);
            LAS unsigned char* wl = lds + wave * 12288;
            for (int i = tid; i < 1860; i += NTHREADS) rpb[i] = AIN(20)[layer * 1860 + i] * LOG2E;
            __syncthreads();
            const int nitA = 2224 + 64 + (layer == 0 ? 64 : 0);
            for (int it = wslot; it < nitA; it += NW) {
                if (it < 1056) s5_state_item((const bf16*)(ws + WS_S5M1) + (size_t)layer * 16 * 2 * 128 * 256, INP + (size_t)R * 256, (float*)(ws + WS_HLOC), it, lane);
                else if (it < 1584) ret_kv_item(Tt, Tt + (size_t)256 * R, (const float*)(ws + WS_COST), (const float*)(ws + WS_SINT), AIN(18) + layer * 8, (float*)(ws + WS_KV), it - 1056, lane);
                else if (it < 2096) fft1_item(INP, (const bf16*)(ws + WS_W128T), (const float*)(ws + WS_TWC), (const float*)(ws + WS_TWS), (bf16*)(ws + WS_FB), it - 1584, lane);
                else if (it < 2224) rope_item(INP + (size_t)2 * R * 256, INP + (size_t)3 * R * 256, (const float*)(ws + WS_COSN), (const float*)(ws + WS_SINN), it - 2096, lane);
                else if (it < 2288) { const int j = 1984 + (it - 2224); na_item(INP + (size_t)5 * R * 256, INP + (size_t)6 * R * 256, Tt + (size_t)512 * R, MIX, rpb, wl, false, j >> 10, (j >> 3) & 127, (j >> 1) & 3, j & 1, lane); }
                else { const int j = it - 2288; na_item(INP + (size_t)5 * R * 256, INP + (size_t)6 * R * 256, Tt + (size_t)512 * R, MIX, rpb, wl, true, j >> 5, 0, (j >> 3) & 3, j & 7, lane); }
            }
            __syncthreads();
        }
        SEAM(pb + 2);
        for (int rep_ = 0; rep_ < NREP(pb + 3); ++rep_) if (IN(pb + 3)) { if (rep_) { FORCE_BAR; } PH_BEGIN
            LAS float* rpb = (LAS float*)(lds + 98304 + 4096); LAS unsigned char* wl = lds + wave * 12288;
            for (int i = tid; i < 1860; i += NTHREADS) rpb[i] = AIN(20)[layer * 1860 + i] * LOG2E;
            __syncthreads();
            for (int vs = wslot; vs < 2048; vs += NW) {
                if (vs < 64) s5_scan_item((const float*)(ws + WS_A16) + (size_t)layer * 2 * 16 * 64 * 2, (const float*)(ws + WS_HLOC), (bf16*)(ws + WS_HIN), wl, vs, lane);
                else { const int j = vs - 64; na_item(INP + (size_t)5 * R * 256, INP + (size_t)6 * R * 256, Tt + (size_t)512 * R, MIX, rpb, wl, false, j >> 10, (j >> 3) & 127, (j >> 1) & 3, j & 1, lane);
                    if (vs >= 1024) ret_scan_item(AIN(18) + layer * 8, (const float*)(ws + WS_KV), (bf16*)(ws + WS_SPREV), vs - 1024, lane); }
            }
            __syncthreads();
        }
        SEAM(pb + 3);
        for (int rep_ = 0; rep_ < NREP(pb + 4); ++rep_) if (IN(pb + 4)) { if (rep_) { FORCE_BAR; } PH_BEGIN
            const int nit = 1056 + 2112 + 2048 + (layer == 0 ? 128 : 0);
            for (int it = wslot; it < nit; it += NW) {
                if (it < 1056) s5_out_item((const bf16*)(ws + WS_S5TAB) + (size_t)layer * 16 * 256 * 512, INP + (size_t)R * 256, (const bf16*)(ws + WS_HIN), (bf16*)(ws + WS_Z), it, lane);
                else if (it < 3168) ret_out_item(INP + (size_t)2 * R * 256, INP + (size_t)3 * R * 256, INP + (size_t)4 * R * 256, Tt + (size_t)256 * R, (const bf16*)(ws + WS_SPREV),
                                                 AIN(18) + layer * 8, AIN(19) + layer * 256, MIX, lds + wave * 12288, it - 1056, lane);
                else if (it < 5216) fft2_item((const bf16*)(ws + WS_FB), (const bf16*)(ws + WS_FCT), (const bf16*)(ws + WS_W64T), MIX, it - 3168, lane);
                else fftc_item(INP, (const bf16*)(ws + WS_FCT), (const bf16*)(ws + WS_W256T), MIX, it - 5216, lane);
            }
        }
        SEAM(pb + 4);
        for (int rep_ = 0; rep_ < NREP(pb + 5); ++rep_) if (IN(pb + 5)) { if (rep_) { FORCE_BAR; } PH_BEGIN
            { PH_BEGIN gp::SchedPlain S{(const char*)(ws + WS_Z), (const char*)(ws + WS_WGLU) + (size_t)layer * 256 * 512, (size_t)256 * 512, (size_t)256 * 512, nM, 1, G, bx, 4};
              gp::EpiGlu E{(const bf16*)(ws + WS_Z), MIX, AIN(17) + layer * 256};
              gp::gemm_phase(lds, tid, 256, 256, 256, S, E); }
            { PH_BEGIN gp::SchedPlain S{(const char*)(ws + WS_H8), (const char*)(ws + WS_WG8) + (size_t)layer * 4096 * 1024, (size_t)256 * 1024, (size_t)256 * 1024, 64, 16, G, bx, 8};
              gp::EpiGates E{(unsigned char*)(ws + WS_GATES), 1.f / WIN_S};
              gp::gemm_phase<gp::EpiGates, gp::SchedPlain, true>(lds, tid, 1024, 512, 512, S, E); }
        }
        SEAM(pb + 5);
        for (int rep_ = 0; rep_ < NREP(pb + 6); ++rep_) if (IN(pb + 6)) { if (rep_) { FORCE_BAR; } PH_BEGIN
            gp::SchedMerge S{(const char*)MIX, (const char*)(ws + WS_WBR) + (size_t)layer * 1024 * 2048, layer == 0 ? 32 : 0, G, bx};
            gp::EpiMerge E{(const unsigned char*)(ws + WS_GATES), (const unsigned char*)(ws + WS_GCTX), (bf16*)(ws + WS_Y), (bf16*)(ws + WS_YP)};
            gp::gemm_phase(lds, tid, 1024, 1024, 1024, S, E);
        }
        SEAM(pb + 6);
        for (int rep_ = 0; rep_ < NREP(pb + 7); ++rep_) if (IN(pb + 7)) { if (rep_) { FORCE_BAR; } PH_BEGIN
            gp::SchedSplit S{(const char*)(ws + WS_Y), (const char*)(ws + WS_WOUT) + (size_t)layer * 1024 * 2048, (size_t)256 * 2048, (size_t)256 * 2048, layer == 0 ? 16 : 0, 16, G, bx,
                             (const char*)(ws + WS_YP), (size_t)256 * 2048, (size_t)CROWS * 2048, 4};
            gp::EpiPlainSplit E{(bf16*)(ws + WS_YO), 1024, (float*)(ws + WS_PARTW), 16};
            gp::gemm_phase(lds, tid, 1024, 1024, 1024, S, E);
        }
        SEAM(pb + 7);
        for (int rep_ = 0; rep_ < NREP(pb + 8); ++rep_) if (IN(pb + 8)) { if (rep_) { FORCE_BAR; } PH_BEGIN
            if (layer == 0) {
                NormCfg C{AIN(0), AIN(2), AOUT, ctxbuf, (const bf16*)(ws + WS_YO), (const float*)(ws + WS_PARTW), 16, normg + D, MODp, 2048, normg + 2 * D, MODp, 4096, 3072, Hh, R, nullptr};
                norm_rows(C, wslot, NW, lane);
            } else {
                LAS float* wrs = (LAS float*)lds; LAS int* rowinfo = (LAS int*)(lds + 32768); LAS unsigned* cntL = (LAS unsigned*)(lds + 32768 + 1024); LAS unsigned* baseL = cntL + 8;
                for (int i = tid; i < 2048; i += NTHREADS) ((LAS f32x4*)wrs)[i] = ((const f32x4*)AIN(26))[i];
                int* list = (int*)(ws + WS_LIST); float* routew = (float*)(ws + WS_ROUTEW);
                for (int grp = vcu; grp < 256; grp += G) {
                    if (tid < 8) cntL[tid] = 0u;
                    __syncthreads();
                    const int r0 = grp * 64 + wave * 8; const float* md = MODp + (size_t)(3 + (r0 < SEQ ? 0 : 1)) * 6144;
                    f32x4 gav[4], scv[4], shv[4]; row_ld_f32(md + 2048, lane, gav); row_ld_f32(md + 4096, lane, scv); row_ld_f32(md + 3072, lane, shv);
                    f32x4 xn[4]; u32x2 tn[4]; row_ld_f32(AOUT + (size_t)r0 * D, lane, xn);
#pragma unroll
                    for (int j = 0; j < 4; ++j) tn[j] = *(const u32x2*)((const bf16*)(ws + WS_YO) + (size_t)r0 * D + 256 * j + 4 * lane);
                    for (int rr = 0; rr < 8; ++rr) { const int r = r0 + rr;
                        f32x4 x[4], t[4], hh[4];
#pragma unroll
                        for (int j = 0; j < 4; ++j) { x[j] = xn[j]; t[j] = (f32x4){bflo(tn[j].x), bfhi(tn[j].x), bflo(tn[j].y), bfhi(tn[j].y)}; }
                        if (rr < 7) { row_ld_f32(AOUT + (size_t)(r + 1) * D, lane, xn);
#pragma unroll
                            for (int j = 0; j < 4; ++j) tn[j] = *(const u32x2*)((const bf16*)(ws + WS_YO) + (size_t)(r + 1) * D + 256 * j + 4 * lane); }
                        { f32x4 gAv[4]; row_ld_f32(normg + D, lane, gAv); const float rs = row_rstd(t);
#pragma unroll
                          for (int j = 0; j < 4; ++j) x[j] = x[j] + gav[j] * (t[j] * rs * gAv[j]); }
                        row_st_f32(AOUT + (size_t)r * D, lane, x);
                        { f32x4 gBv[4]; row_ld_f32(normg + 2 * D, lane, gBv); const float rs = row_rstd(x);
#pragma unroll
                          for (int j = 0; j < 4; ++j) hh[j] = x[j] * rs * gBv[j] * (scv[j] + 1.f) + shv[j]; }
#pragma unroll
                        for (int j = 0; j < 4; ++j) *(unsigned*)(ws + WS_H + (size_t)r * D + 256 * j + 4 * lane) = pk4_f8(hh[j][0], hh[j][1], hh[j][2], hh[j][3]);
                        float lg[8];
#pragma unroll
                        for (int e = 0; e < 8; ++e) lg[e] = 0.f;
#pragma unroll
                        for (int j = 0; j < 4; ++j)
#pragma unroll
                            for (int q = 0; q < 4; ++q) { const int k = 256 * j + 4 * lane + q; const f32x4 w0 = *(const LAS f32x4*)(wrs + k * 8), w1 = *(const LAS f32x4*)(wrs + k * 8 + 4); const float hv = hh[j][q];
                                lg[0] += hv * w0[0]; lg[1] += hv * w0[1]; lg[2] += hv * w0[2]; lg[3] += hv * w0[3]; lg[4] += hv * w1[0]; lg[5] += hv * w1[1]; lg[6] += hv * w1[2]; lg[7] += hv * w1[3]; }
#pragma unroll
                        for (int e = 0; e < 8; ++e) lg[e] = wave_sum(lg[e]) + AIN(27)[e];
                        int i0 = 0; float v0 = lg[0];
#pragma unroll
                        for (int e = 1; e < 8; ++e) if (lg[e] > v0) { v0 = lg[e]; i0 = e; }
                        int i1 = i0 == 0 ? 1 : 0; float v1 = i0 == 0 ? lg[1] : lg[0];
#pragma unroll
                        for (int e = 0; e < 8; ++e) if (e != i0 && lg[e] > v1) { v1 = lg[e]; i1 = e; }
                        const float w0 = 1.f / (1.f + __expf(v1 - v0)), w1 = 1.f - w0;
                        if (lane == 0) { const unsigned s0 = __hip_atomic_fetch_add(cntL + i0, 1u, __ATOMIC_RELAXED, __HIP_MEMORY_SCOPE_WORKGROUP), s1 = __hip_atomic_fetch_add(cntL + i1, 1u, __ATOMIC_RELAXED, __HIP_MEMORY_SCOPE_WORKGROUP);
                            LAS int* ri = rowinfo + (wave * 8 + rr) * 4; ri[0] = i0; ri[1] = (int)s0; ri[2] = i1; ri[3] = (int)s1; routew[(size_t)r * 2] = w0; routew[(size_t)r * 2 + 1] = w1; }
                        if (lane < 8) ((int*)(ws + WS_SMAP))[(size_t)r * 8 + lane] = -1;
                    }
                    __syncthreads();
                    if (tid < 8) baseL[tid] = __hip_atomic_fetch_add((unsigned*)(ws + WS_CTL) + CW_MOECNT + 64 * tid, cntL[tid], __ATOMIC_RELAXED, __HIP_MEMORY_SCOPE_AGENT);
                    __syncthreads();
                    if (tid < 64) { const LAS int* ri = rowinfo + tid * 4; const int r = grp * 64 + tid;
                        list[ri[0] * LCAP + (int)baseL[ri[0]] + ri[1]] = r * 2; list[ri[2] * LCAP + (int)baseL[ri[2]] + ri[3]] = r * 2 + 1; }
                    __syncthreads();
                }
            }
        }
        SEAM(pb + 8);
        LAS unsigned* mt = (LAS unsigned*)(lds + LDSCTL_OFF) + LW_MOE;
        if (layer == 1 && (IN(pb + 9) || IN(pb + 10))) { PH_BEGIN
            if (tid == 0) { unsigned off = 0u;
                for (int e = 0; e < 8; ++e) { const unsigned c = __hip_atomic_load((unsigned*)(ws + WS_CTL) + CW_MOECNT + 64 * e, __ATOMIC_RELAXED, __HIP_MEMORY_SCOPE_AGENT); const unsigned m = (c + 255u) >> 8; mt[e] = c; mt[8 + e] = m; mt[16 + e] = off; off += m; }
                mt[24] = off; const unsigned U = off * 4u, full = (U / (unsigned)G) * (unsigned)G, rem = U - full;
                if (rem != 0u && rem <= 32u && full != 0u) { mt[25] = full; mt[26] = rem; } else { mt[25] = U; mt[26] = 0u; } }
            __syncthreads();
        }
        for (int rep_ = 0; rep_ < NREP(pb + 9); ++rep_) if (IN(pb + 9)) { if (rep_) { FORCE_BAR; } PH_BEGIN
            if (layer == 0) {
                gp::SchedPlain S{(const char*)Hh, (const char*)(ws + WS_FFN1), (size_t)256 * 2048, (size_t)256 * 2048, 66, 22, G, bx, 16};
                gp::EpiSwiglu E{(bf16*)(ws + WS_HID), DFF, false};
                gp::gemm_phase(lds, tid, 1024, 1024, 1024, S, E);
            } else {
                gp::SchedMoe1 S{(const char*)(ws + WS_H), (const char*)(ws + WS_MOE1), (const int*)(ws + WS_LIST), mt, G, bx, 1024u};
                gp::EpiSwigluF8 E{ws + WS_MHID, DFE, true, 1.f / MOE_W1S, MOE_HS};
                gp::gemm_phase<gp::EpiSwigluF8, gp::SchedMoe1, true>(lds, tid, 1024, 512, 512, S, E);
            }
        }
        SEAM(pb + 9);
        for (int rep_ = 0; rep_ < NREP(pb + 10); ++rep_) if (IN(pb + 10)) { if (rep_) { FORCE_BAR; } PH_BEGIN
            if (layer == 0) {
                gp::SchedSplit S{(const char*)(ws + WS_HID), (const char*)(ws + WS_FFN2), (size_t)256 * DFF * 2, (size_t)256 * DFF * 2, 11, DFF / 64, G, bx,
                                 (const char*)(ws + WS_HID) + (size_t)64 * 256 * DFF * 2, (size_t)256 * DFF * 2, 0, 11};
                gp::EpiPlainSplit E{(bf16*)(ws + WS_FO), 1024, (float*)(ws + WS_PARTF), 11};
                gp::gemm_phase(lds, tid, DFF, DFF, DFF, S, E);
            } else {
                { gp::SchedMoe2 S{(const char*)(ws + WS_MHID), (const char*)(ws + WS_MOE2), mt, G, bx, (unsigned)DFE};
                  gp::EpiMoeDown E{(bf16*)(ws + WS_SLOT), (const int*)(ws + WS_LIST), (const float*)(ws + WS_ROUTEW), mt, 1.f / (MOE_HS * MOE_W2S)};
                  gp::gemm_phase<gp::EpiMoeDown, gp::SchedMoe2, true>(lds, tid, DFE, DFE / 2, DFE / 2, S, E); }
                { PH_BEGIN gp::SchedMoe2S S{(const char*)(ws + WS_MHID), (const char*)(ws + WS_MOE2), mt, G, bx, (unsigned)DFE};
                  gp::EpiMoePart E{(bf16*)(ws + WS_PARTM), (const int*)(ws + WS_LIST), mt, (int*)(ws + WS_SMAP), 1.f / (MOE_HS * MOE_W2S)};
                  gp::gemm_phase<gp::EpiMoePart, gp::SchedMoe2S, true>(lds, tid, DFE, DFE / 2, DFE / 2, S, E); }
            }
        }
        SEAM(pb + 10);
        for (int rep_ = 0; rep_ < NREP(pb + 11); ++rep_) if (IN(pb + 11)) { if (rep_) { FORCE_BAR; } PH_BEGIN
            if (layer == 0) { PH_BEGIN NormCfg C{AOUT, ctxbuf, AOUT, ctxbuf, (const bf16*)(ws + WS_FO), (const float*)(ws + WS_PARTF), 11, normg + 3 * D, MODp, 5120, AIN(6) + 4 * D, MODp + 3 * 6144, 1024, 0, Hh, R, ws + WS_H8};
                norm_rows(C, wslot, NW, lane); }
            else { PH_BEGIN for (int r = wslot; r < nrows; r += NW) { const int ci = r < SEQ ? 0 : (r < LROWS ? 1 : 2); const float* md = MODp + (size_t)(layer * 3 + ci) * 6144;
                float* xp = r < LROWS ? AOUT + (size_t)r * D : ctxbuf + (size_t)(r - LROWS) * D;
                f32x4 x[4], t[4]; row_ld_f32(xp, lane, x);
                if (layer == 0) { if (r < LROWS) row_ld_bf16((const bf16*)(ws + WS_FO) + (size_t)r * D, lane, t); else row_ld_part((const float*)(ws + WS_PARTF), 11, r, lane, t); }
                else { typedef int i32x4 __attribute__((ext_vector_type(4)));
                    const i32x4 m0 = *(const i32x4*)((const int*)(ws + WS_SMAP) + (size_t)r * 8), m1 = *(const i32x4*)((const int*)(ws + WS_SMAP) + (size_t)r * 8 + 4);
                    if ((m0.x & m0.y & m0.z & m0.w & m1.x & m1.y & m1.z & m1.w) == -1) {
                        f32x4 t2[4]; row_ld_bf16((const bf16*)(ws + WS_SLOT) + (size_t)r * D, lane, t); row_ld_bf16((const bf16*)(ws + WS_SLOT) + ((size_t)LROWS + r) * D, lane, t2);
#pragma unroll
                        for (int j = 0; j < 4; ++j) t[j] = t[j] + t2[j];
                    } else {
#pragma unroll
                        for (int j = 0; j < 4; ++j) t[j] = (f32x4){0.f, 0.f, 0.f, 0.f};
#pragma unroll
                        for (int k = 0; k < 2; ++k) { const int ent = 2 * r + k; const i32x4 mk = k ? m1 : m0;
#pragma unroll
                            for (int j = 0; j < 4; ++j) { const int mm = j == 0 ? mk.x : (j == 1 ? mk.y : (j == 2 ? mk.z : mk.w));
                                if (mm < 0) { const u32x2 w = *(const u32x2*)((const bf16*)(ws + WS_SLOT) + ((size_t)k * LROWS + r) * D + 256 * j + 4 * lane); t[j] = t[j] + (f32x4){bflo(w.x), bfhi(w.x), bflo(w.y), bfhi(w.y)}; }
                                else { const bf16* pp = (const bf16*)(ws + WS_PARTM) + ((size_t)(mm >> 8) * 7 * 256 + (mm & 255)) * 256 + 4 * lane; f32x4 sacc = (f32x4){0.f, 0.f, 0.f, 0.f};
                                    for (int sl = 0; sl < 7; ++sl) { const u32x2 w = *(const u32x2*)(pp + (size_t)sl * 65536); sacc = sacc + (f32x4){bflo(w.x), bfhi(w.x), bflo(w.y), bfhi(w.y)}; }
                                    t[j] = t[j] + sacc * ((const float*)(ws + WS_ROUTEW))[ent]; } } } } }
                row_resid(x, t, normg + 3 * D, md + 5120, lane); row_st_f32(xp, lane, x);
                } }
        }
        SEAM(pb + 11);
    }
#ifdef MK_STAMP_PHASE
    if (MK_STAMP_PHASE == NPHASE - 1 && wave == 0) *(volatile LAS unsigned long long*)(lctl + 66) = __builtin_amdgcn_s_memrealtime();
    if (blockIdx.x == 0 && wave == 0) { const unsigned long long st0_ = *(volatile LAS unsigned long long*)(lctl + 64), st1_ = *(volatile LAS unsigned long long*)(lctl + 66); const unsigned long long target = __builtin_amdgcn_s_memrealtime() + (unsigned long long)MK_STAMP_AMP * (st1_ - st0_); while (__builtin_amdgcn_s_memrealtime() < target) __builtin_amdgcn_s_sleep(20); }
#endif
#ifdef MK_EXTRA_BARS
    for (int xb_ = 0; xb_ < MK_EXTRA_BARS; ++xb_) { FORCE_BAR; }
#endif
#undef IN
#undef SEAM
#undef PH_BEGIN
#undef normg
#undef AIN
#undef AOUT
#undef MODp
#undef ctxbuf
#undef Hh
#undef MIX
#undef INP
#undef Tt
}

__global__ void dumpk(const unsigned char* src, size_t nbytes, int isf32, float* out, size_t N, int accum) {
    const size_t i = (size_t)blockIdx.x * blockDim.x + threadIdx.x; if (i >= N) return;
    const size_t ne = isf32 ? nbytes / 4 : nbytes / 2; float s = 0.f;
    for (size_t k = i; k < ne; k += N) s += isf32 ? ((const float*)src)[k] : bf2f(((const bf16*)src)[k]);
    out[i] = accum ? out[i] + s : s;
}
extern "C" void kernel_launch(void* const* d_in, const int* in_sizes, int n_in, void* d_out, int out_size, void* d_ws, size_t ws_size, hipStream_t stream) {
    static int grid = 0;
    if (grid == 0) {
        if (n_in != 31 || out_size != LROWS * D || ws_size < WS_END) { fprintf(stderr, "kernel_launch: unexpected shapes (n_in %d, out %d, ws %zu < %zu)\n", n_in, out_size, ws_size, (size_t)WS_END); grid = -1; return; }
        int dev = 0, cus = 0, per_cu = 0;
        if (hipGetDevice(&dev) != hipSuccess || hipDeviceGetAttribute(&cus, hipDeviceAttributeMultiprocessorCount, dev) != hipSuccess) { grid = -1; return; }
        if (hipFuncSetAttribute((const void*)mk_fwd, hipFuncAttributeMaxDynamicSharedMemorySize, LDS_BYTES) != hipSuccess) { fprintf(stderr, "kernel_launch: hipFuncSetAttribute failed\n"); grid = -1; return; }
        if (hipOccupancyMaxActiveBlocksPerMultiprocessor(&per_cu, (const void*)mk_fwd, NTHREADS, LDS_BYTES) != hipSuccess || per_cu < 1) { fprintf(stderr, "kernel_launch: occupancy query says %d\n", per_cu); }
        (void)hipGetLastError();
        grid = cus;
    }
    if (grid < 0) return;
    (void)hipMemsetAsync((char*)d_ws + WS_CTL, 0, CTL_ZERO_BYTES, stream);
    Args a{};
    for (int i = 0; i < 31; ++i) a.in[i] = (const float*)d_in[i];
    a.out = (float*)d_out; a.ws = (unsigned char*)d_ws;
#if MK_MODE == 1
    a.ph_lo = 0; a.ph_hi = NPHASE; a.li = 0;
    hipLaunchKernelGGL(mk_fwd, dim3(grid), dim3(NTHREADS), LDS_BYTES, stream, a);
#else
    for (int p = 0; p < MK_LAST; ++p) { a.ph_lo = p; a.ph_hi = p + 1; a.li = p; hipLaunchKernelGGL(mk_fwd, dim3(grid), dim3(NTHREADS), LDS_BYTES, stream, a); }
#endif
#ifdef MK_DUMP_OFF
    dumpk<<<(LROWS * D + 255) / 256, 256, 0, stream>>>((const unsigned char*)d_ws + (size_t)(MK_DUMP_OFF), (size_t)(MK_DUMP_BYTES), MK_DUMP_F32, (float*)d_out, (size_t)LROWS * D, 0);
#endif
#ifdef MK_DUMP2_OFF
    dumpk<<<(LROWS * D + 255) / 256, 256, 0, stream>>>((const unsigned char*)d_ws + (size_t)(MK_DUMP2_OFF), (size_t)(MK_DUMP2_BYTES), MK_DUMP2_F32, (float*)d_out, (size_t)LROWS * D, 1);
#endif
#ifdef MK_DUMP3_OFF
    dumpk<<<(LROWS * D + 255) / 256, 256, 0, stream>>>((const unsigned char*)d_ws + (size_t)(MK_DUMP3_OFF), (size_t)(MK_DUMP3_BYTES), MK_DUMP3_F32, (float*)d_out, (size_t)LROWS * D, 1);
#endif
}
```

```cpp
#define MK_MODE 1
#include <hip/hip_runtime.h>
#include <cstdio>
#include <cstdint>

#define GAS __attribute__((address_space(1)))
#define LAS __attribute__((address_space(3)))
typedef unsigned short bf16;
typedef short bf16x8 __attribute__((ext_vector_type(8)));
typedef short bf16x4 __attribute__((ext_vector_type(4)));
typedef float f32x2 __attribute__((ext_vector_type(2)));
typedef float f32x4 __attribute__((ext_vector_type(4)));
typedef float f32x16 __attribute__((ext_vector_type(16)));
typedef unsigned u32x2 __attribute__((ext_vector_type(2)));
typedef unsigned u32x4 __attribute__((ext_vector_type(4)));

constexpr int D = 1024, SEQ = 8192, LROWS = 16384, CTXL = 256, CROWS = 512, R = 16896;
constexpr int DFF = 2816, DFE = 3584, NEXP = 8, LCAP = 16640;
constexpr int NWAVES = 8, NTHREADS = 512;
constexpr int NCH16 = R / 16;
constexpr float EPSN = 1e-6f, LOG2E = 1.4426950408889634f;

constexpr size_t MiB = 1u << 20;
constexpr size_t WS_CTL = 0, CTL_ZERO_BYTES = 1 * MiB;
constexpr int CW_TMO = 0, CW_BAR = 4096, CW_MOECNT = 98304, CW_QHEAD = 100352, CW_MQ = 102400;
constexpr size_t CTL_MOD_OFF = 512 * 1024;
constexpr size_t WS_CTXBUF = 1 * MiB;
constexpr size_t WS_COST = 3 * MiB, WS_SINT = 4 * MiB, WS_COSN = 5 * MiB, WS_SINN = 6 * MiB;
constexpr size_t WS_LIST = 7 * MiB;
constexpr size_t WS_ROUTEW = WS_LIST + 8 * LCAP * 4;
constexpr size_t WS_S5K = 8 * MiB;
constexpr size_t WS_A16 = 9 * MiB;
constexpr size_t WS_W128T = WS_A16 + 64 * 1024;
constexpr size_t WS_TWC = WS_W128T + 64 * 1024, WS_TWS = WS_TWC + 32 * 1024;
constexpr size_t WS_FCT = WS_TWS + 32 * 1024;
constexpr size_t WS_W64T = WS_FCT + 32 * 1024;
constexpr size_t WS_W256T = WS_W64T + 32 * 1024;
constexpr size_t WS_MOE1 = 10 * MiB;
constexpr size_t WS_WG8 = 66 * MiB;
constexpr size_t WS_XB = 74 * MiB;
constexpr size_t WS_H8 = 150 * MiB;
constexpr size_t WS_MOE2 = 122 * MiB;
constexpr size_t WS_OTHERW = 178 * MiB;
constexpr size_t WS_WIN = 178 * MiB;
constexpr size_t WS_WBR = 204 * MiB;
constexpr size_t WS_WOUT = 208 * MiB;
constexpr size_t WS_WGLU = 212 * MiB;
constexpr size_t WS_FFN1 = 213 * MiB;
constexpr size_t WS_FFN2 = 224 * MiB;
constexpr size_t WS_S5M1 = 230 * MiB;
constexpr size_t WS_S5TAB = 234 * MiB;
constexpr size_t WS_BIG = 242 * MiB;
constexpr size_t TOK256 = (size_t)R * 256 * 2;
constexpr size_t WS_INP = WS_BIG;
constexpr size_t WS_T = WS_INP + 7 * TOK256;
constexpr size_t WS_HLOC = WS_T + 3 * TOK256;
constexpr size_t WS_HIN = WS_HLOC + 2 * TOK256;
constexpr size_t WS_KV = WS_HIN + TOK256;
constexpr size_t WS_SPREV = WS_KV + 2 * TOK256;
constexpr size_t WS_FB = WS_SPREV + TOK256;
constexpr size_t WS_GATES = WS_BIG;
constexpr size_t WS_Y = WS_BIG + 132 * MiB;
constexpr size_t WS_YO = WS_Y + 33 * MiB;
constexpr size_t WS_Z = WS_YO + 33 * MiB;
constexpr size_t WS_YP = WS_Z;
constexpr size_t WS_PARTW = WS_BIG;
constexpr size_t WS_PARTF = 340 * MiB;
constexpr size_t WS_PARTM = 416 * MiB;
constexpr size_t WS_SMAP = WS_S5K;
constexpr size_t WS_FO = WS_Y;
constexpr size_t WS_HID = WS_BIG;
constexpr size_t WS_MHID = WS_OTHERW;
constexpr size_t WS_H = 449 * MiB;
constexpr size_t WS_MIX = 482 * MiB;
constexpr size_t WS_SLOT = WS_H;
constexpr size_t WS_GCTX = 515 * MiB;
constexpr size_t WS_END = 519 * MiB;
static_assert(WS_FB + 16 * MiB <= WS_Z && WS_Z + TOK256 <= WS_H && WS_MHID + (size_t)34816 * 3584 * 2 <= WS_H && WS_W256T + 256 * 1024 <= WS_MOE1, "ws map");
static_assert(WS_PARTM + (size_t)32 * 7 * 65536 * 2 <= WS_H && WS_MHID + (size_t)34816 * 3584 * 2 <= WS_PARTM, "ws map 3");
static_assert(WS_S5TAB + 8 * MiB <= WS_BIG && WS_FFN2 + (size_t)1024 * 2816 * 2 <= WS_S5M1 && WS_ROUTEW + 32768 * 4 <= WS_S5K, "ws map 2");

constexpr int RING_BYTES = 131072, LDSCTL_OFF = RING_BYTES, LDS_BYTES = 147456;
constexpr int LW_BAR = 8, LW_MOE = 16;

#define VM_WAIT() asm volatile("s_waitcnt vmcnt(0)" ::: "memory")
#define LDS_WAIT() asm volatile("s_waitcnt lgkmcnt(0)" ::: "memory")
typedef __bf16 bf16n2 __attribute__((ext_vector_type(2)));
__device__ __forceinline__ unsigned pk2(float lo, float hi) { bf16n2 v; v.x = (__bf16)lo; v.y = (__bf16)hi; return __builtin_bit_cast(unsigned, v); }
__device__ __forceinline__ unsigned pk4_f8(float a, float b, float c, float d) { int w = 0; w = __builtin_amdgcn_cvt_pk_fp8_f32(a, b, w, false); w = __builtin_amdgcn_cvt_pk_fp8_f32(c, d, w, true); return (unsigned)w; }
__device__ __forceinline__ float bf2f(unsigned short b) { return __builtin_bit_cast(float, ((unsigned)b) << 16); }
__device__ __forceinline__ float bflo(unsigned w) { return __builtin_bit_cast(float, w << 16); }
__device__ __forceinline__ float bfhi(unsigned w) { return __builtin_bit_cast(float, w & 0xffff0000u); }
__device__ __forceinline__ float ex2(float x) { return __builtin_amdgcn_exp2f(x); }
__device__ __forceinline__ float rcpf_(float x) { return __builtin_amdgcn_rcpf(x); }
__device__ __forceinline__ float sigm(float x) { return rcpf_(1.f + ex2(-LOG2E * x)); }
__device__ __forceinline__ float silu_(float x) { return x * sigm(x); }
__device__ __forceinline__ float gelu_tanh(float x) { const float u = 0.7978845608028654f * (x + 0.044715f * x * x * x); const float t = 1.f - 2.f * rcpf_(1.f + ex2(2.885390081777927f * u)); return 0.5f * x * (1.f + t); }
__device__ __forceinline__ float xor32_sum(float v) { const unsigned u = __builtin_bit_cast(unsigned, v); const auto r = __builtin_amdgcn_permlane32_swap(u, u, false, false); return __builtin_bit_cast(float, (unsigned)r[0]) + __builtin_bit_cast(float, (unsigned)r[1]); }
__device__ __forceinline__ float xor32_max(float v) { const unsigned u = __builtin_bit_cast(unsigned, v); const auto r = __builtin_amdgcn_permlane32_swap(u, u, false, false); return fmaxf(__builtin_bit_cast(float, (unsigned)r[0]), __builtin_bit_cast(float, (unsigned)r[1])); }
template <int X> __device__ __forceinline__ float swz_xor(float v) { return __builtin_bit_cast(float, __builtin_amdgcn_ds_swizzle(__builtin_bit_cast(int, v), (X << 10) | 0x1f)); }
__device__ __forceinline__ float wave_sum(float v) { v += swz_xor<1>(v); v += swz_xor<2>(v); v += swz_xor<4>(v); v += swz_xor<8>(v); v += swz_xor<16>(v); return xor32_sum(v); }
__device__ __forceinline__ f32x16 mma32(bf16x8 a, bf16x8 b, f32x16 c) { return __builtin_amdgcn_mfma_f32_32x32x16_bf16(a, b, c, 0, 0, 0); }
__device__ __forceinline__ bf16x8 ldg8(const bf16* p) { return *(const bf16x8*)p; }
__device__ __forceinline__ bf16x8 ldg8p(const bf16* p) { const bf16x4 lo = *(const bf16x4*)p, hi = *(const bf16x4*)(p + 8); return __builtin_shufflevector(lo, hi, 0, 1, 2, 3, 4, 5, 6, 7); }
template <int S> __device__ __forceinline__ bf16x8 accB(const f32x16& c) {
    u32x4 w; w.x = pk2(c[8 * S + 0], c[8 * S + 1]); w.y = pk2(c[8 * S + 2], c[8 * S + 3]); w.z = pk2(c[8 * S + 4], c[8 * S + 5]); w.w = pk2(c[8 * S + 6], c[8 * S + 7]);
    return __builtin_bit_cast(bf16x8, w);
}
__device__ __forceinline__ bf16x8 pack8(const float (&v)[8]) { u32x4 w; w.x = pk2(v[0], v[1]); w.y = pk2(v[2], v[3]); w.z = pk2(v[4], v[5]); w.w = pk2(v[6], v[7]); return __builtin_bit_cast(bf16x8, w); }
__device__ __forceinline__ void unpack8(const bf16x8 x, float (&v)[8]) { const u32x4 w = __builtin_bit_cast(u32x4, x); v[0] = bflo(w.x); v[1] = bfhi(w.x); v[2] = bflo(w.y); v[3] = bfhi(w.y); v[4] = bflo(w.z); v[5] = bfhi(w.z); v[6] = bflo(w.w); v[7] = bfhi(w.w); }
__device__ __forceinline__ f32x16 zero16() { f32x16 z;
#pragma unroll
    for (int i = 0; i < 16; ++i) z[i] = 0.f;
    return z; }

#define XB_TMO      128
#define XB_XCNT(j)  (256  + 64 * (j))
#define XB_XSUB(j)  (1280 + 64 * (j))
#define XB_XGEN(j)  (2304 + 64 * (j))
#define XB_TOP      3328
#define XB_TOPGEN   3392
#define XCD_BAR_WORDS 3456
#define XB_SPIN_CAP (1u << 18)
__device__ __forceinline__ unsigned xb_ld(unsigned* p)              { return __hip_atomic_load(p, __ATOMIC_RELAXED, __HIP_MEMORY_SCOPE_AGENT); }
__device__ __forceinline__ unsigned xb_add(unsigned* p, unsigned v) { return __hip_atomic_fetch_add(p, v, __ATOMIC_RELAXED, __HIP_MEMORY_SCOPE_AGENT); }
__device__ __forceinline__ unsigned xb_xcc_id() { return (unsigned)__builtin_amdgcn_s_getreg((3 << 11) | 20) & 0xFu; }
#define XB_SPIN(cond, bar) do { unsigned _sp = 0; while (cond) { __builtin_amdgcn_s_sleep(1); \
    if ((++_sp & 255u) == 0u) { if (xb_ld(&(bar)[XB_TMO])) break; if (_sp > XB_SPIN_CAP) { atomicAdd(&(bar)[XB_TMO], 1u); break; } } } } while (0)
struct XcdBarrier { unsigned* bar; unsigned x; volatile LAS unsigned* st; };
__device__ __forceinline__ XcdBarrier xcd_barrier_post(unsigned* bar, volatile LAS unsigned* st) {
    XcdBarrier b; b.bar = bar; b.x = xb_xcc_id(); b.st = st;
    if (threadIdx.x == 0) (void)xb_add(&bar[XB_XCNT(b.x)], 1u);
    return b;
}
__device__ __forceinline__ void xcd_barrier_complete(unsigned* bar, unsigned x, unsigned& nloc, unsigned& nx) {
    const unsigned G = gridDim.x * gridDim.y * gridDim.z;
    unsigned sum, cnt, mine, sp = 0u;
    for (;;) {
        sum = 0u; cnt = 0u; mine = 0u;
#pragma unroll
        for (unsigned j = 0; j < 16; ++j) { const unsigned c = xb_ld(&bar[XB_XCNT(j)]); sum += c; cnt += (c > 0u) ? 1u : 0u; mine = (j == x) ? c : mine; }
        if (sum == G) break;
        __builtin_amdgcn_s_sleep(1);
        if ((++sp & 255u) == 0u) { if (xb_ld(&bar[XB_TMO])) break; if (sp > XB_SPIN_CAP) { atomicAdd(&bar[XB_TMO], 1u); break; } }
    }
    nloc = mine > 0u ? mine : 1u; nx = cnt > 0u ? cnt : 1u;
}
__device__ __forceinline__ void xcd_barrier(const XcdBarrier& b) {
    asm volatile("s_waitcnt vmcnt(0)" ::: "memory");
    __syncthreads();
    if (threadIdx.x == 0) {
        unsigned* bar = b.bar;
        __builtin_amdgcn_s_waitcnt(0);
        unsigned nloc = b.st[0], nx = b.st[1];
        if (nloc == 0u) { xcd_barrier_complete(bar, b.x, nloc, nx); b.st[0] = nloc; b.st[1] = nx; }
        const unsigned old = xb_add(&bar[XB_XSUB(b.x)], 1u);
        const unsigned gen = old / nloc;
        if (old + 1u == (gen + 1u) * nloc) {
            __builtin_amdgcn_fence(__ATOMIC_RELEASE, "agent");
            asm volatile("s_waitcnt vmcnt(0)" ::: "memory");
            const unsigned og = xb_add(&bar[XB_TOP], 1u);
            const unsigned tg = og / nx;
            if (og + 1u == (tg + 1u) * nx) xb_add(&bar[XB_TOPGEN], 1u);
            else XB_SPIN(xb_ld(&bar[XB_TOPGEN]) == tg, bar);
            __builtin_amdgcn_fence(__ATOMIC_ACQUIRE, "agent");
            xb_add(&bar[XB_XGEN(b.x)], 1u);
            asm volatile("s_waitcnt vmcnt(0)" ::: "memory");
        } else {
            XB_SPIN(xb_ld(&bar[XB_XGEN(b.x)]) == gen, bar);
            __builtin_amdgcn_fence(__ATOMIC_ACQUIRE, "agent");
            asm volatile("s_waitcnt vmcnt(0)" ::: "memory");
        }
    }
    __syncthreads();
}
namespace gp {
constexpr int BM = 256, BK = 64, HALF = 128, HTB = HALF * BK * 2, STAGE_BYTES = 8 * HTB, NXCD = 8, WGM = 8;
__device__ __forceinline__ int lds_byte(int r, int c) { const int st = (r >> 4) * 2 + (c >> 5), rr = r & 15, cc = c & 31, ob = rr * 64 + cc * 2; return st * 1024 + (ob ^ (((ob >> 9) & 1) << 5)); }
__device__ __forceinline__ void stage_rc(int b, int& Rr, int& C) { const int st = b / 1024, sb = b % 1024, swz = sb ^ (((sb >> 9) & 1) << 5); Rr = (st >> 1) * 16 + swz / 64; C = (st & 1) * 32 + (swz % 64) / 2; }
__device__ __forceinline__ int perm32(int rho) { const int n = rho >> 4, i = rho & 15; return 8 * (i >> 2) + 4 * n + (i & 3); }

struct Unit { const char* a; const char* b; int e0, e1, e2, e3, nt; };

__device__ __forceinline__ void tile_of(int L, int nM, int nN, int& pm, int& pn) {
    const int nwg = nM * nN; int wgid = L;
    { const int q = nwg / NXCD, r = nwg % NXCD, xcd = wgid % NXCD, off = wgid / NXCD; wgid = (xcd < r ? xcd * (q + 1) : r * (q + 1) + (xcd - r) * q) + off; }
    const int nig = WGM * nN, gid = wgid / nig, fm = gid * WGM, gsz = (nM - fm) < WGM ? (nM - fm) : WGM;
    pm = fm + ((wgid % nig) % gsz); pn = (wgid % nig) / gsz;
}

typedef int i32x8 __attribute__((ext_vector_type(8)));
typedef int i32x4v __attribute__((ext_vector_type(4)));
__device__ __forceinline__ i32x8 cat8(const bf16x8 a, const bf16x8 b) { const i32x4v x = __builtin_bit_cast(i32x4v, a), y = __builtin_bit_cast(i32x4v, b); return __builtin_shufflevector(x, y, 0, 1, 2, 3, 4, 5, 6, 7); }
__device__ __forceinline__ void mfma_f8(f32x4& acc, const i32x8 a, const i32x8 b) { asm volatile("s_nop 1\n\tv_mfma_f32_16x16x128_f8f6f4 %0, %1, %2, %0" : "+v"(acc) : "v"(a), "v"(b)); }
template <class Epi, class Sched, bool F8 = false>
__device__ __forceinline__ void gemm_phase(LAS unsigned char* lds, const int tid, const int K, const int lda, const int ldb, const Sched& S, const Epi& E) {
    constexpr bool GATHER = Sched::GATHER;
    const int wid = __builtin_amdgcn_readfirstlane(tid >> 6), lane = tid & 63, wr = wid >> 2, wc = wid & 3, fr = lane & 15, fq = lane >> 4;
    unsigned voffA[2], voffB[2];
#pragma unroll
    for (int i = 0; i < 2; ++i) { int Rr, C; stage_rc(tid * 16 + i * 8192, Rr, C); const int Rb = (Rr & ~31) + perm32(Rr & 31);
        voffA[i] = (unsigned)(Rr * lda + C) * 2u; voffB[i] = (unsigned)(Rb * ldb + C) * 2u; }
#define PG8_GOFF(dst, unit) do { _Pragma("unroll") for (int _h = 0; _h < 2; ++_h) _Pragma("unroll") for (int _i = 0; _i < 2; ++_i) { int _R, _C; stage_rc(tid * 16 + _i * 8192, _R, _C); dst[_h][_i] = S.rowoff(unit, _R + _h * HALF) + (unsigned)_C * 2u; } } while (0)
    const size_t kstep = (size_t)(BK * 2);
    const unsigned hstepA = (unsigned)HALF * (unsigned)lda * 2u; const size_t hstepB = (size_t)HALF * ldb * 2;
    const unsigned ldsw = (unsigned)wid * 1024u;
    const int aoff = lds_byte(wr * 64 + fr, fq * 8), boff = lds_byte(wc * 32 + fr, fq * 8);
#define PG8_SA(b, h) (((b) * 2 + (h)) * HTB)
#define PG8_SB(b, h) ((4 + (b) * 2 + (h)) * HTB)
#define PG8_STB(bufoff, gbase, hh) do { const char* _gb = (const char*)(gbase) + (size_t)(hh) * hstepB; _Pragma("unroll") for (int _i = 0; _i < 2; ++_i) \
        __builtin_amdgcn_global_load_lds((const unsigned*)(_gb + voffB[_i]), (LAS unsigned*)(lds + (bufoff) + ldsw + _i * 8192), 16, 0, 0); } while (0)
#define PG8_STA(bufoff, gbase, hh, VG) do { const char* _ga = (const char*)(gbase) + (GATHER ? (size_t)0 : (size_t)(hh) * hstepA); _Pragma("unroll") for (int _i = 0; _i < 2; ++_i) { const unsigned _o = GATHER ? (VG) : voffA[_i]; \
        __builtin_amdgcn_global_load_lds((const unsigned*)(_ga + _o), (LAS unsigned*)(lds + (bufoff) + ldsw + _i * 8192), 16, 0, 0); } } while (0)
#define PG8_LDA(dst, b, h) do { _Pragma("unroll") for (int m = 0; m < 4; ++m) _Pragma("unroll") for (int k = 0; k < 2; ++k) dst[m][k] = *(const LAS bf16x8*)(lds + PG8_SA(b, h) + aoff + m * 2048 + k * 1024); } while (0)
#define PG8_LDB(dst, b, h) do { _Pragma("unroll") for (int n = 0; n < 2; ++n) _Pragma("unroll") for (int k = 0; k < 2; ++k) dst[n][k] = *(const LAS bf16x8*)(lds + PG8_SB(b, h) + boff + n * 2048 + k * 1024); } while (0)
#define PG8_MMA(ai, bj, At, Bt) do { __builtin_amdgcn_s_setprio(1); _Pragma("unroll") for (int m = 0; m < 4; ++m) _Pragma("unroll") for (int n = 0; n < 2; ++n) { \
        if constexpr (F8) mfma_f8(acc[ai][bj][m][n], cat8(Bt[n][0], Bt[n][1]), cat8(At[m][0], At[m][1])); \
        else { _Pragma("unroll") for (int k = 0; k < 2; ++k) acc[ai][bj][m][n] = __builtin_amdgcn_mfma_f32_16x16x32_bf16(Bt[n][k], At[m][k], acc[ai][bj][m][n], 0, 0, 0); } } __builtin_amdgcn_s_setprio(0); } while (0)
#define PG8_WAIT_V(n) asm volatile("s_waitcnt vmcnt(" #n ")" ::: "memory")
#define PG8_WAIT_L(n) asm volatile("s_waitcnt lgkmcnt(" #n ")" ::: "memory")
#define PG8_BAR __builtin_amdgcn_s_barrier()
#define PG8_SCHED __builtin_amdgcn_sched_barrier(0)
    Unit cur, nxt; int ui = 0;
    if (!S.next(0, cur)) return;
    f32x4 acc[2][2][4][2];
#pragma unroll
    for (int a = 0; a < 2; ++a)
#pragma unroll
        for (int b = 0; b < 2; ++b)
#pragma unroll
            for (int m = 0; m < 4; ++m)
#pragma unroll
                for (int n = 0; n < 2; ++n) acc[a][b][m][n] = (f32x4){0.f, 0.f, 0.f, 0.f};
    bf16x8 At[4][2], B0[2][2], B1[2][2];
    unsigned vgc[2][2], vgn[2][2];
    if constexpr (GATHER) { PG8_GOFF(vgc, cur); }
#pragma unroll
    for (int h = 0; h < 2; ++h)
#pragma unroll
        for (int i = 0; i < 2; ++i) { if (!GATHER) vgc[h][i] = 0u; vgn[h][i] = vgc[h][i]; }
    const char* cA = cur.a; const char* cB = cur.b;
    PG8_STB(PG8_SB(0, 0), cB, 0); PG8_STB(PG8_SB(0, 1), cB, 1); PG8_STA(PG8_SA(0, 0), cA, 0, vgc[0][_i]); PG8_STA(PG8_SA(0, 1), cA, 1, vgc[1][_i]);
    if (wr == 1) PG8_BAR;
    PG8_WAIT_V(2); PG8_BAR;
    PG8_STB(PG8_SB(1, 0), cB + kstep, 0); PG8_STA(PG8_SA(1, 0), cA + kstep, 0, vgc[0][_i]); PG8_STB(PG8_SB(1, 1), cB + kstep, 1);
    PG8_WAIT_V(6); PG8_BAR;
    for (;;) {
        const bool has_next = S.next(ui + 1, nxt);
        const char* nA = has_next ? nxt.a : cA; const char* nB = has_next ? nxt.b : cB;
        int nt = cur.nt; asm volatile("" : "+s"(nt));
#pragma unroll 1
        for (int t = 0; t < nt; t += 2) {
            const bool last = (t == nt - 2);
            const char* a1 = cA + (size_t)(t + 1) * kstep;
            const char* a2 = last ? nA : cA + (size_t)(t + 2) * kstep; const char* b2 = last ? nB : cB + (size_t)(t + 2) * kstep;
            const char* a3 = a2 + kstep; const char* b3 = b2 + kstep;
            if constexpr (Epi::MID) { if (t != 0 && (t & 3) == 0 && cur.nt == 16) E.mid(acc, cur, (t >> 2) - 1, wr, wc, fr, fq); }
            if constexpr (GATHER) { if (last && has_next) { PG8_GOFF(vgn, nxt); } }
            PG8_LDB(B0, 0, 0); PG8_LDB(B1, 0, 1); PG8_SCHED; PG8_LDA(At, 0, 0); PG8_STA(PG8_SA(1, 1), a1, 1, vgc[1][_i]);
            PG8_WAIT_V(8); PG8_WAIT_L(0); PG8_BAR; PG8_MMA(0, 0, At, B0); PG8_MMA(0, 1, At, B1); PG8_BAR; PG8_SCHED;
            PG8_LDA(At, 0, 1); PG8_STB(PG8_SB(0, 0), b2, 0); PG8_STB(PG8_SB(0, 1), b2, 1); PG8_STA(PG8_SA(0, 0), a2, 0, (last ? vgn[0][_i] : vgc[0][_i]));
            PG8_WAIT_V(8); PG8_WAIT_L(0); PG8_BAR; PG8_MMA(1, 0, At, B0); PG8_MMA(1, 1, At, B1); PG8_BAR; PG8_SCHED;
            PG8_LDB(B0, 1, 0); PG8_LDB(B1, 1, 1); PG8_SCHED; PG8_LDA(At, 1, 0); PG8_STA(PG8_SA(0, 1), a2, 1, (last ? vgn[1][_i] : vgc[1][_i]));
            PG8_WAIT_V(8); PG8_WAIT_L(0); PG8_BAR; PG8_MMA(0, 0, At, B0); PG8_MMA(0, 1, At, B1); PG8_BAR; PG8_SCHED;
            PG8_LDA(At, 1, 1); PG8_STB(PG8_SB(1, 0), b3, 0); PG8_STB(PG8_SB(1, 1), b3, 1); PG8_STA(PG8_SA(1, 0), a3, 0, (last ? vgn[0][_i] : vgc[0][_i]));
            PG8_WAIT_V(8); PG8_WAIT_L(0); PG8_BAR; PG8_MMA(1, 0, At, B0); PG8_MMA(1, 1, At, B1); PG8_BAR; PG8_SCHED;
        }
        if constexpr (F8) { asm volatile("s_nop 15\n\ts_nop 15" ::: "memory"); }
        if (wr == 0) PG8_BAR;
        Unit ue = cur; int le = lane;
        if constexpr (Epi::LAUNDER) { int t0 = cur.e0, t1 = cur.e1, t2 = cur.e2, t3 = cur.e3; asm volatile("" : "+v"(t0), "+v"(t1), "+v"(t2), "+v"(t3), "+v"(le));
          ue.e0 = __builtin_amdgcn_readfirstlane(t0); ue.e1 = __builtin_amdgcn_readfirstlane(t1); ue.e2 = __builtin_amdgcn_readfirstlane(t2); ue.e3 = __builtin_amdgcn_readfirstlane(t3); le &= 63; }
        const int fre = le & 15, fqe = le >> 4;
        if constexpr (Epi::CARRY) { E.carry(acc, ue, wr, wc, fre, fqe); if (!has_next) break; }
        else {
        E(acc, ue, wr, wc, fre, fqe);
        if (!has_next) break;
#pragma unroll
        for (int a = 0; a < 2; ++a)
#pragma unroll
            for (int b = 0; b < 2; ++b)
#pragma unroll
                for (int m = 0; m < 4; ++m)
#pragma unroll
                    for (int n = 0; n < 2; ++n) acc[a][b][m][n] = (f32x4){0.f, 0.f, 0.f, 0.f};
        }
        cur = nxt; cA = nA; cB = nB; ++ui;
#pragma unroll
        for (int h = 0; h < 2; ++h)
#pragma unroll
            for (int i = 0; i < 2; ++i) vgc[h][i] = vgn[h][i];
        if (wr == 1) PG8_BAR;
    }
    PG8_WAIT_V(0);
    PG8_BAR;
#undef PG8_SA
#undef PG8_SB
#undef PG8_STA
#undef PG8_GOFF
#undef PG8_STB
#undef PG8_LDA
#undef PG8_LDB
#undef PG8_MMA
#undef PG8_WAIT_V
#undef PG8_WAIT_L
#undef PG8_BAR
#undef PG8_SCHED
}

struct SchedPlain {
    static constexpr bool GATHER = false;
    const char* A; const char* B; size_t ta, tb; int nM, nN, G, c, nt;
    __device__ __forceinline__ bool next(int i, Unit& u) const {
        const long L = (long)i * G + c; if (L >= (long)nM * nN) return false;
        int pm, pn; tile_of((int)L, nM, nN, pm, pn); u.a = A + (size_t)pm * ta; u.b = B + (size_t)pn * tb; u.e0 = pm; u.e1 = pn; u.e2 = 0; u.e3 = 0; u.nt = nt; return true; }
    __device__ __forceinline__ unsigned rowoff(const Unit&, int) const { return 0u; }
};
struct SchedInprojA {
    static constexpr bool GATHER = false;
    const char* Hh; const char* W; int nM, G, c, ng;
    __device__ __forceinline__ bool next(int i, Unit& u) const {
        long L = (long)i * G + c; const int n1 = nM * 7, n2 = 3 * nM; if (L >= n1 + n2 + ng) return false;
        int pm, pn;
        if (L < n1) { tile_of((int)L, nM, 7, pm, pn); u.a = Hh + (size_t)pm * (256 * 2048); u.b = W + (size_t)pn * (256 * 2048); u.e2 = 0; }
        else if (L < n1 + n2) { tile_of((int)(L - n1), 3, nM, pm, pn); u.a = W + (size_t)(23 + pm) * (256 * 2048); u.b = Hh + (size_t)pn * (256 * 2048); u.e2 = 1; }
        else { const int q = (int)(L - n1 - n2); pm = q >> 4; pn = q & 15; u.a = Hh + (size_t)(64 + pm) * (256 * 2048); u.b = W + (size_t)(7 + pn) * (256 * 2048); u.e2 = 2; }
        u.e0 = pm; u.e1 = pn; u.e3 = 0; u.nt = 16; return true; }
    __device__ __forceinline__ unsigned rowoff(const Unit&, int) const { return 0u; }
};
struct SchedSplit {
    static constexpr bool GATHER = false;
    const char* A; const char* B; size_t ta, tb; int nslice, ntf, G, c; const char* Ac; size_t tac, sac; int ks;
    __device__ __forceinline__ bool next(int i, Unit& u) const {
        const long L = (long)i * G + c; int pm, pn;
        if (L < 256) { tile_of((int)L, 64, 4, pm, pn); u.a = A + (size_t)pm * ta; u.b = B + (size_t)pn * tb; u.e2 = 0; u.e3 = 0; u.nt = ntf; }
        else { const int q = (int)(L - 256); if (q >= 8 * nslice) return false; const int tile = q / nslice, s = q % nslice; pm = 64 + (tile >> 2); pn = tile & 3;
            u.a = Ac + (size_t)(tile >> 2) * tac + (size_t)(s / ks) * sac + (s % ks) * 512; u.b = B + (size_t)pn * tb + (s % ks) * 512; u.e2 = s + 1; u.e3 = tile; u.nt = 4; }
        u.e0 = pm; u.e1 = pn; return true; }
    __device__ __forceinline__ unsigned rowoff(const Unit&, int) const { return 0u; }
};
struct SchedMerge {
    static constexpr bool GATHER = false;
    const char* Mix; const char* Wb; int nctx, G, c;
    __device__ __forceinline__ bool next(int i, Unit& u) const {
        const long L = (long)i * G + c; int pm, pn;
        if (L < 256) { tile_of((int)L, 64, 4, pm, pn); u.a = Mix + (size_t)pm * (256 * 2048); u.b = Wb + (size_t)pn * (256 * 2048); u.e2 = 0; u.e3 = 0; u.nt = 16; }
        else { const long q = L - 256; if (q >= nctx) return false; const int tile = (int)q >> 2, b = (int)q & 3; pm = 64 + (tile >> 2); pn = tile & 3;
            u.a = Mix + (size_t)pm * (256 * 2048) + b * 512; u.b = Wb + (size_t)pn * (256 * 2048) + b * 512; u.e2 = b; u.e3 = 1; u.nt = 4; }
        u.e0 = pm; u.e1 = pn; return true; }
    __device__ __forceinline__ unsigned rowoff(const Unit&, int) const { return 0u; }
};
__device__ __forceinline__ int mtu(const LAS unsigned* mt, int i) { return __builtin_amdgcn_readfirstlane((int)mt[i]); }
struct SchedMoe1 {
    static constexpr bool GATHER = true;
    const char* Hh; const char* W; const int* list; const LAS unsigned* mt; int G, c; unsigned rb;
    __device__ __forceinline__ bool next(int i, Unit& u) const {
        long L = (long)i * G + c; int e = 0;
        for (; e < 8; ++e) { const long ue = (long)mtu(mt, 8 + e) * 28; if (L < ue) break; L -= ue; }
        if (e == 8) return false;
        const int m_e = mtu(mt, 8 + e), nti = (int)(L / m_e), mti = (int)(L % m_e);
        u.a = Hh; u.b = W + ((size_t)e * 7168 + (size_t)nti * 256) * rb; u.e0 = e; u.e1 = mti; u.e2 = nti; u.e3 = (mtu(mt, 16 + e) + mti) * 256; u.nt = (int)(rb >> 7); return true; }
    __device__ __forceinline__ unsigned rowoff(const Unit& u, int r) const {
        const int li = u.e1 * 256 + r; const int ent = (li < (int)mt[u.e0]) ? list[u.e0 * LCAP + li] : 0; return (unsigned)(ent >> 1) * rb; }
};
__device__ __forceinline__ bool moe2_unit(long L, const LAS unsigned* mt, const char* Hid, const char* W, Unit& u, const size_t rb) {
    int e = 0;
    for (; e < 8; ++e) { const long ue = (long)mtu(mt, 8 + e) * 4; if (L < ue) break; L -= ue; }
    if (e == 8) return false;
    const int m_e = mtu(mt, 8 + e), nti = (int)(L / m_e), mti = (int)(L % m_e);
    u.a = Hid + (size_t)(mtu(mt, 16 + e) + mti) * 256 * rb; u.b = W + ((size_t)e * 1024 + (size_t)nti * 256) * rb; u.e0 = e; u.e1 = mti; u.e2 = nti; u.e3 = 0; u.nt = (int)(rb >> 7); return true;
}
struct SchedMoe2 {
    static constexpr bool GATHER = false;
    const char* Hid; const char* W; const LAS unsigned* mt; int G, c; unsigned rb;
    __device__ __forceinline__ bool next(int i, Unit& u) const { const long L = (long)i * G + c; if (L >= (long)mtu(mt, 25)) return false; return moe2_unit(L, mt, Hid, W, u, rb); }
    __device__ __forceinline__ unsigned rowoff(const Unit&, int) const { return 0u; }
};
struct SchedMoe2S {
    static constexpr bool GATHER = false;
    const char* Hid; const char* W; const LAS unsigned* mt; int G, c; unsigned rb;
    __device__ __forceinline__ bool next(int i, Unit& u) const { const long q = (long)i * G + c; if (q >= (long)mtu(mt, 26) * 7) return false;
        if (!moe2_unit((long)mtu(mt, 25) + q / 7, mt, Hid, W, u, rb)) return false; const int s = (int)(q % 7); const unsigned sb = rb / 7u; u.a += s * sb; u.b += s * sb; u.e3 = (int)q; u.nt = (int)(sb >> 7); return true; }
    __device__ __forceinline__ unsigned rowoff(const Unit&, int) const { return 0u; }
};

#define EPI_ROWS(ai, m) (128 * (ai) + 64 * wr + 16 * (m) + fr)
#define EPI_COL(bj) (128 * (bj) + 32 * wc + 8 * fq)
__device__ __forceinline__ u32x4 pack_acc8(const f32x4 a, const f32x4 b) { u32x4 w; w.x = pk2(a[0], a[1]); w.y = pk2(a[2], a[3]); w.z = pk2(b[0], b[1]); w.w = pk2(b[2], b[3]); return w; }

__device__ __forceinline__ unsigned gq8(float g) { const unsigned q = (unsigned)(g * 255.f + 0.5f); return q < 1u ? 1u : q; }
__device__ __forceinline__ u32x2 pack_gate8(const f32x4 a, const f32x4 b) {
    u32x2 w; w.x = gq8(a[0]) | (gq8(a[1]) << 8) | (gq8(a[2]) << 16) | (gq8(a[3]) << 24); w.y = gq8(b[0]) | (gq8(b[1]) << 8) | (gq8(b[2]) << 16) | (gq8(b[3]) << 24); return w; }
__device__ __forceinline__ size_t gate_off(int pm, int j, int b, int wr, int wc, int ai, int m, int bj, int fr, int fq) { return ((((size_t)((pm * 4 + j) * 4 + b) * 8 + wr * 4 + wc) * 16 + (ai * 4 + m) * 2 + bj) * 64 + fq * 16 + fr) * 8; }
__device__ __forceinline__ float gate8(unsigned w, int k) { return (float)((w >> (8 * k)) & 255u) * (1.f / 255.f); }
struct EpiPlain { static constexpr bool CARRY = false, LAUNDER = false, MID = false;
    bf16* O; int ld;
    __device__ __forceinline__ void operator()(const f32x4 (&acc)[2][2][4][2], const Unit& u, int wr, int wc, int fr, int fq) const {
#pragma unroll
        for (int ai = 0; ai < 2; ++ai)
#pragma unroll
            for (int m = 0; m < 4; ++m) { bf16* rowp = O + (size_t)(u.e0 * 256 + EPI_ROWS(ai, m)) * ld + u.e1 * 256;
#pragma unroll
                for (int bj = 0; bj < 2; ++bj) *(u32x4*)(rowp + EPI_COL(bj)) = pack_acc8(acc[ai][bj][m][0], acc[ai][bj][m][1]); }
    }
};
struct EpiPlainSplit { static constexpr bool CARRY = false, LAUNDER = false, MID = false;
    bf16* O; int ld; float* P; int nslice;
    __device__ __forceinline__ void operator()(const f32x4 (&acc)[2][2][4][2], const Unit& u, int wr, int wc, int fr, int fq) const {
        if (u.e2 == 0) {
#pragma unroll
            for (int ai = 0; ai < 2; ++ai)
#pragma unroll
                for (int m = 0; m < 4; ++m) { bf16* rowp = O + (size_t)(u.e0 * 256 + EPI_ROWS(ai, m)) * ld + u.e1 * 256;
#pragma unroll
                    for (int bj = 0; bj < 2; ++bj) *(u32x4*)(rowp + EPI_COL(bj)) = pack_acc8(acc[ai][bj][m][0], acc[ai][bj][m][1]); }
        } else { float* pt = P + (size_t)(u.e3 * nslice + (u.e2 - 1)) * 65536;
#pragma unroll
            for (int ai = 0; ai < 2; ++ai)
#pragma unroll
                for (int m = 0; m < 4; ++m)
#pragma unroll
                    for (int bj = 0; bj < 2; ++bj) { float* p = pt + EPI_ROWS(ai, m) * 256 + EPI_COL(bj); *(f32x4*)p = acc[ai][bj][m][0]; *(f32x4*)(p + 4) = acc[ai][bj][m][1]; }
        }
    }
};
struct EpiInprojA { static constexpr bool CARRY = false, LAUNDER = false, MID = false;
    bf16* INP; bf16* T; unsigned char* Gc;
    __device__ __forceinline__ void operator()(const f32x4 (&acc)[2][2][4][2], const Unit& u, int wr, int wc, int fr, int fq) const {
        if (u.e2 == 2) {
#pragma unroll
            for (int ai = 0; ai < 2; ++ai)
#pragma unroll
                for (int m = 0; m < 4; ++m)
#pragma unroll
                    for (int bj = 0; bj < 2; ++bj) { f32x4 a = acc[ai][bj][m][0], b = acc[ai][bj][m][1];
#pragma unroll
                        for (int j = 0; j < 4; ++j) { a[j] = sigm(a[j]); b[j] = sigm(b[j]); }
                        *(u32x2*)(Gc + gate_off(u.e0, u.e1 & 3, u.e1 >> 2, wr, wc, ai, m, bj, fr, fq)) = pack_gate8(a, b); }
        } else if (u.e2 == 0) {
            bf16* base = INP + (size_t)u.e1 * ((size_t)R * 256);
            const bool regroup = (u.e1 == 1);
#pragma unroll
            for (int ai = 0; ai < 2; ++ai)
#pragma unroll
                for (int m = 0; m < 4; ++m) { const int row = u.e0 * 256 + EPI_ROWS(ai, m);
#pragma unroll
                    for (int bj = 0; bj < 2; ++bj) { const int col = EPI_COL(bj);
                        bf16* p = regroup ? base + ((((size_t)(col >> 4) * 33 + (row >> 9)) * 16 + (row & 15)) * 64 + ((col & 8) << 2) + ((row >> 4) & 31)) * 8 : base + (size_t)row * 256 + col;
                        *(u32x4*)p = pack_acc8(acc[ai][bj][m][0], acc[ai][bj][m][1]); } }
        } else {
#pragma unroll
            for (int ai = 0; ai < 2; ++ai)
#pragma unroll
                for (int m = 0; m < 4; ++m) { bf16* rowp = T + (size_t)(u.e0 * 256 + EPI_ROWS(ai, m)) * R + u.e1 * 256;
#pragma unroll
                    for (int bj = 0; bj < 2; ++bj) *(u32x4*)(rowp + EPI_COL(bj)) = pack_acc8(acc[ai][bj][m][0], acc[ai][bj][m][1]); }
        }
    }
};
struct EpiGates { static constexpr bool CARRY = false, LAUNDER = false, MID = false;
    unsigned char* Gt; float isc;
    __device__ __forceinline__ void operator()(const f32x4 (&acc)[2][2][4][2], const Unit& u, int wr, int wc, int fr, int fq) const {
#pragma unroll
        for (int ai = 0; ai < 2; ++ai)
#pragma unroll
            for (int m = 0; m < 4; ++m)
#pragma unroll
                for (int bj = 0; bj < 2; ++bj) { f32x4 a = acc[ai][bj][m][0], b = acc[ai][bj][m][1];
#pragma unroll
                    for (int j = 0; j < 4; ++j) { a[j] = sigm(a[j] * isc); b[j] = sigm(b[j] * isc); }
                    *(u32x2*)(Gt + gate_off(u.e0, u.e1 & 3, u.e1 >> 2, wr, wc, ai, m, bj, fr, fq)) = pack_gate8(a, b); }
    }
};
struct EpiGlu { static constexpr bool CARRY = false, LAUNDER = false, MID = false;
    const bf16* Zz; bf16* Mix; const float* bglu;
    __device__ __forceinline__ void operator()(const f32x4 (&acc)[2][2][4][2], const Unit& u, int wr, int wc, int fr, int fq) const {
#pragma unroll
        for (int bj = 0; bj < 2; ++bj) { const int col = EPI_COL(bj);
            const f32x4 b0 = *(const f32x4*)(bglu + col), b1 = *(const f32x4*)(bglu + col + 4);
#pragma unroll
            for (int ai = 0; ai < 2; ++ai)
#pragma unroll
                for (int m = 0; m < 4; ++m) { const size_t row = (size_t)(u.e0 * 256 + EPI_ROWS(ai, m));
                    const u32x4 zz = *(const u32x4*)(Zz + row * 256 + col);
                    f32x4 a = acc[ai][bj][m][0] + b0, b = acc[ai][bj][m][1] + b1;
                    a[0] = bflo(zz.x) * sigm(a[0]); a[1] = bfhi(zz.x) * sigm(a[1]); a[2] = bflo(zz.y) * sigm(a[2]); a[3] = bfhi(zz.y) * sigm(a[3]);
                    b[0] = bflo(zz.z) * sigm(b[0]); b[1] = bfhi(zz.z) * sigm(b[1]); b[2] = bflo(zz.w) * sigm(b[2]); b[3] = bfhi(zz.w) * sigm(b[3]);
                    *(u32x4*)(Mix + row * 1024 + 256 + col) = pack_acc8(a, b); } }
    }
};
struct EpiMerge {
    static constexpr bool CARRY = false, LAUNDER = false, MID = true;
    const unsigned char* Gt; const unsigned char* Gc; bf16* Y; bf16* YP;
    __device__ __forceinline__ void mid(f32x4 (&acc)[2][2][4][2], const Unit& u, int b, int wr, int wc, int fr, int fq) const {
#pragma unroll
        for (int ai = 0; ai < 2; ++ai) {
            u32x2 g[4][2], gn[4][2];
#pragma unroll
            for (int m = 0; m < 4; ++m)
#pragma unroll
                for (int bj = 0; bj < 2; ++bj) { const unsigned char* gp = Gt + gate_off(u.e0, u.e1, b, wr, wc, ai, m, bj, fr, fq); g[m][bj] = *(const u32x2*)gp; gn[m][bj] = *(const u32x2*)(gp + 65536); }
#pragma unroll
            for (int m = 0; m < 4; ++m)
#pragma unroll
                for (int bj = 0; bj < 2; ++bj) { f32x4 a0 = acc[ai][bj][m][0], a1 = acc[ai][bj][m][1];
#pragma unroll
                    for (int j = 0; j < 4; ++j) { a0[j] *= gate8(g[m][bj].x, j) * rcpf_(gate8(gn[m][bj].x, j)); a1[j] *= gate8(g[m][bj].y, j) * rcpf_(gate8(gn[m][bj].y, j)); }
                    acc[ai][bj][m][0] = a0; acc[ai][bj][m][1] = a1; } }
    }
    __device__ __forceinline__ void operator()(const f32x4 (&acc)[2][2][4][2], const Unit& u, int wr, int wc, int fr, int fq) const {
        const int b = u.e3 ? u.e2 : 3;
#pragma unroll
        for (int ai = 0; ai < 2; ++ai)
#pragma unroll
            for (int m = 0; m < 4; ++m) { const size_t row = (size_t)(u.e0 * 256 + EPI_ROWS(ai, m));
                bf16* orow = (u.e3 ? YP + ((size_t)b * CROWS + (row - LROWS)) * 1024 : Y + row * 1024) + u.e1 * 256;
#pragma unroll
                for (int bj = 0; bj < 2; ++bj) { const u32x2 g = *(const u32x2*)((u.e3 ? Gc : Gt) + gate_off(u.e3 ? u.e0 - 64 : u.e0, u.e1, b, wr, wc, ai, m, bj, fr, fq)); f32x4 a0 = acc[ai][bj][m][0], a1 = acc[ai][bj][m][1];
#pragma unroll
                    for (int j = 0; j < 4; ++j) { a0[j] *= gate8(g.x, j); a1[j] *= gate8(g.y, j); }
                    *(u32x4*)(orow + EPI_COL(bj)) = pack_acc8(a0, a1); } }
    }
};
struct EpiSwiglu { static constexpr bool CARRY = false, LAUNDER = false, MID = false;
    bf16* Hd; int ldh; bool moe;
    __device__ __forceinline__ void operator()(const f32x4 (&acc)[2][2][4][2], const Unit& u, int wr, int wc, int fr, int fq) const {
        const int rowbase = moe ? u.e3 : u.e0 * 256, pn = moe ? u.e2 : u.e1;
#pragma unroll
        for (int ai = 0; ai < 2; ++ai)
#pragma unroll
            for (int m = 0; m < 4; ++m) { bf16* p = Hd + (size_t)(rowbase + EPI_ROWS(ai, m)) * ldh + pn * 128 + 32 * wc + 8 * fq;
                f32x4 a = acc[ai][0][m][0], b = acc[ai][0][m][1]; const f32x4 ua = acc[ai][1][m][0], ub = acc[ai][1][m][1];
#pragma unroll
                for (int j = 0; j < 4; ++j) { a[j] = silu_(a[j]) * ua[j]; b[j] = silu_(b[j]) * ub[j]; }
                *(u32x4*)p = pack_acc8(a, b); }
    }
};
struct EpiSwigluF8 { static constexpr bool CARRY = false, LAUNDER = true, MID = false;
    unsigned char* Hd; int ldh; bool moe; float ws, hs;
    __device__ __forceinline__ void operator()(const f32x4 (&acc)[2][2][4][2], const Unit& u, int wr, int wc, int fr, int fq) const {
        const int rowbase = moe ? u.e3 : u.e0 * 256, pn = moe ? u.e2 : u.e1; const float hs2 = hs * ws;
#pragma unroll
        for (int ai = 0; ai < 2; ++ai)
#pragma unroll
            for (int m = 0; m < 4; ++m) { unsigned char* p = Hd + (size_t)(rowbase + EPI_ROWS(ai, m)) * ldh + pn * 128 + 32 * wc + 8 * fq;
                f32x4 a = acc[ai][0][m][0], b = acc[ai][0][m][1]; const f32x4 ua = acc[ai][1][m][0], ub = acc[ai][1][m][1];
#pragma unroll
                for (int j = 0; j < 4; ++j) { a[j] = __builtin_amdgcn_fmed3f(silu_(a[j] * ws) * (ua[j] * hs2), -448.f, 448.f); b[j] = __builtin_amdgcn_fmed3f(silu_(b[j] * ws) * (ub[j] * hs2), -448.f, 448.f); }
                u32x2 w; w.x = pk4_f8(a[0], a[1], a[2], a[3]); w.y = pk4_f8(b[0], b[1], b[2], b[3]); *(u32x2*)p = w; }
    }
};
struct EpiMoeDown { static constexpr bool CARRY = false, LAUNDER = true, MID = false;
    bf16* Slot; const int* list; const float* routew; const LAS unsigned* mt; float osc;
    __device__ __forceinline__ void operator()(const f32x4 (&acc)[2][2][4][2], const Unit& u, int wr, int wc, int fr, int fq) const {
        const int cnt = (int)mt[u.e0];
#pragma unroll
        for (int ai = 0; ai < 2; ++ai)
#pragma unroll
            for (int m = 0; m < 4; ++m) { const int li = u.e1 * 256 + EPI_ROWS(ai, m);
                if (li < cnt) { const int ent = list[u.e0 * LCAP + li]; const float w = routew[ent] * osc;
                    bf16* rowp = Slot + ((size_t)(ent & 1) * LROWS + (size_t)(ent >> 1)) * 1024 + u.e2 * 256;
#pragma unroll
                    for (int bj = 0; bj < 2; ++bj) *(u32x4*)(rowp + EPI_COL(bj)) = pack_acc8(acc[ai][bj][m][0] * w, acc[ai][bj][m][1] * w); } }
    }
};
struct EpiMoePart { static constexpr bool CARRY = false, LAUNDER = true, MID = false;
    bf16* Pm; const int* list; const LAS unsigned* mt; int* smap; float osc;
    __device__ __forceinline__ void operator()(const f32x4 (&acc)[2][2][4][2], const Unit& u, int wr, int wc, int fr, int fq) const {
        const int cnt = (int)mt[u.e0], q = u.e3; bf16* pt = Pm + (size_t)q * 65536; const bool mapper = (q % 7 == 0) && wc == 0 && fq == 0;
#pragma unroll
        for (int ai = 0; ai < 2; ++ai)
#pragma unroll
            for (int m = 0; m < 4; ++m) { const int rl = EPI_ROWS(ai, m), li = u.e1 * 256 + rl;
#pragma unroll
                for (int bj = 0; bj < 2; ++bj) *(u32x4*)(pt + rl * 256 + EPI_COL(bj)) = pack_acc8(acc[ai][bj][m][0] * osc, acc[ai][bj][m][1] * osc);
                if (mapper && li < cnt) smap[list[u.e0 * LCAP + li] * 4 + u.e2] = ((q / 7) << 8) | rl; }
    }
};
}
#define DROW(reg, h) (((reg) & 3) + 8 * ((reg) >> 2) + 4 * (h))

__device__ __forceinline__ void s5_state_item(const bf16* M1F  , const bf16* SUF, float* HLOC, int item, int lane) {
    const int cb = item % 33, gd = item / 33, g = gd >> 1, dir = gd & 1, li = lane & 31, h = lane >> 5;
    const bf16* A = M1F + (size_t)(g * 2 + dir) * 128 * 256 + lane * 8;
    const bf16* B = SUF + (size_t)(g * 33 + cb) * 16 * 512 + lane * 8;
    f32x16 acc[4];
#pragma unroll
    for (int rt = 0; rt < 4; ++rt) acc[rt] = zero16();
    bf16x8 a0[2][4], b0[2], a1[2][4], b1[2];
#define S5S_LOAD(AA, BB, grp) do { _Pragma("unroll") for (int s = 0; s < 2; ++s) { const int ks = (grp) * 2 + s; BB[s] = ldg8(B + ks * 512); \
        _Pragma("unroll") for (int rt = 0; rt < 4; ++rt) AA[s][rt] = ldg8(A + (ks * 4 + rt) * 512); } } while (0)
#define S5S_MMA(AA, BB) do { _Pragma("unroll") for (int s = 0; s < 2; ++s) _Pragma("unroll") for (int rt = 0; rt < 4; ++rt) acc[rt] = mma32(AA[s][rt], BB[s], acc[rt]); } while (0)
    S5S_LOAD(a0, b0, 0);
#pragma unroll 1
    for (int gp = 0; gp < 8; gp += 2) {
        S5S_LOAD(a1, b1, gp + 1);
        S5S_MMA(a0, b0);
        if (gp + 2 < 8) S5S_LOAD(a0, b0, gp + 2);
        S5S_MMA(a1, b1);
    }
#undef S5S_LOAD
#undef S5S_MMA
    const int c = cb * 32 + li; float* o = HLOC + (((size_t)(g * 2 + dir) * (NCH16 / 2) + (c >> 1)) * 64) * 4 + (c & 1) * 2;
#pragma unroll
    for (int rt = 0; rt < 4; ++rt)
#pragma unroll
        for (int q = 0; q < 4; ++q) { const int p0 = 16 * rt + 4 * q + 2 * h;
            *(f32x2*)(o + (size_t)p0 * 4) = (f32x2){acc[rt][4 * q], acc[rt][4 * q + 1]}; *(f32x2*)(o + (size_t)(p0 + 1) * 4) = (f32x2){acc[rt][4 * q + 2], acc[rt][4 * q + 3]}; }
}
__device__ __forceinline__ void s5_scan_item(const float* A16  , const float* HLOC, bf16* HINF, LAS unsigned char* wl, int item, int lane) {
    const int dir = item & 1, g = (item >> 1) & 15, b = item >> 5, p = lane;
    const f32x2 a = *(const f32x2*)(A16 + ((size_t)(dir * 16 + g) * 64 + p) * 2);
    const float* src = HLOC + ((size_t)(g * 2 + dir) * (NCH16 / 2) * 64 + p) * 4;
    const int k2 = dir * 128 + 2 * p;
    bf16* dctx = HINF + ((size_t)(g * 33 + 32) * 16 + (k2 >> 4)) * 512 + ((k2 >> 3) & 1) * 256 + (k2 & 7);
    float hr = 0.f, hi = 0.f;
#define S5_STEP(xr, xi) do { const float nr_ = a.x * hr - a.y * hi + (xr), ni_ = a.x * hi + a.y * hr + (xi); hr = nr_; hi = ni_; } while (0)
    {
        f32x4 v[8];
#pragma unroll
        for (int j = 0; j < 8; ++j) v[j] = *(const f32x4*)(src + (size_t)(512 + 8 * b + (dir ? 7 - j : j)) * 256);
#pragma unroll
        for (int j = 0; j < 8; ++j) { const int cl0 = 16 * b + 2 * (dir ? 7 - j : j);
            if (!dir) { *(unsigned*)(dctx + (cl0) * 8) = pk2(hr, hi); S5_STEP(v[j][0], v[j][1]); *(unsigned*)(dctx + (cl0 + 1) * 8) = pk2(hr, hi); S5_STEP(v[j][2], v[j][3]); }
            else      { *(unsigned*)(dctx + (cl0 + 1) * 8) = pk2(hr, hi); S5_STEP(v[j][2], v[j][3]); *(unsigned*)(dctx + (cl0) * 8) = pk2(hr, hi); S5_STEP(v[j][0], v[j][1]); } }
    }
    const int pg = p >> 2; LAS unsigned char* wbase = wl + ((p >> 3) * 64 + (pg & 1) * 32) * 16 + 4 * (p & 3);
    f32x4 vn[16];
#pragma unroll
    for (int j = 0; j < 16; ++j) vn[j] = *(const f32x4*)(src + (size_t)(256 * b + (dir ? 255 - j : j)) * 256);
#pragma unroll 1
    for (int blk = 0; blk < 16; ++blk) {
        f32x4 v[16];
#pragma unroll
        for (int j = 0; j < 16; ++j) v[j] = vn[j];
        if (blk < 15) {
#pragma unroll
            for (int j = 0; j < 16; ++j) { const int pj = 16 * (blk + 1) + j; vn[j] = *(const f32x4*)(src + (size_t)(256 * b + (dir ? 255 - pj : pj)) * 256); } }
#pragma unroll
        for (int j = 0; j < 16; ++j) { const int pl = dir ? 15 - j : j;
            if (!dir) { *(LAS unsigned*)(wbase + ((2 * pl + pg) & 31) * 16) = pk2(hr, hi); S5_STEP(v[j][0], v[j][1]); *(LAS unsigned*)(wbase + ((2 * pl + 1 + pg) & 31) * 16) = pk2(hr, hi); S5_STEP(v[j][2], v[j][3]); }
            else      { *(LAS unsigned*)(wbase + ((2 * pl + 1 + pg) & 31) * 16) = pk2(hr, hi); S5_STEP(v[j][2], v[j][3]); *(LAS unsigned*)(wbase + ((2 * pl + pg) & 31) * 16) = pk2(hr, hi); S5_STEP(v[j][0], v[j][1]); } }
        const int cb = 16 * b + (dir ? 15 - blk : blk), hs = lane >> 5, cl = lane & 31;
        bf16* dout = HINF + ((size_t)(g * 33 + cb) * 16 + dir * 8) * 512 + lane * 8;
#pragma unroll
        for (int j = 0; j < 8; ++j) *(u32x4*)(dout + j * 512) = *(const LAS u32x4*)(wl + (j * 64 + hs * 32 + ((cl + 2 * j + hs) & 31)) * 16);
    }
#undef S5_STEP
}
__device__ __forceinline__ void s5_out_item(const bf16* TABF  , const bf16* SUF, const bf16* HINF, bf16* Z, int item, int lane) {
    const int mh = item & 1, it2 = item >> 1, cb = it2 % 33, g = it2 / 33, li = lane & 31, h = lane >> 5, c = cb * 32 + li;
    const bf16* A = TABF + ((size_t)g * 256 + mh * 128) * 512 + lane * 8;
    const bf16* B0 = SUF + (size_t)(g * 33 + cb) * 16 * 512 + lane * 8;
    const bf16* B1 = HINF + (size_t)(g * 33 + cb) * 16 * 512 + lane * 8;
    f32x16 acc[4];
#pragma unroll
    for (int rt = 0; rt < 4; ++rt) acc[rt] = zero16();
    bf16x8 a0[2][4], b0[2], a1[2][4], b1[2];
#define S5O_LOAD(AA, BB, grp) do { _Pragma("unroll") for (int s = 0; s < 2; ++s) { const int ks = (grp) * 2 + s; BB[s] = ldg8((ks < 16 ? B0 + ks * 512 : B1 + (ks - 16) * 512)); \
        _Pragma("unroll") for (int rt = 0; rt < 4; ++rt) AA[s][rt] = ldg8(A + (ks * 4 + rt) * 512); } } while (0)
#define S5O_MMA(AA, BB) do { _Pragma("unroll") for (int s = 0; s < 2; ++s) _Pragma("unroll") for (int rt = 0; rt < 4; ++rt) acc[rt] = mma32(AA[s][rt], BB[s], acc[rt]); } while (0)
    S5O_LOAD(a0, b0, 0);
#pragma unroll 1
    for (int gp = 0; gp < 16; gp += 2) {
        S5O_LOAD(a1, b1, gp + 1);
        S5O_MMA(a0, b0);
        if (gp + 2 < 16) S5O_LOAD(a0, b0, gp + 2);
        S5O_MMA(a1, b1);
    }
#undef S5O_LOAD
#undef S5O_MMA
#pragma unroll
    for (int rt = 0; rt < 4; ++rt)
#pragma unroll
        for (int q = 0; q < 4; ++q) {
            const int i = 8 * mh + 2 * rt + (q >> 1), ho0 = 8 * (q & 1) + 4 * h;
            u32x2 w; w.x = pk2(gelu_tanh(acc[rt][4 * q]), gelu_tanh(acc[rt][4 * q + 1])); w.y = pk2(gelu_tanh(acc[rt][4 * q + 2]), gelu_tanh(acc[rt][4 * q + 3]));
            *(u32x2*)(Z + ((size_t)c * 16 + i) * 256 + g * 16 + ho0) = w; }
}

__device__ __forceinline__ int ret_tok0(int b, int n) { return n < 64 ? b * SEQ + n * 128 : LROWS + b * CTXL + (n - 64) * 128; }
__device__ __forceinline__ void ret_kv_item(const bf16* RKT, const bf16* RVT, const float* COST, const float* SINT, const float* decay  , float* KV, int item, int lane) {
    const int n = item % 66, bh = item / 66, hd = bh & 3, b = bh >> 2, li = lane & 31, h = lane >> 5;
    const int tok0 = ret_tok0(b, n); const bool lat = n < 64;
    const float lgf = -log2f(1.f + __expf(-decay[hd])), lgr = -log2f(1.f + __expf(-decay[4 + hd]));
    f32x16 acc[2][2][2];
#pragma unroll
    for (int a = 0; a < 2; ++a)
#pragma unroll
        for (int c = 0; c < 2; ++c)
#pragma unroll
            for (int d = 0; d < 2; ++d) acc[a][c][d] = zero16();
    const bf16* k0p = RKT + (size_t)(hd * 64 + li) * R + tok0 + 8 * h;
    const bf16* v0p = RVT + (size_t)(hd * 64 + li) * R + tok0 + 8 * h;
#pragma unroll 2
    for (int ks = 0; ks < 8; ++ks) {
        float k1[8], k2[8];
        unpack8(ldg8(k0p + ks * 16), k1); unpack8(ldg8(k0p + (size_t)32 * R + ks * 16), k2);
        if (lat) {
            const float* cp = COST + (size_t)li * SEQ + n * 128 + ks * 16 + 8 * h; const float* sp = SINT + (size_t)li * SEQ + n * 128 + ks * 16 + 8 * h;
            const f32x4 c0 = *(const f32x4*)cp, c1 = *(const f32x4*)(cp + 4), s0 = *(const f32x4*)sp, s1 = *(const f32x4*)(sp + 4);
#pragma unroll
            for (int j = 0; j < 8; ++j) { const float cc = j < 4 ? c0[j & 3] : c1[j & 3], ss = j < 4 ? s0[j & 3] : s1[j & 3];
                const float x1 = k1[j], x2 = k2[j]; k1[j] = x1 * cc - x2 * ss; k2[j] = x1 * ss + x2 * cc; }
        }
        const bf16x8 vf0 = ldg8(v0p + ks * 16), vf1 = ldg8(v0p + (size_t)32 * R + ks * 16);
#pragma unroll
        for (int dir = 0; dir < 2; ++dir) {
            float a1[8], a2[8];
#pragma unroll
            for (int j = 0; j < 8; ++j) { const int i = ks * 16 + 8 * h + j; const float w = dir == 0 ? ex2(lgf * (float)(127 - i)) : ex2(lgr * (float)i); a1[j] = k1[j] * w; a2[j] = k2[j] * w; }
            const bf16x8 kd0 = pack8(a1), kd1 = pack8(a2);
            acc[dir][0][0] = mma32(kd0, vf0, acc[dir][0][0]); acc[dir][0][1] = mma32(kd0, vf1, acc[dir][0][1]);
            acc[dir][1][0] = mma32(kd1, vf0, acc[dir][1][0]); acc[dir][1][1] = mma32(kd1, vf1, acc[dir][1][1]);
        }
    }
#pragma unroll
    for (int dir = 0; dir < 2; ++dir) { float* o = KV + ((size_t)((b * 4 + hd) * 2 + dir) * 66 + n) * 4096;
#pragma unroll
        for (int dt = 0; dt < 2; ++dt)
#pragma unroll
            for (int et = 0; et < 2; ++et)
#pragma unroll
                for (int q = 0; q < 4; ++q) *(f32x4*)(o + (size_t)(et * 32 + li) * 64 + dt * 32 + 8 * q + 4 * h) = (f32x4){acc[dir][dt][et][4 * q], acc[dir][dt][et][4 * q + 1], acc[dir][dt][et][4 * q + 2], acc[dir][dt][et][4 * q + 3]}; }
}
__device__ __forceinline__ void ret_scan_item(const float* decay, const float* KV, bf16* SPREV, int item, int lane) {
    const int blk = item & 63, bhd = item >> 6, dir = bhd & 1, hd = (bhd >> 1) & 3, idx = blk * 64 + lane;
    const float lg = -log2f(1.f + __expf(-decay[dir * 4 + hd])), cd = ex2(128.f * lg);
    const float* src = KV + (size_t)bhd * 66 * 4096 + idx; bf16* dst = SPREV + (size_t)bhd * 66 * 4096 + idx;
    float s = 0.f;
    for (int s0 = 0; s0 < 66; s0 += 11) {
        float v[11];
#pragma unroll
        for (int j = 0; j < 11; ++j) { const int t = s0 + j; const int n = dir == 0 ? (t < 2 ? 64 + t : t - 2) : (t < 2 ? 65 - t : 65 - t); v[j] = src[(size_t)n * 4096]; }
#pragma unroll
        for (int j = 0; j < 11; ++j) { const int t = s0 + j; const int n = dir == 0 ? (t < 2 ? 64 + t : t - 2) : (t < 2 ? 65 - t : 65 - t); dst[(size_t)n * 4096] = (bf16)(pk2(s, 0.f) & 0xffffu); s = cd * s + v[j]; }
    }
}
struct KVTile { u32x4 k[4], v[4]; };
__device__ __forceinline__ void kv_tile_load(KVTile& T, const bf16* Kh  , const bf16* VTh  , int tok0, int lane) {
#pragma unroll
    for (int i = 0; i < 4; ++i) T.k[i] = *(const u32x4*)(Kh + (size_t)(tok0 + 8 * i + (lane >> 3)) * 256 + (lane & 7) * 8);
#pragma unroll
    for (int i = 0; i < 4; ++i) T.v[i] = *(const u32x4*)(VTh + (size_t)(16 * i + (lane >> 2)) * R + tok0 + (lane & 3) * 8);
}
__device__ __forceinline__ void kv_tile_store(const KVTile& T, LAS unsigned char* wl, int lane) {
#pragma unroll
    for (int i = 0; i < 4; ++i) *(LAS u32x4*)(wl + (8 * i + (lane >> 3)) * 144 + (lane & 7) * 16) = T.k[i];
#pragma unroll
    for (int i = 0; i < 4; ++i) *(LAS u32x4*)(wl + 4608 + (16 * i + (lane >> 2)) * 80 + (lane & 3) * 16) = T.v[i];
}
__device__ __forceinline__ void kv_tile_frags(const LAS unsigned char* wl, int lane, bf16x8 (&kf)[4], bf16x8 (&vf)[2][2]) {
    const int li = lane & 31, h = lane >> 5;
#pragma unroll
    for (int s = 0; s < 4; ++s) kf[s] = *(const LAS bf16x8*)(wl + li * 144 + (2 * s + h) * 16);
#pragma unroll
    for (int et = 0; et < 2; ++et)
#pragma unroll
        for (int s2 = 0; s2 < 2; ++s2) { const LAS unsigned char* p = wl + 4608 + (et * 32 + li) * 80 + s2 * 32 + 8 * h;
            const bf16x4 lo = *(const LAS bf16x4*)p, hi = *(const LAS bf16x4*)(p + 16); vf[et][s2] = __builtin_shufflevector(lo, hi, 0, 1, 2, 3, 4, 5, 6, 7); }
}

__device__ __forceinline__ void rope_item(bf16* RQ, bf16* RK, const float* COSN, const float* SINN, int item, int lane) {
    const int u = lane & 15, off = (u >> 2) * 64 + (u & 3) * 8, c8 = (u & 3) * 8;
#pragma unroll 4
    for (int st = 0; st < 32; ++st) { const int row = item * 128 + 4 * st + (lane >> 4), tl = row & (SEQ - 1);
        const f32x4 c0 = *(const f32x4*)(COSN + (size_t)tl * 32 + c8), c1 = *(const f32x4*)(COSN + (size_t)tl * 32 + c8 + 4), s0 = *(const f32x4*)(SINN + (size_t)tl * 32 + c8), s1 = *(const f32x4*)(SINN + (size_t)tl * 32 + c8 + 4);
#pragma unroll
        for (int w = 0; w < 2; ++w) { bf16* p = (w ? RK : RQ) + (size_t)row * 256 + off; float x1[8], x2[8]; unpack8(*(const bf16x8*)p, x1); unpack8(*(const bf16x8*)(p + 32), x2);
#pragma unroll
            for (int j = 0; j < 8; ++j) { const float cc = j < 4 ? c0[j & 3] : c1[j & 3], ss = j < 4 ? s0[j & 3] : s1[j & 3]; const float a = x1[j], bb = x2[j]; x1[j] = a * cc - bb * ss; x2[j] = a * ss + bb * cc; }
            *(bf16x8*)p = pack8(x1); *(bf16x8*)(p + 32) = pack8(x2); } }
}
__device__ __forceinline__ void ret_out_item(const bf16* RQ, const bf16* RK, const bf16* RG, const bf16* RVT, const bf16* SPREV, const float* decay, const float* gn  , bf16* MIX,
                                             LAS unsigned char* wl, int item, int lane) {
    const int qb = item & 3, it2 = item >> 2, n = it2 % 66, bh = it2 / 66, hd = bh & 3, b = bh >> 2, li = lane & 31, h = lane >> 5;
    const int tok0 = ret_tok0(b, n);
    const float lgf = -log2f(1.f + __expf(-decay[hd])), lgr = -log2f(1.f + __expf(-decay[4 + hd]));
    const int iq = qb * 32 + li;
    const bf16* Kh = RK + hd * 64; const bf16* VTh = RVT + (size_t)hd * 64 * R;
    KVTile T; kv_tile_load(T, Kh, VTh, tok0, lane);
    bf16x8 qf[4];
    { const bf16* qp = RQ + (size_t)(tok0 + iq) * 256 + hd * 64 + 8 * h;
#pragma unroll
      for (int s = 0; s < 4; ++s) qf[s] = ldg8(qp + 16 * s); }
    kv_tile_store(T, wl, lane);
    f32x16 accO[2] = {zero16(), zero16()};
#pragma unroll 1
    for (int kt = 0; kt < 4; ++kt) {
        kv_tile_load(T, Kh, VTh, tok0 + (kt < 3 ? kt + 1 : kt) * 32, lane);
        bf16x8 kf[4], vf[2][2]; kv_tile_frags(wl, lane, kf, vf);
        f32x16 st = zero16();
#pragma unroll
        for (int s = 0; s < 4; ++s) st = mma32(kf[s], qf[s], st);
#pragma unroll
        for (int r = 0; r < 16; ++r) { const int j = kt * 32 + DROW(r, h), df = iq - j;
            const float w = df > 0 ? ex2(lgf * (float)df) : (df < 0 ? ex2(lgr * (float)(-df)) : 2.f); st[r] *= w; }
        const bf16x8 p0 = accB<0>(st), p1 = accB<1>(st);
        accO[0] = mma32(vf[0][0], p0, accO[0]); accO[0] = mma32(vf[0][1], p1, accO[0]); accO[1] = mma32(vf[1][0], p0, accO[1]); accO[1] = mma32(vf[1][1], p1, accO[1]);
        kv_tile_store(T, wl, lane);
    }
    const float cf = ex2(lgf * (float)(iq + 1)), cr = ex2(lgr * (float)(128 - iq));
#pragma unroll
    for (int dir = 0; dir < 2; ++dir) { const bf16* sp = SPREV + ((size_t)((b * 4 + hd) * 2 + dir) * 66 + n) * 4096;
#pragma unroll
        for (int et = 0; et < 2; ++et) { f32x16 a = zero16();
#pragma unroll
            for (int s = 0; s < 4; ++s) a = mma32(ldg8(sp + (size_t)(et * 32 + li) * 64 + 16 * s + 8 * h), qf[s], a);
            const float sc = dir == 0 ? cf : cr;
#pragma unroll
            for (int r = 0; r < 16; ++r) accO[et][r] += sc * a[r]; } }
    float s1 = 0.f;
#pragma unroll
    for (int et = 0; et < 2; ++et)
#pragma unroll
        for (int r = 0; r < 16; ++r) s1 += accO[et][r];
    s1 = xor32_sum(s1); const float mu = s1 * (1.f / 64.f);
    float s2 = 0.f;
#pragma unroll
    for (int et = 0; et < 2; ++et)
#pragma unroll
        for (int r = 0; r < 16; ++r) { const float dlt = accO[et][r] - mu; s2 += dlt * dlt; }
    s2 = xor32_sum(s2); const float rstd = __builtin_amdgcn_rsqf(s2 * (1.f / 64.f) + EPSN);
    const size_t tok = (size_t)(tok0 + iq);
#pragma unroll
    for (int et = 0; et < 2; ++et)
#pragma unroll
        for (int q = 0; q < 4; ++q) { const int e0 = hd * 64 + et * 32 + 8 * q + 4 * h;
            const f32x4 gv = *(const f32x4*)(gn + e0); const u32x2 gg = *(const u32x2*)(RG + tok * 256 + e0);
            const float g0 = bflo(gg.x), g1 = bfhi(gg.x), g2 = bflo(gg.y), g3 = bfhi(gg.y);
            u32x2 w; w.x = pk2(silu_(g0) * (accO[et][4 * q] - mu) * rstd * gv[0], silu_(g1) * (accO[et][4 * q + 1] - mu) * rstd * gv[1]);
            w.y = pk2(silu_(g2) * (accO[et][4 * q + 2] - mu) * rstd * gv[2], silu_(g3) * (accO[et][4 * q + 3] - mu) * rstd * gv[3]);
            *(u32x2*)(MIX + tok * 1024 + 512 + e0) = w; }
}

__device__ __forceinline__ int na_tile_tok(int t, int b, int rs) { const int tb = t - 8; return t >= 8 ? b * SEQ + (rs + (tb >> 1)) * 64 + (tb & 1) * 32 : LROWS + b * CTXL + t * 32; }
__device__ __forceinline__ void na_item(const bf16* NQ, const bf16* NK, const bf16* NVT, bf16* MIX, const LAS float* rpb2, LAS unsigned char* wl, bool ctxq, int b, int r, int hd, int qs, int lane) {
    const int li = lane & 31, h = lane >> 5;
    const int tokq = ctxq ? LROWS + b * CTXL + qs * 32 + li : b * SEQ + r * 64 + qs * 32 + li;
    bf16x8 qf[4];
#pragma unroll
    for (int s = 0; s < 4; ++s) qf[s] = ldg8(NQ + (size_t)tokq * 256 + hd * 64 + 16 * s + 8 * h);
    float mrun = -1e30f, lrun = 0.f;
    f32x16 accO[2] = {zero16(), zero16()};
    const int rs = r - 4 < 0 ? 0 : (r - 4 > 120 ? 120 : r - 4);
    const int qc = qs * 32 + li, cs = qc - 8 < 0 ? 0 : (qc - 8 > 48 ? 48 : qc - 8);
    const int ntile = ctxq ? 8 : 24;
    const float c1 = 0.125f * LOG2E;
    const bf16* Kh = NK + hd * 64; const bf16* VTh = NVT + (size_t)hd * 64 * R;
    KVTile T; kv_tile_load(T, Kh, VTh, na_tile_tok(0, b, rs), lane); kv_tile_store(T, wl, lane);
#pragma unroll 1
    for (int t = 0; t < ntile; ++t) {
        const bool band = t >= 8; const int tb = t - 8, rr = rs + (tb >> 1), ct = tb & 1;
        kv_tile_load(T, Kh, VTh, na_tile_tok(t + 1 < ntile ? t + 1 : t, b, rs), lane);
        bf16x8 kf[4], vf[2][2]; kv_tile_frags(wl, lane, kf, vf);
        f32x16 st = zero16();
#pragma unroll
        for (int s = 0; s < 4; ++s) st = mma32(kf[s], qf[s], st);
        float mt = -INFINITY;
        if (band) { const int dr = rr - r + 7; const LAS float* bp = rpb2 + ((hd * 15 + dr) * 31 + 32 * ct - qc + 15 + 4 * h); const int d0 = 32 * ct + 4 * h - cs;
#pragma unroll
            for (int g = 0; g < 16; ++g) { const int o = 8 * (g >> 2) + (g & 3); const bool inw = (unsigned)(d0 + o) < 16u;
                const float v = inw ? st[g] * c1 + bp[o] : -INFINITY; st[g] = v; mt = fmaxf(mt, v); }
        } else {
#pragma unroll
            for (int g = 0; g < 16; ++g) { const float v = st[g] * c1; st[g] = v; mt = fmaxf(mt, v); }
        }
        mt = xor32_max(mt);
        const float mnew = fmaxf(mrun, mt);
        if (__builtin_amdgcn_ballot_w64(mnew > mrun)) { const float alpha = ex2(mrun - mnew); lrun *= alpha;
#pragma unroll
            for (int et = 0; et < 2; ++et)
#pragma unroll
                for (int g = 0; g < 16; ++g) accO[et][g] *= alpha; }
        mrun = mnew;
        float ps = 0.f;
#pragma unroll
        for (int g = 0; g < 16; ++g) { const float p = ex2(st[g] - mnew); st[g] = p; ps += p; }
        lrun += xor32_sum(ps);
        const bf16x8 p0 = accB<0>(st), p1 = accB<1>(st);
        accO[0] = mma32(vf[0][0], p0, accO[0]); accO[0] = mma32(vf[0][1], p1, accO[0]); accO[1] = mma32(vf[1][0], p0, accO[1]); accO[1] = mma32(vf[1][1], p1, accO[1]);
        kv_tile_store(T, wl, lane);
    }
    const float inv = 1.f / lrun;
#pragma unroll
    for (int et = 0; et < 2; ++et)
#pragma unroll
        for (int q = 0; q < 4; ++q) { u32x2 w; w.x = pk2(accO[et][4 * q] * inv, accO[et][4 * q + 1] * inv); w.y = pk2(accO[et][4 * q + 2] * inv, accO[et][4 * q + 3] * inv);
            *(u32x2*)(MIX + (size_t)tokq * 1024 + 768 + hd * 64 + et * 32 + 8 * q + 4 * h) = w; }
}

__device__ __forceinline__ void fft1_item(const bf16* F, const bf16* W128T, const float* TWC, const float* TWS, bf16* FB, int item, int lane) {
    const int l2 = item & 63, g = (item >> 6) & 3, b = item >> 8, li = lane & 31, h = lane >> 5;
    bf16x8 idf[4];
#pragma unroll
    for (int s = 0; s < 4; ++s) { float v[8];
#pragma unroll
        for (int j = 0; j < 8; ++j) v[j] = (16 * (s & 1) + 8 * h + j == li) ? 1.f : 0.f;
        idf[s] = pack8(v); }
    bf16x8 xb[4][2][2];
#pragma unroll
    for (int lt = 0; lt < 4; ++lt) {
        const bf16* xp = F + (size_t)(b * SEQ + 64 * (lt * 32 + li) + l2) * 256 + g * 64 + 8 * h;
        const bf16x8 x0 = ldg8(xp), x1 = ldg8(xp + 16), x2 = ldg8(xp + 32), x3 = ldg8(xp + 48);
        f32x16 c0 = zero16(), c1 = zero16();
        c0 = mma32(x0, idf[0], c0); c0 = mma32(x1, idf[1], c0);
        c1 = mma32(x2, idf[0], c1); c1 = mma32(x3, idf[1], c1);
        xb[lt][0][0] = accB<0>(c0); xb[lt][0][1] = accB<1>(c0); xb[lt][1][0] = accB<0>(c1); xb[lt][1][1] = accB<1>(c1);
    }
#pragma unroll 1
    for (int kb = 0; kb < 4; ++kb) {
        f32x16 acc[2][2];
#pragma unroll
        for (int ri = 0; ri < 2; ++ri) { acc[ri][0] = zero16(); acc[ri][1] = zero16();
            const bf16* wp = W128T + ((size_t)ri * 128 + kb * 32 + li) * 128 + 4 * h;
#pragma unroll
            for (int lt = 0; lt < 4; ++lt)
#pragma unroll
                for (int s = 0; s < 2; ++s) { const bf16x8 wf = ldg8p(wp + lt * 32 + 16 * s);
                    acc[ri][0] = mma32(wf, xb[lt][0][s], acc[ri][0]); acc[ri][1] = mma32(wf, xb[lt][1][s], acc[ri][1]); } }
#pragma unroll
        for (int q = 0; q < 4; ++q) { const int k1 = kb * 32 + 8 * q + 4 * h;
            const f32x4 tc = *(const f32x4*)(TWC + l2 * 128 + k1), ts = *(const f32x4*)(TWS + l2 * 128 + k1);
#pragma unroll
            for (int j = 0; j < 4; ++j)
#pragma unroll
                for (int ct = 0; ct < 2; ++ct) { const float ar = acc[0][ct][4 * q + j], ai = acc[1][ct][4 * q + j];
                    const float br = ar * tc[j] + ai * ts[j], bi = ai * tc[j] - ar * ts[j];
                    bf16* o = FB + ((((size_t)(b * 4 + g) * 128 + k1 + j) * 2) * 64 + l2) * 64 + ct * 32 + li;
                    o[0] = (bf16)(pk2(br, 0.f) & 0xffffu); o[64 * 64] = (bf16)(pk2(bi, 0.f) & 0xffffu); } }
    }
}
__device__ __forceinline__ void fft2_item(const bf16* FB, const bf16* FCT, const bf16* W64T, bf16* MIX, int item, int lane) {
    const int mh = item & 1, k1 = (item >> 1) & 127, g = (item >> 8) & 3, b = item >> 10, li = lane & 31, h = lane >> 5;
    const bf16* br = FB + (((size_t)(b * 4 + g) * 128 + k1) * 2) * 64 * 64; const bf16* bi = br + 64 * 64;
    const bf16* fc = FCT + (size_t)(mh * 32 + li) * 64 + 8 * h; const bf16* fs = fc + 64 * 64; const bf16* fn = fc + 2 * 64 * 64;
    bf16x8 eb[2][2][2];
#pragma unroll
    for (int lt = 0; lt < 2; ++lt) { f32x16 er = zero16(), ei = zero16();
#pragma unroll
        for (int s = 0; s < 4; ++s) { const bf16x8 ar = ldg8(br + (size_t)(lt * 32 + li) * 64 + 16 * s + 8 * h), ai = ldg8(bi + (size_t)(lt * 32 + li) * 64 + 16 * s + 8 * h);
            const bf16x8 c = ldg8(fc + 16 * s), sn = ldg8(fs + 16 * s), ns = ldg8(fn + 16 * s);
            er = mma32(ar, c, er); er = mma32(ai, sn, er); ei = mma32(ai, c, ei); ei = mma32(ar, ns, ei); }
        eb[lt][0][0] = accB<0>(er); eb[lt][0][1] = accB<1>(er); eb[lt][1][0] = accB<0>(ei); eb[lt][1][1] = accB<1>(ei); }
#pragma unroll
    for (int kt = 0; kt < 2; ++kt) { f32x16 o = zero16();
        const bf16* wc = W64T + (size_t)(kt * 32 + li) * 64 + 4 * h; const bf16* wsn = wc + 64 * 64;
#pragma unroll
        for (int lt = 0; lt < 2; ++lt)
#pragma unroll
            for (int s = 0; s < 2; ++s) { o = mma32(ldg8p(wc + lt * 32 + 16 * s), eb[lt][0][s], o); o = mma32(ldg8p(wsn + lt * 32 + 16 * s), eb[lt][1][s], o); }
#pragma unroll
        for (int rg = 0; rg < 16; ++rg) { const int k2 = kt * 32 + DROW(rg, h);
            MIX[(size_t)(b * SEQ + k1 + 128 * k2) * 1024 + g * 64 + mh * 32 + li] = (bf16)(pk2(o[rg], 0.f) & 0xffffu); } }
}
__device__ __forceinline__ void fftc_item(const bf16* F, const bf16* FCT, const bf16* W256T, bf16* MIX, int item, int lane) {
    const int mh = item & 1, kb = (item >> 1) & 7, g = (item >> 4) & 3, b = item >> 6, li = lane & 31, h = lane >> 5;
    const bf16* fc = FCT + (size_t)(mh * 32 + li) * 64 + 8 * h; const bf16* fn = fc + 2 * 64 * 64;
    const bf16* wc = W256T + (size_t)(kb * 32 + li) * 256 + 4 * h; const bf16* wsn = wc + 256 * 256;
    f32x16 o = zero16();
#pragma unroll 1
    for (int lt = 0; lt < 8; ++lt) { f32x16 zr = zero16(), zi = zero16();
        const bf16* xp = F + (size_t)(LROWS + b * CTXL + lt * 32 + li) * 256 + g * 64 + 8 * h;
#pragma unroll
        for (int s = 0; s < 4; ++s) { const bf16x8 x = ldg8(xp + 16 * s); zr = mma32(x, ldg8(fc + 16 * s), zr); zi = mma32(x, ldg8(fn + 16 * s), zi); }
        o = mma32(ldg8p(wc + lt * 32), accB<0>(zr), o); o = mma32(ldg8p(wc + lt * 32 + 16), accB<1>(zr), o);
        o = mma32(ldg8p(wsn + lt * 32), accB<0>(zi), o); o = mma32(ldg8p(wsn + lt * 32 + 16), accB<1>(zi), o); }
#pragma unroll
    for (int rg = 0; rg < 16; ++rg) { const int k = kb * 32 + DROW(rg, h);
        MIX[(size_t)(LROWS + b * CTXL + k) * 1024 + g * 64 + mh * 32 + li] = (bf16)(pk2(o[rg], 0.f) & 0xffffu); }
}
__device__ __forceinline__ void row_ld_f32(const float* p, int lane, f32x4 (&v)[4]) {
#pragma unroll
    for (int j = 0; j < 4; ++j) v[j] = *(const f32x4*)(p + 256 * j + 4 * lane); }
__device__ __forceinline__ void row_ld_bf16(const bf16* p, int lane, f32x4 (&v)[4]) {
#pragma unroll
    for (int j = 0; j < 4; ++j) { const u32x2 w = *(const u32x2*)(p + 256 * j + 4 * lane); v[j] = (f32x4){bflo(w.x), bfhi(w.x), bflo(w.y), bfhi(w.y)}; } }
__device__ __forceinline__ void row_ld_part(const float* P, int nslice, int r, int lane, f32x4 (&v)[4]) {
#pragma unroll
    for (int j = 0; j < 4; ++j) { const float* p = P + ((size_t)((((r - LROWS) >> 8) * 4 + j) * nslice) * 256 + (r & 255)) * 256 + 4 * lane; f32x4 s = *(const f32x4*)p;
        for (int k = 1; k < nslice; ++k) s = s + *(const f32x4*)(p + (size_t)k * 65536);
        v[j] = s; } }
__device__ __forceinline__ void row_st_f32(float* p, int lane, const f32x4 (&v)[4]) {
#pragma unroll
    for (int j = 0; j < 4; ++j) *(f32x4*)(p + 256 * j + 4 * lane) = v[j]; }
__device__ __forceinline__ void row_st_bf16(bf16* p, int lane, const f32x4 (&v)[4]) {
#pragma unroll
    for (int j = 0; j < 4; ++j) { u32x2 w; w.x = pk2(v[j][0], v[j][1]); w.y = pk2(v[j][2], v[j][3]); *(u32x2*)(p + 256 * j + 4 * lane) = w; } }
__device__ __forceinline__ void row_st_f8(unsigned char* p, int lane, const f32x4 (&v)[4]) {
#pragma unroll
    for (int j = 0; j < 4; ++j) *(unsigned*)(p + 256 * j + 4 * lane) = pk4_f8(v[j][0], v[j][1], v[j][2], v[j][3]); }
__device__ __forceinline__ float row_rstd(const f32x4 (&v)[4]) { float s = 0.f;
#pragma unroll
    for (int j = 0; j < 4; ++j) s += (v[j][0] * v[j][0] + v[j][1] * v[j][1]) + (v[j][2] * v[j][2] + v[j][3] * v[j][3]);
    return __builtin_amdgcn_rsqf(wave_sum(s) * (1.f / 1024.f) + EPSN); }
__device__ __forceinline__ void row_modnorm(const f32x4 (&x)[4], const float* g, const float* sc, const float* sh, int lane, f32x4 (&hh)[4]) {
    const float rs = row_rstd(x); f32x4 gv[4], scv[4], shv[4]; row_ld_f32(g, lane, gv); row_ld_f32(sc, lane, scv); row_ld_f32(sh, lane, shv);
#pragma unroll
    for (int j = 0; j < 4; ++j) hh[j] = x[j] * rs * gv[j] * (scv[j] + 1.f) + shv[j]; }
__device__ __forceinline__ void row_resid(f32x4 (&x)[4], const f32x4 (&t)[4], const float* g, const float* gate, int lane) {
    const float rs = row_rstd(t); f32x4 gv[4], ga[4]; row_ld_f32(g, lane, gv); row_ld_f32(gate, lane, ga);
#pragma unroll
    for (int j = 0; j < 4; ++j) x[j] = x[j] + ga[j] * (t[j] * rs * gv[j]); }

struct NormCfg {
    const float* xin_lat; const float* xin_ctx;
    float* xout_lat; float* xout_ctx;
    const bf16* trow;
    const float* tpart; int npart;
    const float* gA; const float* modA; int gate_off;
    const float* gB; const float* modB; int sc_off, sh_off; bf16* hout;
    int nrows;
    unsigned char* hout8;
    const bf16* xin_b; bf16* xout_b;
};
__device__ __forceinline__ void row_ld_raw16(const bf16* p, int lane, u32x2 (&w)[4]) {
#pragma unroll
    for (int j = 0; j < 4; ++j) w[j] = *(const u32x2*)(p + 256 * j + 4 * lane); }
__device__ __forceinline__ void norm_rows(const NormCfg& C, int wslot, int NW, int lane) {
    const int nlat = C.nrows < LROWS ? C.nrows : LROWS;
    int r = wslot;
    if (r < nlat) {
        int cur = -1; f32x4 gav[4], scv[4], shv[4];
        f32x4 xn[4]; u32x2 tn[4], xb[4];
#pragma unroll
        for (int j = 0; j < 4; ++j) { tn[j] = (u32x2){0u, 0u}; xb[j] = (u32x2){0u, 0u}; xn[j] = gav[j] = scv[j] = shv[j] = (f32x4){0.f, 0.f, 0.f, 0.f}; }
        if (C.xin_b) row_ld_raw16(C.xin_b + (size_t)r * D, lane, xb); else row_ld_f32(C.xin_lat + (size_t)r * D, lane, xn);
        if (C.trow) {
#pragma unroll
            for (int j = 0; j < 4; ++j) tn[j] = *(const u32x2*)(C.trow + (size_t)r * D + 256 * j + 4 * lane); }
        for (; r < nlat; r += NW) {
            f32x4 x[4]; u32x2 tr[4];
#pragma unroll
            for (int j = 0; j < 4; ++j) { x[j] = C.xin_b ? (f32x4){bflo(xb[j].x), bfhi(xb[j].x), bflo(xb[j].y), bfhi(xb[j].y)} : xn[j]; tr[j] = tn[j]; }
            const int r2 = r + NW;
            if (r2 < nlat) { if (C.xin_b) row_ld_raw16(C.xin_b + (size_t)r2 * D, lane, xb); else row_ld_f32(C.xin_lat + (size_t)r2 * D, lane, xn);
                if (C.trow) {
#pragma unroll
                    for (int j = 0; j < 4; ++j) tn[j] = *(const u32x2*)(C.trow + (size_t)r2 * D + 256 * j + 4 * lane); } }
            const int ci = r < SEQ ? 0 : 1;
            if (ci != cur) { cur = ci;
                if (C.trow) row_ld_f32(C.modA + (size_t)ci * 6144 + C.gate_off, lane, gav);
                if (C.gB) { row_ld_f32(C.modB + (size_t)ci * 6144 + C.sc_off, lane, scv); row_ld_f32(C.modB + (size_t)ci * 6144 + C.sh_off, lane, shv); } }
            if (C.trow) { f32x4 t[4], gAv[4]; row_ld_f32(C.gA, lane, gAv);
#pragma unroll
                for (int j = 0; j < 4; ++j) t[j] = (f32x4){bflo(tr[j].x), bfhi(tr[j].x), bflo(tr[j].y), bfhi(tr[j].y)};
                const float rs = row_rstd(t);
#pragma unroll
                for (int j = 0; j < 4; ++j) x[j] = x[j] + gav[j] * (t[j] * rs * gAv[j]);
                if (C.xout_b) row_st_bf16(C.xout_b + (size_t)r * D, lane, x); else row_st_f32(C.xout_lat + (size_t)r * D, lane, x); }
            if (C.gB) { f32x4 gBv[4]; row_ld_f32(C.gB, lane, gBv); const float rs = row_rstd(x); f32x4 hh[4];
#pragma unroll
                for (int j = 0; j < 4; ++j) hh[j] = x[j] * rs * gBv[j] * (scv[j] + 1.f) + shv[j];
                row_st_bf16(C.hout + (size_t)r * D, lane, hh); if (C.hout8) row_st_f8(C.hout8 + (size_t)r * D, lane, hh); }
        }
    }
    for (r = LROWS + wslot; r < C.nrows; r += NW) {
        f32x4 x[4]; row_ld_f32(C.xin_ctx + (size_t)(r - LROWS) * D, lane, x);
        if (C.trow) { f32x4 t[4]; if (C.tpart) row_ld_part(C.tpart, C.npart, r, lane, t); else row_ld_bf16(C.trow + (size_t)r * D, lane, t);
            row_resid(x, t, C.gA, C.modA + (size_t)2 * 6144 + C.gate_off, lane); row_st_f32(C.xout_ctx + (size_t)(r - LROWS) * D, lane, x); }
        if (C.gB) { f32x4 hh[4]; row_modnorm(x, C.gB, C.modB + (size_t)2 * 6144 + C.sc_off, C.modB + (size_t)2 * 6144 + C.sh_off, lane, hh); row_st_bf16(C.hout + (size_t)r * D, lane, hh); if (C.hout8) row_st_f8(C.hout8 + (size_t)r * D, lane, hh); }
    }
}

__device__ __forceinline__ void transpose_item(const float* W, int ldw, int k0, int n0, bf16* dst, int ldd, float scale, LAS float* scr, int lane) {
#pragma unroll 8
    for (int i = 0; i < 32; ++i) { const int kk = 2 * i + (lane >> 5); scr[kk * 33 + (lane & 31)] = W[(size_t)(k0 + kk) * ldw + n0 + (lane & 31)]; }
    LDS_WAIT(); asm volatile("" ::: "memory");
    const int c = lane & 7;
#pragma unroll
    for (int j = 0; j < 4; ++j) { const int n = (lane >> 3) + 8 * j; const LAS float* s = scr + (8 * c) * 33 + n;
        u32x4 o; o.x = pk2(s[0 * 33] * scale, s[1 * 33] * scale); o.y = pk2(s[2 * 33] * scale, s[3 * 33] * scale); o.z = pk2(s[4 * 33] * scale, s[5 * 33] * scale); o.w = pk2(s[6 * 33] * scale, s[7 * 33] * scale);
        *(u32x4*)(dst + (size_t)n * ldd + k0 + 8 * c) = o; }
    LDS_WAIT(); asm volatile("" ::: "memory");
}
#ifndef MK_MODE
#define MK_MODE 1
#endif
#ifndef MK_LAST
#define MK_LAST 24
#endif
constexpr int NPHASE = 24;
struct Args { const float* in[31]; float* out; unsigned char* ws; int ph_lo, ph_hi, li, pad; };


struct TrJob { const float* src; unsigned char* dst; int ldw, k0, n0, ldd, esz; float scale; };
#define CAS __attribute__((address_space(4)))
constexpr float MOE_W1S = 32.f, MOE_W2S = 64.f, MOE_HS = 2.f, WIN_S = 32.f;
constexpr int NTR = 60096, NTRQ = NTR / 8;
__device__ __forceinline__ void tr_decode(int it, const CAS Args* ap_, unsigned char* ws, TrJob& J) {
#define TIN(k) ((const float*)(const GAS float*)ap_->in[k])
    int kb; J.scale = 1.f; J.esz = 2;
    if (it < 43008) { const int e = it / 5376, r = it % 5376, w = r / 1792, li = r % 1792; J.esz = 1;
        if (w < 2) { J.src = TIN(28 + w) + (size_t)e * 1024 * DFE; J.ldw = DFE; kb = li / 112; J.n0 = (li % 112) * 32; J.ldd = 1024; J.scale = MOE_W1S;
            J.dst = ws + WS_MOE1 + ((size_t)e * 7168 + 256 * (J.n0 / 128) + (J.n0 % 128) + 128 * w) * 1024; }
        else { J.src = TIN(30) + (size_t)e * DFE * 1024; J.ldw = 1024; kb = li / 32; J.n0 = (li % 32) * 32; J.ldd = DFE; J.scale = MOE_W2S; J.dst = ws + WS_MOE2 + ((size_t)e * 1024 + J.n0) * DFE; }
    } else if (it < 47232) { const int r = it - 43008, w = r / 1408, li = r % 1408;
        if (w < 2) { J.src = TIN(23 + w); J.ldw = DFF; kb = li / 88; J.n0 = (li % 88) * 32; J.ldd = 1024; J.dst = ws + WS_FFN1 + (size_t)(256 * (J.n0 / 128) + (J.n0 % 128) + 128 * w) * 1024 * 2; }
        else { J.src = TIN(25); J.ldw = 1024; kb = li / 32; J.n0 = (li % 32) * 32; J.ldd = DFF; J.dst = ws + WS_FFN2 + (size_t)J.n0 * DFF * 2; }
    } else if (it >= 56000) { const int r = it - 56000, l = r / 2048, q = r % 2048; kb = q / 128; const int nb = q % 128; J.esz = 1; J.scale = WIN_S;
        J.src = TIN(7) + (size_t)l * 1024 * 6400; J.ldw = 6400; J.n0 = 2304 + 32 * nb; J.ldd = 1024; J.dst = ws + WS_WG8 + ((size_t)l * 4096 + 32 * nb) * 1024;
    } else { const int r = it - 47232, l = r / 4384, q = r % 4384;
        if (q < 3328) { const int t = q / 128, li = q % 128; kb = li / 8; const int nb = li % 8; if (l == 1 && t >= 7 && t < 23) J.esz = 0;
            const int srcc = t < 4 ? 256 * t : (t < 7 ? 256 * (t + 1) : (t < 23 ? 2304 + 256 * (t - 7) : (t == 23 ? 768 : (t == 24 ? 1024 : 2048))));
            J.src = TIN(7) + (size_t)l * 1024 * 6400; J.ldw = 6400; J.n0 = srcc + 32 * nb; J.ldd = 1024; J.dst = ws + WS_WIN + ((size_t)(l * 26 + t) * 256 + 32 * nb) * 1024 * 2; J.scale = (t == 3 || t == 23) ? 0.125f : 1.f; }
        else if (q < 3360) { const int li = q - 3328; kb = li / 8; J.n0 = (li % 8) * 32; J.src = TIN(16) + (size_t)l * 65536; J.ldw = 256; J.ldd = 256; J.dst = ws + WS_WGLU + ((size_t)l * 256 + J.n0) * 256 * 2; }
        else if (q < 3872) { const int li = q - 3360, bb = li / 128, li2 = li % 128; kb = li2 / 32; J.n0 = (li2 % 32) * 32; J.src = TIN(21) + (size_t)(l * 4 + bb) * 256 * 1024; J.ldw = 1024; J.ldd = 1024; J.dst = ws + WS_WBR + (((size_t)l * 1024 + J.n0) * 1024 + bb * 256) * 2; }
        else { const int li = q - 3872; kb = li / 32; J.n0 = (li % 32) * 32; J.src = TIN(22) + (size_t)l * 1024 * 1024; J.ldw = 1024; J.ldd = 1024; J.dst = ws + WS_WOUT + ((size_t)l * 1024 + J.n0) * 1024 * 2; }
    }
    J.k0 = kb * 64;
#undef TIN
}
__device__ __forceinline__ void tr_load(const TrJob& J, int lane, float (&v)[32]) {
    if (J.esz == 0) return;
#pragma unroll
    for (int i = 0; i < 32; ++i) { const int kk = 2 * i + (lane >> 5); v[i] = J.src[(size_t)(J.k0 + kk) * J.ldw + J.n0 + (lane & 31)]; } }
__device__ __forceinline__ void tr_store(const TrJob& J, int lane, const float (&v)[32], LAS float* scr) {
    if (J.esz == 0) return;
#pragma unroll
    for (int i = 0; i < 32; ++i) { const int kk = 2 * i + (lane >> 5); scr[kk * 33 + (lane & 31)] = v[i]; }
    LDS_WAIT(); asm volatile("" ::: "memory");
    const int c = lane & 7;
#pragma unroll
    for (int j = 0; j < 4; ++j) { const int n = (lane >> 3) + 8 * j; const LAS float* s = scr + (8 * c) * 33 + n; const float sc = J.scale;
        if (J.esz == 2) { u32x4 o; o.x = pk2(s[0 * 33] * sc, s[1 * 33] * sc); o.y = pk2(s[2 * 33] * sc, s[3 * 33] * sc); o.z = pk2(s[4 * 33] * sc, s[5 * 33] * sc); o.w = pk2(s[6 * 33] * sc, s[7 * 33] * sc);
            *(u32x4*)(J.dst + ((size_t)n * J.ldd + J.k0 + 8 * c) * 2) = o; }
        else { u32x2 o; o.x = pk4_f8(s[0 * 33] * sc, s[1 * 33] * sc, s[2 * 33] * sc, s[3 * 33] * sc); o.y = pk4_f8(s[4 * 33] * sc, s[5 * 33] * sc, s[6 * 33] * sc, s[7 * 33] * sc);
            *(u32x2*)(J.dst + (size_t)n * J.ldd + J.k0 + 8 * c) = o; } }
    LDS_WAIT(); asm volatile("" ::: "memory");
}

__device__ __forceinline__ void cs2pi(int m, int N, float& c, float& s) { sincospif(2.0f * (float)(m % N) / (float)N, &s, &c); }

__global__ void __launch_bounds__(NTHREADS, 2) mk_fwd(Args args) {
    extern __shared__ __attribute__((aligned(16))) unsigned char lds_raw[];
    LAS unsigned char* lds = (LAS unsigned char*)lds_raw;
    const int tid0 = threadIdx.x, wave = __builtin_amdgcn_readfirstlane(tid0 >> 6);
    const int G = gridDim.x, bx = blockIdx.x, vcu = (G % 8 == 0) ? (bx % 8) * (G / 8) + bx / 8 : bx;
    const int wslot = wave * G + vcu, NW = G * NWAVES;
    volatile LAS unsigned* lctl = (volatile LAS unsigned*)(lds + LDSCTL_OFF);
    for (int u = tid0; u < (LDS_BYTES - LDSCTL_OFF) / 4; u += NTHREADS) lctl[u] = 0u;
    __syncthreads();
    const int lo = args.ph_lo, hi = args.ph_hi, bli = args.li;
#ifdef MK_STAMP_PHASE
    if (wave == 0) *(volatile LAS unsigned long long*)(lctl + 64) = __builtin_amdgcn_s_memrealtime();
#endif
    { XcdBarrier b0 = xcd_barrier_post((unsigned*)(args.ws + WS_CTL) + CW_BAR + bli * XCD_BAR_WORDS, lctl + LW_BAR); (void)b0; }
#define IN(k) (lo <= (k) && (k) < hi)
#ifndef MK_DBL
#define MK_DBL 0
#endif
#define MK_NR(k) (MK_DBL == (k) ? 2 : 1)
#ifndef MK_REP_MASK
#define MK_REP_MASK 0u
#endif
#define NREP(k) (((MK_REP_MASK >> (k)) & 1u) ? 2 : 1)
#define FORCE_BAR do { PH_BEGIN XcdBarrier b_; b_.bar = (unsigned*)(ws + WS_CTL) + CW_BAR + bli * XCD_BAR_WORDS; b_.x = xb_xcc_id(); b_.st = lctl + LW_BAR; xcd_barrier(b_); } while (0)
#ifdef MK_STAMP_PHASE
#define STAMP_AT(k) do { if (wave == 0) { if ((k) == MK_STAMP_PHASE - 1) *(volatile LAS unsigned long long*)(lctl + 64) = __builtin_amdgcn_s_memrealtime(); if ((k) == MK_STAMP_PHASE) *(volatile LAS unsigned long long*)(lctl + 66) = __builtin_amdgcn_s_memrealtime(); } } while (0)
#else
#define STAMP_AT(k) do { } while (0)
#endif
#define SEAM(k) do { if (IN(k) && IN((k) + 1)) { PH_BEGIN XcdBarrier b_; b_.bar = (unsigned*)(ws + WS_CTL) + CW_BAR + bli * XCD_BAR_WORDS; b_.x = xb_xcc_id(); b_.st = lctl + LW_BAR; xcd_barrier(b_); } STAMP_AT(k); } while (0)
#define PH_BEGIN int tid; { int l_; asm volatile("v_mbcnt_lo_u32_b32 %0, -1, 0\n\tv_mbcnt_hi_u32_b32 %0, -1, %0" : "=v"(l_)); tid = wave * 64 + (l_ & 63); } const CAS Args* ap_ = (const CAS Args*)__builtin_amdgcn_kernarg_segment_ptr(); asm volatile("" : "+s"(ap_)); unsigned char* ws = (unsigned char*)(GAS unsigned char*)ap_->ws; const int lane = tid & 63; (void)lane;
#define AIN(k) ((const float*)(const GAS float*)ap_->in[k])
#define AOUT ((float*)(GAS float*)ap_->out)
#define XB ((bf16*)(ws + WS_XB))
#define MODp ((float*)(ws + CTL_MOD_OFF))
#define ctxbuf ((float*)(ws + WS_CTXBUF))
#define Hh ((bf16*)(ws + WS_H))
#define MIX ((bf16*)(ws + WS_MIX))
#define INP ((bf16*)(ws + WS_INP))
#define Tt ((bf16*)(ws + WS_T))

    for (int rep_ = 0; rep_ < NREP(0); ++rep_) if (IN(0)) { if (rep_) { FORCE_BAR; } PH_BEGIN
        for (int dd_ = 0; dd_ < MK_NR(20); ++dd_) for (int it = bx; it < 32; it += G) {
            const int l = it >> 4, g = it & 15;
            LAS f32x2* apow = (LAS f32x2*)lds; LAS f32x2* bbar = (LAS f32x2*)(lds + 8704); LAS f32x2* Cc = (LAS f32x2*)(lds + 16896); LAS float* Kt = (LAS float*)(lds + 25088);
            for (int dir = 0; dir < 2; ++dir) { const size_t pg = (size_t)(l * 2 + dir) * 16 + g;
                if (tid < 64) { const int p = tid;
                    const float are = AIN(8)[pg * 64 + p], aim = AIN(9)[pg * 64 + p], dt = expf(AIN(10)[pg]);
                    for (int t = 0; t <= 16; ++t) { const float mag = expf(are * dt * (float)t); float sn, cs; sincosf(aim * dt * (float)t, &sn, &cs); apow[t * 64 + p] = (f32x2){mag * cs, mag * sn}; }
                    const f32x2 a = apow[64 + p]; const float nr = a.x - 1.f, ni = a.y, den = 1.f / (are * are + aim * aim);
                    const float cr = (nr * are + ni * aim) * den, ci = (ni * are - nr * aim) * den;
                    for (int h = 0; h < 16; ++h) { const float br = AIN(11)[(pg * 64 + p) * 16 + h], bi = AIN(12)[(pg * 64 + p) * 16 + h]; bbar[p * 16 + h] = (f32x2){cr * br - ci * bi, cr * bi + ci * br}; }
                    *(f32x2*)((float*)(ws + WS_A16) + (pg * 64 + p) * 2) = apow[16 * 64 + p];
                }
                for (int i = tid; i < 1024; i += NTHREADS) Cc[i] = (f32x2){AIN(13)[pg * 1024 + i], AIN(14)[pg * 1024 + i]};
                __syncthreads();
                bf16* M1 = (bf16*)(ws + WS_S5M1) + ((size_t)(l * 16 + g) * 2 + dir) * 128 * 256;
                for (int v = tid; v < 4096; v += NTHREADS) { const int row = v >> 5, col0 = (v & 31) * 8, j = col0 >> 4, h0 = col0 & 15, p = row >> 1, ri = row & 1;
                    const f32x2 pw = apow[(dir == 0 ? 15 - j : j) * 64 + p]; float vals[8];
#pragma unroll
                    for (int hh = 0; hh < 8; ++hh) { const f32x2 bb = bbar[p * 16 + h0 + hh]; vals[hh] = ri ? pw.x * bb.y + pw.y * bb.x : pw.x * bb.x - pw.y * bb.y; }
                    *(bf16x8*)(M1 + ((((col0 >> 4) * 4 + (row >> 5)) * 64 + ((col0 >> 3) & 1) * 32 + (row & 31)) * 8)) = pack8(vals); }
                bf16* TAB = (bf16*)(ws + WS_S5TAB) + (size_t)(l * 16 + g) * 256 * 512;
                for (int v = tid; v < 4096; v += NTHREADS) { const int row = v >> 4, cv = v & 15, i = row >> 4, ho = row & 15; float vals[8];
#pragma unroll
                    for (int pp = 0; pp < 4; ++pp) { const int p = cv * 4 + pp; const f32x2 cc = Cc[ho * 64 + p];
                        const f32x2 pw = apow[(dir == 0 ? i + 1 : 16 - i) * 64 + p]; vals[2 * pp] = cc.x * pw.x - cc.y * pw.y; vals[2 * pp + 1] = -(cc.x * pw.y + cc.y * pw.x); }
                    { const int colt = 256 + dir * 128 + cv * 8; *(bf16x8*)(TAB + (((((row >> 7) * 32 + (colt >> 4)) * 4 + ((row >> 5) & 3)) * 64 + ((colt >> 3) & 1) * 32 + (row & 31)) * 8)) = pack8(vals); } }
                for (int e = tid; e < 4096; e += NTHREADS) { const int t = e >> 8, ho = (e >> 4) & 15, h = e & 15; float acc = 0.f;
#pragma unroll 8
                    for (int p = 0; p < 64; ++p) { const f32x2 cc = Cc[ho * 64 + p], pw = apow[t * 64 + p], bb = bbar[p * 16 + h];
                        const float xr = cc.x * pw.x - cc.y * pw.y, xi = cc.x * pw.y + cc.y * pw.x; acc += xr * bb.x - xi * bb.y; }
                    Kt[dir * 4096 + e] = acc; }
                __syncthreads();
            }
            for (int v = tid; v < 8192; v += NTHREADS) { const int row = v >> 5, col0 = (v & 31) * 8, i = row >> 4, ho = row & 15, j = col0 >> 4, h0 = col0 & 15; float vals[8];
#pragma unroll
                for (int hh = 0; hh < 8; ++hh) { const int h = h0 + hh;
                    vals[hh] = j < i ? Kt[(i - j) * 256 + ho * 16 + h] : (j > i ? Kt[4096 + (j - i) * 256 + ho * 16 + h] : Kt[ho * 16 + h] + Kt[4096 + ho * 16 + h] + (ho == h ? AIN(15)[l * 256 + g * 16 + h] : 0.f)); }
                *(bf16x8*)((bf16*)(ws + WS_S5TAB) + (size_t)(l * 16 + g) * 256 * 512 + (((((row >> 7) * 32 + (col0 >> 4)) * 4 + ((row >> 5) & 3)) * 64 + ((col0 >> 3) & 1) * 32 + (row & 31)) * 8)) = pack8(vals); }
            __syncthreads();
        }
        __syncthreads();
        for (int it = (bx >= 32 ? bx - 32 : bx + G - 32); it < 192; it += G) { const int l = it / 96, cb = it % 96, col = cb * 64 + lane, ks = wave;
            const float* wm = AIN(4) + ((size_t)l * 1024 + ks * 128) * 6144 + col; float a0 = 0.f, a1 = 0.f, a2 = 0.f;
#pragma unroll 8
            for (int k = 0; k < 128; ++k) { const float w = wm[(size_t)k * 6144]; const int kk = ks * 128 + k;
                const float c0 = AIN(1)[kk], c1 = AIN(1)[1024 + kk], c2 = AIN(3)[kk];
                a0 += w * (c0 / (1.f + __expf(-c0))); a1 += w * (c1 / (1.f + __expf(-c1))); a2 += w * (c2 / (1.f + __expf(-c2))); }
            LAS float* part = (LAS float*)lds;
            part[(wave * 3 + 0) * 64 + lane] = a0; part[(wave * 3 + 1) * 64 + lane] = a1; part[(wave * 3 + 2) * 64 + lane] = a2;
            __syncthreads();
            if (tid < 192) { const int i = tid >> 6, c = tid & 63; float sacc = AIN(5)[l * 6144 + cb * 64 + c];
#pragma unroll
                for (int w = 0; w < 8; ++w) sacc += part[(w * 3 + i) * 64 + c];
                MODp[(size_t)(l * 3 + i) * 6144 + cb * 64 + c] = sacc; }
            __syncthreads();
        }
        { LAS float* scr = (LAS float*)(lds + wave * 16384);
          unsigned* qh = (unsigned*)(ws + WS_CTL) + CW_QHEAD;
          int q = bx & 7, tries = 0;
#define TR_POP(dst) do { dst = -1; while (tries < 8) { unsigned b_ = 0u; if (lane == 0) b_ = __hip_atomic_fetch_add(qh + 64 * q, 2u, __ATOMIC_RELAXED, __HIP_MEMORY_SCOPE_AGENT); \
              b_ = (unsigned)__builtin_amdgcn_readfirstlane((int)b_); if (b_ < (unsigned)NTRQ) { dst = q * NTRQ + (int)b_; break; } q = (q + 1) & 7; ++tries; } } while (0)
#define TR_LOAD2(VA, VB, g_) do { TrJob j_; tr_decode(g_, ap_, ws, j_); tr_load(j_, lane, VA); tr_decode((g_) + (((g_) % NTRQ) + 1 < NTRQ ? 1 : 0), ap_, ws, j_); tr_load(j_, lane, VB); } while (0)
#define TR_STORE2(VA, VB, g_) do { TrJob j_; tr_decode(g_, ap_, ws, j_); tr_store(j_, lane, VA, scr); if (((g_) % NTRQ) + 1 < NTRQ) { tr_decode((g_) + 1, ap_, ws, j_); tr_store(j_, lane, VB, scr); } } while (0)
          float a0[32], a1[32], b0[32], b1[32]; int s0, s1;
          TR_POP(s0); if (s0 >= 0) TR_LOAD2(a0, a1, s0);
          TR_POP(s1);
          while (s0 >= 0) {
              int s2, s3 = -1;
              if (s1 >= 0) TR_LOAD2(b0, b1, s1);
              TR_POP(s2);
              TR_STORE2(a0, a1, s0);
              if (s1 < 0) break;
              if (s2 >= 0) TR_LOAD2(a0, a1, s2);
              TR_POP(s3);
              TR_STORE2(b0, b1, s1);
              s0 = s2; s1 = s3;
          }
#undef TR_POP
#undef TR_LOAD2
#undef TR_STORE2
        }
        for (int v = wslot * 64 + lane; v < 32 * SEQ; v += NW * 64) { const int p = v >> 13, t = v & 8191; const float pos = (float)(p < 16 ? (t >> 6) : (t & 63));
            const float inv = 1.0f / powf(10000.f, (float)(p & 15) / 16.f); float sn, cs; sincosf(pos * inv, &sn, &cs);
            ((float*)(ws + WS_COST))[v] = cs; ((float*)(ws + WS_SINT))[v] = sn; ((float*)(ws + WS_COSN))[t * 32 + p] = cs; ((float*)(ws + WS_SINN))[t * 32 + p] = sn; }
        for (int v = wslot * 64 + lane; v < 192512; v += NW * 64) { float c, s;
            if (v < 32768) { const int ri = v >> 14, k1 = (v >> 7) & 127, l1 = v & 127; cs2pi(k1 * l1, 128, c, s); const float sc = 0.08838834764831845f;
                ((bf16*)(ws + WS_W128T))[v] = (bf16)(pk2(ri ? -s * sc : c * sc, 0.f) & 0xffffu); }
            else if (v < 40960) { const int u = v - 32768, l2 = u >> 7, k1 = u & 127; cs2pi(k1 * l2, 8192, c, s); ((float*)(ws + WS_TWC))[u] = c; ((float*)(ws + WS_TWS))[u] = s; }
            else if (v < 53248) { const int u = v - 40960, w = u >> 12, m = (u >> 6) & 63, cc = u & 63; cs2pi(m * cc, 64, c, s);
                ((bf16*)(ws + WS_FCT))[u] = (bf16)(pk2((w == 0 ? c : (w == 1 ? s : -s)) * 0.125f, 0.f) & 0xffffu); }
            else if (v < 61440) { const int u = v - 53248, w = u >> 12, k2 = (u >> 6) & 63, l2 = u & 63; cs2pi(k2 * l2, 64, c, s); ((bf16*)(ws + WS_W64T))[u] = (bf16)(pk2((w == 0 ? c : s) * 0.125f, 0.f) & 0xffffu); }
            else { const int u = v - 61440, w = u >> 16, k = (u >> 8) & 255, l = u & 255; cs2pi(k * l, 256, c, s); ((bf16*)(ws + WS_W256T))[u] = (bf16)(pk2((w == 0 ? c : s) * 0.0625f, 0.f) & 0xffffu); }
        }
    }
    SEAM(0);

    for (int rep_ = 0; rep_ < NREP(1); ++rep_) if (IN(1)) { if (rep_) { FORCE_BAR; } PH_BEGIN
        { NormCfg C{AIN(0), AIN(2), nullptr, nullptr, nullptr, nullptr, 0, nullptr, nullptr, 0, AIN(6), MODp, 1024, 0, Hh, R, ws + WS_H8, nullptr, nullptr}; norm_rows(C, wslot, NW, lane); }
    }
    SEAM(1);

    for (int layer = 0; layer < 2; ++layer) {
        const int pb = 1 + 11 * layer;
        const int nM = layer == 0 ? 66 : 64;
        const int nrows = layer == 0 ? R : LROWS;
#define normg (AIN(6) + (size_t)layer * 4 * D)
        for (int rep_ = 0; rep_ < NREP(pb + 1); ++rep_) if (IN(pb + 1)) { if (rep_) { FORCE_BAR; } PH_BEGIN
            gp::SchedInprojA S{(const char*)Hh, (const char*)(ws + WS_WIN) + (size_t)layer * 26 * 256 * 2048, 66, G, bx, layer == 0 ? 32 : 0};
            gp::EpiInprojA E{INP, Tt, (unsigned char*)(ws + WS_GCTX)};
            gp::gemm_phase(lds, tid, 1024, 1024, 1024, S, E);
        }
        SEAM(pb + 1);
        for (int rep_ = 0; rep_ < NREP(pb + 2); ++rep_) if (IN(pb + 2)) { if (rep_) { FORCE_BAR; } PH_BEGIN
            LAS float* rpb = (LAS float*)(lds + 98304 + 4096);
            LAS unsigned char* wl = lds + wave * 12288;
            for (int i = tid; i < 1860; i += NTHREADS) rpb[i] = AIN(20)[layer * 1860 + i] * LOG2E;
            __syncthreads();
            const int nitA = 2224 + 64 + (layer == 0 ? 64 : 0);
            for (int it = wslot; it < nitA; it += NW) {
                if (it < 1056) s5_state_item((const bf16*)(ws + WS_S5M1) + (size_t)layer * 16 * 2 * 128 * 256, INP + (size_t)R * 256, (float*)(ws + WS_HLOC), it, lane);
                else if (it < 1584) ret_kv_item(Tt, Tt + (size_t)256 * R, (const float*)(ws + WS_COST), (const float*)(ws + WS_SINT), AIN(18) + layer * 8, (float*)(ws + WS_KV), it - 1056, lane);
                else if (it < 2096) fft1_item(INP, (const bf16*)(ws + WS_W128T), (const float*)(ws + WS_TWC), (const float*)(ws + WS_TWS), (bf16*)(ws + WS_FB), it - 1584, lane);
                else if (it < 2224) rope_item(INP + (size_t)2 * R * 256, INP + (size_t)3 * R * 256, (const float*)(ws + WS_COSN), (const float*)(ws + WS_SINN), it - 2096, lane);
                else if (it < 2288) { const int j = 1984 + (it - 2224); na_item(INP + (size_t)5 * R * 256, INP + (size_t)6 * R * 256, Tt + (size_t)512 * R, MIX, rpb, wl, false, j >> 10, (j >> 3) & 127, (j >> 1) & 3, j & 1, lane); }
                else { const int j = it - 2288; na_item(INP + (size_t)5 * R * 256, INP + (size_t)6 * R * 256, Tt + (size_t)512 * R, MIX, rpb, wl, true, j >> 5, 0, (j >> 3) & 3, j & 7, lane); }
            }
            __syncthreads();
        }
        SEAM(pb + 2);
        for (int rep_ = 0; rep_ < NREP(pb + 3); ++rep_) if (IN(pb + 3)) { if (rep_) { FORCE_BAR; } PH_BEGIN
            LAS float* rpb = (LAS float*)(lds + 98304 + 4096); LAS unsigned char* wl = lds + wave * 12288;
            for (int i = tid; i < 1860; i += NTHREADS) rpb[i] = AIN(20)[layer * 1860 + i] * LOG2E;
            __syncthreads();
            for (int vs = wslot; vs < 2048; vs += NW) {
                if (vs < 64) s5_scan_item((const float*)(ws + WS_A16) + (size_t)layer * 2 * 16 * 64 * 2, (const float*)(ws + WS_HLOC), (bf16*)(ws + WS_HIN), wl, vs, lane);
                else { const int j = vs - 64; na_item(INP + (size_t)5 * R * 256, INP + (size_t)6 * R * 256, Tt + (size_t)512 * R, MIX, rpb, wl, false, j >> 10, (j >> 3) & 127, (j >> 1) & 3, j & 1, lane);
                    if (vs >= 1024) ret_scan_item(AIN(18) + layer * 8, (const float*)(ws + WS_KV), (bf16*)(ws + WS_SPREV), vs - 1024, lane); }
            }
            __syncthreads();
        }
        SEAM(pb + 3);
        for (int rep_ = 0; rep_ < NREP(pb + 4); ++rep_) if (IN(pb + 4)) { if (rep_) { FORCE_BAR; } PH_BEGIN
            const int nit = 1056 + 2112 + 2048 + (layer == 0 ? 128 : 0);
            for (int it = wslot; it < nit; it += NW) {
                if (it < 1056) s5_out_item((const bf16*)(ws + WS_S5TAB) + (size_t)layer * 16 * 256 * 512, INP + (size_t)R * 256, (const bf16*)(ws + WS_HIN), (bf16*)(ws + WS_Z), it, lane);
                else if (it < 3168) ret_out_item(INP + (size_t)2 * R * 256, INP + (size_t)3 * R * 256, INP + (size_t)4 * R * 256, Tt + (size_t)256 * R, (const bf16*)(ws + WS_SPREV),
                                                 AIN(18) + layer * 8, AIN(19) + layer * 256, MIX, lds + wave * 12288, it - 1056, lane);
                else if (it < 5216) fft2_item((const bf16*)(ws + WS_FB), (const bf16*)(ws + WS_FCT), (const bf16*)(ws + WS_W64T), MIX, it - 3168, lane);
                else fftc_item(INP, (const bf16*)(ws + WS_FCT), (const bf16*)(ws + WS_W256T), MIX, it - 5216, lane);
            }
        }
        SEAM(pb + 4);
        for (int rep_ = 0; rep_ < NREP(pb + 5); ++rep_) if (IN(pb + 5)) { if (rep_) { FORCE_BAR; } PH_BEGIN
            { PH_BEGIN gp::SchedPlain S{(const char*)(ws + WS_Z), (const char*)(ws + WS_WGLU) + (size_t)layer * 256 * 512, (size_t)256 * 512, (size_t)256 * 512, nM, 1, G, bx, 4};
              gp::EpiGlu E{(const bf16*)(ws + WS_Z), MIX, AIN(17) + layer * 256};
              gp::gemm_phase(lds, tid, 256, 256, 256, S, E); }
            { PH_BEGIN gp::SchedPlain S{(const char*)(ws + WS_H8), (const char*)(ws + WS_WG8) + (size_t)layer * 4096 * 1024, (size_t)256 * 1024, (size_t)256 * 1024, 64, 16, G, bx, 8};
              gp::EpiGates E{(unsigned char*)(ws + WS_GATES), 1.f / WIN_S};
              gp::gemm_phase<gp::EpiGates, gp::SchedPlain, true>(lds, tid, 1024, 512, 512, S, E); }
        }
        SEAM(pb + 5);
        for (int rep_ = 0; rep_ < NREP(pb + 6); ++rep_) if (IN(pb + 6)) { if (rep_) { FORCE_BAR; } PH_BEGIN
            gp::SchedMerge S{(const char*)MIX, (const char*)(ws + WS_WBR) + (size_t)layer * 1024 * 2048, layer == 0 ? 32 : 0, G, bx};
            gp::EpiMerge E{(const unsigned char*)(ws + WS_GATES), (const unsigned char*)(ws + WS_GCTX), (bf16*)(ws + WS_Y), (bf16*)(ws + WS_YP)};
            gp::gemm_phase(lds, tid, 1024, 1024, 1024, S, E);
        }
        SEAM(pb + 6);
        for (int rep_ = 0; rep_ < NREP(pb + 7); ++rep_) if (IN(pb + 7)) { if (rep_) { FORCE_BAR; } PH_BEGIN
            gp::SchedSplit S{(const char*)(ws + WS_Y), (const char*)(ws + WS_WOUT) + (size_t)layer * 1024 * 2048, (size_t)256 * 2048, (size_t)256 * 2048, layer == 0 ? 16 : 0, 16, G, bx,
                             (const char*)(ws + WS_YP), (size_t)256 * 2048, (size_t)CROWS * 2048, 4};
            gp::EpiPlainSplit E{(bf16*)(ws + WS_YO), 1024, (float*)(ws + WS_PARTW), 16};
            gp::gemm_phase(lds, tid, 1024, 1024, 1024, S, E);
        }
        SEAM(pb + 7);
        for (int rep_ = 0; rep_ < NREP(pb + 8); ++rep_) if (IN(pb + 8)) { if (rep_) { FORCE_BAR; } PH_BEGIN
            if (layer == 0) {
                NormCfg C{AIN(0), AIN(2), nullptr, ctxbuf, (const bf16*)(ws + WS_YO), (const float*)(ws + WS_PARTW), 16, normg + D, MODp, 2048, normg + 2 * D, MODp, 4096, 3072, Hh, R, nullptr, nullptr, XB};
                norm_rows(C, wslot, NW, lane);
            } else {
                LAS float* wrs = (LAS float*)lds; LAS int* rowinfo = (LAS int*)(lds + 32768); LAS unsigned* cntL = (LAS unsigned*)(lds + 32768 + 1024); LAS unsigned* baseL = cntL + 8;
                for (int i = tid; i < 2048; i += NTHREADS) ((LAS f32x4*)wrs)[i] = ((const f32x4*)AIN(26))[i];
                int* list = (int*)(ws + WS_LIST); float* routew = (float*)(ws + WS_ROUTEW);
                for (int grp = vcu; grp < 256; grp += G) {
                    if (tid < 8) cntL[tid] = 0u;
                    __syncthreads();
                    const int r0 = grp * 64 + wave * 8; const float* md = MODp + (size_t)(3 + (r0 < SEQ ? 0 : 1)) * 6144;
                    f32x4 gav[4], scv[4], shv[4]; row_ld_f32(md + 2048, lane, gav); row_ld_f32(md + 4096, lane, scv); row_ld_f32(md + 3072, lane, shv);
                    u32x2 xn[4]; u32x2 tn[4]; row_ld_raw16(XB + (size_t)r0 * D, lane, xn);
#pragma unroll
                    for (int j = 0; j < 4; ++j) tn[j] = *(const u32x2*)((const bf16*)(ws + WS_YO) + (size_t)r0 * D + 256 * j + 4 * lane);
                    for (int rr = 0; rr < 8; ++rr) { const int r = r0 + rr;
                        f32x4 x[4], t[4], hh[4];
#pragma unroll
                        for (int j = 0; j < 4; ++j) { x[j] = (f32x4){bflo(xn[j].x), bfhi(xn[j].x), bflo(xn[j].y), bfhi(xn[j].y)}; t[j] = (f32x4){bflo(tn[j].x), bfhi(tn[j].x), bflo(tn[j].y), bfhi(tn[j].y)}; }
                        if (rr < 7) { row_ld_raw16(XB + (size_t)(r + 1) * D, lane, xn);
#pragma unroll
                            for (int j = 0; j < 4; ++j) tn[j] = *(const u32x2*)((const bf16*)(ws + WS_YO) + (size_t)(r + 1) * D + 256 * j + 4 * lane); }
                        { f32x4 gAv[4]; row_ld_f32(normg + D, lane, gAv); const float rs = row_rstd(t);
#pragma unroll
                          for (int j = 0; j < 4; ++j) x[j] = x[j] + gav[j] * (t[j] * rs * gAv[j]); }
                        row_st_bf16(XB + (size_t)r * D, lane, x);
                        { f32x4 gBv[4]; row_ld_f32(normg + 2 * D, lane, gBv); const float rs = row_rstd(x);
#pragma unroll
                          for (int j = 0; j < 4; ++j) hh[j] = x[j] * rs * gBv[j] * (scv[j] + 1.f) + shv[j]; }
#pragma unroll
                        for (int j = 0; j < 4; ++j) *(unsigned*)(ws + WS_H + (size_t)r * D + 256 * j + 4 * lane) = pk4_f8(hh[j][0], hh[j][1], hh[j][2], hh[j][3]);
                        float lg[8];
#pragma unroll
                        for (int e = 0; e < 8; ++e) lg[e] = 0.f;
#pragma unroll
                        for (int j = 0; j < 4; ++j)
#pragma unroll
                            for (int q = 0; q < 4; ++q) { const int k = 256 * j + 4 * lane + q; const f32x4 w0 = *(const LAS f32x4*)(wrs + k * 8), w1 = *(const LAS f32x4*)(wrs + k * 8 + 4); const float hv = hh[j][q];
                                lg[0] += hv * w0[0]; lg[1] += hv * w0[1]; lg[2] += hv * w0[2]; lg[3] += hv * w0[3]; lg[4] += hv * w1[0]; lg[5] += hv * w1[1]; lg[6] += hv * w1[2]; lg[7] += hv * w1[3]; }
#pragma unroll
                        for (int e = 0; e < 8; ++e) lg[e] = wave_sum(lg[e]) + AIN(27)[e];
                        int i0 = 0; float v0 = lg[0];
#pragma unroll
                        for (int e = 1; e < 8; ++e) if (lg[e] > v0) { v0 = lg[e]; i0 = e; }
                        int i1 = i0 == 0 ? 1 : 0; float v1 = i0 == 0 ? lg[1] : lg[0];
#pragma unroll
                        for (int e = 0; e < 8; ++e) if (e != i0 && lg[e] > v1) { v1 = lg[e]; i1 = e; }
                        const float w0 = 1.f / (1.f + __expf(v1 - v0)), w1 = 1.f - w0;
                        if (lane == 0) { const unsigned s0 = __hip_atomic_fetch_add(cntL + i0, 1u, __ATOMIC_RELAXED, __HIP_MEMORY_SCOPE_WORKGROUP), s1 = __hip_atomic_fetch_add(cntL + i1, 1u, __ATOMIC_RELAXED, __HIP_MEMORY_SCOPE_WORKGROUP);
                            LAS int* ri = rowinfo + (wave * 8 + rr) * 4; ri[0] = i0; ri[1] = (int)s0; ri[2] = i1; ri[3] = (int)s1; routew[(size_t)r * 2] = w0; routew[(size_t)r * 2 + 1] = w1; }
                        if (lane < 8) ((int*)(ws + WS_SMAP))[(size_t)r * 8 + lane] = -1;
                    }
                    __syncthreads();
                    if (tid < 8) baseL[tid] = __hip_atomic_fetch_add((unsigned*)(ws + WS_CTL) + CW_MOECNT + 64 * tid, cntL[tid], __ATOMIC_RELAXED, __HIP_MEMORY_SCOPE_AGENT);
                    __syncthreads();
                    if (tid < 64) { const LAS int* ri = rowinfo + tid * 4; const int r = grp * 64 + tid;
                        list[ri[0] * LCAP + (int)baseL[ri[0]] + ri[1]] = r * 2; list[ri[2] * LCAP + (int)baseL[ri[2]] + ri[3]] = r * 2 + 1; }
                    __syncthreads();
                }
            }
        }
        SEAM(pb + 8);
        LAS unsigned* mt = (LAS unsigned*)(lds + LDSCTL_OFF) + LW_MOE;
        if (layer == 1 && (IN(pb + 9) || IN(pb + 10))) { PH_BEGIN
            if (tid == 0) { unsigned off = 0u;
                for (int e = 0; e < 8; ++e) { const unsigned c = __hip_atomic_load((unsigned*)(ws + WS_CTL) + CW_MOECNT + 64 * e, __ATOMIC_RELAXED, __HIP_MEMORY_SCOPE_AGENT); const unsigned m = (c + 255u) >> 8; mt[e] = c; mt[8 + e] = m; mt[16 + e] = off; off += m; }
                mt[24] = off; const unsigned U = off * 4u, full = (U / (unsigned)G) * (unsigned)G, rem = U - full;
                if (rem != 0u && rem <= 32u && full != 0u) { mt[25] = full; mt[26] = rem; } else { mt[25] = U; mt[26] = 0u; } }
            __syncthreads();
        }
        for (int rep_ = 0; rep_ < NREP(pb + 9); ++rep_) if (IN(pb + 9)) { if (rep_) { FORCE_BAR; } PH_BEGIN
            if (layer == 0) {
                gp::SchedPlain S{(const char*)Hh, (const char*)(ws + WS_FFN1), (size_t)256 * 2048, (size_t)256 * 2048, 66, 22, G, bx, 16};
                gp::EpiSwiglu E{(bf16*)(ws + WS_HID), DFF, false};
                gp::gemm_phase(lds, tid, 1024, 1024, 1024, S, E);
            } else {
                gp::SchedMoe1 S{(const char*)(ws + WS_H), (const char*)(ws + WS_MOE1), (const int*)(ws + WS_LIST), mt, G, bx, 1024u};
                gp::EpiSwigluF8 E{ws + WS_MHID, DFE, true, 1.f / MOE_W1S, MOE_HS};
                gp::gemm_phase<gp::EpiSwigluF8, gp::SchedMoe1, true>(lds, tid, 1024, 512, 512, S, E);
            }
        }
        SEAM(pb + 9);
        for (int rep_ = 0; rep_ < NREP(pb + 10); ++rep_) if (IN(pb + 10)) { if (rep_) { FORCE_BAR; } PH_BEGIN
            if (layer == 0) {
                gp::SchedSplit S{(const char*)(ws + WS_HID), (const char*)(ws + WS_FFN2), (size_t)256 * DFF * 2, (size_t)256 * DFF * 2, 11, DFF / 64, G, bx,
                                 (const char*)(ws + WS_HID) + (size_t)64 * 256 * DFF * 2, (size_t)256 * DFF * 2, 0, 11};
                gp::EpiPlainSplit E{(bf16*)(ws + WS_FO), 1024, (float*)(ws + WS_PARTF), 11};
                gp::gemm_phase(lds, tid, DFF, DFF, DFF, S, E);
            } else {
                { gp::SchedMoe2 S{(const char*)(ws + WS_MHID), (const char*)(ws + WS_MOE2), mt, G, bx, (unsigned)DFE};
                  gp::EpiMoeDown E{(bf16*)(ws + WS_SLOT), (const int*)(ws + WS_LIST), (const float*)(ws + WS_ROUTEW), mt, 1.f / (MOE_HS * MOE_W2S)};
                  gp::gemm_phase<gp::EpiMoeDown, gp::SchedMoe2, true>(lds, tid, DFE, DFE / 2, DFE / 2, S, E); }
                { PH_BEGIN gp::SchedMoe2S S{(const char*)(ws + WS_MHID), (const char*)(ws + WS_MOE2), mt, G, bx, (unsigned)DFE};
                  gp::EpiMoePart E{(bf16*)(ws + WS_PARTM), (const int*)(ws + WS_LIST), mt, (int*)(ws + WS_SMAP), 1.f / (MOE_HS * MOE_W2S)};
                  gp::gemm_phase<gp::EpiMoePart, gp::SchedMoe2S, true>(lds, tid, DFE, DFE / 2, DFE / 2, S, E); }
            }
        }
        SEAM(pb + 10);
        for (int rep_ = 0; rep_ < NREP(pb + 11); ++rep_) if (IN(pb + 11)) { if (rep_) { FORCE_BAR; } PH_BEGIN
            if (layer == 0) { PH_BEGIN NormCfg C{nullptr, ctxbuf, nullptr, ctxbuf, (const bf16*)(ws + WS_FO), (const float*)(ws + WS_PARTF), 11, normg + 3 * D, MODp, 5120, AIN(6) + 4 * D, MODp + 3 * 6144, 1024, 0, Hh, R, ws + WS_H8, XB, XB};
                norm_rows(C, wslot, NW, lane); }
            else { PH_BEGIN for (int r = wslot; r < nrows; r += NW) { const int ci = r < SEQ ? 0 : (r < LROWS ? 1 : 2); const float* md = MODp + (size_t)(layer * 3 + ci) * 6144;
                float* xp = r < LROWS ? AOUT + (size_t)r * D : ctxbuf + (size_t)(r - LROWS) * D;
                f32x4 x[4], t[4]; if (r < LROWS) row_ld_bf16(XB + (size_t)r * D, lane, x); else row_ld_f32(xp, lane, x);
                if (layer == 0) { if (r < LROWS) row_ld_bf16((const bf16*)(ws + WS_FO) + (size_t)r * D, lane, t); else row_ld_part((const float*)(ws + WS_PARTF), 11, r, lane, t); }
                else { typedef int i32x4 __attribute__((ext_vector_type(4)));
                    const i32x4 m0 = *(const i32x4*)((const int*)(ws + WS_SMAP) + (size_t)r * 8), m1 = *(const i32x4*)((const int*)(ws + WS_SMAP) + (size_t)r * 8 + 4);
                    if ((m0.x & m0.y & m0.z & m0.w & m1.x & m1.y & m1.z & m1.w) == -1) {
                        f32x4 t2[4]; row_ld_bf16((const bf16*)(ws + WS_SLOT) + (size_t)r * D, lane, t); row_ld_bf16((const bf16*)(ws + WS_SLOT) + ((size_t)LROWS + r) * D, lane, t2);
#pragma unroll
                        for (int j = 0; j < 4; ++j) t[j] = t[j] + t2[j];
                    } else {
#pragma unroll
                        for (int j = 0; j < 4; ++j) t[j] = (f32x4){0.f, 0.f, 0.f, 0.f};
#pragma unroll
                        for (int k = 0; k < 2; ++k) { const int ent = 2 * r + k; const i32x4 mk = k ? m1 : m0;
#pragma unroll
                            for (int j = 0; j < 4; ++j) { const int mm = j == 0 ? mk.x : (j == 1 ? mk.y : (j == 2 ? mk.z : mk.w));
                                if (mm < 0) { const u32x2 w = *(const u32x2*)((const bf16*)(ws + WS_SLOT) + ((size_t)k * LROWS + r) * D + 256 * j + 4 * lane); t[j] = t[j] + (f32x4){bflo(w.x), bfhi(w.x), bflo(w.y), bfhi(w.y)}; }
                                else { const bf16* pp = (const bf16*)(ws + WS_PARTM) + ((size_t)(mm >> 8) * 7 * 256 + (mm & 255)) * 256 + 4 * lane; f32x4 sacc = (f32x4){0.f, 0.f, 0.f, 0.f};
                                    for (int sl = 0; sl < 7; ++sl) { const u32x2 w = *(const u32x2*)(pp + (size_t)sl * 65536); sacc = sacc + (f32x4){bflo(w.x), bfhi(w.x), bflo(w.y), bfhi(w.y)}; }
                                    t[j] = t[j] + sacc * ((const float*)(ws + WS_ROUTEW))[ent]; } } } } }
                row_resid(x, t, normg + 3 * D, md + 5120, lane); row_st_f32(xp, lane, x);
                } }
        }
        SEAM(pb + 11);
    }
#ifdef MK_STAMP_PHASE
    if (MK_STAMP_PHASE == NPHASE - 1 && wave == 0) *(volatile LAS unsigned long long*)(lctl + 66) = __builtin_amdgcn_s_memrealtime();
    if (blockIdx.x == 0 && wave == 0) { const unsigned long long st0_ = *(volatile LAS unsigned long long*)(lctl + 64), st1_ = *(volatile LAS unsigned long long*)(lctl + 66); const unsigned long long target = __builtin_amdgcn_s_memrealtime() + (unsigned long long)MK_STAMP_AMP * (st1_ - st0_); while (__builtin_amdgcn_s_memrealtime() < target) __builtin_amdgcn_s_sleep(20); }
#endif
#ifdef MK_EXTRA_BARS
    for (int xb_ = 0; xb_ < MK_EXTRA_BARS; ++xb_) { FORCE_BAR; }
#endif
#undef IN
#undef SEAM
#undef PH_BEGIN
#undef normg
#undef AIN
#undef AOUT
#undef XB
#undef MODp
#undef ctxbuf
#undef Hh
#undef MIX
#undef INP
#undef Tt
}

__global__ void dumpk(const unsigned char* src, size_t nbytes, int isf32, float* out, size_t N, int accum) {
    const size_t i = (size_t)blockIdx.x * blockDim.x + threadIdx.x; if (i >= N) return;
    const size_t ne = isf32 ? nbytes / 4 : nbytes / 2; float s = 0.f;
    for (size_t k = i; k < ne; k += N) s += isf32 ? ((const float*)src)[k] : bf2f(((const bf16*)src)[k]);
    out[i] = accum ? out[i] + s : s;
}
extern "C" void kernel_launch(void* const* d_in, const int* in_sizes, int n_in, void* d_out, int out_size, void* d_ws, size_t ws_size, hipStream_t stream) {
    static int grid = 0;
    if (grid == 0) {
        if (n_in != 31 || out_size != LROWS * D || ws_size < WS_END) { fprintf(stderr, "kernel_launch: unexpected shapes (n_in %d, out %d, ws %zu < %zu)\n", n_in, out_size, ws_size, (size_t)WS_END); grid = -1; return; }
        int dev = 0, cus = 0, per_cu = 0;
        if (hipGetDevice(&dev) != hipSuccess || hipDeviceGetAttribute(&cus, hipDeviceAttributeMultiprocessorCount, dev) != hipSuccess) { grid = -1; return; }
        if (hipFuncSetAttribute((const void*)mk_fwd, hipFuncAttributeMaxDynamicSharedMemorySize, LDS_BYTES) != hipSuccess) { fprintf(stderr, "kernel_launch: hipFuncSetAttribute failed\n"); grid = -1; return; }
        if (hipOccupancyMaxActiveBlocksPerMultiprocessor(&per_cu, (const void*)mk_fwd, NTHREADS, LDS_BYTES) != hipSuccess || per_cu < 1) { fprintf(stderr, "kernel_launch: occupancy query says %d\n", per_cu); }
        (void)hipGetLastError();
        grid = cus;
    }
    if (grid < 0) return;
    (void)hipMemsetAsync((char*)d_ws + WS_CTL, 0, CTL_ZERO_BYTES, stream);
    Args a{};
    for (int i = 0; i < 31; ++i) a.in[i] = (const float*)d_in[i];
    a.out = (float*)d_out; a.ws = (unsigned char*)d_ws;
#if MK_MODE == 1
    a.ph_lo = 0; a.ph_hi = NPHASE; a.li = 0;
    hipLaunchKernelGGL(mk_fwd, dim3(grid), dim3(NTHREADS), LDS_BYTES, stream, a);
#else
    for (int p = 0; p < MK_LAST; ++p) { a.ph_lo = p; a.ph_hi = p + 1; a.li = p; hipLaunchKernelGGL(mk_fwd, dim3(grid), dim3(NTHREADS), LDS_BYTES, stream, a); }
#endif
#ifdef MK_DUMP_OFF
    dumpk<<<(LROWS * D + 255) / 256, 256, 0, stream>>>((const unsigned char*)d_ws + (size_t)(MK_DUMP_OFF), (size_t)(MK_DUMP_BYTES), MK_DUMP_F32, (float*)d_out, (size_t)LROWS * D, 0);
#endif
#ifdef MK_DUMP2_OFF
    dumpk<<<(LROWS * D + 255) / 256, 256, 0, stream>>>((const unsigned char*)d_ws + (size_t)(MK_DUMP2_OFF), (size_t)(MK_DUMP2_BYTES), MK_DUMP2_F32, (float*)d_out, (size_t)LROWS * D, 1);
#endif
#ifdef MK_DUMP3_OFF
    dumpk<<<(LROWS * D + 255) / 256, 256, 0, stream>>>((const unsigned char*)d_ws + (size_t)(MK_DUMP3_OFF), (size_t)(MK_DUMP3_BYTES), MK_DUMP3_F32, (float*)d_out, (size_t)LROWS * D, 1);
#endif
}
```

```cpp
#define MK_MODE 1
#include <hip/hip_runtime.h>
#include <cstdio>
#include <cstdint>

#define GAS __attribute__((address_space(1)))
#define LAS __attribute__((address_space(3)))
typedef unsigned short bf16;
typedef short bf16x8 __attribute__((ext_vector_type(8)));
typedef short bf16x4 __attribute__((ext_vector_type(4)));
typedef float f32x2 __attribute__((ext_vector_type(2)));
typedef float f32x4 __attribute__((ext_vector_type(4)));
typedef float f32x16 __attribute__((ext_vector_type(16)));
typedef unsigned u32x2 __attribute__((ext_vector_type(2)));
typedef unsigned u32x4 __attribute__((ext_vector_type(4)));

constexpr int D = 1024, SEQ = 8192, LROWS = 16384, CTXL = 256, CROWS = 512, R = 16896;
constexpr int DFF = 2816, DFE = 3584, NEXP = 8, LCAP = 16640;
constexpr int NWAVES = 8, NTHREADS = 512;
constexpr int NCH16 = R / 16;
constexpr float EPSN = 1e-6f, LOG2E = 1.4426950408889634f;

constexpr size_t MiB = 1u << 20;
constexpr size_t WS_CTL = 0, CTL_ZERO_BYTES = 1 * MiB;
constexpr int CW_TMO = 0, CW_BAR = 4096, CW_MOECNT = 98304, CW_QHEAD = 100352, CW_MQ = 102400;
constexpr size_t CTL_MOD_OFF = 512 * 1024;
constexpr size_t WS_CTXBUF = 1 * MiB;
constexpr size_t WS_COST = 3 * MiB, WS_SINT = 4 * MiB, WS_COSN = 5 * MiB, WS_SINN = 6 * MiB;
constexpr size_t WS_LIST = 7 * MiB;
constexpr size_t WS_ROUTEW = WS_LIST + 8 * LCAP * 4;
constexpr size_t WS_S5K = 8 * MiB;
constexpr size_t WS_A16 = 9 * MiB;
constexpr size_t WS_W128T = WS_A16 + 64 * 1024;
constexpr size_t WS_TWC = WS_W128T + 64 * 1024, WS_TWS = WS_TWC + 32 * 1024;
constexpr size_t WS_FCT = WS_TWS + 32 * 1024;
constexpr size_t WS_W64T = WS_FCT + 32 * 1024;
constexpr size_t WS_W256T = WS_W64T + 32 * 1024;
constexpr size_t WS_MOE1 = 10 * MiB;
constexpr size_t WS_WG8 = 66 * MiB;
constexpr size_t WS_XB = 74 * MiB;
constexpr size_t WS_H8 = 150 * MiB;
constexpr size_t WS_MOE2 = 122 * MiB;
constexpr size_t WS_OTHERW = 178 * MiB;
constexpr size_t WS_WIN = 178 * MiB;
constexpr size_t WS_WBR = 204 * MiB;
constexpr size_t WS_WOUT = 208 * MiB;
constexpr size_t WS_WGLU = 212 * MiB;
constexpr size_t WS_FFN1 = 213 * MiB;
constexpr size_t WS_FFN2 = 224 * MiB;
constexpr size_t WS_S5M1 = 230 * MiB;
constexpr size_t WS_S5TAB = 234 * MiB;
constexpr size_t WS_BIG = 242 * MiB;
constexpr size_t TOK256 = (size_t)R * 256 * 2;
constexpr size_t WS_INP = WS_BIG;
constexpr size_t WS_T = WS_INP + 7 * TOK256;
constexpr size_t WS_HLOC = WS_T + 3 * TOK256;
constexpr size_t WS_HIN = WS_HLOC + 2 * TOK256;
constexpr size_t WS_KV = WS_HIN + TOK256;
constexpr size_t WS_SPREV = WS_KV + 2 * TOK256;
constexpr size_t WS_FB = WS_SPREV + TOK256;
constexpr size_t WS_GATES = WS_BIG;
constexpr size_t WS_Y = WS_BIG + 132 * MiB;
constexpr size_t WS_YO = WS_Y + 33 * MiB;
constexpr size_t WS_Z = WS_YO + 33 * MiB;
constexpr size_t WS_YP = WS_Z;
constexpr size_t WS_PARTW = WS_BIG;
constexpr size_t WS_PARTF = 340 * MiB;
constexpr size_t WS_PARTM = 416 * MiB;
constexpr size_t WS_SMAP = WS_S5K;
constexpr size_t WS_FO = WS_Y;
constexpr size_t WS_HID = WS_BIG;
constexpr size_t WS_MHID = WS_OTHERW;
constexpr size_t WS_H = 449 * MiB;
constexpr size_t WS_MIX = 482 * MiB;
constexpr size_t WS_SLOT = WS_H;
constexpr size_t WS_GCTX = 515 * MiB;
constexpr size_t WS_END = 519 * MiB;
static_assert(WS_FB + 16 * MiB <= WS_Z && WS_Z + TOK256 <= WS_H && WS_MHID + (size_t)34816 * 3584 * 2 <= WS_H && WS_W256T + 256 * 1024 <= WS_MOE1, "ws map");
static_assert(WS_PARTM + (size_t)32 * 7 * 65536 * 2 <= WS_H && WS_MHID + (size_t)34816 * 3584 * 2 <= WS_PARTM, "ws map 3");
static_assert(WS_S5TAB + 8 * MiB <= WS_BIG && WS_FFN2 + (size_t)1024 * 2816 * 2 <= WS_S5M1 && WS_ROUTEW + 32768 * 4 <= WS_S5K, "ws map 2");

constexpr int RING_BYTES = 131072, LDSCTL_OFF = RING_BYTES, LDS_BYTES = 147456;
constexpr int LW_BAR = 8, LW_MOE = 16;

#define VM_WAIT() asm volatile("s_waitcnt vmcnt(0)" ::: "memory")
#define LDS_WAIT() asm volatile("s_waitcnt lgkmcnt(0)" ::: "memory")
typedef __bf16 bf16n2 __attribute__((ext_vector_type(2)));
__device__ __forceinline__ unsigned pk2(float lo, float hi) { bf16n2 v; v.x = (__bf16)lo; v.y = (__bf16)hi; return __builtin_bit_cast(unsigned, v); }
__device__ __forceinline__ unsigned pk4_f8(float a, float b, float c, float d) { int w = 0; w = __builtin_amdgcn_cvt_pk_fp8_f32(a, b, w, false); w = __builtin_amdgcn_cvt_pk_fp8_f32(c, d, w, true); return (unsigned)w; }
__device__ __forceinline__ float bf2f(unsigned short b) { return __builtin_bit_cast(float, ((unsigned)b) << 16); }
__device__ __forceinline__ float bflo(unsigned w) { return __builtin_bit_cast(float, w << 16); }
__device__ __forceinline__ float bfhi(unsigned w) { return __builtin_bit_cast(float, w & 0xffff0000u); }
__device__ __forceinline__ float ex2(float x) { return __builtin_amdgcn_exp2f(x); }
__device__ __forceinline__ float rcpf_(float x) { return __builtin_amdgcn_rcpf(x); }
__device__ __forceinline__ float sigm(float x) { return rcpf_(1.f + ex2(-LOG2E * x)); }
__device__ __forceinline__ float silu_(float x) { return x * sigm(x); }
__device__ __forceinline__ float gelu_tanh(float x) { const float u = 0.7978845608028654f * (x + 0.044715f * x * x * x); const float t = 1.f - 2.f * rcpf_(1.f + ex2(2.885390081777927f * u)); return 0.5f * x * (1.f + t); }
__device__ __forceinline__ float xor32_sum(float v) { const unsigned u = __builtin_bit_cast(unsigned, v); const auto r = __builtin_amdgcn_permlane32_swap(u, u, false, false); return __builtin_bit_cast(float, (unsigned)r[0]) + __builtin_bit_cast(float, (unsigned)r[1]); }
__device__ __forceinline__ float xor32_max(float v) { const unsigned u = __builtin_bit_cast(unsigned, v); const auto r = __builtin_amdgcn_permlane32_swap(u, u, false, false); return fmaxf(__builtin_bit_cast(float, (unsigned)r[0]), __builtin_bit_cast(float, (unsigned)r[1])); }
template <int X> __device__ __forceinline__ float swz_xor(float v) { return __builtin_bit_cast(float, __builtin_amdgcn_ds_swizzle(__builtin_bit_cast(int, v), (X << 10) | 0x1f)); }
__device__ __forceinline__ float wave_sum(float v) { v += swz_xor<1>(v); v += swz_xor<2>(v); v += swz_xor<4>(v); v += swz_xor<8>(v); v += swz_xor<16>(v); return xor32_sum(v); }
__device__ __forceinline__ f32x16 mma32(bf16x8 a, bf16x8 b, f32x16 c) { return __builtin_amdgcn_mfma_f32_32x32x16_bf16(a, b, c, 0, 0, 0); }
__device__ __forceinline__ bf16x8 ldg8(const bf16* p) { return *(const bf16x8*)p; }
__device__ __forceinline__ bf16x8 ldg8p(const bf16* p) { const bf16x4 lo = *(const bf16x4*)p, hi = *(const bf16x4*)(p + 8); return __builtin_shufflevector(lo, hi, 0, 1, 2, 3, 4, 5, 6, 7); }
template <int S> __device__ __forceinline__ bf16x8 accB(const f32x16& c) {
    u32x4 w; w.x = pk2(c[8 * S + 0], c[8 * S + 1]); w.y = pk2(c[8 * S + 2], c[8 * S + 3]); w.z = pk2(c[8 * S + 4], c[8 * S + 5]); w.w = pk2(c[8 * S + 6], c[8 * S + 7]);
    return __builtin_bit_cast(bf16x8, w);
}
__device__ __forceinline__ bf16x8 pack8(const float (&v)[8]) { u32x4 w; w.x = pk2(v[0], v[1]); w.y = pk2(v[2], v[3]); w.z = pk2(v[4], v[5]); w.w = pk2(v[6], v[7]); return __builtin_bit_cast(bf16x8, w); }
__device__ __forceinline__ void unpack8(const bf16x8 x, float (&v)[8]) { const u32x4 w = __builtin_bit_cast(u32x4, x); v[0] = bflo(w.x); v[1] = bfhi(w.x); v[2] = bflo(w.y); v[3] = bfhi(w.y); v[4] = bflo(w.z); v[5] = bfhi(w.z); v[6] = bflo(w.w); v[7] = bfhi(w.w); }
__device__ __forceinline__ f32x16 zero16() { f32x16 z;
#pragma unroll
    for (int i = 0; i < 16; ++i) z[i] = 0.f;
    return z; }

#define XB_TMO      128
#define XB_XCNT(j)  (256  + 64 * (j))
#define XB_XSUB(j)  (1280 + 64 * (j))
#define XB_XGEN(j)  (2304 + 64 * (j))
#define XB_TOP      3328
#define XB_TOPGEN   3392
#define XCD_BAR_WORDS 3456
#define XB_SPIN_CAP (1u << 18)
__device__ __forceinline__ unsigned xb_ld(unsigned* p)              { return __hip_atomic_load(p, __ATOMIC_RELAXED, __HIP_MEMORY_SCOPE_AGENT); }
__device__ __forceinline__ unsigned xb_add(unsigned* p, unsigned v) { return __hip_atomic_fetch_add(p, v, __ATOMIC_RELAXED, __HIP_MEMORY_SCOPE_AGENT); }
__device__ __forceinline__ unsigned xb_xcc_id() { return (unsigned)__builtin_amdgcn_s_getreg((3 << 11) | 20) & 0xFu; }
#define XB_SPIN(cond, bar) do { unsigned _sp = 0; while (cond) { __builtin_amdgcn_s_sleep(1); \
    if ((++_sp & 255u) == 0u) { if (xb_ld(&(bar)[XB_TMO])) break; if (_sp > XB_SPIN_CAP) { atomicAdd(&(bar)[XB_TMO], 1u); break; } } } } while (0)
struct XcdBarrier { unsigned* bar; unsigned x; volatile LAS unsigned* st; };
__device__ __forceinline__ XcdBarrier xcd_barrier_post(unsigned* bar, volatile LAS unsigned* st) {
    XcdBarrier b; b.bar = bar; b.x = xb_xcc_id(); b.st = st;
    if (threadIdx.x == 0) (void)xb_add(&bar[XB_XCNT(b.x)], 1u);
    return b;
}
__device__ __forceinline__ void xcd_barrier_complete(unsigned* bar, unsigned x, unsigned& nloc, unsigned& nx) {
    const unsigned G = gridDim.x * gridDim.y * gridDim.z;
    unsigned sum, cnt, mine, sp = 0u;
    for (;;) {
        sum = 0u; cnt = 0u; mine = 0u;
#pragma unroll
        for (unsigned j = 0; j < 16; ++j) { const unsigned c = xb_ld(&bar[XB_XCNT(j)]); sum += c; cnt += (c > 0u) ? 1u : 0u; mine = (j == x) ? c : mine; }
        if (sum == G) break;
        __builtin_amdgcn_s_sleep(1);
        if ((++sp & 255u) == 0u) { if (xb_ld(&bar[XB_TMO])) break; if (sp > XB_SPIN_CAP) { atomicAdd(&bar[XB_TMO], 1u); break; } }
    }
    nloc = mine > 0u ? mine : 1u; nx = cnt > 0u ? cnt : 1u;
}
__device__ __forceinline__ void xcd_barrier(const XcdBarrier& b) {
    asm volatile("s_waitcnt vmcnt(0)" ::: "memory");
    __syncthreads();
    if (threadIdx.x == 0) {
        unsigned* bar = b.bar;
        __builtin_amdgcn_s_waitcnt(0);
        unsigned nloc = b.st[0], nx = b.st[1];
        if (nloc == 0u) { xcd_barrier_complete(bar, b.x, nloc, nx); b.st[0] = nloc; b.st[1] = nx; }
        const unsigned old = xb_add(&bar[XB_XSUB(b.x)], 1u);
        const unsigned gen = old / nloc;
        if (old + 1u == (gen + 1u) * nloc) {
            __builtin_amdgcn_fence(__ATOMIC_RELEASE, "agent");
            asm volatile("s_waitcnt vmcnt(0)" ::: "memory");
            const unsigned og = xb_add(&bar[XB_TOP], 1u);
            const unsigned tg = og / nx;
            if (og + 1u == (tg + 1u) * nx) xb_add(&bar[XB_TOPGEN], 1u);
            else XB_SPIN(xb_ld(&bar[XB_TOPGEN]) == tg, bar);
            __builtin_amdgcn_fence(__ATOMIC_ACQUIRE, "agent");
            xb_add(&bar[XB_XGEN(b.x)], 1u);
            asm volatile("s_waitcnt vmcnt(0)" ::: "memory");
        } else {
            XB_SPIN(xb_ld(&bar[XB_XGEN(b.x)]) == gen, bar);
            __builtin_amdgcn_fence(__ATOMIC_ACQUIRE, "agent");
            asm volatile("s_waitcnt vmcnt(0)" ::: "memory");
        }
    }
    __syncthreads();
}
namespace gp {
constexpr int BM = 256, BK = 64, HALF = 128, HTB = HALF * BK * 2, STAGE_BYTES = 8 * HTB, NXCD = 8, WGM = 8;
__device__ __forceinline__ int lds_byte(int r, int c) { const int st = (r >> 4) * 2 + (c >> 5), rr = r & 15, cc = c & 31, ob = rr * 64 + cc * 2; return st * 1024 + (ob ^ (((ob >> 9) & 1) << 5)); }
__device__ __forceinline__ void stage_rc(int b, int& Rr, int& C) { const int st = b / 1024, sb = b % 1024, swz = sb ^ (((sb >> 9) & 1) << 5); Rr = (st >> 1) * 16 + swz / 64; C = (st & 1) * 32 + (swz % 64) / 2; }
__device__ __forceinline__ int perm32(int rho) { const int n = rho >> 4, i = rho & 15; return 8 * (i >> 2) + 4 * n + (i & 3); }

struct Unit { const char* a; const char* b; int e0, e1, e2, e3, nt; };

__device__ __forceinline__ void tile_of(int L, int nM, int nN, int& pm, int& pn) {
    const int nwg = nM * nN; int wgid = L;
    { const int q = nwg / NXCD, r = nwg % NXCD, xcd = wgid % NXCD, off = wgid / NXCD; wgid = (xcd < r ? xcd * (q + 1) : r * (q + 1) + (xcd - r) * q) + off; }
    const int nig = WGM * nN, gid = wgid / nig, fm = gid * WGM, gsz = (nM - fm) < WGM ? (nM - fm) : WGM;
    pm = fm + ((wgid % nig) % gsz); pn = (wgid % nig) / gsz;
}

typedef int i32x8 __attribute__((ext_vector_type(8)));
typedef int i32x4v __attribute__((ext_vector_type(4)));
__device__ __forceinline__ i32x8 cat8(const bf16x8 a, const bf16x8 b) { const i32x4v x = __builtin_bit_cast(i32x4v, a), y = __builtin_bit_cast(i32x4v, b); return __builtin_shufflevector(x, y, 0, 1, 2, 3, 4, 5, 6, 7); }
__device__ __forceinline__ void mfma_f8(f32x4& acc, const i32x8 a, const i32x8 b) { asm volatile("s_nop 1\n\tv_mfma_f32_16x16x128_f8f6f4 %0, %1, %2, %0" : "+v"(acc) : "v"(a), "v"(b)); }
template <class Epi, class Sched, bool F8 = false>
__device__ __forceinline__ void gemm_phase(LAS unsigned char* lds, const int tid, const int K, const int lda, const int ldb, const Sched& S, const Epi& E) {
    constexpr bool GATHER = Sched::GATHER;
    const int wid = __builtin_amdgcn_readfirstlane(tid >> 6), lane = tid & 63, wr = wid >> 2, wc = wid & 3, fr = lane & 15, fq = lane >> 4;
    unsigned voffA[2], voffB[2];
#pragma unroll
    for (int i = 0; i < 2; ++i) { int Rr, C; stage_rc(tid * 16 + i * 8192, Rr, C); const int Rb = (Rr & ~31) + perm32(Rr & 31);
        voffA[i] = (unsigned)(Rr * lda + C) * 2u; voffB[i] = (unsigned)(Rb * ldb + C) * 2u; }
#define PG8_GOFF(dst, unit) do { _Pragma("unroll") for (int _h = 0; _h < 2; ++_h) _Pragma("unroll") for (int _i = 0; _i < 2; ++_i) { int _R, _C; stage_rc(tid * 16 + _i * 8192, _R, _C); dst[_h][_i] = S.rowoff(unit, _R + _h * HALF) + (unsigned)_C * 2u; } } while (0)
    const size_t kstep = (size_t)(BK * 2);
    const unsigned hstepA = (unsigned)HALF * (unsigned)lda * 2u; const size_t hstepB = (size_t)HALF * ldb * 2;
    const unsigned ldsw = (unsigned)wid * 1024u;
    const int aoff = lds_byte(wr * 64 + fr, fq * 8), boff = lds_byte(wc * 32 + fr, fq * 8);
#define PG8_SA(b, h) (((b) * 2 + (h)) * HTB)
#define PG8_SB(b, h) ((4 + (b) * 2 + (h)) * HTB)
#define PG8_STB(bufoff, gbase, hh) do { const char* _gb = (const char*)(gbase) + (size_t)(hh) * hstepB; _Pragma("unroll") for (int _i = 0; _i < 2; ++_i) \
        __builtin_amdgcn_global_load_lds((const unsigned*)(_gb + voffB[_i]), (LAS unsigned*)(lds + (bufoff) + ldsw + _i * 8192), 16, 0, 0); } while (0)
#define PG8_STA(bufoff, gbase, hh, VG) do { const char* _ga = (const char*)(gbase) + (GATHER ? (size_t)0 : (size_t)(hh) * hstepA); _Pragma("unroll") for (int _i = 0; _i < 2; ++_i) { const unsigned _o = GATHER ? (VG) : voffA[_i]; \
        __builtin_amdgcn_global_load_lds((const unsigned*)(_ga + _o), (LAS unsigned*)(lds + (bufoff) + ldsw + _i * 8192), 16, 0, 0); } } while (0)
#define PG8_LDA(dst, b, h) do { _Pragma("unroll") for (int m = 0; m < 4; ++m) _Pragma("unroll") for (int k = 0; k < 2; ++k) dst[m][k] = *(const LAS bf16x8*)(lds + PG8_SA(b, h) + aoff + m * 2048 + k * 1024); } while (0)
#define PG8_LDB(dst, b, h) do { _Pragma("unroll") for (int n = 0; n < 2; ++n) _Pragma("unroll") for (int k = 0; k < 2; ++k) dst[n][k] = *(const LAS bf16x8*)(lds + PG8_SB(b, h) + boff + n * 2048 + k * 1024); } while (0)
#define PG8_MMA(ai, bj, At, Bt) do { __builtin_amdgcn_s_setprio(1); _Pragma("unroll") for (int m = 0; m < 4; ++m) _Pragma("unroll") for (int n = 0; n < 2; ++n) { \
        if constexpr (F8) mfma_f8(acc[ai][bj][m][n], cat8(Bt[n][0], Bt[n][1]), cat8(At[m][0], At[m][1])); \
        else { _Pragma("unroll") for (int k = 0; k < 2; ++k) acc[ai][bj][m][n] = __builtin_amdgcn_mfma_f32_16x16x32_bf16(Bt[n][k], At[m][k], acc[ai][bj][m][n], 0, 0, 0); } } __builtin_amdgcn_s_setprio(0); } while (0)
#define PG8_WAIT_V(n) asm volatile("s_waitcnt vmcnt(" #n ")" ::: "memory")
#define PG8_WAIT_L(n) asm volatile("s_waitcnt lgkmcnt(" #n ")" ::: "memory")
#define PG8_BAR __builtin_amdgcn_s_barrier()
#define PG8_SCHED __builtin_amdgcn_sched_barrier(0)
    Unit cur, nxt; int ui = 0;
    if (!S.next(0, cur)) return;
    f32x4 acc[2][2][4][2];
#pragma unroll
    for (int a = 0; a < 2; ++a)
#pragma unroll
        for (int b = 0; b < 2; ++b)
#pragma unroll
            for (int m = 0; m < 4; ++m)
#pragma unroll
                for (int n = 0; n < 2; ++n) acc[a][b][m][n] = (f32x4){0.f, 0.f, 0.f, 0.f};
    bf16x8 At[4][2], B0[2][2], B1[2][2];
    unsigned vgc[2][2], vgn[2][2];
    if constexpr (GATHER) { PG8_GOFF(vgc, cur); }
#pragma unroll
    for (int h = 0; h < 2; ++h)
#pragma unroll
        for (int i = 0; i < 2; ++i) { if (!GATHER) vgc[h][i] = 0u; vgn[h][i] = vgc[h][i]; }
    const char* cA = cur.a; const char* cB = cur.b;
    PG8_STB(PG8_SB(0, 0), cB, 0); PG8_STB(PG8_SB(0, 1), cB, 1); PG8_STA(PG8_SA(0, 0), cA, 0, vgc[0][_i]); PG8_STA(PG8_SA(0, 1), cA, 1, vgc[1][_i]);
    if (wr == 1) PG8_BAR;
    PG8_WAIT_V(2); PG8_BAR;
    PG8_STB(PG8_SB(1, 0), cB + kstep, 0); PG8_STA(PG8_SA(1, 0), cA + kstep, 0, vgc[0][_i]); PG8_STB(PG8_SB(1, 1), cB + kstep, 1);
    PG8_WAIT_V(6); PG8_BAR;
    for (;;) {
        const bool has_next = S.next(ui + 1, nxt);
        const char* nA = has_next ? nxt.a : cA; const char* nB = has_next ? nxt.b : cB;
        int nt = cur.nt; asm volatile("" : "+s"(nt));
#pragma unroll 1
        for (int t = 0; t < nt; t += 2) {
            const bool last = (t == nt - 2);
            const char* a1 = cA + (size_t)(t + 1) * kstep;
            const char* a2 = last ? nA : cA + (size_t)(t + 2) * kstep; const char* b2 = last ? nB : cB + (size_t)(t + 2) * kstep;
            const char* a3 = a2 + kstep; const char* b3 = b2 + kstep;
            if constexpr (Epi::MID) { if (t != 0 && (t & 3) == 0 && cur.nt == 16) E.mid(acc, cur, (t >> 2) - 1, wr, wc, fr, fq); }
            if constexpr (GATHER) { if (last && has_next) { PG8_GOFF(vgn, nxt); } }
            PG8_LDB(B0, 0, 0); PG8_LDB(B1, 0, 1); PG8_SCHED; PG8_LDA(At, 0, 0); PG8_STA(PG8_SA(1, 1), a1, 1, vgc[1][_i]);
            PG8_WAIT_V(8); PG8_WAIT_L(0); PG8_BAR; PG8_MMA(0, 0, At, B0); PG8_MMA(0, 1, At, B1); PG8_BAR; PG8_SCHED;
            PG8_LDA(At, 0, 1); PG8_STB(PG8_SB(0, 0), b2, 0); PG8_STB(PG8_SB(0, 1), b2, 1); PG8_STA(PG8_SA(0, 0), a2, 0, (last ? vgn[0][_i] : vgc[0][_i]));
            PG8_WAIT_V(8); PG8_WAIT_L(0); PG8_BAR; PG8_MMA(1, 0, At, B0); PG8_MMA(1, 1, At, B1); PG8_BAR; PG8_SCHED;
            PG8_LDB(B0, 1, 0); PG8_LDB(B1, 1, 1); PG8_SCHED; PG8_LDA(At, 1, 0); PG8_STA(PG8_SA(0, 1), a2, 1, (last ? vgn[1][_i] : vgc[1][_i]));
            PG8_WAIT_V(8); PG8_WAIT_L(0); PG8_BAR; PG8_MMA(0, 0, At, B0); PG8_MMA(0, 1, At, B1); PG8_BAR; PG8_SCHED;
            PG8_LDA(At, 1, 1); PG8_STB(PG8_SB(1, 0), b3, 0); PG8_STB(PG8_SB(1, 1), b3, 1); PG8_STA(PG8_SA(1, 0), a3, 0, (last ? vgn[0][_i] : vgc[0][_i]));
            PG8_WAIT_V(8); PG8_WAIT_L(0); PG8_BAR; PG8_MMA(1, 0, At, B0); PG8_MMA(1, 1, At, B1); PG8_BAR; PG8_SCHED;
        }
        if constexpr (F8) { asm volatile("s_nop 15\n\ts_nop 15" ::: "memory"); }
        if (wr == 0) PG8_BAR;
        Unit ue = cur; int le = lane;
        if constexpr (Epi::LAUNDER) { int t0 = cur.e0, t1 = cur.e1, t2 = cur.e2, t3 = cur.e3; asm volatile("" : "+v"(t0), "+v"(t1), "+v"(t2), "+v"(t3), "+v"(le));
          ue.e0 = __builtin_amdgcn_readfirstlane(t0); ue.e1 = __builtin_amdgcn_readfirstlane(t1); ue.e2 = __builtin_amdgcn_readfirstlane(t2); ue.e3 = __builtin_amdgcn_readfirstlane(t3); le &= 63; }
        const int fre = le & 15, fqe = le >> 4;
        if constexpr (Epi::CARRY) { E.carry(acc, ue, wr, wc, fre, fqe); if (!has_next) break; }
        else {
        E(acc, ue, wr, wc, fre, fqe);
        if (!has_next) break;
#pragma unroll
        for (int a = 0; a < 2; ++a)
#pragma unroll
            for (int b = 0; b < 2; ++b)
#pragma unroll
                for (int m = 0; m < 4; ++m)
#pragma unroll
                    for (int n = 0; n < 2; ++n) acc[a][b][m][n] = (f32x4){0.f, 0.f, 0.f, 0.f};
        }
        cur = nxt; cA = nA; cB = nB; ++ui;
#pragma unroll
        for (int h = 0; h < 2; ++h)
#pragma unroll
            for (int i = 0; i < 2; ++i) vgc[h][i] = vgn[h][i];
        if (wr == 1) PG8_BAR;
    }
    PG8_WAIT_V(0);
    PG8_BAR;
#undef PG8_SA
#undef PG8_SB
#undef PG8_STA
#undef PG8_GOFF
#undef PG8_STB
#undef PG8_LDA
#undef PG8_LDB
#undef PG8_MMA
#undef PG8_WAIT_V
#undef PG8_WAIT_L
#undef PG8_BAR
#undef PG8_SCHED
}

struct SchedPlain {
    static constexpr bool GATHER = false;
    const char* A; const char* B; size_t ta, tb; int nM, nN, G, c, nt;
    __device__ __forceinline__ bool next(int i, Unit& u) const {
        const long L = (long)i * G + c; if (L >= (long)nM * nN) return false;
        int pm, pn; tile_of((int)L, nM, nN, pm, pn); u.a = A + (size_t)pm * ta; u.b = B + (size_t)pn * tb; u.e0 = pm; u.e1 = pn; u.e2 = 0; u.e3 = 0; u.nt = nt; return true; }
    __device__ __forceinline__ unsigned rowoff(const Unit&, int) const { return 0u; }
};
struct SchedInprojA {
    static constexpr bool GATHER = false;
    const char* Hh; const char* W; int nM, G, c, ng;
    __device__ __forceinline__ bool next(int i, Unit& u) const {
        long L = (long)i * G + c; const int n1 = nM * 7, n2 = 3 * nM; if (L >= n1 + n2 + ng) return false;
        int pm, pn;
        if (L < n1) { tile_of((int)L, nM, 7, pm, pn); u.a = Hh + (size_t)pm * (256 * 2048); u.b = W + (size_t)pn * (256 * 2048); u.e2 = 0; }
        else if (L < n1 + n2) { tile_of((int)(L - n1), 3, nM, pm, pn); u.a = W + (size_t)(23 + pm) * (256 * 2048); u.b = Hh + (size_t)pn * (256 * 2048); u.e2 = 1; }
        else { const int q = (int)(L - n1 - n2); pm = q >> 4; pn = q & 15; u.a = Hh + (size_t)(64 + pm) * (256 * 2048); u.b = W + (size_t)(7 + pn) * (256 * 2048); u.e2 = 2; }
        u.e0 = pm; u.e1 = pn; u.e3 = 0; u.nt = 16; return true; }
    __device__ __forceinline__ unsigned rowoff(const Unit&, int) const { return 0u; }
};
struct SchedSplit {
    static constexpr bool GATHER = false;
    const char* A; const char* B; size_t ta, tb; int nslice, ntf, G, c; const char* Ac; size_t tac, sac; int ks;
    __device__ __forceinline__ bool next(int i, Unit& u) const {
        const long L = (long)i * G + c; int pm, pn;
        if (L < 256) { tile_of((int)L, 64, 4, pm, pn); u.a = A + (size_t)pm * ta; u.b = B + (size_t)pn * tb; u.e2 = 0; u.e3 = 0; u.nt = ntf; }
        else { const int q = (int)(L - 256); if (q >= 8 * nslice) return false; const int tile = q / nslice, s = q % nslice; pm = 64 + (tile >> 2); pn = tile & 3;
            u.a = Ac + (size_t)(tile >> 2) * tac + (size_t)(s / ks) * sac + (s % ks) * 512; u.b = B + (size_t)pn * tb + (s % ks) * 512; u.e2 = s + 1; u.e3 = tile; u.nt = 4; }
        u.e0 = pm; u.e1 = pn; return true; }
    __device__ __forceinline__ unsigned rowoff(const Unit&, int) const { return 0u; }
};
struct SchedMerge {
    static constexpr bool GATHER = false;
    const char* Mix; const char* Wb; int nctx, G, c;
    __device__ __forceinline__ bool next(int i, Unit& u) const {
        const long L = (long)i * G + c; int pm, pn;
        if (L < 256) { tile_of((int)L, 64, 4, pm, pn); u.a = Mix + (size_t)pm * (256 * 2048); u.b = Wb + (size_t)pn * (256 * 2048); u.e2 = 0; u.e3 = 0; u.nt = 16; }
        else { const long q = L - 256; if (q >= nctx) return false; const int tile = (int)q >> 2, b = (int)q & 3; pm = 64 + (tile >> 2); pn = tile & 3;
            u.a = Mix + (size_t)pm * (256 * 2048) + b * 512; u.b = Wb + (size_t)pn * (256 * 2048) + b * 512; u.e2 = b; u.e3 = 1; u.nt = 4; }
        u.e0 = pm; u.e1 = pn; return true; }
    __device__ __forceinline__ unsigned rowoff(const Unit&, int) const { return 0u; }
};
__device__ __forceinline__ int mtu(const LAS unsigned* mt, int i) { return __builtin_amdgcn_readfirstlane((int)mt[i]); }
struct SchedMoe1 {
    static constexpr bool GATHER = true;
    const char* Hh; const char* W; const int* list; const LAS unsigned* mt; int G, c; unsigned rb;
    __device__ __forceinline__ bool next(int i, Unit& u) const {
        long L = (long)i * G + c; int e = 0;
        for (; e < 8; ++e) { const long ue = (long)mtu(mt, 8 + e) * 28; if (L < ue) break; L -= ue; }
        if (e == 8) return false;
        const int m_e = mtu(mt, 8 + e), nti = (int)(L / m_e), mti = (int)(L % m_e);
        u.a = Hh; u.b = W + ((size_t)e * 7168 + (size_t)nti * 256) * rb; u.e0 = e; u.e1 = mti; u.e2 = nti; u.e3 = (mtu(mt, 16 + e) + mti) * 256; u.nt = (int)(rb >> 7); return true; }
    __device__ __forceinline__ unsigned rowoff(const Unit& u, int r) const {
        const int li = u.e1 * 256 + r; const int ent = (li < (int)mt[u.e0]) ? list[u.e0 * LCAP + li] : 0; return (unsigned)(ent >> 1) * rb; }
};
__device__ __forceinline__ bool moe2_unit(long L, const LAS unsigned* mt, const char* Hid, const char* W, Unit& u, const size_t rb) {
    int e = 0;
    for (; e < 8; ++e) { const long ue = (long)mtu(mt, 8 + e) * 4; if (L < ue) break; L -= ue; }
    if (e == 8) return false;
    const int m_e = mtu(mt, 8 + e), nti = (int)(L / m_e), mti = (int)(L % m_e);
    u.a = Hid + (size_t)(mtu(mt, 16 + e) + mti) * 256 * rb; u.b = W + ((size_t)e * 1024 + (size_t)nti * 256) * rb; u.e0 = e; u.e1 = mti; u.e2 = nti; u.e3 = 0; u.nt = (int)(rb >> 7); return true;
}
struct SchedMoe2 {
    static constexpr bool GATHER = false;
    const char* Hid; const char* W; const LAS unsigned* mt; int G, c; unsigned rb;
    __device__ __forceinline__ bool next(int i, Unit& u) const { const long L = (long)i * G + c; if (L >= (long)mtu(mt, 25)) return false; return moe2_unit(L, mt, Hid, W, u, rb); }
    __device__ __forceinline__ unsigned rowoff(const Unit&, int) const { return 0u; }
};
struct SchedMoe2S {
    static constexpr bool GATHER = false;
    const char* Hid; const char* W; const LAS unsigned* mt; int G, c; unsigned rb;
    __device__ __forceinline__ bool next(int i, Unit& u) const { const long q = (long)i * G + c; if (q >= (long)mtu(mt, 26) * 7) return false;
        if (!moe2_unit((long)mtu(mt, 25) + q / 7, mt, Hid, W, u, rb)) return false; const int s = (int)(q % 7); const unsigned sb = rb / 7u; u.a += s * sb; u.b += s * sb; u.e3 = (int)q; u.nt = (int)(sb >> 7); return true; }
    __device__ __forceinline__ unsigned rowoff(const Unit&, int) const { return 0u; }
};

#define EPI_ROWS(ai, m) (128 * (ai) + 64 * wr + 16 * (m) + fr)
#define EPI_COL(bj) (128 * (bj) + 32 * wc + 8 * fq)
__device__ __forceinline__ u32x4 pack_acc8(const f32x4 a, const f32x4 b) { u32x4 w; w.x = pk2(a[0], a[1]); w.y = pk2(a[2], a[3]); w.z = pk2(b[0], b[1]); w.w = pk2(b[2], b[3]); return w; }

__device__ __forceinline__ unsigned gq8(float g) { const unsigned q = (unsigned)(g * 255.f + 0.5f); return q < 1u ? 1u : q; }
__device__ __forceinline__ u32x2 pack_gate8(const f32x4 a, const f32x4 b) {
    u32x2 w; w.x = gq8(a[0]) | (gq8(a[1]) << 8) | (gq8(a[2]) << 16) | (gq8(a[3]) << 24); w.y = gq8(b[0]) | (gq8(b[1]) << 8) | (gq8(b[2]) << 16) | (gq8(b[3]) << 24); return w; }
__device__ __forceinline__ size_t gate_off(int pm, int j, int b, int wr, int wc, int ai, int m, int bj, int fr, int fq) { return ((((size_t)((pm * 4 + j) * 4 + b) * 8 + wr * 4 + wc) * 16 + (ai * 4 + m) * 2 + bj) * 64 + fq * 16 + fr) * 8; }
__device__ __forceinline__ float gate8(unsigned w, int k) { return (float)((w >> (8 * k)) & 255u) * (1.f / 255.f); }
struct EpiPlain { static constexpr bool CARRY = false, LAUNDER = false, MID = false;
    bf16* O; int ld;
    __device__ __forceinline__ void operator()(const f32x4 (&acc)[2][2][4][2], const Unit& u, int wr, int wc, int fr, int fq) const {
#pragma unroll
        for (int ai = 0; ai < 2; ++ai)
#pragma unroll
            for (int m = 0; m < 4; ++m) { bf16* rowp = O + (size_t)(u.e0 * 256 + EPI_ROWS(ai, m)) * ld + u.e1 * 256;
#pragma unroll
                for (int bj = 0; bj < 2; ++bj) *(u32x4*)(rowp + EPI_COL(bj)) = pack_acc8(acc[ai][bj][m][0], acc[ai][bj][m][1]); }
    }
};
struct EpiPlainSplit { static constexpr bool CARRY = false, LAUNDER = false, MID = false;
    bf16* O; int ld; float* P; int nslice;
    __device__ __forceinline__ void operator()(const f32x4 (&acc)[2][2][4][2], const Unit& u, int wr, int wc, int fr, int fq) const {
        if (u.e2 == 0) {
#pragma unroll
            for (int ai = 0; ai < 2; ++ai)
#pragma unroll
                for (int m = 0; m < 4; ++m) { bf16* rowp = O + (size_t)(u.e0 * 256 + EPI_ROWS(ai, m)) * ld + u.e1 * 256;
#pragma unroll
                    for (int bj = 0; bj < 2; ++bj) *(u32x4*)(rowp + EPI_COL(bj)) = pack_acc8(acc[ai][bj][m][0], acc[ai][bj][m][1]); }
        } else { float* pt = P + (size_t)(u.e3 * nslice + (u.e2 - 1)) * 65536;
#pragma unroll
            for (int ai = 0; ai < 2; ++ai)
#pragma unroll
                for (int m = 0; m < 4; ++m)
#pragma unroll
                    for (int bj = 0; bj < 2; ++bj) { float* p = pt + EPI_ROWS(ai, m) * 256 + EPI_COL(bj); *(f32x4*)p = acc[ai][bj][m][0]; *(f32x4*)(p + 4) = acc[ai][bj][m][1]; }
        }
    }
};
struct EpiInprojA { static constexpr bool CARRY = false, LAUNDER = false, MID = false;
    bf16* INP; bf16* T; unsigned char* Gc;
    __device__ __forceinline__ void operator()(const f32x4 (&acc)[2][2][4][2], const Unit& u, int wr, int wc, int fr, int fq) const {
        if (u.e2 == 2) {
#pragma unroll
            for (int ai = 0; ai < 2; ++ai)
#pragma unroll
                for (int m = 0; m < 4; ++m)
#pragma unroll
                    for (int bj = 0; bj < 2; ++bj) { f32x4 a = acc[ai][bj][m][0], b = acc[ai][bj][m][1];
#pragma unroll
                        for (int j = 0; j < 4; ++j) { a[j] = sigm(a[j]); b[j] = sigm(b[j]); }
                        *(u32x2*)(Gc + gate_off(u.e0, u.e1 & 3, u.e1 >> 2, wr, wc, ai, m, bj, fr, fq)) = pack_gate8(a, b); }
        } else if (u.e2 == 0) {
            bf16* base = INP + (size_t)u.e1 * ((size_t)R * 256);
            const bool regroup = (u.e1 == 1);
#pragma unroll
            for (int ai = 0; ai < 2; ++ai)
#pragma unroll
                for (int m = 0; m < 4; ++m) { const int row = u.e0 * 256 + EPI_ROWS(ai, m);
#pragma unroll
                    for (int bj = 0; bj < 2; ++bj) { const int col = EPI_COL(bj);
                        bf16* p = regroup ? base + ((((size_t)(col >> 4) * 33 + (row >> 9)) * 16 + (row & 15)) * 64 + ((col & 8) << 2) + ((row >> 4) & 31)) * 8 : base + (size_t)row * 256 + col;
                        *(u32x4*)p = pack_acc8(acc[ai][bj][m][0], acc[ai][bj][m][1]); } }
        } else {
#pragma unroll
            for (int ai = 0; ai < 2; ++ai)
#pragma unroll
                for (int m = 0; m < 4; ++m) { bf16* rowp = T + (size_t)(u.e0 * 256 + EPI_ROWS(ai, m)) * R + u.e1 * 256;
#pragma unroll
                    for (int bj = 0; bj < 2; ++bj) *(u32x4*)(rowp + EPI_COL(bj)) = pack_acc8(acc[ai][bj][m][0], acc[ai][bj][m][1]); }
        }
    }
};
struct EpiGates { static constexpr bool CARRY = false, LAUNDER = false, MID = false;
    unsigned char* Gt; float isc;
    __device__ __forceinline__ void operator()(const f32x4 (&acc)[2][2][4][2], const Unit& u, int wr, int wc, int fr, int fq) const {
#pragma unroll
        for (int ai = 0; ai < 2; ++ai)
#pragma unroll
            for (int m = 0; m < 4; ++m)
#pragma unroll
                for (int bj = 0; bj < 2; ++bj) { f32x4 a = acc[ai][bj][m][0], b = acc[ai][bj][m][1];
#pragma unroll
                    for (int j = 0; j < 4; ++j) { a[j] = sigm(a[j] * isc); b[j] = sigm(b[j] * isc); }
                    *(u32x2*)(Gt + gate_off(u.e0, u.e1 & 3, u.e1 >> 2, wr, wc, ai, m, bj, fr, fq)) = pack_gate8(a, b); }
    }
};
struct EpiGlu { static constexpr bool CARRY = false, LAUNDER = false, MID = false;
    const bf16* Zz; bf16* Mix; const float* bglu;
    __device__ __forceinline__ void operator()(const f32x4 (&acc)[2][2][4][2], const Unit& u, int wr, int wc, int fr, int fq) const {
#pragma unroll
        for (int bj = 0; bj < 2; ++bj) { const int col = EPI_COL(bj);
            const f32x4 b0 = *(const f32x4*)(bglu + col), b1 = *(const f32x4*)(bglu + col + 4);
#pragma unroll
            for (int ai = 0; ai < 2; ++ai)
#pragma unroll
                for (int m = 0; m < 4; ++m) { const size_t row = (size_t)(u.e0 * 256 + EPI_ROWS(ai, m));
                    const u32x4 zz = *(const u32x4*)(Zz + row * 256 + col);
                    f32x4 a = acc[ai][bj][m][0] + b0, b = acc[ai][bj][m][1] + b1;
                    a[0] = bflo(zz.x) * sigm(a[0]); a[1] = bfhi(zz.x) * sigm(a[1]); a[2] = bflo(zz.y) * sigm(a[2]); a[3] = bfhi(zz.y) * sigm(a[3]);
                    b[0] = bflo(zz.z) * sigm(b[0]); b[1] = bfhi(zz.z) * sigm(b[1]); b[2] = bflo(zz.w) * sigm(b[2]); b[3] = bfhi(zz.w) * sigm(b[3]);
                    *(u32x4*)(Mix + row * 1024 + 256 + col) = pack_acc8(a, b); } }
    }
};
struct EpiMerge {
    static constexpr bool CARRY = false, LAUNDER = false, MID = true;
    const unsigned char* Gt; const unsigned char* Gc; bf16* Y; bf16* YP;
    __device__ __forceinline__ void mid(f32x4 (&acc)[2][2][4][2], const Unit& u, int b, int wr, int wc, int fr, int fq) const {
#pragma unroll
        for (int ai = 0; ai < 2; ++ai) {
            u32x2 g[4][2], gn[4][2];
#pragma unroll
            for (int m = 0; m < 4; ++m)
#pragma unroll
                for (int bj = 0; bj < 2; ++bj) { const unsigned char* gp = Gt + gate_off(u.e0, u.e1, b, wr, wc, ai, m, bj, fr, fq); g[m][bj] = *(const u32x2*)gp; gn[m][bj] = *(const u32x2*)(gp + 65536); }
#pragma unroll
            for (int m = 0; m < 4; ++m)
#pragma unroll
                for (int bj = 0; bj < 2; ++bj) { f32x4 a0 = acc[ai][bj][m][0], a1 = acc[ai][bj][m][1];
#pragma unroll
                    for (int j = 0; j < 4; ++j) { a0[j] *= gate8(g[m][bj].x, j) * rcpf_(gate8(gn[m][bj].x, j)); a1[j] *= gate8(g[m][bj].y, j) * rcpf_(gate8(gn[m][bj].y, j)); }
                    acc[ai][bj][m][0] = a0; acc[ai][bj][m][1] = a1; } }
    }
    __device__ __forceinline__ void operator()(const f32x4 (&acc)[2][2][4][2], const Unit& u, int wr, int wc, int fr, int fq) const {
        const int b = u.e3 ? u.e2 : 3;
#pragma unroll
        for (int ai = 0; ai < 2; ++ai)
#pragma unroll
            for (int m = 0; m < 4; ++m) { const size_t row = (size_t)(u.e0 * 256 + EPI_ROWS(ai, m));
                bf16* orow = (u.e3 ? YP + ((size_t)b * CROWS + (row - LROWS)) * 1024 : Y + row * 1024) + u.e1 * 256;
#pragma unroll
                for (int bj = 0; bj < 2; ++bj) { const u32x2 g = *(const u32x2*)((u.e3 ? Gc : Gt) + gate_off(u.e3 ? u.e0 - 64 : u.e0, u.e1, b, wr, wc, ai, m, bj, fr, fq)); f32x4 a0 = acc[ai][bj][m][0], a1 = acc[ai][bj][m][1];
#pragma unroll
                    for (int j = 0; j < 4; ++j) { a0[j] *= gate8(g.x, j); a1[j] *= gate8(g.y, j); }
                    *(u32x4*)(orow + EPI_COL(bj)) = pack_acc8(a0, a1); } }
    }
};
struct EpiSwiglu { static constexpr bool CARRY = false, LAUNDER = false, MID = false;
    bf16* Hd; int ldh; bool moe;
    __device__ __forceinline__ void operator()(const f32x4 (&acc)[2][2][4][2], const Unit& u, int wr, int wc, int fr, int fq) const {
        const int rowbase = moe ? u.e3 : u.e0 * 256, pn = moe ? u.e2 : u.e1;
#pragma unroll
        for (int ai = 0; ai < 2; ++ai)
#pragma unroll
            for (int m = 0; m < 4; ++m) { bf16* p = Hd + (size_t)(rowbase + EPI_ROWS(ai, m)) * ldh + pn * 128 + 32 * wc + 8 * fq;
                f32x4 a = acc[ai][0][m][0], b = acc[ai][0][m][1]; const f32x4 ua = acc[ai][1][m][0], ub = acc[ai][1][m][1];
#pragma unroll
                for (int j = 0; j < 4; ++j) { a[j] = silu_(a[j]) * ua[j]; b[j] = silu_(b[j]) * ub[j]; }
                *(u32x4*)p = pack_acc8(a, b); }
    }
};
struct EpiSwigluF8 { static constexpr bool CARRY = false, LAUNDER = true, MID = false;
    unsigned char* Hd; int ldh; bool moe; float ws, hs;
    __device__ __forceinline__ void operator()(const f32x4 (&acc)[2][2][4][2], const Unit& u, int wr, int wc, int fr, int fq) const {
        const int rowbase = moe ? u.e3 : u.e0 * 256, pn = moe ? u.e2 : u.e1; const float hs2 = hs * ws;
#pragma unroll
        for (int ai = 0; ai < 2; ++ai)
#pragma unroll
            for (int m = 0; m < 4; ++m) { unsigned char* p = Hd + (size_t)(rowbase + EPI_ROWS(ai, m)) * ldh + pn * 128 + 32 * wc + 8 * fq;
                f32x4 a = acc[ai][0][m][0], b = acc[ai][0][m][1]; const f32x4 ua = acc[ai][1][m][0], ub = acc[ai][1][m][1];
#pragma unroll
                for (int j = 0; j < 4; ++j) { a[j] = __builtin_amdgcn_fmed3f(silu_(a[j] * ws) * (ua[j] * hs2), -448.f, 448.f); b[j] = __builtin_amdgcn_fmed3f(silu_(b[j] * ws) * (ub[j] * hs2), -448.f, 448.f); }
                u32x2 w; w.x = pk4_f8(a[0], a[1], a[2], a[3]); w.y = pk4_f8(b[0], b[1], b[2], b[3]); *(u32x2*)p = w; }
    }
};
struct EpiMoeDown { static constexpr bool CARRY = false, LAUNDER = true, MID = false;
    bf16* Slot; const int* list; const float* routew; const LAS unsigned* mt; float osc;
    __device__ __forceinline__ void operator()(const f32x4 (&acc)[2][2][4][2], const Unit& u, int wr, int wc, int fr, int fq) const {
        const int cnt = (int)mt[u.e0];
#pragma unroll
        for (int ai = 0; ai < 2; ++ai)
#pragma unroll
            for (int m = 0; m < 4; ++m) { const int li = u.e1 * 256 + EPI_ROWS(ai, m);
                if (li < cnt) { const int ent = list[u.e0 * LCAP + li]; const float w = routew[ent] * osc;
                    bf16* rowp = Slot + ((size_t)(ent & 1) * LROWS + (size_t)(ent >> 1)) * 1024 + u.e2 * 256;
#pragma unroll
                    for (int bj = 0; bj < 2; ++bj) *(u32x4*)(rowp + EPI_COL(bj)) = pack_acc8(acc[ai][bj][m][0] * w, acc[ai][bj][m][1] * w); } }
    }
};
struct EpiMoePart { static constexpr bool CARRY = false, LAUNDER = true, MID = false;
    bf16* Pm; const int* list; const LAS unsigned* mt; int* smap; float osc;
    __device__ __forceinline__ void operator()(const f32x4 (&acc)[2][2][4][2], const Unit& u, int wr, int wc, int fr, int fq) const {
        const int cnt = (int)mt[u.e0], q = u.e3; bf16* pt = Pm + (size_t)q * 65536; const bool mapper = (q % 7 == 0) && wc == 0 && fq == 0;
#pragma unroll
        for (int ai = 0; ai < 2; ++ai)
#pragma unroll
            for (int m = 0; m < 4; ++m) { const int rl = EPI_ROWS(ai, m), li = u.e1 * 256 + rl;
#pragma unroll
                for (int bj = 0; bj < 2; ++bj) *(u32x4*)(pt + rl * 256 + EPI_COL(bj)) = pack_acc8(acc[ai][bj][m][0] * osc, acc[ai][bj][m][1] * osc);
                if (mapper && li < cnt) smap[list[u.e0 * LCAP + li] * 4 + u.e2] = ((q / 7) << 8) | rl; }
    }
};
}
#define DROW(reg, h) (((reg) & 3) + 8 * ((reg) >> 2) + 4 * (h))

__device__ __forceinline__ void s5_state_item(const bf16* M1F  , const bf16* SUF, float* HLOC, int item, int lane) {
    const int cb = item % 33, gd = item / 33, g = gd >> 1, dir = gd & 1, li = lane & 31, h = lane >> 5;
    const bf16* A = M1F + (size_t)(g * 2 + dir) * 128 * 256 + lane * 8;
    const bf16* B = SUF + (size_t)(g * 33 + cb) * 16 * 512 + lane * 8;
    f32x16 acc[4];
#pragma unroll
    for (int rt = 0; rt < 4; ++rt) acc[rt] = zero16();
    bf16x8 a0[2][4], b0[2], a1[2][4], b1[2];
#define S5S_LOAD(AA, BB, grp) do { _Pragma("unroll") for (int s = 0; s < 2; ++s) { const int ks = (grp) * 2 + s; BB[s] = ldg8(B + ks * 512); \
        _Pragma("unroll") for (int rt = 0; rt < 4; ++rt) AA[s][rt] = ldg8(A + (ks * 4 + rt) * 512); } } while (0)
#define S5S_MMA(AA, BB) do { _Pragma("unroll") for (int s = 0; s < 2; ++s) _Pragma("unroll") for (int rt = 0; rt < 4; ++rt) acc[rt] = mma32(AA[s][rt], BB[s], acc[rt]); } while (0)
    S5S_LOAD(a0, b0, 0);
#pragma unroll 1
    for (int gp = 0; gp < 8; gp += 2) {
        S5S_LOAD(a1, b1, gp + 1);
        S5S_MMA(a0, b0);
        if (gp + 2 < 8) S5S_LOAD(a0, b0, gp + 2);
        S5S_MMA(a1, b1);
    }
#undef S5S_LOAD
#undef S5S_MMA
    const int c = cb * 32 + li; float* o = HLOC + (((size_t)(g * 2 + dir) * (NCH16 / 2) + (c >> 1)) * 64) * 4 + (c & 1) * 2;
#pragma unroll
    for (int rt = 0; rt < 4; ++rt)
#pragma unroll
        for (int q = 0; q < 4; ++q) { const int p0 = 16 * rt + 4 * q + 2 * h;
            *(f32x2*)(o + (size_t)p0 * 4) = (f32x2){acc[rt][4 * q], acc[rt][4 * q + 1]}; *(f32x2*)(o + (size_t)(p0 + 1) * 4) = (f32x2){acc[rt][4 * q + 2], acc[rt][4 * q + 3]}; }
}
__device__ __forceinline__ void s5_scan_item(const float* A16  , const float* HLOC, bf16* HINF, LAS unsigned char* wl, int item, int lane) {
    const int dir = item & 1, g = (item >> 1) & 15, b = item >> 5, p = lane;
    const f32x2 a = *(const f32x2*)(A16 + ((size_t)(dir * 16 + g) * 64 + p) * 2);
    const float* src = HLOC + ((size_t)(g * 2 + dir) * (NCH16 / 2) * 64 + p) * 4;
    const int k2 = dir * 128 + 2 * p;
    bf16* dctx = HINF + ((size_t)(g * 33 + 32) * 16 + (k2 >> 4)) * 512 + ((k2 >> 3) & 1) * 256 + (k2 & 7);
    float hr = 0.f, hi = 0.f;
#define S5_STEP(xr, xi) do { const float nr_ = a.x * hr - a.y * hi + (xr), ni_ = a.x * hi + a.y * hr + (xi); hr = nr_; hi = ni_; } while (0)
    {
        f32x4 v[8];
#pragma unroll
        for (int j = 0; j < 8; ++j) v[j] = *(const f32x4*)(src + (size_t)(512 + 8 * b + (dir ? 7 - j : j)) * 256);
#pragma unroll
        for (int j = 0; j < 8; ++j) { const int cl0 = 16 * b + 2 * (dir ? 7 - j : j);
            if (!dir) { *(unsigned*)(dctx + (cl0) * 8) = pk2(hr, hi); S5_STEP(v[j][0], v[j][1]); *(unsigned*)(dctx + (cl0 + 1) * 8) = pk2(hr, hi); S5_STEP(v[j][2], v[j][3]); }
            else      { *(unsigned*)(dctx + (cl0 + 1) * 8) = pk2(hr, hi); S5_STEP(v[j][2], v[j][3]); *(unsigned*)(dctx + (cl0) * 8) = pk2(hr, hi); S5_STEP(v[j][0], v[j][1]); } }
    }
    const int pg = p >> 2; LAS unsigned char* wbase = wl + ((p >> 3) * 64 + (pg & 1) * 32) * 16 + 4 * (p & 3);
    f32x4 vn[16];
#pragma unroll
    for (int j = 0; j < 16; ++j) vn[j] = *(const f32x4*)(src + (size_t)(256 * b + (dir ? 255 - j : j)) * 256);
#pragma unroll 1
    for (int blk = 0; blk < 16; ++blk) {
        f32x4 v[16];
#pragma unroll
        for (int j = 0; j < 16; ++j) v[j] = vn[j];
        if (blk < 15) {
#pragma unroll
            for (int j = 0; j < 16; ++j) { const int pj = 16 * (blk + 1) + j; vn[j] = *(const f32x4*)(src + (size_t)(256 * b + (dir ? 255 - pj : pj)) * 256); } }
#pragma unroll
        for (int j = 0; j < 16; ++j) { const int pl = dir ? 15 - j : j;
            if (!dir) { *(LAS unsigned*)(wbase + ((2 * pl + pg) & 31) * 16) = pk2(hr, hi); S5_STEP(v[j][0], v[j][1]); *(LAS unsigned*)(wbase + ((2 * pl + 1 + pg) & 31) * 16) = pk2(hr, hi); S5_STEP(v[j][2], v[j][3]); }
            else      { *(LAS unsigned*)(wbase + ((2 * pl + 1 + pg) & 31) * 16) = pk2(hr, hi); S5_STEP(v[j][2], v[j][3]); *(LAS unsigned*)(wbase + ((2 * pl + pg) & 31) * 16) = pk2(hr, hi); S5_STEP(v[j][0], v[j][1]); } }
        const int cb = 16 * b + (dir ? 15 - blk : blk), hs = lane >> 5, cl = lane & 31;
        bf16* dout = HINF + ((size_t)(g * 33 + cb) * 16 + dir * 8) * 512 + lane * 8;
#pragma unroll
        for (int j = 0; j < 8; ++j) *(u32x4*)(dout + j * 512) = *(const LAS u32x4*)(wl + (j * 64 + hs * 32 + ((cl + 2 * j + hs) & 31)) * 16);
    }
#undef S5_STEP
}
__device__ __forceinline__ void s5_out_item(const bf16* TABF  , const bf16* SUF, const bf16* HINF, bf16* Z, int item, int lane) {
    const int mh = item & 1, it2 = item >> 1, cb = it2 % 33, g = it2 / 33, li = lane & 31, h = lane >> 5, c = cb * 32 + li;
    const bf16* A = TABF + ((size_t)g * 256 + mh * 128) * 512 + lane * 8;
    const bf16* B0 = SUF + (size_t)(g * 33 + cb) * 16 * 512 + lane * 8;
    const bf16* B1 = HINF + (size_t)(g * 33 + cb) * 16 * 512 + lane * 8;
    f32x16 acc[4];
#pragma unroll
    for (int rt = 0; rt < 4; ++rt) acc[rt] = zero16();
    bf16x8 a0[2][4], b0[2], a1[2][4], b1[2];
#define S5O_LOAD(AA, BB, grp) do { _Pragma("unroll") for (int s = 0; s < 2; ++s) { const int ks = (grp) * 2 + s; BB[s] = ldg8((ks < 16 ? B0 + ks * 512 : B1 + (ks - 16) * 512)); \
        _Pragma("unroll") for (int rt = 0; rt < 4; ++rt) AA[s][rt] = ldg8(A + (ks * 4 + rt) * 512); } } while (0)
#define S5O_MMA(AA, BB) do { _Pragma("unroll") for (int s = 0; s < 2; ++s) _Pragma("unroll") for (int rt = 0; rt < 4; ++rt) acc[rt] = mma32(AA[s][rt], BB[s], acc[rt]); } while (0)
    S5O_LOAD(a0, b0, 0);
#pragma unroll 1
    for (int gp = 0; gp < 16; gp += 2) {
        S5O_LOAD(a1, b1, gp + 1);
        S5O_MMA(a0, b0);
        if (gp + 2 < 16) S5O_LOAD(a0, b0, gp + 2);
        S5O_MMA(a1, b1);
    }
#undef S5O_LOAD
#undef S5O_MMA
#pragma unroll
    for (int rt = 0; rt < 4; ++rt)
#pragma unroll
        for (int q = 0; q < 4; ++q) {
            const int i = 8 * mh + 2 * rt + (q >> 1), ho0 = 8 * (q & 1) + 4 * h;
            u32x2 w; w.x = pk2(gelu_tanh(acc[rt][4 * q]), gelu_tanh(acc[rt][4 * q + 1])); w.y = pk2(gelu_tanh(acc[rt][4 * q + 2]), gelu_tanh(acc[rt][4 * q + 3]));
            *(u32x2*)(Z + ((size_t)c * 16 + i) * 256 + g * 16 + ho0) = w; }
}

__device__ __forceinline__ int ret_tok0(int b, int n) { return n < 64 ? b * SEQ + n * 128 : LROWS + b * CTXL + (n - 64) * 128; }
__device__ __forceinline__ void ret_kv_item(const bf16* RKT, const bf16* RVT, const float* COST, const float* SINT, const float* decay  , float* KV, int item, int lane) {
    const int n = item % 66, bh = item / 66, hd = bh & 3, b = bh >> 2, li = lane & 31, h = lane >> 5;
    const int tok0 = ret_tok0(b, n); const bool lat = n < 64;
    const float lgf = -log2f(1.f + __expf(-decay[hd])), lgr = -log2f(1.f + __expf(-decay[4 + hd]));
    f32x16 acc[2][2][2];
#pragma unroll
    for (int a = 0; a < 2; ++a)
#pragma unroll
        for (int c = 0; c < 2; ++c)
#pragma unroll
            for (int d = 0; d < 2; ++d) acc[a][c][d] = zero16();
    const bf16* k0p = RKT + (size_t)(hd * 64 + li) * R + tok0 + 8 * h;
    const bf16* v0p = RVT + (size_t)(hd * 64 + li) * R + tok0 + 8 * h;
#pragma unroll 2
    for (int ks = 0; ks < 8; ++ks) {
        float k1[8], k2[8];
        unpack8(ldg8(k0p + ks * 16), k1); unpack8(ldg8(k0p + (size_t)32 * R + ks * 16), k2);
        if (lat) {
            const float* cp = COST + (size_t)li * SEQ + n * 128 + ks * 16 + 8 * h; const float* sp = SINT + (size_t)li * SEQ + n * 128 + ks * 16 + 8 * h;
            const f32x4 c0 = *(const f32x4*)cp, c1 = *(const f32x4*)(cp + 4), s0 = *(const f32x4*)sp, s1 = *(const f32x4*)(sp + 4);
#pragma unroll
            for (int j = 0; j < 8; ++j) { const float cc = j < 4 ? c0[j & 3] : c1[j & 3], ss = j < 4 ? s0[j & 3] : s1[j & 3];
                const float x1 = k1[j], x2 = k2[j]; k1[j] = x1 * cc - x2 * ss; k2[j] = x1 * ss + x2 * cc; }
        }
        const bf16x8 vf0 = ldg8(v0p + ks * 16), vf1 = ldg8(v0p + (size_t)32 * R + ks * 16);
#pragma unroll
        for (int dir = 0; dir < 2; ++dir) {
            float a1[8], a2[8];
#pragma unroll
            for (int j = 0; j < 8; ++j) { const int i = ks * 16 + 8 * h + j; const float w = dir == 0 ? ex2(lgf * (float)(127 - i)) : ex2(lgr * (float)i); a1[j] = k1[j] * w; a2[j] = k2[j] * w; }
            const bf16x8 kd0 = pack8(a1), kd1 = pack8(a2);
            acc[dir][0][0] = mma32(kd0, vf0, acc[dir][0][0]); acc[dir][0][1] = mma32(kd0, vf1, acc[dir][0][1]);
            acc[dir][1][0] = mma32(kd1, vf0, acc[dir][1][0]); acc[dir][1][1] = mma32(kd1, vf1, acc[dir][1][1]);
        }
    }
#pragma unroll
    for (int dir = 0; dir < 2; ++dir) { float* o = KV + ((size_t)((b * 4 + hd) * 2 + dir) * 66 + n) * 4096;
#pragma unroll
        for (int dt = 0; dt < 2; ++dt)
#pragma unroll
            for (int et = 0; et < 2; ++et)
#pragma unroll
                for (int q = 0; q < 4; ++q) *(f32x4*)(o + (size_t)(et * 32 + li) * 64 + dt * 32 + 8 * q + 4 * h) = (f32x4){acc[dir][dt][et][4 * q], acc[dir][dt][et][4 * q + 1], acc[dir][dt][et][4 * q + 2], acc[dir][dt][et][4 * q + 3]}; }
}
__device__ __forceinline__ void ret_scan_item(const float* decay, const float* KV, bf16* SPREV, int item, int lane) {
    const int blk = item & 63, bhd = item >> 6, dir = bhd & 1, hd = (bhd >> 1) & 3, idx = blk * 64 + lane;
    const float lg = -log2f(1.f + __expf(-decay[dir * 4 + hd])), cd = ex2(128.f * lg);
    const float* src = KV + (size_t)bhd * 66 * 4096 + idx; bf16* dst = SPREV + (size_t)bhd * 66 * 4096 + idx;
    float s = 0.f;
    for (int s0 = 0; s0 < 66; s0 += 11) {
        float v[11];
#pragma unroll
        for (int j = 0; j < 11; ++j) { const int t = s0 + j; const int n = dir == 0 ? (t < 2 ? 64 + t : t - 2) : (t < 2 ? 65 - t : 65 - t); v[j] = src[(size_t)n * 4096]; }
#pragma unroll
        for (int j = 0; j < 11; ++j) { const int t = s0 + j; const int n = dir == 0 ? (t < 2 ? 64 + t : t - 2) : (t < 2 ? 65 - t : 65 - t); dst[(size_t)n * 4096] = (bf16)(pk2(s, 0.f) & 0xffffu); s = cd * s + v[j]; }
    }
}
struct KVTile { u32x4 k[4], v[4]; };
__device__ __forceinline__ void kv_tile_load(KVTile& T, const bf16* Kh  , const bf16* VTh  , int tok0, int lane) {
#pragma unroll
    for (int i = 0; i < 4; ++i) T.k[i] = *(const u32x4*)(Kh + (size_t)(tok0 + 8 * i + (lane >> 3)) * 256 + (lane & 7) * 8);
#pragma unroll
    for (int i = 0; i < 4; ++i) T.v[i] = *(const u32x4*)(VTh + (size_t)(16 * i + (lane >> 2)) * R + tok0 + (lane & 3) * 8);
}
__device__ __forceinline__ void kv_tile_store(const KVTile& T, LAS unsigned char* wl, int lane) {
#pragma unroll
    for (int i = 0; i < 4; ++i) *(LAS u32x4*)(wl + (8 * i + (lane >> 3)) * 144 + (lane & 7) * 16) = T.k[i];
#pragma unroll
    for (int i = 0; i < 4; ++i) *(LAS u32x4*)(wl + 4608 + (16 * i + (lane >> 2)) * 80 + (lane & 3) * 16) = T.v[i];
}
__device__ __forceinline__ void kv_tile_frags(const LAS unsigned char* wl, int lane, bf16x8 (&kf)[4], bf16x8 (&vf)[2][2]) {
    const int li = lane & 31, h = lane >> 5;
#pragma unroll
    for (int s = 0; s < 4; ++s) kf[s] = *(const LAS bf16x8*)(wl + li * 144 + (2 * s + h) * 16);
#pragma unroll
    for (int et = 0; et < 2; ++et)
#pragma unroll
        for (int s2 = 0; s2 < 2; ++s2) { const LAS unsigned char* p = wl + 4608 + (et * 32 + li) * 80 + s2 * 32 + 8 * h;
            const bf16x4 lo = *(const LAS bf16x4*)p, hi = *(const LAS bf16x4*)(p + 16); vf[et][s2] = __builtin_shufflevector(lo, hi, 0, 1, 2, 3, 4, 5, 6, 7); }
}

__device__ __forceinline__ void rope_item(bf16* RQ, bf16* RK, const float* COSN, const float* SINN, int item, int lane) {
    const int u = lane & 15, off = (u >> 2) * 64 + (u & 3) * 8, c8 = (u & 3) * 8;
#pragma unroll 4
    for (int st = 0; st < 32; ++st) { const int row = item * 128 + 4 * st + (lane >> 4), tl = row & (SEQ - 1);
        const f32x4 c0 = *(const f32x4*)(COSN + (size_t)tl * 32 + c8), c1 = *(const f32x4*)(COSN + (size_t)tl * 32 + c8 + 4), s0 = *(const f32x4*)(SINN + (size_t)tl * 32 + c8), s1 = *(const f32x4*)(SINN + (size_t)tl * 32 + c8 + 4);
#pragma unroll
        for (int w = 0; w < 2; ++w) { bf16* p = (w ? RK : RQ) + (size_t)row * 256 + off; float x1[8], x2[8]; unpack8(*(const bf16x8*)p, x1); unpack8(*(const bf16x8*)(p + 32), x2);
#pragma unroll
            for (int j = 0; j < 8; ++j) { const float cc = j < 4 ? c0[j & 3] : c1[j & 3], ss = j < 4 ? s0[j & 3] : s1[j & 3]; const float a = x1[j], bb = x2[j]; x1[j] = a * cc - bb * ss; x2[j] = a * ss + bb * cc; }
            *(bf16x8*)p = pack8(x1); *(bf16x8*)(p + 32) = pack8(x2); } }
}
__device__ __forceinline__ void ret_out_item(const bf16* RQ, const bf16* RK, const bf16* RG, const bf16* RVT, const bf16* SPREV, const float* decay, const float* gn  , bf16* MIX,
                                             LAS unsigned char* wl, int item, int lane) {
    const int qb = item & 3, it2 = item >> 2, n = it2 % 66, bh = it2 / 66, hd = bh & 3, b = bh >> 2, li = lane & 31, h = lane >> 5;
    const int tok0 = ret_tok0(b, n);
    const float lgf = -log2f(1.f + __expf(-decay[hd])), lgr = -log2f(1.f + __expf(-decay[4 + hd]));
    const int iq = qb * 32 + li;
    const bf16* Kh = RK + hd * 64; const bf16* VTh = RVT + (size_t)hd * 64 * R;
    KVTile T; kv_tile_load(T, Kh, VTh, tok0, lane);
    bf16x8 qf[4];
    { const bf16* qp = RQ + (size_t)(tok0 + iq) * 256 + hd * 64 + 8 * h;
#pragma unroll
      for (int s = 0; s < 4; ++s) qf[s] = ldg8(qp + 16 * s); }
    kv_tile_store(T, wl, lane);
    f32x16 accO[2] = {zero16(), zero16()};
#pragma unroll 1
    for (int kt = 0; kt < 4; ++kt) {
        kv_tile_load(T, Kh, VTh, tok0 + (kt < 3 ? kt + 1 : kt) * 32, lane);
        bf16x8 kf[4], vf[2][2]; kv_tile_frags(wl, lane, kf, vf);
        f32x16 st = zero16();
#pragma unroll
        for (int s = 0; s < 4; ++s) st = mma32(kf[s], qf[s], st);
#pragma unroll
        for (int r = 0; r < 16; ++r) { const int j = kt * 32 + DROW(r, h), df = iq - j;
            const float w = df > 0 ? ex2(lgf * (float)df) : (df < 0 ? ex2(lgr * (float)(-df)) : 2.f); st[r] *= w; }
        const bf16x8 p0 = accB<0>(st), p1 = accB<1>(st);
        accO[0] = mma32(vf[0][0], p0, accO[0]); accO[0] = mma32(vf[0][1], p1, accO[0]); accO[1] = mma32(vf[1][0], p0, accO[1]); accO[1] = mma32(vf[1][1], p1, accO[1]);
        kv_tile_store(T, wl, lane);
    }
    const float cf = ex2(lgf * (float)(iq + 1)), cr = ex2(lgr * (float)(128 - iq));
#pragma unroll
    for (int dir = 0; dir < 2; ++dir) { const bf16* sp = SPREV + ((size_t)((b * 4 + hd) * 2 + dir) * 66 + n) * 4096;
#pragma unroll
        for (int et = 0; et < 2; ++et) { f32x16 a = zero16();
#pragma unroll
            for (int s = 0; s < 4; ++s) a = mma32(ldg8(sp + (size_t)(et * 32 + li) * 64 + 16 * s + 8 * h), qf[s], a);
            const float sc = dir == 0 ? cf : cr;
#pragma unroll
            for (int r = 0; r < 16; ++r) accO[et][r] += sc * a[r]; } }
    float s1 = 0.f;
#pragma unroll
    for (int et = 0; et < 2; ++et)
#pragma unroll
        for (int r = 0; r < 16; ++r) s1 += accO[et][r];
    s1 = xor32_sum(s1); const float mu = s1 * (1.f / 64.f);
    float s2 = 0.f;
#pragma unroll
    for (int et = 0; et < 2; ++et)
#pragma unroll
        for (int r = 0; r < 16; ++r) { const float dlt = accO[et][r] - mu; s2 += dlt * dlt; }
    s2 = xor32_sum(s2); const float rstd = __builtin_amdgcn_rsqf(s2 * (1.f / 64.f) + EPSN);
    const size_t tok = (size_t)(tok0 + iq);
#pragma unroll
    for (int et = 0; et < 2; ++et)
#pragma unroll
        for (int q = 0; q < 4; ++q) { const int e0 = hd * 64 + et * 32 + 8 * q + 4 * h;
            const f32x4 gv = *(const f32x4*)(gn + e0); const u32x2 gg = *(const u32x2*)(RG + tok * 256 + e0);
            const float g0 = bflo(gg.x), g1 = bfhi(gg.x), g2 = bflo(gg.y), g3 = bfhi(gg.y);
            u32x2 w; w.x = pk2(silu_(g0) * (accO[et][4 * q] - mu) * rstd * gv[0], silu_(g1) * (accO[et][4 * q + 1] - mu) * rstd * gv[1]);
            w.y = pk2(silu_(g2) * (accO[et][4 * q + 2] - mu) * rstd * gv[2], silu_(g3) * (accO[et][4 * q + 3] - mu) * rstd * gv[3]);
            *(u32x2*)(MIX + tok * 1024 + 512 + e0) = w; }
}

__device__ __forceinline__ int na_tile_tok(int t, int b, int rs) { const int tb = t - 8; return t >= 8 ? b * SEQ + (rs + (tb >> 1)) * 64 + (tb & 1) * 32 : LROWS + b * CTXL + t * 32; }
__device__ __forceinline__ void na_item(const bf16* NQ, const bf16* NK, const bf16* NVT, bf16* MIX, const LAS float* rpb2, LAS unsigned char* wl, bool ctxq, int b, int r, int hd, int qs, int lane) {
    const int li = lane & 31, h = lane >> 5;
    const int tokq = ctxq ? LROWS + b * CTXL + qs * 32 + li : b * SEQ + r * 64 + qs * 32 + li;
    bf16x8 qf[4];
#pragma unroll
    for (int s = 0; s < 4; ++s) qf[s] = ldg8(NQ + (size_t)tokq * 256 + hd * 64 + 16 * s + 8 * h);
    float mrun = -1e30f, lrun = 0.f;
    f32x16 accO[2] = {zero16(), zero16()};
    const int rs = r - 4 < 0 ? 0 : (r - 4 > 120 ? 120 : r - 4);
    const int qc = qs * 32 + li, cs = qc - 8 < 0 ? 0 : (qc - 8 > 48 ? 48 : qc - 8);
    const int ntile = ctxq ? 8 : 24;
    const float c1 = 0.125f * LOG2E;
    const bf16* Kh = NK + hd * 64; const bf16* VTh = NVT + (size_t)hd * 64 * R;
    KVTile T; kv_tile_load(T, Kh, VTh, na_tile_tok(0, b, rs), lane); kv_tile_store(T, wl, lane);
#pragma unroll 1
    for (int t = 0; t < ntile; ++t) {
        const bool band = t >= 8; const int tb = t - 8, rr = rs + (tb >> 1), ct = tb & 1;
        kv_tile_load(T, Kh, VTh, na_tile_tok(t + 1 < ntile ? t + 1 : t, b, rs), lane);
        bf16x8 kf[4], vf[2][2]; kv_tile_frags(wl, lane, kf, vf);
        f32x16 st = zero16();
#pragma unroll
        for (int s = 0; s < 4; ++s) st = mma32(kf[s], qf[s], st);
        float mt = -INFINITY;
        if (band) { const int dr = rr - r + 7; const LAS float* bp = rpb2 + ((hd * 15 + dr) * 31 + 32 * ct - qc + 15 + 4 * h); const int d0 = 32 * ct + 4 * h - cs;
#pragma unroll
            for (int g = 0; g < 16; ++g) { const int o = 8 * (g >> 2) + (g & 3); const bool inw = (unsigned)(d0 + o) < 16u;
                const float v = inw ? st[g] * c1 + bp[o] : -INFINITY; st[g] = v; mt = fmaxf(mt, v); }
        } else {
#pragma unroll
            for (int g = 0; g < 16; ++g) { const float v = st[g] * c1; st[g] = v; mt = fmaxf(mt, v); }
        }
        mt = xor32_max(mt);
        const float mnew = fmaxf(mrun, mt);
        if (__builtin_amdgcn_ballot_w64(mnew > mrun)) { const float alpha = ex2(mrun - mnew); lrun *= alpha;
#pragma unroll
            for (int et = 0; et < 2; ++et)
#pragma unroll
                for (int g = 0; g < 16; ++g) accO[et][g] *= alpha; }
        mrun = mnew;
        float ps = 0.f;
#pragma unroll
        for (int g = 0; g < 16; ++g) { const float p = ex2(st[g] - mnew); st[g] = p; ps += p; }
        lrun += xor32_sum(ps);
        const bf16x8 p0 = accB<0>(st), p1 = accB<1>(st);
        accO[0] = mma32(vf[0][0], p0, accO[0]); accO[0] = mma32(vf[0][1], p1, accO[0]); accO[1] = mma32(vf[1][0], p0, accO[1]); accO[1] = mma32(vf[1][1], p1, accO[1]);
        kv_tile_store(T, wl, lane);
    }
    const float inv = 1.f / lrun;
#pragma unroll
    for (int et = 0; et < 2; ++et)
#pragma unroll
        for (int q = 0; q < 4; ++q) { u32x2 w; w.x = pk2(accO[et][4 * q] * inv, accO[et][4 * q + 1] * inv); w.y = pk2(accO[et][4 * q + 2] * inv, accO[et][4 * q + 3] * inv);
            *(u32x2*)(MIX + (size_t)tokq * 1024 + 768 + hd * 64 + et * 32 + 8 * q + 4 * h) = w; }
}

__device__ __forceinline__ void fft1_item(const bf16* F, const bf16* W128T, const float* TWC, const float* TWS, bf16* FB, int item, int lane) {
    const int l2 = item & 63, g = (item >> 6) & 3, b = item >> 8, li = lane & 31, h = lane >> 5;
    bf16x8 idf[4];
#pragma unroll
    for (int s = 0; s < 4; ++s) { float v[8];
#pragma unroll
        for (int j = 0; j < 8; ++j) v[j] = (16 * (s & 1) + 8 * h + j == li) ? 1.f : 0.f;
        idf[s] = pack8(v); }
    bf16x8 xb[4][2][2];
#pragma unroll
    for (int lt = 0; lt < 4; ++lt) {
        const bf16* xp = F + (size_t)(b * SEQ + 64 * (lt * 32 + li) + l2) * 256 + g * 64 + 8 * h;
        const bf16x8 x0 = ldg8(xp), x1 = ldg8(xp + 16), x2 = ldg8(xp + 32), x3 = ldg8(xp + 48);
        f32x16 c0 = zero16(), c1 = zero16();
        c0 = mma32(x0, idf[0], c0); c0 = mma32(x1, idf[1], c0);
        c1 = mma32(x2, idf[0], c1); c1 = mma32(x3, idf[1], c1);
        xb[lt][0][0] = accB<0>(c0); xb[lt][0][1] = accB<1>(c0); xb[lt][1][0] = accB<0>(c1); xb[lt][1][1] = accB<1>(c1);
    }
#pragma unroll 1
    for (int kb = 0; kb < 4; ++kb) {
        f32x16 acc[2][2];
#pragma unroll
        for (int ri = 0; ri < 2; ++ri) { acc[ri][0] = zero16(); acc[ri][1] = zero16();
            const bf16* wp = W128T + ((size_t)ri * 128 + kb * 32 + li) * 128 + 4 * h;
#pragma unroll
            for (int lt = 0; lt < 4; ++lt)
#pragma unroll
                for (int s = 0; s < 2; ++s) { const bf16x8 wf = ldg8p(wp + lt * 32 + 16 * s);
                    acc[ri][0] = mma32(wf, xb[lt][0][s], acc[ri][0]); acc[ri][1] = mma32(wf, xb[lt][1][s], acc[ri][1]); } }
#pragma unroll
        for (int q = 0; q < 4; ++q) { const int k1 = kb * 32 + 8 * q + 4 * h;
            const f32x4 tc = *(const f32x4*)(TWC + l2 * 128 + k1), ts = *(const f32x4*)(TWS + l2 * 128 + k1);
#pragma unroll
            for (int j = 0; j < 4; ++j)
#pragma unroll
                for (int ct = 0; ct < 2; ++ct) { const float ar = acc[0][ct][4 * q + j], ai = acc[1][ct][4 * q + j];
                    const float br = ar * tc[j] + ai * ts[j], bi = ai * tc[j] - ar * ts[j];
                    bf16* o = FB + ((((size_t)(b * 4 + g) * 128 + k1 + j) * 2) * 64 + l2) * 64 + ct * 32 + li;
                    o[0] = (bf16)(pk2(br, 0.f) & 0xffffu); o[64 * 64] = (bf16)(pk2(bi, 0.f) & 0xffffu); } }
    }
}
__device__ __forceinline__ void fft2_item(const bf16* FB, const bf16* FCT, const bf16* W64T, bf16* MIX, int item, int lane) {
    const int mh = item & 1, k1 = (item >> 1) & 127, g = (item >> 8) & 3, b = item >> 10, li = lane & 31, h = lane >> 5;
    const bf16* br = FB + (((size_t)(b * 4 + g) * 128 + k1) * 2) * 64 * 64; const bf16* bi = br + 64 * 64;
    const bf16* fc = FCT + (size_t)(mh * 32 + li) * 64 + 8 * h; const bf16* fs = fc + 64 * 64; const bf16* fn = fc + 2 * 64 * 64;
    bf16x8 eb[2][2][2];
#pragma unroll
    for (int lt = 0; lt < 2; ++lt) { f32x16 er = zero16(), ei = zero16();
#pragma unroll
        for (int s = 0; s < 4; ++s) { const bf16x8 ar = ldg8(br + (size_t)(lt * 32 + li) * 64 + 16 * s + 8 * h), ai = ldg8(bi + (size_t)(lt * 32 + li) * 64 + 16 * s + 8 * h);
            const bf16x8 c = ldg8(fc + 16 * s), sn = ldg8(fs + 16 * s), ns = ldg8(fn + 16 * s);
            er = mma32(ar, c, er); er = mma32(ai, sn, er); ei = mma32(ai, c, ei); ei = mma32(ar, ns, ei); }
        eb[lt][0][0] = accB<0>(er); eb[lt][0][1] = accB<1>(er); eb[lt][1][0] = accB<0>(ei); eb[lt][1][1] = accB<1>(ei); }
#pragma unroll
    for (int kt = 0; kt < 2; ++kt) { f32x16 o = zero16();
        const bf16* wc = W64T + (size_t)(kt * 32 + li) * 64 + 4 * h; const bf16* wsn = wc + 64 * 64;
#pragma unroll
        for (int lt = 0; lt < 2; ++lt)
#pragma unroll
            for (int s = 0; s < 2; ++s) { o = mma32(ldg8p(wc + lt * 32 + 16 * s), eb[lt][0][s], o); o = mma32(ldg8p(wsn + lt * 32 + 16 * s), eb[lt][1][s], o); }
#pragma unroll
        for (int rg = 0; rg < 16; ++rg) { const int k2 = kt * 32 + DROW(rg, h);
            MIX[(size_t)(b * SEQ + k1 + 128 * k2) * 1024 + g * 64 + mh * 32 + li] = (bf16)(pk2(o[rg], 0.f) & 0xffffu); } }
}
__device__ __forceinline__ void fftc_item(const bf16* F, const bf16* FCT, const bf16* W256T, bf16* MIX, int item, int lane) {
    const int mh = item & 1, kb = (item >> 1) & 7, g = (item >> 4) & 3, b = item >> 6, li = lane & 31, h = lane >> 5;
    const bf16* fc = FCT + (size_t)(mh * 32 + li) * 64 + 8 * h; const bf16* fn = fc + 2 * 64 * 64;
    const bf16* wc = W256T + (size_t)(kb * 32 + li) * 256 + 4 * h; const bf16* wsn = wc + 256 * 256;
    f32x16 o = zero16();
#pragma unroll 1
    for (int lt = 0; lt < 8; ++lt) { f32x16 zr = zero16(), zi = zero16();
        const bf16* xp = F + (size_t)(LROWS + b * CTXL + lt * 32 + li) * 256 + g * 64 + 8 * h;
#pragma unroll
        for (int s = 0; s < 4; ++s) { const bf16x8 x = ldg8(xp + 16 * s); zr = mma32(x, ldg8(fc + 16 * s), zr); zi = mma32(x, ldg8(fn + 16 * s), zi); }
        o = mma32(ldg8p(wc + lt * 32), accB<0>(zr), o); o = mma32(ldg8p(wc + lt * 32 + 16), accB<1>(zr), o);
        o = mma32(ldg8p(wsn + lt * 32), accB<0>(zi), o); o = mma32(ldg8p(wsn + lt * 32 + 16), accB<1>(zi), o); }
#pragma unroll
    for (int rg = 0; rg < 16; ++rg) { const int k = kb * 32 + DROW(rg, h);
        MIX[(size_t)(LROWS + b * CTXL + k) * 1024 + g * 64 + mh * 32 + li] = (bf16)(pk2(o[rg], 0.f) & 0xffffu); }
}
__device__ __forceinline__ void row_ld_f32(const float* p, int lane, f32x4 (&v)[4]) {
#pragma unroll
    for (int j = 0; j < 4; ++j) v[j] = *(const f32x4*)(p + 256 * j + 4 * lane); }
__device__ __forceinline__ void row_ld_bf16(const bf16* p, int lane, f32x4 (&v)[4]) {
#pragma unroll
    for (int j = 0; j < 4; ++j) { const u32x2 w = *(const u32x2*)(p + 256 * j + 4 * lane); v[j] = (f32x4){bflo(w.x), bfhi(w.x), bflo(w.y), bfhi(w.y)}; } }
__device__ __forceinline__ void row_ld_part(const float* P, int nslice, int r, int lane, f32x4 (&v)[4]) {
#pragma unroll
    for (int j = 0; j < 4; ++j) { const float* p = P + ((size_t)((((r - LROWS) >> 8) * 4 + j) * nslice) * 256 + (r & 255)) * 256 + 4 * lane; f32x4 s = *(const f32x4*)p;
        for (int k = 1; k < nslice; ++k) s = s + *(const f32x4*)(p + (size_t)k * 65536);
        v[j] = s; } }
__device__ __forceinline__ void row_st_f32(float* p, int lane, const f32x4 (&v)[4]) {
#pragma unroll
    for (int j = 0; j < 4; ++j) *(f32x4*)(p + 256 * j + 4 * lane) = v[j]; }
__device__ __forceinline__ void row_st_bf16(bf16* p, int lane, const f32x4 (&v)[4]) {
#pragma unroll
    for (int j = 0; j < 4; ++j) { u32x2 w; w.x = pk2(v[j][0], v[j][1]); w.y = pk2(v[j][2], v[j][3]); *(u32x2*)(p + 256 * j + 4 * lane) = w; } }
__device__ __forceinline__ void row_st_f8(unsigned char* p, int lane, const f32x4 (&v)[4]) {
#pragma unroll
    for (int j = 0; j < 4; ++j) *(unsigned*)(p + 256 * j + 4 * lane) = pk4_f8(v[j][0], v[j][1], v[j][2], v[j][3]); }
__device__ __forceinline__ float row_rstd(const f32x4 (&v)[4]) { float s = 0.f;
#pragma unroll
    for (int j = 0; j < 4; ++j) s += (v[j][0] * v[j][0] + v[j][1] * v[j][1]) + (v[j][2] * v[j][2] + v[j][3] * v[j][3]);
    return __builtin_amdgcn_rsqf(wave_sum(s) * (1.f / 1024.f) + EPSN); }
__device__ __forceinline__ void row_modnorm(const f32x4 (&x)[4], const float* g, const float* sc, const float* sh, int lane, f32x4 (&hh)[4]) {
    const float rs = row_rstd(x); f32x4 gv[4], scv[4], shv[4]; row_ld_f32(g, lane, gv); row_ld_f32(sc, lane, scv); row_ld_f32(sh, lane, shv);
#pragma unroll
    for (int j = 0; j < 4; ++j) hh[j] = x[j] * rs * gv[j] * (scv[j] + 1.f) + shv[j]; }
__device__ __forceinline__ void row_resid(f32x4 (&x)[4], const f32x4 (&t)[4], const float* g, const float* gate, int lane) {
    const float rs = row_rstd(t); f32x4 gv[4], ga[4]; row_ld_f32(g, lane, gv); row_ld_f32(gate, lane, ga);
#pragma unroll
    for (int j = 0; j < 4; ++j) x[j] = x[j] + ga[j] * (t[j] * rs * gv[j]); }

struct NormCfg {
    const float* xin_lat; const float* xin_ctx;
    float* xout_lat; float* xout_ctx;
    const bf16* trow;
    const float* tpart; int npart;
    const float* gA; const float* modA; int gate_off;
    const float* gB; const float* modB; int sc_off, sh_off; bf16* hout;
    int nrows;
    unsigned char* hout8;
    const bf16* xin_b; bf16* xout_b;
};
__device__ __forceinline__ void row_ld_raw16(const bf16* p, int lane, u32x2 (&w)[4]) {
#pragma unroll
    for (int j = 0; j < 4; ++j) w[j] = *(const u32x2*)(p + 256 * j + 4 * lane); }
__device__ __forceinline__ void norm_rows(const NormCfg& C, int wslot, int NW, int lane) {
    const int nlat = C.nrows < LROWS ? C.nrows : LROWS;
    int r = wslot;
    if (r < nlat) {
        int cur = -1; f32x4 gav[4], scv[4], shv[4];
        f32x4 xn[4]; u32x2 tn[4], xb[4];
#pragma unroll
        for (int j = 0; j < 4; ++j) { tn[j] = (u32x2){0u, 0u}; xb[j] = (u32x2){0u, 0u}; xn[j] = gav[j] = scv[j] = shv[j] = (f32x4){0.f, 0.f, 0.f, 0.f}; }
        f32x4 gAv[4], gBv[4];
#pragma unroll
        for (int j = 0; j < 4; ++j) gAv[j] = gBv[j] = (f32x4){0.f, 0.f, 0.f, 0.f};
        if (C.trow) row_ld_f32(C.gA, lane, gAv);
        if (C.gB) row_ld_f32(C.gB, lane, gBv);
        if (C.xin_b) row_ld_raw16(C.xin_b + (size_t)r * D, lane, xb); else row_ld_f32(C.xin_lat + (size_t)r * D, lane, xn);
        if (C.trow) {
#pragma unroll
            for (int j = 0; j < 4; ++j) tn[j] = *(const u32x2*)(C.trow + (size_t)r * D + 256 * j + 4 * lane); }
        for (; r < nlat; r += NW) {
            f32x4 x[4]; u32x2 tr[4];
#pragma unroll
            for (int j = 0; j < 4; ++j) { x[j] = C.xin_b ? (f32x4){bflo(xb[j].x), bfhi(xb[j].x), bflo(xb[j].y), bfhi(xb[j].y)} : xn[j]; tr[j] = tn[j]; }
            const int r2 = r + NW;
            if (r2 < nlat) { if (C.xin_b) row_ld_raw16(C.xin_b + (size_t)r2 * D, lane, xb); else row_ld_f32(C.xin_lat + (size_t)r2 * D, lane, xn);
                if (C.trow) {
#pragma unroll
                    for (int j = 0; j < 4; ++j) tn[j] = *(const u32x2*)(C.trow + (size_t)r2 * D + 256 * j + 4 * lane); } }
            const int ci = r < SEQ ? 0 : 1;
            if (ci != cur) { cur = ci;
                if (C.trow) row_ld_f32(C.modA + (size_t)ci * 6144 + C.gate_off, lane, gav);
                if (C.gB) { row_ld_f32(C.modB + (size_t)ci * 6144 + C.sc_off, lane, scv); row_ld_f32(C.modB + (size_t)ci * 6144 + C.sh_off, lane, shv); } }
            if (C.trow) { f32x4 t[4];
#pragma unroll
                for (int j = 0; j < 4; ++j) t[j] = (f32x4){bflo(tr[j].x), bfhi(tr[j].x), bflo(tr[j].y), bfhi(tr[j].y)};
                const float rs = row_rstd(t);
#pragma unroll
                for (int j = 0; j < 4; ++j) x[j] = x[j] + gav[j] * (t[j] * rs * gAv[j]);
                if (C.xout_b) row_st_bf16(C.xout_b + (size_t)r * D, lane, x); else row_st_f32(C.xout_lat + (size_t)r * D, lane, x); }
            if (C.gB) { const float rs = row_rstd(x); f32x4 hh[4];
#pragma unroll
                for (int j = 0; j < 4; ++j) hh[j] = x[j] * rs * gBv[j] * (scv[j] + 1.f) + shv[j];
                row_st_bf16(C.hout + (size_t)r * D, lane, hh); if (C.hout8) row_st_f8(C.hout8 + (size_t)r * D, lane, hh); }
        }
    }
    for (r = LROWS + wslot; r < C.nrows; r += NW) {
        f32x4 x[4]; row_ld_f32(C.xin_ctx + (size_t)(r - LROWS) * D, lane, x);
        if (C.trow) { f32x4 t[4]; if (C.tpart) row_ld_part(C.tpart, C.npart, r, lane, t); else row_ld_bf16(C.trow + (size_t)r * D, lane, t);
            row_resid(x, t, C.gA, C.modA + (size_t)2 * 6144 + C.gate_off, lane); row_st_f32(C.xout_ctx + (size_t)(r - LROWS) * D, lane, x); }
        if (C.gB) { f32x4 hh[4]; row_modnorm(x, C.gB, C.modB + (size_t)2 * 6144 + C.sc_off, C.modB + (size_t)2 * 6144 + C.sh_off, lane, hh); row_st_bf16(C.hout + (size_t)r * D, lane, hh); if (C.hout8) row_st_f8(C.hout8 + (size_t)r * D, lane, hh); }
    }
}

__device__ __forceinline__ void transpose_item(const float* W, int ldw, int k0, int n0, bf16* dst, int ldd, float scale, LAS float* scr, int lane) {
#pragma unroll 8
    for (int i = 0; i < 32; ++i) { const int kk = 2 * i + (lane >> 5); scr[kk * 33 + (lane & 31)] = W[(size_t)(k0 + kk) * ldw + n0 + (lane & 31)]; }
    LDS_WAIT(); asm volatile("" ::: "memory");
    const int c = lane & 7;
#pragma unroll
    for (int j = 0; j < 4; ++j) { const int n = (lane >> 3) + 8 * j; const LAS float* s = scr + (8 * c) * 33 + n;
        u32x4 o; o.x = pk2(s[0 * 33] * scale, s[1 * 33] * scale); o.y = pk2(s[2 * 33] * scale, s[3 * 33] * scale); o.z = pk2(s[4 * 33] * scale, s[5 * 33] * scale); o.w = pk2(s[6 * 33] * scale, s[7 * 33] * scale);
        *(u32x4*)(dst + (size_t)n * ldd + k0 + 8 * c) = o; }
    LDS_WAIT(); asm volatile("" ::: "memory");
}
#ifndef MK_MODE
#define MK_MODE 1
#endif
#ifndef MK_LAST
#define MK_LAST 24
#endif
constexpr int NPHASE = 24;
struct Args { const float* in[31]; float* out; unsigned char* ws; int ph_lo, ph_hi, li, pad; };


struct TrJob { const float* src; unsigned char* dst; int ldw, k0, n0, ldd, esz; float scale; };
#define CAS __attribute__((address_space(4)))
constexpr float MOE_W1S = 32.f, MOE_W2S = 64.f, MOE_HS = 2.f, WIN_S = 32.f;
constexpr int NTR = 60096, NTRQ = NTR / 8;
__device__ __forceinline__ void tr_decode(int it, const CAS Args* ap_, unsigned char* ws, TrJob& J) {
#define TIN(k) ((const float*)(const GAS float*)ap_->in[k])
    int kb; J.scale = 1.f; J.esz = 2;
    if (it < 43008) { const int e = it / 5376, r = it % 5376, w = r / 1792, li = r % 1792; J.esz = 1;
        if (w < 2) { J.src = TIN(28 + w) + (size_t)e * 1024 * DFE; J.ldw = DFE; kb = li / 112; J.n0 = (li % 112) * 32; J.ldd = 1024; J.scale = MOE_W1S;
            J.dst = ws + WS_MOE1 + ((size_t)e * 7168 + 256 * (J.n0 / 128) + (J.n0 % 128) + 128 * w) * 1024; }
        else { J.src = TIN(30) + (size_t)e * DFE * 1024; J.ldw = 1024; kb = li / 32; J.n0 = (li % 32) * 32; J.ldd = DFE; J.scale = MOE_W2S; J.dst = ws + WS_MOE2 + ((size_t)e * 1024 + J.n0) * DFE; }
    } else if (it < 47232) { const int r = it - 43008, w = r / 1408, li = r % 1408;
        if (w < 2) { J.src = TIN(23 + w); J.ldw = DFF; kb = li / 88; J.n0 = (li % 88) * 32; J.ldd = 1024; J.dst = ws + WS_FFN1 + (size_t)(256 * (J.n0 / 128) + (J.n0 % 128) + 128 * w) * 1024 * 2; }
        else { J.src = TIN(25); J.ldw = 1024; kb = li / 32; J.n0 = (li % 32) * 32; J.ldd = DFF; J.dst = ws + WS_FFN2 + (size_t)J.n0 * DFF * 2; }
    } else if (it >= 56000) { const int r = it - 56000, l = r / 2048, q = r % 2048; kb = q / 128; const int nb = q % 128; J.esz = 1; J.scale = WIN_S;
        J.src = TIN(7) + (size_t)l * 1024 * 6400; J.ldw = 6400; J.n0 = 2304 + 32 * nb; J.ldd = 1024; J.dst = ws + WS_WG8 + ((size_t)l * 4096 + 32 * nb) * 1024;
    } else { const int r = it - 47232, l = r / 4384, q = r % 4384;
        if (q < 3328) { const int t = q / 128, li = q % 128; kb = li / 8; const int nb = li % 8; if (l == 1 && t >= 7 && t < 23) J.esz = 0;
            const int srcc = t < 4 ? 256 * t : (t < 7 ? 256 * (t + 1) : (t < 23 ? 2304 + 256 * (t - 7) : (t == 23 ? 768 : (t == 24 ? 1024 : 2048))));
            J.src = TIN(7) + (size_t)l * 1024 * 6400; J.ldw = 6400; J.n0 = srcc + 32 * nb; J.ldd = 1024; J.dst = ws + WS_WIN + ((size_t)(l * 26 + t) * 256 + 32 * nb) * 1024 * 2; J.scale = (t == 3 || t == 23) ? 0.125f : 1.f; }
        else if (q < 3360) { const int li = q - 3328; kb = li / 8; J.n0 = (li % 8) * 32; J.src = TIN(16) + (size_t)l * 65536; J.ldw = 256; J.ldd = 256; J.dst = ws + WS_WGLU + ((size_t)l * 256 + J.n0) * 256 * 2; }
        else if (q < 3872) { const int li = q - 3360, bb = li / 128, li2 = li % 128; kb = li2 / 32; J.n0 = (li2 % 32) * 32; J.src = TIN(21) + (size_t)(l * 4 + bb) * 256 * 1024; J.ldw = 1024; J.ldd = 1024; J.dst = ws + WS_WBR + (((size_t)l * 1024 + J.n0) * 1024 + bb * 256) * 2; }
        else { const int li = q - 3872; kb = li / 32; J.n0 = (li % 32) * 32; J.src = TIN(22) + (size_t)l * 1024 * 1024; J.ldw = 1024; J.ldd = 1024; J.dst = ws + WS_WOUT + ((size_t)l * 1024 + J.n0) * 1024 * 2; }
    }
    J.k0 = kb * 64;
#undef TIN
}
__device__ __forceinline__ void tr_load(const TrJob& J, int lane, float (&v)[32]) {
    if (J.esz == 0) return;
#pragma unroll
    for (int i = 0; i < 32; ++i) { const int kk = 2 * i + (lane >> 5); v[i] = J.src[(size_t)(J.k0 + kk) * J.ldw + J.n0 + (lane & 31)]; } }
__device__ __forceinline__ void tr_store(const TrJob& J, int lane, const float (&v)[32], LAS float* scr) {
    if (J.esz == 0) return;
#pragma unroll
    for (int i = 0; i < 32; ++i) { const int kk = 2 * i + (lane >> 5); scr[kk * 33 + (lane & 31)] = v[i]; }
    LDS_WAIT(); asm volatile("" ::: "memory");
    const int c = lane & 7;
#pragma unroll
    for (int j = 0; j < 4; ++j) { const int n = (lane >> 3) + 8 * j; const LAS float* s = scr + (8 * c) * 33 + n; const float sc = J.scale;
        if (J.esz == 2) { u32x4 o; o.x = pk2(s[0 * 33] * sc, s[1 * 33] * sc); o.y = pk2(s[2 * 33] * sc, s[3 * 33] * sc); o.z = pk2(s[4 * 33] * sc, s[5 * 33] * sc); o.w = pk2(s[6 * 33] * sc, s[7 * 33] * sc);
            *(u32x4*)(J.dst + ((size_t)n * J.ldd + J.k0 + 8 * c) * 2) = o; }
        else { u32x2 o; o.x = pk4_f8(s[0 * 33] * sc, s[1 * 33] * sc, s[2 * 33] * sc, s[3 * 33] * sc); o.y = pk4_f8(s[4 * 33] * sc, s[5 * 33] * sc, s[6 * 33] * sc, s[7 * 33] * sc);
            *(u32x2*)(J.dst + (size_t)n * J.ldd + J.k0 + 8 * c) = o; } }
    LDS_WAIT(); asm volatile("" ::: "memory");
}

__device__ __forceinline__ void cs2pi(int m, int N, float& c, float& s) { sincospif(2.0f * (float)(m % N) / (float)N, &s, &c); }

__global__ void __launch_bounds__(NTHREADS, 2) mk_fwd(Args args) {
    extern __shared__ __attribute__((aligned(16))) unsigned char lds_raw[];
    LAS unsigned char* lds = (LAS unsigned char*)lds_raw;
    const int tid0 = threadIdx.x, wave = __builtin_amdgcn_readfirstlane(tid0 >> 6);
    const int G = gridDim.x, bx = blockIdx.x, vcu = (G % 8 == 0) ? (bx % 8) * (G / 8) + bx / 8 : bx;
    const int wslot = wave * G + vcu, NW = G * NWAVES;
    volatile LAS unsigned* lctl = (volatile LAS unsigned*)(lds + LDSCTL_OFF);
    for (int u = tid0; u < (LDS_BYTES - LDSCTL_OFF) / 4; u += NTHREADS) lctl[u] = 0u;
    __syncthreads();
    const int lo = args.ph_lo, hi = args.ph_hi, bli = args.li;
#ifdef MK_STAMP_PHASE
    if (wave == 0) *(volatile LAS unsigned long long*)(lctl + 64) = __builtin_amdgcn_s_memrealtime();
#endif
    { XcdBarrier b0 = xcd_barrier_post((unsigned*)(args.ws + WS_CTL) + CW_BAR + bli * XCD_BAR_WORDS, lctl + LW_BAR); (void)b0; }
#define IN(k) (lo <= (k) && (k) < hi)
#ifndef MK_DBL
#define MK_DBL 0
#endif
#define MK_NR(k) (MK_DBL == (k) ? 2 : 1)
#ifndef MK_REP_MASK
#define MK_REP_MASK 0u
#endif
#define NREP(k) (((MK_REP_MASK >> (k)) & 1u) ? 2 : 1)
#define FORCE_BAR do { PH_BEGIN XcdBarrier b_; b_.bar = (unsigned*)(ws + WS_CTL) + CW_BAR + bli * XCD_BAR_WORDS; b_.x = xb_xcc_id(); b_.st = lctl + LW_BAR; xcd_barrier(b_); } while (0)
#ifdef MK_STAMP_PHASE
#define STAMP_AT(k) do { if (wave == 0) { if ((k) == MK_STAMP_PHASE - 1) *(volatile LAS unsigned long long*)(lctl + 64) = __builtin_amdgcn_s_memrealtime(); if ((k) == MK_STAMP_PHASE) *(volatile LAS unsigned long long*)(lctl + 66) = __builtin_amdgcn_s_memrealtime(); } } while (0)
#else
#define STAMP_AT(k) do { } while (0)
#endif
#define SEAM(k) do { if (IN(k) && IN((k) + 1)) { PH_BEGIN XcdBarrier b_; b_.bar = (unsigned*)(ws + WS_CTL) + CW_BAR + bli * XCD_BAR_WORDS; b_.x = xb_xcc_id(); b_.st = lctl + LW_BAR; xcd_barrier(b_); } STAMP_AT(k); } while (0)
#define PH_BEGIN int tid; { int l_; asm volatile("v_mbcnt_lo_u32_b32 %0, -1, 0\n\tv_mbcnt_hi_u32_b32 %0, -1, %0" : "=v"(l_)); tid = wave * 64 + (l_ & 63); } const CAS Args* ap_ = (const CAS Args*)__builtin_amdgcn_kernarg_segment_ptr(); asm volatile("" : "+s"(ap_)); unsigned char* ws = (unsigned char*)(GAS unsigned char*)ap_->ws; const int lane = tid & 63; (void)lane;
#define AIN(k) ((const float*)(const GAS float*)ap_->in[k])
#define AOUT ((float*)(GAS float*)ap_->out)
#define XB ((bf16*)(ws + WS_XB))
#define MODp ((float*)(ws + CTL_MOD_OFF))
#define ctxbuf ((float*)(ws + WS_CTXBUF))
#define Hh ((bf16*)(ws + WS_H))
#define MIX ((bf16*)(ws + WS_MIX))
#define INP ((bf16*)(ws + WS_INP))
#define Tt ((bf16*)(ws + WS_T))

    for (int rep_ = 0; rep_ < NREP(0); ++rep_) if (IN(0)) { if (rep_) { FORCE_BAR; } PH_BEGIN
        for (int dd_ = 0; dd_ < MK_NR(20); ++dd_) for (int it = bx; it < 32; it += G) {
            const int l = it >> 4, g = it & 15;
            LAS f32x2* apow = (LAS f32x2*)lds; LAS f32x2* bbar = (LAS f32x2*)(lds + 8704); LAS f32x2* Cc = (LAS f32x2*)(lds + 16896); LAS float* Kt = (LAS float*)(lds + 25088);
            for (int dir = 0; dir < 2; ++dir) { const size_t pg = (size_t)(l * 2 + dir) * 16 + g;
                if (tid < 64) { const int p = tid;
                    const float are = AIN(8)[pg * 64 + p], aim = AIN(9)[pg * 64 + p], dt = expf(AIN(10)[pg]);
                    for (int t = 0; t <= 16; ++t) { const float mag = expf(are * dt * (float)t); float sn, cs; sincosf(aim * dt * (float)t, &sn, &cs); apow[t * 64 + p] = (f32x2){mag * cs, mag * sn}; }
                    const f32x2 a = apow[64 + p]; const float nr = a.x - 1.f, ni = a.y, den = 1.f / (are * are + aim * aim);
                    const float cr = (nr * are + ni * aim) * den, ci = (ni * are - nr * aim) * den;
                    for (int h = 0; h < 16; ++h) { const float br = AIN(11)[(pg * 64 + p) * 16 + h], bi = AIN(12)[(pg * 64 + p) * 16 + h]; bbar[p * 16 + h] = (f32x2){cr * br - ci * bi, cr * bi + ci * br}; }
                    *(f32x2*)((float*)(ws + WS_A16) + (pg * 64 + p) * 2) = apow[16 * 64 + p];
                }
                for (int i = tid; i < 1024; i += NTHREADS) Cc[i] = (f32x2){AIN(13)[pg * 1024 + i], AIN(14)[pg * 1024 + i]};
                __syncthreads();
                bf16* M1 = (bf16*)(ws + WS_S5M1) + ((size_t)(l * 16 + g) * 2 + dir) * 128 * 256;
                for (int v = tid; v < 4096; v += NTHREADS) { const int row = v >> 5, col0 = (v & 31) * 8, j = col0 >> 4, h0 = col0 & 15, p = row >> 1, ri = row & 1;
                    const f32x2 pw = apow[(dir == 0 ? 15 - j : j) * 64 + p]; float vals[8];
#pragma unroll
                    for (int hh = 0; hh < 8; ++hh) { const f32x2 bb = bbar[p * 16 + h0 + hh]; vals[hh] = ri ? pw.x * bb.y + pw.y * bb.x : pw.x * bb.x - pw.y * bb.y; }
                    *(bf16x8*)(M1 + ((((col0 >> 4) * 4 + (row >> 5)) * 64 + ((col0 >> 3) & 1) * 32 + (row & 31)) * 8)) = pack8(vals); }
                bf16* TAB = (bf16*)(ws + WS_S5TAB) + (size_t)(l * 16 + g) * 256 * 512;
                for (int v = tid; v < 4096; v += NTHREADS) { const int row = v >> 4, cv = v & 15, i = row >> 4, ho = row & 15; float vals[8];
#pragma unroll
                    for (int pp = 0; pp < 4; ++pp) { const int p = cv * 4 + pp; const f32x2 cc = Cc[ho * 64 + p];
                        const f32x2 pw = apow[(dir == 0 ? i + 1 : 16 - i) * 64 + p]; vals[2 * pp] = cc.x * pw.x - cc.y * pw.y; vals[2 * pp + 1] = -(cc.x * pw.y + cc.y * pw.x); }
                    { const int colt = 256 + dir * 128 + cv * 8; *(bf16x8*)(TAB + (((((row >> 7) * 32 + (colt >> 4)) * 4 + ((row >> 5) & 3)) * 64 + ((colt >> 3) & 1) * 32 + (row & 31)) * 8)) = pack8(vals); } }
                for (int e = tid; e < 4096; e += NTHREADS) { const int t = e >> 8, ho = (e >> 4) & 15, h = e & 15; float acc = 0.f;
#pragma unroll 8
                    for (int p = 0; p < 64; ++p) { const f32x2 cc = Cc[ho * 64 + p], pw = apow[t * 64 + p], bb = bbar[p * 16 + h];
                        const float xr = cc.x * pw.x - cc.y * pw.y, xi = cc.x * pw.y + cc.y * pw.x; acc += xr * bb.x - xi * bb.y; }
                    Kt[dir * 4096 + e] = acc; }
                __syncthreads();
            }
            for (int v = tid; v < 8192; v += NTHREADS) { const int row = v >> 5, col0 = (v & 31) * 8, i = row >> 4, ho = row & 15, j = col0 >> 4, h0 = col0 & 15; float vals[8];
#pragma unroll
                for (int hh = 0; hh < 8; ++hh) { const int h = h0 + hh;
                    vals[hh] = j < i ? Kt[(i - j) * 256 + ho * 16 + h] : (j > i ? Kt[4096 + (j - i) * 256 + ho * 16 + h] : Kt[ho * 16 + h] + Kt[4096 + ho * 16 + h] + (ho == h ? AIN(15)[l * 256 + g * 16 + h] : 0.f)); }
                *(bf16x8*)((bf16*)(ws + WS_S5TAB) + (size_t)(l * 16 + g) * 256 * 512 + (((((row >> 7) * 32 + (col0 >> 4)) * 4 + ((row >> 5) & 3)) * 64 + ((col0 >> 3) & 1) * 32 + (row & 31)) * 8)) = pack8(vals); }
            __syncthreads();
        }
        __syncthreads();
        for (int it = (bx >= 32 ? bx - 32 : bx + G - 32); it < 192; it += G) { const int l = it / 96, cb = it % 96, col = cb * 64 + lane, ks = wave;
            const float* wm = AIN(4) + ((size_t)l * 1024 + ks * 128) * 6144 + col; float a0 = 0.f, a1 = 0.f, a2 = 0.f;
#pragma unroll 8
            for (int k = 0; k < 128; ++k) { const float w = wm[(size_t)k * 6144]; const int kk = ks * 128 + k;
                const float c0 = AIN(1)[kk], c1 = AIN(1)[1024 + kk], c2 = AIN(3)[kk];
                a0 += w * (c0 / (1.f + __expf(-c0))); a1 += w * (c1 / (1.f + __expf(-c1))); a2 += w * (c2 / (1.f + __expf(-c2))); }
            LAS float* part = (LAS float*)lds;
            part[(wave * 3 + 0) * 64 + lane] = a0; part[(wave * 3 + 1) * 64 + lane] = a1; part[(wave * 3 + 2) * 64 + lane] = a2;
            __syncthreads();
            if (tid < 192) { const int i = tid >> 6, c = tid & 63; float sacc = AIN(5)[l * 6144 + cb * 64 + c];
#pragma unroll
                for (int w = 0; w < 8; ++w) sacc += part[(w * 3 + i) * 64 + c];
                MODp[(size_t)(l * 3 + i) * 6144 + cb * 64 + c] = sacc; }
            __syncthreads();
        }
        { LAS float* scr = (LAS float*)(lds + wave * 16384);
          unsigned* qh = (unsigned*)(ws + WS_CTL) + CW_QHEAD;
          int q = bx & 7, tries = 0;
#define TR_POP(dst) do { dst = -1; while (tries < 8) { unsigned b_ = 0u; if (lane == 0) b_ = __hip_atomic_fetch_add(qh + 64 * q, 2u, __ATOMIC_RELAXED, __HIP_MEMORY_SCOPE_AGENT); \
              b_ = (unsigned)__builtin_amdgcn_readfirstlane((int)b_); if (b_ < (unsigned)NTRQ) { dst = q * NTRQ + (int)b_; break; } q = (q + 1) & 7; ++tries; } } while (0)
#define TR_LOAD2(VA, VB, g_) do { TrJob j_; tr_decode(g_, ap_, ws, j_); tr_load(j_, lane, VA); tr_decode((g_) + (((g_) % NTRQ) + 1 < NTRQ ? 1 : 0), ap_, ws, j_); tr_load(j_, lane, VB); } while (0)
#define TR_STORE2(VA, VB, g_) do { TrJob j_; tr_decode(g_, ap_, ws, j_); tr_store(j_, lane, VA, scr); if (((g_) % NTRQ) + 1 < NTRQ) { tr_decode((g_) + 1, ap_, ws, j_); tr_store(j_, lane, VB, scr); } } while (0)
          float a0[32], a1[32], b0[32], b1[32]; int s0, s1;
          TR_POP(s0); if (s0 >= 0) TR_LOAD2(a0, a1, s0);
          TR_POP(s1);
          while (s0 >= 0) {
              int s2, s3 = -1;
              if (s1 >= 0) TR_LOAD2(b0, b1, s1);
              TR_POP(s2);
              TR_STORE2(a0, a1, s0);
              if (s1 < 0) break;
              if (s2 >= 0) TR_LOAD2(a0, a1, s2);
              TR_POP(s3);
              TR_STORE2(b0, b1, s1);
              s0 = s2; s1 = s3;
          }
#undef TR_POP
#undef TR_LOAD2
#undef TR_STORE2
        }
        for (int v = wslot * 64 + lane; v < 32 * SEQ; v += NW * 64) { const int p = v >> 13, t = v & 8191; const float pos = (float)(p < 16 ? (t >> 6) : (t & 63));
            const float inv = 1.0f / powf(10000.f, (float)(p & 15) / 16.f); float sn, cs; sincosf(pos * inv, &sn, &cs);
            ((float*)(ws + WS_COST))[v] = cs; ((float*)(ws + WS_SINT))[v] = sn; ((float*)(ws + WS_COSN))[t * 32 + p] = cs; ((float*)(ws + WS_SINN))[t * 32 + p] = sn; }
        for (int v = wslot * 64 + lane; v < 192512; v += NW * 64) { float c, s;
            if (v < 32768) { const int ri = v >> 14, k1 = (v >> 7) & 127, l1 = v & 127; cs2pi(k1 * l1, 128, c, s); const float sc = 0.08838834764831845f;
                ((bf16*)(ws + WS_W128T))[v] = (bf16)(pk2(ri ? -s * sc : c * sc, 0.f) & 0xffffu); }
            else if (v < 40960) { const int u = v - 32768, l2 = u >> 7, k1 = u & 127; cs2pi(k1 * l2, 8192, c, s); ((float*)(ws + WS_TWC))[u] = c; ((float*)(ws + WS_TWS))[u] = s; }
            else if (v < 53248) { const int u = v - 40960, w = u >> 12, m = (u >> 6) & 63, cc = u & 63; cs2pi(m * cc, 64, c, s);
                ((bf16*)(ws + WS_FCT))[u] = (bf16)(pk2((w == 0 ? c : (w == 1 ? s : -s)) * 0.125f, 0.f) & 0xffffu); }
            else if (v < 61440) { const int u = v - 53248, w = u >> 12, k2 = (u >> 6) & 63, l2 = u & 63; cs2pi(k2 * l2, 64, c, s); ((bf16*)(ws + WS_W64T))[u] = (bf16)(pk2((w == 0 ? c : s) * 0.125f, 0.f) & 0xffffu); }
            else { const int u = v - 61440, w = u >> 16, k = (u >> 8) & 255, l = u & 255; cs2pi(k * l, 256, c, s); ((bf16*)(ws + WS_W256T))[u] = (bf16)(pk2((w == 0 ? c : s) * 0.0625f, 0.f) & 0xffffu); }
        }
    }
    SEAM(0);

    for (int rep_ = 0; rep_ < NREP(1); ++rep_) if (IN(1)) { if (rep_) { FORCE_BAR; } PH_BEGIN
        { NormCfg C{AIN(0), AIN(2), nullptr, nullptr, nullptr, nullptr, 0, nullptr, nullptr, 0, AIN(6), MODp, 1024, 0, Hh, R, ws + WS_H8, nullptr, nullptr}; norm_rows(C, wslot, NW, lane); }
    }
    SEAM(1);

    for (int layer = 0; layer < 2; ++layer) {
        const int pb = 1 + 11 * layer;
        const int nM = layer == 0 ? 66 : 64;
        const int nrows = layer == 0 ? R : LROWS;
#define normg (AIN(6) + (size_t)layer * 4 * D)
        for (int rep_ = 0; rep_ < NREP(pb + 1); ++rep_) if (IN(pb + 1)) { if (rep_) { FORCE_BAR; } PH_BEGIN
            gp::SchedInprojA S{(const char*)Hh, (const char*)(ws + WS_WIN) + (size_t)layer * 26 * 256 * 2048, 66, G, bx, layer == 0 ? 32 : 0};
            gp::EpiInprojA E{INP, Tt, (unsigned char*)(ws + WS_GCTX)};
            gp::gemm_phase(lds, tid, 1024, 1024, 1024, S, E);
        }
        SEAM(pb + 1);
        for (int rep_ = 0; rep_ < NREP(pb + 2); ++rep_) if (IN(pb + 2)) { if (rep_) { FORCE_BAR; } PH_BEGIN
            LAS float* rpb = (LAS float*)(lds + 98304 + 4096);
            LAS unsigned char* wl = lds + wave * 12288;
            for (int i = tid; i < 1860; i += NTHREADS) rpb[i] = AIN(20)[layer * 1860 + i] * LOG2E;
            __syncthreads();
            const int nitA = 2224 + 64 + (layer == 0 ? 64 : 0);
            for (int it = wslot; it < nitA; it += NW) {
                if (it < 1056) s5_state_item((const bf16*)(ws + WS_S5M1) + (size_t)layer * 16 * 2 * 128 * 256, INP + (size_t)R * 256, (float*)(ws + WS_HLOC), it, lane);
                else if (it < 1584) ret_kv_item(Tt, Tt + (size_t)256 * R, (const float*)(ws + WS_COST), (const float*)(ws + WS_SINT), AIN(18) + layer * 8, (float*)(ws + WS_KV), it - 1056, lane);
                else if (it < 2096) fft1_item(INP, (const bf16*)(ws + WS_W128T), (const float*)(ws + WS_TWC), (const float*)(ws + WS_TWS), (bf16*)(ws + WS_FB), it - 1584, lane);
                else if (it < 2224) rope_item(INP + (size_t)2 * R * 256, INP + (size_t)3 * R * 256, (const float*)(ws + WS_COSN), (const float*)(ws + WS_SINN), it - 2096, lane);
                else if (it < 2288) { const int j = 1984 + (it - 2224); na_item(INP + (size_t)5 * R * 256, INP + (size_t)6 * R * 256, Tt + (size_t)512 * R, MIX, rpb, wl, false, j >> 10, (j >> 3) & 127, (j >> 1) & 3, j & 1, lane); }
                else { const int j = it - 2288; na_item(INP + (size_t)5 * R * 256, INP + (size_t)6 * R * 256, Tt + (size_t)512 * R, MIX, rpb, wl, true, j >> 5, 0, (j >> 3) & 3, j & 7, lane); }
            }
            __syncthreads();
        }
        SEAM(pb + 2);
        for (int rep_ = 0; rep_ < NREP(pb + 3); ++rep_) if (IN(pb + 3)) { if (rep_) { FORCE_BAR; } PH_BEGIN
            LAS float* rpb = (LAS float*)(lds + 98304 + 4096); LAS unsigned char* wl = lds + wave * 12288;
            for (int i = tid; i < 1860; i += NTHREADS) rpb[i] = AIN(20)[layer * 1860 + i] * LOG2E;
            __syncthreads();
            for (int vs = wslot; vs < 2048; vs += NW) {
                if (vs < 64) s5_scan_item((const float*)(ws + WS_A16) + (size_t)layer * 2 * 16 * 64 * 2, (const float*)(ws + WS_HLOC), (bf16*)(ws + WS_HIN), wl, vs, lane);
                else { const int j = vs - 64; na_item(INP + (size_t)5 * R * 256, INP + (size_t)6 * R * 256, Tt + (size_t)512 * R, MIX, rpb, wl, false, j >> 10, (j >> 3) & 127, (j >> 1) & 3, j & 1, lane);
                    if (vs >= 1024) ret_scan_item(AIN(18) + layer * 8, (const float*)(ws + WS_KV), (bf16*)(ws + WS_SPREV), vs - 1024, lane); }
            }
            __syncthreads();
        }
        SEAM(pb + 3);
        for (int rep_ = 0; rep_ < NREP(pb + 4); ++rep_) if (IN(pb + 4)) { if (rep_) { FORCE_BAR; } PH_BEGIN
            const int nit = 1056 + 2112 + 2048 + (layer == 0 ? 128 : 0);
            for (int it = wslot; it < nit; it += NW) {
                if (it < 1056) s5_out_item((const bf16*)(ws + WS_S5TAB) + (size_t)layer * 16 * 256 * 512, INP + (size_t)R * 256, (const bf16*)(ws + WS_HIN), (bf16*)(ws + WS_Z), it, lane);
                else if (it < 3168) ret_out_item(INP + (size_t)2 * R * 256, INP + (size_t)3 * R * 256, INP + (size_t)4 * R * 256, Tt + (size_t)256 * R, (const bf16*)(ws + WS_SPREV),
                                                 AIN(18) + layer * 8, AIN(19) + layer * 256, MIX, lds + wave * 12288, it - 1056, lane);
                else if (it < 5216) fft2_item((const bf16*)(ws + WS_FB), (const bf16*)(ws + WS_FCT), (const bf16*)(ws + WS_W64T), MIX, it - 3168, lane);
                else fftc_item(INP, (const bf16*)(ws + WS_FCT), (const bf16*)(ws + WS_W256T), MIX, it - 5216, lane);
            }
        }
        SEAM(pb + 4);
        for (int rep_ = 0; rep_ < NREP(pb + 5); ++rep_) if (IN(pb + 5)) { if (rep_) { FORCE_BAR; } PH_BEGIN
            { PH_BEGIN gp::SchedPlain S{(const char*)(ws + WS_Z), (const char*)(ws + WS_WGLU) + (size_t)layer * 256 * 512, (size_t)256 * 512, (size_t)256 * 512, nM, 1, G, bx, 4};
              gp::EpiGlu E{(const bf16*)(ws + WS_Z), MIX, AIN(17) + layer * 256};
              gp::gemm_phase(lds, tid, 256, 256, 256, S, E); }
            { PH_BEGIN gp::SchedPlain S{(const char*)(ws + WS_H8), (const char*)(ws + WS_WG8) + (size_t)layer * 4096 * 1024, (size_t)256 * 1024, (size_t)256 * 1024, 64, 16, G, bx, 8};
              gp::EpiGates E{(unsigned char*)(ws + WS_GATES), 1.f / WIN_S};
              gp::gemm_phase<gp::EpiGates, gp::SchedPlain, true>(lds, tid, 1024, 512, 512, S, E); }
        }
        SEAM(pb + 5);
        for (int rep_ = 0; rep_ < NREP(pb + 6); ++rep_) if (IN(pb + 6)) { if (rep_) { FORCE_BAR; } PH_BEGIN
            gp::SchedMerge S{(const char*)MIX, (const char*)(ws + WS_WBR) + (size_t)layer * 1024 * 2048, layer == 0 ? 32 : 0, G, bx};
            gp::EpiMerge E{(const unsigned char*)(ws + WS_GATES), (const unsigned char*)(ws + WS_GCTX), (bf16*)(ws + WS_Y), (bf16*)(ws + WS_YP)};
            gp::gemm_phase(lds, tid, 1024, 1024, 1024, S, E);
        }
        SEAM(pb + 6);
        for (int rep_ = 0; rep_ < NREP(pb + 7); ++rep_) if (IN(pb + 7)) { if (rep_) { FORCE_BAR; } PH_BEGIN
            gp::SchedSplit S{(const char*)(ws + WS_Y), (const char*)(ws + WS_WOUT) + (size_t)layer * 1024 * 2048, (size_t)256 * 2048, (size_t)256 * 2048, layer == 0 ? 16 : 0, 16, G, bx,
                             (const char*)(ws + WS_YP), (size_t)256 * 2048, (size_t)CROWS * 2048, 4};
            gp::EpiPlainSplit E{(bf16*)(ws + WS_YO), 1024, (float*)(ws + WS_PARTW), 16};
            gp::gemm_phase(lds, tid, 1024, 1024, 1024, S, E);
        }
        SEAM(pb + 7);
        for (int rep_ = 0; rep_ < NREP(pb + 8); ++rep_) if (IN(pb + 8)) { if (rep_) { FORCE_BAR; } PH_BEGIN
            if (layer == 0) {
                NormCfg C{AIN(0), AIN(2), nullptr, ctxbuf, (const bf16*)(ws + WS_YO), (const float*)(ws + WS_PARTW), 16, normg + D, MODp, 2048, normg + 2 * D, MODp, 4096, 3072, Hh, R, nullptr, nullptr, XB};
                norm_rows(C, wslot, NW, lane);
            } else {
                LAS float* wrs = (LAS float*)lds; LAS int* rowinfo = (LAS int*)(lds + 32768); LAS unsigned* cntL = (LAS unsigned*)(lds + 32768 + 1024); LAS unsigned* baseL = cntL + 8;
                for (int i = tid; i < 2048; i += NTHREADS) ((LAS f32x4*)wrs)[i] = ((const f32x4*)AIN(26))[i];
                int* list = (int*)(ws + WS_LIST); float* routew = (float*)(ws + WS_ROUTEW);
                f32x4 gAv[4], gBv[4]; row_ld_f32(normg + D, lane, gAv); row_ld_f32(normg + 2 * D, lane, gBv);
                float rbias[8];
#pragma unroll
                for (int e = 0; e < 8; ++e) rbias[e] = AIN(27)[e];
                for (int grp = vcu; grp < 256; grp += G) {
                    if (tid < 8) cntL[tid] = 0u;
                    __syncthreads();
                    const int r0 = grp * 64 + wave * 8; const float* md = MODp + (size_t)(3 + (r0 < SEQ ? 0 : 1)) * 6144;
                    f32x4 gav[4], scv[4], shv[4]; row_ld_f32(md + 2048, lane, gav); row_ld_f32(md + 4096, lane, scv); row_ld_f32(md + 3072, lane, shv);
                    u32x2 xn[4]; u32x2 tn[4]; row_ld_raw16(XB + (size_t)r0 * D, lane, xn);
#pragma unroll
                    for (int j = 0; j < 4; ++j) tn[j] = *(const u32x2*)((const bf16*)(ws + WS_YO) + (size_t)r0 * D + 256 * j + 4 * lane);
                    for (int rr = 0; rr < 8; ++rr) { const int r = r0 + rr;
                        f32x4 x[4], t[4], hh[4];
#pragma unroll
                        for (int j = 0; j < 4; ++j) { x[j] = (f32x4){bflo(xn[j].x), bfhi(xn[j].x), bflo(xn[j].y), bfhi(xn[j].y)}; t[j] = (f32x4){bflo(tn[j].x), bfhi(tn[j].x), bflo(tn[j].y), bfhi(tn[j].y)}; }
                        if (rr < 7) { row_ld_raw16(XB + (size_t)(r + 1) * D, lane, xn);
#pragma unroll
                            for (int j = 0; j < 4; ++j) tn[j] = *(const u32x2*)((const bf16*)(ws + WS_YO) + (size_t)(r + 1) * D + 256 * j + 4 * lane); }
                        { const float rs = row_rstd(t);
#pragma unroll
                          for (int j = 0; j < 4; ++j) x[j] = x[j] + gav[j] * (t[j] * rs * gAv[j]); }
                        row_st_bf16(XB + (size_t)r * D, lane, x);
                        { const float rs = row_rstd(x);
#pragma unroll
                          for (int j = 0; j < 4; ++j) hh[j] = x[j] * rs * gBv[j] * (scv[j] + 1.f) + shv[j]; }
#pragma unroll
                        for (int j = 0; j < 4; ++j) *(unsigned*)(ws + WS_H + (size_t)r * D + 256 * j + 4 * lane) = pk4_f8(hh[j][0], hh[j][1], hh[j][2], hh[j][3]);
                        float lg[8];
#pragma unroll
                        for (int e = 0; e < 8; ++e) lg[e] = 0.f;
#pragma unroll
                        for (int j = 0; j < 4; ++j)
#pragma unroll
                            for (int q = 0; q < 4; ++q) { const int k = 256 * j + 4 * lane + q; const f32x4 w0 = *(const LAS f32x4*)(wrs + k * 8), w1 = *(const LAS f32x4*)(wrs + k * 8 + 4); const float hv = hh[j][q];
                                lg[0] += hv * w0[0]; lg[1] += hv * w0[1]; lg[2] += hv * w0[2]; lg[3] += hv * w0[3]; lg[4] += hv * w1[0]; lg[5] += hv * w1[1]; lg[6] += hv * w1[2]; lg[7] += hv * w1[3]; }
#pragma unroll
                        for (int e = 0; e < 8; ++e) lg[e] = wave_sum(lg[e]) + rbias[e];
                        int i0 = 0; float v0 = lg[0];
#pragma unroll
                        for (int e = 1; e < 8; ++e) if (lg[e] > v0) { v0 = lg[e]; i0 = e; }
                        int i1 = i0 == 0 ? 1 : 0; float v1 = i0 == 0 ? lg[1] : lg[0];
#pragma unroll
                        for (int e = 0; e < 8; ++e) if (e != i0 && lg[e] > v1) { v1 = lg[e]; i1 = e; }
                        const float w0 = 1.f / (1.f + __expf(v1 - v0)), w1 = 1.f - w0;
                        if (lane == 0) { const unsigned s0 = __hip_atomic_fetch_add(cntL + i0, 1u, __ATOMIC_RELAXED, __HIP_MEMORY_SCOPE_WORKGROUP), s1 = __hip_atomic_fetch_add(cntL + i1, 1u, __ATOMIC_RELAXED, __HIP_MEMORY_SCOPE_WORKGROUP);
                            LAS int* ri = rowinfo + (wave * 8 + rr) * 4; ri[0] = i0; ri[1] = (int)s0; ri[2] = i1; ri[3] = (int)s1; routew[(size_t)r * 2] = w0; routew[(size_t)r * 2 + 1] = w1; }
                        if (lane < 8) ((int*)(ws + WS_SMAP))[(size_t)r * 8 + lane] = -1;
                    }
                    __syncthreads();
                    if (tid < 8) baseL[tid] = __hip_atomic_fetch_add((unsigned*)(ws + WS_CTL) + CW_MOECNT + 64 * tid, cntL[tid], __ATOMIC_RELAXED, __HIP_MEMORY_SCOPE_AGENT);
                    __syncthreads();
                    if (tid < 64) { const LAS int* ri = rowinfo + tid * 4; const int r = grp * 64 + tid;
                        list[ri[0] * LCAP + (int)baseL[ri[0]] + ri[1]] = r * 2; list[ri[2] * LCAP + (int)baseL[ri[2]] + ri[3]] = r * 2 + 1; }
                    __syncthreads();
                }
            }
        }
        SEAM(pb + 8);
        LAS unsigned* mt = (LAS unsigned*)(lds + LDSCTL_OFF) + LW_MOE;
        if (layer == 1 && (IN(pb + 9) || IN(pb + 10))) { PH_BEGIN
            if (tid == 0) { unsigned off = 0u;
                for (int e = 0; e < 8; ++e) { const unsigned c = __hip_atomic_load((unsigned*)(ws + WS_CTL) + CW_MOECNT + 64 * e, __ATOMIC_RELAXED, __HIP_MEMORY_SCOPE_AGENT); const unsigned m = (c + 255u) >> 8; mt[e] = c; mt[8 + e] = m; mt[16 + e] = off; off += m; }
                mt[24] = off; const unsigned U = off * 4u, full = (U / (unsigned)G) * (unsigned)G, rem = U - full;
                if (rem != 0u && rem <= 32u && full != 0u) { mt[25] = full; mt[26] = rem; } else { mt[25] = U; mt[26] = 0u; } }
            __syncthreads();
        }
        for (int rep_ = 0; rep_ < NREP(pb + 9); ++rep_) if (IN(pb + 9)) { if (rep_) { FORCE_BAR; } PH_BEGIN
            if (layer == 0) {
                gp::SchedPlain S{(const char*)Hh, (const char*)(ws + WS_FFN1), (size_t)256 * 2048, (size_t)256 * 2048, 66, 22, G, bx, 16};
                gp::EpiSwiglu E{(bf16*)(ws + WS_HID), DFF, false};
                gp::gemm_phase(lds, tid, 1024, 1024, 1024, S, E);
            } else {
                gp::SchedMoe1 S{(const char*)(ws + WS_H), (const char*)(ws + WS_MOE1), (const int*)(ws + WS_LIST), mt, G, bx, 1024u};
                gp::EpiSwigluF8 E{ws + WS_MHID, DFE, true, 1.f / MOE_W1S, MOE_HS};
                gp::gemm_phase<gp::EpiSwigluF8, gp::SchedMoe1, true>(lds, tid, 1024, 512, 512, S, E);
            }
        }
        SEAM(pb + 9);
        for (int rep_ = 0; rep_ < NREP(pb + 10); ++rep_) if (IN(pb + 10)) { if (rep_) { FORCE_BAR; } PH_BEGIN
            if (layer == 0) {
                gp::SchedSplit S{(const char*)(ws + WS_HID), (const char*)(ws + WS_FFN2), (size_t)256 * DFF * 2, (size_t)256 * DFF * 2, 11, DFF / 64, G, bx,
                                 (const char*)(ws + WS_HID) + (size_t)64 * 256 * DFF * 2, (size_t)256 * DFF * 2, 0, 11};
                gp::EpiPlainSplit E{(bf16*)(ws + WS_FO), 1024, (float*)(ws + WS_PARTF), 11};
                gp::gemm_phase(lds, tid, DFF, DFF, DFF, S, E);
            } else {
                { gp::SchedMoe2 S{(const char*)(ws + WS_MHID), (const char*)(ws + WS_MOE2), mt, G, bx, (unsigned)DFE};
                  gp::EpiMoeDown E{(bf16*)(ws + WS_SLOT), (const int*)(ws + WS_LIST), (const float*)(ws + WS_ROUTEW), mt, 1.f / (MOE_HS * MOE_W2S)};
                  gp::gemm_phase<gp::EpiMoeDown, gp::SchedMoe2, true>(lds, tid, DFE, DFE / 2, DFE / 2, S, E); }
                { PH_BEGIN gp::SchedMoe2S S{(const char*)(ws + WS_MHID), (const char*)(ws + WS_MOE2), mt, G, bx, (unsigned)DFE};
                  gp::EpiMoePart E{(bf16*)(ws + WS_PARTM), (const int*)(ws + WS_LIST), mt, (int*)(ws + WS_SMAP), 1.f / (MOE_HS * MOE_W2S)};
                  gp::gemm_phase<gp::EpiMoePart, gp::SchedMoe2S, true>(lds, tid, DFE, DFE / 2, DFE / 2, S, E); }
            }
        }
        SEAM(pb + 10);
        for (int rep_ = 0; rep_ < NREP(pb + 11); ++rep_) if (IN(pb + 11)) { if (rep_) { FORCE_BAR; } PH_BEGIN
            if (layer == 0) { PH_BEGIN NormCfg C{nullptr, ctxbuf, nullptr, ctxbuf, (const bf16*)(ws + WS_FO), (const float*)(ws + WS_PARTF), 11, normg + 3 * D, MODp, 5120, AIN(6) + 4 * D, MODp + 3 * 6144, 1024, 0, Hh, R, ws + WS_H8, XB, XB};
                norm_rows(C, wslot, NW, lane); }
            else { PH_BEGIN
                typedef int i32x4 __attribute__((ext_vector_type(4)));
                const bf16* S0 = (const bf16*)(ws + WS_SLOT); const bf16* S1 = S0 + (size_t)LROWS * D; const int* smap = (const int*)(ws + WS_SMAP);
                f32x4 gv[4], ga[4]; row_ld_f32(normg + 3 * D, lane, gv);
                u32x2 xb[4], s0[4], s1[4]; i32x4 m0 = (i32x4){-1, -1, -1, -1}, m1 = m0; int curci = -1;
#pragma unroll
                for (int j = 0; j < 4; ++j) { xb[j] = s0[j] = s1[j] = (u32x2){0u, 0u}; ga[j] = (f32x4){0.f, 0.f, 0.f, 0.f}; }
                int r = wslot;
                if (r < LROWS) { row_ld_raw16(XB + (size_t)r * D, lane, xb); row_ld_raw16(S0 + (size_t)r * D, lane, s0); row_ld_raw16(S1 + (size_t)r * D, lane, s1); m0 = *(const i32x4*)(smap + (size_t)r * 8); m1 = *(const i32x4*)(smap + (size_t)r * 8 + 4); }
                for (; r < LROWS; r += NW) {
                    u32x2 cx[4], c0[4], c1[4]; const i32x4 cm0 = m0, cm1 = m1;
#pragma unroll
                    for (int j = 0; j < 4; ++j) { cx[j] = xb[j]; c0[j] = s0[j]; c1[j] = s1[j]; }
                    const int r2 = r + NW;
                    if (r2 < LROWS) { row_ld_raw16(XB + (size_t)r2 * D, lane, xb); row_ld_raw16(S0 + (size_t)r2 * D, lane, s0); row_ld_raw16(S1 + (size_t)r2 * D, lane, s1); m0 = *(const i32x4*)(smap + (size_t)r2 * 8); m1 = *(const i32x4*)(smap + (size_t)r2 * 8 + 4); }
                    const int ci = r < SEQ ? 0 : 1;
                    if (ci != curci) { curci = ci; row_ld_f32(MODp + (size_t)(3 + ci) * 6144 + 5120, lane, ga); }
                    f32x4 x[4], t[4];
#pragma unroll
                    for (int j = 0; j < 4; ++j) x[j] = (f32x4){bflo(cx[j].x), bfhi(cx[j].x), bflo(cx[j].y), bfhi(cx[j].y)};
                    if ((cm0.x & cm0.y & cm0.z & cm0.w & cm1.x & cm1.y & cm1.z & cm1.w) == -1) {
#pragma unroll
                        for (int j = 0; j < 4; ++j) t[j] = (f32x4){bflo(c0[j].x), bfhi(c0[j].x), bflo(c0[j].y), bfhi(c0[j].y)} + (f32x4){bflo(c1[j].x), bfhi(c1[j].x), bflo(c1[j].y), bfhi(c1[j].y)};
                    } else {
#pragma unroll
                        for (int j = 0; j < 4; ++j) t[j] = (f32x4){0.f, 0.f, 0.f, 0.f};
#pragma unroll
                        for (int k = 0; k < 2; ++k) { const int ent = 2 * r + k; const i32x4 mk = k ? cm1 : cm0;
#pragma unroll
                            for (int j = 0; j < 4; ++j) { const int mm = j == 0 ? mk.x : (j == 1 ? mk.y : (j == 2 ? mk.z : mk.w));
                                if (mm < 0) { const u32x2 w = k ? c1[j] : c0[j]; t[j] = t[j] + (f32x4){bflo(w.x), bfhi(w.x), bflo(w.y), bfhi(w.y)}; }
                                else { const bf16* pp = (const bf16*)(ws + WS_PARTM) + ((size_t)(mm >> 8) * 7 * 256 + (mm & 255)) * 256 + 4 * lane; f32x4 sacc = (f32x4){0.f, 0.f, 0.f, 0.f};
                                    for (int sl = 0; sl < 7; ++sl) { const u32x2 w = *(const u32x2*)(pp + (size_t)sl * 65536); sacc = sacc + (f32x4){bflo(w.x), bfhi(w.x), bflo(w.y), bfhi(w.y)}; }
                                    t[j] = t[j] + sacc * ((const float*)(ws + WS_ROUTEW))[ent]; } } } }
                    const float rs = row_rstd(t);
#pragma unroll
                    for (int j = 0; j < 4; ++j) x[j] = x[j] + ga[j] * (t[j] * rs * gv[j]);
                    row_st_f32(AOUT + (size_t)r * D, lane, x);
                } }
        }
        SEAM(pb + 11);
    }
#ifdef MK_STAMP_PHASE
    if (MK_STAMP_PHASE == NPHASE - 1 && wave == 0) *(volatile LAS unsigned long long*)(lctl + 66) = __builtin_amdgcn_s_memrealtime();
    if (blockIdx.x == 0 && wave == 0) { const unsigned long long st0_ = *(volatile LAS unsigned long long*)(lctl + 64), st1_ = *(volatile LAS unsigned long long*)(lctl + 66); const unsigned long long target = __builtin_amdgcn_s_memrealtime() + (unsigned long long)MK_STAMP_AMP * (st1_ - st0_); while (__builtin_amdgcn_s_memrealtime() < target) __builtin_amdgcn_s_sleep(20); }
#endif
#ifdef MK_EXTRA_BARS
    for (int xb_ = 0; xb_ < MK_EXTRA_BARS; ++xb_) { FORCE_BAR; }
#endif
#undef IN
#undef SEAM
#undef PH_BEGIN
#undef normg
#undef AIN
#undef AOUT
#undef XB
#undef MODp
#undef ctxbuf
#undef Hh
#undef MIX
#undef INP
#undef Tt
}

__global__ void dumpk(const unsigned char* src, size_t nbytes, int isf32, float* out, size_t N, int accum) {
    const size_t i = (size_t)blockIdx.x * blockDim.x + threadIdx.x; if (i >= N) return;
    const size_t ne = isf32 ? nbytes / 4 : nbytes / 2; float s = 0.f;
    for (size_t k = i; k < ne; k += N) s += isf32 ? ((const float*)src)[k] : bf2f(((const bf16*)src)[k]);
    out[i] = accum ? out[i] + s : s;
}
extern "C" void kernel_launch(void* const* d_in, const int* in_sizes, int n_in, void* d_out, int out_size, void* d_ws, size_t ws_size, hipStream_t stream) {
    static int grid = 0;
    if (grid == 0) {
        if (n_in != 31 || out_size != LROWS * D || ws_size < WS_END) { fprintf(stderr, "kernel_launch: unexpected shapes (n_in %d, out %d, ws %zu < %zu)\n", n_in, out_size, ws_size, (size_t)WS_END); grid = -1; return; }
        int dev = 0, cus = 0, per_cu = 0;
        if (hipGetDevice(&dev) != hipSuccess || hipDeviceGetAttribute(&cus, hipDeviceAttributeMultiprocessorCount, dev) != hipSuccess) { grid = -1; return; }
        if (hipFuncSetAttribute((const void*)mk_fwd, hipFuncAttributeMaxDynamicSharedMemorySize, LDS_BYTES) != hipSuccess) { fprintf(stderr, "kernel_launch: hipFuncSetAttribute failed\n"); grid = -1; return; }
        if (hipOccupancyMaxActiveBlocksPerMultiprocessor(&per_cu, (const void*)mk_fwd, NTHREADS, LDS_BYTES) != hipSuccess || per_cu < 1) { fprintf(stderr, "kernel_launch: occupancy query says %d\n", per_cu); }
        (void)hipGetLastError();
        grid = cus;
    }
    if (grid < 0) return;
    (void)hipMemsetAsync((char*)d_ws + WS_CTL, 0, CTL_ZERO_BYTES, stream);
    Args a{};
    for (int i = 0; i < 31; ++i) a.in[i] = (const float*)d_in[i];
    a.out = (float*)d_out; a.ws = (unsigned char*)d_ws;
#if MK_MODE == 1
    a.ph_lo = 0; a.ph_hi = NPHASE; a.li = 0;
    hipLaunchKernelGGL(mk_fwd, dim3(grid), dim3(NTHREADS), LDS_BYTES, stream, a);
#else
    for (int p = 0; p < MK_LAST; ++p) { a.ph_lo = p; a.ph_hi = p + 1; a.li = p; hipLaunchKernelGGL(mk_fwd, dim3(grid), dim3(NTHREADS), LDS_BYTES, stream, a); }
#endif
#ifdef MK_DUMP_OFF
    dumpk<<<(LROWS * D + 255) / 256, 256, 0, stream>>>((const unsigned char*)d_ws + (size_t)(MK_DUMP_OFF), (size_t)(MK_DUMP_BYTES), MK_DUMP_F32, (float*)d_out, (size_t)LROWS * D, 0);
#endif
#ifdef MK_DUMP2_OFF
    dumpk<<<(LROWS * D + 255) / 256, 256, 0, stream>>>((const unsigned char*)d_ws + (size_t)(MK_DUMP2_OFF), (size_t)(MK_DUMP2_BYTES), MK_DUMP2_F32, (float*)d_out, (size_t)LROWS * D, 1);
#endif
#ifdef MK_DUMP3_OFF
    dumpk<<<(LROWS * D + 255) / 256, 256, 0, stream>>>((const unsigned char*)d_ws + (size_t)(MK_DUMP3_OFF), (size_t)(MK_DUMP3_BYTES), MK_DUMP3_F32, (float*)d_out, (size_t)LROWS * D, 1);
#endif
}
```

```cpp
#define MK_MODE 1
#include <hip/hip_runtime.h>
#include <cstdio>
#include <cstdint>

#define GAS __attribute__((address_space(1)))
#define LAS __attribute__((address_space(3)))
typedef unsigned short bf16;
typedef short bf16x8 __attribute__((ext_vector_type(8)));
typedef short bf16x4 __attribute__((ext_vector_type(4)));
typedef float f32x2 __attribute__((ext_vector_type(2)));
typedef float f32x4 __attribute__((ext_vector_type(4)));
typedef float f32x16 __attribute__((ext_vector_type(16)));
typedef unsigned u32x2 __attribute__((ext_vector_type(2)));
typedef unsigned u32x4 __attribute__((ext_vector_type(4)));

constexpr int D = 1024, SEQ = 8192, LROWS = 16384, CTXL = 256, CROWS = 512, R = 16896;
constexpr int DFF = 2816, DFE = 3584, NEXP = 8, LCAP = 16640;
constexpr int NWAVES = 8, NTHREADS = 512;
constexpr int NCH16 = R / 16;
constexpr float EPSN = 1e-6f, LOG2E = 1.4426950408889634f;

constexpr size_t MiB = 1u << 20;
constexpr size_t WS_CTL = 0, CTL_ZERO_BYTES = 1 * MiB;
constexpr int CW_TMO = 0, CW_BAR = 4096, CW_MOECNT = 98304, CW_QHEAD = 100352, CW_MQ = 102400;
constexpr size_t CTL_MOD_OFF = 512 * 1024;
constexpr size_t WS_CTXBUF = 1 * MiB;
constexpr size_t WS_COST = 3 * MiB, WS_SINT = 4 * MiB, WS_COSN = 5 * MiB, WS_SINN = 6 * MiB;
constexpr size_t WS_LIST = 7 * MiB;
constexpr size_t WS_ROUTEW = WS_LIST + 8 * LCAP * 4;
constexpr size_t WS_S5K = 8 * MiB;
constexpr size_t WS_A16 = 9 * MiB;
constexpr size_t WS_W128T = WS_A16 + 64 * 1024;
constexpr size_t WS_TWC = WS_W128T + 64 * 1024, WS_TWS = WS_TWC + 32 * 1024;
constexpr size_t WS_FCT = WS_TWS + 32 * 1024;
constexpr size_t WS_W64T = WS_FCT + 32 * 1024;
constexpr size_t WS_W256T = WS_W64T + 32 * 1024;
constexpr size_t WS_MOE1 = 10 * MiB;
constexpr size_t WS_WG8 = 66 * MiB;
constexpr size_t WS_XB = 74 * MiB;
constexpr size_t WS_H8 = 150 * MiB;
constexpr size_t WS_MOE2 = 122 * MiB;
constexpr size_t WS_OTHERW = 178 * MiB;
constexpr size_t WS_WIN = 178 * MiB;
constexpr size_t WS_WBR = 204 * MiB;
constexpr size_t WS_WOUT = 208 * MiB;
constexpr size_t WS_WGLU = 212 * MiB;
constexpr size_t WS_FFN1 = 213 * MiB;
constexpr size_t WS_FFN2 = 224 * MiB;
constexpr size_t WS_S5M1 = 230 * MiB;
constexpr size_t WS_S5TAB = 234 * MiB;
constexpr size_t WS_BIG = 242 * MiB;
constexpr size_t TOK256 = (size_t)R * 256 * 2;
constexpr size_t WS_INP = WS_BIG;
constexpr size_t WS_T = WS_INP + 7 * TOK256;
constexpr size_t WS_HLOC = WS_T + 3 * TOK256;
constexpr size_t WS_HIN = WS_HLOC + 2 * TOK256;
constexpr size_t WS_KV = WS_HIN + TOK256;
constexpr size_t WS_SPREV = WS_KV + 2 * TOK256;
constexpr size_t WS_FB = WS_SPREV + TOK256;
constexpr size_t WS_GATES = WS_BIG;
constexpr size_t WS_Y = WS_BIG + 132 * MiB;
constexpr size_t WS_YO = WS_Y + 33 * MiB;
constexpr size_t WS_Z = WS_YO + 33 * MiB;
constexpr size_t WS_YP = WS_Z;
constexpr size_t WS_PARTW = WS_BIG;
constexpr size_t WS_PARTF = 340 * MiB;
constexpr size_t WS_PARTM = 416 * MiB;
constexpr size_t WS_SMAP = WS_S5K;
constexpr size_t WS_FO = WS_Y;
constexpr size_t WS_HID = WS_BIG;
constexpr size_t WS_MHID = WS_OTHERW;
constexpr size_t WS_H = 449 * MiB;
constexpr size_t WS_MIX = 482 * MiB;
constexpr size_t WS_SLOT = WS_H;
constexpr size_t WS_GCTX = 515 * MiB;
constexpr size_t WS_END = 519 * MiB;
static_assert(WS_FB + 16 * MiB <= WS_Z && WS_Z + TOK256 <= WS_H && WS_MHID + (size_t)34816 * 3584 * 2 <= WS_H && WS_W256T + 256 * 1024 <= WS_MOE1, "ws map");
static_assert(WS_PARTM + (size_t)32 * 7 * 65536 * 2 <= WS_H && WS_MHID + (size_t)34816 * 3584 * 2 <= WS_PARTM, "ws map 3");
static_assert(WS_S5TAB + 8 * MiB <= WS_BIG && WS_FFN2 + (size_t)1024 * 2816 * 2 <= WS_S5M1 && WS_ROUTEW + 32768 * 4 <= WS_S5K, "ws map 2");

constexpr int RING_BYTES = 131072, LDSCTL_OFF = RING_BYTES, LDS_BYTES = 147456;
constexpr int LW_BAR = 8, LW_MOE = 16;

#define VM_WAIT() asm volatile("s_waitcnt vmcnt(0)" ::: "memory")
#define LDS_WAIT() asm volatile("s_waitcnt lgkmcnt(0)" ::: "memory")
typedef __bf16 bf16n2 __attribute__((ext_vector_type(2)));
__device__ __forceinline__ unsigned pk2(float lo, float hi) { bf16n2 v; v.x = (__bf16)lo; v.y = (__bf16)hi; return __builtin_bit_cast(unsigned, v); }
__device__ __forceinline__ unsigned pk4_f8(float a, float b, float c, float d) { int w = 0; w = __builtin_amdgcn_cvt_pk_fp8_f32(a, b, w, false); w = __builtin_amdgcn_cvt_pk_fp8_f32(c, d, w, true); return (unsigned)w; }
__device__ __forceinline__ float bf2f(unsigned short b) { return __builtin_bit_cast(float, ((unsigned)b) << 16); }
__device__ __forceinline__ float bflo(unsigned w) { return __builtin_bit_cast(float, w << 16); }
__device__ __forceinline__ float bfhi(unsigned w) { return __builtin_bit_cast(float, w & 0xffff0000u); }
__device__ __forceinline__ float ex2(float x) { return __builtin_amdgcn_exp2f(x); }
__device__ __forceinline__ float rcpf_(float x) { return __builtin_amdgcn_rcpf(x); }
__device__ __forceinline__ float sigm(float x) { return rcpf_(1.f + ex2(-LOG2E * x)); }
__device__ __forceinline__ float silu_(float x) { return x * sigm(x); }
__device__ __forceinline__ float gelu_tanh(float x) { const float u = 0.7978845608028654f * (x + 0.044715f * x * x * x); const float t = 1.f - 2.f * rcpf_(1.f + ex2(2.885390081777927f * u)); return 0.5f * x * (1.f + t); }
__device__ __forceinline__ float xor32_sum(float v) { const unsigned u = __builtin_bit_cast(unsigned, v); const auto r = __builtin_amdgcn_permlane32_swap(u, u, false, false); return __builtin_bit_cast(float, (unsigned)r[0]) + __builtin_bit_cast(float, (unsigned)r[1]); }
__device__ __forceinline__ float xor32_max(float v) { const unsigned u = __builtin_bit_cast(unsigned, v); const auto r = __builtin_amdgcn_permlane32_swap(u, u, false, false); return fmaxf(__builtin_bit_cast(float, (unsigned)r[0]), __builtin_bit_cast(float, (unsigned)r[1])); }
template <int X> __device__ __forceinline__ float swz_xor(float v) { return __builtin_bit_cast(float, __builtin_amdgcn_ds_swizzle(__builtin_bit_cast(int, v), (X << 10) | 0x1f)); }
__device__ __forceinline__ float wave_sum(float v) { v += swz_xor<1>(v); v += swz_xor<2>(v); v += swz_xor<4>(v); v += swz_xor<8>(v); v += swz_xor<16>(v); return xor32_sum(v); }
__device__ __forceinline__ f32x16 mma32(bf16x8 a, bf16x8 b, f32x16 c) { return __builtin_amdgcn_mfma_f32_32x32x16_bf16(a, b, c, 0, 0, 0); }
__device__ __forceinline__ bf16x8 ldg8(const bf16* p) { return *(const bf16x8*)p; }
__device__ __forceinline__ bf16x8 ldg8p(const bf16* p) { const bf16x4 lo = *(const bf16x4*)p, hi = *(const bf16x4*)(p + 8); return __builtin_shufflevector(lo, hi, 0, 1, 2, 3, 4, 5, 6, 7); }
template <int S> __device__ __forceinline__ bf16x8 accB(const f32x16& c) {
    u32x4 w; w.x = pk2(c[8 * S + 0], c[8 * S + 1]); w.y = pk2(c[8 * S + 2], c[8 * S + 3]); w.z = pk2(c[8 * S + 4], c[8 * S + 5]); w.w = pk2(c[8 * S + 6], c[8 * S + 7]);
    return __builtin_bit_cast(bf16x8, w);
}
__device__ __forceinline__ bf16x8 pack8(const float (&v)[8]) { u32x4 w; w.x = pk2(v[0], v[1]); w.y = pk2(v[2], v[3]); w.z = pk2(v[4], v[5]); w.w = pk2(v[6], v[7]); return __builtin_bit_cast(bf16x8, w); }
__device__ __forceinline__ void unpack8(const bf16x8 x, float (&v)[8]) { const u32x4 w = __builtin_bit_cast(u32x4, x); v[0] = bflo(w.x); v[1] = bfhi(w.x); v[2] = bflo(w.y); v[3] = bfhi(w.y); v[4] = bflo(w.z); v[5] = bfhi(w.z); v[6] = bflo(w.w); v[7] = bfhi(w.w); }
__device__ __forceinline__ f32x16 zero16() { f32x16 z;
#pragma unroll
    for (int i = 0; i < 16; ++i) z[i] = 0.f;
    return z; }

#define XB_TMO      128
#define XB_XCNT(j)  (256  + 64 * (j))
#define XB_XSUB(j)  (1280 + 64 * (j))
#define XB_XGEN(j)  (2304 + 64 * (j))
#define XB_TOP      3328
#define XB_TOPGEN   3392
#define XCD_BAR_WORDS 3456
#define XB_SPIN_CAP (1u << 18)
__device__ __forceinline__ unsigned xb_ld(unsigned* p)              { return __hip_atomic_load(p, __ATOMIC_RELAXED, __HIP_MEMORY_SCOPE_AGENT); }
__device__ __forceinline__ unsigned xb_add(unsigned* p, unsigned v) { return __hip_atomic_fetch_add(p, v, __ATOMIC_RELAXED, __HIP_MEMORY_SCOPE_AGENT); }
__device__ __forceinline__ unsigned xb_xcc_id() { return (unsigned)__builtin_amdgcn_s_getreg((3 << 11) | 20) & 0xFu; }
#define XB_SPIN(cond, bar) do { unsigned _sp = 0; while (cond) { __builtin_amdgcn_s_sleep(1); \
    if ((++_sp & 255u) == 0u) { if (xb_ld(&(bar)[XB_TMO])) break; if (_sp > XB_SPIN_CAP) { atomicAdd(&(bar)[XB_TMO], 1u); break; } } } } while (0)
struct XcdBarrier { unsigned* bar; unsigned x; volatile LAS unsigned* st; };
__device__ __forceinline__ XcdBarrier xcd_barrier_post(unsigned* bar, volatile LAS unsigned* st) {
    XcdBarrier b; b.bar = bar; b.x = xb_xcc_id(); b.st = st;
    if (threadIdx.x == 0) (void)xb_add(&bar[XB_XCNT(b.x)], 1u);
    return b;
}
__device__ __forceinline__ void xcd_barrier_complete(unsigned* bar, unsigned x, unsigned& nloc, unsigned& nx) {
    const unsigned G = gridDim.x * gridDim.y * gridDim.z;
    unsigned sum, cnt, mine, sp = 0u;
    for (;;) {
        sum = 0u; cnt = 0u; mine = 0u;
#pragma unroll
        for (unsigned j = 0; j < 16; ++j) { const unsigned c = xb_ld(&bar[XB_XCNT(j)]); sum += c; cnt += (c > 0u) ? 1u : 0u; mine = (j == x) ? c : mine; }
        if (sum == G) break;
        __builtin_amdgcn_s_sleep(1);
        if ((++sp & 255u) == 0u) { if (xb_ld(&bar[XB_TMO])) break; if (sp > XB_SPIN_CAP) { atomicAdd(&bar[XB_TMO], 1u); break; } }
    }
    nloc = mine > 0u ? mine : 1u; nx = cnt > 0u ? cnt : 1u;
}
__device__ __forceinline__ void xcd_barrier(const XcdBarrier& b) {
    asm volatile("s_waitcnt vmcnt(0)" ::: "memory");
    __syncthreads();
    if (threadIdx.x == 0) {
        unsigned* bar = b.bar;
        __builtin_amdgcn_s_waitcnt(0);
        unsigned nloc = b.st[0], nx = b.st[1];
        if (nloc == 0u) { xcd_barrier_complete(bar, b.x, nloc, nx); b.st[0] = nloc; b.st[1] = nx; }
        const unsigned old = xb_add(&bar[XB_XSUB(b.x)], 1u);
        const unsigned gen = old / nloc;
        if (old + 1u == (gen + 1u) * nloc) {
            __builtin_amdgcn_fence(__ATOMIC_RELEASE, "agent");
            asm volatile("s_waitcnt vmcnt(0)" ::: "memory");
            const unsigned og = xb_add(&bar[XB_TOP], 1u);
            const unsigned tg = og / nx;
            if (og + 1u == (tg + 1u) * nx) xb_add(&bar[XB_TOPGEN], 1u);
            else XB_SPIN(xb_ld(&bar[XB_TOPGEN]) == tg, bar);
            __builtin_amdgcn_fence(__ATOMIC_ACQUIRE, "agent");
            xb_add(&bar[XB_XGEN(b.x)], 1u);
            asm volatile("s_waitcnt vmcnt(0)" ::: "memory");
        } else {
            XB_SPIN(xb_ld(&bar[XB_XGEN(b.x)]) == gen, bar);
            __builtin_amdgcn_fence(__ATOMIC_ACQUIRE, "agent");
            asm volatile("s_waitcnt vmcnt(0)" ::: "memory");
        }
    }
    __syncthreads();
}
namespace gp {
constexpr int BM = 256, BK = 64, HALF = 128, HTB = HALF * BK * 2, STAGE_BYTES = 8 * HTB, NXCD = 8, WGM = 8;
__device__ __forceinline__ int lds_byte(int r, int c) { const int st = (r >> 4) * 2 + (c >> 5), rr = r & 15, cc = c & 31, ob = rr * 64 + cc * 2; return st * 1024 + (ob ^ (((ob >> 9) & 1) << 5)); }
__device__ __forceinline__ void stage_rc(int b, int& Rr, int& C) { const int st = b / 1024, sb = b % 1024, swz = sb ^ (((sb >> 9) & 1) << 5); Rr = (st >> 1) * 16 + swz / 64; C = (st & 1) * 32 + (swz % 64) / 2; }
__device__ __forceinline__ int perm32(int rho) { const int n = rho >> 4, i = rho & 15; return 8 * (i >> 2) + 4 * n + (i & 3); }

struct Unit { const char* a; const char* b; int e0, e1, e2, e3, nt; };

__device__ __forceinline__ void tile_of(int L, int nM, int nN, int& pm, int& pn) {
    const int nwg = nM * nN; int wgid = L;
    { const int q = nwg / NXCD, r = nwg % NXCD, xcd = wgid % NXCD, off = wgid / NXCD; wgid = (xcd < r ? xcd * (q + 1) : r * (q + 1) + (xcd - r) * q) + off; }
    const int nig = WGM * nN, gid = wgid / nig, fm = gid * WGM, gsz = (nM - fm) < WGM ? (nM - fm) : WGM;
    pm = fm + ((wgid % nig) % gsz); pn = (wgid % nig) / gsz;
}

typedef int i32x8 __attribute__((ext_vector_type(8)));
typedef int i32x4v __attribute__((ext_vector_type(4)));
__device__ __forceinline__ i32x8 cat8(const bf16x8 a, const bf16x8 b) { const i32x4v x = __builtin_bit_cast(i32x4v, a), y = __builtin_bit_cast(i32x4v, b); return __builtin_shufflevector(x, y, 0, 1, 2, 3, 4, 5, 6, 7); }
__device__ __forceinline__ void mfma_f8(f32x4& acc, const i32x8 a, const i32x8 b) { asm volatile("s_nop 1\n\tv_mfma_f32_16x16x128_f8f6f4 %0, %1, %2, %0" : "+v"(acc) : "v"(a), "v"(b)); }
template <class Epi, class Sched, bool F8 = false>
__device__ __forceinline__ void gemm_phase(LAS unsigned char* lds, const int tid, const int K, const int lda, const int ldb, const Sched& S, const Epi& E) {
    constexpr bool GATHER = Sched::GATHER;
    const int wid = __builtin_amdgcn_readfirstlane(tid >> 6), lane = tid & 63, wr = wid >> 2, wc = wid & 3, fr = lane & 15, fq = lane >> 4;
    unsigned voffA[2], voffB[2];
#pragma unroll
    for (int i = 0; i < 2; ++i) { int Rr, C; stage_rc(tid * 16 + i * 8192, Rr, C); const int Rb = (Rr & ~31) + perm32(Rr & 31);
        voffA[i] = (unsigned)(Rr * lda + C) * 2u; voffB[i] = (unsigned)(Rb * ldb + C) * 2u; }
#define PG8_GOFF(dst, unit) do { _Pragma("unroll") for (int _h = 0; _h < 2; ++_h) _Pragma("unroll") for (int _i = 0; _i < 2; ++_i) { int _R, _C; stage_rc(tid * 16 + _i * 8192, _R, _C); dst[_h][_i] = S.rowoff(unit, _R + _h * HALF) + (unsigned)_C * 2u; } } while (0)
    const size_t kstep = (size_t)(BK * 2);
    const unsigned hstepA = (unsigned)HALF * (unsigned)lda * 2u; const size_t hstepB = (size_t)HALF * ldb * 2;
    const unsigned ldsw = (unsigned)wid * 1024u;
    const int aoff = lds_byte(wr * 64 + fr, fq * 8), boff = lds_byte(wc * 32 + fr, fq * 8);
#define PG8_SA(b, h) (((b) * 2 + (h)) * HTB)
#define PG8_SB(b, h) ((4 + (b) * 2 + (h)) * HTB)
#define PG8_STB(bufoff, gbase, hh) do { const char* _gb = (const char*)(gbase) + (size_t)(hh) * hstepB; _Pragma("unroll") for (int _i = 0; _i < 2; ++_i) \
        __builtin_amdgcn_global_load_lds((const unsigned*)(_gb + voffB[_i]), (LAS unsigned*)(lds + (bufoff) + ldsw + _i * 8192), 16, 0, 0); } while (0)
#define PG8_STA(bufoff, gbase, hh, VG) do { const char* _ga = (const char*)(gbase) + (GATHER ? (size_t)0 : (size_t)(hh) * hstepA); _Pragma("unroll") for (int _i = 0; _i < 2; ++_i) { const unsigned _o = GATHER ? (VG) : voffA[_i]; \
        __builtin_amdgcn_global_load_lds((const unsigned*)(_ga + _o), (LAS unsigned*)(lds + (bufoff) + ldsw + _i * 8192), 16, 0, 0); } } while (0)
#define PG8_LDA(dst, b, h) do { _Pragma("unroll") for (int m = 0; m < 4; ++m) _Pragma("unroll") for (int k = 0; k < 2; ++k) dst[m][k] = *(const LAS bf16x8*)(lds + PG8_SA(b, h) + aoff + m * 2048 + k * 1024); } while (0)
#define PG8_LDB(dst, b, h) do { _Pragma("unroll") for (int n = 0; n < 2; ++n) _Pragma("unroll") for (int k = 0; k < 2; ++k) dst[n][k] = *(const LAS bf16x8*)(lds + PG8_SB(b, h) + boff + n * 2048 + k * 1024); } while (0)
#define PG8_MMA(ai, bj, At, Bt) do { __builtin_amdgcn_s_setprio(1); _Pragma("unroll") for (int m = 0; m < 4; ++m) _Pragma("unroll") for (int n = 0; n < 2; ++n) { \
        if constexpr (F8) mfma_f8(acc[ai][bj][m][n], cat8(Bt[n][0], Bt[n][1]), cat8(At[m][0], At[m][1])); \
        else { _Pragma("unroll") for (int k = 0; k < 2; ++k) acc[ai][bj][m][n] = __builtin_amdgcn_mfma_f32_16x16x32_bf16(Bt[n][k], At[m][k], acc[ai][bj][m][n], 0, 0, 0); } } __builtin_amdgcn_s_setprio(0); } while (0)
#define PG8_WAIT_V(n) asm volatile("s_waitcnt vmcnt(" #n ")" ::: "memory")
#define PG8_WAIT_L(n) asm volatile("s_waitcnt lgkmcnt(" #n ")" ::: "memory")
#define PG8_BAR __builtin_amdgcn_s_barrier()
#define PG8_SCHED __builtin_amdgcn_sched_barrier(0)
    Unit cur, nxt; int ui = 0;
    if (!S.next(0, cur)) return;
    f32x4 acc[2][2][4][2];
#pragma unroll
    for (int a = 0; a < 2; ++a)
#pragma unroll
        for (int b = 0; b < 2; ++b)
#pragma unroll
            for (int m = 0; m < 4; ++m)
#pragma unroll
                for (int n = 0; n < 2; ++n) acc[a][b][m][n] = (f32x4){0.f, 0.f, 0.f, 0.f};
    bf16x8 At[4][2], B0[2][2], B1[2][2];
    unsigned vgc[2][2], vgn[2][2];
    if constexpr (GATHER) { PG8_GOFF(vgc, cur); }
#pragma unroll
    for (int h = 0; h < 2; ++h)
#pragma unroll
        for (int i = 0; i < 2; ++i) { if (!GATHER) vgc[h][i] = 0u; vgn[h][i] = vgc[h][i]; }
    const char* cA = cur.a; const char* cB = cur.b;
    PG8_STB(PG8_SB(0, 0), cB, 0); PG8_STB(PG8_SB(0, 1), cB, 1); PG8_STA(PG8_SA(0, 0), cA, 0, vgc[0][_i]); PG8_STA(PG8_SA(0, 1), cA, 1, vgc[1][_i]);
    if (wr == 1) PG8_BAR;
    PG8_WAIT_V(2); PG8_BAR;
    PG8_STB(PG8_SB(1, 0), cB + kstep, 0); PG8_STA(PG8_SA(1, 0), cA + kstep, 0, vgc[0][_i]); PG8_STB(PG8_SB(1, 1), cB + kstep, 1);
    PG8_WAIT_V(6); PG8_BAR;
    for (;;) {
        const bool has_next = S.next(ui + 1, nxt);
        const char* nA = has_next ? nxt.a : cA; const char* nB = has_next ? nxt.b : cB;
        int nt = cur.nt; asm volatile("" : "+s"(nt));
#pragma unroll 1
        for (int t = 0; t < nt; t += 2) {
            const bool last = (t == nt - 2);
            const char* a1 = cA + (size_t)(t + 1) * kstep;
            const char* a2 = last ? nA : cA + (size_t)(t + 2) * kstep; const char* b2 = last ? nB : cB + (size_t)(t + 2) * kstep;
            const char* a3 = a2 + kstep; const char* b3 = b2 + kstep;
            if constexpr (Epi::MID) { if (t != 0 && (t & 3) == 0 && cur.nt == 16) E.mid(acc, cur, (t >> 2) - 1, wr, wc, fr, fq); }
            if constexpr (GATHER) { if (last && has_next) { PG8_GOFF(vgn, nxt); } }
            PG8_LDB(B0, 0, 0); PG8_LDB(B1, 0, 1); PG8_SCHED; PG8_LDA(At, 0, 0); PG8_STA(PG8_SA(1, 1), a1, 1, vgc[1][_i]);
            PG8_WAIT_V(8); PG8_WAIT_L(0); PG8_BAR; PG8_MMA(0, 0, At, B0); PG8_MMA(0, 1, At, B1); PG8_BAR; PG8_SCHED;
            PG8_LDA(At, 0, 1); PG8_STB(PG8_SB(0, 0), b2, 0); PG8_STB(PG8_SB(0, 1), b2, 1); PG8_STA(PG8_SA(0, 0), a2, 0, (last ? vgn[0][_i] : vgc[0][_i]));
            PG8_WAIT_V(8); PG8_WAIT_L(0); PG8_BAR; PG8_MMA(1, 0, At, B0); PG8_MMA(1, 1, At, B1); PG8_BAR; PG8_SCHED;
            PG8_LDB(B0, 1, 0); PG8_LDB(B1, 1, 1); PG8_SCHED; PG8_LDA(At, 1, 0); PG8_STA(PG8_SA(0, 1), a2, 1, (last ? vgn[1][_i] : vgc[1][_i]));
            PG8_WAIT_V(8); PG8_WAIT_L(0); PG8_BAR; PG8_MMA(0, 0, At, B0); PG8_MMA(0, 1, At, B1); PG8_BAR; PG8_SCHED;
            PG8_LDA(At, 1, 1); PG8_STB(PG8_SB(1, 0), b3, 0); PG8_STB(PG8_SB(1, 1), b3, 1); PG8_STA(PG8_SA(1, 0), a3, 0, (last ? vgn[0][_i] : vgc[0][_i]));
            PG8_WAIT_V(8); PG8_WAIT_L(0); PG8_BAR; PG8_MMA(1, 0, At, B0); PG8_MMA(1, 1, At, B1); PG8_BAR; PG8_SCHED;
        }
        if constexpr (F8) { asm volatile("s_nop 15\n\ts_nop 15" ::: "memory"); }
        if (wr == 0) PG8_BAR;
        Unit ue = cur; int le = lane;
        if constexpr (Epi::LAUNDER) { int t0 = cur.e0, t1 = cur.e1, t2 = cur.e2, t3 = cur.e3; asm volatile("" : "+v"(t0), "+v"(t1), "+v"(t2), "+v"(t3), "+v"(le));
          ue.e0 = __builtin_amdgcn_readfirstlane(t0); ue.e1 = __builtin_amdgcn_readfirstlane(t1); ue.e2 = __builtin_amdgcn_readfirstlane(t2); ue.e3 = __builtin_amdgcn_readfirstlane(t3); le &= 63; }
        const int fre = le & 15, fqe = le >> 4;
        if constexpr (Epi::CARRY) { E.carry(acc, ue, wr, wc, fre, fqe); if (!has_next) break; }
        else {
        E(acc, ue, wr, wc, fre, fqe);
        if (!has_next) break;
#pragma unroll
        for (int a = 0; a < 2; ++a)
#pragma unroll
            for (int b = 0; b < 2; ++b)
#pragma unroll
                for (int m = 0; m < 4; ++m)
#pragma unroll
                    for (int n = 0; n < 2; ++n) acc[a][b][m][n] = (f32x4){0.f, 0.f, 0.f, 0.f};
        }
        cur = nxt; cA = nA; cB = nB; ++ui;
#pragma unroll
        for (int h = 0; h < 2; ++h)
#pragma unroll
            for (int i = 0; i < 2; ++i) vgc[h][i] = vgn[h][i];
        if (wr == 1) PG8_BAR;
    }
    PG8_WAIT_V(0);
    PG8_BAR;
#undef PG8_SA
#undef PG8_SB
#undef PG8_STA
#undef PG8_GOFF
#undef PG8_STB
#undef PG8_LDA
#undef PG8_LDB
#undef PG8_MMA
#undef PG8_WAIT_V
#undef PG8_WAIT_L
#undef PG8_BAR
#undef PG8_SCHED
}

struct SchedPlain {
    static constexpr bool GATHER = false;
    const char* A; const char* B; size_t ta, tb; int nM, nN, G, c, nt;
    __device__ __forceinline__ bool next(int i, Unit& u) const {
        const long L = (long)i * G + c; if (L >= (long)nM * nN) return false;
        int pm, pn; tile_of((int)L, nM, nN, pm, pn); u.a = A + (size_t)pm * ta; u.b = B + (size_t)pn * tb; u.e0 = pm; u.e1 = pn; u.e2 = 0; u.e3 = 0; u.nt = nt; return true; }
    __device__ __forceinline__ unsigned rowoff(const Unit&, int) const { return 0u; }
};
struct SchedInprojA {
    static constexpr bool GATHER = false;
    const char* Hh; const char* W; int nM, G, c, ng;
    __device__ __forceinline__ bool next(int i, Unit& u) const {
        long L = (long)i * G + c; const int n1 = nM * 7, n2 = 3 * nM; if (L >= n1 + n2 + ng) return false;
        int pm, pn;
        if (L < n1) { tile_of((int)L, nM, 7, pm, pn); u.a = Hh + (size_t)pm * (256 * 2048); u.b = W + (size_t)pn * (256 * 2048); u.e2 = 0; }
        else if (L < n1 + n2) { tile_of((int)(L - n1), 3, nM, pm, pn); u.a = W + (size_t)(23 + pm) * (256 * 2048); u.b = Hh + (size_t)pn * (256 * 2048); u.e2 = 1; }
        else { const int q = (int)(L - n1 - n2); pm = q >> 4; pn = q & 15; u.a = Hh + (size_t)(64 + pm) * (256 * 2048); u.b = W + (size_t)(7 + pn) * (256 * 2048); u.e2 = 2; }
        u.e0 = pm; u.e1 = pn; u.e3 = 0; u.nt = 16; return true; }
    __device__ __forceinline__ unsigned rowoff(const Unit&, int) const { return 0u; }
};
struct SchedSplit {
    static constexpr bool GATHER = false;
    const char* A; const char* B; size_t ta, tb; int nslice, ntf, G, c; const char* Ac; size_t tac, sac; int ks;
    __device__ __forceinline__ bool next(int i, Unit& u) const {
        const long L = (long)i * G + c; int pm, pn;
        if (L < 256) { tile_of((int)L, 64, 4, pm, pn); u.a = A + (size_t)pm * ta; u.b = B + (size_t)pn * tb; u.e2 = 0; u.e3 = 0; u.nt = ntf; }
        else { const int q = (int)(L - 256); if (q >= 8 * nslice) return false; const int tile = q / nslice, s = q % nslice; pm = 64 + (tile >> 2); pn = tile & 3;
            u.a = Ac + (size_t)(tile >> 2) * tac + (size_t)(s / ks) * sac + (s % ks) * 512; u.b = B + (size_t)pn * tb + (s % ks) * 512; u.e2 = s + 1; u.e3 = tile; u.nt = 4; }
        u.e0 = pm; u.e1 = pn; return true; }
    __device__ __forceinline__ unsigned rowoff(const Unit&, int) const { return 0u; }
};
struct SchedMerge {
    static constexpr bool GATHER = false;
    const char* Mix; const char* Wb; int nctx, G, c;
    __device__ __forceinline__ bool next(int i, Unit& u) const {
        const long L = (long)i * G + c; int pm, pn;
        if (L < 256) { tile_of((int)L, 64, 4, pm, pn); u.a = Mix + (size_t)pm * (256 * 2048); u.b = Wb + (size_t)pn * (256 * 2048); u.e2 = 0; u.e3 = 0; u.nt = 16; }
        else { const long q = L - 256; if (q >= nctx) return false; const int tile = (int)q >> 2, b = (int)q & 3; pm = 64 + (tile >> 2); pn = tile & 3;
            u.a = Mix + (size_t)pm * (256 * 2048) + b * 512; u.b = Wb + (size_t)pn * (256 * 2048) + b * 512; u.e2 = b; u.e3 = 1; u.nt = 4; }
        u.e0 = pm; u.e1 = pn; return true; }
    __device__ __forceinline__ unsigned rowoff(const Unit&, int) const { return 0u; }
};
__device__ __forceinline__ int mtu(const LAS unsigned* mt, int i) { return __builtin_amdgcn_readfirstlane((int)mt[i]); }
struct SchedMoe1 {
    static constexpr bool GATHER = true;
    const char* Hh; const char* W; const int* list; const LAS unsigned* mt; int G, c; unsigned rb;
    __device__ __forceinline__ bool next(int i, Unit& u) const {
        long L = (long)i * G + c; int e = 0;
        for (; e < 8; ++e) { const long ue = (long)mtu(mt, 8 + e) * 28; if (L < ue) break; L -= ue; }
        if (e == 8) return false;
        const int m_e = mtu(mt, 8 + e), nti = (int)(L / m_e), mti = (int)(L % m_e);
        u.a = Hh; u.b = W + ((size_t)e * 7168 + (size_t)nti * 256) * rb; u.e0 = e; u.e1 = mti; u.e2 = nti; u.e3 = (mtu(mt, 16 + e) + mti) * 256; u.nt = (int)(rb >> 7); return true; }
    __device__ __forceinline__ unsigned rowoff(const Unit& u, int r) const {
        const int li = u.e1 * 256 + r; const int ent = (li < (int)mt[u.e0]) ? list[u.e0 * LCAP + li] : 0; return (unsigned)(ent >> 1) * rb; }
};
__device__ __forceinline__ bool moe2_unit(long L, const LAS unsigned* mt, const char* Hid, const char* W, Unit& u, const size_t rb) {
    int e = 0;
    for (; e < 8; ++e) { const long ue = (long)mtu(mt, 8 + e) * 4; if (L < ue) break; L -= ue; }
    if (e == 8) return false;
    const int m_e = mtu(mt, 8 + e), nti = (int)(L / m_e), mti = (int)(L % m_e);
    u.a = Hid + (size_t)(mtu(mt, 16 + e) + mti) * 256 * rb; u.b = W + ((size_t)e * 1024 + (size_t)nti * 256) * rb; u.e0 = e; u.e1 = mti; u.e2 = nti; u.e3 = 0; u.nt = (int)(rb >> 7); return true;
}
struct SchedMoe2 {
    static constexpr bool GATHER = false;
    const char* Hid; const char* W; const LAS unsigned* mt; int G, c; unsigned rb;
    __device__ __forceinline__ bool next(int i, Unit& u) const { const long L = (long)i * G + c; if (L >= (long)mtu(mt, 25)) return false; return moe2_unit(L, mt, Hid, W, u, rb); }
    __device__ __forceinline__ unsigned rowoff(const Unit&, int) const { return 0u; }
};
struct SchedMoe2S {
    static constexpr bool GATHER = false;
    const char* Hid; const char* W; const LAS unsigned* mt; int G, c; unsigned rb;
    __device__ __forceinline__ bool next(int i, Unit& u) const { const long q = (long)i * G + c; if (q >= (long)mtu(mt, 26) * 7) return false;
        if (!moe2_unit((long)mtu(mt, 25) + q / 7, mt, Hid, W, u, rb)) return false; const int s = (int)(q % 7); const unsigned sb = rb / 7u; u.a += s * sb; u.b += s * sb; u.e3 = (int)q; u.nt = (int)(sb >> 7); return true; }
    __device__ __forceinline__ unsigned rowoff(const Unit&, int) const { return 0u; }
};

#define EPI_ROWS(ai, m) (128 * (ai) + 64 * wr + 16 * (m) + fr)
#define EPI_COL(bj) (128 * (bj) + 32 * wc + 8 * fq)
__device__ __forceinline__ u32x4 pack_acc8(const f32x4 a, const f32x4 b) { u32x4 w; w.x = pk2(a[0], a[1]); w.y = pk2(a[2], a[3]); w.z = pk2(b[0], b[1]); w.w = pk2(b[2], b[3]); return w; }

__device__ __forceinline__ unsigned pk4_u8(const f32x4 a) {
    unsigned w = 0u;
    w = __builtin_amdgcn_cvt_pk_u8_f32(fmaxf(a[0] * 255.f, 1.f), 0u, w); w = __builtin_amdgcn_cvt_pk_u8_f32(fmaxf(a[1] * 255.f, 1.f), 1u, w);
    w = __builtin_amdgcn_cvt_pk_u8_f32(fmaxf(a[2] * 255.f, 1.f), 2u, w); w = __builtin_amdgcn_cvt_pk_u8_f32(fmaxf(a[3] * 255.f, 1.f), 3u, w); return w; }
__device__ __forceinline__ u32x2 pack_gate8(const f32x4 a, const f32x4 b) { u32x2 w; w.x = pk4_u8(a); w.y = pk4_u8(b); return w; }
__device__ __forceinline__ size_t gate_off(int pm, int j, int b, int wr, int wc, int ai, int m, int bj, int fr, int fq) { return ((((size_t)((pm * 4 + j) * 4 + b) * 8 + wr * 4 + wc) * 16 + (ai * 4 + m) * 2 + bj) * 64 + fq * 16 + fr) * 8; }
__device__ __forceinline__ float gate8(unsigned w, int k) { return (float)((w >> (8 * k)) & 255u) * (1.f / 255.f); }
struct EpiPlain { static constexpr bool CARRY = false, LAUNDER = false, MID = false;
    bf16* O; int ld;
    __device__ __forceinline__ void operator()(const f32x4 (&acc)[2][2][4][2], const Unit& u, int wr, int wc, int fr, int fq) const {
#pragma unroll
        for (int ai = 0; ai < 2; ++ai)
#pragma unroll
            for (int m = 0; m < 4; ++m) { bf16* rowp = O + (size_t)(u.e0 * 256 + EPI_ROWS(ai, m)) * ld + u.e1 * 256;
#pragma unroll
                for (int bj = 0; bj < 2; ++bj) *(u32x4*)(rowp + EPI_COL(bj)) = pack_acc8(acc[ai][bj][m][0], acc[ai][bj][m][1]); }
    }
};
struct EpiPlainSplit { static constexpr bool CARRY = false, LAUNDER = false, MID = false;
    bf16* O; int ld; float* P; int nslice;
    __device__ __forceinline__ void operator()(const f32x4 (&acc)[2][2][4][2], const Unit& u, int wr, int wc, int fr, int fq) const {
        if (u.e2 == 0) {
#pragma unroll
            for (int ai = 0; ai < 2; ++ai)
#pragma unroll
                for (int m = 0; m < 4; ++m) { bf16* rowp = O + (size_t)(u.e0 * 256 + EPI_ROWS(ai, m)) * ld + u.e1 * 256;
#pragma unroll
                    for (int bj = 0; bj < 2; ++bj) *(u32x4*)(rowp + EPI_COL(bj)) = pack_acc8(acc[ai][bj][m][0], acc[ai][bj][m][1]); }
        } else { float* pt = P + (size_t)(u.e3 * nslice + (u.e2 - 1)) * 65536;
#pragma unroll
            for (int ai = 0; ai < 2; ++ai)
#pragma unroll
                for (int m = 0; m < 4; ++m)
#pragma unroll
                    for (int bj = 0; bj < 2; ++bj) { float* p = pt + EPI_ROWS(ai, m) * 256 + EPI_COL(bj); *(f32x4*)p = acc[ai][bj][m][0]; *(f32x4*)(p + 4) = acc[ai][bj][m][1]; }
        }
    }
};
struct EpiInprojA { static constexpr bool CARRY = false, LAUNDER = false, MID = false;
    bf16* INP; bf16* T; unsigned char* Gc;
    __device__ __forceinline__ void operator()(const f32x4 (&acc)[2][2][4][2], const Unit& u, int wr, int wc, int fr, int fq) const {
        if (u.e2 == 2) {
#pragma unroll
            for (int ai = 0; ai < 2; ++ai)
#pragma unroll
                for (int m = 0; m < 4; ++m)
#pragma unroll
                    for (int bj = 0; bj < 2; ++bj) { f32x4 a = acc[ai][bj][m][0], b = acc[ai][bj][m][1];
#pragma unroll
                        for (int j = 0; j < 4; ++j) { a[j] = sigm(a[j]); b[j] = sigm(b[j]); }
                        *(u32x2*)(Gc + gate_off(u.e0, u.e1 & 3, u.e1 >> 2, wr, wc, ai, m, bj, fr, fq)) = pack_gate8(a, b); }
        } else if (u.e2 == 0) {
            bf16* base = INP + (size_t)u.e1 * ((size_t)R * 256);
            const bool regroup = (u.e1 == 1);
#pragma unroll
            for (int ai = 0; ai < 2; ++ai)
#pragma unroll
                for (int m = 0; m < 4; ++m) { const int row = u.e0 * 256 + EPI_ROWS(ai, m);
#pragma unroll
                    for (int bj = 0; bj < 2; ++bj) { const int col = EPI_COL(bj);
                        bf16* p = regroup ? base + ((((size_t)(col >> 4) * 33 + (row >> 9)) * 16 + (row & 15)) * 64 + ((col & 8) << 2) + ((row >> 4) & 31)) * 8 : base + (size_t)row * 256 + col;
                        *(u32x4*)p = pack_acc8(acc[ai][bj][m][0], acc[ai][bj][m][1]); } }
        } else {
#pragma unroll
            for (int ai = 0; ai < 2; ++ai)
#pragma unroll
                for (int m = 0; m < 4; ++m) { bf16* rowp = T + (size_t)(u.e0 * 256 + EPI_ROWS(ai, m)) * R + u.e1 * 256;
#pragma unroll
                    for (int bj = 0; bj < 2; ++bj) *(u32x4*)(rowp + EPI_COL(bj)) = pack_acc8(acc[ai][bj][m][0], acc[ai][bj][m][1]); }
        }
    }
};
struct EpiGates { static constexpr bool CARRY = false, LAUNDER = false, MID = false;
    unsigned char* Gt; float isc;
    __device__ __forceinline__ void operator()(const f32x4 (&acc)[2][2][4][2], const Unit& u, int wr, int wc, int fr, int fq) const {
#pragma unroll
        for (int ai = 0; ai < 2; ++ai)
#pragma unroll
            for (int m = 0; m < 4; ++m)
#pragma unroll
                for (int bj = 0; bj < 2; ++bj) { f32x4 a = acc[ai][bj][m][0], b = acc[ai][bj][m][1];
#pragma unroll
                    for (int j = 0; j < 4; ++j) { a[j] = sigm(a[j] * isc); b[j] = sigm(b[j] * isc); }
                    *(u32x2*)(Gt + gate_off(u.e0, u.e1 & 3, u.e1 >> 2, wr, wc, ai, m, bj, fr, fq)) = pack_gate8(a, b); }
    }
};
struct EpiGlu { static constexpr bool CARRY = false, LAUNDER = false, MID = false;
    const bf16* Zz; bf16* Mix; const float* bglu;
    __device__ __forceinline__ void operator()(const f32x4 (&acc)[2][2][4][2], const Unit& u, int wr, int wc, int fr, int fq) const {
#pragma unroll
        for (int bj = 0; bj < 2; ++bj) { const int col = EPI_COL(bj);
            const f32x4 b0 = *(const f32x4*)(bglu + col), b1 = *(const f32x4*)(bglu + col + 4);
#pragma unroll
            for (int ai = 0; ai < 2; ++ai)
#pragma unroll
                for (int m = 0; m < 4; ++m) { const size_t row = (size_t)(u.e0 * 256 + EPI_ROWS(ai, m));
                    const u32x4 zz = *(const u32x4*)(Zz + row * 256 + col);
                    f32x4 a = acc[ai][bj][m][0] + b0, b = acc[ai][bj][m][1] + b1;
                    a[0] = bflo(zz.x) * sigm(a[0]); a[1] = bfhi(zz.x) * sigm(a[1]); a[2] = bflo(zz.y) * sigm(a[2]); a[3] = bfhi(zz.y) * sigm(a[3]);
                    b[0] = bflo(zz.z) * sigm(b[0]); b[1] = bfhi(zz.z) * sigm(b[1]); b[2] = bflo(zz.w) * sigm(b[2]); b[3] = bfhi(zz.w) * sigm(b[3]);
                    *(u32x4*)(Mix + row * 1024 + 256 + col) = pack_acc8(a, b); } }
    }
};
struct EpiMerge {
    static constexpr bool CARRY = false, LAUNDER = false, MID = true;
    const unsigned char* Gt; const unsigned char* Gc; bf16* Y; bf16* YP;
    __device__ __forceinline__ void mid(f32x4 (&acc)[2][2][4][2], const Unit& u, int b, int wr, int wc, int fr, int fq) const {
#pragma unroll
        for (int ai = 0; ai < 2; ++ai) {
            u32x2 g[4][2], gn[4][2];
#pragma unroll
            for (int m = 0; m < 4; ++m)
#pragma unroll
                for (int bj = 0; bj < 2; ++bj) { const unsigned char* gp = Gt + gate_off(u.e0, u.e1, b, wr, wc, ai, m, bj, fr, fq); g[m][bj] = *(const u32x2*)gp; gn[m][bj] = *(const u32x2*)(gp + 65536); }
#pragma unroll
            for (int m = 0; m < 4; ++m)
#pragma unroll
                for (int bj = 0; bj < 2; ++bj) { f32x4 a0 = acc[ai][bj][m][0], a1 = acc[ai][bj][m][1];
#pragma unroll
                    for (int j = 0; j < 4; ++j) { a0[j] *= gate8(g[m][bj].x, j) * rcpf_(gate8(gn[m][bj].x, j)); a1[j] *= gate8(g[m][bj].y, j) * rcpf_(gate8(gn[m][bj].y, j)); }
                    acc[ai][bj][m][0] = a0; acc[ai][bj][m][1] = a1; } }
    }
    __device__ __forceinline__ void operator()(const f32x4 (&acc)[2][2][4][2], const Unit& u, int wr, int wc, int fr, int fq) const {
        const int b = u.e3 ? u.e2 : 3;
#pragma unroll
        for (int ai = 0; ai < 2; ++ai)
#pragma unroll
            for (int m = 0; m < 4; ++m) { const size_t row = (size_t)(u.e0 * 256 + EPI_ROWS(ai, m));
                bf16* orow = (u.e3 ? YP + ((size_t)b * CROWS + (row - LROWS)) * 1024 : Y + row * 1024) + u.e1 * 256;
#pragma unroll
                for (int bj = 0; bj < 2; ++bj) { const u32x2 g = *(const u32x2*)((u.e3 ? Gc : Gt) + gate_off(u.e3 ? u.e0 - 64 : u.e0, u.e1, b, wr, wc, ai, m, bj, fr, fq)); f32x4 a0 = acc[ai][bj][m][0], a1 = acc[ai][bj][m][1];
#pragma unroll
                    for (int j = 0; j < 4; ++j) { a0[j] *= gate8(g.x, j); a1[j] *= gate8(g.y, j); }
                    *(u32x4*)(orow + EPI_COL(bj)) = pack_acc8(a0, a1); } }
    }
};
struct EpiSwiglu { static constexpr bool CARRY = false, LAUNDER = false, MID = false;
    bf16* Hd; int ldh; bool moe;
    __device__ __forceinline__ void operator()(const f32x4 (&acc)[2][2][4][2], const Unit& u, int wr, int wc, int fr, int fq) const {
        const int rowbase = moe ? u.e3 : u.e0 * 256, pn = moe ? u.e2 : u.e1;
#pragma unroll
        for (int ai = 0; ai < 2; ++ai)
#pragma unroll
            for (int m = 0; m < 4; ++m) { bf16* p = Hd + (size_t)(rowbase + EPI_ROWS(ai, m)) * ldh + pn * 128 + 32 * wc + 8 * fq;
                f32x4 a = acc[ai][0][m][0], b = acc[ai][0][m][1]; const f32x4 ua = acc[ai][1][m][0], ub = acc[ai][1][m][1];
#pragma unroll
                for (int j = 0; j < 4; ++j) { a[j] = silu_(a[j]) * ua[j]; b[j] = silu_(b[j]) * ub[j]; }
                *(u32x4*)p = pack_acc8(a, b); }
    }
};
struct EpiSwigluF8 { static constexpr bool CARRY = false, LAUNDER = true, MID = false;
    unsigned char* Hd; int ldh; bool moe; float ws, hs;
    __device__ __forceinline__ void operator()(const f32x4 (&acc)[2][2][4][2], const Unit& u, int wr, int wc, int fr, int fq) const {
        const int rowbase = moe ? u.e3 : u.e0 * 256, pn = moe ? u.e2 : u.e1; const float hs2 = hs * ws;
#pragma unroll
        for (int ai = 0; ai < 2; ++ai)
#pragma unroll
            for (int m = 0; m < 4; ++m) { unsigned char* p = Hd + (size_t)(rowbase + EPI_ROWS(ai, m)) * ldh + pn * 128 + 32 * wc + 8 * fq;
                f32x4 a = acc[ai][0][m][0], b = acc[ai][0][m][1]; const f32x4 ua = acc[ai][1][m][0], ub = acc[ai][1][m][1];
#pragma unroll
                for (int j = 0; j < 4; ++j) { a[j] = __builtin_amdgcn_fmed3f(silu_(a[j] * ws) * (ua[j] * hs2), -448.f, 448.f); b[j] = __builtin_amdgcn_fmed3f(silu_(b[j] * ws) * (ub[j] * hs2), -448.f, 448.f); }
                u32x2 w; w.x = pk4_f8(a[0], a[1], a[2], a[3]); w.y = pk4_f8(b[0], b[1], b[2], b[3]); *(u32x2*)p = w; }
    }
};
struct EpiMoeDown { static constexpr bool CARRY = false, LAUNDER = true, MID = false;
    bf16* Slot; const int* list; const float* routew; const LAS unsigned* mt; float osc;
    __device__ __forceinline__ void operator()(const f32x4 (&acc)[2][2][4][2], const Unit& u, int wr, int wc, int fr, int fq) const {
        const int cnt = (int)mt[u.e0];
#pragma unroll
        for (int ai = 0; ai < 2; ++ai)
#pragma unroll
            for (int m = 0; m < 4; ++m) { const int li = u.e1 * 256 + EPI_ROWS(ai, m);
                if (li < cnt) { const int ent = list[u.e0 * LCAP + li]; const float w = routew[ent] * osc;
                    bf16* rowp = Slot + ((size_t)(ent & 1) * LROWS + (size_t)(ent >> 1)) * 1024 + u.e2 * 256;
#pragma unroll
                    for (int bj = 0; bj < 2; ++bj) *(u32x4*)(rowp + EPI_COL(bj)) = pack_acc8(acc[ai][bj][m][0] * w, acc[ai][bj][m][1] * w); } }
    }
};
struct EpiMoePart { static constexpr bool CARRY = false, LAUNDER = true, MID = false;
    bf16* Pm; const int* list; const LAS unsigned* mt; int* smap; float osc;
    __device__ __forceinline__ void operator()(const f32x4 (&acc)[2][2][4][2], const Unit& u, int wr, int wc, int fr, int fq) const {
        const int cnt = (int)mt[u.e0], q = u.e3; bf16* pt = Pm + (size_t)q * 65536; const bool mapper = (q % 7 == 0) && wc == 0 && fq == 0;
#pragma unroll
        for (int ai = 0; ai < 2; ++ai)
#pragma unroll
            for (int m = 0; m < 4; ++m) { const int rl = EPI_ROWS(ai, m), li = u.e1 * 256 + rl;
#pragma unroll
                for (int bj = 0; bj < 2; ++bj) *(u32x4*)(pt + rl * 256 + EPI_COL(bj)) = pack_acc8(acc[ai][bj][m][0] * osc, acc[ai][bj][m][1] * osc);
                if (mapper && li < cnt) smap[list[u.e0 * LCAP + li] * 4 + u.e2] = ((q / 7) << 8) | rl; }
    }
};
}
#define DROW(reg, h) (((reg) & 3) + 8 * ((reg) >> 2) + 4 * (h))

__device__ __forceinline__ void s5_state_item(const bf16* M1F  , const bf16* SUF, float* HLOC, int item, int lane) {
    const int cb = item % 33, gd = item / 33, g = gd >> 1, dir = gd & 1, li = lane & 31, h = lane >> 5;
    const bf16* A = M1F + (size_t)(g * 2 + dir) * 128 * 256 + lane * 8;
    const bf16* B = SUF + (size_t)(g * 33 + cb) * 16 * 512 + lane * 8;
    f32x16 acc[4];
#pragma unroll
    for (int rt = 0; rt < 4; ++rt) acc[rt] = zero16();
    bf16x8 a0[2][4], b0[2], a1[2][4], b1[2];
#define S5S_LOAD(AA, BB, grp) do { _Pragma("unroll") for (int s = 0; s < 2; ++s) { const int ks = (grp) * 2 + s; BB[s] = ldg8(B + ks * 512); \
        _Pragma("unroll") for (int rt = 0; rt < 4; ++rt) AA[s][rt] = ldg8(A + (ks * 4 + rt) * 512); } } while (0)
#define S5S_MMA(AA, BB) do { _Pragma("unroll") for (int s = 0; s < 2; ++s) _Pragma("unroll") for (int rt = 0; rt < 4; ++rt) acc[rt] = mma32(AA[s][rt], BB[s], acc[rt]); } while (0)
    S5S_LOAD(a0, b0, 0);
#pragma unroll 1
    for (int gp = 0; gp < 8; gp += 2) {
        S5S_LOAD(a1, b1, gp + 1);
        S5S_MMA(a0, b0);
        if (gp + 2 < 8) S5S_LOAD(a0, b0, gp + 2);
        S5S_MMA(a1, b1);
    }
#undef S5S_LOAD
#undef S5S_MMA
    const int c = cb * 32 + li; float* o = HLOC + (((size_t)(g * 2 + dir) * (NCH16 / 2) + (c >> 1)) * 64) * 4 + (c & 1) * 2;
#pragma unroll
    for (int rt = 0; rt < 4; ++rt)
#pragma unroll
        for (int q = 0; q < 4; ++q) { const int p0 = 16 * rt + 4 * q + 2 * h;
            *(f32x2*)(o + (size_t)p0 * 4) = (f32x2){acc[rt][4 * q], acc[rt][4 * q + 1]}; *(f32x2*)(o + (size_t)(p0 + 1) * 4) = (f32x2){acc[rt][4 * q + 2], acc[rt][4 * q + 3]}; }
}
__device__ __forceinline__ void s5_scan_item(const float* A16  , const float* HLOC, bf16* HINF, LAS unsigned char* wl, int item, int lane) {
    const int dir = item & 1, g = (item >> 1) & 15, b = item >> 5, p = lane;
    const f32x2 a = *(const f32x2*)(A16 + ((size_t)(dir * 16 + g) * 64 + p) * 2);
    const float* src = HLOC + ((size_t)(g * 2 + dir) * (NCH16 / 2) * 64 + p) * 4;
    const int k2 = dir * 128 + 2 * p;
    bf16* dctx = HINF + ((size_t)(g * 33 + 32) * 16 + (k2 >> 4)) * 512 + ((k2 >> 3) & 1) * 256 + (k2 & 7);
    float hr = 0.f, hi = 0.f;
#define S5_STEP(xr, xi) do { const float nr_ = a.x * hr - a.y * hi + (xr), ni_ = a.x * hi + a.y * hr + (xi); hr = nr_; hi = ni_; } while (0)
    {
        f32x4 v[8];
#pragma unroll
        for (int j = 0; j < 8; ++j) v[j] = *(const f32x4*)(src + (size_t)(512 + 8 * b + (dir ? 7 - j : j)) * 256);
#pragma unroll
        for (int j = 0; j < 8; ++j) { const int cl0 = 16 * b + 2 * (dir ? 7 - j : j);
            if (!dir) { *(unsigned*)(dctx + (cl0) * 8) = pk2(hr, hi); S5_STEP(v[j][0], v[j][1]); *(unsigned*)(dctx + (cl0 + 1) * 8) = pk2(hr, hi); S5_STEP(v[j][2], v[j][3]); }
            else      { *(unsigned*)(dctx + (cl0 + 1) * 8) = pk2(hr, hi); S5_STEP(v[j][2], v[j][3]); *(unsigned*)(dctx + (cl0) * 8) = pk2(hr, hi); S5_STEP(v[j][0], v[j][1]); } }
    }
    const int pg = p >> 2; LAS unsigned char* wbase = wl + ((p >> 3) * 64 + (pg & 1) * 32) * 16 + 4 * (p & 3);
    f32x4 vn[16];
#pragma unroll
    for (int j = 0; j < 16; ++j) vn[j] = *(const f32x4*)(src + (size_t)(256 * b + (dir ? 255 - j : j)) * 256);
#pragma unroll 1
    for (int blk = 0; blk < 16; ++blk) {
        f32x4 v[16];
#pragma unroll
        for (int j = 0; j < 16; ++j) v[j] = vn[j];
        if (blk < 15) {
#pragma unroll
            for (int j = 0; j < 16; ++j) { const int pj = 16 * (blk + 1) + j; vn[j] = *(const f32x4*)(src + (size_t)(256 * b + (dir ? 255 - pj : pj)) * 256); } }
#pragma unroll
        for (int j = 0; j < 16; ++j) { const int pl = dir ? 15 - j : j;
            if (!dir) { *(LAS unsigned*)(wbase + ((2 * pl + pg) & 31) * 16) = pk2(hr, hi); S5_STEP(v[j][0], v[j][1]); *(LAS unsigned*)(wbase + ((2 * pl + 1 + pg) & 31) * 16) = pk2(hr, hi); S5_STEP(v[j][2], v[j][3]); }
            else      { *(LAS unsigned*)(wbase + ((2 * pl + 1 + pg) & 31) * 16) = pk2(hr, hi); S5_STEP(v[j][2], v[j][3]); *(LAS unsigned*)(wbase + ((2 * pl + pg) & 31) * 16) = pk2(hr, hi); S5_STEP(v[j][0], v[j][1]); } }
        const int cb = 16 * b + (dir ? 15 - blk : blk), hs = lane >> 5, cl = lane & 31;
        bf16* dout = HINF + ((size_t)(g * 33 + cb) * 16 + dir * 8) * 512 + lane * 8;
#pragma unroll
        for (int j = 0; j < 8; ++j) *(u32x4*)(dout + j * 512) = *(const LAS u32x4*)(wl + (j * 64 + hs * 32 + ((cl + 2 * j + hs) & 31)) * 16);
    }
#undef S5_STEP
}
__device__ __forceinline__ void s5_out_item(const bf16* TABF  , const bf16* SUF, const bf16* HINF, bf16* Z, int item, int lane) {
    const int mh = item & 1, it2 = item >> 1, cb = it2 % 33, g = it2 / 33, li = lane & 31, h = lane >> 5, c = cb * 32 + li;
    const bf16* A = TABF + ((size_t)g * 256 + mh * 128) * 512 + lane * 8;
    const bf16* B0 = SUF + (size_t)(g * 33 + cb) * 16 * 512 + lane * 8;
    const bf16* B1 = HINF + (size_t)(g * 33 + cb) * 16 * 512 + lane * 8;
    f32x16 acc[4];
#pragma unroll
    for (int rt = 0; rt < 4; ++rt) acc[rt] = zero16();
    bf16x8 a0[2][4], b0[2], a1[2][4], b1[2];
#define S5O_LOAD(AA, BB, grp) do { _Pragma("unroll") for (int s = 0; s < 2; ++s) { const int ks = (grp) * 2 + s; BB[s] = ldg8((ks < 16 ? B0 + ks * 512 : B1 + (ks - 16) * 512)); \
        _Pragma("unroll") for (int rt = 0; rt < 4; ++rt) AA[s][rt] = ldg8(A + (ks * 4 + rt) * 512); } } while (0)
#define S5O_MMA(AA, BB) do { _Pragma("unroll") for (int s = 0; s < 2; ++s) _Pragma("unroll") for (int rt = 0; rt < 4; ++rt) acc[rt] = mma32(AA[s][rt], BB[s], acc[rt]); } while (0)
    S5O_LOAD(a0, b0, 0);
#pragma unroll 1
    for (int gp = 0; gp < 16; gp += 2) {
        S5O_LOAD(a1, b1, gp + 1);
        S5O_MMA(a0, b0);
        if (gp + 2 < 16) S5O_LOAD(a0, b0, gp + 2);
        S5O_MMA(a1, b1);
    }
#undef S5O_LOAD
#undef S5O_MMA
#pragma unroll
    for (int rt = 0; rt < 4; ++rt)
#pragma unroll
        for (int q = 0; q < 4; ++q) {
            const int i = 8 * mh + 2 * rt + (q >> 1), ho0 = 8 * (q & 1) + 4 * h;
            u32x2 w; w.x = pk2(gelu_tanh(acc[rt][4 * q]), gelu_tanh(acc[rt][4 * q + 1])); w.y = pk2(gelu_tanh(acc[rt][4 * q + 2]), gelu_tanh(acc[rt][4 * q + 3]));
            *(u32x2*)(Z + ((size_t)c * 16 + i) * 256 + g * 16 + ho0) = w; }
}

__device__ __forceinline__ int ret_tok0(int b, int n) { return n < 64 ? b * SEQ + n * 128 : LROWS + b * CTXL + (n - 64) * 128; }
__device__ __forceinline__ void ret_kv_item(const bf16* RKT, const bf16* RVT, const float* COST, const float* SINT, const float* decay  , float* KV, int item, int lane) {
    const int n = item % 66, bh = item / 66, hd = bh & 3, b = bh >> 2, li = lane & 31, h = lane >> 5;
    const int tok0 = ret_tok0(b, n); const bool lat = n < 64;
    const float lgf = -log2f(1.f + __expf(-decay[hd])), lgr = -log2f(1.f + __expf(-decay[4 + hd]));
    f32x16 acc[2][2][2];
#pragma unroll
    for (int a = 0; a < 2; ++a)
#pragma unroll
        for (int c = 0; c < 2; ++c)
#pragma unroll
            for (int d = 0; d < 2; ++d) acc[a][c][d] = zero16();
    const bf16* k0p = RKT + (size_t)(hd * 64 + li) * R + tok0 + 8 * h;
    const bf16* v0p = RVT + (size_t)(hd * 64 + li) * R + tok0 + 8 * h;
#pragma unroll 2
    for (int ks = 0; ks < 8; ++ks) {
        float k1[8], k2[8];
        unpack8(ldg8(k0p + ks * 16), k1); unpack8(ldg8(k0p + (size_t)32 * R + ks * 16), k2);
        if (lat) {
            const float* cp = COST + (size_t)li * SEQ + n * 128 + ks * 16 + 8 * h; const float* sp = SINT + (size_t)li * SEQ + n * 128 + ks * 16 + 8 * h;
            const f32x4 c0 = *(const f32x4*)cp, c1 = *(const f32x4*)(cp + 4), s0 = *(const f32x4*)sp, s1 = *(const f32x4*)(sp + 4);
#pragma unroll
            for (int j = 0; j < 8; ++j) { const float cc = j < 4 ? c0[j & 3] : c1[j & 3], ss = j < 4 ? s0[j & 3] : s1[j & 3];
                const float x1 = k1[j], x2 = k2[j]; k1[j] = x1 * cc - x2 * ss; k2[j] = x1 * ss + x2 * cc; }
        }
        const bf16x8 vf0 = ldg8(v0p + ks * 16), vf1 = ldg8(v0p + (size_t)32 * R + ks * 16);
#pragma unroll
        for (int dir = 0; dir < 2; ++dir) {
            float a1[8], a2[8];
#pragma unroll
            for (int j = 0; j < 8; ++j) { const int i = ks * 16 + 8 * h + j; const float w = dir == 0 ? ex2(lgf * (float)(127 - i)) : ex2(lgr * (float)i); a1[j] = k1[j] * w; a2[j] = k2[j] * w; }
            const bf16x8 kd0 = pack8(a1), kd1 = pack8(a2);
            acc[dir][0][0] = mma32(kd0, vf0, acc[dir][0][0]); acc[dir][0][1] = mma32(kd0, vf1, acc[dir][0][1]);
            acc[dir][1][0] = mma32(kd1, vf0, acc[dir][1][0]); acc[dir][1][1] = mma32(kd1, vf1, acc[dir][1][1]);
        }
    }
#pragma unroll
    for (int dir = 0; dir < 2; ++dir) { float* o = KV + ((size_t)((b * 4 + hd) * 2 + dir) * 66 + n) * 4096;
#pragma unroll
        for (int dt = 0; dt < 2; ++dt)
#pragma unroll
            for (int et = 0; et < 2; ++et)
#pragma unroll
                for (int q = 0; q < 4; ++q) *(f32x4*)(o + (size_t)(et * 32 + li) * 64 + dt * 32 + 8 * q + 4 * h) = (f32x4){acc[dir][dt][et][4 * q], acc[dir][dt][et][4 * q + 1], acc[dir][dt][et][4 * q + 2], acc[dir][dt][et][4 * q + 3]}; }
}
__device__ __forceinline__ void ret_scan_item(const float* decay, const float* KV, bf16* SPREV, int item, int lane) {
    const int blk = item & 63, bhd = item >> 6, dir = bhd & 1, hd = (bhd >> 1) & 3, idx = blk * 64 + lane;
    const float lg = -log2f(1.f + __expf(-decay[dir * 4 + hd])), cd = ex2(128.f * lg);
    const float* src = KV + (size_t)bhd * 66 * 4096 + idx; bf16* dst = SPREV + (size_t)bhd * 66 * 4096 + idx;
    float s = 0.f;
    for (int s0 = 0; s0 < 66; s0 += 11) {
        float v[11];
#pragma unroll
        for (int j = 0; j < 11; ++j) { const int t = s0 + j; const int n = dir == 0 ? (t < 2 ? 64 + t : t - 2) : (t < 2 ? 65 - t : 65 - t); v[j] = src[(size_t)n * 4096]; }
#pragma unroll
        for (int j = 0; j < 11; ++j) { const int t = s0 + j; const int n = dir == 0 ? (t < 2 ? 64 + t : t - 2) : (t < 2 ? 65 - t : 65 - t); dst[(size_t)n * 4096] = (bf16)(pk2(s, 0.f) & 0xffffu); s = cd * s + v[j]; }
    }
}
struct KVTile { u32x4 k[4], v[4]; };
__device__ __forceinline__ void kv_tile_load(KVTile& T, const bf16* Kh  , const bf16* VTh  , int tok0, int lane) {
#pragma unroll
    for (int i = 0; i < 4; ++i) T.k[i] = *(const u32x4*)(Kh + (size_t)(tok0 + 8 * i + (lane >> 3)) * 256 + (lane & 7) * 8);
#pragma unroll
    for (int i = 0; i < 4; ++i) T.v[i] = *(const u32x4*)(VTh + (size_t)(16 * i + (lane >> 2)) * R + tok0 + (lane & 3) * 8);
}
__device__ __forceinline__ void kv_tile_store(const KVTile& T, LAS unsigned char* wl, int lane) {
#pragma unroll
    for (int i = 0; i < 4; ++i) *(LAS u32x4*)(wl + (8 * i + (lane >> 3)) * 144 + (lane & 7) * 16) = T.k[i];
#pragma unroll
    for (int i = 0; i < 4; ++i) *(LAS u32x4*)(wl + 4608 + (16 * i + (lane >> 2)) * 80 + (lane & 3) * 16) = T.v[i];
}
__device__ __forceinline__ void kv_tile_frags(const LAS unsigned char* wl, int lane, bf16x8 (&kf)[4], bf16x8 (&vf)[2][2]) {
    const int li = lane & 31, h = lane >> 5;
#pragma unroll
    for (int s = 0; s < 4; ++s) kf[s] = *(const LAS bf16x8*)(wl + li * 144 + (2 * s + h) * 16);
#pragma unroll
    for (int et = 0; et < 2; ++et)
#pragma unroll
        for (int s2 = 0; s2 < 2; ++s2) { const LAS unsigned char* p = wl + 4608 + (et * 32 + li) * 80 + s2 * 32 + 8 * h;
            const bf16x4 lo = *(const LAS bf16x4*)p, hi = *(const LAS bf16x4*)(p + 16); vf[et][s2] = __builtin_shufflevector(lo, hi, 0, 1, 2, 3, 4, 5, 6, 7); }
}

__device__ __forceinline__ void rope_item(bf16* RQ, bf16* RK, const float* COSN, const float* SINN, int item, int lane) {
    const int u = lane & 15, off = (u >> 2) * 64 + (u & 3) * 8, c8 = (u & 3) * 8;
#pragma unroll 4
    for (int st = 0; st < 32; ++st) { const int row = item * 128 + 4 * st + (lane >> 4), tl = row & (SEQ - 1);
        const f32x4 c0 = *(const f32x4*)(COSN + (size_t)tl * 32 + c8), c1 = *(const f32x4*)(COSN + (size_t)tl * 32 + c8 + 4), s0 = *(const f32x4*)(SINN + (size_t)tl * 32 + c8), s1 = *(const f32x4*)(SINN + (size_t)tl * 32 + c8 + 4);
#pragma unroll
        for (int w = 0; w < 2; ++w) { bf16* p = (w ? RK : RQ) + (size_t)row * 256 + off; float x1[8], x2[8]; unpack8(*(const bf16x8*)p, x1); unpack8(*(const bf16x8*)(p + 32), x2);
#pragma unroll
            for (int j = 0; j < 8; ++j) { const float cc = j < 4 ? c0[j & 3] : c1[j & 3], ss = j < 4 ? s0[j & 3] : s1[j & 3]; const float a = x1[j], bb = x2[j]; x1[j] = a * cc - bb * ss; x2[j] = a * ss + bb * cc; }
            *(bf16x8*)p = pack8(x1); *(bf16x8*)(p + 32) = pack8(x2); } }
}
__device__ __forceinline__ void ret_out_item(const bf16* RQ, const bf16* RK, const bf16* RG, const bf16* RVT, const bf16* SPREV, const float* decay, const float* gn  , bf16* MIX,
                                             LAS unsigned char* wl, int item, int lane) {
    const int qb = item & 3, it2 = item >> 2, n = it2 % 66, bh = it2 / 66, hd = bh & 3, b = bh >> 2, li = lane & 31, h = lane >> 5;
    const int tok0 = ret_tok0(b, n);
    const float lgf = -log2f(1.f + __expf(-decay[hd])), lgr = -log2f(1.f + __expf(-decay[4 + hd]));
    const int iq = qb * 32 + li;
    const bf16* Kh = RK + hd * 64; const bf16* VTh = RVT + (size_t)hd * 64 * R;
    KVTile T; kv_tile_load(T, Kh, VTh, tok0, lane);
    bf16x8 qf[4];
    { const bf16* qp = RQ + (size_t)(tok0 + iq) * 256 + hd * 64 + 8 * h;
#pragma unroll
      for (int s = 0; s < 4; ++s) qf[s] = ldg8(qp + 16 * s); }
    kv_tile_store(T, wl, lane);
    f32x16 accO[2] = {zero16(), zero16()};
#pragma unroll 1
    for (int kt = 0; kt < 4; ++kt) {
        kv_tile_load(T, Kh, VTh, tok0 + (kt < 3 ? kt + 1 : kt) * 32, lane);
        bf16x8 kf[4], vf[2][2]; kv_tile_frags(wl, lane, kf, vf);
        f32x16 st = zero16();
#pragma unroll
        for (int s = 0; s < 4; ++s) st = mma32(kf[s], qf[s], st);
#pragma unroll
        for (int r = 0; r < 16; ++r) { const int j = kt * 32 + DROW(r, h), df = iq - j;
            const float w = df > 0 ? ex2(lgf * (float)df) : (df < 0 ? ex2(lgr * (float)(-df)) : 2.f); st[r] *= w; }
        const bf16x8 p0 = accB<0>(st), p1 = accB<1>(st);
        accO[0] = mma32(vf[0][0], p0, accO[0]); accO[0] = mma32(vf[0][1], p1, accO[0]); accO[1] = mma32(vf[1][0], p0, accO[1]); accO[1] = mma32(vf[1][1], p1, accO[1]);
        kv_tile_store(T, wl, lane);
    }
    const float cf = ex2(lgf * (float)(iq + 1)), cr = ex2(lgr * (float)(128 - iq));
#pragma unroll
    for (int dir = 0; dir < 2; ++dir) { const bf16* sp = SPREV + ((size_t)((b * 4 + hd) * 2 + dir) * 66 + n) * 4096;
#pragma unroll
        for (int et = 0; et < 2; ++et) { f32x16 a = zero16();
#pragma unroll
            for (int s = 0; s < 4; ++s) a = mma32(ldg8(sp + (size_t)(et * 32 + li) * 64 + 16 * s + 8 * h), qf[s], a);
            const float sc = dir == 0 ? cf : cr;
#pragma unroll
            for (int r = 0; r < 16; ++r) accO[et][r] += sc * a[r]; } }
    float s1 = 0.f;
#pragma unroll
    for (int et = 0; et < 2; ++et)
#pragma unroll
        for (int r = 0; r < 16; ++r) s1 += accO[et][r];
    s1 = xor32_sum(s1); const float mu = s1 * (1.f / 64.f);
    float s2 = 0.f;
#pragma unroll
    for (int et = 0; et < 2; ++et)
#pragma unroll
        for (int r = 0; r < 16; ++r) { const float dlt = accO[et][r] - mu; s2 += dlt * dlt; }
    s2 = xor32_sum(s2); const float rstd = __builtin_amdgcn_rsqf(s2 * (1.f / 64.f) + EPSN);
    const size_t tok = (size_t)(tok0 + iq);
#pragma unroll
    for (int et = 0; et < 2; ++et)
#pragma unroll
        for (int q = 0; q < 4; ++q) { const int e0 = hd * 64 + et * 32 + 8 * q + 4 * h;
            const f32x4 gv = *(const f32x4*)(gn + e0); const u32x2 gg = *(const u32x2*)(RG + tok * 256 + e0);
            const float g0 = bflo(gg.x), g1 = bfhi(gg.x), g2 = bflo(gg.y), g3 = bfhi(gg.y);
            u32x2 w; w.x = pk2(silu_(g0) * (accO[et][4 * q] - mu) * rstd * gv[0], silu_(g1) * (accO[et][4 * q + 1] - mu) * rstd * gv[1]);
            w.y = pk2(silu_(g2) * (accO[et][4 * q + 2] - mu) * rstd * gv[2], silu_(g3) * (accO[et][4 * q + 3] - mu) * rstd * gv[3]);
            *(u32x2*)(MIX + tok * 1024 + 512 + e0) = w; }
}

__device__ __forceinline__ int na_tile_tok(int t, int b, int rs) { const int tb = t - 8; return t >= 8 ? b * SEQ + (rs + (tb >> 1)) * 64 + (tb & 1) * 32 : LROWS + b * CTXL + t * 32; }
__device__ __forceinline__ void na_item(const bf16* NQ, const bf16* NK, const bf16* NVT, bf16* MIX, const LAS float* rpb2, LAS unsigned char* wl, bool ctxq, int b, int r, int hd, int qs, int lane) {
    const int li = lane & 31, h = lane >> 5;
    const int tokq = ctxq ? LROWS + b * CTXL + qs * 32 + li : b * SEQ + r * 64 + qs * 32 + li;
    bf16x8 qf[4];
#pragma unroll
    for (int s = 0; s < 4; ++s) qf[s] = ldg8(NQ + (size_t)tokq * 256 + hd * 64 + 16 * s + 8 * h);
    float mrun = -1e30f, lrun = 0.f;
    f32x16 accO[2] = {zero16(), zero16()};
    const int rs = r - 4 < 0 ? 0 : (r - 4 > 120 ? 120 : r - 4);
    const int qc = qs * 32 + li, cs = qc - 8 < 0 ? 0 : (qc - 8 > 48 ? 48 : qc - 8);
    const int ntile = ctxq ? 8 : 24;
    const float c1 = 0.125f * LOG2E;
    const bf16* Kh = NK + hd * 64; const bf16* VTh = NVT + (size_t)hd * 64 * R;
    KVTile T; kv_tile_load(T, Kh, VTh, na_tile_tok(0, b, rs), lane); kv_tile_store(T, wl, lane);
#pragma unroll 1
    for (int t = 0; t < ntile; ++t) {
        const bool band = t >= 8; const int tb = t - 8, rr = rs + (tb >> 1), ct = tb & 1;
        kv_tile_load(T, Kh, VTh, na_tile_tok(t + 1 < ntile ? t + 1 : t, b, rs), lane);
        bf16x8 kf[4], vf[2][2]; kv_tile_frags(wl, lane, kf, vf);
        f32x16 st = zero16();
#pragma unroll
        for (int s = 0; s < 4; ++s) st = mma32(kf[s], qf[s], st);
        float mt = -INFINITY;
        if (band) { const int dr = rr - r + 7; const LAS float* bp = rpb2 + ((hd * 15 + dr) * 31 + 32 * ct - qc + 15 + 4 * h); const int d0 = 32 * ct + 4 * h - cs;
#pragma unroll
            for (int g = 0; g < 16; ++g) { const int o = 8 * (g >> 2) + (g & 3); const bool inw = (unsigned)(d0 + o) < 16u;
                const float v = inw ? st[g] * c1 + bp[o] : -INFINITY; st[g] = v; mt = fmaxf(mt, v); }
        } else {
#pragma unroll
            for (int g = 0; g < 16; ++g) { const float v = st[g] * c1; st[g] = v; mt = fmaxf(mt, v); }
        }
        mt = xor32_max(mt);
        const float mnew = fmaxf(mrun, mt);
        if (__builtin_amdgcn_ballot_w64(mnew > mrun)) { const float alpha = ex2(mrun - mnew); lrun *= alpha;
#pragma unroll
            for (int et = 0; et < 2; ++et)
#pragma unroll
                for (int g = 0; g < 16; ++g) accO[et][g] *= alpha; }
        mrun = mnew;
        float ps = 0.f;
#pragma unroll
        for (int g = 0; g < 16; ++g) { const float p = ex2(st[g] - mnew); st[g] = p; ps += p; }
        lrun += xor32_sum(ps);
        const bf16x8 p0 = accB<0>(st), p1 = accB<1>(st);
        accO[0] = mma32(vf[0][0], p0, accO[0]); accO[0] = mma32(vf[0][1], p1, accO[0]); accO[1] = mma32(vf[1][0], p0, accO[1]); accO[1] = mma32(vf[1][1], p1, accO[1]);
        kv_tile_store(T, wl, lane);
    }
    const float inv = 1.f / lrun;
#pragma unroll
    for (int et = 0; et < 2; ++et)
#pragma unroll
        for (int q = 0; q < 4; ++q) { u32x2 w; w.x = pk2(accO[et][4 * q] * inv, accO[et][4 * q + 1] * inv); w.y = pk2(accO[et][4 * q + 2] * inv, accO[et][4 * q + 3] * inv);
            *(u32x2*)(MIX + (size_t)tokq * 1024 + 768 + hd * 64 + et * 32 + 8 * q + 4 * h) = w; }
}

__device__ __forceinline__ void fft1_item(const bf16* F, const bf16* W128T, const float* TWC, const float* TWS, bf16* FB, int item, int lane) {
    const int l2 = item & 63, g = (item >> 6) & 3, b = item >> 8, li = lane & 31, h = lane >> 5;
    bf16x8 idf[4];
#pragma unroll
    for (int s = 0; s < 4; ++s) { float v[8];
#pragma unroll
        for (int j = 0; j < 8; ++j) v[j] = (16 * (s & 1) + 8 * h + j == li) ? 1.f : 0.f;
        idf[s] = pack8(v); }
    bf16x8 xb[4][2][2];
#pragma unroll
    for (int lt = 0; lt < 4; ++lt) {
        const bf16* xp = F + (size_t)(b * SEQ + 64 * (lt * 32 + li) + l2) * 256 + g * 64 + 8 * h;
        const bf16x8 x0 = ldg8(xp), x1 = ldg8(xp + 16), x2 = ldg8(xp + 32), x3 = ldg8(xp + 48);
        f32x16 c0 = zero16(), c1 = zero16();
        c0 = mma32(x0, idf[0], c0); c0 = mma32(x1, idf[1], c0);
        c1 = mma32(x2, idf[0], c1); c1 = mma32(x3, idf[1], c1);
        xb[lt][0][0] = accB<0>(c0); xb[lt][0][1] = accB<1>(c0); xb[lt][1][0] = accB<0>(c1); xb[lt][1][1] = accB<1>(c1);
    }
#pragma unroll 1
    for (int kb = 0; kb < 4; ++kb) {
        f32x16 acc[2][2];
#pragma unroll
        for (int ri = 0; ri < 2; ++ri) { acc[ri][0] = zero16(); acc[ri][1] = zero16();
            const bf16* wp = W128T + ((size_t)ri * 128 + kb * 32 + li) * 128 + 4 * h;
#pragma unroll
            for (int lt = 0; lt < 4; ++lt)
#pragma unroll
                for (int s = 0; s < 2; ++s) { const bf16x8 wf = ldg8p(wp + lt * 32 + 16 * s);
                    acc[ri][0] = mma32(wf, xb[lt][0][s], acc[ri][0]); acc[ri][1] = mma32(wf, xb[lt][1][s], acc[ri][1]); } }
#pragma unroll
        for (int q = 0; q < 4; ++q) { const int k1 = kb * 32 + 8 * q + 4 * h;
            const f32x4 tc = *(const f32x4*)(TWC + l2 * 128 + k1), ts = *(const f32x4*)(TWS + l2 * 128 + k1);
#pragma unroll
            for (int j = 0; j < 4; ++j)
#pragma unroll
                for (int ct = 0; ct < 2; ++ct) { const float ar = acc[0][ct][4 * q + j], ai = acc[1][ct][4 * q + j];
                    const float br = ar * tc[j] + ai * ts[j], bi = ai * tc[j] - ar * ts[j];
                    bf16* o = FB + ((((size_t)(b * 4 + g) * 128 + k1 + j) * 2) * 64 + l2) * 64 + ct * 32 + li;
                    o[0] = (bf16)(pk2(br, 0.f) & 0xffffu); o[64 * 64] = (bf16)(pk2(bi, 0.f) & 0xffffu); } }
    }
}
__device__ __forceinline__ void fft2_item(const bf16* FB, const bf16* FCT, const bf16* W64T, bf16* MIX, int item, int lane) {
    const int mh = item & 1, k1 = (item >> 1) & 127, g = (item >> 8) & 3, b = item >> 10, li = lane & 31, h = lane >> 5;
    const bf16* br = FB + (((size_t)(b * 4 + g) * 128 + k1) * 2) * 64 * 64; const bf16* bi = br + 64 * 64;
    const bf16* fc = FCT + (size_t)(mh * 32 + li) * 64 + 8 * h; const bf16* fs = fc + 64 * 64; const bf16* fn = fc + 2 * 64 * 64;
    bf16x8 eb[2][2][2];
#pragma unroll
    for (int lt = 0; lt < 2; ++lt) { f32x16 er = zero16(), ei = zero16();
#pragma unroll
        for (int s = 0; s < 4; ++s) { const bf16x8 ar = ldg8(br + (size_t)(lt * 32 + li) * 64 + 16 * s + 8 * h), ai = ldg8(bi + (size_t)(lt * 32 + li) * 64 + 16 * s + 8 * h);
            const bf16x8 c = ldg8(fc + 16 * s), sn = ldg8(fs + 16 * s), ns = ldg8(fn + 16 * s);
            er = mma32(ar, c, er); er = mma32(ai, sn, er); ei = mma32(ai, c, ei); ei = mma32(ar, ns, ei); }
        eb[lt][0][0] = accB<0>(er); eb[lt][0][1] = accB<1>(er); eb[lt][1][0] = accB<0>(ei); eb[lt][1][1] = accB<1>(ei); }
#pragma unroll
    for (int kt = 0; kt < 2; ++kt) { f32x16 o = zero16();
        const bf16* wc = W64T + (size_t)(kt * 32 + li) * 64 + 4 * h; const bf16* wsn = wc + 64 * 64;
#pragma unroll
        for (int lt = 0; lt < 2; ++lt)
#pragma unroll
            for (int s = 0; s < 2; ++s) { o = mma32(ldg8p(wc + lt * 32 + 16 * s), eb[lt][0][s], o); o = mma32(ldg8p(wsn + lt * 32 + 16 * s), eb[lt][1][s], o); }
#pragma unroll
        for (int rg = 0; rg < 16; ++rg) { const int k2 = kt * 32 + DROW(rg, h);
            MIX[(size_t)(b * SEQ + k1 + 128 * k2) * 1024 + g * 64 + mh * 32 + li] = (bf16)(pk2(o[rg], 0.f) & 0xffffu); } }
}
__device__ __forceinline__ void fftc_item(const bf16* F, const bf16* FCT, const bf16* W256T, bf16* MIX, int item, int lane) {
    const int mh = item & 1, kb = (item >> 1) & 7, g = (item >> 4) & 3, b = item >> 6, li = lane & 31, h = lane >> 5;
    const bf16* fc = FCT + (size_t)(mh * 32 + li) * 64 + 8 * h; const bf16* fn = fc + 2 * 64 * 64;
    const bf16* wc = W256T + (size_t)(kb * 32 + li) * 256 + 4 * h; const bf16* wsn = wc + 256 * 256;
    f32x16 o = zero16();
#pragma unroll 1
    for (int lt = 0; lt < 8; ++lt) { f32x16 zr = zero16(), zi = zero16();
        const bf16* xp = F + (size_t)(LROWS + b * CTXL + lt * 32 + li) * 256 + g * 64 + 8 * h;
#pragma unroll
        for (int s = 0; s < 4; ++s) { const bf16x8 x = ldg8(xp + 16 * s); zr = mma32(x, ldg8(fc + 16 * s), zr); zi = mma32(x, ldg8(fn + 16 * s), zi); }
        o = mma32(ldg8p(wc + lt * 32), accB<0>(zr), o); o = mma32(ldg8p(wc + lt * 32 + 16), accB<1>(zr), o);
        o = mma32(ldg8p(wsn + lt * 32), accB<0>(zi), o); o = mma32(ldg8p(wsn + lt * 32 + 16), accB<1>(zi), o); }
#pragma unroll
    for (int rg = 0; rg < 16; ++rg) { const int k = kb * 32 + DROW(rg, h);
        MIX[(size_t)(LROWS + b * CTXL + k) * 1024 + g * 64 + mh * 32 + li] = (bf16)(pk2(o[rg], 0.f) & 0xffffu); }
}
__device__ __forceinline__ void row_ld_f32(const float* p, int lane, f32x4 (&v)[4]) {
#pragma unroll
    for (int j = 0; j < 4; ++j) v[j] = *(const f32x4*)(p + 256 * j + 4 * lane); }
__device__ __forceinline__ void row_ld_bf16(const bf16* p, int lane, f32x4 (&v)[4]) {
#pragma unroll
    for (int j = 0; j < 4; ++j) { const u32x2 w = *(const u32x2*)(p + 256 * j + 4 * lane); v[j] = (f32x4){bflo(w.x), bfhi(w.x), bflo(w.y), bfhi(w.y)}; } }
__device__ __forceinline__ void row_ld_part(const float* P, int nslice, int r, int lane, f32x4 (&v)[4]) {
#pragma unroll
    for (int j = 0; j < 4; ++j) { const float* p = P + ((size_t)((((r - LROWS) >> 8) * 4 + j) * nslice) * 256 + (r & 255)) * 256 + 4 * lane; f32x4 s = *(const f32x4*)p;
        for (int k = 1; k < nslice; ++k) s = s + *(const f32x4*)(p + (size_t)k * 65536);
        v[j] = s; } }
__device__ __forceinline__ void row_st_f32(float* p, int lane, const f32x4 (&v)[4]) {
#pragma unroll
    for (int j = 0; j < 4; ++j) *(f32x4*)(p + 256 * j + 4 * lane) = v[j]; }
__device__ __forceinline__ void row_st_bf16(bf16* p, int lane, const f32x4 (&v)[4]) {
#pragma unroll
    for (int j = 0; j < 4; ++j) { u32x2 w; w.x = pk2(v[j][0], v[j][1]); w.y = pk2(v[j][2], v[j][3]); *(u32x2*)(p + 256 * j + 4 * lane) = w; } }
__device__ __forceinline__ void row_st_f8(unsigned char* p, int lane, const f32x4 (&v)[4]) {
#pragma unroll
    for (int j = 0; j < 4; ++j) *(unsigned*)(p + 256 * j + 4 * lane) = pk4_f8(v[j][0], v[j][1], v[j][2], v[j][3]); }
__device__ __forceinline__ float row_rstd(const f32x4 (&v)[4]) { float s = 0.f;
#pragma unroll
    for (int j = 0; j < 4; ++j) s += (v[j][0] * v[j][0] + v[j][1] * v[j][1]) + (v[j][2] * v[j][2] + v[j][3] * v[j][3]);
    return __builtin_amdgcn_rsqf(wave_sum(s) * (1.f / 1024.f) + EPSN); }
__device__ __forceinline__ void row_modnorm(const f32x4 (&x)[4], const float* g, const float* sc, const float* sh, int lane, f32x4 (&hh)[4]) {
    const float rs = row_rstd(x); f32x4 gv[4], scv[4], shv[4]; row_ld_f32(g, lane, gv); row_ld_f32(sc, lane, scv); row_ld_f32(sh, lane, shv);
#pragma unroll
    for (int j = 0; j < 4; ++j) hh[j] = x[j] * rs * gv[j] * (scv[j] + 1.f) + shv[j]; }
__device__ __forceinline__ void row_resid(f32x4 (&x)[4], const f32x4 (&t)[4], const float* g, const float* gate, int lane) {
    const float rs = row_rstd(t); f32x4 gv[4], ga[4]; row_ld_f32(g, lane, gv); row_ld_f32(gate, lane, ga);
#pragma unroll
    for (int j = 0; j < 4; ++j) x[j] = x[j] + ga[j] * (t[j] * rs * gv[j]); }

struct NormCfg {
    const float* xin_lat; const float* xin_ctx;
    float* xout_lat; float* xout_ctx;
    const bf16* trow;
    const float* tpart; int npart;
    const float* gA; const float* modA; int gate_off;
    const float* gB; const float* modB; int sc_off, sh_off; bf16* hout;
    int nrows;
    unsigned char* hout8;
    const bf16* xin_b; bf16* xout_b;
};
__device__ __forceinline__ void row_ld_raw16(const bf16* p, int lane, u32x2 (&w)[4]) {
#pragma unroll
    for (int j = 0; j < 4; ++j) w[j] = *(const u32x2*)(p + 256 * j + 4 * lane); }
__device__ __forceinline__ void norm_rows(const NormCfg& C, int wslot, int NW, int lane) {
    const int nlat = C.nrows < LROWS ? C.nrows : LROWS;
    int r = wslot;
    if (r < nlat) {
        int cur = -1; f32x4 gav[4], scv[4], shv[4];
        f32x4 xn[4]; u32x2 tn[4], xb[4];
#pragma unroll
        for (int j = 0; j < 4; ++j) { tn[j] = (u32x2){0u, 0u}; xb[j] = (u32x2){0u, 0u}; xn[j] = gav[j] = scv[j] = shv[j] = (f32x4){0.f, 0.f, 0.f, 0.f}; }
        f32x4 gAv[4], gBv[4];
#pragma unroll
        for (int j = 0; j < 4; ++j) gAv[j] = gBv[j] = (f32x4){0.f, 0.f, 0.f, 0.f};
        if (C.trow) row_ld_f32(C.gA, lane, gAv);
        if (C.gB) row_ld_f32(C.gB, lane, gBv);
        if (C.xin_b) row_ld_raw16(C.xin_b + (size_t)r * D, lane, xb); else row_ld_f32(C.xin_lat + (size_t)r * D, lane, xn);
        if (C.trow) {
#pragma unroll
            for (int j = 0; j < 4; ++j) tn[j] = *(const u32x2*)(C.trow + (size_t)r * D + 256 * j + 4 * lane); }
        for (; r < nlat; r += NW) {
            f32x4 x[4]; u32x2 tr[4];
#pragma unroll
            for (int j = 0; j < 4; ++j) { x[j] = C.xin_b ? (f32x4){bflo(xb[j].x), bfhi(xb[j].x), bflo(xb[j].y), bfhi(xb[j].y)} : xn[j]; tr[j] = tn[j]; }
            const int r2 = r + NW;
            if (r2 < nlat) { if (C.xin_b) row_ld_raw16(C.xin_b + (size_t)r2 * D, lane, xb); else row_ld_f32(C.xin_lat + (size_t)r2 * D, lane, xn);
                if (C.trow) {
#pragma unroll
                    for (int j = 0; j < 4; ++j) tn[j] = *(const u32x2*)(C.trow + (size_t)r2 * D + 256 * j + 4 * lane); } }
            const int ci = r < SEQ ? 0 : 1;
            if (ci != cur) { cur = ci;
                if (C.trow) row_ld_f32(C.modA + (size_t)ci * 6144 + C.gate_off, lane, gav);
                if (C.gB) { row_ld_f32(C.modB + (size_t)ci * 6144 + C.sc_off, lane, scv); row_ld_f32(C.modB + (size_t)ci * 6144 + C.sh_off, lane, shv); } }
            if (C.trow) { f32x4 t[4];
#pragma unroll
                for (int j = 0; j < 4; ++j) t[j] = (f32x4){bflo(tr[j].x), bfhi(tr[j].x), bflo(tr[j].y), bfhi(tr[j].y)};
                const float rs = row_rstd(t);
#pragma unroll
                for (int j = 0; j < 4; ++j) x[j] = x[j] + gav[j] * (t[j] * rs * gAv[j]);
                if (C.xout_b) row_st_bf16(C.xout_b + (size_t)r * D, lane, x); else row_st_f32(C.xout_lat + (size_t)r * D, lane, x); }
            if (C.gB) { const float rs = row_rstd(x); f32x4 hh[4];
#pragma unroll
                for (int j = 0; j < 4; ++j) hh[j] = x[j] * rs * gBv[j] * (scv[j] + 1.f) + shv[j];
                row_st_bf16(C.hout + (size_t)r * D, lane, hh); if (C.hout8) row_st_f8(C.hout8 + (size_t)r * D, lane, hh); }
        }
    }
    for (r = LROWS + wslot; r < C.nrows; r += NW) {
        f32x4 x[4]; row_ld_f32(C.xin_ctx + (size_t)(r - LROWS) * D, lane, x);
        if (C.trow) { f32x4 t[4]; if (C.tpart) row_ld_part(C.tpart, C.npart, r, lane, t); else row_ld_bf16(C.trow + (size_t)r * D, lane, t);
            row_resid(x, t, C.gA, C.modA + (size_t)2 * 6144 + C.gate_off, lane); row_st_f32(C.xout_ctx + (size_t)(r - LROWS) * D, lane, x); }
        if (C.gB) { f32x4 hh[4]; row_modnorm(x, C.gB, C.modB + (size_t)2 * 6144 + C.sc_off, C.modB + (size_t)2 * 6144 + C.sh_off, lane, hh); row_st_bf16(C.hout + (size_t)r * D, lane, hh); if (C.hout8) row_st_f8(C.hout8 + (size_t)r * D, lane, hh); }
    }
}

__device__ __forceinline__ void transpose_item(const float* W, int ldw, int k0, int n0, bf16* dst, int ldd, float scale, LAS float* scr, int lane) {
#pragma unroll 8
    for (int i = 0; i < 32; ++i) { const int kk = 2 * i + (lane >> 5); scr[kk * 33 + (lane & 31)] = W[(size_t)(k0 + kk) * ldw + n0 + (lane & 31)]; }
    LDS_WAIT(); asm volatile("" ::: "memory");
    const int c = lane & 7;
#pragma unroll
    for (int j = 0; j < 4; ++j) { const int n = (lane >> 3) + 8 * j; const LAS float* s = scr + (8 * c) * 33 + n;
        u32x4 o; o.x = pk2(s[0 * 33] * scale, s[1 * 33] * scale); o.y = pk2(s[2 * 33] * scale, s[3 * 33] * scale); o.z = pk2(s[4 * 33] * scale, s[5 * 33] * scale); o.w = pk2(s[6 * 33] * scale, s[7 * 33] * scale);
        *(u32x4*)(dst + (size_t)n * ldd + k0 + 8 * c) = o; }
    LDS_WAIT(); asm volatile("" ::: "memory");
}
#ifndef MK_MODE
#define MK_MODE 1
#endif
#ifndef MK_LAST
#define MK_LAST 24
#endif
constexpr int NPHASE = 24;
struct Args { const float* in[31]; float* out; unsigned char* ws; int ph_lo, ph_hi, li, pad; };


struct TrJob { const float* src; unsigned char* dst; int ldw, k0, n0, ldd, esz; float scale; };
#define CAS __attribute__((address_space(4)))
constexpr float MOE_W1S = 32.f, MOE_W2S = 64.f, MOE_HS = 2.f, WIN_S = 32.f;
constexpr int NTR = 60096, NTRQ = NTR / 8;
__device__ __forceinline__ void tr_decode(int it, const CAS Args* ap_, unsigned char* ws, TrJob& J) {
#define TIN(k) ((const float*)(const GAS float*)ap_->in[k])
    int kb; J.scale = 1.f; J.esz = 2;
    if (it < 43008) { const int e = it / 5376, r = it % 5376, w = r / 1792, li = r % 1792; J.esz = 1;
        if (w < 2) { J.src = TIN(28 + w) + (size_t)e * 1024 * DFE; J.ldw = DFE; kb = li / 112; J.n0 = (li % 112) * 32; J.ldd = 1024; J.scale = MOE_W1S;
            J.dst = ws + WS_MOE1 + ((size_t)e * 7168 + 256 * (J.n0 / 128) + (J.n0 % 128) + 128 * w) * 1024; }
        else { J.src = TIN(30) + (size_t)e * DFE * 1024; J.ldw = 1024; kb = li / 32; J.n0 = (li % 32) * 32; J.ldd = DFE; J.scale = MOE_W2S; J.dst = ws + WS_MOE2 + ((size_t)e * 1024 + J.n0) * DFE; }
    } else if (it < 47232) { const int r = it - 43008, w = r / 1408, li = r % 1408;
        if (w < 2) { J.src = TIN(23 + w); J.ldw = DFF; kb = li / 88; J.n0 = (li % 88) * 32; J.ldd = 1024; J.dst = ws + WS_FFN1 + (size_t)(256 * (J.n0 / 128) + (J.n0 % 128) + 128 * w) * 1024 * 2; }
        else { J.src = TIN(25); J.ldw = 1024; kb = li / 32; J.n0 = (li % 32) * 32; J.ldd = DFF; J.dst = ws + WS_FFN2 + (size_t)J.n0 * DFF * 2; }
    } else if (it >= 56000) { const int r = it - 56000, l = r / 2048, q = r % 2048; kb = q / 128; const int nb = q % 128; J.esz = 1; J.scale = WIN_S;
        J.src = TIN(7) + (size_t)l * 1024 * 6400; J.ldw = 6400; J.n0 = 2304 + 32 * nb; J.ldd = 1024; J.dst = ws + WS_WG8 + ((size_t)l * 4096 + 32 * nb) * 1024;
    } else { const int r = it - 47232, l = r / 4384, q = r % 4384;
        if (q < 3328) { const int t = q / 128, li = q % 128; kb = li / 8; const int nb = li % 8; if (l == 1 && t >= 7 && t < 23) J.esz = 0;
            const int srcc = t < 4 ? 256 * t : (t < 7 ? 256 * (t + 1) : (t < 23 ? 2304 + 256 * (t - 7) : (t == 23 ? 768 : (t == 24 ? 1024 : 2048))));
            J.src = TIN(7) + (size_t)l * 1024 * 6400; J.ldw = 6400; J.n0 = srcc + 32 * nb; J.ldd = 1024; J.dst = ws + WS_WIN + ((size_t)(l * 26 + t) * 256 + 32 * nb) * 1024 * 2; J.scale = (t == 3 || t == 23) ? 0.125f : 1.f; }
        else if (q < 3360) { const int li = q - 3328; kb = li / 8; J.n0 = (li % 8) * 32; J.src = TIN(16) + (size_t)l * 65536; J.ldw = 256; J.ldd = 256; J.dst = ws + WS_WGLU + ((size_t)l * 256 + J.n0) * 256 * 2; }
        else if (q < 3872) { const int li = q - 3360, bb = li / 128, li2 = li % 128; kb = li2 / 32; J.n0 = (li2 % 32) * 32; J.src = TIN(21) + (size_t)(l * 4 + bb) * 256 * 1024; J.ldw = 1024; J.ldd = 1024; J.dst = ws + WS_WBR + (((size_t)l * 1024 + J.n0) * 1024 + bb * 256) * 2; }
        else { const int li = q - 3872; kb = li / 32; J.n0 = (li % 32) * 32; J.src = TIN(22) + (size_t)l * 1024 * 1024; J.ldw = 1024; J.ldd = 1024; J.dst = ws + WS_WOUT + ((size_t)l * 1024 + J.n0) * 1024 * 2; }
    }
    J.k0 = kb * 64;
#undef TIN
}
__device__ __forceinline__ void tr_load(const TrJob& J, int lane, float (&v)[32]) {
    if (J.esz == 0) return;
#pragma unroll
    for (int i = 0; i < 32; ++i) { const int kk = 2 * i + (lane >> 5); v[i] = __builtin_nontemporal_load(J.src + (size_t)(J.k0 + kk) * J.ldw + J.n0 + (lane & 31)); } }
__device__ __forceinline__ void tr_store(const TrJob& J, int lane, const float (&v)[32], LAS float* scr) {
    if (J.esz == 0) return;
#pragma unroll
    for (int i = 0; i < 32; ++i) { const int kk = 2 * i + (lane >> 5); scr[kk * 33 + (lane & 31)] = v[i]; }
    LDS_WAIT(); asm volatile("" ::: "memory");
    const int c = lane & 7;
#pragma unroll
    for (int j = 0; j < 4; ++j) { const int n = (lane >> 3) + 8 * j; const LAS float* s = scr + (8 * c) * 33 + n; const float sc = J.scale;
        if (J.esz == 2) { u32x4 o; o.x = pk2(s[0 * 33] * sc, s[1 * 33] * sc); o.y = pk2(s[2 * 33] * sc, s[3 * 33] * sc); o.z = pk2(s[4 * 33] * sc, s[5 * 33] * sc); o.w = pk2(s[6 * 33] * sc, s[7 * 33] * sc);
            *(u32x4*)(J.dst + ((size_t)n * J.ldd + J.k0 + 8 * c) * 2) = o; }
        else { u32x2 o; o.x = pk4_f8(s[0 * 33] * sc, s[1 * 33] * sc, s[2 * 33] * sc, s[3 * 33] * sc); o.y = pk4_f8(s[4 * 33] * sc, s[5 * 33] * sc, s[6 * 33] * sc, s[7 * 33] * sc);
            *(u32x2*)(J.dst + (size_t)n * J.ldd + J.k0 + 8 * c) = o; } }
    LDS_WAIT(); asm volatile("" ::: "memory");
}

__device__ __forceinline__ void cs2pi(int m, int N, float& c, float& s) { sincospif(2.0f * (float)(m % N) / (float)N, &s, &c); }

__global__ void __launch_bounds__(NTHREADS, 2) mk_fwd(Args args) {
    extern __shared__ __attribute__((aligned(16))) unsigned char lds_raw[];
    LAS unsigned char* lds = (LAS unsigned char*)lds_raw;
    const int tid0 = threadIdx.x, wave = __builtin_amdgcn_readfirstlane(tid0 >> 6);
    const int G = gridDim.x, bx = blockIdx.x, vcu = (G % 8 == 0) ? (bx % 8) * (G / 8) + bx / 8 : bx;
    const int wslot = wave * G + vcu, NW = G * NWAVES;
    volatile LAS unsigned* lctl = (volatile LAS unsigned*)(lds + LDSCTL_OFF);
    for (int u = tid0; u < (LDS_BYTES - LDSCTL_OFF) / 4; u += NTHREADS) lctl[u] = 0u;
    __syncthreads();
    const int lo = args.ph_lo, hi = args.ph_hi, bli = args.li;
#ifdef MK_STAMP_PHASE
    if (wave == 0) *(volatile LAS unsigned long long*)(lctl + 64) = __builtin_amdgcn_s_memrealtime();
#endif
    { XcdBarrier b0 = xcd_barrier_post((unsigned*)(args.ws + WS_CTL) + CW_BAR + bli * XCD_BAR_WORDS, lctl + LW_BAR); (void)b0; }
#define IN(k) (lo <= (k) && (k) < hi)
#ifndef MK_DBL
#define MK_DBL 0
#endif
#define MK_NR(k) (MK_DBL == (k) ? 2 : 1)
#ifndef MK_REP_MASK
#define MK_REP_MASK 0u
#endif
#define NREP(k) (((MK_REP_MASK >> (k)) & 1u) ? 2 : 1)
#define FORCE_BAR do { PH_BEGIN XcdBarrier b_; b_.bar = (unsigned*)(ws + WS_CTL) + CW_BAR + bli * XCD_BAR_WORDS; b_.x = xb_xcc_id(); b_.st = lctl + LW_BAR; xcd_barrier(b_); } while (0)
#ifdef MK_STAMP_PHASE
#define STAMP_AT(k) do { if (wave == 0) { if ((k) == MK_STAMP_PHASE - 1) *(volatile LAS unsigned long long*)(lctl + 64) = __builtin_amdgcn_s_memrealtime(); if ((k) == MK_STAMP_PHASE) *(volatile LAS unsigned long long*)(lctl + 66) = __builtin_amdgcn_s_memrealtime(); } } while (0)
#else
#define STAMP_AT(k) do { } while (0)
#endif
#define SEAM(k) do { if (IN(k) && IN((k) + 1)) { PH_BEGIN XcdBarrier b_; b_.bar = (unsigned*)(ws + WS_CTL) + CW_BAR + bli * XCD_BAR_WORDS; b_.x = xb_xcc_id(); b_.st = lctl + LW_BAR; xcd_barrier(b_); } STAMP_AT(k); } while (0)
#define PH_BEGIN int tid; { int l_; asm volatile("v_mbcnt_lo_u32_b32 %0, -1, 0\n\tv_mbcnt_hi_u32_b32 %0, -1, %0" : "=v"(l_)); tid = wave * 64 + (l_ & 63); } const CAS Args* ap_ = (const CAS Args*)__builtin_amdgcn_kernarg_segment_ptr(); asm volatile("" : "+s"(ap_)); unsigned char* ws = (unsigned char*)(GAS unsigned char*)ap_->ws; const int lane = tid & 63; (void)lane;
#define AIN(k) ((const float*)(const GAS float*)ap_->in[k])
#define AOUT ((float*)(GAS float*)ap_->out)
#define XB ((bf16*)(ws + WS_XB))
#define MODp ((float*)(ws + CTL_MOD_OFF))
#define ctxbuf ((float*)(ws + WS_CTXBUF))
#define Hh ((bf16*)(ws + WS_H))
#define MIX ((bf16*)(ws + WS_MIX))
#define INP ((bf16*)(ws + WS_INP))
#define Tt ((bf16*)(ws + WS_T))

    for (int rep_ = 0; rep_ < NREP(0); ++rep_) if (IN(0)) { if (rep_) { FORCE_BAR; } PH_BEGIN
        for (int dd_ = 0; dd_ < MK_NR(20); ++dd_) for (int it = bx; it < 32; it += G) {
            const int l = it >> 4, g = it & 15;
            LAS f32x2* apow = (LAS f32x2*)lds; LAS f32x2* bbar = (LAS f32x2*)(lds + 8704); LAS f32x2* Cc = (LAS f32x2*)(lds + 16896); LAS float* Kt = (LAS float*)(lds + 25088);
            for (int dir = 0; dir < 2; ++dir) { const size_t pg = (size_t)(l * 2 + dir) * 16 + g;
                if (tid < 64) { const int p = tid;
                    const float are = AIN(8)[pg * 64 + p], aim = AIN(9)[pg * 64 + p], dt = expf(AIN(10)[pg]);
                    for (int t = 0; t <= 16; ++t) { const float mag = expf(are * dt * (float)t); float sn, cs; sincosf(aim * dt * (float)t, &sn, &cs); apow[t * 64 + p] = (f32x2){mag * cs, mag * sn}; }
                    const f32x2 a = apow[64 + p]; const float nr = a.x - 1.f, ni = a.y, den = 1.f / (are * are + aim * aim);
                    const float cr = (nr * are + ni * aim) * den, ci = (ni * are - nr * aim) * den;
                    for (int h = 0; h < 16; ++h) { const float br = AIN(11)[(pg * 64 + p) * 16 + h], bi = AIN(12)[(pg * 64 + p) * 16 + h]; bbar[p * 16 + h] = (f32x2){cr * br - ci * bi, cr * bi + ci * br}; }
                    *(f32x2*)((float*)(ws + WS_A16) + (pg * 64 + p) * 2) = apow[16 * 64 + p];
                }
                for (int i = tid; i < 1024; i += NTHREADS) Cc[i] = (f32x2){AIN(13)[pg * 1024 + i], AIN(14)[pg * 1024 + i]};
                __syncthreads();
                bf16* M1 = (bf16*)(ws + WS_S5M1) + ((size_t)(l * 16 + g) * 2 + dir) * 128 * 256;
                for (int v = tid; v < 4096; v += NTHREADS) { const int row = v >> 5, col0 = (v & 31) * 8, j = col0 >> 4, h0 = col0 & 15, p = row >> 1, ri = row & 1;
                    const f32x2 pw = apow[(dir == 0 ? 15 - j : j) * 64 + p]; float vals[8];
#pragma unroll
                    for (int hh = 0; hh < 8; ++hh) { const f32x2 bb = bbar[p * 16 + h0 + hh]; vals[hh] = ri ? pw.x * bb.y + pw.y * bb.x : pw.x * bb.x - pw.y * bb.y; }
                    *(bf16x8*)(M1 + ((((col0 >> 4) * 4 + (row >> 5)) * 64 + ((col0 >> 3) & 1) * 32 + (row & 31)) * 8)) = pack8(vals); }
                bf16* TAB = (bf16*)(ws + WS_S5TAB) + (size_t)(l * 16 + g) * 256 * 512;
                for (int v = tid; v < 4096; v += NTHREADS) { const int row = v >> 4, cv = v & 15, i = row >> 4, ho = row & 15; float vals[8];
#pragma unroll
                    for (int pp = 0; pp < 4; ++pp) { const int p = cv * 4 + pp; const f32x2 cc = Cc[ho * 64 + p];
                        const f32x2 pw = apow[(dir == 0 ? i + 1 : 16 - i) * 64 + p]; vals[2 * pp] = cc.x * pw.x - cc.y * pw.y; vals[2 * pp + 1] = -(cc.x * pw.y + cc.y * pw.x); }
                    { const int colt = 256 + dir * 128 + cv * 8; *(bf16x8*)(TAB + (((((row >> 7) * 32 + (colt >> 4)) * 4 + ((row >> 5) & 3)) * 64 + ((colt >> 3) & 1) * 32 + (row & 31)) * 8)) = pack8(vals); } }
                for (int e = tid; e < 4096; e += NTHREADS) { const int t = e >> 8, ho = (e >> 4) & 15, h = e & 15; float acc = 0.f;
#pragma unroll 8
                    for (int p = 0; p < 64; ++p) { const f32x2 cc = Cc[ho * 64 + p], pw = apow[t * 64 + p], bb = bbar[p * 16 + h];
                        const float xr = cc.x * pw.x - cc.y * pw.y, xi = cc.x * pw.y + cc.y * pw.x; acc += xr * bb.x - xi * bb.y; }
                    Kt[dir * 4096 + e] = acc; }
                __syncthreads();
            }
            for (int v = tid; v < 8192; v += NTHREADS) { const int row = v >> 5, col0 = (v & 31) * 8, i = row >> 4, ho = row & 15, j = col0 >> 4, h0 = col0 & 15; float vals[8];
#pragma unroll
                for (int hh = 0; hh < 8; ++hh) { const int h = h0 + hh;
                    vals[hh] = j < i ? Kt[(i - j) * 256 + ho * 16 + h] : (j > i ? Kt[4096 + (j - i) * 256 + ho * 16 + h] : Kt[ho * 16 + h] + Kt[4096 + ho * 16 + h] + (ho == h ? AIN(15)[l * 256 + g * 16 + h] : 0.f)); }
                *(bf16x8*)((bf16*)(ws + WS_S5TAB) + (size_t)(l * 16 + g) * 256 * 512 + (((((row >> 7) * 32 + (col0 >> 4)) * 4 + ((row >> 5) & 3)) * 64 + ((col0 >> 3) & 1) * 32 + (row & 31)) * 8)) = pack8(vals); }
            __syncthreads();
        }
        __syncthreads();
        for (int it = (bx >= 32 ? bx - 32 : bx + G - 32); it < 192; it += G) { const int l = it / 96, cb = it % 96, col = cb * 64 + lane, ks = wave;
            const float* wm = AIN(4) + ((size_t)l * 1024 + ks * 128) * 6144 + col; float a0 = 0.f, a1 = 0.f, a2 = 0.f;
#pragma unroll 8
            for (int k = 0; k < 128; ++k) { const float w = __builtin_nontemporal_load(wm + (size_t)k * 6144); const int kk = ks * 128 + k;
                const float c0 = AIN(1)[kk], c1 = AIN(1)[1024 + kk], c2 = AIN(3)[kk];
                a0 += w * (c0 / (1.f + __expf(-c0))); a1 += w * (c1 / (1.f + __expf(-c1))); a2 += w * (c2 / (1.f + __expf(-c2))); }
            LAS float* part = (LAS float*)lds;
            part[(wave * 3 + 0) * 64 + lane] = a0; part[(wave * 3 + 1) * 64 + lane] = a1; part[(wave * 3 + 2) * 64 + lane] = a2;
            __syncthreads();
            if (tid < 192) { const int i = tid >> 6, c = tid & 63; float sacc = AIN(5)[l * 6144 + cb * 64 + c];
#pragma unroll
                for (int w = 0; w < 8; ++w) sacc += part[(w * 3 + i) * 64 + c];
                MODp[(size_t)(l * 3 + i) * 6144 + cb * 64 + c] = sacc; }
            __syncthreads();
        }
        { LAS float* scr = (LAS float*)(lds + wave * 16384);
          unsigned* qh = (unsigned*)(ws + WS_CTL) + CW_QHEAD;
          int q = bx & 7, tries = 0;
#define TR_POP(dst) do { dst = -1; while (tries < 8) { unsigned b_ = 0u; if (lane == 0) b_ = __hip_atomic_fetch_add(qh + 64 * q, 2u, __ATOMIC_RELAXED, __HIP_MEMORY_SCOPE_AGENT); \
              b_ = (unsigned)__builtin_amdgcn_readfirstlane((int)b_); if (b_ < (unsigned)NTRQ) { dst = q * NTRQ + (int)b_; break; } q = (q + 1) & 7; ++tries; } } while (0)
#define TR_LOAD2(VA, VB, g_) do { TrJob j_; tr_decode(g_, ap_, ws, j_); tr_load(j_, lane, VA); tr_decode((g_) + (((g_) % NTRQ) + 1 < NTRQ ? 1 : 0), ap_, ws, j_); tr_load(j_, lane, VB); } while (0)
#define TR_STORE2(VA, VB, g_) do { TrJob j_; tr_decode(g_, ap_, ws, j_); tr_store(j_, lane, VA, scr); if (((g_) % NTRQ) + 1 < NTRQ) { tr_decode((g_) + 1, ap_, ws, j_); tr_store(j_, lane, VB, scr); } } while (0)
          float a0[32], a1[32], b0[32], b1[32]; int s0, s1;
          TR_POP(s0); if (s0 >= 0) TR_LOAD2(a0, a1, s0);
          TR_POP(s1);
          while (s0 >= 0) {
              int s2, s3 = -1;
              if (s1 >= 0) TR_LOAD2(b0, b1, s1);
              TR_POP(s2);
              TR_STORE2(a0, a1, s0);
              if (s1 < 0) break;
              if (s2 >= 0) TR_LOAD2(a0, a1, s2);
              TR_POP(s3);
              TR_STORE2(b0, b1, s1);
              s0 = s2; s1 = s3;
          }
#undef TR_POP
#undef TR_LOAD2
#undef TR_STORE2
        }
        for (int v = wslot * 64 + lane; v < 32 * SEQ; v += NW * 64) { const int p = v >> 13, t = v & 8191; const float pos = (float)(p < 16 ? (t >> 6) : (t & 63));
            const float inv = 1.0f / powf(10000.f, (float)(p & 15) / 16.f); float sn, cs; sincosf(pos * inv, &sn, &cs);
            ((float*)(ws + WS_COST))[v] = cs; ((float*)(ws + WS_SINT))[v] = sn; ((float*)(ws + WS_COSN))[t * 32 + p] = cs; ((float*)(ws + WS_SINN))[t * 32 + p] = sn; }
        for (int v = wslot * 64 + lane; v < 192512; v += NW * 64) { float c, s;
            if (v < 32768) { const int ri = v >> 14, k1 = (v >> 7) & 127, l1 = v & 127; cs2pi(k1 * l1, 128, c, s); const float sc = 0.08838834764831845f;
                ((bf16*)(ws + WS_W128T))[v] = (bf16)(pk2(ri ? -s * sc : c * sc, 0.f) & 0xffffu); }
            else if (v < 40960) { const int u = v - 32768, l2 = u >> 7, k1 = u & 127; cs2pi(k1 * l2, 8192, c, s); ((float*)(ws + WS_TWC))[u] = c; ((float*)(ws + WS_TWS))[u] = s; }
            else if (v < 53248) { const int u = v - 40960, w = u >> 12, m = (u >> 6) & 63, cc = u & 63; cs2pi(m * cc, 64, c, s);
                ((bf16*)(ws + WS_FCT))[u] = (bf16)(pk2((w == 0 ? c : (w == 1 ? s : -s)) * 0.125f, 0.f) & 0xffffu); }
            else if (v < 61440) { const int u = v - 53248, w = u >> 12, k2 = (u >> 6) & 63, l2 = u & 63; cs2pi(k2 * l2, 64, c, s); ((bf16*)(ws + WS_W64T))[u] = (bf16)(pk2((w == 0 ? c : s) * 0.125f, 0.f) & 0xffffu); }
            else { const int u = v - 61440, w = u >> 16, k = (u >> 8) & 255, l = u & 255; cs2pi(k * l, 256, c, s); ((bf16*)(ws + WS_W256T))[u] = (bf16)(pk2((w == 0 ? c : s) * 0.0625f, 0.f) & 0xffffu); }
        }
    }
    SEAM(0);

    for (int rep_ = 0; rep_ < NREP(1); ++rep_) if (IN(1)) { if (rep_) { FORCE_BAR; } PH_BEGIN
        { NormCfg C{AIN(0), AIN(2), nullptr, nullptr, nullptr, nullptr, 0, nullptr, nullptr, 0, AIN(6), MODp, 1024, 0, Hh, R, ws + WS_H8, nullptr, nullptr}; norm_rows(C, wslot, NW, lane); }
    }
    SEAM(1);

    for (int layer = 0; layer < 2; ++layer) {
        const int pb = 1 + 11 * layer;
        const int nM = layer == 0 ? 66 : 64;
        const int nrows = layer == 0 ? R : LROWS;
#define normg (AIN(6) + (size_t)layer * 4 * D)
        for (int rep_ = 0; rep_ < NREP(pb + 1); ++rep_) if (IN(pb + 1)) { if (rep_) { FORCE_BAR; } PH_BEGIN
            gp::SchedInprojA S{(const char*)Hh, (const char*)(ws + WS_WIN) + (size_t)layer * 26 * 256 * 2048, 66, G, bx, layer == 0 ? 32 : 0};
            gp::EpiInprojA E{INP, Tt, (unsigned char*)(ws + WS_GCTX)};
            gp::gemm_phase(lds, tid, 1024, 1024, 1024, S, E);
        }
        SEAM(pb + 1);
        for (int rep_ = 0; rep_ < NREP(pb + 2); ++rep_) if (IN(pb + 2)) { if (rep_) { FORCE_BAR; } PH_BEGIN
            LAS float* rpb = (LAS float*)(lds + 98304 + 4096);
            LAS unsigned char* wl = lds + wave * 12288;
            for (int i = tid; i < 1860; i += NTHREADS) rpb[i] = AIN(20)[layer * 1860 + i] * LOG2E;
            __syncthreads();
            const int nitA = 2224 + 64 + (layer == 0 ? 64 : 0);
            for (int it = wslot; it < nitA; it += NW) {
                if (it < 1056) s5_state_item((const bf16*)(ws + WS_S5M1) + (size_t)layer * 16 * 2 * 128 * 256, INP + (size_t)R * 256, (float*)(ws + WS_HLOC), it, lane);
                else if (it < 1584) ret_kv_item(Tt, Tt + (size_t)256 * R, (const float*)(ws + WS_COST), (const float*)(ws + WS_SINT), AIN(18) + layer * 8, (float*)(ws + WS_KV), it - 1056, lane);
                else if (it < 2096) fft1_item(INP, (const bf16*)(ws + WS_W128T), (const float*)(ws + WS_TWC), (const float*)(ws + WS_TWS), (bf16*)(ws + WS_FB), it - 1584, lane);
                else if (it < 2224) rope_item(INP + (size_t)2 * R * 256, INP + (size_t)3 * R * 256, (const float*)(ws + WS_COSN), (const float*)(ws + WS_SINN), it - 2096, lane);
                else if (it < 2288) { const int j = 1984 + (it - 2224); na_item(INP + (size_t)5 * R * 256, INP + (size_t)6 * R * 256, Tt + (size_t)512 * R, MIX, rpb, wl, false, j >> 10, (j >> 3) & 127, (j >> 1) & 3, j & 1, lane); }
                else { const int j = it - 2288; na_item(INP + (size_t)5 * R * 256, INP + (size_t)6 * R * 256, Tt + (size_t)512 * R, MIX, rpb, wl, true, j >> 5, 0, (j >> 3) & 3, j & 7, lane); }
            }
            __syncthreads();
        }
        SEAM(pb + 2);
        for (int rep_ = 0; rep_ < NREP(pb + 3); ++rep_) if (IN(pb + 3)) { if (rep_) { FORCE_BAR; } PH_BEGIN
            LAS float* rpb = (LAS float*)(lds + 98304 + 4096); LAS unsigned char* wl = lds + wave * 12288;
            for (int i = tid; i < 1860; i += NTHREADS) rpb[i] = AIN(20)[layer * 1860 + i] * LOG2E;
            __syncthreads();
            for (int vs = wslot; vs < 2048; vs += NW) {
                if (vs < 64) s5_scan_item((const float*)(ws + WS_A16) + (size_t)layer * 2 * 16 * 64 * 2, (const float*)(ws + WS_HLOC), (bf16*)(ws + WS_HIN), wl, vs, lane);
                else { const int j = vs - 64; na_item(INP + (size_t)5 * R * 256, INP + (size_t)6 * R * 256, Tt + (size_t)512 * R, MIX, rpb, wl, false, j >> 10, (j >> 3) & 127, (j >> 1) & 3, j & 1, lane);
                    if (vs >= 1024) ret_scan_item(AIN(18) + layer * 8, (const float*)(ws + WS_KV), (bf16*)(ws + WS_SPREV), vs - 1024, lane); }
            }
            __syncthreads();
        }
        SEAM(pb + 3);
        for (int rep_ = 0; rep_ < NREP(pb + 4); ++rep_) if (IN(pb + 4)) { if (rep_) { FORCE_BAR; } PH_BEGIN
            const int nit = 1056 + 2112 + 2048 + (layer == 0 ? 128 : 0);
            for (int it = wslot; it < nit; it += NW) {
                if (it < 1056) s5_out_item((const bf16*)(ws + WS_S5TAB) + (size_t)layer * 16 * 256 * 512, INP + (size_t)R * 256, (const bf16*)(ws + WS_HIN), (bf16*)(ws + WS_Z), it, lane);
                else if (it < 3168) ret_out_item(INP + (size_t)2 * R * 256, INP + (size_t)3 * R * 256, INP + (size_t)4 * R * 256, Tt + (size_t)256 * R, (const bf16*)(ws + WS_SPREV),
                                                 AIN(18) + layer * 8, AIN(19) + layer * 256, MIX, lds + wave * 12288, it - 1056, lane);
                else if (it < 5216) fft2_item((const bf16*)(ws + WS_FB), (const bf16*)(ws + WS_FCT), (const bf16*)(ws + WS_W64T), MIX, it - 3168, lane);
                else fftc_item(INP, (const bf16*)(ws + WS_FCT), (const bf16*)(ws + WS_W256T), MIX, it - 5216, lane);
            }
        }
        SEAM(pb + 4);
        for (int rep_ = 0; rep_ < NREP(pb + 5); ++rep_) if (IN(pb + 5)) { if (rep_) { FORCE_BAR; } PH_BEGIN
            { PH_BEGIN gp::SchedPlain S{(const char*)(ws + WS_Z), (const char*)(ws + WS_WGLU) + (size_t)layer * 256 * 512, (size_t)256 * 512, (size_t)256 * 512, nM, 1, G, bx, 4};
              gp::EpiGlu E{(const bf16*)(ws + WS_Z), MIX, AIN(17) + layer * 256};
              gp::gemm_phase(lds, tid, 256, 256, 256, S, E); }
            { PH_BEGIN gp::SchedPlain S{(const char*)(ws + WS_H8), (const char*)(ws + WS_WG8) + (size_t)layer * 4096 * 1024, (size_t)256 * 1024, (size_t)256 * 1024, 64, 16, G, bx, 8};
              gp::EpiGates E{(unsigned char*)(ws + WS_GATES), 1.f / WIN_S};
              gp::gemm_phase<gp::EpiGates, gp::SchedPlain, true>(lds, tid, 1024, 512, 512, S, E); }
        }
        SEAM(pb + 5);
        for (int rep_ = 0; rep_ < NREP(pb + 6); ++rep_) if (IN(pb + 6)) { if (rep_) { FORCE_BAR; } PH_BEGIN
            gp::SchedMerge S{(const char*)MIX, (const char*)(ws + WS_WBR) + (size_t)layer * 1024 * 2048, layer == 0 ? 32 : 0, G, bx};
            gp::EpiMerge E{(const unsigned char*)(ws + WS_GATES), (const unsigned char*)(ws + WS_GCTX), (bf16*)(ws + WS_Y), (bf16*)(ws + WS_YP)};
            gp::gemm_phase(lds, tid, 1024, 1024, 1024, S, E);
        }
        SEAM(pb + 6);
        for (int rep_ = 0; rep_ < NREP(pb + 7); ++rep_) if (IN(pb + 7)) { if (rep_) { FORCE_BAR; } PH_BEGIN
            gp::SchedSplit S{(const char*)(ws + WS_Y), (const char*)(ws + WS_WOUT) + (size_t)layer * 1024 * 2048, (size_t)256 * 2048, (size_t)256 * 2048, layer == 0 ? 16 : 0, 16, G, bx,
                             (const char*)(ws + WS_YP), (size_t)256 * 2048, (size_t)CROWS * 2048, 4};
            gp::EpiPlainSplit E{(bf16*)(ws + WS_YO), 1024, (float*)(ws + WS_PARTW), 16};
            gp::gemm_phase(lds, tid, 1024, 1024, 1024, S, E);
        }
        SEAM(pb + 7);
        for (int rep_ = 0; rep_ < NREP(pb + 8); ++rep_) if (IN(pb + 8)) { if (rep_) { FORCE_BAR; } PH_BEGIN
            if (layer == 0) {
                NormCfg C{AIN(0), AIN(2), nullptr, ctxbuf, (const bf16*)(ws + WS_YO), (const float*)(ws + WS_PARTW), 16, normg + D, MODp, 2048, normg + 2 * D, MODp, 4096, 3072, Hh, R, nullptr, nullptr, XB};
                norm_rows(C, wslot, NW, lane);
            } else {
                LAS float* wrs = (LAS float*)lds; LAS int* rowinfo = (LAS int*)(lds + 32768); LAS unsigned* cntL = (LAS unsigned*)(lds + 32768 + 1024); LAS unsigned* baseL = cntL + 8;
                for (int i = tid; i < 2048; i += NTHREADS) ((LAS f32x4*)wrs)[i] = ((const f32x4*)AIN(26))[i];
                int* list = (int*)(ws + WS_LIST); float* routew = (float*)(ws + WS_ROUTEW);
                f32x4 gAv[4], gBv[4]; row_ld_f32(normg + D, lane, gAv); row_ld_f32(normg + 2 * D, lane, gBv);
                float rbias[8];
#pragma unroll
                for (int e = 0; e < 8; ++e) rbias[e] = AIN(27)[e];
                for (int grp = vcu; grp < 256; grp += G) {
                    if (tid < 8) cntL[tid] = 0u;
                    __syncthreads();
                    const int r0 = grp * 64 + wave * 8; const float* md = MODp + (size_t)(3 + (r0 < SEQ ? 0 : 1)) * 6144;
                    f32x4 gav[4], scv[4], shv[4]; row_ld_f32(md + 2048, lane, gav); row_ld_f32(md + 4096, lane, scv); row_ld_f32(md + 3072, lane, shv);
                    u32x2 xn[4]; u32x2 tn[4]; row_ld_raw16(XB + (size_t)r0 * D, lane, xn);
#pragma unroll
                    for (int j = 0; j < 4; ++j) tn[j] = *(const u32x2*)((const bf16*)(ws + WS_YO) + (size_t)r0 * D + 256 * j + 4 * lane);
                    for (int rr = 0; rr < 8; ++rr) { const int r = r0 + rr;
                        f32x4 x[4], t[4], hh[4];
#pragma unroll
                        for (int j = 0; j < 4; ++j) { x[j] = (f32x4){bflo(xn[j].x), bfhi(xn[j].x), bflo(xn[j].y), bfhi(xn[j].y)}; t[j] = (f32x4){bflo(tn[j].x), bfhi(tn[j].x), bflo(tn[j].y), bfhi(tn[j].y)}; }
                        if (rr < 7) { row_ld_raw16(XB + (size_t)(r + 1) * D, lane, xn);
#pragma unroll
                            for (int j = 0; j < 4; ++j) tn[j] = *(const u32x2*)((const bf16*)(ws + WS_YO) + (size_t)(r + 1) * D + 256 * j + 4 * lane); }
                        { const float rs = row_rstd(t);
#pragma unroll
                          for (int j = 0; j < 4; ++j) x[j] = x[j] + gav[j] * (t[j] * rs * gAv[j]); }
                        row_st_bf16(XB + (size_t)r * D, lane, x);
                        { const float rs = row_rstd(x);
#pragma unroll
                          for (int j = 0; j < 4; ++j) hh[j] = x[j] * rs * gBv[j] * (scv[j] + 1.f) + shv[j]; }
#pragma unroll
                        for (int j = 0; j < 4; ++j) *(unsigned*)(ws + WS_H + (size_t)r * D + 256 * j + 4 * lane) = pk4_f8(hh[j][0], hh[j][1], hh[j][2], hh[j][3]);
                        float lg[8];
#pragma unroll
                        for (int e = 0; e < 8; ++e) lg[e] = 0.f;
#pragma unroll
                        for (int j = 0; j < 4; ++j)
#pragma unroll
                            for (int q = 0; q < 4; ++q) { const int k = 256 * j + 4 * lane + q; const f32x4 w0 = *(const LAS f32x4*)(wrs + k * 8), w1 = *(const LAS f32x4*)(wrs + k * 8 + 4); const float hv = hh[j][q];
                                lg[0] += hv * w0[0]; lg[1] += hv * w0[1]; lg[2] += hv * w0[2]; lg[3] += hv * w0[3]; lg[4] += hv * w1[0]; lg[5] += hv * w1[1]; lg[6] += hv * w1[2]; lg[7] += hv * w1[3]; }
#pragma unroll
                        for (int e = 0; e < 8; ++e) lg[e] = wave_sum(lg[e]) + rbias[e];
                        int i0 = 0; float v0 = lg[0];
#pragma unroll
                        for (int e = 1; e < 8; ++e) if (lg[e] > v0) { v0 = lg[e]; i0 = e; }
                        int i1 = i0 == 0 ? 1 : 0; float v1 = i0 == 0 ? lg[1] : lg[0];
#pragma unroll
                        for (int e = 0; e < 8; ++e) if (e != i0 && lg[e] > v1) { v1 = lg[e]; i1 = e; }
                        const float w0 = 1.f / (1.f + __expf(v1 - v0)), w1 = 1.f - w0;
                        if (lane == 0) { const unsigned s0 = __hip_atomic_fetch_add(cntL + i0, 1u, __ATOMIC_RELAXED, __HIP_MEMORY_SCOPE_WORKGROUP), s1 = __hip_atomic_fetch_add(cntL + i1, 1u, __ATOMIC_RELAXED, __HIP_MEMORY_SCOPE_WORKGROUP);
                            LAS int* ri = rowinfo + (wave * 8 + rr) * 4; ri[0] = i0; ri[1] = (int)s0; ri[2] = i1; ri[3] = (int)s1; routew[(size_t)r * 2] = w0; routew[(size_t)r * 2 + 1] = w1; }
                        if (lane < 8) ((int*)(ws + WS_SMAP))[(size_t)r * 8 + lane] = -1;
                    }
                    __syncthreads();
                    if (tid < 8) baseL[tid] = __hip_atomic_fetch_add((unsigned*)(ws + WS_CTL) + CW_MOECNT + 64 * tid, cntL[tid], __ATOMIC_RELAXED, __HIP_MEMORY_SCOPE_AGENT);
                    __syncthreads();
                    if (tid < 64) { const LAS int* ri = rowinfo + tid * 4; const int r = grp * 64 + tid;
                        list[ri[0] * LCAP + (int)baseL[ri[0]] + ri[1]] = r * 2; list[ri[2] * LCAP + (int)baseL[ri[2]] + ri[3]] = r * 2 + 1; }
                    __syncthreads();
                }
            }
        }
        SEAM(pb + 8);
        LAS unsigned* mt = (LAS unsigned*)(lds + LDSCTL_OFF) + LW_MOE;
        if (layer == 1 && (IN(pb + 9) || IN(pb + 10))) { PH_BEGIN
            if (tid == 0) { unsigned off = 0u;
                for (int e = 0; e < 8; ++e) { const unsigned c = __hip_atomic_load((unsigned*)(ws + WS_CTL) + CW_MOECNT + 64 * e, __ATOMIC_RELAXED, __HIP_MEMORY_SCOPE_AGENT); const unsigned m = (c + 255u) >> 8; mt[e] = c; mt[8 + e] = m; mt[16 + e] = off; off += m; }
                mt[24] = off; const unsigned U = off * 4u, full = (U / (unsigned)G) * (unsigned)G, rem = U - full;
                if (rem != 0u && rem <= 32u && full != 0u) { mt[25] = full; mt[26] = rem; } else { mt[25] = U; mt[26] = 0u; } }
            __syncthreads();
        }
        for (int rep_ = 0; rep_ < NREP(pb + 9); ++rep_) if (IN(pb + 9)) { if (rep_) { FORCE_BAR; } PH_BEGIN
            if (layer == 0) {
                gp::SchedPlain S{(const char*)Hh, (const char*)(ws + WS_FFN1), (size_t)256 * 2048, (size_t)256 * 2048, 66, 22, G, bx, 16};
                gp::EpiSwiglu E{(bf16*)(ws + WS_HID), DFF, false};
                gp::gemm_phase(lds, tid, 1024, 1024, 1024, S, E);
            } else {
                gp::SchedMoe1 S{(const char*)(ws + WS_H), (const char*)(ws + WS_MOE1), (const int*)(ws + WS_LIST), mt, G, bx, 1024u};
                gp::EpiSwigluF8 E{ws + WS_MHID, DFE, true, 1.f / MOE_W1S, MOE_HS};
                gp::gemm_phase<gp::EpiSwigluF8, gp::SchedMoe1, true>(lds, tid, 1024, 512, 512, S, E);
            }
        }
        SEAM(pb + 9);
        for (int rep_ = 0; rep_ < NREP(pb + 10); ++rep_) if (IN(pb + 10)) { if (rep_) { FORCE_BAR; } PH_BEGIN
            if (layer == 0) {
                gp::SchedSplit S{(const char*)(ws + WS_HID), (const char*)(ws + WS_FFN2), (size_t)256 * DFF * 2, (size_t)256 * DFF * 2, 11, DFF / 64, G, bx,
                                 (const char*)(ws + WS_HID) + (size_t)64 * 256 * DFF * 2, (size_t)256 * DFF * 2, 0, 11};
                gp::EpiPlainSplit E{(bf16*)(ws + WS_FO), 1024, (float*)(ws + WS_PARTF), 11};
                gp::gemm_phase(lds, tid, DFF, DFF, DFF, S, E);
            } else {
                { gp::SchedMoe2 S{(const char*)(ws + WS_MHID), (const char*)(ws + WS_MOE2), mt, G, bx, (unsigned)DFE};
                  gp::EpiMoeDown E{(bf16*)(ws + WS_SLOT), (const int*)(ws + WS_LIST), (const float*)(ws + WS_ROUTEW), mt, 1.f / (MOE_HS * MOE_W2S)};
                  gp::gemm_phase<gp::EpiMoeDown, gp::SchedMoe2, true>(lds, tid, DFE, DFE / 2, DFE / 2, S, E); }
                { PH_BEGIN gp::SchedMoe2S S{(const char*)(ws + WS_MHID), (const char*)(ws + WS_MOE2), mt, G, bx, (unsigned)DFE};
                  gp::EpiMoePart E{(bf16*)(ws + WS_PARTM), (const int*)(ws + WS_LIST), mt, (int*)(ws + WS_SMAP), 1.f / (MOE_HS * MOE_W2S)};
                  gp::gemm_phase<gp::EpiMoePart, gp::SchedMoe2S, true>(lds, tid, DFE, DFE / 2, DFE / 2, S, E); }
            }
        }
        SEAM(pb + 10);
        for (int rep_ = 0; rep_ < NREP(pb + 11); ++rep_) if (IN(pb + 11)) { if (rep_) { FORCE_BAR; } PH_BEGIN
            if (layer == 0) { PH_BEGIN NormCfg C{nullptr, ctxbuf, nullptr, ctxbuf, (const bf16*)(ws + WS_FO), (const float*)(ws + WS_PARTF), 11, normg + 3 * D, MODp, 5120, AIN(6) + 4 * D, MODp + 3 * 6144, 1024, 0, Hh, R, ws + WS_H8, XB, XB};
                norm_rows(C, wslot, NW, lane); }
            else { PH_BEGIN
                typedef int i32x4 __attribute__((ext_vector_type(4)));
                const bf16* S0 = (const bf16*)(ws + WS_SLOT); const bf16* S1 = S0 + (size_t)LROWS * D; const int* smap = (const int*)(ws + WS_SMAP);
                f32x4 gv[4], ga[4]; row_ld_f32(normg + 3 * D, lane, gv);
                u32x2 xb[4], s0[4], s1[4]; i32x4 m0 = (i32x4){-1, -1, -1, -1}, m1 = m0; int curci = -1;
#pragma unroll
                for (int j = 0; j < 4; ++j) { xb[j] = s0[j] = s1[j] = (u32x2){0u, 0u}; ga[j] = (f32x4){0.f, 0.f, 0.f, 0.f}; }
                int r = wslot;
                if (r < LROWS) { row_ld_raw16(XB + (size_t)r * D, lane, xb); row_ld_raw16(S0 + (size_t)r * D, lane, s0); row_ld_raw16(S1 + (size_t)r * D, lane, s1); m0 = *(const i32x4*)(smap + (size_t)r * 8); m1 = *(const i32x4*)(smap + (size_t)r * 8 + 4); }
                for (; r < LROWS; r += NW) {
                    u32x2 cx[4], c0[4], c1[4]; const i32x4 cm0 = m0, cm1 = m1;
#pragma unroll
                    for (int j = 0; j < 4; ++j) { cx[j] = xb[j]; c0[j] = s0[j]; c1[j] = s1[j]; }
                    const int r2 = r + NW;
                    if (r2 < LROWS) { row_ld_raw16(XB + (size_t)r2 * D, lane, xb); row_ld_raw16(S0 + (size_t)r2 * D, lane, s0); row_ld_raw16(S1 + (size_t)r2 * D, lane, s1); m0 = *(const i32x4*)(smap + (size_t)r2 * 8); m1 = *(const i32x4*)(smap + (size_t)r2 * 8 + 4); }
                    const int ci = r < SEQ ? 0 : 1;
                    if (ci != curci) { curci = ci; row_ld_f32(MODp + (size_t)(3 + ci) * 6144 + 5120, lane, ga); }
                    f32x4 x[4], t[4];
#pragma unroll
                    for (int j = 0; j < 4; ++j) x[j] = (f32x4){bflo(cx[j].x), bfhi(cx[j].x), bflo(cx[j].y), bfhi(cx[j].y)};
                    if ((cm0.x & cm0.y & cm0.z & cm0.w & cm1.x & cm1.y & cm1.z & cm1.w) == -1) {
#pragma unroll
                        for (int j = 0; j < 4; ++j) t[j] = (f32x4){bflo(c0[j].x), bfhi(c0[j].x), bflo(c0[j].y), bfhi(c0[j].y)} + (f32x4){bflo(c1[j].x), bfhi(c1[j].x), bflo(c1[j].y), bfhi(c1[j].y)};
                    } else {
#pragma unroll
                        for (int j = 0; j < 4; ++j) t[j] = (f32x4){0.f, 0.f, 0.f, 0.f};
#pragma unroll
                        for (int k = 0; k < 2; ++k) { const int ent = 2 * r + k; const i32x4 mk = k ? cm1 : cm0;
#pragma unroll
                            for (int j = 0; j < 4; ++j) { const int mm = j == 0 ? mk.x : (j == 1 ? mk.y : (j == 2 ? mk.z : mk.w));
                                if (mm < 0) { const u32x2 w = k ? c1[j] : c0[j]; t[j] = t[j] + (f32x4){bflo(w.x), bfhi(w.x), bflo(w.y), bfhi(w.y)}; }
                                else { const bf16* pp = (const bf16*)(ws + WS_PARTM) + ((size_t)(mm >> 8) * 7 * 256 + (mm & 255)) * 256 + 4 * lane; f32x4 sacc = (f32x4){0.f, 0.f, 0.f, 0.f};
                                    for (int sl = 0; sl < 7; ++sl) { const u32x2 w = *(const u32x2*)(pp + (size_t)sl * 65536); sacc = sacc + (f32x4){bflo(w.x), bfhi(w.x), bflo(w.y), bfhi(w.y)}; }
                                    t[j] = t[j] + sacc * ((const float*)(ws + WS_ROUTEW))[ent]; } } } }
                    const float rs = row_rstd(t);
#pragma unroll
                    for (int j = 0; j < 4; ++j) x[j] = x[j] + ga[j] * (t[j] * rs * gv[j]);
                    row_st_f32(AOUT + (size_t)r * D, lane, x);
                } }
        }
        SEAM(pb + 11);
    }
#ifdef MK_STAMP_PHASE
    if (MK_STAMP_PHASE == NPHASE - 1 && wave == 0) *(volatile LAS unsigned long long*)(lctl + 66) = __builtin_amdgcn_s_memrealtime();
    if (blockIdx.x == 0 && wave == 0) { const unsigned long long st0_ = *(volatile LAS unsigned long long*)(lctl + 64), st1_ = *(volatile LAS unsigned long long*)(lctl + 66); const unsigned long long target = __builtin_amdgcn_s_memrealtime() + (unsigned long long)MK_STAMP_AMP * (st1_ - st0_); while (__builtin_amdgcn_s_memrealtime() < target) __builtin_amdgcn_s_sleep(20); }
#endif
#ifdef MK_EXTRA_BARS
    for (int xb_ = 0; xb_ < MK_EXTRA_BARS; ++xb_) { FORCE_BAR; }
#endif
#undef IN
#undef SEAM
#undef PH_BEGIN
#undef normg
#undef AIN
#undef AOUT
#undef XB
#undef MODp
#undef ctxbuf
#undef Hh
#undef MIX
#undef INP
#undef Tt
}

__global__ void dumpk(const unsigned char* src, size_t nbytes, int isf32, float* out, size_t N, int accum) {
    const size_t i = (size_t)blockIdx.x * blockDim.x + threadIdx.x; if (i >= N) return;
    const size_t ne = isf32 ? nbytes / 4 : nbytes / 2; float s = 0.f;
    for (size_t k = i; k < ne; k += N) s += isf32 ? ((const float*)src)[k] : bf2f(((const bf16*)src)[k]);
    out[i] = accum ? out[i] + s : s;
}
extern "C" void kernel_launch(void* const* d_in, const int* in_sizes, int n_in, void* d_out, int out_size, void* d_ws, size_t ws_size, hipStream_t stream) {
    static int grid = 0;
    if (grid == 0) {
        if (n_in != 31 || out_size != LROWS * D || ws_size < WS_END) { fprintf(stderr, "kernel_launch: unexpected shapes (n_in %d, out %d, ws %zu < %zu)\n", n_in, out_size, ws_size, (size_t)WS_END); grid = -1; return; }
        int dev = 0, cus = 0, per_cu = 0;
        if (hipGetDevice(&dev) != hipSuccess || hipDeviceGetAttribute(&cus, hipDeviceAttributeMultiprocessorCount, dev) != hipSuccess) { grid = -1; return; }
        if (hipFuncSetAttribute((const void*)mk_fwd, hipFuncAttributeMaxDynamicSharedMemorySize, LDS_BYTES) != hipSuccess) { fprintf(stderr, "kernel_launch: hipFuncSetAttribute failed\n"); grid = -1; return; }
        if (hipOccupancyMaxActiveBlocksPerMultiprocessor(&per_cu, (const void*)mk_fwd, NTHREADS, LDS_BYTES) != hipSuccess || per_cu < 1) { fprintf(stderr, "kernel_launch: occupancy query says %d\n", per_cu); }
        (void)hipGetLastError();
        grid = cus;
    }
    if (grid < 0) return;
    (void)hipMemsetAsync((char*)d_ws + WS_CTL, 0, CTL_ZERO_BYTES, stream);
    Args a{};
    for (int i = 0; i < 31; ++i) a.in[i] = (const float*)d_in[i];
    a.out = (float*)d_out; a.ws = (unsigned char*)d_ws;
#if MK_MODE == 1
    a.ph_lo = 0; a.ph_hi = NPHASE; a.li = 0;
    hipLaunchKernelGGL(mk_fwd, dim3(grid), dim3(NTHREADS), LDS_BYTES, stream, a);
#else
    for (int p = 0; p < MK_LAST; ++p) { a.ph_lo = p; a.ph_hi = p + 1; a.li = p; hipLaunchKernelGGL(mk_fwd, dim3(grid), dim3(NTHREADS), LDS_BYTES, stream, a); }
#endif
#ifdef MK_DUMP_OFF
    dumpk<<<(LROWS * D + 255) / 256, 256, 0, stream>>>((const unsigned char*)d_ws + (size_t)(MK_DUMP_OFF), (size_t)(MK_DUMP_BYTES), MK_DUMP_F32, (float*)d_out, (size_t)LROWS * D, 0);
#endif
#ifdef MK_DUMP2_OFF
    dumpk<<<(LROWS * D + 255) / 256, 256, 0, stream>>>((const unsigned char*)d_ws + (size_t)(MK_DUMP2_OFF), (size_t)(MK_DUMP2_BYTES), MK_DUMP2_F32, (float*)d_out, (size_t)LROWS * D, 1);
#endif
#ifdef MK_DUMP3_OFF
    dumpk<<<(LROWS * D + 255) / 256, 256, 0, stream>>>((const unsigned char*)d_ws + (size_t)(MK_DUMP3_OFF), (size_t)(MK_DUMP3_BYTES), MK_DUMP3_F32, (float*)d_out, (size_t)LROWS * D, 1);
#endif
}
```

```cpp
#include <hip/hip_runtime.h>
#include <cstdio>
#include <cstdint>

#define GAS __attribute__((address_space(1)))
#define LAS __attribute__((address_space(3)))
typedef unsigned short bf16;
typedef short bf16x8 __attribute__((ext_vector_type(8)));
typedef short bf16x4 __attribute__((ext_vector_type(4)));
typedef float f32x2 __attribute__((ext_vector_type(2)));
typedef float f32x4 __attribute__((ext_vector_type(4)));
typedef float f32x16 __attribute__((ext_vector_type(16)));
typedef unsigned u32x2 __attribute__((ext_vector_type(2)));
typedef unsigned u32x4 __attribute__((ext_vector_type(4)));

constexpr int D = 1024, SEQ = 8192, LROWS = 16384, CTXL = 256, CROWS = 512, R = 16896;
constexpr int DFF = 2816, DFE = 3584, NEXP = 8, LCAP = 16640;
constexpr int NWAVES = 8, NTHREADS = 512;
constexpr int NCH16 = R / 16;
constexpr float EPSN = 1e-6f, LOG2E = 1.4426950408889634f;

constexpr size_t MiB = 1u << 20;
constexpr size_t WS_CTL = 0, CTL_ZERO_BYTES = 1 * MiB;
constexpr int CW_TMO = 0, CW_BAR = 4096, CW_MOECNT = 98304, CW_QHEAD = 100352, CW_MQ = 102400;
constexpr size_t CTL_MOD_OFF = 512 * 1024;
constexpr size_t WS_CTXBUF = 1 * MiB;
constexpr size_t WS_COST = 3 * MiB, WS_SINT = 4 * MiB, WS_COSN = 5 * MiB, WS_SINN = 6 * MiB;
constexpr size_t WS_LIST = 7 * MiB;
constexpr size_t WS_ROUTEW = WS_LIST + 8 * LCAP * 4;
constexpr size_t WS_S5K = 8 * MiB;
constexpr size_t WS_A16 = 9 * MiB;
constexpr size_t WS_W128T = WS_A16 + 64 * 1024;
constexpr size_t WS_TWC = WS_W128T + 64 * 1024, WS_TWS = WS_TWC + 32 * 1024;
constexpr size_t WS_FCT = WS_TWS + 32 * 1024;
constexpr size_t WS_W64T = WS_FCT + 32 * 1024;
constexpr size_t WS_W256T = WS_W64T + 32 * 1024;
constexpr size_t WS_MOE1 = 10 * MiB;
constexpr size_t WS_WG8 = 66 * MiB;
constexpr size_t WS_XB = 74 * MiB;
constexpr size_t WS_H8 = 150 * MiB;
constexpr size_t WS_MOE2 = 122 * MiB;
constexpr size_t WS_OTHERW = 178 * MiB;
constexpr size_t WS_WIN = 178 * MiB;
constexpr size_t WS_WBR = 204 * MiB;
constexpr size_t WS_WOUT = 208 * MiB;
constexpr size_t WS_WGLU = 212 * MiB;
constexpr size_t WS_FFN1 = 213 * MiB;
constexpr size_t WS_FFN2 = 224 * MiB;
constexpr size_t WS_S5M1 = 230 * MiB;
constexpr size_t WS_S5TAB = 234 * MiB;
constexpr size_t WS_BIG = 242 * MiB;
constexpr size_t TOK256 = (size_t)R * 256 * 2;
constexpr size_t WS_INP = WS_BIG;
constexpr size_t WS_T = WS_INP + 7 * TOK256;
constexpr size_t WS_HLOC = WS_T + 3 * TOK256;
constexpr size_t WS_HIN = WS_HLOC + 2 * TOK256;
constexpr size_t WS_KV = WS_HIN + TOK256;
constexpr size_t WS_SPREV = WS_KV + 2 * TOK256;
constexpr size_t WS_FB = WS_SPREV + TOK256;
constexpr size_t WS_GATES = WS_BIG;
constexpr size_t WS_Y = WS_BIG + 132 * MiB;
constexpr size_t WS_YO = WS_Y + 33 * MiB;
constexpr size_t WS_YO1 = WS_BIG;
constexpr size_t WS_H8S = 297 * MiB;
constexpr size_t WS_Z = WS_YO + 33 * MiB;
constexpr size_t WS_YP = WS_Z;
constexpr size_t WS_PARTW = WS_BIG;
constexpr size_t WS_PARTF = 340 * MiB;
constexpr size_t WS_PARTM = 416 * MiB;
constexpr size_t WS_SMAP = WS_S5K;
constexpr size_t WS_FO = WS_Y;
constexpr size_t WS_HID = WS_BIG;
constexpr size_t WS_MHID = WS_OTHERW;
constexpr size_t WS_H = 449 * MiB;
constexpr size_t WS_MIX = 482 * MiB;
constexpr size_t WS_SLOT = WS_H;
constexpr size_t WS_GCTX = 515 * MiB;
constexpr size_t WS_END = 519 * MiB;
static_assert(WS_FB + 16 * MiB <= WS_Z && WS_Z + TOK256 <= WS_H && WS_MHID + (size_t)34816 * 3584 * 2 <= WS_H && WS_W256T + 256 * 1024 <= WS_MOE1, "ws map");
static_assert(WS_MHID + (size_t)34816 * 3584 <= WS_H8S && WS_H8S + (size_t)8 * LCAP * 1024 <= WS_H, "ws map 4");
static_assert(WS_PARTM + (size_t)32 * 7 * 65536 * 2 <= WS_H && WS_MHID + (size_t)34816 * 3584 * 2 <= WS_PARTM, "ws map 3");
static_assert(WS_S5TAB + 8 * MiB <= WS_BIG && WS_FFN2 + (size_t)1024 * 2816 * 2 <= WS_S5M1 && WS_ROUTEW + 32768 * 4 <= WS_S5K, "ws map 2");

constexpr int RING_BYTES = 131072, LDSCTL_OFF = RING_BYTES, LDS_BYTES = 147456;
constexpr int LW_BAR = 8, LW_MOE = 16;

#define VM_WAIT() asm volatile("s_waitcnt vmcnt(0)" ::: "memory")
#define LDS_WAIT() asm volatile("s_waitcnt lgkmcnt(0)" ::: "memory")
typedef __bf16 bf16n2 __attribute__((ext_vector_type(2)));
__device__ __forceinline__ unsigned pk2(float lo, float hi) { bf16n2 v; v.x = (__bf16)lo; v.y = (__bf16)hi; return __builtin_bit_cast(unsigned, v); }
__device__ __forceinline__ unsigned pk4_f8(float a, float b, float c, float d) { int w = 0; w = __builtin_amdgcn_cvt_pk_fp8_f32(a, b, w, false); w = __builtin_amdgcn_cvt_pk_fp8_f32(c, d, w, true); return (unsigned)w; }
__device__ __forceinline__ float bf2f(unsigned short b) { return __builtin_bit_cast(float, ((unsigned)b) << 16); }
__device__ __forceinline__ float bflo(unsigned w) { return __builtin_bit_cast(float, w << 16); }
__device__ __forceinline__ float bfhi(unsigned w) { return __builtin_bit_cast(float, w & 0xffff0000u); }
__device__ __forceinline__ float ex2(float x) { return __builtin_amdgcn_exp2f(x); }
__device__ __forceinline__ float rcpf_(float x) { return __builtin_amdgcn_rcpf(x); }
__device__ __forceinline__ float sigm(float x) { return rcpf_(1.f + ex2(-LOG2E * x)); }
__device__ __forceinline__ float silu_(float x) { return x * sigm(x); }
__device__ __forceinline__ float gelu_tanh(float x) { const float u = 0.7978845608028654f * (x + 0.044715f * x * x * x); const float t = 1.f - 2.f * rcpf_(1.f + ex2(2.885390081777927f * u)); return 0.5f * x * (1.f + t); }
__device__ __forceinline__ float xor32_sum(float v) { const unsigned u = __builtin_bit_cast(unsigned, v); const auto r = __builtin_amdgcn_permlane32_swap(u, u, false, false); return __builtin_bit_cast(float, (unsigned)r[0]) + __builtin_bit_cast(float, (unsigned)r[1]); }
__device__ __forceinline__ float xor32_max(float v) { const unsigned u = __builtin_bit_cast(unsigned, v); const auto r = __builtin_amdgcn_permlane32_swap(u, u, false, false); return fmaxf(__builtin_bit_cast(float, (unsigned)r[0]), __builtin_bit_cast(float, (unsigned)r[1])); }
template <int X> __device__ __forceinline__ float swz_xor(float v) { return __builtin_bit_cast(float, __builtin_amdgcn_ds_swizzle(__builtin_bit_cast(int, v), (X << 10) | 0x1f)); }
__device__ __forceinline__ float wave_sum(float v) { v += swz_xor<1>(v); v += swz_xor<2>(v); v += swz_xor<4>(v); v += swz_xor<8>(v); v += swz_xor<16>(v); return xor32_sum(v); }
__device__ __forceinline__ f32x16 mma32(bf16x8 a, bf16x8 b, f32x16 c) { return __builtin_amdgcn_mfma_f32_32x32x16_bf16(a, b, c, 0, 0, 0); }
__device__ __forceinline__ bf16x8 ldg8(const bf16* p) { return *(const bf16x8*)p; }
__device__ __forceinline__ bf16x8 ldg8p(const bf16* p) { const bf16x4 lo = *(const bf16x4*)p, hi = *(const bf16x4*)(p + 8); return __builtin_shufflevector(lo, hi, 0, 1, 2, 3, 4, 5, 6, 7); }
template <int S> __device__ __forceinline__ bf16x8 accB(const f32x16& c) {
    u32x4 w; w.x = pk2(c[8 * S + 0], c[8 * S + 1]); w.y = pk2(c[8 * S + 2], c[8 * S + 3]); w.z = pk2(c[8 * S + 4], c[8 * S + 5]); w.w = pk2(c[8 * S + 6], c[8 * S + 7]);
    return __builtin_bit_cast(bf16x8, w);
}
__device__ __forceinline__ bf16x8 pack8(const float (&v)[8]) { u32x4 w; w.x = pk2(v[0], v[1]); w.y = pk2(v[2], v[3]); w.z = pk2(v[4], v[5]); w.w = pk2(v[6], v[7]); return __builtin_bit_cast(bf16x8, w); }
__device__ __forceinline__ void unpack8(const bf16x8 x, float (&v)[8]) { const u32x4 w = __builtin_bit_cast(u32x4, x); v[0] = bflo(w.x); v[1] = bfhi(w.x); v[2] = bflo(w.y); v[3] = bfhi(w.y); v[4] = bflo(w.z); v[5] = bfhi(w.z); v[6] = bflo(w.w); v[7] = bfhi(w.w); }
__device__ __forceinline__ f32x16 zero16() { f32x16 z;
#pragma unroll
    for (int i = 0; i < 16; ++i) z[i] = 0.f;
    return z; }

#define XB_TMO      128
#define XB_XCNT(j)  (256  + 64 * (j))
#define XB_XSUB(j)  (1280 + 64 * (j))
#define XB_XGEN(j)  (2304 + 64 * (j))
#define XB_TOP      3328
#define XB_TOPGEN   3392
#define XCD_BAR_WORDS 3456
#define XB_SPIN_CAP (1u << 18)
__device__ __forceinline__ unsigned xb_ld(unsigned* p)              { return __hip_atomic_load(p, __ATOMIC_RELAXED, __HIP_MEMORY_SCOPE_AGENT); }
__device__ __forceinline__ unsigned xb_add(unsigned* p, unsigned v) { return __hip_atomic_fetch_add(p, v, __ATOMIC_RELAXED, __HIP_MEMORY_SCOPE_AGENT); }
__device__ __forceinline__ unsigned xb_xcc_id() { return (unsigned)__builtin_amdgcn_s_getreg((3 << 11) | 20) & 0xFu; }
#define XB_SPIN(cond, bar) do { unsigned _sp = 0; while (cond) { __builtin_amdgcn_s_sleep(1); \
    if ((++_sp & 255u) == 0u) { if (xb_ld(&(bar)[XB_TMO])) break; if (_sp > XB_SPIN_CAP) { atomicAdd(&(bar)[XB_TMO], 1u); break; } } } } while (0)
struct XcdBarrier { unsigned* bar; unsigned x; volatile LAS unsigned* st; };
__device__ __forceinline__ XcdBarrier xcd_barrier_post(unsigned* bar, volatile LAS unsigned* st) {
    XcdBarrier b; b.bar = bar; b.x = xb_xcc_id(); b.st = st;
    if (threadIdx.x == 0) (void)xb_add(&bar[XB_XCNT(b.x)], 1u);
    return b;
}
__device__ __forceinline__ void xcd_barrier_complete(unsigned* bar, unsigned x, unsigned& nloc, unsigned& nx) {
    const unsigned G = gridDim.x * gridDim.y * gridDim.z;
    unsigned sum, cnt, mine, sp = 0u;
    for (;;) {
        sum = 0u; cnt = 0u; mine = 0u;
#pragma unroll
        for (unsigned j = 0; j < 16; ++j) { const unsigned c = xb_ld(&bar[XB_XCNT(j)]); sum += c; cnt += (c > 0u) ? 1u : 0u; mine = (j == x) ? c : mine; }
        if (sum == G) break;
        __builtin_amdgcn_s_sleep(1);
        if ((++sp & 255u) == 0u) { if (xb_ld(&bar[XB_TMO])) break; if (sp > XB_SPIN_CAP) { atomicAdd(&bar[XB_TMO], 1u); break; } }
    }
    nloc = mine > 0u ? mine : 1u; nx = cnt > 0u ? cnt : 1u;
}
__device__ __forceinline__ void xcd_barrier(const XcdBarrier& b) {
    asm volatile("s_waitcnt vmcnt(0)" ::: "memory");
    __syncthreads();
    if (threadIdx.x == 0) {
        unsigned* bar = b.bar;
        __builtin_amdgcn_s_waitcnt(0);
        unsigned nloc = b.st[0], nx = b.st[1];
        if (nloc == 0u) { xcd_barrier_complete(bar, b.x, nloc, nx); b.st[0] = nloc; b.st[1] = nx; }
        const unsigned old = xb_add(&bar[XB_XSUB(b.x)], 1u);
        const unsigned gen = old / nloc;
        if (old + 1u == (gen + 1u) * nloc) {
            __builtin_amdgcn_fence(__ATOMIC_RELEASE, "agent");
            asm volatile("s_waitcnt vmcnt(0)" ::: "memory");
            const unsigned og = xb_add(&bar[XB_TOP], 1u);
            const unsigned tg = og / nx;
            if (og + 1u == (tg + 1u) * nx) xb_add(&bar[XB_TOPGEN], 1u);
            else XB_SPIN(xb_ld(&bar[XB_TOPGEN]) == tg, bar);
            __builtin_amdgcn_fence(__ATOMIC_ACQUIRE, "agent");
            xb_add(&bar[XB_XGEN(b.x)], 1u);
            asm volatile("s_waitcnt vmcnt(0)" ::: "memory");
        } else {
            XB_SPIN(xb_ld(&bar[XB_XGEN(b.x)]) == gen, bar);
            __builtin_amdgcn_fence(__ATOMIC_ACQUIRE, "agent");
            asm volatile("s_waitcnt vmcnt(0)" ::: "memory");
        }
    }
    __syncthreads();
}
namespace gp {
constexpr int BM = 256, BK = 64, HALF = 128, HTB = HALF * BK * 2, STAGE_BYTES = 8 * HTB, NXCD = 8, WGM = 8;
__device__ __forceinline__ int lds_byte(int r, int c) { const int st = (r >> 4) * 2 + (c >> 5), rr = r & 15, cc = c & 31, ob = rr * 64 + cc * 2; return st * 1024 + (ob ^ (((ob >> 9) & 1) << 5)); }
__device__ __forceinline__ void stage_rc(int b, int& Rr, int& C) { const int st = b / 1024, sb = b % 1024, swz = sb ^ (((sb >> 9) & 1) << 5); Rr = (st >> 1) * 16 + swz / 64; C = (st & 1) * 32 + (swz % 64) / 2; }
__device__ __forceinline__ int perm32(int rho) { const int n = rho >> 4, i = rho & 15; return 8 * (i >> 2) + 4 * n + (i & 3); }

struct Unit { const char* a; const char* b; int e0, e1, e2, e3, nt; };

__device__ __forceinline__ void tile_of(int L, int nM, int nN, int& pm, int& pn) {
    const int nwg = nM * nN; int wgid = L;
    { const int q = nwg / NXCD, r = nwg % NXCD, xcd = wgid % NXCD, off = wgid / NXCD; wgid = (xcd < r ? xcd * (q + 1) : r * (q + 1) + (xcd - r) * q) + off; }
    const int nig = WGM * nN, gid = wgid / nig, fm = gid * WGM, gsz = (nM - fm) < WGM ? (nM - fm) : WGM;
    pm = fm + ((wgid % nig) % gsz); pn = (wgid % nig) / gsz;
}

typedef int i32x8 __attribute__((ext_vector_type(8)));
typedef int i32x4v __attribute__((ext_vector_type(4)));
__device__ __forceinline__ i32x8 cat8(const bf16x8 a, const bf16x8 b) { const i32x4v x = __builtin_bit_cast(i32x4v, a), y = __builtin_bit_cast(i32x4v, b); return __builtin_shufflevector(x, y, 0, 1, 2, 3, 4, 5, 6, 7); }
__device__ __forceinline__ void mfma_f8(f32x4& acc, const i32x8 a, const i32x8 b) { asm volatile("s_nop 1\n\tv_mfma_f32_16x16x128_f8f6f4 %0, %1, %2, %0" : "+v"(acc) : "v"(a), "v"(b)); }
template <class Epi, class Sched, bool F8 = false>
__device__ __forceinline__ void gemm_phase(LAS unsigned char* lds, const int tid, const int K, const int lda, const int ldb, const Sched& S, const Epi& E) {
    constexpr bool GATHER = Sched::GATHER;
    const int wid = __builtin_amdgcn_readfirstlane(tid >> 6), lane = tid & 63, wr = wid >> 2, wc = wid & 3, fr = lane & 15, fq = lane >> 4;
    unsigned voffA[2], voffB[2];
#pragma unroll
    for (int i = 0; i < 2; ++i) { int Rr, C; stage_rc(tid * 16 + i * 8192, Rr, C); const int Rb = (Rr & ~31) + perm32(Rr & 31);
        voffA[i] = (unsigned)(Rr * lda + C) * 2u; voffB[i] = (unsigned)(Rb * ldb + C) * 2u; }
#define PG8_GOFF(dst, unit) do { _Pragma("unroll") for (int _h = 0; _h < 2; ++_h) _Pragma("unroll") for (int _i = 0; _i < 2; ++_i) { int _R, _C; stage_rc(tid * 16 + _i * 8192, _R, _C); dst[_h][_i] = S.rowoff(unit, _R + _h * HALF) + (unsigned)_C * 2u; } } while (0)
    const size_t kstep = (size_t)(BK * 2);
    const unsigned hstepA = (unsigned)HALF * (unsigned)lda * 2u; const size_t hstepB = (size_t)HALF * ldb * 2;
    const unsigned ldsw = (unsigned)wid * 1024u;
    const int aoff = lds_byte(wr * 64 + fr, fq * 8), boff = lds_byte(wc * 32 + fr, fq * 8);
#define PG8_SA(b, h) (((b) * 2 + (h)) * HTB)
#define PG8_SB(b, h) ((4 + (b) * 2 + (h)) * HTB)
#define PG8_STB(bufoff, gbase, hh) do { const char* _gb = (const char*)(gbase) + (size_t)(hh) * hstepB; _Pragma("unroll") for (int _i = 0; _i < 2; ++_i) \
        __builtin_amdgcn_global_load_lds((const unsigned*)(_gb + voffB[_i]), (LAS unsigned*)(lds + (bufoff) + ldsw + _i * 8192), 16, 0, 0); } while (0)
#define PG8_STA(bufoff, gbase, hh, VG) do { const char* _ga = (const char*)(gbase) + (GATHER ? (size_t)0 : (size_t)(hh) * hstepA); _Pragma("unroll") for (int _i = 0; _i < 2; ++_i) { const unsigned _o = GATHER ? (VG) : voffA[_i]; \
        __builtin_amdgcn_global_load_lds((const unsigned*)(_ga + _o), (LAS unsigned*)(lds + (bufoff) + ldsw + _i * 8192), 16, 0, 0); } } while (0)
#define PG8_LDA(dst, b, h) do { _Pragma("unroll") for (int m = 0; m < 4; ++m) _Pragma("unroll") for (int k = 0; k < 2; ++k) dst[m][k] = *(const LAS bf16x8*)(lds + PG8_SA(b, h) + aoff + m * 2048 + k * 1024); } while (0)
#define PG8_LDB(dst, b, h) do { _Pragma("unroll") for (int n = 0; n < 2; ++n) _Pragma("unroll") for (int k = 0; k < 2; ++k) dst[n][k] = *(const LAS bf16x8*)(lds + PG8_SB(b, h) + boff + n * 2048 + k * 1024); } while (0)
#define PG8_MMA(ai, bj, At, Bt) do { __builtin_amdgcn_s_setprio(1); _Pragma("unroll") for (int m = 0; m < 4; ++m) _Pragma("unroll") for (int n = 0; n < 2; ++n) { \
        if constexpr (F8) mfma_f8(acc[ai][bj][m][n], cat8(Bt[n][0], Bt[n][1]), cat8(At[m][0], At[m][1])); \
        else { _Pragma("unroll") for (int k = 0; k < 2; ++k) acc[ai][bj][m][n] = __builtin_amdgcn_mfma_f32_16x16x32_bf16(Bt[n][k], At[m][k], acc[ai][bj][m][n], 0, 0, 0); } } __builtin_amdgcn_s_setprio(0); } while (0)
#define PG8_WAIT_V(n) asm volatile("s_waitcnt vmcnt(" #n ")" ::: "memory")
#define PG8_WAIT_L(n) asm volatile("s_waitcnt lgkmcnt(" #n ")" ::: "memory")
#define PG8_BAR __builtin_amdgcn_s_barrier()
#define PG8_SCHED __builtin_amdgcn_sched_barrier(0)
    Unit cur, nxt; int ui = 0;
    if (!S.next(0, cur)) return;
    f32x4 acc[2][2][4][2];
#pragma unroll
    for (int a = 0; a < 2; ++a)
#pragma unroll
        for (int b = 0; b < 2; ++b)
#pragma unroll
            for (int m = 0; m < 4; ++m)
#pragma unroll
                for (int n = 0; n < 2; ++n) acc[a][b][m][n] = (f32x4){0.f, 0.f, 0.f, 0.f};
    bf16x8 At[4][2], B0[2][2], B1[2][2];
    unsigned vgc[2][2], vgn[2][2];
    if constexpr (GATHER) { PG8_GOFF(vgc, cur); }
#pragma unroll
    for (int h = 0; h < 2; ++h)
#pragma unroll
        for (int i = 0; i < 2; ++i) { if (!GATHER) vgc[h][i] = 0u; vgn[h][i] = vgc[h][i]; }
    const char* cA = cur.a; const char* cB = cur.b;
    PG8_STB(PG8_SB(0, 0), cB, 0); PG8_STB(PG8_SB(0, 1), cB, 1); PG8_STA(PG8_SA(0, 0), cA, 0, vgc[0][_i]); PG8_STA(PG8_SA(0, 1), cA, 1, vgc[1][_i]);
    if (wr == 1) PG8_BAR;
    PG8_WAIT_V(2); PG8_BAR;
    PG8_STB(PG8_SB(1, 0), cB + kstep, 0); PG8_STA(PG8_SA(1, 0), cA + kstep, 0, vgc[0][_i]); PG8_STB(PG8_SB(1, 1), cB + kstep, 1);
    PG8_WAIT_V(6); PG8_BAR;
    for (;;) {
        const bool has_next = S.next(ui + 1, nxt);
        const char* nA = has_next ? nxt.a : cA; const char* nB = has_next ? nxt.b : cB;
        int nt = cur.nt; asm volatile("" : "+s"(nt));
#pragma unroll 1
        for (int t = 0; t < nt; t += 2) {
            const bool last = (t == nt - 2);
            const char* a1 = cA + (size_t)(t + 1) * kstep;
            const char* a2 = last ? nA : cA + (size_t)(t + 2) * kstep; const char* b2 = last ? nB : cB + (size_t)(t + 2) * kstep;
            const char* a3 = a2 + kstep; const char* b3 = b2 + kstep;
            if constexpr (Epi::MID) { if (t != 0 && (t & 3) == 0 && cur.nt == 16) E.mid(acc, cur, (t >> 2) - 1, wr, wc, fr, fq); }
            if constexpr (GATHER) { if (last && has_next) { PG8_GOFF(vgn, nxt); } }
            PG8_LDB(B0, 0, 0); PG8_LDB(B1, 0, 1); PG8_SCHED; PG8_LDA(At, 0, 0); PG8_STA(PG8_SA(1, 1), a1, 1, vgc[1][_i]);
            PG8_WAIT_V(8); PG8_WAIT_L(0); PG8_BAR; PG8_MMA(0, 0, At, B0); PG8_MMA(0, 1, At, B1); PG8_BAR; PG8_SCHED;
            PG8_LDA(At, 0, 1); PG8_STB(PG8_SB(0, 0), b2, 0); PG8_STB(PG8_SB(0, 1), b2, 1); PG8_STA(PG8_SA(0, 0), a2, 0, (last ? vgn[0][_i] : vgc[0][_i]));
            PG8_WAIT_V(8); PG8_WAIT_L(0); PG8_BAR; PG8_MMA(1, 0, At, B0); PG8_MMA(1, 1, At, B1); PG8_BAR; PG8_SCHED;
            PG8_LDB(B0, 1, 0); PG8_LDB(B1, 1, 1); PG8_SCHED; PG8_LDA(At, 1, 0); PG8_STA(PG8_SA(0, 1), a2, 1, (last ? vgn[1][_i] : vgc[1][_i]));
            PG8_WAIT_V(8); PG8_WAIT_L(0); PG8_BAR; PG8_MMA(0, 0, At, B0); PG8_MMA(0, 1, At, B1); PG8_BAR; PG8_SCHED;
            PG8_LDA(At, 1, 1); PG8_STB(PG8_SB(1, 0), b3, 0); PG8_STB(PG8_SB(1, 1), b3, 1); PG8_STA(PG8_SA(1, 0), a3, 0, (last ? vgn[0][_i] : vgc[0][_i]));
            PG8_WAIT_V(8); PG8_WAIT_L(0); PG8_BAR; PG8_MMA(1, 0, At, B0); PG8_MMA(1, 1, At, B1); PG8_BAR; PG8_SCHED;
        }
        if constexpr (F8) { asm volatile("s_nop 15\n\ts_nop 15" ::: "memory"); }
        if (wr == 0) PG8_BAR;
        Unit ue = cur; int le = lane;
        if constexpr (Epi::LAUNDER) { int t0 = cur.e0, t1 = cur.e1, t2 = cur.e2, t3 = cur.e3; asm volatile("" : "+v"(t0), "+v"(t1), "+v"(t2), "+v"(t3), "+v"(le));
          ue.e0 = __builtin_amdgcn_readfirstlane(t0); ue.e1 = __builtin_amdgcn_readfirstlane(t1); ue.e2 = __builtin_amdgcn_readfirstlane(t2); ue.e3 = __builtin_amdgcn_readfirstlane(t3); le &= 63; }
        const int fre = le & 15, fqe = le >> 4;
        if constexpr (Epi::CARRY) { E.carry(acc, ue, wr, wc, fre, fqe); if (!has_next) break; }
        else {
        E(acc, ue, wr, wc, fre, fqe);
        if (!has_next) break;
#pragma unroll
        for (int a = 0; a < 2; ++a)
#pragma unroll
            for (int b = 0; b < 2; ++b)
#pragma unroll
                for (int m = 0; m < 4; ++m)
#pragma unroll
                    for (int n = 0; n < 2; ++n) acc[a][b][m][n] = (f32x4){0.f, 0.f, 0.f, 0.f};
        }
        cur = nxt; cA = nA; cB = nB; ++ui;
#pragma unroll
        for (int h = 0; h < 2; ++h)
#pragma unroll
            for (int i = 0; i < 2; ++i) vgc[h][i] = vgn[h][i];
        if (wr == 1) PG8_BAR;
    }
    PG8_WAIT_V(0);
    PG8_BAR;
#undef PG8_SA
#undef PG8_SB
#undef PG8_STA
#undef PG8_GOFF
#undef PG8_STB
#undef PG8_LDA
#undef PG8_LDB
#undef PG8_MMA
#undef PG8_WAIT_V
#undef PG8_WAIT_L
#undef PG8_BAR
#undef PG8_SCHED
}

struct SchedPlain {
    static constexpr bool GATHER = false;
    const char* A; const char* B; size_t ta, tb; int nM, nN, G, c, nt; int lim = 0x7fffffff;
    __device__ __forceinline__ bool next(int i, Unit& u) const {
        const long L = (long)i * G + c; if (L >= (long)nM * nN || L >= (long)lim) return false;
        int pm, pn; tile_of((int)L, nM, nN, pm, pn); u.a = A + (size_t)pm * ta; u.b = B + (size_t)pn * tb; u.e0 = pm; u.e1 = pn; u.e2 = 0; u.e3 = 0; u.nt = nt; return true; }
    __device__ __forceinline__ unsigned rowoff(const Unit&, int) const { return 0u; }
};
struct SchedInprojA {
    static constexpr bool GATHER = false;
    const char* Hh; const char* W; int nM, G, c, ng;
    __device__ __forceinline__ bool next(int i, Unit& u) const {
        long L = (long)i * G + c; const int n1 = nM * 7, n2 = 3 * nM; if (L >= n1 + n2 + ng) return false;
        int pm, pn;
        if (L < n1) { tile_of((int)L, nM, 7, pm, pn); u.a = Hh + (size_t)pm * (256 * 2048); u.b = W + (size_t)pn * (256 * 2048); u.e2 = 0; }
        else if (L < n1 + n2) { tile_of((int)(L - n1), 3, nM, pm, pn); u.a = W + (size_t)(23 + pm) * (256 * 2048); u.b = Hh + (size_t)pn * (256 * 2048); u.e2 = 1; }
        else { const int q = (int)(L - n1 - n2); pm = q >> 4; pn = q & 15; u.a = Hh + (size_t)(64 + pm) * (256 * 2048); u.b = W + (size_t)(7 + pn) * (256 * 2048); u.e2 = 2; }
        u.e0 = pm; u.e1 = pn; u.e3 = 0; u.nt = 16; return true; }
    __device__ __forceinline__ unsigned rowoff(const Unit&, int) const { return 0u; }
};
struct SchedSplit {
    static constexpr bool GATHER = false;
    const char* A; const char* B; size_t ta, tb; int nslice, ntf, G, c; const char* Ac; size_t tac, sac; int ks;
    __device__ __forceinline__ bool next(int i, Unit& u) const {
        const long L = (long)i * G + c; int pm, pn;
        if (L < 256) { tile_of((int)L, 64, 4, pm, pn); u.a = A + (size_t)pm * ta; u.b = B + (size_t)pn * tb; u.e2 = 0; u.e3 = 0; u.nt = ntf; }
        else { const int q = (int)(L - 256); if (q >= 8 * nslice) return false; const int tile = q / nslice, s = q % nslice; pm = 64 + (tile >> 2); pn = tile & 3;
            u.a = Ac + (size_t)(tile >> 2) * tac + (size_t)(s / ks) * sac + (s % ks) * 512; u.b = B + (size_t)pn * tb + (s % ks) * 512; u.e2 = s + 1; u.e3 = tile; u.nt = 4; }
        u.e0 = pm; u.e1 = pn; return true; }
    __device__ __forceinline__ unsigned rowoff(const Unit&, int) const { return 0u; }
};
struct SchedMerge {
    static constexpr bool GATHER = false;
    const char* Mix; const char* Wb; int nctx, G, c;
    __device__ __forceinline__ bool next(int i, Unit& u) const {
        const long L = (long)i * G + c; int pm, pn;
        if (L < 256) { tile_of((int)L, 64, 4, pm, pn); u.a = Mix + (size_t)pm * (256 * 2048); u.b = Wb + (size_t)pn * (256 * 2048); u.e2 = 0; u.e3 = 0; u.nt = 16; }
        else { const long q = L - 256; if (q >= nctx) return false; const int tile = (int)q >> 2, b = (int)q & 3; pm = 64 + (tile >> 2); pn = tile & 3;
            u.a = Mix + (size_t)pm * (256 * 2048) + b * 512; u.b = Wb + (size_t)pn * (256 * 2048) + b * 512; u.e2 = b; u.e3 = 1; u.nt = 4; }
        u.e0 = pm; u.e1 = pn; return true; }
    __device__ __forceinline__ unsigned rowoff(const Unit&, int) const { return 0u; }
};
__device__ __forceinline__ int mtu(const LAS unsigned* mt, int i) { return __builtin_amdgcn_readfirstlane((int)mt[i]); }
struct SchedMoe1 {
    static constexpr bool GATHER = true;
    const char* Hh; const char* W; const int* list; const LAS unsigned* mt; int G, c; unsigned rb;
    __device__ __forceinline__ bool next(int i, Unit& u) const {
        long L = (long)i * G + c; int e = 0;
        for (; e < 8; ++e) { const long ue = (long)mtu(mt, 8 + e) * 28; if (L < ue) break; L -= ue; }
        if (e == 8) return false;
        const int m_e = mtu(mt, 8 + e), nti = (int)(L / m_e), mti = (int)(L % m_e);
        u.a = Hh; u.b = W + ((size_t)e * 7168 + (size_t)nti * 256) * rb; u.e0 = e; u.e1 = mti; u.e2 = nti; u.e3 = (mtu(mt, 16 + e) + mti) * 256; u.nt = (int)(rb >> 7); return true; }
    __device__ __forceinline__ unsigned rowoff(const Unit& u, int r) const {
        const int li = u.e1 * 256 + r; const int ent = (li < (int)mt[u.e0]) ? list[u.e0 * LCAP + li] : 0; return (unsigned)(ent >> 1) * rb; }
};
__device__ __forceinline__ void moe_mn(int L, int nM, int nN, int& mti, int& nti) { const int nig = 8 * nN, gid = L / nig, fm = gid * 8, gsz = (nM - fm) < 8 ? (nM - fm) : 8, r = L - gid * nig; mti = fm + r % gsz; nti = r / gsz; }
struct SchedMoe1P {
    static constexpr bool GATHER = false;
    const char* Hs; const char* W; const LAS unsigned* mt; int G, c; unsigned rb;
    __device__ __forceinline__ bool next(int i, Unit& u) const {
        long L = (long)i * G + c; int e = 0;
        for (; e < 8; ++e) { const long ue = (long)mtu(mt, 8 + e) * 28; if (L < ue) break; L -= ue; }
        if (e == 8) return false;
        const int m_e = mtu(mt, 8 + e); int nti, mti; moe_mn((int)L, m_e, 28, mti, nti);
        u.a = Hs + ((size_t)e * LCAP + (size_t)mti * 256) * rb; u.b = W + ((size_t)e * 7168 + (size_t)nti * 256) * rb; u.e0 = e; u.e1 = mti; u.e2 = nti; u.e3 = (mtu(mt, 16 + e) + mti) * 256; u.nt = (int)(rb >> 7); return true; }
    __device__ __forceinline__ unsigned rowoff(const Unit&, int) const { return 0u; }
};
__device__ __forceinline__ bool moe2_unit(long L, const LAS unsigned* mt, const char* Hid, const char* W, Unit& u, const size_t rb) {
    int e = 0;
    for (; e < 8; ++e) { const long ue = (long)mtu(mt, 8 + e) * 4; if (L < ue) break; L -= ue; }
    if (e == 8) return false;
    const int m_e = mtu(mt, 8 + e); int nti, mti; moe_mn((int)L, m_e, 4, mti, nti);
    u.a = Hid + (size_t)(mtu(mt, 16 + e) + mti) * 256 * rb; u.b = W + ((size_t)e * 1024 + (size_t)nti * 256) * rb; u.e0 = e; u.e1 = mti; u.e2 = nti; u.e3 = 0; u.nt = (int)(rb >> 7); return true;
}
struct SchedMoe2 {
    static constexpr bool GATHER = false;
    const char* Hid; const char* W; const LAS unsigned* mt; int G, c; unsigned rb;
    __device__ __forceinline__ bool next(int i, Unit& u) const { const long L = (long)i * G + c; if (L >= (long)mtu(mt, 25)) return false; return moe2_unit(L, mt, Hid, W, u, rb); }
    __device__ __forceinline__ unsigned rowoff(const Unit&, int) const { return 0u; }
};
struct SchedMoe2S {
    static constexpr bool GATHER = false;
    const char* Hid; const char* W; const LAS unsigned* mt; int G, c; unsigned rb;
    __device__ __forceinline__ bool next(int i, Unit& u) const { const long q = (long)i * G + c; if (q >= (long)mtu(mt, 26) * 7) return false;
        if (!moe2_unit((long)mtu(mt, 25) + q / 7, mt, Hid, W, u, rb)) return false; const int s = (int)(q % 7); const unsigned sb = rb / 7u; u.a += s * sb; u.b += s * sb; u.e3 = (int)q; u.nt = (int)(sb >> 7); return true; }
    __device__ __forceinline__ unsigned rowoff(const Unit&, int) const { return 0u; }
};

#define EPI_ROWS(ai, m) (128 * (ai) + 64 * wr + 16 * (m) + fr)
#define EPI_COL(bj) (128 * (bj) + 32 * wc + 8 * fq)
__device__ __forceinline__ u32x4 pack_acc8(const f32x4 a, const f32x4 b) { u32x4 w; w.x = pk2(a[0], a[1]); w.y = pk2(a[2], a[3]); w.z = pk2(b[0], b[1]); w.w = pk2(b[2], b[3]); return w; }

__device__ __forceinline__ unsigned pk4_u8(const f32x4 a) {
    unsigned w = 0u;
    w = __builtin_amdgcn_cvt_pk_u8_f32(fmaxf(a[0] * 255.f, 1.f), 0u, w); w = __builtin_amdgcn_cvt_pk_u8_f32(fmaxf(a[1] * 255.f, 1.f), 1u, w);
    w = __builtin_amdgcn_cvt_pk_u8_f32(fmaxf(a[2] * 255.f, 1.f), 2u, w); w = __builtin_amdgcn_cvt_pk_u8_f32(fmaxf(a[3] * 255.f, 1.f), 3u, w); return w; }
__device__ __forceinline__ u32x2 pack_gate8(const f32x4 a, const f32x4 b) { u32x2 w; w.x = pk4_u8(a); w.y = pk4_u8(b); return w; }
__device__ __forceinline__ unsigned pk4_u8s(const f32x4 a) {
    unsigned w = 0u;
    w = __builtin_amdgcn_cvt_pk_u8_f32(fmaxf(a[0], 1.f), 0u, w); w = __builtin_amdgcn_cvt_pk_u8_f32(fmaxf(a[1], 1.f), 1u, w);
    w = __builtin_amdgcn_cvt_pk_u8_f32(fmaxf(a[2], 1.f), 2u, w); w = __builtin_amdgcn_cvt_pk_u8_f32(fmaxf(a[3], 1.f), 3u, w); return w; }
__device__ __forceinline__ u32x2 pack_gate8s(const f32x4 a, const f32x4 b) { u32x2 w; w.x = pk4_u8s(a); w.y = pk4_u8s(b); return w; }
__device__ __forceinline__ size_t gate_off(int pm, int j, int b, int wr, int wc, int ai, int m, int bj, int fr, int fq) { return ((((size_t)((pm * 4 + j) * 4 + b) * 8 + wr * 4 + wc) * 16 + (ai * 4 + m) * 2 + bj) * 64 + fq * 16 + fr) * 8; }
__device__ __forceinline__ float gate8(unsigned w, int k) { return (float)((w >> (8 * k)) & 255u) * (1.f / 255.f); }
__device__ __forceinline__ float gate8r(unsigned w, int k) { return (float)((w >> (8 * k)) & 255u); }
struct EpiPlain { static constexpr bool CARRY = false, LAUNDER = false, MID = false;
    bf16* O; int ld;
    __device__ __forceinline__ void operator()(const f32x4 (&acc)[2][2][4][2], const Unit& u, int wr, int wc, int fr, int fq) const {
#pragma unroll
        for (int ai = 0; ai < 2; ++ai)
#pragma unroll
            for (int m = 0; m < 4; ++m) { bf16* rowp = O + (size_t)(u.e0 * 256 + EPI_ROWS(ai, m)) * ld + u.e1 * 256;
#pragma unroll
                for (int bj = 0; bj < 2; ++bj) *(u32x4*)(rowp + EPI_COL(bj)) = pack_acc8(acc[ai][bj][m][0], acc[ai][bj][m][1]); }
    }
};
struct EpiPlainSplit { static constexpr bool CARRY = false, LAUNDER = false, MID = false;
    bf16* O; int ld; float* P; int nslice;
    __device__ __forceinline__ void operator()(const f32x4 (&acc)[2][2][4][2], const Unit& u, int wr, int wc, int fr, int fq) const {
        if (u.e2 == 0) {
#pragma unroll
            for (int ai = 0; ai < 2; ++ai)
#pragma unroll
                for (int m = 0; m < 4; ++m) { bf16* rowp = O + (size_t)(u.e0 * 256 + EPI_ROWS(ai, m)) * ld + u.e1 * 256;
#pragma unroll
                    for (int bj = 0; bj < 2; ++bj) *(u32x4*)(rowp + EPI_COL(bj)) = pack_acc8(acc[ai][bj][m][0], acc[ai][bj][m][1]); }
        } else { float* pt = P + (size_t)(u.e3 * nslice + (u.e2 - 1)) * 65536;
#pragma unroll
            for (int ai = 0; ai < 2; ++ai)
#pragma unroll
                for (int m = 0; m < 4; ++m)
#pragma unroll
                    for (int bj = 0; bj < 2; ++bj) { float* p = pt + EPI_ROWS(ai, m) * 256 + EPI_COL(bj); *(f32x4*)p = acc[ai][bj][m][0]; *(f32x4*)(p + 4) = acc[ai][bj][m][1]; }
        }
    }
};
struct EpiInprojA { static constexpr bool CARRY = false, LAUNDER = true, MID = false;
    bf16* INP; bf16* T; unsigned char* Gc;
    __device__ __forceinline__ void operator()(const f32x4 (&acc)[2][2][4][2], const Unit& u, int wr, int wc, int fr, int fq) const {
        if (u.e2 == 2) {
#pragma unroll
            for (int ai = 0; ai < 2; ++ai)
#pragma unroll
                for (int m = 0; m < 4; ++m)
#pragma unroll
                    for (int bj = 0; bj < 2; ++bj) { f32x4 a = acc[ai][bj][m][0], b = acc[ai][bj][m][1];
#pragma unroll
                        for (int j = 0; j < 4; ++j) { a[j] = sigm(a[j]); b[j] = sigm(b[j]); }
                        *(u32x2*)(Gc + gate_off(u.e0, u.e1 & 3, u.e1 >> 2, wr, wc, ai, m, bj, fr, fq)) = pack_gate8(a, b); }
        } else if (u.e2 == 0) {
            bf16* base = INP + (size_t)u.e1 * ((size_t)R * 256);
            const bool regroup = (u.e1 == 1), kfrag = (u.e1 == 6);
#pragma unroll
            for (int ai = 0; ai < 2; ++ai)
#pragma unroll
                for (int m = 0; m < 4; ++m) { const int row = u.e0 * 256 + EPI_ROWS(ai, m);
#pragma unroll
                    for (int bj = 0; bj < 2; ++bj) { const int col = EPI_COL(bj);
                        bf16* p = regroup ? base + ((((size_t)(col >> 4) * 33 + (row >> 9)) * 16 + (row & 15)) * 64 + ((col & 8) << 2) + ((row >> 4) & 31)) * 8
                                : (kfrag ? base + ((((size_t)(row >> 5) * 4 + (col >> 6)) * 4 + ((col >> 4) & 3)) * 64 + ((col >> 3) & 1) * 32 + (row & 31)) * 8 : base + (size_t)row * 256 + col);
                        *(u32x4*)p = pack_acc8(acc[ai][bj][m][0], acc[ai][bj][m][1]); } }
        } else {
#pragma unroll
            for (int ai = 0; ai < 2; ++ai)
#pragma unroll
                for (int m = 0; m < 4; ++m) { bf16* rowp = T + (size_t)(u.e0 * 256 + EPI_ROWS(ai, m)) * R + u.e1 * 256;
#pragma unroll
                    for (int bj = 0; bj < 2; ++bj) { const u32x4 w = pack_acc8(acc[ai][bj][m][0], acc[ai][bj][m][1]);
                        if (u.e0 != 2) *(u32x4*)(rowp + EPI_COL(bj)) = w;
                        else {
                            const int ch = EPI_ROWS(ai, m), t0 = u.e1 * 256 + EPI_COL(bj), k0 = t0 & 31;
                            bf16* f = T + (size_t)512 * R + (((((size_t)(t0 >> 5) * 4 + (ch >> 6)) * 2 + ((ch >> 5) & 1)) * 2 + (k0 >> 4)) * 64 + (ch & 31)) * 8 + ((k0 & 8) ? 4 : 0);
                            *(u32x2*)f = (u32x2){w.x, w.y}; *(u32x2*)(f + 32 * 8) = (u32x2){w.z, w.w}; } } }
        }
    }
};
struct EpiGates { static constexpr bool CARRY = false, LAUNDER = false, MID = false;
    unsigned char* Gt; float isc;
    __device__ __forceinline__ void operator()(const f32x4 (&acc)[2][2][4][2], const Unit& u, int wr, int wc, int fr, int fq) const {
        const float ec = -LOG2E * isc;
#pragma unroll
        for (int ai = 0; ai < 2; ++ai)
#pragma unroll
            for (int m = 0; m < 4; ++m)
#pragma unroll
                for (int bj = 0; bj < 2; ++bj) { f32x4 a = acc[ai][bj][m][0], b = acc[ai][bj][m][1];
#pragma unroll
                    for (int j = 0; j < 4; ++j) { a[j] = rcpf_(__builtin_fmaf(ex2(a[j] * ec), 1.f / 255.f, 1.f / 255.f)); b[j] = rcpf_(__builtin_fmaf(ex2(b[j] * ec), 1.f / 255.f, 1.f / 255.f)); }
                    *(u32x2*)(Gt + gate_off(u.e0, u.e1 & 3, u.e1 >> 2, wr, wc, ai, m, bj, fr, fq)) = pack_gate8s(a, b); }
    }
};
struct EpiGlu { static constexpr bool CARRY = false, LAUNDER = false, MID = false;
    const bf16* Zz; bf16* Mix; const float* bglu;
    __device__ __forceinline__ void operator()(const f32x4 (&acc)[2][2][4][2], const Unit& u, int wr, int wc, int fr, int fq) const {
        u32x4 zq[2][2][4];
#pragma unroll
        for (int bj = 0; bj < 2; ++bj)
#pragma unroll
            for (int ai = 0; ai < 2; ++ai)
#pragma unroll
                for (int m = 0; m < 4; ++m) zq[bj][ai][m] = *(const u32x4*)(Zz + (size_t)(u.e0 * 256 + EPI_ROWS(ai, m)) * 256 + EPI_COL(bj));
#pragma unroll
        for (int bj = 0; bj < 2; ++bj) { const int col = EPI_COL(bj);
            const f32x4 b0 = *(const f32x4*)(bglu + col), b1 = *(const f32x4*)(bglu + col + 4);
#pragma unroll
            for (int ai = 0; ai < 2; ++ai)
#pragma unroll
                for (int m = 0; m < 4; ++m) { const size_t row = (size_t)(u.e0 * 256 + EPI_ROWS(ai, m));
                    const u32x4 zz = zq[bj][ai][m];
                    f32x4 a = acc[ai][bj][m][0] + b0, b = acc[ai][bj][m][1] + b1;
                    a[0] = bflo(zz.x) * sigm(a[0]); a[1] = bfhi(zz.x) * sigm(a[1]); a[2] = bflo(zz.y) * sigm(a[2]); a[3] = bfhi(zz.y) * sigm(a[3]);
                    b[0] = bflo(zz.z) * sigm(b[0]); b[1] = bfhi(zz.z) * sigm(b[1]); b[2] = bflo(zz.w) * sigm(b[2]); b[3] = bfhi(zz.w) * sigm(b[3]);
                    *(u32x4*)(Mix + row * 1024 + 256 + col) = pack_acc8(a, b); } }
    }
};
struct EpiMerge {
    static constexpr bool CARRY = false, LAUNDER = false, MID = true;
    const unsigned char* Gt; const unsigned char* Gc; bf16* Y; bf16* YP;
    __device__ __forceinline__ void mid(f32x4 (&acc)[2][2][4][2], const Unit& u, int b, int wr, int wc, int fr, int fq) const {
        u32x2 g[2][4][2], gn[2][4][2];
#pragma unroll
        for (int ai = 0; ai < 2; ++ai)
#pragma unroll
            for (int m = 0; m < 4; ++m)
#pragma unroll
                for (int bj = 0; bj < 2; ++bj) { const unsigned char* gp = Gt + gate_off(u.e0, u.e1, b, wr, wc, ai, m, bj, fr, fq); g[ai][m][bj] = *(const u32x2*)gp; gn[ai][m][bj] = *(const u32x2*)(gp + 65536); }
#pragma unroll
        for (int ai = 0; ai < 2; ++ai)
#pragma unroll
            for (int m = 0; m < 4; ++m)
#pragma unroll
                for (int bj = 0; bj < 2; ++bj) { f32x4 a0 = acc[ai][bj][m][0], a1 = acc[ai][bj][m][1];
#pragma unroll
                    for (int j = 0; j < 4; ++j) { a0[j] *= gate8r(g[ai][m][bj].x, j) * rcpf_(gate8r(gn[ai][m][bj].x, j)); a1[j] *= gate8r(g[ai][m][bj].y, j) * rcpf_(gate8r(gn[ai][m][bj].y, j)); }
                    acc[ai][bj][m][0] = a0; acc[ai][bj][m][1] = a1; }
    }
    __device__ __forceinline__ void operator()(const f32x4 (&acc)[2][2][4][2], const Unit& u, int wr, int wc, int fr, int fq) const {
        const int b = u.e3 ? u.e2 : 3;
        u32x2 gg[2][4][2];
#pragma unroll
        for (int ai = 0; ai < 2; ++ai)
#pragma unroll
            for (int m = 0; m < 4; ++m)
#pragma unroll
                for (int bj = 0; bj < 2; ++bj) gg[ai][m][bj] = *(const u32x2*)((u.e3 ? Gc : Gt) + gate_off(u.e3 ? u.e0 - 64 : u.e0, u.e1, b, wr, wc, ai, m, bj, fr, fq));
#pragma unroll
        for (int ai = 0; ai < 2; ++ai)
#pragma unroll
            for (int m = 0; m < 4; ++m) { const size_t row = (size_t)(u.e0 * 256 + EPI_ROWS(ai, m));
                bf16* orow = (u.e3 ? YP + ((size_t)b * CROWS + (row - LROWS)) * 1024 : Y + row * 1024) + u.e1 * 256;
#pragma unroll
                for (int bj = 0; bj < 2; ++bj) { const u32x2 g = gg[ai][m][bj]; f32x4 a0 = acc[ai][bj][m][0], a1 = acc[ai][bj][m][1];
#pragma unroll
                    for (int j = 0; j < 4; ++j) { a0[j] *= gate8(g.x, j); a1[j] *= gate8(g.y, j); }
                    *(u32x4*)(orow + EPI_COL(bj)) = pack_acc8(a0, a1); } }
    }
};
struct EpiSwiglu { static constexpr bool CARRY = false, LAUNDER = false, MID = false;
    bf16* Hd; int ldh; bool moe;
    __device__ __forceinline__ void operator()(const f32x4 (&acc)[2][2][4][2], const Unit& u, int wr, int wc, int fr, int fq) const {
        const int rowbase = moe ? u.e3 : u.e0 * 256, pn = moe ? u.e2 : u.e1;
#pragma unroll
        for (int ai = 0; ai < 2; ++ai)
#pragma unroll
            for (int m = 0; m < 4; ++m) { bf16* p = Hd + (size_t)(rowbase + EPI_ROWS(ai, m)) * ldh + pn * 128 + 32 * wc + 8 * fq;
                f32x4 a = acc[ai][0][m][0], b = acc[ai][0][m][1]; const f32x4 ua = acc[ai][1][m][0], ub = acc[ai][1][m][1];
#pragma unroll
                for (int j = 0; j < 4; ++j) { a[j] = silu_(a[j]) * ua[j]; b[j] = silu_(b[j]) * ub[j]; }
                *(u32x4*)p = pack_acc8(a, b); }
    }
};
struct EpiSwigluF8 { static constexpr bool CARRY = false, LAUNDER = true, MID = false;
    unsigned char* Hd; int ldh; bool moe; float ws, hs;
    __device__ __forceinline__ void operator()(const f32x4 (&acc)[2][2][4][2], const Unit& u, int wr, int wc, int fr, int fq) const {
        const int rowbase = moe ? u.e3 : u.e0 * 256, pn = moe ? u.e2 : u.e1; const float ec = -LOG2E * ws, ik = 1.f / (hs * ws * ws);
#pragma unroll
        for (int ai = 0; ai < 2; ++ai)
#pragma unroll
            for (int m = 0; m < 4; ++m) { unsigned char* p = Hd + (size_t)(rowbase + EPI_ROWS(ai, m)) * ldh + pn * 128 + 32 * wc + 8 * fq;
                f32x4 a = acc[ai][0][m][0], b = acc[ai][0][m][1]; const f32x4 ua = acc[ai][1][m][0], ub = acc[ai][1][m][1];
#pragma unroll
                for (int j = 0; j < 4; ++j) {
                    a[j] = __builtin_amdgcn_fmed3f((a[j] * ua[j]) * rcpf_(__builtin_fmaf(ex2(a[j] * ec), ik, ik)), -448.f, 448.f); b[j] = __builtin_amdgcn_fmed3f((b[j] * ub[j]) * rcpf_(__builtin_fmaf(ex2(b[j] * ec), ik, ik)), -448.f, 448.f); }
                u32x2 w; w.x = pk4_f8(a[0], a[1], a[2], a[3]); w.y = pk4_f8(b[0], b[1], b[2], b[3]); *(u32x2*)p = w; }
    }
};
struct EpiMoeDown { static constexpr bool CARRY = false, LAUNDER = true, MID = false;
    bf16* Slot; const int* list; const float* routew; const LAS unsigned* mt; float osc;
    __device__ __forceinline__ void operator()(const f32x4 (&acc)[2][2][4][2], const Unit& u, int wr, int wc, int fr, int fq) const {
        const int cnt = (int)mt[u.e0];
        int ents[2][4]; float ws_[2][4];
#pragma unroll
        for (int ai = 0; ai < 2; ++ai)
#pragma unroll
            for (int m = 0; m < 4; ++m) { const int li = u.e1 * 256 + EPI_ROWS(ai, m); ents[ai][m] = list[u.e0 * LCAP + (li < cnt ? li : 0)]; }
#pragma unroll
        for (int ai = 0; ai < 2; ++ai)
#pragma unroll
            for (int m = 0; m < 4; ++m) ws_[ai][m] = routew[ents[ai][m]] * osc;
#pragma unroll
        for (int ai = 0; ai < 2; ++ai)
#pragma unroll
            for (int m = 0; m < 4; ++m) { const int li = u.e1 * 256 + EPI_ROWS(ai, m);
                if (li < cnt) { const int ent = ents[ai][m]; const float w = ws_[ai][m];
                    bf16* rowp = Slot + ((size_t)(ent & 1) * LROWS + (size_t)(ent >> 1)) * 1024 + u.e2 * 256;
#pragma unroll
                    for (int bj = 0; bj < 2; ++bj) *(u32x4*)(rowp + EPI_COL(bj)) = pack_acc8(acc[ai][bj][m][0] * w, acc[ai][bj][m][1] * w); } }
    }
};
struct EpiMoePart { static constexpr bool CARRY = false, LAUNDER = true, MID = false;
    bf16* Pm; const int* list; const LAS unsigned* mt; int* smap; float osc;
    __device__ __forceinline__ void operator()(const f32x4 (&acc)[2][2][4][2], const Unit& u, int wr, int wc, int fr, int fq) const {
        const int cnt = (int)mt[u.e0], q = u.e3; bf16* pt = Pm + (size_t)q * 65536; const bool mapper = (q % 7 == 0) && wc == 0 && fq == 0;
#pragma unroll
        for (int ai = 0; ai < 2; ++ai)
#pragma unroll
            for (int m = 0; m < 4; ++m) { const int rl = EPI_ROWS(ai, m), li = u.e1 * 256 + rl;
#pragma unroll
                for (int bj = 0; bj < 2; ++bj) *(u32x4*)(pt + rl * 256 + EPI_COL(bj)) = pack_acc8(acc[ai][bj][m][0] * osc, acc[ai][bj][m][1] * osc);
                if (mapper && li < cnt) smap[list[u.e0 * LCAP + li] * 4 + u.e2] = ((q / 7) << 8) | rl; }
    }
};
}
#define DROW(reg, h) (((reg) & 3) + 8 * ((reg) >> 2) + 4 * (h))

__device__ __forceinline__ void s5_state_item(const bf16* M1F  , const bf16* SUF, bf16* HLOCB, int item, int lane) {
    const int cb = item % 33, gd = item / 33, g = gd >> 1, dir = gd & 1, li = lane & 31, h = lane >> 5;
    const bf16* A = M1F + (size_t)(g * 2 + dir) * 128 * 256 + lane * 8;
    const bf16* B = SUF + (size_t)(g * 33 + cb) * 16 * 512 + lane * 8;
    f32x16 acc[4];
#pragma unroll
    for (int rt = 0; rt < 4; ++rt) acc[rt] = zero16();
    bf16x8 a0[2][4], b0[2], a1[2][4], b1[2];
#define S5S_LOAD(AA, BB, grp) do { _Pragma("unroll") for (int s = 0; s < 2; ++s) { const int ks = (grp) * 2 + s; BB[s] = ldg8(B + ks * 512); \
        _Pragma("unroll") for (int rt = 0; rt < 4; ++rt) AA[s][rt] = ldg8(A + (ks * 4 + rt) * 512); } } while (0)
#define S5S_MMA(AA, BB) do { _Pragma("unroll") for (int s = 0; s < 2; ++s) _Pragma("unroll") for (int rt = 0; rt < 4; ++rt) acc[rt] = mma32(AA[s][rt], BB[s], acc[rt]); } while (0)
    S5S_LOAD(a0, b0, 0);
#pragma unroll 1
    for (int gp = 0; gp < 8; gp += 2) {
        S5S_LOAD(a1, b1, gp + 1);
        S5S_MMA(a0, b0);
        if (gp + 2 < 8) S5S_LOAD(a0, b0, gp + 2);
        S5S_MMA(a1, b1);
    }
#undef S5S_LOAD
#undef S5S_MMA
    const int c = cb * 32 + li; bf16* o = HLOCB + (((size_t)(g * 2 + dir) * (NCH16 / 4) + (c >> 2)) * 64) * 8 + (c & 3) * 2;
#pragma unroll
    for (int rt = 0; rt < 4; ++rt)
#pragma unroll
        for (int q = 0; q < 4; ++q) { const int p0 = 16 * rt + 4 * q + 2 * h;
            *(unsigned*)(o + (size_t)p0 * 8) = pk2(acc[rt][4 * q], acc[rt][4 * q + 1]); *(unsigned*)(o + (size_t)(p0 + 1) * 8) = pk2(acc[rt][4 * q + 2], acc[rt][4 * q + 3]); }
}
__device__ __forceinline__ void s5_scan_item(const float* A16  , const bf16* HLOCB, bf16* HINF, LAS unsigned char* wl, int item, int lane) {
    const int dir = item & 1, g = (item >> 1) & 15, b = item >> 5, p = lane;
    const f32x2 a = *(const f32x2*)(A16 + ((size_t)(dir * 16 + g) * 64 + p) * 2);
    const bf16* src = HLOCB + ((size_t)(g * 2 + dir) * (NCH16 / 4) * 64 + p) * 8;
    const int k2 = dir * 128 + 2 * p;
    bf16* dctx = HINF + ((size_t)(g * 33 + 32) * 16 + (k2 >> 4)) * 512 + ((k2 >> 3) & 1) * 256 + (k2 & 7);
    float hr = 0.f, hi = 0.f;
#define S5_STEP(xr, xi) do { const float nr_ = a.x * hr - a.y * hi + (xr), ni_ = a.x * hi + a.y * hr + (xi); hr = nr_; hi = ni_; } while (0)
#define S5_W(v, k) ((k) == 0 ? (v).x : ((k) == 1 ? (v).y : ((k) == 2 ? (v).z : (v).w)))
#define S5_LOADQ(buf, blk_) do { _Pragma("unroll") for (int j = 0; j < 8; ++j) { const int qi_ = 8 * (blk_) + j; buf[j] = *(const u32x4*)(src + (size_t)(128 * b + (dir ? 127 - qi_ : qi_)) * 512); } } while (0)
    u32x4 q0[8], q1[8], q2[8], q3[8];
    S5_LOADQ(q0, 0); S5_LOADQ(q1, 1); S5_LOADQ(q2, 2);
    {
        u32x4 v[4];
#pragma unroll
        for (int j = 0; j < 4; ++j) v[j] = *(const u32x4*)(src + (size_t)(256 + 4 * b + (dir ? 3 - j : j)) * 512);
#pragma unroll
        for (int j = 0; j < 4; ++j) { const int cl0 = 16 * b + 4 * (dir ? 3 - j : j);
#pragma unroll
            for (int kk = 0; kk < 4; ++kk) { const int k = dir ? 3 - kk : kk; const unsigned w = S5_W(v[j], k);
                *(unsigned*)(dctx + (cl0 + k) * 8) = pk2(hr, hi); S5_STEP(bflo(w), bfhi(w)); } }
    }
    const int pg = p >> 2; LAS unsigned char* wbase = wl + ((p >> 3) * 64 + (pg & 1) * 32) * 16 + 4 * (p & 3);
    const int hs = lane >> 5, cl_ = lane & 31;
#define S5_PROC(buf, blk_) do { \
        _Pragma("unroll") for (int j = 0; j < 8; ++j) { const int ql = dir ? 7 - j : j; \
            _Pragma("unroll") for (int kk = 0; kk < 4; ++kk) { const int k = dir ? 3 - kk : kk; const unsigned w = S5_W(buf[j], k); \
                *(LAS unsigned*)(wbase + ((4 * ql + k + pg) & 31) * 16) = pk2(hr, hi); S5_STEP(bflo(w), bfhi(w)); } } \
        { const int cb = 16 * b + (dir ? 15 - (blk_) : (blk_)); bf16* dout = HINF + ((size_t)(g * 33 + cb) * 16 + dir * 8) * 512 + lane * 8; \
          _Pragma("unroll") for (int j = 0; j < 8; ++j) *(u32x4*)(dout + j * 512) = *(const LAS u32x4*)(wl + (j * 64 + hs * 32 + ((cl_ + 2 * j + hs) & 31)) * 16); } } while (0)
#pragma unroll 1
    for (int blk = 0; blk < 16; blk += 4) {
        S5_LOADQ(q3, blk + 3); S5_PROC(q0, blk);
        if (blk + 4 < 16) S5_LOADQ(q0, blk + 4);
        S5_PROC(q1, blk + 1);
        if (blk + 5 < 16) S5_LOADQ(q1, blk + 5);
        S5_PROC(q2, blk + 2);
        if (blk + 6 < 16) S5_LOADQ(q2, blk + 6);
        S5_PROC(q3, blk + 3);
    }
#undef S5_STEP
#undef S5_W
#undef S5_LOADQ
#undef S5_PROC
}
__device__ __forceinline__ void s5_out_item(const bf16* TABF  , const bf16* SUF, const bf16* HINF, bf16* Z, int item, int lane) {
    const int mh = item & 1, it2 = item >> 1, cb = it2 % 33, g = it2 / 33, li = lane & 31, h = lane >> 5, c = cb * 32 + li;
    const bf16* A = TABF + ((size_t)g * 256 + mh * 128) * 512 + lane * 8;
    const bf16* B0 = SUF + (size_t)(g * 33 + cb) * 16 * 512 + lane * 8;
    const bf16* B1 = HINF + (size_t)(g * 33 + cb) * 16 * 512 + lane * 8;
    f32x16 acc[4];
#pragma unroll
    for (int rt = 0; rt < 4; ++rt) acc[rt] = zero16();
    bf16x8 a0[2][4], b0[2], a1[2][4], b1[2];
#define S5O_LOAD(AA, BB, grp) do { _Pragma("unroll") for (int s = 0; s < 2; ++s) { const int ks = (grp) * 2 + s; BB[s] = ldg8((ks < 16 ? B0 + ks * 512 : B1 + (ks - 16) * 512)); \
        _Pragma("unroll") for (int rt = 0; rt < 4; ++rt) AA[s][rt] = ldg8(A + (ks * 4 + rt) * 512); } } while (0)
#define S5O_MMA(AA, BB) do { _Pragma("unroll") for (int s = 0; s < 2; ++s) _Pragma("unroll") for (int rt = 0; rt < 4; ++rt) acc[rt] = mma32(AA[s][rt], BB[s], acc[rt]); } while (0)
    S5O_LOAD(a0, b0, 0);
#pragma unroll 1
    for (int gp = 0; gp < 16; gp += 2) {
        S5O_LOAD(a1, b1, gp + 1);
        S5O_MMA(a0, b0);
        if (gp + 2 < 16) S5O_LOAD(a0, b0, gp + 2);
        S5O_MMA(a1, b1);
    }
#undef S5O_LOAD
#undef S5O_MMA
#pragma unroll
    for (int rt = 0; rt < 4; ++rt)
#pragma unroll
        for (int q = 0; q < 4; ++q) {
            const int i = 8 * mh + 2 * rt + (q >> 1), ho0 = 8 * (q & 1) + 4 * h;
            u32x2 w; w.x = pk2(gelu_tanh(acc[rt][4 * q]), gelu_tanh(acc[rt][4 * q + 1])); w.y = pk2(gelu_tanh(acc[rt][4 * q + 2]), gelu_tanh(acc[rt][4 * q + 3]));
            *(u32x2*)(Z + ((size_t)c * 16 + i) * 256 + g * 16 + ho0) = w; }
}

__device__ __forceinline__ int ret_tok0(int b, int n) { return n < 64 ? b * SEQ + n * 128 : LROWS + b * CTXL + (n - 64) * 128; }
__device__ __forceinline__ void ret_kv_item(const bf16* RKT, const bf16* RVT, const float* COST, const float* SINT, const float* decay  , float* KV, int item, int lane) {
    const int n = item % 66, bh = item / 66, hd = bh & 3, b = bh >> 2, li = lane & 31, h = lane >> 5;
    const int tok0 = ret_tok0(b, n); const bool lat = n < 64;
    const float lgf = -log2f(1.f + __expf(-decay[hd])), lgr = -log2f(1.f + __expf(-decay[4 + hd]));
    f32x16 acc[2][2][2];
#pragma unroll
    for (int a = 0; a < 2; ++a)
#pragma unroll
        for (int c = 0; c < 2; ++c)
#pragma unroll
            for (int d = 0; d < 2; ++d) acc[a][c][d] = zero16();
    const bf16* k0p = RKT + (size_t)(hd * 64 + li) * R + tok0 + 8 * h;
    const bf16* v0p = RVT + (size_t)(hd * 64 + li) * R + tok0 + 8 * h;
#pragma unroll 2
    for (int ks = 0; ks < 8; ++ks) {
        float k1[8], k2[8];
        unpack8(ldg8(k0p + ks * 16), k1); unpack8(ldg8(k0p + (size_t)32 * R + ks * 16), k2);
        if (lat) {
            const float* cp = COST + (size_t)li * SEQ + n * 128 + ks * 16 + 8 * h; const float* sp = SINT + (size_t)li * SEQ + n * 128 + ks * 16 + 8 * h;
            const f32x4 c0 = *(const f32x4*)cp, c1 = *(const f32x4*)(cp + 4), s0 = *(const f32x4*)sp, s1 = *(const f32x4*)(sp + 4);
#pragma unroll
            for (int j = 0; j < 8; ++j) { const float cc = j < 4 ? c0[j & 3] : c1[j & 3], ss = j < 4 ? s0[j & 3] : s1[j & 3];
                const float x1 = k1[j], x2 = k2[j]; k1[j] = x1 * cc - x2 * ss; k2[j] = x1 * ss + x2 * cc; }
        }
        const bf16x8 vf0 = ldg8(v0p + ks * 16), vf1 = ldg8(v0p + (size_t)32 * R + ks * 16);
#pragma unroll
        for (int dir = 0; dir < 2; ++dir) {
            float a1[8], a2[8];
#pragma unroll
            for (int j = 0; j < 8; ++j) { const int i = ks * 16 + 8 * h + j; const float w = dir == 0 ? ex2(lgf * (float)(127 - i)) : ex2(lgr * (float)i); a1[j] = k1[j] * w; a2[j] = k2[j] * w; }
            const bf16x8 kd0 = pack8(a1), kd1 = pack8(a2);
            acc[dir][0][0] = mma32(kd0, vf0, acc[dir][0][0]); acc[dir][0][1] = mma32(kd0, vf1, acc[dir][0][1]);
            acc[dir][1][0] = mma32(kd1, vf0, acc[dir][1][0]); acc[dir][1][1] = mma32(kd1, vf1, acc[dir][1][1]);
        }
    }
#pragma unroll
    for (int dir = 0; dir < 2; ++dir) { float* o = KV + ((size_t)((b * 4 + hd) * 2 + dir) * 66 + n) * 4096;
#pragma unroll
        for (int dt = 0; dt < 2; ++dt)
#pragma unroll
            for (int et = 0; et < 2; ++et)
#pragma unroll
                for (int q = 0; q < 4; ++q) *(f32x4*)(o + (size_t)(et * 32 + li) * 64 + dt * 32 + 8 * q + 4 * h) = (f32x4){acc[dir][dt][et][4 * q], acc[dir][dt][et][4 * q + 1], acc[dir][dt][et][4 * q + 2], acc[dir][dt][et][4 * q + 3]}; }
}
__device__ __forceinline__ void ret_scan_item(const float* decay, const float* KV, bf16* SPREV, int item, int lane) {
    const int blk = item & 63, bhd = item >> 6, dir = bhd & 1, hd = (bhd >> 1) & 3, idx = blk * 64 + lane;
    const float lg = -log2f(1.f + __expf(-decay[dir * 4 + hd])), cd = ex2(128.f * lg);
    const float* src = KV + (size_t)bhd * 66 * 4096 + idx; bf16* dst = SPREV + (size_t)bhd * 66 * 4096 + idx;
    float s = 0.f;
    for (int s0 = 0; s0 < 66; s0 += 11) {
        float v[11];
#pragma unroll
        for (int j = 0; j < 11; ++j) { const int t = s0 + j; const int n = dir == 0 ? (t < 2 ? 64 + t : t - 2) : (t < 2 ? 65 - t : 65 - t); v[j] = src[(size_t)n * 4096]; }
#pragma unroll
        for (int j = 0; j < 11; ++j) { const int t = s0 + j; const int n = dir == 0 ? (t < 2 ? 64 + t : t - 2) : (t < 2 ? 65 - t : 65 - t); dst[(size_t)n * 4096] = (bf16)(pk2(s, 0.f) & 0xffffu); s = cd * s + v[j]; }
    }
}
struct KVTile { u32x4 k[4], v[4]; };
__device__ __forceinline__ void kv_tile_load(KVTile& T, const bf16* Kh  , const bf16* VTh  , int tok0, int lane) {
#pragma unroll
    for (int i = 0; i < 4; ++i) T.k[i] = *(const u32x4*)(Kh + (size_t)(tok0 + 8 * i + (lane >> 3)) * 256 + (lane & 7) * 8);
#pragma unroll
    for (int i = 0; i < 4; ++i) T.v[i] = *(const u32x4*)(VTh + (size_t)(16 * i + (lane >> 2)) * R + tok0 + (lane & 3) * 8);
}
__device__ __forceinline__ void kv_tile_store(const KVTile& T, LAS unsigned char* wl, int lane) {
#pragma unroll
    for (int i = 0; i < 4; ++i) *(LAS u32x4*)(wl + (8 * i + (lane >> 3)) * 144 + (lane & 7) * 16) = T.k[i];
#pragma unroll
    for (int i = 0; i < 4; ++i) *(LAS u32x4*)(wl + 4608 + (16 * i + (lane >> 2)) * 80 + (lane & 3) * 16) = T.v[i];
}
__device__ __forceinline__ void kv_tile_frags(const LAS unsigned char* wl, int lane, bf16x8 (&kf)[4], bf16x8 (&vf)[2][2]) {
    const int li = lane & 31, h = lane >> 5;
#pragma unroll
    for (int s = 0; s < 4; ++s) kf[s] = *(const LAS bf16x8*)(wl + li * 144 + (2 * s + h) * 16);
#pragma unroll
    for (int et = 0; et < 2; ++et)
#pragma unroll
        for (int s2 = 0; s2 < 2; ++s2) { const LAS unsigned char* p = wl + 4608 + (et * 32 + li) * 80 + s2 * 32 + 8 * h;
            const bf16x4 lo = *(const LAS bf16x4*)p, hi = *(const LAS bf16x4*)(p + 16); vf[et][s2] = __builtin_shufflevector(lo, hi, 0, 1, 2, 3, 4, 5, 6, 7); }
}

__device__ __forceinline__ void rope_item(bf16* RQ, bf16* RK, const float* COSN, const float* SINN, int item, int lane) {
    const int u = lane & 15, off = (u >> 2) * 64 + (u & 3) * 8, c8 = (u & 3) * 8;
#pragma unroll 4
    for (int st = 0; st < 32; ++st) { const int row = item * 128 + 4 * st + (lane >> 4), tl = row & (SEQ - 1);
        const f32x4 c0 = *(const f32x4*)(COSN + (size_t)tl * 32 + c8), c1 = *(const f32x4*)(COSN + (size_t)tl * 32 + c8 + 4), s0 = *(const f32x4*)(SINN + (size_t)tl * 32 + c8), s1 = *(const f32x4*)(SINN + (size_t)tl * 32 + c8 + 4);
#pragma unroll
        for (int w = 0; w < 2; ++w) { bf16* p = (w ? RK : RQ) + (size_t)row * 256 + off; float x1[8], x2[8]; unpack8(*(const bf16x8*)p, x1); unpack8(*(const bf16x8*)(p + 32), x2);
#pragma unroll
            for (int j = 0; j < 8; ++j) { const float cc = j < 4 ? c0[j & 3] : c1[j & 3], ss = j < 4 ? s0[j & 3] : s1[j & 3]; const float a = x1[j], bb = x2[j]; x1[j] = a * cc - bb * ss; x2[j] = a * ss + bb * cc; }
            *(bf16x8*)p = pack8(x1); *(bf16x8*)(p + 32) = pack8(x2); } }
}
__device__ __forceinline__ void ret_out_item(const bf16* RQ, const bf16* RK, const bf16* RG, const bf16* RVT, const bf16* SPREV, const float* decay, const float* gn  , bf16* MIX,
                                             LAS unsigned char* wl, int item, int lane) {
    const int qb = item & 3, it2 = item >> 2, n = it2 % 66, bh = it2 / 66, hd = bh & 3, b = bh >> 2, li = lane & 31, h = lane >> 5;
    const int tok0 = ret_tok0(b, n);
    const float lgf = -log2f(1.f + __expf(-decay[hd])), lgr = -log2f(1.f + __expf(-decay[4 + hd]));
    const int iq = qb * 32 + li;
    const bf16* Kh = RK + hd * 64; const bf16* VTh = RVT + (size_t)hd * 64 * R;
    KVTile T; kv_tile_load(T, Kh, VTh, tok0, lane);
    bf16x8 qf[4];
    { const bf16* qp = RQ + (size_t)(tok0 + iq) * 256 + hd * 64 + 8 * h;
#pragma unroll
      for (int s = 0; s < 4; ++s) qf[s] = ldg8(qp + 16 * s); }
    kv_tile_store(T, wl, lane);
    f32x16 accO[2] = {zero16(), zero16()};
#pragma unroll 1
    for (int kt = 0; kt < 4; ++kt) {
        kv_tile_load(T, Kh, VTh, tok0 + (kt < 3 ? kt + 1 : kt) * 32, lane);
        bf16x8 kf[4], vf[2][2]; kv_tile_frags(wl, lane, kf, vf);
        f32x16 st = zero16();
#pragma unroll
        for (int s = 0; s < 4; ++s) st = mma32(kf[s], qf[s], st);
#pragma unroll
        for (int r = 0; r < 16; ++r) { const int j = kt * 32 + DROW(r, h), df = iq - j;
            const float w = df > 0 ? ex2(lgf * (float)df) : (df < 0 ? ex2(lgr * (float)(-df)) : 2.f); st[r] *= w; }
        const bf16x8 p0 = accB<0>(st), p1 = accB<1>(st);
        accO[0] = mma32(vf[0][0], p0, accO[0]); accO[0] = mma32(vf[0][1], p1, accO[0]); accO[1] = mma32(vf[1][0], p0, accO[1]); accO[1] = mma32(vf[1][1], p1, accO[1]);
        kv_tile_store(T, wl, lane);
    }
    const float cf = ex2(lgf * (float)(iq + 1)), cr = ex2(lgr * (float)(128 - iq));
#pragma unroll
    for (int dir = 0; dir < 2; ++dir) { const bf16* sp = SPREV + ((size_t)((b * 4 + hd) * 2 + dir) * 66 + n) * 4096;
#pragma unroll
        for (int et = 0; et < 2; ++et) { f32x16 a = zero16();
#pragma unroll
            for (int s = 0; s < 4; ++s) a = mma32(ldg8(sp + (size_t)(et * 32 + li) * 64 + 16 * s + 8 * h), qf[s], a);
            const float sc = dir == 0 ? cf : cr;
#pragma unroll
            for (int r = 0; r < 16; ++r) accO[et][r] += sc * a[r]; } }
    float s1 = 0.f;
#pragma unroll
    for (int et = 0; et < 2; ++et)
#pragma unroll
        for (int r = 0; r < 16; ++r) s1 += accO[et][r];
    s1 = xor32_sum(s1); const float mu = s1 * (1.f / 64.f);
    float s2 = 0.f;
#pragma unroll
    for (int et = 0; et < 2; ++et)
#pragma unroll
        for (int r = 0; r < 16; ++r) { const float dlt = accO[et][r] - mu; s2 += dlt * dlt; }
    s2 = xor32_sum(s2); const float rstd = __builtin_amdgcn_rsqf(s2 * (1.f / 64.f) + EPSN);
    const size_t tok = (size_t)(tok0 + iq);
#pragma unroll
    for (int et = 0; et < 2; ++et)
#pragma unroll
        for (int q = 0; q < 4; ++q) { const int e0 = hd * 64 + et * 32 + 8 * q + 4 * h;
            const f32x4 gv = *(const f32x4*)(gn + e0); const u32x2 gg = *(const u32x2*)(RG + tok * 256 + e0);
            const float g0 = bflo(gg.x), g1 = bfhi(gg.x), g2 = bflo(gg.y), g3 = bfhi(gg.y);
            u32x2 w; w.x = pk2(silu_(g0) * (accO[et][4 * q] - mu) * rstd * gv[0], silu_(g1) * (accO[et][4 * q + 1] - mu) * rstd * gv[1]);
            w.y = pk2(silu_(g2) * (accO[et][4 * q + 2] - mu) * rstd * gv[2], silu_(g3) * (accO[et][4 * q + 3] - mu) * rstd * gv[3]);
            *(u32x2*)(MIX + tok * 1024 + 512 + e0) = w; }
}

__device__ __forceinline__ int na_tile_tok(int t, int b, int rs) { const int tb = t - 8; return t >= 8 ? b * SEQ + (rs + (tb >> 1)) * 64 + (tb & 1) * 32 : LROWS + b * CTXL + t * 32; }
struct KVF { bf16x8 k[4], v[2][2]; };
__device__ __forceinline__ void kvf_load(KVF& F, const bf16* NKF, const bf16* NVF, int tok0, int hd, int lane) {
    const size_t o = ((size_t)((tok0 >> 5) * 4 + hd) * 256 + lane) * 8;
#pragma unroll
    for (int s = 0; s < 4; ++s) F.k[s] = ldg8(NKF + o + s * 512);
#pragma unroll
    for (int et = 0; et < 2; ++et)
#pragma unroll
        for (int s2 = 0; s2 < 2; ++s2) F.v[et][s2] = ldg8(NVF + o + (et * 2 + s2) * 512);
}
__device__ __forceinline__ void na_tile(const KVF& F, const bf16x8 (&qf)[4], int t, int r, int rs, int hd, int qc, int cs, int h, const LAS float* rpb2, float& mrun, float& lrun, f32x16 (&accO)[2]) {
    const bool band = t >= 8; const int tb = t - 8, rr = rs + (tb >> 1), ct = tb & 1; const float c1 = 0.125f * LOG2E;
    f32x16 st = zero16();
#pragma unroll
    for (int s = 0; s < 4; ++s) st = mma32(F.k[s], qf[s], st);
    float mt = -INFINITY;
    if (band) { const int dr = rr - r + 7; const LAS float* bp = rpb2 + ((hd * 15 + dr) * 31 + 32 * ct - qc + 15 + 4 * h); const int d0 = 32 * ct + 4 * h - cs;
        float bv[16];
#pragma unroll
        for (int g = 0; g < 16; ++g) bv[g] = bp[8 * (g >> 2) + (g & 3)];
#pragma unroll
        for (int g = 0; g < 16; ++g) { const int o = 8 * (g >> 2) + (g & 3); const bool inw = (unsigned)(d0 + o) < 16u;
            const float tv = st[g] * c1 + bv[g]; const float v = inw ? tv : -INFINITY; st[g] = v; mt = fmaxf(mt, v); }
    } else {
#pragma unroll
        for (int g = 0; g < 16; ++g) { const float v = st[g] * c1; st[g] = v; mt = fmaxf(mt, v); }
    }
    mt = xor32_max(mt);
    const float mnew = fmaxf(mrun, mt);
    if (__builtin_amdgcn_ballot_w64(mnew > mrun)) { const float alpha = ex2(mrun - mnew); lrun *= alpha;
#pragma unroll
        for (int et = 0; et < 2; ++et)
#pragma unroll
            for (int g = 0; g < 16; ++g) accO[et][g] *= alpha; }
    mrun = mnew;
    float ps = 0.f;
#pragma unroll
    for (int g = 0; g < 16; ++g) { const float p = ex2(st[g] - mnew); st[g] = p; ps += p; }
    lrun += xor32_sum(ps);
    const bf16x8 p0 = accB<0>(st), p1 = accB<1>(st);
    accO[0] = mma32(F.v[0][0], p0, accO[0]); accO[0] = mma32(F.v[0][1], p1, accO[0]); accO[1] = mma32(F.v[1][0], p0, accO[1]); accO[1] = mma32(F.v[1][1], p1, accO[1]);
}
__device__ __forceinline__ void na_item(const bf16* NQ, const bf16* NKF, const bf16* NVF, bf16* MIX, const LAS float* rpb2, LAS unsigned char* wl, bool ctxq, int b, int r, int hd, int qs, int lane) {
    (void)wl;
    const int li = lane & 31, h = lane >> 5;
    const int tokq = ctxq ? LROWS + b * CTXL + qs * 32 + li : b * SEQ + r * 64 + qs * 32 + li;
    bf16x8 qf[4];
#pragma unroll
    for (int s = 0; s < 4; ++s) qf[s] = ldg8(NQ + (size_t)tokq * 256 + hd * 64 + 16 * s + 8 * h);
    float mrun = -1e30f, lrun = 0.f;
    f32x16 accO[2] = {zero16(), zero16()};
    const int rs = r - 4 < 0 ? 0 : (r - 4 > 120 ? 120 : r - 4);
    const int qc = qs * 32 + li, cs = qc - 8 < 0 ? 0 : (qc - 8 > 48 ? 48 : qc - 8);
    const int ntile = ctxq ? 8 : 24;
    KVF A, B; kvf_load(A, NKF, NVF, na_tile_tok(0, b, rs), hd, lane);
#pragma unroll 1
    for (int t = 0; t < ntile; t += 2) {
        kvf_load(B, NKF, NVF, na_tile_tok(t + 1, b, rs), hd, lane);
        na_tile(A, qf, t, r, rs, hd, qc, cs, h, rpb2, mrun, lrun, accO);
        kvf_load(A, NKF, NVF, na_tile_tok(t + 2 < ntile ? t + 2 : t, b, rs), hd, lane);
        na_tile(B, qf, t + 1, r, rs, hd, qc, cs, h, rpb2, mrun, lrun, accO);
    }
    const float inv = 1.f / lrun;
#pragma unroll
    for (int et = 0; et < 2; ++et)
#pragma unroll
        for (int q = 0; q < 4; ++q) { u32x2 w; w.x = pk2(accO[et][4 * q] * inv, accO[et][4 * q + 1] * inv); w.y = pk2(accO[et][4 * q + 2] * inv, accO[et][4 * q + 3] * inv);
            *(u32x2*)(MIX + (size_t)tokq * 1024 + 768 + hd * 64 + et * 32 + 8 * q + 4 * h) = w; }
}

__device__ __forceinline__ void fft1_item(const bf16* F, const bf16* W128T, const float* TWC, const float* TWS, bf16* FB, int item, int lane) {
    const int l2 = item & 63, g = (item >> 6) & 3, b = item >> 8, li = lane & 31, h = lane >> 5;
    bf16x8 idf[4];
#pragma unroll
    for (int s = 0; s < 4; ++s) { float v[8];
#pragma unroll
        for (int j = 0; j < 8; ++j) v[j] = (16 * (s & 1) + 8 * h + j == li) ? 1.f : 0.f;
        idf[s] = pack8(v); }
    bf16x8 xb[4][2][2];
#pragma unroll
    for (int lt = 0; lt < 4; ++lt) {
        const bf16* xp = F + (size_t)(b * SEQ + 64 * (lt * 32 + li) + l2) * 256 + g * 64 + 8 * h;
        const bf16x8 x0 = ldg8(xp), x1 = ldg8(xp + 16), x2 = ldg8(xp + 32), x3 = ldg8(xp + 48);
        f32x16 c0 = zero16(), c1 = zero16();
        c0 = mma32(x0, idf[0], c0); c0 = mma32(x1, idf[1], c0);
        c1 = mma32(x2, idf[0], c1); c1 = mma32(x3, idf[1], c1);
        xb[lt][0][0] = accB<0>(c0); xb[lt][0][1] = accB<1>(c0); xb[lt][1][0] = accB<0>(c1); xb[lt][1][1] = accB<1>(c1);
    }
#pragma unroll 1
    for (int kb = 0; kb < 4; ++kb) {
        f32x16 acc[2][2];
#pragma unroll
        for (int ri = 0; ri < 2; ++ri) { acc[ri][0] = zero16(); acc[ri][1] = zero16();
            const bf16* wp = W128T + ((size_t)ri * 128 + kb * 32 + li) * 128 + 4 * h;
#pragma unroll
            for (int lt = 0; lt < 4; ++lt)
#pragma unroll
                for (int s = 0; s < 2; ++s) { const bf16x8 wf = ldg8p(wp + lt * 32 + 16 * s);
                    acc[ri][0] = mma32(wf, xb[lt][0][s], acc[ri][0]); acc[ri][1] = mma32(wf, xb[lt][1][s], acc[ri][1]); } }
#pragma unroll
        for (int q = 0; q < 4; ++q) { const int k1 = kb * 32 + 8 * q + 4 * h;
            const f32x4 tc = *(const f32x4*)(TWC + l2 * 128 + k1), ts = *(const f32x4*)(TWS + l2 * 128 + k1);
#pragma unroll
            for (int j = 0; j < 4; ++j)
#pragma unroll
                for (int ct = 0; ct < 2; ++ct) { const float ar = acc[0][ct][4 * q + j], ai = acc[1][ct][4 * q + j];
                    const float br = ar * tc[j] + ai * ts[j], bi = ai * tc[j] - ar * ts[j];
                    bf16* o = FB + ((((size_t)(b * 4 + g) * 128 + k1 + j) * 2) * 64 + l2) * 64 + ct * 32 + li;
                    o[0] = (bf16)(pk2(br, 0.f) & 0xffffu); o[64 * 64] = (bf16)(pk2(bi, 0.f) & 0xffffu); } }
    }
}
__device__ __forceinline__ void fft2_item(const bf16* FB, const bf16* FCT, const bf16* W64T, bf16* MIX, int item, int lane) {
    const int mh = item & 1, k1 = (item >> 1) & 127, g = (item >> 8) & 3, b = item >> 10, li = lane & 31, h = lane >> 5;
    const bf16* br = FB + (((size_t)(b * 4 + g) * 128 + k1) * 2) * 64 * 64; const bf16* bi = br + 64 * 64;
    const bf16* fc = FCT + (size_t)(mh * 32 + li) * 64 + 8 * h; const bf16* fs = fc + 64 * 64; const bf16* fn = fc + 2 * 64 * 64;
    bf16x8 eb[2][2][2];
#pragma unroll
    for (int lt = 0; lt < 2; ++lt) { f32x16 er = zero16(), ei = zero16();
#pragma unroll
        for (int s = 0; s < 4; ++s) { const bf16x8 ar = ldg8(br + (size_t)(lt * 32 + li) * 64 + 16 * s + 8 * h), ai = ldg8(bi + (size_t)(lt * 32 + li) * 64 + 16 * s + 8 * h);
            const bf16x8 c = ldg8(fc + 16 * s), sn = ldg8(fs + 16 * s), ns = ldg8(fn + 16 * s);
            er = mma32(ar, c, er); er = mma32(ai, sn, er); ei = mma32(ai, c, ei); ei = mma32(ar, ns, ei); }
        eb[lt][0][0] = accB<0>(er); eb[lt][0][1] = accB<1>(er); eb[lt][1][0] = accB<0>(ei); eb[lt][1][1] = accB<1>(ei); }
#pragma unroll
    for (int kt = 0; kt < 2; ++kt) { f32x16 o = zero16();
        const bf16* wc = W64T + (size_t)(kt * 32 + li) * 64 + 4 * h; const bf16* wsn = wc + 64 * 64;
#pragma unroll
        for (int lt = 0; lt < 2; ++lt)
#pragma unroll
            for (int s = 0; s < 2; ++s) { o = mma32(ldg8p(wc + lt * 32 + 16 * s), eb[lt][0][s], o); o = mma32(ldg8p(wsn + lt * 32 + 16 * s), eb[lt][1][s], o); }
#pragma unroll
        for (int rg = 0; rg < 16; ++rg) { const int k2 = kt * 32 + DROW(rg, h);
            MIX[(size_t)(b * SEQ + k1 + 128 * k2) * 1024 + g * 64 + mh * 32 + li] = (bf16)(pk2(o[rg], 0.f) & 0xffffu); } }
}
__device__ __forceinline__ void fftc_item(const bf16* F, const bf16* FCT, const bf16* W256T, bf16* MIX, int item, int lane) {
    const int mh = item & 1, kb = (item >> 1) & 7, g = (item >> 4) & 3, b = item >> 6, li = lane & 31, h = lane >> 5;
    const bf16* fc = FCT + (size_t)(mh * 32 + li) * 64 + 8 * h; const bf16* fn = fc + 2 * 64 * 64;
    const bf16* wc = W256T + (size_t)(kb * 32 + li) * 256 + 4 * h; const bf16* wsn = wc + 256 * 256;
    f32x16 o = zero16();
#pragma unroll 1
    for (int lt = 0; lt < 8; ++lt) { f32x16 zr = zero16(), zi = zero16();
        const bf16* xp = F + (size_t)(LROWS + b * CTXL + lt * 32 + li) * 256 + g * 64 + 8 * h;
#pragma unroll
        for (int s = 0; s < 4; ++s) { const bf16x8 x = ldg8(xp + 16 * s); zr = mma32(x, ldg8(fc + 16 * s), zr); zi = mma32(x, ldg8(fn + 16 * s), zi); }
        o = mma32(ldg8p(wc + lt * 32), accB<0>(zr), o); o = mma32(ldg8p(wc + lt * 32 + 16), accB<1>(zr), o);
        o = mma32(ldg8p(wsn + lt * 32), accB<0>(zi), o); o = mma32(ldg8p(wsn + lt * 32 + 16), accB<1>(zi), o); }
#pragma unroll
    for (int rg = 0; rg < 16; ++rg) { const int k = kb * 32 + DROW(rg, h);
        MIX[(size_t)(LROWS + b * CTXL + k) * 1024 + g * 64 + mh * 32 + li] = (bf16)(pk2(o[rg], 0.f) & 0xffffu); }
}
__device__ __forceinline__ void row_ld_f32(const float* p, int lane, f32x4 (&v)[4]) {
#pragma unroll
    for (int j = 0; j < 4; ++j) v[j] = *(const f32x4*)(p + 256 * j + 4 * lane); }
__device__ __forceinline__ void row_ld_bf16(const bf16* p, int lane, f32x4 (&v)[4]) {
#pragma unroll
    for (int j = 0; j < 4; ++j) { const u32x2 w = *(const u32x2*)(p + 256 * j + 4 * lane); v[j] = (f32x4){bflo(w.x), bfhi(w.x), bflo(w.y), bfhi(w.y)}; } }
__device__ __forceinline__ void row_ld_part(const float* P, int nslice, int r, int lane, f32x4 (&v)[4]) {
#pragma unroll
    for (int j = 0; j < 4; ++j) { const float* p = P + ((size_t)((((r - LROWS) >> 8) * 4 + j) * nslice) * 256 + (r & 255)) * 256 + 4 * lane; f32x4 s = *(const f32x4*)p;
        for (int k = 1; k < nslice; ++k) s = s + *(const f32x4*)(p + (size_t)k * 65536);
        v[j] = s; } }
__device__ __forceinline__ void row_st_f32(float* p, int lane, const f32x4 (&v)[4]) {
#pragma unroll
    for (int j = 0; j < 4; ++j) *(f32x4*)(p + 256 * j + 4 * lane) = v[j]; }
__device__ __forceinline__ void row_st_f32_nt(float* p, int lane, const f32x4 (&v)[4]) {
#pragma unroll
    for (int j = 0; j < 4; ++j) __builtin_nontemporal_store(v[j], (f32x4*)(p + 256 * j + 4 * lane)); }
__device__ __forceinline__ void row_st_bf16(bf16* p, int lane, const f32x4 (&v)[4]) {
#pragma unroll
    for (int j = 0; j < 4; ++j) { u32x2 w; w.x = pk2(v[j][0], v[j][1]); w.y = pk2(v[j][2], v[j][3]); *(u32x2*)(p + 256 * j + 4 * lane) = w; } }
__device__ __forceinline__ void row_st_f8(unsigned char* p, int lane, const f32x4 (&v)[4]) {
#pragma unroll
    for (int j = 0; j < 4; ++j) *(unsigned*)(p + 256 * j + 4 * lane) = pk4_f8(v[j][0], v[j][1], v[j][2], v[j][3]); }
__device__ __forceinline__ float row_rstd(const f32x4 (&v)[4]) { float s = 0.f;
#pragma unroll
    for (int j = 0; j < 4; ++j) s += (v[j][0] * v[j][0] + v[j][1] * v[j][1]) + (v[j][2] * v[j][2] + v[j][3] * v[j][3]);
    return __builtin_amdgcn_rsqf(wave_sum(s) * (1.f / 1024.f) + EPSN); }
__device__ __forceinline__ void row_modnorm(const f32x4 (&x)[4], const float* g, const float* sc, const float* sh, int lane, f32x4 (&hh)[4]) {
    const float rs = row_rstd(x); f32x4 gv[4], scv[4], shv[4]; row_ld_f32(g, lane, gv); row_ld_f32(sc, lane, scv); row_ld_f32(sh, lane, shv);
#pragma unroll
    for (int j = 0; j < 4; ++j) hh[j] = x[j] * rs * gv[j] * (scv[j] + 1.f) + shv[j]; }
__device__ __forceinline__ void row_resid(f32x4 (&x)[4], const f32x4 (&t)[4], const float* g, const float* gate, int lane) {
    const float rs = row_rstd(t); f32x4 gv[4], ga[4]; row_ld_f32(g, lane, gv); row_ld_f32(gate, lane, ga);
#pragma unroll
    for (int j = 0; j < 4; ++j) x[j] = x[j] + ga[j] * (t[j] * rs * gv[j]); }

struct NormCfg {
    const float* xin_lat; const float* xin_ctx;
    float* xout_lat; float* xout_ctx;
    const bf16* trow;
    const float* tpart; int npart;
    const float* gA; const float* modA; int gate_off;
    const float* gB; const float* modB; int sc_off, sh_off; bf16* hout;
    int nrows;
    unsigned char* hout8;
    const bf16* xin_b; bf16* xout_b;
};
__device__ __forceinline__ void row_ld_raw16(const bf16* p, int lane, u32x2 (&w)[4]) {
#pragma unroll
    for (int j = 0; j < 4; ++j) w[j] = *(const u32x2*)(p + 256 * j + 4 * lane); }
__device__ __forceinline__ void norm_rows(const NormCfg& C, int wslot, int NW, int lane) {
    const int nlat = C.nrows < LROWS ? C.nrows : LROWS;
    int r = wslot;
    if (r < nlat) {
        int cur = -1; f32x4 gav[4], scv[4], shv[4];
        f32x4 xn[4]; u32x2 tn[4], xb[4];
#pragma unroll
        for (int j = 0; j < 4; ++j) { tn[j] = (u32x2){0u, 0u}; xb[j] = (u32x2){0u, 0u}; xn[j] = gav[j] = scv[j] = shv[j] = (f32x4){0.f, 0.f, 0.f, 0.f}; }
        f32x4 gAv[4], gBv[4];
#pragma unroll
        for (int j = 0; j < 4; ++j) gAv[j] = gBv[j] = (f32x4){0.f, 0.f, 0.f, 0.f};
        if (C.trow) row_ld_f32(C.gA, lane, gAv);
        if (C.gB) row_ld_f32(C.gB, lane, gBv);
        if (C.xin_b) row_ld_raw16(C.xin_b + (size_t)r * D, lane, xb); else row_ld_f32(C.xin_lat + (size_t)r * D, lane, xn);
        if (C.trow) {
#pragma unroll
            for (int j = 0; j < 4; ++j) tn[j] = *(const u32x2*)(C.trow + (size_t)r * D + 256 * j + 4 * lane); }
        for (; r < nlat; r += NW) {
            f32x4 x[4]; u32x2 tr[4];
#pragma unroll
            for (int j = 0; j < 4; ++j) { x[j] = C.xin_b ? (f32x4){bflo(xb[j].x), bfhi(xb[j].x), bflo(xb[j].y), bfhi(xb[j].y)} : xn[j]; tr[j] = tn[j]; }
            const int r2 = r + NW;
            if (r2 < nlat) { if (C.xin_b) row_ld_raw16(C.xin_b + (size_t)r2 * D, lane, xb); else row_ld_f32(C.xin_lat + (size_t)r2 * D, lane, xn);
                if (C.trow) {
#pragma unroll
                    for (int j = 0; j < 4; ++j) tn[j] = *(const u32x2*)(C.trow + (size_t)r2 * D + 256 * j + 4 * lane); } }
            const int ci = r < SEQ ? 0 : 1;
            if (ci != cur) { cur = ci;
                if (C.trow) row_ld_f32(C.modA + (size_t)ci * 6144 + C.gate_off, lane, gav);
                if (C.gB) { row_ld_f32(C.modB + (size_t)ci * 6144 + C.sc_off, lane, scv); row_ld_f32(C.modB + (size_t)ci * 6144 + C.sh_off, lane, shv); } }
            if (C.trow) { f32x4 t[4];
#pragma unroll
                for (int j = 0; j < 4; ++j) t[j] = (f32x4){bflo(tr[j].x), bfhi(tr[j].x), bflo(tr[j].y), bfhi(tr[j].y)};
                const float rs = row_rstd(t);
#pragma unroll
                for (int j = 0; j < 4; ++j) x[j] = x[j] + gav[j] * (t[j] * rs * gAv[j]);
                if (C.xout_b) row_st_bf16(C.xout_b + (size_t)r * D, lane, x); else row_st_f32(C.xout_lat + (size_t)r * D, lane, x); }
            if (C.gB) { const float rs = row_rstd(x); f32x4 hh[4];
#pragma unroll
                for (int j = 0; j < 4; ++j) hh[j] = x[j] * rs * gBv[j] * (scv[j] + 1.f) + shv[j];
                row_st_bf16(C.hout + (size_t)r * D, lane, hh); if (C.hout8) row_st_f8(C.hout8 + (size_t)r * D, lane, hh); }
        }
    }
    for (r = LROWS + wslot; r < C.nrows; r += NW) {
        f32x4 x[4]; row_ld_f32(C.xin_ctx + (size_t)(r - LROWS) * D, lane, x);
        if (C.trow) { f32x4 t[4]; if (C.tpart) row_ld_part(C.tpart, C.npart, r, lane, t); else row_ld_bf16(C.trow + (size_t)r * D, lane, t);
            row_resid(x, t, C.gA, C.modA + (size_t)2 * 6144 + C.gate_off, lane); row_st_f32(C.xout_ctx + (size_t)(r - LROWS) * D, lane, x); }
        if (C.gB) { f32x4 hh[4]; row_modnorm(x, C.gB, C.modB + (size_t)2 * 6144 + C.sc_off, C.modB + (size_t)2 * 6144 + C.sh_off, lane, hh); row_st_bf16(C.hout + (size_t)r * D, lane, hh); if (C.hout8) row_st_f8(C.hout8 + (size_t)r * D, lane, hh); }
    }
}

__device__ __forceinline__ void transpose_item(const float* W, int ldw, int k0, int n0, bf16* dst, int ldd, float scale, LAS float* scr, int lane) {
#pragma unroll 8
    for (int i = 0; i < 32; ++i) { const int kk = 2 * i + (lane >> 5); scr[kk * 33 + (lane & 31)] = W[(size_t)(k0 + kk) * ldw + n0 + (lane & 31)]; }
    LDS_WAIT(); asm volatile("" ::: "memory");
    const int c = lane & 7;
#pragma unroll
    for (int j = 0; j < 4; ++j) { const int n = (lane >> 3) + 8 * j; const LAS float* s = scr + (8 * c) * 33 + n;
        u32x4 o; o.x = pk2(s[0 * 33] * scale, s[1 * 33] * scale); o.y = pk2(s[2 * 33] * scale, s[3 * 33] * scale); o.z = pk2(s[4 * 33] * scale, s[5 * 33] * scale); o.w = pk2(s[6 * 33] * scale, s[7 * 33] * scale);
        *(u32x4*)(dst + (size_t)n * ldd + k0 + 8 * c) = o; }
    LDS_WAIT(); asm volatile("" ::: "memory");
}
#ifndef MK_MODE
#define MK_MODE 1
#endif
#ifndef MK_LAST
#define MK_LAST 24
#endif
constexpr int NPHASE = 24;
struct Args { const float* in[31]; float* out; unsigned char* ws; int ph_lo, ph_hi, li, pad; };


struct TrJob { const float* src; unsigned char* dst; int ldw, k0, n0, ldd, esz; float scale; };
#define CAS __attribute__((address_space(4)))
constexpr float MOE_W1S = 32.f, MOE_W2S = 64.f, MOE_HS = 2.f, WIN_S = 32.f;
constexpr int NTR = 60096, NTRQ = NTR / 8;
constexpr int NTRD = 6720, NTRPQ = (NTR - NTRD) / 8;
__device__ __forceinline__ void tr_decode(int it, const CAS Args* ap_, unsigned char* ws, TrJob& J) {
#define TIN(k) ((const float*)(const GAS float*)ap_->in[k])
    int kb; J.scale = 1.f; J.esz = 2;
    if (it < 43008) { const int e = it / 5376, r = it % 5376, w = r / 1792, li = r % 1792; J.esz = 1;
        if (w < 2) { J.src = TIN(28 + w) + (size_t)e * 1024 * DFE; J.ldw = DFE; kb = li / 112; J.n0 = (li % 112) * 32; J.ldd = 1024; J.scale = MOE_W1S;
            J.dst = ws + WS_MOE1 + ((size_t)e * 7168 + 256 * (J.n0 / 128) + (J.n0 % 128) + 128 * w) * 1024; }
        else { J.src = TIN(30) + (size_t)e * DFE * 1024; J.ldw = 1024; kb = li / 32; J.n0 = (li % 32) * 32; J.ldd = DFE; J.scale = MOE_W2S; J.dst = ws + WS_MOE2 + ((size_t)e * 1024 + J.n0) * DFE; }
    } else if (it < 47232) { const int r = it - 43008, w = r / 1408, li = r % 1408;
        if (w < 2) { J.src = TIN(23 + w); J.ldw = DFF; kb = li / 88; J.n0 = (li % 88) * 32; J.ldd = 1024; J.dst = ws + WS_FFN1 + (size_t)(256 * (J.n0 / 128) + (J.n0 % 128) + 128 * w) * 1024 * 2; }
        else { J.src = TIN(25); J.ldw = 1024; kb = li / 32; J.n0 = (li % 32) * 32; J.ldd = DFF; J.dst = ws + WS_FFN2 + (size_t)J.n0 * DFF * 2; }
    } else if (it >= 56000) { const int r = it - 56000, l = r / 2048, q = r % 2048; kb = q / 128; const int nb = q % 128; J.esz = 1; J.scale = WIN_S;
        J.src = TIN(7) + (size_t)l * 1024 * 6400; J.ldw = 6400; J.n0 = 2304 + 32 * nb; J.ldd = 1024; J.dst = ws + WS_WG8 + ((size_t)l * 4096 + 32 * nb) * 1024;
    } else { const int r = it - 47232, l = r / 4384, q = r % 4384;
        if (q < 3328) { const int t = q / 128, li = q % 128; kb = li / 8; const int nb = li % 8; if (l == 1 && t >= 7 && t < 23) J.esz = 0;
            const int srcc = t < 4 ? 256 * t : (t < 7 ? 256 * (t + 1) : (t < 23 ? 2304 + 256 * (t - 7) : (t == 23 ? 768 : (t == 24 ? 1024 : 2048))));
            J.src = TIN(7) + (size_t)l * 1024 * 6400; J.ldw = 6400; J.n0 = srcc + 32 * nb; J.ldd = 1024; J.dst = ws + WS_WIN + ((size_t)(l * 26 + t) * 256 + 32 * nb) * 1024 * 2; J.scale = (t == 3 || t == 23) ? 0.125f : 1.f; }
        else if (q < 3360) { const int li = q - 3328; kb = li / 8; J.n0 = (li % 8) * 32; J.src = TIN(16) + (size_t)l * 65536; J.ldw = 256; J.ldd = 256; J.dst = ws + WS_WGLU + ((size_t)l * 256 + J.n0) * 256 * 2; }
        else if (q < 3872) { const int li = q - 3360, bb = li / 128, li2 = li % 128; kb = li2 / 32; J.n0 = (li2 % 32) * 32; J.src = TIN(21) + (size_t)(l * 4 + bb) * 256 * 1024; J.ldw = 1024; J.ldd = 1024; J.dst = ws + WS_WBR + (((size_t)l * 1024 + J.n0) * 1024 + bb * 256) * 2; }
        else { const int li = q - 3872; kb = li / 32; J.n0 = (li % 32) * 32; J.src = TIN(22) + (size_t)l * 1024 * 1024; J.ldw = 1024; J.ldd = 1024; J.dst = ws + WS_WOUT + ((size_t)l * 1024 + J.n0) * 1024 * 2; }
    }
    J.k0 = kb * 64;
#undef TIN
}
__device__ __forceinline__ void tr_load(const TrJob& J, int lane, float (&v)[32]) {
    if (J.esz == 0) return;
#pragma unroll
    for (int i = 0; i < 32; ++i) { const int kk = 2 * i + (lane >> 5); v[i] = __builtin_nontemporal_load(J.src + (size_t)(J.k0 + kk) * J.ldw + J.n0 + (lane & 31)); } }
__device__ __forceinline__ void tr_store(const TrJob& J, int lane, const float (&v)[32], LAS float* scr) {
    if (J.esz == 0) return;
#pragma unroll
    for (int i = 0; i < 32; ++i) { const int kk = 2 * i + (lane >> 5); scr[kk * 33 + (lane & 31)] = v[i]; }
    LDS_WAIT(); asm volatile("" ::: "memory");
    const int c = lane & 7;
#pragma unroll
    for (int j = 0; j < 4; ++j) { const int n = (lane >> 3) + 8 * j; const LAS float* s = scr + (8 * c) * 33 + n; const float sc = J.scale;
        if (J.esz == 2) { u32x4 o; o.x = pk2(s[0 * 33] * sc, s[1 * 33] * sc); o.y = pk2(s[2 * 33] * sc, s[3 * 33] * sc); o.z = pk2(s[4 * 33] * sc, s[5 * 33] * sc); o.w = pk2(s[6 * 33] * sc, s[7 * 33] * sc);
            *(u32x4*)(J.dst + ((size_t)n * J.ldd + J.k0 + 8 * c) * 2) = o; }
        else { u32x2 o; o.x = pk4_f8(s[0 * 33] * sc, s[1 * 33] * sc, s[2 * 33] * sc, s[3 * 33] * sc); o.y = pk4_f8(s[4 * 33] * sc, s[5 * 33] * sc, s[6 * 33] * sc, s[7 * 33] * sc);
            *(u32x2*)(J.dst + (size_t)n * J.ldd + J.k0 + 8 * c) = o; } }
    LDS_WAIT(); asm volatile("" ::: "memory");
}

__device__ __forceinline__ void tr_static(const CAS Args* ap_, unsigned char* ws, LAS float* scr, int w0, int np, int lane) {
#pragma unroll 1
    for (int p = 0; p < np; ++p) { const int g = 2 * (w0 + p); float a0[32], a1[32]; TrJob j0, j1;
        tr_decode(g, ap_, ws, j0); tr_load(j0, lane, a0); tr_decode(g + 1, ap_, ws, j1); tr_load(j1, lane, a1);
        tr_store(j0, lane, a0, scr); tr_store(j1, lane, a1, scr); }
}

__device__ __forceinline__ void cs2pi(int m, int N, float& c, float& s) { sincospif(2.0f * (float)(m % N) / (float)N, &s, &c); }

__global__ void __launch_bounds__(NTHREADS, 2) mk_fwd(Args args) {
    extern __shared__ __attribute__((aligned(16))) unsigned char lds_raw[];
    LAS unsigned char* lds = (LAS unsigned char*)lds_raw;
    const int tid0 = threadIdx.x, wave = __builtin_amdgcn_readfirstlane(tid0 >> 6);
    const int G = gridDim.x, bx = blockIdx.x, vcu = (G % 8 == 0) ? (bx % 8) * (G / 8) + bx / 8 : bx;
    const int wslot = wave * G + vcu, NW = G * NWAVES;
    volatile LAS unsigned* lctl = (volatile LAS unsigned*)(lds + LDSCTL_OFF);
    for (int u = tid0; u < (LDS_BYTES - LDSCTL_OFF) / 4; u += NTHREADS) lctl[u] = 0u;
    __syncthreads();
    const int lo = args.ph_lo, hi = args.ph_hi, bli = args.li;
#ifdef MK_STAMP_PHASE
    if (wave == 0) *(volatile LAS unsigned long long*)(lctl + 64) = __builtin_amdgcn_s_memrealtime();
#endif
    { XcdBarrier b0 = xcd_barrier_post((unsigned*)(args.ws + WS_CTL) + CW_BAR + bli * XCD_BAR_WORDS, lctl + LW_BAR); (void)b0; }
#define IN(k) (lo <= (k) && (k) < hi)
#ifndef MK_DBL
#define MK_DBL 0
#endif
#define MK_NR(k) (MK_DBL == (k) ? 2 : 1)
#ifndef MK_REP_MASK
#define MK_REP_MASK 0u
#endif
#define NREP(k) (((MK_REP_MASK >> (k)) & 1u) ? 2 : 1)
#define FORCE_BAR do { PH_BEGIN XcdBarrier b_; b_.bar = (unsigned*)(ws + WS_CTL) + CW_BAR + bli * XCD_BAR_WORDS; b_.x = xb_xcc_id(); b_.st = lctl + LW_BAR; xcd_barrier(b_); } while (0)
#ifdef MK_STAMP_PHASE
#define STAMP_AT(k) do { if (wave == 0) { if ((k) == MK_STAMP_PHASE - 1) *(volatile LAS unsigned long long*)(lctl + 64) = __builtin_amdgcn_s_memrealtime(); if ((k) == MK_STAMP_PHASE) *(volatile LAS unsigned long long*)(lctl + 66) = __builtin_amdgcn_s_memrealtime(); } } while (0)
#else
#define STAMP_AT(k) do { } while (0)
#endif
#define SEAM(k) do { if (IN(k) && IN((k) + 1)) { PH_BEGIN XcdBarrier b_; b_.bar = (unsigned*)(ws + WS_CTL) + CW_BAR + bli * XCD_BAR_WORDS; b_.x = xb_xcc_id(); b_.st = lctl + LW_BAR; xcd_barrier(b_); } STAMP_AT(k); } while (0)
#define PH_BEGIN int tid; { int l_; asm volatile("v_mbcnt_lo_u32_b32 %0, -1, 0\n\tv_mbcnt_hi_u32_b32 %0, -1, %0" : "=v"(l_)); tid = wave * 64 + (l_ & 63); } const CAS Args* ap_ = (const CAS Args*)__builtin_amdgcn_kernarg_segment_ptr(); asm volatile("" : "+s"(ap_)); unsigned char* ws = (unsigned char*)(GAS unsigned char*)ap_->ws; const int lane = tid & 63; (void)lane;
#define AIN(k) ((const float*)(const GAS float*)ap_->in[k])
#define AOUT ((float*)(GAS float*)ap_->out)
#define XB ((bf16*)(ws + WS_XB))
#define MODp ((float*)(ws + CTL_MOD_OFF))
#define ctxbuf ((float*)(ws + WS_CTXBUF))
#define Hh ((bf16*)(ws + WS_H))
#define MIX ((bf16*)(ws + WS_MIX))
#define INP ((bf16*)(ws + WS_INP))
#define Tt ((bf16*)(ws + WS_T))

    for (int rep_ = 0; rep_ < NREP(0); ++rep_) if (IN(0)) { if (rep_) { FORCE_BAR; } PH_BEGIN
        for (int dd_ = 0; dd_ < MK_NR(20); ++dd_) for (int it = bx; it < 32; it += G) {
            const int l = it >> 4, g = it & 15;
            LAS f32x2* apow = (LAS f32x2*)lds; LAS f32x2* bbar = (LAS f32x2*)(lds + 8704); LAS f32x2* Cc = (LAS f32x2*)(lds + 16896); LAS float* Kt = (LAS float*)(lds + 25088);
            for (int dir = 0; dir < 2; ++dir) { const size_t pg = (size_t)(l * 2 + dir) * 16 + g;
                if (tid < 64) { const int p = tid;
                    const float are = AIN(8)[pg * 64 + p], aim = AIN(9)[pg * 64 + p], dt = expf(AIN(10)[pg]);
                    for (int t = 0; t <= 16; ++t) { const float mag = expf(are * dt * (float)t); float sn, cs; sincosf(aim * dt * (float)t, &sn, &cs); apow[t * 64 + p] = (f32x2){mag * cs, mag * sn}; }
                    const f32x2 a = apow[64 + p]; const float nr = a.x - 1.f, ni = a.y, den = 1.f / (are * are + aim * aim);
                    const float cr = (nr * are + ni * aim) * den, ci = (ni * are - nr * aim) * den;
                    for (int h = 0; h < 16; ++h) { const float br = AIN(11)[(pg * 64 + p) * 16 + h], bi = AIN(12)[(pg * 64 + p) * 16 + h]; bbar[p * 16 + h] = (f32x2){cr * br - ci * bi, cr * bi + ci * br}; }
                    *(f32x2*)((float*)(ws + WS_A16) + (pg * 64 + p) * 2) = apow[16 * 64 + p];
                }
                for (int i = tid; i < 1024; i += NTHREADS) Cc[i] = (f32x2){AIN(13)[pg * 1024 + i], AIN(14)[pg * 1024 + i]};
                __syncthreads();
                bf16* M1 = (bf16*)(ws + WS_S5M1) + ((size_t)(l * 16 + g) * 2 + dir) * 128 * 256;
                for (int v = tid; v < 4096; v += NTHREADS) { const int row = v >> 5, col0 = (v & 31) * 8, j = col0 >> 4, h0 = col0 & 15, p = row >> 1, ri = row & 1;
                    const f32x2 pw = apow[(dir == 0 ? 15 - j : j) * 64 + p]; float vals[8];
#pragma unroll
                    for (int hh = 0; hh < 8; ++hh) { const f32x2 bb = bbar[p * 16 + h0 + hh]; vals[hh] = ri ? pw.x * bb.y + pw.y * bb.x : pw.x * bb.x - pw.y * bb.y; }
                    *(bf16x8*)(M1 + ((((col0 >> 4) * 4 + (row >> 5)) * 64 + ((col0 >> 3) & 1) * 32 + (row & 31)) * 8)) = pack8(vals); }
                bf16* TAB = (bf16*)(ws + WS_S5TAB) + (size_t)(l * 16 + g) * 256 * 512;
                for (int v = tid; v < 4096; v += NTHREADS) { const int row = v >> 4, cv = v & 15, i = row >> 4, ho = row & 15; float vals[8];
#pragma unroll
                    for (int pp = 0; pp < 4; ++pp) { const int p = cv * 4 + pp; const f32x2 cc = Cc[ho * 64 + p];
                        const f32x2 pw = apow[(dir == 0 ? i + 1 : 16 - i) * 64 + p]; vals[2 * pp] = cc.x * pw.x - cc.y * pw.y; vals[2 * pp + 1] = -(cc.x * pw.y + cc.y * pw.x); }
                    { const int colt = 256 + dir * 128 + cv * 8; *(bf16x8*)(TAB + (((((row >> 7) * 32 + (colt >> 4)) * 4 + ((row >> 5) & 3)) * 64 + ((colt >> 3) & 1) * 32 + (row & 31)) * 8)) = pack8(vals); } }
                for (int e = tid; e < 4096; e += NTHREADS) { const int t = e >> 8, ho = (e >> 4) & 15, h = e & 15; float acc = 0.f;
#pragma unroll 8
                    for (int p = 0; p < 64; ++p) { const f32x2 cc = Cc[ho * 64 + p], pw = apow[t * 64 + p], bb = bbar[p * 16 + h];
                        const float xr = cc.x * pw.x - cc.y * pw.y, xi = cc.x * pw.y + cc.y * pw.x; acc += xr * bb.x - xi * bb.y; }
                    Kt[dir * 4096 + e] = acc; }
                __syncthreads();
            }
            for (int v = tid; v < 8192; v += NTHREADS) { const int row = v >> 5, col0 = (v & 31) * 8, i = row >> 4, ho = row & 15, j = col0 >> 4, h0 = col0 & 15; float vals[8];
#pragma unroll
                for (int hh = 0; hh < 8; ++hh) { const int h = h0 + hh;
                    vals[hh] = j < i ? Kt[(i - j) * 256 + ho * 16 + h] : (j > i ? Kt[4096 + (j - i) * 256 + ho * 16 + h] : Kt[ho * 16 + h] + Kt[4096 + ho * 16 + h] + (ho == h ? AIN(15)[l * 256 + g * 16 + h] : 0.f)); }
                *(bf16x8*)((bf16*)(ws + WS_S5TAB) + (size_t)(l * 16 + g) * 256 * 512 + (((((row >> 7) * 32 + (col0 >> 4)) * 4 + ((row >> 5) & 3)) * 64 + ((col0 >> 3) & 1) * 32 + (row & 31)) * 8)) = pack8(vals); }
            __syncthreads();
        }
        __syncthreads();
        for (int it = (bx >= 32 ? bx - 32 : bx + G - 32); it < 192; it += G) { const int l = it / 96, cb = it % 96, col = cb * 64 + lane, ks = wave;
            const float* wm = AIN(4) + ((size_t)l * 1024 + ks * 128) * 6144 + col; float a0 = 0.f, a1 = 0.f, a2 = 0.f;
#pragma unroll
            for (int hf = 0; hf < 2; ++hf) { const int kl = ks * 128 + hf * 64 + lane;
                const float c0 = AIN(1)[kl], c1 = AIN(1)[1024 + kl], c2 = AIN(3)[kl];
                const float s0 = c0 / (1.f + __expf(-c0)), s1 = c1 / (1.f + __expf(-c1)), s2 = c2 / (1.f + __expf(-c2));
#pragma unroll 32
                for (int k = 0; k < 64; ++k) { const float w = __builtin_nontemporal_load(wm + (size_t)(hf * 64 + k) * 6144);
                    a0 += w * __builtin_bit_cast(float, __builtin_amdgcn_readlane(__builtin_bit_cast(int, s0), k)); a1 += w * __builtin_bit_cast(float, __builtin_amdgcn_readlane(__builtin_bit_cast(int, s1), k));
                    a2 += w * __builtin_bit_cast(float, __builtin_amdgcn_readlane(__builtin_bit_cast(int, s2), k)); } }
            LAS float* part = (LAS float*)lds;
            part[(wave * 3 + 0) * 64 + lane] = a0; part[(wave * 3 + 1) * 64 + lane] = a1; part[(wave * 3 + 2) * 64 + lane] = a2;
            __syncthreads();
            if (tid < 192) { const int i = tid >> 6, c = tid & 63; float sacc = AIN(5)[l * 6144 + cb * 64 + c];
#pragma unroll
                for (int w = 0; w < 8; ++w) sacc += part[(w * 3 + i) * 64 + c];
                MODp[(size_t)(l * 3 + i) * 6144 + cb * 64 + c] = sacc; }
            __syncthreads();
        }
        { LAS float* scr = (LAS float*)(lds + wave * 16384);
          unsigned* qh = (unsigned*)(ws + WS_CTL) + CW_QHEAD;
          int q = bx & 7, tries = 0;
#define TR_POP(dst) do { dst = -1; while (tries < 8) { unsigned b_ = 0u; if (lane == 0) b_ = __hip_atomic_fetch_add(qh + 64 * q, 2u, __ATOMIC_RELAXED, __HIP_MEMORY_SCOPE_AGENT); \
              b_ = (unsigned)__builtin_amdgcn_readfirstlane((int)b_); if (b_ < (unsigned)NTRPQ) { dst = NTRD + q * NTRPQ + (int)b_; break; } q = (q + 1) & 7; ++tries; } } while (0)
#define TR_LOAD2(VA, VB, g_) do { TrJob j_; tr_decode(g_, ap_, ws, j_); tr_load(j_, lane, VA); tr_decode((g_) + 1, ap_, ws, j_); tr_load(j_, lane, VB); } while (0)
#define TR_STORE2(VA, VB, g_) do { TrJob j_; tr_decode(g_, ap_, ws, j_); tr_store(j_, lane, VA, scr); { tr_decode((g_) + 1, ap_, ws, j_); tr_store(j_, lane, VB, scr); } } while (0)
          float a0[32], a1[32], b0[32], b1[32]; int s0, s1;
          TR_POP(s0); if (s0 >= 0) TR_LOAD2(a0, a1, s0);
          TR_POP(s1);
          while (s0 >= 0) {
              int s2, s3 = -1;
              if (s1 >= 0) TR_LOAD2(b0, b1, s1);
              TR_POP(s2);
              TR_STORE2(a0, a1, s0);
              if (s1 < 0) break;
              if (s2 >= 0) TR_LOAD2(a0, a1, s2);
              TR_POP(s3);
              TR_STORE2(b0, b1, s1);
              s0 = s2; s1 = s3;
          }
#undef TR_POP
#undef TR_LOAD2
#undef TR_STORE2
        }
        for (int v = wslot * 64 + lane; v < 32 * SEQ; v += NW * 64) { const int p = v >> 13, t = v & 8191; const float pos = (float)(p < 16 ? (t >> 6) : (t & 63));
            const float inv = 1.0f / powf(10000.f, (float)(p & 15) / 16.f); float sn, cs; sincosf(pos * inv, &sn, &cs);
            ((float*)(ws + WS_COST))[v] = cs; ((float*)(ws + WS_SINT))[v] = sn; ((float*)(ws + WS_COSN))[t * 32 + p] = cs; ((float*)(ws + WS_SINN))[t * 32 + p] = sn; }
        for (int v = wslot * 64 + lane; v < 192512; v += NW * 64) { float c, s;
            if (v < 32768) { const int ri = v >> 14, k1 = (v >> 7) & 127, l1 = v & 127; cs2pi(k1 * l1, 128, c, s); const float sc = 0.08838834764831845f;
                ((bf16*)(ws + WS_W128T))[v] = (bf16)(pk2(ri ? -s * sc : c * sc, 0.f) & 0xffffu); }
            else if (v < 40960) { const int u = v - 32768, l2 = u >> 7, k1 = u & 127; cs2pi(k1 * l2, 8192, c, s); ((float*)(ws + WS_TWC))[u] = c; ((float*)(ws + WS_TWS))[u] = s; }
            else if (v < 53248) { const int u = v - 40960, w = u >> 12, m = (u >> 6) & 63, cc = u & 63; cs2pi(m * cc, 64, c, s);
                ((bf16*)(ws + WS_FCT))[u] = (bf16)(pk2((w == 0 ? c : (w == 1 ? s : -s)) * 0.125f, 0.f) & 0xffffu); }
            else if (v < 61440) { const int u = v - 53248, w = u >> 12, k2 = (u >> 6) & 63, l2 = u & 63; cs2pi(k2 * l2, 64, c, s); ((bf16*)(ws + WS_W64T))[u] = (bf16)(pk2((w == 0 ? c : s) * 0.125f, 0.f) & 0xffffu); }
            else { const int u = v - 61440, w = u >> 16, k = (u >> 8) & 255, l = u & 255; cs2pi(k * l, 256, c, s); ((bf16*)(ws + WS_W256T))[u] = (bf16)(pk2((w == 0 ? c : s) * 0.0625f, 0.f) & 0xffffu); }
        }
    }
    SEAM(0);

    for (int rep_ = 0; rep_ < NREP(1); ++rep_) if (IN(1)) { if (rep_) { FORCE_BAR; } PH_BEGIN
        { NormCfg C{AIN(0), AIN(2), nullptr, nullptr, nullptr, nullptr, 0, nullptr, nullptr, 0, AIN(6), MODp, 1024, 0, Hh, R, ws + WS_H8, nullptr, nullptr}; norm_rows(C, wslot, NW, lane); }
    }
    SEAM(1);

    for (int layer = 0; layer < 2; ++layer) {
        const int pb = 1 + 11 * layer;
        const int nM = layer == 0 ? 66 : 64;
        const int nrows = layer == 0 ? R : LROWS;
#define normg (AIN(6) + (size_t)layer * 4 * D)
        for (int rep_ = 0; rep_ < NREP(pb + 1); ++rep_) if (IN(pb + 1)) { if (rep_) { FORCE_BAR; } PH_BEGIN
            gp::SchedInprojA S{(const char*)Hh, (const char*)(ws + WS_WIN) + (size_t)layer * 26 * 256 * 2048, 66, G, bx, layer == 0 ? 32 : 0};
            gp::EpiInprojA E{INP, Tt, (unsigned char*)(ws + WS_GCTX)};
            gp::gemm_phase(lds, tid, 1024, 1024, 1024, S, E);
            { const int j = bx - (660 + (layer == 0 ? 32 : 0) - 2 * G);
              if (G == 256 && j >= 0 && j < 66) { PH_BEGIN
                  gp::SchedPlain S2{(const char*)(ws + WS_H8), (const char*)(ws + WS_WG8) + (size_t)layer * 4096 * 1024, (size_t)256 * 1024, (size_t)256 * 1024, 64, 16, 4096, 768 + j, 8};
                  int pm2, pn2; gp::tile_of(768 + j, 64, 16, pm2, pn2);
                  gp::EpiGates E2{(unsigned char*)(ws + WS_Y + 18 * MiB) + (size_t)j * 65536 - gp::gate_off(pm2, pn2 & 3, pn2 >> 2, 0, 0, 0, 0, 0, 0, 0), 1.f / WIN_S};
                  gp::gemm_phase<gp::EpiGates, gp::SchedPlain, true>(lds, tid, 1024, 512, 512, S2, E2); } }
        }
        SEAM(pb + 1);
        for (int rep_ = 0; rep_ < NREP(pb + 2); ++rep_) if (IN(pb + 2)) { if (rep_) { FORCE_BAR; } PH_BEGIN
            LAS float* rpb = (LAS float*)(lds + 98304 + 4096);
            LAS unsigned char* wl = lds + wave * 12288;
            for (int i = tid; i < 1860; i += NTHREADS) rpb[i] = AIN(20)[layer * 1860 + i] * LOG2E;
            __syncthreads();
            const int nitA = 2224 + 64 + (layer == 0 ? 64 : 0);
            for (int it = wslot; it < nitA; it += NW) {
                if (it < 1056) s5_state_item((const bf16*)(ws + WS_S5M1) + (size_t)layer * 16 * 2 * 128 * 256, INP + (size_t)R * 256, (bf16*)(ws + WS_HLOC), it, lane);
                else if (it < 1584) ret_kv_item(Tt, Tt + (size_t)256 * R, (const float*)(ws + WS_COST), (const float*)(ws + WS_SINT), AIN(18) + layer * 8, (float*)(ws + WS_KV), it - 1056, lane);
                else if (it < 2096) fft1_item(INP, (const bf16*)(ws + WS_W128T), (const float*)(ws + WS_TWC), (const float*)(ws + WS_TWS), (bf16*)(ws + WS_FB), it - 1584, lane);
                else if (it < 2224) rope_item(INP + (size_t)2 * R * 256, INP + (size_t)3 * R * 256, (const float*)(ws + WS_COSN), (const float*)(ws + WS_SINN), it - 2096, lane);
                else { int ln = lane; asm volatile("" : "+v"(ln));
                    if (it < 2288) { const int j = 1984 + (it - 2224); na_item(INP + (size_t)5 * R * 256, INP + (size_t)6 * R * 256, Tt + (size_t)512 * R, MIX, rpb, wl, false, j >> 10, (j >> 3) & 127, (j >> 1) & 3, j & 1, ln); }
                    else { const int j = it - 2288; na_item(INP + (size_t)5 * R * 256, INP + (size_t)6 * R * 256, Tt + (size_t)512 * R, MIX, rpb, wl, true, j >> 5, 0, (j >> 3) & 3, j & 7, ln); } }
            }
            __syncthreads();
        }
        SEAM(pb + 2);
        for (int rep_ = 0; rep_ < NREP(pb + 3); ++rep_) if (IN(pb + 3)) { if (rep_) { FORCE_BAR; } PH_BEGIN
            LAS float* rpb = (LAS float*)(lds + 98304 + 4096); LAS unsigned char* wl = lds + wave * 12288;
            for (int i = tid; i < 1860; i += NTHREADS) rpb[i] = AIN(20)[layer * 1860 + i] * LOG2E;
            __syncthreads();
            for (int vs = wslot; vs < 2048; vs += NW) {
                if (vs < 64) s5_scan_item((const float*)(ws + WS_A16) + (size_t)layer * 2 * 16 * 64 * 2, (const bf16*)(ws + WS_HLOC), (bf16*)(ws + WS_HIN), wl, vs, lane);
                else { const int j = vs - 64; na_item(INP + (size_t)5 * R * 256, INP + (size_t)6 * R * 256, Tt + (size_t)512 * R, MIX, rpb, wl, false, j >> 10, (j >> 3) & 127, (j >> 1) & 3, j & 1, lane);
                    if (vs >= 1024) ret_scan_item(AIN(18) + layer * 8, (const float*)(ws + WS_KV), (bf16*)(ws + WS_SPREV), vs - 1024, lane); }
            }
            __syncthreads();
        }
        SEAM(pb + 3);
        for (int rep_ = 0; rep_ < NREP(pb + 4); ++rep_) if (IN(pb + 4)) { if (rep_) { FORCE_BAR; } PH_BEGIN
            const int nit = 1056 + 2112 + 2048 + (layer == 0 ? 128 : 0);
            for (int it = wslot; it < nit; it += NW) {
                if (it < 1056) s5_out_item((const bf16*)(ws + WS_S5TAB) + (size_t)layer * 16 * 256 * 512, INP + (size_t)R * 256, (const bf16*)(ws + WS_HIN), (bf16*)(ws + WS_Z), it, lane);
                else if (it < 3168) ret_out_item(INP + (size_t)2 * R * 256, INP + (size_t)3 * R * 256, INP + (size_t)4 * R * 256, Tt + (size_t)256 * R, (const bf16*)(ws + WS_SPREV),
                                                 AIN(18) + layer * 8, AIN(19) + layer * 256, MIX, lds + wave * 12288, it - 1056, lane);
                else if (it < 5216) fft2_item((const bf16*)(ws + WS_FB), (const bf16*)(ws + WS_FCT), (const bf16*)(ws + WS_W64T), MIX, it - 3168, lane);
                else fftc_item(INP, (const bf16*)(ws + WS_FCT), (const bf16*)(ws + WS_W256T), MIX, it - 5216, lane);
            }
        }
        SEAM(pb + 4);
        for (int rep_ = 0; rep_ < NREP(pb + 5); ++rep_) if (IN(pb + 5)) { if (rep_) { FORCE_BAR; } PH_BEGIN
            { PH_BEGIN gp::SchedPlain S{(const char*)(ws + WS_Z), (const char*)(ws + WS_WGLU) + (size_t)layer * 256 * 512, (size_t)256 * 512, (size_t)256 * 512, nM, 1, G, bx, 4};
              gp::EpiGlu E{(const bf16*)(ws + WS_Z), MIX, AIN(17) + layer * 256};
              gp::gemm_phase(lds, tid, 256, 256, 256, S, E); }
            if (G == 256 && bx < 66) { PH_BEGIN
                int pm, pn; gp::tile_of(768 + bx, 64, 16, pm, pn); const size_t off = gp::gate_off(pm, pn & 3, pn >> 2, 0, 0, 0, 0, 0, 0, 0) + (size_t)tid * 128;
                u32x4 t_[8];
#pragma unroll
                for (int i = 0; i < 8; ++i) t_[i] = *(const u32x4*)(ws + WS_Y + 18 * MiB + (size_t)bx * 65536 + (size_t)tid * 128 + 16 * i);
#pragma unroll
                for (int i = 0; i < 8; ++i) *(u32x4*)(ws + WS_GATES + off + 16 * i) = t_[i]; }
            { PH_BEGIN gp::SchedPlain S{(const char*)(ws + WS_H8), (const char*)(ws + WS_WG8) + (size_t)layer * 4096 * 1024, (size_t)256 * 1024, (size_t)256 * 1024, 64, 16, G, bx, 8, (G == 256 && bx < 66) ? 768 : 0x7fffffff};
              gp::EpiGates E{(unsigned char*)(ws + WS_GATES), 1.f / WIN_S};
              gp::gemm_phase<gp::EpiGates, gp::SchedPlain, true>(lds, tid, 1024, 512, 512, S, E); }
        }
        SEAM(pb + 5);
        for (int rep_ = 0; rep_ < NREP(pb + 6); ++rep_) if (IN(pb + 6)) { if (rep_) { FORCE_BAR; } PH_BEGIN
            gp::SchedMerge S{(const char*)MIX, (const char*)(ws + WS_WBR) + (size_t)layer * 1024 * 2048, layer == 0 ? 32 : 0, G, bx};
            gp::EpiMerge E{(const unsigned char*)(ws + WS_GATES), (const unsigned char*)(ws + WS_GCTX), (bf16*)(ws + WS_Y), (bf16*)(ws + WS_YP)};
            gp::gemm_phase(lds, tid, 1024, 1024, 1024, S, E);
        }
        SEAM(pb + 6);
        for (int rep_ = 0; rep_ < NREP(pb + 7); ++rep_) if (IN(pb + 7)) { if (rep_) { FORCE_BAR; } PH_BEGIN
            gp::SchedSplit S{(const char*)(ws + WS_Y), (const char*)(ws + WS_WOUT) + (size_t)layer * 1024 * 2048, (size_t)256 * 2048, (size_t)256 * 2048, layer == 0 ? 16 : 0, 16, G, bx,
                             (const char*)(ws + WS_YP), (size_t)256 * 2048, (size_t)CROWS * 2048, 4};
            gp::EpiPlainSplit E{(bf16*)(ws + (layer == 0 ? WS_YO : WS_YO1)), 1024, (float*)(ws + WS_PARTW), 16};
            gp::gemm_phase(lds, tid, 1024, 1024, 1024, S, E);
        }
        SEAM(pb + 7);
        for (int rep_ = 0; rep_ < NREP(pb + 8); ++rep_) if (IN(pb + 8)) { if (rep_) { FORCE_BAR; } PH_BEGIN
            if (layer == 0) {
                NormCfg C{AIN(0), AIN(2), nullptr, ctxbuf, (const bf16*)(ws + WS_YO), (const float*)(ws + WS_PARTW), 16, normg + D, MODp, 2048, normg + 2 * D, MODp, 4096, 3072, Hh, R, nullptr, nullptr, XB};
                norm_rows(C, wslot, NW, lane);
            } else {
                LAS float* wrs = (LAS float*)lds; LAS int* rowinfo = (LAS int*)(lds + 32768); LAS unsigned* cntL = (LAS unsigned*)(lds + 32768 + 1024); LAS unsigned* baseL = cntL + 8; LAS unsigned char* hst = lds + 40960;
                for (int i = tid; i < 2048; i += NTHREADS) { const int k = i >> 1; ((LAS f32x4*)wrs)[((((k >> 8) * 4 + (k & 3)) * 64 + ((k >> 2) & 63)) << 1) + (i & 1)] = ((const f32x4*)AIN(26))[i]; }
                int* list = (int*)(ws + WS_LIST); float* routew = (float*)(ws + WS_ROUTEW);
                f32x4 gAv[4], gBv[4]; row_ld_f32(normg + D, lane, gAv); row_ld_f32(normg + 2 * D, lane, gBv);
                float rbias[8];
#pragma unroll
                for (int e = 0; e < 8; ++e) rbias[e] = AIN(27)[e];
                for (int grp = vcu; grp < 256; grp += G) {
                    if (tid < 8) cntL[tid] = 0u;
                    __syncthreads();
                    const int r0 = grp * 64 + wave * 8; const float* md = MODp + (size_t)(3 + (r0 < SEQ ? 0 : 1)) * 6144;
                    f32x4 gav[4], scv[4], shv[4]; row_ld_f32(md + 2048, lane, gav); row_ld_f32(md + 4096, lane, scv); row_ld_f32(md + 3072, lane, shv);
                    u32x2 xn[4]; u32x2 tn[4]; row_ld_raw16(XB + (size_t)r0 * D, lane, xn);
#pragma unroll
                    for (int j = 0; j < 4; ++j) tn[j] = *(const u32x2*)((const bf16*)(ws + WS_YO1) + (size_t)r0 * D + 256 * j + 4 * lane);
                    for (int rr = 0; rr < 8; ++rr) { const int r = r0 + rr;
                        f32x4 x[4], t[4], hh[4];
#pragma unroll
                        for (int j = 0; j < 4; ++j) { x[j] = (f32x4){bflo(xn[j].x), bfhi(xn[j].x), bflo(xn[j].y), bfhi(xn[j].y)}; t[j] = (f32x4){bflo(tn[j].x), bfhi(tn[j].x), bflo(tn[j].y), bfhi(tn[j].y)}; }
                        if (rr < 7) { row_ld_raw16(XB + (size_t)(r + 1) * D, lane, xn);
#pragma unroll
                            for (int j = 0; j < 4; ++j) tn[j] = *(const u32x2*)((const bf16*)(ws + WS_YO1) + (size_t)(r + 1) * D + 256 * j + 4 * lane); }
                        { const float rs = row_rstd(t);
#pragma unroll
                          for (int j = 0; j < 4; ++j) x[j] = x[j] + gav[j] * (t[j] * rs * gAv[j]); }
                        row_st_bf16(XB + (size_t)r * D, lane, x);
                        { const float rs = row_rstd(x);
#pragma unroll
                          for (int j = 0; j < 4; ++j) hh[j] = x[j] * rs * gBv[j] * (scv[j] + 1.f) + shv[j]; }
#pragma unroll
                        for (int j = 0; j < 4; ++j) *(LAS unsigned*)(hst + (wave * 8 + rr) * 1024 + 256 * j + 4 * lane) = pk4_f8(hh[j][0], hh[j][1], hh[j][2], hh[j][3]);
                        float lg[8];
#pragma unroll
                        for (int e = 0; e < 8; ++e) lg[e] = 0.f;
#pragma unroll
                        for (int j = 0; j < 4; ++j)
#pragma unroll
                            for (int q = 0; q < 4; ++q) { const LAS float* wp_ = wrs + ((j * 4 + q) * 64 + lane) * 8; const f32x4 w0 = *(const LAS f32x4*)wp_, w1 = *(const LAS f32x4*)(wp_ + 4); const float hv = hh[j][q];
                                lg[0] += hv * w0[0]; lg[1] += hv * w0[1]; lg[2] += hv * w0[2]; lg[3] += hv * w0[3]; lg[4] += hv * w1[0]; lg[5] += hv * w1[1]; lg[6] += hv * w1[2]; lg[7] += hv * w1[3]; }
#pragma unroll
                        for (int e = 0; e < 8; ++e) lg[e] = wave_sum(lg[e]) + rbias[e];
                        int i0 = 0; float v0 = lg[0];
#pragma unroll
                        for (int e = 1; e < 8; ++e) if (lg[e] > v0) { v0 = lg[e]; i0 = e; }
                        int i1 = i0 == 0 ? 1 : 0; float v1 = i0 == 0 ? lg[1] : lg[0];
#pragma unroll
                        for (int e = 0; e < 8; ++e) if (e != i0 && lg[e] > v1) { v1 = lg[e]; i1 = e; }
                        const float w0 = 1.f / (1.f + __expf(v1 - v0)), w1 = 1.f - w0;
                        if (lane == 0) { const unsigned s0 = __hip_atomic_fetch_add(cntL + i0, 1u, __ATOMIC_RELAXED, __HIP_MEMORY_SCOPE_WORKGROUP), s1 = __hip_atomic_fetch_add(cntL + i1, 1u, __ATOMIC_RELAXED, __HIP_MEMORY_SCOPE_WORKGROUP);
                            LAS int* ri = rowinfo + (wave * 8 + rr) * 4; ri[0] = i0; ri[1] = (int)s0; ri[2] = i1; ri[3] = (int)s1; routew[(size_t)r * 2] = w0; routew[(size_t)r * 2 + 1] = w1; }
                        if (lane < 8) ((int*)(ws + WS_SMAP))[(size_t)r * 8 + lane] = -1;
                    }
                    __syncthreads();
                    if (tid < 8) baseL[tid] = __hip_atomic_fetch_add((unsigned*)(ws + WS_CTL) + CW_MOECNT + 64 * tid, cntL[tid], __ATOMIC_RELAXED, __HIP_MEMORY_SCOPE_AGENT);
                    __syncthreads();
                    if (tid < 64) { const LAS int* ri = rowinfo + tid * 4; const int r = grp * 64 + tid;
                        list[ri[0] * LCAP + (int)baseL[ri[0]] + ri[1]] = r * 2; list[ri[2] * LCAP + (int)baseL[ri[2]] + ri[3]] = r * 2 + 1; }
                    for (int rr = 0; rr < 8; ++rr) { const int row = wave * 8 + rr; const LAS int* ri = rowinfo + row * 4;
                        const u32x4 v = *(const LAS u32x4*)(hst + row * 1024 + 16 * lane);
                        const size_t d0 = ((size_t)ri[0] * LCAP + baseL[ri[0]] + (unsigned)ri[1]) * 1024, d1 = ((size_t)ri[2] * LCAP + baseL[ri[2]] + (unsigned)ri[3]) * 1024;
                        *(u32x4*)(ws + WS_H8S + d0 + 16 * lane) = v; *(u32x4*)(ws + WS_H8S + d1 + 16 * lane) = v; }
                    __syncthreads();
                }
            }
        }
        SEAM(pb + 8);
        LAS unsigned* mt = (LAS unsigned*)(lds + LDSCTL_OFF) + LW_MOE;
        if (layer == 1 && (IN(pb + 9) || IN(pb + 10))) { PH_BEGIN
            if (tid == 0) { unsigned off = 0u;
                for (int e = 0; e < 8; ++e) { const unsigned c = __hip_atomic_load((unsigned*)(ws + WS_CTL) + CW_MOECNT + 64 * e, __ATOMIC_RELAXED, __HIP_MEMORY_SCOPE_AGENT); const unsigned m = (c + 255u) >> 8; mt[e] = c; mt[8 + e] = m; mt[16 + e] = off; off += m; }
                mt[24] = off; const unsigned U = off * 4u, full = (U / (unsigned)G) * (unsigned)G, rem = U - full;
                if (rem != 0u && rem <= 32u && full != 0u) { mt[25] = full; mt[26] = rem; } else { mt[25] = U; mt[26] = 0u; } }
            __syncthreads();
        }
        for (int rep_ = 0; rep_ < NREP(pb + 9); ++rep_) if (IN(pb + 9)) { if (rep_) { FORCE_BAR; } PH_BEGIN
            if (layer == 0) {
                gp::SchedPlain S{(const char*)Hh, (const char*)(ws + WS_FFN1), (size_t)256 * 2048, (size_t)256 * 2048, 66, 22, G, bx, 16};
                gp::EpiSwiglu E{(bf16*)(ws + WS_HID), DFF, false};
                gp::gemm_phase(lds, tid, 1024, 1024, 1024, S, E);
            } else {
                gp::SchedMoe1P S{(const char*)(ws + WS_H8S), (const char*)(ws + WS_MOE1), mt, G, vcu, 1024u};
                gp::EpiSwigluF8 E{ws + WS_MHID, DFE, true, 1.f / MOE_W1S, MOE_HS};
                gp::gemm_phase<gp::EpiSwigluF8, gp::SchedMoe1P, true>(lds, tid, 1024, 512, 512, S, E);
            }
        }
        if (layer == 0 && IN(pb + 9) && G == 256 && bx >= 172) { PH_BEGIN
            __syncthreads();
            tr_static(ap_, ws, (LAS float*)(lds + wave * 16384), ((bx - 172) * 8 + wave) * 5, 5, lane);
            __syncthreads(); }
        SEAM(pb + 9);
        for (int rep_ = 0; rep_ < NREP(pb + 10); ++rep_) if (IN(pb + 10)) { if (rep_) { FORCE_BAR; } PH_BEGIN
            if (layer == 0) {
                gp::SchedSplit S{(const char*)(ws + WS_HID), (const char*)(ws + WS_FFN2), (size_t)256 * DFF * 2, (size_t)256 * DFF * 2, 11, DFF / 64, G, bx,
                                 (const char*)(ws + WS_HID) + (size_t)64 * 256 * DFF * 2, (size_t)256 * DFF * 2, 0, 11};
                gp::EpiPlainSplit E{(bf16*)(ws + WS_FO), 1024, (float*)(ws + WS_PARTF), 11};
                gp::gemm_phase(lds, tid, DFF, DFF, DFF, S, E);
            } else {
                { gp::SchedMoe2 S{(const char*)(ws + WS_MHID), (const char*)(ws + WS_MOE2), mt, G, vcu, (unsigned)DFE};
                  gp::EpiMoeDown E{(bf16*)(ws + WS_SLOT), (const int*)(ws + WS_LIST), (const float*)(ws + WS_ROUTEW), mt, 1.f / (MOE_HS * MOE_W2S)};
                  gp::gemm_phase<gp::EpiMoeDown, gp::SchedMoe2, true>(lds, tid, DFE, DFE / 2, DFE / 2, S, E); }
                { PH_BEGIN gp::SchedMoe2S S{(const char*)(ws + WS_MHID), (const char*)(ws + WS_MOE2), mt, G, vcu, (unsigned)DFE};
                  gp::EpiMoePart E{(bf16*)(ws + WS_PARTM), (const int*)(ws + WS_LIST), mt, (int*)(ws + WS_SMAP), 1.f / (MOE_HS * MOE_W2S)};
                  gp::gemm_phase<gp::EpiMoePart, gp::SchedMoe2S, true>(lds, tid, DFE, DFE / 2, DFE / 2, S, E); }
            }
        }
        SEAM(pb + 10);
        for (int rep_ = 0; rep_ < NREP(pb + 11); ++rep_) if (IN(pb + 11)) { if (rep_) { FORCE_BAR; } PH_BEGIN
            if (layer == 0) { PH_BEGIN NormCfg C{nullptr, ctxbuf, nullptr, ctxbuf, (const bf16*)(ws + WS_FO), (const float*)(ws + WS_PARTF), 11, normg + 3 * D, MODp, 5120, AIN(6) + 4 * D, MODp + 3 * 6144, 1024, 0, Hh, R, ws + WS_H8, XB, XB};
                norm_rows(C, wslot, NW, lane); }
            else { PH_BEGIN
                typedef int i32x4 __attribute__((ext_vector_type(4)));
                const bf16* S0 = (const bf16*)(ws + WS_SLOT); const bf16* S1 = S0 + (size_t)LROWS * D; const int* smap = (const int*)(ws + WS_SMAP);
                f32x4 gv[4], ga[4]; row_ld_f32(normg + 3 * D, lane, gv);
                u32x2 xb[4], s0[4], s1[4]; i32x4 m0 = (i32x4){-1, -1, -1, -1}, m1 = m0; int curci = -1;
#pragma unroll
                for (int j = 0; j < 4; ++j) { xb[j] = s0[j] = s1[j] = (u32x2){0u, 0u}; ga[j] = (f32x4){0.f, 0.f, 0.f, 0.f}; }
                int r = wslot;
                if (r < LROWS) { row_ld_raw16(XB + (size_t)r * D, lane, xb); row_ld_raw16(S0 + (size_t)r * D, lane, s0); row_ld_raw16(S1 + (size_t)r * D, lane, s1); m0 = *(const i32x4*)(smap + (size_t)r * 8); m1 = *(const i32x4*)(smap + (size_t)r * 8 + 4); }
                for (; r < LROWS; r += NW) {
                    u32x2 cx[4], c0[4], c1[4]; const i32x4 cm0 = m0, cm1 = m1;
#pragma unroll
                    for (int j = 0; j < 4; ++j) { cx[j] = xb[j]; c0[j] = s0[j]; c1[j] = s1[j]; }
                    const int r2 = r + NW;
                    if (r2 < LROWS) { row_ld_raw16(XB + (size_t)r2 * D, lane, xb); row_ld_raw16(S0 + (size_t)r2 * D, lane, s0); row_ld_raw16(S1 + (size_t)r2 * D, lane, s1); m0 = *(const i32x4*)(smap + (size_t)r2 * 8); m1 = *(const i32x4*)(smap + (size_t)r2 * 8 + 4); }
                    const int ci = r < SEQ ? 0 : 1;
                    if (ci != curci) { curci = ci; row_ld_f32(MODp + (size_t)(3 + ci) * 6144 + 5120, lane, ga); }
                    f32x4 x[4], t[4];
#pragma unroll
                    for (int j = 0; j < 4; ++j) x[j] = (f32x4){bflo(cx[j].x), bfhi(cx[j].x), bflo(cx[j].y), bfhi(cx[j].y)};
                    if ((cm0.x & cm0.y & cm0.z & cm0.w & cm1.x & cm1.y & cm1.z & cm1.w) == -1) {
#pragma unroll
                        for (int j = 0; j < 4; ++j) t[j] = (f32x4){bflo(c0[j].x), bfhi(c0[j].x), bflo(c0[j].y), bfhi(c0[j].y)} + (f32x4){bflo(c1[j].x), bfhi(c1[j].x), bflo(c1[j].y), bfhi(c1[j].y)};
                    } else {
#pragma unroll
                        for (int j = 0; j < 4; ++j) t[j] = (f32x4){0.f, 0.f, 0.f, 0.f};
#pragma unroll
                        for (int k = 0; k < 2; ++k) { const int ent = 2 * r + k; const i32x4 mk = k ? cm1 : cm0;
#pragma unroll
                            for (int j = 0; j < 4; ++j) { const int mm = j == 0 ? mk.x : (j == 1 ? mk.y : (j == 2 ? mk.z : mk.w));
                                if (mm < 0) { const u32x2 w = k ? c1[j] : c0[j]; t[j] = t[j] + (f32x4){bflo(w.x), bfhi(w.x), bflo(w.y), bfhi(w.y)}; }
                                else { const bf16* pp = (const bf16*)(ws + WS_PARTM) + ((size_t)(mm >> 8) * 7 * 256 + (mm & 255)) * 256 + 4 * lane; f32x4 sacc = (f32x4){0.f, 0.f, 0.f, 0.f};
                                    for (int sl = 0; sl < 7; ++sl) { const u32x2 w = *(const u32x2*)(pp + (size_t)sl * 65536); sacc = sacc + (f32x4){bflo(w.x), bfhi(w.x), bflo(w.y), bfhi(w.y)}; }
                                    t[j] = t[j] + sacc * ((const float*)(ws + WS_ROUTEW))[ent]; } } } }
                    const float rs = row_rstd(t);
#pragma unroll
                    for (int j = 0; j < 4; ++j) x[j] = x[j] + ga[j] * (t[j] * rs * gv[j]);
                    row_st_f32_nt(AOUT + (size_t)r * D, lane, x);
                } }
        }
        SEAM(pb + 11);
    }
#ifdef MK_STAMP_PHASE
    if (MK_STAMP_PHASE == NPHASE - 1 && wave == 0) *(volatile LAS unsigned long long*)(lctl + 66) = __builtin_amdgcn_s_memrealtime();
    if (blockIdx.x == 0 && wave == 0) { const unsigned long long st0_ = *(volatile LAS unsigned long long*)(lctl + 64), st1_ = *(volatile LAS unsigned long long*)(lctl + 66); const unsigned long long target = __builtin_amdgcn_s_memrealtime() + (unsigned long long)MK_STAMP_AMP * (st1_ - st0_); while (__builtin_amdgcn_s_memrealtime() < target) __builtin_amdgcn_s_sleep(20); }
#endif
#ifdef MK_EXTRA_BARS
    for (int xb_ = 0; xb_ < MK_EXTRA_BARS; ++xb_) { FORCE_BAR; }
#endif
#undef IN
#undef SEAM
#undef PH_BEGIN
#undef normg
#undef AIN
#undef AOUT
#undef XB
#undef MODp
#undef ctxbuf
#undef Hh
#undef MIX
#undef INP
#undef Tt
}

__global__ void dumpk(const unsigned char* src, size_t nbytes, int isf32, float* out, size_t N, int accum) {
    const size_t i = (size_t)blockIdx.x * blockDim.x + threadIdx.x; if (i >= N) return;
    const size_t ne = isf32 ? nbytes / 4 : nbytes / 2; float s = 0.f;
    for (size_t k = i; k < ne; k += N) s += isf32 ? ((const float*)src)[k] : bf2f(((const bf16*)src)[k]);
    out[i] = accum ? out[i] + s : s;
}
extern "C" void kernel_launch(void* const* d_in, const int* in_sizes, int n_in, void* d_out, int out_size, void* d_ws, size_t ws_size, hipStream_t stream) {
    static int grid = 0;
    if (grid == 0) {
        if (n_in != 31 || out_size != LROWS * D || ws_size < WS_END) { fprintf(stderr, "kernel_launch: unexpected shapes (n_in %d, out %d, ws %zu < %zu)\n", n_in, out_size, ws_size, (size_t)WS_END); grid = -1; return; }
        int dev = 0, cus = 0, per_cu = 0;
        if (hipGetDevice(&dev) != hipSuccess || hipDeviceGetAttribute(&cus, hipDeviceAttributeMultiprocessorCount, dev) != hipSuccess) { grid = -1; return; }
        if (hipFuncSetAttribute((const void*)mk_fwd, hipFuncAttributeMaxDynamicSharedMemorySize, LDS_BYTES) != hipSuccess) { fprintf(stderr, "kernel_launch: hipFuncSetAttribute failed\n"); grid = -1; return; }
        if (hipOccupancyMaxActiveBlocksPerMultiprocessor(&per_cu, (const void*)mk_fwd, NTHREADS, LDS_BYTES) != hipSuccess || per_cu < 1) { fprintf(stderr, "kernel_launch: occupancy query says %d\n", per_cu); }
        (void)hipGetLastError();
        grid = cus;
    }
    if (grid < 0) return;
    (void)hipMemsetAsync((char*)d_ws + WS_CTL, 0, CTL_ZERO_BYTES, stream);
    Args a{};
    for (int i = 0; i < 31; ++i) a.in[i] = (const float*)d_in[i];
    a.out = (float*)d_out; a.ws = (unsigned char*)d_ws;
#if MK_MODE == 1
    a.ph_lo = 0; a.ph_hi = NPHASE; a.li = 0;
    hipLaunchKernelGGL(mk_fwd, dim3(grid), dim3(NTHREADS), LDS_BYTES, stream, a);
#else
    for (int p = 0; p < MK_LAST; ++p) { a.ph_lo = p; a.ph_hi = p + 1; a.li = p; hipLaunchKernelGGL(mk_fwd, dim3(grid), dim3(NTHREADS), LDS_BYTES, stream, a); }
#endif
#ifdef MK_DUMP_OFF
    dumpk<<<(LROWS * D + 255) / 256, 256, 0, stream>>>((const unsigned char*)d_ws + (size_t)(MK_DUMP_OFF), (size_t)(MK_DUMP_BYTES), MK_DUMP_F32, (float*)d_out, (size_t)LROWS * D, 0);
#endif
#ifdef MK_DUMP2_OFF
    dumpk<<<(LROWS * D + 255) / 256, 256, 0, stream>>>((const unsigned char*)d_ws + (size_t)(MK_DUMP2_OFF), (size_t)(MK_DUMP2_BYTES), MK_DUMP2_F32, (float*)d_out, (size_t)LROWS * D, 1);
#endif
#ifdef MK_DUMP3_OFF
    dumpk<<<(LROWS * D + 255) / 256, 256, 0, stream>>>((const unsigned char*)d_ws + (size_t)(MK_DUMP3_OFF), (size_t)(MK_DUMP3_BYTES), MK_DUMP3_F32, (float*)d_out, (size_t)LROWS * D, 1);
#endif
}
```
